# Optimizing an MI355X kernel written in HIP

```python
import math
import jax, jax.numpy as jnp
from jax import lax
import numpy as np

D_MODEL = 2048
BATCH = 4
SEQ = 4096
DEPTH = 2

EPS = 1e-6
GLA_HEADS = 4
GLA_DV = D_MODEL // 2 // GLA_HEADS
GLA_DK = GLA_DV // 2
GLA_QK = GLA_HEADS * GLA_DK
GLA_V = GLA_HEADS * GLA_DV
GLA_RANK = 16
GLA_GATE_NORM = 16.0
GLA_CHUNK = 64
GMLP_HEADS = 8
GMLP_WIDTH = D_MODEL // 2
GMLP_DH = GMLP_WIDTH // GMLP_HEADS
GMLP_CHUNK = 128
IN_COLS = 2 * GLA_QK + 2 * GLA_V + GLA_RANK + 2 * GMLP_WIDTH
N_KEYS = 128
N_EXPERTS = N_KEYS * N_KEYS
PEER_HEADS = 8
PEER_TOPK = 16
PEER_DQ = 256
PEER_BLOCK = 64

kernel_name = "hybrid_gla_gmlp_peer_adaln"


def rmsnorm(x, g):
    xf = x.astype(jnp.float32)
    y = xf * lax.rsqrt(jnp.mean(xf * xf, axis=-1, keepdims=True) + EPS)
    return (y * g.astype(jnp.float32)).astype(x.dtype)


def gla_mixer(q, k, v, r, a_low, w_a2, b_a, norm_g):
    B, S, _ = q.shape
    n = S // GLA_CHUNK
    f32 = jnp.float32
    qh = q.reshape(B, S, GLA_HEADS, GLA_DK).astype(f32) * (GLA_DK ** -0.5)
    kh = k.reshape(B, S, GLA_HEADS, GLA_DK).astype(f32)
    vh = v.reshape(B, S, GLA_HEADS, GLA_DV).astype(f32)
    z = (a_low @ w_a2 + b_a).astype(f32)
    log_a = (jax.nn.log_sigmoid(z) / GLA_GATE_NORM).reshape(B, S, GLA_HEADS, GLA_DK)

    def to_chunks(t):
        return t.reshape(B, n, GLA_CHUNK, GLA_HEADS, t.shape[-1]).transpose(1, 0, 3, 2, 4)

    qc, kc, vc, lac = to_chunks(qh), to_chunks(kh), to_chunks(vh), to_chunks(log_a)
    G = jnp.cumsum(lac, axis=3)
    causal = jnp.tril(jnp.ones((GLA_CHUNK, GLA_CHUNK), dtype=bool))

    def step(state, inp):
        qi, ki, vi, Gi = inp
        diff = Gi[:, :, :, None, :] - Gi[:, :, None, :, :]
        decay = jnp.exp(jnp.where(causal[:, :, None], diff, -jnp.inf))
        attn = jnp.einsum('bhid,bhjd,bhijd->bhij', qi, ki, decay)
        o = attn @ vi + jnp.einsum('bhid,bhde->bhie', qi * jnp.exp(Gi), state)
        g_last = Gi[:, :, -1, :]
        k_dec = ki * jnp.exp(g_last[:, :, None, :] - Gi)
        state = jnp.exp(g_last)[..., None] * state + jnp.einsum('bhjd,bhje->bhde', k_dec, vi)
        return state, o

    state0 = jnp.zeros((B, GLA_HEADS, GLA_DK, GLA_DV), f32)
    _, o = lax.scan(step, state0, (qc, kc, vc, G))
    o = o.transpose(1, 0, 3, 2, 4).reshape(B, S, GLA_HEADS, GLA_DV)
    o = rmsnorm(o, norm_g)
    out = o.reshape(B, S, GLA_V) * jax.nn.silu(r.astype(f32))
    return out.astype(r.dtype)


def gmlp_mixer(u, v, vnorm_g, ws, b, out_g):
    B, S, _ = u.shape
    n = S // GMLP_CHUNK
    u = jax.nn.gelu(u).reshape(B, S, GMLP_HEADS, GMLP_DH)
    v = rmsnorm(jax.nn.gelu(v).reshape(B, S, GMLP_HEADS, GMLP_DH), vnorm_g)
    v = v.reshape(B, n, GMLP_CHUNK, GMLP_HEADS, GMLP_DH)
    w = ws * jnp.tril(jnp.ones((GMLP_CHUNK, GMLP_CHUNK), ws.dtype))
    sv = jnp.einsum('hts,bnshd->bnthd', w, v) + b.T[:, :, None]
    y = u * sv.reshape(B, S, GMLP_HEADS, GMLP_DH)
    y = rmsnorm(y, out_g)
    return y.reshape(B, S, GMLP_WIDTH)


def peer(h, wq, k1, k2, pu, pv):
    B, S, D = h.shape
    T = B * S
    hf = h.reshape(T, D)
    q = (hf @ wq).reshape(T, PEER_HEADS, PEER_DQ).astype(jnp.float32)
    half = PEER_DQ // 2
    s1 = jnp.einsum('thd,hkd->thk', q[..., :half], k1.astype(jnp.float32))
    s2 = jnp.einsum('thd,hkd->thk', q[..., half:], k2.astype(jnp.float32))
    v1, i1 = lax.top_k(s1, PEER_TOPK)
    v2, i2 = lax.top_k(s2, PEER_TOPK)
    cand = (v1[..., :, None] + v2[..., None, :]).reshape(T, PEER_HEADS, PEER_TOPK * PEER_TOPK)
    sc, ci = lax.top_k(cand, PEER_TOPK)
    e = (jnp.take_along_axis(i1, ci // PEER_TOPK, axis=-1) * N_KEYS
         + jnp.take_along_axis(i2, ci % PEER_TOPK, axis=-1))
    g = jax.nn.softmax(sc, axis=-1).astype(h.dtype)
    nb = T // PEER_BLOCK

    def block(args):
        hb, eb, gb = args
        ue = pu[eb]
        a = jax.nn.gelu(jnp.einsum('td,thkd->thk', hb, ue)) * gb
        return jnp.einsum('thk,thkd->td', a, pv[eb])

    y = lax.map(block, (hf.reshape(nb, PEER_BLOCK, D),
                        e.reshape(nb, PEER_BLOCK, PEER_HEADS, PEER_TOPK),
                        g.reshape(nb, PEER_BLOCK, PEER_HEADS, PEER_TOPK)))
    return y.reshape(B, S, D)


def setup_inputs(seed: int = 0) -> dict:
    key = jax.random.key(seed)
    ks = jax.random.split(key, 24)
    D = D_MODEL
    nrm = jax.random.normal
    f32 = jnp.float32
    return {
        "x": nrm(ks[0], (BATCH, SEQ, D), f32),
        "c": nrm(ks[1], (BATCH, D), f32),
        "ada_w": nrm(ks[2], (DEPTH, D, 6 * D), f32) * (0.5 * D ** -0.5),
        "ada_b": nrm(ks[3], (DEPTH, 6 * D), f32) * 0.01,
        "norm1_g": 1.0 + 0.01 * nrm(ks[4], (DEPTH, D), f32),
        "w_in": nrm(ks[5], (DEPTH, D, IN_COLS), f32) * D ** -0.5,
        "gla_w_a2": nrm(ks[6], (DEPTH, GLA_RANK, GLA_QK), f32) * GLA_RANK ** -0.5,
        "gla_b_a": nrm(ks[7], (DEPTH, GLA_QK), f32) * 0.1,
        "gla_norm_g": 1.0 + 0.01 * nrm(ks[8], (DEPTH, GLA_HEADS, GLA_DV), f32),
        "gmlp_vnorm_g": 1.0 + 0.01 * nrm(ks[9], (DEPTH, GMLP_HEADS, GMLP_DH), f32),
        "gmlp_ws": nrm(ks[10], (DEPTH, GMLP_HEADS, GMLP_CHUNK, GMLP_CHUNK), f32) * GMLP_CHUNK ** -0.5,
        "gmlp_b": 1.0 + 0.1 * nrm(ks[11], (DEPTH, GMLP_HEADS, GMLP_CHUNK), f32),
        "gmlp_out_g": 1.0 + 0.01 * nrm(ks[12], (DEPTH, GMLP_HEADS, GMLP_DH), f32),
        "w_out": nrm(ks[13], (DEPTH, D, D), f32) * D ** -0.5,
        "norm2_g": 1.0 + 0.01 * nrm(ks[14], (DEPTH, D), f32),
        "peer_wq": nrm(ks[15], (DEPTH, D, PEER_HEADS * PEER_DQ), f32) * D ** -0.5,
        "peer_k1": nrm(ks[16], (DEPTH, PEER_HEADS, N_KEYS, PEER_DQ // 2), f32) * (PEER_DQ // 2) ** -0.5,
        "peer_k2": nrm(ks[17], (DEPTH, PEER_HEADS, N_KEYS, PEER_DQ // 2), f32) * (PEER_DQ // 2) ** -0.5,
        "peer_u": nrm(ks[18], (DEPTH, N_EXPERTS, D), f32) * D ** -0.5,
        "peer_v": nrm(ks[19], (DEPTH, N_EXPERTS, D), f32) * PEER_HEADS ** -0.5,
        "final_g": 1.0 + 0.01 * nrm(ks[20], (D,), f32),
    }


def reference(x, c, ada_w, ada_b, norm1_g, w_in, gla_w_a2, gla_b_a, gla_norm_g,
              gmlp_vnorm_g, gmlp_ws, gmlp_b, gmlp_out_g, w_out, norm2_g,
              peer_wq, peer_k1, peer_k2, peer_u, peer_v, final_g):
    widths = [GLA_QK, GLA_QK, GLA_V, GLA_V, GLA_RANK, GMLP_WIDTH]
    splits = [int(s) for s in np.cumsum(widths)]
    cond = jax.nn.silu(c)
    for l in range(DEPTH):
        mod = (cond @ ada_w[l] + ada_b[l])[:, None, :]
        sh1, sc1, gt1, sh2, sc2, gt2 = jnp.split(mod, 6, axis=-1)
        h = rmsnorm(x, norm1_g[l]) * (1 + sc1) + sh1
        proj = h @ w_in[l]
        q, k, v, r, a_low, u_sp, v_sp = jnp.split(proj, splits, axis=-1)
        y_gla = gla_mixer(q, k, v, r, a_low, gla_w_a2[l], gla_b_a[l], gla_norm_g[l])
        y_gmlp = gmlp_mixer(u_sp, v_sp, gmlp_vnorm_g[l], gmlp_ws[l], gmlp_b[l], gmlp_out_g[l])
        mix = jnp.concatenate([y_gla, y_gmlp], axis=-1) @ w_out[l]
        x = x + gt1 * mix
        h = rmsnorm(x, norm2_g[l]) * (1 + sc2) + sh2
        x = x + gt2 * peer(h, peer_wq[l], peer_k1[l], peer_k2[l], peer_u[l], peer_v[l])
    return rmsnorm(x, final_g)
```

```cpp
#include <hip/hip_runtime.h>
#include <cstdio>
#include <cstdint>
#ifndef MK_N_LAUNCHES
#define MK_N_LAUNCHES 1
#endif
#define DBG_SIMPLE_TOPK 1
namespace pg8 {
#define PG8_LAS __attribute__((address_space(3)))
typedef unsigned short bf16_t;
typedef short bf16x8 __attribute__((ext_vector_type(8)));
typedef float f32x4 __attribute__((ext_vector_type(4)));
typedef unsigned u32x4 __attribute__((ext_vector_type(4)));
constexpr int BM = 256, BK = 64, HALF = 128, HTB = HALF * BK * 2  , STAGE_BYTES = 8 * HTB, NXCD = 8, WGM = 8;

__host__ __device__ __forceinline__ int lds_byte(int r, int c) { const int st = (r >> 4) * 2 + (c >> 5), rr = r & 15, cc = c & 31, ob = rr * 64 + cc * 2; return st * 1024 + (ob ^ (((ob >> 9) & 1) << 5)); }
__host__ __device__ __forceinline__ void stage_rc(int b, int& R, int& C) { const int st = b / 1024, sb = b % 1024, swz = sb ^ (((sb >> 9) & 1) << 5); R = (st >> 1) * 16 + swz / 64; C = (st & 1) * 32 + (swz % 64) / 2; }
__host__ __device__ __forceinline__ int perm32(int rho) { const int n = rho >> 4, i = rho & 15; return 8 * (i >> 2) + 4 * n + (i & 3); }

struct Unit { int pm, pn; };
struct Gemm { const bf16_t* A; const bf16_t* Bt; int M, N, K; };

struct StaticOrder {
    int nM, nN, nwg, G, c;
    __host__ __device__ void init(int M, int N, int G_, int c_) { nM = M / BM; nN = N / BM; nwg = nM * nN; G = G_; c = c_; }
    __host__ __device__ bool next(int i, Unit& u) const {
        const long L = (long)i * G + c; if (L >= nwg) return false;
        int wgid = (int)L; { const int q = nwg / NXCD, r = nwg % NXCD, xcd = wgid % NXCD, off = wgid / NXCD; wgid = (xcd < r ? xcd * (q + 1) : r * (q + 1) + (xcd - r) * q) + off; }
        const int nig = WGM * nN, gid = wgid / nig, fm = gid * WGM, gsz = (nM - fm) < WGM ? (nM - fm) : WGM;
        u.pm = fm + ((wgid % nig) % gsz); u.pn = (wgid % nig) / gsz; return true;
    }
    __device__ __forceinline__ void a_ready(const Unit&) const {}
    __device__ __forceinline__ void done(const Unit&) const {}
};
__device__ __forceinline__ unsigned cvt_pk_bf16(float lo, float hi) { unsigned r; asm volatile("v_cvt_pk_bf16_f32 %0, %1, %2" : "=v"(r) : "v"(lo), "v"(hi)); return r; }
struct EpiBf16 {
    static constexpr bool PERM = true, AFTER_DRAIN = false;
    bf16_t* O; int ldc;
    __device__ __forceinline__ void operator()(const f32x4 (&acc)[2][2][4][2], const Unit& u, int wr, int wc, int fr, int fq) const {
        const int row0 = u.pm * BM + wr * 64 + fr; const int col0 = u.pn * BM + wc * 32 + 8 * fq;
#pragma unroll
        for (int ai = 0; ai < 2; ++ai)
#pragma unroll
            for (int m = 0; m < 4; ++m) { bf16_t* rowp = O + (size_t)(row0 + ai * HALF + m * 16) * ldc + col0;
#pragma unroll
                for (int bj = 0; bj < 2; ++bj) { const f32x4 v0 = acc[ai][bj][m][0], v1 = acc[ai][bj][m][1];
                    u32x4 w; w.x = cvt_pk_bf16(v0[0], v0[1]); w.y = cvt_pk_bf16(v0[2], v0[3]); w.z = cvt_pk_bf16(v1[0], v1[1]); w.w = cvt_pk_bf16(v1[2], v1[3]);
                    *(u32x4*)(rowp + bj * HALF) = w; } }
    }
};
struct EpiResGate {
    static constexpr bool PERM = false, AFTER_DRAIN = false;
    const float* base; float* out; const float* gate; int gpitch;
    __device__ __forceinline__ void operator()(const f32x4 (&acc)[2][2][4][2], const Unit& u, int wr, int wc, int fr, int fq) const {
        const int row0 = u.pm * BM + wr * 64 + fr, col0 = u.pn * BM + wc * 32 + 4 * fq;
        const float* gp = gate + (size_t)(u.pm >> 4) * gpitch + col0;
        f32x4 gv[2][2];
#pragma unroll
        for (int bj = 0; bj < 2; ++bj)
#pragma unroll
            for (int n = 0; n < 2; ++n) gv[bj][n] = *(const f32x4*)(gp + bj * HALF + n * 16);
#pragma unroll
        for (int ai = 0; ai < 2; ++ai)
#pragma unroll
            for (int m = 0; m < 4; ++m) { const size_t off = (size_t)(row0 + ai * HALF + m * 16) * 2048 + col0;
#pragma unroll
                for (int bj = 0; bj < 2; ++bj)
#pragma unroll
                    for (int n = 0; n < 2; ++n) { const f32x4 bs = *(const f32x4*)(base + off + bj * HALF + n * 16); *(f32x4*)(out + off + bj * HALF + n * 16) = bs + gv[bj][n] * acc[ai][bj][m][n]; }
                asm volatile("" ::: "memory"); }
    }
};

template <class Epi, class Sched>
__device__ __forceinline__ void gemm_phase(PG8_LAS unsigned char* lds, const Gemm g, const Sched& S, const Epi& E) {
    const int tid = threadIdx.x, wid = __builtin_amdgcn_readfirstlane(tid >> 6), lane = tid & 63, wr = wid >> 2, wc = wid & 3, fr = lane & 15, fq = lane >> 4;
    const int K = g.K, nt = K / BK;
    unsigned voffA[2], voffB[2];
#pragma unroll
    for (int i = 0; i < 2; ++i) { int R, C; stage_rc(tid * 16 + i * 8192, R, C); const int Rb = Epi::PERM ? ((R & ~31) + perm32(R & 31)) : R;
        voffA[i] = (unsigned)(R * K + C) * 2u; voffB[i] = (unsigned)(Rb * K + C) * 2u; }
    const size_t kstep = (size_t)(BK * 2);
    const size_t hstep = (size_t)HALF * K * 2;
    const size_t tstep = 2 * hstep;
    const unsigned ldsw = (unsigned)wid * 1024u;
    const int aoff = lds_byte(wr * 64 + fr, fq * 8), boff = lds_byte(wc * 32 + fr, fq * 8);
#define PG8_SA(b, h) (((b) * 2 + (h)) * HTB)
#define PG8_SB(b, h) ((4 + (b) * 2 + (h)) * HTB)
#define PG8_STAGE(bufoff, gbase, voff) do { _Pragma("unroll") for (int _i = 0; _i < 2; ++_i) \
        __builtin_amdgcn_global_load_lds((const unsigned*)((const char*)(gbase) + (voff)[_i]), (PG8_LAS unsigned*)(lds + (bufoff) + ldsw + _i * 8192), 16, 0, 0); } while (0)
#define PG8_LDA(dst, b, h) do { _Pragma("unroll") for (int m = 0; m < 4; ++m) _Pragma("unroll") for (int k = 0; k < 2; ++k) dst[m][k] = *(const PG8_LAS bf16x8*)(lds + PG8_SA(b, h) + aoff + m * 2048 + k * 1024); } while (0)
#define PG8_LDB(dst, b, h) do { _Pragma("unroll") for (int n = 0; n < 2; ++n) _Pragma("unroll") for (int k = 0; k < 2; ++k) dst[n][k] = *(const PG8_LAS bf16x8*)(lds + PG8_SB(b, h) + boff + n * 2048 + k * 1024); } while (0)
#define PG8_MMA(ai, bj, At, Bt) do { __builtin_amdgcn_s_setprio(1); _Pragma("unroll") for (int m = 0; m < 4; ++m) _Pragma("unroll") for (int n = 0; n < 2; ++n) _Pragma("unroll") for (int k = 0; k < 2; ++k) \
        acc[ai][bj][m][n] = __builtin_amdgcn_mfma_f32_16x16x32_bf16(Bt[n][k], At[m][k], acc[ai][bj][m][n], 0, 0, 0); __builtin_amdgcn_s_setprio(0); } while (0)
#define PG8_WAIT_V(n) asm volatile("s_waitcnt vmcnt(" #n ")" ::: "memory")
#define PG8_WAIT_L(n) asm volatile("s_waitcnt lgkmcnt(" #n ")" ::: "memory")
#define PG8_BAR __builtin_amdgcn_s_barrier()
#define PG8_SCHED __builtin_amdgcn_sched_barrier(0)
    Unit cur, nxt; int ui = 0;
    if (!S.next(0, cur)) return;
    f32x4 acc[2][2][4][2];
#pragma unroll
    for (int a = 0; a < 2; ++a)
#pragma unroll
        for (int b = 0; b < 2; ++b)
#pragma unroll
            for (int m = 0; m < 4; ++m)
#pragma unroll
                for (int n = 0; n < 2; ++n) acc[a][b][m][n] = (f32x4){0.f, 0.f, 0.f, 0.f};
    bf16x8 At[4][2], B0[2][2], B1[2][2];
    const char* cA = (const char*)g.A + (size_t)cur.pm * tstep; const char* cB = (const char*)g.Bt + (size_t)cur.pn * tstep;
    S.a_ready(cur);
    PG8_STAGE(PG8_SB(0, 0), cB, voffB); PG8_STAGE(PG8_SA(0, 0), cA, voffA); PG8_STAGE(PG8_SB(0, 1), cB + hstep, voffB); PG8_STAGE(PG8_SA(0, 1), cA + hstep, voffA);
    if (wr == 1) PG8_BAR;
    PG8_WAIT_V(4); PG8_BAR;
    PG8_STAGE(PG8_SB(1, 0), cB + kstep, voffB); PG8_STAGE(PG8_SA(1, 0), cA + kstep, voffA); PG8_STAGE(PG8_SB(1, 1), cB + hstep + kstep, voffB);
    PG8_WAIT_V(6); PG8_BAR;
    for (;;) {
        const bool has_next = S.next(ui + 1, nxt);
        const char* nA = has_next ? (const char*)g.A + (size_t)nxt.pm * tstep : cA; const char* nB = has_next ? (const char*)g.Bt + (size_t)nxt.pn * tstep : cB;
        for (int t = 0; t < nt; t += 2) {
            const bool last = (t == nt - 2);
            const char* a1 = cA + (size_t)(t + 1) * kstep;
            const char* a2 = last ? nA : cA + (size_t)(t + 2) * kstep; const char* b2 = last ? nB : cB + (size_t)(t + 2) * kstep;
            const char* a3 = a2 + kstep; const char* b3 = b2 + kstep;
            if (last && has_next) S.a_ready(nxt);
            PG8_LDB(B0, 0, 0); PG8_SCHED; PG8_LDA(At, 0, 0); PG8_STAGE(PG8_SA(1, 1), a1 + hstep, voffA);
            PG8_WAIT_L(8); PG8_BAR; PG8_WAIT_L(0); PG8_MMA(0, 0, At, B0); PG8_BAR; PG8_SCHED;
            PG8_LDB(B1, 0, 1); PG8_STAGE(PG8_SB(0, 0), b2, voffB);
            PG8_BAR; PG8_WAIT_L(0); PG8_MMA(0, 1, At, B1); PG8_BAR;
            PG8_LDA(At, 0, 1); PG8_STAGE(PG8_SA(0, 0), a2, voffA);
            PG8_BAR; PG8_WAIT_L(0); PG8_MMA(1, 0, At, B0); PG8_BAR; PG8_SCHED;
            PG8_STAGE(PG8_SB(0, 1), b2 + hstep, voffB);
            PG8_WAIT_V(6); PG8_BAR; PG8_MMA(1, 1, At, B1); PG8_BAR;
            PG8_LDB(B0, 1, 0); PG8_SCHED; PG8_LDA(At, 1, 0); PG8_STAGE(PG8_SA(0, 1), a2 + hstep, voffA);
            PG8_WAIT_L(8); PG8_BAR; PG8_WAIT_L(0); PG8_MMA(0, 0, At, B0); PG8_BAR; PG8_SCHED;
            PG8_LDB(B1, 1, 1); PG8_STAGE(PG8_SB(1, 0), b3, voffB);
            PG8_BAR; PG8_WAIT_L(0); PG8_MMA(0, 1, At, B1); PG8_BAR;
            PG8_LDA(At, 1, 1); PG8_STAGE(PG8_SA(1, 0), a3, voffA);
            PG8_BAR; PG8_WAIT_L(0); PG8_MMA(1, 0, At, B0); PG8_BAR; PG8_SCHED;
            PG8_STAGE(PG8_SB(1, 1), b3 + hstep, voffB);
            PG8_WAIT_V(6); PG8_BAR; PG8_MMA(1, 1, At, B1); PG8_BAR;
        }
        if constexpr (!Epi::AFTER_DRAIN) { E(acc, cur, wr, wc, fr, fq); S.done(cur); }
        if (!has_next) break;
#pragma unroll
        for (int a = 0; a < 2; ++a)
#pragma unroll
            for (int b = 0; b < 2; ++b)
#pragma unroll
                for (int m = 0; m < 4; ++m)
#pragma unroll
                    for (int n = 0; n < 2; ++n) acc[a][b][m][n] = (f32x4){0.f, 0.f, 0.f, 0.f};
        cur = nxt; cA = nA; cB = nB; ++ui;
    }
    PG8_WAIT_V(0);
    if (wr == 0) PG8_BAR;
    PG8_BAR;
    if constexpr (Epi::AFTER_DRAIN) { E.fused(acc, cur, wr, wc, fr, fq, lds, wid, lane); S.done(cur); }
#undef PG8_SA
#undef PG8_SB
#undef PG8_STAGE
#undef PG8_LDA
#undef PG8_LDB
#undef PG8_MMA
#undef PG8_WAIT_V
#undef PG8_WAIT_L
#undef PG8_BAR
#undef PG8_SCHED
}
}
constexpr int NWAVES = 8, NTHR = 512;
constexpr int D = 2048, NBATCH = 4, SEQ = 4096, T = NBATCH * SEQ, DEPTH = 2;
constexpr int GLA_H = 4, GLA_DK = 128, GLA_DV = 256, GLA_CH = 64;
constexpr int MLP_H = 8, MLP_DH = 128, MLP_CH = 128;
constexpr int IN_COLS = 5136, NPROJ = 5120;
constexpr int C_Q = 0, C_K = 512, C_V = 1024, C_R = 2048, C_U = 3072, C_VS = 4096;
constexpr int NEXP = 16384, PEER_H = 8;
constexpr float EPS = 1e-6f;
constexpr int MODW = 6 * D;
constexpr size_t MiB = 1u << 20;
constexpr size_t WS_CTL = 0, CTL_ZERO_BYTES = 1 * MiB;
constexpr size_t WS_MOD = 1 * MiB;
constexpr size_t WS_K1B = 2 * MiB, WS_K2B = 2 * MiB + 512 * 1024, WS_WSB = 3 * MiB, WS_DEC = 3 * MiB + 512 * 1024, WS_ALOW = 4 * MiB;
constexpr size_t WS_WTIN = 8 * MiB;
constexpr size_t WTIN_L = (size_t)5136 * 2048;
constexpr size_t WS_WTOUT = 49 * MiB, WS_WTQ = 65 * MiB;
constexpr size_t WS_PUB = 81 * MiB, WS_PVB = 209 * MiB;
constexpr size_t WS_H = 337 * MiB;
constexpr size_t WS_PROJ = 401 * MiB;
constexpr size_t WS_SBUF = 561 * MiB;
constexpr size_t WS_CONCAT = 625 * MiB;
constexpr size_t WS_QB = 689 * MiB;
constexpr size_t WS_EB = 753 * MiB, WS_PG = 761 * MiB, WS_END = 769 * MiB;
static_assert(WS_WTIN + 2 * WTIN_L * 2 <= WS_WTOUT, "ws map");
constexpr int CW_BAR = 4096;
constexpr int RING_BYTES = 131072, LDSCTL_OFF = RING_BYTES, MISC_OFF = LDSCTL_OFF + 320, LDS_BYTES = 147456;

#define DI __device__ __forceinline__
#define LAS __attribute__((address_space(3)))
typedef unsigned short bf16;
typedef short bf16x8 __attribute__((ext_vector_type(8)));
typedef short s16x4 __attribute__((ext_vector_type(4)));
typedef short v4i16_t __attribute__((ext_vector_type(4)));
typedef __bf16 bf16x2_t __attribute__((ext_vector_type(2)));
typedef float f32x4 __attribute__((ext_vector_type(4)));
typedef float f32x2 __attribute__((ext_vector_type(2)));
typedef unsigned u32x4 __attribute__((ext_vector_type(4)));
typedef unsigned u32x2 __attribute__((ext_vector_type(2)));
typedef LAS unsigned char* ldsp;

DI unsigned f2bf(float f) { unsigned u = __builtin_bit_cast(unsigned, f); return (u + 0x7fffu + ((u >> 16) & 1u)) >> 16; }
DI unsigned pk2(float lo, float hi) { return f2bf(lo) | (f2bf(hi) << 16); }
DI float bflo(unsigned u) { return __builtin_bit_cast(float, u << 16); }
DI float bfhi(unsigned u) { return __builtin_bit_cast(float, u & 0xffff0000u); }
DI float bf1(bf16 v) { return __builtin_bit_cast(float, ((unsigned)v) << 16); }
DI float fexp2(float x) { return __builtin_amdgcn_exp2f(x); }
DI float flog2(float x) { return __builtin_amdgcn_logf(x); }
DI float frcp(float x) { return __builtin_amdgcn_rcpf(x); }
DI float frsq(float x) { return __builtin_amdgcn_rsqf(x); }
DI float gelu_t(float x) { const float u = 0.7978845608f * (x + 0.044715f * x * x * x); return x * frcp(1.f + fexp2(-2.885390082f * u)); }
DI float silu_f(float x) { return x * frcp(1.f + fexp2(-1.442695041f * x)); }
DI float wave_sum(float v) {
#pragma unroll
    for (int o = 1; o < 64; o <<= 1) v += __shfl_xor(v, o);
    return v;
}
DI float dot2bf(unsigned a, unsigned b, float c) { return __builtin_amdgcn_fdot2_f32_bf16(__builtin_bit_cast(bf16x2_t, a), __builtin_bit_cast(bf16x2_t, b), c, false); }
DI f32x4 mfma16(bf16x8 a, bf16x8 b, f32x4 c) { return __builtin_amdgcn_mfma_f32_16x16x32_bf16(a, b, c, 0, 0, 0); }
DI s16x4 tr4(const LAS bf16* p) { return __builtin_bit_cast(s16x4, __builtin_amdgcn_ds_read_tr16_b64_v4i16((LAS v4i16_t*)p)); }
DI bf16x8 tr8(const LAS bf16* p, int stride) { const s16x4 a = tr4(p), b = tr4(p + 4 * stride); return (bf16x8){a[0], a[1], a[2], a[3], b[0], b[1], b[2], b[3]}; }

#define XB_TMO      128
#define XB_XCNT(j)  (256  + 64 * (j))
#define XB_XSUB(j)  (1280 + 64 * (j))
#define XB_XGEN(j)  (2304 + 64 * (j))
#define XB_TOP      3328
#define XB_TOPGEN   3392
#define XCD_BAR_WORDS 3456
#define XB_SPIN_CAP (1u << 18)

__device__ __forceinline__ unsigned xb_ld(unsigned* p)              { return __hip_atomic_load(p, __ATOMIC_RELAXED, __HIP_MEMORY_SCOPE_AGENT); }
__device__ __forceinline__ unsigned xb_add(unsigned* p, unsigned v) { return __hip_atomic_fetch_add(p, v, __ATOMIC_RELAXED, __HIP_MEMORY_SCOPE_AGENT); }
__device__ __forceinline__ unsigned xb_xcc_id() { return (unsigned)__builtin_amdgcn_s_getreg((3 << 11) | 20) & 0xFu; }
#define XB_SPIN(cond, bar) do { unsigned _sp = 0; while (cond) { __builtin_amdgcn_s_sleep(1); \
    if ((++_sp & 255u) == 0u) { if (xb_ld(&(bar)[XB_TMO])) break; if (_sp > XB_SPIN_CAP) { atomicAdd(&(bar)[XB_TMO], 1u); break; } } } } while (0)

struct XcdBarrier {
    unsigned* bar; unsigned x;
    volatile LAS unsigned* st;
};

__device__ __forceinline__ XcdBarrier xcd_barrier_post(unsigned* bar, volatile LAS unsigned* st) {
    XcdBarrier b; b.bar = bar; b.x = xb_xcc_id(); b.st = st;
    if (threadIdx.x == 0) (void)xb_add(&bar[XB_XCNT(b.x)], 1u);
    return b;
}
__device__ __forceinline__ void xcd_barrier_complete(unsigned* bar, unsigned x, unsigned& nloc, unsigned& nx) {
    const unsigned G = gridDim.x * gridDim.y * gridDim.z;
    unsigned sum, cnt, mine, sp = 0u;
    for (;;) {
        sum = 0u; cnt = 0u; mine = 0u;
#pragma unroll
        for (unsigned j = 0; j < 16; ++j) { const unsigned c = xb_ld(&bar[XB_XCNT(j)]); sum += c; cnt += (c > 0u) ? 1u : 0u; mine = (j == x) ? c : mine; }
        if (sum == G) break;
        __builtin_amdgcn_s_sleep(1);
        if ((++sp & 255u) == 0u) { if (xb_ld(&bar[XB_TMO])) break; if (sp > XB_SPIN_CAP) { atomicAdd(&bar[XB_TMO], 1u); break; } }
    }
    nloc = mine > 0u ? mine : 1u; nx = cnt > 0u ? cnt : 1u;
}

__device__ __forceinline__ void xcd_barrier(const XcdBarrier& b) {
    asm volatile("s_waitcnt vmcnt(0)" ::: "memory");
    __syncthreads();
    if (threadIdx.x == 0) {
        unsigned* bar = b.bar;
        __builtin_amdgcn_s_waitcnt(0);
        unsigned nloc = b.st[0], nx = b.st[1];
        if (nloc == 0u) { xcd_barrier_complete(bar, b.x, nloc, nx); b.st[0] = nloc; b.st[1] = nx; }
        const unsigned old = xb_add(&bar[XB_XSUB(b.x)], 1u);
        const unsigned gen = old / nloc;
        if (old + 1u == (gen + 1u) * nloc) {
            __builtin_amdgcn_fence(__ATOMIC_RELEASE, "agent");
            asm volatile("s_waitcnt vmcnt(0)" ::: "memory");
            const unsigned og = xb_add(&bar[XB_TOP], 1u);
            const unsigned tg = og / nx;
            if (og + 1u == (tg + 1u) * nx) xb_add(&bar[XB_TOPGEN], 1u);
            else XB_SPIN(xb_ld(&bar[XB_TOPGEN]) == tg, bar);
            __builtin_amdgcn_fence(__ATOMIC_ACQUIRE, "agent");
            xb_add(&bar[XB_XGEN(b.x)], 1u);
            asm volatile("s_waitcnt vmcnt(0)" ::: "memory");
        } else {
            XB_SPIN(xb_ld(&bar[XB_XGEN(b.x)]) == gen, bar);
            __builtin_amdgcn_fence(__ATOMIC_ACQUIRE, "agent");
            asm volatile("s_waitcnt vmcnt(0)" ::: "memory");
        }
    }
    __syncthreads();
}
struct Ctx {
    ldsp lds; int tid, lane, wave, bid, G, gw, NGW;
    const float* in[21]; float* out; unsigned char* ws;
};
#define LDS_WAIT() asm volatile("s_waitcnt lgkmcnt(0)" ::: "memory")
enum { I_X = 0, I_C, I_ADAW, I_ADAB, I_N1G, I_WIN, I_WA2, I_BA, I_GNG, I_VNG, I_MWS, I_MB, I_MOG, I_WOUT, I_N2G, I_WQ, I_K1, I_K2, I_PU, I_PV, I_FG };

DI void p0_ada(const Ctx& C) {
    LAS float* red = (LAS float*)C.lds;
    float* MOD = (float*)(C.ws + WS_MOD);
    for (int it = C.bid; it < 192; it += C.G) {
        const int l = it / 96, cg = it % 96, c0 = cg * 128 + C.lane * 2;
        const float* W = C.in[I_ADAW] + (size_t)l * D * MODW + (size_t)(C.wave * 256) * MODW + c0;
        float cv[4][4];
#pragma unroll
        for (int b = 0; b < 4; ++b)
#pragma unroll
            for (int i = 0; i < 4; ++i) cv[b][i] = silu_f(C.in[I_C][b * D + C.wave * 256 + i * 64 + C.lane]);
        float acc[4][2];
#pragma unroll
        for (int b = 0; b < 4; ++b) { acc[b][0] = 0.f; acc[b][1] = 0.f; }
#pragma unroll
        for (int i = 0; i < 4; ++i) {
#pragma unroll 8
            for (int j = 0; j < 64; ++j) {
                const f32x2 w = *(const f32x2*)(W + (size_t)(i * 64 + j) * MODW);
#pragma unroll
                for (int b = 0; b < 4; ++b) { const float s = __builtin_bit_cast(float, __builtin_amdgcn_readlane(__builtin_bit_cast(int, cv[b][i]), j)); acc[b][0] += s * w.x; acc[b][1] += s * w.y; }
            }
        }
#pragma unroll
        for (int b = 0; b < 4; ++b) *(LAS f32x2*)(red + (C.wave * 4 + b) * 128 + C.lane * 2) = (f32x2){acc[b][0], acc[b][1]};
        __syncthreads();
        { const int b = C.tid >> 7, col = C.tid & 127; float s = C.in[I_ADAB][l * MODW + cg * 128 + col];
#pragma unroll
          for (int w = 0; w < 8; ++w) s += red[(w * 4 + b) * 128 + col];
          MOD[(size_t)(l * 4 + b) * MODW + cg * 128 + col] = s; }
        __syncthreads();
    }
}
DI void transpose_item(const float* W, int ldw, int src_col0, int ncols, bf16* WT, int dst_row0, int k0, LAS float* scr, int lane) {
    const int cl = lane & 31;
#pragma unroll 8
    for (int i = 0; i < 32; ++i) { const int kk = 2 * i + (lane >> 5); float v = 0.f; if (cl < ncols) v = W[(size_t)(k0 + kk) * ldw + src_col0 + cl]; scr[kk * 33 + cl] = v; }
    LDS_WAIT();
    const int c = lane & 7;
#pragma unroll
    for (int j = 0; j < 4; ++j) { const int n = (lane >> 3) + 8 * j;
        if (n < ncols) { const LAS float* s = scr + (8 * c) * 33 + n;
            u32x4 o; o.x = pk2(s[0 * 33], s[1 * 33]); o.y = pk2(s[2 * 33], s[3 * 33]); o.z = pk2(s[4 * 33], s[5 * 33]); o.w = pk2(s[6 * 33], s[7 * 33]);
            *(u32x4*)(WT + (size_t)(dst_row0 + n) * 2048 + k0 + 8 * c) = o; } }
    LDS_WAIT();
}
DI void p0_prologue(const Ctx& C) {
    p0_ada(C);
    LAS float* scr = (LAS float*)(C.lds + C.wave * 16384);
    constexpr int PER_L = (161 + 64 + 64) * 32;
    for (int it = C.gw; it < 2 * PER_L; it += C.NGW) {
        const int l = it / PER_L; int r = it % PER_L;
        if (r < 161 * 32) { const int kb = r / 161, nb = r % 161; bf16* WT = (bf16*)(C.ws + WS_WTIN) + (size_t)l * WTIN_L;
            const float* W = C.in[I_WIN] + (size_t)l * D * IN_COLS;
            if (nb < 160) { const int n0 = 32 * nb; transpose_item(W, IN_COLS, n0 + (n0 >= 3072 ? 16 : 0), 32, WT, n0, 64 * kb, scr, C.lane); }
            else transpose_item(W, IN_COLS, 3072, 16, WT, 5120, 64 * kb, scr, C.lane);
            continue; }
        r -= 161 * 32;
        if (r < 2048) { const int kb = r / 64, nb = r % 64; transpose_item(C.in[I_WOUT] + (size_t)l * D * D, D, 32 * nb, 32, (bf16*)(C.ws + WS_WTOUT) + (size_t)l * D * D, 32 * nb, 64 * kb, scr, C.lane); continue; }
        r -= 2048;
        { const int kb = r / 64, nb = r % 64; transpose_item(C.in[I_WQ] + (size_t)l * D * D, D, 32 * nb, 32, (bf16*)(C.ws + WS_WTQ) + (size_t)l * D * D, 32 * nb, 64 * kb, scr, C.lane); }
    }
    const int gt = C.bid * NTHR + C.tid, NT = C.G * NTHR;
    { bf16* K1B = (bf16*)(C.ws + WS_K1B); bf16* K2B = (bf16*)(C.ws + WS_K2B); bf16* WSB = (bf16*)(C.ws + WS_WSB);
      for (int i = gt; i < 262144; i += NT) { K1B[i] = (bf16)f2bf(C.in[I_K1][i]); K2B[i] = (bf16)f2bf(C.in[I_K2][i]);
          const int s = i & 127, t = (i >> 7) & 127; WSB[i] = (s <= t) ? (bf16)f2bf(C.in[I_MWS][i]) : (bf16)0; } }
#pragma unroll 1
    for (int tb = 0; tb < 2; ++tb) {
        const f32x4* src = (const f32x4*)C.in[tb ? I_PV : I_PU]; u32x4* dst = (u32x4*)(C.ws + (tb ? WS_PVB : WS_PUB));
#pragma unroll 4
        for (int i = gt; i < 8388608; i += NT) { const f32x4 a = src[2 * (size_t)i], b = src[2 * (size_t)i + 1];
            u32x4 o; o.x = pk2(a.x, a.y); o.y = pk2(a.z, a.w); o.z = pk2(b.x, b.y); o.w = pk2(b.z, b.w); dst[i] = o; }
    }
}
DI void norm_phase(const Ctx& C, const float* X, const float* g, const float* modl, int sh_off, int sc_off, bf16* Hout) {
    const int r0 = C.gw * 8, b = r0 >> 12;
    const f32x4* shp = (const f32x4*)(modl + (size_t)b * MODW + sh_off); const f32x4* scp = (const f32x4*)(modl + (size_t)b * MODW + sc_off);
    f32x4 gm[8], shv[8];
#pragma unroll
    for (int j = 0; j < 8; ++j) { const int idx = 64 * j + C.lane; gm[j] = ((const f32x4*)g)[idx] * (scp[idx] + 1.0f); shv[j] = shp[idx]; }
#pragma unroll 1
    for (int i = 0; i < 8; ++i) {
        const f32x4* xr = (const f32x4*)(X + (size_t)(r0 + i) * D) + C.lane; f32x4 v[8]; float s = 0.f;
#pragma unroll
        for (int j = 0; j < 8; ++j) { v[j] = xr[64 * j]; s += (v[j].x * v[j].x + v[j].y * v[j].y) + (v[j].z * v[j].z + v[j].w * v[j].w); }
        const float rstd = frsq(wave_sum(s) * (1.f / D) + EPS);
        u32x2* o = (u32x2*)(Hout + (size_t)(r0 + i) * D) + C.lane;
#pragma unroll
        for (int j = 0; j < 8; ++j) { const f32x4 y = v[j] * rstd * gm[j] + shv[j]; u32x2 w; w.x = pk2(y.x, y.y); w.y = pk2(y.z, y.w); o[64 * j] = w; }
    }
}
DI void alow_phase(const Ctx& C, const bf16* Hb, const bf16* WtA, float* ALOW) {
    if (C.wave < 4) {
        const int task = C.bid * 4 + C.wave, r0 = task * 16, fr = C.lane & 15, fq = C.lane >> 4;
        const bf16* ap = Hb + (size_t)(r0 + fr) * D + 8 * fq; const bf16* bp = WtA + (size_t)fr * D + 8 * fq;
        f32x4 acc = (f32x4){0.f, 0.f, 0.f, 0.f};
#pragma unroll 8
        for (int ks = 0; ks < 64; ++ks) { const bf16x8 a = *(const bf16x8*)(ap + 32 * ks), b = *(const bf16x8*)(bp + 32 * ks); acc = mfma16(a, b, acc); }
#pragma unroll
        for (int r = 0; r < 4; ++r) ALOW[(size_t)(r0 + 4 * fq + r) * 16 + fr] = acc[r];
    }
}
DI void gla_gates(const Ctx& C, LAS float* al, LAS float* tot, const float* ALOW, const float* wa2, const float* ba, int t0, int h, float (&Gl)[16], float& off, float& gref, float& g63) {
    const int d = C.tid & 127, jg = C.tid >> 7;
    if (C.tid < 256) ((LAS f32x4*)al)[C.tid] = ((const f32x4*)(ALOW + (size_t)t0 * 16))[C.tid];
    float w2[16];
#pragma unroll
    for (int r = 0; r < 16; ++r) w2[r] = wa2[r * 512 + h * 128 + d];
    const float bav = ba[h * 128 + d];
    __syncthreads();
    float run = 0.f;
#pragma unroll
    for (int jj = 0; jj < 16; ++jj) {
        const LAS f32x4* ar = (const LAS f32x4*)(al + (jg * 16 + jj) * 16);
        const f32x4 a0 = ar[0], a1 = ar[1], a2 = ar[2], a3 = ar[3];
        float z = bav;
        z += a0.x * w2[0] + a0.y * w2[1] + a0.z * w2[2] + a0.w * w2[3];
        z += a1.x * w2[4] + a1.y * w2[5] + a1.z * w2[6] + a1.w * w2[7];
        z += a2.x * w2[8] + a2.y * w2[9] + a2.z * w2[10] + a2.w * w2[11];
        z += a3.x * w2[12] + a3.y * w2[13] + a3.z * w2[14] + a3.w * w2[15];
        const float ls = fminf(z, 0.f) - 0.6931471806f * flog2(1.f + fexp2(-1.442695041f * fabsf(z)));
        run += ls * (1.442695041f / 16.f);
        Gl[jj] = run;
    }
    tot[jg * 128 + d] = run;
    __syncthreads();
    const float t0_ = tot[d], t1_ = tot[128 + d], t2_ = tot[256 + d], t3_ = tot[384 + d];
    off = (jg > 0 ? t0_ : 0.f) + (jg > 1 ? t1_ : 0.f) + (jg > 2 ? t2_ : 0.f); gref = t0_ + t1_; g63 = (t0_ + t1_) + (t2_ + t3_);
}
constexpr int KST = 136, VST = 264, PST = 72;
DI void load_v_tile(const Ctx& C, const bf16* PROJ, int t0, int h, LAS bf16* VL) {
#pragma unroll
    for (int i = 0; i < 4; ++i) { const int c = C.tid + 512 * i, j = c >> 5, ec = c & 31;
        *(LAS u32x4*)(VL + j * VST + 8 * ec) = *(const u32x4*)(PROJ + (size_t)(t0 + j) * NPROJ + C_V + h * 256 + 8 * ec); }
}
DI void glaA_item(const Ctx& C, int l, int idx, const bf16* PROJ, const float* ALOW, bf16* SBUF, float* DEC) {
    const int b = idx >> 8, h = (idx >> 6) & 3, n = idx & 63, t0 = b * SEQ + n * 64;
    LAS float* al = (LAS float*)(C.lds); LAS float* tot = (LAS float*)(C.lds + 4096);
    LAS bf16* KD = (LAS bf16*)(C.lds + 8192); LAS bf16* VL = (LAS bf16*)(C.lds + 25600);
    float Gl[16], off, gref, g63;
    gla_gates(C, al, tot, ALOW, C.in[I_WA2] + (size_t)l * 16 * 512, C.in[I_BA] + (size_t)l * 512, t0, h, Gl, off, gref, g63);
    const int d = C.tid & 127, jg = C.tid >> 7;
#pragma unroll
    for (int jj = 0; jj < 16; ++jj) { const int j = jg * 16 + jj; const float kv = bf1(PROJ[(size_t)(t0 + j) * NPROJ + C_K + h * 128 + d]);
        KD[j * KST + d] = (bf16)f2bf(kv * fexp2(g63 - (off + Gl[jj]))); }
    if (jg == 0) DEC[(size_t)idx * 128 + d] = fexp2(g63);
    load_v_tile(C, PROJ, t0, h, VL);
    __syncthreads();
    const int lane = C.lane, g = lane >> 4, qq = (lane & 15) >> 2, p = lane & 3, fr = lane & 15;
    bf16x8 A[2];
#pragma unroll
    for (int ks = 0; ks < 2; ++ks) A[ks] = tr8(KD + (32 * ks + 8 * g + qq) * KST + 16 * C.wave + 4 * p, KST);
    bf16* Sit = SBUF + (size_t)idx * 256 * 128;
#pragma unroll
    for (int half = 0; half < 2; ++half) {
        f32x4 acc[8];
#pragma unroll
        for (int nt = 0; nt < 8; ++nt) acc[nt] = (f32x4){0.f, 0.f, 0.f, 0.f};
#pragma unroll
        for (int nt = 0; nt < 8; ++nt)
#pragma unroll
            for (int ks = 0; ks < 2; ++ks) { const bf16x8 Bf = tr8(VL + (32 * ks + 8 * g + qq) * VST + 16 * (half * 8 + nt) + 4 * p, VST); acc[nt] = mfma16(A[ks], Bf, acc[nt]); }
#pragma unroll
        for (int nt = 0; nt < 8; ++nt) { const int e = 16 * (half * 8 + nt) + fr, dd = 16 * C.wave + 4 * g;
            u32x2 w; w.x = pk2(acc[nt][0], acc[nt][1]); w.y = pk2(acc[nt][2], acc[nt][3]); *(u32x2*)(Sit + (size_t)e * 128 + dd) = w; }
    }
    __syncthreads();
}
DI void scan_phase(const Ctx& C, bf16* SBUF, const float* DEC) {
    const int gt = C.bid * NTHR + C.tid, bh = gt >> 13, rem = gt & 8191, e = rem >> 5, dq = rem & 31;
    u32x2* p = (u32x2*)(SBUF + ((size_t)(bh * 64) * 256 + e) * 128 + 4 * dq);
    const f32x4* dp = (const f32x4*)(DEC + (size_t)(bh * 64) * 128 + 4 * dq);
    f32x4 st = (f32x4){0.f, 0.f, 0.f, 0.f};
#pragma unroll 1
    for (int n0 = 0; n0 < 64; n0 += 8) {
        u32x2 tmp[8]; f32x4 dc[8];
#pragma unroll
        for (int u = 0; u < 8; ++u) { tmp[u] = p[(size_t)(n0 + u) * 8192]; dc[u] = dp[(n0 + u) * 32]; }
#pragma unroll
        for (int u = 0; u < 8; ++u) { u32x2 w; w.x = pk2(st.x, st.y); w.y = pk2(st.z, st.w); p[(size_t)(n0 + u) * 8192] = w;
            st = dc[u] * st + (f32x4){bflo(tmp[u].x), bfhi(tmp[u].x), bflo(tmp[u].y), bfhi(tmp[u].y)}; }
    }
}
DI void glaC_item(const Ctx& C, int l, int idx, const bf16* PROJ, const float* ALOW, const bf16* SBUF, bf16* CONCAT) {
    const int b = idx >> 8, h = (idx >> 6) & 3, n = idx & 63, t0 = b * SEQ + n * 64;
    LAS float* al = (LAS float*)(C.lds); LAS float* tot = (LAS float*)(C.lds + 4096); LAS float* RS = (LAS float*)(C.lds + 6144);
    LAS bf16* QT = (LAS bf16*)(C.lds + 8192); LAS bf16* KT = (LAS bf16*)(C.lds + 25600); LAS bf16* QG = (LAS bf16*)(C.lds + 43008);
    LAS bf16* VL = (LAS bf16*)(C.lds + 60416); LAS bf16* PL = (LAS bf16*)(C.lds + 94208);
    float Gl[16], off, gref, g63;
    gla_gates(C, al, tot, ALOW, C.in[I_WA2] + (size_t)l * 16 * 512, C.in[I_BA] + (size_t)l * 512, t0, h, Gl, off, gref, g63);
    const int d = C.tid & 127, jg = C.tid >> 7;
#pragma unroll
    for (int jj = 0; jj < 16; ++jj) { const int j = jg * 16 + jj; const float Gv = off + Gl[jj];
        const bf16* row = PROJ + (size_t)(t0 + j) * NPROJ + h * 128 + d;
        const float q = bf1(row[C_Q]) * 0.08838834764831845f, k = bf1(row[C_K]);
        QT[j * KST + d] = (bf16)f2bf(q * fexp2(Gv - gref)); KT[j * KST + d] = (bf16)f2bf(k * fexp2(gref - Gv)); QG[j * KST + d] = (bf16)f2bf(q * fexp2(Gv)); }
    load_v_tile(C, PROJ, t0, h, VL);
    __syncthreads();
    const int lane = C.lane, g = lane >> 4, qq = (lane & 15) >> 2, p = lane & 3, fr = lane & 15;
    {
        const int nt = C.wave & 3;
#pragma unroll
        for (int mi = 0; mi < 2; ++mi) { const int mt = 2 * (C.wave >> 2) + mi; f32x4 acc = (f32x4){0.f, 0.f, 0.f, 0.f};
#pragma unroll
            for (int ks = 0; ks < 4; ++ks) { const bf16x8 a = *(const LAS bf16x8*)(KT + (16 * mt + fr) * KST + 32 * ks + 8 * g), bq = *(const LAS bf16x8*)(QT + (16 * nt + fr) * KST + 32 * ks + 8 * g); acc = mfma16(a, bq, acc); }
            const int i = 16 * nt + fr, j0 = 16 * mt + 4 * g;
            const float v0 = (j0 + 0 <= i) ? acc[0] : 0.f, v1 = (j0 + 1 <= i) ? acc[1] : 0.f, v2 = (j0 + 2 <= i) ? acc[2] : 0.f, v3 = (j0 + 3 <= i) ? acc[3] : 0.f;
            u32x2 w; w.x = pk2(v0, v1); w.y = pk2(v2, v3); *(LAS u32x2*)(PL + i * PST + j0) = w; }
    }
    __syncthreads();
    f32x4 acc[2][4];
#pragma unroll
    for (int mi = 0; mi < 2; ++mi)
#pragma unroll
        for (int nt = 0; nt < 4; ++nt) acc[mi][nt] = (f32x4){0.f, 0.f, 0.f, 0.f};
#pragma unroll
    for (int mi = 0; mi < 2; ++mi) { const int mt = 2 * C.wave + mi;
#pragma unroll
        for (int ks = 0; ks < 2; ++ks) { const bf16x8 a = tr8(VL + (32 * ks + 8 * g + qq) * VST + 16 * mt + 4 * p, VST);
#pragma unroll
            for (int nt = 0; nt < 4; ++nt) { const bf16x8 bp = *(const LAS bf16x8*)(PL + (16 * nt + fr) * PST + 32 * ks + 8 * g); acc[mi][nt] = mfma16(a, bp, acc[mi][nt]); } }
        const bf16* Srow = SBUF + ((size_t)idx * 256 + 16 * mt + fr) * 128 + 8 * g;
#pragma unroll
        for (int ks = 0; ks < 4; ++ks) { const bf16x8 a = *(const bf16x8*)(Srow + 32 * ks);
#pragma unroll
            for (int nt = 0; nt < 4; ++nt) { const bf16x8 bq = *(const LAS bf16x8*)(QG + (16 * nt + fr) * KST + 32 * ks + 8 * g); acc[mi][nt] = mfma16(a, bq, acc[mi][nt]); } }
    }
#pragma unroll
    for (int nt = 0; nt < 4; ++nt) { float s = 0.f;
#pragma unroll
        for (int mi = 0; mi < 2; ++mi) s += (acc[mi][nt][0] * acc[mi][nt][0] + acc[mi][nt][1] * acc[mi][nt][1]) + (acc[mi][nt][2] * acc[mi][nt][2] + acc[mi][nt][3] * acc[mi][nt][3]);
        s += __shfl_xor(s, 16); s += __shfl_xor(s, 32);
        if (g == 0) RS[C.wave * 64 + 16 * nt + fr] = s; }
    __syncthreads();
    const float* ng = C.in[I_GNG] + (size_t)(l * 4 + h) * 256;
#pragma unroll
    for (int nt = 0; nt < 4; ++nt) { const int i = 16 * nt + fr; float ts = 0.f;
#pragma unroll
        for (int w = 0; w < 8; ++w) ts += RS[w * 64 + i];
        const float rstd = frsq(ts * (1.f / 256.f) + EPS);
#pragma unroll
        for (int mi = 0; mi < 2; ++mi) { const int e = 16 * (2 * C.wave + mi) + 4 * g;
            const u32x2 rr = *(const u32x2*)(PROJ + (size_t)(t0 + i) * NPROJ + C_R + h * 256 + e); const f32x4 gg = *(const f32x4*)(ng + e);
            const float o0 = acc[mi][nt][0] * rstd * gg.x * silu_f(bflo(rr.x)), o1 = acc[mi][nt][1] * rstd * gg.y * silu_f(bfhi(rr.x));
            const float o2 = acc[mi][nt][2] * rstd * gg.z * silu_f(bflo(rr.y)), o3 = acc[mi][nt][3] * rstd * gg.w * silu_f(bfhi(rr.y));
            u32x2 w; w.x = pk2(o0, o1); w.y = pk2(o2, o3); *(u32x2*)(CONCAT + (size_t)(t0 + i) * D + h * 256 + e) = w; } }
    __syncthreads();
}
constexpr int GST = 136;
DI void gmlp_item(const Ctx& C, int l, int idx, const bf16* PROJ, const bf16* WSB, bf16* CONCAT) {
    const int h = idx & 7, n = (idx >> 3) & 31, b = idx >> 8, t0 = b * SEQ + n * 128;
    LAS bf16* VL2 = (LAS bf16*)(C.lds); LAS bf16* UL = (LAS bf16*)(C.lds + 34816);
    const float* vg = C.in[I_VNG] + (size_t)(l * 8 + h) * 128; const float* og = C.in[I_MOG] + (size_t)(l * 8 + h) * 128; const float* bb = C.in[I_MB] + (size_t)(l * 8 + h) * 128;
#pragma unroll
    for (int i = 0; i < 4; ++i) { const int c = C.tid + 512 * i, t = c >> 4, ch = c & 15;
        const bf16* row = PROJ + (size_t)(t0 + t) * NPROJ + h * 128 + 8 * ch;
        const u32x4 uu = *(const u32x4*)(row + C_U), vv = *(const u32x4*)(row + C_VS);
        float v[8] = {gelu_t(bflo(vv.x)), gelu_t(bfhi(vv.x)), gelu_t(bflo(vv.y)), gelu_t(bfhi(vv.y)), gelu_t(bflo(vv.z)), gelu_t(bfhi(vv.z)), gelu_t(bflo(vv.w)), gelu_t(bfhi(vv.w))};
        float ss = 0.f;
#pragma unroll
        for (int k = 0; k < 8; ++k) ss += v[k] * v[k];
        ss += __shfl_xor(ss, 1); ss += __shfl_xor(ss, 2); ss += __shfl_xor(ss, 4); ss += __shfl_xor(ss, 8);
        const float rstd = frsq(ss * (1.f / 128.f) + EPS);
        const f32x4 g0 = *(const f32x4*)(vg + 8 * ch), g1 = *(const f32x4*)(vg + 8 * ch + 4);
        u32x4 wv; wv.x = pk2(v[0] * rstd * g0.x, v[1] * rstd * g0.y); wv.y = pk2(v[2] * rstd * g0.z, v[3] * rstd * g0.w); wv.z = pk2(v[4] * rstd * g1.x, v[5] * rstd * g1.y); wv.w = pk2(v[6] * rstd * g1.z, v[7] * rstd * g1.w);
        *(LAS u32x4*)(VL2 + t * GST + 8 * ch) = wv;
        u32x4 wu; wu.x = pk2(gelu_t(bflo(uu.x)), gelu_t(bfhi(uu.x))); wu.y = pk2(gelu_t(bflo(uu.y)), gelu_t(bfhi(uu.y))); wu.z = pk2(gelu_t(bflo(uu.z)), gelu_t(bfhi(uu.z))); wu.w = pk2(gelu_t(bflo(uu.w)), gelu_t(bfhi(uu.w)));
        *(LAS u32x4*)(UL + t * GST + 8 * ch) = wu; }
    __syncthreads();
    const int lane = C.lane, g = lane >> 4, qq = (lane & 15) >> 2, p = lane & 3, fr = lane & 15;
    f32x4 acc[8];
#pragma unroll
    for (int mt = 0; mt < 8; ++mt) acc[mt] = (f32x4){0.f, 0.f, 0.f, 0.f};
    const int nks = (C.wave >> 1) + 1;
    const bf16* Wrow = WSB + ((size_t)(l * 8 + h) * 128 + 16 * C.wave + fr) * 128 + 8 * g;
#pragma unroll 1
    for (int ks = 0; ks < nks; ++ks) { const bf16x8 bw = *(const bf16x8*)(Wrow + 32 * ks);
#pragma unroll
        for (int mt = 0; mt < 8; ++mt) { const bf16x8 a = tr8(VL2 + (32 * ks + 8 * g + qq) * GST + 16 * mt + 4 * p, GST); acc[mt] = mfma16(a, bw, acc[mt]); } }
    const int tl = 16 * C.wave + fr; const float bt = bb[tl]; float ss = 0.f;
#pragma unroll
    for (int mt = 0; mt < 8; ++mt) { const u32x2 uu = *(const LAS u32x2*)(UL + tl * GST + 16 * mt + 4 * g);
        acc[mt][0] = bflo(uu.x) * (acc[mt][0] + bt); acc[mt][1] = bfhi(uu.x) * (acc[mt][1] + bt); acc[mt][2] = bflo(uu.y) * (acc[mt][2] + bt); acc[mt][3] = bfhi(uu.y) * (acc[mt][3] + bt);
        ss += (acc[mt][0] * acc[mt][0] + acc[mt][1] * acc[mt][1]) + (acc[mt][2] * acc[mt][2] + acc[mt][3] * acc[mt][3]); }
    ss += __shfl_xor(ss, 16); ss += __shfl_xor(ss, 32);
    const float rstd = frsq(ss * (1.f / 128.f) + EPS);
#pragma unroll
    for (int mt = 0; mt < 8; ++mt) { const f32x4 gg = *(const f32x4*)(og + 16 * mt + 4 * g);
        u32x2 w; w.x = pk2(acc[mt][0] * rstd * gg.x, acc[mt][1] * rstd * gg.y); w.y = pk2(acc[mt][2] * rstd * gg.z, acc[mt][3] * rstd * gg.w);
        *(u32x2*)(CONCAT + (size_t)(t0 + tl) * D + 1024 + h * 128 + 16 * mt + 4 * g) = w; }
    __syncthreads();
}
DI void list_insert(float (&L)[16], float x) {
#pragma unroll
    for (int i = 15; i >= 1; --i) L[i] = __builtin_amdgcn_fmed3f(x, L[i - 1], L[i]);
    L[0] = fmaxf(L[0], x);
}
DI void list_merge_xor(float (&L)[16], int mask) {
    float M[16];
#pragma unroll
    for (int i = 0; i < 16; ++i) M[i] = fmaxf(L[i], __shfl_xor(L[15 - i], mask));
#pragma unroll
    for (int s = 8; s >= 1; s >>= 1)
#pragma unroll
        for (int i = 0; i < 16; ++i) if ((i & s) == 0) { const float hi = fmaxf(M[i], M[i + s]), lo = fminf(M[i], M[i + s]); M[i] = hi; M[i + s] = lo; }
#pragma unroll
    for (int i = 0; i < 16; ++i) L[i] = M[i];
}
DI float unp7(float x) { return __builtin_bit_cast(float, __builtin_bit_cast(unsigned, x) & 0xFFFFFF80u); }
DI void topk_phase(const Ctx& C, int l, const bf16* QB, const bf16* K1B, const bf16* K2B, int* EB, float* PG) {
    LAS unsigned* tk = (LAS unsigned*)(C.lds + C.wave * 4096);
    const int lane = C.lane, fr = lane & 15, fq = lane >> 4;
#pragma unroll 1
    for (int wi = C.gw; wi < 4096; wi += C.NGW) {
        const int h = wi & 7, tt0 = (wi >> 3) * 32;
        float L[2][2][16];
#pragma unroll
        for (int half = 0; half < 2; ++half) {
            f32x4 acc[8][2];
#pragma unroll
            for (int mt = 0; mt < 8; ++mt) { acc[mt][0] = (f32x4){0.f, 0.f, 0.f, 0.f}; acc[mt][1] = (f32x4){0.f, 0.f, 0.f, 0.f}; }
            const bf16* Kb = (half ? K2B : K1B) + ((size_t)(l * 8 + h) * 128 + fr) * 128 + 8 * fq;
            const bf16* Qp = QB + (size_t)(tt0 + fr) * D + h * 256 + half * 128 + 8 * fq;
#pragma unroll
            for (int ks = 0; ks < 4; ++ks) {
                const bf16x8 b0 = *(const bf16x8*)(Qp + 32 * ks), b1 = *(const bf16x8*)(Qp + (size_t)16 * D + 32 * ks);
#pragma unroll
                for (int mt = 0; mt < 8; ++mt) { const bf16x8 a = *(const bf16x8*)(Kb + (size_t)(16 * mt) * 128 + 32 * ks);
                    acc[mt][0] = mfma16(a, b0, acc[mt][0]); acc[mt][1] = mfma16(a, b1, acc[mt][1]); }
            }
#pragma unroll
            for (int ntl = 0; ntl < 2; ++ntl) {
#pragma unroll
                for (int i = 0; i < 16; ++i) L[half][ntl][i] = __builtin_bit_cast(float, 0xFF800000u);
#pragma unroll
                for (int mt = 0; mt < 8; ++mt)
#pragma unroll
                    for (int r = 0; r < 4; ++r) { const unsigned key = (unsigned)(16 * mt + 4 * fq + r);
                        list_insert(L[half][ntl], __builtin_bit_cast(float, (__builtin_bit_cast(unsigned, acc[mt][ntl][r]) & 0xFFFFFF80u) | key)); }
                list_merge_xor(L[half][ntl], 16); list_merge_xor(L[half][ntl], 32);
            }
        }
#pragma unroll
        for (int ntl = 0; ntl < 2; ++ntl) {
            if (fq == 0) {
#pragma unroll
                for (int i = 0; i < 16; ++i) { tk[(fr * 2 + 0) * 16 + i] = __builtin_bit_cast(unsigned, L[0][ntl][i]); tk[(fr * 2 + 1) * 16 + i] = __builtin_bit_cast(unsigned, L[1][ntl][i]); }
            }
            float Cn[16];
#pragma unroll
            for (int i = 0; i < 16; ++i) Cn[i] = __builtin_bit_cast(float, 0xFF800000u);
#pragma unroll
            for (int i = 0; i < 16; ++i)
#pragma unroll
                for (int j = 0; j < 16; ++j) if ((i + 1) * (j + 1) <= 16) {
                    const float s = unp7(L[0][ntl][i]) + unp7(L[1][ntl][j]);
                    list_insert(Cn, __builtin_bit_cast(float, (__builtin_bit_cast(unsigned, s) & 0xFFFFFF00u) | (unsigned)(i * 16 + j))); }
            LDS_WAIT();
            float sc[4]; int ex[4];
#pragma unroll
            for (int m = 0; m < 4; ++m) {
                const float ck = fq == 0 ? Cn[m] : (fq == 1 ? Cn[4 + m] : (fq == 2 ? Cn[8 + m] : Cn[12 + m]));
                const unsigned cc = __builtin_bit_cast(unsigned, ck) & 255u;
                const unsigned p1 = tk[(fr * 2 + 0) * 16 + (cc >> 4)], p2 = tk[(fr * 2 + 1) * 16 + (cc & 15u)];
                sc[m] = __builtin_bit_cast(float, p1 & 0xFFFFFF80u) + __builtin_bit_cast(float, p2 & 0xFFFFFF80u);
                ex[m] = (int)((p1 & 127u) * 128u + (p2 & 127u));
            }
            float mx = fmaxf(fmaxf(sc[0], sc[1]), fmaxf(sc[2], sc[3]));
            mx = fmaxf(mx, __shfl_xor(mx, 16)); mx = fmaxf(mx, __shfl_xor(mx, 32));
            float w[4], sum = 0.f;
#pragma unroll
            for (int m = 0; m < 4; ++m) { w[m] = fexp2((sc[m] - mx) * 1.442695041f); sum += w[m]; }
            sum += __shfl_xor(sum, 16); sum += __shfl_xor(sum, 32);
            const float inv = 1.0f / sum;
            const size_t o = (size_t)(tt0 + 16 * ntl + fr) * 128 + h * 16 + 4 * fq;
            *(int4*)(EB + o) = make_int4(ex[0], ex[1], ex[2], ex[3]);
            *(f32x4*)(PG + o) = (f32x4){w[0] * inv, w[1] * inv, w[2] * inv, w[3] * inv};
            LDS_WAIT();
        }
    }
}
constexpr int PEER_R = 2;
template <bool LAST>
DI void peer_phase(const Ctx& C, int l, const bf16* Hb, const int* EB, const float* PG, const bf16* PU, const bf16* PV, float* X, const float* gate  ,
                   const float* ng, const float* modn  , bf16* Hout) {
    const int lane = C.lane;
#pragma unroll 1
    for (int ti = 0; ti < 8; ++ti) {
        const int m = C.gw * 8 + ti, b = m >> 12;
        u32x4 hp[4];
#pragma unroll
        for (int c = 0; c < 4; ++c) hp[c] = ((const u32x4*)(Hb + (size_t)m * D))[c * 64 + lane];
        const int e_lo = EB[(size_t)m * 128 + lane], e_hi = EB[(size_t)m * 128 + 64 + lane];
        const float g_lo = PG[(size_t)m * 128 + lane], g_hi = PG[(size_t)m * 128 + 64 + lane];
        float acc[4][8];
#pragma unroll
        for (int c = 0; c < 4; ++c)
#pragma unroll
            for (int i = 0; i < 8; ++i) acc[c][i] = 0.f;
#pragma unroll 1
        for (int k0 = 0; k0 < 128; k0 += PEER_R) {
            u32x4 ur[PEER_R][4], vr[PEER_R][4]; float gk[PEER_R];
#pragma unroll
            for (int r = 0; r < PEER_R; ++r) { const int k = k0 + r;
                const int ek = __builtin_amdgcn_readlane(k0 < 64 ? e_lo : e_hi, k & 63);
                gk[r] = __builtin_bit_cast(float, __builtin_amdgcn_readlane(__builtin_bit_cast(int, k0 < 64 ? g_lo : g_hi), k & 63));
                const u32x4* up = (const u32x4*)(PU + (size_t)ek * D) + lane; const u32x4* vp = (const u32x4*)(PV + (size_t)ek * D) + lane;
#pragma unroll
                for (int c = 0; c < 4; ++c) { ur[r][c] = up[c * 64]; vr[r][c] = vp[c * 64]; } }
#pragma unroll
            for (int r = 0; r < PEER_R; ++r) { float p = 0.f;
#pragma unroll
                for (int c = 0; c < 4; ++c) { p = dot2bf(ur[r][c].x, hp[c].x, p); p = dot2bf(ur[r][c].y, hp[c].y, p); p = dot2bf(ur[r][c].z, hp[c].z, p); p = dot2bf(ur[r][c].w, hp[c].w, p); }
#ifdef DBG_NO_PEER
                const float a = 0.f * gelu_t(wave_sum(p)) * gk[r];
#else
                const float a = gelu_t(wave_sum(p)) * gk[r];
#endif
#pragma unroll
                for (int c = 0; c < 4; ++c) {
                    acc[c][0] += a * bflo(vr[r][c].x); acc[c][1] += a * bfhi(vr[r][c].x); acc[c][2] += a * bflo(vr[r][c].y); acc[c][3] += a * bfhi(vr[r][c].y);
                    acc[c][4] += a * bflo(vr[r][c].z); acc[c][5] += a * bfhi(vr[r][c].z); acc[c][6] += a * bflo(vr[r][c].w); acc[c][7] += a * bfhi(vr[r][c].w); } }
        }
        float* xr = X + (size_t)m * D; const float* gp = gate + (size_t)b * MODW; float ss = 0.f;
#pragma unroll
        for (int c = 0; c < 4; ++c) { const int e0 = c * 512 + lane * 8;
            const f32x4 x0 = *(const f32x4*)(xr + e0), x1 = *(const f32x4*)(xr + e0 + 4), t0 = *(const f32x4*)(gp + e0), t1 = *(const f32x4*)(gp + e0 + 4);
            acc[c][0] = x0.x + t0.x * acc[c][0]; acc[c][1] = x0.y + t0.y * acc[c][1]; acc[c][2] = x0.z + t0.z * acc[c][2]; acc[c][3] = x0.w + t0.w * acc[c][3];
            acc[c][4] = x1.x + t1.x * acc[c][4]; acc[c][5] = x1.y + t1.y * acc[c][5]; acc[c][6] = x1.z + t1.z * acc[c][6]; acc[c][7] = x1.w + t1.w * acc[c][7];
#pragma unroll
            for (int i = 0; i < 8; ++i) ss += acc[c][i] * acc[c][i]; }
        const float rstd = frsq(wave_sum(ss) * (1.f / D) + EPS);
#pragma unroll
        for (int c = 0; c < 4; ++c) { const int e0 = c * 512 + lane * 8;
            const f32x4 g0 = *(const f32x4*)(ng + e0), g1 = *(const f32x4*)(ng + e0 + 4);
            if (LAST) {
                *(f32x4*)(xr + e0) = (f32x4){acc[c][0] * rstd * g0.x, acc[c][1] * rstd * g0.y, acc[c][2] * rstd * g0.z, acc[c][3] * rstd * g0.w};
                *(f32x4*)(xr + e0 + 4) = (f32x4){acc[c][4] * rstd * g1.x, acc[c][5] * rstd * g1.y, acc[c][6] * rstd * g1.z, acc[c][7] * rstd * g1.w};
            } else {
                *(f32x4*)(xr + e0) = (f32x4){acc[c][0], acc[c][1], acc[c][2], acc[c][3]};
                *(f32x4*)(xr + e0 + 4) = (f32x4){acc[c][4], acc[c][5], acc[c][6], acc[c][7]};
                const float* sh = modn + (size_t)b * MODW; const float* sc = sh + D;
                const f32x4 s0 = *(const f32x4*)(sc + e0), s1 = *(const f32x4*)(sc + e0 + 4), h0 = *(const f32x4*)(sh + e0), h1 = *(const f32x4*)(sh + e0 + 4);
                u32x4 w;
                w.x = pk2(acc[c][0] * rstd * g0.x * (1.f + s0.x) + h0.x, acc[c][1] * rstd * g0.y * (1.f + s0.y) + h0.y);
                w.y = pk2(acc[c][2] * rstd * g0.z * (1.f + s0.z) + h0.z, acc[c][3] * rstd * g0.w * (1.f + s0.w) + h0.w);
                w.z = pk2(acc[c][4] * rstd * g1.x * (1.f + s1.x) + h1.x, acc[c][5] * rstd * g1.y * (1.f + s1.y) + h1.y);
                w.w = pk2(acc[c][6] * rstd * g1.z * (1.f + s1.z) + h1.z, acc[c][7] * rstd * g1.w * (1.f + s1.w) + h1.w);
                ((u32x4*)(Hout + (size_t)m * D))[c * 64 + lane] = w;
            } }
    }
}
DI void topk_simple(const Ctx& C, int l, const bf16* QB, const bf16* K1B, const bf16* K2B, int* EB, float* PG) {
    LAS float* vs = (LAS float*)(C.lds + C.wave * 4096);
    LAS int* is = (LAS int*)(C.lds + C.wave * 4096 + 256);
    const int lane = C.lane; const float NEGINF = __builtin_bit_cast(float, 0xFF800000u);
#pragma unroll 1
    for (int task = C.gw; task < T * 8; task += C.NGW) {
        const int t = task >> 3, h = task & 7;
        float s[2][2];
#pragma unroll
        for (int half = 0; half < 2; ++half)
#pragma unroll
            for (int kk = 0; kk < 2; ++kk) {
                const bf16* kr = (half ? K2B : K1B) + ((size_t)(l * 8 + h) * 128 + lane + 64 * kk) * 128; const bf16* qr = QB + (size_t)t * D + h * 256 + half * 128;
                float a = 0.f;
#pragma unroll 4
                for (int d = 0; d < 128; d += 8) { const u32x4 kv = *(const u32x4*)(kr + d), qv = *(const u32x4*)(qr + d);
                    a += bflo(kv.x) * bflo(qv.x) + bfhi(kv.x) * bfhi(qv.x) + bflo(kv.y) * bflo(qv.y) + bfhi(kv.y) * bfhi(qv.y) + bflo(kv.z) * bflo(qv.z) + bfhi(kv.z) * bfhi(qv.z) + bflo(kv.w) * bflo(qv.w) + bfhi(kv.w) * bfhi(qv.w); }
                s[half][kk] = a; }
#pragma unroll
        for (int half = 0; half < 2; ++half) { float a0 = s[half][0], a1 = s[half][1];
#pragma unroll 1
            for (int r = 0; r < 16; ++r) {
                float m = a0 >= a1 ? a0 : a1; int id = a0 >= a1 ? lane : lane + 64;
#pragma unroll
                for (int o = 1; o < 64; o <<= 1) { const float om = __shfl_xor(m, o); const int oid = __shfl_xor(id, o); if (om > m || (om == m && oid < id)) { m = om; id = oid; } }
                if (lane == 0) { vs[half * 16 + r] = m; is[half * 16 + r] = id; }
                if (id == lane) a0 = NEGINF; if (id == lane + 64) a1 = NEGINF; } }
        LDS_WAIT();
        float cv[4];
#pragma unroll
        for (int tt = 0; tt < 4; ++tt) { const int c = lane * 4 + tt; cv[tt] = vs[c >> 4] + vs[16 + (c & 15)]; }
        float mysc = 0.f; int mye = 0;
#pragma unroll 1
        for (int r = 0; r < 16; ++r) {
            float m = cv[0]; int id = lane * 4;
#pragma unroll
            for (int tt = 1; tt < 4; ++tt) if (cv[tt] > m) { m = cv[tt]; id = lane * 4 + tt; }
#pragma unroll
            for (int o = 1; o < 64; o <<= 1) { const float om = __shfl_xor(m, o); const int oid = __shfl_xor(id, o); if (om > m || (om == m && oid < id)) { m = om; id = oid; } }
            if (lane == r) { mysc = m; mye = is[id >> 4] * 128 + is[16 + (id & 15)]; }
#pragma unroll
            for (int tt = 0; tt < 4; ++tt) if (id == lane * 4 + tt) cv[tt] = NEGINF;
        }
        float mx = lane < 16 ? mysc : NEGINF;
#pragma unroll
        for (int o = 1; o < 64; o <<= 1) mx = fmaxf(mx, __shfl_xor(mx, o));
        float w = lane < 16 ? fexp2((mysc - mx) * 1.442695041f) : 0.f; float sum = w;
#pragma unroll
        for (int o = 1; o < 64; o <<= 1) sum += __shfl_xor(sum, o);
        if (lane < 16) { EB[(size_t)t * 128 + h * 16 + lane] = mye; PG[(size_t)t * 128 + h * 16 + lane] = w / sum; }
        LDS_WAIT();
    }
}
constexpr int NPH = 20;
struct Args { const float* in[21]; float* out; unsigned char* ws; int ph_lo, ph_hi, pad0, pad1; };
__global__ void __launch_bounds__(NTHR, 2) mk_fwd(Args args) {
    extern __shared__ __attribute__((aligned(16))) unsigned char lds_raw[];
    ldsp ldsb = (ldsp)lds_raw;
    volatile LAS unsigned* MISC = (volatile LAS unsigned*)(ldsb + MISC_OFF);
    for (int u = threadIdx.x; u < (LDS_BYTES - LDSCTL_OFF) / 4; u += NTHR) ((LAS unsigned*)(ldsb + LDSCTL_OFF))[u] = 0u;
    __syncthreads();
    unsigned* barw = (unsigned*)(args.ws + WS_CTL) + CW_BAR;
    XcdBarrier bar; bar.bar = barw; bar.x = 0; bar.st = nullptr;
    const bool multi = (args.ph_hi - args.ph_lo) > 1;
    if (multi) bar = xcd_barrier_post(barw, MISC + 8);

#pragma unroll 1
    for (int ph = args.ph_lo; ph < args.ph_hi; ++ph) {
        int tid_ = threadIdx.x, bid_ = blockIdx.x; asm volatile("" : "+v"(tid_)); asm volatile("" : "+s"(bid_));
        Ctx C;
        C.lds = ldsb; C.tid = tid_; C.lane = tid_ & 63; C.wave = __builtin_amdgcn_readfirstlane(tid_ >> 6);
        C.bid = bid_; C.G = gridDim.x; C.gw = C.bid * NWAVES + C.wave; C.NGW = C.G * NWAVES;
#pragma unroll
        for (int i = 0; i < 21; ++i) C.in[i] = args.in[i];
        C.out = args.out; C.ws = args.ws;
        float* MOD = (float*)(C.ws + WS_MOD);
        bf16* Hb = (bf16*)(C.ws + WS_H); bf16* PROJ = (bf16*)(C.ws + WS_PROJ); bf16* SBUF = (bf16*)(C.ws + WS_SBUF); bf16* CONCAT = (bf16*)(C.ws + WS_CONCAT); bf16* QB = (bf16*)(C.ws + WS_QB);
        float* ALOW = (float*)(C.ws + WS_ALOW); float* DEC = (float*)(C.ws + WS_DEC); int* EB = (int*)(C.ws + WS_EB); float* PG = (float*)(C.ws + WS_PG);
        float* X = C.out;
        const int l = ph < 2 ? 0 : (ph - 2) / 9, kind = ph < 2 ? -1 : (ph - 2) % 9;
        const float* modl = MOD + (size_t)l * 4 * MODW;
        if (ph == 0) p0_prologue(C);
        else if (ph == 1) norm_phase(C, C.in[I_X], C.in[I_N1G], modl, 0, D, Hb);
        else if (kind == 0 || kind == 6) {
            const bool isq = (kind == 6);
            pg8::Gemm g{Hb, isq ? (const bf16*)(C.ws + WS_WTQ) + (size_t)l * D * D : (const bf16*)(C.ws + WS_WTIN) + (size_t)l * WTIN_L, T, isq ? D : NPROJ, D};
            pg8::StaticOrder S; S.init(T, g.N, C.G, C.bid);
            pg8::EpiBf16 E{isq ? QB : PROJ, isq ? D : NPROJ};
            pg8::gemm_phase<pg8::EpiBf16, pg8::StaticOrder>(C.lds, g, S, E);
            if (!isq) alow_phase(C, Hb, (const bf16*)(C.ws + WS_WTIN) + (size_t)l * WTIN_L + (size_t)NPROJ * D, ALOW);
        }
        else if (kind == 1) {
#pragma unroll 1
            for (int i = 0; i < 8; ++i) { const int idx = (i >> 1) * C.G + C.bid;
                if (idx < 1024) { if (i & 1) gmlp_item(C, l, idx, PROJ, (const bf16*)(C.ws + WS_WSB), CONCAT); else glaA_item(C, l, idx, PROJ, ALOW, SBUF, DEC); } }
        }
        else if (kind == 2) scan_phase(C, SBUF, DEC);
        else if (kind == 3) {
#pragma unroll 1
            for (int idx = C.bid; idx < 1024; idx += C.G) glaC_item(C, l, idx, PROJ, ALOW, SBUF, CONCAT);
        }
        else if (kind == 4) {
            pg8::Gemm g{CONCAT, (const bf16*)(C.ws + WS_WTOUT) + (size_t)l * D * D, T, D, D};
            pg8::StaticOrder S; S.init(T, D, C.G, C.bid);
            pg8::EpiResGate E{l == 0 ? C.in[I_X] : (const float*)X, X, modl + 2 * D, MODW};
            pg8::gemm_phase<pg8::EpiResGate, pg8::StaticOrder>(C.lds, g, S, E);
        }
        else if (kind == 5) norm_phase(C, X, C.in[I_N2G] + (size_t)l * D, modl, 3 * D, 4 * D, Hb);
#ifdef DBG_SIMPLE_TOPK
        else if (kind == 7) topk_simple(C, l, QB, (const bf16*)(C.ws + WS_K1B), (const bf16*)(C.ws + WS_K2B), EB, PG);
#else
        else if (kind == 7) topk_phase(C, l, QB, (const bf16*)(C.ws + WS_K1B), (const bf16*)(C.ws + WS_K2B), EB, PG);
#endif
        else {
            const bf16* PU = (const bf16*)(C.ws + WS_PUB) + (size_t)l * NEXP * D; const bf16* PV = (const bf16*)(C.ws + WS_PVB) + (size_t)l * NEXP * D;
            if (l == DEPTH - 1) peer_phase<true>(C, l, Hb, EB, PG, PU, PV, X, modl + 5 * D, C.in[I_FG], nullptr, Hb);
            else peer_phase<false>(C, l, Hb, EB, PG, PU, PV, X, modl + 5 * D, C.in[I_N1G] + (size_t)(l + 1) * D, MOD + (size_t)(l + 1) * 4 * MODW, Hb);
        }
        if (ph + 1 < args.ph_hi) xcd_barrier(bar);
    }
}

extern "C" void kernel_launch(void* const* d_in, const int* in_sizes, int n_in, void* d_out, int out_size, void* d_ws, size_t ws_size, hipStream_t stream) {
    static int grid = 0;
    if (grid == 0) {
        if (n_in != 21 || out_size != T * D || ws_size < WS_END) { fprintf(stderr, "kernel_launch: unexpected shapes (n_in %d, out %d, ws %zu)\n", n_in, out_size, ws_size); grid = -1; return; }
        int dev = 0, cus = 0, per_cu = 0;
        if (hipGetDevice(&dev) != hipSuccess || hipDeviceGetAttribute(&cus, hipDeviceAttributeMultiprocessorCount, dev) != hipSuccess) { grid = -1; return; }
        if (hipFuncSetAttribute((const void*)mk_fwd, hipFuncAttributeMaxDynamicSharedMemorySize, LDS_BYTES) != hipSuccess) { fprintf(stderr, "kernel_launch: hipFuncSetAttribute failed\n"); grid = -1; return; }
        if (hipOccupancyMaxActiveBlocksPerMultiprocessor(&per_cu, (const void*)mk_fwd, NTHR, LDS_BYTES) != hipSuccess || per_cu < 1) { fprintf(stderr, "kernel_launch: occupancy query says %d blocks per CU\n", per_cu); (void)hipGetLastError(); grid = -1; return; }
        if (cus != 256) { fprintf(stderr, "kernel_launch: built for a 256-CU device (got %d)\n", cus); grid = -1; return; }
        grid = cus;
    }
    if (grid < 0) return;
    (void)hipMemsetAsync((char*)d_ws + WS_CTL, 0, CTL_ZERO_BYTES, stream);
    Args a{};
    for (int i = 0; i < 21; ++i) a.in[i] = (const float*)d_in[i];
    a.out = (float*)d_out; a.ws = (unsigned char*)d_ws;
#if MK_N_LAUNCHES == 1
    a.ph_lo = 0; a.ph_hi = NPH;
    hipLaunchKernelGGL(mk_fwd, dim3(grid), dim3(NTHR), LDS_BYTES, stream, a);
#else
    for (int p = 0; p < NPH; ++p) { a.ph_lo = p; a.ph_hi = p + 1; hipLaunchKernelGGL(mk_fwd, dim3(grid), dim3(NTHR), LDS_BYTES, stream, a); }
#endif
}
```

```cpp
#include <hip/hip_runtime.h>
#include <cstdio>
#include <cstdint>
#ifndef MK_N_LAUNCHES
#define MK_N_LAUNCHES 1
#endif
namespace pg8 {
#define PG8_LAS __attribute__((address_space(3)))
typedef unsigned short bf16_t;
typedef short bf16x8 __attribute__((ext_vector_type(8)));
typedef float f32x4 __attribute__((ext_vector_type(4)));
typedef unsigned u32x4 __attribute__((ext_vector_type(4)));
constexpr int BM = 256, BK = 64, HALF = 128, HTB = HALF * BK * 2  , STAGE_BYTES = 8 * HTB, NXCD = 8, WGM = 8;

__host__ __device__ __forceinline__ int lds_byte(int r, int c) { const int st = (r >> 4) * 2 + (c >> 5), rr = r & 15, cc = c & 31, ob = rr * 64 + cc * 2; return st * 1024 + (ob ^ (((ob >> 9) & 1) << 5)); }
__host__ __device__ __forceinline__ void stage_rc(int b, int& R, int& C) { const int st = b / 1024, sb = b % 1024, swz = sb ^ (((sb >> 9) & 1) << 5); R = (st >> 1) * 16 + swz / 64; C = (st & 1) * 32 + (swz % 64) / 2; }
__host__ __device__ __forceinline__ int perm32(int rho) { const int n = rho >> 4, i = rho & 15; return 8 * (i >> 2) + 4 * n + (i & 3); }

struct Unit { int pm, pn; };
struct Gemm { const bf16_t* A; const bf16_t* Bt; int M, N, K; };

struct StaticOrder {
    int nM, nN, nwg, G, c;
    __host__ __device__ void init(int M, int N, int G_, int c_) { nM = M / BM; nN = N / BM; nwg = nM * nN; G = G_; c = c_; }
    __host__ __device__ bool next(int i, Unit& u) const {
        const long L = (long)i * G + c; if (L >= nwg) return false;
        int wgid = (int)L; { const int q = nwg / NXCD, r = nwg % NXCD, xcd = wgid % NXCD, off = wgid / NXCD; wgid = (xcd < r ? xcd * (q + 1) : r * (q + 1) + (xcd - r) * q) + off; }
        const int nig = WGM * nN, gid = wgid / nig, fm = gid * WGM, gsz = (nM - fm) < WGM ? (nM - fm) : WGM;
        u.pm = fm + ((wgid % nig) % gsz); u.pn = (wgid % nig) / gsz; return true;
    }
    __device__ __forceinline__ void a_ready(const Unit&) const {}
    __device__ __forceinline__ void done(const Unit&) const {}
};
__device__ __forceinline__ unsigned cvt_pk_bf16(float lo, float hi) { unsigned r; asm volatile("v_cvt_pk_bf16_f32 %0, %1, %2" : "=v"(r) : "v"(lo), "v"(hi)); return r; }
struct EpiBf16 {
    static constexpr bool PERM = true, AFTER_DRAIN = false;
    bf16_t* O; int ldc;
    __device__ __forceinline__ void operator()(const f32x4 (&acc)[2][2][4][2], const Unit& u, int wr, int wc, int fr, int fq) const {
        const int row0 = u.pm * BM + wr * 64 + fr; const int col0 = u.pn * BM + wc * 32 + 8 * fq;
#pragma unroll
        for (int ai = 0; ai < 2; ++ai)
#pragma unroll
            for (int m = 0; m < 4; ++m) { bf16_t* rowp = O + (size_t)(row0 + ai * HALF + m * 16) * ldc + col0;
#pragma unroll
                for (int bj = 0; bj < 2; ++bj) { const f32x4 v0 = acc[ai][bj][m][0], v1 = acc[ai][bj][m][1];
                    u32x4 w; w.x = cvt_pk_bf16(v0[0], v0[1]); w.y = cvt_pk_bf16(v0[2], v0[3]); w.z = cvt_pk_bf16(v1[0], v1[1]); w.w = cvt_pk_bf16(v1[2], v1[3]);
                    *(u32x4*)(rowp + bj * HALF) = w; } }
    }
};
struct EpiResGate {
    static constexpr bool PERM = false, AFTER_DRAIN = false;
    const float* base; float* out; const float* gate; int gpitch;
    __device__ __forceinline__ void operator()(const f32x4 (&acc)[2][2][4][2], const Unit& u, int wr, int wc, int fr, int fq) const {
        const int row0 = u.pm * BM + wr * 64 + fr, col0 = u.pn * BM + wc * 32 + 4 * fq;
        const float* gp = gate + (size_t)(u.pm >> 4) * gpitch + col0;
        f32x4 gv[2][2];
#pragma unroll
        for (int bj = 0; bj < 2; ++bj)
#pragma unroll
            for (int n = 0; n < 2; ++n) gv[bj][n] = *(const f32x4*)(gp + bj * HALF + n * 16);
#pragma unroll
        for (int ai = 0; ai < 2; ++ai)
#pragma unroll
            for (int m = 0; m < 4; ++m) { const size_t off = (size_t)(row0 + ai * HALF + m * 16) * 2048 + col0;
#pragma unroll
                for (int bj = 0; bj < 2; ++bj)
#pragma unroll
                    for (int n = 0; n < 2; ++n) { const f32x4 bs = *(const f32x4*)(base + off + bj * HALF + n * 16); *(f32x4*)(out + off + bj * HALF + n * 16) = bs + gv[bj][n] * acc[ai][bj][m][n]; }
                asm volatile("" ::: "memory"); }
    }
};

template <class Epi, class Sched>
__device__ __forceinline__ void gemm_phase(PG8_LAS unsigned char* lds, const Gemm g, const Sched& S, const Epi& E) {
    const int tid = threadIdx.x, wid = __builtin_amdgcn_readfirstlane(tid >> 6), lane = tid & 63, wr = wid >> 2, wc = wid & 3, fr = lane & 15, fq = lane >> 4;
    const int K = g.K, nt = K / BK;
    unsigned voffA[2], voffB[2];
#pragma unroll
    for (int i = 0; i < 2; ++i) { int R, C; stage_rc(tid * 16 + i * 8192, R, C); const int Rb = Epi::PERM ? ((R & ~31) + perm32(R & 31)) : R;
        voffA[i] = (unsigned)(R * K + C) * 2u; voffB[i] = (unsigned)(Rb * K + C) * 2u; }
    const size_t kstep = (size_t)(BK * 2);
    const size_t hstep = (size_t)HALF * K * 2;
    const size_t tstep = 2 * hstep;
    const unsigned ldsw = (unsigned)wid * 1024u;
    const int aoff = lds_byte(wr * 64 + fr, fq * 8), boff = lds_byte(wc * 32 + fr, fq * 8);
#define PG8_SA(b, h) (((b) * 2 + (h)) * HTB)
#define PG8_SB(b, h) ((4 + (b) * 2 + (h)) * HTB)
#define PG8_STAGE(bufoff, gbase, voff) do { _Pragma("unroll") for (int _i = 0; _i < 2; ++_i) \
        __builtin_amdgcn_global_load_lds((const unsigned*)((const char*)(gbase) + (voff)[_i]), (PG8_LAS unsigned*)(lds + (bufoff) + ldsw + _i * 8192), 16, 0, 0); } while (0)
#define PG8_LDA(dst, b, h) do { _Pragma("unroll") for (int m = 0; m < 4; ++m) _Pragma("unroll") for (int k = 0; k < 2; ++k) dst[m][k] = *(const PG8_LAS bf16x8*)(lds + PG8_SA(b, h) + aoff + m * 2048 + k * 1024); } while (0)
#define PG8_LDB(dst, b, h) do { _Pragma("unroll") for (int n = 0; n < 2; ++n) _Pragma("unroll") for (int k = 0; k < 2; ++k) dst[n][k] = *(const PG8_LAS bf16x8*)(lds + PG8_SB(b, h) + boff + n * 2048 + k * 1024); } while (0)
#define PG8_MMA(ai, bj, At, Bt) do { __builtin_amdgcn_s_setprio(1); _Pragma("unroll") for (int m = 0; m < 4; ++m) _Pragma("unroll") for (int n = 0; n < 2; ++n) _Pragma("unroll") for (int k = 0; k < 2; ++k) \
        acc[ai][bj][m][n] = __builtin_amdgcn_mfma_f32_16x16x32_bf16(Bt[n][k], At[m][k], acc[ai][bj][m][n], 0, 0, 0); __builtin_amdgcn_s_setprio(0); } while (0)
#define PG8_WAIT_V(n) asm volatile("s_waitcnt vmcnt(" #n ")" ::: "memory")
#define PG8_WAIT_L(n) asm volatile("s_waitcnt lgkmcnt(" #n ")" ::: "memory")
#define PG8_BAR __builtin_amdgcn_s_barrier()
#define PG8_SCHED __builtin_amdgcn_sched_barrier(0)
    Unit cur, nxt; int ui = 0;
    if (!S.next(0, cur)) return;
    f32x4 acc[2][2][4][2];
#pragma unroll
    for (int a = 0; a < 2; ++a)
#pragma unroll
        for (int b = 0; b < 2; ++b)
#pragma unroll
            for (int m = 0; m < 4; ++m)
#pragma unroll
                for (int n = 0; n < 2; ++n) acc[a][b][m][n] = (f32x4){0.f, 0.f, 0.f, 0.f};
    bf16x8 At[4][2], B0[2][2], B1[2][2];
    const char* cA = (const char*)g.A + (size_t)cur.pm * tstep; const char* cB = (const char*)g.Bt + (size_t)cur.pn * tstep;
    S.a_ready(cur);
    PG8_STAGE(PG8_SB(0, 0), cB, voffB); PG8_STAGE(PG8_SA(0, 0), cA, voffA); PG8_STAGE(PG8_SB(0, 1), cB + hstep, voffB); PG8_STAGE(PG8_SA(0, 1), cA + hstep, voffA);
    if (wr == 1) PG8_BAR;
    PG8_WAIT_V(4); PG8_BAR;
    PG8_STAGE(PG8_SB(1, 0), cB + kstep, voffB); PG8_STAGE(PG8_SA(1, 0), cA + kstep, voffA); PG8_STAGE(PG8_SB(1, 1), cB + hstep + kstep, voffB);
    PG8_WAIT_V(6); PG8_BAR;
    for (;;) {
        const bool has_next = S.next(ui + 1, nxt);
        const char* nA = has_next ? (const char*)g.A + (size_t)nxt.pm * tstep : cA; const char* nB = has_next ? (const char*)g.Bt + (size_t)nxt.pn * tstep : cB;
        for (int t = 0; t < nt; t += 2) {
            const bool last = (t == nt - 2);
            const char* a1 = cA + (size_t)(t + 1) * kstep;
            const char* a2 = last ? nA : cA + (size_t)(t + 2) * kstep; const char* b2 = last ? nB : cB + (size_t)(t + 2) * kstep;
            const char* a3 = a2 + kstep; const char* b3 = b2 + kstep;
            if (last && has_next) S.a_ready(nxt);
            PG8_LDB(B0, 0, 0); PG8_SCHED; PG8_LDA(At, 0, 0); PG8_STAGE(PG8_SA(1, 1), a1 + hstep, voffA);
            PG8_WAIT_L(8); PG8_BAR; PG8_WAIT_L(0); PG8_MMA(0, 0, At, B0); PG8_BAR; PG8_SCHED;
            PG8_LDB(B1, 0, 1); PG8_STAGE(PG8_SB(0, 0), b2, voffB);
            PG8_BAR; PG8_WAIT_L(0); PG8_MMA(0, 1, At, B1); PG8_BAR;
            PG8_LDA(At, 0, 1); PG8_STAGE(PG8_SA(0, 0), a2, voffA);
            PG8_BAR; PG8_WAIT_L(0); PG8_MMA(1, 0, At, B0); PG8_BAR; PG8_SCHED;
            PG8_STAGE(PG8_SB(0, 1), b2 + hstep, voffB);
            PG8_WAIT_V(6); PG8_BAR; PG8_MMA(1, 1, At, B1); PG8_BAR;
            PG8_LDB(B0, 1, 0); PG8_SCHED; PG8_LDA(At, 1, 0); PG8_STAGE(PG8_SA(0, 1), a2 + hstep, voffA);
            PG8_WAIT_L(8); PG8_BAR; PG8_WAIT_L(0); PG8_MMA(0, 0, At, B0); PG8_BAR; PG8_SCHED;
            PG8_LDB(B1, 1, 1); PG8_STAGE(PG8_SB(1, 0), b3, voffB);
            PG8_BAR; PG8_WAIT_L(0); PG8_MMA(0, 1, At, B1); PG8_BAR;
            PG8_LDA(At, 1, 1); PG8_STAGE(PG8_SA(1, 0), a3, voffA);
            PG8_BAR; PG8_WAIT_L(0); PG8_MMA(1, 0, At, B0); PG8_BAR; PG8_SCHED;
            PG8_STAGE(PG8_SB(1, 1), b3 + hstep, voffB);
            PG8_WAIT_V(6); PG8_BAR; PG8_MMA(1, 1, At, B1); PG8_BAR;
        }
        if constexpr (!Epi::AFTER_DRAIN) { E(acc, cur, wr, wc, fr, fq); S.done(cur); }
        if (!has_next) break;
#pragma unroll
        for (int a = 0; a < 2; ++a)
#pragma unroll
            for (int b = 0; b < 2; ++b)
#pragma unroll
                for (int m = 0; m < 4; ++m)
#pragma unroll
                    for (int n = 0; n < 2; ++n) acc[a][b][m][n] = (f32x4){0.f, 0.f, 0.f, 0.f};
        cur = nxt; cA = nA; cB = nB; ++ui;
    }
    PG8_WAIT_V(0);
    if (wr == 0) PG8_BAR;
    PG8_BAR;
    if constexpr (Epi::AFTER_DRAIN) { E.fused(acc, cur, wr, wc, fr, fq, lds, wid, lane); S.done(cur); }
#undef PG8_SA
#undef PG8_SB
#undef PG8_STAGE
#undef PG8_LDA
#undef PG8_LDB
#undef PG8_MMA
#undef PG8_WAIT_V
#undef PG8_WAIT_L
#undef PG8_BAR
#undef PG8_SCHED
}
}
constexpr int NWAVES = 8, NTHR = 512;
constexpr int D = 2048, NBATCH = 4, SEQ = 4096, T = NBATCH * SEQ, DEPTH = 2;
constexpr int GLA_H = 4, GLA_DK = 128, GLA_DV = 256, GLA_CH = 64;
constexpr int MLP_H = 8, MLP_DH = 128, MLP_CH = 128;
constexpr int IN_COLS = 5136, NPROJ = 5120;
constexpr int C_Q = 0, C_K = 512, C_V = 1024, C_R = 2048, C_U = 3072, C_VS = 4096;
constexpr int NEXP = 16384, PEER_H = 8;
constexpr float EPS = 1e-6f;
constexpr int MODW = 6 * D;
constexpr size_t MiB = 1u << 20;
constexpr size_t WS_CTL = 0, CTL_ZERO_BYTES = 1 * MiB;
constexpr size_t WS_MOD = 1 * MiB;
constexpr size_t WS_K1B = 2 * MiB, WS_K2B = 2 * MiB + 512 * 1024, WS_WSB = 3 * MiB, WS_DEC = 3 * MiB + 512 * 1024, WS_ALOW = 4 * MiB;
constexpr size_t WS_WTIN = 8 * MiB;
constexpr size_t WTIN_L = (size_t)5136 * 2048;
constexpr size_t WS_WTOUT = 49 * MiB, WS_WTQ = 65 * MiB;
constexpr size_t WS_PUB = 81 * MiB, WS_PVB = 209 * MiB;
constexpr size_t WS_H = 337 * MiB;
constexpr size_t WS_PROJ = 401 * MiB;
constexpr size_t WS_SBUF = 561 * MiB;
constexpr size_t WS_CONCAT = 625 * MiB;
constexpr size_t WS_QB = 689 * MiB;
constexpr size_t WS_EB = 753 * MiB, WS_PG = 761 * MiB, WS_END = 769 * MiB;
static_assert(WS_WTIN + 2 * WTIN_L * 2 <= WS_WTOUT, "ws map");
constexpr int CW_BAR = 4096;
constexpr int RING_BYTES = 131072, LDSCTL_OFF = RING_BYTES, MISC_OFF = LDSCTL_OFF + 320, LDS_BYTES = 147456;

#define DI __device__ __forceinline__
#define LAS __attribute__((address_space(3)))
typedef unsigned short bf16;
typedef short bf16x8 __attribute__((ext_vector_type(8)));
typedef short s16x4 __attribute__((ext_vector_type(4)));
typedef short v4i16_t __attribute__((ext_vector_type(4)));
typedef __bf16 bf16x2_t __attribute__((ext_vector_type(2)));
typedef float f32x4 __attribute__((ext_vector_type(4)));
typedef float f32x2 __attribute__((ext_vector_type(2)));
typedef unsigned u32x4 __attribute__((ext_vector_type(4)));
typedef unsigned u32x2 __attribute__((ext_vector_type(2)));
typedef LAS unsigned char* ldsp;

DI unsigned f2bf(float f) { unsigned u = __builtin_bit_cast(unsigned, f); return (u + 0x7fffu + ((u >> 16) & 1u)) >> 16; }
DI unsigned pk2(float lo, float hi) { return f2bf(lo) | (f2bf(hi) << 16); }
DI float bflo(unsigned u) { return __builtin_bit_cast(float, u << 16); }
DI float bfhi(unsigned u) { return __builtin_bit_cast(float, u & 0xffff0000u); }
DI float bf1(bf16 v) { return __builtin_bit_cast(float, ((unsigned)v) << 16); }
DI float fexp2(float x) { return __builtin_amdgcn_exp2f(x); }
DI float flog2(float x) { return __builtin_amdgcn_logf(x); }
DI float frcp(float x) { return __builtin_amdgcn_rcpf(x); }
DI float frsq(float x) { return __builtin_amdgcn_rsqf(x); }
DI float gelu_t(float x) { const float u = 0.7978845608f * (x + 0.044715f * x * x * x); return x * frcp(1.f + fexp2(-2.885390082f * u)); }
DI float silu_f(float x) { return x * frcp(1.f + fexp2(-1.442695041f * x)); }
DI float wave_sum(float v) {
#pragma unroll
    for (int o = 1; o < 64; o <<= 1) v += __shfl_xor(v, o);
    return v;
}
DI float dot2bf(unsigned a, unsigned b, float c) { return __builtin_amdgcn_fdot2_f32_bf16(__builtin_bit_cast(bf16x2_t, a), __builtin_bit_cast(bf16x2_t, b), c, false); }
DI f32x4 mfma16(bf16x8 a, bf16x8 b, f32x4 c) { return __builtin_amdgcn_mfma_f32_16x16x32_bf16(a, b, c, 0, 0, 0); }
DI s16x4 tr4(const LAS bf16* p) { return __builtin_bit_cast(s16x4, __builtin_amdgcn_ds_read_tr16_b64_v4i16((LAS v4i16_t*)p)); }
DI bf16x8 tr8(const LAS bf16* p, int stride) { const s16x4 a = tr4(p), b = tr4(p + 4 * stride); return (bf16x8){a[0], a[1], a[2], a[3], b[0], b[1], b[2], b[3]}; }

#define XB_TMO      128
#define XB_XCNT(j)  (256  + 64 * (j))
#define XB_XSUB(j)  (1280 + 64 * (j))
#define XB_XGEN(j)  (2304 + 64 * (j))
#define XB_TOP      3328
#define XB_TOPGEN   3392
#define XCD_BAR_WORDS 3456
#define XB_SPIN_CAP (1u << 18)

__device__ __forceinline__ unsigned xb_ld(unsigned* p)              { return __hip_atomic_load(p, __ATOMIC_RELAXED, __HIP_MEMORY_SCOPE_AGENT); }
__device__ __forceinline__ unsigned xb_add(unsigned* p, unsigned v) { return __hip_atomic_fetch_add(p, v, __ATOMIC_RELAXED, __HIP_MEMORY_SCOPE_AGENT); }
__device__ __forceinline__ unsigned xb_xcc_id() { return (unsigned)__builtin_amdgcn_s_getreg((3 << 11) | 20) & 0xFu; }
#define XB_SPIN(cond, bar) do { unsigned _sp = 0; while (cond) { __builtin_amdgcn_s_sleep(1); \
    if ((++_sp & 255u) == 0u) { if (xb_ld(&(bar)[XB_TMO])) break; if (_sp > XB_SPIN_CAP) { atomicAdd(&(bar)[XB_TMO], 1u); break; } } } } while (0)

struct XcdBarrier {
    unsigned* bar; unsigned x;
    volatile LAS unsigned* st;
};

__device__ __forceinline__ XcdBarrier xcd_barrier_post(unsigned* bar, volatile LAS unsigned* st) {
    XcdBarrier b; b.bar = bar; b.x = xb_xcc_id(); b.st = st;
    if (threadIdx.x == 0) (void)xb_add(&bar[XB_XCNT(b.x)], 1u);
    return b;
}
__device__ __forceinline__ void xcd_barrier_complete(unsigned* bar, unsigned x, unsigned& nloc, unsigned& nx) {
    const unsigned G = gridDim.x * gridDim.y * gridDim.z;
    unsigned sum, cnt, mine, sp = 0u;
    for (;;) {
        sum = 0u; cnt = 0u; mine = 0u;
#pragma unroll
        for (unsigned j = 0; j < 16; ++j) { const unsigned c = xb_ld(&bar[XB_XCNT(j)]); sum += c; cnt += (c > 0u) ? 1u : 0u; mine = (j == x) ? c : mine; }
        if (sum == G) break;
        __builtin_amdgcn_s_sleep(1);
        if ((++sp & 255u) == 0u) { if (xb_ld(&bar[XB_TMO])) break; if (sp > XB_SPIN_CAP) { atomicAdd(&bar[XB_TMO], 1u); break; } }
    }
    nloc = mine > 0u ? mine : 1u; nx = cnt > 0u ? cnt : 1u;
}

__device__ __forceinline__ void xcd_barrier(const XcdBarrier& b) {
    asm volatile("s_waitcnt vmcnt(0)" ::: "memory");
    __syncthreads();
    if (threadIdx.x == 0) {
        unsigned* bar = b.bar;
        __builtin_amdgcn_s_waitcnt(0);
        unsigned nloc = b.st[0], nx = b.st[1];
        if (nloc == 0u) { xcd_barrier_complete(bar, b.x, nloc, nx); b.st[0] = nloc; b.st[1] = nx; }
        const unsigned old = xb_add(&bar[XB_XSUB(b.x)], 1u);
        const unsigned gen = old / nloc;
        if (old + 1u == (gen + 1u) * nloc) {
            __builtin_amdgcn_fence(__ATOMIC_RELEASE, "agent");
            asm volatile("s_waitcnt vmcnt(0)" ::: "memory");
            const unsigned og = xb_add(&bar[XB_TOP], 1u);
            const unsigned tg = og / nx;
            if (og + 1u == (tg + 1u) * nx) xb_add(&bar[XB_TOPGEN], 1u);
            else XB_SPIN(xb_ld(&bar[XB_TOPGEN]) == tg, bar);
            __builtin_amdgcn_fence(__ATOMIC_ACQUIRE, "agent");
            xb_add(&bar[XB_XGEN(b.x)], 1u);
            asm volatile("s_waitcnt vmcnt(0)" ::: "memory");
        } else {
            XB_SPIN(xb_ld(&bar[XB_XGEN(b.x)]) == gen, bar);
            __builtin_amdgcn_fence(__ATOMIC_ACQUIRE, "agent");
            asm volatile("s_waitcnt vmcnt(0)" ::: "memory");
        }
    }
    __syncthreads();
}
struct Ctx {
    ldsp lds; int tid, lane, wave, bid, G, gw, NGW;
    const float* in[21]; float* out; unsigned char* ws;
};
#define LDS_WAIT() asm volatile("s_waitcnt lgkmcnt(0)" ::: "memory")
enum { I_X = 0, I_C, I_ADAW, I_ADAB, I_N1G, I_WIN, I_WA2, I_BA, I_GNG, I_VNG, I_MWS, I_MB, I_MOG, I_WOUT, I_N2G, I_WQ, I_K1, I_K2, I_PU, I_PV, I_FG };

DI void p0_ada(const Ctx& C) {
    LAS float* red = (LAS float*)C.lds;
    float* MOD = (float*)(C.ws + WS_MOD);
    for (int it = C.bid; it < 192; it += C.G) {
        const int l = it / 96, cg = it % 96, c0 = cg * 128 + C.lane * 2;
        const float* W = C.in[I_ADAW] + (size_t)l * D * MODW + (size_t)(C.wave * 256) * MODW + c0;
        float cv[4][4];
#pragma unroll
        for (int b = 0; b < 4; ++b)
#pragma unroll
            for (int i = 0; i < 4; ++i) cv[b][i] = silu_f(C.in[I_C][b * D + C.wave * 256 + i * 64 + C.lane]);
        float acc[4][2];
#pragma unroll
        for (int b = 0; b < 4; ++b) { acc[b][0] = 0.f; acc[b][1] = 0.f; }
#pragma unroll
        for (int i = 0; i < 4; ++i) {
#pragma unroll 8
            for (int j = 0; j < 64; ++j) {
                const f32x2 w = *(const f32x2*)(W + (size_t)(i * 64 + j) * MODW);
#pragma unroll
                for (int b = 0; b < 4; ++b) { const float s = __builtin_bit_cast(float, __builtin_amdgcn_readlane(__builtin_bit_cast(int, cv[b][i]), j)); acc[b][0] += s * w.x; acc[b][1] += s * w.y; }
            }
        }
#pragma unroll
        for (int b = 0; b < 4; ++b) *(LAS f32x2*)(red + (C.wave * 4 + b) * 128 + C.lane * 2) = (f32x2){acc[b][0], acc[b][1]};
        __syncthreads();
        { const int b = C.tid >> 7, col = C.tid & 127; float s = C.in[I_ADAB][l * MODW + cg * 128 + col];
#pragma unroll
          for (int w = 0; w < 8; ++w) s += red[(w * 4 + b) * 128 + col];
          MOD[(size_t)(l * 4 + b) * MODW + cg * 128 + col] = s; }
        __syncthreads();
    }
}
DI void transpose_item(const float* W, int ldw, int src_col0, int ncols, bf16* WT, int dst_row0, int k0, LAS float* scr, int lane) {
    const int cl = lane & 31;
#pragma unroll 8
    for (int i = 0; i < 32; ++i) { const int kk = 2 * i + (lane >> 5); float v = 0.f; if (cl < ncols) v = W[(size_t)(k0 + kk) * ldw + src_col0 + cl]; scr[kk * 33 + cl] = v; }
    LDS_WAIT();
    const int c = lane & 7;
#pragma unroll
    for (int j = 0; j < 4; ++j) { const int n = (lane >> 3) + 8 * j;
        if (n < ncols) { const LAS float* s = scr + (8 * c) * 33 + n;
            u32x4 o; o.x = pk2(s[0 * 33], s[1 * 33]); o.y = pk2(s[2 * 33], s[3 * 33]); o.z = pk2(s[4 * 33], s[5 * 33]); o.w = pk2(s[6 * 33], s[7 * 33]);
            *(u32x4*)(WT + (size_t)(dst_row0 + n) * 2048 + k0 + 8 * c) = o; } }
    LDS_WAIT();
}
DI void p0_prologue(const Ctx& C) {
    p0_ada(C);
    LAS float* scr = (LAS float*)(C.lds + C.wave * 16384);
    constexpr int PER_L = (161 + 64 + 64) * 32;
    for (int it = C.gw; it < 2 * PER_L; it += C.NGW) {
        const int l = it / PER_L; int r = it % PER_L;
        if (r < 161 * 32) { const int kb = r / 161, nb = r % 161; bf16* WT = (bf16*)(C.ws + WS_WTIN) + (size_t)l * WTIN_L;
            const float* W = C.in[I_WIN] + (size_t)l * D * IN_COLS;
            if (nb < 160) { const int n0 = 32 * nb; transpose_item(W, IN_COLS, n0 + (n0 >= 3072 ? 16 : 0), 32, WT, n0, 64 * kb, scr, C.lane); }
            else transpose_item(W, IN_COLS, 3072, 16, WT, 5120, 64 * kb, scr, C.lane);
            continue; }
        r -= 161 * 32;
        if (r < 2048) { const int kb = r / 64, nb = r % 64; transpose_item(C.in[I_WOUT] + (size_t)l * D * D, D, 32 * nb, 32, (bf16*)(C.ws + WS_WTOUT) + (size_t)l * D * D, 32 * nb, 64 * kb, scr, C.lane); continue; }
        r -= 2048;
        { const int kb = r / 64, nb = r % 64; transpose_item(C.in[I_WQ] + (size_t)l * D * D, D, 32 * nb, 32, (bf16*)(C.ws + WS_WTQ) + (size_t)l * D * D, 32 * nb, 64 * kb, scr, C.lane); }
    }
    const int gt = C.bid * NTHR + C.tid, NT = C.G * NTHR;
    { bf16* K1B = (bf16*)(C.ws + WS_K1B); bf16* K2B = (bf16*)(C.ws + WS_K2B); bf16* WSB = (bf16*)(C.ws + WS_WSB);
      for (int i = gt; i < 262144; i += NT) { K1B[i] = (bf16)f2bf(C.in[I_K1][i]); K2B[i] = (bf16)f2bf(C.in[I_K2][i]);
          const int s = i & 127, t = (i >> 7) & 127; WSB[i] = (s <= t) ? (bf16)f2bf(C.in[I_MWS][i]) : (bf16)0; } }
#pragma unroll 1
    for (int tb = 0; tb < 2; ++tb) {
        const f32x4* src = (const f32x4*)C.in[tb ? I_PV : I_PU]; u32x4* dst = (u32x4*)(C.ws + (tb ? WS_PVB : WS_PUB));
#pragma unroll 4
        for (int i = gt; i < 8388608; i += NT) { const f32x4 a = src[2 * (size_t)i], b = src[2 * (size_t)i + 1];
            u32x4 o; o.x = pk2(a.x, a.y); o.y = pk2(a.z, a.w); o.z = pk2(b.x, b.y); o.w = pk2(b.z, b.w); dst[i] = o; }
    }
}
DI void norm_phase(const Ctx& C, const float* X, const float* g, const float* modl, int sh_off, int sc_off, bf16* Hout) {
    const int r0 = C.gw * 8, b = r0 >> 12;
    const f32x4* shp = (const f32x4*)(modl + (size_t)b * MODW + sh_off); const f32x4* scp = (const f32x4*)(modl + (size_t)b * MODW + sc_off);
    f32x4 gm[8], shv[8];
#pragma unroll
    for (int j = 0; j < 8; ++j) { const int idx = 64 * j + C.lane; gm[j] = ((const f32x4*)g)[idx] * (scp[idx] + 1.0f); shv[j] = shp[idx]; }
#pragma unroll 1
    for (int i = 0; i < 8; ++i) {
        const f32x4* xr = (const f32x4*)(X + (size_t)(r0 + i) * D) + C.lane; f32x4 v[8]; float s = 0.f;
#pragma unroll
        for (int j = 0; j < 8; ++j) { v[j] = xr[64 * j]; s += (v[j].x * v[j].x + v[j].y * v[j].y) + (v[j].z * v[j].z + v[j].w * v[j].w); }
        const float rstd = frsq(wave_sum(s) * (1.f / D) + EPS);
        u32x2* o = (u32x2*)(Hout + (size_t)(r0 + i) * D) + C.lane;
#pragma unroll
        for (int j = 0; j < 8; ++j) { const f32x4 y = v[j] * rstd * gm[j] + shv[j]; u32x2 w; w.x = pk2(y.x, y.y); w.y = pk2(y.z, y.w); o[64 * j] = w; }
    }
}
DI void alow_phase(const Ctx& C, const bf16* Hb, const bf16* WtA, float* ALOW) {
    if (C.wave < 4) {
        const int task = C.bid * 4 + C.wave, r0 = task * 16, fr = C.lane & 15, fq = C.lane >> 4;
        const bf16* ap = Hb + (size_t)(r0 + fr) * D + 8 * fq; const bf16* bp = WtA + (size_t)fr * D + 8 * fq;
        f32x4 acc = (f32x4){0.f, 0.f, 0.f, 0.f};
#pragma unroll 8
        for (int ks = 0; ks < 64; ++ks) { const bf16x8 a = *(const bf16x8*)(ap + 32 * ks), b = *(const bf16x8*)(bp + 32 * ks); acc = mfma16(a, b, acc); }
#pragma unroll
        for (int r = 0; r < 4; ++r) ALOW[(size_t)(r0 + 4 * fq + r) * 16 + fr] = acc[r];
    }
}
DI void gla_gates(const Ctx& C, LAS float* al, LAS float* tot, const float* ALOW, const float* wa2, const float* ba, int t0, int h, float (&Gl)[16], float& off, float& gref, float& g63) {
    const int d = C.tid & 127, jg = C.tid >> 7;
    if (C.tid < 256) ((LAS f32x4*)al)[C.tid] = ((const f32x4*)(ALOW + (size_t)t0 * 16))[C.tid];
    float w2[16];
#pragma unroll
    for (int r = 0; r < 16; ++r) w2[r] = wa2[r * 512 + h * 128 + d];
    const float bav = ba[h * 128 + d];
    __syncthreads();
    float run = 0.f;
#pragma unroll
    for (int jj = 0; jj < 16; ++jj) {
        const LAS f32x4* ar = (const LAS f32x4*)(al + (jg * 16 + jj) * 16);
        const f32x4 a0 = ar[0], a1 = ar[1], a2 = ar[2], a3 = ar[3];
        float z = bav;
        z += a0.x * w2[0] + a0.y * w2[1] + a0.z * w2[2] + a0.w * w2[3];
        z += a1.x * w2[4] + a1.y * w2[5] + a1.z * w2[6] + a1.w * w2[7];
        z += a2.x * w2[8] + a2.y * w2[9] + a2.z * w2[10] + a2.w * w2[11];
        z += a3.x * w2[12] + a3.y * w2[13] + a3.z * w2[14] + a3.w * w2[15];
        const float ls = fminf(z, 0.f) - 0.6931471806f * flog2(1.f + fexp2(-1.442695041f * fabsf(z)));
        run += ls * (1.442695041f / 16.f);
        Gl[jj] = run;
    }
    tot[jg * 128 + d] = run;
    __syncthreads();
    const float t0_ = tot[d], t1_ = tot[128 + d], t2_ = tot[256 + d], t3_ = tot[384 + d];
    off = (jg > 0 ? t0_ : 0.f) + (jg > 1 ? t1_ : 0.f) + (jg > 2 ? t2_ : 0.f); gref = t0_ + t1_; g63 = (t0_ + t1_) + (t2_ + t3_);
}
constexpr int KST = 136, VST = 264, PST = 72;
DI void load_v_tile(const Ctx& C, const bf16* PROJ, int t0, int h, LAS bf16* VL) {
#pragma unroll
    for (int i = 0; i < 4; ++i) { const int c = C.tid + 512 * i, j = c >> 5, ec = c & 31;
        *(LAS u32x4*)(VL + j * VST + 8 * ec) = *(const u32x4*)(PROJ + (size_t)(t0 + j) * NPROJ + C_V + h * 256 + 8 * ec); }
}
DI void glaA_item(const Ctx& C, int l, int idx, const bf16* PROJ, const float* ALOW, bf16* SBUF, float* DEC) {
    const int b = idx >> 8, h = (idx >> 6) & 3, n = idx & 63, t0 = b * SEQ + n * 64;
    LAS float* al = (LAS float*)(C.lds); LAS float* tot = (LAS float*)(C.lds + 4096);
    LAS bf16* KD = (LAS bf16*)(C.lds + 8192); LAS bf16* VL = (LAS bf16*)(C.lds + 25600);
    float Gl[16], off, gref, g63;
    gla_gates(C, al, tot, ALOW, C.in[I_WA2] + (size_t)l * 16 * 512, C.in[I_BA] + (size_t)l * 512, t0, h, Gl, off, gref, g63);
    const int d = C.tid & 127, jg = C.tid >> 7;
#pragma unroll
    for (int jj = 0; jj < 16; ++jj) { const int j = jg * 16 + jj; const float kv = bf1(PROJ[(size_t)(t0 + j) * NPROJ + C_K + h * 128 + d]);
        KD[j * KST + d] = (bf16)f2bf(kv * fexp2(g63 - (off + Gl[jj]))); }
    if (jg == 0) DEC[(size_t)idx * 128 + d] = fexp2(g63);
    load_v_tile(C, PROJ, t0, h, VL);
    __syncthreads();
    const int lane = C.lane, g = lane >> 4, qq = (lane & 15) >> 2, p = lane & 3, fr = lane & 15;
    bf16x8 A[2];
#pragma unroll
    for (int ks = 0; ks < 2; ++ks) A[ks] = tr8(KD + (32 * ks + 8 * g + qq) * KST + 16 * C.wave + 4 * p, KST);
    bf16* Sit = SBUF + (size_t)idx * 256 * 128;
#pragma unroll
    for (int half = 0; half < 2; ++half) {
        f32x4 acc[8];
#pragma unroll
        for (int nt = 0; nt < 8; ++nt) acc[nt] = (f32x4){0.f, 0.f, 0.f, 0.f};
#pragma unroll
        for (int nt = 0; nt < 8; ++nt)
#pragma unroll
            for (int ks = 0; ks < 2; ++ks) { const bf16x8 Bf = tr8(VL + (32 * ks + 8 * g + qq) * VST + 16 * (half * 8 + nt) + 4 * p, VST); acc[nt] = mfma16(A[ks], Bf, acc[nt]); }
#pragma unroll
        for (int nt = 0; nt < 8; ++nt) { const int e = 16 * (half * 8 + nt) + fr, dd = 16 * C.wave + 4 * g;
            u32x2 w; w.x = pk2(acc[nt][0], acc[nt][1]); w.y = pk2(acc[nt][2], acc[nt][3]); *(u32x2*)(Sit + (size_t)e * 128 + dd) = w; }
    }
    __syncthreads();
}
DI void scan_phase(const Ctx& C, bf16* SBUF, const float* DEC) {
    const int gt = C.bid * NTHR + C.tid, bh = gt >> 13, rem = gt & 8191, e = rem >> 5, dq = rem & 31;
    u32x2* p = (u32x2*)(SBUF + ((size_t)(bh * 64) * 256 + e) * 128 + 4 * dq);
    const f32x4* dp = (const f32x4*)(DEC + (size_t)(bh * 64) * 128 + 4 * dq);
    f32x4 st = (f32x4){0.f, 0.f, 0.f, 0.f};
#pragma unroll 1
    for (int n0 = 0; n0 < 64; n0 += 8) {
        u32x2 tmp[8]; f32x4 dc[8];
#pragma unroll
        for (int u = 0; u < 8; ++u) { tmp[u] = p[(size_t)(n0 + u) * 8192]; dc[u] = dp[(n0 + u) * 32]; }
#pragma unroll
        for (int u = 0; u < 8; ++u) { u32x2 w; w.x = pk2(st.x, st.y); w.y = pk2(st.z, st.w); p[(size_t)(n0 + u) * 8192] = w;
            st = dc[u] * st + (f32x4){bflo(tmp[u].x), bfhi(tmp[u].x), bflo(tmp[u].y), bfhi(tmp[u].y)}; }
    }
}
DI void glaC_item(const Ctx& C, int l, int idx, const bf16* PROJ, const float* ALOW, const bf16* SBUF, bf16* CONCAT) {
    const int b = idx >> 8, h = (idx >> 6) & 3, n = idx & 63, t0 = b * SEQ + n * 64;
    LAS float* al = (LAS float*)(C.lds); LAS float* tot = (LAS float*)(C.lds + 4096); LAS float* RS = (LAS float*)(C.lds + 6144);
    LAS bf16* QT = (LAS bf16*)(C.lds + 8192); LAS bf16* KT = (LAS bf16*)(C.lds + 25600); LAS bf16* QG = (LAS bf16*)(C.lds + 43008);
    LAS bf16* VL = (LAS bf16*)(C.lds + 60416); LAS bf16* PL = (LAS bf16*)(C.lds + 94208);
    float Gl[16], off, gref, g63;
    gla_gates(C, al, tot, ALOW, C.in[I_WA2] + (size_t)l * 16 * 512, C.in[I_BA] + (size_t)l * 512, t0, h, Gl, off, gref, g63);
    const int d = C.tid & 127, jg = C.tid >> 7;
#pragma unroll
    for (int jj = 0; jj < 16; ++jj) { const int j = jg * 16 + jj; const float Gv = off + Gl[jj];
        const bf16* row = PROJ + (size_t)(t0 + j) * NPROJ + h * 128 + d;
        const float q = bf1(row[C_Q]) * 0.08838834764831845f, k = bf1(row[C_K]);
        QT[j * KST + d] = (bf16)f2bf(q * fexp2(Gv - gref)); KT[j * KST + d] = (bf16)f2bf(k * fexp2(gref - Gv)); QG[j * KST + d] = (bf16)f2bf(q * fexp2(Gv)); }
    load_v_tile(C, PROJ, t0, h, VL);
    __syncthreads();
    const int lane = C.lane, g = lane >> 4, qq = (lane & 15) >> 2, p = lane & 3, fr = lane & 15;
    {
        const int nt = C.wave & 3;
#pragma unroll
        for (int mi = 0; mi < 2; ++mi) { const int mt = 2 * (C.wave >> 2) + mi; f32x4 acc = (f32x4){0.f, 0.f, 0.f, 0.f};
#pragma unroll
            for (int ks = 0; ks < 4; ++ks) { const bf16x8 a = *(const LAS bf16x8*)(KT + (16 * mt + fr) * KST + 32 * ks + 8 * g), bq = *(const LAS bf16x8*)(QT + (16 * nt + fr) * KST + 32 * ks + 8 * g); acc = mfma16(a, bq, acc); }
            const int i = 16 * nt + fr, j0 = 16 * mt + 4 * g;
            const float v0 = (j0 + 0 <= i) ? acc[0] : 0.f, v1 = (j0 + 1 <= i) ? acc[1] : 0.f, v2 = (j0 + 2 <= i) ? acc[2] : 0.f, v3 = (j0 + 3 <= i) ? acc[3] : 0.f;
            u32x2 w; w.x = pk2(v0, v1); w.y = pk2(v2, v3); *(LAS u32x2*)(PL + i * PST + j0) = w; }
    }
    __syncthreads();
    f32x4 acc[2][4];
#pragma unroll
    for (int mi = 0; mi < 2; ++mi)
#pragma unroll
        for (int nt = 0; nt < 4; ++nt) acc[mi][nt] = (f32x4){0.f, 0.f, 0.f, 0.f};
#pragma unroll
    for (int mi = 0; mi < 2; ++mi) { const int mt = 2 * C.wave + mi;
#pragma unroll
        for (int ks = 0; ks < 2; ++ks) { const bf16x8 a = tr8(VL + (32 * ks + 8 * g + qq) * VST + 16 * mt + 4 * p, VST);
#pragma unroll
            for (int nt = 0; nt < 4; ++nt) { const bf16x8 bp = *(const LAS bf16x8*)(PL + (16 * nt + fr) * PST + 32 * ks + 8 * g); acc[mi][nt] = mfma16(a, bp, acc[mi][nt]); } }
        const bf16* Srow = SBUF + ((size_t)idx * 256 + 16 * mt + fr) * 128 + 8 * g;
#pragma unroll
        for (int ks = 0; ks < 4; ++ks) { const bf16x8 a = *(const bf16x8*)(Srow + 32 * ks);
#pragma unroll
            for (int nt = 0; nt < 4; ++nt) { const bf16x8 bq = *(const LAS bf16x8*)(QG + (16 * nt + fr) * KST + 32 * ks + 8 * g); acc[mi][nt] = mfma16(a, bq, acc[mi][nt]); } }
    }
#pragma unroll
    for (int nt = 0; nt < 4; ++nt) { float s = 0.f;
#pragma unroll
        for (int mi = 0; mi < 2; ++mi) s += (acc[mi][nt][0] * acc[mi][nt][0] + acc[mi][nt][1] * acc[mi][nt][1]) + (acc[mi][nt][2] * acc[mi][nt][2] + acc[mi][nt][3] * acc[mi][nt][3]);
        s += __shfl_xor(s, 16); s += __shfl_xor(s, 32);
        if (g == 0) RS[C.wave * 64 + 16 * nt + fr] = s; }
    __syncthreads();
    const float* ng = C.in[I_GNG] + (size_t)(l * 4 + h) * 256;
#pragma unroll
    for (int nt = 0; nt < 4; ++nt) { const int i = 16 * nt + fr; float ts = 0.f;
#pragma unroll
        for (int w = 0; w < 8; ++w) ts += RS[w * 64 + i];
        const float rstd = frsq(ts * (1.f / 256.f) + EPS);
#pragma unroll
        for (int mi = 0; mi < 2; ++mi) { const int e = 16 * (2 * C.wave + mi) + 4 * g;
            const u32x2 rr = *(const u32x2*)(PROJ + (size_t)(t0 + i) * NPROJ + C_R + h * 256 + e); const f32x4 gg = *(const f32x4*)(ng + e);
            const float o0 = acc[mi][nt][0] * rstd * gg.x * silu_f(bflo(rr.x)), o1 = acc[mi][nt][1] * rstd * gg.y * silu_f(bfhi(rr.x));
            const float o2 = acc[mi][nt][2] * rstd * gg.z * silu_f(bflo(rr.y)), o3 = acc[mi][nt][3] * rstd * gg.w * silu_f(bfhi(rr.y));
            u32x2 w; w.x = pk2(o0, o1); w.y = pk2(o2, o3); *(u32x2*)(CONCAT + (size_t)(t0 + i) * D + h * 256 + e) = w; } }
    __syncthreads();
}
constexpr int GST = 136;
DI void gmlp_item(const Ctx& C, int l, int idx, const bf16* PROJ, const bf16* WSB, bf16* CONCAT) {
    const int h = idx & 7, n = (idx >> 3) & 31, b = idx >> 8, t0 = b * SEQ + n * 128;
    LAS bf16* VL2 = (LAS bf16*)(C.lds); LAS bf16* UL = (LAS bf16*)(C.lds + 34816);
    const float* vg = C.in[I_VNG] + (size_t)(l * 8 + h) * 128; const float* og = C.in[I_MOG] + (size_t)(l * 8 + h) * 128; const float* bb = C.in[I_MB] + (size_t)(l * 8 + h) * 128;
#pragma unroll
    for (int i = 0; i < 4; ++i) { const int c = C.tid + 512 * i, t = c >> 4, ch = c & 15;
        const bf16* row = PROJ + (size_t)(t0 + t) * NPROJ + h * 128 + 8 * ch;
        const u32x4 uu = *(const u32x4*)(row + C_U), vv = *(const u32x4*)(row + C_VS);
        float v[8] = {gelu_t(bflo(vv.x)), gelu_t(bfhi(vv.x)), gelu_t(bflo(vv.y)), gelu_t(bfhi(vv.y)), gelu_t(bflo(vv.z)), gelu_t(bfhi(vv.z)), gelu_t(bflo(vv.w)), gelu_t(bfhi(vv.w))};
        float ss = 0.f;
#pragma unroll
        for (int k = 0; k < 8; ++k) ss += v[k] * v[k];
        ss += __shfl_xor(ss, 1); ss += __shfl_xor(ss, 2); ss += __shfl_xor(ss, 4); ss += __shfl_xor(ss, 8);
        const float rstd = frsq(ss * (1.f / 128.f) + EPS);
        const f32x4 g0 = *(const f32x4*)(vg + 8 * ch), g1 = *(const f32x4*)(vg + 8 * ch + 4);
        u32x4 wv; wv.x = pk2(v[0] * rstd * g0.x, v[1] * rstd * g0.y); wv.y = pk2(v[2] * rstd * g0.z, v[3] * rstd * g0.w); wv.z = pk2(v[4] * rstd * g1.x, v[5] * rstd * g1.y); wv.w = pk2(v[6] * rstd * g1.z, v[7] * rstd * g1.w);
        *(LAS u32x4*)(VL2 + t * GST + 8 * ch) = wv;
        u32x4 wu; wu.x = pk2(gelu_t(bflo(uu.x)), gelu_t(bfhi(uu.x))); wu.y = pk2(gelu_t(bflo(uu.y)), gelu_t(bfhi(uu.y))); wu.z = pk2(gelu_t(bflo(uu.z)), gelu_t(bfhi(uu.z))); wu.w = pk2(gelu_t(bflo(uu.w)), gelu_t(bfhi(uu.w)));
        *(LAS u32x4*)(UL + t * GST + 8 * ch) = wu; }
    __syncthreads();
    const int lane = C.lane, g = lane >> 4, qq = (lane & 15) >> 2, p = lane & 3, fr = lane & 15;
    f32x4 acc[8];
#pragma unroll
    for (int mt = 0; mt < 8; ++mt) acc[mt] = (f32x4){0.f, 0.f, 0.f, 0.f};
    const int nks = (C.wave >> 1) + 1;
    const bf16* Wrow = WSB + ((size_t)(l * 8 + h) * 128 + 16 * C.wave + fr) * 128 + 8 * g;
#pragma unroll 1
    for (int ks = 0; ks < nks; ++ks) { const bf16x8 bw = *(const bf16x8*)(Wrow + 32 * ks);
#pragma unroll
        for (int mt = 0; mt < 8; ++mt) { const bf16x8 a = tr8(VL2 + (32 * ks + 8 * g + qq) * GST + 16 * mt + 4 * p, GST); acc[mt] = mfma16(a, bw, acc[mt]); } }
    const int tl = 16 * C.wave + fr; const float bt = bb[tl]; float ss = 0.f;
#pragma unroll
    for (int mt = 0; mt < 8; ++mt) { const u32x2 uu = *(const LAS u32x2*)(UL + tl * GST + 16 * mt + 4 * g);
        acc[mt][0] = bflo(uu.x) * (acc[mt][0] + bt); acc[mt][1] = bfhi(uu.x) * (acc[mt][1] + bt); acc[mt][2] = bflo(uu.y) * (acc[mt][2] + bt); acc[mt][3] = bfhi(uu.y) * (acc[mt][3] + bt);
        ss += (acc[mt][0] * acc[mt][0] + acc[mt][1] * acc[mt][1]) + (acc[mt][2] * acc[mt][2] + acc[mt][3] * acc[mt][3]); }
    ss += __shfl_xor(ss, 16); ss += __shfl_xor(ss, 32);
    const float rstd = frsq(ss * (1.f / 128.f) + EPS);
#pragma unroll
    for (int mt = 0; mt < 8; ++mt) { const f32x4 gg = *(const f32x4*)(og + 16 * mt + 4 * g);
        u32x2 w; w.x = pk2(acc[mt][0] * rstd * gg.x, acc[mt][1] * rstd * gg.y); w.y = pk2(acc[mt][2] * rstd * gg.z, acc[mt][3] * rstd * gg.w);
        *(u32x2*)(CONCAT + (size_t)(t0 + tl) * D + 1024 + h * 128 + 16 * mt + 4 * g) = w; }
    __syncthreads();
}
DI void list_insert(float (&L)[16], float x) {
#pragma unroll
    for (int i = 15; i >= 1; --i) L[i] = __builtin_amdgcn_fmed3f(x, L[i - 1], L[i]);
    L[0] = fmaxf(L[0], x);
}
DI void list_merge_xor(float (&L)[16], int mask) {
    float M[16];
#pragma unroll
    for (int i = 0; i < 16; ++i) M[i] = fmaxf(L[i], __shfl_xor(L[15 - i], mask));
#pragma unroll
    for (int s = 8; s >= 1; s >>= 1)
#pragma unroll
        for (int i = 0; i < 16; ++i) if ((i & s) == 0) { const float hi = fmaxf(M[i], M[i + s]), lo = fminf(M[i], M[i + s]); M[i] = hi; M[i + s] = lo; }
#pragma unroll
    for (int i = 0; i < 16; ++i) L[i] = M[i];
}
DI unsigned fbits(float x) { return __builtin_bit_cast(unsigned, x); }
DI float unp7(float x) { return __builtin_bit_cast(float, __builtin_bit_cast(unsigned, x) & 0xFFFFFF80u); }
DI void topk_phase(const Ctx& C, int l, const bf16* QB, const bf16* K1B, const bf16* K2B, int* EB, float* PG) {
    LAS unsigned* tk = (LAS unsigned*)(C.lds + C.wave * 4096);
    const int lane = C.lane, fr = lane & 15, fq = lane >> 4;
#pragma unroll 1
    for (int wi = C.gw; wi < 8192; wi += C.NGW) {
        const int h = wi & 7, tt0 = (wi >> 3) * 16;
        float L[2][16];
#pragma unroll
        for (int half = 0; half < 2; ++half) {
            f32x4 acc[8];
#pragma unroll
            for (int mt = 0; mt < 8; ++mt) acc[mt] = (f32x4){0.f, 0.f, 0.f, 0.f};
            const bf16* Kb = (half ? K2B : K1B) + ((size_t)(l * 8 + h) * 128 + fr) * 128 + 8 * fq;
            const bf16* Qp = QB + (size_t)(tt0 + fr) * D + h * 256 + half * 128 + 8 * fq;
#pragma unroll
            for (int ks = 0; ks < 4; ++ks) {
                const bf16x8 b0 = *(const bf16x8*)(Qp + 32 * ks);
#pragma unroll
                for (int mt = 0; mt < 8; ++mt) { const bf16x8 a = *(const bf16x8*)(Kb + (size_t)(16 * mt) * 128 + 32 * ks); acc[mt] = mfma16(a, b0, acc[mt]); }
            }
#pragma unroll
            for (int i = 0; i < 16; ++i) L[half][i] = __builtin_bit_cast(float, 0xFF800000u);
#pragma unroll
            for (int mt = 0; mt < 8; ++mt)
#pragma unroll
                for (int r = 0; r < 4; ++r) { const unsigned key = (unsigned)(16 * mt + 4 * fq + r);
                    const float sv = acc[mt][r];
                    list_insert(L[half], __builtin_bit_cast(float, (fbits(sv) & 0xFFFFFF80u) | key)); }
            list_merge_xor(L[half], 16); list_merge_xor(L[half], 32);
        }
        if (fq == 0) {
#pragma unroll
            for (int i = 0; i < 16; ++i) { tk[(fr * 2 + 0) * 16 + i] = fbits(L[0][i]); tk[(fr * 2 + 1) * 16 + i] = fbits(L[1][i]); }
        }
        float Cn[16];
#pragma unroll
        for (int i = 0; i < 16; ++i) Cn[i] = __builtin_bit_cast(float, 0xFF800000u);
#pragma unroll
        for (int i = 0; i < 16; ++i)
#pragma unroll
            for (int j = 0; j < 16; ++j) if ((i + 1) * (j + 1) <= 16) {
                const float s = unp7(L[0][i]) + unp7(L[1][j]);
                list_insert(Cn, __builtin_bit_cast(float, (fbits(s) & 0xFFFFFF00u) | (unsigned)(i * 16 + j))); }
        LDS_WAIT();
        float sc[4]; int ex[4];
#pragma unroll
        for (int m = 0; m < 4; ++m) {
            const float ck = fq == 0 ? Cn[m] : (fq == 1 ? Cn[4 + m] : (fq == 2 ? Cn[8 + m] : Cn[12 + m]));
            const unsigned cc = fbits(ck) & 255u;
            const unsigned p1 = tk[(fr * 2 + 0) * 16 + (cc >> 4)], p2 = tk[(fr * 2 + 1) * 16 + (cc & 15u)];
            sc[m] = __builtin_bit_cast(float, p1 & 0xFFFFFF80u) + __builtin_bit_cast(float, p2 & 0xFFFFFF80u);
            ex[m] = (int)((p1 & 127u) * 128u + (p2 & 127u));
        }
        float mx = fmaxf(fmaxf(sc[0], sc[1]), fmaxf(sc[2], sc[3]));
        mx = fmaxf(mx, __shfl_xor(mx, 16)); mx = fmaxf(mx, __shfl_xor(mx, 32));
        float w[4], sum = 0.f;
#pragma unroll
        for (int m = 0; m < 4; ++m) { w[m] = fexp2((sc[m] - mx) * 1.442695041f); sum += w[m]; }
        sum += __shfl_xor(sum, 16); sum += __shfl_xor(sum, 32);
        const float inv = 1.0f / sum;
        const size_t o = (size_t)(tt0 + fr) * 128 + h * 16 + 4 * fq;
        *(int4*)(EB + o) = make_int4(ex[0], ex[1], ex[2], ex[3]);
        *(f32x4*)(PG + o) = (f32x4){w[0] * inv, w[1] * inv, w[2] * inv, w[3] * inv};
        LDS_WAIT();
    }
}
constexpr int PEER_R = 2;
template <bool LAST>
DI void peer_phase(const Ctx& C, int l, const bf16* Hb, const int* EB, const float* PG, const bf16* PU, const bf16* PV, float* X, const float* gate  ,
                   const float* ng, const float* modn  , bf16* Hout) {
    const int lane = C.lane;
#pragma unroll 1
    for (int ti = 0; ti < 8; ++ti) {
        const int m = C.gw * 8 + ti, b = m >> 12;
        u32x4 hp[4];
#pragma unroll
        for (int c = 0; c < 4; ++c) hp[c] = ((const u32x4*)(Hb + (size_t)m * D))[c * 64 + lane];
        const int e_lo = EB[(size_t)m * 128 + lane], e_hi = EB[(size_t)m * 128 + 64 + lane];
        const float g_lo = PG[(size_t)m * 128 + lane], g_hi = PG[(size_t)m * 128 + 64 + lane];
        float acc[4][8];
#pragma unroll
        for (int c = 0; c < 4; ++c)
#pragma unroll
            for (int i = 0; i < 8; ++i) acc[c][i] = 0.f;
#pragma unroll 1
        for (int k0 = 0; k0 < 128; k0 += PEER_R) {
            u32x4 ur[PEER_R][4], vr[PEER_R][4]; float gk[PEER_R];
#pragma unroll
            for (int r = 0; r < PEER_R; ++r) { const int k = k0 + r;
                const int ek = __builtin_amdgcn_readlane(k0 < 64 ? e_lo : e_hi, k & 63);
                gk[r] = __builtin_bit_cast(float, __builtin_amdgcn_readlane(__builtin_bit_cast(int, k0 < 64 ? g_lo : g_hi), k & 63));
                const u32x4* up = (const u32x4*)(PU + (size_t)ek * D) + lane; const u32x4* vp = (const u32x4*)(PV + (size_t)ek * D) + lane;
#pragma unroll
                for (int c = 0; c < 4; ++c) { ur[r][c] = up[c * 64]; vr[r][c] = vp[c * 64]; } }
#pragma unroll
            for (int r = 0; r < PEER_R; ++r) { float p = 0.f;
#pragma unroll
                for (int c = 0; c < 4; ++c) { p = dot2bf(ur[r][c].x, hp[c].x, p); p = dot2bf(ur[r][c].y, hp[c].y, p); p = dot2bf(ur[r][c].z, hp[c].z, p); p = dot2bf(ur[r][c].w, hp[c].w, p); }
#ifdef DBG_NO_PEER
                const float a = 0.f * gelu_t(wave_sum(p)) * gk[r];
#else
                const float a = gelu_t(wave_sum(p)) * gk[r];
#endif
#pragma unroll
                for (int c = 0; c < 4; ++c) {
                    acc[c][0] += a * bflo(vr[r][c].x); acc[c][1] += a * bfhi(vr[r][c].x); acc[c][2] += a * bflo(vr[r][c].y); acc[c][3] += a * bfhi(vr[r][c].y);
                    acc[c][4] += a * bflo(vr[r][c].z); acc[c][5] += a * bfhi(vr[r][c].z); acc[c][6] += a * bflo(vr[r][c].w); acc[c][7] += a * bfhi(vr[r][c].w); } }
        }
        float* xr = X + (size_t)m * D; const float* gp = gate + (size_t)b * MODW; float ss = 0.f;
#pragma unroll
        for (int c = 0; c < 4; ++c) { const int e0 = c * 512 + lane * 8;
            const f32x4 x0 = *(const f32x4*)(xr + e0), x1 = *(const f32x4*)(xr + e0 + 4), t0 = *(const f32x4*)(gp + e0), t1 = *(const f32x4*)(gp + e0 + 4);
            acc[c][0] = x0.x + t0.x * acc[c][0]; acc[c][1] = x0.y + t0.y * acc[c][1]; acc[c][2] = x0.z + t0.z * acc[c][2]; acc[c][3] = x0.w + t0.w * acc[c][3];
            acc[c][4] = x1.x + t1.x * acc[c][4]; acc[c][5] = x1.y + t1.y * acc[c][5]; acc[c][6] = x1.z + t1.z * acc[c][6]; acc[c][7] = x1.w + t1.w * acc[c][7];
#pragma unroll
            for (int i = 0; i < 8; ++i) ss += acc[c][i] * acc[c][i]; }
        const float rstd = frsq(wave_sum(ss) * (1.f / D) + EPS);
#pragma unroll
        for (int c = 0; c < 4; ++c) { const int e0 = c * 512 + lane * 8;
            const f32x4 g0 = *(const f32x4*)(ng + e0), g1 = *(const f32x4*)(ng + e0 + 4);
            if (LAST) {
                *(f32x4*)(xr + e0) = (f32x4){acc[c][0] * rstd * g0.x, acc[c][1] * rstd * g0.y, acc[c][2] * rstd * g0.z, acc[c][3] * rstd * g0.w};
                *(f32x4*)(xr + e0 + 4) = (f32x4){acc[c][4] * rstd * g1.x, acc[c][5] * rstd * g1.y, acc[c][6] * rstd * g1.z, acc[c][7] * rstd * g1.w};
            } else {
                *(f32x4*)(xr + e0) = (f32x4){acc[c][0], acc[c][1], acc[c][2], acc[c][3]};
                *(f32x4*)(xr + e0 + 4) = (f32x4){acc[c][4], acc[c][5], acc[c][6], acc[c][7]};
                const float* sh = modn + (size_t)b * MODW; const float* sc = sh + D;
                const f32x4 s0 = *(const f32x4*)(sc + e0), s1 = *(const f32x4*)(sc + e0 + 4), h0 = *(const f32x4*)(sh + e0), h1 = *(const f32x4*)(sh + e0 + 4);
                u32x4 w;
                w.x = pk2(acc[c][0] * rstd * g0.x * (1.f + s0.x) + h0.x, acc[c][1] * rstd * g0.y * (1.f + s0.y) + h0.y);
                w.y = pk2(acc[c][2] * rstd * g0.z * (1.f + s0.z) + h0.z, acc[c][3] * rstd * g0.w * (1.f + s0.w) + h0.w);
                w.z = pk2(acc[c][4] * rstd * g1.x * (1.f + s1.x) + h1.x, acc[c][5] * rstd * g1.y * (1.f + s1.y) + h1.y);
                w.w = pk2(acc[c][6] * rstd * g1.z * (1.f + s1.z) + h1.z, acc[c][7] * rstd * g1.w * (1.f + s1.w) + h1.w);
                ((u32x4*)(Hout + (size_t)m * D))[c * 64 + lane] = w;
            } }
    }
}
DI void topk_simple(const Ctx& C, int l, const bf16* QB, const bf16* K1B, const bf16* K2B, int* EB, float* PG) {
    LAS float* vs = (LAS float*)(C.lds + C.wave * 4096);
    LAS int* is = (LAS int*)(C.lds + C.wave * 4096 + 256);
    const int lane = C.lane; const float NEGINF = __builtin_bit_cast(float, 0xFF800000u);
#pragma unroll 1
    for (int task = C.gw; task < T * 8; task += C.NGW) {
        const int t = task >> 3, h = task & 7;
        float s[2][2];
#pragma unroll
        for (int half = 0; half < 2; ++half)
#pragma unroll
            for (int kk = 0; kk < 2; ++kk) {
                const bf16* kr = (half ? K2B : K1B) + ((size_t)(l * 8 + h) * 128 + lane + 64 * kk) * 128; const bf16* qr = QB + (size_t)t * D + h * 256 + half * 128;
                float a = 0.f;
#pragma unroll 4
                for (int d = 0; d < 128; d += 8) { const u32x4 kv = *(const u32x4*)(kr + d), qv = *(const u32x4*)(qr + d);
                    a += bflo(kv.x) * bflo(qv.x) + bfhi(kv.x) * bfhi(qv.x) + bflo(kv.y) * bflo(qv.y) + bfhi(kv.y) * bfhi(qv.y) + bflo(kv.z) * bflo(qv.z) + bfhi(kv.z) * bfhi(qv.z) + bflo(kv.w) * bflo(qv.w) + bfhi(kv.w) * bfhi(qv.w); }
                s[half][kk] = a; }
#pragma unroll
        for (int half = 0; half < 2; ++half) { float a0 = s[half][0], a1 = s[half][1];
#pragma unroll 1
            for (int r = 0; r < 16; ++r) {
                float m = a0 >= a1 ? a0 : a1; int id = a0 >= a1 ? lane : lane + 64;
#pragma unroll
                for (int o = 1; o < 64; o <<= 1) { const float om = __shfl_xor(m, o); const int oid = __shfl_xor(id, o); if (om > m || (om == m && oid < id)) { m = om; id = oid; } }
                if (lane == 0) { vs[half * 16 + r] = m; is[half * 16 + r] = id; }
                if (id == lane) a0 = NEGINF; if (id == lane + 64) a1 = NEGINF; } }
        LDS_WAIT();
        float cv[4];
#pragma unroll
        for (int tt = 0; tt < 4; ++tt) { const int c = lane * 4 + tt; cv[tt] = vs[c >> 4] + vs[16 + (c & 15)]; }
        float mysc = 0.f; int mye = 0;
#pragma unroll 1
        for (int r = 0; r < 16; ++r) {
            float m = cv[0]; int id = lane * 4;
#pragma unroll
            for (int tt = 1; tt < 4; ++tt) if (cv[tt] > m) { m = cv[tt]; id = lane * 4 + tt; }
#pragma unroll
            for (int o = 1; o < 64; o <<= 1) { const float om = __shfl_xor(m, o); const int oid = __shfl_xor(id, o); if (om > m || (om == m && oid < id)) { m = om; id = oid; } }
            if (lane == r) { mysc = m; mye = is[id >> 4] * 128 + is[16 + (id & 15)]; }
#pragma unroll
            for (int tt = 0; tt < 4; ++tt) if (id == lane * 4 + tt) cv[tt] = NEGINF;
        }
        float mx = lane < 16 ? mysc : NEGINF;
#pragma unroll
        for (int o = 1; o < 64; o <<= 1) mx = fmaxf(mx, __shfl_xor(mx, o));
        float w = lane < 16 ? fexp2((mysc - mx) * 1.442695041f) : 0.f; float sum = w;
#pragma unroll
        for (int o = 1; o < 64; o <<= 1) sum += __shfl_xor(sum, o);
        if (lane < 16) { EB[(size_t)t * 128 + h * 16 + lane] = mye; PG[(size_t)t * 128 + h * 16 + lane] = w / sum; }
        LDS_WAIT();
    }
}
constexpr int NPH = 20;
struct Args { const float* in[21]; float* out; unsigned char* ws; int ph_lo, ph_hi, pad0, pad1; };
__global__ void __launch_bounds__(NTHR, 2) mk_fwd(Args args) {
    extern __shared__ __attribute__((aligned(16))) unsigned char lds_raw[];
    ldsp ldsb = (ldsp)lds_raw;
    volatile LAS unsigned* MISC = (volatile LAS unsigned*)(ldsb + MISC_OFF);
    for (int u = threadIdx.x; u < (LDS_BYTES - LDSCTL_OFF) / 4; u += NTHR) ((LAS unsigned*)(ldsb + LDSCTL_OFF))[u] = 0u;
    __syncthreads();
    unsigned* barw = (unsigned*)(args.ws + WS_CTL) + CW_BAR;
    XcdBarrier bar; bar.bar = barw; bar.x = 0; bar.st = nullptr;
    const bool multi = (args.ph_hi - args.ph_lo) > 1;
    if (multi) bar = xcd_barrier_post(barw, MISC + 8);

#pragma unroll 1
    for (int ph = args.ph_lo; ph < args.ph_hi; ++ph) {
        int tid_ = threadIdx.x, bid_ = blockIdx.x; asm volatile("" : "+v"(tid_)); asm volatile("" : "+s"(bid_));
        Ctx C;
        C.lds = ldsb; C.tid = tid_; C.lane = tid_ & 63; C.wave = __builtin_amdgcn_readfirstlane(tid_ >> 6);
        C.bid = bid_; C.G = gridDim.x; C.gw = C.bid * NWAVES + C.wave; C.NGW = C.G * NWAVES;
#pragma unroll
        for (int i = 0; i < 21; ++i) C.in[i] = args.in[i];
        C.out = args.out; C.ws = args.ws;
        float* MOD = (float*)(C.ws + WS_MOD);
        bf16* Hb = (bf16*)(C.ws + WS_H); bf16* PROJ = (bf16*)(C.ws + WS_PROJ); bf16* SBUF = (bf16*)(C.ws + WS_SBUF); bf16* CONCAT = (bf16*)(C.ws + WS_CONCAT); bf16* QB = (bf16*)(C.ws + WS_QB);
        float* ALOW = (float*)(C.ws + WS_ALOW); float* DEC = (float*)(C.ws + WS_DEC); int* EB = (int*)(C.ws + WS_EB); float* PG = (float*)(C.ws + WS_PG);
        float* X = C.out;
        const int l = ph < 2 ? 0 : (ph - 2) / 9, kind = ph < 2 ? -1 : (ph - 2) % 9;
        const float* modl = MOD + (size_t)l * 4 * MODW;
        if (ph == 0) p0_prologue(C);
        else if (ph == 1) norm_phase(C, C.in[I_X], C.in[I_N1G], modl, 0, D, Hb);
        else if (kind == 0 || kind == 6) {
            const bool isq = (kind == 6);
            pg8::Gemm g{Hb, isq ? (const bf16*)(C.ws + WS_WTQ) + (size_t)l * D * D : (const bf16*)(C.ws + WS_WTIN) + (size_t)l * WTIN_L, T, isq ? D : NPROJ, D};
            pg8::StaticOrder S; S.init(T, g.N, C.G, C.bid);
            pg8::EpiBf16 E{isq ? QB : PROJ, isq ? D : NPROJ};
            pg8::gemm_phase<pg8::EpiBf16, pg8::StaticOrder>(C.lds, g, S, E);
            if (!isq) alow_phase(C, Hb, (const bf16*)(C.ws + WS_WTIN) + (size_t)l * WTIN_L + (size_t)NPROJ * D, ALOW);
        }
        else if (kind == 1) {
#pragma unroll 1
            for (int i = 0; i < 8; ++i) { const int idx = (i >> 1) * C.G + C.bid;
                if (idx < 1024) { if (i & 1) gmlp_item(C, l, idx, PROJ, (const bf16*)(C.ws + WS_WSB), CONCAT); else glaA_item(C, l, idx, PROJ, ALOW, SBUF, DEC); } }
        }
        else if (kind == 2) scan_phase(C, SBUF, DEC);
        else if (kind == 3) {
#pragma unroll 1
            for (int idx = C.bid; idx < 1024; idx += C.G) glaC_item(C, l, idx, PROJ, ALOW, SBUF, CONCAT);
        }
        else if (kind == 4) {
            pg8::Gemm g{CONCAT, (const bf16*)(C.ws + WS_WTOUT) + (size_t)l * D * D, T, D, D};
            pg8::StaticOrder S; S.init(T, D, C.G, C.bid);
            pg8::EpiResGate E{l == 0 ? C.in[I_X] : (const float*)X, X, modl + 2 * D, MODW};
            pg8::gemm_phase<pg8::EpiResGate, pg8::StaticOrder>(C.lds, g, S, E);
        }
        else if (kind == 5) norm_phase(C, X, C.in[I_N2G] + (size_t)l * D, modl, 3 * D, 4 * D, Hb);
#ifdef DBG_SIMPLE_TOPK
        else if (kind == 7) topk_simple(C, l, QB, (const bf16*)(C.ws + WS_K1B), (const bf16*)(C.ws + WS_K2B), EB, PG);
#else
        else if (kind == 7) topk_phase(C, l, QB, (const bf16*)(C.ws + WS_K1B), (const bf16*)(C.ws + WS_K2B), EB, PG);
#endif
        else {
            const bf16* PU = (const bf16*)(C.ws + WS_PUB) + (size_t)l * NEXP * D; const bf16* PV = (const bf16*)(C.ws + WS_PVB) + (size_t)l * NEXP * D;
            if (l == DEPTH - 1) peer_phase<true>(C, l, Hb, EB, PG, PU, PV, X, modl + 5 * D, C.in[I_FG], nullptr, Hb);
            else peer_phase<false>(C, l, Hb, EB, PG, PU, PV, X, modl + 5 * D, C.in[I_N1G] + (size_t)(l + 1) * D, MOD + (size_t)(l + 1) * 4 * MODW, Hb);
        }
        if (ph + 1 < args.ph_hi) xcd_barrier(bar);
    }
}

extern "C" void kernel_launch(void* const* d_in, const int* in_sizes, int n_in, void* d_out, int out_size, void* d_ws, size_t ws_size, hipStream_t stream) {
    static int grid = 0;
    if (grid == 0) {
        if (n_in != 21 || out_size != T * D || ws_size < WS_END) { fprintf(stderr, "kernel_launch: unexpected shapes (n_in %d, out %d, ws %zu)\n", n_in, out_size, ws_size); grid = -1; return; }
        int dev = 0, cus = 0, per_cu = 0;
        if (hipGetDevice(&dev) != hipSuccess || hipDeviceGetAttribute(&cus, hipDeviceAttributeMultiprocessorCount, dev) != hipSuccess) { grid = -1; return; }
        if (hipFuncSetAttribute((const void*)mk_fwd, hipFuncAttributeMaxDynamicSharedMemorySize, LDS_BYTES) != hipSuccess) { fprintf(stderr, "kernel_launch: hipFuncSetAttribute failed\n"); grid = -1; return; }
        if (hipOccupancyMaxActiveBlocksPerMultiprocessor(&per_cu, (const void*)mk_fwd, NTHR, LDS_BYTES) != hipSuccess || per_cu < 1) { fprintf(stderr, "kernel_launch: occupancy query says %d blocks per CU\n", per_cu); (void)hipGetLastError(); grid = -1; return; }
        if (cus != 256) { fprintf(stderr, "kernel_launch: built for a 256-CU device (got %d)\n", cus); grid = -1; return; }
        grid = cus;
    }
    if (grid < 0) return;
    (void)hipMemsetAsync((char*)d_ws + WS_CTL, 0, CTL_ZERO_BYTES, stream);
    Args a{};
    for (int i = 0; i < 21; ++i) a.in[i] = (const float*)d_in[i];
    a.out = (float*)d_out; a.ws = (unsigned char*)d_ws;
#if MK_N_LAUNCHES == 1
    a.ph_lo = 0; a.ph_hi = NPH;
    hipLaunchKernelGGL(mk_fwd, dim3(grid), dim3(NTHR), LDS_BYTES, stream, a);
#else
    for (int p = 0; p < NPH; ++p) { a.ph_lo = p; a.ph_hi = p + 1; hipLaunchKernelGGL(mk_fwd, dim3(grid), dim3(NTHR), LDS_BYTES, stream, a); }
#endif
}
```

```cpp
#include <hip/hip_runtime.h>
#include <cstdio>
#include <cstdint>
#ifndef MK_N_LAUNCHES
#define MK_N_LAUNCHES 1
#endif
namespace pg8 {
#define PG8_LAS __attribute__((address_space(3)))
typedef unsigned short bf16_t;
typedef short bf16x8 __attribute__((ext_vector_type(8)));
typedef float f32x4 __attribute__((ext_vector_type(4)));
typedef unsigned u32x4 __attribute__((ext_vector_type(4)));
constexpr int BM = 256, BK = 64, HALF = 128, HTB = HALF * BK * 2  , STAGE_BYTES = 8 * HTB, NXCD = 8, WGM = 8;

__host__ __device__ __forceinline__ int lds_byte(int r, int c) { const int st = (r >> 4) * 2 + (c >> 5), rr = r & 15, cc = c & 31, ob = rr * 64 + cc * 2; return st * 1024 + (ob ^ (((ob >> 9) & 1) << 5)); }
__host__ __device__ __forceinline__ void stage_rc(int b, int& R, int& C) { const int st = b / 1024, sb = b % 1024, swz = sb ^ (((sb >> 9) & 1) << 5); R = (st >> 1) * 16 + swz / 64; C = (st & 1) * 32 + (swz % 64) / 2; }
__host__ __device__ __forceinline__ int perm32(int rho) { const int n = rho >> 4, i = rho & 15; return 8 * (i >> 2) + 4 * n + (i & 3); }

struct Unit { int pm, pn; };
struct Gemm { const bf16_t* A; const bf16_t* Bt; int M, N, K; };

struct StaticOrder {
    int nM, nN, nwg, G, c;
    __host__ __device__ void init(int M, int N, int G_, int c_) { nM = M / BM; nN = N / BM; nwg = nM * nN; G = G_; c = c_; }
    __host__ __device__ bool next(int i, Unit& u) const {
        const long L = (long)i * G + c; if (L >= nwg) return false;
        int wgid = (int)L; { const int q = nwg / NXCD, r = nwg % NXCD, xcd = wgid % NXCD, off = wgid / NXCD; wgid = (xcd < r ? xcd * (q + 1) : r * (q + 1) + (xcd - r) * q) + off; }
        const int nig = WGM * nN, gid = wgid / nig, fm = gid * WGM, gsz = (nM - fm) < WGM ? (nM - fm) : WGM;
        u.pm = fm + ((wgid % nig) % gsz); u.pn = (wgid % nig) / gsz; return true;
    }
    __device__ __forceinline__ void a_ready(const Unit&) const {}
    __device__ __forceinline__ void done(const Unit&) const {}
};
__device__ __forceinline__ unsigned cvt_pk_bf16(float lo, float hi) { unsigned r; asm volatile("v_cvt_pk_bf16_f32 %0, %1, %2" : "=v"(r) : "v"(lo), "v"(hi)); return r; }
struct EpiBf16 {
    static constexpr bool PERM = true, AFTER_DRAIN = false;
    bf16_t* O; int ldc;
    __device__ __forceinline__ void operator()(const f32x4 (&acc)[2][2][4][2], const Unit& u, int wr, int wc, int fr, int fq) const {
        const int row0 = u.pm * BM + wr * 64 + fr; const int col0 = u.pn * BM + wc * 32 + 8 * fq;
#pragma unroll
        for (int ai = 0; ai < 2; ++ai)
#pragma unroll
            for (int m = 0; m < 4; ++m) { bf16_t* rowp = O + (size_t)(row0 + ai * HALF + m * 16) * ldc + col0;
#pragma unroll
                for (int bj = 0; bj < 2; ++bj) { const f32x4 v0 = acc[ai][bj][m][0], v1 = acc[ai][bj][m][1];
                    u32x4 w; w.x = cvt_pk_bf16(v0[0], v0[1]); w.y = cvt_pk_bf16(v0[2], v0[3]); w.z = cvt_pk_bf16(v1[0], v1[1]); w.w = cvt_pk_bf16(v1[2], v1[3]);
                    *(u32x4*)(rowp + bj * HALF) = w; } }
    }
};
struct EpiResGate {
    static constexpr bool PERM = false, AFTER_DRAIN = false;
    const float* base; float* out; const float* gate; int gpitch;
    __device__ __forceinline__ void operator()(const f32x4 (&acc)[2][2][4][2], const Unit& u, int wr, int wc, int fr, int fq) const {
        const int row0 = u.pm * BM + wr * 64 + fr, col0 = u.pn * BM + wc * 32 + 4 * fq;
        const float* gp = gate + (size_t)(u.pm >> 4) * gpitch + col0;
        f32x4 gv[2][2];
#pragma unroll
        for (int bj = 0; bj < 2; ++bj)
#pragma unroll
            for (int n = 0; n < 2; ++n) gv[bj][n] = *(const f32x4*)(gp + bj * HALF + n * 16);
#pragma unroll
        for (int ai = 0; ai < 2; ++ai)
#pragma unroll
            for (int m = 0; m < 4; ++m) { const size_t off = (size_t)(row0 + ai * HALF + m * 16) * 2048 + col0;
#pragma unroll
                for (int bj = 0; bj < 2; ++bj)
#pragma unroll
                    for (int n = 0; n < 2; ++n) { const f32x4 bs = *(const f32x4*)(base + off + bj * HALF + n * 16); *(f32x4*)(out + off + bj * HALF + n * 16) = bs + gv[bj][n] * acc[ai][bj][m][n]; }
                asm volatile("" ::: "memory"); }
    }
};

template <class Epi, class Sched>
__device__ __forceinline__ void gemm_phase(PG8_LAS unsigned char* lds, const Gemm g, const Sched& S, const Epi& E) {
    const int tid = threadIdx.x, wid = __builtin_amdgcn_readfirstlane(tid >> 6), lane = tid & 63, wr = wid >> 2, wc = wid & 3, fr = lane & 15, fq = lane >> 4;
    const int K = g.K, nt = K / BK;
    unsigned voffA[2], voffB[2];
#pragma unroll
    for (int i = 0; i < 2; ++i) { int R, C; stage_rc(tid * 16 + i * 8192, R, C); const int Rb = Epi::PERM ? ((R & ~31) + perm32(R & 31)) : R;
        voffA[i] = (unsigned)(R * K + C) * 2u; voffB[i] = (unsigned)(Rb * K + C) * 2u; }
    const size_t kstep = (size_t)(BK * 2);
    const size_t hstep = (size_t)HALF * K * 2;
    const size_t tstep = 2 * hstep;
    const unsigned ldsw = (unsigned)wid * 1024u;
    const int aoff = lds_byte(wr * 64 + fr, fq * 8), boff = lds_byte(wc * 32 + fr, fq * 8);
#define PG8_SA(b, h) (((b) * 2 + (h)) * HTB)
#define PG8_SB(b, h) ((4 + (b) * 2 + (h)) * HTB)
#define PG8_STAGE(bufoff, gbase, voff) do { _Pragma("unroll") for (int _i = 0; _i < 2; ++_i) \
        __builtin_amdgcn_global_load_lds((const unsigned*)((const char*)(gbase) + (voff)[_i]), (PG8_LAS unsigned*)(lds + (bufoff) + ldsw + _i * 8192), 16, 0, 0); } while (0)
#define PG8_LDA(dst, b, h) do { _Pragma("unroll") for (int m = 0; m < 4; ++m) _Pragma("unroll") for (int k = 0; k < 2; ++k) dst[m][k] = *(const PG8_LAS bf16x8*)(lds + PG8_SA(b, h) + aoff + m * 2048 + k * 1024); } while (0)
#define PG8_LDB(dst, b, h) do { _Pragma("unroll") for (int n = 0; n < 2; ++n) _Pragma("unroll") for (int k = 0; k < 2; ++k) dst[n][k] = *(const PG8_LAS bf16x8*)(lds + PG8_SB(b, h) + boff + n * 2048 + k * 1024); } while (0)
#define PG8_MMA(ai, bj, At, Bt) do { __builtin_amdgcn_s_setprio(1); _Pragma("unroll") for (int m = 0; m < 4; ++m) _Pragma("unroll") for (int n = 0; n < 2; ++n) _Pragma("unroll") for (int k = 0; k < 2; ++k) \
        acc[ai][bj][m][n] = __builtin_amdgcn_mfma_f32_16x16x32_bf16(Bt[n][k], At[m][k], acc[ai][bj][m][n], 0, 0, 0); __builtin_amdgcn_s_setprio(0); } while (0)
#define PG8_WAIT_V(n) asm volatile("s_waitcnt vmcnt(" #n ")" ::: "memory")
#define PG8_WAIT_L(n) asm volatile("s_waitcnt lgkmcnt(" #n ")" ::: "memory")
#define PG8_BAR __builtin_amdgcn_s_barrier()
#define PG8_SCHED __builtin_amdgcn_sched_barrier(0)
    Unit cur, nxt; int ui = 0;
    if (!S.next(0, cur)) return;
    f32x4 acc[2][2][4][2];
#pragma unroll
    for (int a = 0; a < 2; ++a)
#pragma unroll
        for (int b = 0; b < 2; ++b)
#pragma unroll
            for (int m = 0; m < 4; ++m)
#pragma unroll
                for (int n = 0; n < 2; ++n) acc[a][b][m][n] = (f32x4){0.f, 0.f, 0.f, 0.f};
    bf16x8 At[4][2], B0[2][2], B1[2][2];
    const char* cA = (const char*)g.A + (size_t)cur.pm * tstep; const char* cB = (const char*)g.Bt + (size_t)cur.pn * tstep;
    S.a_ready(cur);
    PG8_STAGE(PG8_SB(0, 0), cB, voffB); PG8_STAGE(PG8_SA(0, 0), cA, voffA); PG8_STAGE(PG8_SB(0, 1), cB + hstep, voffB); PG8_STAGE(PG8_SA(0, 1), cA + hstep, voffA);
    if (wr == 1) PG8_BAR;
    PG8_WAIT_V(4); PG8_BAR;
    PG8_STAGE(PG8_SB(1, 0), cB + kstep, voffB); PG8_STAGE(PG8_SA(1, 0), cA + kstep, voffA); PG8_STAGE(PG8_SB(1, 1), cB + hstep + kstep, voffB);
    PG8_WAIT_V(6); PG8_BAR;
    for (;;) {
        const bool has_next = S.next(ui + 1, nxt);
        const char* nA = has_next ? (const char*)g.A + (size_t)nxt.pm * tstep : cA; const char* nB = has_next ? (const char*)g.Bt + (size_t)nxt.pn * tstep : cB;
        for (int t = 0; t < nt; t += 2) {
            const bool last = (t == nt - 2);
            const char* a1 = cA + (size_t)(t + 1) * kstep;
            const char* a2 = last ? nA : cA + (size_t)(t + 2) * kstep; const char* b2 = last ? nB : cB + (size_t)(t + 2) * kstep;
            const char* a3 = a2 + kstep; const char* b3 = b2 + kstep;
            if (last && has_next) S.a_ready(nxt);
            PG8_LDB(B0, 0, 0); PG8_SCHED; PG8_LDA(At, 0, 0); PG8_STAGE(PG8_SA(1, 1), a1 + hstep, voffA);
            PG8_WAIT_L(8); PG8_BAR; PG8_WAIT_L(0); PG8_MMA(0, 0, At, B0); PG8_BAR; PG8_SCHED;
            PG8_LDB(B1, 0, 1); PG8_STAGE(PG8_SB(0, 0), b2, voffB);
            PG8_BAR; PG8_WAIT_L(0); PG8_MMA(0, 1, At, B1); PG8_BAR;
            PG8_LDA(At, 0, 1); PG8_STAGE(PG8_SA(0, 0), a2, voffA);
            PG8_BAR; PG8_WAIT_L(0); PG8_MMA(1, 0, At, B0); PG8_BAR; PG8_SCHED;
            PG8_STAGE(PG8_SB(0, 1), b2 + hstep, voffB);
            PG8_WAIT_V(6); PG8_BAR; PG8_MMA(1, 1, At, B1); PG8_BAR;
            PG8_LDB(B0, 1, 0); PG8_SCHED; PG8_LDA(At, 1, 0); PG8_STAGE(PG8_SA(0, 1), a2 + hstep, voffA);
            PG8_WAIT_L(8); PG8_BAR; PG8_WAIT_L(0); PG8_MMA(0, 0, At, B0); PG8_BAR; PG8_SCHED;
            PG8_LDB(B1, 1, 1); PG8_STAGE(PG8_SB(1, 0), b3, voffB);
            PG8_BAR; PG8_WAIT_L(0); PG8_MMA(0, 1, At, B1); PG8_BAR;
            PG8_LDA(At, 1, 1); PG8_STAGE(PG8_SA(1, 0), a3, voffA);
            PG8_BAR; PG8_WAIT_L(0); PG8_MMA(1, 0, At, B0); PG8_BAR; PG8_SCHED;
            PG8_STAGE(PG8_SB(1, 1), b3 + hstep, voffB);
            PG8_WAIT_V(6); PG8_BAR; PG8_MMA(1, 1, At, B1); PG8_BAR;
        }
        if constexpr (!Epi::AFTER_DRAIN) { E(acc, cur, wr, wc, fr, fq); S.done(cur); }
        if (!has_next) break;
#pragma unroll
        for (int a = 0; a < 2; ++a)
#pragma unroll
            for (int b = 0; b < 2; ++b)
#pragma unroll
                for (int m = 0; m < 4; ++m)
#pragma unroll
                    for (int n = 0; n < 2; ++n) acc[a][b][m][n] = (f32x4){0.f, 0.f, 0.f, 0.f};
        cur = nxt; cA = nA; cB = nB; ++ui;
    }
    PG8_WAIT_V(0);
    if (wr == 0) PG8_BAR;
    PG8_BAR;
    if constexpr (Epi::AFTER_DRAIN) { E.fused(acc, cur, wr, wc, fr, fq, lds, wid, lane); S.done(cur); }
#undef PG8_SA
#undef PG8_SB
#undef PG8_STAGE
#undef PG8_LDA
#undef PG8_LDB
#undef PG8_MMA
#undef PG8_WAIT_V
#undef PG8_WAIT_L
#undef PG8_BAR
#undef PG8_SCHED
}
}
constexpr int NWAVES = 8, NTHR = 512;
constexpr int D = 2048, NBATCH = 4, SEQ = 4096, T = NBATCH * SEQ, DEPTH = 2;
constexpr int GLA_H = 4, GLA_DK = 128, GLA_DV = 256, GLA_CH = 64;
constexpr int MLP_H = 8, MLP_DH = 128, MLP_CH = 128;
constexpr int IN_COLS = 5136, NPROJ = 5120;
constexpr int C_Q = 0, C_K = 512, C_V = 1024, C_R = 2048, C_U = 3072, C_VS = 4096;
constexpr int NEXP = 16384, PEER_H = 8;
constexpr float EPS = 1e-6f;
constexpr int MODW = 6 * D;
constexpr size_t MiB = 1u << 20;
constexpr size_t WS_CTL = 0, CTL_ZERO_BYTES = 1 * MiB;
constexpr size_t WS_MOD = 1 * MiB;
constexpr size_t WS_K1B = 2 * MiB, WS_K2B = 2 * MiB + 512 * 1024, WS_WSB = 3 * MiB, WS_DEC = 3 * MiB + 512 * 1024, WS_ALOW = 4 * MiB;
constexpr size_t WS_KU = 5 * MiB, WS_KV = 5 * MiB + 256 * 1024;
constexpr size_t WS_WTIN = 8 * MiB;
constexpr size_t WTIN_L = (size_t)5136 * 2048;
constexpr size_t WS_WTOUT = 49 * MiB, WS_WTQ = 65 * MiB;
constexpr size_t WS_PUB = 81 * MiB, WS_PVB = 209 * MiB;
constexpr size_t WS_H = 337 * MiB;
constexpr size_t WS_PROJ = 401 * MiB;
constexpr size_t WS_SBUF = 561 * MiB;
constexpr size_t WS_CONCAT = 625 * MiB;
constexpr size_t WS_QB = 689 * MiB;
constexpr size_t WS_EB = 753 * MiB, WS_PG = 761 * MiB, WS_END = 769 * MiB;
static_assert(WS_WTIN + 2 * WTIN_L * 2 <= WS_WTOUT, "ws map");
constexpr int CW_BAR = 4096;
constexpr int RING_BYTES = 131072, LDSCTL_OFF = RING_BYTES, MISC_OFF = LDSCTL_OFF + 320, LDS_BYTES = 147456;

#define DI __device__ __forceinline__
#define LAS __attribute__((address_space(3)))
typedef unsigned short bf16;
typedef short bf16x8 __attribute__((ext_vector_type(8)));
typedef short s16x4 __attribute__((ext_vector_type(4)));
typedef short v4i16_t __attribute__((ext_vector_type(4)));
typedef __bf16 bf16x2_t __attribute__((ext_vector_type(2)));
typedef float f32x4 __attribute__((ext_vector_type(4)));
typedef float f32x2 __attribute__((ext_vector_type(2)));
typedef unsigned u32x4 __attribute__((ext_vector_type(4)));
typedef unsigned u32x2 __attribute__((ext_vector_type(2)));
typedef LAS unsigned char* ldsp;

DI unsigned f2bf(float f) { unsigned u = __builtin_bit_cast(unsigned, f); return (u + 0x7fffu + ((u >> 16) & 1u)) >> 16; }
DI unsigned pk2(float lo, float hi) { return f2bf(lo) | (f2bf(hi) << 16); }
DI float bflo(unsigned u) { return __builtin_bit_cast(float, u << 16); }
DI float bfhi(unsigned u) { return __builtin_bit_cast(float, u & 0xffff0000u); }
DI float bf1(bf16 v) { return __builtin_bit_cast(float, ((unsigned)v) << 16); }
DI float fexp2(float x) { return __builtin_amdgcn_exp2f(x); }
DI float flog2(float x) { return __builtin_amdgcn_logf(x); }
DI float frcp(float x) { return __builtin_amdgcn_rcpf(x); }
DI float frsq(float x) { return __builtin_amdgcn_rsqf(x); }
DI float gelu_t(float x) { const float u = 0.7978845608f * (x + 0.044715f * x * x * x); return x * frcp(1.f + fexp2(-2.885390082f * u)); }
DI float silu_f(float x) { return x * frcp(1.f + fexp2(-1.442695041f * x)); }
template <int CTRL> DI float dppf(float v) { return __builtin_bit_cast(float, __builtin_amdgcn_update_dpp(0, __builtin_bit_cast(int, v), CTRL, 0xf, 0xf, true)); }
DI float wave_sum_u(float v) {
    v += dppf<0xB1>(v); v += dppf<0x4E>(v); v += dppf<0x141>(v); v += dppf<0x140>(v);
    const int iv = __builtin_bit_cast(int, v);
    return (__builtin_bit_cast(float, __builtin_amdgcn_readlane(iv, 0)) + __builtin_bit_cast(float, __builtin_amdgcn_readlane(iv, 16))) +
           (__builtin_bit_cast(float, __builtin_amdgcn_readlane(iv, 32)) + __builtin_bit_cast(float, __builtin_amdgcn_readlane(iv, 48)));
}
DI float wave_sum(float v) {
#pragma unroll
    for (int o = 1; o < 64; o <<= 1) v += __shfl_xor(v, o);
    return v;
}
DI float dot2bf(unsigned a, unsigned b, float c) { return __builtin_amdgcn_fdot2_f32_bf16(__builtin_bit_cast(bf16x2_t, a), __builtin_bit_cast(bf16x2_t, b), c, false); }
DI f32x4 mfma16(bf16x8 a, bf16x8 b, f32x4 c) { return __builtin_amdgcn_mfma_f32_16x16x32_bf16(a, b, c, 0, 0, 0); }
DI s16x4 tr4(const LAS bf16* p) { return __builtin_bit_cast(s16x4, __builtin_amdgcn_ds_read_tr16_b64_v4i16((LAS v4i16_t*)p)); }
DI bf16x8 tr8(const LAS bf16* p, int stride) { const s16x4 a = tr4(p), b = tr4(p + 4 * stride); return (bf16x8){a[0], a[1], a[2], a[3], b[0], b[1], b[2], b[3]}; }

#define XB_TMO      128
#define XB_XCNT(j)  (256  + 64 * (j))
#define XB_XSUB(j)  (1280 + 64 * (j))
#define XB_XGEN(j)  (2304 + 64 * (j))
#define XB_TOP      3328
#define XB_TOPGEN   3392
#define XCD_BAR_WORDS 3456
#define XB_SPIN_CAP (1u << 18)

__device__ __forceinline__ unsigned xb_ld(unsigned* p)              { return __hip_atomic_load(p, __ATOMIC_RELAXED, __HIP_MEMORY_SCOPE_AGENT); }
__device__ __forceinline__ unsigned xb_add(unsigned* p, unsigned v) { return __hip_atomic_fetch_add(p, v, __ATOMIC_RELAXED, __HIP_MEMORY_SCOPE_AGENT); }
__device__ __forceinline__ unsigned xb_xcc_id() { return (unsigned)__builtin_amdgcn_s_getreg((3 << 11) | 20) & 0xFu; }
#define XB_SPIN(cond, bar) do { unsigned _sp = 0; while (cond) { __builtin_amdgcn_s_sleep(1); \
    if ((++_sp & 255u) == 0u) { if (xb_ld(&(bar)[XB_TMO])) break; if (_sp > XB_SPIN_CAP) { atomicAdd(&(bar)[XB_TMO], 1u); break; } } } } while (0)

struct XcdBarrier {
    unsigned* bar; unsigned x;
    volatile LAS unsigned* st;
};

__device__ __forceinline__ XcdBarrier xcd_barrier_post(unsigned* bar, volatile LAS unsigned* st) {
    XcdBarrier b; b.bar = bar; b.x = xb_xcc_id(); b.st = st;
    if (threadIdx.x == 0) (void)xb_add(&bar[XB_XCNT(b.x)], 1u);
    return b;
}
__device__ __forceinline__ void xcd_barrier_complete(unsigned* bar, unsigned x, unsigned& nloc, unsigned& nx) {
    const unsigned G = gridDim.x * gridDim.y * gridDim.z;
    unsigned sum, cnt, mine, sp = 0u;
    for (;;) {
        sum = 0u; cnt = 0u; mine = 0u;
#pragma unroll
        for (unsigned j = 0; j < 16; ++j) { const unsigned c = xb_ld(&bar[XB_XCNT(j)]); sum += c; cnt += (c > 0u) ? 1u : 0u; mine = (j == x) ? c : mine; }
        if (sum == G) break;
        __builtin_amdgcn_s_sleep(1);
        if ((++sp & 255u) == 0u) { if (xb_ld(&bar[XB_TMO])) break; if (sp > XB_SPIN_CAP) { atomicAdd(&bar[XB_TMO], 1u); break; } }
    }
    nloc = mine > 0u ? mine : 1u; nx = cnt > 0u ? cnt : 1u;
}

__device__ __forceinline__ void xcd_barrier(const XcdBarrier& b) {
    asm volatile("s_waitcnt vmcnt(0)" ::: "memory");
    __syncthreads();
    if (threadIdx.x == 0) {
        unsigned* bar = b.bar;
        __builtin_amdgcn_s_waitcnt(0);
        unsigned nloc = b.st[0], nx = b.st[1];
        if (nloc == 0u) { xcd_barrier_complete(bar, b.x, nloc, nx); b.st[0] = nloc; b.st[1] = nx; }
        const unsigned old = xb_add(&bar[XB_XSUB(b.x)], 1u);
        const unsigned gen = old / nloc;
        if (old + 1u == (gen + 1u) * nloc) {
            __builtin_amdgcn_fence(__ATOMIC_RELEASE, "agent");
            asm volatile("s_waitcnt vmcnt(0)" ::: "memory");
            const unsigned og = xb_add(&bar[XB_TOP], 1u);
            const unsigned tg = og / nx;
            if (og + 1u == (tg + 1u) * nx) xb_add(&bar[XB_TOPGEN], 1u);
            else XB_SPIN(xb_ld(&bar[XB_TOPGEN]) == tg, bar);
            __builtin_amdgcn_fence(__ATOMIC_ACQUIRE, "agent");
            xb_add(&bar[XB_XGEN(b.x)], 1u);
            asm volatile("s_waitcnt vmcnt(0)" ::: "memory");
        } else {
            XB_SPIN(xb_ld(&bar[XB_XGEN(b.x)]) == gen, bar);
            __builtin_amdgcn_fence(__ATOMIC_ACQUIRE, "agent");
            asm volatile("s_waitcnt vmcnt(0)" ::: "memory");
        }
    }
    __syncthreads();
}
struct Ctx {
    ldsp lds; int tid, lane, wave, bid, G, gw, NGW;
    const float* in[21]; float* out; unsigned char* ws;
};
#define LDS_WAIT() asm volatile("s_waitcnt lgkmcnt(0)" ::: "memory")
enum { I_X = 0, I_C, I_ADAW, I_ADAB, I_N1G, I_WIN, I_WA2, I_BA, I_GNG, I_VNG, I_MWS, I_MB, I_MOG, I_WOUT, I_N2G, I_WQ, I_K1, I_K2, I_PU, I_PV, I_FG };

DI void p0_ada(const Ctx& C) {
    LAS float* red = (LAS float*)C.lds;
    float* MOD = (float*)(C.ws + WS_MOD);
    for (int it = C.bid; it < 192; it += C.G) {
        const int l = it / 96, cg = it % 96, c0 = cg * 128 + C.lane * 2;
        const float* W = C.in[I_ADAW] + (size_t)l * D * MODW + (size_t)(C.wave * 256) * MODW + c0;
        float cv[4][4];
#pragma unroll
        for (int b = 0; b < 4; ++b)
#pragma unroll
            for (int i = 0; i < 4; ++i) cv[b][i] = silu_f(C.in[I_C][b * D + C.wave * 256 + i * 64 + C.lane]);
        float acc[4][2];
#pragma unroll
        for (int b = 0; b < 4; ++b) { acc[b][0] = 0.f; acc[b][1] = 0.f; }
#pragma unroll
        for (int i = 0; i < 4; ++i) {
#pragma unroll 8
            for (int j = 0; j < 64; ++j) {
                const f32x2 w = *(const f32x2*)(W + (size_t)(i * 64 + j) * MODW);
#pragma unroll
                for (int b = 0; b < 4; ++b) { const float s = __builtin_bit_cast(float, __builtin_amdgcn_readlane(__builtin_bit_cast(int, cv[b][i]), j)); acc[b][0] += s * w.x; acc[b][1] += s * w.y; }
            }
        }
#pragma unroll
        for (int b = 0; b < 4; ++b) *(LAS f32x2*)(red + (C.wave * 4 + b) * 128 + C.lane * 2) = (f32x2){acc[b][0], acc[b][1]};
        __syncthreads();
        { const int b = C.tid >> 7, col = C.tid & 127; float s = C.in[I_ADAB][l * MODW + cg * 128 + col];
#pragma unroll
          for (int w = 0; w < 8; ++w) s += red[(w * 4 + b) * 128 + col];
          MOD[(size_t)(l * 4 + b) * MODW + cg * 128 + col] = s; }
        __syncthreads();
    }
}
DI void transpose_item(const float* W, int ldw, int src_col0, int ncols, bf16* WT, int dst_row0, int k0, LAS float* scr, int lane) {
    const int cl = lane & 31;
#pragma unroll 8
    for (int i = 0; i < 32; ++i) { const int kk = 2 * i + (lane >> 5); float v = 0.f; if (cl < ncols) v = W[(size_t)(k0 + kk) * ldw + src_col0 + cl]; scr[kk * 33 + cl] = v; }
    LDS_WAIT();
    const int c = lane & 7;
#pragma unroll
    for (int j = 0; j < 4; ++j) { const int n = (lane >> 3) + 8 * j;
        if (n < ncols) { const LAS float* s = scr + (8 * c) * 33 + n;
            u32x4 o; o.x = pk2(s[0 * 33], s[1 * 33]); o.y = pk2(s[2 * 33], s[3 * 33]); o.z = pk2(s[4 * 33], s[5 * 33]); o.w = pk2(s[6 * 33], s[7 * 33]);
            *(u32x4*)(WT + (size_t)(dst_row0 + n) * 2048 + k0 + 8 * c) = o; } }
    LDS_WAIT();
}
DI void p0_prologue(const Ctx& C) {
    p0_ada(C);
    LAS float* scr = (LAS float*)(C.lds + C.wave * 16384);
    constexpr int PER_L = (161 + 64 + 64) * 32;
    for (int it = C.gw; it < 2 * PER_L; it += C.NGW) {
        const int l = it / PER_L; int r = it % PER_L;
        if (r < 161 * 32) { const int kb = r / 161, nb = r % 161; bf16* WT = (bf16*)(C.ws + WS_WTIN) + (size_t)l * WTIN_L;
            const float* W = C.in[I_WIN] + (size_t)l * D * IN_COLS;
            if (nb < 160) { const int n0 = 32 * nb; transpose_item(W, IN_COLS, n0 + (n0 >= 3072 ? 16 : 0), 32, WT, n0, 64 * kb, scr, C.lane); }
            else transpose_item(W, IN_COLS, 3072, 16, WT, 5120, 64 * kb, scr, C.lane);
            continue; }
        r -= 161 * 32;
        if (r < 2048) { const int kb = r / 64, nb = r % 64; transpose_item(C.in[I_WOUT] + (size_t)l * D * D, D, 32 * nb, 32, (bf16*)(C.ws + WS_WTOUT) + (size_t)l * D * D, 32 * nb, 64 * kb, scr, C.lane); continue; }
        r -= 2048;
        { const int kb = r / 64, nb = r % 64; transpose_item(C.in[I_WQ] + (size_t)l * D * D, D, 32 * nb, 32, (bf16*)(C.ws + WS_WTQ) + (size_t)l * D * D, 32 * nb, 64 * kb, scr, C.lane); }
    }
    const int gt = C.bid * NTHR + C.tid, NT = C.G * NTHR;
    { bf16* K1B = (bf16*)(C.ws + WS_K1B); bf16* K2B = (bf16*)(C.ws + WS_K2B); bf16* WSB = (bf16*)(C.ws + WS_WSB);
      for (int i = gt; i < 262144; i += NT) { K1B[i] = (bf16)f2bf(C.in[I_K1][i]); K2B[i] = (bf16)f2bf(C.in[I_K2][i]);
          const int s = i & 127, t = (i >> 7) & 127; WSB[i] = (s <= t) ? (bf16)f2bf(C.in[I_MWS][i]) : (bf16)0; } }
    { int* KU = (int*)(C.ws + WS_KU); int* KV = (int*)(C.ws + WS_KV);
#pragma unroll 1
      for (int row = C.gw; row < 4 * NEXP; row += C.NGW) {
          const int tb = row >> 15, rr = row & 32767;
          const f32x4* src = (const f32x4*)(C.in[tb ? I_PV : I_PU] + (size_t)rr * D) + C.lane;
          f32x4 v[8]; float mx = 0.f;
#pragma unroll
          for (int j = 0; j < 8; ++j) { v[j] = src[64 * j]; mx = fmaxf(mx, fmaxf(fmaxf(fabsf(v[j].x), fabsf(v[j].y)), fmaxf(fabsf(v[j].z), fabsf(v[j].w)))); }
#pragma unroll
          for (int o = 1; o < 64; o <<= 1) mx = fmaxf(mx, __shfl_xor(mx, o));
          int k = 0;
          if (mx > 0.f) { k = (int)((__builtin_bit_cast(unsigned, 224.0f / mx) >> 23) & 255u) - 127; k = k < -60 ? -60 : (k > 60 ? 60 : k); }
          const float sc = __builtin_bit_cast(float, (unsigned)(k + 127) << 23);
          unsigned* dst = (unsigned*)(C.ws + (tb ? WS_PVB : WS_PUB) + (size_t)rr * D) + C.lane;
#pragma unroll
          for (int j = 0; j < 8; ++j) { int p = 0; p = __builtin_amdgcn_cvt_pk_fp8_f32(v[j].x * sc, v[j].y * sc, p, false); p = __builtin_amdgcn_cvt_pk_fp8_f32(v[j].z * sc, v[j].w * sc, p, true); dst[64 * j] = (unsigned)p; }
          if (C.lane == 0) (tb ? KV : KU)[rr] = k;
      } }
}
DI void norm_phase(const Ctx& C, const float* X, const float* g, const float* modl, int sh_off, int sc_off, bf16* Hout) {
    const int r0 = C.gw * 8, b = r0 >> 12;
    const f32x4* shp = (const f32x4*)(modl + (size_t)b * MODW + sh_off); const f32x4* scp = (const f32x4*)(modl + (size_t)b * MODW + sc_off);
    f32x4 gm[8], shv[8];
#pragma unroll
    for (int j = 0; j < 8; ++j) { const int idx = 64 * j + C.lane; gm[j] = ((const f32x4*)g)[idx] * (scp[idx] + 1.0f); shv[j] = shp[idx]; }
#pragma unroll 1
    for (int i = 0; i < 8; ++i) {
        const f32x4* xr = (const f32x4*)(X + (size_t)(r0 + i) * D) + C.lane; f32x4 v[8]; float s = 0.f;
#pragma unroll
        for (int j = 0; j < 8; ++j) { v[j] = xr[64 * j]; s += (v[j].x * v[j].x + v[j].y * v[j].y) + (v[j].z * v[j].z + v[j].w * v[j].w); }
        const float rstd = frsq(wave_sum(s) * (1.f / D) + EPS);
        u32x2* o = (u32x2*)(Hout + (size_t)(r0 + i) * D) + C.lane;
#pragma unroll
        for (int j = 0; j < 8; ++j) { const f32x4 y = v[j] * rstd * gm[j] + shv[j]; u32x2 w; w.x = pk2(y.x, y.y); w.y = pk2(y.z, y.w); o[64 * j] = w; }
    }
}
DI void alow_phase(const Ctx& C, const bf16* Hb, const bf16* WtA, float* ALOW) {
    if (C.wave < 4) {
        const int task = C.bid * 4 + C.wave, r0 = task * 16, fr = C.lane & 15, fq = C.lane >> 4;
        const bf16* ap = Hb + (size_t)(r0 + fr) * D + 8 * fq; const bf16* bp = WtA + (size_t)fr * D + 8 * fq;
        f32x4 acc = (f32x4){0.f, 0.f, 0.f, 0.f};
#pragma unroll 8
        for (int ks = 0; ks < 64; ++ks) { const bf16x8 a = *(const bf16x8*)(ap + 32 * ks), b = *(const bf16x8*)(bp + 32 * ks); acc = mfma16(a, b, acc); }
#pragma unroll
        for (int r = 0; r < 4; ++r) ALOW[(size_t)(r0 + 4 * fq + r) * 16 + fr] = acc[r];
    }
}
DI void gla_gates(const Ctx& C, LAS float* al, LAS float* tot, const float* ALOW, const float* wa2, const float* ba, int t0, int h, float (&Gl)[16], float& off, float& gref, float& g63) {
    const int d = C.tid & 127, jg = C.tid >> 7;
    if (C.tid < 256) ((LAS f32x4*)al)[C.tid] = ((const f32x4*)(ALOW + (size_t)t0 * 16))[C.tid];
    float w2[16];
#pragma unroll
    for (int r = 0; r < 16; ++r) w2[r] = wa2[r * 512 + h * 128 + d];
    const float bav = ba[h * 128 + d];
    __syncthreads();
    float run = 0.f;
#pragma unroll
    for (int jj = 0; jj < 16; ++jj) {
        const LAS f32x4* ar = (const LAS f32x4*)(al + (jg * 16 + jj) * 16);
        const f32x4 a0 = ar[0], a1 = ar[1], a2 = ar[2], a3 = ar[3];
        float z = bav;
        z += a0.x * w2[0] + a0.y * w2[1] + a0.z * w2[2] + a0.w * w2[3];
        z += a1.x * w2[4] + a1.y * w2[5] + a1.z * w2[6] + a1.w * w2[7];
        z += a2.x * w2[8] + a2.y * w2[9] + a2.z * w2[10] + a2.w * w2[11];
        z += a3.x * w2[12] + a3.y * w2[13] + a3.z * w2[14] + a3.w * w2[15];
        const float ls = fminf(z, 0.f) - 0.6931471806f * flog2(1.f + fexp2(-1.442695041f * fabsf(z)));
        run += ls * (1.442695041f / 16.f);
        Gl[jj] = run;
    }
    tot[jg * 128 + d] = run;
    __syncthreads();
    const float t0_ = tot[d], t1_ = tot[128 + d], t2_ = tot[256 + d], t3_ = tot[384 + d];
    off = (jg > 0 ? t0_ : 0.f) + (jg > 1 ? t1_ : 0.f) + (jg > 2 ? t2_ : 0.f); gref = t0_ + t1_; g63 = (t0_ + t1_) + (t2_ + t3_);
}
constexpr int KST = 136, VST = 264, PST = 72;
DI void load_v_tile(const Ctx& C, const bf16* PROJ, int t0, int h, LAS bf16* VL) {
#pragma unroll
    for (int i = 0; i < 4; ++i) { const int c = C.tid + 512 * i, j = c >> 5, ec = c & 31;
        *(LAS u32x4*)(VL + j * VST + 8 * ec) = *(const u32x4*)(PROJ + (size_t)(t0 + j) * NPROJ + C_V + h * 256 + 8 * ec); }
}
DI void glaA_item(const Ctx& C, int l, int idx, const bf16* PROJ, const float* ALOW, bf16* SBUF, float* DEC) {
    const int b = idx >> 8, h = (idx >> 6) & 3, n = idx & 63, t0 = b * SEQ + n * 64;
    LAS float* al = (LAS float*)(C.lds); LAS float* tot = (LAS float*)(C.lds + 4096);
    LAS bf16* KD = (LAS bf16*)(C.lds + 8192); LAS bf16* VL = (LAS bf16*)(C.lds + 25600);
    float Gl[16], off, gref, g63;
    gla_gates(C, al, tot, ALOW, C.in[I_WA2] + (size_t)l * 16 * 512, C.in[I_BA] + (size_t)l * 512, t0, h, Gl, off, gref, g63);
    const int d = C.tid & 127, jg = C.tid >> 7;
#pragma unroll
    for (int jj = 0; jj < 16; ++jj) { const int j = jg * 16 + jj; const float kv = bf1(PROJ[(size_t)(t0 + j) * NPROJ + C_K + h * 128 + d]);
        KD[j * KST + d] = (bf16)f2bf(kv * fexp2(g63 - (off + Gl[jj]))); }
    if (jg == 0) DEC[(size_t)idx * 128 + d] = fexp2(g63);
    load_v_tile(C, PROJ, t0, h, VL);
    __syncthreads();
    const int lane = C.lane, g = lane >> 4, qq = (lane & 15) >> 2, p = lane & 3, fr = lane & 15;
    bf16x8 A[2];
#pragma unroll
    for (int ks = 0; ks < 2; ++ks) A[ks] = tr8(KD + (32 * ks + 8 * g + qq) * KST + 16 * C.wave + 4 * p, KST);
    bf16* Sit = SBUF + (size_t)idx * 256 * 128;
#pragma unroll
    for (int half = 0; half < 2; ++half) {
        f32x4 acc[8];
#pragma unroll
        for (int nt = 0; nt < 8; ++nt) acc[nt] = (f32x4){0.f, 0.f, 0.f, 0.f};
#pragma unroll
        for (int nt = 0; nt < 8; ++nt)
#pragma unroll
            for (int ks = 0; ks < 2; ++ks) { const bf16x8 Bf = tr8(VL + (32 * ks + 8 * g + qq) * VST + 16 * (half * 8 + nt) + 4 * p, VST); acc[nt] = mfma16(A[ks], Bf, acc[nt]); }
#pragma unroll
        for (int nt = 0; nt < 8; ++nt) { const int e = 16 * (half * 8 + nt) + fr, dd = 16 * C.wave + 4 * g;
            u32x2 w; w.x = pk2(acc[nt][0], acc[nt][1]); w.y = pk2(acc[nt][2], acc[nt][3]); *(u32x2*)(Sit + (size_t)e * 128 + dd) = w; }
    }
    __syncthreads();
}
DI void scan_phase(const Ctx& C, bf16* SBUF, const float* DEC) {
    const int gt = C.bid * NTHR + C.tid, bh = gt >> 13, rem = gt & 8191, e = rem >> 5, dq = rem & 31;
    u32x2* p = (u32x2*)(SBUF + ((size_t)(bh * 64) * 256 + e) * 128 + 4 * dq);
    const f32x4* dp = (const f32x4*)(DEC + (size_t)(bh * 64) * 128 + 4 * dq);
    f32x4 st = (f32x4){0.f, 0.f, 0.f, 0.f};
#pragma unroll 1
    for (int n0 = 0; n0 < 64; n0 += 8) {
        u32x2 tmp[8]; f32x4 dc[8];
#pragma unroll
        for (int u = 0; u < 8; ++u) { tmp[u] = p[(size_t)(n0 + u) * 8192]; dc[u] = dp[(n0 + u) * 32]; }
#pragma unroll
        for (int u = 0; u < 8; ++u) { u32x2 w; w.x = pk2(st.x, st.y); w.y = pk2(st.z, st.w); p[(size_t)(n0 + u) * 8192] = w;
            st = dc[u] * st + (f32x4){bflo(tmp[u].x), bfhi(tmp[u].x), bflo(tmp[u].y), bfhi(tmp[u].y)}; }
    }
}
DI void glaC_item(const Ctx& C, int l, int idx, const bf16* PROJ, const float* ALOW, const bf16* SBUF, bf16* CONCAT) {
    const int b = idx >> 8, h = (idx >> 6) & 3, n = idx & 63, t0 = b * SEQ + n * 64;
    LAS float* al = (LAS float*)(C.lds); LAS float* tot = (LAS float*)(C.lds + 4096); LAS float* RS = (LAS float*)(C.lds + 6144);
    LAS bf16* QT = (LAS bf16*)(C.lds + 8192); LAS bf16* KT = (LAS bf16*)(C.lds + 25600); LAS bf16* QG = (LAS bf16*)(C.lds + 43008);
    LAS bf16* VL = (LAS bf16*)(C.lds + 60416); LAS bf16* PL = (LAS bf16*)(C.lds + 94208);
    float Gl[16], off, gref, g63;
    gla_gates(C, al, tot, ALOW, C.in[I_WA2] + (size_t)l * 16 * 512, C.in[I_BA] + (size_t)l * 512, t0, h, Gl, off, gref, g63);
    const int d = C.tid & 127, jg = C.tid >> 7;
#pragma unroll
    for (int jj = 0; jj < 16; ++jj) { const int j = jg * 16 + jj; const float Gv = off + Gl[jj];
        const bf16* row = PROJ + (size_t)(t0 + j) * NPROJ + h * 128 + d;
        const float q = bf1(row[C_Q]) * 0.08838834764831845f, k = bf1(row[C_K]);
        QT[j * KST + d] = (bf16)f2bf(q * fexp2(Gv - gref)); KT[j * KST + d] = (bf16)f2bf(k * fexp2(gref - Gv)); QG[j * KST + d] = (bf16)f2bf(q * fexp2(Gv)); }
    load_v_tile(C, PROJ, t0, h, VL);
    __syncthreads();
    const int lane = C.lane, g = lane >> 4, qq = (lane & 15) >> 2, p = lane & 3, fr = lane & 15;
    {
        const int nt = C.wave & 3;
#pragma unroll
        for (int mi = 0; mi < 2; ++mi) { const int mt = 2 * (C.wave >> 2) + mi; f32x4 acc = (f32x4){0.f, 0.f, 0.f, 0.f};
#pragma unroll
            for (int ks = 0; ks < 4; ++ks) { const bf16x8 a = *(const LAS bf16x8*)(KT + (16 * mt + fr) * KST + 32 * ks + 8 * g), bq = *(const LAS bf16x8*)(QT + (16 * nt + fr) * KST + 32 * ks + 8 * g); acc = mfma16(a, bq, acc); }
            const int i = 16 * nt + fr, j0 = 16 * mt + 4 * g;
            const float v0 = (j0 + 0 <= i) ? acc[0] : 0.f, v1 = (j0 + 1 <= i) ? acc[1] : 0.f, v2 = (j0 + 2 <= i) ? acc[2] : 0.f, v3 = (j0 + 3 <= i) ? acc[3] : 0.f;
            u32x2 w; w.x = pk2(v0, v1); w.y = pk2(v2, v3); *(LAS u32x2*)(PL + i * PST + j0) = w; }
    }
    __syncthreads();
    f32x4 acc[2][4];
#pragma unroll
    for (int mi = 0; mi < 2; ++mi)
#pragma unroll
        for (int nt = 0; nt < 4; ++nt) acc[mi][nt] = (f32x4){0.f, 0.f, 0.f, 0.f};
#pragma unroll
    for (int mi = 0; mi < 2; ++mi) { const int mt = 2 * C.wave + mi;
#pragma unroll
        for (int ks = 0; ks < 2; ++ks) { const bf16x8 a = tr8(VL + (32 * ks + 8 * g + qq) * VST + 16 * mt + 4 * p, VST);
#pragma unroll
            for (int nt = 0; nt < 4; ++nt) { const bf16x8 bp = *(const LAS bf16x8*)(PL + (16 * nt + fr) * PST + 32 * ks + 8 * g); acc[mi][nt] = mfma16(a, bp, acc[mi][nt]); } }
        const bf16* Srow = SBUF + ((size_t)idx * 256 + 16 * mt + fr) * 128 + 8 * g;
#pragma unroll
        for (int ks = 0; ks < 4; ++ks) { const bf16x8 a = *(const bf16x8*)(Srow + 32 * ks);
#pragma unroll
            for (int nt = 0; nt < 4; ++nt) { const bf16x8 bq = *(const LAS bf16x8*)(QG + (16 * nt + fr) * KST + 32 * ks + 8 * g); acc[mi][nt] = mfma16(a, bq, acc[mi][nt]); } }
    }
#pragma unroll
    for (int nt = 0; nt < 4; ++nt) { float s = 0.f;
#pragma unroll
        for (int mi = 0; mi < 2; ++mi) s += (acc[mi][nt][0] * acc[mi][nt][0] + acc[mi][nt][1] * acc[mi][nt][1]) + (acc[mi][nt][2] * acc[mi][nt][2] + acc[mi][nt][3] * acc[mi][nt][3]);
        s += __shfl_xor(s, 16); s += __shfl_xor(s, 32);
        if (g == 0) RS[C.wave * 64 + 16 * nt + fr] = s; }
    __syncthreads();
    const float* ng = C.in[I_GNG] + (size_t)(l * 4 + h) * 256;
#pragma unroll
    for (int nt = 0; nt < 4; ++nt) { const int i = 16 * nt + fr; float ts = 0.f;
#pragma unroll
        for (int w = 0; w < 8; ++w) ts += RS[w * 64 + i];
        const float rstd = frsq(ts * (1.f / 256.f) + EPS);
#pragma unroll
        for (int mi = 0; mi < 2; ++mi) { const int e = 16 * (2 * C.wave + mi) + 4 * g;
            const u32x2 rr = *(const u32x2*)(PROJ + (size_t)(t0 + i) * NPROJ + C_R + h * 256 + e); const f32x4 gg = *(const f32x4*)(ng + e);
            const float o0 = acc[mi][nt][0] * rstd * gg.x * silu_f(bflo(rr.x)), o1 = acc[mi][nt][1] * rstd * gg.y * silu_f(bfhi(rr.x));
            const float o2 = acc[mi][nt][2] * rstd * gg.z * silu_f(bflo(rr.y)), o3 = acc[mi][nt][3] * rstd * gg.w * silu_f(bfhi(rr.y));
            u32x2 w; w.x = pk2(o0, o1); w.y = pk2(o2, o3); *(u32x2*)(CONCAT + (size_t)(t0 + i) * D + h * 256 + e) = w; } }
    __syncthreads();
}
constexpr int GST = 136;
DI void gmlp_item(const Ctx& C, int l, int idx, const bf16* PROJ, const bf16* WSB, bf16* CONCAT) {
    const int h = idx & 7, n = (idx >> 3) & 31, b = idx >> 8, t0 = b * SEQ + n * 128;
    LAS bf16* VL2 = (LAS bf16*)(C.lds); LAS bf16* UL = (LAS bf16*)(C.lds + 34816);
    const float* vg = C.in[I_VNG] + (size_t)(l * 8 + h) * 128; const float* og = C.in[I_MOG] + (size_t)(l * 8 + h) * 128; const float* bb = C.in[I_MB] + (size_t)(l * 8 + h) * 128;
#pragma unroll
    for (int i = 0; i < 4; ++i) { const int c = C.tid + 512 * i, t = c >> 4, ch = c & 15;
        const bf16* row = PROJ + (size_t)(t0 + t) * NPROJ + h * 128 + 8 * ch;
        const u32x4 uu = *(const u32x4*)(row + C_U), vv = *(const u32x4*)(row + C_VS);
        float v[8] = {gelu_t(bflo(vv.x)), gelu_t(bfhi(vv.x)), gelu_t(bflo(vv.y)), gelu_t(bfhi(vv.y)), gelu_t(bflo(vv.z)), gelu_t(bfhi(vv.z)), gelu_t(bflo(vv.w)), gelu_t(bfhi(vv.w))};
        float ss = 0.f;
#pragma unroll
        for (int k = 0; k < 8; ++k) ss += v[k] * v[k];
        ss += __shfl_xor(ss, 1); ss += __shfl_xor(ss, 2); ss += __shfl_xor(ss, 4); ss += __shfl_xor(ss, 8);
        const float rstd = frsq(ss * (1.f / 128.f) + EPS);
        const f32x4 g0 = *(const f32x4*)(vg + 8 * ch), g1 = *(const f32x4*)(vg + 8 * ch + 4);
        u32x4 wv; wv.x = pk2(v[0] * rstd * g0.x, v[1] * rstd * g0.y); wv.y = pk2(v[2] * rstd * g0.z, v[3] * rstd * g0.w); wv.z = pk2(v[4] * rstd * g1.x, v[5] * rstd * g1.y); wv.w = pk2(v[6] * rstd * g1.z, v[7] * rstd * g1.w);
        *(LAS u32x4*)(VL2 + t * GST + 8 * ch) = wv;
        u32x4 wu; wu.x = pk2(gelu_t(bflo(uu.x)), gelu_t(bfhi(uu.x))); wu.y = pk2(gelu_t(bflo(uu.y)), gelu_t(bfhi(uu.y))); wu.z = pk2(gelu_t(bflo(uu.z)), gelu_t(bfhi(uu.z))); wu.w = pk2(gelu_t(bflo(uu.w)), gelu_t(bfhi(uu.w)));
        *(LAS u32x4*)(UL + t * GST + 8 * ch) = wu; }
    __syncthreads();
    const int lane = C.lane, g = lane >> 4, qq = (lane & 15) >> 2, p = lane & 3, fr = lane & 15;
    f32x4 acc[8];
#pragma unroll
    for (int mt = 0; mt < 8; ++mt) acc[mt] = (f32x4){0.f, 0.f, 0.f, 0.f};
    const int nks = (C.wave >> 1) + 1;
    const bf16* Wrow = WSB + ((size_t)(l * 8 + h) * 128 + 16 * C.wave + fr) * 128 + 8 * g;
#pragma unroll 1
    for (int ks = 0; ks < nks; ++ks) { const bf16x8 bw = *(const bf16x8*)(Wrow + 32 * ks);
#pragma unroll
        for (int mt = 0; mt < 8; ++mt) { const bf16x8 a = tr8(VL2 + (32 * ks + 8 * g + qq) * GST + 16 * mt + 4 * p, GST); acc[mt] = mfma16(a, bw, acc[mt]); } }
    const int tl = 16 * C.wave + fr; const float bt = bb[tl]; float ss = 0.f;
#pragma unroll
    for (int mt = 0; mt < 8; ++mt) { const u32x2 uu = *(const LAS u32x2*)(UL + tl * GST + 16 * mt + 4 * g);
        acc[mt][0] = bflo(uu.x) * (acc[mt][0] + bt); acc[mt][1] = bfhi(uu.x) * (acc[mt][1] + bt); acc[mt][2] = bflo(uu.y) * (acc[mt][2] + bt); acc[mt][3] = bfhi(uu.y) * (acc[mt][3] + bt);
        ss += (acc[mt][0] * acc[mt][0] + acc[mt][1] * acc[mt][1]) + (acc[mt][2] * acc[mt][2] + acc[mt][3] * acc[mt][3]); }
    ss += __shfl_xor(ss, 16); ss += __shfl_xor(ss, 32);
    const float rstd = frsq(ss * (1.f / 128.f) + EPS);
#pragma unroll
    for (int mt = 0; mt < 8; ++mt) { const f32x4 gg = *(const f32x4*)(og + 16 * mt + 4 * g);
        u32x2 w; w.x = pk2(acc[mt][0] * rstd * gg.x, acc[mt][1] * rstd * gg.y); w.y = pk2(acc[mt][2] * rstd * gg.z, acc[mt][3] * rstd * gg.w);
        *(u32x2*)(CONCAT + (size_t)(t0 + tl) * D + 1024 + h * 128 + 16 * mt + 4 * g) = w; }
    __syncthreads();
}
DI void list_insert(float (&L)[16], float x) {
#pragma unroll
    for (int i = 15; i >= 1; --i) L[i] = __builtin_amdgcn_fmed3f(x, L[i - 1], L[i]);
    L[0] = fmaxf(L[0], x);
}
DI void list_merge_xor(float (&L)[16], int mask) {
    float M[16];
#pragma unroll
    for (int i = 0; i < 16; ++i) M[i] = fmaxf(L[i], __shfl_xor(L[15 - i], mask));
#pragma unroll
    for (int s = 8; s >= 1; s >>= 1)
#pragma unroll
        for (int i = 0; i < 16; ++i) if ((i & s) == 0) { const float hi = fmaxf(M[i], M[i + s]), lo = fminf(M[i], M[i + s]); M[i] = hi; M[i + s] = lo; }
#pragma unroll
    for (int i = 0; i < 16; ++i) L[i] = M[i];
}
DI unsigned fbits(float x) { return __builtin_bit_cast(unsigned, x); }
DI float unp7(float x) { return __builtin_bit_cast(float, __builtin_bit_cast(unsigned, x) & 0xFFFFFF80u); }
DI void topk_phase(const Ctx& C, int l, const bf16* QB, const bf16* K1B, const bf16* K2B, const int* KU, const int* KV, int* EB, float* PG) {
    LAS unsigned* tk = (LAS unsigned*)(C.lds + C.wave * 4096);
    const int lane = C.lane, fr = lane & 15, fq = lane >> 4;
#pragma unroll 1
    for (int wi = C.gw; wi < 8192; wi += C.NGW) {
        const int h = wi & 7, tt0 = (wi >> 3) * 16;
        float L[2][16];
#pragma unroll
        for (int half = 0; half < 2; ++half) {
            f32x4 acc[8];
#pragma unroll
            for (int mt = 0; mt < 8; ++mt) acc[mt] = (f32x4){0.f, 0.f, 0.f, 0.f};
            const bf16* Kb = (half ? K2B : K1B) + ((size_t)(l * 8 + h) * 128 + fr) * 128 + 8 * fq;
            const bf16* Qp = QB + (size_t)(tt0 + fr) * D + h * 256 + half * 128 + 8 * fq;
#pragma unroll
            for (int ks = 0; ks < 4; ++ks) {
                const bf16x8 b0 = *(const bf16x8*)(Qp + 32 * ks);
#pragma unroll
                for (int mt = 0; mt < 8; ++mt) { const bf16x8 a = *(const bf16x8*)(Kb + (size_t)(16 * mt) * 128 + 32 * ks); acc[mt] = mfma16(a, b0, acc[mt]); }
            }
#pragma unroll
            for (int i = 0; i < 16; ++i) L[half][i] = __builtin_bit_cast(float, 0xFF800000u);
#pragma unroll
            for (int mt = 0; mt < 8; ++mt)
#pragma unroll
                for (int r = 0; r < 4; ++r) { const unsigned key = (unsigned)(16 * mt + 4 * fq + r);
                    const float sv = acc[mt][r];
                    list_insert(L[half], __builtin_bit_cast(float, (fbits(sv) & 0xFFFFFF80u) | key)); }
            list_merge_xor(L[half], 16); list_merge_xor(L[half], 32);
        }
        if (fq == 0) {
#pragma unroll
            for (int i = 0; i < 16; ++i) { tk[(fr * 2 + 0) * 16 + i] = fbits(L[0][i]); tk[(fr * 2 + 1) * 16 + i] = fbits(L[1][i]); }
        }
        float Cn[16];
#pragma unroll
        for (int i = 0; i < 16; ++i) Cn[i] = __builtin_bit_cast(float, 0xFF800000u);
#pragma unroll
        for (int i = 0; i < 16; ++i)
#pragma unroll
            for (int j = 0; j < 16; ++j) if ((i + 1) * (j + 1) <= 16) {
                const float s = unp7(L[0][i]) + unp7(L[1][j]);
                list_insert(Cn, __builtin_bit_cast(float, (fbits(s) & 0xFFFFFF00u) | (unsigned)(i * 16 + j))); }
        LDS_WAIT();
        float sc[4]; int ex[4];
#pragma unroll
        for (int m = 0; m < 4; ++m) {
            const float ck = fq == 0 ? Cn[m] : (fq == 1 ? Cn[4 + m] : (fq == 2 ? Cn[8 + m] : Cn[12 + m]));
            const unsigned cc = fbits(ck) & 255u;
            const unsigned p1 = tk[(fr * 2 + 0) * 16 + (cc >> 4)], p2 = tk[(fr * 2 + 1) * 16 + (cc & 15u)];
            sc[m] = __builtin_bit_cast(float, p1 & 0xFFFFFF80u) + __builtin_bit_cast(float, p2 & 0xFFFFFF80u);
            ex[m] = (int)((p1 & 127u) * 128u + (p2 & 127u));
        }
        float mx = fmaxf(fmaxf(sc[0], sc[1]), fmaxf(sc[2], sc[3]));
        mx = fmaxf(mx, __shfl_xor(mx, 16)); mx = fmaxf(mx, __shfl_xor(mx, 32));
        float w[4], sum = 0.f;
#pragma unroll
        for (int m = 0; m < 4; ++m) { w[m] = fexp2((sc[m] - mx) * 1.442695041f); sum += w[m]; }
        sum += __shfl_xor(sum, 16); sum += __shfl_xor(sum, 32);
        const float inv = 1.0f / sum;
        const size_t o = (size_t)(tt0 + fr) * 128 + h * 16 + 4 * fq;
#pragma unroll
        for (int m = 0; m < 4; ++m) { const int ku = KU[ex[m]], kv = KV[ex[m]]; w[m] = w[m] * inv * __builtin_bit_cast(float, (unsigned)(127 - kv) << 23); ex[m] |= (127 - ku) << 16; }
        *(int4*)(EB + o) = make_int4(ex[0], ex[1], ex[2], ex[3]);
        *(f32x4*)(PG + o) = (f32x4){w[0], w[1], w[2], w[3]};
        LDS_WAIT();
    }
}
constexpr int PEER_R = 2;
typedef unsigned char fp8_t;
template <bool LAST>
DI void peer_phase(const Ctx& C, int l, const bf16* Hb, const int* EB, const float* PG, const fp8_t* PU, const fp8_t* PV, float* X, const float* gate  ,
                   const float* ng, const float* modn  , bf16* Hout) {
    const int lane = C.lane;
#pragma unroll 1
    for (int ti = 0; ti < 8; ++ti) {
        const int m = C.gw * 8 + ti, b = m >> 12;
        float hv[2][16];
#pragma unroll
        for (int c = 0; c < 2; ++c) { const u32x4* hp = (const u32x4*)(Hb + (size_t)m * D + c * 1024 + lane * 16); const u32x4 h0 = hp[0], h1 = hp[1];
            hv[c][0] = bflo(h0.x); hv[c][1] = bfhi(h0.x); hv[c][2] = bflo(h0.y); hv[c][3] = bfhi(h0.y); hv[c][4] = bflo(h0.z); hv[c][5] = bfhi(h0.z); hv[c][6] = bflo(h0.w); hv[c][7] = bfhi(h0.w);
            hv[c][8] = bflo(h1.x); hv[c][9] = bfhi(h1.x); hv[c][10] = bflo(h1.y); hv[c][11] = bfhi(h1.y); hv[c][12] = bflo(h1.z); hv[c][13] = bfhi(h1.z); hv[c][14] = bflo(h1.w); hv[c][15] = bfhi(h1.w); }
        const int e_lo = EB[(size_t)m * 128 + lane], e_hi = EB[(size_t)m * 128 + 64 + lane];
        const float g_lo = PG[(size_t)m * 128 + lane], g_hi = PG[(size_t)m * 128 + 64 + lane];
        float acc[2][16];
#pragma unroll
        for (int c = 0; c < 2; ++c)
#pragma unroll
            for (int i = 0; i < 16; ++i) acc[c][i] = 0.f;
#pragma unroll 1
        for (int k0 = 0; k0 < 128; k0 += PEER_R) {
            u32x4 ur[PEER_R][2], vr[PEER_R][2]; float gk[PEER_R], isu[PEER_R];
#pragma unroll
            for (int r = 0; r < PEER_R; ++r) { const int k = k0 + r;
                const int ep = __builtin_amdgcn_readlane(k0 < 64 ? e_lo : e_hi, k & 63); const int ek = ep & 0xFFFF;
                isu[r] = __builtin_bit_cast(float, (unsigned)(ep >> 16) << 23);
                gk[r] = __builtin_bit_cast(float, __builtin_amdgcn_readlane(__builtin_bit_cast(int, k0 < 64 ? g_lo : g_hi), k & 63));
                const u32x4* up = (const u32x4*)(PU + (size_t)ek * D) + lane; const u32x4* vp = (const u32x4*)(PV + (size_t)ek * D) + lane;
#pragma unroll
                for (int c = 0; c < 2; ++c) { ur[r][c] = up[c * 64]; vr[r][c] = vp[c * 64]; } }
#pragma unroll
            for (int r = 0; r < PEER_R; ++r) { float p = 0.f;
#pragma unroll
                for (int c = 0; c < 2; ++c) {
#pragma unroll
                    for (int w = 0; w < 4; ++w) { const int dw = (int)ur[r][c][w]; const f32x2 lo = __builtin_amdgcn_cvt_pk_f32_fp8(dw, false), hi = __builtin_amdgcn_cvt_pk_f32_fp8(dw, true);
                        p += lo.x * hv[c][4 * w] + lo.y * hv[c][4 * w + 1] + hi.x * hv[c][4 * w + 2] + hi.y * hv[c][4 * w + 3]; } }
#ifdef DBG_NO_PEER
                const float a = 0.f * gelu_t(wave_sum_u(p) * isu[r]) * gk[r];
#else
                const float a = gelu_t(wave_sum_u(p) * isu[r]) * gk[r];
#endif
#pragma unroll
                for (int c = 0; c < 2; ++c) {
#pragma unroll
                    for (int w = 0; w < 4; ++w) { const int dw = (int)vr[r][c][w]; const f32x2 lo = __builtin_amdgcn_cvt_pk_f32_fp8(dw, false), hi = __builtin_amdgcn_cvt_pk_f32_fp8(dw, true);
                        acc[c][4 * w] += a * lo.x; acc[c][4 * w + 1] += a * lo.y; acc[c][4 * w + 2] += a * hi.x; acc[c][4 * w + 3] += a * hi.y; } } }
        }
        float* xr = X + (size_t)m * D; const float* gp = gate + (size_t)b * MODW; float ss = 0.f;
#pragma unroll
        for (int c = 0; c < 2; ++c)
#pragma unroll
            for (int q = 0; q < 4; ++q) { const int e0 = c * 1024 + lane * 16 + 4 * q;
                const f32x4 x0 = *(const f32x4*)(xr + e0), t0 = *(const f32x4*)(gp + e0);
                acc[c][4 * q] = x0.x + t0.x * acc[c][4 * q]; acc[c][4 * q + 1] = x0.y + t0.y * acc[c][4 * q + 1]; acc[c][4 * q + 2] = x0.z + t0.z * acc[c][4 * q + 2]; acc[c][4 * q + 3] = x0.w + t0.w * acc[c][4 * q + 3];
                ss += (acc[c][4 * q] * acc[c][4 * q] + acc[c][4 * q + 1] * acc[c][4 * q + 1]) + (acc[c][4 * q + 2] * acc[c][4 * q + 2] + acc[c][4 * q + 3] * acc[c][4 * q + 3]); }
        const float rstd = frsq(wave_sum_u(ss) * (1.f / D) + EPS);
#pragma unroll
        for (int c = 0; c < 2; ++c) {
            unsigned hw[8];
#pragma unroll
            for (int q = 0; q < 4; ++q) { const int e0 = c * 1024 + lane * 16 + 4 * q;
                const f32x4 g0 = *(const f32x4*)(ng + e0);
                if (LAST) {
                    *(f32x4*)(xr + e0) = (f32x4){acc[c][4 * q] * rstd * g0.x, acc[c][4 * q + 1] * rstd * g0.y, acc[c][4 * q + 2] * rstd * g0.z, acc[c][4 * q + 3] * rstd * g0.w};
                } else {
                    *(f32x4*)(xr + e0) = (f32x4){acc[c][4 * q], acc[c][4 * q + 1], acc[c][4 * q + 2], acc[c][4 * q + 3]};
                    const float* sh = modn + (size_t)b * MODW; const float* scp = sh + D;
                    const f32x4 s0 = *(const f32x4*)(scp + e0), h0 = *(const f32x4*)(sh + e0);
                    hw[2 * q] = pk2(acc[c][4 * q] * rstd * g0.x * (1.f + s0.x) + h0.x, acc[c][4 * q + 1] * rstd * g0.y * (1.f + s0.y) + h0.y);
                    hw[2 * q + 1] = pk2(acc[c][4 * q + 2] * rstd * g0.z * (1.f + s0.z) + h0.z, acc[c][4 * q + 3] * rstd * g0.w * (1.f + s0.w) + h0.w);
                } }
            if (!LAST) { u32x4* ho = (u32x4*)(Hout + (size_t)m * D + c * 1024 + lane * 16);
                ho[0] = (u32x4){hw[0], hw[1], hw[2], hw[3]}; ho[1] = (u32x4){hw[4], hw[5], hw[6], hw[7]}; }
        }
    }
}
constexpr int NPH = 20;
struct Args { const float* in[21]; float* out; unsigned char* ws; int ph_lo, ph_hi, pad0, pad1; };
__global__ void __launch_bounds__(NTHR, 2) mk_fwd(Args args) {
    extern __shared__ __attribute__((aligned(16))) unsigned char lds_raw[];
    ldsp ldsb = (ldsp)lds_raw;
    volatile LAS unsigned* MISC = (volatile LAS unsigned*)(ldsb + MISC_OFF);
    for (int u = threadIdx.x; u < (LDS_BYTES - LDSCTL_OFF) / 4; u += NTHR) ((LAS unsigned*)(ldsb + LDSCTL_OFF))[u] = 0u;
    __syncthreads();
    unsigned* barw = (unsigned*)(args.ws + WS_CTL) + CW_BAR;
    XcdBarrier bar; bar.bar = barw; bar.x = 0; bar.st = nullptr;
    const bool multi = (args.ph_hi - args.ph_lo) > 1;
    if (multi) bar = xcd_barrier_post(barw, MISC + 8);

    int repflag = 0; (void)repflag;
#pragma unroll 1
    for (int ph = args.ph_lo; ph < args.ph_hi; ++ph) {
        int tid_ = threadIdx.x, bid_ = blockIdx.x; asm volatile("" : "+v"(tid_)); asm volatile("" : "+s"(bid_));
        Ctx C;
        C.lds = ldsb; C.tid = tid_; C.lane = tid_ & 63; C.wave = __builtin_amdgcn_readfirstlane(tid_ >> 6);
        C.bid = bid_; C.G = gridDim.x; C.gw = C.bid * NWAVES + C.wave; C.NGW = C.G * NWAVES;
#pragma unroll
        for (int i = 0; i < 21; ++i) C.in[i] = args.in[i];
        C.out = args.out; C.ws = args.ws;
        float* MOD = (float*)(C.ws + WS_MOD);
        bf16* Hb = (bf16*)(C.ws + WS_H); bf16* PROJ = (bf16*)(C.ws + WS_PROJ); bf16* SBUF = (bf16*)(C.ws + WS_SBUF); bf16* CONCAT = (bf16*)(C.ws + WS_CONCAT); bf16* QB = (bf16*)(C.ws + WS_QB);
        float* ALOW = (float*)(C.ws + WS_ALOW); float* DEC = (float*)(C.ws + WS_DEC); int* EB = (int*)(C.ws + WS_EB); float* PG = (float*)(C.ws + WS_PG);
        float* X = C.out;
        const int l = ph < 2 ? 0 : (ph - 2) / 9, kind = ph < 2 ? -1 : (ph - 2) % 9;
        const float* modl = MOD + (size_t)l * 4 * MODW;
        if (ph == 0) p0_prologue(C);
        else if (ph == 1) norm_phase(C, C.in[I_X], C.in[I_N1G], modl, 0, D, Hb);
        else if (kind == 0 || kind == 6) {
            const bool isq = (kind == 6);
            pg8::Gemm g{Hb, isq ? (const bf16*)(C.ws + WS_WTQ) + (size_t)l * D * D : (const bf16*)(C.ws + WS_WTIN) + (size_t)l * WTIN_L, T, isq ? D : NPROJ, D};
            pg8::StaticOrder S; S.init(T, g.N, C.G, C.bid);
            pg8::EpiBf16 E{isq ? QB : PROJ, isq ? D : NPROJ};
            pg8::gemm_phase<pg8::EpiBf16, pg8::StaticOrder>(C.lds, g, S, E);
            if (!isq) alow_phase(C, Hb, (const bf16*)(C.ws + WS_WTIN) + (size_t)l * WTIN_L + (size_t)NPROJ * D, ALOW);
        }
        else if (kind == 1) {
#pragma unroll 1
            for (int i = 0; i < 8; ++i) { const int idx = (i >> 1) * C.G + C.bid;
                if (idx < 1024) { if (i & 1) gmlp_item(C, l, idx, PROJ, (const bf16*)(C.ws + WS_WSB), CONCAT); else glaA_item(C, l, idx, PROJ, ALOW, SBUF, DEC); } }
        }
        else if (kind == 2) scan_phase(C, SBUF, DEC);
        else if (kind == 3) {
#pragma unroll 1
            for (int idx = C.bid; idx < 1024; idx += C.G) glaC_item(C, l, idx, PROJ, ALOW, SBUF, CONCAT);
        }
        else if (kind == 4) {
            pg8::Gemm g{CONCAT, (const bf16*)(C.ws + WS_WTOUT) + (size_t)l * D * D, T, D, D};
            pg8::StaticOrder S; S.init(T, D, C.G, C.bid);
            pg8::EpiResGate E{l == 0 ? C.in[I_X] : (const float*)X, X, modl + 2 * D, MODW};
            pg8::gemm_phase<pg8::EpiResGate, pg8::StaticOrder>(C.lds, g, S, E);
        }
        else if (kind == 5) norm_phase(C, X, C.in[I_N2G] + (size_t)l * D, modl, 3 * D, 4 * D, Hb);
        else if (kind == 7) topk_phase(C, l, QB, (const bf16*)(C.ws + WS_K1B), (const bf16*)(C.ws + WS_K2B), (const int*)(C.ws + WS_KU) + l * NEXP, (const int*)(C.ws + WS_KV) + l * NEXP, EB, PG);
        else {
            const fp8_t* PU = (const fp8_t*)(C.ws + WS_PUB) + (size_t)l * NEXP * D; const fp8_t* PV = (const fp8_t*)(C.ws + WS_PVB) + (size_t)l * NEXP * D;
            if (l == DEPTH - 1) peer_phase<true>(C, l, Hb, EB, PG, PU, PV, X, modl + 5 * D, C.in[I_FG], nullptr, Hb);
            else peer_phase<false>(C, l, Hb, EB, PG, PU, PV, X, modl + 5 * D, C.in[I_N1G] + (size_t)(l + 1) * D, MOD + (size_t)(l + 1) * 4 * MODW, Hb);
        }
        if (ph + 1 < args.ph_hi) xcd_barrier(bar);
#ifdef DBG_REP_MASK
        { const int bit = ph < 2 ? ph : 2 + kind; bool want = ((DBG_REP_MASK) >> bit) & 1;
#ifdef DBG_REP_L0
          if (l != 0) want = false;
#endif
          if (want && !repflag) { repflag = 1; --ph; } else repflag = 0; }
#endif
    }
}

extern "C" void kernel_launch(void* const* d_in, const int* in_sizes, int n_in, void* d_out, int out_size, void* d_ws, size_t ws_size, hipStream_t stream) {
    static int grid = 0;
    if (grid == 0) {
        if (n_in != 21 || out_size != T * D || ws_size < WS_END) { fprintf(stderr, "kernel_launch: unexpected shapes (n_in %d, out %d, ws %zu)\n", n_in, out_size, ws_size); grid = -1; return; }
        int dev = 0, cus = 0, per_cu = 0;
        if (hipGetDevice(&dev) != hipSuccess || hipDeviceGetAttribute(&cus, hipDeviceAttributeMultiprocessorCount, dev) != hipSuccess) { grid = -1; return; }
        if (hipFuncSetAttribute((const void*)mk_fwd, hipFuncAttributeMaxDynamicSharedMemorySize, LDS_BYTES) != hipSuccess) { fprintf(stderr, "kernel_launch: hipFuncSetAttribute failed\n"); grid = -1; return; }
        if (hipOccupancyMaxActiveBlocksPerMultiprocessor(&per_cu, (const void*)mk_fwd, NTHR, LDS_BYTES) != hipSuccess || per_cu < 1) { fprintf(stderr, "kernel_launch: occupancy query says %d blocks per CU\n", per_cu); (void)hipGetLastError(); grid = -1; return; }
        if (cus != 256) { fprintf(stderr, "kernel_launch: built for a 256-CU device (got %d)\n", cus); grid = -1; return; }
        grid = cus;
    }
    if (grid < 0) return;
    (void)hipMemsetAsync((char*)d_ws + WS_CTL, 0, CTL_ZERO_BYTES, stream);
    Args a{};
    for (int i = 0; i < 21; ++i) a.in[i] = (const float*)d_in[i];
    a.out = (float*)d_out; a.ws = (unsigned char*)d_ws;
#if MK_N_LAUNCHES == 1
    a.ph_lo = 0; a.ph_hi = NPH;
    hipLaunchKernelGGL(mk_fwd, dim3(grid), dim3(NTHR), LDS_BYTES, stream, a);
#else
    for (int p = 0; p < NPH; ++p) { a.ph_lo = p; a.ph_hi = p + 1; hipLaunchKernelGGL(mk_fwd, dim3(grid), dim3(NTHR), LDS_BYTES, stream, a); }
#endif
}
```

```cpp
#include <hip/hip_runtime.h>
#include <cstdio>
#include <cstdint>
#ifndef MK_N_LAUNCHES
#define MK_N_LAUNCHES 1
#endif
namespace pg8 {
#define PG8_LAS __attribute__((address_space(3)))
typedef unsigned short bf16_t;
typedef short bf16x8 __attribute__((ext_vector_type(8)));
typedef float f32x4 __attribute__((ext_vector_type(4)));
typedef unsigned u32x4 __attribute__((ext_vector_type(4)));
constexpr int BM = 256, BK = 64, HALF = 128, HTB = HALF * BK * 2  , STAGE_BYTES = 8 * HTB, NXCD = 8, WGM = 8;

__host__ __device__ __forceinline__ int lds_byte(int r, int c) { const int st = (r >> 4) * 2 + (c >> 5), rr = r & 15, cc = c & 31, ob = rr * 64 + cc * 2; return st * 1024 + (ob ^ (((ob >> 9) & 1) << 5)); }
__host__ __device__ __forceinline__ void stage_rc(int b, int& R, int& C) { const int st = b / 1024, sb = b % 1024, swz = sb ^ (((sb >> 9) & 1) << 5); R = (st >> 1) * 16 + swz / 64; C = (st & 1) * 32 + (swz % 64) / 2; }
__host__ __device__ __forceinline__ int perm32(int rho) { const int n = rho >> 4, i = rho & 15; return 8 * (i >> 2) + 4 * n + (i & 3); }

struct Unit { int pm, pn; };
struct Gemm { const bf16_t* A; const bf16_t* Bt; int M, N, K; };

struct StaticOrder {
    int nM, nN, nwg, G, c;
    __host__ __device__ void init(int M, int N, int G_, int c_) { nM = M / BM; nN = N / BM; nwg = nM * nN; G = G_; c = c_; }
    __host__ __device__ bool next(int i, Unit& u) const {
        const long L = (long)i * G + c; if (L >= nwg) return false;
        int wgid = (int)L; { const int q = nwg / NXCD, r = nwg % NXCD, xcd = wgid % NXCD, off = wgid / NXCD; wgid = (xcd < r ? xcd * (q + 1) : r * (q + 1) + (xcd - r) * q) + off; }
        const int nig = WGM * nN, gid = wgid / nig, fm = gid * WGM, gsz = (nM - fm) < WGM ? (nM - fm) : WGM;
        u.pm = fm + ((wgid % nig) % gsz); u.pn = (wgid % nig) / gsz; return true;
    }
    __device__ __forceinline__ void a_ready(const Unit&) const {}
    __device__ __forceinline__ void done(const Unit&) const {}
};
__device__ __forceinline__ unsigned cvt_pk_bf16(float lo, float hi) { unsigned r; asm volatile("v_cvt_pk_bf16_f32 %0, %1, %2" : "=v"(r) : "v"(lo), "v"(hi)); return r; }
struct EpiBf16 {
    static constexpr bool PERM = true, AFTER_DRAIN = false;
    bf16_t* O; int ldc;
    __device__ __forceinline__ void operator()(const f32x4 (&acc)[2][2][4][2], const Unit& u, int wr, int wc, int fr, int fq) const {
        const int row0 = u.pm * BM + wr * 64 + fr; const int col0 = u.pn * BM + wc * 32 + 8 * fq;
#pragma unroll
        for (int ai = 0; ai < 2; ++ai)
#pragma unroll
            for (int m = 0; m < 4; ++m) { bf16_t* rowp = O + (size_t)(row0 + ai * HALF + m * 16) * ldc + col0;
#pragma unroll
                for (int bj = 0; bj < 2; ++bj) { const f32x4 v0 = acc[ai][bj][m][0], v1 = acc[ai][bj][m][1];
                    u32x4 w; w.x = cvt_pk_bf16(v0[0], v0[1]); w.y = cvt_pk_bf16(v0[2], v0[3]); w.z = cvt_pk_bf16(v1[0], v1[1]); w.w = cvt_pk_bf16(v1[2], v1[3]);
                    *(u32x4*)(rowp + bj * HALF) = w; } }
    }
};
struct EpiResGate {
    static constexpr bool PERM = false, AFTER_DRAIN = false;
    const float* base; float* out; const float* gate; int gpitch;
    __device__ __forceinline__ void operator()(const f32x4 (&acc)[2][2][4][2], const Unit& u, int wr, int wc, int fr, int fq) const {
        const int row0 = u.pm * BM + wr * 64 + fr, col0 = u.pn * BM + wc * 32 + 4 * fq;
        const float* gp = gate + (size_t)(u.pm >> 4) * gpitch + col0;
        f32x4 gv[2][2];
#pragma unroll
        for (int bj = 0; bj < 2; ++bj)
#pragma unroll
            for (int n = 0; n < 2; ++n) gv[bj][n] = *(const f32x4*)(gp + bj * HALF + n * 16);
#pragma unroll
        for (int ai = 0; ai < 2; ++ai)
#pragma unroll
            for (int m = 0; m < 4; ++m) { const size_t off = (size_t)(row0 + ai * HALF + m * 16) * 2048 + col0;
#pragma unroll
                for (int bj = 0; bj < 2; ++bj)
#pragma unroll
                    for (int n = 0; n < 2; ++n) { const f32x4 bs = *(const f32x4*)(base + off + bj * HALF + n * 16); *(f32x4*)(out + off + bj * HALF + n * 16) = bs + gv[bj][n] * acc[ai][bj][m][n]; }
                asm volatile("" ::: "memory"); }
    }
};

template <class Epi, class Sched>
__device__ __forceinline__ void gemm_phase(PG8_LAS unsigned char* lds, const Gemm g, const Sched& S, const Epi& E, const int tid  ) {
    const int wid = __builtin_amdgcn_readfirstlane(tid >> 6), lane = tid & 63, wr = wid >> 2, wc = wid & 3, fr = lane & 15, fq = lane >> 4;
    const int K = g.K, nt = K / BK;
    unsigned voffA[2], voffB[2];
#pragma unroll
    for (int i = 0; i < 2; ++i) { int R, C; stage_rc(tid * 16 + i * 8192, R, C); const int Rb = Epi::PERM ? ((R & ~31) + perm32(R & 31)) : R;
        voffA[i] = (unsigned)(R * K + C) * 2u; voffB[i] = (unsigned)(Rb * K + C) * 2u; }
    const size_t kstep = (size_t)(BK * 2);
    const size_t hstep = (size_t)HALF * K * 2;
    const size_t tstep = 2 * hstep;
    const unsigned ldsw = (unsigned)wid * 1024u;
    const int aoff = lds_byte(wr * 64 + fr, fq * 8), boff = lds_byte(wc * 32 + fr, fq * 8);
#define PG8_SA(b, h) (((b) * 2 + (h)) * HTB)
#define PG8_SB(b, h) ((4 + (b) * 2 + (h)) * HTB)
#define PG8_STAGE(bufoff, gbase, voff) do { _Pragma("unroll") for (int _i = 0; _i < 2; ++_i) \
        __builtin_amdgcn_global_load_lds((const unsigned*)((const char*)(gbase) + (voff)[_i]), (PG8_LAS unsigned*)(lds + (bufoff) + ldsw + _i * 8192), 16, 0, 0); } while (0)
#define PG8_LDA(dst, b, h) do { _Pragma("unroll") for (int m = 0; m < 4; ++m) _Pragma("unroll") for (int k = 0; k < 2; ++k) dst[m][k] = *(const PG8_LAS bf16x8*)(lds + PG8_SA(b, h) + aoff + m * 2048 + k * 1024); } while (0)
#define PG8_LDB(dst, b, h) do { _Pragma("unroll") for (int n = 0; n < 2; ++n) _Pragma("unroll") for (int k = 0; k < 2; ++k) dst[n][k] = *(const PG8_LAS bf16x8*)(lds + PG8_SB(b, h) + boff + n * 2048 + k * 1024); } while (0)
#define PG8_MMA(ai, bj, At, Bt) do { __builtin_amdgcn_s_setprio(1); _Pragma("unroll") for (int m = 0; m < 4; ++m) _Pragma("unroll") for (int n = 0; n < 2; ++n) _Pragma("unroll") for (int k = 0; k < 2; ++k) \
        acc[ai][bj][m][n] = __builtin_amdgcn_mfma_f32_16x16x32_bf16(Bt[n][k], At[m][k], acc[ai][bj][m][n], 0, 0, 0); __builtin_amdgcn_s_setprio(0); } while (0)
#define PG8_WAIT_V(n) asm volatile("s_waitcnt vmcnt(" #n ")" ::: "memory")
#define PG8_WAIT_L(n) asm volatile("s_waitcnt lgkmcnt(" #n ")" ::: "memory")
#define PG8_BAR __builtin_amdgcn_s_barrier()
#define PG8_SCHED __builtin_amdgcn_sched_barrier(0)
    Unit cur, nxt; int ui = 0;
    if (!S.next(0, cur)) return;
    f32x4 acc[2][2][4][2];
#pragma unroll
    for (int a = 0; a < 2; ++a)
#pragma unroll
        for (int b = 0; b < 2; ++b)
#pragma unroll
            for (int m = 0; m < 4; ++m)
#pragma unroll
                for (int n = 0; n < 2; ++n) acc[a][b][m][n] = (f32x4){0.f, 0.f, 0.f, 0.f};
    bf16x8 At[4][2], B0[2][2], B1[2][2];
    const char* cA = (const char*)g.A + (size_t)cur.pm * tstep; const char* cB = (const char*)g.Bt + (size_t)cur.pn * tstep;
    S.a_ready(cur);
    PG8_STAGE(PG8_SB(0, 0), cB, voffB); PG8_STAGE(PG8_SA(0, 0), cA, voffA); PG8_STAGE(PG8_SB(0, 1), cB + hstep, voffB); PG8_STAGE(PG8_SA(0, 1), cA + hstep, voffA);
    if (wr == 1) PG8_BAR;
    PG8_WAIT_V(4); PG8_BAR;
    PG8_STAGE(PG8_SB(1, 0), cB + kstep, voffB); PG8_STAGE(PG8_SA(1, 0), cA + kstep, voffA); PG8_STAGE(PG8_SB(1, 1), cB + hstep + kstep, voffB);
    PG8_WAIT_V(6); PG8_BAR;
    for (;;) {
        const bool has_next = S.next(ui + 1, nxt);
        const char* nA = has_next ? (const char*)g.A + (size_t)nxt.pm * tstep : cA; const char* nB = has_next ? (const char*)g.Bt + (size_t)nxt.pn * tstep : cB;
        for (int t = 0; t < nt; t += 2) {
            const bool last = (t == nt - 2);
            const char* a1 = cA + (size_t)(t + 1) * kstep;
            const char* a2 = last ? nA : cA + (size_t)(t + 2) * kstep; const char* b2 = last ? nB : cB + (size_t)(t + 2) * kstep;
            const char* a3 = a2 + kstep; const char* b3 = b2 + kstep;
            if (last && has_next) S.a_ready(nxt);
            PG8_LDB(B0, 0, 0); PG8_SCHED; PG8_LDA(At, 0, 0); PG8_STAGE(PG8_SA(1, 1), a1 + hstep, voffA);
            PG8_WAIT_L(8); PG8_BAR; PG8_WAIT_L(0); PG8_MMA(0, 0, At, B0); PG8_BAR; PG8_SCHED;
            PG8_LDB(B1, 0, 1); PG8_STAGE(PG8_SB(0, 0), b2, voffB);
            PG8_BAR; PG8_WAIT_L(0); PG8_MMA(0, 1, At, B1); PG8_BAR;
            PG8_LDA(At, 0, 1); PG8_STAGE(PG8_SA(0, 0), a2, voffA);
            PG8_BAR; PG8_WAIT_L(0); PG8_MMA(1, 0, At, B0); PG8_BAR; PG8_SCHED;
            PG8_STAGE(PG8_SB(0, 1), b2 + hstep, voffB);
            PG8_WAIT_V(6); PG8_BAR; PG8_MMA(1, 1, At, B1); PG8_BAR;
            PG8_LDB(B0, 1, 0); PG8_SCHED; PG8_LDA(At, 1, 0); PG8_STAGE(PG8_SA(0, 1), a2 + hstep, voffA);
            PG8_WAIT_L(8); PG8_BAR; PG8_WAIT_L(0); PG8_MMA(0, 0, At, B0); PG8_BAR; PG8_SCHED;
            PG8_LDB(B1, 1, 1); PG8_STAGE(PG8_SB(1, 0), b3, voffB);
            PG8_BAR; PG8_WAIT_L(0); PG8_MMA(0, 1, At, B1); PG8_BAR;
            PG8_LDA(At, 1, 1); PG8_STAGE(PG8_SA(1, 0), a3, voffA);
            PG8_BAR; PG8_WAIT_L(0); PG8_MMA(1, 0, At, B0); PG8_BAR; PG8_SCHED;
            PG8_STAGE(PG8_SB(1, 1), b3 + hstep, voffB);
            PG8_WAIT_V(6); PG8_BAR; PG8_MMA(1, 1, At, B1); PG8_BAR;
        }
        if constexpr (!Epi::AFTER_DRAIN) { E(acc, cur, wr, wc, fr, fq); S.done(cur); }
        if (!has_next) break;
#pragma unroll
        for (int a = 0; a < 2; ++a)
#pragma unroll
            for (int b = 0; b < 2; ++b)
#pragma unroll
                for (int m = 0; m < 4; ++m)
#pragma unroll
                    for (int n = 0; n < 2; ++n) acc[a][b][m][n] = (f32x4){0.f, 0.f, 0.f, 0.f};
        cur = nxt; cA = nA; cB = nB; ++ui;
    }
    PG8_WAIT_V(0);
    if (wr == 0) PG8_BAR;
    PG8_BAR;
    if constexpr (Epi::AFTER_DRAIN) { E.fused(acc, cur, wr, wc, fr, fq, lds, wid, lane); S.done(cur); }
#undef PG8_SA
#undef PG8_SB
#undef PG8_STAGE
#undef PG8_LDA
#undef PG8_LDB
#undef PG8_MMA
#undef PG8_WAIT_V
#undef PG8_WAIT_L
#undef PG8_BAR
#undef PG8_SCHED
}
}
constexpr int NWAVES = 8, NTHR = 512;
constexpr int D = 2048, NBATCH = 4, SEQ = 4096, T = NBATCH * SEQ, DEPTH = 2;
constexpr int GLA_H = 4, GLA_DK = 128, GLA_DV = 256, GLA_CH = 64;
constexpr int MLP_H = 8, MLP_DH = 128, MLP_CH = 128;
constexpr int IN_COLS = 5136, NPROJ = 5120;
constexpr int C_Q = 0, C_K = 512, C_V = 1024, C_R = 2048, C_U = 3072, C_VS = 4096;
constexpr int NEXP = 16384, PEER_H = 8;
constexpr float EPS = 1e-6f;
constexpr int MODW = 6 * D;
constexpr size_t MiB = 1u << 20;
constexpr size_t WS_CTL = 0, CTL_ZERO_BYTES = 1 * MiB;
constexpr size_t WS_MOD = 1 * MiB;
constexpr size_t WS_K1B = 2 * MiB, WS_K2B = 2 * MiB + 512 * 1024, WS_WSB = 3 * MiB, WS_DEC = 3 * MiB + 512 * 1024, WS_ALOW = 4 * MiB;
constexpr size_t WS_KU = 5 * MiB, WS_KV = 5 * MiB + 256 * 1024;
constexpr size_t WS_WTIN = 8 * MiB;
constexpr size_t WTIN_L = (size_t)5136 * 2048;
constexpr size_t WS_WTOUT = 49 * MiB, WS_WTQ = 65 * MiB;
constexpr size_t WS_PUB = 81 * MiB, WS_PVB = 209 * MiB;
constexpr size_t WS_H = 337 * MiB;
constexpr size_t WS_PROJ = 401 * MiB;
constexpr size_t WS_SBUF = 561 * MiB;
constexpr size_t WS_CONCAT = 625 * MiB;
constexpr size_t WS_QB = 689 * MiB;
constexpr size_t WS_EB = 753 * MiB, WS_PG = 761 * MiB, WS_END = 769 * MiB;
static_assert(WS_WTIN + 2 * WTIN_L * 2 <= WS_WTOUT, "ws map");
constexpr int CW_BAR = 4096;
constexpr int RING_BYTES = 131072, LDSCTL_OFF = RING_BYTES, MISC_OFF = LDSCTL_OFF + 320, LDS_BYTES = 147456;

#define DI __device__ __forceinline__
#define LAS __attribute__((address_space(3)))
typedef unsigned short bf16;
typedef short bf16x8 __attribute__((ext_vector_type(8)));
typedef short s16x4 __attribute__((ext_vector_type(4)));
typedef short v4i16_t __attribute__((ext_vector_type(4)));
typedef __bf16 bf16x2_t __attribute__((ext_vector_type(2)));
typedef float f32x4 __attribute__((ext_vector_type(4)));
typedef float f32x2 __attribute__((ext_vector_type(2)));
typedef unsigned u32x4 __attribute__((ext_vector_type(4)));
typedef unsigned u32x2 __attribute__((ext_vector_type(2)));
typedef LAS unsigned char* ldsp;

DI unsigned f2bf(float f) { unsigned u = __builtin_bit_cast(unsigned, f); return (u + 0x7fffu + ((u >> 16) & 1u)) >> 16; }
DI unsigned pk2(float lo, float hi) { return f2bf(lo) | (f2bf(hi) << 16); }
DI float bflo(unsigned u) { return __builtin_bit_cast(float, u << 16); }
DI float bfhi(unsigned u) { return __builtin_bit_cast(float, u & 0xffff0000u); }
DI float bf1(bf16 v) { return __builtin_bit_cast(float, ((unsigned)v) << 16); }
DI float fexp2(float x) { return __builtin_amdgcn_exp2f(x); }
DI float flog2(float x) { return __builtin_amdgcn_logf(x); }
DI float frcp(float x) { return __builtin_amdgcn_rcpf(x); }
DI float frsq(float x) { return __builtin_amdgcn_rsqf(x); }
DI float gelu_t(float x) { const float u = 0.7978845608f * (x + 0.044715f * x * x * x); return x * frcp(1.f + fexp2(-2.885390082f * u)); }
DI float silu_f(float x) { return x * frcp(1.f + fexp2(-1.442695041f * x)); }
template <int CTRL> DI float dppf(float v) { return __builtin_bit_cast(float, __builtin_amdgcn_update_dpp(0, __builtin_bit_cast(int, v), CTRL, 0xf, 0xf, true)); }
DI float wave_sum_u(float v) {
    v += dppf<0xB1>(v); v += dppf<0x4E>(v); v += dppf<0x141>(v); v += dppf<0x140>(v);
    const int iv = __builtin_bit_cast(int, v);
    return (__builtin_bit_cast(float, __builtin_amdgcn_readlane(iv, 0)) + __builtin_bit_cast(float, __builtin_amdgcn_readlane(iv, 16))) +
           (__builtin_bit_cast(float, __builtin_amdgcn_readlane(iv, 32)) + __builtin_bit_cast(float, __builtin_amdgcn_readlane(iv, 48)));
}
DI float wave_sum(float v) {
#pragma unroll
    for (int o = 1; o < 64; o <<= 1) v += __shfl_xor(v, o);
    return v;
}
DI float dot2bf(unsigned a, unsigned b, float c) { return __builtin_amdgcn_fdot2_f32_bf16(__builtin_bit_cast(bf16x2_t, a), __builtin_bit_cast(bf16x2_t, b), c, false); }
DI f32x4 mfma16(bf16x8 a, bf16x8 b, f32x4 c) { return __builtin_amdgcn_mfma_f32_16x16x32_bf16(a, b, c, 0, 0, 0); }
DI s16x4 tr4(const LAS bf16* p) { return __builtin_bit_cast(s16x4, __builtin_amdgcn_ds_read_tr16_b64_v4i16((LAS v4i16_t*)p)); }
DI bf16x8 tr8(const LAS bf16* p, int stride) { const s16x4 a = tr4(p), b = tr4(p + 4 * stride); return (bf16x8){a[0], a[1], a[2], a[3], b[0], b[1], b[2], b[3]}; }

#define XB_TMO      128
#define XB_XCNT(j)  (256  + 64 * (j))
#define XB_XSUB(j)  (1280 + 64 * (j))
#define XB_XGEN(j)  (2304 + 64 * (j))
#define XB_TOP      3328
#define XB_TOPGEN   3392
#define XCD_BAR_WORDS 3456
#define XB_SPIN_CAP (1u << 18)

__device__ __forceinline__ unsigned xb_ld(unsigned* p)              { return __hip_atomic_load(p, __ATOMIC_RELAXED, __HIP_MEMORY_SCOPE_AGENT); }
__device__ __forceinline__ unsigned xb_add(unsigned* p, unsigned v) { return __hip_atomic_fetch_add(p, v, __ATOMIC_RELAXED, __HIP_MEMORY_SCOPE_AGENT); }
__device__ __forceinline__ unsigned xb_xcc_id() { return (unsigned)__builtin_amdgcn_s_getreg((3 << 11) | 20) & 0xFu; }
#define XB_SPIN(cond, bar) do { unsigned _sp = 0; while (cond) { __builtin_amdgcn_s_sleep(1); \
    if ((++_sp & 255u) == 0u) { if (xb_ld(&(bar)[XB_TMO])) break; if (_sp > XB_SPIN_CAP) { atomicAdd(&(bar)[XB_TMO], 1u); break; } } } } while (0)

struct XcdBarrier {
    unsigned* bar; unsigned x;
    volatile LAS unsigned* st;
};

__device__ __forceinline__ XcdBarrier xcd_barrier_post(unsigned* bar, volatile LAS unsigned* st) {
    XcdBarrier b; b.bar = bar; b.x = xb_xcc_id(); b.st = st;
    if (threadIdx.x == 0) (void)xb_add(&bar[XB_XCNT(b.x)], 1u);
    return b;
}
__device__ __forceinline__ void xcd_barrier_complete(unsigned* bar, unsigned x, unsigned& nloc, unsigned& nx) {
    const unsigned G = gridDim.x * gridDim.y * gridDim.z;
    unsigned sum, cnt, mine, sp = 0u;
    for (;;) {
        sum = 0u; cnt = 0u; mine = 0u;
#pragma unroll
        for (unsigned j = 0; j < 16; ++j) { const unsigned c = xb_ld(&bar[XB_XCNT(j)]); sum += c; cnt += (c > 0u) ? 1u : 0u; mine = (j == x) ? c : mine; }
        if (sum == G) break;
        __builtin_amdgcn_s_sleep(1);
        if ((++sp & 255u) == 0u) { if (xb_ld(&bar[XB_TMO])) break; if (sp > XB_SPIN_CAP) { atomicAdd(&bar[XB_TMO], 1u); break; } }
    }
    nloc = mine > 0u ? mine : 1u; nx = cnt > 0u ? cnt : 1u;
}

__device__ __forceinline__ void xcd_barrier(const XcdBarrier& b) {
    asm volatile("s_waitcnt vmcnt(0)" ::: "memory");
    __syncthreads();
    if (threadIdx.x == 0) {
        unsigned* bar = b.bar;
        __builtin_amdgcn_s_waitcnt(0);
        unsigned nloc = b.st[0], nx = b.st[1];
        if (nloc == 0u) { xcd_barrier_complete(bar, b.x, nloc, nx); b.st[0] = nloc; b.st[1] = nx; }
        const unsigned old = xb_add(&bar[XB_XSUB(b.x)], 1u);
        const unsigned gen = old / nloc;
        if (old + 1u == (gen + 1u) * nloc) {
            __builtin_amdgcn_fence(__ATOMIC_RELEASE, "agent");
            asm volatile("s_waitcnt vmcnt(0)" ::: "memory");
            const unsigned og = xb_add(&bar[XB_TOP], 1u);
            const unsigned tg = og / nx;
            if (og + 1u == (tg + 1u) * nx) xb_add(&bar[XB_TOPGEN], 1u);
            else XB_SPIN(xb_ld(&bar[XB_TOPGEN]) == tg, bar);
            __builtin_amdgcn_fence(__ATOMIC_ACQUIRE, "agent");
            xb_add(&bar[XB_XGEN(b.x)], 1u);
            asm volatile("s_waitcnt vmcnt(0)" ::: "memory");
        } else {
            XB_SPIN(xb_ld(&bar[XB_XGEN(b.x)]) == gen, bar);
            __builtin_amdgcn_fence(__ATOMIC_ACQUIRE, "agent");
            asm volatile("s_waitcnt vmcnt(0)" ::: "memory");
        }
    }
    __syncthreads();
}
struct Ctx {
    ldsp lds; int tid, lane, wave, bid, G, gw, NGW;
    const float* in[21]; float* out; unsigned char* ws;
};
#define LDS_WAIT() asm volatile("s_waitcnt lgkmcnt(0)" ::: "memory")
enum { I_X = 0, I_C, I_ADAW, I_ADAB, I_N1G, I_WIN, I_WA2, I_BA, I_GNG, I_VNG, I_MWS, I_MB, I_MOG, I_WOUT, I_N2G, I_WQ, I_K1, I_K2, I_PU, I_PV, I_FG };

DI void p0_ada(const Ctx& C) {
    LAS float* red = (LAS float*)C.lds;
    float* MOD = (float*)(C.ws + WS_MOD);
    for (int it = C.bid; it < 192; it += C.G) {
        const int l = it / 96, cg = it % 96, c0 = cg * 128 + C.lane * 2;
        const float* W = C.in[I_ADAW] + (size_t)l * D * MODW + (size_t)(C.wave * 256) * MODW + c0;
        float cv[4][4];
#pragma unroll
        for (int b = 0; b < 4; ++b)
#pragma unroll
            for (int i = 0; i < 4; ++i) cv[b][i] = silu_f(C.in[I_C][b * D + C.wave * 256 + i * 64 + C.lane]);
        float acc[4][2];
#pragma unroll
        for (int b = 0; b < 4; ++b) { acc[b][0] = 0.f; acc[b][1] = 0.f; }
#pragma unroll
        for (int i = 0; i < 4; ++i) {
#pragma unroll 8
            for (int j = 0; j < 64; ++j) {
                const f32x2 w = *(const f32x2*)(W + (size_t)(i * 64 + j) * MODW);
#pragma unroll
                for (int b = 0; b < 4; ++b) { const float s = __builtin_bit_cast(float, __builtin_amdgcn_readlane(__builtin_bit_cast(int, cv[b][i]), j)); acc[b][0] += s * w.x; acc[b][1] += s * w.y; }
            }
        }
#pragma unroll
        for (int b = 0; b < 4; ++b) *(LAS f32x2*)(red + (C.wave * 4 + b) * 128 + C.lane * 2) = (f32x2){acc[b][0], acc[b][1]};
        __syncthreads();
        { const int b = C.tid >> 7, col = C.tid & 127; float s = C.in[I_ADAB][l * MODW + cg * 128 + col];
#pragma unroll
          for (int w = 0; w < 8; ++w) s += red[(w * 4 + b) * 128 + col];
          MOD[(size_t)(l * 4 + b) * MODW + cg * 128 + col] = s; }
        __syncthreads();
    }
}
DI void transpose_item(const float* W, int ldw, int src_col0, int ncols, bf16* WT, int dst_row0, int k0, LAS float* scr, int lane) {
    const int cl = lane & 31;
#pragma unroll 8
    for (int i = 0; i < 32; ++i) { const int kk = 2 * i + (lane >> 5); float v = 0.f; if (cl < ncols) v = W[(size_t)(k0 + kk) * ldw + src_col0 + cl]; scr[kk * 33 + cl] = v; }
    LDS_WAIT();
    const int c = lane & 7;
#pragma unroll
    for (int j = 0; j < 4; ++j) { const int n = (lane >> 3) + 8 * j;
        if (n < ncols) { const LAS float* s = scr + (8 * c) * 33 + n;
            u32x4 o; o.x = pk2(s[0 * 33], s[1 * 33]); o.y = pk2(s[2 * 33], s[3 * 33]); o.z = pk2(s[4 * 33], s[5 * 33]); o.w = pk2(s[6 * 33], s[7 * 33]);
            *(u32x4*)(WT + (size_t)(dst_row0 + n) * 2048 + k0 + 8 * c) = o; } }
    LDS_WAIT();
}
DI void p0_prologue(const Ctx& C) {
    p0_ada(C);
    LAS float* scr = (LAS float*)(C.lds + C.wave * 16384);
    constexpr int PER_L = (161 + 64 + 64) * 32;
    for (int it = C.gw; it < 2 * PER_L; it += C.NGW) {
        const int l = it / PER_L; int r = it % PER_L;
        if (r < 161 * 32) { const int kb = r / 161, nb = r % 161; bf16* WT = (bf16*)(C.ws + WS_WTIN) + (size_t)l * WTIN_L;
            const float* W = C.in[I_WIN] + (size_t)l * D * IN_COLS;
            if (nb < 160) { const int n0 = 32 * nb; transpose_item(W, IN_COLS, n0 + (n0 >= 3072 ? 16 : 0), 32, WT, n0, 64 * kb, scr, C.lane); }
            else transpose_item(W, IN_COLS, 3072, 16, WT, 5120, 64 * kb, scr, C.lane);
            continue; }
        r -= 161 * 32;
        if (r < 2048) { const int kb = r / 64, nb = r % 64; transpose_item(C.in[I_WOUT] + (size_t)l * D * D, D, 32 * nb, 32, (bf16*)(C.ws + WS_WTOUT) + (size_t)l * D * D, 32 * nb, 64 * kb, scr, C.lane); continue; }
        r -= 2048;
        { const int kb = r / 64, nb = r % 64; transpose_item(C.in[I_WQ] + (size_t)l * D * D, D, 32 * nb, 32, (bf16*)(C.ws + WS_WTQ) + (size_t)l * D * D, 32 * nb, 64 * kb, scr, C.lane); }
    }
    const int gt = C.bid * NTHR + C.tid, NT = C.G * NTHR;
    { bf16* K1B = (bf16*)(C.ws + WS_K1B); bf16* K2B = (bf16*)(C.ws + WS_K2B); bf16* WSB = (bf16*)(C.ws + WS_WSB);
      for (int i = gt; i < 262144; i += NT) { K1B[i] = (bf16)f2bf(C.in[I_K1][i]); K2B[i] = (bf16)f2bf(C.in[I_K2][i]);
          const int s = i & 127, t = (i >> 7) & 127; WSB[i] = (s <= t) ? (bf16)f2bf(C.in[I_MWS][i]) : (bf16)0; } }
    { int* KU = (int*)(C.ws + WS_KU); int* KV = (int*)(C.ws + WS_KV);
#pragma unroll 1
      for (int row = C.gw; row < 4 * NEXP; row += C.NGW) {
          const int tb = row >> 15, rr = row & 32767;
          const f32x4* src = (const f32x4*)(C.in[tb ? I_PV : I_PU] + (size_t)rr * D) + C.lane;
          f32x4 v[8]; float mx = 0.f;
#pragma unroll
          for (int j = 0; j < 8; ++j) { v[j] = src[64 * j]; mx = fmaxf(mx, fmaxf(fmaxf(fabsf(v[j].x), fabsf(v[j].y)), fmaxf(fabsf(v[j].z), fabsf(v[j].w)))); }
#pragma unroll
          for (int o = 1; o < 64; o <<= 1) mx = fmaxf(mx, __shfl_xor(mx, o));
          int k = 0;
          if (mx > 0.f) { k = (int)((__builtin_bit_cast(unsigned, 224.0f / mx) >> 23) & 255u) - 127; k = k < -60 ? -60 : (k > 60 ? 60 : k); }
          const float sc = __builtin_bit_cast(float, (unsigned)(k + 127) << 23);
          const int lyr = rr >> 14, ee = rr & 16383;
          unsigned* dst = (unsigned*)(C.ws + (tb ? WS_PVB : WS_PUB) + (size_t)lyr * NEXP * D + (size_t)ee * 256) + C.lane;
#pragma unroll
          for (int j = 0; j < 8; ++j) { int p = 0; p = __builtin_amdgcn_cvt_pk_fp8_f32(v[j].x * sc, v[j].y * sc, p, false); p = __builtin_amdgcn_cvt_pk_fp8_f32(v[j].z * sc, v[j].w * sc, p, true); dst[(size_t)j * (NEXP * 256 / 4)] = (unsigned)p; }
          if (C.lane == 0) (tb ? KV : KU)[rr] = k;
      } }
}
DI void norm_phase(const Ctx& C, const float* X, const float* g, const float* modl, int sh_off, int sc_off, bf16* Hout) {
    const int r0 = C.gw * 8, b = r0 >> 12;
    const f32x4* shp = (const f32x4*)(modl + (size_t)b * MODW + sh_off); const f32x4* scp = (const f32x4*)(modl + (size_t)b * MODW + sc_off);
    f32x4 gm[8], shv[8];
#pragma unroll
    for (int j = 0; j < 8; ++j) { const int idx = 64 * j + C.lane; gm[j] = ((const f32x4*)g)[idx] * (scp[idx] + 1.0f); shv[j] = shp[idx]; }
#pragma unroll 1
    for (int i = 0; i < 8; ++i) {
        const f32x4* xr = (const f32x4*)(X + (size_t)(r0 + i) * D) + C.lane; f32x4 v[8]; float s = 0.f;
#pragma unroll
        for (int j = 0; j < 8; ++j) { v[j] = xr[64 * j]; s += (v[j].x * v[j].x + v[j].y * v[j].y) + (v[j].z * v[j].z + v[j].w * v[j].w); }
        const float rstd = frsq(wave_sum(s) * (1.f / D) + EPS);
        u32x2* o = (u32x2*)(Hout + (size_t)(r0 + i) * D) + C.lane;
#pragma unroll
        for (int j = 0; j < 8; ++j) { const f32x4 y = v[j] * rstd * gm[j] + shv[j]; u32x2 w; w.x = pk2(y.x, y.y); w.y = pk2(y.z, y.w); o[64 * j] = w; }
    }
}
DI void alow_phase(const Ctx& C, const bf16* Hb, const bf16* WtA, float* ALOW) {
    if (C.wave < 4) {
        const int task = C.bid * 4 + C.wave, r0 = task * 16, fr = C.lane & 15, fq = C.lane >> 4;
        const bf16* ap = Hb + (size_t)(r0 + fr) * D + 8 * fq; const bf16* bp = WtA + (size_t)fr * D + 8 * fq;
        f32x4 acc = (f32x4){0.f, 0.f, 0.f, 0.f};
#pragma unroll 8
        for (int ks = 0; ks < 64; ++ks) { const bf16x8 a = *(const bf16x8*)(ap + 32 * ks), b = *(const bf16x8*)(bp + 32 * ks); acc = mfma16(a, b, acc); }
#pragma unroll
        for (int r = 0; r < 4; ++r) ALOW[(size_t)(r0 + 4 * fq + r) * 16 + fr] = acc[r];
    }
}
DI void gla_gates(const Ctx& C, LAS float* al, LAS float* tot, const float* ALOW, const float* wa2, const float* ba, int t0, int h, float (&Gl)[16], float& off, float& gref, float& g63) {
    const int d = C.tid & 127, jg = C.tid >> 7;
    if (C.tid < 256) ((LAS f32x4*)al)[C.tid] = ((const f32x4*)(ALOW + (size_t)t0 * 16))[C.tid];
    float w2[16];
#pragma unroll
    for (int r = 0; r < 16; ++r) w2[r] = wa2[r * 512 + h * 128 + d];
    const float bav = ba[h * 128 + d];
    __syncthreads();
    float run = 0.f;
#pragma unroll
    for (int jj = 0; jj < 16; ++jj) {
        const LAS f32x4* ar = (const LAS f32x4*)(al + (jg * 16 + jj) * 16);
        const f32x4 a0 = ar[0], a1 = ar[1], a2 = ar[2], a3 = ar[3];
        float z = bav;
        z += a0.x * w2[0] + a0.y * w2[1] + a0.z * w2[2] + a0.w * w2[3];
        z += a1.x * w2[4] + a1.y * w2[5] + a1.z * w2[6] + a1.w * w2[7];
        z += a2.x * w2[8] + a2.y * w2[9] + a2.z * w2[10] + a2.w * w2[11];
        z += a3.x * w2[12] + a3.y * w2[13] + a3.z * w2[14] + a3.w * w2[15];
        const float ls = fminf(z, 0.f) - 0.6931471806f * flog2(1.f + fexp2(-1.442695041f * fabsf(z)));
        run += ls * (1.442695041f / 16.f);
        Gl[jj] = run;
    }
    tot[jg * 128 + d] = run;
    __syncthreads();
    const float t0_ = tot[d], t1_ = tot[128 + d], t2_ = tot[256 + d], t3_ = tot[384 + d];
    off = (jg > 0 ? t0_ : 0.f) + (jg > 1 ? t1_ : 0.f) + (jg > 2 ? t2_ : 0.f); gref = t0_ + t1_; g63 = (t0_ + t1_) + (t2_ + t3_);
}
constexpr int KST = 136, VST = 264, PST = 72;
DI void load_v_tile(const Ctx& C, const bf16* PROJ, int t0, int h, LAS bf16* VL) {
#pragma unroll
    for (int i = 0; i < 4; ++i) { const int c = C.tid + 512 * i, j = c >> 5, ec = c & 31;
        *(LAS u32x4*)(VL + j * VST + 8 * ec) = *(const u32x4*)(PROJ + (size_t)(t0 + j) * NPROJ + C_V + h * 256 + 8 * ec); }
}
DI void glaA_item(const Ctx& C, int l, int idx, const bf16* PROJ, const float* ALOW, bf16* SBUF, float* DEC) {
    const int b = idx >> 8, h = (idx >> 6) & 3, n = idx & 63, t0 = b * SEQ + n * 64;
    LAS float* al = (LAS float*)(C.lds); LAS float* tot = (LAS float*)(C.lds + 4096);
    LAS bf16* KD = (LAS bf16*)(C.lds + 8192); LAS bf16* VL = (LAS bf16*)(C.lds + 25600);
    float Gl[16], off, gref, g63;
    gla_gates(C, al, tot, ALOW, C.in[I_WA2] + (size_t)l * 16 * 512, C.in[I_BA] + (size_t)l * 512, t0, h, Gl, off, gref, g63);
    const int d = C.tid & 127, jg = C.tid >> 7;
#pragma unroll
    for (int jj = 0; jj < 16; ++jj) { const int j = jg * 16 + jj; const float kv = bf1(PROJ[(size_t)(t0 + j) * NPROJ + C_K + h * 128 + d]);
        KD[j * KST + d] = (bf16)f2bf(kv * fexp2(g63 - (off + Gl[jj]))); }
    if (jg == 0) DEC[(size_t)idx * 128 + d] = fexp2(g63);
    load_v_tile(C, PROJ, t0, h, VL);
    __syncthreads();
    const int lane = C.lane, g = lane >> 4, qq = (lane & 15) >> 2, p = lane & 3, fr = lane & 15;
    bf16x8 A[2];
#pragma unroll
    for (int ks = 0; ks < 2; ++ks) A[ks] = tr8(KD + (32 * ks + 8 * g + qq) * KST + 16 * C.wave + 4 * p, KST);
    bf16* Sit = SBUF + (size_t)idx * 256 * 128;
#pragma unroll
    for (int half = 0; half < 2; ++half) {
        f32x4 acc[8];
#pragma unroll
        for (int nt = 0; nt < 8; ++nt) acc[nt] = (f32x4){0.f, 0.f, 0.f, 0.f};
#pragma unroll
        for (int nt = 0; nt < 8; ++nt)
#pragma unroll
            for (int ks = 0; ks < 2; ++ks) { const bf16x8 Bf = tr8(VL + (32 * ks + 8 * g + qq) * VST + 16 * (half * 8 + nt) + 4 * p, VST); acc[nt] = mfma16(A[ks], Bf, acc[nt]); }
#pragma unroll
        for (int nt = 0; nt < 8; ++nt) { const int e = 16 * (half * 8 + nt) + fr, dd = 16 * C.wave + 4 * g;
            u32x2 w; w.x = pk2(acc[nt][0], acc[nt][1]); w.y = pk2(acc[nt][2], acc[nt][3]); *(u32x2*)(Sit + (size_t)e * 128 + dd) = w; }
    }
    __syncthreads();
}
DI void scan_phase(const Ctx& C, bf16* SBUF, const float* DEC) {
    const int gt = C.bid * NTHR + C.tid, bh = gt >> 13, rem = gt & 8191, e = rem >> 5, dq = rem & 31;
    u32x2* p = (u32x2*)(SBUF + ((size_t)(bh * 64) * 256 + e) * 128 + 4 * dq);
    const f32x4* dp = (const f32x4*)(DEC + (size_t)(bh * 64) * 128 + 4 * dq);
    f32x4 st = (f32x4){0.f, 0.f, 0.f, 0.f};
#pragma unroll 1
    for (int n0 = 0; n0 < 64; n0 += 8) {
        u32x2 tmp[8]; f32x4 dc[8];
#pragma unroll
        for (int u = 0; u < 8; ++u) { tmp[u] = p[(size_t)(n0 + u) * 8192]; dc[u] = dp[(n0 + u) * 32]; }
#pragma unroll
        for (int u = 0; u < 8; ++u) { u32x2 w; w.x = pk2(st.x, st.y); w.y = pk2(st.z, st.w); p[(size_t)(n0 + u) * 8192] = w;
            st = dc[u] * st + (f32x4){bflo(tmp[u].x), bfhi(tmp[u].x), bflo(tmp[u].y), bfhi(tmp[u].y)}; }
    }
}
DI void glaC_item(const Ctx& C, int l, int idx, const bf16* PROJ, const float* ALOW, const bf16* SBUF, bf16* CONCAT) {
    const int b = idx >> 8, h = (idx >> 6) & 3, n = idx & 63, t0 = b * SEQ + n * 64;
    LAS float* al = (LAS float*)(C.lds); LAS float* tot = (LAS float*)(C.lds + 4096); LAS float* RS = (LAS float*)(C.lds + 6144);
    LAS bf16* QT = (LAS bf16*)(C.lds + 8192); LAS bf16* KT = (LAS bf16*)(C.lds + 25600); LAS bf16* QG = (LAS bf16*)(C.lds + 43008);
    LAS bf16* VL = (LAS bf16*)(C.lds + 60416); LAS bf16* PL = (LAS bf16*)(C.lds + 94208);
    float Gl[16], off, gref, g63;
    gla_gates(C, al, tot, ALOW, C.in[I_WA2] + (size_t)l * 16 * 512, C.in[I_BA] + (size_t)l * 512, t0, h, Gl, off, gref, g63);
    const int d = C.tid & 127, jg = C.tid >> 7;
#pragma unroll
    for (int jj = 0; jj < 16; ++jj) { const int j = jg * 16 + jj; const float Gv = off + Gl[jj];
        const bf16* row = PROJ + (size_t)(t0 + j) * NPROJ + h * 128 + d;
        const float q = bf1(row[C_Q]) * 0.08838834764831845f, k = bf1(row[C_K]);
        QT[j * KST + d] = (bf16)f2bf(q * fexp2(Gv - gref)); KT[j * KST + d] = (bf16)f2bf(k * fexp2(gref - Gv)); QG[j * KST + d] = (bf16)f2bf(q * fexp2(Gv)); }
    load_v_tile(C, PROJ, t0, h, VL);
    __syncthreads();
    const int lane = C.lane, g = lane >> 4, qq = (lane & 15) >> 2, p = lane & 3, fr = lane & 15;
    {
        const int nt = C.wave & 3;
#pragma unroll
        for (int mi = 0; mi < 2; ++mi) { const int mt = 2 * (C.wave >> 2) + mi; f32x4 acc = (f32x4){0.f, 0.f, 0.f, 0.f};
#pragma unroll
            for (int ks = 0; ks < 4; ++ks) { const bf16x8 a = *(const LAS bf16x8*)(KT + (16 * mt + fr) * KST + 32 * ks + 8 * g), bq = *(const LAS bf16x8*)(QT + (16 * nt + fr) * KST + 32 * ks + 8 * g); acc = mfma16(a, bq, acc); }
            const int i = 16 * nt + fr, j0 = 16 * mt + 4 * g;
            const float v0 = (j0 + 0 <= i) ? acc[0] : 0.f, v1 = (j0 + 1 <= i) ? acc[1] : 0.f, v2 = (j0 + 2 <= i) ? acc[2] : 0.f, v3 = (j0 + 3 <= i) ? acc[3] : 0.f;
            u32x2 w; w.x = pk2(v0, v1); w.y = pk2(v2, v3); *(LAS u32x2*)(PL + i * PST + j0) = w; }
    }
    __syncthreads();
    f32x4 acc[2][4];
#pragma unroll
    for (int mi = 0; mi < 2; ++mi)
#pragma unroll
        for (int nt = 0; nt < 4; ++nt) acc[mi][nt] = (f32x4){0.f, 0.f, 0.f, 0.f};
#pragma unroll
    for (int mi = 0; mi < 2; ++mi) { const int mt = 2 * C.wave + mi;
#pragma unroll
        for (int ks = 0; ks < 2; ++ks) { const bf16x8 a = tr8(VL + (32 * ks + 8 * g + qq) * VST + 16 * mt + 4 * p, VST);
#pragma unroll
            for (int nt = 0; nt < 4; ++nt) { const bf16x8 bp = *(const LAS bf16x8*)(PL + (16 * nt + fr) * PST + 32 * ks + 8 * g); acc[mi][nt] = mfma16(a, bp, acc[mi][nt]); } }
        const bf16* Srow = SBUF + ((size_t)idx * 256 + 16 * mt + fr) * 128 + 8 * g;
#pragma unroll
        for (int ks = 0; ks < 4; ++ks) { const bf16x8 a = *(const bf16x8*)(Srow + 32 * ks);
#pragma unroll
            for (int nt = 0; nt < 4; ++nt) { const bf16x8 bq = *(const LAS bf16x8*)(QG + (16 * nt + fr) * KST + 32 * ks + 8 * g); acc[mi][nt] = mfma16(a, bq, acc[mi][nt]); } }
    }
#pragma unroll
    for (int nt = 0; nt < 4; ++nt) { float s = 0.f;
#pragma unroll
        for (int mi = 0; mi < 2; ++mi) s += (acc[mi][nt][0] * acc[mi][nt][0] + acc[mi][nt][1] * acc[mi][nt][1]) + (acc[mi][nt][2] * acc[mi][nt][2] + acc[mi][nt][3] * acc[mi][nt][3]);
        s += __shfl_xor(s, 16); s += __shfl_xor(s, 32);
        if (g == 0) RS[C.wave * 64 + 16 * nt + fr] = s; }
    __syncthreads();
    const float* ng = C.in[I_GNG] + (size_t)(l * 4 + h) * 256;
#pragma unroll
    for (int nt = 0; nt < 4; ++nt) { const int i = 16 * nt + fr; float ts = 0.f;
#pragma unroll
        for (int w = 0; w < 8; ++w) ts += RS[w * 64 + i];
        const float rstd = frsq(ts * (1.f / 256.f) + EPS);
#pragma unroll
        for (int mi = 0; mi < 2; ++mi) { const int e = 16 * (2 * C.wave + mi) + 4 * g;
            const u32x2 rr = *(const u32x2*)(PROJ + (size_t)(t0 + i) * NPROJ + C_R + h * 256 + e); const f32x4 gg = *(const f32x4*)(ng + e);
            const float o0 = acc[mi][nt][0] * rstd * gg.x * silu_f(bflo(rr.x)), o1 = acc[mi][nt][1] * rstd * gg.y * silu_f(bfhi(rr.x));
            const float o2 = acc[mi][nt][2] * rstd * gg.z * silu_f(bflo(rr.y)), o3 = acc[mi][nt][3] * rstd * gg.w * silu_f(bfhi(rr.y));
            u32x2 w; w.x = pk2(o0, o1); w.y = pk2(o2, o3); *(u32x2*)(CONCAT + (size_t)(t0 + i) * D + h * 256 + e) = w; } }
    __syncthreads();
}
constexpr int GST = 136;
DI void gmlp_item(const Ctx& C, int l, int idx, const bf16* PROJ, const bf16* WSB, bf16* CONCAT) {
    const int h = idx & 7, n = (idx >> 3) & 31, b = idx >> 8, t0 = b * SEQ + n * 128;
    LAS bf16* VL2 = (LAS bf16*)(C.lds); LAS bf16* UL = (LAS bf16*)(C.lds + 34816);
    const float* vg = C.in[I_VNG] + (size_t)(l * 8 + h) * 128; const float* og = C.in[I_MOG] + (size_t)(l * 8 + h) * 128; const float* bb = C.in[I_MB] + (size_t)(l * 8 + h) * 128;
#pragma unroll
    for (int i = 0; i < 4; ++i) { const int c = C.tid + 512 * i, t = c >> 4, ch = c & 15;
        const bf16* row = PROJ + (size_t)(t0 + t) * NPROJ + h * 128 + 8 * ch;
        const u32x4 uu = *(const u32x4*)(row + C_U), vv = *(const u32x4*)(row + C_VS);
        float v[8] = {gelu_t(bflo(vv.x)), gelu_t(bfhi(vv.x)), gelu_t(bflo(vv.y)), gelu_t(bfhi(vv.y)), gelu_t(bflo(vv.z)), gelu_t(bfhi(vv.z)), gelu_t(bflo(vv.w)), gelu_t(bfhi(vv.w))};
        float ss = 0.f;
#pragma unroll
        for (int k = 0; k < 8; ++k) ss += v[k] * v[k];
        ss += __shfl_xor(ss, 1); ss += __shfl_xor(ss, 2); ss += __shfl_xor(ss, 4); ss += __shfl_xor(ss, 8);
        const float rstd = frsq(ss * (1.f / 128.f) + EPS);
        const f32x4 g0 = *(const f32x4*)(vg + 8 * ch), g1 = *(const f32x4*)(vg + 8 * ch + 4);
        u32x4 wv; wv.x = pk2(v[0] * rstd * g0.x, v[1] * rstd * g0.y); wv.y = pk2(v[2] * rstd * g0.z, v[3] * rstd * g0.w); wv.z = pk2(v[4] * rstd * g1.x, v[5] * rstd * g1.y); wv.w = pk2(v[6] * rstd * g1.z, v[7] * rstd * g1.w);
        *(LAS u32x4*)(VL2 + t * GST + 8 * ch) = wv;
        u32x4 wu; wu.x = pk2(gelu_t(bflo(uu.x)), gelu_t(bfhi(uu.x))); wu.y = pk2(gelu_t(bflo(uu.y)), gelu_t(bfhi(uu.y))); wu.z = pk2(gelu_t(bflo(uu.z)), gelu_t(bfhi(uu.z))); wu.w = pk2(gelu_t(bflo(uu.w)), gelu_t(bfhi(uu.w)));
        *(LAS u32x4*)(UL + t * GST + 8 * ch) = wu; }
    __syncthreads();
    const int lane = C.lane, g = lane >> 4, qq = (lane & 15) >> 2, p = lane & 3, fr = lane & 15;
    f32x4 acc[8];
#pragma unroll
    for (int mt = 0; mt < 8; ++mt) acc[mt] = (f32x4){0.f, 0.f, 0.f, 0.f};
    const int nks = (C.wave >> 1) + 1;
    const bf16* Wrow = WSB + ((size_t)(l * 8 + h) * 128 + 16 * C.wave + fr) * 128 + 8 * g;
#pragma unroll 1
    for (int ks = 0; ks < nks; ++ks) { const bf16x8 bw = *(const bf16x8*)(Wrow + 32 * ks);
#pragma unroll
        for (int mt = 0; mt < 8; ++mt) { const bf16x8 a = tr8(VL2 + (32 * ks + 8 * g + qq) * GST + 16 * mt + 4 * p, GST); acc[mt] = mfma16(a, bw, acc[mt]); } }
    const int tl = 16 * C.wave + fr; const float bt = bb[tl]; float ss = 0.f;
#pragma unroll
    for (int mt = 0; mt < 8; ++mt) { const u32x2 uu = *(const LAS u32x2*)(UL + tl * GST + 16 * mt + 4 * g);
        acc[mt][0] = bflo(uu.x) * (acc[mt][0] + bt); acc[mt][1] = bfhi(uu.x) * (acc[mt][1] + bt); acc[mt][2] = bflo(uu.y) * (acc[mt][2] + bt); acc[mt][3] = bfhi(uu.y) * (acc[mt][3] + bt);
        ss += (acc[mt][0] * acc[mt][0] + acc[mt][1] * acc[mt][1]) + (acc[mt][2] * acc[mt][2] + acc[mt][3] * acc[mt][3]); }
    ss += __shfl_xor(ss, 16); ss += __shfl_xor(ss, 32);
    const float rstd = frsq(ss * (1.f / 128.f) + EPS);
#pragma unroll
    for (int mt = 0; mt < 8; ++mt) { const f32x4 gg = *(const f32x4*)(og + 16 * mt + 4 * g);
        u32x2 w; w.x = pk2(acc[mt][0] * rstd * gg.x, acc[mt][1] * rstd * gg.y); w.y = pk2(acc[mt][2] * rstd * gg.z, acc[mt][3] * rstd * gg.w);
        *(u32x2*)(CONCAT + (size_t)(t0 + tl) * D + 1024 + h * 128 + 16 * mt + 4 * g) = w; }
    __syncthreads();
}
DI void list_insert(float (&L)[16], float x) {
#pragma unroll
    for (int i = 15; i >= 1; --i) L[i] = __builtin_amdgcn_fmed3f(x, L[i - 1], L[i]);
    L[0] = fmaxf(L[0], x);
}
DI void list_merge_xor(float (&L)[16], int mask) {
    float M[16];
#pragma unroll
    for (int i = 0; i < 16; ++i) M[i] = fmaxf(L[i], __shfl_xor(L[15 - i], mask));
#pragma unroll
    for (int s = 8; s >= 1; s >>= 1)
#pragma unroll
        for (int i = 0; i < 16; ++i) if ((i & s) == 0) { const float hi = fmaxf(M[i], M[i + s]), lo = fminf(M[i], M[i + s]); M[i] = hi; M[i + s] = lo; }
#pragma unroll
    for (int i = 0; i < 16; ++i) L[i] = M[i];
}
DI unsigned fbits(float x) { return __builtin_bit_cast(unsigned, x); }
DI float unp7(float x) { return __builtin_bit_cast(float, __builtin_bit_cast(unsigned, x) & 0xFFFFFF80u); }
constexpr int TKST = 136;
DI void topk_phase(const Ctx& C, int l, const bf16* QB, const bf16* K1B, const bf16* K2B, const int* KU, const int* KV, int* EB, float* PG) {
    LAS bf16* KL = (LAS bf16*)C.lds;
    LAS unsigned* tk = (LAS unsigned*)(C.lds + 2 * 128 * TKST * 2 + C.wave * 2048);
    const int lane = C.lane, fr = lane & 15, fq = lane >> 4, h = C.bid & 7, rank = C.bid >> 3;
#pragma unroll
    for (int i = 0; i < 8; ++i) { const int c = C.tid + 512 * i, tb = c >> 11, row = (c & 2047) >> 4, ch = c & 15;
        *(LAS u32x4*)(KL + (tb * 128 + row) * TKST + 8 * ch) = *(const u32x4*)((tb ? K2B : K1B) + ((size_t)(l * 8 + h) * 128 + row) * 128 + 8 * ch); }
    __syncthreads();
#pragma unroll 1
    for (int it = 0; it < 4; ++it) {
        const int tt0 = rank * 512 + C.wave * 64 + it * 16;
        float L[2][16];
        bf16x8 bq[2][4];
#pragma unroll
        for (int half = 0; half < 2; ++half)
#pragma unroll
            for (int ks = 0; ks < 4; ++ks) bq[half][ks] = *(const bf16x8*)(QB + (size_t)(tt0 + fr) * D + h * 256 + half * 128 + 8 * fq + 32 * ks);
#pragma unroll
        for (int half = 0; half < 2; ++half) {
            f32x4 acc[8];
#pragma unroll
            for (int mt = 0; mt < 8; ++mt) acc[mt] = (f32x4){0.f, 0.f, 0.f, 0.f};
            const LAS bf16* Kb = KL + (half * 128 + fr) * TKST + 8 * fq;
#pragma unroll
            for (int ks = 0; ks < 4; ++ks)
#pragma unroll
                for (int mt = 0; mt < 8; ++mt) { const bf16x8 a = *(const LAS bf16x8*)(Kb + (16 * mt) * TKST + 32 * ks); acc[mt] = mfma16(a, bq[half][ks], acc[mt]); }
#pragma unroll
            for (int i = 0; i < 16; ++i) L[half][i] = __builtin_bit_cast(float, 0xFF800000u);
#pragma unroll
            for (int mt = 0; mt < 8; ++mt)
#pragma unroll
                for (int r = 0; r < 4; ++r) { const unsigned key = (unsigned)(16 * mt + 4 * fq + r);
                    const float sv = acc[mt][r];
                    list_insert(L[half], __builtin_bit_cast(float, (fbits(sv) & 0xFFFFFF80u) | key)); }
            list_merge_xor(L[half], 16); list_merge_xor(L[half], 32);
        }
        if (fq == 0) {
#pragma unroll
            for (int i = 0; i < 16; ++i) { tk[(fr * 2 + 0) * 16 + i] = fbits(L[0][i]); tk[(fr * 2 + 1) * 16 + i] = fbits(L[1][i]); }
        }
        float Cn[16];
#pragma unroll
        for (int i = 0; i < 16; ++i) Cn[i] = __builtin_bit_cast(float, 0xFF800000u);
#pragma unroll
        for (int i = 0; i < 16; ++i)
#pragma unroll
            for (int j = 0; j < 16; ++j) if ((i + 1) * (j + 1) <= 16) {
                const float s = unp7(L[0][i]) + unp7(L[1][j]);
                list_insert(Cn, __builtin_bit_cast(float, (fbits(s) & 0xFFFFFF00u) | (unsigned)(i * 16 + j))); }
        LDS_WAIT();
        float sc[4]; int ex[4];
#pragma unroll
        for (int m = 0; m < 4; ++m) {
            const float ck = fq == 0 ? Cn[m] : (fq == 1 ? Cn[4 + m] : (fq == 2 ? Cn[8 + m] : Cn[12 + m]));
            const unsigned cc = fbits(ck) & 255u;
            const unsigned p1 = tk[(fr * 2 + 0) * 16 + (cc >> 4)], p2 = tk[(fr * 2 + 1) * 16 + (cc & 15u)];
            sc[m] = __builtin_bit_cast(float, p1 & 0xFFFFFF80u) + __builtin_bit_cast(float, p2 & 0xFFFFFF80u);
            ex[m] = (int)((p1 & 127u) * 128u + (p2 & 127u));
        }
        float mx = fmaxf(fmaxf(sc[0], sc[1]), fmaxf(sc[2], sc[3]));
        mx = fmaxf(mx, __shfl_xor(mx, 16)); mx = fmaxf(mx, __shfl_xor(mx, 32));
        float w[4], sum = 0.f;
#pragma unroll
        for (int m = 0; m < 4; ++m) { w[m] = fexp2((sc[m] - mx) * 1.442695041f); sum += w[m]; }
        sum += __shfl_xor(sum, 16); sum += __shfl_xor(sum, 32);
        const float inv = 1.0f / sum;
        const size_t o = (size_t)(tt0 + fr) * 128 + h * 16 + 4 * fq;
#pragma unroll
        for (int m = 0; m < 4; ++m) { const int ku = KU[ex[m]], kv = KV[ex[m]]; w[m] = w[m] * inv * __builtin_bit_cast(float, (unsigned)(127 - kv) << 23); ex[m] |= (127 - ku) << 16; }
        *(int4*)(EB + o) = make_int4(ex[0], ex[1], ex[2], ex[3]);
        *(f32x4*)(PG + o) = (f32x4){w[0], w[1], w[2], w[3]};
        LDS_WAIT();
    }
}
typedef unsigned char fp8_t;
DI void unpack16(const u32x4 q, float (&f)[16]) {
#pragma unroll
    for (int w = 0; w < 4; ++w) { const int dw = (int)q[w]; const f32x2 lo = __builtin_amdgcn_cvt_pk_f32_fp8(dw, false), hi = __builtin_amdgcn_cvt_pk_f32_fp8(dw, true);
        f[4 * w] = lo.x; f[4 * w + 1] = lo.y; f[4 * w + 2] = hi.x; f[4 * w + 3] = hi.y; }
}
DI void peerU_phase(const Ctx& C, const bf16* Hb, const int* EB, const fp8_t* PU8, float* PART) {
    const int x = C.bid & 7, rank = C.bid >> 3, lane = C.lane, g = lane >> 4, i16 = lane & 15;
    const fp8_t* tab = PU8 + (size_t)x * NEXP * 256 + 16 * i16;
    float* part = PART + (size_t)x * T * 128;
    const int tbase = rank * 512 + C.wave * 64;
    const int* ebase = EB + (size_t)tbase * 128 + lane;
    int ep0 = ebase[0], ep1 = ebase[64], ep0n = ebase[128], ep1n = ebase[192];
    u32x4 cur[8], nxt[8];
#pragma unroll
    for (int u = 0; u < 8; ++u) { const int e = __shfl(ep0, 4 * u + g) & 0xFFFF; cur[u] = *(const u32x4*)(tab + (size_t)e * 256); nxt[u] = cur[u]; }
    float hv[16]; float res0 = 0.f, res1 = 0.f;
#pragma unroll
    for (int j = 0; j < 16; ++j) hv[j] = 0.f;
#pragma unroll 1
    for (int s = 0; s < 256; ++s) {
        const int ti = s >> 2, q = s & 3, t = tbase + ti;
        if (q == 0) {
            const u32x4* hp = (const u32x4*)(Hb + (size_t)t * D + 256 * x + 16 * i16); const u32x4 h0 = hp[0], h1 = hp[1];
            hv[0] = bflo(h0.x); hv[1] = bfhi(h0.x); hv[2] = bflo(h0.y); hv[3] = bfhi(h0.y); hv[4] = bflo(h0.z); hv[5] = bfhi(h0.z); hv[6] = bflo(h0.w); hv[7] = bfhi(h0.w);
            hv[8] = bflo(h1.x); hv[9] = bfhi(h1.x); hv[10] = bflo(h1.y); hv[11] = bfhi(h1.y); hv[12] = bflo(h1.z); hv[13] = bfhi(h1.z); hv[14] = bflo(h1.w); hv[15] = bfhi(h1.w);
            res0 = 0.f; res1 = 0.f;
        }
        if (q == 3) { ep0 = ep0n; ep1 = ep1n; if (ti + 2 < 64) { ep0n = ebase[(ti + 2) * 128]; ep1n = ebase[(ti + 2) * 128 + 64]; } }
        if (s + 1 < 256) { const int q1 = (s + 1) & 3; const int sel = q1 < 2 ? ep0 : ep1;
#pragma unroll
            for (int u = 0; u < 8; ++u) { const int e = __shfl(sel, (4 * (8 * q1 + u) + g) & 63) & 0xFFFF; nxt[u] = *(const u32x4*)(tab + (size_t)e * 256); } }
#pragma unroll
        for (int u = 0; u < 8; ++u) { float f[16]; unpack16(cur[u], f); float p = 0.f;
#pragma unroll
            for (int j = 0; j < 16; ++j) p += f[j] * hv[j];
            p += dppf<0xB1>(p); p += dppf<0x4E>(p); p += dppf<0x141>(p); p += dppf<0x140>(p);
            const bool hit = ((8 * q + u) & 15) == i16;
            res0 = (hit && q < 2) ? p : res0; res1 = (hit && q >= 2) ? p : res1;
            __builtin_amdgcn_sched_barrier(0); }
        if (q == 3) { part[(size_t)t * 128 + 4 * i16 + g] = res0; part[(size_t)t * 128 + 64 + 4 * i16 + g] = res1; }
#pragma unroll
        for (int u = 0; u < 8; ++u) cur[u] = nxt[u];
    }
}
DI void peerV_phase(const Ctx& C, const int* EB, const float* PG, const float* PART, const fp8_t* PV8, float* X, const float* gate  ) {
    const int x = C.bid & 7, rank = C.bid >> 3, lane = C.lane, g = lane >> 4, i16 = lane & 15;
    const fp8_t* tab = PV8 + (size_t)x * NEXP * 256 + 16 * i16;
    const int tbase = rank * 512 + C.wave * 64;
    float pr0[8], pr1[8]; int rep0, rep1; float rg0, rg1;
#define PV_LOAD_RAW(tt) do { _Pragma("unroll") for (int xx = 0; xx < 8; ++xx) { const float* pp = PART + ((size_t)xx * T + (tt)) * 128 + lane; pr0[xx] = pp[0]; pr1[xx] = pp[64]; } \
        rep0 = EB[(size_t)(tt) * 128 + lane]; rep1 = EB[(size_t)(tt) * 128 + 64 + lane]; rg0 = PG[(size_t)(tt) * 128 + lane]; rg1 = PG[(size_t)(tt) * 128 + 64 + lane]; } while (0)
#define PV_FINISH(A0, A1, E0, E1) do { const float s0_ = ((pr0[0] + pr0[1]) + (pr0[2] + pr0[3])) + ((pr0[4] + pr0[5]) + (pr0[6] + pr0[7])), s1_ = ((pr1[0] + pr1[1]) + (pr1[2] + pr1[3])) + ((pr1[4] + pr1[5]) + (pr1[6] + pr1[7])); \
        A0 = gelu_t(s0_ * __builtin_bit_cast(float, (unsigned)(rep0 >> 16) << 23)) * rg0; A1 = gelu_t(s1_ * __builtin_bit_cast(float, (unsigned)(rep1 >> 16) << 23)) * rg1; E0 = rep0 & 0xFFFF; E1 = rep1 & 0xFFFF; } while (0)
    float a0, a1, a0n = 0.f, a1n = 0.f; int e0, e1, e0n = 0, e1n = 0;
    PV_LOAD_RAW(tbase); PV_FINISH(a0, a1, e0, e1);
    PV_LOAD_RAW(tbase + 1);
    u32x4 cur[8], nxt[8]; float avc[8], avn[8];
#pragma unroll
    for (int u = 0; u < 8; ++u) { const int src = 4 * u + g; const int e = __shfl(e0, src); avc[u] = __shfl(a0, src); cur[u] = *(const u32x4*)(tab + (size_t)e * 256); nxt[u] = cur[u]; avn[u] = avc[u]; }
    float acc[16];
#pragma unroll
    for (int j = 0; j < 16; ++j) acc[j] = 0.f;
#pragma unroll 1
    for (int s = 0; s < 256; ++s) {
        const int ti = s >> 2, q = s & 3, t = tbase + ti;
        if (q == 2 && ti + 1 < 64) PV_FINISH(a0n, a1n, e0n, e1n);
        if (q == 3) { a0 = a0n; a1 = a1n; e0 = e0n; e1 = e1n; if (ti + 2 < 64) PV_LOAD_RAW(t + 2); }
        if (s + 1 < 256) { const int q1 = (s + 1) & 3; const int esel = q1 < 2 ? e0 : e1; const float asel = q1 < 2 ? a0 : a1;
#pragma unroll
            for (int u = 0; u < 8; ++u) { const int src = (4 * (8 * q1 + u) + g) & 63; const int e = __shfl(esel, src); avn[u] = __shfl(asel, src); nxt[u] = *(const u32x4*)(tab + (size_t)e * 256); } }
#pragma unroll
        for (int u = 0; u < 8; ++u) { float f[16]; unpack16(cur[u], f);
#pragma unroll
            for (int j = 0; j < 16; ++j) acc[j] += avc[u] * f[j];
            __builtin_amdgcn_sched_barrier(0); }
        if (q == 3) {
#pragma unroll
            for (int j = 0; j < 16; ++j) { acc[j] += __shfl_xor(acc[j], 16); acc[j] += __shfl_xor(acc[j], 32); }
            f32x4 y;
            y.x = g == 0 ? acc[0] : (g == 1 ? acc[4] : (g == 2 ? acc[8] : acc[12]));
            y.y = g == 0 ? acc[1] : (g == 1 ? acc[5] : (g == 2 ? acc[9] : acc[13]));
            y.z = g == 0 ? acc[2] : (g == 1 ? acc[6] : (g == 2 ? acc[10] : acc[14]));
            y.w = g == 0 ? acc[3] : (g == 1 ? acc[7] : (g == 2 ? acc[11] : acc[15]));
            const int col = 256 * x + 16 * i16 + 4 * g, b = t >> 12;
            f32x4* xp = (f32x4*)(X + (size_t)t * D + col); const f32x4 gt = *(const f32x4*)(gate + (size_t)b * MODW + col);
#ifndef DBG_NO_PEER
            *xp = *xp + gt * y;
#endif
#pragma unroll
            for (int j = 0; j < 16; ++j) acc[j] = 0.f;
        }
#pragma unroll
        for (int u = 0; u < 8; ++u) { cur[u] = nxt[u]; avc[u] = avn[u]; }
    }
#undef PV_LOAD_RAW
#undef PV_FINISH
}
DI void final_norm_phase(const Ctx& C, float* X, const float* g) {
    const int r0 = C.gw * 8;
    f32x4 gm[8];
#pragma unroll
    for (int j = 0; j < 8; ++j) gm[j] = ((const f32x4*)g)[64 * j + C.lane];
#pragma unroll 1
    for (int i = 0; i < 8; ++i) {
        f32x4* xr = (f32x4*)(X + (size_t)(r0 + i) * D) + C.lane; f32x4 v[8]; float s = 0.f;
#pragma unroll
        for (int j = 0; j < 8; ++j) { v[j] = xr[64 * j]; s += (v[j].x * v[j].x + v[j].y * v[j].y) + (v[j].z * v[j].z + v[j].w * v[j].w); }
        const float rstd = frsq(wave_sum(s) * (1.f / D) + EPS);
#pragma unroll
        for (int j = 0; j < 8; ++j) xr[64 * j] = v[j] * rstd * gm[j];
    }
}
#ifndef PH_MASK
#define PH_MASK 0xFFFFF
#endif
#define EN(k) (((PH_MASK) >> (k)) & 1)
constexpr int NKIND = 11, NPH = 2 + 2 * NKIND;
struct Args { const float* in[21]; float* out; unsigned char* ws; int ph_lo, ph_hi, pad0, pad1; };
__global__ void __launch_bounds__(NTHR, 2) mk_fwd(Args args) {
    extern __shared__ __attribute__((aligned(16))) unsigned char lds_raw[];
    ldsp ldsb = (ldsp)lds_raw;
    volatile LAS unsigned* MISC = (volatile LAS unsigned*)(ldsb + MISC_OFF);
    for (int u = threadIdx.x; u < (LDS_BYTES - LDSCTL_OFF) / 4; u += NTHR) ((LAS unsigned*)(ldsb + LDSCTL_OFF))[u] = 0u;
    __syncthreads();
    unsigned* barw = (unsigned*)(args.ws + WS_CTL) + CW_BAR;
    XcdBarrier bar; bar.bar = barw; bar.x = 0; bar.st = nullptr;
    const bool multi = (args.ph_hi - args.ph_lo) > 1;
    if (multi) bar = xcd_barrier_post(barw, MISC + 8);

    int repflag = 0; (void)repflag;
#pragma unroll 1
    for (int ph = args.ph_lo; ph < args.ph_hi; ++ph) {
#define MKCTX Ctx C; { int tid_ = threadIdx.x, bid_ = blockIdx.x; asm volatile("" : "+v"(tid_)); asm volatile("" : "+s"(bid_)); \
        C.lds = ldsb; C.tid = tid_; C.lane = tid_ & 63; C.wave = __builtin_amdgcn_readfirstlane(tid_ >> 6); C.bid = bid_; C.G = gridDim.x; C.gw = C.bid * NWAVES + C.wave; C.NGW = C.G * NWAVES; \
        _Pragma("unroll") for (int i_ = 0; i_ < 21; ++i_) C.in[i_] = args.in[i_]; C.out = args.out; C.ws = args.ws; }
        unsigned char* const wsb = args.ws;
        float* MOD = (float*)(wsb + WS_MOD);
        bf16* Hb = (bf16*)(wsb + WS_H); bf16* PROJ = (bf16*)(wsb + WS_PROJ); bf16* SBUF = (bf16*)(wsb + WS_SBUF); bf16* CONCAT = (bf16*)(wsb + WS_CONCAT); bf16* QB = (bf16*)(wsb + WS_QB);
        float* ALOW = (float*)(wsb + WS_ALOW); float* DEC = (float*)(wsb + WS_DEC); int* EB = (int*)(wsb + WS_EB); float* PG = (float*)(wsb + WS_PG);
        float* X = args.out;
        const int l = ph < 2 ? 0 : (ph - 2) / NKIND, kind = ph < 2 ? -1 : (ph - 2) % NKIND;
        const float* modl = MOD + (size_t)l * 4 * MODW;
        if (ph == 0) { if (EN(0)) { MKCTX; p0_prologue(C); } }
        else if (ph == 1) { if (EN(1)) { MKCTX; norm_phase(C, C.in[I_X], C.in[I_N1G], modl, 0, D, Hb); } }
        else if ((kind == 0 || kind == 6) && EN(2)) {
            MKCTX; const bool isq = (kind == 6);
            pg8::Gemm g{Hb, isq ? (const bf16*)(wsb + WS_WTQ) + (size_t)l * D * D : (const bf16*)(wsb + WS_WTIN) + (size_t)l * WTIN_L, T, isq ? D : NPROJ, D};
            pg8::StaticOrder S; S.init(T, g.N, C.G, C.bid);
            pg8::EpiBf16 E{isq ? QB : PROJ, isq ? D : NPROJ};
            pg8::gemm_phase<pg8::EpiBf16, pg8::StaticOrder>(C.lds, g, S, E, C.tid);
            if (!isq) alow_phase(C, Hb, (const bf16*)(wsb + WS_WTIN) + (size_t)l * WTIN_L + (size_t)NPROJ * D, ALOW);
        }
        else if (kind == 1 && EN(3)) {
            MKCTX;
#pragma unroll 1
            for (int i = 0; i < 8; ++i) { const int idx = (i >> 1) * C.G + C.bid;
                if (idx < 1024) { if (i & 1) gmlp_item(C, l, idx, PROJ, (const bf16*)(wsb + WS_WSB), CONCAT); else glaA_item(C, l, idx, PROJ, ALOW, SBUF, DEC); } }
        }
        else if (kind == 2) { if (EN(4)) { MKCTX; scan_phase(C, SBUF, DEC); } }
        else if (kind == 3 && EN(5)) {
            MKCTX;
#pragma unroll 1
            for (int idx = C.bid; idx < 1024; idx += C.G) glaC_item(C, l, idx, PROJ, ALOW, SBUF, CONCAT);
        }
        else if (kind == 4 && EN(6)) {
            MKCTX;
            pg8::Gemm g{CONCAT, (const bf16*)(wsb + WS_WTOUT) + (size_t)l * D * D, T, D, D};
            pg8::StaticOrder S; S.init(T, D, C.G, C.bid);
            pg8::EpiResGate E{l == 0 ? C.in[I_X] : (const float*)X, X, modl + 2 * D, MODW};
            pg8::gemm_phase<pg8::EpiResGate, pg8::StaticOrder>(C.lds, g, S, E, C.tid);
        }
        else if (kind == 5) { if (EN(1)) { MKCTX; norm_phase(C, X, C.in[I_N2G] + (size_t)l * D, modl, 3 * D, 4 * D, Hb); } }
        else if (kind == 7) { if (EN(7)) { MKCTX; topk_phase(C, l, QB, (const bf16*)(wsb + WS_K1B), (const bf16*)(wsb + WS_K2B), (const int*)(wsb + WS_KU) + l * NEXP, (const int*)(wsb + WS_KV) + l * NEXP, EB, PG); } }
        else if (kind == 8) { if (EN(8)) { MKCTX; peerU_phase(C, Hb, EB, (const fp8_t*)(wsb + WS_PUB) + (size_t)l * NEXP * D, (float*)SBUF); } }
        else if (kind == 9) { if (EN(9)) { MKCTX; peerV_phase(C, EB, PG, (const float*)SBUF, (const fp8_t*)(wsb + WS_PVB) + (size_t)l * NEXP * D, X, modl + 5 * D); } }
        else if (EN(10)) {
            MKCTX;
            if (l == DEPTH - 1) final_norm_phase(C, X, C.in[I_FG]);
            else norm_phase(C, X, C.in[I_N1G] + (size_t)(l + 1) * D, MOD + (size_t)(l + 1) * 4 * MODW, 0, D, Hb);
        }
        if (ph + 1 < args.ph_hi) xcd_barrier(bar);
#ifdef DBG_REP_MASK
        { const int bit = ph < 2 ? ph : 2 + kind; bool want = ((DBG_REP_MASK) >> bit) & 1;
#ifdef DBG_REP_L0
          if (l != 0) want = false;
#endif
          if (want && !repflag) { repflag = 1; --ph; } else repflag = 0; }
#endif
    }
}

extern "C" void kernel_launch(void* const* d_in, const int* in_sizes, int n_in, void* d_out, int out_size, void* d_ws, size_t ws_size, hipStream_t stream) {
    static int grid = 0;
    if (grid == 0) {
        if (n_in != 21 || out_size != T * D || ws_size < WS_END) { fprintf(stderr, "kernel_launch: unexpected shapes (n_in %d, out %d, ws %zu)\n", n_in, out_size, ws_size); grid = -1; return; }
        int dev = 0, cus = 0, per_cu = 0;
        if (hipGetDevice(&dev) != hipSuccess || hipDeviceGetAttribute(&cus, hipDeviceAttributeMultiprocessorCount, dev) != hipSuccess) { grid = -1; return; }
        if (hipFuncSetAttribute((const void*)mk_fwd, hipFuncAttributeMaxDynamicSharedMemorySize, LDS_BYTES) != hipSuccess) { fprintf(stderr, "kernel_launch: hipFuncSetAttribute failed\n"); grid = -1; return; }
        if (hipOccupancyMaxActiveBlocksPerMultiprocessor(&per_cu, (const void*)mk_fwd, NTHR, LDS_BYTES) != hipSuccess || per_cu < 1) { fprintf(stderr, "kernel_launch: occupancy query says %d blocks per CU\n", per_cu); (void)hipGetLastError(); grid = -1; return; }
        if (cus != 256) { fprintf(stderr, "kernel_launch: built for a 256-CU device (got %d)\n", cus); grid = -1; return; }
        grid = cus;
    }
    if (grid < 0) return;
    (void)hipMemsetAsync((char*)d_ws + WS_CTL, 0, CTL_ZERO_BYTES, stream);
    Args a{};
    for (int i = 0; i < 21; ++i) a.in[i] = (const float*)d_in[i];
    a.out = (float*)d_out; a.ws = (unsigned char*)d_ws;
#if MK_N_LAUNCHES == 1
    a.ph_lo = 0; a.ph_hi = NPH;
    hipLaunchKernelGGL(mk_fwd, dim3(grid), dim3(NTHR), LDS_BYTES, stream, a);
#else
    for (int p = 0; p < NPH; ++p) { a.ph_lo = p; a.ph_hi = p + 1; hipLaunchKernelGGL(mk_fwd, dim3(grid), dim3(NTHR), LDS_BYTES, stream, a); }
#endif
}
```

```cpp
#include <hip/hip_runtime.h>
#include <cstdio>
#include <cstdint>
#ifndef MK_N_LAUNCHES
#define MK_N_LAUNCHES 1
#endif
namespace pg8 {
#define PG8_LAS __attribute__((address_space(3)))
typedef unsigned short bf16_t;
typedef short bf16x8 __attribute__((ext_vector_type(8)));
typedef float f32x4 __attribute__((ext_vector_type(4)));
typedef unsigned u32x4 __attribute__((ext_vector_type(4)));
constexpr int BM = 256, BK = 64, HALF = 128, HTB = HALF * BK * 2  , STAGE_BYTES = 8 * HTB, NXCD = 8, WGM = 8;

__host__ __device__ __forceinline__ int lds_byte(int r, int c) { const int st = (r >> 4) * 2 + (c >> 5), rr = r & 15, cc = c & 31, ob = rr * 64 + cc * 2; return st * 1024 + (ob ^ (((ob >> 9) & 1) << 5)); }
__host__ __device__ __forceinline__ void stage_rc(int b, int& R, int& C) { const int st = b / 1024, sb = b % 1024, swz = sb ^ (((sb >> 9) & 1) << 5); R = (st >> 1) * 16 + swz / 64; C = (st & 1) * 32 + (swz % 64) / 2; }
__host__ __device__ __forceinline__ int perm32(int rho) { const int n = rho >> 4, i = rho & 15; return 8 * (i >> 2) + 4 * n + (i & 3); }

struct Unit { int pm, pn; };
struct Gemm { const bf16_t* A; const bf16_t* Bt; int M, N, K; };

struct StaticOrder {
    int nM, nN, nwg, G, c;
    __host__ __device__ void init(int M, int N, int G_, int c_) { nM = M / BM; nN = N / BM; nwg = nM * nN; G = G_; c = c_; }
    __host__ __device__ bool next(int i, Unit& u) const {
        const long L = (long)i * G + c; if (L >= nwg) return false;
        int wgid = (int)L; { const int q = nwg / NXCD, r = nwg % NXCD, xcd = wgid % NXCD, off = wgid / NXCD; wgid = (xcd < r ? xcd * (q + 1) : r * (q + 1) + (xcd - r) * q) + off; }
        const int nig = WGM * nN, gid = wgid / nig, fm = gid * WGM, gsz = (nM - fm) < WGM ? (nM - fm) : WGM;
        u.pm = fm + ((wgid % nig) % gsz); u.pn = (wgid % nig) / gsz; return true;
    }
    __device__ __forceinline__ void a_ready(const Unit&) const {}
    __device__ __forceinline__ void done(const Unit&) const {}
};
__device__ __forceinline__ unsigned cvt_pk_bf16(float lo, float hi) { unsigned r; asm volatile("v_cvt_pk_bf16_f32 %0, %1, %2" : "=v"(r) : "v"(lo), "v"(hi)); return r; }
struct EpiBf16 {
    static constexpr bool PERM = true, AFTER_DRAIN = false;
    bf16_t* O; int ldc;
    __device__ __forceinline__ void operator()(const f32x4 (&acc)[2][2][4][2], const Unit& u, int wr, int wc, int fr, int fq) const {
        const int row0 = u.pm * BM + wr * 64 + fr; const int col0 = u.pn * BM + wc * 32 + 8 * fq;
#pragma unroll
        for (int ai = 0; ai < 2; ++ai)
#pragma unroll
            for (int m = 0; m < 4; ++m) { bf16_t* rowp = O + (size_t)(row0 + ai * HALF + m * 16) * ldc + col0;
#pragma unroll
                for (int bj = 0; bj < 2; ++bj) { const f32x4 v0 = acc[ai][bj][m][0], v1 = acc[ai][bj][m][1];
                    u32x4 w; w.x = cvt_pk_bf16(v0[0], v0[1]); w.y = cvt_pk_bf16(v0[2], v0[3]); w.z = cvt_pk_bf16(v1[0], v1[1]); w.w = cvt_pk_bf16(v1[2], v1[3]);
                    *(u32x4*)(rowp + bj * HALF) = w; } }
    }
};
struct EpiResGate {
    static constexpr bool PERM = false, AFTER_DRAIN = false;
    const float* base; float* out; const float* gate; int gpitch;
    __device__ __forceinline__ void operator()(const f32x4 (&acc)[2][2][4][2], const Unit& u, int wr, int wc, int fr, int fq) const {
        const int row0 = u.pm * BM + wr * 64 + fr, col0 = u.pn * BM + wc * 32 + 4 * fq;
        const float* gp = gate + (size_t)(u.pm >> 4) * gpitch + col0;
        f32x4 gv[2][2];
#pragma unroll
        for (int bj = 0; bj < 2; ++bj)
#pragma unroll
            for (int n = 0; n < 2; ++n) gv[bj][n] = *(const f32x4*)(gp + bj * HALF + n * 16);
#pragma unroll
        for (int ai = 0; ai < 2; ++ai)
#pragma unroll
            for (int m = 0; m < 4; ++m) { const size_t off = (size_t)(row0 + ai * HALF + m * 16) * 2048 + col0;
#pragma unroll
                for (int bj = 0; bj < 2; ++bj)
#pragma unroll
                    for (int n = 0; n < 2; ++n) { const f32x4 bs = *(const f32x4*)(base + off + bj * HALF + n * 16); *(f32x4*)(out + off + bj * HALF + n * 16) = bs + gv[bj][n] * acc[ai][bj][m][n]; }
                asm volatile("" ::: "memory"); }
    }
};

template <class Epi, class Sched>
__device__ __forceinline__ void gemm_phase(PG8_LAS unsigned char* lds, const Gemm g, const Sched& S, const Epi& E, const int tid  ) {
    const int wid = __builtin_amdgcn_readfirstlane(tid >> 6), lane = tid & 63, wr = wid >> 2, wc = wid & 3, fr = lane & 15, fq = lane >> 4;
    const int K = g.K, nt = K / BK;
    unsigned voffA[2], voffB[2];
#pragma unroll
    for (int i = 0; i < 2; ++i) { int R, C; stage_rc(tid * 16 + i * 8192, R, C); const int Rb = Epi::PERM ? ((R & ~31) + perm32(R & 31)) : R;
        voffA[i] = (unsigned)(R * K + C) * 2u; voffB[i] = (unsigned)(Rb * K + C) * 2u; }
    const size_t kstep = (size_t)(BK * 2);
    const size_t hstep = (size_t)HALF * K * 2;
    const size_t tstep = 2 * hstep;
    const unsigned ldsw = (unsigned)wid * 1024u;
    const int aoff = lds_byte(wr * 64 + fr, fq * 8), boff = lds_byte(wc * 32 + fr, fq * 8);
#define PG8_SA(b, h) (((b) * 2 + (h)) * HTB)
#define PG8_SB(b, h) ((4 + (b) * 2 + (h)) * HTB)
#define PG8_STAGE(bufoff, gbase, voff) do { _Pragma("unroll") for (int _i = 0; _i < 2; ++_i) \
        __builtin_amdgcn_global_load_lds((const unsigned*)((const char*)(gbase) + (voff)[_i]), (PG8_LAS unsigned*)(lds + (bufoff) + ldsw + _i * 8192), 16, 0, 0); } while (0)
#define PG8_LDA(dst, b, h) do { _Pragma("unroll") for (int m = 0; m < 4; ++m) _Pragma("unroll") for (int k = 0; k < 2; ++k) dst[m][k] = *(const PG8_LAS bf16x8*)(lds + PG8_SA(b, h) + aoff + m * 2048 + k * 1024); } while (0)
#define PG8_LDB(dst, b, h) do { _Pragma("unroll") for (int n = 0; n < 2; ++n) _Pragma("unroll") for (int k = 0; k < 2; ++k) dst[n][k] = *(const PG8_LAS bf16x8*)(lds + PG8_SB(b, h) + boff + n * 2048 + k * 1024); } while (0)
#define PG8_MMA(ai, bj, At, Bt) do { __builtin_amdgcn_s_setprio(1); _Pragma("unroll") for (int m = 0; m < 4; ++m) _Pragma("unroll") for (int n = 0; n < 2; ++n) _Pragma("unroll") for (int k = 0; k < 2; ++k) \
        acc[ai][bj][m][n] = __builtin_amdgcn_mfma_f32_16x16x32_bf16(Bt[n][k], At[m][k], acc[ai][bj][m][n], 0, 0, 0); __builtin_amdgcn_s_setprio(0); } while (0)
#define PG8_WAIT_V(n) asm volatile("s_waitcnt vmcnt(" #n ")" ::: "memory")
#define PG8_WAIT_L(n) asm volatile("s_waitcnt lgkmcnt(" #n ")" ::: "memory")
#define PG8_BAR __builtin_amdgcn_s_barrier()
#define PG8_SCHED __builtin_amdgcn_sched_barrier(0)
    Unit cur, nxt; int ui = 0;
    if (!S.next(0, cur)) return;
    f32x4 acc[2][2][4][2];
#pragma unroll
    for (int a = 0; a < 2; ++a)
#pragma unroll
        for (int b = 0; b < 2; ++b)
#pragma unroll
            for (int m = 0; m < 4; ++m)
#pragma unroll
                for (int n = 0; n < 2; ++n) acc[a][b][m][n] = (f32x4){0.f, 0.f, 0.f, 0.f};
    bf16x8 At[4][2], B0[2][2], B1[2][2];
    const char* cA = (const char*)g.A + (size_t)cur.pm * tstep; const char* cB = (const char*)g.Bt + (size_t)cur.pn * tstep;
    S.a_ready(cur);
    PG8_STAGE(PG8_SB(0, 0), cB, voffB); PG8_STAGE(PG8_SA(0, 0), cA, voffA); PG8_STAGE(PG8_SB(0, 1), cB + hstep, voffB); PG8_STAGE(PG8_SA(0, 1), cA + hstep, voffA);
    if (wr == 1) PG8_BAR;
    PG8_WAIT_V(4); PG8_BAR;
    PG8_STAGE(PG8_SB(1, 0), cB + kstep, voffB); PG8_STAGE(PG8_SA(1, 0), cA + kstep, voffA); PG8_STAGE(PG8_SB(1, 1), cB + hstep + kstep, voffB);
    PG8_WAIT_V(6); PG8_BAR;
    for (;;) {
        const bool has_next = S.next(ui + 1, nxt);
        const char* nA = has_next ? (const char*)g.A + (size_t)nxt.pm * tstep : cA; const char* nB = has_next ? (const char*)g.Bt + (size_t)nxt.pn * tstep : cB;
        for (int t = 0; t < nt; t += 2) {
            const bool last = (t == nt - 2);
            const char* a1 = cA + (size_t)(t + 1) * kstep;
            const char* a2 = last ? nA : cA + (size_t)(t + 2) * kstep; const char* b2 = last ? nB : cB + (size_t)(t + 2) * kstep;
            const char* a3 = a2 + kstep; const char* b3 = b2 + kstep;
            if (last && has_next) S.a_ready(nxt);
            PG8_LDB(B0, 0, 0); PG8_SCHED; PG8_LDA(At, 0, 0); PG8_STAGE(PG8_SA(1, 1), a1 + hstep, voffA);
            PG8_WAIT_L(8); PG8_BAR; PG8_WAIT_L(0); PG8_MMA(0, 0, At, B0); PG8_BAR; PG8_SCHED;
            PG8_LDB(B1, 0, 1); PG8_STAGE(PG8_SB(0, 0), b2, voffB);
            PG8_BAR; PG8_WAIT_L(0); PG8_MMA(0, 1, At, B1); PG8_BAR;
            PG8_LDA(At, 0, 1); PG8_STAGE(PG8_SA(0, 0), a2, voffA);
            PG8_BAR; PG8_WAIT_L(0); PG8_MMA(1, 0, At, B0); PG8_BAR; PG8_SCHED;
            PG8_STAGE(PG8_SB(0, 1), b2 + hstep, voffB);
            PG8_WAIT_V(6); PG8_BAR; PG8_MMA(1, 1, At, B1); PG8_BAR;
            PG8_LDB(B0, 1, 0); PG8_SCHED; PG8_LDA(At, 1, 0); PG8_STAGE(PG8_SA(0, 1), a2 + hstep, voffA);
            PG8_WAIT_L(8); PG8_BAR; PG8_WAIT_L(0); PG8_MMA(0, 0, At, B0); PG8_BAR; PG8_SCHED;
            PG8_LDB(B1, 1, 1); PG8_STAGE(PG8_SB(1, 0), b3, voffB);
            PG8_BAR; PG8_WAIT_L(0); PG8_MMA(0, 1, At, B1); PG8_BAR;
            PG8_LDA(At, 1, 1); PG8_STAGE(PG8_SA(1, 0), a3, voffA);
            PG8_BAR; PG8_WAIT_L(0); PG8_MMA(1, 0, At, B0); PG8_BAR; PG8_SCHED;
            PG8_STAGE(PG8_SB(1, 1), b3 + hstep, voffB);
            PG8_WAIT_V(6); PG8_BAR; PG8_MMA(1, 1, At, B1); PG8_BAR;
        }
        if constexpr (!Epi::AFTER_DRAIN) { E(acc, cur, wr, wc, fr, fq); S.done(cur); }
        if (!has_next) break;
#pragma unroll
        for (int a = 0; a < 2; ++a)
#pragma unroll
            for (int b = 0; b < 2; ++b)
#pragma unroll
                for (int m = 0; m < 4; ++m)
#pragma unroll
                    for (int n = 0; n < 2; ++n) acc[a][b][m][n] = (f32x4){0.f, 0.f, 0.f, 0.f};
        cur = nxt; cA = nA; cB = nB; ++ui;
    }
    PG8_WAIT_V(0);
    if (wr == 0) PG8_BAR;
    PG8_BAR;
    if constexpr (Epi::AFTER_DRAIN) { E.fused(acc, cur, wr, wc, fr, fq, lds, wid, lane); S.done(cur); }
#undef PG8_SA
#undef PG8_SB
#undef PG8_STAGE
#undef PG8_LDA
#undef PG8_LDB
#undef PG8_MMA
#undef PG8_WAIT_V
#undef PG8_WAIT_L
#undef PG8_BAR
#undef PG8_SCHED
}
}
constexpr int NWAVES = 8, NTHR = 512;
constexpr int D = 2048, NBATCH = 4, SEQ = 4096, T = NBATCH * SEQ, DEPTH = 2;
constexpr int GLA_H = 4, GLA_DK = 128, GLA_DV = 256, GLA_CH = 64;
constexpr int MLP_H = 8, MLP_DH = 128, MLP_CH = 128;
constexpr int IN_COLS = 5136, NPROJ = 5120;
constexpr int C_Q = 0, C_K = 512, C_V = 1024, C_R = 2048, C_U = 3072, C_VS = 4096;
constexpr int NEXP = 16384, PEER_H = 8;
constexpr float EPS = 1e-6f;
constexpr int MODW = 6 * D;
constexpr size_t MiB = 1u << 20;
constexpr size_t WS_CTL = 0, CTL_ZERO_BYTES = 1 * MiB;
constexpr size_t WS_MOD = 1 * MiB;
constexpr size_t WS_K1B = 2 * MiB, WS_K2B = 2 * MiB + 512 * 1024, WS_WSB = 3 * MiB, WS_DEC = 3 * MiB + 512 * 1024, WS_ALOW = 4 * MiB;
constexpr size_t WS_KU = 5 * MiB, WS_KV = 5 * MiB + 256 * 1024;
constexpr size_t WS_WTIN = 8 * MiB;
constexpr size_t WTIN_L = (size_t)5136 * 2048;
constexpr size_t WS_WTOUT = 49 * MiB, WS_WTQ = 65 * MiB;
constexpr size_t WS_PUB = 81 * MiB, WS_PVB = 209 * MiB;
constexpr size_t WS_H = 337 * MiB;
constexpr size_t WS_PROJ = 401 * MiB;
constexpr size_t WS_SBUF = 561 * MiB;
constexpr size_t WS_CONCAT = 625 * MiB;
constexpr size_t WS_QB = 689 * MiB;
constexpr size_t WS_EB = 753 * MiB, WS_PG = 761 * MiB;
constexpr size_t WS_H8 = 769 * MiB, WS_END = 833 * MiB;
static_assert(WS_WTIN + 2 * WTIN_L * 2 <= WS_WTOUT, "ws map");
constexpr int CW_BAR = 4096;
constexpr int RING_BYTES = 131072, LDSCTL_OFF = RING_BYTES, MISC_OFF = LDSCTL_OFF + 320, LDS_BYTES = 147456;

#define DI __device__ __forceinline__
#define LAS __attribute__((address_space(3)))
typedef unsigned short bf16;
typedef short bf16x8 __attribute__((ext_vector_type(8)));
typedef short s16x4 __attribute__((ext_vector_type(4)));
typedef short v4i16_t __attribute__((ext_vector_type(4)));
typedef __bf16 bf16x2_t __attribute__((ext_vector_type(2)));
typedef float f32x4 __attribute__((ext_vector_type(4)));
typedef float f32x2 __attribute__((ext_vector_type(2)));
typedef unsigned u32x4 __attribute__((ext_vector_type(4)));
typedef unsigned u32x2 __attribute__((ext_vector_type(2)));
typedef LAS unsigned char* ldsp;

DI unsigned f2bf(float f) { unsigned u = __builtin_bit_cast(unsigned, f); return (u + 0x7fffu + ((u >> 16) & 1u)) >> 16; }
DI unsigned pk2(float lo, float hi) { return f2bf(lo) | (f2bf(hi) << 16); }
DI float bflo(unsigned u) { return __builtin_bit_cast(float, u << 16); }
DI float bfhi(unsigned u) { return __builtin_bit_cast(float, u & 0xffff0000u); }
DI float bf1(bf16 v) { return __builtin_bit_cast(float, ((unsigned)v) << 16); }
DI float fexp2(float x) { return __builtin_amdgcn_exp2f(x); }
DI float flog2(float x) { return __builtin_amdgcn_logf(x); }
DI float frcp(float x) { return __builtin_amdgcn_rcpf(x); }
DI float frsq(float x) { return __builtin_amdgcn_rsqf(x); }
DI float gelu_t(float x) { const float u = 0.7978845608f * (x + 0.044715f * x * x * x); return x * frcp(1.f + fexp2(-2.885390082f * u)); }
DI float silu_f(float x) { return x * frcp(1.f + fexp2(-1.442695041f * x)); }
template <int CTRL> DI float dppf(float v) { return __builtin_bit_cast(float, __builtin_amdgcn_update_dpp(0, __builtin_bit_cast(int, v), CTRL, 0xf, 0xf, true)); }
DI float wave_sum_u(float v) {
    v += dppf<0xB1>(v); v += dppf<0x4E>(v); v += dppf<0x141>(v); v += dppf<0x140>(v);
    const int iv = __builtin_bit_cast(int, v);
    return (__builtin_bit_cast(float, __builtin_amdgcn_readlane(iv, 0)) + __builtin_bit_cast(float, __builtin_amdgcn_readlane(iv, 16))) +
           (__builtin_bit_cast(float, __builtin_amdgcn_readlane(iv, 32)) + __builtin_bit_cast(float, __builtin_amdgcn_readlane(iv, 48)));
}
DI float wave_sum(float v) {
#pragma unroll
    for (int o = 1; o < 64; o <<= 1) v += __shfl_xor(v, o);
    return v;
}
DI float dot2bf(unsigned a, unsigned b, float c) { return __builtin_amdgcn_fdot2_f32_bf16(__builtin_bit_cast(bf16x2_t, a), __builtin_bit_cast(bf16x2_t, b), c, false); }
DI f32x4 mfma16(bf16x8 a, bf16x8 b, f32x4 c) { return __builtin_amdgcn_mfma_f32_16x16x32_bf16(a, b, c, 0, 0, 0); }
DI s16x4 tr4(const LAS bf16* p) { return __builtin_bit_cast(s16x4, __builtin_amdgcn_ds_read_tr16_b64_v4i16((LAS v4i16_t*)p)); }
DI bf16x8 tr8(const LAS bf16* p, int stride) { const s16x4 a = tr4(p), b = tr4(p + 4 * stride); return (bf16x8){a[0], a[1], a[2], a[3], b[0], b[1], b[2], b[3]}; }

#define XB_TMO      128
#define XB_XCNT(j)  (256  + 64 * (j))
#define XB_XSUB(j)  (1280 + 64 * (j))
#define XB_XGEN(j)  (2304 + 64 * (j))
#define XB_TOP      3328
#define XB_TOPGEN   3392
#define XCD_BAR_WORDS 3456
#define XB_SPIN_CAP (1u << 18)

__device__ __forceinline__ unsigned xb_ld(unsigned* p)              { return __hip_atomic_load(p, __ATOMIC_RELAXED, __HIP_MEMORY_SCOPE_AGENT); }
__device__ __forceinline__ unsigned xb_add(unsigned* p, unsigned v) { return __hip_atomic_fetch_add(p, v, __ATOMIC_RELAXED, __HIP_MEMORY_SCOPE_AGENT); }
__device__ __forceinline__ unsigned xb_xcc_id() { return (unsigned)__builtin_amdgcn_s_getreg((3 << 11) | 20) & 0xFu; }
#define XB_SPIN(cond, bar) do { unsigned _sp = 0; while (cond) { __builtin_amdgcn_s_sleep(1); \
    if ((++_sp & 255u) == 0u) { if (xb_ld(&(bar)[XB_TMO])) break; if (_sp > XB_SPIN_CAP) { atomicAdd(&(bar)[XB_TMO], 1u); break; } } } } while (0)

struct XcdBarrier {
    unsigned* bar; unsigned x;
    volatile LAS unsigned* st;
};

__device__ __forceinline__ XcdBarrier xcd_barrier_post(unsigned* bar, volatile LAS unsigned* st) {
    XcdBarrier b; b.bar = bar; b.x = xb_xcc_id(); b.st = st;
    if (threadIdx.x == 0) (void)xb_add(&bar[XB_XCNT(b.x)], 1u);
    return b;
}
__device__ __forceinline__ void xcd_barrier_complete(unsigned* bar, unsigned x, unsigned& nloc, unsigned& nx) {
    const unsigned G = gridDim.x * gridDim.y * gridDim.z;
    unsigned sum, cnt, mine, sp = 0u;
    for (;;) {
        sum = 0u; cnt = 0u; mine = 0u;
#pragma unroll
        for (unsigned j = 0; j < 16; ++j) { const unsigned c = xb_ld(&bar[XB_XCNT(j)]); sum += c; cnt += (c > 0u) ? 1u : 0u; mine = (j == x) ? c : mine; }
        if (sum == G) break;
        __builtin_amdgcn_s_sleep(1);
        if ((++sp & 255u) == 0u) { if (xb_ld(&bar[XB_TMO])) break; if (sp > XB_SPIN_CAP) { atomicAdd(&bar[XB_TMO], 1u); break; } }
    }
    nloc = mine > 0u ? mine : 1u; nx = cnt > 0u ? cnt : 1u;
}

__device__ __forceinline__ void xcd_barrier(const XcdBarrier& b) {
    asm volatile("s_waitcnt vmcnt(0)" ::: "memory");
    __syncthreads();
    if (threadIdx.x == 0) {
        unsigned* bar = b.bar;
        __builtin_amdgcn_s_waitcnt(0);
        unsigned nloc = b.st[0], nx = b.st[1];
        if (nloc == 0u) { xcd_barrier_complete(bar, b.x, nloc, nx); b.st[0] = nloc; b.st[1] = nx; }
        const unsigned old = xb_add(&bar[XB_XSUB(b.x)], 1u);
        const unsigned gen = old / nloc;
        if (old + 1u == (gen + 1u) * nloc) {
            __builtin_amdgcn_fence(__ATOMIC_RELEASE, "agent");
            asm volatile("s_waitcnt vmcnt(0)" ::: "memory");
            const unsigned og = xb_add(&bar[XB_TOP], 1u);
            const unsigned tg = og / nx;
            if (og + 1u == (tg + 1u) * nx) xb_add(&bar[XB_TOPGEN], 1u);
            else XB_SPIN(xb_ld(&bar[XB_TOPGEN]) == tg, bar);
            __builtin_amdgcn_fence(__ATOMIC_ACQUIRE, "agent");
            xb_add(&bar[XB_XGEN(b.x)], 1u);
            asm volatile("s_waitcnt vmcnt(0)" ::: "memory");
        } else {
            XB_SPIN(xb_ld(&bar[XB_XGEN(b.x)]) == gen, bar);
            __builtin_amdgcn_fence(__ATOMIC_ACQUIRE, "agent");
            asm volatile("s_waitcnt vmcnt(0)" ::: "memory");
        }
    }
    __syncthreads();
}
struct Ctx {
    ldsp lds; int tid, lane, wave, bid, G, gw, NGW;
    const float* in[21]; float* out; unsigned char* ws;
};
#define LDS_WAIT() asm volatile("s_waitcnt lgkmcnt(0)" ::: "memory")
enum { I_X = 0, I_C, I_ADAW, I_ADAB, I_N1G, I_WIN, I_WA2, I_BA, I_GNG, I_VNG, I_MWS, I_MB, I_MOG, I_WOUT, I_N2G, I_WQ, I_K1, I_K2, I_PU, I_PV, I_FG };

DI void p0_ada(const Ctx& C) {
    LAS float* red = (LAS float*)C.lds;
    float* MOD = (float*)(C.ws + WS_MOD);
    for (int it = C.bid; it < 192; it += C.G) {
        const int l = it / 96, cg = it % 96, c0 = cg * 128 + C.lane * 2;
        const float* W = C.in[I_ADAW] + (size_t)l * D * MODW + (size_t)(C.wave * 256) * MODW + c0;
        float cv[4][4];
#pragma unroll
        for (int b = 0; b < 4; ++b)
#pragma unroll
            for (int i = 0; i < 4; ++i) cv[b][i] = silu_f(C.in[I_C][b * D + C.wave * 256 + i * 64 + C.lane]);
        float acc[4][2];
#pragma unroll
        for (int b = 0; b < 4; ++b) { acc[b][0] = 0.f; acc[b][1] = 0.f; }
#pragma unroll
        for (int i = 0; i < 4; ++i) {
#pragma unroll 8
            for (int j = 0; j < 64; ++j) {
                const f32x2 w = *(const f32x2*)(W + (size_t)(i * 64 + j) * MODW);
#pragma unroll
                for (int b = 0; b < 4; ++b) { const float s = __builtin_bit_cast(float, __builtin_amdgcn_readlane(__builtin_bit_cast(int, cv[b][i]), j)); acc[b][0] += s * w.x; acc[b][1] += s * w.y; }
            }
        }
#pragma unroll
        for (int b = 0; b < 4; ++b) *(LAS f32x2*)(red + (C.wave * 4 + b) * 128 + C.lane * 2) = (f32x2){acc[b][0], acc[b][1]};
        __syncthreads();
        { const int b = C.tid >> 7, col = C.tid & 127; float s = C.in[I_ADAB][l * MODW + cg * 128 + col];
#pragma unroll
          for (int w = 0; w < 8; ++w) s += red[(w * 4 + b) * 128 + col];
          MOD[(size_t)(l * 4 + b) * MODW + cg * 128 + col] = s; }
        __syncthreads();
    }
}
DI void transpose_item(const float* W, int ldw, int src_col0, int ncols, bf16* WT, int dst_row0, int k0, LAS float* scr, int lane) {
    const int cl = lane & 31;
#pragma unroll 8
    for (int i = 0; i < 32; ++i) { const int kk = 2 * i + (lane >> 5); float v = 0.f; if (cl < ncols) v = W[(size_t)(k0 + kk) * ldw + src_col0 + cl]; scr[kk * 33 + cl] = v; }
    LDS_WAIT();
    const int c = lane & 7;
#pragma unroll
    for (int j = 0; j < 4; ++j) { const int n = (lane >> 3) + 8 * j;
        if (n < ncols) { const LAS float* s = scr + (8 * c) * 33 + n;
            u32x4 o; o.x = pk2(s[0 * 33], s[1 * 33]); o.y = pk2(s[2 * 33], s[3 * 33]); o.z = pk2(s[4 * 33], s[5 * 33]); o.w = pk2(s[6 * 33], s[7 * 33]);
            *(u32x4*)(WT + (size_t)(dst_row0 + n) * 2048 + k0 + 8 * c) = o; } }
    LDS_WAIT();
}
DI void p0_prologue(const Ctx& C) {
    p0_ada(C);
    LAS float* scr = (LAS float*)(C.lds + C.wave * 16384);
    constexpr int PER_L = (161 + 64 + 64) * 32;
    for (int it = C.gw; it < 2 * PER_L; it += C.NGW) {
        const int l = it / PER_L; int r = it % PER_L;
        if (r < 161 * 32) { const int kb = r / 161, nb = r % 161; bf16* WT = (bf16*)(C.ws + WS_WTIN) + (size_t)l * WTIN_L;
            const float* W = C.in[I_WIN] + (size_t)l * D * IN_COLS;
            if (nb < 160) { const int n0 = 32 * nb; transpose_item(W, IN_COLS, n0 + (n0 >= 3072 ? 16 : 0), 32, WT, n0, 64 * kb, scr, C.lane); }
            else transpose_item(W, IN_COLS, 3072, 16, WT, 5120, 64 * kb, scr, C.lane);
            continue; }
        r -= 161 * 32;
        if (r < 2048) { const int kb = r / 64, nb = r % 64; transpose_item(C.in[I_WOUT] + (size_t)l * D * D, D, 32 * nb, 32, (bf16*)(C.ws + WS_WTOUT) + (size_t)l * D * D, 32 * nb, 64 * kb, scr, C.lane); continue; }
        r -= 2048;
        { const int kb = r / 64, nb = r % 64; transpose_item(C.in[I_WQ] + (size_t)l * D * D, D, 32 * nb, 32, (bf16*)(C.ws + WS_WTQ) + (size_t)l * D * D, 32 * nb, 64 * kb, scr, C.lane); }
    }
    const int gt = C.bid * NTHR + C.tid, NT = C.G * NTHR;
    { bf16* K1B = (bf16*)(C.ws + WS_K1B); bf16* K2B = (bf16*)(C.ws + WS_K2B); bf16* WSB = (bf16*)(C.ws + WS_WSB);
      for (int i = gt; i < 262144; i += NT) { K1B[i] = (bf16)f2bf(C.in[I_K1][i]); K2B[i] = (bf16)f2bf(C.in[I_K2][i]);
          const int s = i & 127, t = (i >> 7) & 127; WSB[i] = (s <= t) ? (bf16)f2bf(C.in[I_MWS][i]) : (bf16)0; } }
    { int* KU = (int*)(C.ws + WS_KU); int* KV = (int*)(C.ws + WS_KV);
#pragma unroll 1
      for (int row = C.gw; row < 4 * NEXP; row += C.NGW) {
          const int tb = row >> 15, rr = row & 32767;
          const f32x4* src = (const f32x4*)(C.in[tb ? I_PV : I_PU] + (size_t)rr * D) + C.lane;
          f32x4 v[8]; float mx = 0.f;
#pragma unroll
          for (int j = 0; j < 8; ++j) { v[j] = src[64 * j]; mx = fmaxf(mx, fmaxf(fmaxf(fabsf(v[j].x), fabsf(v[j].y)), fmaxf(fabsf(v[j].z), fabsf(v[j].w)))); }
#pragma unroll
          for (int o = 1; o < 64; o <<= 1) mx = fmaxf(mx, __shfl_xor(mx, o));
          int k = 0;
          if (mx > 0.f) { k = (int)((__builtin_bit_cast(unsigned, 224.0f / mx) >> 23) & 255u) - 127; k = k < -60 ? -60 : (k > 60 ? 60 : k); }
          const float sc = __builtin_bit_cast(float, (unsigned)(k + 127) << 23);
          const int lyr = rr >> 14, ee = rr & 16383;
          unsigned* dst = (unsigned*)(C.ws + (tb ? WS_PVB : WS_PUB) + (size_t)lyr * NEXP * D + (size_t)ee * 256) + C.lane;
#pragma unroll
          for (int j = 0; j < 8; ++j) { int p = 0; p = __builtin_amdgcn_cvt_pk_fp8_f32(v[j].x * sc, v[j].y * sc, p, false); p = __builtin_amdgcn_cvt_pk_fp8_f32(v[j].z * sc, v[j].w * sc, p, true); dst[(size_t)j * (NEXP * 256 / 4)] = (unsigned)p; }
          if (C.lane == 0) (tb ? KV : KU)[rr] = k;
      } }
}
template <bool FP8 = false>
DI void norm_phase(const Ctx& C, const float* X, const float* g, const float* modl, int sh_off, int sc_off, bf16* Hout, unsigned char* H8 = nullptr) {
    const int r0 = C.gw * 8, b = r0 >> 12;
    const f32x4* shp = (const f32x4*)(modl + (size_t)b * MODW + sh_off); const f32x4* scp = (const f32x4*)(modl + (size_t)b * MODW + sc_off);
    f32x4 gm[8], shv[8];
#pragma unroll
    for (int j = 0; j < 8; ++j) { const int idx = 64 * j + C.lane; gm[j] = ((const f32x4*)g)[idx] * (scp[idx] + 1.0f); shv[j] = shp[idx]; }
#pragma unroll 1
    for (int i = 0; i < 8; ++i) {
        const f32x4* xr = (const f32x4*)(X + (size_t)(r0 + i) * D) + C.lane; f32x4 v[8]; float s = 0.f;
#pragma unroll
        for (int j = 0; j < 8; ++j) { v[j] = xr[64 * j]; s += (v[j].x * v[j].x + v[j].y * v[j].y) + (v[j].z * v[j].z + v[j].w * v[j].w); }
        const float rstd = frsq(wave_sum(s) * (1.f / D) + EPS);
        u32x2* o = (u32x2*)(Hout + (size_t)(r0 + i) * D) + C.lane;
#pragma unroll
        for (int j = 0; j < 8; ++j) { const f32x4 y = v[j] * rstd * gm[j] + shv[j]; u32x2 w; w.x = pk2(y.x, y.y); w.y = pk2(y.z, y.w); o[64 * j] = w;
            if (FP8) {
                const f32x4 ys = y * 16.0f; int ph = 0; ph = __builtin_amdgcn_cvt_pk_fp8_f32(ys.x, ys.y, ph, false); ph = __builtin_amdgcn_cvt_pk_fp8_f32(ys.z, ys.w, ph, true);
                const f32x2 b0 = __builtin_amdgcn_cvt_pk_f32_fp8(ph, false), b1 = __builtin_amdgcn_cvt_pk_f32_fp8(ph, true);
                int pl = 0; pl = __builtin_amdgcn_cvt_pk_fp8_f32((ys.x - b0.x) * 16.0f, (ys.y - b0.y) * 16.0f, pl, false); pl = __builtin_amdgcn_cvt_pk_fp8_f32((ys.z - b1.x) * 16.0f, (ys.w - b1.y) * 16.0f, pl, true);
                unsigned* h8 = (unsigned*)(H8 + (size_t)(r0 + i) * 4096) + C.lane; h8[64 * j] = (unsigned)ph; h8[512 + 64 * j] = (unsigned)pl; } }
    }
}
DI void alow_phase(const Ctx& C, const bf16* Hb, const bf16* WtA, float* ALOW) {
    if (C.wave < 4) {
        const int task = C.bid * 4 + C.wave, r0 = task * 16, fr = C.lane & 15, fq = C.lane >> 4;
        const bf16* ap = Hb + (size_t)(r0 + fr) * D + 8 * fq; const bf16* bp = WtA + (size_t)fr * D + 8 * fq;
        f32x4 acc = (f32x4){0.f, 0.f, 0.f, 0.f};
#pragma unroll 8
        for (int ks = 0; ks < 64; ++ks) { const bf16x8 a = *(const bf16x8*)(ap + 32 * ks), b = *(const bf16x8*)(bp + 32 * ks); acc = mfma16(a, b, acc); }
#pragma unroll
        for (int r = 0; r < 4; ++r) ALOW[(size_t)(r0 + 4 * fq + r) * 16 + fr] = acc[r];
    }
}
DI void gla_gates(const Ctx& C, LAS float* al, LAS float* tot, const float* ALOW, const float* wa2, const float* ba, int t0, int h, float (&Gl)[16], float& off, float& gref, float& g63) {
    const int d = C.tid & 127, jg = C.tid >> 7;
    if (C.tid < 256) ((LAS f32x4*)al)[C.tid] = ((const f32x4*)(ALOW + (size_t)t0 * 16))[C.tid];
    float w2[16];
#pragma unroll
    for (int r = 0; r < 16; ++r) w2[r] = wa2[r * 512 + h * 128 + d];
    const float bav = ba[h * 128 + d];
    __syncthreads();
    float run = 0.f;
#pragma unroll
    for (int jj = 0; jj < 16; ++jj) {
        const LAS f32x4* ar = (const LAS f32x4*)(al + (jg * 16 + jj) * 16);
        const f32x4 a0 = ar[0], a1 = ar[1], a2 = ar[2], a3 = ar[3];
        float z = bav;
        z += a0.x * w2[0] + a0.y * w2[1] + a0.z * w2[2] + a0.w * w2[3];
        z += a1.x * w2[4] + a1.y * w2[5] + a1.z * w2[6] + a1.w * w2[7];
        z += a2.x * w2[8] + a2.y * w2[9] + a2.z * w2[10] + a2.w * w2[11];
        z += a3.x * w2[12] + a3.y * w2[13] + a3.z * w2[14] + a3.w * w2[15];
        const float ls = fminf(z, 0.f) - 0.6931471806f * flog2(1.f + fexp2(-1.442695041f * fabsf(z)));
        run += ls * (1.442695041f / 16.f);
        Gl[jj] = run;
    }
    tot[jg * 128 + d] = run;
    __syncthreads();
    const float t0_ = tot[d], t1_ = tot[128 + d], t2_ = tot[256 + d], t3_ = tot[384 + d];
    off = (jg > 0 ? t0_ : 0.f) + (jg > 1 ? t1_ : 0.f) + (jg > 2 ? t2_ : 0.f); gref = t0_ + t1_; g63 = (t0_ + t1_) + (t2_ + t3_);
}
constexpr int KST = 136, VST = 264, PST = 72;
DI void load_v_tile(const Ctx& C, const bf16* PROJ, int t0, int h, LAS bf16* VL) {
#pragma unroll
    for (int i = 0; i < 4; ++i) { const int c = C.tid + 512 * i, j = c >> 5, ec = c & 31;
        *(LAS u32x4*)(VL + j * VST + 8 * ec) = *(const u32x4*)(PROJ + (size_t)(t0 + j) * NPROJ + C_V + h * 256 + 8 * ec); }
}
DI void glaA_item(const Ctx& C, int l, int idx, const bf16* PROJ, const float* ALOW, bf16* SBUF, float* DEC) {
    const int b = idx >> 8, h = (idx >> 6) & 3, n = idx & 63, t0 = b * SEQ + n * 64;
    LAS float* al = (LAS float*)(C.lds); LAS float* tot = (LAS float*)(C.lds + 4096);
    LAS bf16* KD = (LAS bf16*)(C.lds + 8192); LAS bf16* VL = (LAS bf16*)(C.lds + 25600);
    float Gl[16], off, gref, g63;
    gla_gates(C, al, tot, ALOW, C.in[I_WA2] + (size_t)l * 16 * 512, C.in[I_BA] + (size_t)l * 512, t0, h, Gl, off, gref, g63);
    const int d = C.tid & 127, jg = C.tid >> 7;
#pragma unroll
    for (int jj = 0; jj < 16; ++jj) { const int j = jg * 16 + jj; const float kv = bf1(PROJ[(size_t)(t0 + j) * NPROJ + C_K + h * 128 + d]);
        KD[j * KST + d] = (bf16)f2bf(kv * fexp2(g63 - (off + Gl[jj]))); }
    if (jg == 0) DEC[(size_t)idx * 128 + d] = fexp2(g63);
    load_v_tile(C, PROJ, t0, h, VL);
    __syncthreads();
    const int lane = C.lane, g = lane >> 4, qq = (lane & 15) >> 2, p = lane & 3, fr = lane & 15;
    bf16x8 A[2];
#pragma unroll
    for (int ks = 0; ks < 2; ++ks) A[ks] = tr8(KD + (32 * ks + 8 * g + qq) * KST + 16 * C.wave + 4 * p, KST);
    bf16* Sit = SBUF + (size_t)idx * 256 * 128;
#pragma unroll
    for (int half = 0; half < 2; ++half) {
        f32x4 acc[8];
#pragma unroll
        for (int nt = 0; nt < 8; ++nt) acc[nt] = (f32x4){0.f, 0.f, 0.f, 0.f};
#pragma unroll
        for (int nt = 0; nt < 8; ++nt)
#pragma unroll
            for (int ks = 0; ks < 2; ++ks) { const bf16x8 Bf = tr8(VL + (32 * ks + 8 * g + qq) * VST + 16 * (half * 8 + nt) + 4 * p, VST); acc[nt] = mfma16(A[ks], Bf, acc[nt]); }
#pragma unroll
        for (int nt = 0; nt < 8; ++nt) { const int e = 16 * (half * 8 + nt) + fr, dd = 16 * C.wave + 4 * g;
            u32x2 w; w.x = pk2(acc[nt][0], acc[nt][1]); w.y = pk2(acc[nt][2], acc[nt][3]); *(u32x2*)(Sit + (size_t)e * 128 + dd) = w; }
    }
    __syncthreads();
}
DI void scan_phase(const Ctx& C, bf16* SBUF, const float* DEC) {
    const int gt = C.bid * NTHR + C.tid, bh = gt >> 13, rem = gt & 8191, e = rem >> 5, dq = rem & 31;
    u32x2* p = (u32x2*)(SBUF + ((size_t)(bh * 64) * 256 + e) * 128 + 4 * dq);
    const f32x4* dp = (const f32x4*)(DEC + (size_t)(bh * 64) * 128 + 4 * dq);
    f32x4 st = (f32x4){0.f, 0.f, 0.f, 0.f};
#pragma unroll 1
    for (int n0 = 0; n0 < 64; n0 += 8) {
        u32x2 tmp[8]; f32x4 dc[8];
#pragma unroll
        for (int u = 0; u < 8; ++u) { tmp[u] = p[(size_t)(n0 + u) * 8192]; dc[u] = dp[(n0 + u) * 32]; }
#pragma unroll
        for (int u = 0; u < 8; ++u) { u32x2 w; w.x = pk2(st.x, st.y); w.y = pk2(st.z, st.w); p[(size_t)(n0 + u) * 8192] = w;
            st = dc[u] * st + (f32x4){bflo(tmp[u].x), bfhi(tmp[u].x), bflo(tmp[u].y), bfhi(tmp[u].y)}; }
    }
}
DI void glaC_item(const Ctx& C, int l, int idx, const bf16* PROJ, const float* ALOW, const bf16* SBUF, bf16* CONCAT) {
    const int b = idx >> 8, h = (idx >> 6) & 3, n = idx & 63, t0 = b * SEQ + n * 64;
    LAS float* al = (LAS float*)(C.lds); LAS float* tot = (LAS float*)(C.lds + 4096); LAS float* RS = (LAS float*)(C.lds + 6144);
    LAS bf16* QT = (LAS bf16*)(C.lds + 8192); LAS bf16* KT = (LAS bf16*)(C.lds + 25600); LAS bf16* QG = (LAS bf16*)(C.lds + 43008);
    LAS bf16* VL = (LAS bf16*)(C.lds + 60416); LAS bf16* PL = (LAS bf16*)(C.lds + 94208);
    float Gl[16], off, gref, g63;
    gla_gates(C, al, tot, ALOW, C.in[I_WA2] + (size_t)l * 16 * 512, C.in[I_BA] + (size_t)l * 512, t0, h, Gl, off, gref, g63);
    const int d = C.tid & 127, jg = C.tid >> 7;
#pragma unroll
    for (int jj = 0; jj < 16; ++jj) { const int j = jg * 16 + jj; const float Gv = off + Gl[jj];
        const bf16* row = PROJ + (size_t)(t0 + j) * NPROJ + h * 128 + d;
        const float q = bf1(row[C_Q]) * 0.08838834764831845f, k = bf1(row[C_K]);
        QT[j * KST + d] = (bf16)f2bf(q * fexp2(Gv - gref)); KT[j * KST + d] = (bf16)f2bf(k * fexp2(gref - Gv)); QG[j * KST + d] = (bf16)f2bf(q * fexp2(Gv)); }
    load_v_tile(C, PROJ, t0, h, VL);
    __syncthreads();
    const int lane = C.lane, g = lane >> 4, qq = (lane & 15) >> 2, p = lane & 3, fr = lane & 15;
    {
        const int nt = C.wave & 3;
#pragma unroll
        for (int mi = 0; mi < 2; ++mi) { const int mt = 2 * (C.wave >> 2) + mi; f32x4 acc = (f32x4){0.f, 0.f, 0.f, 0.f};
#pragma unroll
            for (int ks = 0; ks < 4; ++ks) { const bf16x8 a = *(const LAS bf16x8*)(KT + (16 * mt + fr) * KST + 32 * ks + 8 * g), bq = *(const LAS bf16x8*)(QT + (16 * nt + fr) * KST + 32 * ks + 8 * g); acc = mfma16(a, bq, acc); }
            const int i = 16 * nt + fr, j0 = 16 * mt + 4 * g;
            const float v0 = (j0 + 0 <= i) ? acc[0] : 0.f, v1 = (j0 + 1 <= i) ? acc[1] : 0.f, v2 = (j0 + 2 <= i) ? acc[2] : 0.f, v3 = (j0 + 3 <= i) ? acc[3] : 0.f;
            u32x2 w; w.x = pk2(v0, v1); w.y = pk2(v2, v3); *(LAS u32x2*)(PL + i * PST + j0) = w; }
    }
    __syncthreads();
    f32x4 acc[2][4];
#pragma unroll
    for (int mi = 0; mi < 2; ++mi)
#pragma unroll
        for (int nt = 0; nt < 4; ++nt) acc[mi][nt] = (f32x4){0.f, 0.f, 0.f, 0.f};
#pragma unroll
    for (int mi = 0; mi < 2; ++mi) { const int mt = 2 * C.wave + mi;
#pragma unroll
        for (int ks = 0; ks < 2; ++ks) { const bf16x8 a = tr8(VL + (32 * ks + 8 * g + qq) * VST + 16 * mt + 4 * p, VST);
#pragma unroll
            for (int nt = 0; nt < 4; ++nt) { const bf16x8 bp = *(const LAS bf16x8*)(PL + (16 * nt + fr) * PST + 32 * ks + 8 * g); acc[mi][nt] = mfma16(a, bp, acc[mi][nt]); } }
        const bf16* Srow = SBUF + ((size_t)idx * 256 + 16 * mt + fr) * 128 + 8 * g;
#pragma unroll
        for (int ks = 0; ks < 4; ++ks) { const bf16x8 a = *(const bf16x8*)(Srow + 32 * ks);
#pragma unroll
            for (int nt = 0; nt < 4; ++nt) { const bf16x8 bq = *(const LAS bf16x8*)(QG + (16 * nt + fr) * KST + 32 * ks + 8 * g); acc[mi][nt] = mfma16(a, bq, acc[mi][nt]); } }
    }
#pragma unroll
    for (int nt = 0; nt < 4; ++nt) { float s = 0.f;
#pragma unroll
        for (int mi = 0; mi < 2; ++mi) s += (acc[mi][nt][0] * acc[mi][nt][0] + acc[mi][nt][1] * acc[mi][nt][1]) + (acc[mi][nt][2] * acc[mi][nt][2] + acc[mi][nt][3] * acc[mi][nt][3]);
        s += __shfl_xor(s, 16); s += __shfl_xor(s, 32);
        if (g == 0) RS[C.wave * 64 + 16 * nt + fr] = s; }
    __syncthreads();
    const float* ng = C.in[I_GNG] + (size_t)(l * 4 + h) * 256;
#pragma unroll
    for (int nt = 0; nt < 4; ++nt) { const int i = 16 * nt + fr; float ts = 0.f;
#pragma unroll
        for (int w = 0; w < 8; ++w) ts += RS[w * 64 + i];
        const float rstd = frsq(ts * (1.f / 256.f) + EPS);
#pragma unroll
        for (int mi = 0; mi < 2; ++mi) { const int e = 16 * (2 * C.wave + mi) + 4 * g;
            const u32x2 rr = *(const u32x2*)(PROJ + (size_t)(t0 + i) * NPROJ + C_R + h * 256 + e); const f32x4 gg = *(const f32x4*)(ng + e);
            const float o0 = acc[mi][nt][0] * rstd * gg.x * silu_f(bflo(rr.x)), o1 = acc[mi][nt][1] * rstd * gg.y * silu_f(bfhi(rr.x));
            const float o2 = acc[mi][nt][2] * rstd * gg.z * silu_f(bflo(rr.y)), o3 = acc[mi][nt][3] * rstd * gg.w * silu_f(bfhi(rr.y));
            u32x2 w; w.x = pk2(o0, o1); w.y = pk2(o2, o3); *(u32x2*)(CONCAT + (size_t)(t0 + i) * D + h * 256 + e) = w; } }
    __syncthreads();
}
constexpr int GST = 136;
DI void gmlp_item(const Ctx& C, int l, int idx, const bf16* PROJ, const bf16* WSB, bf16* CONCAT) {
    const int h = idx & 7, n = (idx >> 3) & 31, b = idx >> 8, t0 = b * SEQ + n * 128;
    LAS bf16* VL2 = (LAS bf16*)(C.lds); LAS bf16* UL = (LAS bf16*)(C.lds + 34816);
    const float* vg = C.in[I_VNG] + (size_t)(l * 8 + h) * 128; const float* og = C.in[I_MOG] + (size_t)(l * 8 + h) * 128; const float* bb = C.in[I_MB] + (size_t)(l * 8 + h) * 128;
#pragma unroll
    for (int i = 0; i < 4; ++i) { const int c = C.tid + 512 * i, t = c >> 4, ch = c & 15;
        const bf16* row = PROJ + (size_t)(t0 + t) * NPROJ + h * 128 + 8 * ch;
        const u32x4 uu = *(const u32x4*)(row + C_U), vv = *(const u32x4*)(row + C_VS);
        float v[8] = {gelu_t(bflo(vv.x)), gelu_t(bfhi(vv.x)), gelu_t(bflo(vv.y)), gelu_t(bfhi(vv.y)), gelu_t(bflo(vv.z)), gelu_t(bfhi(vv.z)), gelu_t(bflo(vv.w)), gelu_t(bfhi(vv.w))};
        float ss = 0.f;
#pragma unroll
        for (int k = 0; k < 8; ++k) ss += v[k] * v[k];
        ss += __shfl_xor(ss, 1); ss += __shfl_xor(ss, 2); ss += __shfl_xor(ss, 4); ss += __shfl_xor(ss, 8);
        const float rstd = frsq(ss * (1.f / 128.f) + EPS);
        const f32x4 g0 = *(const f32x4*)(vg + 8 * ch), g1 = *(const f32x4*)(vg + 8 * ch + 4);
        u32x4 wv; wv.x = pk2(v[0] * rstd * g0.x, v[1] * rstd * g0.y); wv.y = pk2(v[2] * rstd * g0.z, v[3] * rstd * g0.w); wv.z = pk2(v[4] * rstd * g1.x, v[5] * rstd * g1.y); wv.w = pk2(v[6] * rstd * g1.z, v[7] * rstd * g1.w);
        *(LAS u32x4*)(VL2 + t * GST + 8 * ch) = wv;
        u32x4 wu; wu.x = pk2(gelu_t(bflo(uu.x)), gelu_t(bfhi(uu.x))); wu.y = pk2(gelu_t(bflo(uu.y)), gelu_t(bfhi(uu.y))); wu.z = pk2(gelu_t(bflo(uu.z)), gelu_t(bfhi(uu.z))); wu.w = pk2(gelu_t(bflo(uu.w)), gelu_t(bfhi(uu.w)));
        *(LAS u32x4*)(UL + t * GST + 8 * ch) = wu; }
    __syncthreads();
    const int lane = C.lane, g = lane >> 4, qq = (lane & 15) >> 2, p = lane & 3, fr = lane & 15;
    f32x4 acc[8];
#pragma unroll
    for (int mt = 0; mt < 8; ++mt) acc[mt] = (f32x4){0.f, 0.f, 0.f, 0.f};
    const int nks = (C.wave >> 1) + 1;
    const bf16* Wrow = WSB + ((size_t)(l * 8 + h) * 128 + 16 * C.wave + fr) * 128 + 8 * g;
#pragma unroll 1
    for (int ks = 0; ks < nks; ++ks) { const bf16x8 bw = *(const bf16x8*)(Wrow + 32 * ks);
#pragma unroll
        for (int mt = 0; mt < 8; ++mt) { const bf16x8 a = tr8(VL2 + (32 * ks + 8 * g + qq) * GST + 16 * mt + 4 * p, GST); acc[mt] = mfma16(a, bw, acc[mt]); } }
    const int tl = 16 * C.wave + fr; const float bt = bb[tl]; float ss = 0.f;
#pragma unroll
    for (int mt = 0; mt < 8; ++mt) { const u32x2 uu = *(const LAS u32x2*)(UL + tl * GST + 16 * mt + 4 * g);
        acc[mt][0] = bflo(uu.x) * (acc[mt][0] + bt); acc[mt][1] = bfhi(uu.x) * (acc[mt][1] + bt); acc[mt][2] = bflo(uu.y) * (acc[mt][2] + bt); acc[mt][3] = bfhi(uu.y) * (acc[mt][3] + bt);
        ss += (acc[mt][0] * acc[mt][0] + acc[mt][1] * acc[mt][1]) + (acc[mt][2] * acc[mt][2] + acc[mt][3] * acc[mt][3]); }
    ss += __shfl_xor(ss, 16); ss += __shfl_xor(ss, 32);
    const float rstd = frsq(ss * (1.f / 128.f) + EPS);
#pragma unroll
    for (int mt = 0; mt < 8; ++mt) { const f32x4 gg = *(const f32x4*)(og + 16 * mt + 4 * g);
        u32x2 w; w.x = pk2(acc[mt][0] * rstd * gg.x, acc[mt][1] * rstd * gg.y); w.y = pk2(acc[mt][2] * rstd * gg.z, acc[mt][3] * rstd * gg.w);
        *(u32x2*)(CONCAT + (size_t)(t0 + tl) * D + 1024 + h * 128 + 16 * mt + 4 * g) = w; }
    __syncthreads();
}
DI void list_insert(float (&L)[16], float x) {
#pragma unroll
    for (int i = 15; i >= 1; --i) L[i] = __builtin_amdgcn_fmed3f(x, L[i - 1], L[i]);
    L[0] = fmaxf(L[0], x);
}
DI void list_merge_xor(float (&L)[16], int mask) {
    float M[16];
#pragma unroll
    for (int i = 0; i < 16; ++i) M[i] = fmaxf(L[i], __shfl_xor(L[15 - i], mask));
#pragma unroll
    for (int s = 8; s >= 1; s >>= 1)
#pragma unroll
        for (int i = 0; i < 16; ++i) if ((i & s) == 0) { const float hi = fmaxf(M[i], M[i + s]), lo = fminf(M[i], M[i + s]); M[i] = hi; M[i + s] = lo; }
#pragma unroll
    for (int i = 0; i < 16; ++i) L[i] = M[i];
}
DI unsigned fbits(float x) { return __builtin_bit_cast(unsigned, x); }
DI float unp7(float x) { return __builtin_bit_cast(float, __builtin_bit_cast(unsigned, x) & 0xFFFFFF80u); }
constexpr int TKST = 136;
DI void topk_phase(const Ctx& C, int l, const bf16* QB, const bf16* K1B, const bf16* K2B, const int* KU, const int* KV, int* EB, float* PG) {
    LAS bf16* KL = (LAS bf16*)C.lds;
    LAS unsigned* tk = (LAS unsigned*)(C.lds + 2 * 128 * TKST * 2 + C.wave * 2048);
    const int lane = C.lane, fr = lane & 15, fq = lane >> 4, h = C.bid & 7, rank = C.bid >> 3;
#pragma unroll
    for (int i = 0; i < 8; ++i) { const int c = C.tid + 512 * i, tb = c >> 11, row = (c & 2047) >> 4, ch = c & 15;
        *(LAS u32x4*)(KL + (tb * 128 + row) * TKST + 8 * ch) = *(const u32x4*)((tb ? K2B : K1B) + ((size_t)(l * 8 + h) * 128 + row) * 128 + 8 * ch); }
    __syncthreads();
#pragma unroll 1
    for (int it = 0; it < 4; ++it) {
        const int tt0 = rank * 512 + C.wave * 64 + it * 16;
        float L[2][16];
        bf16x8 bq[2][4];
#pragma unroll
        for (int half = 0; half < 2; ++half)
#pragma unroll
            for (int ks = 0; ks < 4; ++ks) bq[half][ks] = *(const bf16x8*)(QB + (size_t)(tt0 + fr) * D + h * 256 + half * 128 + 8 * fq + 32 * ks);
#pragma unroll
        for (int half = 0; half < 2; ++half) {
            f32x4 acc[8];
#pragma unroll
            for (int mt = 0; mt < 8; ++mt) acc[mt] = (f32x4){0.f, 0.f, 0.f, 0.f};
            const LAS bf16* Kb = KL + (half * 128 + fr) * TKST + 8 * fq;
#pragma unroll
            for (int ks = 0; ks < 4; ++ks)
#pragma unroll
                for (int mt = 0; mt < 8; ++mt) { const bf16x8 a = *(const LAS bf16x8*)(Kb + (16 * mt) * TKST + 32 * ks); acc[mt] = mfma16(a, bq[half][ks], acc[mt]); }
#pragma unroll
            for (int i = 0; i < 16; ++i) L[half][i] = __builtin_bit_cast(float, 0xFF800000u);
#pragma unroll
            for (int mt = 0; mt < 8; ++mt)
#pragma unroll
                for (int r = 0; r < 4; ++r) { const unsigned key = (unsigned)(16 * mt + 4 * fq + r);
                    const float sv = acc[mt][r];
                    list_insert(L[half], __builtin_bit_cast(float, (fbits(sv) & 0xFFFFFF80u) | key)); }
            list_merge_xor(L[half], 16); list_merge_xor(L[half], 32);
        }
        if (fq == 0) {
#pragma unroll
            for (int i = 0; i < 16; ++i) { tk[(fr * 2 + 0) * 16 + i] = fbits(L[0][i]); tk[(fr * 2 + 1) * 16 + i] = fbits(L[1][i]); }
        }
        float Cn[16];
#pragma unroll
        for (int i = 0; i < 16; ++i) Cn[i] = __builtin_bit_cast(float, 0xFF800000u);
#pragma unroll
        for (int i = 0; i < 16; ++i)
#pragma unroll
            for (int j = 0; j < 16; ++j) if ((i + 1) * (j + 1) <= 16) {
                const float s = unp7(L[0][i]) + unp7(L[1][j]);
                list_insert(Cn, __builtin_bit_cast(float, (fbits(s) & 0xFFFFFF00u) | (unsigned)(i * 16 + j))); }
        LDS_WAIT();
        float sc[4]; int ex[4];
#pragma unroll
        for (int m = 0; m < 4; ++m) {
            const float ck = fq == 0 ? Cn[m] : (fq == 1 ? Cn[4 + m] : (fq == 2 ? Cn[8 + m] : Cn[12 + m]));
            const unsigned cc = fbits(ck) & 255u;
            const unsigned p1 = tk[(fr * 2 + 0) * 16 + (cc >> 4)], p2 = tk[(fr * 2 + 1) * 16 + (cc & 15u)];
            sc[m] = __builtin_bit_cast(float, p1 & 0xFFFFFF80u) + __builtin_bit_cast(float, p2 & 0xFFFFFF80u);
            ex[m] = (int)((p1 & 127u) * 128u + (p2 & 127u));
        }
        float mx = fmaxf(fmaxf(sc[0], sc[1]), fmaxf(sc[2], sc[3]));
        mx = fmaxf(mx, __shfl_xor(mx, 16)); mx = fmaxf(mx, __shfl_xor(mx, 32));
        float w[4], sum = 0.f;
#pragma unroll
        for (int m = 0; m < 4; ++m) { w[m] = fexp2((sc[m] - mx) * 1.442695041f); sum += w[m]; }
        sum += __shfl_xor(sum, 16); sum += __shfl_xor(sum, 32);
        const float inv = 1.0f / sum;
        const size_t o = (size_t)(tt0 + fr) * 128 + h * 16 + 4 * fq;
#pragma unroll
        for (int m = 0; m < 4; ++m) { const int ku = KU[ex[m]], kv = KV[ex[m]]; w[m] = w[m] * inv * __builtin_bit_cast(float, (unsigned)(127 - kv) << 23); ex[m] |= (127 - ku) << 16; }
        *(int4*)(EB + o) = make_int4(ex[0], ex[1], ex[2], ex[3]);
        *(f32x4*)(PG + o) = (f32x4){w[0], w[1], w[2], w[3]};
        LDS_WAIT();
    }
}
typedef unsigned char fp8_t;
DI void unpack16(const u32x4 q, float (&f)[16]) {
#pragma unroll
    for (int w = 0; w < 4; ++w) { const int dw = (int)q[w]; const f32x2 lo = __builtin_amdgcn_cvt_pk_f32_fp8(dw, false), hi = __builtin_amdgcn_cvt_pk_f32_fp8(dw, true);
        f[4 * w] = lo.x; f[4 * w + 1] = lo.y; f[4 * w + 2] = hi.x; f[4 * w + 3] = hi.y; }
}
typedef long i64_t;
DI f32x4 sel4(bool c, const f32x4 a, const f32x4 b) { return (f32x4){c ? a.x : b.x, c ? a.y : b.y, c ? a.z : b.z, c ? a.w : b.w}; }
constexpr int PU_RST = 272, PU_TILE = 16 * PU_RST, PU_WAVE = 2 * PU_TILE;
DI void peerU_phase(const Ctx& C, const unsigned char* H8, const int* EB, const fp8_t* PU8, float* PART, const int emask = 0xFFFF) {
    const int x = C.bid & 7, rank = C.bid >> 3, lane = C.lane, kq = lane >> 4, m16 = lane & 15;
    const fp8_t* tab = PU8 + (size_t)x * NEXP * 256 + 16 * m16;
    float* part = PART + (size_t)x * T * 128;
    const int tbase = rank * 512 + C.wave * 64;
    const int* ebase = EB + (size_t)tbase * 128 + lane;
    const unsigned char* hbase = H8 + (size_t)tbase * 4096 + (m16 & 1) * 2048 + 256 * x + 8 * kq;
    ldsp wl = C.lds + C.wave * PU_WAVE;
    const int wr_off = kq * PU_RST + 16 * m16;
    const int rd_off = m16 * PU_RST + 8 * kq;
    const int bp0 = 4 * kq;
    int ep0 = ebase[0], ep1 = ebase[64], ep0n = ebase[128], ep1n = ebase[192];
    u32x2 hc[8], hn[8];
#pragma unroll
    for (int c = 0; c < 8; ++c) { hc[c] = *(const u32x2*)(hbase + 32 * c); hn[c] = *(const u32x2*)(hbase + 4096 + 32 * c); }
    u32x4 ra[8], rb[8];
#define PU_ISSUE(BUF, ESEL, Q1) do { _Pragma("unroll") for (int i_ = 0; i_ < 8; ++i_) { const int ad_ = (bp0 + 4 * (32 * (Q1) + 4 * i_)) & 255; \
        const int e_ = __builtin_amdgcn_ds_bpermute(ad_, (ESEL)) & emask; BUF[i_] = *(const u32x4*)(tab + (size_t)e_ * 256); } } while (0)
#define PU_STEP(BUF, T0) do { _Pragma("unroll") for (int i_ = 0; i_ < 8; ++i_) *(LAS u32x4*)(wl + wr_off + (i_ >> 2) * PU_TILE + (i_ & 3) * 4 * PU_RST) = BUF[i_]; \
        _Pragma("unroll") for (int tt = 0; tt < 2; ++tt) _Pragma("unroll") for (int c = 0; c < 8; ++c) { const u32x2 av_ = *(const LAS u32x2*)(wl + rd_off + tt * PU_TILE + 32 * c); \
            acc[(T0) + tt] = __builtin_amdgcn_mfma_f32_16x16x32_fp8_fp8((i64_t)(((unsigned long long)av_.y << 32) | av_.x), (i64_t)(((unsigned long long)hc[c].y << 32) | hc[c].x), acc[(T0) + tt], 0, 0, 0); } } while (0)
    PU_ISSUE(ra, ep0, 0);
#pragma unroll 1
    for (int ti = 0; ti < 64; ++ti) {
        const int t = tbase + ti;
        f32x4 acc[8];
#pragma unroll
        for (int tl = 0; tl < 8; ++tl) acc[tl] = (f32x4){0.f, 0.f, 0.f, 0.f};
        PU_ISSUE(rb, ep0, 1); PU_STEP(ra, 0);
        PU_ISSUE(ra, ep1, 2); PU_STEP(rb, 2);
        PU_ISSUE(rb, ep1, 3); PU_STEP(ra, 4);
        if (ti + 1 < 64) PU_ISSUE(ra, ep0n, 0);
        PU_STEP(rb, 6);
        {   const int n = m16, rg = kq;
            const f32x4 s01 = sel4((n >> 1) & 1, acc[1], acc[0]), s23 = sel4((n >> 1) & 1, acc[3], acc[2]), s45 = sel4((n >> 1) & 1, acc[5], acc[4]), s67 = sel4((n >> 1) & 1, acc[7], acc[6]);
            const f32x4 s03 = sel4((n >> 2) & 1, s23, s01), s47 = sel4((n >> 2) & 1, s67, s45), sv = sel4((n >> 3) & 1, s47, s03);
            const float p0 = dppf<0xB1>(sv.x), p1 = dppf<0xB1>(sv.y), p2 = dppf<0xB1>(sv.z), p3 = dppf<0xB1>(sv.w);
            const bool odd = n & 1;
            const float o0 = odd ? (p2 + sv.z * 0.0625f) : (sv.x + p0 * 0.0625f), o1 = odd ? (p3 + sv.w * 0.0625f) : (sv.y + p1 * 0.0625f);
            *(f32x2*)(part + (size_t)t * 128 + 16 * (n >> 1) + 4 * rg + 2 * (n & 1)) = (f32x2){o0 * 0.0625f, o1 * 0.0625f}; }
        ep0 = ep0n; ep1 = ep1n;
#pragma unroll
        for (int c = 0; c < 8; ++c) hc[c] = hn[c];
        if (ti + 2 < 64) { ep0n = ebase[(ti + 2) * 128]; ep1n = ebase[(ti + 2) * 128 + 64];
#pragma unroll
            for (int c = 0; c < 8; ++c) hn[c] = *(const u32x2*)(hbase + (size_t)(ti + 2) * 4096 + 32 * c); }
    }
#undef PU_ISSUE
#undef PU_STEP
}
DI void peerV_phase(const Ctx& C, const int* EB, const float* PG, const float* PART, const fp8_t* PV8, float* X, const float* gate  ) {
    const int x = C.bid & 7, rank = C.bid >> 3, lane = C.lane, g = lane >> 4, i16 = lane & 15;
    const fp8_t* tab = PV8 + (size_t)x * NEXP * 256 + 16 * i16;
    const int tbase = rank * 512 + C.wave * 64;
    const int bp0 = 4 * g;
    float pr0[8], pr1[8]; int rep0, rep1; float rg0, rg1;
#define PV_LOAD_RAW(tt) do { _Pragma("unroll") for (int xx = 0; xx < 8; ++xx) { const float* pp = PART + ((size_t)xx * T + (tt)) * 128 + lane; pr0[xx] = pp[0]; pr1[xx] = pp[64]; } \
        rep0 = EB[(size_t)(tt) * 128 + lane]; rep1 = EB[(size_t)(tt) * 128 + 64 + lane]; rg0 = PG[(size_t)(tt) * 128 + lane]; rg1 = PG[(size_t)(tt) * 128 + 64 + lane]; } while (0)
#define PV_FINISH(A0, A1, E0, E1) do { const float s0_ = ((pr0[0] + pr0[1]) + (pr0[2] + pr0[3])) + ((pr0[4] + pr0[5]) + (pr0[6] + pr0[7])), s1_ = ((pr1[0] + pr1[1]) + (pr1[2] + pr1[3])) + ((pr1[4] + pr1[5]) + (pr1[6] + pr1[7])); \
        A0 = gelu_t(s0_ * __builtin_bit_cast(float, (unsigned)(rep0 >> 16) << 23)) * rg0; A1 = gelu_t(s1_ * __builtin_bit_cast(float, (unsigned)(rep1 >> 16) << 23)) * rg1; E0 = (rep0 & 0xFFFF) * 256; E1 = (rep1 & 0xFFFF) * 256; } while (0)
    float a0, a1, a0n = 0.f, a1n = 0.f; int e0, e1, e0n = 0, e1n = 0;
    PV_LOAD_RAW(tbase); PV_FINISH(a0, a1, e0, e1);
    PV_LOAD_RAW(tbase + 1);
    u32x4 ra[8], rb[8]; float aa[8], ab[8];
#define PV_ISSUE(BUF, AV, ESEL, ASEL, Q1) do { _Pragma("unroll") for (int u = 0; u < 8; ++u) { const int ad_ = (bp0 + 16 * (8 * (Q1) + u)) & 255; \
        const int eo_ = __builtin_amdgcn_ds_bpermute(ad_, (ESEL)); AV[u] = __builtin_bit_cast(float, __builtin_amdgcn_ds_bpermute(ad_, __builtin_bit_cast(int, (ASEL)))); BUF[u] = *(const u32x4*)(tab + eo_); } } while (0)
#define PV_FMA(BUF, AV) do { _Pragma("unroll") for (int u = 0; u < 8; ++u) { float f[16]; unpack16(BUF[u], f); _Pragma("unroll") for (int j = 0; j < 16; ++j) acc[j] += AV[u] * f[j]; \
        asm volatile("" : "+v"(acc[0]), "+v"(acc[1]), "+v"(acc[2]), "+v"(acc[3]), "+v"(acc[4]), "+v"(acc[5]), "+v"(acc[6]), "+v"(acc[7]), "+v"(acc[8]), "+v"(acc[9]), "+v"(acc[10]), "+v"(acc[11]), "+v"(acc[12]), "+v"(acc[13]), "+v"(acc[14]), "+v"(acc[15])); } } while (0)
    PV_ISSUE(ra, aa, e0, a0, 0);
#pragma unroll 1
    for (int ti = 0; ti < 64; ++ti) {
        const int t = tbase + ti;
        float acc[16];
#pragma unroll
        for (int j = 0; j < 16; ++j) acc[j] = 0.f;
        PV_ISSUE(rb, ab, e0, a0, 1); PV_FMA(ra, aa);
        PV_ISSUE(ra, aa, e1, a1, 2); PV_FMA(rb, ab);
        if (ti + 1 < 64) PV_FINISH(a0n, a1n, e0n, e1n);
        PV_ISSUE(rb, ab, e1, a1, 3); PV_FMA(ra, aa);
        a0 = a0n; a1 = a1n; e0 = e0n; e1 = e1n;
        if (ti + 2 < 64) PV_LOAD_RAW(t + 2);
        if (ti + 1 < 64) PV_ISSUE(ra, aa, e0, a0, 0);
        PV_FMA(rb, ab);
#pragma unroll
        for (int j = 0; j < 16; ++j) { acc[j] += __shfl_xor(acc[j], 16); acc[j] += __shfl_xor(acc[j], 32); }
        f32x4 y;
        y.x = g == 0 ? acc[0] : (g == 1 ? acc[4] : (g == 2 ? acc[8] : acc[12]));
        y.y = g == 0 ? acc[1] : (g == 1 ? acc[5] : (g == 2 ? acc[9] : acc[13]));
        y.z = g == 0 ? acc[2] : (g == 1 ? acc[6] : (g == 2 ? acc[10] : acc[14]));
        y.w = g == 0 ? acc[3] : (g == 1 ? acc[7] : (g == 2 ? acc[11] : acc[15]));
        const int col = 256 * x + 16 * i16 + 4 * g, b = t >> 12;
        f32x4* xp = (f32x4*)(X + (size_t)t * D + col); const f32x4 gt = *(const f32x4*)(gate + (size_t)b * MODW + col);
#ifndef DBG_NO_PEER
        *xp = *xp + gt * y;
#endif
    }
#undef PV_LOAD_RAW
#undef PV_FINISH
#undef PV_ISSUE
#undef PV_FMA
}
DI void final_norm_phase(const Ctx& C, float* X, const float* g) {
    const int r0 = C.gw * 8;
    f32x4 gm[8];
#pragma unroll
    for (int j = 0; j < 8; ++j) gm[j] = ((const f32x4*)g)[64 * j + C.lane];
#pragma unroll 1
    for (int i = 0; i < 8; ++i) {
        f32x4* xr = (f32x4*)(X + (size_t)(r0 + i) * D) + C.lane; f32x4 v[8]; float s = 0.f;
#pragma unroll
        for (int j = 0; j < 8; ++j) { v[j] = xr[64 * j]; s += (v[j].x * v[j].x + v[j].y * v[j].y) + (v[j].z * v[j].z + v[j].w * v[j].w); }
        const float rstd = frsq(wave_sum(s) * (1.f / D) + EPS);
#pragma unroll
        for (int j = 0; j < 8; ++j) xr[64 * j] = v[j] * rstd * gm[j];
    }
}
#ifndef PH_MASK
#define PH_MASK 0xFFFFF
#endif
#define EN(k) (((PH_MASK) >> (k)) & 1)
constexpr int NKIND = 11, NPH = 2 + 2 * NKIND;
struct Args { const float* in[21]; float* out; unsigned char* ws; int ph_lo, ph_hi, pad0, pad1; };
__global__ void __launch_bounds__(NTHR, 2) mk_fwd(Args args) {
    extern __shared__ __attribute__((aligned(16))) unsigned char lds_raw[];
    ldsp ldsb = (ldsp)lds_raw;
    volatile LAS unsigned* MISC = (volatile LAS unsigned*)(ldsb + MISC_OFF);
    for (int u = threadIdx.x; u < (LDS_BYTES - LDSCTL_OFF) / 4; u += NTHR) ((LAS unsigned*)(ldsb + LDSCTL_OFF))[u] = 0u;
    __syncthreads();
    unsigned* barw = (unsigned*)(args.ws + WS_CTL) + CW_BAR;
    XcdBarrier bar; bar.bar = barw; bar.x = 0; bar.st = nullptr;
    const bool multi = (args.ph_hi - args.ph_lo) > 1;
    if (multi) bar = xcd_barrier_post(barw, MISC + 8);

    int repflag = 0; (void)repflag;
#pragma unroll 1
    for (int ph = args.ph_lo; ph < args.ph_hi; ++ph) {
#define MKCTX Ctx C; { int tid_ = threadIdx.x, bid_ = blockIdx.x; asm volatile("" : "+v"(tid_)); asm volatile("" : "+s"(bid_)); \
        C.lds = ldsb; C.tid = tid_; C.lane = tid_ & 63; C.wave = __builtin_amdgcn_readfirstlane(tid_ >> 6); C.bid = bid_; C.G = gridDim.x; C.gw = C.bid * NWAVES + C.wave; C.NGW = C.G * NWAVES; \
        _Pragma("unroll") for (int i_ = 0; i_ < 21; ++i_) C.in[i_] = args.in[i_]; C.out = args.out; C.ws = args.ws; }
        unsigned char* const wsb = args.ws;
        float* MOD = (float*)(wsb + WS_MOD);
        bf16* Hb = (bf16*)(wsb + WS_H); bf16* PROJ = (bf16*)(wsb + WS_PROJ); bf16* SBUF = (bf16*)(wsb + WS_SBUF); bf16* CONCAT = (bf16*)(wsb + WS_CONCAT); bf16* QB = (bf16*)(wsb + WS_QB);
        float* ALOW = (float*)(wsb + WS_ALOW); float* DEC = (float*)(wsb + WS_DEC); int* EB = (int*)(wsb + WS_EB); float* PG = (float*)(wsb + WS_PG);
        float* X = args.out;
        const int l = ph < 2 ? 0 : (ph - 2) / NKIND, kind = ph < 2 ? -1 : (ph - 2) % NKIND;
        const float* modl = MOD + (size_t)l * 4 * MODW;
        if (ph == 0) { if (EN(0)) { MKCTX; p0_prologue(C); } }
        else if (ph == 1) { if (EN(1)) { MKCTX; norm_phase(C, C.in[I_X], C.in[I_N1G], modl, 0, D, Hb); } }
        else if ((kind == 0 || kind == 6) && EN(2)) {
            MKCTX; const bool isq = (kind == 6);
            pg8::Gemm g{Hb, isq ? (const bf16*)(wsb + WS_WTQ) + (size_t)l * D * D : (const bf16*)(wsb + WS_WTIN) + (size_t)l * WTIN_L, T, isq ? D : NPROJ, D};
            pg8::StaticOrder S; S.init(T, g.N, C.G, C.bid);
            pg8::EpiBf16 E{isq ? QB : PROJ, isq ? D : NPROJ};
            pg8::gemm_phase<pg8::EpiBf16, pg8::StaticOrder>(C.lds, g, S, E, C.tid);
            if (!isq) alow_phase(C, Hb, (const bf16*)(wsb + WS_WTIN) + (size_t)l * WTIN_L + (size_t)NPROJ * D, ALOW);
        }
        else if (kind == 1 && EN(3)) {
            MKCTX;
#pragma unroll 1
            for (int i = 0; i < 8; ++i) { const int idx = (i >> 1) * C.G + C.bid;
                if (idx < 1024) { if (i & 1) gmlp_item(C, l, idx, PROJ, (const bf16*)(wsb + WS_WSB), CONCAT); else glaA_item(C, l, idx, PROJ, ALOW, SBUF, DEC); } }
        }
        else if (kind == 2) { if (EN(4)) { MKCTX; scan_phase(C, SBUF, DEC); } }
        else if (kind == 3 && EN(5)) {
            MKCTX;
#pragma unroll 1
            for (int idx = C.bid; idx < 1024; idx += C.G) glaC_item(C, l, idx, PROJ, ALOW, SBUF, CONCAT);
        }
        else if (kind == 4 && EN(6)) {
            MKCTX;
            pg8::Gemm g{CONCAT, (const bf16*)(wsb + WS_WTOUT) + (size_t)l * D * D, T, D, D};
            pg8::StaticOrder S; S.init(T, D, C.G, C.bid);
            pg8::EpiResGate E{l == 0 ? C.in[I_X] : (const float*)X, X, modl + 2 * D, MODW};
            pg8::gemm_phase<pg8::EpiResGate, pg8::StaticOrder>(C.lds, g, S, E, C.tid);
        }
        else if (kind == 5) { if (EN(1)) { MKCTX; norm_phase<true>(C, X, C.in[I_N2G] + (size_t)l * D, modl, 3 * D, 4 * D, Hb, wsb + WS_H8); } }
        else if (kind == 7) { if (EN(7)) { MKCTX; topk_phase(C, l, QB, (const bf16*)(wsb + WS_K1B), (const bf16*)(wsb + WS_K2B), (const int*)(wsb + WS_KU) + l * NEXP, (const int*)(wsb + WS_KV) + l * NEXP, EB, PG); } }
#ifdef DBG_FAKE_U
        else if (kind == 8) { if (EN(8)) { MKCTX; peerU_phase(C, wsb + WS_H8, EB, (const fp8_t*)(wsb + WS_PUB) + (size_t)l * NEXP * D, (float*)(wsb + WS_END), DBG_FAKE_U); peerU_phase(C, wsb + WS_H8, EB, (const fp8_t*)(wsb + WS_PUB) + (size_t)l * NEXP * D, (float*)SBUF); } }
#else
        else if (kind == 8) { if (EN(8)) { MKCTX; peerU_phase(C, wsb + WS_H8, EB, (const fp8_t*)(wsb + WS_PUB) + (size_t)l * NEXP * D, (float*)SBUF); } }
#endif
        else if (kind == 9) { if (EN(9)) { MKCTX; peerV_phase(C, EB, PG, (const float*)SBUF, (const fp8_t*)(wsb + WS_PVB) + (size_t)l * NEXP * D, X, modl + 5 * D); } }
        else if (EN(10)) {
            MKCTX;
            if (l == DEPTH - 1) final_norm_phase(C, X, C.in[I_FG]);
            else norm_phase(C, X, C.in[I_N1G] + (size_t)(l + 1) * D, MOD + (size_t)(l + 1) * 4 * MODW, 0, D, Hb);
        }
        if (ph + 1 < args.ph_hi) xcd_barrier(bar);
#ifdef DBG_REP_MASK
        { const int bit = ph < 2 ? ph : 2 + kind; bool want = ((DBG_REP_MASK) >> bit) & 1;
#ifdef DBG_REP_L0
          if (l != 0) want = false;
#endif
          if (want && !repflag) { repflag = 1; --ph; } else repflag = 0; }
#endif
    }
}

extern "C" void kernel_launch(void* const* d_in, const int* in_sizes, int n_in, void* d_out, int out_size, void* d_ws, size_t ws_size, hipStream_t stream) {
    static int grid = 0;
    if (grid == 0) {
        if (n_in != 21 || out_size != T * D || ws_size < WS_END) { fprintf(stderr, "kernel_launch: unexpected shapes (n_in %d, out %d, ws %zu)\n", n_in, out_size, ws_size); grid = -1; return; }
        int dev = 0, cus = 0, per_cu = 0;
        if (hipGetDevice(&dev) != hipSuccess || hipDeviceGetAttribute(&cus, hipDeviceAttributeMultiprocessorCount, dev) != hipSuccess) { grid = -1; return; }
        if (hipFuncSetAttribute((const void*)mk_fwd, hipFuncAttributeMaxDynamicSharedMemorySize, LDS_BYTES) != hipSuccess) { fprintf(stderr, "kernel_launch: hipFuncSetAttribute failed\n"); grid = -1; return; }
        if (hipOccupancyMaxActiveBlocksPerMultiprocessor(&per_cu, (const void*)mk_fwd, NTHR, LDS_BYTES) != hipSuccess || per_cu < 1) { fprintf(stderr, "kernel_launch: occupancy query says %d blocks per CU\n", per_cu); (void)hipGetLastError(); grid = -1; return; }
        if (cus != 256) { fprintf(stderr, "kernel_launch: built for a 256-CU device (got %d)\n", cus); grid = -1; return; }
        grid = cus;
    }
    if (grid < 0) return;
    (void)hipMemsetAsync((char*)d_ws + WS_CTL, 0, CTL_ZERO_BYTES, stream);
    Args a{};
    for (int i = 0; i < 21; ++i) a.in[i] = (const float*)d_in[i];
    a.out = (float*)d_out; a.ws = (unsigned char*)d_ws;
#if MK_N_LAUNCHES == 1
    a.ph_lo = 0; a.ph_hi = NPH;
    hipLaunchKernelGGL(mk_fwd, dim3(grid), dim3(NTHR), LDS_BYTES, stream, a);
#else
    for (int p = 0; p < NPH; ++p) { a.ph_lo = p; a.ph_hi = p + 1; hipLaunchKernelGGL(mk_fwd, dim3(grid), dim3(NTHR), LDS_BYTES, stream, a); }
#endif
}
```

```cpp
#include <hip/hip_runtime.h>
#include <cstdio>
#include <cstdint>
#ifndef MK_N_LAUNCHES
#define MK_N_LAUNCHES 1
#endif
namespace pg8 {
#define PG8_LAS __attribute__((address_space(3)))
typedef unsigned short bf16_t;
typedef short bf16x8 __attribute__((ext_vector_type(8)));
typedef float f32x4 __attribute__((ext_vector_type(4)));
typedef unsigned u32x4 __attribute__((ext_vector_type(4)));
constexpr int BM = 256, BK = 64, HALF = 128, HTB = HALF * BK * 2  , STAGE_BYTES = 8 * HTB, NXCD = 8, WGM = 8;

__host__ __device__ __forceinline__ int lds_byte(int r, int c) { const int st = (r >> 4) * 2 + (c >> 5), rr = r & 15, cc = c & 31, ob = rr * 64 + cc * 2; return st * 1024 + (ob ^ (((ob >> 9) & 1) << 5)); }
__host__ __device__ __forceinline__ void stage_rc(int b, int& R, int& C) { const int st = b / 1024, sb = b % 1024, swz = sb ^ (((sb >> 9) & 1) << 5); R = (st >> 1) * 16 + swz / 64; C = (st & 1) * 32 + (swz % 64) / 2; }
__host__ __device__ __forceinline__ int perm32(int rho) { const int n = rho >> 4, i = rho & 15; return 8 * (i >> 2) + 4 * n + (i & 3); }

struct Unit { int pm, pn; };
struct Gemm { const bf16_t* A; const bf16_t* Bt; int M, N, K; };

struct StaticOrder {
    int nM, nN, nwg, G, c;
    __host__ __device__ void init(int M, int N, int G_, int c_) { nM = M / BM; nN = N / BM; nwg = nM * nN; G = G_; c = c_; }
    __host__ __device__ bool next(int i, Unit& u) const {
        const long L = (long)i * G + c; if (L >= nwg) return false;
        int wgid = (int)L; { const int q = nwg / NXCD, r = nwg % NXCD, xcd = wgid % NXCD, off = wgid / NXCD; wgid = (xcd < r ? xcd * (q + 1) : r * (q + 1) + (xcd - r) * q) + off; }
        const int nig = WGM * nN, gid = wgid / nig, fm = gid * WGM, gsz = (nM - fm) < WGM ? (nM - fm) : WGM;
        u.pm = fm + ((wgid % nig) % gsz); u.pn = (wgid % nig) / gsz; return true;
    }
    __device__ __forceinline__ void a_ready(const Unit&) const {}
    __device__ __forceinline__ void done(const Unit&) const {}
};
__device__ __forceinline__ unsigned cvt_pk_bf16(float lo, float hi) { unsigned r; asm volatile("v_cvt_pk_bf16_f32 %0, %1, %2" : "=v"(r) : "v"(lo), "v"(hi)); return r; }
struct EpiBf16 {
    static constexpr bool PERM = true, AFTER_DRAIN = false;
    bf16_t* O; int ldc;
    __device__ __forceinline__ void operator()(const f32x4 (&acc)[2][2][4][2], const Unit& u, int wr, int wc, int fr, int fq) const {
        const int row0 = u.pm * BM + wr * 64 + fr; const int col0 = u.pn * BM + wc * 32 + 8 * fq;
#pragma unroll
        for (int ai = 0; ai < 2; ++ai)
#pragma unroll
            for (int m = 0; m < 4; ++m) { bf16_t* rowp = O + (size_t)(row0 + ai * HALF + m * 16) * ldc + col0;
#pragma unroll
                for (int bj = 0; bj < 2; ++bj) { const f32x4 v0 = acc[ai][bj][m][0], v1 = acc[ai][bj][m][1];
                    u32x4 w; w.x = cvt_pk_bf16(v0[0], v0[1]); w.y = cvt_pk_bf16(v0[2], v0[3]); w.z = cvt_pk_bf16(v1[0], v1[1]); w.w = cvt_pk_bf16(v1[2], v1[3]);
                    *(u32x4*)(rowp + bj * HALF) = w; } }
    }
};
struct EpiResGate {
    static constexpr bool PERM = false, AFTER_DRAIN = false;
    const float* base; float* out; const float* gate; int gpitch;
    __device__ __forceinline__ void operator()(const f32x4 (&acc)[2][2][4][2], const Unit& u, int wr, int wc, int fr, int fq) const {
        const int row0 = u.pm * BM + wr * 64 + fr, col0 = u.pn * BM + wc * 32 + 4 * fq;
        const float* gp = gate + (size_t)(u.pm >> 4) * gpitch + col0;
        f32x4 gv[2][2];
#pragma unroll
        for (int bj = 0; bj < 2; ++bj)
#pragma unroll
            for (int n = 0; n < 2; ++n) gv[bj][n] = *(const f32x4*)(gp + bj * HALF + n * 16);
#pragma unroll
        for (int ai = 0; ai < 2; ++ai)
#pragma unroll
            for (int m = 0; m < 4; ++m) { const size_t off = (size_t)(row0 + ai * HALF + m * 16) * 2048 + col0;
#pragma unroll
                for (int bj = 0; bj < 2; ++bj)
#pragma unroll
                    for (int n = 0; n < 2; ++n) { const f32x4 bs = *(const f32x4*)(base + off + bj * HALF + n * 16); *(f32x4*)(out + off + bj * HALF + n * 16) = bs + gv[bj][n] * acc[ai][bj][m][n]; }
                asm volatile("" ::: "memory"); }
    }
};

template <class Epi, class Sched>
__device__ __forceinline__ void gemm_phase(PG8_LAS unsigned char* lds, const Gemm g, const Sched& S, const Epi& E, const int tid  ) {
    const int wid = __builtin_amdgcn_readfirstlane(tid >> 6), lane = tid & 63, wr = wid >> 2, wc = wid & 3, fr = lane & 15, fq = lane >> 4;
    const int K = g.K, nt = K / BK;
    unsigned voffA[2], voffB[2];
#pragma unroll
    for (int i = 0; i < 2; ++i) { int R, C; stage_rc(tid * 16 + i * 8192, R, C); const int Rb = Epi::PERM ? ((R & ~31) + perm32(R & 31)) : R;
        voffA[i] = (unsigned)(R * K + C) * 2u; voffB[i] = (unsigned)(Rb * K + C) * 2u; }
    const size_t kstep = (size_t)(BK * 2);
    const size_t hstep = (size_t)HALF * K * 2;
    const size_t tstep = 2 * hstep;
    const unsigned ldsw = (unsigned)wid * 1024u;
    const int aoff = lds_byte(wr * 64 + fr, fq * 8), boff = lds_byte(wc * 32 + fr, fq * 8);
#define PG8_SA(b, h) (((b) * 2 + (h)) * HTB)
#define PG8_SB(b, h) ((4 + (b) * 2 + (h)) * HTB)
#define PG8_STAGE(bufoff, gbase, voff) do { _Pragma("unroll") for (int _i = 0; _i < 2; ++_i) \
        __builtin_amdgcn_global_load_lds((const unsigned*)((const char*)(gbase) + (voff)[_i]), (PG8_LAS unsigned*)(lds + (bufoff) + ldsw + _i * 8192), 16, 0, 0); } while (0)
#define PG8_LDA(dst, b, h) do { _Pragma("unroll") for (int m = 0; m < 4; ++m) _Pragma("unroll") for (int k = 0; k < 2; ++k) dst[m][k] = *(const PG8_LAS bf16x8*)(lds + PG8_SA(b, h) + aoff + m * 2048 + k * 1024); } while (0)
#define PG8_LDB(dst, b, h) do { _Pragma("unroll") for (int n = 0; n < 2; ++n) _Pragma("unroll") for (int k = 0; k < 2; ++k) dst[n][k] = *(const PG8_LAS bf16x8*)(lds + PG8_SB(b, h) + boff + n * 2048 + k * 1024); } while (0)
#define PG8_MMA(ai, bj, At, Bt) do { __builtin_amdgcn_s_setprio(1); _Pragma("unroll") for (int m = 0; m < 4; ++m) _Pragma("unroll") for (int n = 0; n < 2; ++n) _Pragma("unroll") for (int k = 0; k < 2; ++k) \
        acc[ai][bj][m][n] = __builtin_amdgcn_mfma_f32_16x16x32_bf16(Bt[n][k], At[m][k], acc[ai][bj][m][n], 0, 0, 0); __builtin_amdgcn_s_setprio(0); } while (0)
#define PG8_WAIT_V(n) asm volatile("s_waitcnt vmcnt(" #n ")" ::: "memory")
#define PG8_WAIT_L(n) asm volatile("s_waitcnt lgkmcnt(" #n ")" ::: "memory")
#define PG8_BAR __builtin_amdgcn_s_barrier()
#define PG8_SCHED __builtin_amdgcn_sched_barrier(0)
    Unit cur, nxt; int ui = 0;
    if (!S.next(0, cur)) return;
    f32x4 acc[2][2][4][2];
#pragma unroll
    for (int a = 0; a < 2; ++a)
#pragma unroll
        for (int b = 0; b < 2; ++b)
#pragma unroll
            for (int m = 0; m < 4; ++m)
#pragma unroll
                for (int n = 0; n < 2; ++n) acc[a][b][m][n] = (f32x4){0.f, 0.f, 0.f, 0.f};
    bf16x8 At[4][2], B0[2][2], B1[2][2];
    const char* cA = (const char*)g.A + (size_t)cur.pm * tstep; const char* cB = (const char*)g.Bt + (size_t)cur.pn * tstep;
    S.a_ready(cur);
    PG8_STAGE(PG8_SB(0, 0), cB, voffB); PG8_STAGE(PG8_SA(0, 0), cA, voffA); PG8_STAGE(PG8_SB(0, 1), cB + hstep, voffB); PG8_STAGE(PG8_SA(0, 1), cA + hstep, voffA);
    if (wr == 1) PG8_BAR;
    PG8_WAIT_V(4); PG8_BAR;
    PG8_STAGE(PG8_SB(1, 0), cB + kstep, voffB); PG8_STAGE(PG8_SA(1, 0), cA + kstep, voffA); PG8_STAGE(PG8_SB(1, 1), cB + hstep + kstep, voffB);
    PG8_WAIT_V(6); PG8_BAR;
    for (;;) {
        const bool has_next = S.next(ui + 1, nxt);
        const char* nA = has_next ? (const char*)g.A + (size_t)nxt.pm * tstep : cA; const char* nB = has_next ? (const char*)g.Bt + (size_t)nxt.pn * tstep : cB;
        for (int t = 0; t < nt; t += 2) {
            const bool last = (t == nt - 2);
            const char* a1 = cA + (size_t)(t + 1) * kstep;
            const char* a2 = last ? nA : cA + (size_t)(t + 2) * kstep; const char* b2 = last ? nB : cB + (size_t)(t + 2) * kstep;
            const char* a3 = a2 + kstep; const char* b3 = b2 + kstep;
            if (last && has_next) S.a_ready(nxt);
            PG8_LDB(B0, 0, 0); PG8_SCHED; PG8_LDA(At, 0, 0); PG8_STAGE(PG8_SA(1, 1), a1 + hstep, voffA);
            PG8_WAIT_L(8); PG8_BAR; PG8_WAIT_L(0); PG8_MMA(0, 0, At, B0); PG8_BAR; PG8_SCHED;
            PG8_LDB(B1, 0, 1); PG8_STAGE(PG8_SB(0, 0), b2, voffB);
            PG8_BAR; PG8_WAIT_L(0); PG8_MMA(0, 1, At, B1); PG8_BAR;
            PG8_LDA(At, 0, 1); PG8_STAGE(PG8_SA(0, 0), a2, voffA);
            PG8_BAR; PG8_WAIT_L(0); PG8_MMA(1, 0, At, B0); PG8_BAR; PG8_SCHED;
            PG8_STAGE(PG8_SB(0, 1), b2 + hstep, voffB);
            PG8_WAIT_V(6); PG8_BAR; PG8_MMA(1, 1, At, B1); PG8_BAR;
            PG8_LDB(B0, 1, 0); PG8_SCHED; PG8_LDA(At, 1, 0); PG8_STAGE(PG8_SA(0, 1), a2 + hstep, voffA);
            PG8_WAIT_L(8); PG8_BAR; PG8_WAIT_L(0); PG8_MMA(0, 0, At, B0); PG8_BAR; PG8_SCHED;
            PG8_LDB(B1, 1, 1); PG8_STAGE(PG8_SB(1, 0), b3, voffB);
            PG8_BAR; PG8_WAIT_L(0); PG8_MMA(0, 1, At, B1); PG8_BAR;
            PG8_LDA(At, 1, 1); PG8_STAGE(PG8_SA(1, 0), a3, voffA);
            PG8_BAR; PG8_WAIT_L(0); PG8_MMA(1, 0, At, B0); PG8_BAR; PG8_SCHED;
            PG8_STAGE(PG8_SB(1, 1), b3 + hstep, voffB);
            PG8_WAIT_V(6); PG8_BAR; PG8_MMA(1, 1, At, B1); PG8_BAR;
        }
        if constexpr (!Epi::AFTER_DRAIN) { E(acc, cur, wr, wc, fr, fq); S.done(cur); }
        if (!has_next) break;
#pragma unroll
        for (int a = 0; a < 2; ++a)
#pragma unroll
            for (int b = 0; b < 2; ++b)
#pragma unroll
                for (int m = 0; m < 4; ++m)
#pragma unroll
                    for (int n = 0; n < 2; ++n) acc[a][b][m][n] = (f32x4){0.f, 0.f, 0.f, 0.f};
        cur = nxt; cA = nA; cB = nB; ++ui;
    }
    PG8_WAIT_V(0);
    if (wr == 0) PG8_BAR;
    PG8_BAR;
    if constexpr (Epi::AFTER_DRAIN) { E.fused(acc, cur, wr, wc, fr, fq, lds, wid, lane); S.done(cur); }
#undef PG8_SA
#undef PG8_SB
#undef PG8_STAGE
#undef PG8_LDA
#undef PG8_LDB
#undef PG8_MMA
#undef PG8_WAIT_V
#undef PG8_WAIT_L
#undef PG8_BAR
#undef PG8_SCHED
}
}
constexpr int NWAVES = 8, NTHR = 512;
constexpr int D = 2048, NBATCH = 4, SEQ = 4096, T = NBATCH * SEQ, DEPTH = 2;
constexpr int GLA_H = 4, GLA_DK = 128, GLA_DV = 256, GLA_CH = 64;
constexpr int MLP_H = 8, MLP_DH = 128, MLP_CH = 128;
constexpr int IN_COLS = 5136, NPROJ = 5120;
constexpr int C_Q = 0, C_K = 512, C_V = 1024, C_R = 2048, C_U = 3072, C_VS = 4096;
constexpr int NEXP = 16384, PEER_H = 8;
constexpr float EPS = 1e-6f;
constexpr int MODW = 6 * D;
constexpr size_t MiB = 1u << 20;
constexpr size_t WS_CTL = 0, CTL_ZERO_BYTES = 1 * MiB;
constexpr size_t WS_MOD = 1 * MiB;
constexpr size_t WS_K1B = 2 * MiB, WS_K2B = 2 * MiB + 512 * 1024, WS_WSB = 3 * MiB, WS_DEC = 3 * MiB + 512 * 1024, WS_ALOW = 4 * MiB;
constexpr size_t WS_KU = 5 * MiB, WS_KV = 5 * MiB + 256 * 1024;
constexpr size_t WS_WTIN = 8 * MiB;
constexpr size_t WTIN_L = (size_t)5136 * 2048;
constexpr size_t WS_WTOUT = 49 * MiB, WS_WTQ = 65 * MiB;
constexpr size_t WS_PUB = 81 * MiB, WS_PVB = 209 * MiB;
constexpr size_t WS_H = 337 * MiB;
constexpr size_t WS_PROJ = 401 * MiB;
constexpr size_t WS_SBUF = 561 * MiB;
constexpr size_t WS_CONCAT = 625 * MiB;
constexpr size_t WS_QB = 689 * MiB;
constexpr size_t WS_EB = 753 * MiB, WS_PG = 761 * MiB;
constexpr size_t WS_H8 = 769 * MiB, WS_END = 833 * MiB;
static_assert(WS_WTIN + 2 * WTIN_L * 2 <= WS_WTOUT, "ws map");
constexpr int CW_BAR = 4096;
constexpr int RING_BYTES = 131072, LDSCTL_OFF = RING_BYTES, MISC_OFF = LDSCTL_OFF + 320, LDS_BYTES = 147456;

#define DI __device__ __forceinline__
#define LAS __attribute__((address_space(3)))
typedef unsigned short bf16;
typedef short bf16x8 __attribute__((ext_vector_type(8)));
typedef short s16x4 __attribute__((ext_vector_type(4)));
typedef short v4i16_t __attribute__((ext_vector_type(4)));
typedef __bf16 bf16x2_t __attribute__((ext_vector_type(2)));
typedef float f32x4 __attribute__((ext_vector_type(4)));
typedef float f32x2 __attribute__((ext_vector_type(2)));
typedef unsigned u32x4 __attribute__((ext_vector_type(4)));
typedef unsigned u32x2 __attribute__((ext_vector_type(2)));
typedef LAS unsigned char* ldsp;

DI unsigned f2bf(float f) { unsigned u = __builtin_bit_cast(unsigned, f); return (u + 0x7fffu + ((u >> 16) & 1u)) >> 16; }
DI unsigned pk2(float lo, float hi) { return f2bf(lo) | (f2bf(hi) << 16); }
DI float bflo(unsigned u) { return __builtin_bit_cast(float, u << 16); }
DI float bfhi(unsigned u) { return __builtin_bit_cast(float, u & 0xffff0000u); }
DI float bf1(bf16 v) { return __builtin_bit_cast(float, ((unsigned)v) << 16); }
DI float fexp2(float x) { return __builtin_amdgcn_exp2f(x); }
DI float flog2(float x) { return __builtin_amdgcn_logf(x); }
DI float frcp(float x) { return __builtin_amdgcn_rcpf(x); }
DI float frsq(float x) { return __builtin_amdgcn_rsqf(x); }
DI float gelu_t(float x) { const float u = 0.7978845608f * (x + 0.044715f * x * x * x); return x * frcp(1.f + fexp2(-2.885390082f * u)); }
DI float silu_f(float x) { return x * frcp(1.f + fexp2(-1.442695041f * x)); }
template <int CTRL> DI float dppf(float v) { return __builtin_bit_cast(float, __builtin_amdgcn_update_dpp(0, __builtin_bit_cast(int, v), CTRL, 0xf, 0xf, true)); }
DI float wave_sum_u(float v) {
    v += dppf<0xB1>(v); v += dppf<0x4E>(v); v += dppf<0x141>(v); v += dppf<0x140>(v);
    const int iv = __builtin_bit_cast(int, v);
    return (__builtin_bit_cast(float, __builtin_amdgcn_readlane(iv, 0)) + __builtin_bit_cast(float, __builtin_amdgcn_readlane(iv, 16))) +
           (__builtin_bit_cast(float, __builtin_amdgcn_readlane(iv, 32)) + __builtin_bit_cast(float, __builtin_amdgcn_readlane(iv, 48)));
}
DI float wave_sum(float v) {
#pragma unroll
    for (int o = 1; o < 64; o <<= 1) v += __shfl_xor(v, o);
    return v;
}
DI float dot2bf(unsigned a, unsigned b, float c) { return __builtin_amdgcn_fdot2_f32_bf16(__builtin_bit_cast(bf16x2_t, a), __builtin_bit_cast(bf16x2_t, b), c, false); }
DI f32x4 mfma16(bf16x8 a, bf16x8 b, f32x4 c) { return __builtin_amdgcn_mfma_f32_16x16x32_bf16(a, b, c, 0, 0, 0); }
DI s16x4 tr4(const LAS bf16* p) { return __builtin_bit_cast(s16x4, __builtin_amdgcn_ds_read_tr16_b64_v4i16((LAS v4i16_t*)p)); }
DI bf16x8 tr8(const LAS bf16* p, int stride) { const s16x4 a = tr4(p), b = tr4(p + 4 * stride); return (bf16x8){a[0], a[1], a[2], a[3], b[0], b[1], b[2], b[3]}; }

#define XB_TMO      128
#define XB_XCNT(j)  (256  + 64 * (j))
#define XB_XSUB(j)  (1280 + 64 * (j))
#define XB_XGEN(j)  (2304 + 64 * (j))
#define XB_TOP      3328
#define XB_TOPGEN   3392
#define XCD_BAR_WORDS 3456
#define XB_SPIN_CAP (1u << 18)

__device__ __forceinline__ unsigned xb_ld(unsigned* p)              { return __hip_atomic_load(p, __ATOMIC_RELAXED, __HIP_MEMORY_SCOPE_AGENT); }
__device__ __forceinline__ unsigned xb_add(unsigned* p, unsigned v) { return __hip_atomic_fetch_add(p, v, __ATOMIC_RELAXED, __HIP_MEMORY_SCOPE_AGENT); }
__device__ __forceinline__ unsigned xb_xcc_id() { return (unsigned)__builtin_amdgcn_s_getreg((3 << 11) | 20) & 0xFu; }
#define XB_SPIN(cond, bar) do { unsigned _sp = 0; while (cond) { __builtin_amdgcn_s_sleep(1); \
    if ((++_sp & 255u) == 0u) { if (xb_ld(&(bar)[XB_TMO])) break; if (_sp > XB_SPIN_CAP) { atomicAdd(&(bar)[XB_TMO], 1u); break; } } } } while (0)

struct XcdBarrier {
    unsigned* bar; unsigned x;
    volatile LAS unsigned* st;
};

__device__ __forceinline__ XcdBarrier xcd_barrier_post(unsigned* bar, volatile LAS unsigned* st) {
    XcdBarrier b; b.bar = bar; b.x = xb_xcc_id(); b.st = st;
    if (threadIdx.x == 0) (void)xb_add(&bar[XB_XCNT(b.x)], 1u);
    return b;
}
__device__ __forceinline__ void xcd_barrier_complete(unsigned* bar, unsigned x, unsigned& nloc, unsigned& nx) {
    const unsigned G = gridDim.x * gridDim.y * gridDim.z;
    unsigned sum, cnt, mine, sp = 0u;
    for (;;) {
        sum = 0u; cnt = 0u; mine = 0u;
#pragma unroll
        for (unsigned j = 0; j < 16; ++j) { const unsigned c = xb_ld(&bar[XB_XCNT(j)]); sum += c; cnt += (c > 0u) ? 1u : 0u; mine = (j == x) ? c : mine; }
        if (sum == G) break;
        __builtin_amdgcn_s_sleep(1);
        if ((++sp & 255u) == 0u) { if (xb_ld(&bar[XB_TMO])) break; if (sp > XB_SPIN_CAP) { atomicAdd(&bar[XB_TMO], 1u); break; } }
    }
    nloc = mine > 0u ? mine : 1u; nx = cnt > 0u ? cnt : 1u;
}

__device__ __forceinline__ void xcd_barrier(const XcdBarrier& b) {
    asm volatile("s_waitcnt vmcnt(0)" ::: "memory");
    __syncthreads();
    if (threadIdx.x == 0) {
        unsigned* bar = b.bar;
        __builtin_amdgcn_s_waitcnt(0);
        unsigned nloc = b.st[0], nx = b.st[1];
        if (nloc == 0u) { xcd_barrier_complete(bar, b.x, nloc, nx); b.st[0] = nloc; b.st[1] = nx; }
        const unsigned old = xb_add(&bar[XB_XSUB(b.x)], 1u);
        const unsigned gen = old / nloc;
        if (old + 1u == (gen + 1u) * nloc) {
            __builtin_amdgcn_fence(__ATOMIC_RELEASE, "agent");
            asm volatile("s_waitcnt vmcnt(0)" ::: "memory");
            const unsigned og = xb_add(&bar[XB_TOP], 1u);
            const unsigned tg = og / nx;
            if (og + 1u == (tg + 1u) * nx) xb_add(&bar[XB_TOPGEN], 1u);
            else XB_SPIN(xb_ld(&bar[XB_TOPGEN]) == tg, bar);
            __builtin_amdgcn_fence(__ATOMIC_ACQUIRE, "agent");
            xb_add(&bar[XB_XGEN(b.x)], 1u);
            asm volatile("s_waitcnt vmcnt(0)" ::: "memory");
        } else {
            XB_SPIN(xb_ld(&bar[XB_XGEN(b.x)]) == gen, bar);
            __builtin_amdgcn_fence(__ATOMIC_ACQUIRE, "agent");
            asm volatile("s_waitcnt vmcnt(0)" ::: "memory");
        }
    }
    __syncthreads();
}
struct Ctx {
    ldsp lds; int tid, lane, wave, bid, G, gw, NGW;
    const float* in[21]; float* out; unsigned char* ws;
};
#define LDS_WAIT() asm volatile("s_waitcnt lgkmcnt(0)" ::: "memory")
enum { I_X = 0, I_C, I_ADAW, I_ADAB, I_N1G, I_WIN, I_WA2, I_BA, I_GNG, I_VNG, I_MWS, I_MB, I_MOG, I_WOUT, I_N2G, I_WQ, I_K1, I_K2, I_PU, I_PV, I_FG };

DI void p0_ada(const Ctx& C) {
    LAS float* red = (LAS float*)C.lds;
    float* MOD = (float*)(C.ws + WS_MOD);
    for (int it = C.bid; it < 192; it += C.G) {
        const int l = it / 96, cg = it % 96, c0 = cg * 128 + C.lane * 2;
        const float* W = C.in[I_ADAW] + (size_t)l * D * MODW + (size_t)(C.wave * 256) * MODW + c0;
        float cv[4][4];
#pragma unroll
        for (int b = 0; b < 4; ++b)
#pragma unroll
            for (int i = 0; i < 4; ++i) cv[b][i] = silu_f(C.in[I_C][b * D + C.wave * 256 + i * 64 + C.lane]);
        float acc[4][2];
#pragma unroll
        for (int b = 0; b < 4; ++b) { acc[b][0] = 0.f; acc[b][1] = 0.f; }
#pragma unroll
        for (int i = 0; i < 4; ++i) {
#pragma unroll 8
            for (int j = 0; j < 64; ++j) {
                const f32x2 w = *(const f32x2*)(W + (size_t)(i * 64 + j) * MODW);
#pragma unroll
                for (int b = 0; b < 4; ++b) { const float s = __builtin_bit_cast(float, __builtin_amdgcn_readlane(__builtin_bit_cast(int, cv[b][i]), j)); acc[b][0] += s * w.x; acc[b][1] += s * w.y; }
            }
        }
#pragma unroll
        for (int b = 0; b < 4; ++b) *(LAS f32x2*)(red + (C.wave * 4 + b) * 128 + C.lane * 2) = (f32x2){acc[b][0], acc[b][1]};
        __syncthreads();
        { const int b = C.tid >> 7, col = C.tid & 127; float s = C.in[I_ADAB][l * MODW + cg * 128 + col];
#pragma unroll
          for (int w = 0; w < 8; ++w) s += red[(w * 4 + b) * 128 + col];
          MOD[(size_t)(l * 4 + b) * MODW + cg * 128 + col] = s; }
        __syncthreads();
    }
}
DI void transpose_item(const float* W, int ldw, int src_col0, int ncols, bf16* WT, int dst_row0, int k0, LAS float* scr, int lane) {
    const int cl = lane & 31;
#pragma unroll 8
    for (int i = 0; i < 32; ++i) { const int kk = 2 * i + (lane >> 5); float v = 0.f; if (cl < ncols) v = W[(size_t)(k0 + kk) * ldw + src_col0 + cl]; scr[kk * 33 + cl] = v; }
    LDS_WAIT();
    const int c = lane & 7;
#pragma unroll
    for (int j = 0; j < 4; ++j) { const int n = (lane >> 3) + 8 * j;
        if (n < ncols) { const LAS float* s = scr + (8 * c) * 33 + n;
            u32x4 o; o.x = pk2(s[0 * 33], s[1 * 33]); o.y = pk2(s[2 * 33], s[3 * 33]); o.z = pk2(s[4 * 33], s[5 * 33]); o.w = pk2(s[6 * 33], s[7 * 33]);
            *(u32x4*)(WT + (size_t)(dst_row0 + n) * 2048 + k0 + 8 * c) = o; } }
    LDS_WAIT();
}
DI void p0_prologue(const Ctx& C) {
    p0_ada(C);
    LAS float* scr = (LAS float*)(C.lds + C.wave * 16384);
    constexpr int PER_L = (161 + 64 + 64) * 32;
    for (int it = C.gw; it < 2 * PER_L; it += C.NGW) {
        const int l = it / PER_L; int r = it % PER_L;
        if (r < 161 * 32) { const int kb = r / 161, nb = r % 161; bf16* WT = (bf16*)(C.ws + WS_WTIN) + (size_t)l * WTIN_L;
            const float* W = C.in[I_WIN] + (size_t)l * D * IN_COLS;
            if (nb < 160) { const int n0 = 32 * nb; transpose_item(W, IN_COLS, n0 + (n0 >= 3072 ? 16 : 0), 32, WT, n0, 64 * kb, scr, C.lane); }
            else transpose_item(W, IN_COLS, 3072, 16, WT, 5120, 64 * kb, scr, C.lane);
            continue; }
        r -= 161 * 32;
        if (r < 2048) { const int kb = r / 64, nb = r % 64; transpose_item(C.in[I_WOUT] + (size_t)l * D * D, D, 32 * nb, 32, (bf16*)(C.ws + WS_WTOUT) + (size_t)l * D * D, 32 * nb, 64 * kb, scr, C.lane); continue; }
        r -= 2048;
        { const int kb = r / 64, nb = r % 64; transpose_item(C.in[I_WQ] + (size_t)l * D * D, D, 32 * nb, 32, (bf16*)(C.ws + WS_WTQ) + (size_t)l * D * D, 32 * nb, 64 * kb, scr, C.lane); }
    }
    const int gt = C.bid * NTHR + C.tid, NT = C.G * NTHR;
    { bf16* K1B = (bf16*)(C.ws + WS_K1B); bf16* K2B = (bf16*)(C.ws + WS_K2B); bf16* WSB = (bf16*)(C.ws + WS_WSB);
      for (int i = gt; i < 262144; i += NT) { K1B[i] = (bf16)f2bf(C.in[I_K1][i]); K2B[i] = (bf16)f2bf(C.in[I_K2][i]);
          const int s = i & 127, t = (i >> 7) & 127; WSB[i] = (s <= t) ? (bf16)f2bf(C.in[I_MWS][i]) : (bf16)0; } }
    { int* KU = (int*)(C.ws + WS_KU); int* KV = (int*)(C.ws + WS_KV);
#pragma unroll 1
      for (int row = C.gw; row < 4 * NEXP; row += C.NGW) {
          const int tb = row >> 15, rr = row & 32767;
          const f32x4* src = (const f32x4*)(C.in[tb ? I_PV : I_PU] + (size_t)rr * D) + C.lane;
          f32x4 v[8]; float mx = 0.f;
#pragma unroll
          for (int j = 0; j < 8; ++j) { v[j] = src[64 * j]; mx = fmaxf(mx, fmaxf(fmaxf(fabsf(v[j].x), fabsf(v[j].y)), fmaxf(fabsf(v[j].z), fabsf(v[j].w)))); }
#pragma unroll
          for (int o = 1; o < 64; o <<= 1) mx = fmaxf(mx, __shfl_xor(mx, o));
          int k = 0;
          if (mx > 0.f) { k = (int)((__builtin_bit_cast(unsigned, 224.0f / mx) >> 23) & 255u) - 127; k = k < -60 ? -60 : (k > 60 ? 60 : k); }
          const float sc = __builtin_bit_cast(float, (unsigned)(k + 127) << 23);
          const int lyr = rr >> 14, ee = rr & 16383;
          unsigned* dst = (unsigned*)(C.ws + (tb ? WS_PVB : WS_PUB) + (size_t)lyr * NEXP * D + (size_t)ee * 256) + C.lane;
#pragma unroll
          for (int j = 0; j < 8; ++j) { int p = 0; p = __builtin_amdgcn_cvt_pk_fp8_f32(v[j].x * sc, v[j].y * sc, p, false); p = __builtin_amdgcn_cvt_pk_fp8_f32(v[j].z * sc, v[j].w * sc, p, true); dst[(size_t)j * (NEXP * 256 / 4)] = (unsigned)p; }
          if (C.lane == 0) (tb ? KV : KU)[rr] = k;
      } }
}
template <bool FP8 = false>
DI void norm_phase(const Ctx& C, const float* X, const float* g, const float* modl, int sh_off, int sc_off, bf16* Hout, unsigned char* H8 = nullptr) {
    const int r0 = C.gw * 8, b = r0 >> 12;
    const f32x4* shp = (const f32x4*)(modl + (size_t)b * MODW + sh_off); const f32x4* scp = (const f32x4*)(modl + (size_t)b * MODW + sc_off);
    f32x4 gm[8], shv[8];
#pragma unroll
    for (int j = 0; j < 8; ++j) { const int idx = 64 * j + C.lane; gm[j] = ((const f32x4*)g)[idx] * (scp[idx] + 1.0f); shv[j] = shp[idx]; }
#pragma unroll 1
    for (int i = 0; i < 8; ++i) {
        const f32x4* xr = (const f32x4*)(X + (size_t)(r0 + i) * D) + C.lane; f32x4 v[8]; float s = 0.f;
#pragma unroll
        for (int j = 0; j < 8; ++j) { v[j] = xr[64 * j]; s += (v[j].x * v[j].x + v[j].y * v[j].y) + (v[j].z * v[j].z + v[j].w * v[j].w); }
        const float rstd = frsq(wave_sum(s) * (1.f / D) + EPS);
        u32x2* o = (u32x2*)(Hout + (size_t)(r0 + i) * D) + C.lane;
#pragma unroll
        for (int j = 0; j < 8; ++j) { const f32x4 y = v[j] * rstd * gm[j] + shv[j]; u32x2 w; w.x = pk2(y.x, y.y); w.y = pk2(y.z, y.w); o[64 * j] = w;
            if (FP8) {
                const f32x4 ys = y * 16.0f; int ph = 0; ph = __builtin_amdgcn_cvt_pk_fp8_f32(ys.x, ys.y, ph, false); ph = __builtin_amdgcn_cvt_pk_fp8_f32(ys.z, ys.w, ph, true);
                const f32x2 b0 = __builtin_amdgcn_cvt_pk_f32_fp8(ph, false), b1 = __builtin_amdgcn_cvt_pk_f32_fp8(ph, true);
                int pl = 0; pl = __builtin_amdgcn_cvt_pk_fp8_f32((ys.x - b0.x) * 16.0f, (ys.y - b0.y) * 16.0f, pl, false); pl = __builtin_amdgcn_cvt_pk_fp8_f32((ys.z - b1.x) * 16.0f, (ys.w - b1.y) * 16.0f, pl, true);
                unsigned* h8 = (unsigned*)(H8 + (size_t)(r0 + i) * 4096) + C.lane; h8[64 * j] = (unsigned)ph; h8[512 + 64 * j] = (unsigned)pl; } }
    }
}
DI void alow_phase(const Ctx& C, const bf16* Hb, const bf16* WtA, float* ALOW) {
    if (C.wave < 4) {
        const int task = C.bid * 4 + C.wave, r0 = task * 16, fr = C.lane & 15, fq = C.lane >> 4;
        const bf16* ap = Hb + (size_t)(r0 + fr) * D + 8 * fq; const bf16* bp = WtA + (size_t)fr * D + 8 * fq;
        f32x4 acc = (f32x4){0.f, 0.f, 0.f, 0.f};
#pragma unroll 8
        for (int ks = 0; ks < 64; ++ks) { const bf16x8 a = *(const bf16x8*)(ap + 32 * ks), b = *(const bf16x8*)(bp + 32 * ks); acc = mfma16(a, b, acc); }
#pragma unroll
        for (int r = 0; r < 4; ++r) ALOW[(size_t)(r0 + 4 * fq + r) * 16 + fr] = acc[r];
    }
}
DI void gla_gates(const Ctx& C, LAS float* al, LAS float* tot, const float* ALOW, const float* wa2, const float* ba, int t0, int h, float (&Gl)[16], float& off, float& gref, float& g63) {
    const int d = C.tid & 127, jg = C.tid >> 7;
    if (C.tid < 256) ((LAS f32x4*)al)[C.tid] = ((const f32x4*)(ALOW + (size_t)t0 * 16))[C.tid];
    float w2[16];
#pragma unroll
    for (int r = 0; r < 16; ++r) w2[r] = wa2[r * 512 + h * 128 + d];
    const float bav = ba[h * 128 + d];
    __syncthreads();
    float run = 0.f;
#pragma unroll
    for (int jj = 0; jj < 16; ++jj) {
        const LAS f32x4* ar = (const LAS f32x4*)(al + (jg * 16 + jj) * 16);
        const f32x4 a0 = ar[0], a1 = ar[1], a2 = ar[2], a3 = ar[3];
        float z = bav;
        z += a0.x * w2[0] + a0.y * w2[1] + a0.z * w2[2] + a0.w * w2[3];
        z += a1.x * w2[4] + a1.y * w2[5] + a1.z * w2[6] + a1.w * w2[7];
        z += a2.x * w2[8] + a2.y * w2[9] + a2.z * w2[10] + a2.w * w2[11];
        z += a3.x * w2[12] + a3.y * w2[13] + a3.z * w2[14] + a3.w * w2[15];
        const float ls = fminf(z, 0.f) - 0.6931471806f * flog2(1.f + fexp2(-1.442695041f * fabsf(z)));
        run += ls * (1.442695041f / 16.f);
        Gl[jj] = run;
    }
    tot[jg * 128 + d] = run;
    __syncthreads();
    const float t0_ = tot[d], t1_ = tot[128 + d], t2_ = tot[256 + d], t3_ = tot[384 + d];
    off = (jg > 0 ? t0_ : 0.f) + (jg > 1 ? t1_ : 0.f) + (jg > 2 ? t2_ : 0.f); gref = t0_ + t1_; g63 = (t0_ + t1_) + (t2_ + t3_);
}
constexpr int KST = 136, VST = 264, PST = 72;
DI void load_v_tile(const Ctx& C, const bf16* PROJ, int t0, int h, LAS bf16* VL) {
#pragma unroll
    for (int i = 0; i < 4; ++i) { const int c = C.tid + 512 * i, j = c >> 5, ec = c & 31;
        *(LAS u32x4*)(VL + j * VST + 8 * ec) = *(const u32x4*)(PROJ + (size_t)(t0 + j) * NPROJ + C_V + h * 256 + 8 * ec); }
}
DI void glaA_item(const Ctx& C, int l, int idx, const bf16* PROJ, const float* ALOW, bf16* SBUF, float* DEC) {
    const int b = idx >> 8, h = (idx >> 6) & 3, n = idx & 63, t0 = b * SEQ + n * 64;
    LAS float* al = (LAS float*)(C.lds); LAS float* tot = (LAS float*)(C.lds + 4096);
    LAS bf16* KD = (LAS bf16*)(C.lds + 8192); LAS bf16* VL = (LAS bf16*)(C.lds + 25600);
    const int d = C.tid & 127, jg = C.tid >> 7;
    bf16 kraw[16];
#pragma unroll
    for (int jj = 0; jj < 16; ++jj) kraw[jj] = PROJ[(size_t)(t0 + jg * 16 + jj) * NPROJ + C_K + h * 128 + d];
    float Gl[16], off, gref, g63;
    gla_gates(C, al, tot, ALOW, C.in[I_WA2] + (size_t)l * 16 * 512, C.in[I_BA] + (size_t)l * 512, t0, h, Gl, off, gref, g63);
#pragma unroll
    for (int jj = 0; jj < 16; ++jj) { const int j = jg * 16 + jj; KD[j * KST + d] = (bf16)f2bf(bf1(kraw[jj]) * fexp2(g63 - (off + Gl[jj]))); }
    if (jg == 0) DEC[(size_t)idx * 128 + d] = fexp2(g63);
    load_v_tile(C, PROJ, t0, h, VL);
    __syncthreads();
    const int lane = C.lane, g = lane >> 4, qq = (lane & 15) >> 2, p = lane & 3, fr = lane & 15;
    bf16x8 A[2];
#pragma unroll
    for (int ks = 0; ks < 2; ++ks) A[ks] = tr8(KD + (32 * ks + 8 * g + qq) * KST + 16 * C.wave + 4 * p, KST);
    bf16* Sit = SBUF + (size_t)idx * 256 * 128;
#pragma unroll
    for (int half = 0; half < 2; ++half) {
        f32x4 acc[8];
#pragma unroll
        for (int nt = 0; nt < 8; ++nt) acc[nt] = (f32x4){0.f, 0.f, 0.f, 0.f};
#pragma unroll
        for (int nt = 0; nt < 8; ++nt)
#pragma unroll
            for (int ks = 0; ks < 2; ++ks) { const bf16x8 Bf = tr8(VL + (32 * ks + 8 * g + qq) * VST + 16 * (half * 8 + nt) + 4 * p, VST); acc[nt] = mfma16(A[ks], Bf, acc[nt]); }
#pragma unroll
        for (int nt = 0; nt < 8; ++nt) { const int e = 16 * (half * 8 + nt) + fr, dd = 16 * C.wave + 4 * g;
            u32x2 w; w.x = pk2(acc[nt][0], acc[nt][1]); w.y = pk2(acc[nt][2], acc[nt][3]); *(u32x2*)(Sit + (size_t)e * 128 + dd) = w; }
    }
    __syncthreads();
}
DI void scan_phase(const Ctx& C, bf16* SBUF, const float* DEC) {
    const int gt = C.bid * NTHR + C.tid, bh = gt >> 13, rem = gt & 8191, e = rem >> 5, dq = rem & 31;
    u32x2* p = (u32x2*)(SBUF + ((size_t)(bh * 64) * 256 + e) * 128 + 4 * dq);
    const f32x4* dp = (const f32x4*)(DEC + (size_t)(bh * 64) * 128 + 4 * dq);
    f32x4 st = (f32x4){0.f, 0.f, 0.f, 0.f};
#pragma unroll 1
    for (int n0 = 0; n0 < 64; n0 += 8) {
        u32x2 tmp[8]; f32x4 dc[8];
#pragma unroll
        for (int u = 0; u < 8; ++u) { tmp[u] = p[(size_t)(n0 + u) * 8192]; dc[u] = dp[(n0 + u) * 32]; }
#pragma unroll
        for (int u = 0; u < 8; ++u) { u32x2 w; w.x = pk2(st.x, st.y); w.y = pk2(st.z, st.w); p[(size_t)(n0 + u) * 8192] = w;
            st = dc[u] * st + (f32x4){bflo(tmp[u].x), bfhi(tmp[u].x), bflo(tmp[u].y), bfhi(tmp[u].y)}; }
    }
}
DI void glaC_item(const Ctx& C, int l, int idx, const bf16* PROJ, const float* ALOW, const bf16* SBUF, bf16* CONCAT) {
    const int b = idx >> 8, h = (idx >> 6) & 3, n = idx & 63, t0 = b * SEQ + n * 64;
    LAS float* al = (LAS float*)(C.lds); LAS float* tot = (LAS float*)(C.lds + 4096); LAS float* RS = (LAS float*)(C.lds + 6144);
    LAS bf16* QT = (LAS bf16*)(C.lds + 8192); LAS bf16* KT = (LAS bf16*)(C.lds + 25600); LAS bf16* QG = (LAS bf16*)(C.lds + 43008);
    LAS bf16* VL = (LAS bf16*)(C.lds + 60416); LAS bf16* PL = (LAS bf16*)(C.lds + 94208);
    const int d = C.tid & 127, jg = C.tid >> 7;
    bf16 qraw[16], kraw[16];
#pragma unroll
    for (int jj = 0; jj < 16; ++jj) { const bf16* row = PROJ + (size_t)(t0 + jg * 16 + jj) * NPROJ + h * 128 + d; qraw[jj] = row[C_Q]; kraw[jj] = row[C_K]; }
    float Gl[16], off, gref, g63;
    gla_gates(C, al, tot, ALOW, C.in[I_WA2] + (size_t)l * 16 * 512, C.in[I_BA] + (size_t)l * 512, t0, h, Gl, off, gref, g63);
#pragma unroll
    for (int jj = 0; jj < 16; ++jj) { const int j = jg * 16 + jj; const float Gv = off + Gl[jj];
        const float q = bf1(qraw[jj]) * 0.08838834764831845f, k = bf1(kraw[jj]);
        QT[j * KST + d] = (bf16)f2bf(q * fexp2(Gv - gref)); KT[j * KST + d] = (bf16)f2bf(k * fexp2(gref - Gv)); QG[j * KST + d] = (bf16)f2bf(q * fexp2(Gv)); }
    load_v_tile(C, PROJ, t0, h, VL);
    const int lane = C.lane, g = lane >> 4, qq = (lane & 15) >> 2, p = lane & 3, fr = lane & 15;
    bf16x8 Sf[2][4]; u32x2 rraw[4][2];
#pragma unroll
    for (int mi = 0; mi < 2; ++mi) { const bf16* Srow = SBUF + ((size_t)idx * 256 + 16 * (2 * C.wave + mi) + fr) * 128 + 8 * g;
#pragma unroll
        for (int ks = 0; ks < 4; ++ks) Sf[mi][ks] = *(const bf16x8*)(Srow + 32 * ks); }
#pragma unroll
    for (int nt = 0; nt < 4; ++nt)
#pragma unroll
        for (int mi = 0; mi < 2; ++mi) rraw[nt][mi] = *(const u32x2*)(PROJ + (size_t)(t0 + 16 * nt + fr) * NPROJ + C_R + h * 256 + 16 * (2 * C.wave + mi) + 4 * g);
    __syncthreads();
    {
        const int nt = C.wave & 3;
#pragma unroll
        for (int mi = 0; mi < 2; ++mi) { const int mt = 2 * (C.wave >> 2) + mi; f32x4 acc = (f32x4){0.f, 0.f, 0.f, 0.f};
#pragma unroll
            for (int ks = 0; ks < 4; ++ks) { const bf16x8 a = *(const LAS bf16x8*)(KT + (16 * mt + fr) * KST + 32 * ks + 8 * g), bq = *(const LAS bf16x8*)(QT + (16 * nt + fr) * KST + 32 * ks + 8 * g); acc = mfma16(a, bq, acc); }
            const int i = 16 * nt + fr, j0 = 16 * mt + 4 * g;
            const float v0 = (j0 + 0 <= i) ? acc[0] : 0.f, v1 = (j0 + 1 <= i) ? acc[1] : 0.f, v2 = (j0 + 2 <= i) ? acc[2] : 0.f, v3 = (j0 + 3 <= i) ? acc[3] : 0.f;
            u32x2 w; w.x = pk2(v0, v1); w.y = pk2(v2, v3); *(LAS u32x2*)(PL + i * PST + j0) = w; }
    }
    __syncthreads();
    f32x4 acc[2][4];
#pragma unroll
    for (int mi = 0; mi < 2; ++mi)
#pragma unroll
        for (int nt = 0; nt < 4; ++nt) acc[mi][nt] = (f32x4){0.f, 0.f, 0.f, 0.f};
#pragma unroll
    for (int mi = 0; mi < 2; ++mi) { const int mt = 2 * C.wave + mi;
#pragma unroll
        for (int ks = 0; ks < 2; ++ks) { const bf16x8 a = tr8(VL + (32 * ks + 8 * g + qq) * VST + 16 * mt + 4 * p, VST);
#pragma unroll
            for (int nt = 0; nt < 4; ++nt) { const bf16x8 bp = *(const LAS bf16x8*)(PL + (16 * nt + fr) * PST + 32 * ks + 8 * g); acc[mi][nt] = mfma16(a, bp, acc[mi][nt]); } }
#pragma unroll
        for (int ks = 0; ks < 4; ++ks) { const bf16x8 a = Sf[mi][ks];
#pragma unroll
            for (int nt = 0; nt < 4; ++nt) { const bf16x8 bq = *(const LAS bf16x8*)(QG + (16 * nt + fr) * KST + 32 * ks + 8 * g); acc[mi][nt] = mfma16(a, bq, acc[mi][nt]); } }
    }
#pragma unroll
    for (int nt = 0; nt < 4; ++nt) { float s = 0.f;
#pragma unroll
        for (int mi = 0; mi < 2; ++mi) s += (acc[mi][nt][0] * acc[mi][nt][0] + acc[mi][nt][1] * acc[mi][nt][1]) + (acc[mi][nt][2] * acc[mi][nt][2] + acc[mi][nt][3] * acc[mi][nt][3]);
        s += __shfl_xor(s, 16); s += __shfl_xor(s, 32);
        if (g == 0) RS[C.wave * 64 + 16 * nt + fr] = s; }
    __syncthreads();
    const float* ng = C.in[I_GNG] + (size_t)(l * 4 + h) * 256;
#pragma unroll
    for (int nt = 0; nt < 4; ++nt) { const int i = 16 * nt + fr; float ts = 0.f;
#pragma unroll
        for (int w = 0; w < 8; ++w) ts += RS[w * 64 + i];
        const float rstd = frsq(ts * (1.f / 256.f) + EPS);
#pragma unroll
        for (int mi = 0; mi < 2; ++mi) { const int e = 16 * (2 * C.wave + mi) + 4 * g;
            const u32x2 rr = rraw[nt][mi]; const f32x4 gg = *(const f32x4*)(ng + e);
            const float o0 = acc[mi][nt][0] * rstd * gg.x * silu_f(bflo(rr.x)), o1 = acc[mi][nt][1] * rstd * gg.y * silu_f(bfhi(rr.x));
            const float o2 = acc[mi][nt][2] * rstd * gg.z * silu_f(bflo(rr.y)), o3 = acc[mi][nt][3] * rstd * gg.w * silu_f(bfhi(rr.y));
            u32x2 w; w.x = pk2(o0, o1); w.y = pk2(o2, o3); *(u32x2*)(CONCAT + (size_t)(t0 + i) * D + h * 256 + e) = w; } }
    __syncthreads();
}
constexpr int GST = 136;
DI void gmlp_item(const Ctx& C, int l, int idx, const bf16* PROJ, const bf16* WSB, bf16* CONCAT) {
    const int h = idx & 7, n = (idx >> 3) & 31, b = idx >> 8, t0 = b * SEQ + n * 128;
    LAS bf16* VL2 = (LAS bf16*)(C.lds); LAS bf16* UL = (LAS bf16*)(C.lds + 34816);
    const float* vg = C.in[I_VNG] + (size_t)(l * 8 + h) * 128; const float* og = C.in[I_MOG] + (size_t)(l * 8 + h) * 128; const float* bb = C.in[I_MB] + (size_t)(l * 8 + h) * 128;
    bf16x8 Wf[4];
    { const bf16* Wrow = WSB + ((size_t)(l * 8 + h) * 128 + 16 * C.wave + (C.lane & 15)) * 128 + 8 * (C.lane >> 4);
#pragma unroll
      for (int ks = 0; ks < 4; ++ks) Wf[ks] = *(const bf16x8*)(Wrow + 32 * ks); }
#pragma unroll
    for (int i = 0; i < 4; ++i) { const int c = C.tid + 512 * i, t = c >> 4, ch = c & 15;
        const bf16* row = PROJ + (size_t)(t0 + t) * NPROJ + h * 128 + 8 * ch;
        const u32x4 uu = *(const u32x4*)(row + C_U), vv = *(const u32x4*)(row + C_VS);
        float v[8] = {gelu_t(bflo(vv.x)), gelu_t(bfhi(vv.x)), gelu_t(bflo(vv.y)), gelu_t(bfhi(vv.y)), gelu_t(bflo(vv.z)), gelu_t(bfhi(vv.z)), gelu_t(bflo(vv.w)), gelu_t(bfhi(vv.w))};
        float ss = 0.f;
#pragma unroll
        for (int k = 0; k < 8; ++k) ss += v[k] * v[k];
        ss += __shfl_xor(ss, 1); ss += __shfl_xor(ss, 2); ss += __shfl_xor(ss, 4); ss += __shfl_xor(ss, 8);
        const float rstd = frsq(ss * (1.f / 128.f) + EPS);
        const f32x4 g0 = *(const f32x4*)(vg + 8 * ch), g1 = *(const f32x4*)(vg + 8 * ch + 4);
        u32x4 wv; wv.x = pk2(v[0] * rstd * g0.x, v[1] * rstd * g0.y); wv.y = pk2(v[2] * rstd * g0.z, v[3] * rstd * g0.w); wv.z = pk2(v[4] * rstd * g1.x, v[5] * rstd * g1.y); wv.w = pk2(v[6] * rstd * g1.z, v[7] * rstd * g1.w);
        *(LAS u32x4*)(VL2 + t * GST + 8 * ch) = wv;
        u32x4 wu; wu.x = pk2(gelu_t(bflo(uu.x)), gelu_t(bfhi(uu.x))); wu.y = pk2(gelu_t(bflo(uu.y)), gelu_t(bfhi(uu.y))); wu.z = pk2(gelu_t(bflo(uu.z)), gelu_t(bfhi(uu.z))); wu.w = pk2(gelu_t(bflo(uu.w)), gelu_t(bfhi(uu.w)));
        *(LAS u32x4*)(UL + t * GST + 8 * ch) = wu; }
    __syncthreads();
    const int lane = C.lane, g = lane >> 4, qq = (lane & 15) >> 2, p = lane & 3, fr = lane & 15;
    f32x4 acc[8];
#pragma unroll
    for (int mt = 0; mt < 8; ++mt) acc[mt] = (f32x4){0.f, 0.f, 0.f, 0.f};
    const int nks = (C.wave >> 1) + 1;
#pragma unroll
    for (int ks = 0; ks < 4; ++ks) if (ks < nks) { const bf16x8 bw = Wf[ks];
#pragma unroll
        for (int mt = 0; mt < 8; ++mt) { const bf16x8 a = tr8(VL2 + (32 * ks + 8 * g + qq) * GST + 16 * mt + 4 * p, GST); acc[mt] = mfma16(a, bw, acc[mt]); } }
    const int tl = 16 * C.wave + fr; const float bt = bb[tl]; float ss = 0.f;
#pragma unroll
    for (int mt = 0; mt < 8; ++mt) { const u32x2 uu = *(const LAS u32x2*)(UL + tl * GST + 16 * mt + 4 * g);
        acc[mt][0] = bflo(uu.x) * (acc[mt][0] + bt); acc[mt][1] = bfhi(uu.x) * (acc[mt][1] + bt); acc[mt][2] = bflo(uu.y) * (acc[mt][2] + bt); acc[mt][3] = bfhi(uu.y) * (acc[mt][3] + bt);
        ss += (acc[mt][0] * acc[mt][0] + acc[mt][1] * acc[mt][1]) + (acc[mt][2] * acc[mt][2] + acc[mt][3] * acc[mt][3]); }
    ss += __shfl_xor(ss, 16); ss += __shfl_xor(ss, 32);
    const float rstd = frsq(ss * (1.f / 128.f) + EPS);
#pragma unroll
    for (int mt = 0; mt < 8; ++mt) { const f32x4 gg = *(const f32x4*)(og + 16 * mt + 4 * g);
        u32x2 w; w.x = pk2(acc[mt][0] * rstd * gg.x, acc[mt][1] * rstd * gg.y); w.y = pk2(acc[mt][2] * rstd * gg.z, acc[mt][3] * rstd * gg.w);
        *(u32x2*)(CONCAT + (size_t)(t0 + tl) * D + 1024 + h * 128 + 16 * mt + 4 * g) = w; }
    __syncthreads();
}
DI void list_insert(float (&L)[16], float x) {
#pragma unroll
    for (int i = 15; i >= 1; --i) L[i] = __builtin_amdgcn_fmed3f(x, L[i - 1], L[i]);
    L[0] = fmaxf(L[0], x);
}
DI void list_merge_xor(float (&L)[16], int mask) {
    float M[16];
#pragma unroll
    for (int i = 0; i < 16; ++i) M[i] = fmaxf(L[i], __shfl_xor(L[15 - i], mask));
#pragma unroll
    for (int s = 8; s >= 1; s >>= 1)
#pragma unroll
        for (int i = 0; i < 16; ++i) if ((i & s) == 0) { const float hi = fmaxf(M[i], M[i + s]), lo = fminf(M[i], M[i + s]); M[i] = hi; M[i + s] = lo; }
#pragma unroll
    for (int i = 0; i < 16; ++i) L[i] = M[i];
}
DI unsigned fbits(float x) { return __builtin_bit_cast(unsigned, x); }
DI float unp7(float x) { return __builtin_bit_cast(float, __builtin_bit_cast(unsigned, x) & 0xFFFFFF80u); }
constexpr int TKST = 136;
DI void topk_phase(const Ctx& C, int l, const bf16* QB, const bf16* K1B, const bf16* K2B, const int* KU, const int* KV, int* EB, float* PG) {
    LAS bf16* KL = (LAS bf16*)C.lds;
    LAS unsigned* tk = (LAS unsigned*)(C.lds + 2 * 128 * TKST * 2 + C.wave * 2048);
    const int lane = C.lane, fr = lane & 15, fq = lane >> 4, h = C.bid & 7, rank = C.bid >> 3;
#pragma unroll
    for (int i = 0; i < 8; ++i) { const int c = C.tid + 512 * i, tb = c >> 11, row = (c & 2047) >> 4, ch = c & 15;
        *(LAS u32x4*)(KL + (tb * 128 + row) * TKST + 8 * ch) = *(const u32x4*)((tb ? K2B : K1B) + ((size_t)(l * 8 + h) * 128 + row) * 128 + 8 * ch); }
    __syncthreads();
#pragma unroll 1
    for (int it = 0; it < 4; ++it) {
        const int tt0 = rank * 512 + C.wave * 64 + it * 16;
        float L[2][16];
        bf16x8 bq[2][4];
#pragma unroll
        for (int half = 0; half < 2; ++half)
#pragma unroll
            for (int ks = 0; ks < 4; ++ks) bq[half][ks] = *(const bf16x8*)(QB + (size_t)(tt0 + fr) * D + h * 256 + half * 128 + 8 * fq + 32 * ks);
#pragma unroll
        for (int half = 0; half < 2; ++half) {
            f32x4 acc[8];
#pragma unroll
            for (int mt = 0; mt < 8; ++mt) acc[mt] = (f32x4){0.f, 0.f, 0.f, 0.f};
            const LAS bf16* Kb = KL + (half * 128 + fr) * TKST + 8 * fq;
#pragma unroll
            for (int ks = 0; ks < 4; ++ks)
#pragma unroll
                for (int mt = 0; mt < 8; ++mt) { const bf16x8 a = *(const LAS bf16x8*)(Kb + (16 * mt) * TKST + 32 * ks); acc[mt] = mfma16(a, bq[half][ks], acc[mt]); }
#pragma unroll
            for (int i = 0; i < 16; ++i) L[half][i] = __builtin_bit_cast(float, 0xFF800000u);
#pragma unroll
            for (int mt = 0; mt < 8; ++mt)
#pragma unroll
                for (int r = 0; r < 4; ++r) { const unsigned key = (unsigned)(16 * mt + 4 * fq + r);
                    const float sv = acc[mt][r];
                    list_insert(L[half], __builtin_bit_cast(float, (fbits(sv) & 0xFFFFFF80u) | key)); }
            list_merge_xor(L[half], 16); list_merge_xor(L[half], 32);
        }
        if (fq == 0) {
#pragma unroll
            for (int i = 0; i < 16; ++i) { tk[(fr * 2 + 0) * 16 + i] = fbits(L[0][i]); tk[(fr * 2 + 1) * 16 + i] = fbits(L[1][i]); }
        }
        float Cn[16];
#pragma unroll
        for (int i = 0; i < 16; ++i) Cn[i] = __builtin_bit_cast(float, 0xFF800000u);
#pragma unroll
        for (int i = 0; i < 16; ++i)
#pragma unroll
            for (int j = 0; j < 16; ++j) if ((i + 1) * (j + 1) <= 16) {
                const float s = unp7(L[0][i]) + unp7(L[1][j]);
                list_insert(Cn, __builtin_bit_cast(float, (fbits(s) & 0xFFFFFF00u) | (unsigned)(i * 16 + j))); }
        LDS_WAIT();
        float sc[4]; int ex[4];
#pragma unroll
        for (int m = 0; m < 4; ++m) {
            const float ck = fq == 0 ? Cn[m] : (fq == 1 ? Cn[4 + m] : (fq == 2 ? Cn[8 + m] : Cn[12 + m]));
            const unsigned cc = fbits(ck) & 255u;
            const unsigned p1 = tk[(fr * 2 + 0) * 16 + (cc >> 4)], p2 = tk[(fr * 2 + 1) * 16 + (cc & 15u)];
            sc[m] = __builtin_bit_cast(float, p1 & 0xFFFFFF80u) + __builtin_bit_cast(float, p2 & 0xFFFFFF80u);
            ex[m] = (int)((p1 & 127u) * 128u + (p2 & 127u));
        }
        float mx = fmaxf(fmaxf(sc[0], sc[1]), fmaxf(sc[2], sc[3]));
        mx = fmaxf(mx, __shfl_xor(mx, 16)); mx = fmaxf(mx, __shfl_xor(mx, 32));
        float w[4], sum = 0.f;
#pragma unroll
        for (int m = 0; m < 4; ++m) { w[m] = fexp2((sc[m] - mx) * 1.442695041f); sum += w[m]; }
        sum += __shfl_xor(sum, 16); sum += __shfl_xor(sum, 32);
        const float inv = 1.0f / sum;
        const size_t o = (size_t)(tt0 + fr) * 128 + h * 16 + 4 * fq;
#pragma unroll
        for (int m = 0; m < 4; ++m) { const int ku = KU[ex[m]], kv = KV[ex[m]]; w[m] = w[m] * inv * __builtin_bit_cast(float, (unsigned)(127 - kv) << 23); ex[m] |= (127 - ku) << 16; }
        *(int4*)(EB + o) = make_int4(ex[0], ex[1], ex[2], ex[3]);
        *(f32x4*)(PG + o) = (f32x4){w[0], w[1], w[2], w[3]};
        LDS_WAIT();
    }
}
typedef unsigned char fp8_t;
DI void unpack16(const u32x4 q, float (&f)[16]) {
#pragma unroll
    for (int w = 0; w < 4; ++w) { const int dw = (int)q[w]; const f32x2 lo = __builtin_amdgcn_cvt_pk_f32_fp8(dw, false), hi = __builtin_amdgcn_cvt_pk_f32_fp8(dw, true);
        f[4 * w] = lo.x; f[4 * w + 1] = lo.y; f[4 * w + 2] = hi.x; f[4 * w + 3] = hi.y; }
}
typedef long i64_t;
DI f32x4 sel4(bool c, const f32x4 a, const f32x4 b) { return (f32x4){c ? a.x : b.x, c ? a.y : b.y, c ? a.z : b.z, c ? a.w : b.w}; }
constexpr int PU_RST = 272, PU_TILE = 16 * PU_RST, PU_WAVE = 2 * PU_TILE;
DI void peerU_phase(const Ctx& C, const unsigned char* H8, const int* EB, const fp8_t* PU8, float* PART, const int emask = 0xFFFF) {
    const int x = C.bid & 7, rank = C.bid >> 3, lane = C.lane, kq = lane >> 4, m16 = lane & 15;
    const fp8_t* tab = PU8 + (size_t)x * NEXP * 256 + 16 * m16;
    float* part = PART + (size_t)x * T * 128;
    const int tbase = rank * 512 + C.wave * 64;
    const int* ebase = EB + (size_t)tbase * 128 + lane;
    const unsigned char* hbase = H8 + (size_t)tbase * 4096 + (m16 & 1) * 2048 + 256 * x + 8 * kq;
    ldsp wl = C.lds + C.wave * PU_WAVE;
    const int wr_off = kq * PU_RST + 16 * m16;
    const int rd_off = m16 * PU_RST + 8 * kq;
    const int bp0 = 4 * kq;
    int ep0 = ebase[0], ep1 = ebase[64], ep0n = ebase[128], ep1n = ebase[192];
    u32x2 hc[8], hn[8];
#pragma unroll
    for (int c = 0; c < 8; ++c) { hc[c] = *(const u32x2*)(hbase + 32 * c); hn[c] = *(const u32x2*)(hbase + 4096 + 32 * c); }
    u32x4 ra[8], rb[8];
#define PU_ISSUE(BUF, ESEL, Q1) do { _Pragma("unroll") for (int i_ = 0; i_ < 8; ++i_) { const int ad_ = (bp0 + 4 * (32 * (Q1) + 4 * i_)) & 255; \
        const int e_ = __builtin_amdgcn_ds_bpermute(ad_, (ESEL)) & emask; BUF[i_] = *(const u32x4*)(tab + (size_t)e_ * 256); } } while (0)
#define PU_STEP(BUF, T0) do { _Pragma("unroll") for (int i_ = 0; i_ < 8; ++i_) *(LAS u32x4*)(wl + wr_off + (i_ >> 2) * PU_TILE + (i_ & 3) * 4 * PU_RST) = BUF[i_]; \
        _Pragma("unroll") for (int tt = 0; tt < 2; ++tt) _Pragma("unroll") for (int c = 0; c < 8; ++c) { const u32x2 av_ = *(const LAS u32x2*)(wl + rd_off + tt * PU_TILE + 32 * c); \
            acc[(T0) + tt] = __builtin_amdgcn_mfma_f32_16x16x32_fp8_fp8((i64_t)(((unsigned long long)av_.y << 32) | av_.x), (i64_t)(((unsigned long long)hc[c].y << 32) | hc[c].x), acc[(T0) + tt], 0, 0, 0); } } while (0)
    PU_ISSUE(ra, ep0, 0);
    f32x2 pend = (f32x2){0.f, 0.f}; f32x2* pend_p = nullptr;
#pragma unroll 1
    for (int ti = 0; ti < 64; ++ti) {
        const int t = tbase + ti;
        f32x4 acc[8];
#pragma unroll
        for (int tl = 0; tl < 8; ++tl) acc[tl] = (f32x4){0.f, 0.f, 0.f, 0.f};
        PU_ISSUE(rb, ep0, 1);
        if (ti > 0) *pend_p = pend;
        PU_STEP(ra, 0);
        PU_ISSUE(ra, ep1, 2); PU_STEP(rb, 2);
        PU_ISSUE(rb, ep1, 3); PU_STEP(ra, 4);
        if (ti + 1 < 64) PU_ISSUE(ra, ep0n, 0);
        PU_STEP(rb, 6);
        {   const int n = m16, rg = kq;
            const f32x4 s01 = sel4((n >> 1) & 1, acc[1], acc[0]), s23 = sel4((n >> 1) & 1, acc[3], acc[2]), s45 = sel4((n >> 1) & 1, acc[5], acc[4]), s67 = sel4((n >> 1) & 1, acc[7], acc[6]);
            const f32x4 s03 = sel4((n >> 2) & 1, s23, s01), s47 = sel4((n >> 2) & 1, s67, s45), sv = sel4((n >> 3) & 1, s47, s03);
            const float p0 = dppf<0xB1>(sv.x), p1 = dppf<0xB1>(sv.y), p2 = dppf<0xB1>(sv.z), p3 = dppf<0xB1>(sv.w);
            const bool odd = n & 1;
            const float o0 = odd ? (p2 + sv.z * 0.0625f) : (sv.x + p0 * 0.0625f), o1 = odd ? (p3 + sv.w * 0.0625f) : (sv.y + p1 * 0.0625f);
            pend = (f32x2){o0 * 0.0625f, o1 * 0.0625f}; pend_p = (f32x2*)(part + (size_t)t * 128 + 16 * (n >> 1) + 4 * rg + 2 * (n & 1)); }
        ep0 = ep0n; ep1 = ep1n;
#pragma unroll
        for (int c = 0; c < 8; ++c) hc[c] = hn[c];
        if (ti + 2 < 64) { ep0n = ebase[(ti + 2) * 128]; ep1n = ebase[(ti + 2) * 128 + 64];
#pragma unroll
            for (int c = 0; c < 8; ++c) hn[c] = *(const u32x2*)(hbase + (size_t)(ti + 2) * 4096 + 32 * c); }
    }
    *pend_p = pend;
#undef PU_ISSUE
#undef PU_STEP
}
typedef int v2i32_t __attribute__((ext_vector_type(2)));
constexpr int PV_TILE = 32 * PU_RST, PV_A8 = PV_TILE, PV_Y = PV_TILE + 256, PV_WAVE = 10240;
DI float wave_max_u(float v) {
    v = fmaxf(v, dppf<0xB1>(v)); v = fmaxf(v, dppf<0x4E>(v)); v = fmaxf(v, dppf<0x141>(v)); v = fmaxf(v, dppf<0x140>(v));
    const int iv = __builtin_bit_cast(int, v);
    return fmaxf(fmaxf(__builtin_bit_cast(float, __builtin_amdgcn_readlane(iv, 0)), __builtin_bit_cast(float, __builtin_amdgcn_readlane(iv, 16))),
                 fmaxf(__builtin_bit_cast(float, __builtin_amdgcn_readlane(iv, 32)), __builtin_bit_cast(float, __builtin_amdgcn_readlane(iv, 48))));
}
DI void peerV_phase(const Ctx& C, const int* EB, const float* PG, const float* PART, const fp8_t* PV8, float* X, const float* gate  , const int emask = 0xFFFF, const int FAKE = 0) {
    const int x = C.bid & 7, rank = C.bid >> 3, lane = C.lane, kq = lane >> 4, m16 = lane & 15;
    const fp8_t* tab = PV8 + (size_t)x * NEXP * 256 + 16 * m16;
    const int tbase = rank * 512 + C.wave * 64;
    ldsp wl = C.lds + C.wave * PV_WAVE;
    const int wr_off = kq * PU_RST + 16 * m16;
    const int tr_off = (8 * kq + (m16 >> 1)) * PU_RST + 8 * (m16 & 1);
    const int a_off = PV_A8 + (m16 & 1) * 128 + 8 * kq;
    const int bp0 = 4 * kq;
    float pr0[8], pr1[8]; int rep0, rep1; float rg0, rg1;
#define PV_LOAD_RAW(tt) do { _Pragma("unroll") for (int xx = 0; xx < 8; ++xx) { const float* pp = PART + ((size_t)xx * T + (tt)) * 128 + lane; pr0[xx] = pp[0]; pr1[xx] = pp[64]; } \
        rep0 = EB[(size_t)(tt) * 128 + lane]; rep1 = EB[(size_t)(tt) * 128 + 64 + lane]; rg0 = PG[(size_t)(tt) * 128 + lane]; rg1 = PG[(size_t)(tt) * 128 + 64 + lane]; } while (0)
#define PV_FINISH(A0, A1, E0, E1) do { const float s0_ = ((pr0[0] + pr0[1]) + (pr0[2] + pr0[3])) + ((pr0[4] + pr0[5]) + (pr0[6] + pr0[7])), s1_ = ((pr1[0] + pr1[1]) + (pr1[2] + pr1[3])) + ((pr1[4] + pr1[5]) + (pr1[6] + pr1[7])); \
        A0 = gelu_t(s0_ * __builtin_bit_cast(float, (unsigned)(rep0 >> 16) << 23)) * rg0; A1 = gelu_t(s1_ * __builtin_bit_cast(float, (unsigned)(rep1 >> 16) << 23)) * rg1; E0 = (rep0 & emask) * 256; E1 = (rep1 & emask) * 256; } while (0)
    float a0, a1, a0n = 0.f, a1n = 0.f; int e0, e1, e0n = 0, e1n = 0;
    PV_LOAD_RAW(tbase); PV_FINISH(a0, a1, e0, e1);
    PV_LOAD_RAW(tbase + 1);
    u32x4 ra[8], rb[8];
#define PV_ISSUE(BUF, ESEL, Q1) do { _Pragma("unroll") for (int i_ = 0; i_ < 8; ++i_) { const int ad_ = (bp0 + 4 * (32 * (Q1) + 4 * i_)) & 255; \
        const int eo_ = __builtin_amdgcn_ds_bpermute(ad_, (ESEL)); BUF[i_] = *(const u32x4*)(tab + eo_); } } while (0)
#define PV_STEP(BUF, KS) do { _Pragma("unroll") for (int i_ = 0; i_ < 8; ++i_) *(LAS u32x4*)(wl + wr_off + i_ * 4 * PU_RST) = BUF[i_]; \
        const u32x2 ao_ = *(const LAS u32x2*)(wl + a_off + 32 * (KS)); const i64_t aop_ = (i64_t)(((unsigned long long)ao_.y << 32) | ao_.x); \
        _Pragma("unroll") for (int nt = 0; nt < 16; ++nt) { const v2i32_t bv_ = __builtin_amdgcn_ds_read_tr8_b64_v2i32((LAS v2i32_t*)(wl + tr_off + 16 * nt)); \
            acc[nt] = __builtin_amdgcn_mfma_f32_16x16x32_fp8_fp8(aop_, (i64_t)(((unsigned long long)(unsigned)bv_[1] << 32) | (unsigned)bv_[0]), acc[nt], 0, 0, 0); } } while (0)
    PV_ISSUE(ra, e0, 0);
    f32x4 xpend = (f32x4){0.f, 0.f, 0.f, 0.f}; f32x4* xpend_p = nullptr;
#pragma unroll 1
    for (int ti = 0; ti < 64; ++ti) {
        const int t = tbase + ti;
        const float amax = wave_max_u(fmaxf(fabsf(a0), fabsf(a1)));
        int ka = 0; if (amax > 0.f) { ka = (int)((__builtin_bit_cast(unsigned, 224.0f / amax) >> 23) & 255u) - 127; ka = ka < -100 ? -100 : (ka > 100 ? 100 : ka); }
        const float sca = __builtin_bit_cast(float, (unsigned)(ka + 127) << 23), inva = __builtin_bit_cast(float, (unsigned)(127 - ka) << 23);
        {   const float s0 = a0 * sca, s1 = a1 * sca;
            const int ph = __builtin_amdgcn_cvt_pk_fp8_f32(s0, s1, 0, false); const f32x2 bk = __builtin_amdgcn_cvt_pk_f32_fp8(ph, false);
            const int pl = __builtin_amdgcn_cvt_pk_fp8_f32((s0 - bk.x) * 16.0f, (s1 - bk.y) * 16.0f, 0, false);
            LAS unsigned char* a8 = (LAS unsigned char*)(wl + PV_A8);
            a8[lane] = (unsigned char)(ph & 255); a8[64 + lane] = (unsigned char)((ph >> 8) & 255); a8[128 + lane] = (unsigned char)(pl & 255); a8[192 + lane] = (unsigned char)((pl >> 8) & 255); }
        f32x4 acc[16];
#pragma unroll
        for (int nt = 0; nt < 16; ++nt) acc[nt] = (f32x4){0.f, 0.f, 0.f, 0.f};
        const int col = 256 * x + 4 * lane, b = t >> 12;
        f32x4* xp = (f32x4*)(X + (size_t)t * D + col);
        f32x4 xold = (f32x4){0.f, 0.f, 0.f, 0.f}; if (!FAKE) xold = *xp;
        const f32x4 gt = *(const f32x4*)(gate + (size_t)b * MODW + col);
        PV_ISSUE(rb, e0, 1);
        if (ti > 0 && !FAKE) *xpend_p = xpend;
        PV_STEP(ra, 0);
        PV_ISSUE(ra, e1, 2); PV_STEP(rb, 1);
        if (ti + 1 < 64) PV_FINISH(a0n, a1n, e0n, e1n);
        PV_ISSUE(rb, e1, 3); PV_STEP(ra, 2);
        if (ti + 2 < 64) PV_LOAD_RAW(t + 2);
        if (ti + 1 < 64) PV_ISSUE(ra, e0n, 0);
        PV_STEP(rb, 3);
        if (kq == 0) {
#pragma unroll
            for (int nt = 0; nt < 16; ++nt) *(LAS float*)(wl + PV_Y + 4 * (16 * nt + m16)) = (acc[nt][0] + acc[nt][1] * 0.0625f) * inva; }
        const f32x4 y = *(const LAS f32x4*)(wl + PV_Y + 16 * lane);
        if (FAKE) { if (y.x == 123.456f) *xp = y; }
        xpend = xold + gt * y; xpend_p = xp;
        a0 = a0n; a1 = a1n; e0 = e0n; e1 = e1n;
    }
    if (!FAKE) *xpend_p = xpend;
#undef PV_LOAD_RAW
#undef PV_FINISH
#undef PV_ISSUE
#undef PV_STEP
}
DI void final_norm_phase(const Ctx& C, float* X, const float* g) {
    const int r0 = C.gw * 8;
    f32x4 gm[8];
#pragma unroll
    for (int j = 0; j < 8; ++j) gm[j] = ((const f32x4*)g)[64 * j + C.lane];
#pragma unroll 1
    for (int i = 0; i < 8; ++i) {
        f32x4* xr = (f32x4*)(X + (size_t)(r0 + i) * D) + C.lane; f32x4 v[8]; float s = 0.f;
#pragma unroll
        for (int j = 0; j < 8; ++j) { v[j] = xr[64 * j]; s += (v[j].x * v[j].x + v[j].y * v[j].y) + (v[j].z * v[j].z + v[j].w * v[j].w); }
        const float rstd = frsq(wave_sum(s) * (1.f / D) + EPS);
#pragma unroll
        for (int j = 0; j < 8; ++j) xr[64 * j] = v[j] * rstd * gm[j];
    }
}
#ifndef PH_MASK
#define PH_MASK 0xFFFFF
#endif
#define EN(k) (((PH_MASK) >> (k)) & 1)
constexpr int NKIND = 11, NPH = 2 + 2 * NKIND;
struct Args { const float* in[21]; float* out; unsigned char* ws; int ph_lo, ph_hi, pad0, pad1; };
__global__ void __launch_bounds__(NTHR, 2) mk_fwd(Args args) {
    extern __shared__ __attribute__((aligned(16))) unsigned char lds_raw[];
    ldsp ldsb = (ldsp)lds_raw;
    volatile LAS unsigned* MISC = (volatile LAS unsigned*)(ldsb + MISC_OFF);
    for (int u = threadIdx.x; u < (LDS_BYTES - LDSCTL_OFF) / 4; u += NTHR) ((LAS unsigned*)(ldsb + LDSCTL_OFF))[u] = 0u;
    __syncthreads();
    unsigned* barw = (unsigned*)(args.ws + WS_CTL) + CW_BAR;
    XcdBarrier bar; bar.bar = barw; bar.x = 0; bar.st = nullptr;
    const bool multi = (args.ph_hi - args.ph_lo) > 1;
    if (multi) bar = xcd_barrier_post(barw, MISC + 8);

    int repflag = 0; (void)repflag;
#pragma unroll 1
    for (int ph = args.ph_lo; ph < args.ph_hi; ++ph) {
#define MKCTX Ctx C; { int tid_ = threadIdx.x, bid_ = blockIdx.x; asm volatile("" : "+v"(tid_)); asm volatile("" : "+s"(bid_)); \
        C.lds = ldsb; C.tid = tid_; C.lane = tid_ & 63; C.wave = __builtin_amdgcn_readfirstlane(tid_ >> 6); C.bid = bid_; C.G = gridDim.x; C.gw = C.bid * NWAVES + C.wave; C.NGW = C.G * NWAVES; \
        _Pragma("unroll") for (int i_ = 0; i_ < 21; ++i_) C.in[i_] = args.in[i_]; C.out = args.out; C.ws = args.ws; }
        unsigned char* const wsb = args.ws;
        float* MOD = (float*)(wsb + WS_MOD);
        bf16* Hb = (bf16*)(wsb + WS_H); bf16* PROJ = (bf16*)(wsb + WS_PROJ); bf16* SBUF = (bf16*)(wsb + WS_SBUF); bf16* CONCAT = (bf16*)(wsb + WS_CONCAT); bf16* QB = (bf16*)(wsb + WS_QB);
        float* ALOW = (float*)(wsb + WS_ALOW); float* DEC = (float*)(wsb + WS_DEC); int* EB = (int*)(wsb + WS_EB); float* PG = (float*)(wsb + WS_PG);
        float* X = args.out;
        const int l = ph < 2 ? 0 : (ph - 2) / NKIND, kind = ph < 2 ? -1 : (ph - 2) % NKIND;
        const float* modl = MOD + (size_t)l * 4 * MODW;
        if (ph == 0) { if (EN(0)) { MKCTX; p0_prologue(C); } }
        else if (ph == 1) { if (EN(1)) { MKCTX; norm_phase(C, C.in[I_X], C.in[I_N1G], modl, 0, D, Hb); } }
        else if ((kind == 0 || kind == 6) && EN(2)) {
            MKCTX; const bool isq = (kind == 6);
            pg8::Gemm g{Hb, isq ? (const bf16*)(wsb + WS_WTQ) + (size_t)l * D * D : (const bf16*)(wsb + WS_WTIN) + (size_t)l * WTIN_L, T, isq ? D : NPROJ, D};
            pg8::StaticOrder S; S.init(T, g.N, C.G, C.bid);
            pg8::EpiBf16 E{isq ? QB : PROJ, isq ? D : NPROJ};
            pg8::gemm_phase<pg8::EpiBf16, pg8::StaticOrder>(C.lds, g, S, E, C.tid);
            if (!isq) alow_phase(C, Hb, (const bf16*)(wsb + WS_WTIN) + (size_t)l * WTIN_L + (size_t)NPROJ * D, ALOW);
        }
        else if (kind == 1 && EN(3)) {
            MKCTX;
#pragma unroll 1
            for (int i = 0; i < 8; ++i) { const int idx = (i >> 1) * C.G + C.bid;
                if (idx < 1024) { if (i & 1) gmlp_item(C, l, idx, PROJ, (const bf16*)(wsb + WS_WSB), CONCAT); else glaA_item(C, l, idx, PROJ, ALOW, SBUF, DEC); } }
        }
        else if (kind == 2) { if (EN(4)) { MKCTX; scan_phase(C, SBUF, DEC); } }
        else if (kind == 3 && EN(5)) {
            MKCTX;
#pragma unroll 1
            for (int idx = C.bid; idx < 1024; idx += C.G) glaC_item(C, l, idx, PROJ, ALOW, SBUF, CONCAT);
        }
        else if (kind == 4 && EN(6)) {
            MKCTX;
            pg8::Gemm g{CONCAT, (const bf16*)(wsb + WS_WTOUT) + (size_t)l * D * D, T, D, D};
            pg8::StaticOrder S; S.init(T, D, C.G, C.bid);
            pg8::EpiResGate E{l == 0 ? C.in[I_X] : (const float*)X, X, modl + 2 * D, MODW};
            pg8::gemm_phase<pg8::EpiResGate, pg8::StaticOrder>(C.lds, g, S, E, C.tid);
        }
        else if (kind == 5) { if (EN(1)) { MKCTX; norm_phase<true>(C, X, C.in[I_N2G] + (size_t)l * D, modl, 3 * D, 4 * D, Hb, wsb + WS_H8); } }
        else if (kind == 7) { if (EN(7)) { MKCTX; topk_phase(C, l, QB, (const bf16*)(wsb + WS_K1B), (const bf16*)(wsb + WS_K2B), (const int*)(wsb + WS_KU) + l * NEXP, (const int*)(wsb + WS_KV) + l * NEXP, EB, PG); } }
#ifdef DBG_FAKE_U
        else if (kind == 8) { if (EN(8)) { MKCTX; peerU_phase(C, wsb + WS_H8, EB, (const fp8_t*)(wsb + WS_PUB) + (size_t)l * NEXP * D, (float*)(wsb + WS_END), DBG_FAKE_U); peerU_phase(C, wsb + WS_H8, EB, (const fp8_t*)(wsb + WS_PUB) + (size_t)l * NEXP * D, (float*)SBUF); } }
#else
        else if (kind == 8) { if (EN(8)) { MKCTX; peerU_phase(C, wsb + WS_H8, EB, (const fp8_t*)(wsb + WS_PUB) + (size_t)l * NEXP * D, (float*)SBUF); } }
#endif
#ifdef DBG_FAKE_V
        else if (kind == 9) { if (EN(9)) { MKCTX; const int fake = (repflag == 0); peerV_phase(C, EB, PG, (const float*)SBUF, (const fp8_t*)(wsb + WS_PVB) + (size_t)l * NEXP * D, X, modl + 5 * D, fake ? (DBG_FAKE_V) : 0xFFFF, fake); } }
#else
        else if (kind == 9) { if (EN(9)) { MKCTX; peerV_phase(C, EB, PG, (const float*)SBUF, (const fp8_t*)(wsb + WS_PVB) + (size_t)l * NEXP * D, X, modl + 5 * D); } }
#endif
        else if (EN(10)) {
            MKCTX;
            if (l == DEPTH - 1) final_norm_phase(C, X, C.in[I_FG]);
            else norm_phase(C, X, C.in[I_N1G] + (size_t)(l + 1) * D, MOD + (size_t)(l + 1) * 4 * MODW, 0, D, Hb);
        }
        if (ph + 1 < args.ph_hi) xcd_barrier(bar);
#ifdef DBG_REP_MASK
        { const int bit = ph < 2 ? ph : 2 + kind; bool want = ((DBG_REP_MASK) >> bit) & 1;
#ifdef DBG_REP_L0
          if (l != 0) want = false;
#endif
          if (want && !repflag) { repflag = 1; --ph; } else repflag = 0; }
#endif
    }
}

extern "C" void kernel_launch(void* const* d_in, const int* in_sizes, int n_in, void* d_out, int out_size, void* d_ws, size_t ws_size, hipStream_t stream) {
    static int grid = 0;
    if (grid == 0) {
        if (n_in != 21 || out_size != T * D || ws_size < WS_END) { fprintf(stderr, "kernel_launch: unexpected shapes (n_in %d, out %d, ws %zu)\n", n_in, out_size, ws_size); grid = -1; return; }
        int dev = 0, cus = 0, per_cu = 0;
        if (hipGetDevice(&dev) != hipSuccess || hipDeviceGetAttribute(&cus, hipDeviceAttributeMultiprocessorCount, dev) != hipSuccess) { grid = -1; return; }
        if (hipFuncSetAttribute((const void*)mk_fwd, hipFuncAttributeMaxDynamicSharedMemorySize, LDS_BYTES) != hipSuccess) { fprintf(stderr, "kernel_launch: hipFuncSetAttribute failed\n"); grid = -1; return; }
        if (hipOccupancyMaxActiveBlocksPerMultiprocessor(&per_cu, (const void*)mk_fwd, NTHR, LDS_BYTES) != hipSuccess || per_cu < 1) { fprintf(stderr, "kernel_launch: occupancy query says %d blocks per CU\n", per_cu); (void)hipGetLastError(); grid = -1; return; }
        if (cus != 256) { fprintf(stderr, "kernel_launch: built for a 256-CU device (got %d)\n", cus); grid = -1; return; }
        grid = cus;
    }
    if (grid < 0) return;
    (void)hipMemsetAsync((char*)d_ws + WS_CTL, 0, CTL_ZERO_BYTES, stream);
    Args a{};
    for (int i = 0; i < 21; ++i) a.in[i] = (const float*)d_in[i];
    a.out = (float*)d_out; a.ws = (unsigned char*)d_ws;
#if MK_N_LAUNCHES == 1
    a.ph_lo = 0; a.ph_hi = NPH;
    hipLaunchKernelGGL(mk_fwd, dim3(grid), dim3(NTHR), LDS_BYTES, stream, a);
#else
    for (int p = 0; p < NPH; ++p) { a.ph_lo = p; a.ph_hi = p + 1; hipLaunchKernelGGL(mk_fwd, dim3(grid), dim3(NTHR), LDS_BYTES, stream, a); }
#endif
}
```

```cpp
#include <hip/hip_runtime.h>
#include <cstdio>
#include <cstdint>
#ifndef MK_N_LAUNCHES
#define MK_N_LAUNCHES 1
#endif
namespace pg8 {
#define PG8_LAS __attribute__((address_space(3)))
typedef unsigned short bf16_t;
typedef short bf16x8 __attribute__((ext_vector_type(8)));
typedef float f32x4 __attribute__((ext_vector_type(4)));
typedef unsigned u32x4 __attribute__((ext_vector_type(4)));
constexpr int BM = 256, BK = 64, HALF = 128, HTB = HALF * BK * 2  , STAGE_BYTES = 8 * HTB, NXCD = 8, WGM = 8;

__host__ __device__ __forceinline__ int lds_byte(int r, int c) { const int st = (r >> 4) * 2 + (c >> 5), rr = r & 15, cc = c & 31, ob = rr * 64 + cc * 2; return st * 1024 + (ob ^ (((ob >> 9) & 1) << 5)); }
__host__ __device__ __forceinline__ void stage_rc(int b, int& R, int& C) { const int st = b / 1024, sb = b % 1024, swz = sb ^ (((sb >> 9) & 1) << 5); R = (st >> 1) * 16 + swz / 64; C = (st & 1) * 32 + (swz % 64) / 2; }
__host__ __device__ __forceinline__ int perm32(int rho) { const int n = rho >> 4, i = rho & 15; return 8 * (i >> 2) + 4 * n + (i & 3); }

struct Unit { int pm, pn; };
struct Gemm { const bf16_t* A; const bf16_t* Bt; int M, N, K; };

struct StaticOrder {
    int nM, nN, nwg, G, c;
    __host__ __device__ void init(int M, int N, int G_, int c_) { nM = M / BM; nN = N / BM; nwg = nM * nN; G = G_; c = c_; }
    __host__ __device__ bool next(int i, Unit& u) const {
        const long L = (long)i * G + c; if (L >= nwg) return false;
        int wgid = (int)L; { const int q = nwg / NXCD, r = nwg % NXCD, xcd = wgid % NXCD, off = wgid / NXCD; wgid = (xcd < r ? xcd * (q + 1) : r * (q + 1) + (xcd - r) * q) + off; }
        const int nig = WGM * nN, gid = wgid / nig, fm = gid * WGM, gsz = (nM - fm) < WGM ? (nM - fm) : WGM;
        u.pm = fm + ((wgid % nig) % gsz); u.pn = (wgid % nig) / gsz; return true;
    }
    __device__ __forceinline__ void a_ready(const Unit&) const {}
    __device__ __forceinline__ void done(const Unit&) const {}
};
__device__ __forceinline__ unsigned cvt_pk_bf16(float lo, float hi) { unsigned r; asm volatile("v_cvt_pk_bf16_f32 %0, %1, %2" : "=v"(r) : "v"(lo), "v"(hi)); return r; }
struct EpiBf16 {
    static constexpr bool PERM = true, AFTER_DRAIN = false;
    bf16_t* O; int ldc;
    __device__ __forceinline__ void operator()(const f32x4 (&acc)[2][2][4][2], const Unit& u, int wr, int wc, int fr, int fq) const {
        const int row0 = u.pm * BM + wr * 64 + fr; const int col0 = u.pn * BM + wc * 32 + 8 * fq;
#pragma unroll
        for (int ai = 0; ai < 2; ++ai)
#pragma unroll
            for (int m = 0; m < 4; ++m) { bf16_t* rowp = O + (size_t)(row0 + ai * HALF + m * 16) * ldc + col0;
#pragma unroll
                for (int bj = 0; bj < 2; ++bj) { const f32x4 v0 = acc[ai][bj][m][0], v1 = acc[ai][bj][m][1];
                    u32x4 w; w.x = cvt_pk_bf16(v0[0], v0[1]); w.y = cvt_pk_bf16(v0[2], v0[3]); w.z = cvt_pk_bf16(v1[0], v1[1]); w.w = cvt_pk_bf16(v1[2], v1[3]);
                    *(u32x4*)(rowp + bj * HALF) = w; } }
    }
};
struct EpiResGate {
    static constexpr bool PERM = false, AFTER_DRAIN = false;
    const float* base; float* out; const float* gate; int gpitch;
    __device__ __forceinline__ void operator()(const f32x4 (&acc)[2][2][4][2], const Unit& u, int wr, int wc, int fr, int fq) const {
        const int row0 = u.pm * BM + wr * 64 + fr, col0 = u.pn * BM + wc * 32 + 4 * fq;
        const float* gp = gate + (size_t)(u.pm >> 4) * gpitch + col0;
        f32x4 gv[2][2];
#pragma unroll
        for (int bj = 0; bj < 2; ++bj)
#pragma unroll
            for (int n = 0; n < 2; ++n) gv[bj][n] = *(const f32x4*)(gp + bj * HALF + n * 16);
#pragma unroll
        for (int ai = 0; ai < 2; ++ai)
#pragma unroll
            for (int m = 0; m < 4; ++m) { const size_t off = (size_t)(row0 + ai * HALF + m * 16) * 2048 + col0;
#pragma unroll
                for (int bj = 0; bj < 2; ++bj)
#pragma unroll
                    for (int n = 0; n < 2; ++n) { const f32x4 bs = *(const f32x4*)(base + off + bj * HALF + n * 16); *(f32x4*)(out + off + bj * HALF + n * 16) = bs + gv[bj][n] * acc[ai][bj][m][n]; }
                asm volatile("" ::: "memory"); }
    }
};

template <class Epi, class Sched>
__device__ __forceinline__ void gemm_phase(PG8_LAS unsigned char* lds, const Gemm g, const Sched& S, const Epi& E, const int tid  ) {
    const int wid = __builtin_amdgcn_readfirstlane(tid >> 6), lane = tid & 63, wr = wid >> 2, wc = wid & 3, fr = lane & 15, fq = lane >> 4;
    const int K = g.K, nt = K / BK;
    unsigned voffA[2], voffB[2];
#pragma unroll
    for (int i = 0; i < 2; ++i) { int R, C; stage_rc(tid * 16 + i * 8192, R, C); const int Rb = Epi::PERM ? ((R & ~31) + perm32(R & 31)) : R;
        voffA[i] = (unsigned)(R * K + C) * 2u; voffB[i] = (unsigned)(Rb * K + C) * 2u; }
    const size_t kstep = (size_t)(BK * 2);
    const size_t hstep = (size_t)HALF * K * 2;
    const size_t tstep = 2 * hstep;
    const unsigned ldsw = (unsigned)wid * 1024u;
    const int aoff = lds_byte(wr * 64 + fr, fq * 8), boff = lds_byte(wc * 32 + fr, fq * 8);
#define PG8_SA(b, h) (((b) * 2 + (h)) * HTB)
#define PG8_SB(b, h) ((4 + (b) * 2 + (h)) * HTB)
#define PG8_STAGE(bufoff, gbase, voff) do { _Pragma("unroll") for (int _i = 0; _i < 2; ++_i) \
        __builtin_amdgcn_global_load_lds((const unsigned*)((const char*)(gbase) + (voff)[_i]), (PG8_LAS unsigned*)(lds + (bufoff) + ldsw + _i * 8192), 16, 0, 0); } while (0)
#define PG8_LDA(dst, b, h) do { _Pragma("unroll") for (int m = 0; m < 4; ++m) _Pragma("unroll") for (int k = 0; k < 2; ++k) dst[m][k] = *(const PG8_LAS bf16x8*)(lds + PG8_SA(b, h) + aoff + m * 2048 + k * 1024); } while (0)
#define PG8_LDB(dst, b, h) do { _Pragma("unroll") for (int n = 0; n < 2; ++n) _Pragma("unroll") for (int k = 0; k < 2; ++k) dst[n][k] = *(const PG8_LAS bf16x8*)(lds + PG8_SB(b, h) + boff + n * 2048 + k * 1024); } while (0)
#define PG8_MMA(ai, bj, At, Bt) do { __builtin_amdgcn_s_setprio(1); _Pragma("unroll") for (int m = 0; m < 4; ++m) _Pragma("unroll") for (int n = 0; n < 2; ++n) _Pragma("unroll") for (int k = 0; k < 2; ++k) \
        acc[ai][bj][m][n] = __builtin_amdgcn_mfma_f32_16x16x32_bf16(Bt[n][k], At[m][k], acc[ai][bj][m][n], 0, 0, 0); __builtin_amdgcn_s_setprio(0); } while (0)
#define PG8_WAIT_V(n) asm volatile("s_waitcnt vmcnt(" #n ")" ::: "memory")
#define PG8_WAIT_L(n) asm volatile("s_waitcnt lgkmcnt(" #n ")" ::: "memory")
#define PG8_BAR __builtin_amdgcn_s_barrier()
#define PG8_SCHED __builtin_amdgcn_sched_barrier(0)
    Unit cur, nxt; int ui = 0;
    if (!S.next(0, cur)) return;
    f32x4 acc[2][2][4][2];
#pragma unroll
    for (int a = 0; a < 2; ++a)
#pragma unroll
        for (int b = 0; b < 2; ++b)
#pragma unroll
            for (int m = 0; m < 4; ++m)
#pragma unroll
                for (int n = 0; n < 2; ++n) acc[a][b][m][n] = (f32x4){0.f, 0.f, 0.f, 0.f};
    bf16x8 At[4][2], B0[2][2], B1[2][2];
    const char* cA = (const char*)g.A + (size_t)cur.pm * tstep; const char* cB = (const char*)g.Bt + (size_t)cur.pn * tstep;
    S.a_ready(cur);
    PG8_STAGE(PG8_SB(0, 0), cB, voffB); PG8_STAGE(PG8_SA(0, 0), cA, voffA); PG8_STAGE(PG8_SB(0, 1), cB + hstep, voffB); PG8_STAGE(PG8_SA(0, 1), cA + hstep, voffA);
    if (wr == 1) PG8_BAR;
    PG8_WAIT_V(4); PG8_BAR;
    PG8_STAGE(PG8_SB(1, 0), cB + kstep, voffB); PG8_STAGE(PG8_SA(1, 0), cA + kstep, voffA); PG8_STAGE(PG8_SB(1, 1), cB + hstep + kstep, voffB);
    PG8_WAIT_V(6); PG8_BAR;
    for (;;) {
        const bool has_next = S.next(ui + 1, nxt);
        const char* nA = has_next ? (const char*)g.A + (size_t)nxt.pm * tstep : cA; const char* nB = has_next ? (const char*)g.Bt + (size_t)nxt.pn * tstep : cB;
        for (int t = 0; t < nt; t += 2) {
            const bool last = (t == nt - 2);
            const char* a1 = cA + (size_t)(t + 1) * kstep;
            const char* a2 = last ? nA : cA + (size_t)(t + 2) * kstep; const char* b2 = last ? nB : cB + (size_t)(t + 2) * kstep;
            const char* a3 = a2 + kstep; const char* b3 = b2 + kstep;
            if (last && has_next) S.a_ready(nxt);
            PG8_LDB(B0, 0, 0); PG8_SCHED; PG8_LDA(At, 0, 0); PG8_STAGE(PG8_SA(1, 1), a1 + hstep, voffA);
            PG8_WAIT_L(8); PG8_BAR; PG8_WAIT_L(0); PG8_MMA(0, 0, At, B0); PG8_BAR; PG8_SCHED;
            PG8_LDB(B1, 0, 1); PG8_STAGE(PG8_SB(0, 0), b2, voffB);
            PG8_BAR; PG8_WAIT_L(0); PG8_MMA(0, 1, At, B1); PG8_BAR;
            PG8_LDA(At, 0, 1); PG8_STAGE(PG8_SA(0, 0), a2, voffA);
            PG8_BAR; PG8_WAIT_L(0); PG8_MMA(1, 0, At, B0); PG8_BAR; PG8_SCHED;
            PG8_STAGE(PG8_SB(0, 1), b2 + hstep, voffB);
            PG8_WAIT_V(6); PG8_BAR; PG8_MMA(1, 1, At, B1); PG8_BAR;
            PG8_LDB(B0, 1, 0); PG8_SCHED; PG8_LDA(At, 1, 0); PG8_STAGE(PG8_SA(0, 1), a2 + hstep, voffA);
            PG8_WAIT_L(8); PG8_BAR; PG8_WAIT_L(0); PG8_MMA(0, 0, At, B0); PG8_BAR; PG8_SCHED;
            PG8_LDB(B1, 1, 1); PG8_STAGE(PG8_SB(1, 0), b3, voffB);
            PG8_BAR; PG8_WAIT_L(0); PG8_MMA(0, 1, At, B1); PG8_BAR;
            PG8_LDA(At, 1, 1); PG8_STAGE(PG8_SA(1, 0), a3, voffA);
            PG8_BAR; PG8_WAIT_L(0); PG8_MMA(1, 0, At, B0); PG8_BAR; PG8_SCHED;
            PG8_STAGE(PG8_SB(1, 1), b3 + hstep, voffB);
            PG8_WAIT_V(6); PG8_BAR; PG8_MMA(1, 1, At, B1); PG8_BAR;
        }
        if constexpr (!Epi::AFTER_DRAIN) { E(acc, cur, wr, wc, fr, fq); S.done(cur); }
        if (!has_next) break;
#pragma unroll
        for (int a = 0; a < 2; ++a)
#pragma unroll
            for (int b = 0; b < 2; ++b)
#pragma unroll
                for (int m = 0; m < 4; ++m)
#pragma unroll
                    for (int n = 0; n < 2; ++n) acc[a][b][m][n] = (f32x4){0.f, 0.f, 0.f, 0.f};
        cur = nxt; cA = nA; cB = nB; ++ui;
    }
    PG8_WAIT_V(0);
    if (wr == 0) PG8_BAR;
    PG8_BAR;
    if constexpr (Epi::AFTER_DRAIN) { E.fused(acc, cur, wr, wc, fr, fq, lds, wid, lane); S.done(cur); }
#undef PG8_SA
#undef PG8_SB
#undef PG8_STAGE
#undef PG8_LDA
#undef PG8_LDB
#undef PG8_MMA
#undef PG8_WAIT_V
#undef PG8_WAIT_L
#undef PG8_BAR
#undef PG8_SCHED
}
}
constexpr int NWAVES = 8, NTHR = 512;
constexpr int D = 2048, NBATCH = 4, SEQ = 4096, T = NBATCH * SEQ, DEPTH = 2;
constexpr int GLA_H = 4, GLA_DK = 128, GLA_DV = 256, GLA_CH = 64;
constexpr int MLP_H = 8, MLP_DH = 128, MLP_CH = 128;
constexpr int IN_COLS = 5136, NPROJ = 5120;
constexpr int C_Q = 0, C_K = 512, C_V = 1024, C_R = 2048, C_U = 3072, C_VS = 4096;
constexpr int NEXP = 16384, PEER_H = 8;
constexpr float EPS = 1e-6f;
constexpr int MODW = 6 * D;
constexpr size_t MiB = 1u << 20;
constexpr size_t WS_CTL = 0, CTL_ZERO_BYTES = 1 * MiB;
constexpr size_t WS_MOD = 1 * MiB;
constexpr size_t WS_K1B = 2 * MiB, WS_K2B = 2 * MiB + 512 * 1024, WS_WSB = 3 * MiB, WS_DEC = 3 * MiB + 512 * 1024, WS_ALOW = 4 * MiB;
constexpr size_t WS_KU = 5 * MiB, WS_KV = 5 * MiB + 256 * 1024;
constexpr size_t WS_WTIN = 8 * MiB;
constexpr size_t WTIN_L = (size_t)5136 * 2048;
constexpr size_t WS_WTOUT = 49 * MiB, WS_WTQ = 65 * MiB;
constexpr size_t WS_PUB = 81 * MiB, WS_PVB = 209 * MiB;
constexpr size_t WS_H = 337 * MiB;
constexpr size_t WS_PROJ = 401 * MiB;
constexpr size_t WS_SBUF = 561 * MiB;
constexpr size_t WS_CONCAT = 625 * MiB;
constexpr size_t WS_QB = 689 * MiB;
constexpr size_t WS_EB = 753 * MiB, WS_PG = 761 * MiB;
constexpr size_t WS_H8 = 769 * MiB, WS_END = 833 * MiB;
static_assert(WS_WTIN + 2 * WTIN_L * 2 <= WS_WTOUT, "ws map");
constexpr int CW_BAR = 4096;
constexpr int RING_BYTES = 131072, LDSCTL_OFF = RING_BYTES, MISC_OFF = LDSCTL_OFF + 320, LDS_BYTES = 147456;

#define DI __device__ __forceinline__
#define LAS __attribute__((address_space(3)))
typedef unsigned short bf16;
typedef short bf16x8 __attribute__((ext_vector_type(8)));
typedef short s16x4 __attribute__((ext_vector_type(4)));
typedef short v4i16_t __attribute__((ext_vector_type(4)));
typedef __bf16 bf16x2_t __attribute__((ext_vector_type(2)));
typedef float f32x4 __attribute__((ext_vector_type(4)));
typedef float f32x2 __attribute__((ext_vector_type(2)));
typedef unsigned u32x4 __attribute__((ext_vector_type(4)));
typedef unsigned u32x2 __attribute__((ext_vector_type(2)));
typedef LAS unsigned char* ldsp;

DI unsigned f2bf(float f) { unsigned u = __builtin_bit_cast(unsigned, f); return (u + 0x7fffu + ((u >> 16) & 1u)) >> 16; }
DI unsigned pk2(float lo, float hi) { return f2bf(lo) | (f2bf(hi) << 16); }
DI float bflo(unsigned u) { return __builtin_bit_cast(float, u << 16); }
DI float bfhi(unsigned u) { return __builtin_bit_cast(float, u & 0xffff0000u); }
DI float bf1(bf16 v) { return __builtin_bit_cast(float, ((unsigned)v) << 16); }
DI float fexp2(float x) { return __builtin_amdgcn_exp2f(x); }
DI float flog2(float x) { return __builtin_amdgcn_logf(x); }
DI float frcp(float x) { return __builtin_amdgcn_rcpf(x); }
DI float frsq(float x) { return __builtin_amdgcn_rsqf(x); }
DI float gelu_t(float x) { const float u = 0.7978845608f * (x + 0.044715f * x * x * x); return x * frcp(1.f + fexp2(-2.885390082f * u)); }
DI float silu_f(float x) { return x * frcp(1.f + fexp2(-1.442695041f * x)); }
template <int CTRL> DI float dppf(float v) { return __builtin_bit_cast(float, __builtin_amdgcn_update_dpp(0, __builtin_bit_cast(int, v), CTRL, 0xf, 0xf, true)); }
DI float wave_sum_u(float v) {
    v += dppf<0xB1>(v); v += dppf<0x4E>(v); v += dppf<0x141>(v); v += dppf<0x140>(v);
    const int iv = __builtin_bit_cast(int, v);
    return (__builtin_bit_cast(float, __builtin_amdgcn_readlane(iv, 0)) + __builtin_bit_cast(float, __builtin_amdgcn_readlane(iv, 16))) +
           (__builtin_bit_cast(float, __builtin_amdgcn_readlane(iv, 32)) + __builtin_bit_cast(float, __builtin_amdgcn_readlane(iv, 48)));
}
DI float wave_sum(float v) {
#pragma unroll
    for (int o = 1; o < 64; o <<= 1) v += __shfl_xor(v, o);
    return v;
}
DI float dot2bf(unsigned a, unsigned b, float c) { return __builtin_amdgcn_fdot2_f32_bf16(__builtin_bit_cast(bf16x2_t, a), __builtin_bit_cast(bf16x2_t, b), c, false); }
DI f32x4 mfma16(bf16x8 a, bf16x8 b, f32x4 c) { return __builtin_amdgcn_mfma_f32_16x16x32_bf16(a, b, c, 0, 0, 0); }
DI s16x4 tr4(const LAS bf16* p) { return __builtin_bit_cast(s16x4, __builtin_amdgcn_ds_read_tr16_b64_v4i16((LAS v4i16_t*)p)); }
DI bf16x8 tr8(const LAS bf16* p, int stride) { const s16x4 a = tr4(p), b = tr4(p + 4 * stride); return (bf16x8){a[0], a[1], a[2], a[3], b[0], b[1], b[2], b[3]}; }

#define XB_TMO      128
#define XB_XCNT(j)  (256  + 64 * (j))
#define XB_XSUB(j)  (1280 + 64 * (j))
#define XB_XGEN(j)  (2304 + 64 * (j))
#define XB_TOP      3328
#define XB_TOPGEN   3392
#define XCD_BAR_WORDS 3456
#define XB_SPIN_CAP (1u << 18)

__device__ __forceinline__ unsigned xb_ld(unsigned* p)              { return __hip_atomic_load(p, __ATOMIC_RELAXED, __HIP_MEMORY_SCOPE_AGENT); }
__device__ __forceinline__ unsigned xb_add(unsigned* p, unsigned v) { return __hip_atomic_fetch_add(p, v, __ATOMIC_RELAXED, __HIP_MEMORY_SCOPE_AGENT); }
__device__ __forceinline__ unsigned xb_xcc_id() { return (unsigned)__builtin_amdgcn_s_getreg((3 << 11) | 20) & 0xFu; }
#define XB_SPIN(cond, bar) do { unsigned _sp = 0; while (cond) { __builtin_amdgcn_s_sleep(1); \
    if ((++_sp & 255u) == 0u) { if (xb_ld(&(bar)[XB_TMO])) break; if (_sp > XB_SPIN_CAP) { atomicAdd(&(bar)[XB_TMO], 1u); break; } } } } while (0)

struct XcdBarrier {
    unsigned* bar; unsigned x;
    volatile LAS unsigned* st;
};

__device__ __forceinline__ XcdBarrier xcd_barrier_post(unsigned* bar, volatile LAS unsigned* st) {
    XcdBarrier b; b.bar = bar; b.x = xb_xcc_id(); b.st = st;
    if (threadIdx.x == 0) (void)xb_add(&bar[XB_XCNT(b.x)], 1u);
    return b;
}
__device__ __forceinline__ void xcd_barrier_complete(unsigned* bar, unsigned x, unsigned& nloc, unsigned& nx) {
    const unsigned G = gridDim.x * gridDim.y * gridDim.z;
    unsigned sum, cnt, mine, sp = 0u;
    for (;;) {
        sum = 0u; cnt = 0u; mine = 0u;
#pragma unroll
        for (unsigned j = 0; j < 16; ++j) { const unsigned c = xb_ld(&bar[XB_XCNT(j)]); sum += c; cnt += (c > 0u) ? 1u : 0u; mine = (j == x) ? c : mine; }
        if (sum == G) break;
        __builtin_amdgcn_s_sleep(1);
        if ((++sp & 255u) == 0u) { if (xb_ld(&bar[XB_TMO])) break; if (sp > XB_SPIN_CAP) { atomicAdd(&bar[XB_TMO], 1u); break; } }
    }
    nloc = mine > 0u ? mine : 1u; nx = cnt > 0u ? cnt : 1u;
}

__device__ __forceinline__ void xcd_barrier(const XcdBarrier& b) {
    asm volatile("s_waitcnt vmcnt(0)" ::: "memory");
    __syncthreads();
    if (threadIdx.x == 0) {
        unsigned* bar = b.bar;
        __builtin_amdgcn_s_waitcnt(0);
        unsigned nloc = b.st[0], nx = b.st[1];
        if (nloc == 0u) { xcd_barrier_complete(bar, b.x, nloc, nx); b.st[0] = nloc; b.st[1] = nx; }
        const unsigned old = xb_add(&bar[XB_XSUB(b.x)], 1u);
        const unsigned gen = old / nloc;
        if (old + 1u == (gen + 1u) * nloc) {
            __builtin_amdgcn_fence(__ATOMIC_RELEASE, "agent");
            asm volatile("s_waitcnt vmcnt(0)" ::: "memory");
            const unsigned og = xb_add(&bar[XB_TOP], 1u);
            const unsigned tg = og / nx;
            if (og + 1u == (tg + 1u) * nx) xb_add(&bar[XB_TOPGEN], 1u);
            else XB_SPIN(xb_ld(&bar[XB_TOPGEN]) == tg, bar);
            __builtin_amdgcn_fence(__ATOMIC_ACQUIRE, "agent");
            xb_add(&bar[XB_XGEN(b.x)], 1u);
            asm volatile("s_waitcnt vmcnt(0)" ::: "memory");
        } else {
            XB_SPIN(xb_ld(&bar[XB_XGEN(b.x)]) == gen, bar);
            __builtin_amdgcn_fence(__ATOMIC_ACQUIRE, "agent");
            asm volatile("s_waitcnt vmcnt(0)" ::: "memory");
        }
    }
    __syncthreads();
}
struct Ctx {
    ldsp lds; int tid, lane, wave, bid, G, gw, NGW;
    const float* in[21]; float* out; unsigned char* ws;
};
#define LDS_WAIT() asm volatile("s_waitcnt lgkmcnt(0)" ::: "memory")
enum { I_X = 0, I_C, I_ADAW, I_ADAB, I_N1G, I_WIN, I_WA2, I_BA, I_GNG, I_VNG, I_MWS, I_MB, I_MOG, I_WOUT, I_N2G, I_WQ, I_K1, I_K2, I_PU, I_PV, I_FG };

DI void p0_ada(const Ctx& C) {
    LAS float* red = (LAS float*)C.lds;
    float* MOD = (float*)(C.ws + WS_MOD);
    for (int it = C.bid; it < 192; it += C.G) {
        const int l = it / 96, cg = it % 96, c0 = cg * 128 + C.lane * 2;
        const float* W = C.in[I_ADAW] + (size_t)l * D * MODW + (size_t)(C.wave * 256) * MODW + c0;
        float cv[4][4];
#pragma unroll
        for (int b = 0; b < 4; ++b)
#pragma unroll
            for (int i = 0; i < 4; ++i) cv[b][i] = silu_f(C.in[I_C][b * D + C.wave * 256 + i * 64 + C.lane]);
        float acc[4][2];
#pragma unroll
        for (int b = 0; b < 4; ++b) { acc[b][0] = 0.f; acc[b][1] = 0.f; }
#pragma unroll
        for (int i = 0; i < 4; ++i) {
#pragma unroll 8
            for (int j = 0; j < 64; ++j) {
                const f32x2 w = *(const f32x2*)(W + (size_t)(i * 64 + j) * MODW);
#pragma unroll
                for (int b = 0; b < 4; ++b) { const float s = __builtin_bit_cast(float, __builtin_amdgcn_readlane(__builtin_bit_cast(int, cv[b][i]), j)); acc[b][0] += s * w.x; acc[b][1] += s * w.y; }
            }
        }
#pragma unroll
        for (int b = 0; b < 4; ++b) *(LAS f32x2*)(red + (C.wave * 4 + b) * 128 + C.lane * 2) = (f32x2){acc[b][0], acc[b][1]};
        __syncthreads();
        { const int b = C.tid >> 7, col = C.tid & 127; float s = C.in[I_ADAB][l * MODW + cg * 128 + col];
#pragma unroll
          for (int w = 0; w < 8; ++w) s += red[(w * 4 + b) * 128 + col];
          MOD[(size_t)(l * 4 + b) * MODW + cg * 128 + col] = s; }
        __syncthreads();
    }
}
DI void transpose_item(const float* W, int ldw, int src_col0, int ncols, bf16* WT, int dst_row0, int k0, LAS float* scr, int lane) {
    const int cl = lane & 31;
#pragma unroll 8
    for (int i = 0; i < 32; ++i) { const int kk = 2 * i + (lane >> 5); float v = 0.f; if (cl < ncols) v = W[(size_t)(k0 + kk) * ldw + src_col0 + cl]; scr[kk * 33 + cl] = v; }
    LDS_WAIT();
    const int c = lane & 7;
#pragma unroll
    for (int j = 0; j < 4; ++j) { const int n = (lane >> 3) + 8 * j;
        if (n < ncols) { const LAS float* s = scr + (8 * c) * 33 + n;
            u32x4 o; o.x = pk2(s[0 * 33], s[1 * 33]); o.y = pk2(s[2 * 33], s[3 * 33]); o.z = pk2(s[4 * 33], s[5 * 33]); o.w = pk2(s[6 * 33], s[7 * 33]);
            *(u32x4*)(WT + (size_t)(dst_row0 + n) * 2048 + k0 + 8 * c) = o; } }
    LDS_WAIT();
}
DI void p0_prologue(const Ctx& C) {
    p0_ada(C);
    LAS float* scr = (LAS float*)(C.lds + C.wave * 16384);
    constexpr int PER_L = (161 + 64 + 64) * 32;
    for (int it = C.gw; it < 2 * PER_L; it += C.NGW) {
        const int l = it / PER_L; int r = it % PER_L;
        if (r < 161 * 32) { const int kb = r / 161, nb = r % 161; bf16* WT = (bf16*)(C.ws + WS_WTIN) + (size_t)l * WTIN_L;
            const float* W = C.in[I_WIN] + (size_t)l * D * IN_COLS;
            if (nb < 160) { const int n0 = 32 * nb; transpose_item(W, IN_COLS, n0 + (n0 >= 3072 ? 16 : 0), 32, WT, n0, 64 * kb, scr, C.lane); }
            else transpose_item(W, IN_COLS, 3072, 16, WT, 5120, 64 * kb, scr, C.lane);
            continue; }
        r -= 161 * 32;
        if (r < 2048) { const int kb = r / 64, nb = r % 64; transpose_item(C.in[I_WOUT] + (size_t)l * D * D, D, 32 * nb, 32, (bf16*)(C.ws + WS_WTOUT) + (size_t)l * D * D, 32 * nb, 64 * kb, scr, C.lane); continue; }
        r -= 2048;
        { const int kb = r / 64, nb = r % 64; transpose_item(C.in[I_WQ] + (size_t)l * D * D, D, 32 * nb, 32, (bf16*)(C.ws + WS_WTQ) + (size_t)l * D * D, 32 * nb, 64 * kb, scr, C.lane); }
    }
    const int gt = C.bid * NTHR + C.tid, NT = C.G * NTHR;
    { bf16* K1B = (bf16*)(C.ws + WS_K1B); bf16* K2B = (bf16*)(C.ws + WS_K2B); bf16* WSB = (bf16*)(C.ws + WS_WSB);
      for (int i = gt; i < 262144; i += NT) { K1B[i] = (bf16)f2bf(C.in[I_K1][i]); K2B[i] = (bf16)f2bf(C.in[I_K2][i]);
          const int s = i & 127, t = (i >> 7) & 127; WSB[i] = (s <= t) ? (bf16)f2bf(C.in[I_MWS][i]) : (bf16)0; } }
    { int* KU = (int*)(C.ws + WS_KU); int* KV = (int*)(C.ws + WS_KV);
#pragma unroll 1
      for (int row = C.gw; row < 4 * NEXP; row += C.NGW) {
          const int tb = row >> 15, rr = row & 32767;
          const f32x4* src = (const f32x4*)(C.in[tb ? I_PV : I_PU] + (size_t)rr * D) + C.lane;
          f32x4 v[8]; float mx = 0.f;
#pragma unroll
          for (int j = 0; j < 8; ++j) { v[j] = src[64 * j]; mx = fmaxf(mx, fmaxf(fmaxf(fabsf(v[j].x), fabsf(v[j].y)), fmaxf(fabsf(v[j].z), fabsf(v[j].w)))); }
#pragma unroll
          for (int o = 1; o < 64; o <<= 1) mx = fmaxf(mx, __shfl_xor(mx, o));
          int k = 0;
          if (mx > 0.f) { k = (int)((__builtin_bit_cast(unsigned, 224.0f / mx) >> 23) & 255u) - 127; k = k < -60 ? -60 : (k > 60 ? 60 : k); }
          const float sc = __builtin_bit_cast(float, (unsigned)(k + 127) << 23);
          const int lyr = rr >> 14, ee = rr & 16383;
          unsigned* dst = (unsigned*)(C.ws + (tb ? WS_PVB : WS_PUB) + (size_t)lyr * NEXP * D + (size_t)ee * 256) + C.lane;
#pragma unroll
          for (int j = 0; j < 8; ++j) { int p = 0; p = __builtin_amdgcn_cvt_pk_fp8_f32(v[j].x * sc, v[j].y * sc, p, false); p = __builtin_amdgcn_cvt_pk_fp8_f32(v[j].z * sc, v[j].w * sc, p, true); dst[(size_t)j * (NEXP * 256 / 4)] = (unsigned)p; }
          if (C.lane == 0) (tb ? KV : KU)[rr] = k;
      } }
}
template <bool FP8 = false>
DI void norm_phase(const Ctx& C, const float* X, const float* g, const float* modl, int sh_off, int sc_off, bf16* Hout, unsigned char* H8 = nullptr) {
    const int r0 = C.gw * 8, b = r0 >> 12;
    const f32x4* shp = (const f32x4*)(modl + (size_t)b * MODW + sh_off); const f32x4* scp = (const f32x4*)(modl + (size_t)b * MODW + sc_off);
    f32x4 gm[8], shv[8];
#pragma unroll
    for (int j = 0; j < 8; ++j) { const int idx = 64 * j + C.lane; gm[j] = ((const f32x4*)g)[idx] * (scp[idx] + 1.0f); shv[j] = shp[idx]; }
#pragma unroll 1
    for (int i = 0; i < 8; ++i) {
        const f32x4* xr = (const f32x4*)(X + (size_t)(r0 + i) * D) + C.lane; f32x4 v[8]; float s = 0.f;
#pragma unroll
        for (int j = 0; j < 8; ++j) { v[j] = xr[64 * j]; s += (v[j].x * v[j].x + v[j].y * v[j].y) + (v[j].z * v[j].z + v[j].w * v[j].w); }
        const float rstd = frsq(wave_sum(s) * (1.f / D) + EPS);
        u32x2* o = (u32x2*)(Hout + (size_t)(r0 + i) * D) + C.lane;
#pragma unroll
        for (int j = 0; j < 8; ++j) { const f32x4 y = v[j] * rstd * gm[j] + shv[j]; u32x2 w; w.x = pk2(y.x, y.y); w.y = pk2(y.z, y.w); o[64 * j] = w;
            if (FP8) {
                const f32x4 ys = y * 16.0f; int ph = 0; ph = __builtin_amdgcn_cvt_pk_fp8_f32(ys.x, ys.y, ph, false); ph = __builtin_amdgcn_cvt_pk_fp8_f32(ys.z, ys.w, ph, true);
                const f32x2 b0 = __builtin_amdgcn_cvt_pk_f32_fp8(ph, false), b1 = __builtin_amdgcn_cvt_pk_f32_fp8(ph, true);
                int pl = 0; pl = __builtin_amdgcn_cvt_pk_fp8_f32((ys.x - b0.x) * 16.0f, (ys.y - b0.y) * 16.0f, pl, false); pl = __builtin_amdgcn_cvt_pk_fp8_f32((ys.z - b1.x) * 16.0f, (ys.w - b1.y) * 16.0f, pl, true);
                unsigned* h8 = (unsigned*)(H8 + (size_t)(r0 + i) * 4096) + C.lane; h8[64 * j] = (unsigned)ph; h8[512 + 64 * j] = (unsigned)pl; } }
    }
}
DI void alow_phase(const Ctx& C, const bf16* Hb, const bf16* WtA, float* ALOW) {
    if (C.wave < 4) {
        const int task = C.bid * 4 + C.wave, r0 = task * 16, fr = C.lane & 15, fq = C.lane >> 4;
        const bf16* ap = Hb + (size_t)(r0 + fr) * D + 8 * fq; const bf16* bp = WtA + (size_t)fr * D + 8 * fq;
        f32x4 acc = (f32x4){0.f, 0.f, 0.f, 0.f};
#pragma unroll 8
        for (int ks = 0; ks < 64; ++ks) { const bf16x8 a = *(const bf16x8*)(ap + 32 * ks), b = *(const bf16x8*)(bp + 32 * ks); acc = mfma16(a, b, acc); }
#pragma unroll
        for (int r = 0; r < 4; ++r) ALOW[(size_t)(r0 + 4 * fq + r) * 16 + fr] = acc[r];
    }
}
#define LBAR() do { asm volatile("s_waitcnt lgkmcnt(0)" ::: "memory"); __builtin_amdgcn_s_barrier(); asm volatile("" ::: "memory"); } while (0)
DI void gla_gates(const Ctx& C, LAS float* al, LAS float* tot, const f32x4 alv, const float (&w2)[16], const float bav, float (&Gl)[16], float& off, float& gref, float& g63) {
    const int d = C.tid & 127, jg = C.tid >> 7;
    if (C.tid < 256) ((LAS f32x4*)al)[C.tid] = alv;
    LBAR();
    float run = 0.f;
#pragma unroll
    for (int jj = 0; jj < 16; ++jj) {
        const LAS f32x4* ar = (const LAS f32x4*)(al + (jg * 16 + jj) * 16);
        const f32x4 a0 = ar[0], a1 = ar[1], a2 = ar[2], a3 = ar[3];
        float z = bav;
        z += a0.x * w2[0] + a0.y * w2[1] + a0.z * w2[2] + a0.w * w2[3];
        z += a1.x * w2[4] + a1.y * w2[5] + a1.z * w2[6] + a1.w * w2[7];
        z += a2.x * w2[8] + a2.y * w2[9] + a2.z * w2[10] + a2.w * w2[11];
        z += a3.x * w2[12] + a3.y * w2[13] + a3.z * w2[14] + a3.w * w2[15];
        const float ls = fminf(z, 0.f) - 0.6931471806f * flog2(1.f + fexp2(-1.442695041f * fabsf(z)));
        run += ls * (1.442695041f / 16.f);
        Gl[jj] = run;
    }
    tot[jg * 128 + d] = run;
    LBAR();
    const float t0_ = tot[d], t1_ = tot[128 + d], t2_ = tot[256 + d], t3_ = tot[384 + d];
    off = (jg > 0 ? t0_ : 0.f) + (jg > 1 ? t1_ : 0.f) + (jg > 2 ? t2_ : 0.f); gref = t0_ + t1_; g63 = (t0_ + t1_) + (t2_ + t3_);
}
constexpr int KST = 136, VST = 264, PST = 72;
DI void load_v_tile(const Ctx& C, const bf16* PROJ, int t0, int h, LAS bf16* VL) {
#pragma unroll
    for (int i = 0; i < 4; ++i) { const int c = C.tid + 512 * i, j = c >> 5, ec = c & 31;
        *(LAS u32x4*)(VL + j * VST + 8 * ec) = *(const u32x4*)(PROJ + (size_t)(t0 + j) * NPROJ + C_V + h * 256 + 8 * ec); }
}
struct GlaIn { f32x4 alv; bf16 qraw[16], kraw[16]; u32x4 vt[4]; };
template <bool WITHQ>
DI void gla_load(const Ctx& C, int idx, const bf16* PROJ, const float* ALOW, GlaIn& in) {
    const int b = idx >> 8, h = (idx >> 6) & 3, n = idx & 63, t0 = b * SEQ + n * 64, d = C.tid & 127, jg = C.tid >> 7;
    in.alv = (f32x4){0.f, 0.f, 0.f, 0.f};
    if (C.tid < 256) in.alv = ((const f32x4*)(ALOW + (size_t)t0 * 16))[C.tid];
#pragma unroll
    for (int jj = 0; jj < 16; ++jj) { const bf16* row = PROJ + (size_t)(t0 + jg * 16 + jj) * NPROJ + h * 128 + d; in.kraw[jj] = row[C_K]; if (WITHQ) in.qraw[jj] = row[C_Q]; }
#pragma unroll
    for (int i = 0; i < 4; ++i) { const int c = C.tid + 512 * i, j = c >> 5, ec = c & 31; in.vt[i] = *(const u32x4*)(PROJ + (size_t)(t0 + j) * NPROJ + C_V + h * 256 + 8 * ec); }
}
DI void store_v_tile(const Ctx& C, const GlaIn& in, LAS bf16* VL) {
#pragma unroll
    for (int i = 0; i < 4; ++i) { const int c = C.tid + 512 * i, j = c >> 5, ec = c & 31; *(LAS u32x4*)(VL + j * VST + 8 * ec) = in.vt[i]; }
}
DI void glaA_phase(const Ctx& C, int l, const bf16* PROJ, const float* ALOW, bf16* SBUF, float* DEC) {
    LAS float* al = (LAS float*)(C.lds); LAS float* tot = (LAS float*)(C.lds + 4096);
    LAS bf16* KD = (LAS bf16*)(C.lds + 8192); LAS bf16* VL = (LAS bf16*)(C.lds + 25600);
    const int d = C.tid & 127, jg = C.tid >> 7, h = (C.bid >> 6) & 3;
    float w2[16];
#pragma unroll
    for (int r = 0; r < 16; ++r) w2[r] = C.in[I_WA2][(size_t)l * 16 * 512 + r * 512 + h * 128 + d];
    const float bav = C.in[I_BA][(size_t)l * 512 + h * 128 + d];
    GlaIn cur, nxt;
    gla_load<false>(C, C.bid, PROJ, ALOW, cur);
#pragma unroll 1
    for (int i = 0; i < 4; ++i) {
        const int idx = i * C.G + C.bid;
        float Gl[16], off, gref, g63;
        gla_gates(C, al, tot, cur.alv, w2, bav, Gl, off, gref, g63);
#pragma unroll
        for (int jj = 0; jj < 16; ++jj) { const int j = jg * 16 + jj; KD[j * KST + d] = (bf16)f2bf(bf1(cur.kraw[jj]) * fexp2(g63 - (off + Gl[jj]))); }
        store_v_tile(C, cur, VL);
        LBAR();
        if (i + 1 < 4) gla_load<false>(C, idx + C.G, PROJ, ALOW, nxt);
        if (jg == 0) DEC[(size_t)idx * 128 + d] = fexp2(g63);
        const int lane = C.lane, g = lane >> 4, qq = (lane & 15) >> 2, p = lane & 3, fr = lane & 15;
        bf16x8 A[2];
#pragma unroll
        for (int ks = 0; ks < 2; ++ks) A[ks] = tr8(KD + (32 * ks + 8 * g + qq) * KST + 16 * C.wave + 4 * p, KST);
        bf16* Sit = SBUF + (size_t)idx * 256 * 128;
#pragma unroll
        for (int half = 0; half < 2; ++half) {
            f32x4 acc[8];
#pragma unroll
            for (int nt = 0; nt < 8; ++nt) acc[nt] = (f32x4){0.f, 0.f, 0.f, 0.f};
#pragma unroll
            for (int nt = 0; nt < 8; ++nt)
#pragma unroll
                for (int ks = 0; ks < 2; ++ks) { const bf16x8 Bf = tr8(VL + (32 * ks + 8 * g + qq) * VST + 16 * (half * 8 + nt) + 4 * p, VST); acc[nt] = mfma16(A[ks], Bf, acc[nt]); }
#pragma unroll
            for (int nt = 0; nt < 8; ++nt) { const int e = 16 * (half * 8 + nt) + fr, dd = 16 * C.wave + 4 * g;
                u32x2 w; w.x = pk2(acc[nt][0], acc[nt][1]); w.y = pk2(acc[nt][2], acc[nt][3]); *(u32x2*)(Sit + (size_t)e * 128 + dd) = w; }
        }
        LBAR();
        cur = nxt;
    }
}
DI void scan_phase(const Ctx& C, bf16* SBUF, const float* DEC) {
    const int gt = C.bid * NTHR + C.tid, bh = gt >> 13, rem = gt & 8191, e = rem >> 5, dq = rem & 31;
    u32x2* p = (u32x2*)(SBUF + ((size_t)(bh * 64) * 256 + e) * 128 + 4 * dq);
    const f32x4* dp = (const f32x4*)(DEC + (size_t)(bh * 64) * 128 + 4 * dq);
    f32x4 st = (f32x4){0.f, 0.f, 0.f, 0.f};
#pragma unroll 1
    for (int n0 = 0; n0 < 64; n0 += 8) {
        u32x2 tmp[8]; f32x4 dc[8];
#pragma unroll
        for (int u = 0; u < 8; ++u) { tmp[u] = p[(size_t)(n0 + u) * 8192]; dc[u] = dp[(n0 + u) * 32]; }
#pragma unroll
        for (int u = 0; u < 8; ++u) { u32x2 w; w.x = pk2(st.x, st.y); w.y = pk2(st.z, st.w); p[(size_t)(n0 + u) * 8192] = w;
            st = dc[u] * st + (f32x4){bflo(tmp[u].x), bfhi(tmp[u].x), bflo(tmp[u].y), bfhi(tmp[u].y)}; }
    }
}
DI void glaC_phase(const Ctx& C, int l, const bf16* PROJ, const float* ALOW, const bf16* SBUF, bf16* CONCAT) {
    const int h = (C.bid >> 6) & 3;
    LAS float* al = (LAS float*)(C.lds); LAS float* tot = (LAS float*)(C.lds + 4096); LAS float* RS = (LAS float*)(C.lds + 6144);
    LAS bf16* QT = (LAS bf16*)(C.lds + 8192); LAS bf16* KT = (LAS bf16*)(C.lds + 25600); LAS bf16* QG = (LAS bf16*)(C.lds + 43008);
    LAS bf16* VL = (LAS bf16*)(C.lds + 60416); LAS bf16* PL = (LAS bf16*)(C.lds + 94208);
    const int d = C.tid & 127, jg = C.tid >> 7;
    float w2[16];
#pragma unroll
    for (int r = 0; r < 16; ++r) w2[r] = C.in[I_WA2][(size_t)l * 16 * 512 + r * 512 + h * 128 + d];
    const float bav = C.in[I_BA][(size_t)l * 512 + h * 128 + d];
    const float* ng = C.in[I_GNG] + (size_t)(l * 4 + h) * 256;
    GlaIn cur;
    f32x4 alv_n = (f32x4){0.f, 0.f, 0.f, 0.f};
    if (C.tid < 256) alv_n = ((const f32x4*)(ALOW + (size_t)((C.bid >> 8) * SEQ + (C.bid & 63) * 64) * 16))[C.tid];
#pragma unroll 1
    for (int it = 0; it < 4; ++it) {
    const int idx = it * C.G + C.bid, b = idx >> 8, n = idx & 63, t0 = b * SEQ + n * 64;
    gla_load<true>(C, idx, PROJ, ALOW, cur); cur.alv = alv_n;
    float Gl[16], off, gref, g63;
    gla_gates(C, al, tot, cur.alv, w2, bav, Gl, off, gref, g63);
#pragma unroll
    for (int jj = 0; jj < 16; ++jj) { const int j = jg * 16 + jj; const float Gv = off + Gl[jj];
        const float q = bf1(cur.qraw[jj]) * 0.08838834764831845f, k = bf1(cur.kraw[jj]);
        QT[j * KST + d] = (bf16)f2bf(q * fexp2(Gv - gref)); KT[j * KST + d] = (bf16)f2bf(k * fexp2(gref - Gv)); QG[j * KST + d] = (bf16)f2bf(q * fexp2(Gv)); }
    store_v_tile(C, cur, VL);
    const int lane = C.lane, g = lane >> 4, qq = (lane & 15) >> 2, p = lane & 3, fr = lane & 15;
    bf16x8 Sf[2][4]; u32x2 rraw[4][2];
#pragma unroll
    for (int mi = 0; mi < 2; ++mi) { const bf16* Srow = SBUF + ((size_t)idx * 256 + 16 * (2 * C.wave + mi) + fr) * 128 + 8 * g;
#pragma unroll
        for (int ks = 0; ks < 4; ++ks) Sf[mi][ks] = *(const bf16x8*)(Srow + 32 * ks); }
#pragma unroll
    for (int nt = 0; nt < 4; ++nt)
#pragma unroll
        for (int mi = 0; mi < 2; ++mi) rraw[nt][mi] = *(const u32x2*)(PROJ + (size_t)(t0 + 16 * nt + fr) * NPROJ + C_R + h * 256 + 16 * (2 * C.wave + mi) + 4 * g);
    LBAR();
    {
        const int nt = C.wave & 3;
#pragma unroll
        for (int mi = 0; mi < 2; ++mi) { const int mt = 2 * (C.wave >> 2) + mi; f32x4 acc = (f32x4){0.f, 0.f, 0.f, 0.f};
#pragma unroll
            for (int ks = 0; ks < 4; ++ks) { const bf16x8 a = *(const LAS bf16x8*)(KT + (16 * mt + fr) * KST + 32 * ks + 8 * g), bq = *(const LAS bf16x8*)(QT + (16 * nt + fr) * KST + 32 * ks + 8 * g); acc = mfma16(a, bq, acc); }
            const int i = 16 * nt + fr, j0 = 16 * mt + 4 * g;
            const float v0 = (j0 + 0 <= i) ? acc[0] : 0.f, v1 = (j0 + 1 <= i) ? acc[1] : 0.f, v2 = (j0 + 2 <= i) ? acc[2] : 0.f, v3 = (j0 + 3 <= i) ? acc[3] : 0.f;
            u32x2 w; w.x = pk2(v0, v1); w.y = pk2(v2, v3); *(LAS u32x2*)(PL + i * PST + j0) = w; }
    }
    LBAR();
    f32x4 acc[2][4];
#pragma unroll
    for (int mi = 0; mi < 2; ++mi)
#pragma unroll
        for (int nt = 0; nt < 4; ++nt) acc[mi][nt] = (f32x4){0.f, 0.f, 0.f, 0.f};
#pragma unroll
    for (int mi = 0; mi < 2; ++mi) { const int mt = 2 * C.wave + mi;
#pragma unroll
        for (int ks = 0; ks < 2; ++ks) { const bf16x8 a = tr8(VL + (32 * ks + 8 * g + qq) * VST + 16 * mt + 4 * p, VST);
#pragma unroll
            for (int nt = 0; nt < 4; ++nt) { const bf16x8 bp = *(const LAS bf16x8*)(PL + (16 * nt + fr) * PST + 32 * ks + 8 * g); acc[mi][nt] = mfma16(a, bp, acc[mi][nt]); } }
#pragma unroll
        for (int ks = 0; ks < 4; ++ks) { const bf16x8 a = Sf[mi][ks];
#pragma unroll
            for (int nt = 0; nt < 4; ++nt) { const bf16x8 bq = *(const LAS bf16x8*)(QG + (16 * nt + fr) * KST + 32 * ks + 8 * g); acc[mi][nt] = mfma16(a, bq, acc[mi][nt]); } }
    }
#pragma unroll
    for (int nt = 0; nt < 4; ++nt) { float s = 0.f;
#pragma unroll
        for (int mi = 0; mi < 2; ++mi) s += (acc[mi][nt][0] * acc[mi][nt][0] + acc[mi][nt][1] * acc[mi][nt][1]) + (acc[mi][nt][2] * acc[mi][nt][2] + acc[mi][nt][3] * acc[mi][nt][3]);
        s += __shfl_xor(s, 16); s += __shfl_xor(s, 32);
        if (g == 0) RS[C.wave * 64 + 16 * nt + fr] = s; }
    LBAR();
    if (it + 1 < 4 && C.tid < 256) { const int ix = idx + C.G; alv_n = ((const f32x4*)(ALOW + (size_t)((ix >> 8) * SEQ + (ix & 63) * 64) * 16))[C.tid]; }
#pragma unroll
    for (int nt = 0; nt < 4; ++nt) { const int i = 16 * nt + fr; float ts = 0.f;
#pragma unroll
        for (int w = 0; w < 8; ++w) ts += RS[w * 64 + i];
        const float rstd = frsq(ts * (1.f / 256.f) + EPS);
#pragma unroll
        for (int mi = 0; mi < 2; ++mi) { const int e = 16 * (2 * C.wave + mi) + 4 * g;
            const u32x2 rr = rraw[nt][mi]; const f32x4 gg = *(const f32x4*)(ng + e);
            const float o0 = acc[mi][nt][0] * rstd * gg.x * silu_f(bflo(rr.x)), o1 = acc[mi][nt][1] * rstd * gg.y * silu_f(bfhi(rr.x));
            const float o2 = acc[mi][nt][2] * rstd * gg.z * silu_f(bflo(rr.y)), o3 = acc[mi][nt][3] * rstd * gg.w * silu_f(bfhi(rr.y));
            u32x2 w; w.x = pk2(o0, o1); w.y = pk2(o2, o3); *(u32x2*)(CONCAT + (size_t)(t0 + i) * D + h * 256 + e) = w; } }
    LBAR();
    }
}
constexpr int GST = 136;
DI void gmlp_phase(const Ctx& C, int l, const bf16* PROJ, const bf16* WSB, bf16* CONCAT) {
    const int h = C.bid & 7;
    LAS bf16* VL2 = (LAS bf16*)(C.lds); LAS bf16* UL = (LAS bf16*)(C.lds + 34816);
    const float* vg = C.in[I_VNG] + (size_t)(l * 8 + h) * 128; const float* og = C.in[I_MOG] + (size_t)(l * 8 + h) * 128; const float* bb = C.in[I_MB] + (size_t)(l * 8 + h) * 128;
    bf16x8 Wf[4];
    { const bf16* Wrow = WSB + ((size_t)(l * 8 + h) * 128 + 16 * C.wave + (C.lane & 15)) * 128 + 8 * (C.lane >> 4);
#pragma unroll
      for (int ks = 0; ks < 4; ++ks) Wf[ks] = *(const bf16x8*)(Wrow + 32 * ks); }
    u32x4 cu[4], cv[4], nu[4], nv[4];
#define GM_LOAD(IDX, U, V) do { const int t0_ = ((IDX) >> 8) * SEQ + (((IDX) >> 3) & 31) * 128; _Pragma("unroll") for (int i = 0; i < 4; ++i) { const int c = C.tid + 512 * i, t = c >> 4, ch = c & 15; \
        const bf16* row = PROJ + (size_t)(t0_ + t) * NPROJ + h * 128 + 8 * ch; U[i] = *(const u32x4*)(row + C_U); V[i] = *(const u32x4*)(row + C_VS); } } while (0)
    GM_LOAD(C.bid, cu, cv);
#pragma unroll 1
    for (int it = 0; it < 4; ++it) {
    const int idx = it * C.G + C.bid, n = (idx >> 3) & 31, b = idx >> 8, t0 = b * SEQ + n * 128;
#pragma unroll
    for (int i = 0; i < 4; ++i) { const int c = C.tid + 512 * i, t = c >> 4, ch = c & 15;
        const u32x4 uu = cu[i], vv = cv[i];
        float v[8] = {gelu_t(bflo(vv.x)), gelu_t(bfhi(vv.x)), gelu_t(bflo(vv.y)), gelu_t(bfhi(vv.y)), gelu_t(bflo(vv.z)), gelu_t(bfhi(vv.z)), gelu_t(bflo(vv.w)), gelu_t(bfhi(vv.w))};
        float ss = 0.f;
#pragma unroll
        for (int k = 0; k < 8; ++k) ss += v[k] * v[k];
        ss += __shfl_xor(ss, 1); ss += __shfl_xor(ss, 2); ss += __shfl_xor(ss, 4); ss += __shfl_xor(ss, 8);
        const float rstd = frsq(ss * (1.f / 128.f) + EPS);
        const f32x4 g0 = *(const f32x4*)(vg + 8 * ch), g1 = *(const f32x4*)(vg + 8 * ch + 4);
        u32x4 wv; wv.x = pk2(v[0] * rstd * g0.x, v[1] * rstd * g0.y); wv.y = pk2(v[2] * rstd * g0.z, v[3] * rstd * g0.w); wv.z = pk2(v[4] * rstd * g1.x, v[5] * rstd * g1.y); wv.w = pk2(v[6] * rstd * g1.z, v[7] * rstd * g1.w);
        *(LAS u32x4*)(VL2 + t * GST + 8 * ch) = wv;
        u32x4 wu; wu.x = pk2(gelu_t(bflo(uu.x)), gelu_t(bfhi(uu.x))); wu.y = pk2(gelu_t(bflo(uu.y)), gelu_t(bfhi(uu.y))); wu.z = pk2(gelu_t(bflo(uu.z)), gelu_t(bfhi(uu.z))); wu.w = pk2(gelu_t(bflo(uu.w)), gelu_t(bfhi(uu.w)));
        *(LAS u32x4*)(UL + t * GST + 8 * ch) = wu; }
    LBAR();
    if (it + 1 < 4) GM_LOAD(idx + C.G, nu, nv);
    const int lane = C.lane, g = lane >> 4, qq = (lane & 15) >> 2, p = lane & 3, fr = lane & 15;
    f32x4 acc[8];
#pragma unroll
    for (int mt = 0; mt < 8; ++mt) acc[mt] = (f32x4){0.f, 0.f, 0.f, 0.f};
    const int nks = (C.wave >> 1) + 1;
#pragma unroll
    for (int ks = 0; ks < 4; ++ks) if (ks < nks) { const bf16x8 bw = Wf[ks];
#pragma unroll
        for (int mt = 0; mt < 8; ++mt) { const bf16x8 a = tr8(VL2 + (32 * ks + 8 * g + qq) * GST + 16 * mt + 4 * p, GST); acc[mt] = mfma16(a, bw, acc[mt]); } }
    const int tl = 16 * C.wave + fr; const float bt = bb[tl]; float ss = 0.f;
#pragma unroll
    for (int mt = 0; mt < 8; ++mt) { const u32x2 uu = *(const LAS u32x2*)(UL + tl * GST + 16 * mt + 4 * g);
        acc[mt][0] = bflo(uu.x) * (acc[mt][0] + bt); acc[mt][1] = bfhi(uu.x) * (acc[mt][1] + bt); acc[mt][2] = bflo(uu.y) * (acc[mt][2] + bt); acc[mt][3] = bfhi(uu.y) * (acc[mt][3] + bt);
        ss += (acc[mt][0] * acc[mt][0] + acc[mt][1] * acc[mt][1]) + (acc[mt][2] * acc[mt][2] + acc[mt][3] * acc[mt][3]); }
    ss += __shfl_xor(ss, 16); ss += __shfl_xor(ss, 32);
    const float rstd = frsq(ss * (1.f / 128.f) + EPS);
#pragma unroll
    for (int mt = 0; mt < 8; ++mt) { const f32x4 gg = *(const f32x4*)(og + 16 * mt + 4 * g);
        u32x2 w; w.x = pk2(acc[mt][0] * rstd * gg.x, acc[mt][1] * rstd * gg.y); w.y = pk2(acc[mt][2] * rstd * gg.z, acc[mt][3] * rstd * gg.w);
        *(u32x2*)(CONCAT + (size_t)(t0 + tl) * D + 1024 + h * 128 + 16 * mt + 4 * g) = w; }
    LBAR();
#pragma unroll
    for (int i = 0; i < 4; ++i) { cu[i] = nu[i]; cv[i] = nv[i]; }
    }
#undef GM_LOAD
}
DI void list_insert(float (&L)[16], float x) {
#pragma unroll
    for (int i = 15; i >= 1; --i) L[i] = __builtin_amdgcn_fmed3f(x, L[i - 1], L[i]);
    L[0] = fmaxf(L[0], x);
}
DI void list_merge_xor(float (&L)[16], int mask) {
    float M[16];
#pragma unroll
    for (int i = 0; i < 16; ++i) M[i] = fmaxf(L[i], __shfl_xor(L[15 - i], mask));
#pragma unroll
    for (int s = 8; s >= 1; s >>= 1)
#pragma unroll
        for (int i = 0; i < 16; ++i) if ((i & s) == 0) { const float hi = fmaxf(M[i], M[i + s]), lo = fminf(M[i], M[i + s]); M[i] = hi; M[i + s] = lo; }
#pragma unroll
    for (int i = 0; i < 16; ++i) L[i] = M[i];
}
DI unsigned fbits(float x) { return __builtin_bit_cast(unsigned, x); }
DI float unp7(float x) { return __builtin_bit_cast(float, __builtin_bit_cast(unsigned, x) & 0xFFFFFF80u); }
constexpr int TKST = 136;
DI void topk_phase(const Ctx& C, int l, const bf16* QB, const bf16* K1B, const bf16* K2B, const int* KU, const int* KV, int* EB, float* PG) {
    LAS bf16* KL = (LAS bf16*)C.lds;
    LAS unsigned* tk = (LAS unsigned*)(C.lds + 2 * 128 * TKST * 2 + C.wave * 2048);
    const int lane = C.lane, fr = lane & 15, fq = lane >> 4, h = C.bid & 7, rank = C.bid >> 3;
#pragma unroll
    for (int i = 0; i < 8; ++i) { const int c = C.tid + 512 * i, tb = c >> 11, row = (c & 2047) >> 4, ch = c & 15;
        *(LAS u32x4*)(KL + (tb * 128 + row) * TKST + 8 * ch) = *(const u32x4*)((tb ? K2B : K1B) + ((size_t)(l * 8 + h) * 128 + row) * 128 + 8 * ch); }
    __syncthreads();
#pragma unroll 1
    for (int it = 0; it < 4; ++it) {
        const int tt0 = rank * 512 + C.wave * 64 + it * 16;
        float L[2][16];
        bf16x8 bq[2][4];
#pragma unroll
        for (int half = 0; half < 2; ++half)
#pragma unroll
            for (int ks = 0; ks < 4; ++ks) bq[half][ks] = *(const bf16x8*)(QB + (size_t)(tt0 + fr) * D + h * 256 + half * 128 + 8 * fq + 32 * ks);
#pragma unroll
        for (int half = 0; half < 2; ++half) {
            f32x4 acc[8];
#pragma unroll
            for (int mt = 0; mt < 8; ++mt) acc[mt] = (f32x4){0.f, 0.f, 0.f, 0.f};
            const LAS bf16* Kb = KL + (half * 128 + fr) * TKST + 8 * fq;
#pragma unroll
            for (int ks = 0; ks < 4; ++ks)
#pragma unroll
                for (int mt = 0; mt < 8; ++mt) { const bf16x8 a = *(const LAS bf16x8*)(Kb + (16 * mt) * TKST + 32 * ks); acc[mt] = mfma16(a, bq[half][ks], acc[mt]); }
#pragma unroll
            for (int i = 0; i < 16; ++i) L[half][i] = __builtin_bit_cast(float, 0xFF800000u);
#pragma unroll
            for (int mt = 0; mt < 8; ++mt)
#pragma unroll
                for (int r = 0; r < 4; ++r) { const unsigned key = (unsigned)(16 * mt + 4 * fq + r);
                    const float sv = acc[mt][r];
                    list_insert(L[half], __builtin_bit_cast(float, (fbits(sv) & 0xFFFFFF80u) | key)); }
            list_merge_xor(L[half], 16); list_merge_xor(L[half], 32);
        }
        if (fq == 0) {
#pragma unroll
            for (int i = 0; i < 16; ++i) { tk[(fr * 2 + 0) * 16 + i] = fbits(L[0][i]); tk[(fr * 2 + 1) * 16 + i] = fbits(L[1][i]); }
        }
        float Cn[16];
#pragma unroll
        for (int i = 0; i < 16; ++i) Cn[i] = __builtin_bit_cast(float, 0xFF800000u);
#pragma unroll
        for (int i = 0; i < 16; ++i)
#pragma unroll
            for (int j = 0; j < 16; ++j) if ((i + 1) * (j + 1) <= 16) {
                const float s = unp7(L[0][i]) + unp7(L[1][j]);
                list_insert(Cn, __builtin_bit_cast(float, (fbits(s) & 0xFFFFFF00u) | (unsigned)(i * 16 + j))); }
        LDS_WAIT();
        float sc[4]; int ex[4];
#pragma unroll
        for (int m = 0; m < 4; ++m) {
            const float ck = fq == 0 ? Cn[m] : (fq == 1 ? Cn[4 + m] : (fq == 2 ? Cn[8 + m] : Cn[12 + m]));
            const unsigned cc = fbits(ck) & 255u;
            const unsigned p1 = tk[(fr * 2 + 0) * 16 + (cc >> 4)], p2 = tk[(fr * 2 + 1) * 16 + (cc & 15u)];
            sc[m] = __builtin_bit_cast(float, p1 & 0xFFFFFF80u) + __builtin_bit_cast(float, p2 & 0xFFFFFF80u);
            ex[m] = (int)((p1 & 127u) * 128u + (p2 & 127u));
        }
        float mx = fmaxf(fmaxf(sc[0], sc[1]), fmaxf(sc[2], sc[3]));
        mx = fmaxf(mx, __shfl_xor(mx, 16)); mx = fmaxf(mx, __shfl_xor(mx, 32));
        float w[4], sum = 0.f;
#pragma unroll
        for (int m = 0; m < 4; ++m) { w[m] = fexp2((sc[m] - mx) * 1.442695041f); sum += w[m]; }
        sum += __shfl_xor(sum, 16); sum += __shfl_xor(sum, 32);
        const float inv = 1.0f / sum;
        const size_t o = (size_t)(tt0 + fr) * 128 + h * 16 + 4 * fq;
#pragma unroll
        for (int m = 0; m < 4; ++m) { const int ku = KU[ex[m]], kv = KV[ex[m]]; w[m] = w[m] * inv * __builtin_bit_cast(float, (unsigned)(127 - kv) << 23); ex[m] |= (127 - ku) << 16; }
        *(int4*)(EB + o) = make_int4(ex[0], ex[1], ex[2], ex[3]);
        *(f32x4*)(PG + o) = (f32x4){w[0], w[1], w[2], w[3]};
        LDS_WAIT();
    }
}
typedef unsigned char fp8_t;
DI void unpack16(const u32x4 q, float (&f)[16]) {
#pragma unroll
    for (int w = 0; w < 4; ++w) { const int dw = (int)q[w]; const f32x2 lo = __builtin_amdgcn_cvt_pk_f32_fp8(dw, false), hi = __builtin_amdgcn_cvt_pk_f32_fp8(dw, true);
        f[4 * w] = lo.x; f[4 * w + 1] = lo.y; f[4 * w + 2] = hi.x; f[4 * w + 3] = hi.y; }
}
typedef long i64_t;
DI f32x4 sel4(bool c, const f32x4 a, const f32x4 b) { return (f32x4){c ? a.x : b.x, c ? a.y : b.y, c ? a.z : b.z, c ? a.w : b.w}; }
constexpr int PU_RST = 272, PU_TILE = 16 * PU_RST, PU_WAVE = 2 * PU_TILE;
DI void peerU_phase(const Ctx& C, const unsigned char* H8, const int* EB, const fp8_t* PU8, float* PART, const int emask = 0xFFFF) {
    const int x = C.bid & 7, rank = C.bid >> 3, lane = C.lane, kq = lane >> 4, m16 = lane & 15;
    const __amdgpu_buffer_rsrc_t trs = __builtin_amdgcn_make_buffer_rsrc((void*)(PU8 + (size_t)x * NEXP * 256), 0, NEXP * 256, 0x00020000);
    float* part = PART + (size_t)x * T * 128;
    const int tbase = rank * 512 + C.wave * 64;
    const int* ebase = EB + (size_t)tbase * 128 + lane;
    const unsigned char* hbase = H8 + (size_t)tbase * 4096 + (m16 & 1) * 2048 + 256 * x + 8 * kq;
    ldsp wl = C.lds + C.wave * PU_WAVE;
    const int wr_off = kq * PU_RST + 16 * m16;
    const int rd_off = m16 * PU_RST + 8 * kq;
    const int bp0 = 4 * kq;
    int ept0 = ebase[0], ept1 = ebase[64];
    int ep0 = ebase[128], ep1 = ebase[192];
    u32x2 hc[8], hn[8];
#pragma unroll
    for (int c = 0; c < 8; ++c) { hc[c] = *(const u32x2*)(hbase + 32 * c); hn[c] = hc[c]; }
    u32x4 r0[8], r1[8], r2[8], r3[8];
#define PU_ISSUE(BUF, ESEL, Q1) do { _Pragma("unroll") for (int i_ = 0; i_ < 8; ++i_) { const int ad_ = (bp0 + 4 * (32 * (Q1) + 4 * i_)) & 255; \
        const int e_ = __builtin_amdgcn_ds_bpermute(ad_, (ESEL)) & emask; BUF[i_] = __builtin_amdgcn_raw_buffer_load_b128(trs, e_ * 256 + 16 * m16, 0, 0); } } while (0)
#define PU_STEP(BUF, T0) do { _Pragma("unroll") for (int i_ = 0; i_ < 8; ++i_) *(LAS u32x4*)(wl + wr_off + (i_ >> 2) * PU_TILE + (i_ & 3) * 4 * PU_RST) = BUF[i_]; \
        _Pragma("unroll") for (int tt = 0; tt < 2; ++tt) _Pragma("unroll") for (int c = 0; c < 8; ++c) { const u32x2 av_ = *(const LAS u32x2*)(wl + rd_off + tt * PU_TILE + 32 * c); \
            acc[(T0) + tt] = __builtin_amdgcn_mfma_f32_16x16x32_fp8_fp8((i64_t)(((unsigned long long)av_.y << 32) | av_.x), (i64_t)(((unsigned long long)hc[c].y << 32) | hc[c].x), acc[(T0) + tt], 0, 0, 0); } } while (0)
    PU_ISSUE(r0, ept0, 0); PU_ISSUE(r1, ept0, 1); PU_ISSUE(r2, ept1, 2); PU_ISSUE(r3, ept1, 3);
    f32x2 pend = (f32x2){0.f, 0.f}; f32x2* pend_p = nullptr;
#pragma unroll 1
    for (int ti = 0; ti < 64; ++ti) {
        const int t = tbase + ti; const bool more = ti + 1 < 64;
        int epn0 = 0, epn1 = 0;
        if (ti + 2 < 64) { epn0 = ebase[(ti + 2) * 128]; epn1 = ebase[(ti + 2) * 128 + 64]; }
        if (more) {
#pragma unroll
            for (int c = 0; c < 8; ++c) hn[c] = *(const u32x2*)(hbase + (size_t)(ti + 1) * 4096 + 32 * c); }
        f32x4 acc[8];
#pragma unroll
        for (int tl = 0; tl < 8; ++tl) acc[tl] = (f32x4){0.f, 0.f, 0.f, 0.f};
        PU_STEP(r0, 0); if (more) PU_ISSUE(r0, ep0, 0);
        if (ti > 0) *pend_p = pend;
        PU_STEP(r1, 2); if (more) PU_ISSUE(r1, ep0, 1);
        PU_STEP(r2, 4); if (more) PU_ISSUE(r2, ep1, 2);
        PU_STEP(r3, 6); if (more) PU_ISSUE(r3, ep1, 3);
        {   const int n = m16, rg = kq;
            const f32x4 s01 = sel4((n >> 1) & 1, acc[1], acc[0]), s23 = sel4((n >> 1) & 1, acc[3], acc[2]), s45 = sel4((n >> 1) & 1, acc[5], acc[4]), s67 = sel4((n >> 1) & 1, acc[7], acc[6]);
            const f32x4 s03 = sel4((n >> 2) & 1, s23, s01), s47 = sel4((n >> 2) & 1, s67, s45), sv = sel4((n >> 3) & 1, s47, s03);
            const float p0 = dppf<0xB1>(sv.x), p1 = dppf<0xB1>(sv.y), p2 = dppf<0xB1>(sv.z), p3 = dppf<0xB1>(sv.w);
            const bool odd = n & 1;
            const float o0 = odd ? (p2 + sv.z * 0.0625f) : (sv.x + p0 * 0.0625f), o1 = odd ? (p3 + sv.w * 0.0625f) : (sv.y + p1 * 0.0625f);
            pend = (f32x2){o0 * 0.0625f, o1 * 0.0625f}; pend_p = (f32x2*)(part + (size_t)t * 128 + 16 * (n >> 1) + 4 * rg + 2 * (n & 1)); }
        ep0 = epn0; ep1 = epn1;
#pragma unroll
        for (int c = 0; c < 8; ++c) hc[c] = hn[c];
    }
    *pend_p = pend;
#undef PU_ISSUE
#undef PU_STEP
}
typedef int v2i32_t __attribute__((ext_vector_type(2)));
constexpr int PV_TILE = 32 * PU_RST, PV_A8 = PV_TILE, PV_Y = PV_TILE + 256, PV_WAVE = 10240;
DI float wave_max_u(float v) {
    v = fmaxf(v, dppf<0xB1>(v)); v = fmaxf(v, dppf<0x4E>(v)); v = fmaxf(v, dppf<0x141>(v)); v = fmaxf(v, dppf<0x140>(v));
    const int iv = __builtin_bit_cast(int, v);
    return fmaxf(fmaxf(__builtin_bit_cast(float, __builtin_amdgcn_readlane(iv, 0)), __builtin_bit_cast(float, __builtin_amdgcn_readlane(iv, 16))),
                 fmaxf(__builtin_bit_cast(float, __builtin_amdgcn_readlane(iv, 32)), __builtin_bit_cast(float, __builtin_amdgcn_readlane(iv, 48))));
}
DI void peerV_phase(const Ctx& C, const int* EB, const float* PG, const float* PART, const fp8_t* PV8, float* X, const float* gate  , const int emask = 0xFFFF, const int FAKE = 0) {
    const int x = C.bid & 7, rank = C.bid >> 3, lane = C.lane, kq = lane >> 4, m16 = lane & 15;
    const fp8_t* tab = PV8 + (size_t)x * NEXP * 256 + 16 * m16;
    const int tbase = rank * 512 + C.wave * 64;
    ldsp wl = C.lds + C.wave * PV_WAVE;
    const int wr_off = kq * PU_RST + 16 * m16;
    const int tr_off = (8 * kq + (m16 >> 1)) * PU_RST + 8 * (m16 & 1);
    const int a_off = PV_A8 + (m16 & 1) * 128 + 8 * kq;
    const int bp0 = 4 * kq;
    float pr0[8], pr1[8]; int rep0, rep1; float rg0, rg1;
#define PV_LOAD_RAW(tt) do { _Pragma("unroll") for (int xx = 0; xx < 8; ++xx) { const float* pp = PART + ((size_t)xx * T + (tt)) * 128 + lane; pr0[xx] = pp[0]; pr1[xx] = pp[64]; } \
        rep0 = EB[(size_t)(tt) * 128 + lane]; rep1 = EB[(size_t)(tt) * 128 + 64 + lane]; rg0 = PG[(size_t)(tt) * 128 + lane]; rg1 = PG[(size_t)(tt) * 128 + 64 + lane]; } while (0)
#define PV_FINISH(A0, A1, E0, E1) do { const float s0_ = ((pr0[0] + pr0[1]) + (pr0[2] + pr0[3])) + ((pr0[4] + pr0[5]) + (pr0[6] + pr0[7])), s1_ = ((pr1[0] + pr1[1]) + (pr1[2] + pr1[3])) + ((pr1[4] + pr1[5]) + (pr1[6] + pr1[7])); \
        A0 = gelu_t(s0_ * __builtin_bit_cast(float, (unsigned)(rep0 >> 16) << 23)) * rg0; A1 = gelu_t(s1_ * __builtin_bit_cast(float, (unsigned)(rep1 >> 16) << 23)) * rg1; E0 = (rep0 & emask) * 256; E1 = (rep1 & emask) * 256; } while (0)
    float a0, a1, a0n = 0.f, a1n = 0.f; int e0, e1, e0n = 0, e1n = 0;
    PV_LOAD_RAW(tbase); PV_FINISH(a0, a1, e0, e1);
    PV_LOAD_RAW(tbase + 1);
    u32x4 ra[8], rb[8];
#define PV_ISSUE(BUF, ESEL, Q1) do { _Pragma("unroll") for (int i_ = 0; i_ < 8; ++i_) { const int ad_ = (bp0 + 4 * (32 * (Q1) + 4 * i_)) & 255; \
        const int eo_ = __builtin_amdgcn_ds_bpermute(ad_, (ESEL)); BUF[i_] = *(const u32x4*)(tab + eo_); } } while (0)
#define PV_STEP(BUF, KS) do { _Pragma("unroll") for (int i_ = 0; i_ < 8; ++i_) *(LAS u32x4*)(wl + wr_off + i_ * 4 * PU_RST) = BUF[i_]; \
        const u32x2 ao_ = *(const LAS u32x2*)(wl + a_off + 32 * (KS)); const i64_t aop_ = (i64_t)(((unsigned long long)ao_.y << 32) | ao_.x); \
        _Pragma("unroll") for (int nt = 0; nt < 16; ++nt) { const v2i32_t bv_ = __builtin_amdgcn_ds_read_tr8_b64_v2i32((LAS v2i32_t*)(wl + tr_off + 16 * nt)); \
            acc[nt] = __builtin_amdgcn_mfma_f32_16x16x32_fp8_fp8(aop_, (i64_t)(((unsigned long long)(unsigned)bv_[1] << 32) | (unsigned)bv_[0]), acc[nt], 0, 0, 0); } } while (0)
    PV_ISSUE(ra, e0, 0);
    f32x4 xpend = (f32x4){0.f, 0.f, 0.f, 0.f}; f32x4* xpend_p = nullptr;
#pragma unroll 1
    for (int ti = 0; ti < 64; ++ti) {
        const int t = tbase + ti;
        const float amax = wave_max_u(fmaxf(fabsf(a0), fabsf(a1)));
        int ka = 0; if (amax > 0.f) { ka = (int)((__builtin_bit_cast(unsigned, 224.0f / amax) >> 23) & 255u) - 127; ka = ka < -100 ? -100 : (ka > 100 ? 100 : ka); }
        const float sca = __builtin_bit_cast(float, (unsigned)(ka + 127) << 23), inva = __builtin_bit_cast(float, (unsigned)(127 - ka) << 23);
        {   const float s0 = a0 * sca, s1 = a1 * sca;
            const int ph = __builtin_amdgcn_cvt_pk_fp8_f32(s0, s1, 0, false); const f32x2 bk = __builtin_amdgcn_cvt_pk_f32_fp8(ph, false);
            const int pl = __builtin_amdgcn_cvt_pk_fp8_f32((s0 - bk.x) * 16.0f, (s1 - bk.y) * 16.0f, 0, false);
            LAS unsigned char* a8 = (LAS unsigned char*)(wl + PV_A8);
            a8[lane] = (unsigned char)(ph & 255); a8[64 + lane] = (unsigned char)((ph >> 8) & 255); a8[128 + lane] = (unsigned char)(pl & 255); a8[192 + lane] = (unsigned char)((pl >> 8) & 255); }
        f32x4 acc[16];
#pragma unroll
        for (int nt = 0; nt < 16; ++nt) acc[nt] = (f32x4){0.f, 0.f, 0.f, 0.f};
        const int col = 256 * x + 4 * lane, b = t >> 12;
        f32x4* xp = (f32x4*)(X + (size_t)t * D + col);
        f32x4 xold = (f32x4){0.f, 0.f, 0.f, 0.f}; if (!FAKE) xold = *xp;
        const f32x4 gt = *(const f32x4*)(gate + (size_t)b * MODW + col);
        PV_ISSUE(rb, e0, 1);
        if (ti > 0 && !FAKE) *xpend_p = xpend;
        PV_STEP(ra, 0);
        PV_ISSUE(ra, e1, 2); PV_STEP(rb, 1);
        if (ti + 1 < 64) PV_FINISH(a0n, a1n, e0n, e1n);
        PV_ISSUE(rb, e1, 3); PV_STEP(ra, 2);
        if (ti + 2 < 64) PV_LOAD_RAW(t + 2);
        if (ti + 1 < 64) PV_ISSUE(ra, e0n, 0);
        PV_STEP(rb, 3);
        if (kq == 0) {
#pragma unroll
            for (int nt = 0; nt < 16; ++nt) *(LAS float*)(wl + PV_Y + 4 * (16 * nt + m16)) = (acc[nt][0] + acc[nt][1] * 0.0625f) * inva; }
        const f32x4 y = *(const LAS f32x4*)(wl + PV_Y + 16 * lane);
        if (FAKE) { if (y.x == 123.456f) *xp = y; }
        xpend = xold + gt * y; xpend_p = xp;
        a0 = a0n; a1 = a1n; e0 = e0n; e1 = e1n;
    }
    if (!FAKE) *xpend_p = xpend;
#undef PV_LOAD_RAW
#undef PV_FINISH
#undef PV_ISSUE
#undef PV_STEP
}
DI void final_norm_phase(const Ctx& C, float* X, const float* g) {
    const int r0 = C.gw * 8;
    f32x4 gm[8];
#pragma unroll
    for (int j = 0; j < 8; ++j) gm[j] = ((const f32x4*)g)[64 * j + C.lane];
#pragma unroll 1
    for (int i = 0; i < 8; ++i) {
        f32x4* xr = (f32x4*)(X + (size_t)(r0 + i) * D) + C.lane; f32x4 v[8]; float s = 0.f;
#pragma unroll
        for (int j = 0; j < 8; ++j) { v[j] = xr[64 * j]; s += (v[j].x * v[j].x + v[j].y * v[j].y) + (v[j].z * v[j].z + v[j].w * v[j].w); }
        const float rstd = frsq(wave_sum(s) * (1.f / D) + EPS);
#pragma unroll
        for (int j = 0; j < 8; ++j) xr[64 * j] = v[j] * rstd * gm[j];
    }
}
#ifndef PH_MASK
#define PH_MASK 0xFFFFF
#endif
#define EN(k) (((PH_MASK) >> (k)) & 1)
constexpr int NKIND = 11, NPH = 2 + 2 * NKIND;
struct Args { const float* in[21]; float* out; unsigned char* ws; int ph_lo, ph_hi, pad0, pad1; };
__global__ void __launch_bounds__(NTHR, 2) mk_fwd(Args args) {
    extern __shared__ __attribute__((aligned(16))) unsigned char lds_raw[];
    ldsp ldsb = (ldsp)lds_raw;
    volatile LAS unsigned* MISC = (volatile LAS unsigned*)(ldsb + MISC_OFF);
    for (int u = threadIdx.x; u < (LDS_BYTES - LDSCTL_OFF) / 4; u += NTHR) ((LAS unsigned*)(ldsb + LDSCTL_OFF))[u] = 0u;
    __syncthreads();
    unsigned* barw = (unsigned*)(args.ws + WS_CTL) + CW_BAR;
    XcdBarrier bar; bar.bar = barw; bar.x = 0; bar.st = nullptr;
    const bool multi = (args.ph_hi - args.ph_lo) > 1;
    if (multi) bar = xcd_barrier_post(barw, MISC + 8);

    int repflag = 0; (void)repflag;
#pragma unroll 1
    for (int ph = args.ph_lo; ph < args.ph_hi; ++ph) {
#define MKCTX Ctx C; { int tid_ = threadIdx.x, bid_ = blockIdx.x; asm volatile("" : "+v"(tid_)); asm volatile("" : "+s"(bid_)); \
        C.lds = ldsb; C.tid = tid_; C.lane = tid_ & 63; C.wave = __builtin_amdgcn_readfirstlane(tid_ >> 6); C.bid = bid_; C.G = gridDim.x; C.gw = C.bid * NWAVES + C.wave; C.NGW = C.G * NWAVES; \
        _Pragma("unroll") for (int i_ = 0; i_ < 21; ++i_) C.in[i_] = args.in[i_]; C.out = args.out; C.ws = args.ws; }
        unsigned char* const wsb = args.ws;
        float* MOD = (float*)(wsb + WS_MOD);
        bf16* Hb = (bf16*)(wsb + WS_H); bf16* PROJ = (bf16*)(wsb + WS_PROJ); bf16* SBUF = (bf16*)(wsb + WS_SBUF); bf16* CONCAT = (bf16*)(wsb + WS_CONCAT); bf16* QB = (bf16*)(wsb + WS_QB);
        float* ALOW = (float*)(wsb + WS_ALOW); float* DEC = (float*)(wsb + WS_DEC); int* EB = (int*)(wsb + WS_EB); float* PG = (float*)(wsb + WS_PG);
        float* X = args.out;
        const int l = ph < 2 ? 0 : (ph - 2) / NKIND, kind = ph < 2 ? -1 : (ph - 2) % NKIND;
        const float* modl = MOD + (size_t)l * 4 * MODW;
        if (ph == 0) { if (EN(0)) { MKCTX; p0_prologue(C); } }
        else if (ph == 1) { if (EN(1)) { MKCTX; norm_phase(C, C.in[I_X], C.in[I_N1G], modl, 0, D, Hb); } }
        else if ((kind == 0 || kind == 6) && EN(2)) {
            MKCTX; const bool isq = (kind == 6);
            pg8::Gemm g{Hb, isq ? (const bf16*)(wsb + WS_WTQ) + (size_t)l * D * D : (const bf16*)(wsb + WS_WTIN) + (size_t)l * WTIN_L, T, isq ? D : NPROJ, D};
            pg8::StaticOrder S; S.init(T, g.N, C.G, C.bid);
            pg8::EpiBf16 E{isq ? QB : PROJ, isq ? D : NPROJ};
            pg8::gemm_phase<pg8::EpiBf16, pg8::StaticOrder>(C.lds, g, S, E, C.tid);
            if (!isq) alow_phase(C, Hb, (const bf16*)(wsb + WS_WTIN) + (size_t)l * WTIN_L + (size_t)NPROJ * D, ALOW);
        }
        else if (kind == 1 && EN(3)) {
            MKCTX;
            glaA_phase(C, l, PROJ, ALOW, SBUF, DEC);
            gmlp_phase(C, l, PROJ, (const bf16*)(wsb + WS_WSB), CONCAT);
        }
        else if (kind == 2) { if (EN(4)) { MKCTX; scan_phase(C, SBUF, DEC); } }
        else if (kind == 3 && EN(5)) { MKCTX; glaC_phase(C, l, PROJ, ALOW, SBUF, CONCAT); }
        else if (kind == 4 && EN(6)) {
            MKCTX;
            pg8::Gemm g{CONCAT, (const bf16*)(wsb + WS_WTOUT) + (size_t)l * D * D, T, D, D};
            pg8::StaticOrder S; S.init(T, D, C.G, C.bid);
            pg8::EpiResGate E{l == 0 ? C.in[I_X] : (const float*)X, X, modl + 2 * D, MODW};
            pg8::gemm_phase<pg8::EpiResGate, pg8::StaticOrder>(C.lds, g, S, E, C.tid);
        }
        else if (kind == 5) { if (EN(1)) { MKCTX; norm_phase<true>(C, X, C.in[I_N2G] + (size_t)l * D, modl, 3 * D, 4 * D, Hb, wsb + WS_H8); } }
        else if (kind == 7) { if (EN(7)) { MKCTX; topk_phase(C, l, QB, (const bf16*)(wsb + WS_K1B), (const bf16*)(wsb + WS_K2B), (const int*)(wsb + WS_KU) + l * NEXP, (const int*)(wsb + WS_KV) + l * NEXP, EB, PG); } }
#ifdef DBG_FAKE_U
        else if (kind == 8) { if (EN(8)) { MKCTX; peerU_phase(C, wsb + WS_H8, EB, (const fp8_t*)(wsb + WS_PUB) + (size_t)l * NEXP * D, (float*)(wsb + WS_END), DBG_FAKE_U); peerU_phase(C, wsb + WS_H8, EB, (const fp8_t*)(wsb + WS_PUB) + (size_t)l * NEXP * D, (float*)SBUF); } }
#else
        else if (kind == 8) { if (EN(8)) { MKCTX; peerU_phase(C, wsb + WS_H8, EB, (const fp8_t*)(wsb + WS_PUB) + (size_t)l * NEXP * D, (float*)SBUF); } }
#endif
#ifdef DBG_FAKE_V
        else if (kind == 9) { if (EN(9)) { MKCTX; const int fake = (repflag == 0); peerV_phase(C, EB, PG, (const float*)SBUF, (const fp8_t*)(wsb + WS_PVB) + (size_t)l * NEXP * D, X, modl + 5 * D, fake ? (DBG_FAKE_V) : 0xFFFF, fake); } }
#else
        else if (kind == 9) { if (EN(9)) { MKCTX; peerV_phase(C, EB, PG, (const float*)SBUF, (const fp8_t*)(wsb + WS_PVB) + (size_t)l * NEXP * D, X, modl + 5 * D); } }
#endif
        else if (EN(10)) {
            MKCTX;
            if (l == DEPTH - 1) final_norm_phase(C, X, C.in[I_FG]);
            else norm_phase(C, X, C.in[I_N1G] + (size_t)(l + 1) * D, MOD + (size_t)(l + 1) * 4 * MODW, 0, D, Hb);
        }
        if (ph + 1 < args.ph_hi) xcd_barrier(bar);
#ifdef DBG_EXTRA_BAR
        if (ph + 1 < args.ph_hi) { xcd_barrier(bar); xcd_barrier(bar); }
#endif
#ifdef DBG_REP_MASK
        { const int bit = ph < 2 ? ph : 2 + kind; bool want = ((DBG_REP_MASK) >> bit) & 1;
#ifdef DBG_REP_L0
          if (l != 0) want = false;
#endif
          if (want && !repflag) { repflag = 1; --ph; } else repflag = 0; }
#endif
    }
}

extern "C" void kernel_launch(void* const* d_in, const int* in_sizes, int n_in, void* d_out, int out_size, void* d_ws, size_t ws_size, hipStream_t stream) {
    static int grid = 0;
    if (grid == 0) {
        if (n_in != 21 || out_size != T * D || ws_size < WS_END) { fprintf(stderr, "kernel_launch: unexpected shapes (n_in %d, out %d, ws %zu)\n", n_in, out_size, ws_size); grid = -1; return; }
        int dev = 0, cus = 0, per_cu = 0;
        if (hipGetDevice(&dev) != hipSuccess || hipDeviceGetAttribute(&cus, hipDeviceAttributeMultiprocessorCount, dev) != hipSuccess) { grid = -1; return; }
        if (hipFuncSetAttribute((const void*)mk_fwd, hipFuncAttributeMaxDynamicSharedMemorySize, LDS_BYTES) != hipSuccess) { fprintf(stderr, "kernel_launch: hipFuncSetAttribute failed\n"); grid = -1; return; }
        if (hipOccupancyMaxActiveBlocksPerMultiprocessor(&per_cu, (const void*)mk_fwd, NTHR, LDS_BYTES) != hipSuccess || per_cu < 1) { fprintf(stderr, "kernel_launch: occupancy query says %d blocks per CU\n", per_cu); (void)hipGetLastError(); grid = -1; return; }
        if (cus != 256) { fprintf(stderr, "kernel_launch: built for a 256-CU device (got %d)\n", cus); grid = -1; return; }
        grid = cus;
    }
    if (grid < 0) return;
    (void)hipMemsetAsync((char*)d_ws + WS_CTL, 0, CTL_ZERO_BYTES, stream);
    Args a{};
    for (int i = 0; i < 21; ++i) a.in[i] = (const float*)d_in[i];
    a.out = (float*)d_out; a.ws = (unsigned char*)d_ws;
#if MK_N_LAUNCHES == 1
    a.ph_lo = 0; a.ph_hi = NPH;
    hipLaunchKernelGGL(mk_fwd, dim3(grid), dim3(NTHR), LDS_BYTES, stream, a);
#else
    for (int p = 0; p < NPH; ++p) { a.ph_lo = p; a.ph_hi = p + 1; hipLaunchKernelGGL(mk_fwd, dim3(grid), dim3(NTHR), LDS_BYTES, stream, a); }
#endif
}
```

```cpp
#include <hip/hip_runtime.h>
#include <cstdio>
#include <cstdint>
#ifndef MK_N_LAUNCHES
#define MK_N_LAUNCHES 1
#endif
namespace pg8 {
#define PG8_LAS __attribute__((address_space(3)))
typedef unsigned short bf16_t;
typedef short bf16x8 __attribute__((ext_vector_type(8)));
typedef float f32x4 __attribute__((ext_vector_type(4)));
typedef unsigned u32x4 __attribute__((ext_vector_type(4)));
constexpr int BM = 256, BK = 64, HALF = 128, HTB = HALF * BK * 2  , STAGE_BYTES = 8 * HTB, NXCD = 8, WGM = 8;

__host__ __device__ __forceinline__ int lds_byte(int r, int c) { const int st = (r >> 4) * 2 + (c >> 5), rr = r & 15, cc = c & 31, ob = rr * 64 + cc * 2; return st * 1024 + (ob ^ (((ob >> 9) & 1) << 5)); }
__host__ __device__ __forceinline__ void stage_rc(int b, int& R, int& C) { const int st = b / 1024, sb = b % 1024, swz = sb ^ (((sb >> 9) & 1) << 5); R = (st >> 1) * 16 + swz / 64; C = (st & 1) * 32 + (swz % 64) / 2; }
__host__ __device__ __forceinline__ int perm32(int rho) { const int n = rho >> 4, i = rho & 15; return 8 * (i >> 2) + 4 * n + (i & 3); }

struct Unit { int pm, pn; };
struct Gemm { const bf16_t* A; const bf16_t* Bt; int M, N, K; };

struct StaticOrder {
    int nM, nN, nwg, G, c;
    __host__ __device__ void init(int M, int N, int G_, int c_) { nM = M / BM; nN = N / BM; nwg = nM * nN; G = G_; c = c_; }
    __host__ __device__ bool next(int i, Unit& u) const {
        const long L = (long)i * G + c; if (L >= nwg) return false;
        int wgid = (int)L; { const int q = nwg / NXCD, r = nwg % NXCD, xcd = wgid % NXCD, off = wgid / NXCD; wgid = (xcd < r ? xcd * (q + 1) : r * (q + 1) + (xcd - r) * q) + off; }
        const int nig = WGM * nN, gid = wgid / nig, fm = gid * WGM, gsz = (nM - fm) < WGM ? (nM - fm) : WGM;
        u.pm = fm + ((wgid % nig) % gsz); u.pn = (wgid % nig) / gsz; return true;
    }
    __device__ __forceinline__ void a_ready(const Unit&) const {}
    __device__ __forceinline__ void done(const Unit&) const {}
};
__device__ __forceinline__ unsigned cvt_pk_bf16(float lo, float hi) { unsigned r; asm volatile("v_cvt_pk_bf16_f32 %0, %1, %2" : "=v"(r) : "v"(lo), "v"(hi)); return r; }
struct EpiBf16 {
    static constexpr bool PERM = true, AFTER_DRAIN = false;
    bf16_t* O; int ldc;
    __device__ __forceinline__ void operator()(const f32x4 (&acc)[2][2][4][2], const Unit& u, int wr, int wc, int fr, int fq) const {
        const int row0 = u.pm * BM + wr * 64 + fr; const int col0 = u.pn * BM + wc * 32 + 8 * fq;
#pragma unroll
        for (int ai = 0; ai < 2; ++ai)
#pragma unroll
            for (int m = 0; m < 4; ++m) { bf16_t* rowp = O + (size_t)(row0 + ai * HALF + m * 16) * ldc + col0;
#pragma unroll
                for (int bj = 0; bj < 2; ++bj) { const f32x4 v0 = acc[ai][bj][m][0], v1 = acc[ai][bj][m][1];
                    u32x4 w; w.x = cvt_pk_bf16(v0[0], v0[1]); w.y = cvt_pk_bf16(v0[2], v0[3]); w.z = cvt_pk_bf16(v1[0], v1[1]); w.w = cvt_pk_bf16(v1[2], v1[3]);
                    *(u32x4*)(rowp + bj * HALF) = w; } }
    }
};
struct EpiResGate {
    static constexpr bool PERM = false, AFTER_DRAIN = false;
    const float* base; float* out; const float* gate; int gpitch;
    __device__ __forceinline__ void operator()(const f32x4 (&acc)[2][2][4][2], const Unit& u, int wr, int wc, int fr, int fq) const {
        const int row0 = u.pm * BM + wr * 64 + fr, col0 = u.pn * BM + wc * 32 + 4 * fq;
        const float* gp = gate + (size_t)(u.pm >> 4) * gpitch + col0;
        f32x4 gv[2][2];
#pragma unroll
        for (int bj = 0; bj < 2; ++bj)
#pragma unroll
            for (int n = 0; n < 2; ++n) gv[bj][n] = *(const f32x4*)(gp + bj * HALF + n * 16);
#pragma unroll
        for (int ai = 0; ai < 2; ++ai)
#pragma unroll
            for (int m = 0; m < 4; ++m) { const size_t off = (size_t)(row0 + ai * HALF + m * 16) * 2048 + col0;
#pragma unroll
                for (int bj = 0; bj < 2; ++bj)
#pragma unroll
                    for (int n = 0; n < 2; ++n) { const f32x4 bs = *(const f32x4*)(base + off + bj * HALF + n * 16); *(f32x4*)(out + off + bj * HALF + n * 16) = bs + gv[bj][n] * acc[ai][bj][m][n]; }
                asm volatile("" ::: "memory"); }
    }
};

template <class Epi, class Sched, bool ALIGN_EPI = false, bool SP2 = false>
__device__ __forceinline__ void gemm_phase(PG8_LAS unsigned char* lds, const Gemm g, const Sched& S, const Epi& E, const int tid  ) {
    const int wid = __builtin_amdgcn_readfirstlane(tid >> 6), lane = tid & 63, wr = wid >> 2, wc = wid & 3, fr = lane & 15, fq = lane >> 4;
    const int K = g.K, nt = K / BK;
    unsigned voffA[2], voffB[2];
#pragma unroll
    for (int i = 0; i < 2; ++i) { int R, C; stage_rc(tid * 16 + i * 8192, R, C); const int Rb = Epi::PERM ? ((R & ~31) + perm32(R & 31)) : R;
        voffA[i] = (unsigned)(R * K + C) * 2u; voffB[i] = (unsigned)(Rb * K + C) * 2u; }
    const size_t kstep = (size_t)(BK * 2);
    const size_t hstep = (size_t)HALF * K * 2;
    const size_t tstep = 2 * hstep;
    const unsigned ldsw = (unsigned)wid * 1024u;
    const int aoff = lds_byte(wr * 64 + fr, fq * 8), boff = lds_byte(wc * 32 + fr, fq * 8);
#define PG8_SA(b, h) (((b) * 2 + (h)) * HTB)
#define PG8_SB(b, h) ((4 + (b) * 2 + (h)) * HTB)
#define PG8_STAGE(bufoff, gbase, voff) do { _Pragma("unroll") for (int _i = 0; _i < 2; ++_i) \
        __builtin_amdgcn_global_load_lds((const unsigned*)((const char*)(gbase) + (voff)[_i]), (PG8_LAS unsigned*)(lds + (bufoff) + ldsw + _i * 8192), 16, 0, 0); } while (0)
#define PG8_LDA(dst, b, h) do { _Pragma("unroll") for (int m = 0; m < 4; ++m) _Pragma("unroll") for (int k = 0; k < 2; ++k) dst[m][k] = *(const PG8_LAS bf16x8*)(lds + PG8_SA(b, h) + aoff + m * 2048 + k * 1024); } while (0)
#define PG8_LDB(dst, b, h) do { _Pragma("unroll") for (int n = 0; n < 2; ++n) _Pragma("unroll") for (int k = 0; k < 2; ++k) dst[n][k] = *(const PG8_LAS bf16x8*)(lds + PG8_SB(b, h) + boff + n * 2048 + k * 1024); } while (0)
#define PG8_MMA(ai, bj, At, Bt) do { __builtin_amdgcn_s_setprio(1); _Pragma("unroll") for (int m = 0; m < 4; ++m) _Pragma("unroll") for (int n = 0; n < 2; ++n) _Pragma("unroll") for (int k = 0; k < 2; ++k) \
        acc[ai][bj][m][n] = __builtin_amdgcn_mfma_f32_16x16x32_bf16(Bt[n][k], At[m][k], acc[ai][bj][m][n], 0, 0, 0); __builtin_amdgcn_s_setprio(0); } while (0)
#define PG8_WAIT_V(n) asm volatile("s_waitcnt vmcnt(" #n ")" ::: "memory")
#define PG8_WAIT_L(n) asm volatile("s_waitcnt lgkmcnt(" #n ")" ::: "memory")
#define PG8_BAR __builtin_amdgcn_s_barrier()
#define PG8_SCHED __builtin_amdgcn_sched_barrier(0)
    Unit cur, nxt; int ui = 0;
    if (!S.next(0, cur)) return;
    f32x4 acc[2][2][4][2];
#pragma unroll
    for (int a = 0; a < 2; ++a)
#pragma unroll
        for (int b = 0; b < 2; ++b)
#pragma unroll
            for (int m = 0; m < 4; ++m)
#pragma unroll
                for (int n = 0; n < 2; ++n) acc[a][b][m][n] = (f32x4){0.f, 0.f, 0.f, 0.f};
    bf16x8 At[4][2], B0[2][2], B1[2][2];
    const char* cA = (const char*)g.A + (size_t)cur.pm * tstep; const char* cB = (const char*)g.Bt + (size_t)cur.pn * tstep;
    S.a_ready(cur);
    if constexpr (SP2) {
        PG8_STAGE(PG8_SB(0, 0), cB, voffB); PG8_STAGE(PG8_SB(0, 1), cB + hstep, voffB); PG8_STAGE(PG8_SA(0, 0), cA, voffA); PG8_STAGE(PG8_SA(0, 1), cA + hstep, voffA);
        if (wr == 1) PG8_BAR;
        PG8_WAIT_V(2); PG8_BAR;
        PG8_STAGE(PG8_SB(1, 0), cB + kstep, voffB); PG8_STAGE(PG8_SA(1, 0), cA + kstep, voffA); PG8_STAGE(PG8_SB(1, 1), cB + hstep + kstep, voffB);
        PG8_WAIT_V(6); PG8_BAR;
    } else {
        PG8_STAGE(PG8_SB(0, 0), cB, voffB); PG8_STAGE(PG8_SA(0, 0), cA, voffA); PG8_STAGE(PG8_SB(0, 1), cB + hstep, voffB); PG8_STAGE(PG8_SA(0, 1), cA + hstep, voffA);
        if (wr == 1) PG8_BAR;
        PG8_WAIT_V(4); PG8_BAR;
        PG8_STAGE(PG8_SB(1, 0), cB + kstep, voffB); PG8_STAGE(PG8_SA(1, 0), cA + kstep, voffA); PG8_STAGE(PG8_SB(1, 1), cB + hstep + kstep, voffB);
        PG8_WAIT_V(6); PG8_BAR;
    }
    for (;;) {
        const bool has_next = S.next(ui + 1, nxt);
        const char* nA = has_next ? (const char*)g.A + (size_t)nxt.pm * tstep : cA; const char* nB = has_next ? (const char*)g.Bt + (size_t)nxt.pn * tstep : cB;
        for (int t = 0; t < nt; t += 2) {
            const bool last = (t == nt - 2);
            const char* a1 = cA + (size_t)(t + 1) * kstep;
            const char* a2 = last ? nA : cA + (size_t)(t + 2) * kstep; const char* b2 = last ? nB : cB + (size_t)(t + 2) * kstep;
            const char* a3 = a2 + kstep; const char* b3 = b2 + kstep;
            if (last && has_next) S.a_ready(nxt);
            if constexpr (SP2) {
            PG8_LDB(B0, 0, 0); PG8_LDB(B1, 0, 1); PG8_SCHED; PG8_LDA(At, 0, 0); PG8_STAGE(PG8_SA(1, 1), a1 + hstep, voffA);
            PG8_WAIT_V(8); PG8_WAIT_L(0); PG8_BAR; PG8_MMA(0, 0, At, B0); PG8_MMA(0, 1, At, B1); PG8_BAR; PG8_SCHED;
            PG8_LDA(At, 0, 1); PG8_STAGE(PG8_SB(0, 0), b2, voffB); PG8_STAGE(PG8_SB(0, 1), b2 + hstep, voffB); PG8_STAGE(PG8_SA(0, 0), a2, voffA);
            PG8_WAIT_V(8); PG8_WAIT_L(0); PG8_BAR; PG8_MMA(1, 0, At, B0); PG8_MMA(1, 1, At, B1); PG8_BAR; PG8_SCHED;
            PG8_LDB(B0, 1, 0); PG8_LDB(B1, 1, 1); PG8_SCHED; PG8_LDA(At, 1, 0); PG8_STAGE(PG8_SA(0, 1), a2 + hstep, voffA);
            PG8_WAIT_V(8); PG8_WAIT_L(0); PG8_BAR; PG8_MMA(0, 0, At, B0); PG8_MMA(0, 1, At, B1); PG8_BAR; PG8_SCHED;
            PG8_LDA(At, 1, 1); PG8_STAGE(PG8_SB(1, 0), b3, voffB); PG8_STAGE(PG8_SB(1, 1), b3 + hstep, voffB); PG8_STAGE(PG8_SA(1, 0), a3, voffA);
            PG8_WAIT_V(8); PG8_WAIT_L(0); PG8_BAR; PG8_MMA(1, 0, At, B0); PG8_MMA(1, 1, At, B1); PG8_BAR; PG8_SCHED;
            } else {
            PG8_LDB(B0, 0, 0); PG8_SCHED; PG8_LDA(At, 0, 0); PG8_STAGE(PG8_SA(1, 1), a1 + hstep, voffA);
            PG8_WAIT_L(8); PG8_BAR; PG8_WAIT_L(0); PG8_MMA(0, 0, At, B0); PG8_BAR; PG8_SCHED;
            PG8_LDB(B1, 0, 1); PG8_STAGE(PG8_SB(0, 0), b2, voffB);
            PG8_BAR; PG8_WAIT_L(0); PG8_MMA(0, 1, At, B1); PG8_BAR;
            PG8_LDA(At, 0, 1); PG8_STAGE(PG8_SA(0, 0), a2, voffA);
            PG8_BAR; PG8_WAIT_L(0); PG8_MMA(1, 0, At, B0); PG8_BAR; PG8_SCHED;
            PG8_STAGE(PG8_SB(0, 1), b2 + hstep, voffB);
            PG8_WAIT_V(6); PG8_BAR; PG8_MMA(1, 1, At, B1); PG8_BAR;
            PG8_LDB(B0, 1, 0); PG8_SCHED; PG8_LDA(At, 1, 0); PG8_STAGE(PG8_SA(0, 1), a2 + hstep, voffA);
            PG8_WAIT_L(8); PG8_BAR; PG8_WAIT_L(0); PG8_MMA(0, 0, At, B0); PG8_BAR; PG8_SCHED;
            PG8_LDB(B1, 1, 1); PG8_STAGE(PG8_SB(1, 0), b3, voffB);
            PG8_BAR; PG8_WAIT_L(0); PG8_MMA(0, 1, At, B1); PG8_BAR;
            PG8_LDA(At, 1, 1); PG8_STAGE(PG8_SA(1, 0), a3, voffA);
            PG8_BAR; PG8_WAIT_L(0); PG8_MMA(1, 0, At, B0); PG8_BAR; PG8_SCHED;
            PG8_STAGE(PG8_SB(1, 1), b3 + hstep, voffB);
            PG8_WAIT_V(6); PG8_BAR; PG8_MMA(1, 1, At, B1); PG8_BAR;
            }
        }
        if constexpr (ALIGN_EPI) { if (wr == 0) PG8_BAR; }
        if constexpr (!Epi::AFTER_DRAIN) { E(acc, cur, wr, wc, fr, fq); S.done(cur); }
        if (!has_next) break;
#pragma unroll
        for (int a = 0; a < 2; ++a)
#pragma unroll
            for (int b = 0; b < 2; ++b)
#pragma unroll
                for (int m = 0; m < 4; ++m)
#pragma unroll
                    for (int n = 0; n < 2; ++n) acc[a][b][m][n] = (f32x4){0.f, 0.f, 0.f, 0.f};
        cur = nxt; cA = nA; cB = nB; ++ui;
        if constexpr (ALIGN_EPI) { if (wr == 1) PG8_BAR; }
    }
    PG8_WAIT_V(0);
    if constexpr (!ALIGN_EPI) { if (wr == 0) PG8_BAR; }
    PG8_BAR;
    if constexpr (Epi::AFTER_DRAIN) { E.fused(acc, cur, wr, wc, fr, fq, lds, wid, lane); S.done(cur); }
#undef PG8_SA
#undef PG8_SB
#undef PG8_STAGE
#undef PG8_LDA
#undef PG8_LDB
#undef PG8_MMA
#undef PG8_WAIT_V
#undef PG8_WAIT_L
#undef PG8_BAR
#undef PG8_SCHED
}
}
constexpr int NWAVES = 8, NTHR = 512;
constexpr int D = 2048, NBATCH = 4, SEQ = 4096, T = NBATCH * SEQ, DEPTH = 2;
constexpr int GLA_H = 4, GLA_DK = 128, GLA_DV = 256, GLA_CH = 64;
constexpr int MLP_H = 8, MLP_DH = 128, MLP_CH = 128;
constexpr int IN_COLS = 5136, NPROJ = 5120;
constexpr int C_Q = 0, C_K = 512, C_V = 1024, C_R = 2048, C_U = 3072, C_VS = 4096;
constexpr int NEXP = 16384, PEER_H = 8;
constexpr float EPS = 1e-6f;
constexpr int MODW = 6 * D;
constexpr size_t MiB = 1u << 20;
constexpr size_t WS_CTL = 0, CTL_ZERO_BYTES = 1 * MiB;
constexpr size_t WS_MOD = 1 * MiB;
constexpr size_t WS_K1B = 2 * MiB, WS_K2B = 2 * MiB + 512 * 1024, WS_WSB = 3 * MiB, WS_DEC = 3 * MiB + 512 * 1024, WS_ALOW = 4 * MiB;
constexpr size_t WS_KU = 5 * MiB, WS_KV = 5 * MiB + 256 * 1024;
constexpr size_t WS_WTIN = 8 * MiB;
constexpr size_t WTIN_L = (size_t)5136 * 2048;
constexpr size_t WS_WTOUT = 49 * MiB, WS_WTQ = 65 * MiB;
constexpr size_t WS_PUB = 81 * MiB, WS_PVB = 209 * MiB;
constexpr size_t WS_H = 337 * MiB;
constexpr size_t WS_PROJ = 401 * MiB;
constexpr size_t WS_SBUF = 561 * MiB;
constexpr size_t WS_CONCAT = 625 * MiB;
constexpr size_t WS_QB = 689 * MiB;
constexpr size_t WS_EB = 753 * MiB, WS_PG = 761 * MiB;
constexpr size_t WS_H8 = 769 * MiB, WS_END = 833 * MiB;
static_assert(WS_WTIN + 2 * WTIN_L * 2 <= WS_WTOUT, "ws map");
constexpr int CW_BAR = 4096;
constexpr int RING_BYTES = 131072, LDSCTL_OFF = RING_BYTES, MISC_OFF = LDSCTL_OFF + 320, LDS_BYTES = 147456;

#define DI __device__ __forceinline__
#define LAS __attribute__((address_space(3)))
typedef unsigned short bf16;
typedef short bf16x8 __attribute__((ext_vector_type(8)));
typedef short s16x4 __attribute__((ext_vector_type(4)));
typedef short v4i16_t __attribute__((ext_vector_type(4)));
typedef __bf16 bf16x2_t __attribute__((ext_vector_type(2)));
typedef float f32x4 __attribute__((ext_vector_type(4)));
typedef float f32x2 __attribute__((ext_vector_type(2)));
typedef unsigned u32x4 __attribute__((ext_vector_type(4)));
typedef unsigned u32x2 __attribute__((ext_vector_type(2)));
typedef LAS unsigned char* ldsp;

DI unsigned f2bf(float f) { unsigned u = __builtin_bit_cast(unsigned, f); return (u + 0x7fffu + ((u >> 16) & 1u)) >> 16; }
DI unsigned pk2(float lo, float hi) { return f2bf(lo) | (f2bf(hi) << 16); }
DI float bflo(unsigned u) { return __builtin_bit_cast(float, u << 16); }
DI float bfhi(unsigned u) { return __builtin_bit_cast(float, u & 0xffff0000u); }
DI float bf1(bf16 v) { return __builtin_bit_cast(float, ((unsigned)v) << 16); }
DI float fexp2(float x) { return __builtin_amdgcn_exp2f(x); }
DI float flog2(float x) { return __builtin_amdgcn_logf(x); }
DI float frcp(float x) { return __builtin_amdgcn_rcpf(x); }
DI float frsq(float x) { return __builtin_amdgcn_rsqf(x); }
DI float gelu_t(float x) { const float u = 0.7978845608f * (x + 0.044715f * x * x * x); return x * frcp(1.f + fexp2(-2.885390082f * u)); }
DI float silu_f(float x) { return x * frcp(1.f + fexp2(-1.442695041f * x)); }
template <int CTRL> DI float dppf(float v) { return __builtin_bit_cast(float, __builtin_amdgcn_update_dpp(0, __builtin_bit_cast(int, v), CTRL, 0xf, 0xf, true)); }
DI float wave_sum_u(float v) {
    v += dppf<0xB1>(v); v += dppf<0x4E>(v); v += dppf<0x141>(v); v += dppf<0x140>(v);
    const int iv = __builtin_bit_cast(int, v);
    return (__builtin_bit_cast(float, __builtin_amdgcn_readlane(iv, 0)) + __builtin_bit_cast(float, __builtin_amdgcn_readlane(iv, 16))) +
           (__builtin_bit_cast(float, __builtin_amdgcn_readlane(iv, 32)) + __builtin_bit_cast(float, __builtin_amdgcn_readlane(iv, 48)));
}
DI float wave_sum(float v) {
#pragma unroll
    for (int o = 1; o < 64; o <<= 1) v += __shfl_xor(v, o);
    return v;
}
DI float dot2bf(unsigned a, unsigned b, float c) { return __builtin_amdgcn_fdot2_f32_bf16(__builtin_bit_cast(bf16x2_t, a), __builtin_bit_cast(bf16x2_t, b), c, false); }
DI f32x4 mfma16(bf16x8 a, bf16x8 b, f32x4 c) { return __builtin_amdgcn_mfma_f32_16x16x32_bf16(a, b, c, 0, 0, 0); }
DI s16x4 tr4(const LAS bf16* p) { return __builtin_bit_cast(s16x4, __builtin_amdgcn_ds_read_tr16_b64_v4i16((LAS v4i16_t*)p)); }
DI bf16x8 tr8(const LAS bf16* p, int stride) { const s16x4 a = tr4(p), b = tr4(p + 4 * stride); return (bf16x8){a[0], a[1], a[2], a[3], b[0], b[1], b[2], b[3]}; }

#define XB_TMO      128
#define XB_XCNT(j)  (256  + 64 * (j))
#define XB_XSUB(j)  (1280 + 64 * (j))
#define XB_XGEN(j)  (2304 + 64 * (j))
#define XB_TOP      3328
#define XB_TOPGEN   3392
#define XCD_BAR_WORDS 3456
#define XB_SPIN_CAP (1u << 18)

__device__ __forceinline__ unsigned xb_ld(unsigned* p)              { return __hip_atomic_load(p, __ATOMIC_RELAXED, __HIP_MEMORY_SCOPE_AGENT); }
__device__ __forceinline__ unsigned xb_add(unsigned* p, unsigned v) { return __hip_atomic_fetch_add(p, v, __ATOMIC_RELAXED, __HIP_MEMORY_SCOPE_AGENT); }
__device__ __forceinline__ unsigned xb_xcc_id() { return (unsigned)__builtin_amdgcn_s_getreg((3 << 11) | 20) & 0xFu; }
#define XB_SPIN(cond, bar) do { unsigned _sp = 0; while (cond) { __builtin_amdgcn_s_sleep(1); \
    if ((++_sp & 255u) == 0u) { if (xb_ld(&(bar)[XB_TMO])) break; if (_sp > XB_SPIN_CAP) { atomicAdd(&(bar)[XB_TMO], 1u); break; } } } } while (0)

struct XcdBarrier {
    unsigned* bar; unsigned x;
    volatile LAS unsigned* st;
};

__device__ __forceinline__ XcdBarrier xcd_barrier_post(unsigned* bar, volatile LAS unsigned* st) {
    XcdBarrier b; b.bar = bar; b.x = xb_xcc_id(); b.st = st;
    if (threadIdx.x == 0) (void)xb_add(&bar[XB_XCNT(b.x)], 1u);
    return b;
}
__device__ __forceinline__ void xcd_barrier_complete(unsigned* bar, unsigned x, unsigned& nloc, unsigned& nx) {
    const unsigned G = gridDim.x * gridDim.y * gridDim.z;
    unsigned sum, cnt, mine, sp = 0u;
    for (;;) {
        sum = 0u; cnt = 0u; mine = 0u;
#pragma unroll
        for (unsigned j = 0; j < 16; ++j) { const unsigned c = xb_ld(&bar[XB_XCNT(j)]); sum += c; cnt += (c > 0u) ? 1u : 0u; mine = (j == x) ? c : mine; }
        if (sum == G) break;
        __builtin_amdgcn_s_sleep(1);
        if ((++sp & 255u) == 0u) { if (xb_ld(&bar[XB_TMO])) break; if (sp > XB_SPIN_CAP) { atomicAdd(&bar[XB_TMO], 1u); break; } }
    }
    nloc = mine > 0u ? mine : 1u; nx = cnt > 0u ? cnt : 1u;
}

__device__ __forceinline__ void xcd_barrier(const XcdBarrier& b) {
    asm volatile("s_waitcnt vmcnt(0)" ::: "memory");
    __syncthreads();
    if (threadIdx.x == 0) {
        unsigned* bar = b.bar;
        __builtin_amdgcn_s_waitcnt(0);
        unsigned nloc = b.st[0], nx = b.st[1];
        if (nloc == 0u) { xcd_barrier_complete(bar, b.x, nloc, nx); b.st[0] = nloc; b.st[1] = nx; }
        const unsigned old = xb_add(&bar[XB_XSUB(b.x)], 1u);
        const unsigned gen = old / nloc;
        if (old + 1u == (gen + 1u) * nloc) {
            __builtin_amdgcn_fence(__ATOMIC_RELEASE, "agent");
            asm volatile("s_waitcnt vmcnt(0)" ::: "memory");
            const unsigned og = xb_add(&bar[XB_TOP], 1u);
            const unsigned tg = og / nx;
            if (og + 1u == (tg + 1u) * nx) xb_add(&bar[XB_TOPGEN], 1u);
            else XB_SPIN(xb_ld(&bar[XB_TOPGEN]) == tg, bar);
            __builtin_amdgcn_fence(__ATOMIC_ACQUIRE, "agent");
            xb_add(&bar[XB_XGEN(b.x)], 1u);
            asm volatile("s_waitcnt vmcnt(0)" ::: "memory");
        } else {
            XB_SPIN(xb_ld(&bar[XB_XGEN(b.x)]) == gen, bar);
            __builtin_amdgcn_fence(__ATOMIC_ACQUIRE, "agent");
            asm volatile("s_waitcnt vmcnt(0)" ::: "memory");
        }
    }
    __syncthreads();
}
struct Ctx {
    ldsp lds; int tid, lane, wave, bid, G, gw, NGW;
    const float* in[21]; float* out; unsigned char* ws;
};
#define LDS_WAIT() asm volatile("s_waitcnt lgkmcnt(0)" ::: "memory")
enum { I_X = 0, I_C, I_ADAW, I_ADAB, I_N1G, I_WIN, I_WA2, I_BA, I_GNG, I_VNG, I_MWS, I_MB, I_MOG, I_WOUT, I_N2G, I_WQ, I_K1, I_K2, I_PU, I_PV, I_FG };

DI void p0_ada(const Ctx& C) {
    LAS float* red = (LAS float*)C.lds;
    float* MOD = (float*)(C.ws + WS_MOD);
    for (int it = C.bid; it < 192; it += C.G) {
        const int l = it / 96, cg = it % 96, c0 = cg * 128 + C.lane * 2;
        const float* W = C.in[I_ADAW] + (size_t)l * D * MODW + (size_t)(C.wave * 256) * MODW + c0;
        float cv[4][4];
#pragma unroll
        for (int b = 0; b < 4; ++b)
#pragma unroll
            for (int i = 0; i < 4; ++i) cv[b][i] = silu_f(C.in[I_C][b * D + C.wave * 256 + i * 64 + C.lane]);
        float acc[4][2];
#pragma unroll
        for (int b = 0; b < 4; ++b) { acc[b][0] = 0.f; acc[b][1] = 0.f; }
#pragma unroll
        for (int i = 0; i < 4; ++i) {
#pragma unroll 16
            for (int j = 0; j < 64; ++j) {
                const f32x2 w = *(const f32x2*)(W + (size_t)(i * 64 + j) * MODW);
#pragma unroll
                for (int b = 0; b < 4; ++b) { const float s = __builtin_bit_cast(float, __builtin_amdgcn_readlane(__builtin_bit_cast(int, cv[b][i]), j)); acc[b][0] += s * w.x; acc[b][1] += s * w.y; }
            }
        }
#pragma unroll
        for (int b = 0; b < 4; ++b) *(LAS f32x2*)(red + (C.wave * 4 + b) * 128 + C.lane * 2) = (f32x2){acc[b][0], acc[b][1]};
        __syncthreads();
        { const int b = C.tid >> 7, col = C.tid & 127; float s = C.in[I_ADAB][l * MODW + cg * 128 + col];
#pragma unroll
          for (int w = 0; w < 8; ++w) s += red[(w * 4 + b) * 128 + col];
          MOD[(size_t)(l * 4 + b) * MODW + cg * 128 + col] = s; }
        __syncthreads();
    }
}
DI void transpose_item(const float* W, int ldw, int src_col0, int ncols, bf16* WT, int dst_row0, int k0, LAS float* scr, int lane) {
    const int cl = lane & 31;
    float v[32];
#pragma unroll
    for (int i = 0; i < 32; ++i) { const int kk = 2 * i + (lane >> 5); v[i] = 0.f; if (cl < ncols) v[i] = W[(size_t)(k0 + kk) * ldw + src_col0 + cl]; }
#pragma unroll
    for (int i = 0; i < 32; ++i) { const int kk = 2 * i + (lane >> 5); scr[kk * 33 + cl] = v[i]; }
    LDS_WAIT();
    const int c = lane & 7;
#pragma unroll
    for (int j = 0; j < 4; ++j) { const int n = (lane >> 3) + 8 * j;
        if (n < ncols) { const LAS float* s = scr + (8 * c) * 33 + n;
            u32x4 o; o.x = pk2(s[0 * 33], s[1 * 33]); o.y = pk2(s[2 * 33], s[3 * 33]); o.z = pk2(s[4 * 33], s[5 * 33]); o.w = pk2(s[6 * 33], s[7 * 33]);
            *(u32x4*)(WT + (size_t)(dst_row0 + n) * 2048 + k0 + 8 * c) = o; } }
    LDS_WAIT();
}
DI void p0_prologue(const Ctx& C) {
    p0_ada(C);
    LAS float* scr = (LAS float*)(C.lds + C.wave * 16384);
    constexpr int PER_L = (161 + 64 + 64) * 32;
    for (int it = C.gw; it < 2 * PER_L; it += C.NGW) {
        const int l = it / PER_L; int r = it % PER_L;
        if (r < 161 * 32) { const int kb = r / 161, nb = r % 161; bf16* WT = (bf16*)(C.ws + WS_WTIN) + (size_t)l * WTIN_L;
            const float* W = C.in[I_WIN] + (size_t)l * D * IN_COLS;
            if (nb < 160) { const int n0 = 32 * nb; transpose_item(W, IN_COLS, n0 + (n0 >= 3072 ? 16 : 0), 32, WT, n0, 64 * kb, scr, C.lane); }
            else transpose_item(W, IN_COLS, 3072, 16, WT, 5120, 64 * kb, scr, C.lane);
            continue; }
        r -= 161 * 32;
        if (r < 2048) { const int kb = r / 64, nb = r % 64; transpose_item(C.in[I_WOUT] + (size_t)l * D * D, D, 32 * nb, 32, (bf16*)(C.ws + WS_WTOUT) + (size_t)l * D * D, 32 * nb, 64 * kb, scr, C.lane); continue; }
        r -= 2048;
        { const int kb = r / 64, nb = r % 64; transpose_item(C.in[I_WQ] + (size_t)l * D * D, D, 32 * nb, 32, (bf16*)(C.ws + WS_WTQ) + (size_t)l * D * D, 32 * nb, 64 * kb, scr, C.lane); }
    }
    const int gt = C.bid * NTHR + C.tid, NT = C.G * NTHR;
    { bf16* K1B = (bf16*)(C.ws + WS_K1B); bf16* K2B = (bf16*)(C.ws + WS_K2B); bf16* WSB = (bf16*)(C.ws + WS_WSB);
      for (int i = gt; i < 262144; i += NT) { K1B[i] = (bf16)f2bf(C.in[I_K1][i]); K2B[i] = (bf16)f2bf(C.in[I_K2][i]);
          const int s = i & 127, t = (i >> 7) & 127; WSB[i] = (s <= t) ? (bf16)f2bf(C.in[I_MWS][i]) : (bf16)0; } }
    { int* KU = (int*)(C.ws + WS_KU); int* KV = (int*)(C.ws + WS_KV);
#pragma unroll 1
      for (int row = C.gw; row < 4 * NEXP; row += C.NGW) {
          const int tb = row >> 15, rr = row & 32767;
          const f32x4* src = (const f32x4*)(C.in[tb ? I_PV : I_PU] + (size_t)rr * D) + C.lane;
          f32x4 v[8]; float mx = 0.f;
#pragma unroll
          for (int j = 0; j < 8; ++j) { v[j] = src[64 * j]; mx = fmaxf(mx, fmaxf(fmaxf(fabsf(v[j].x), fabsf(v[j].y)), fmaxf(fabsf(v[j].z), fabsf(v[j].w)))); }
#pragma unroll
          for (int o = 1; o < 64; o <<= 1) mx = fmaxf(mx, __shfl_xor(mx, o));
          int k = 0;
          if (mx > 0.f) { k = (int)((__builtin_bit_cast(unsigned, 224.0f / mx) >> 23) & 255u) - 127; k = k < -60 ? -60 : (k > 60 ? 60 : k); }
          const float sc = __builtin_bit_cast(float, (unsigned)(k + 127) << 23);
          const int lyr = rr >> 14, ee = rr & 16383;
          unsigned* dst = (unsigned*)(C.ws + (tb ? WS_PVB : WS_PUB) + (size_t)lyr * NEXP * D + (size_t)ee * 256) + C.lane;
#pragma unroll
          for (int j = 0; j < 8; ++j) { int p = 0; p = __builtin_amdgcn_cvt_pk_fp8_f32(v[j].x * sc, v[j].y * sc, p, false); p = __builtin_amdgcn_cvt_pk_fp8_f32(v[j].z * sc, v[j].w * sc, p, true); dst[(size_t)j * (NEXP * 256 / 4)] = (unsigned)p; }
          if (C.lane == 0) (tb ? KV : KU)[rr] = k;
      } }
}
template <bool FP8 = false>
DI void norm_phase(const Ctx& C, const float* X, const float* g, const float* modl, int sh_off, int sc_off, bf16* Hout, unsigned char* H8 = nullptr) {
    const int r0 = C.gw * 8, b = r0 >> 12;
    const f32x4* shp = (const f32x4*)(modl + (size_t)b * MODW + sh_off); const f32x4* scp = (const f32x4*)(modl + (size_t)b * MODW + sc_off);
    f32x4 gm[8], shv[8];
#pragma unroll
    for (int j = 0; j < 8; ++j) { const int idx = 64 * j + C.lane; gm[j] = ((const f32x4*)g)[idx] * (scp[idx] + 1.0f); shv[j] = shp[idx]; }
#pragma unroll 1
    for (int i = 0; i < 8; ++i) {
        const f32x4* xr = (const f32x4*)(X + (size_t)(r0 + i) * D) + C.lane; f32x4 v[8]; float s = 0.f;
#pragma unroll
        for (int j = 0; j < 8; ++j) { v[j] = xr[64 * j]; s += (v[j].x * v[j].x + v[j].y * v[j].y) + (v[j].z * v[j].z + v[j].w * v[j].w); }
        const float rstd = frsq(wave_sum(s) * (1.f / D) + EPS);
        u32x2* o = (u32x2*)(Hout + (size_t)(r0 + i) * D) + C.lane;
#pragma unroll
        for (int j = 0; j < 8; ++j) { const f32x4 y = v[j] * rstd * gm[j] + shv[j]; u32x2 w; w.x = pk2(y.x, y.y); w.y = pk2(y.z, y.w); o[64 * j] = w;
            if (FP8) {
                const f32x4 ys = y * 16.0f; int ph = 0; ph = __builtin_amdgcn_cvt_pk_fp8_f32(ys.x, ys.y, ph, false); ph = __builtin_amdgcn_cvt_pk_fp8_f32(ys.z, ys.w, ph, true);
                const f32x2 b0 = __builtin_amdgcn_cvt_pk_f32_fp8(ph, false), b1 = __builtin_amdgcn_cvt_pk_f32_fp8(ph, true);
                int pl = 0; pl = __builtin_amdgcn_cvt_pk_fp8_f32((ys.x - b0.x) * 16.0f, (ys.y - b0.y) * 16.0f, pl, false); pl = __builtin_amdgcn_cvt_pk_fp8_f32((ys.z - b1.x) * 16.0f, (ys.w - b1.y) * 16.0f, pl, true);
                unsigned* h8 = (unsigned*)(H8 + (size_t)(r0 + i) * 4096) + C.lane; h8[64 * j] = (unsigned)ph; h8[512 + 64 * j] = (unsigned)pl; } }
    }
}
DI void alow_phase(const Ctx& C, const bf16* Hb, const bf16* WtA, float* ALOW) {
    if (C.wave < 4) {
        const int task = C.bid * 4 + C.wave, r0 = task * 16, fr = C.lane & 15, fq = C.lane >> 4;
        const bf16* ap = Hb + (size_t)(r0 + fr) * D + 8 * fq; const bf16* bp = WtA + (size_t)fr * D + 8 * fq;
        f32x4 acc = (f32x4){0.f, 0.f, 0.f, 0.f};
#pragma unroll 8
        for (int ks = 0; ks < 64; ++ks) { const bf16x8 a = *(const bf16x8*)(ap + 32 * ks), b = *(const bf16x8*)(bp + 32 * ks); acc = mfma16(a, b, acc); }
#pragma unroll
        for (int r = 0; r < 4; ++r) ALOW[(size_t)(r0 + 4 * fq + r) * 16 + fr] = acc[r];
    }
}
#define LBAR() do { asm volatile("s_waitcnt lgkmcnt(0)" ::: "memory"); __builtin_amdgcn_s_barrier(); asm volatile("" ::: "memory"); } while (0)
DI void gla_gates(const Ctx& C, LAS float* al, LAS float* tot, const f32x4 alv, const float (&w2)[16], const float bav, float (&Gl)[16], float& off, float& gref, float& g63) {
    const int d = C.tid & 127, jg = C.tid >> 7;
    if (C.tid < 256) ((LAS f32x4*)al)[C.tid] = alv;
    LBAR();
    float run = 0.f;
#pragma unroll
    for (int jj = 0; jj < 16; ++jj) {
        const LAS f32x4* ar = (const LAS f32x4*)(al + (jg * 16 + jj) * 16);
        const f32x4 a0 = ar[0], a1 = ar[1], a2 = ar[2], a3 = ar[3];
        float z = bav;
        z += a0.x * w2[0] + a0.y * w2[1] + a0.z * w2[2] + a0.w * w2[3];
        z += a1.x * w2[4] + a1.y * w2[5] + a1.z * w2[6] + a1.w * w2[7];
        z += a2.x * w2[8] + a2.y * w2[9] + a2.z * w2[10] + a2.w * w2[11];
        z += a3.x * w2[12] + a3.y * w2[13] + a3.z * w2[14] + a3.w * w2[15];
        const float ls = fminf(z, 0.f) - 0.6931471806f * flog2(1.f + fexp2(-1.442695041f * fabsf(z)));
        run += ls * (1.442695041f / 16.f);
        Gl[jj] = run;
    }
    tot[jg * 128 + d] = run;
    LBAR();
    const float t0_ = tot[d], t1_ = tot[128 + d], t2_ = tot[256 + d], t3_ = tot[384 + d];
    off = (jg > 0 ? t0_ : 0.f) + (jg > 1 ? t1_ : 0.f) + (jg > 2 ? t2_ : 0.f); gref = t0_ + t1_; g63 = (t0_ + t1_) + (t2_ + t3_);
}
constexpr int KST = 136, VST = 264, PST = 72;
DI void load_v_tile(const Ctx& C, const bf16* PROJ, int t0, int h, LAS bf16* VL) {
#pragma unroll
    for (int i = 0; i < 4; ++i) { const int c = C.tid + 512 * i, j = c >> 5, ec = c & 31;
        *(LAS u32x4*)(VL + j * VST + 8 * ec) = *(const u32x4*)(PROJ + (size_t)(t0 + j) * NPROJ + C_V + h * 256 + 8 * ec); }
}
struct GlaIn { f32x4 alv; bf16 qraw[16], kraw[16]; u32x4 vt[4]; };
template <bool WITHQ>
DI void gla_load(const Ctx& C, int idx, const bf16* PROJ, const float* ALOW, GlaIn& in) {
    const int b = idx >> 8, h = (idx >> 6) & 3, n = idx & 63, t0 = b * SEQ + n * 64, d = C.tid & 127, jg = C.tid >> 7;
    in.alv = (f32x4){0.f, 0.f, 0.f, 0.f};
    if (C.tid < 256) in.alv = ((const f32x4*)(ALOW + (size_t)t0 * 16))[C.tid];
#pragma unroll
    for (int jj = 0; jj < 16; ++jj) { const bf16* row = PROJ + (size_t)(t0 + jg * 16 + jj) * NPROJ + h * 128 + d; in.kraw[jj] = row[C_K]; if (WITHQ) in.qraw[jj] = row[C_Q]; }
#pragma unroll
    for (int i = 0; i < 4; ++i) { const int c = C.tid + 512 * i, j = c >> 5, ec = c & 31; in.vt[i] = *(const u32x4*)(PROJ + (size_t)(t0 + j) * NPROJ + C_V + h * 256 + 8 * ec); }
}
DI void store_v_tile(const Ctx& C, const GlaIn& in, LAS bf16* VL) {
#pragma unroll
    for (int i = 0; i < 4; ++i) { const int c = C.tid + 512 * i, j = c >> 5, ec = c & 31; *(LAS u32x4*)(VL + j * VST + 8 * ec) = in.vt[i]; }
}
DI void glaA_phase(const Ctx& C, int l, const bf16* PROJ, const float* ALOW, bf16* SBUF, float* DEC) {
    LAS float* al = (LAS float*)(C.lds); LAS float* tot = (LAS float*)(C.lds + 4096);
    LAS bf16* KD = (LAS bf16*)(C.lds + 8192); LAS bf16* VL = (LAS bf16*)(C.lds + 25600);
    const int d = C.tid & 127, jg = C.tid >> 7, h = (C.bid >> 6) & 3;
    float w2[16];
#pragma unroll
    for (int r = 0; r < 16; ++r) w2[r] = C.in[I_WA2][(size_t)l * 16 * 512 + r * 512 + h * 128 + d];
    const float bav = C.in[I_BA][(size_t)l * 512 + h * 128 + d];
    GlaIn cur, nxt;
    gla_load<false>(C, C.bid, PROJ, ALOW, cur);
#pragma unroll 1
    for (int i = 0; i < 4; ++i) {
        const int idx = i * C.G + C.bid;
        float Gl[16], off, gref, g63;
        gla_gates(C, al, tot, cur.alv, w2, bav, Gl, off, gref, g63);
#pragma unroll
        for (int jj = 0; jj < 16; ++jj) { const int j = jg * 16 + jj; KD[j * KST + d] = (bf16)f2bf(bf1(cur.kraw[jj]) * fexp2(g63 - (off + Gl[jj]))); }
        store_v_tile(C, cur, VL);
        LBAR();
        if (i + 1 < 4) gla_load<false>(C, idx + C.G, PROJ, ALOW, nxt);
        if (jg == 0) DEC[(size_t)idx * 128 + d] = fexp2(g63);
        const int lane = C.lane, g = lane >> 4, qq = (lane & 15) >> 2, p = lane & 3, fr = lane & 15;
        bf16x8 A[2];
#pragma unroll
        for (int ks = 0; ks < 2; ++ks) A[ks] = tr8(KD + (32 * ks + 8 * g + qq) * KST + 16 * C.wave + 4 * p, KST);
        bf16* Sit = SBUF + (size_t)idx * 256 * 128;
#pragma unroll
        for (int half = 0; half < 2; ++half) {
            f32x4 acc[8];
#pragma unroll
            for (int nt = 0; nt < 8; ++nt) acc[nt] = (f32x4){0.f, 0.f, 0.f, 0.f};
#pragma unroll
            for (int nt = 0; nt < 8; ++nt)
#pragma unroll
                for (int ks = 0; ks < 2; ++ks) { const bf16x8 Bf = tr8(VL + (32 * ks + 8 * g + qq) * VST + 16 * (half * 8 + nt) + 4 * p, VST); acc[nt] = mfma16(A[ks], Bf, acc[nt]); }
#pragma unroll
            for (int nt = 0; nt < 8; ++nt) { const int e = 16 * (half * 8 + nt) + fr, dd = 16 * C.wave + 4 * g;
                u32x2 w; w.x = pk2(acc[nt][0], acc[nt][1]); w.y = pk2(acc[nt][2], acc[nt][3]); *(u32x2*)(Sit + (size_t)e * 128 + dd) = w; }
        }
        LBAR();
        cur = nxt;
    }
}
DI void scan_phase(const Ctx& C, bf16* SBUF, const float* DEC) {
    const int gt = C.bid * NTHR + C.tid, bh = gt >> 13, rem = gt & 8191, e = rem >> 5, dq = rem & 31;
    u32x2* p = (u32x2*)(SBUF + ((size_t)(bh * 64) * 256 + e) * 128 + 4 * dq);
    const f32x4* dp = (const f32x4*)(DEC + (size_t)(bh * 64) * 128 + 4 * dq);
    f32x4 st = (f32x4){0.f, 0.f, 0.f, 0.f};
#pragma unroll 1
    for (int n0 = 0; n0 < 64; n0 += 8) {
        u32x2 tmp[8]; f32x4 dc[8];
#pragma unroll
        for (int u = 0; u < 8; ++u) { tmp[u] = p[(size_t)(n0 + u) * 8192]; dc[u] = dp[(n0 + u) * 32]; }
#pragma unroll
        for (int u = 0; u < 8; ++u) { u32x2 w; w.x = pk2(st.x, st.y); w.y = pk2(st.z, st.w); p[(size_t)(n0 + u) * 8192] = w;
            st = dc[u] * st + (f32x4){bflo(tmp[u].x), bfhi(tmp[u].x), bflo(tmp[u].y), bfhi(tmp[u].y)}; }
    }
}
DI void glaC_phase(const Ctx& C, int l, const bf16* PROJ, const float* ALOW, const bf16* SBUF, bf16* CONCAT) {
    const int h = (C.bid >> 6) & 3;
    LAS float* al = (LAS float*)(C.lds); LAS float* tot = (LAS float*)(C.lds + 4096); LAS float* RS = (LAS float*)(C.lds + 6144);
    LAS bf16* QT = (LAS bf16*)(C.lds + 8192); LAS bf16* KT = (LAS bf16*)(C.lds + 25600); LAS bf16* QG = (LAS bf16*)(C.lds + 43008);
    LAS bf16* VL = (LAS bf16*)(C.lds + 60416); LAS bf16* PL = (LAS bf16*)(C.lds + 94208);
    const int d = C.tid & 127, jg = C.tid >> 7;
    float w2[16];
#pragma unroll
    for (int r = 0; r < 16; ++r) w2[r] = C.in[I_WA2][(size_t)l * 16 * 512 + r * 512 + h * 128 + d];
    const float bav = C.in[I_BA][(size_t)l * 512 + h * 128 + d];
    const float* ng = C.in[I_GNG] + (size_t)(l * 4 + h) * 256;
    GlaIn cur;
    f32x4 alv_n = (f32x4){0.f, 0.f, 0.f, 0.f};
    if (C.tid < 256) alv_n = ((const f32x4*)(ALOW + (size_t)((C.bid >> 8) * SEQ + (C.bid & 63) * 64) * 16))[C.tid];
#pragma unroll 1
    for (int it = 0; it < 4; ++it) {
    const int idx = it * C.G + C.bid, b = idx >> 8, n = idx & 63, t0 = b * SEQ + n * 64;
    gla_load<true>(C, idx, PROJ, ALOW, cur); cur.alv = alv_n;
    float Gl[16], off, gref, g63;
    gla_gates(C, al, tot, cur.alv, w2, bav, Gl, off, gref, g63);
#pragma unroll
    for (int jj = 0; jj < 16; ++jj) { const int j = jg * 16 + jj; const float Gv = off + Gl[jj];
        const float q = bf1(cur.qraw[jj]) * 0.08838834764831845f, k = bf1(cur.kraw[jj]);
        QT[j * KST + d] = (bf16)f2bf(q * fexp2(Gv - gref)); KT[j * KST + d] = (bf16)f2bf(k * fexp2(gref - Gv)); QG[j * KST + d] = (bf16)f2bf(q * fexp2(Gv)); }
    store_v_tile(C, cur, VL);
    const int lane = C.lane, g = lane >> 4, qq = (lane & 15) >> 2, p = lane & 3, fr = lane & 15;
    bf16x8 Sf[2][4]; u32x2 rraw[4][2];
#pragma unroll
    for (int mi = 0; mi < 2; ++mi) { const bf16* Srow = SBUF + ((size_t)idx * 256 + 16 * (2 * C.wave + mi) + fr) * 128 + 8 * g;
#pragma unroll
        for (int ks = 0; ks < 4; ++ks) Sf[mi][ks] = *(const bf16x8*)(Srow + 32 * ks); }
#pragma unroll
    for (int nt = 0; nt < 4; ++nt)
#pragma unroll
        for (int mi = 0; mi < 2; ++mi) rraw[nt][mi] = *(const u32x2*)(PROJ + (size_t)(t0 + 16 * nt + fr) * NPROJ + C_R + h * 256 + 16 * (2 * C.wave + mi) + 4 * g);
    LBAR();
    {
        const int nt = C.wave & 3;
#pragma unroll
        for (int mi = 0; mi < 2; ++mi) { const int mt = 2 * (C.wave >> 2) + mi; f32x4 acc = (f32x4){0.f, 0.f, 0.f, 0.f};
#pragma unroll
            for (int ks = 0; ks < 4; ++ks) { const bf16x8 a = *(const LAS bf16x8*)(KT + (16 * mt + fr) * KST + 32 * ks + 8 * g), bq = *(const LAS bf16x8*)(QT + (16 * nt + fr) * KST + 32 * ks + 8 * g); acc = mfma16(a, bq, acc); }
            const int i = 16 * nt + fr, j0 = 16 * mt + 4 * g;
            const float v0 = (j0 + 0 <= i) ? acc[0] : 0.f, v1 = (j0 + 1 <= i) ? acc[1] : 0.f, v2 = (j0 + 2 <= i) ? acc[2] : 0.f, v3 = (j0 + 3 <= i) ? acc[3] : 0.f;
            u32x2 w; w.x = pk2(v0, v1); w.y = pk2(v2, v3); *(LAS u32x2*)(PL + i * PST + j0) = w; }
    }
    LBAR();
    f32x4 acc[2][4];
#pragma unroll
    for (int mi = 0; mi < 2; ++mi)
#pragma unroll
        for (int nt = 0; nt < 4; ++nt) acc[mi][nt] = (f32x4){0.f, 0.f, 0.f, 0.f};
#pragma unroll
    for (int mi = 0; mi < 2; ++mi) { const int mt = 2 * C.wave + mi;
#pragma unroll
        for (int ks = 0; ks < 2; ++ks) { const bf16x8 a = tr8(VL + (32 * ks + 8 * g + qq) * VST + 16 * mt + 4 * p, VST);
#pragma unroll
            for (int nt = 0; nt < 4; ++nt) { const bf16x8 bp = *(const LAS bf16x8*)(PL + (16 * nt + fr) * PST + 32 * ks + 8 * g); acc[mi][nt] = mfma16(a, bp, acc[mi][nt]); } }
#pragma unroll
        for (int ks = 0; ks < 4; ++ks) { const bf16x8 a = Sf[mi][ks];
#pragma unroll
            for (int nt = 0; nt < 4; ++nt) { const bf16x8 bq = *(const LAS bf16x8*)(QG + (16 * nt + fr) * KST + 32 * ks + 8 * g); acc[mi][nt] = mfma16(a, bq, acc[mi][nt]); } }
    }
#pragma unroll
    for (int nt = 0; nt < 4; ++nt) { float s = 0.f;
#pragma unroll
        for (int mi = 0; mi < 2; ++mi) s += (acc[mi][nt][0] * acc[mi][nt][0] + acc[mi][nt][1] * acc[mi][nt][1]) + (acc[mi][nt][2] * acc[mi][nt][2] + acc[mi][nt][3] * acc[mi][nt][3]);
        s += __shfl_xor(s, 16); s += __shfl_xor(s, 32);
        if (g == 0) RS[C.wave * 64 + 16 * nt + fr] = s; }
    LBAR();
    if (it + 1 < 4 && C.tid < 256) { const int ix = idx + C.G; alv_n = ((const f32x4*)(ALOW + (size_t)((ix >> 8) * SEQ + (ix & 63) * 64) * 16))[C.tid]; }
#pragma unroll
    for (int nt = 0; nt < 4; ++nt) { const int i = 16 * nt + fr; float ts = 0.f;
#pragma unroll
        for (int w = 0; w < 8; ++w) ts += RS[w * 64 + i];
        const float rstd = frsq(ts * (1.f / 256.f) + EPS);
#pragma unroll
        for (int mi = 0; mi < 2; ++mi) { const int e = 16 * (2 * C.wave + mi) + 4 * g;
            const u32x2 rr = rraw[nt][mi]; const f32x4 gg = *(const f32x4*)(ng + e);
            const float o0 = acc[mi][nt][0] * rstd * gg.x * silu_f(bflo(rr.x)), o1 = acc[mi][nt][1] * rstd * gg.y * silu_f(bfhi(rr.x));
            const float o2 = acc[mi][nt][2] * rstd * gg.z * silu_f(bflo(rr.y)), o3 = acc[mi][nt][3] * rstd * gg.w * silu_f(bfhi(rr.y));
            u32x2 w; w.x = pk2(o0, o1); w.y = pk2(o2, o3); *(u32x2*)(CONCAT + (size_t)(t0 + i) * D + h * 256 + e) = w; } }
    LBAR();
    }
}
constexpr int GST = 136;
DI void gmlp_phase(const Ctx& C, int l, const bf16* PROJ, const bf16* WSB, bf16* CONCAT) {
    const int h = C.bid & 7;
    LAS bf16* VL2 = (LAS bf16*)(C.lds); LAS bf16* UL = (LAS bf16*)(C.lds + 34816);
    const float* vg = C.in[I_VNG] + (size_t)(l * 8 + h) * 128; const float* og = C.in[I_MOG] + (size_t)(l * 8 + h) * 128; const float* bb = C.in[I_MB] + (size_t)(l * 8 + h) * 128;
    bf16x8 Wf[4];
    { const bf16* Wrow = WSB + ((size_t)(l * 8 + h) * 128 + 16 * C.wave + (C.lane & 15)) * 128 + 8 * (C.lane >> 4);
#pragma unroll
      for (int ks = 0; ks < 4; ++ks) Wf[ks] = *(const bf16x8*)(Wrow + 32 * ks); }
    u32x4 cu[4], cv[4], nu[4], nv[4];
#define GM_LOAD(IDX, U, V) do { const int t0_ = ((IDX) >> 8) * SEQ + (((IDX) >> 3) & 31) * 128; _Pragma("unroll") for (int i = 0; i < 4; ++i) { const int c = C.tid + 512 * i, t = c >> 4, ch = c & 15; \
        const bf16* row = PROJ + (size_t)(t0_ + t) * NPROJ + h * 128 + 8 * ch; U[i] = *(const u32x4*)(row + C_U); V[i] = *(const u32x4*)(row + C_VS); } } while (0)
    GM_LOAD(C.bid, cu, cv);
#pragma unroll 1
    for (int it = 0; it < 4; ++it) {
    const int idx = it * C.G + C.bid, n = (idx >> 3) & 31, b = idx >> 8, t0 = b * SEQ + n * 128;
#pragma unroll
    for (int i = 0; i < 4; ++i) { const int c = C.tid + 512 * i, t = c >> 4, ch = c & 15;
        const u32x4 uu = cu[i], vv = cv[i];
        float v[8] = {gelu_t(bflo(vv.x)), gelu_t(bfhi(vv.x)), gelu_t(bflo(vv.y)), gelu_t(bfhi(vv.y)), gelu_t(bflo(vv.z)), gelu_t(bfhi(vv.z)), gelu_t(bflo(vv.w)), gelu_t(bfhi(vv.w))};
        float ss = 0.f;
#pragma unroll
        for (int k = 0; k < 8; ++k) ss += v[k] * v[k];
        ss += __shfl_xor(ss, 1); ss += __shfl_xor(ss, 2); ss += __shfl_xor(ss, 4); ss += __shfl_xor(ss, 8);
        const float rstd = frsq(ss * (1.f / 128.f) + EPS);
        const f32x4 g0 = *(const f32x4*)(vg + 8 * ch), g1 = *(const f32x4*)(vg + 8 * ch + 4);
        u32x4 wv; wv.x = pk2(v[0] * rstd * g0.x, v[1] * rstd * g0.y); wv.y = pk2(v[2] * rstd * g0.z, v[3] * rstd * g0.w); wv.z = pk2(v[4] * rstd * g1.x, v[5] * rstd * g1.y); wv.w = pk2(v[6] * rstd * g1.z, v[7] * rstd * g1.w);
        *(LAS u32x4*)(VL2 + t * GST + 8 * ch) = wv;
        u32x4 wu; wu.x = pk2(gelu_t(bflo(uu.x)), gelu_t(bfhi(uu.x))); wu.y = pk2(gelu_t(bflo(uu.y)), gelu_t(bfhi(uu.y))); wu.z = pk2(gelu_t(bflo(uu.z)), gelu_t(bfhi(uu.z))); wu.w = pk2(gelu_t(bflo(uu.w)), gelu_t(bfhi(uu.w)));
        *(LAS u32x4*)(UL + t * GST + 8 * ch) = wu; }
    LBAR();
    if (it + 1 < 4) GM_LOAD(idx + C.G, nu, nv);
    const int lane = C.lane, g = lane >> 4, qq = (lane & 15) >> 2, p = lane & 3, fr = lane & 15;
    f32x4 acc[8];
#pragma unroll
    for (int mt = 0; mt < 8; ++mt) acc[mt] = (f32x4){0.f, 0.f, 0.f, 0.f};
    const int nks = (C.wave >> 1) + 1;
#pragma unroll
    for (int ks = 0; ks < 4; ++ks) if (ks < nks) { const bf16x8 bw = Wf[ks];
#pragma unroll
        for (int mt = 0; mt < 8; ++mt) { const bf16x8 a = tr8(VL2 + (32 * ks + 8 * g + qq) * GST + 16 * mt + 4 * p, GST); acc[mt] = mfma16(a, bw, acc[mt]); } }
    const int tl = 16 * C.wave + fr; const float bt = bb[tl]; float ss = 0.f;
#pragma unroll
    for (int mt = 0; mt < 8; ++mt) { const u32x2 uu = *(const LAS u32x2*)(UL + tl * GST + 16 * mt + 4 * g);
        acc[mt][0] = bflo(uu.x) * (acc[mt][0] + bt); acc[mt][1] = bfhi(uu.x) * (acc[mt][1] + bt); acc[mt][2] = bflo(uu.y) * (acc[mt][2] + bt); acc[mt][3] = bfhi(uu.y) * (acc[mt][3] + bt);
        ss += (acc[mt][0] * acc[mt][0] + acc[mt][1] * acc[mt][1]) + (acc[mt][2] * acc[mt][2] + acc[mt][3] * acc[mt][3]); }
    ss += __shfl_xor(ss, 16); ss += __shfl_xor(ss, 32);
    const float rstd = frsq(ss * (1.f / 128.f) + EPS);
#pragma unroll
    for (int mt = 0; mt < 8; ++mt) { const f32x4 gg = *(const f32x4*)(og + 16 * mt + 4 * g);
        u32x2 w; w.x = pk2(acc[mt][0] * rstd * gg.x, acc[mt][1] * rstd * gg.y); w.y = pk2(acc[mt][2] * rstd * gg.z, acc[mt][3] * rstd * gg.w);
        *(u32x2*)(CONCAT + (size_t)(t0 + tl) * D + 1024 + h * 128 + 16 * mt + 4 * g) = w; }
    LBAR();
#pragma unroll
    for (int i = 0; i < 4; ++i) { cu[i] = nu[i]; cv[i] = nv[i]; }
    }
#undef GM_LOAD
}
DI void list_insert(float (&L)[16], float x) {
#pragma unroll
    for (int i = 15; i >= 1; --i) L[i] = __builtin_amdgcn_fmed3f(x, L[i - 1], L[i]);
    L[0] = fmaxf(L[0], x);
}
DI void list_merge_xor(float (&L)[16], int mask) {
    float M[16];
#pragma unroll
    for (int i = 0; i < 16; ++i) M[i] = fmaxf(L[i], __shfl_xor(L[15 - i], mask));
#pragma unroll
    for (int s = 8; s >= 1; s >>= 1)
#pragma unroll
        for (int i = 0; i < 16; ++i) if ((i & s) == 0) { const float hi = fmaxf(M[i], M[i + s]), lo = fminf(M[i], M[i + s]); M[i] = hi; M[i + s] = lo; }
#pragma unroll
    for (int i = 0; i < 16; ++i) L[i] = M[i];
}
DI unsigned fbits(float x) { return __builtin_bit_cast(unsigned, x); }
DI float unp7(float x) { return __builtin_bit_cast(float, __builtin_bit_cast(unsigned, x) & 0xFFFFFF80u); }
constexpr int TKST = 136;
DI void topk_phase(const Ctx& C, int l, const bf16* QB, const bf16* K1B, const bf16* K2B, const int* KU, const int* KV, int* EB, float* PG) {
    LAS bf16* KL = (LAS bf16*)C.lds;
    LAS unsigned* tk = (LAS unsigned*)(C.lds + 2 * 128 * TKST * 2 + C.wave * 2048);
    const int lane = C.lane, fr = lane & 15, fq = lane >> 4, h = C.bid & 7, rank = C.bid >> 3;
#pragma unroll
    for (int i = 0; i < 8; ++i) { const int c = C.tid + 512 * i, tb = c >> 11, row = (c & 2047) >> 4, ch = c & 15;
        *(LAS u32x4*)(KL + (tb * 128 + row) * TKST + 8 * ch) = *(const u32x4*)((tb ? K2B : K1B) + ((size_t)(l * 8 + h) * 128 + row) * 128 + 8 * ch); }
    __syncthreads();
#pragma unroll 1
    for (int it = 0; it < 4; ++it) {
        const int tt0 = rank * 512 + C.wave * 64 + it * 16;
        float L[2][16];
        bf16x8 bq[2][4];
#pragma unroll
        for (int half = 0; half < 2; ++half)
#pragma unroll
            for (int ks = 0; ks < 4; ++ks) bq[half][ks] = *(const bf16x8*)(QB + (size_t)(tt0 + fr) * D + h * 256 + half * 128 + 8 * fq + 32 * ks);
#pragma unroll
        for (int half = 0; half < 2; ++half) {
            f32x4 acc[8];
#pragma unroll
            for (int mt = 0; mt < 8; ++mt) acc[mt] = (f32x4){0.f, 0.f, 0.f, 0.f};
            const LAS bf16* Kb = KL + (half * 128 + fr) * TKST + 8 * fq;
#pragma unroll
            for (int ks = 0; ks < 4; ++ks)
#pragma unroll
                for (int mt = 0; mt < 8; ++mt) { const bf16x8 a = *(const LAS bf16x8*)(Kb + (16 * mt) * TKST + 32 * ks); acc[mt] = mfma16(a, bq[half][ks], acc[mt]); }
#pragma unroll
            for (int i = 0; i < 16; ++i) L[half][i] = __builtin_bit_cast(float, 0xFF800000u);
#pragma unroll
            for (int mt = 0; mt < 8; ++mt)
#pragma unroll
                for (int r = 0; r < 4; ++r) { const unsigned key = (unsigned)(16 * mt + 4 * fq + r);
                    const float sv = acc[mt][r];
                    list_insert(L[half], __builtin_bit_cast(float, (fbits(sv) & 0xFFFFFF80u) | key)); }
            list_merge_xor(L[half], 16); list_merge_xor(L[half], 32);
        }
        if (fq == 0) {
#pragma unroll
            for (int i = 0; i < 16; ++i) { tk[(fr * 2 + 0) * 16 + i] = fbits(L[0][i]); tk[(fr * 2 + 1) * 16 + i] = fbits(L[1][i]); }
        }
        float Cn[16];
#pragma unroll
        for (int i = 0; i < 16; ++i) Cn[i] = __builtin_bit_cast(float, 0xFF800000u);
#pragma unroll
        for (int i = 0; i < 16; ++i)
#pragma unroll
            for (int j = 0; j < 16; ++j) if ((i + 1) * (j + 1) <= 16) {
                const float s = unp7(L[0][i]) + unp7(L[1][j]);
                list_insert(Cn, __builtin_bit_cast(float, (fbits(s) & 0xFFFFFF00u) | (unsigned)(i * 16 + j))); }
        LDS_WAIT();
        float sc[4]; int ex[4];
#pragma unroll
        for (int m = 0; m < 4; ++m) {
            const float ck = fq == 0 ? Cn[m] : (fq == 1 ? Cn[4 + m] : (fq == 2 ? Cn[8 + m] : Cn[12 + m]));
            const unsigned cc = fbits(ck) & 255u;
            const unsigned p1 = tk[(fr * 2 + 0) * 16 + (cc >> 4)], p2 = tk[(fr * 2 + 1) * 16 + (cc & 15u)];
            sc[m] = __builtin_bit_cast(float, p1 & 0xFFFFFF80u) + __builtin_bit_cast(float, p2 & 0xFFFFFF80u);
            ex[m] = (int)((p1 & 127u) * 128u + (p2 & 127u));
        }
        float mx = fmaxf(fmaxf(sc[0], sc[1]), fmaxf(sc[2], sc[3]));
        mx = fmaxf(mx, __shfl_xor(mx, 16)); mx = fmaxf(mx, __shfl_xor(mx, 32));
        float w[4], sum = 0.f;
#pragma unroll
        for (int m = 0; m < 4; ++m) { w[m] = fexp2((sc[m] - mx) * 1.442695041f); sum += w[m]; }
        sum += __shfl_xor(sum, 16); sum += __shfl_xor(sum, 32);
        const float inv = 1.0f / sum;
        const size_t o = (size_t)(tt0 + fr) * 128 + h * 16 + 4 * fq;
#pragma unroll
        for (int m = 0; m < 4; ++m) { const int ku = KU[ex[m]], kv = KV[ex[m]]; w[m] = w[m] * inv * __builtin_bit_cast(float, (unsigned)(127 - kv) << 23); ex[m] |= (127 - ku) << 16; }
        *(int4*)(EB + o) = make_int4(ex[0], ex[1], ex[2], ex[3]);
        *(f32x4*)(PG + o) = (f32x4){w[0], w[1], w[2], w[3]};
        LDS_WAIT();
    }
}
typedef unsigned char fp8_t;
DI void unpack16(const u32x4 q, float (&f)[16]) {
#pragma unroll
    for (int w = 0; w < 4; ++w) { const int dw = (int)q[w]; const f32x2 lo = __builtin_amdgcn_cvt_pk_f32_fp8(dw, false), hi = __builtin_amdgcn_cvt_pk_f32_fp8(dw, true);
        f[4 * w] = lo.x; f[4 * w + 1] = lo.y; f[4 * w + 2] = hi.x; f[4 * w + 3] = hi.y; }
}
typedef long i64_t;
DI f32x4 sel4(bool c, const f32x4 a, const f32x4 b) { return (f32x4){c ? a.x : b.x, c ? a.y : b.y, c ? a.z : b.z, c ? a.w : b.w}; }
constexpr int PU_RST = 272, PU_TILE = 16 * PU_RST, PU_WAVE = 2 * PU_TILE;
DI void peerU_phase(const Ctx& C, const unsigned char* H8, const int* EB, const fp8_t* PU8, float* PART, const int emask = 0xFFFF) {
    const int x = C.bid & 7, rank = C.bid >> 3, lane = C.lane, kq = lane >> 4, m16 = lane & 15;
    const __amdgpu_buffer_rsrc_t trs = __builtin_amdgcn_make_buffer_rsrc((void*)(PU8 + (size_t)x * NEXP * 256), 0, NEXP * 256, 0x00020000);
    float* part = PART + (size_t)x * T * 128;
    const int tbase = rank * 512 + C.wave * 64;
    const int* ebase = EB + (size_t)tbase * 128 + lane;
    const unsigned char* hbase = H8 + (size_t)tbase * 4096 + (m16 & 1) * 2048 + 256 * x + 8 * kq;
    ldsp wl = C.lds + C.wave * PU_WAVE;
    const int wr_off = kq * PU_RST + 16 * m16;
    const int rd_off = m16 * PU_RST + 8 * kq;
    const int bp0 = 4 * kq;
    int ept0 = ebase[0], ept1 = ebase[64];
    int ep0 = ebase[128], ep1 = ebase[192];
    u32x2 hc[8], hn[8];
#pragma unroll
    for (int c = 0; c < 8; ++c) { hc[c] = *(const u32x2*)(hbase + 32 * c); hn[c] = hc[c]; }
    u32x4 r0[8], r1[8], r2[8], r3[8];
#define PU_ISSUE(BUF, ESEL, Q1) do { _Pragma("unroll") for (int i_ = 0; i_ < 8; ++i_) { const int ad_ = (bp0 + 4 * (32 * (Q1) + 4 * i_)) & 255; \
        const int e_ = __builtin_amdgcn_ds_bpermute(ad_, (ESEL)) & emask; BUF[i_] = __builtin_amdgcn_raw_buffer_load_b128(trs, e_ * 256 + 16 * m16, 0, 0); } } while (0)
#define PU_STEP(BUF, T0) do { _Pragma("unroll") for (int i_ = 0; i_ < 8; ++i_) *(LAS u32x4*)(wl + wr_off + (i_ >> 2) * PU_TILE + (i_ & 3) * 4 * PU_RST) = BUF[i_]; \
        _Pragma("unroll") for (int tt = 0; tt < 2; ++tt) _Pragma("unroll") for (int c = 0; c < 8; ++c) { const u32x2 av_ = *(const LAS u32x2*)(wl + rd_off + tt * PU_TILE + 32 * c); \
            acc[(T0) + tt] = __builtin_amdgcn_mfma_f32_16x16x32_fp8_fp8((i64_t)(((unsigned long long)av_.y << 32) | av_.x), (i64_t)(((unsigned long long)hc[c].y << 32) | hc[c].x), acc[(T0) + tt], 0, 0, 0); } } while (0)
    PU_ISSUE(r0, ept0, 0); PU_ISSUE(r1, ept0, 1); PU_ISSUE(r2, ept1, 2); PU_ISSUE(r3, ept1, 3);
    f32x2 pend = (f32x2){0.f, 0.f}; f32x2* pend_p = nullptr;
#pragma unroll 1
    for (int ti = 0; ti < 64; ++ti) {
        const int t = tbase + ti; const bool more = ti + 1 < 64;
        int epn0 = 0, epn1 = 0;
        if (ti + 2 < 64) { epn0 = ebase[(ti + 2) * 128]; epn1 = ebase[(ti + 2) * 128 + 64]; }
        if (more) {
#pragma unroll
            for (int c = 0; c < 8; ++c) hn[c] = *(const u32x2*)(hbase + (size_t)(ti + 1) * 4096 + 32 * c); }
        f32x4 acc[8];
#pragma unroll
        for (int tl = 0; tl < 8; ++tl) acc[tl] = (f32x4){0.f, 0.f, 0.f, 0.f};
        PU_STEP(r0, 0); if (more) PU_ISSUE(r0, ep0, 0);
        if (ti > 0) *pend_p = pend;
        PU_STEP(r1, 2); if (more) PU_ISSUE(r1, ep0, 1);
        PU_STEP(r2, 4); if (more) PU_ISSUE(r2, ep1, 2);
        PU_STEP(r3, 6); if (more) PU_ISSUE(r3, ep1, 3);
        {   const int n = m16, rg = kq;
            const f32x4 s01 = sel4((n >> 1) & 1, acc[1], acc[0]), s23 = sel4((n >> 1) & 1, acc[3], acc[2]), s45 = sel4((n >> 1) & 1, acc[5], acc[4]), s67 = sel4((n >> 1) & 1, acc[7], acc[6]);
            const f32x4 s03 = sel4((n >> 2) & 1, s23, s01), s47 = sel4((n >> 2) & 1, s67, s45), sv = sel4((n >> 3) & 1, s47, s03);
            const float p0 = dppf<0xB1>(sv.x), p1 = dppf<0xB1>(sv.y), p2 = dppf<0xB1>(sv.z), p3 = dppf<0xB1>(sv.w);
            const bool odd = n & 1;
            const float o0 = odd ? (p2 + sv.z * 0.0625f) : (sv.x + p0 * 0.0625f), o1 = odd ? (p3 + sv.w * 0.0625f) : (sv.y + p1 * 0.0625f);
            pend = (f32x2){o0 * 0.0625f, o1 * 0.0625f}; pend_p = (f32x2*)(part + (size_t)t * 128 + 16 * (n >> 1) + 4 * rg + 2 * (n & 1)); }
        ep0 = epn0; ep1 = epn1;
#pragma unroll
        for (int c = 0; c < 8; ++c) hc[c] = hn[c];
    }
    *pend_p = pend;
#undef PU_ISSUE
#undef PU_STEP
}
typedef int v2i32_t __attribute__((ext_vector_type(2)));
constexpr int PV_TILE = 32 * PU_RST, PV_A8 = PV_TILE, PV_Y = PV_TILE + 256, PV_WAVE = 10240;
DI float wave_max_u(float v) {
    v = fmaxf(v, dppf<0xB1>(v)); v = fmaxf(v, dppf<0x4E>(v)); v = fmaxf(v, dppf<0x141>(v)); v = fmaxf(v, dppf<0x140>(v));
    const int iv = __builtin_bit_cast(int, v);
    return fmaxf(fmaxf(__builtin_bit_cast(float, __builtin_amdgcn_readlane(iv, 0)), __builtin_bit_cast(float, __builtin_amdgcn_readlane(iv, 16))),
                 fmaxf(__builtin_bit_cast(float, __builtin_amdgcn_readlane(iv, 32)), __builtin_bit_cast(float, __builtin_amdgcn_readlane(iv, 48))));
}
DI void peerV_phase(const Ctx& C, const int* EB, const float* PG, const float* PART, const fp8_t* PV8, float* X, const float* gate  , const int emask = 0xFFFF, const int FAKE = 0) {
    const int x = C.bid & 7, rank = C.bid >> 3, lane = C.lane, kq = lane >> 4, m16 = lane & 15;
    const fp8_t* tab = PV8 + (size_t)x * NEXP * 256 + 16 * m16;
    const int tbase = rank * 512 + C.wave * 64;
    ldsp wl = C.lds + C.wave * PV_WAVE;
    const int wr_off = kq * PU_RST + 16 * m16;
    const int tr_off = (8 * kq + (m16 >> 1)) * PU_RST + 8 * (m16 & 1);
    const int a_off = PV_A8 + (m16 & 1) * 128 + 8 * kq;
    const int bp0 = 4 * kq;
    float pr0[8], pr1[8]; int rep0, rep1; float rg0, rg1;
#define PV_LOAD_RAW(tt) do { _Pragma("unroll") for (int xx = 0; xx < 8; ++xx) { const float* pp = PART + ((size_t)xx * T + (tt)) * 128 + lane; pr0[xx] = pp[0]; pr1[xx] = pp[64]; } \
        rep0 = EB[(size_t)(tt) * 128 + lane]; rep1 = EB[(size_t)(tt) * 128 + 64 + lane]; rg0 = PG[(size_t)(tt) * 128 + lane]; rg1 = PG[(size_t)(tt) * 128 + 64 + lane]; } while (0)
#define PV_FINISH(A0, A1, E0, E1) do { const float s0_ = ((pr0[0] + pr0[1]) + (pr0[2] + pr0[3])) + ((pr0[4] + pr0[5]) + (pr0[6] + pr0[7])), s1_ = ((pr1[0] + pr1[1]) + (pr1[2] + pr1[3])) + ((pr1[4] + pr1[5]) + (pr1[6] + pr1[7])); \
        A0 = gelu_t(s0_ * __builtin_bit_cast(float, (unsigned)(rep0 >> 16) << 23)) * rg0; A1 = gelu_t(s1_ * __builtin_bit_cast(float, (unsigned)(rep1 >> 16) << 23)) * rg1; E0 = (rep0 & emask) * 256; E1 = (rep1 & emask) * 256; } while (0)
    float a0, a1, a0n = 0.f, a1n = 0.f; int e0, e1, e0n = 0, e1n = 0;
    PV_LOAD_RAW(tbase); PV_FINISH(a0, a1, e0, e1);
    PV_LOAD_RAW(tbase + 1);
    u32x4 ra[8], rb[8];
#define PV_ISSUE(BUF, ESEL, Q1) do { _Pragma("unroll") for (int i_ = 0; i_ < 8; ++i_) { const int ad_ = (bp0 + 4 * (32 * (Q1) + 4 * i_)) & 255; \
        const int eo_ = __builtin_amdgcn_ds_bpermute(ad_, (ESEL)); BUF[i_] = *(const u32x4*)(tab + eo_); } } while (0)
#define PV_STEP(BUF, KS) do { _Pragma("unroll") for (int i_ = 0; i_ < 8; ++i_) *(LAS u32x4*)(wl + wr_off + i_ * 4 * PU_RST) = BUF[i_]; \
        const u32x2 ao_ = *(const LAS u32x2*)(wl + a_off + 32 * (KS)); const i64_t aop_ = (i64_t)(((unsigned long long)ao_.y << 32) | ao_.x); \
        _Pragma("unroll") for (int nt = 0; nt < 16; ++nt) { const v2i32_t bv_ = __builtin_amdgcn_ds_read_tr8_b64_v2i32((LAS v2i32_t*)(wl + tr_off + 16 * nt)); \
            acc[nt] = __builtin_amdgcn_mfma_f32_16x16x32_fp8_fp8(aop_, (i64_t)(((unsigned long long)(unsigned)bv_[1] << 32) | (unsigned)bv_[0]), acc[nt], 0, 0, 0); } } while (0)
    PV_ISSUE(ra, e0, 0);
    f32x4 xpend = (f32x4){0.f, 0.f, 0.f, 0.f}; f32x4* xpend_p = nullptr;
#pragma unroll 1
    for (int ti = 0; ti < 64; ++ti) {
        const int t = tbase + ti;
        const float amax = wave_max_u(fmaxf(fabsf(a0), fabsf(a1)));
        int ka = 0; if (amax > 0.f) { ka = (int)((__builtin_bit_cast(unsigned, 224.0f / amax) >> 23) & 255u) - 127; ka = ka < -100 ? -100 : (ka > 100 ? 100 : ka); }
        const float sca = __builtin_bit_cast(float, (unsigned)(ka + 127) << 23), inva = __builtin_bit_cast(float, (unsigned)(127 - ka) << 23);
        {   const float s0 = a0 * sca, s1 = a1 * sca;
            const int ph = __builtin_amdgcn_cvt_pk_fp8_f32(s0, s1, 0, false); const f32x2 bk = __builtin_amdgcn_cvt_pk_f32_fp8(ph, false);
            const int pl = __builtin_amdgcn_cvt_pk_fp8_f32((s0 - bk.x) * 16.0f, (s1 - bk.y) * 16.0f, 0, false);
            LAS unsigned char* a8 = (LAS unsigned char*)(wl + PV_A8);
            a8[lane] = (unsigned char)(ph & 255); a8[64 + lane] = (unsigned char)((ph >> 8) & 255); a8[128 + lane] = (unsigned char)(pl & 255); a8[192 + lane] = (unsigned char)((pl >> 8) & 255); }
        f32x4 acc[16];
#pragma unroll
        for (int nt = 0; nt < 16; ++nt) acc[nt] = (f32x4){0.f, 0.f, 0.f, 0.f};
        const int col = 256 * x + 4 * lane, b = t >> 12;
        f32x4* xp = (f32x4*)(X + (size_t)t * D + col);
        f32x4 xold = (f32x4){0.f, 0.f, 0.f, 0.f}; if (!FAKE) xold = *xp;
        const f32x4 gt = *(const f32x4*)(gate + (size_t)b * MODW + col);
        PV_ISSUE(rb, e0, 1);
        if (ti > 0 && !FAKE) *xpend_p = xpend;
        PV_STEP(ra, 0);
        PV_ISSUE(ra, e1, 2); PV_STEP(rb, 1);
        if (ti + 1 < 64) PV_FINISH(a0n, a1n, e0n, e1n);
        PV_ISSUE(rb, e1, 3); PV_STEP(ra, 2);
        if (ti + 2 < 64) PV_LOAD_RAW(t + 2);
        if (ti + 1 < 64) PV_ISSUE(ra, e0n, 0);
        PV_STEP(rb, 3);
        if (kq == 0) {
#pragma unroll
            for (int nt = 0; nt < 16; ++nt) *(LAS float*)(wl + PV_Y + 4 * (16 * nt + m16)) = (acc[nt][0] + acc[nt][1] * 0.0625f) * inva; }
        const f32x4 y = *(const LAS f32x4*)(wl + PV_Y + 16 * lane);
        if (FAKE) { if (y.x == 123.456f) *xp = y; }
        xpend = xold + gt * y; xpend_p = xp;
        a0 = a0n; a1 = a1n; e0 = e0n; e1 = e1n;
    }
    if (!FAKE) *xpend_p = xpend;
#undef PV_LOAD_RAW
#undef PV_FINISH
#undef PV_ISSUE
#undef PV_STEP
}
DI void final_norm_phase(const Ctx& C, float* X, const float* g) {
    const int r0 = C.gw * 8;
    f32x4 gm[8];
#pragma unroll
    for (int j = 0; j < 8; ++j) gm[j] = ((const f32x4*)g)[64 * j + C.lane];
#pragma unroll 1
    for (int i = 0; i < 8; ++i) {
        f32x4* xr = (f32x4*)(X + (size_t)(r0 + i) * D) + C.lane; f32x4 v[8]; float s = 0.f;
#pragma unroll
        for (int j = 0; j < 8; ++j) { v[j] = xr[64 * j]; s += (v[j].x * v[j].x + v[j].y * v[j].y) + (v[j].z * v[j].z + v[j].w * v[j].w); }
        const float rstd = frsq(wave_sum(s) * (1.f / D) + EPS);
#pragma unroll
        for (int j = 0; j < 8; ++j) xr[64 * j] = v[j] * rstd * gm[j];
    }
}
#ifndef PH_MASK
#define PH_MASK 0xFFFFF
#endif
#define EN(k) (((PH_MASK) >> (k)) & 1)
#ifndef GEMM_SP2
#define GEMM_SP2 true
#endif
#ifndef GEMM_ALIGN
#define GEMM_ALIGN false
#endif
constexpr int NKIND = 11, NPH = 2 + 2 * NKIND;
struct Args { const float* in[21]; float* out; unsigned char* ws; int ph_lo, ph_hi, pad0, pad1; };
__global__ void __launch_bounds__(NTHR, 2) mk_fwd(Args args) {
    extern __shared__ __attribute__((aligned(16))) unsigned char lds_raw[];
    ldsp ldsb = (ldsp)lds_raw;
    volatile LAS unsigned* MISC = (volatile LAS unsigned*)(ldsb + MISC_OFF);
    for (int u = threadIdx.x; u < (LDS_BYTES - LDSCTL_OFF) / 4; u += NTHR) ((LAS unsigned*)(ldsb + LDSCTL_OFF))[u] = 0u;
    __syncthreads();
    unsigned* barw = (unsigned*)(args.ws + WS_CTL) + CW_BAR;
    XcdBarrier bar; bar.bar = barw; bar.x = 0; bar.st = nullptr;
    const bool multi = (args.ph_hi - args.ph_lo) > 1;
    if (multi) bar = xcd_barrier_post(barw, MISC + 8);

    int repflag = 0; (void)repflag;
#pragma unroll 1
    for (int ph = args.ph_lo; ph < args.ph_hi; ++ph) {
#define MKCTX Ctx C; { int tid_ = threadIdx.x, bid_ = blockIdx.x; asm volatile("" : "+v"(tid_)); asm volatile("" : "+s"(bid_)); \
        C.lds = ldsb; C.tid = tid_; C.lane = tid_ & 63; C.wave = __builtin_amdgcn_readfirstlane(tid_ >> 6); C.bid = bid_; C.G = gridDim.x; C.gw = C.bid * NWAVES + C.wave; C.NGW = C.G * NWAVES; \
        _Pragma("unroll") for (int i_ = 0; i_ < 21; ++i_) C.in[i_] = args.in[i_]; C.out = args.out; C.ws = args.ws; }
        unsigned char* const wsb = args.ws;
        float* MOD = (float*)(wsb + WS_MOD);
        bf16* Hb = (bf16*)(wsb + WS_H); bf16* PROJ = (bf16*)(wsb + WS_PROJ); bf16* SBUF = (bf16*)(wsb + WS_SBUF); bf16* CONCAT = (bf16*)(wsb + WS_CONCAT); bf16* QB = (bf16*)(wsb + WS_QB);
        float* ALOW = (float*)(wsb + WS_ALOW); float* DEC = (float*)(wsb + WS_DEC); int* EB = (int*)(wsb + WS_EB); float* PG = (float*)(wsb + WS_PG);
        float* X = args.out;
        const int l = ph < 2 ? 0 : (ph - 2) / NKIND, kind = ph < 2 ? -1 : (ph - 2) % NKIND;
        const float* modl = MOD + (size_t)l * 4 * MODW;
        if (ph == 0) { if (EN(0)) { MKCTX; p0_prologue(C); } }
        else if (ph == 1) { if (EN(1)) { MKCTX; norm_phase(C, C.in[I_X], C.in[I_N1G], modl, 0, D, Hb); } }
        else if ((kind == 0 || kind == 6) && EN(2)) {
            MKCTX; const bool isq = (kind == 6);
            pg8::Gemm g{Hb, isq ? (const bf16*)(wsb + WS_WTQ) + (size_t)l * D * D : (const bf16*)(wsb + WS_WTIN) + (size_t)l * WTIN_L, T, isq ? D : NPROJ, D};
            pg8::StaticOrder S; S.init(T, g.N, C.G, C.bid);
            pg8::EpiBf16 E{isq ? QB : PROJ, isq ? D : NPROJ};
            pg8::gemm_phase<pg8::EpiBf16, pg8::StaticOrder, GEMM_ALIGN, GEMM_SP2>(C.lds, g, S, E, C.tid);
            if (!isq) alow_phase(C, Hb, (const bf16*)(wsb + WS_WTIN) + (size_t)l * WTIN_L + (size_t)NPROJ * D, ALOW);
#ifdef DBG_DUP_ALOW
            if (!isq) { alow_phase(C, Hb, (const bf16*)(wsb + WS_WTIN) + (size_t)l * WTIN_L + (size_t)NPROJ * D, ALOW); alow_phase(C, Hb, (const bf16*)(wsb + WS_WTIN) + (size_t)l * WTIN_L + (size_t)NPROJ * D, ALOW); }
#endif
        }
        else if (kind == 1 && EN(3)) {
            MKCTX;
            glaA_phase(C, l, PROJ, ALOW, SBUF, DEC);
            gmlp_phase(C, l, PROJ, (const bf16*)(wsb + WS_WSB), CONCAT);
        }
        else if (kind == 2) { if (EN(4)) { MKCTX; scan_phase(C, SBUF, DEC); } }
        else if (kind == 3 && EN(5)) { MKCTX; glaC_phase(C, l, PROJ, ALOW, SBUF, CONCAT); }
        else if (kind == 4 && EN(6)) {
            MKCTX;
            pg8::Gemm g{CONCAT, (const bf16*)(wsb + WS_WTOUT) + (size_t)l * D * D, T, D, D};
            pg8::StaticOrder S; S.init(T, D, C.G, C.bid);
            pg8::EpiResGate E{l == 0 ? C.in[I_X] : (const float*)X, X, modl + 2 * D, MODW};
            pg8::gemm_phase<pg8::EpiResGate, pg8::StaticOrder, GEMM_ALIGN, GEMM_SP2>(C.lds, g, S, E, C.tid);
        }
        else if (kind == 5) { if (EN(1)) { MKCTX; norm_phase<true>(C, X, C.in[I_N2G] + (size_t)l * D, modl, 3 * D, 4 * D, Hb, wsb + WS_H8); } }
        else if (kind == 7) { if (EN(7)) { MKCTX; topk_phase(C, l, QB, (const bf16*)(wsb + WS_K1B), (const bf16*)(wsb + WS_K2B), (const int*)(wsb + WS_KU) + l * NEXP, (const int*)(wsb + WS_KV) + l * NEXP, EB, PG); } }
#ifdef DBG_FAKE_U
        else if (kind == 8) { if (EN(8)) { MKCTX; peerU_phase(C, wsb + WS_H8, EB, (const fp8_t*)(wsb + WS_PUB) + (size_t)l * NEXP * D, (float*)(wsb + WS_END), DBG_FAKE_U); peerU_phase(C, wsb + WS_H8, EB, (const fp8_t*)(wsb + WS_PUB) + (size_t)l * NEXP * D, (float*)SBUF); } }
#else
        else if (kind == 8) { if (EN(8)) { MKCTX; peerU_phase(C, wsb + WS_H8, EB, (const fp8_t*)(wsb + WS_PUB) + (size_t)l * NEXP * D, (float*)SBUF); } }
#endif
#ifdef DBG_FAKE_V
        else if (kind == 9) { if (EN(9)) { MKCTX; const int fake = (repflag == 0); peerV_phase(C, EB, PG, (const float*)SBUF, (const fp8_t*)(wsb + WS_PVB) + (size_t)l * NEXP * D, X, modl + 5 * D, fake ? (DBG_FAKE_V) : 0xFFFF, fake); } }
#else
        else if (kind == 9) { if (EN(9)) { MKCTX; peerV_phase(C, EB, PG, (const float*)SBUF, (const fp8_t*)(wsb + WS_PVB) + (size_t)l * NEXP * D, X, modl + 5 * D); } }
#endif
        else if (EN(10)) {
            MKCTX;
            if (l == DEPTH - 1) final_norm_phase(C, X, C.in[I_FG]);
            else norm_phase(C, X, C.in[I_N1G] + (size_t)(l + 1) * D, MOD + (size_t)(l + 1) * 4 * MODW, 0, D, Hb);
        }
        if (ph + 1 < args.ph_hi) xcd_barrier(bar);
#ifdef DBG_EXTRA_BAR
        if (ph + 1 < args.ph_hi) { xcd_barrier(bar); xcd_barrier(bar); }
#endif
#ifdef DBG_REP_MASK
        { const int bit = ph < 2 ? ph : 2 + kind; bool want = ((DBG_REP_MASK) >> bit) & 1;
#ifdef DBG_REP_L0
          if (l != 0) want = false;
#endif
          if (want && !repflag) { repflag = 1; --ph; } else repflag = 0; }
#endif
    }
}

extern "C" void kernel_launch(void* const* d_in, const int* in_sizes, int n_in, void* d_out, int out_size, void* d_ws, size_t ws_size, hipStream_t stream) {
    static int grid = 0;
    if (grid == 0) {
        if (n_in != 21 || out_size != T * D || ws_size < WS_END) { fprintf(stderr, "kernel_launch: unexpected shapes (n_in %d, out %d, ws %zu)\n", n_in, out_size, ws_size); grid = -1; return; }
        int dev = 0, cus = 0, per_cu = 0;
        if (hipGetDevice(&dev) != hipSuccess || hipDeviceGetAttribute(&cus, hipDeviceAttributeMultiprocessorCount, dev) != hipSuccess) { grid = -1; return; }
        if (hipFuncSetAttribute((const void*)mk_fwd, hipFuncAttributeMaxDynamicSharedMemorySize, LDS_BYTES) != hipSuccess) { fprintf(stderr, "kernel_launch: hipFuncSetAttribute failed\n"); grid = -1; return; }
        if (hipOccupancyMaxActiveBlocksPerMultiprocessor(&per_cu, (const void*)mk_fwd, NTHR, LDS_BYTES) != hipSuccess || per_cu < 1) { fprintf(stderr, "kernel_launch: occupancy query says %d blocks per CU\n", per_cu); (void)hipGetLastError(); grid = -1; return; }
        if (cus != 256) { fprintf(stderr, "kernel_launch: built for a 256-CU device (got %d)\n", cus); grid = -1; return; }
        grid = cus;
    }
    if (grid < 0) return;
    (void)hipMemsetAsync((char*)d_ws + WS_CTL, 0, CTL_ZERO_BYTES, stream);
    Args a{};
    for (int i = 0; i < 21; ++i) a.in[i] = (const float*)d_in[i];
    a.out = (float*)d_out; a.ws = (unsigned char*)d_ws;
#if MK_N_LAUNCHES == 1
    a.ph_lo = 0; a.ph_hi = NPH;
    hipLaunchKernelGGL(mk_fwd, dim3(grid), dim3(NTHR), LDS_BYTES, stream, a);
#else
    for (int p = 0; p < NPH; ++p) { a.ph_lo = p; a.ph_hi = p + 1; hipLaunchKernelGGL(mk_fwd, dim3(grid), dim3(NTHR), LDS_BYTES, stream, a); }
#endif
}
```

```cpp
#include <hip/hip_runtime.h>
#include <cstdio>
#include <cstdint>
#ifndef MK_N_LAUNCHES
#define MK_N_LAUNCHES 1
#endif
namespace pg8 {
#define PG8_LAS __attribute__((address_space(3)))
typedef unsigned short bf16_t;
typedef short bf16x8 __attribute__((ext_vector_type(8)));
typedef float f32x4 __attribute__((ext_vector_type(4)));
typedef unsigned u32x4 __attribute__((ext_vector_type(4)));
constexpr int BM = 256, BK = 64, HALF = 128, HTB = HALF * BK * 2  , STAGE_BYTES = 8 * HTB, NXCD = 8, WGM = 8;

__host__ __device__ __forceinline__ int lds_byte(int r, int c) { const int st = (r >> 4) * 2 + (c >> 5), rr = r & 15, cc = c & 31, ob = rr * 64 + cc * 2; return st * 1024 + (ob ^ (((ob >> 9) & 1) << 5)); }
__host__ __device__ __forceinline__ void stage_rc(int b, int& R, int& C) { const int st = b / 1024, sb = b % 1024, swz = sb ^ (((sb >> 9) & 1) << 5); R = (st >> 1) * 16 + swz / 64; C = (st & 1) * 32 + (swz % 64) / 2; }
__host__ __device__ __forceinline__ int perm32(int rho) { const int n = rho >> 4, i = rho & 15; return 8 * (i >> 2) + 4 * n + (i & 3); }

struct Unit { int pm, pn; };
struct Gemm { const bf16_t* A; const bf16_t* Bt; int M, N, K; };

struct StaticOrder {
    int nM, nN, nwg, G, c;
    __host__ __device__ void init(int M, int N, int G_, int c_) { nM = M / BM; nN = N / BM; nwg = nM * nN; G = G_; c = c_; }
    __host__ __device__ bool next(int i, Unit& u) const {
        const long L = (long)i * G + c; if (L >= nwg) return false;
        int wgid = (int)L; { const int q = nwg / NXCD, r = nwg % NXCD, xcd = wgid % NXCD, off = wgid / NXCD; wgid = (xcd < r ? xcd * (q + 1) : r * (q + 1) + (xcd - r) * q) + off; }
        const int nig = WGM * nN, gid = wgid / nig, fm = gid * WGM, gsz = (nM - fm) < WGM ? (nM - fm) : WGM;
        u.pm = fm + ((wgid % nig) % gsz); u.pn = (wgid % nig) / gsz; return true;
    }
    __device__ __forceinline__ void a_ready(const Unit&) const {}
    __device__ __forceinline__ void done(const Unit&) const {}
};
__device__ __forceinline__ unsigned cvt_pk_bf16(float lo, float hi) { unsigned r; asm volatile("v_cvt_pk_bf16_f32 %0, %1, %2" : "=v"(r) : "v"(lo), "v"(hi)); return r; }
struct EpiBf16 {
    static constexpr bool PERM = true, AFTER_DRAIN = false;
    bf16_t* O; int ldc;
    __device__ __forceinline__ void operator()(const f32x4 (&acc)[2][2][4][2], const Unit& u, int wr, int wc, int fr, int fq) const {
        const int row0 = u.pm * BM + wr * 64 + fr; const int col0 = u.pn * BM + wc * 32 + 8 * fq;
#pragma unroll
        for (int ai = 0; ai < 2; ++ai)
#pragma unroll
            for (int m = 0; m < 4; ++m) { bf16_t* rowp = O + (size_t)(row0 + ai * HALF + m * 16) * ldc + col0;
#pragma unroll
                for (int bj = 0; bj < 2; ++bj) { const f32x4 v0 = acc[ai][bj][m][0], v1 = acc[ai][bj][m][1];
                    u32x4 w; w.x = cvt_pk_bf16(v0[0], v0[1]); w.y = cvt_pk_bf16(v0[2], v0[3]); w.z = cvt_pk_bf16(v1[0], v1[1]); w.w = cvt_pk_bf16(v1[2], v1[3]);
                    *(u32x4*)(rowp + bj * HALF) = w; } }
    }
};
struct EpiResGate {
    static constexpr bool PERM = false, AFTER_DRAIN = false;
    const float* base; float* out; const float* gate; int gpitch;
    __device__ __forceinline__ void operator()(const f32x4 (&acc)[2][2][4][2], const Unit& u, int wr, int wc, int fr, int fq) const {
        const int row0 = u.pm * BM + wr * 64 + fr, col0 = u.pn * BM + wc * 32 + 4 * fq;
        const float* gp = gate + (size_t)(u.pm >> 4) * gpitch + col0;
        f32x4 gv[2][2];
#pragma unroll
        for (int bj = 0; bj < 2; ++bj)
#pragma unroll
            for (int n = 0; n < 2; ++n) gv[bj][n] = *(const f32x4*)(gp + bj * HALF + n * 16);
#pragma unroll
        for (int ai = 0; ai < 2; ++ai)
#pragma unroll
            for (int m = 0; m < 4; ++m) { const size_t off = (size_t)(row0 + ai * HALF + m * 16) * 2048 + col0;
#pragma unroll
                for (int bj = 0; bj < 2; ++bj)
#pragma unroll
                    for (int n = 0; n < 2; ++n) { const f32x4 bs = *(const f32x4*)(base + off + bj * HALF + n * 16); *(f32x4*)(out + off + bj * HALF + n * 16) = bs + gv[bj][n] * acc[ai][bj][m][n]; }
                asm volatile("" ::: "memory"); }
    }
};

template <class Epi, class Sched, bool ALIGN_EPI = false, bool SP2 = false>
__device__ __forceinline__ void gemm_phase(PG8_LAS unsigned char* lds, const Gemm g, const Sched& S, const Epi& E, const int tid  ) {
    const int wid = __builtin_amdgcn_readfirstlane(tid >> 6), lane = tid & 63, wr = wid >> 2, wc = wid & 3, fr = lane & 15, fq = lane >> 4;
    const int K = g.K, nt = K / BK;
    unsigned voffA[2], voffB[2];
#pragma unroll
    for (int i = 0; i < 2; ++i) { int R, C; stage_rc(tid * 16 + i * 8192, R, C); const int Rb = Epi::PERM ? ((R & ~31) + perm32(R & 31)) : R;
        voffA[i] = (unsigned)(R * K + C) * 2u; voffB[i] = (unsigned)(Rb * K + C) * 2u; }
    const size_t kstep = (size_t)(BK * 2);
    const size_t hstep = (size_t)HALF * K * 2;
    const size_t tstep = 2 * hstep;
    const unsigned ldsw = (unsigned)wid * 1024u;
    const int aoff = lds_byte(wr * 64 + fr, fq * 8), boff = lds_byte(wc * 32 + fr, fq * 8);
#define PG8_SA(b, h) (((b) * 2 + (h)) * HTB)
#define PG8_SB(b, h) ((4 + (b) * 2 + (h)) * HTB)
#define PG8_STAGE(bufoff, gbase, voff) do { _Pragma("unroll") for (int _i = 0; _i < 2; ++_i) \
        __builtin_amdgcn_global_load_lds((const unsigned*)((const char*)(gbase) + (voff)[_i]), (PG8_LAS unsigned*)(lds + (bufoff) + ldsw + _i * 8192), 16, 0, 0); } while (0)
#define PG8_LDA(dst, b, h) do { _Pragma("unroll") for (int m = 0; m < 4; ++m) _Pragma("unroll") for (int k = 0; k < 2; ++k) dst[m][k] = *(const PG8_LAS bf16x8*)(lds + PG8_SA(b, h) + aoff + m * 2048 + k * 1024); } while (0)
#define PG8_LDB(dst, b, h) do { _Pragma("unroll") for (int n = 0; n < 2; ++n) _Pragma("unroll") for (int k = 0; k < 2; ++k) dst[n][k] = *(const PG8_LAS bf16x8*)(lds + PG8_SB(b, h) + boff + n * 2048 + k * 1024); } while (0)
#define PG8_MMA(ai, bj, At, Bt) do { __builtin_amdgcn_s_setprio(1); _Pragma("unroll") for (int m = 0; m < 4; ++m) _Pragma("unroll") for (int n = 0; n < 2; ++n) _Pragma("unroll") for (int k = 0; k < 2; ++k) \
        acc[ai][bj][m][n] = __builtin_amdgcn_mfma_f32_16x16x32_bf16(Bt[n][k], At[m][k], acc[ai][bj][m][n], 0, 0, 0); __builtin_amdgcn_s_setprio(0); } while (0)
#define PG8_WAIT_V(n) asm volatile("s_waitcnt vmcnt(" #n ")" ::: "memory")
#define PG8_WAIT_L(n) asm volatile("s_waitcnt lgkmcnt(" #n ")" ::: "memory")
#define PG8_BAR __builtin_amdgcn_s_barrier()
#define PG8_SCHED __builtin_amdgcn_sched_barrier(0)
    Unit cur, nxt; int ui = 0;
    if (!S.next(0, cur)) return;
    f32x4 acc[2][2][4][2];
#pragma unroll
    for (int a = 0; a < 2; ++a)
#pragma unroll
        for (int b = 0; b < 2; ++b)
#pragma unroll
            for (int m = 0; m < 4; ++m)
#pragma unroll
                for (int n = 0; n < 2; ++n) acc[a][b][m][n] = (f32x4){0.f, 0.f, 0.f, 0.f};
    bf16x8 At[4][2], B0[2][2], B1[2][2];
    const char* cA = (const char*)g.A + (size_t)cur.pm * tstep; const char* cB = (const char*)g.Bt + (size_t)cur.pn * tstep;
    S.a_ready(cur);
    if constexpr (SP2) {
        PG8_STAGE(PG8_SB(0, 0), cB, voffB); PG8_STAGE(PG8_SB(0, 1), cB + hstep, voffB); PG8_STAGE(PG8_SA(0, 0), cA, voffA); PG8_STAGE(PG8_SA(0, 1), cA + hstep, voffA);
        if (wr == 1) PG8_BAR;
        PG8_WAIT_V(2); PG8_BAR;
        PG8_STAGE(PG8_SB(1, 0), cB + kstep, voffB); PG8_STAGE(PG8_SA(1, 0), cA + kstep, voffA); PG8_STAGE(PG8_SB(1, 1), cB + hstep + kstep, voffB);
        PG8_WAIT_V(6); PG8_BAR;
    } else {
        PG8_STAGE(PG8_SB(0, 0), cB, voffB); PG8_STAGE(PG8_SA(0, 0), cA, voffA); PG8_STAGE(PG8_SB(0, 1), cB + hstep, voffB); PG8_STAGE(PG8_SA(0, 1), cA + hstep, voffA);
        if (wr == 1) PG8_BAR;
        PG8_WAIT_V(4); PG8_BAR;
        PG8_STAGE(PG8_SB(1, 0), cB + kstep, voffB); PG8_STAGE(PG8_SA(1, 0), cA + kstep, voffA); PG8_STAGE(PG8_SB(1, 1), cB + hstep + kstep, voffB);
        PG8_WAIT_V(6); PG8_BAR;
    }
    for (;;) {
        const bool has_next = S.next(ui + 1, nxt);
        const char* nA = has_next ? (const char*)g.A + (size_t)nxt.pm * tstep : cA; const char* nB = has_next ? (const char*)g.Bt + (size_t)nxt.pn * tstep : cB;
        for (int t = 0; t < nt; t += 2) {
            const bool last = (t == nt - 2);
            const char* a1 = cA + (size_t)(t + 1) * kstep;
            const char* a2 = last ? nA : cA + (size_t)(t + 2) * kstep; const char* b2 = last ? nB : cB + (size_t)(t + 2) * kstep;
            const char* a3 = a2 + kstep; const char* b3 = b2 + kstep;
            if (last && has_next) S.a_ready(nxt);
            if constexpr (SP2) {
            PG8_LDB(B0, 0, 0); PG8_LDB(B1, 0, 1); PG8_SCHED; PG8_LDA(At, 0, 0); PG8_STAGE(PG8_SA(1, 1), a1 + hstep, voffA);
            PG8_WAIT_V(8); PG8_WAIT_L(0); PG8_BAR; PG8_MMA(0, 0, At, B0); PG8_MMA(0, 1, At, B1); PG8_BAR; PG8_SCHED;
            PG8_LDA(At, 0, 1); PG8_STAGE(PG8_SB(0, 0), b2, voffB); PG8_STAGE(PG8_SB(0, 1), b2 + hstep, voffB); PG8_STAGE(PG8_SA(0, 0), a2, voffA);
            PG8_WAIT_V(8); PG8_WAIT_L(0); PG8_BAR; PG8_MMA(1, 0, At, B0); PG8_MMA(1, 1, At, B1); PG8_BAR; PG8_SCHED;
            PG8_LDB(B0, 1, 0); PG8_LDB(B1, 1, 1); PG8_SCHED; PG8_LDA(At, 1, 0); PG8_STAGE(PG8_SA(0, 1), a2 + hstep, voffA);
            PG8_WAIT_V(8); PG8_WAIT_L(0); PG8_BAR; PG8_MMA(0, 0, At, B0); PG8_MMA(0, 1, At, B1); PG8_BAR; PG8_SCHED;
            PG8_LDA(At, 1, 1); PG8_STAGE(PG8_SB(1, 0), b3, voffB); PG8_STAGE(PG8_SB(1, 1), b3 + hstep, voffB); PG8_STAGE(PG8_SA(1, 0), a3, voffA);
            PG8_WAIT_V(8); PG8_WAIT_L(0); PG8_BAR; PG8_MMA(1, 0, At, B0); PG8_MMA(1, 1, At, B1); PG8_BAR; PG8_SCHED;
            } else {
            PG8_LDB(B0, 0, 0); PG8_SCHED; PG8_LDA(At, 0, 0); PG8_STAGE(PG8_SA(1, 1), a1 + hstep, voffA);
            PG8_WAIT_L(8); PG8_BAR; PG8_WAIT_L(0); PG8_MMA(0, 0, At, B0); PG8_BAR; PG8_SCHED;
            PG8_LDB(B1, 0, 1); PG8_STAGE(PG8_SB(0, 0), b2, voffB);
            PG8_BAR; PG8_WAIT_L(0); PG8_MMA(0, 1, At, B1); PG8_BAR;
            PG8_LDA(At, 0, 1); PG8_STAGE(PG8_SA(0, 0), a2, voffA);
            PG8_BAR; PG8_WAIT_L(0); PG8_MMA(1, 0, At, B0); PG8_BAR; PG8_SCHED;
            PG8_STAGE(PG8_SB(0, 1), b2 + hstep, voffB);
            PG8_WAIT_V(6); PG8_BAR; PG8_MMA(1, 1, At, B1); PG8_BAR;
            PG8_LDB(B0, 1, 0); PG8_SCHED; PG8_LDA(At, 1, 0); PG8_STAGE(PG8_SA(0, 1), a2 + hstep, voffA);
            PG8_WAIT_L(8); PG8_BAR; PG8_WAIT_L(0); PG8_MMA(0, 0, At, B0); PG8_BAR; PG8_SCHED;
            PG8_LDB(B1, 1, 1); PG8_STAGE(PG8_SB(1, 0), b3, voffB);
            PG8_BAR; PG8_WAIT_L(0); PG8_MMA(0, 1, At, B1); PG8_BAR;
            PG8_LDA(At, 1, 1); PG8_STAGE(PG8_SA(1, 0), a3, voffA);
            PG8_BAR; PG8_WAIT_L(0); PG8_MMA(1, 0, At, B0); PG8_BAR; PG8_SCHED;
            PG8_STAGE(PG8_SB(1, 1), b3 + hstep, voffB);
            PG8_WAIT_V(6); PG8_BAR; PG8_MMA(1, 1, At, B1); PG8_BAR;
            }
        }
        if constexpr (ALIGN_EPI) { if (wr == 0) PG8_BAR; }
        if constexpr (!Epi::AFTER_DRAIN) { E(acc, cur, wr, wc, fr, fq); S.done(cur); }
        if (!has_next) break;
#pragma unroll
        for (int a = 0; a < 2; ++a)
#pragma unroll
            for (int b = 0; b < 2; ++b)
#pragma unroll
                for (int m = 0; m < 4; ++m)
#pragma unroll
                    for (int n = 0; n < 2; ++n) acc[a][b][m][n] = (f32x4){0.f, 0.f, 0.f, 0.f};
        cur = nxt; cA = nA; cB = nB; ++ui;
        if constexpr (ALIGN_EPI) { if (wr == 1) PG8_BAR; }
    }
    PG8_WAIT_V(0);
    if constexpr (!ALIGN_EPI) { if (wr == 0) PG8_BAR; }
    PG8_BAR;
    if constexpr (Epi::AFTER_DRAIN) { E.fused(acc, cur, wr, wc, fr, fq, lds, wid, lane); S.done(cur); }
#undef PG8_SA
#undef PG8_SB
#undef PG8_STAGE
#undef PG8_LDA
#undef PG8_LDB
#undef PG8_MMA
#undef PG8_WAIT_V
#undef PG8_WAIT_L
#undef PG8_BAR
#undef PG8_SCHED
}
}
constexpr int NWAVES = 8, NTHR = 512;
constexpr int D = 2048, NBATCH = 4, SEQ = 4096, T = NBATCH * SEQ, DEPTH = 2;
constexpr int GLA_H = 4, GLA_DK = 128, GLA_DV = 256, GLA_CH = 64;
constexpr int MLP_H = 8, MLP_DH = 128, MLP_CH = 128;
constexpr int IN_COLS = 5136, NPROJ = 5120;
constexpr int C_Q = 0, C_K = 512, C_V = 1024, C_R = 2048, C_U = 3072, C_VS = 4096;
constexpr int NEXP = 16384, PEER_H = 8;
constexpr float EPS = 1e-6f;
constexpr int MODW = 6 * D;
constexpr size_t MiB = 1u << 20;
constexpr size_t WS_CTL = 0, CTL_ZERO_BYTES = 1 * MiB;
constexpr size_t WS_MOD = 1 * MiB;
constexpr size_t WS_K1B = 2 * MiB, WS_K2B = 2 * MiB + 512 * 1024, WS_WSB = 3 * MiB, WS_DEC = 3 * MiB + 512 * 1024, WS_ALOW = 4 * MiB;
constexpr size_t WS_KU = 5 * MiB, WS_KV = 5 * MiB + 256 * 1024;
constexpr size_t WS_WTIN = 8 * MiB;
constexpr size_t WTIN_L = (size_t)5136 * 2048;
constexpr size_t WS_WTOUT = 49 * MiB, WS_WTQ = 65 * MiB;
constexpr size_t WS_PUB = 81 * MiB, WS_PVB = 209 * MiB;
constexpr size_t WS_H = 337 * MiB;
constexpr size_t WS_PROJ = 401 * MiB;
constexpr size_t WS_SBUF = 561 * MiB;
constexpr size_t WS_CONCAT = 625 * MiB;
constexpr size_t WS_QB = 689 * MiB;
constexpr size_t WS_EB = 753 * MiB, WS_PG = 761 * MiB;
constexpr size_t WS_H8 = 769 * MiB, WS_END = 833 * MiB;
static_assert(WS_WTIN + 2 * WTIN_L * 2 <= WS_WTOUT, "ws map");
constexpr int CW_BAR = 4096;
constexpr int RING_BYTES = 131072, LDSCTL_OFF = RING_BYTES, MISC_OFF = LDSCTL_OFF + 320, LDS_BYTES = 147456;

#define DI __device__ __forceinline__
#define LAS __attribute__((address_space(3)))
typedef unsigned short bf16;
typedef short bf16x8 __attribute__((ext_vector_type(8)));
typedef short s16x4 __attribute__((ext_vector_type(4)));
typedef short v4i16_t __attribute__((ext_vector_type(4)));
typedef __bf16 bf16x2_t __attribute__((ext_vector_type(2)));
typedef float f32x4 __attribute__((ext_vector_type(4)));
typedef float f32x2 __attribute__((ext_vector_type(2)));
typedef unsigned u32x4 __attribute__((ext_vector_type(4)));
typedef unsigned u32x2 __attribute__((ext_vector_type(2)));
typedef LAS unsigned char* ldsp;

DI unsigned f2bf(float f) { unsigned u = __builtin_bit_cast(unsigned, f); return (u + 0x7fffu + ((u >> 16) & 1u)) >> 16; }
DI unsigned pk2(float lo, float hi) { return f2bf(lo) | (f2bf(hi) << 16); }
DI float bflo(unsigned u) { return __builtin_bit_cast(float, u << 16); }
DI float bfhi(unsigned u) { return __builtin_bit_cast(float, u & 0xffff0000u); }
DI float bf1(bf16 v) { return __builtin_bit_cast(float, ((unsigned)v) << 16); }
DI float fexp2(float x) { return __builtin_amdgcn_exp2f(x); }
DI float flog2(float x) { return __builtin_amdgcn_logf(x); }
DI float frcp(float x) { return __builtin_amdgcn_rcpf(x); }
DI float frsq(float x) { return __builtin_amdgcn_rsqf(x); }
DI float gelu_t(float x) { const float u = 0.7978845608f * (x + 0.044715f * x * x * x); return x * frcp(1.f + fexp2(-2.885390082f * u)); }
DI float silu_f(float x) { return x * frcp(1.f + fexp2(-1.442695041f * x)); }
template <int CTRL> DI float dppf(float v) { return __builtin_bit_cast(float, __builtin_amdgcn_update_dpp(0, __builtin_bit_cast(int, v), CTRL, 0xf, 0xf, true)); }
DI float wave_sum_u(float v) {
    v += dppf<0xB1>(v); v += dppf<0x4E>(v); v += dppf<0x141>(v); v += dppf<0x140>(v);
    const int iv = __builtin_bit_cast(int, v);
    return (__builtin_bit_cast(float, __builtin_amdgcn_readlane(iv, 0)) + __builtin_bit_cast(float, __builtin_amdgcn_readlane(iv, 16))) +
           (__builtin_bit_cast(float, __builtin_amdgcn_readlane(iv, 32)) + __builtin_bit_cast(float, __builtin_amdgcn_readlane(iv, 48)));
}
DI float wave_sum(float v) {
#pragma unroll
    for (int o = 1; o < 64; o <<= 1) v += __shfl_xor(v, o);
    return v;
}
DI float dot2bf(unsigned a, unsigned b, float c) { return __builtin_amdgcn_fdot2_f32_bf16(__builtin_bit_cast(bf16x2_t, a), __builtin_bit_cast(bf16x2_t, b), c, false); }
DI f32x4 mfma16(bf16x8 a, bf16x8 b, f32x4 c) { return __builtin_amdgcn_mfma_f32_16x16x32_bf16(a, b, c, 0, 0, 0); }
DI s16x4 tr4(const LAS bf16* p) { return __builtin_bit_cast(s16x4, __builtin_amdgcn_ds_read_tr16_b64_v4i16((LAS v4i16_t*)p)); }
DI bf16x8 tr8(const LAS bf16* p, int stride) { const s16x4 a = tr4(p), b = tr4(p + 4 * stride); return (bf16x8){a[0], a[1], a[2], a[3], b[0], b[1], b[2], b[3]}; }

#define XB_TMO      128
#define XB_XCNT(j)  (256  + 64 * (j))
#define XB_XSUB(j)  (1280 + 64 * (j))
#define XB_XGEN(j)  (2304 + 64 * (j))
#define XB_TOP      3328
#define XB_TOPGEN   3392
#define XCD_BAR_WORDS 3456
#define XB_SPIN_CAP (1u << 18)

__device__ __forceinline__ unsigned xb_ld(unsigned* p)              { return __hip_atomic_load(p, __ATOMIC_RELAXED, __HIP_MEMORY_SCOPE_AGENT); }
__device__ __forceinline__ unsigned xb_add(unsigned* p, unsigned v) { return __hip_atomic_fetch_add(p, v, __ATOMIC_RELAXED, __HIP_MEMORY_SCOPE_AGENT); }
__device__ __forceinline__ unsigned xb_xcc_id() { return (unsigned)__builtin_amdgcn_s_getreg((3 << 11) | 20) & 0xFu; }
#define XB_SPIN(cond, bar) do { unsigned _sp = 0; while (cond) { __builtin_amdgcn_s_sleep(1); \
    if ((++_sp & 255u) == 0u) { if (xb_ld(&(bar)[XB_TMO])) break; if (_sp > XB_SPIN_CAP) { atomicAdd(&(bar)[XB_TMO], 1u); break; } } } } while (0)

struct XcdBarrier {
    unsigned* bar; unsigned x;
    volatile LAS unsigned* st;
};

__device__ __forceinline__ XcdBarrier xcd_barrier_post(unsigned* bar, volatile LAS unsigned* st) {
    XcdBarrier b; b.bar = bar; b.x = xb_xcc_id(); b.st = st;
    if (threadIdx.x == 0) (void)xb_add(&bar[XB_XCNT(b.x)], 1u);
    return b;
}
__device__ __forceinline__ void xcd_barrier_complete(unsigned* bar, unsigned x, unsigned& nloc, unsigned& nx) {
    const unsigned G = gridDim.x * gridDim.y * gridDim.z;
    unsigned sum, cnt, mine, sp = 0u;
    for (;;) {
        sum = 0u; cnt = 0u; mine = 0u;
#pragma unroll
        for (unsigned j = 0; j < 16; ++j) { const unsigned c = xb_ld(&bar[XB_XCNT(j)]); sum += c; cnt += (c > 0u) ? 1u : 0u; mine = (j == x) ? c : mine; }
        if (sum == G) break;
        __builtin_amdgcn_s_sleep(1);
        if ((++sp & 255u) == 0u) { if (xb_ld(&bar[XB_TMO])) break; if (sp > XB_SPIN_CAP) { atomicAdd(&bar[XB_TMO], 1u); break; } }
    }
    nloc = mine > 0u ? mine : 1u; nx = cnt > 0u ? cnt : 1u;
}

__device__ __forceinline__ void xcd_barrier(const XcdBarrier& b) {
    asm volatile("s_waitcnt vmcnt(0)" ::: "memory");
    __syncthreads();
    if (threadIdx.x == 0) {
        unsigned* bar = b.bar;
        __builtin_amdgcn_s_waitcnt(0);
        unsigned nloc = b.st[0], nx = b.st[1];
        if (nloc == 0u) { xcd_barrier_complete(bar, b.x, nloc, nx); b.st[0] = nloc; b.st[1] = nx; }
        const unsigned old = xb_add(&bar[XB_XSUB(b.x)], 1u);
        const unsigned gen = old / nloc;
        if (old + 1u == (gen + 1u) * nloc) {
            __builtin_amdgcn_fence(__ATOMIC_RELEASE, "agent");
            asm volatile("s_waitcnt vmcnt(0)" ::: "memory");
            const unsigned og = xb_add(&bar[XB_TOP], 1u);
            const unsigned tg = og / nx;
            if (og + 1u == (tg + 1u) * nx) xb_add(&bar[XB_TOPGEN], 1u);
            else XB_SPIN(xb_ld(&bar[XB_TOPGEN]) == tg, bar);
            __builtin_amdgcn_fence(__ATOMIC_ACQUIRE, "agent");
            xb_add(&bar[XB_XGEN(b.x)], 1u);
            asm volatile("s_waitcnt vmcnt(0)" ::: "memory");
        } else {
            XB_SPIN(xb_ld(&bar[XB_XGEN(b.x)]) == gen, bar);
            __builtin_amdgcn_fence(__ATOMIC_ACQUIRE, "agent");
            asm volatile("s_waitcnt vmcnt(0)" ::: "memory");
        }
    }
    __syncthreads();
}
struct Ctx {
    ldsp lds; int tid, lane, wave, bid, G, gw, NGW;
    unsigned char* ws;
};
DI const float* KARG(int k) { asm volatile("" : "+s"(k)); return ((const float* const*)__builtin_amdgcn_kernarg_segment_ptr())[k]; }
#define LDS_WAIT() asm volatile("s_waitcnt lgkmcnt(0)" ::: "memory")
enum { I_X = 0, I_C, I_ADAW, I_ADAB, I_N1G, I_WIN, I_WA2, I_BA, I_GNG, I_VNG, I_MWS, I_MB, I_MOG, I_WOUT, I_N2G, I_WQ, I_K1, I_K2, I_PU, I_PV, I_FG };

DI void p0_ada(const Ctx& C) {
    LAS float* red = (LAS float*)C.lds;
    float* MOD = (float*)(C.ws + WS_MOD);
    for (int it = C.bid; it < 192; it += C.G) {
        const int l = it / 96, cg = it % 96, c0 = cg * 128 + C.lane * 2;
        const float* W = KARG(I_ADAW) + (size_t)l * D * MODW + (size_t)(C.wave * 256) * MODW + c0;
        float cv[4][4];
#pragma unroll
        for (int b = 0; b < 4; ++b)
#pragma unroll
            for (int i = 0; i < 4; ++i) cv[b][i] = silu_f(KARG(I_C)[b * D + C.wave * 256 + i * 64 + C.lane]);
        float acc[4][2];
#pragma unroll
        for (int b = 0; b < 4; ++b) { acc[b][0] = 0.f; acc[b][1] = 0.f; }
#pragma unroll
        for (int i = 0; i < 4; ++i) {
#pragma unroll 16
            for (int j = 0; j < 64; ++j) {
                const f32x2 w = *(const f32x2*)(W + (size_t)(i * 64 + j) * MODW);
#pragma unroll
                for (int b = 0; b < 4; ++b) { const float s = __builtin_bit_cast(float, __builtin_amdgcn_readlane(__builtin_bit_cast(int, cv[b][i]), j)); acc[b][0] += s * w.x; acc[b][1] += s * w.y; }
            }
        }
#pragma unroll
        for (int b = 0; b < 4; ++b) *(LAS f32x2*)(red + (C.wave * 4 + b) * 128 + C.lane * 2) = (f32x2){acc[b][0], acc[b][1]};
        __syncthreads();
        { const int b = C.tid >> 7, col = C.tid & 127; float s = KARG(I_ADAB)[l * MODW + cg * 128 + col];
#pragma unroll
          for (int w = 0; w < 8; ++w) s += red[(w * 4 + b) * 128 + col];
          MOD[(size_t)(l * 4 + b) * MODW + cg * 128 + col] = s; }
        __syncthreads();
    }
}
DI void transpose_item(const float* W, int ldw, int src_col0, int ncols, bf16* WT, int dst_row0, int k0, LAS float* scr, int lane) {
    const int cl = lane & 31;
    float v[32];
#pragma unroll
    for (int i = 0; i < 32; ++i) { const int kk = 2 * i + (lane >> 5); v[i] = 0.f; if (cl < ncols) v[i] = W[(size_t)(k0 + kk) * ldw + src_col0 + cl]; }
#pragma unroll
    for (int i = 0; i < 32; ++i) { const int kk = 2 * i + (lane >> 5); scr[kk * 33 + cl] = v[i]; }
    LDS_WAIT();
    const int c = lane & 7;
#pragma unroll
    for (int j = 0; j < 4; ++j) { const int n = (lane >> 3) + 8 * j;
        if (n < ncols) { const LAS float* s = scr + (8 * c) * 33 + n;
            u32x4 o; o.x = pk2(s[0 * 33], s[1 * 33]); o.y = pk2(s[2 * 33], s[3 * 33]); o.z = pk2(s[4 * 33], s[5 * 33]); o.w = pk2(s[6 * 33], s[7 * 33]);
            *(u32x4*)(WT + (size_t)(dst_row0 + n) * 2048 + k0 + 8 * c) = o; } }
    LDS_WAIT();
}
DI void p0_prologue(const Ctx& C) {
    p0_ada(C);
    LAS float* scr = (LAS float*)(C.lds + C.wave * 16384);
    constexpr int PER_L = (161 + 64 + 64) * 32;
    for (int it = C.gw; it < 2 * PER_L; it += C.NGW) {
        const int l = it / PER_L; int r = it % PER_L;
        if (r < 161 * 32) { const int kb = r / 161, nb = r % 161; bf16* WT = (bf16*)(C.ws + WS_WTIN) + (size_t)l * WTIN_L;
            const float* W = KARG(I_WIN) + (size_t)l * D * IN_COLS;
            if (nb < 160) { const int n0 = 32 * nb; transpose_item(W, IN_COLS, n0 + (n0 >= 3072 ? 16 : 0), 32, WT, n0, 64 * kb, scr, C.lane); }
            else transpose_item(W, IN_COLS, 3072, 16, WT, 5120, 64 * kb, scr, C.lane);
            continue; }
        r -= 161 * 32;
        if (r < 2048) { const int kb = r / 64, nb = r % 64; transpose_item(KARG(I_WOUT) + (size_t)l * D * D, D, 32 * nb, 32, (bf16*)(C.ws + WS_WTOUT) + (size_t)l * D * D, 32 * nb, 64 * kb, scr, C.lane); continue; }
        r -= 2048;
        { const int kb = r / 64, nb = r % 64; transpose_item(KARG(I_WQ) + (size_t)l * D * D, D, 32 * nb, 32, (bf16*)(C.ws + WS_WTQ) + (size_t)l * D * D, 32 * nb, 64 * kb, scr, C.lane); }
    }
    const int gt = C.bid * NTHR + C.tid, NT = C.G * NTHR;
    { bf16* K1B = (bf16*)(C.ws + WS_K1B); bf16* K2B = (bf16*)(C.ws + WS_K2B); bf16* WSB = (bf16*)(C.ws + WS_WSB);
      for (int i = gt; i < 262144; i += NT) { K1B[i] = (bf16)f2bf(KARG(I_K1)[i]); K2B[i] = (bf16)f2bf(KARG(I_K2)[i]);
          const int s = i & 127, t = (i >> 7) & 127; WSB[i] = (s <= t) ? (bf16)f2bf(KARG(I_MWS)[i]) : (bf16)0; } }
    { int* KU = (int*)(C.ws + WS_KU); int* KV = (int*)(C.ws + WS_KV);
#pragma unroll 1
      for (int row = C.gw; row < 4 * NEXP; row += C.NGW) {
          const int tb = row >> 15, rr = row & 32767;
          const f32x4* src = (const f32x4*)(KARG(tb ? I_PV : I_PU) + (size_t)rr * D) + C.lane;
          f32x4 v[8]; float mx = 0.f;
#pragma unroll
          for (int j = 0; j < 8; ++j) { v[j] = src[64 * j]; mx = fmaxf(mx, fmaxf(fmaxf(fabsf(v[j].x), fabsf(v[j].y)), fmaxf(fabsf(v[j].z), fabsf(v[j].w)))); }
#pragma unroll
          for (int o = 1; o < 64; o <<= 1) mx = fmaxf(mx, __shfl_xor(mx, o));
          int k = 0;
          if (mx > 0.f) { k = (int)((__builtin_bit_cast(unsigned, 224.0f / mx) >> 23) & 255u) - 127; k = k < -60 ? -60 : (k > 60 ? 60 : k); }
          const float sc = __builtin_bit_cast(float, (unsigned)(k + 127) << 23);
          const int lyr = rr >> 14, ee = rr & 16383;
          unsigned* dst = (unsigned*)(C.ws + (tb ? WS_PVB : WS_PUB) + (size_t)lyr * NEXP * D + (size_t)ee * 256) + C.lane;
#pragma unroll
          for (int j = 0; j < 8; ++j) { int p = 0; p = __builtin_amdgcn_cvt_pk_fp8_f32(v[j].x * sc, v[j].y * sc, p, false); p = __builtin_amdgcn_cvt_pk_fp8_f32(v[j].z * sc, v[j].w * sc, p, true); dst[(size_t)j * (NEXP * 256 / 4)] = (unsigned)p; }
          if (C.lane == 0) (tb ? KV : KU)[rr] = k;
      } }
}
template <bool FP8 = false>
DI void norm_phase(const Ctx& C, const float* X, const float* g, const float* modl, int sh_off, int sc_off, bf16* Hout, unsigned char* H8 = nullptr) {
    const int r0 = C.gw * 8, b = r0 >> 12;
    const f32x4* shp = (const f32x4*)(modl + (size_t)b * MODW + sh_off); const f32x4* scp = (const f32x4*)(modl + (size_t)b * MODW + sc_off);
    f32x4 gm[8], shv[8];
#pragma unroll
    for (int j = 0; j < 8; ++j) { const int idx = 64 * j + C.lane; gm[j] = ((const f32x4*)g)[idx] * (scp[idx] + 1.0f); shv[j] = shp[idx]; }
#pragma unroll 1
    for (int i = 0; i < 8; ++i) {
        const f32x4* xr = (const f32x4*)(X + (size_t)(r0 + i) * D) + C.lane; f32x4 v[8]; float s = 0.f;
#pragma unroll
        for (int j = 0; j < 8; ++j) { v[j] = xr[64 * j]; s += (v[j].x * v[j].x + v[j].y * v[j].y) + (v[j].z * v[j].z + v[j].w * v[j].w); }
        const float rstd = frsq(wave_sum(s) * (1.f / D) + EPS);
        u32x2* o = (u32x2*)(Hout + (size_t)(r0 + i) * D) + C.lane;
#pragma unroll
        for (int j = 0; j < 8; ++j) { const f32x4 y = v[j] * rstd * gm[j] + shv[j]; u32x2 w; w.x = pk2(y.x, y.y); w.y = pk2(y.z, y.w); o[64 * j] = w;
            if (FP8) {
                const f32x4 ys = y * 16.0f; int ph = 0; ph = __builtin_amdgcn_cvt_pk_fp8_f32(ys.x, ys.y, ph, false); ph = __builtin_amdgcn_cvt_pk_fp8_f32(ys.z, ys.w, ph, true);
                const f32x2 b0 = __builtin_amdgcn_cvt_pk_f32_fp8(ph, false), b1 = __builtin_amdgcn_cvt_pk_f32_fp8(ph, true);
                int pl = 0; pl = __builtin_amdgcn_cvt_pk_fp8_f32((ys.x - b0.x) * 16.0f, (ys.y - b0.y) * 16.0f, pl, false); pl = __builtin_amdgcn_cvt_pk_fp8_f32((ys.z - b1.x) * 16.0f, (ys.w - b1.y) * 16.0f, pl, true);
                unsigned* h8 = (unsigned*)(H8 + (size_t)(r0 + i) * 4096) + C.lane; h8[64 * j] = (unsigned)ph; h8[512 + 64 * j] = (unsigned)pl; } }
    }
}
DI void alow_phase(const Ctx& C, const bf16* Hb, const bf16* WtA, float* ALOW) {
    if (C.wave < 4) {
        const int task = C.bid * 4 + C.wave, r0 = task * 16, fr = C.lane & 15, fq = C.lane >> 4;
        const bf16* ap = Hb + (size_t)(r0 + fr) * D + 8 * fq; const bf16* bp = WtA + (size_t)fr * D + 8 * fq;
        f32x4 acc = (f32x4){0.f, 0.f, 0.f, 0.f};
#pragma unroll 8
        for (int ks = 0; ks < 64; ++ks) { const bf16x8 a = *(const bf16x8*)(ap + 32 * ks), b = *(const bf16x8*)(bp + 32 * ks); acc = mfma16(a, b, acc); }
#pragma unroll
        for (int r = 0; r < 4; ++r) ALOW[(size_t)(r0 + 4 * fq + r) * 16 + fr] = acc[r];
    }
}
#define LBAR() do { asm volatile("s_waitcnt lgkmcnt(0)" ::: "memory"); __builtin_amdgcn_s_barrier(); asm volatile("" ::: "memory"); } while (0)
DI void gla_gates(const Ctx& C, LAS float* al, LAS float* tot, const f32x4 alv, const float (&w2)[16], const float bav, float (&Gl)[16], float& off, float& gref, float& g63) {
    const int d = C.tid & 127, jg = C.tid >> 7;
    if (C.tid < 256) ((LAS f32x4*)al)[C.tid] = alv;
    LBAR();
    float run = 0.f;
#pragma unroll
    for (int jj = 0; jj < 16; ++jj) {
        const LAS f32x4* ar = (const LAS f32x4*)(al + (jg * 16 + jj) * 16);
        const f32x4 a0 = ar[0], a1 = ar[1], a2 = ar[2], a3 = ar[3];
        float z = bav;
        z += a0.x * w2[0] + a0.y * w2[1] + a0.z * w2[2] + a0.w * w2[3];
        z += a1.x * w2[4] + a1.y * w2[5] + a1.z * w2[6] + a1.w * w2[7];
        z += a2.x * w2[8] + a2.y * w2[9] + a2.z * w2[10] + a2.w * w2[11];
        z += a3.x * w2[12] + a3.y * w2[13] + a3.z * w2[14] + a3.w * w2[15];
        const float ls = fminf(z, 0.f) - 0.6931471806f * flog2(1.f + fexp2(-1.442695041f * fabsf(z)));
        run += ls * (1.442695041f / 16.f);
        Gl[jj] = run;
    }
    tot[jg * 128 + d] = run;
    LBAR();
    const float t0_ = tot[d], t1_ = tot[128 + d], t2_ = tot[256 + d], t3_ = tot[384 + d];
    off = (jg > 0 ? t0_ : 0.f) + (jg > 1 ? t1_ : 0.f) + (jg > 2 ? t2_ : 0.f); gref = t0_ + t1_; g63 = (t0_ + t1_) + (t2_ + t3_);
}
constexpr int KST = 136, VST = 264, PST = 72;
DI void load_v_tile(const Ctx& C, const bf16* PROJ, int t0, int h, LAS bf16* VL) {
#pragma unroll
    for (int i = 0; i < 4; ++i) { const int c = C.tid + 512 * i, j = c >> 5, ec = c & 31;
        *(LAS u32x4*)(VL + j * VST + 8 * ec) = *(const u32x4*)(PROJ + (size_t)(t0 + j) * NPROJ + C_V + h * 256 + 8 * ec); }
}
struct GlaIn { f32x4 alv; bf16 qraw[16], kraw[16]; u32x4 vt[4]; };
template <bool WITHQ>
DI void gla_load(const Ctx& C, int idx, const bf16* PROJ, const float* ALOW, GlaIn& in) {
    const int b = idx >> 8, h = (idx >> 6) & 3, n = idx & 63, t0 = b * SEQ + n * 64, d = C.tid & 127, jg = C.tid >> 7;
    in.alv = (f32x4){0.f, 0.f, 0.f, 0.f};
    if (C.tid < 256) in.alv = ((const f32x4*)(ALOW + (size_t)t0 * 16))[C.tid];
#pragma unroll
    for (int jj = 0; jj < 16; ++jj) { const bf16* row = PROJ + (size_t)(t0 + jg * 16 + jj) * NPROJ + h * 128 + d; in.kraw[jj] = row[C_K]; if (WITHQ) in.qraw[jj] = row[C_Q]; }
#pragma unroll
    for (int i = 0; i < 4; ++i) { const int c = C.tid + 512 * i, j = c >> 5, ec = c & 31; in.vt[i] = *(const u32x4*)(PROJ + (size_t)(t0 + j) * NPROJ + C_V + h * 256 + 8 * ec); }
}
DI void store_v_tile(const Ctx& C, const GlaIn& in, LAS bf16* VL) {
#pragma unroll
    for (int i = 0; i < 4; ++i) { const int c = C.tid + 512 * i, j = c >> 5, ec = c & 31; *(LAS u32x4*)(VL + j * VST + 8 * ec) = in.vt[i]; }
}
DI void glaA_phase(const Ctx& C, int l, const bf16* PROJ, const float* ALOW, bf16* SBUF, float* DEC) {
    LAS float* al = (LAS float*)(C.lds); LAS float* tot = (LAS float*)(C.lds + 4096);
    LAS bf16* KD = (LAS bf16*)(C.lds + 8192); LAS bf16* VL = (LAS bf16*)(C.lds + 25600);
    const int d = C.tid & 127, jg = C.tid >> 7, h = (C.bid >> 6) & 3;
    float w2[16];
#pragma unroll
    for (int r = 0; r < 16; ++r) w2[r] = KARG(I_WA2)[(size_t)l * 16 * 512 + r * 512 + h * 128 + d];
    const float bav = KARG(I_BA)[(size_t)l * 512 + h * 128 + d];
    GlaIn cur, nxt;
    gla_load<false>(C, C.bid, PROJ, ALOW, cur);
#pragma unroll 1
    for (int i = 0; i < 4; ++i) {
        const int idx = i * C.G + C.bid;
        float Gl[16], off, gref, g63;
        gla_gates(C, al, tot, cur.alv, w2, bav, Gl, off, gref, g63);
#pragma unroll
        for (int jj = 0; jj < 16; ++jj) { const int j = jg * 16 + jj; KD[j * KST + d] = (bf16)f2bf(bf1(cur.kraw[jj]) * fexp2(g63 - (off + Gl[jj]))); }
        store_v_tile(C, cur, VL);
        LBAR();
        if (i + 1 < 4) gla_load<false>(C, idx + C.G, PROJ, ALOW, nxt);
        if (jg == 0) DEC[(size_t)idx * 128 + d] = fexp2(g63);
        const int lane = C.lane, g = lane >> 4, qq = (lane & 15) >> 2, p = lane & 3, fr = lane & 15;
        bf16x8 A[2];
#pragma unroll
        for (int ks = 0; ks < 2; ++ks) A[ks] = tr8(KD + (32 * ks + 8 * g + qq) * KST + 16 * C.wave + 4 * p, KST);
        bf16* Sit = SBUF + (size_t)idx * 256 * 128;
#pragma unroll
        for (int half = 0; half < 2; ++half) {
            f32x4 acc[8];
#pragma unroll
            for (int nt = 0; nt < 8; ++nt) acc[nt] = (f32x4){0.f, 0.f, 0.f, 0.f};
#pragma unroll
            for (int nt = 0; nt < 8; ++nt)
#pragma unroll
                for (int ks = 0; ks < 2; ++ks) { const bf16x8 Bf = tr8(VL + (32 * ks + 8 * g + qq) * VST + 16 * (half * 8 + nt) + 4 * p, VST); acc[nt] = mfma16(A[ks], Bf, acc[nt]); }
#pragma unroll
            for (int nt = 0; nt < 8; ++nt) { const int e = 16 * (half * 8 + nt) + fr, dd = 16 * C.wave + 4 * g;
                u32x2 w; w.x = pk2(acc[nt][0], acc[nt][1]); w.y = pk2(acc[nt][2], acc[nt][3]); *(u32x2*)(Sit + (size_t)e * 128 + dd) = w; }
        }
        LBAR();
        cur = nxt;
    }
}
DI void scan_phase(const Ctx& C, bf16* SBUF, const float* DEC) {
    const int gt = C.bid * NTHR + C.tid, bh = gt >> 13, rem = gt & 8191, e = rem >> 5, dq = rem & 31;
    u32x2* p = (u32x2*)(SBUF + ((size_t)(bh * 64) * 256 + e) * 128 + 4 * dq);
    const f32x4* dp = (const f32x4*)(DEC + (size_t)(bh * 64) * 128 + 4 * dq);
    f32x4 st = (f32x4){0.f, 0.f, 0.f, 0.f};
#pragma unroll 1
    for (int n0 = 0; n0 < 64; n0 += 8) {
        u32x2 tmp[8]; f32x4 dc[8];
#pragma unroll
        for (int u = 0; u < 8; ++u) { tmp[u] = p[(size_t)(n0 + u) * 8192]; dc[u] = dp[(n0 + u) * 32]; }
#pragma unroll
        for (int u = 0; u < 8; ++u) { u32x2 w; w.x = pk2(st.x, st.y); w.y = pk2(st.z, st.w); p[(size_t)(n0 + u) * 8192] = w;
            st = dc[u] * st + (f32x4){bflo(tmp[u].x), bfhi(tmp[u].x), bflo(tmp[u].y), bfhi(tmp[u].y)}; }
    }
}
DI void glaC_phase(const Ctx& C, int l, const bf16* PROJ, const float* ALOW, const bf16* SBUF, bf16* CONCAT) {
    const int h = (C.bid >> 6) & 3;
    LAS float* al = (LAS float*)(C.lds); LAS float* tot = (LAS float*)(C.lds + 4096); LAS float* RS = (LAS float*)(C.lds + 6144);
    LAS bf16* QT = (LAS bf16*)(C.lds + 8192); LAS bf16* KT = (LAS bf16*)(C.lds + 25600); LAS bf16* QG = (LAS bf16*)(C.lds + 43008);
    LAS bf16* VL = (LAS bf16*)(C.lds + 60416); LAS bf16* PL = (LAS bf16*)(C.lds + 94208);
    const int d = C.tid & 127, jg = C.tid >> 7;
    float w2[16];
#pragma unroll
    for (int r = 0; r < 16; ++r) w2[r] = KARG(I_WA2)[(size_t)l * 16 * 512 + r * 512 + h * 128 + d];
    const float bav = KARG(I_BA)[(size_t)l * 512 + h * 128 + d];
    const float* ng = KARG(I_GNG) + (size_t)(l * 4 + h) * 256;
    GlaIn cur;
    f32x4 alv_n = (f32x4){0.f, 0.f, 0.f, 0.f};
    if (C.tid < 256) alv_n = ((const f32x4*)(ALOW + (size_t)((C.bid >> 8) * SEQ + (C.bid & 63) * 64) * 16))[C.tid];
#pragma unroll 1
    for (int it = 0; it < 4; ++it) {
    const int idx = it * C.G + C.bid, b = idx >> 8, n = idx & 63, t0 = b * SEQ + n * 64;
    gla_load<true>(C, idx, PROJ, ALOW, cur); cur.alv = alv_n;
    float Gl[16], off, gref, g63;
    gla_gates(C, al, tot, cur.alv, w2, bav, Gl, off, gref, g63);
#pragma unroll
    for (int jj = 0; jj < 16; ++jj) { const int j = jg * 16 + jj; const float Gv = off + Gl[jj];
        const float q = bf1(cur.qraw[jj]) * 0.08838834764831845f, k = bf1(cur.kraw[jj]);
        QT[j * KST + d] = (bf16)f2bf(q * fexp2(Gv - gref)); KT[j * KST + d] = (bf16)f2bf(k * fexp2(gref - Gv)); QG[j * KST + d] = (bf16)f2bf(q * fexp2(Gv)); }
    store_v_tile(C, cur, VL);
    const int lane = C.lane, g = lane >> 4, qq = (lane & 15) >> 2, p = lane & 3, fr = lane & 15;
    bf16x8 Sf[2][4]; u32x2 rraw[4][2];
#pragma unroll
    for (int mi = 0; mi < 2; ++mi) { const bf16* Srow = SBUF + ((size_t)idx * 256 + 16 * (2 * C.wave + mi) + fr) * 128 + 8 * g;
#pragma unroll
        for (int ks = 0; ks < 4; ++ks) Sf[mi][ks] = *(const bf16x8*)(Srow + 32 * ks); }
#pragma unroll
    for (int nt = 0; nt < 4; ++nt)
#pragma unroll
        for (int mi = 0; mi < 2; ++mi) rraw[nt][mi] = *(const u32x2*)(PROJ + (size_t)(t0 + 16 * nt + fr) * NPROJ + C_R + h * 256 + 16 * (2 * C.wave + mi) + 4 * g);
    LBAR();
    {
        const int nt = C.wave & 3;
#pragma unroll
        for (int mi = 0; mi < 2; ++mi) { const int mt = 2 * (C.wave >> 2) + mi; f32x4 acc = (f32x4){0.f, 0.f, 0.f, 0.f};
#pragma unroll
            for (int ks = 0; ks < 4; ++ks) { const bf16x8 a = *(const LAS bf16x8*)(KT + (16 * mt + fr) * KST + 32 * ks + 8 * g), bq = *(const LAS bf16x8*)(QT + (16 * nt + fr) * KST + 32 * ks + 8 * g); acc = mfma16(a, bq, acc); }
            const int i = 16 * nt + fr, j0 = 16 * mt + 4 * g;
            const float v0 = (j0 + 0 <= i) ? acc[0] : 0.f, v1 = (j0 + 1 <= i) ? acc[1] : 0.f, v2 = (j0 + 2 <= i) ? acc[2] : 0.f, v3 = (j0 + 3 <= i) ? acc[3] : 0.f;
            u32x2 w; w.x = pk2(v0, v1); w.y = pk2(v2, v3); *(LAS u32x2*)(PL + i * PST + j0) = w; }
    }
    LBAR();
    f32x4 acc[2][4];
#pragma unroll
    for (int mi = 0; mi < 2; ++mi)
#pragma unroll
        for (int nt = 0; nt < 4; ++nt) acc[mi][nt] = (f32x4){0.f, 0.f, 0.f, 0.f};
#pragma unroll
    for (int mi = 0; mi < 2; ++mi) { const int mt = 2 * C.wave + mi;
#pragma unroll
        for (int ks = 0; ks < 2; ++ks) { const bf16x8 a = tr8(VL + (32 * ks + 8 * g + qq) * VST + 16 * mt + 4 * p, VST);
#pragma unroll
            for (int nt = 0; nt < 4; ++nt) { const bf16x8 bp = *(const LAS bf16x8*)(PL + (16 * nt + fr) * PST + 32 * ks + 8 * g); acc[mi][nt] = mfma16(a, bp, acc[mi][nt]); } }
#pragma unroll
        for (int ks = 0; ks < 4; ++ks) { const bf16x8 a = Sf[mi][ks];
#pragma unroll
            for (int nt = 0; nt < 4; ++nt) { const bf16x8 bq = *(const LAS bf16x8*)(QG + (16 * nt + fr) * KST + 32 * ks + 8 * g); acc[mi][nt] = mfma16(a, bq, acc[mi][nt]); } }
    }
#pragma unroll
    for (int nt = 0; nt < 4; ++nt) { float s = 0.f;
#pragma unroll
        for (int mi = 0; mi < 2; ++mi) s += (acc[mi][nt][0] * acc[mi][nt][0] + acc[mi][nt][1] * acc[mi][nt][1]) + (acc[mi][nt][2] * acc[mi][nt][2] + acc[mi][nt][3] * acc[mi][nt][3]);
        s += __shfl_xor(s, 16); s += __shfl_xor(s, 32);
        if (g == 0) RS[C.wave * 64 + 16 * nt + fr] = s; }
    LBAR();
    if (it + 1 < 4 && C.tid < 256) { const int ix = idx + C.G; alv_n = ((const f32x4*)(ALOW + (size_t)((ix >> 8) * SEQ + (ix & 63) * 64) * 16))[C.tid]; }
#pragma unroll
    for (int nt = 0; nt < 4; ++nt) { const int i = 16 * nt + fr; float ts = 0.f;
#pragma unroll
        for (int w = 0; w < 8; ++w) ts += RS[w * 64 + i];
        const float rstd = frsq(ts * (1.f / 256.f) + EPS);
#pragma unroll
        for (int mi = 0; mi < 2; ++mi) { const int e = 16 * (2 * C.wave + mi) + 4 * g;
            const u32x2 rr = rraw[nt][mi]; const f32x4 gg = *(const f32x4*)(ng + e);
            const float o0 = acc[mi][nt][0] * rstd * gg.x * silu_f(bflo(rr.x)), o1 = acc[mi][nt][1] * rstd * gg.y * silu_f(bfhi(rr.x));
            const float o2 = acc[mi][nt][2] * rstd * gg.z * silu_f(bflo(rr.y)), o3 = acc[mi][nt][3] * rstd * gg.w * silu_f(bfhi(rr.y));
            u32x2 w; w.x = pk2(o0, o1); w.y = pk2(o2, o3); *(u32x2*)(CONCAT + (size_t)(t0 + i) * D + h * 256 + e) = w; } }
    LBAR();
    }
}
constexpr int GST = 136;
DI void gmlp_phase(const Ctx& C, int l, const bf16* PROJ, const bf16* WSB, bf16* CONCAT) {
    const int h = C.bid & 7;
    LAS bf16* VL2 = (LAS bf16*)(C.lds); LAS bf16* UL = (LAS bf16*)(C.lds + 34816);
    const float* vg = KARG(I_VNG) + (size_t)(l * 8 + h) * 128; const float* og = KARG(I_MOG) + (size_t)(l * 8 + h) * 128; const float* bb = KARG(I_MB) + (size_t)(l * 8 + h) * 128;
    bf16x8 Wf[4];
    { const bf16* Wrow = WSB + ((size_t)(l * 8 + h) * 128 + 16 * C.wave + (C.lane & 15)) * 128 + 8 * (C.lane >> 4);
#pragma unroll
      for (int ks = 0; ks < 4; ++ks) Wf[ks] = *(const bf16x8*)(Wrow + 32 * ks); }
    u32x4 cu[4], cv[4], nu[4], nv[4];
#define GM_LOAD(IDX, U, V) do { const int t0_ = ((IDX) >> 8) * SEQ + (((IDX) >> 3) & 31) * 128; _Pragma("unroll") for (int i = 0; i < 4; ++i) { const int c = C.tid + 512 * i, t = c >> 4, ch = c & 15; \
        const bf16* row = PROJ + (size_t)(t0_ + t) * NPROJ + h * 128 + 8 * ch; U[i] = *(const u32x4*)(row + C_U); V[i] = *(const u32x4*)(row + C_VS); } } while (0)
    GM_LOAD(C.bid, cu, cv);
#pragma unroll 1
    for (int it = 0; it < 4; ++it) {
    const int idx = it * C.G + C.bid, n = (idx >> 3) & 31, b = idx >> 8, t0 = b * SEQ + n * 128;
#pragma unroll
    for (int i = 0; i < 4; ++i) { const int c = C.tid + 512 * i, t = c >> 4, ch = c & 15;
        const u32x4 uu = cu[i], vv = cv[i];
        float v[8] = {gelu_t(bflo(vv.x)), gelu_t(bfhi(vv.x)), gelu_t(bflo(vv.y)), gelu_t(bfhi(vv.y)), gelu_t(bflo(vv.z)), gelu_t(bfhi(vv.z)), gelu_t(bflo(vv.w)), gelu_t(bfhi(vv.w))};
        float ss = 0.f;
#pragma unroll
        for (int k = 0; k < 8; ++k) ss += v[k] * v[k];
        ss += __shfl_xor(ss, 1); ss += __shfl_xor(ss, 2); ss += __shfl_xor(ss, 4); ss += __shfl_xor(ss, 8);
        const float rstd = frsq(ss * (1.f / 128.f) + EPS);
        const f32x4 g0 = *(const f32x4*)(vg + 8 * ch), g1 = *(const f32x4*)(vg + 8 * ch + 4);
        u32x4 wv; wv.x = pk2(v[0] * rstd * g0.x, v[1] * rstd * g0.y); wv.y = pk2(v[2] * rstd * g0.z, v[3] * rstd * g0.w); wv.z = pk2(v[4] * rstd * g1.x, v[5] * rstd * g1.y); wv.w = pk2(v[6] * rstd * g1.z, v[7] * rstd * g1.w);
        *(LAS u32x4*)(VL2 + t * GST + 8 * ch) = wv;
        u32x4 wu; wu.x = pk2(gelu_t(bflo(uu.x)), gelu_t(bfhi(uu.x))); wu.y = pk2(gelu_t(bflo(uu.y)), gelu_t(bfhi(uu.y))); wu.z = pk2(gelu_t(bflo(uu.z)), gelu_t(bfhi(uu.z))); wu.w = pk2(gelu_t(bflo(uu.w)), gelu_t(bfhi(uu.w)));
        *(LAS u32x4*)(UL + t * GST + 8 * ch) = wu; }
    LBAR();
    if (it + 1 < 4) GM_LOAD(idx + C.G, nu, nv);
    const int lane = C.lane, g = lane >> 4, qq = (lane & 15) >> 2, p = lane & 3, fr = lane & 15;
    f32x4 acc[8];
#pragma unroll
    for (int mt = 0; mt < 8; ++mt) acc[mt] = (f32x4){0.f, 0.f, 0.f, 0.f};
    const int nks = (C.wave >> 1) + 1;
#pragma unroll
    for (int ks = 0; ks < 4; ++ks) if (ks < nks) { const bf16x8 bw = Wf[ks];
#pragma unroll
        for (int mt = 0; mt < 8; ++mt) { const bf16x8 a = tr8(VL2 + (32 * ks + 8 * g + qq) * GST + 16 * mt + 4 * p, GST); acc[mt] = mfma16(a, bw, acc[mt]); } }
    const int tl = 16 * C.wave + fr; const float bt = bb[tl]; float ss = 0.f;
#pragma unroll
    for (int mt = 0; mt < 8; ++mt) { const u32x2 uu = *(const LAS u32x2*)(UL + tl * GST + 16 * mt + 4 * g);
        acc[mt][0] = bflo(uu.x) * (acc[mt][0] + bt); acc[mt][1] = bfhi(uu.x) * (acc[mt][1] + bt); acc[mt][2] = bflo(uu.y) * (acc[mt][2] + bt); acc[mt][3] = bfhi(uu.y) * (acc[mt][3] + bt);
        ss += (acc[mt][0] * acc[mt][0] + acc[mt][1] * acc[mt][1]) + (acc[mt][2] * acc[mt][2] + acc[mt][3] * acc[mt][3]); }
    ss += __shfl_xor(ss, 16); ss += __shfl_xor(ss, 32);
    const float rstd = frsq(ss * (1.f / 128.f) + EPS);
#pragma unroll
    for (int mt = 0; mt < 8; ++mt) { const f32x4 gg = *(const f32x4*)(og + 16 * mt + 4 * g);
        u32x2 w; w.x = pk2(acc[mt][0] * rstd * gg.x, acc[mt][1] * rstd * gg.y); w.y = pk2(acc[mt][2] * rstd * gg.z, acc[mt][3] * rstd * gg.w);
        *(u32x2*)(CONCAT + (size_t)(t0 + tl) * D + 1024 + h * 128 + 16 * mt + 4 * g) = w; }
    LBAR();
#pragma unroll
    for (int i = 0; i < 4; ++i) { cu[i] = nu[i]; cv[i] = nv[i]; }
    }
#undef GM_LOAD
}
DI void list_insert(float (&L)[16], float x) {
#pragma unroll
    for (int i = 15; i >= 1; --i) L[i] = __builtin_amdgcn_fmed3f(x, L[i - 1], L[i]);
    L[0] = fmaxf(L[0], x);
}
DI void list_merge_xor(float (&L)[16], int mask) {
    float M[16];
#pragma unroll
    for (int i = 0; i < 16; ++i) M[i] = fmaxf(L[i], __shfl_xor(L[15 - i], mask));
#pragma unroll
    for (int s = 8; s >= 1; s >>= 1)
#pragma unroll
        for (int i = 0; i < 16; ++i) if ((i & s) == 0) { const float hi = fmaxf(M[i], M[i + s]), lo = fminf(M[i], M[i + s]); M[i] = hi; M[i + s] = lo; }
#pragma unroll
    for (int i = 0; i < 16; ++i) L[i] = M[i];
}
DI unsigned fbits(float x) { return __builtin_bit_cast(unsigned, x); }
DI float unp7(float x) { return __builtin_bit_cast(float, __builtin_bit_cast(unsigned, x) & 0xFFFFFF80u); }
constexpr int TKST = 136;
DI void topk_phase(const Ctx& C, int l, const bf16* QB, const bf16* K1B, const bf16* K2B, const int* KU, const int* KV, int* EB, float* PG) {
    LAS bf16* KL = (LAS bf16*)C.lds;
    LAS unsigned* tk = (LAS unsigned*)(C.lds + 2 * 128 * TKST * 2 + C.wave * 2048);
    const int lane = C.lane, fr = lane & 15, fq = lane >> 4, h = C.bid & 7, rank = C.bid >> 3;
#pragma unroll
    for (int i = 0; i < 8; ++i) { const int c = C.tid + 512 * i, tb = c >> 11, row = (c & 2047) >> 4, ch = c & 15;
        *(LAS u32x4*)(KL + (tb * 128 + row) * TKST + 8 * ch) = *(const u32x4*)((tb ? K2B : K1B) + ((size_t)(l * 8 + h) * 128 + row) * 128 + 8 * ch); }
    __syncthreads();
#pragma unroll 1
    for (int it = 0; it < 4; ++it) {
        const int tt0 = rank * 512 + C.wave * 64 + it * 16;
        float L[2][16];
        bf16x8 bq[2][4];
#pragma unroll
        for (int half = 0; half < 2; ++half)
#pragma unroll
            for (int ks = 0; ks < 4; ++ks) bq[half][ks] = *(const bf16x8*)(QB + (size_t)(tt0 + fr) * D + h * 256 + half * 128 + 8 * fq + 32 * ks);
#pragma unroll
        for (int half = 0; half < 2; ++half) {
            f32x4 acc[8];
#pragma unroll
            for (int mt = 0; mt < 8; ++mt) acc[mt] = (f32x4){0.f, 0.f, 0.f, 0.f};
            const LAS bf16* Kb = KL + (half * 128 + fr) * TKST + 8 * fq;
#pragma unroll
            for (int ks = 0; ks < 4; ++ks)
#pragma unroll
                for (int mt = 0; mt < 8; ++mt) { const bf16x8 a = *(const LAS bf16x8*)(Kb + (16 * mt) * TKST + 32 * ks); acc[mt] = mfma16(a, bq[half][ks], acc[mt]); }
#pragma unroll
            for (int i = 0; i < 16; ++i) L[half][i] = __builtin_bit_cast(float, 0xFF800000u);
#pragma unroll
            for (int mt = 0; mt < 8; ++mt)
#pragma unroll
                for (int r = 0; r < 4; ++r) { const unsigned key = (unsigned)(16 * mt + 4 * fq + r);
                    const float sv = acc[mt][r];
                    list_insert(L[half], __builtin_bit_cast(float, (fbits(sv) & 0xFFFFFF80u) | key)); }
            list_merge_xor(L[half], 16); list_merge_xor(L[half], 32);
        }
        if (fq == 0) {
#pragma unroll
            for (int i = 0; i < 16; ++i) { tk[(fr * 2 + 0) * 16 + i] = fbits(L[0][i]); tk[(fr * 2 + 1) * 16 + i] = fbits(L[1][i]); }
        }
        float Cn[16];
#pragma unroll
        for (int i = 0; i < 16; ++i) Cn[i] = __builtin_bit_cast(float, 0xFF800000u);
#pragma unroll
        for (int i = 0; i < 16; ++i)
#pragma unroll
            for (int j = 0; j < 16; ++j) if ((i + 1) * (j + 1) <= 16) {
                const float s = unp7(L[0][i]) + unp7(L[1][j]);
                list_insert(Cn, __builtin_bit_cast(float, (fbits(s) & 0xFFFFFF00u) | (unsigned)(i * 16 + j))); }
        LDS_WAIT();
        float sc[4]; int ex[4];
#pragma unroll
        for (int m = 0; m < 4; ++m) {
            const float ck = fq == 0 ? Cn[m] : (fq == 1 ? Cn[4 + m] : (fq == 2 ? Cn[8 + m] : Cn[12 + m]));
            const unsigned cc = fbits(ck) & 255u;
            const unsigned p1 = tk[(fr * 2 + 0) * 16 + (cc >> 4)], p2 = tk[(fr * 2 + 1) * 16 + (cc & 15u)];
            sc[m] = __builtin_bit_cast(float, p1 & 0xFFFFFF80u) + __builtin_bit_cast(float, p2 & 0xFFFFFF80u);
            ex[m] = (int)((p1 & 127u) * 128u + (p2 & 127u));
        }
        float mx = fmaxf(fmaxf(sc[0], sc[1]), fmaxf(sc[2], sc[3]));
        mx = fmaxf(mx, __shfl_xor(mx, 16)); mx = fmaxf(mx, __shfl_xor(mx, 32));
        float w[4], sum = 0.f;
#pragma unroll
        for (int m = 0; m < 4; ++m) { w[m] = fexp2((sc[m] - mx) * 1.442695041f); sum += w[m]; }
        sum += __shfl_xor(sum, 16); sum += __shfl_xor(sum, 32);
        const float inv = 1.0f / sum;
        const size_t o = (size_t)(tt0 + fr) * 128 + h * 16 + 4 * fq;
#pragma unroll
        for (int m = 0; m < 4; ++m) { const int ku = KU[ex[m]], kv = KV[ex[m]]; w[m] = w[m] * inv * __builtin_bit_cast(float, (unsigned)(127 - kv) << 23); ex[m] |= (127 - ku) << 16; }
        *(int4*)(EB + o) = make_int4(ex[0], ex[1], ex[2], ex[3]);
        *(f32x4*)(PG + o) = (f32x4){w[0], w[1], w[2], w[3]};
        LDS_WAIT();
    }
}
typedef unsigned char fp8_t;
DI void unpack16(const u32x4 q, float (&f)[16]) {
#pragma unroll
    for (int w = 0; w < 4; ++w) { const int dw = (int)q[w]; const f32x2 lo = __builtin_amdgcn_cvt_pk_f32_fp8(dw, false), hi = __builtin_amdgcn_cvt_pk_f32_fp8(dw, true);
        f[4 * w] = lo.x; f[4 * w + 1] = lo.y; f[4 * w + 2] = hi.x; f[4 * w + 3] = hi.y; }
}
typedef long i64_t;
DI f32x4 sel4(bool c, const f32x4 a, const f32x4 b) { return (f32x4){c ? a.x : b.x, c ? a.y : b.y, c ? a.z : b.z, c ? a.w : b.w}; }
constexpr int PU_RST = 272, PU_TILE = 16 * PU_RST, PU_WAVE = 2 * PU_TILE;
DI void peerU_phase(const Ctx& C, const unsigned char* H8, const int* EB, const fp8_t* PU8, float* PART, const int emask = 0xFFFF) {
    const int x = C.bid & 7, rank = C.bid >> 3, lane = C.lane, kq = lane >> 4, m16 = lane & 15;
    const __amdgpu_buffer_rsrc_t trs = __builtin_amdgcn_make_buffer_rsrc((void*)(PU8 + (size_t)x * NEXP * 256), 0, NEXP * 256, 0x00020000);
    float* part = PART + (size_t)x * T * 128;
    const int tbase = rank * 512 + C.wave * 64;
    const int* ebase = EB + (size_t)tbase * 128 + lane;
    const unsigned char* hbase = H8 + (size_t)tbase * 4096 + (m16 & 1) * 2048 + 256 * x + 8 * kq;
    ldsp wl = C.lds + C.wave * PU_WAVE;
    const int wr_off = kq * PU_RST + 16 * m16;
    const int rd_off = m16 * PU_RST + 8 * kq;
    const int bp0 = 4 * kq;
    int ept0 = ebase[0], ept1 = ebase[64];
    int ep0 = ebase[128], ep1 = ebase[192];
    u32x2 hc[8], hn[8];
#pragma unroll
    for (int c = 0; c < 8; ++c) { hc[c] = *(const u32x2*)(hbase + 32 * c); hn[c] = hc[c]; }
    u32x4 r0[8], r1[8], r2[8], r3[8];
#define PU_ISSUE(BUF, ESEL, Q1) do { _Pragma("unroll") for (int i_ = 0; i_ < 8; ++i_) { const int ad_ = (bp0 + 4 * (32 * (Q1) + 4 * i_)) & 255; \
        const int e_ = __builtin_amdgcn_ds_bpermute(ad_, (ESEL)) & emask; BUF[i_] = __builtin_amdgcn_raw_buffer_load_b128(trs, e_ * 256 + 16 * m16, 0, 0); } } while (0)
#define PU_STEP(BUF, T0) do { _Pragma("unroll") for (int i_ = 0; i_ < 8; ++i_) *(LAS u32x4*)(wl + wr_off + (i_ >> 2) * PU_TILE + (i_ & 3) * 4 * PU_RST) = BUF[i_]; \
        _Pragma("unroll") for (int tt = 0; tt < 2; ++tt) _Pragma("unroll") for (int c = 0; c < 8; ++c) { const u32x2 av_ = *(const LAS u32x2*)(wl + rd_off + tt * PU_TILE + 32 * c); \
            acc[(T0) + tt] = __builtin_amdgcn_mfma_f32_16x16x32_fp8_fp8((i64_t)(((unsigned long long)av_.y << 32) | av_.x), (i64_t)(((unsigned long long)hc[c].y << 32) | hc[c].x), acc[(T0) + tt], 0, 0, 0); } } while (0)
    PU_ISSUE(r0, ept0, 0); PU_ISSUE(r1, ept0, 1); PU_ISSUE(r2, ept1, 2); PU_ISSUE(r3, ept1, 3);
    f32x2 pend = (f32x2){0.f, 0.f}; f32x2* pend_p = nullptr;
#pragma unroll 1
    for (int ti = 0; ti < 64; ++ti) {
        const int t = tbase + ti; const bool more = ti + 1 < 64;
        int epn0 = 0, epn1 = 0;
        if (ti + 2 < 64) { epn0 = ebase[(ti + 2) * 128]; epn1 = ebase[(ti + 2) * 128 + 64]; }
        if (more) {
#pragma unroll
            for (int c = 0; c < 8; ++c) hn[c] = *(const u32x2*)(hbase + (size_t)(ti + 1) * 4096 + 32 * c); }
        f32x4 acc[8];
#pragma unroll
        for (int tl = 0; tl < 8; ++tl) acc[tl] = (f32x4){0.f, 0.f, 0.f, 0.f};
        PU_STEP(r0, 0); if (more) PU_ISSUE(r0, ep0, 0);
        if (ti > 0) *pend_p = pend;
        PU_STEP(r1, 2); if (more) PU_ISSUE(r1, ep0, 1);
        PU_STEP(r2, 4); if (more) PU_ISSUE(r2, ep1, 2);
        PU_STEP(r3, 6); if (more) PU_ISSUE(r3, ep1, 3);
        {   const int n = m16, rg = kq;
            const f32x4 s01 = sel4((n >> 1) & 1, acc[1], acc[0]), s23 = sel4((n >> 1) & 1, acc[3], acc[2]), s45 = sel4((n >> 1) & 1, acc[5], acc[4]), s67 = sel4((n >> 1) & 1, acc[7], acc[6]);
            const f32x4 s03 = sel4((n >> 2) & 1, s23, s01), s47 = sel4((n >> 2) & 1, s67, s45), sv = sel4((n >> 3) & 1, s47, s03);
            const float p0 = dppf<0xB1>(sv.x), p1 = dppf<0xB1>(sv.y), p2 = dppf<0xB1>(sv.z), p3 = dppf<0xB1>(sv.w);
            const bool odd = n & 1;
            const float o0 = odd ? (p2 + sv.z * 0.0625f) : (sv.x + p0 * 0.0625f), o1 = odd ? (p3 + sv.w * 0.0625f) : (sv.y + p1 * 0.0625f);
            pend = (f32x2){o0 * 0.0625f, o1 * 0.0625f}; pend_p = (f32x2*)(part + (size_t)t * 128 + 16 * (n >> 1) + 4 * rg + 2 * (n & 1)); }
        ep0 = epn0; ep1 = epn1;
#pragma unroll
        for (int c = 0; c < 8; ++c) hc[c] = hn[c];
    }
    *pend_p = pend;
#undef PU_ISSUE
#undef PU_STEP
}
typedef int v2i32_t __attribute__((ext_vector_type(2)));
constexpr int PV_TILE = 32 * PU_RST, PV_A8 = PV_TILE, PV_Y = PV_TILE + 256, PV_WAVE = 10240;
DI float wave_max_u(float v) {
    v = fmaxf(v, dppf<0xB1>(v)); v = fmaxf(v, dppf<0x4E>(v)); v = fmaxf(v, dppf<0x141>(v)); v = fmaxf(v, dppf<0x140>(v));
    const int iv = __builtin_bit_cast(int, v);
    return fmaxf(fmaxf(__builtin_bit_cast(float, __builtin_amdgcn_readlane(iv, 0)), __builtin_bit_cast(float, __builtin_amdgcn_readlane(iv, 16))),
                 fmaxf(__builtin_bit_cast(float, __builtin_amdgcn_readlane(iv, 32)), __builtin_bit_cast(float, __builtin_amdgcn_readlane(iv, 48))));
}
DI void peerV_phase(const Ctx& C, const int* EB, const float* PG, const float* PART, const fp8_t* PV8, float* X, const float* gate  , const int emask = 0xFFFF, const int FAKE = 0) {
    const int x = C.bid & 7, rank = C.bid >> 3, lane = C.lane, kq = lane >> 4, m16 = lane & 15;
    const fp8_t* tab = PV8 + (size_t)x * NEXP * 256 + 16 * m16;
    const int tbase = rank * 512 + C.wave * 64;
    ldsp wl = C.lds + C.wave * PV_WAVE;
    const int wr_off = kq * PU_RST + 16 * m16;
    const int tr_off = (8 * kq + (m16 >> 1)) * PU_RST + 8 * (m16 & 1);
    const int a_off = PV_A8 + (m16 & 1) * 128 + 8 * kq;
    const int bp0 = 4 * kq;
    float pr0[8], pr1[8]; int rep0, rep1; float rg0, rg1;
#define PV_LOAD_RAW(tt) do { _Pragma("unroll") for (int xx = 0; xx < 8; ++xx) { const float* pp = PART + ((size_t)xx * T + (tt)) * 128 + lane; pr0[xx] = pp[0]; pr1[xx] = pp[64]; } \
        rep0 = EB[(size_t)(tt) * 128 + lane]; rep1 = EB[(size_t)(tt) * 128 + 64 + lane]; rg0 = PG[(size_t)(tt) * 128 + lane]; rg1 = PG[(size_t)(tt) * 128 + 64 + lane]; } while (0)
#define PV_FINISH(A0, A1, E0, E1) do { const float s0_ = ((pr0[0] + pr0[1]) + (pr0[2] + pr0[3])) + ((pr0[4] + pr0[5]) + (pr0[6] + pr0[7])), s1_ = ((pr1[0] + pr1[1]) + (pr1[2] + pr1[3])) + ((pr1[4] + pr1[5]) + (pr1[6] + pr1[7])); \
        A0 = gelu_t(s0_ * __builtin_bit_cast(float, (unsigned)(rep0 >> 16) << 23)) * rg0; A1 = gelu_t(s1_ * __builtin_bit_cast(float, (unsigned)(rep1 >> 16) << 23)) * rg1; E0 = (rep0 & emask) * 256; E1 = (rep1 & emask) * 256; } while (0)
    float a0, a1, a0n = 0.f, a1n = 0.f; int e0, e1, e0n = 0, e1n = 0;
    PV_LOAD_RAW(tbase); PV_FINISH(a0, a1, e0, e1);
    PV_LOAD_RAW(tbase + 1);
    u32x4 ra[8], rb[8];
#define PV_ISSUE(BUF, ESEL, Q1) do { _Pragma("unroll") for (int i_ = 0; i_ < 8; ++i_) { const int ad_ = (bp0 + 4 * (32 * (Q1) + 4 * i_)) & 255; \
        const int eo_ = __builtin_amdgcn_ds_bpermute(ad_, (ESEL)); BUF[i_] = *(const u32x4*)(tab + eo_); } } while (0)
#define PV_STEP(BUF, KS) do { _Pragma("unroll") for (int i_ = 0; i_ < 8; ++i_) *(LAS u32x4*)(wl + wr_off + i_ * 4 * PU_RST) = BUF[i_]; \
        const u32x2 ao_ = *(const LAS u32x2*)(wl + a_off + 32 * (KS)); const i64_t aop_ = (i64_t)(((unsigned long long)ao_.y << 32) | ao_.x); \
        _Pragma("unroll") for (int nt = 0; nt < 16; ++nt) { const v2i32_t bv_ = __builtin_amdgcn_ds_read_tr8_b64_v2i32((LAS v2i32_t*)(wl + tr_off + 16 * nt)); \
            acc[nt] = __builtin_amdgcn_mfma_f32_16x16x32_fp8_fp8(aop_, (i64_t)(((unsigned long long)(unsigned)bv_[1] << 32) | (unsigned)bv_[0]), acc[nt], 0, 0, 0); } } while (0)
    PV_ISSUE(ra, e0, 0);
    f32x4 xpend = (f32x4){0.f, 0.f, 0.f, 0.f}; f32x4* xpend_p = nullptr;
#pragma unroll 1
    for (int ti = 0; ti < 64; ++ti) {
        const int t = tbase + ti;
        const float amax = wave_max_u(fmaxf(fabsf(a0), fabsf(a1)));
        int ka = 0; if (amax > 0.f) { ka = (int)((__builtin_bit_cast(unsigned, 224.0f / amax) >> 23) & 255u) - 127; ka = ka < -100 ? -100 : (ka > 100 ? 100 : ka); }
        const float sca = __builtin_bit_cast(float, (unsigned)(ka + 127) << 23), inva = __builtin_bit_cast(float, (unsigned)(127 - ka) << 23);
        {   const float s0 = a0 * sca, s1 = a1 * sca;
            const int ph = __builtin_amdgcn_cvt_pk_fp8_f32(s0, s1, 0, false); const f32x2 bk = __builtin_amdgcn_cvt_pk_f32_fp8(ph, false);
            const int pl = __builtin_amdgcn_cvt_pk_fp8_f32((s0 - bk.x) * 16.0f, (s1 - bk.y) * 16.0f, 0, false);
            LAS unsigned char* a8 = (LAS unsigned char*)(wl + PV_A8);
            a8[lane] = (unsigned char)(ph & 255); a8[64 + lane] = (unsigned char)((ph >> 8) & 255); a8[128 + lane] = (unsigned char)(pl & 255); a8[192 + lane] = (unsigned char)((pl >> 8) & 255); }
        f32x4 acc[16];
#pragma unroll
        for (int nt = 0; nt < 16; ++nt) acc[nt] = (f32x4){0.f, 0.f, 0.f, 0.f};
        const int col = 256 * x + 4 * lane, b = t >> 12;
        f32x4* xp = (f32x4*)(X + (size_t)t * D + col);
        f32x4 xold = (f32x4){0.f, 0.f, 0.f, 0.f}; if (!FAKE) xold = *xp;
        const f32x4 gt = *(const f32x4*)(gate + (size_t)b * MODW + col);
        PV_ISSUE(rb, e0, 1);
        if (ti > 0 && !FAKE) *xpend_p = xpend;
        PV_STEP(ra, 0);
        PV_ISSUE(ra, e1, 2); PV_STEP(rb, 1);
        if (ti + 1 < 64) PV_FINISH(a0n, a1n, e0n, e1n);
        PV_ISSUE(rb, e1, 3); PV_STEP(ra, 2);
        if (ti + 2 < 64) PV_LOAD_RAW(t + 2);
        if (ti + 1 < 64) PV_ISSUE(ra, e0n, 0);
        PV_STEP(rb, 3);
        if (kq == 0) {
#pragma unroll
            for (int nt = 0; nt < 16; ++nt) *(LAS float*)(wl + PV_Y + 4 * (16 * nt + m16)) = (acc[nt][0] + acc[nt][1] * 0.0625f) * inva; }
        const f32x4 y = *(const LAS f32x4*)(wl + PV_Y + 16 * lane);
        if (FAKE) { if (y.x == 123.456f) *xp = y; }
        xpend = xold + gt * y; xpend_p = xp;
        a0 = a0n; a1 = a1n; e0 = e0n; e1 = e1n;
    }
    if (!FAKE) *xpend_p = xpend;
#undef PV_LOAD_RAW
#undef PV_FINISH
#undef PV_ISSUE
#undef PV_STEP
}
DI void final_norm_phase(const Ctx& C, float* X, const float* g) {
    const int r0 = C.gw * 8;
    f32x4 gm[8];
#pragma unroll
    for (int j = 0; j < 8; ++j) gm[j] = ((const f32x4*)g)[64 * j + C.lane];
#pragma unroll 1
    for (int i = 0; i < 8; ++i) {
        f32x4* xr = (f32x4*)(X + (size_t)(r0 + i) * D) + C.lane; f32x4 v[8]; float s = 0.f;
#pragma unroll
        for (int j = 0; j < 8; ++j) { v[j] = xr[64 * j]; s += (v[j].x * v[j].x + v[j].y * v[j].y) + (v[j].z * v[j].z + v[j].w * v[j].w); }
        const float rstd = frsq(wave_sum(s) * (1.f / D) + EPS);
#pragma unroll
        for (int j = 0; j < 8; ++j) xr[64 * j] = v[j] * rstd * gm[j];
    }
}
#ifndef PH_MASK
#define PH_MASK 0xFFFFF
#endif
#define EN(k) (((PH_MASK) >> (k)) & 1)
#ifndef GEMM_SP2
#define GEMM_SP2 true
#endif
#ifndef GEMM_ALIGN
#define GEMM_ALIGN false
#endif
constexpr int NKIND = 11, NPH = 2 + 2 * NKIND;
struct Args { const float* in[21]; float* out; unsigned char* ws; int ph_lo, ph_hi, pad0, pad1; };
__global__ void __launch_bounds__(NTHR, 2) mk_fwd(Args args) {
    extern __shared__ __attribute__((aligned(16))) unsigned char lds_raw[];
    ldsp ldsb = (ldsp)lds_raw;
    volatile LAS unsigned* MISC = (volatile LAS unsigned*)(ldsb + MISC_OFF);
    for (int u = threadIdx.x; u < (LDS_BYTES - LDSCTL_OFF) / 4; u += NTHR) ((LAS unsigned*)(ldsb + LDSCTL_OFF))[u] = 0u;
    __syncthreads();
    unsigned* barw = (unsigned*)(args.ws + WS_CTL) + CW_BAR;
    XcdBarrier bar; bar.bar = barw; bar.x = 0; bar.st = nullptr;
    const bool multi = (args.ph_hi - args.ph_lo) > 1;
    if (multi) bar = xcd_barrier_post(barw, MISC + 8);

    int repflag = 0; (void)repflag;
#pragma unroll 1
    for (int ph = args.ph_lo; ph < args.ph_hi; ++ph) {
#define MKCTX Ctx C; { int tid_ = threadIdx.x, bid_ = blockIdx.x; asm volatile("" : "+v"(tid_)); asm volatile("" : "+s"(bid_)); \
        C.lds = ldsb; C.tid = tid_; C.lane = tid_ & 63; C.wave = __builtin_amdgcn_readfirstlane(tid_ >> 6); C.bid = bid_; C.G = gridDim.x; C.gw = C.bid * NWAVES + C.wave; C.NGW = C.G * NWAVES; \
        C.ws = args.ws; }
        unsigned char* const wsb = args.ws;
        float* MOD = (float*)(wsb + WS_MOD);
        bf16* Hb = (bf16*)(wsb + WS_H); bf16* PROJ = (bf16*)(wsb + WS_PROJ); bf16* SBUF = (bf16*)(wsb + WS_SBUF); bf16* CONCAT = (bf16*)(wsb + WS_CONCAT); bf16* QB = (bf16*)(wsb + WS_QB);
        float* ALOW = (float*)(wsb + WS_ALOW); float* DEC = (float*)(wsb + WS_DEC); int* EB = (int*)(wsb + WS_EB); float* PG = (float*)(wsb + WS_PG);
        float* X = args.out;
        const int l = ph < 2 ? 0 : (ph - 2) / NKIND, kind = ph < 2 ? -1 : (ph - 2) % NKIND;
        const float* modl = MOD + (size_t)l * 4 * MODW;
        if (ph == 0) { if (EN(0)) { MKCTX; p0_prologue(C); } }
        else if (ph == 1) { if (EN(1)) { MKCTX; norm_phase(C, KARG(I_X), KARG(I_N1G), modl, 0, D, Hb); } }
        else if ((kind == 0 || kind == 6) && EN(2)) {
            MKCTX; const bool isq = (kind == 6);
            pg8::Gemm g{Hb, isq ? (const bf16*)(wsb + WS_WTQ) + (size_t)l * D * D : (const bf16*)(wsb + WS_WTIN) + (size_t)l * WTIN_L, T, isq ? D : NPROJ, D};
            pg8::StaticOrder S; S.init(T, g.N, C.G, C.bid);
            pg8::EpiBf16 E{isq ? QB : PROJ, isq ? D : NPROJ};
            pg8::gemm_phase<pg8::EpiBf16, pg8::StaticOrder, GEMM_ALIGN, GEMM_SP2>(C.lds, g, S, E, C.tid);
            if (!isq) alow_phase(C, Hb, (const bf16*)(wsb + WS_WTIN) + (size_t)l * WTIN_L + (size_t)NPROJ * D, ALOW);
#ifdef DBG_DUP_ALOW
            if (!isq) { alow_phase(C, Hb, (const bf16*)(wsb + WS_WTIN) + (size_t)l * WTIN_L + (size_t)NPROJ * D, ALOW); alow_phase(C, Hb, (const bf16*)(wsb + WS_WTIN) + (size_t)l * WTIN_L + (size_t)NPROJ * D, ALOW); }
#endif
        }
        else if (kind == 1 && EN(3)) {
            MKCTX;
            glaA_phase(C, l, PROJ, ALOW, SBUF, DEC);
            gmlp_phase(C, l, PROJ, (const bf16*)(wsb + WS_WSB), CONCAT);
        }
        else if (kind == 2) { if (EN(4)) { MKCTX; scan_phase(C, SBUF, DEC); } }
        else if (kind == 3 && EN(5)) { MKCTX; glaC_phase(C, l, PROJ, ALOW, SBUF, CONCAT); }
        else if (kind == 4 && EN(6)) {
            MKCTX;
            pg8::Gemm g{CONCAT, (const bf16*)(wsb + WS_WTOUT) + (size_t)l * D * D, T, D, D};
            pg8::StaticOrder S; S.init(T, D, C.G, C.bid);
            pg8::EpiResGate E{l == 0 ? KARG(I_X) : (const float*)X, X, modl + 2 * D, MODW};
            pg8::gemm_phase<pg8::EpiResGate, pg8::StaticOrder, GEMM_ALIGN, GEMM_SP2>(C.lds, g, S, E, C.tid);
        }
        else if (kind == 5) { if (EN(1)) { MKCTX; norm_phase<true>(C, X, KARG(I_N2G) + (size_t)l * D, modl, 3 * D, 4 * D, Hb, wsb + WS_H8); } }
        else if (kind == 7) { if (EN(7)) { MKCTX; topk_phase(C, l, QB, (const bf16*)(wsb + WS_K1B), (const bf16*)(wsb + WS_K2B), (const int*)(wsb + WS_KU) + l * NEXP, (const int*)(wsb + WS_KV) + l * NEXP, EB, PG); } }
#ifdef DBG_FAKE_U
        else if (kind == 8) { if (EN(8)) { MKCTX; peerU_phase(C, wsb + WS_H8, EB, (const fp8_t*)(wsb + WS_PUB) + (size_t)l * NEXP * D, (float*)(wsb + WS_END), DBG_FAKE_U); peerU_phase(C, wsb + WS_H8, EB, (const fp8_t*)(wsb + WS_PUB) + (size_t)l * NEXP * D, (float*)SBUF); } }
#else
        else if (kind == 8) { if (EN(8)) { MKCTX; peerU_phase(C, wsb + WS_H8, EB, (const fp8_t*)(wsb + WS_PUB) + (size_t)l * NEXP * D, (float*)SBUF); } }
#endif
#ifdef DBG_FAKE_V
        else if (kind == 9) { if (EN(9)) { MKCTX; const int fake = (repflag == 0); peerV_phase(C, EB, PG, (const float*)SBUF, (const fp8_t*)(wsb + WS_PVB) + (size_t)l * NEXP * D, X, modl + 5 * D, fake ? (DBG_FAKE_V) : 0xFFFF, fake); } }
#else
        else if (kind == 9) { if (EN(9)) { MKCTX; peerV_phase(C, EB, PG, (const float*)SBUF, (const fp8_t*)(wsb + WS_PVB) + (size_t)l * NEXP * D, X, modl + 5 * D); } }
#endif
        else if (EN(10)) {
            MKCTX;
            if (l == DEPTH - 1) final_norm_phase(C, X, KARG(I_FG));
            else norm_phase(C, X, KARG(I_N1G) + (size_t)(l + 1) * D, MOD + (size_t)(l + 1) * 4 * MODW, 0, D, Hb);
        }
        if (ph + 1 < args.ph_hi) xcd_barrier(bar);
#ifdef DBG_EXTRA_BAR
        if (ph + 1 < args.ph_hi) { xcd_barrier(bar); xcd_barrier(bar); }
#endif
#ifdef DBG_REP_MASK
        { const int bit = ph < 2 ? ph : 2 + kind; bool want = ((DBG_REP_MASK) >> bit) & 1;
#ifdef DBG_REP_L0
          if (l != 0) want = false;
#endif
          if (want && !repflag) { repflag = 1; --ph; } else repflag = 0; }
#endif
    }
}

extern "C" void kernel_launch(void* const* d_in, const int* in_sizes, int n_in, void* d_out, int out_size, void* d_ws, size_t ws_size, hipStream_t stream) {
    static int grid = 0;
    if (grid == 0) {
        if (n_in != 21 || out_size != T * D || ws_size < WS_END) { fprintf(stderr, "kernel_launch: unexpected shapes (n_in %d, out %d, ws %zu)\n", n_in, out_size, ws_size); grid = -1; return; }
        int dev = 0, cus = 0, per_cu = 0;
        if (hipGetDevice(&dev) != hipSuccess || hipDeviceGetAttribute(&cus, hipDeviceAttributeMultiprocessorCount, dev) != hipSuccess) { grid = -1; return; }
        if (hipFuncSetAttribute((const void*)mk_fwd, hipFuncAttributeMaxDynamicSharedMemorySize, LDS_BYTES) != hipSuccess) { fprintf(stderr, "kernel_launch: hipFuncSetAttribute failed\n"); grid = -1; return; }
        if (hipOccupancyMaxActiveBlocksPerMultiprocessor(&per_cu, (const void*)mk_fwd, NTHR, LDS_BYTES) != hipSuccess || per_cu < 1) { fprintf(stderr, "kernel_launch: occupancy query says %d blocks per CU\n", per_cu); (void)hipGetLastError(); grid = -1; return; }
        if (cus != 256) { fprintf(stderr, "kernel_launch: built for a 256-CU device (got %d)\n", cus); grid = -1; return; }
        grid = cus;
    }
    if (grid < 0) return;
    (void)hipMemsetAsync((char*)d_ws + WS_CTL, 0, CTL_ZERO_BYTES, stream);
    Args a{};
    for (int i = 0; i < 21; ++i) a.in[i] = (const float*)d_in[i];
    a.out = (float*)d_out; a.ws = (unsigned char*)d_ws;
#if MK_N_LAUNCHES == 1
    a.ph_lo = 0; a.ph_hi = NPH;
    hipLaunchKernelGGL(mk_fwd, dim3(grid), dim3(NTHR), LDS_BYTES, stream, a);
#else
    for (int p = 0; p < NPH; ++p) { a.ph_lo = p; a.ph_hi = p + 1; hipLaunchKernelGGL(mk_fwd, dim3(grid), dim3(NTHR), LDS_BYTES, stream, a); }
#endif
}
```

```cpp
#include <hip/hip_runtime.h>
#include <cstdio>
#include <cstdint>
#ifndef MK_N_LAUNCHES
#define MK_N_LAUNCHES 1
#endif
namespace pg8 {
#define PG8_LAS __attribute__((address_space(3)))
typedef unsigned short bf16_t;
typedef short bf16x8 __attribute__((ext_vector_type(8)));
typedef float f32x4 __attribute__((ext_vector_type(4)));
typedef unsigned u32x4 __attribute__((ext_vector_type(4)));
constexpr int BM = 256, BK = 64, HALF = 128, HTB = HALF * BK * 2  , STAGE_BYTES = 8 * HTB, NXCD = 8, WGM = 8;

__host__ __device__ __forceinline__ int lds_byte(int r, int c) { const int st = (r >> 4) * 2 + (c >> 5), rr = r & 15, cc = c & 31, ob = rr * 64 + cc * 2; return st * 1024 + (ob ^ (((ob >> 9) & 1) << 5)); }
__host__ __device__ __forceinline__ void stage_rc(int b, int& R, int& C) { const int st = b / 1024, sb = b % 1024, swz = sb ^ (((sb >> 9) & 1) << 5); R = (st >> 1) * 16 + swz / 64; C = (st & 1) * 32 + (swz % 64) / 2; }
__host__ __device__ __forceinline__ int perm32(int rho) { const int n = rho >> 4, i = rho & 15; return 8 * (i >> 2) + 4 * n + (i & 3); }

struct Unit { int pm, pn; };
struct Gemm { const bf16_t* A; const bf16_t* Bt; int M, N, K; };

struct StaticOrder {
    int nM, nN, nwg, G, c;
    __host__ __device__ void init(int M, int N, int G_, int c_) { nM = M / BM; nN = N / BM; nwg = nM * nN; G = G_; c = c_; }
    __host__ __device__ bool next(int i, Unit& u) const {
        const long L = (long)i * G + c; if (L >= nwg) return false;
        int wgid = (int)L; { const int q = nwg / NXCD, r = nwg % NXCD, xcd = wgid % NXCD, off = wgid / NXCD; wgid = (xcd < r ? xcd * (q + 1) : r * (q + 1) + (xcd - r) * q) + off; }
        const int nig = WGM * nN, gid = wgid / nig, fm = gid * WGM, gsz = (nM - fm) < WGM ? (nM - fm) : WGM;
        u.pm = fm + ((wgid % nig) % gsz); u.pn = (wgid % nig) / gsz; return true;
    }
    __device__ __forceinline__ void a_ready(const Unit&) const {}
    __device__ __forceinline__ void done(const Unit&) const {}
};
__device__ __forceinline__ unsigned cvt_pk_bf16(float lo, float hi) { unsigned r; asm volatile("v_cvt_pk_bf16_f32 %0, %1, %2" : "=v"(r) : "v"(lo), "v"(hi)); return r; }
struct EpiBf16 {
    static constexpr bool PERM = true, AFTER_DRAIN = false;
    bf16_t* O; int ldc;
    __device__ __forceinline__ void operator()(const f32x4 (&acc)[2][2][4][2], const Unit& u, int wr, int wc, int fr, int fq) const {
        const int row0 = u.pm * BM + wr * 64 + fr; const int col0 = u.pn * BM + wc * 32 + 8 * fq;
#pragma unroll
        for (int ai = 0; ai < 2; ++ai)
#pragma unroll
            for (int m = 0; m < 4; ++m) { bf16_t* rowp = O + (size_t)(row0 + ai * HALF + m * 16) * ldc + col0;
#pragma unroll
                for (int bj = 0; bj < 2; ++bj) { const f32x4 v0 = acc[ai][bj][m][0], v1 = acc[ai][bj][m][1];
                    u32x4 w; w.x = cvt_pk_bf16(v0[0], v0[1]); w.y = cvt_pk_bf16(v0[2], v0[3]); w.z = cvt_pk_bf16(v1[0], v1[1]); w.w = cvt_pk_bf16(v1[2], v1[3]);
                    *(u32x4*)(rowp + bj * HALF) = w; } }
    }
};
struct EpiResGate {
    static constexpr bool PERM = false, AFTER_DRAIN = false;
    const float* base; float* out; const float* gate; int gpitch;
    __device__ __forceinline__ void operator()(const f32x4 (&acc)[2][2][4][2], const Unit& u, int wr, int wc, int fr, int fq) const {
        const int row0 = u.pm * BM + wr * 64 + fr, col0 = u.pn * BM + wc * 32 + 4 * fq;
        const float* gp = gate + (size_t)(u.pm >> 4) * gpitch + col0;
        f32x4 gv[2][2];
#pragma unroll
        for (int bj = 0; bj < 2; ++bj)
#pragma unroll
            for (int n = 0; n < 2; ++n) gv[bj][n] = *(const f32x4*)(gp + bj * HALF + n * 16);
#pragma unroll
        for (int ai = 0; ai < 2; ++ai)
#pragma unroll
            for (int m = 0; m < 4; ++m) { const size_t off = (size_t)(row0 + ai * HALF + m * 16) * 2048 + col0;
#pragma unroll
                for (int bj = 0; bj < 2; ++bj)
#pragma unroll
                    for (int n = 0; n < 2; ++n) { const f32x4 bs = *(const f32x4*)(base + off + bj * HALF + n * 16); *(f32x4*)(out + off + bj * HALF + n * 16) = bs + gv[bj][n] * acc[ai][bj][m][n]; }
                asm volatile("" ::: "memory"); }
    }
};

template <class Epi, class Sched, bool ALIGN_EPI = false, bool SP2 = false>
__device__ __forceinline__ void gemm_phase(PG8_LAS unsigned char* lds, const Gemm g, const Sched& S, const Epi& E, const int tid  ) {
    const int wid = __builtin_amdgcn_readfirstlane(tid >> 6), lane = tid & 63, wr = wid >> 2, wc = wid & 3, fr = lane & 15, fq = lane >> 4;
    const int K = g.K, nt = K / BK;
    unsigned voffA[2], voffB[2];
#pragma unroll
    for (int i = 0; i < 2; ++i) { int R, C; stage_rc(tid * 16 + i * 8192, R, C); const int Rb = Epi::PERM ? ((R & ~31) + perm32(R & 31)) : R;
        voffA[i] = (unsigned)(R * K + C) * 2u; voffB[i] = (unsigned)(Rb * K + C) * 2u; }
    const size_t kstep = (size_t)(BK * 2);
    const size_t hstep = (size_t)HALF * K * 2;
    const size_t tstep = 2 * hstep;
    const unsigned ldsw = (unsigned)wid * 1024u;
    const int aoff = lds_byte(wr * 64 + fr, fq * 8), boff = lds_byte(wc * 32 + fr, fq * 8);
#define PG8_SA(b, h) (((b) * 2 + (h)) * HTB)
#define PG8_SB(b, h) ((4 + (b) * 2 + (h)) * HTB)
#define PG8_STAGE(bufoff, gbase, voff) do { _Pragma("unroll") for (int _i = 0; _i < 2; ++_i) \
        __builtin_amdgcn_global_load_lds((const unsigned*)((const char*)(gbase) + (voff)[_i]), (PG8_LAS unsigned*)(lds + (bufoff) + ldsw + _i * 8192), 16, 0, 0); } while (0)
#define PG8_LDA(dst, b, h) do { _Pragma("unroll") for (int m = 0; m < 4; ++m) _Pragma("unroll") for (int k = 0; k < 2; ++k) dst[m][k] = *(const PG8_LAS bf16x8*)(lds + PG8_SA(b, h) + aoff + m * 2048 + k * 1024); } while (0)
#define PG8_LDB(dst, b, h) do { _Pragma("unroll") for (int n = 0; n < 2; ++n) _Pragma("unroll") for (int k = 0; k < 2; ++k) dst[n][k] = *(const PG8_LAS bf16x8*)(lds + PG8_SB(b, h) + boff + n * 2048 + k * 1024); } while (0)
#define PG8_MMA(ai, bj, At, Bt) do { __builtin_amdgcn_s_setprio(1); _Pragma("unroll") for (int m = 0; m < 4; ++m) _Pragma("unroll") for (int n = 0; n < 2; ++n) _Pragma("unroll") for (int k = 0; k < 2; ++k) \
        acc[ai][bj][m][n] = __builtin_amdgcn_mfma_f32_16x16x32_bf16(Bt[n][k], At[m][k], acc[ai][bj][m][n], 0, 0, 0); __builtin_amdgcn_s_setprio(0); } while (0)
#define PG8_WAIT_V(n) asm volatile("s_waitcnt vmcnt(" #n ")" ::: "memory")
#define PG8_WAIT_L(n) asm volatile("s_waitcnt lgkmcnt(" #n ")" ::: "memory")
#define PG8_BAR __builtin_amdgcn_s_barrier()
#define PG8_SCHED __builtin_amdgcn_sched_barrier(0)
    Unit cur, nxt; int ui = 0;
    if (!S.next(0, cur)) return;
    f32x4 acc[2][2][4][2];
#pragma unroll
    for (int a = 0; a < 2; ++a)
#pragma unroll
        for (int b = 0; b < 2; ++b)
#pragma unroll
            for (int m = 0; m < 4; ++m)
#pragma unroll
                for (int n = 0; n < 2; ++n) acc[a][b][m][n] = (f32x4){0.f, 0.f, 0.f, 0.f};
    bf16x8 At[4][2], B0[2][2], B1[2][2];
    const char* cA = (const char*)g.A + (size_t)cur.pm * tstep; const char* cB = (const char*)g.Bt + (size_t)cur.pn * tstep;
    S.a_ready(cur);
    if constexpr (SP2) {
        PG8_STAGE(PG8_SB(0, 0), cB, voffB); PG8_STAGE(PG8_SB(0, 1), cB + hstep, voffB); PG8_STAGE(PG8_SA(0, 0), cA, voffA); PG8_STAGE(PG8_SA(0, 1), cA + hstep, voffA);
        if (wr == 1) PG8_BAR;
        PG8_WAIT_V(2); PG8_BAR;
        PG8_STAGE(PG8_SB(1, 0), cB + kstep, voffB); PG8_STAGE(PG8_SA(1, 0), cA + kstep, voffA); PG8_STAGE(PG8_SB(1, 1), cB + hstep + kstep, voffB);
        PG8_WAIT_V(6); PG8_BAR;
    } else {
        PG8_STAGE(PG8_SB(0, 0), cB, voffB); PG8_STAGE(PG8_SA(0, 0), cA, voffA); PG8_STAGE(PG8_SB(0, 1), cB + hstep, voffB); PG8_STAGE(PG8_SA(0, 1), cA + hstep, voffA);
        if (wr == 1) PG8_BAR;
        PG8_WAIT_V(4); PG8_BAR;
        PG8_STAGE(PG8_SB(1, 0), cB + kstep, voffB); PG8_STAGE(PG8_SA(1, 0), cA + kstep, voffA); PG8_STAGE(PG8_SB(1, 1), cB + hstep + kstep, voffB);
        PG8_WAIT_V(6); PG8_BAR;
    }
    for (;;) {
        const bool has_next = S.next(ui + 1, nxt);
        const char* nA = has_next ? (const char*)g.A + (size_t)nxt.pm * tstep : cA; const char* nB = has_next ? (const char*)g.Bt + (size_t)nxt.pn * tstep : cB;
        for (int t = 0; t < nt; t += 2) {
            const bool last = (t == nt - 2);
            const char* a1 = cA + (size_t)(t + 1) * kstep;
            const char* a2 = last ? nA : cA + (size_t)(t + 2) * kstep; const char* b2 = last ? nB : cB + (size_t)(t + 2) * kstep;
            const char* a3 = a2 + kstep; const char* b3 = b2 + kstep;
            if (last && has_next) S.a_ready(nxt);
            if constexpr (SP2) {
            PG8_LDB(B0, 0, 0); PG8_LDB(B1, 0, 1); PG8_SCHED; PG8_LDA(At, 0, 0); PG8_STAGE(PG8_SA(1, 1), a1 + hstep, voffA);
            PG8_WAIT_V(8); PG8_WAIT_L(0); PG8_BAR; PG8_MMA(0, 0, At, B0); PG8_MMA(0, 1, At, B1); PG8_BAR; PG8_SCHED;
            PG8_LDA(At, 0, 1); PG8_STAGE(PG8_SB(0, 0), b2, voffB); PG8_STAGE(PG8_SB(0, 1), b2 + hstep, voffB); PG8_STAGE(PG8_SA(0, 0), a2, voffA);
            PG8_WAIT_V(8); PG8_WAIT_L(0); PG8_BAR; PG8_MMA(1, 0, At, B0); PG8_MMA(1, 1, At, B1); PG8_BAR; PG8_SCHED;
            PG8_LDB(B0, 1, 0); PG8_LDB(B1, 1, 1); PG8_SCHED; PG8_LDA(At, 1, 0); PG8_STAGE(PG8_SA(0, 1), a2 + hstep, voffA);
            PG8_WAIT_V(8); PG8_WAIT_L(0); PG8_BAR; PG8_MMA(0, 0, At, B0); PG8_MMA(0, 1, At, B1); PG8_BAR; PG8_SCHED;
            PG8_LDA(At, 1, 1); PG8_STAGE(PG8_SB(1, 0), b3, voffB); PG8_STAGE(PG8_SB(1, 1), b3 + hstep, voffB); PG8_STAGE(PG8_SA(1, 0), a3, voffA);
            PG8_WAIT_V(8); PG8_WAIT_L(0); PG8_BAR; PG8_MMA(1, 0, At, B0); PG8_MMA(1, 1, At, B1); PG8_BAR; PG8_SCHED;
            } else {
            PG8_LDB(B0, 0, 0); PG8_SCHED; PG8_LDA(At, 0, 0); PG8_STAGE(PG8_SA(1, 1), a1 + hstep, voffA);
            PG8_WAIT_L(8); PG8_BAR; PG8_WAIT_L(0); PG8_MMA(0, 0, At, B0); PG8_BAR; PG8_SCHED;
            PG8_LDB(B1, 0, 1); PG8_STAGE(PG8_SB(0, 0), b2, voffB);
            PG8_BAR; PG8_WAIT_L(0); PG8_MMA(0, 1, At, B1); PG8_BAR;
            PG8_LDA(At, 0, 1); PG8_STAGE(PG8_SA(0, 0), a2, voffA);
            PG8_BAR; PG8_WAIT_L(0); PG8_MMA(1, 0, At, B0); PG8_BAR; PG8_SCHED;
            PG8_STAGE(PG8_SB(0, 1), b2 + hstep, voffB);
            PG8_WAIT_V(6); PG8_BAR; PG8_MMA(1, 1, At, B1); PG8_BAR;
            PG8_LDB(B0, 1, 0); PG8_SCHED; PG8_LDA(At, 1, 0); PG8_STAGE(PG8_SA(0, 1), a2 + hstep, voffA);
            PG8_WAIT_L(8); PG8_BAR; PG8_WAIT_L(0); PG8_MMA(0, 0, At, B0); PG8_BAR; PG8_SCHED;
            PG8_LDB(B1, 1, 1); PG8_STAGE(PG8_SB(1, 0), b3, voffB);
            PG8_BAR; PG8_WAIT_L(0); PG8_MMA(0, 1, At, B1); PG8_BAR;
            PG8_LDA(At, 1, 1); PG8_STAGE(PG8_SA(1, 0), a3, voffA);
            PG8_BAR; PG8_WAIT_L(0); PG8_MMA(1, 0, At, B0); PG8_BAR; PG8_SCHED;
            PG8_STAGE(PG8_SB(1, 1), b3 + hstep, voffB);
            PG8_WAIT_V(6); PG8_BAR; PG8_MMA(1, 1, At, B1); PG8_BAR;
            }
        }
        if constexpr (ALIGN_EPI) { if (wr == 0) PG8_BAR; }
        if constexpr (!Epi::AFTER_DRAIN) { E(acc, cur, wr, wc, fr, fq); S.done(cur); }
        if (!has_next) break;
#pragma unroll
        for (int a = 0; a < 2; ++a)
#pragma unroll
            for (int b = 0; b < 2; ++b)
#pragma unroll
                for (int m = 0; m < 4; ++m)
#pragma unroll
                    for (int n = 0; n < 2; ++n) acc[a][b][m][n] = (f32x4){0.f, 0.f, 0.f, 0.f};
        cur = nxt; cA = nA; cB = nB; ++ui;
        if constexpr (ALIGN_EPI) { if (wr == 1) PG8_BAR; }
    }
    PG8_WAIT_V(0);
    if constexpr (!ALIGN_EPI) { if (wr == 0) PG8_BAR; }
    PG8_BAR;
    if constexpr (Epi::AFTER_DRAIN) { E.fused(acc, cur, wr, wc, fr, fq, lds, wid, lane); S.done(cur); }
#undef PG8_SA
#undef PG8_SB
#undef PG8_STAGE
#undef PG8_LDA
#undef PG8_LDB
#undef PG8_MMA
#undef PG8_WAIT_V
#undef PG8_WAIT_L
#undef PG8_BAR
#undef PG8_SCHED
}
}
constexpr int NWAVES = 8, NTHR = 512;
constexpr int D = 2048, NBATCH = 4, SEQ = 4096, T = NBATCH * SEQ, DEPTH = 2;
constexpr int GLA_H = 4, GLA_DK = 128, GLA_DV = 256, GLA_CH = 64;
constexpr int MLP_H = 8, MLP_DH = 128, MLP_CH = 128;
constexpr int IN_COLS = 5136, NPROJ = 5120;
constexpr int C_Q = 0, C_K = 512, C_V = 1024, C_R = 2048, C_U = 3072, C_VS = 4096;
constexpr int NEXP = 16384, PEER_H = 8;
constexpr float EPS = 1e-6f;
constexpr int MODW = 6 * D;
constexpr size_t MiB = 1u << 20;
constexpr size_t WS_CTL = 0, CTL_ZERO_BYTES = 1 * MiB;
constexpr size_t WS_MOD = 1 * MiB;
constexpr size_t WS_K1B = 2 * MiB, WS_K2B = 2 * MiB + 512 * 1024, WS_WSB = 3 * MiB, WS_DEC = 3 * MiB + 512 * 1024, WS_ALOW = 4 * MiB;
constexpr size_t WS_KU = 5 * MiB, WS_KV = 5 * MiB + 256 * 1024;
constexpr size_t WS_WTIN = 8 * MiB;
constexpr size_t WTIN_L = (size_t)5136 * 2048;
constexpr size_t WS_WTOUT = 49 * MiB, WS_WTQ = 65 * MiB;
constexpr size_t WS_PUB = 81 * MiB, WS_PVB = 209 * MiB;
constexpr size_t WS_H = 337 * MiB;
constexpr size_t WS_PROJ = 401 * MiB;
constexpr size_t WS_SBUF = 561 * MiB;
constexpr size_t WS_CONCAT = 625 * MiB;
constexpr size_t WS_QB = 689 * MiB;
constexpr size_t WS_EB = 753 * MiB, WS_PG = 761 * MiB;
constexpr size_t WS_H8 = 769 * MiB, WS_END = 833 * MiB;
static_assert(WS_WTIN + 2 * WTIN_L * 2 <= WS_WTOUT, "ws map");
constexpr int CW_BAR = 4096;
constexpr int RING_BYTES = 131072, LDSCTL_OFF = RING_BYTES, MISC_OFF = LDSCTL_OFF + 320, LDS_BYTES = 147456;

#define DI __device__ __forceinline__
#define LAS __attribute__((address_space(3)))
typedef unsigned short bf16;
typedef short bf16x8 __attribute__((ext_vector_type(8)));
typedef short s16x4 __attribute__((ext_vector_type(4)));
typedef short v4i16_t __attribute__((ext_vector_type(4)));
typedef __bf16 bf16x2_t __attribute__((ext_vector_type(2)));
typedef float f32x4 __attribute__((ext_vector_type(4)));
typedef float f32x2 __attribute__((ext_vector_type(2)));
typedef unsigned u32x4 __attribute__((ext_vector_type(4)));
typedef unsigned u32x2 __attribute__((ext_vector_type(2)));
typedef LAS unsigned char* ldsp;

DI unsigned f2bf(float f) { unsigned u = __builtin_bit_cast(unsigned, f); return (u + 0x7fffu + ((u >> 16) & 1u)) >> 16; }
DI unsigned pk2(float lo, float hi) { return f2bf(lo) | (f2bf(hi) << 16); }
DI float bflo(unsigned u) { return __builtin_bit_cast(float, u << 16); }
DI float bfhi(unsigned u) { return __builtin_bit_cast(float, u & 0xffff0000u); }
DI float bf1(bf16 v) { return __builtin_bit_cast(float, ((unsigned)v) << 16); }
DI float fexp2(float x) { return __builtin_amdgcn_exp2f(x); }
DI float flog2(float x) { return __builtin_amdgcn_logf(x); }
DI float frcp(float x) { return __builtin_amdgcn_rcpf(x); }
DI float frsq(float x) { return __builtin_amdgcn_rsqf(x); }
DI float gelu_t(float x) { const float u = 0.7978845608f * (x + 0.044715f * x * x * x); return x * frcp(1.f + fexp2(-2.885390082f * u)); }
DI float silu_f(float x) { return x * frcp(1.f + fexp2(-1.442695041f * x)); }
template <int CTRL> DI float dppf(float v) { return __builtin_bit_cast(float, __builtin_amdgcn_update_dpp(0, __builtin_bit_cast(int, v), CTRL, 0xf, 0xf, true)); }
DI float wave_sum_u(float v) {
    v += dppf<0xB1>(v); v += dppf<0x4E>(v); v += dppf<0x141>(v); v += dppf<0x140>(v);
    const int iv = __builtin_bit_cast(int, v);
    return (__builtin_bit_cast(float, __builtin_amdgcn_readlane(iv, 0)) + __builtin_bit_cast(float, __builtin_amdgcn_readlane(iv, 16))) +
           (__builtin_bit_cast(float, __builtin_amdgcn_readlane(iv, 32)) + __builtin_bit_cast(float, __builtin_amdgcn_readlane(iv, 48)));
}
DI float wave_sum(float v) {
#pragma unroll
    for (int o = 1; o < 64; o <<= 1) v += __shfl_xor(v, o);
    return v;
}
DI float dot2bf(unsigned a, unsigned b, float c) { return __builtin_amdgcn_fdot2_f32_bf16(__builtin_bit_cast(bf16x2_t, a), __builtin_bit_cast(bf16x2_t, b), c, false); }
DI f32x4 mfma16(bf16x8 a, bf16x8 b, f32x4 c) { return __builtin_amdgcn_mfma_f32_16x16x32_bf16(a, b, c, 0, 0, 0); }
DI s16x4 tr4(const LAS bf16* p) { return __builtin_bit_cast(s16x4, __builtin_amdgcn_ds_read_tr16_b64_v4i16((LAS v4i16_t*)p)); }
DI bf16x8 tr8(const LAS bf16* p, int stride) { const s16x4 a = tr4(p), b = tr4(p + 4 * stride); return (bf16x8){a[0], a[1], a[2], a[3], b[0], b[1], b[2], b[3]}; }

#define XB_TMO      128
#define XB_XCNT(j)  (256  + 64 * (j))
#define XB_XSUB(j)  (1280 + 64 * (j))
#define XB_XGEN(j)  (2304 + 64 * (j))
#define XB_TOP      3328
#define XB_TOPGEN   3392
#define XCD_BAR_WORDS 3456
#define XB_SPIN_CAP (1u << 18)

__device__ __forceinline__ unsigned xb_ld(unsigned* p)              { return __hip_atomic_load(p, __ATOMIC_RELAXED, __HIP_MEMORY_SCOPE_AGENT); }
__device__ __forceinline__ unsigned xb_add(unsigned* p, unsigned v) { return __hip_atomic_fetch_add(p, v, __ATOMIC_RELAXED, __HIP_MEMORY_SCOPE_AGENT); }
__device__ __forceinline__ unsigned xb_xcc_id() { return (unsigned)__builtin_amdgcn_s_getreg((3 << 11) | 20) & 0xFu; }
#define XB_SPIN(cond, bar) do { unsigned _sp = 0; while (cond) { __builtin_amdgcn_s_sleep(1); \
    if ((++_sp & 255u) == 0u) { if (xb_ld(&(bar)[XB_TMO])) break; if (_sp > XB_SPIN_CAP) { atomicAdd(&(bar)[XB_TMO], 1u); break; } } } } while (0)

struct XcdBarrier {
    unsigned* bar; unsigned x;
    volatile LAS unsigned* st;
};

__device__ __forceinline__ XcdBarrier xcd_barrier_post(unsigned* bar, volatile LAS unsigned* st) {
    XcdBarrier b; b.bar = bar; b.x = xb_xcc_id(); b.st = st;
    if (threadIdx.x == 0) (void)xb_add(&bar[XB_XCNT(b.x)], 1u);
    return b;
}
__device__ __forceinline__ void xcd_barrier_complete(unsigned* bar, unsigned x, unsigned& nloc, unsigned& nx) {
    const unsigned G = gridDim.x * gridDim.y * gridDim.z;
    unsigned sum, cnt, mine, sp = 0u;
    for (;;) {
        sum = 0u; cnt = 0u; mine = 0u;
#pragma unroll
        for (unsigned j = 0; j < 16; ++j) { const unsigned c = xb_ld(&bar[XB_XCNT(j)]); sum += c; cnt += (c > 0u) ? 1u : 0u; mine = (j == x) ? c : mine; }
        if (sum == G) break;
        __builtin_amdgcn_s_sleep(1);
        if ((++sp & 255u) == 0u) { if (xb_ld(&bar[XB_TMO])) break; if (sp > XB_SPIN_CAP) { atomicAdd(&bar[XB_TMO], 1u); break; } }
    }
    nloc = mine > 0u ? mine : 1u; nx = cnt > 0u ? cnt : 1u;
}

__device__ __forceinline__ void xcd_barrier(const XcdBarrier& b) {
    asm volatile("s_waitcnt vmcnt(0)" ::: "memory");
    __syncthreads();
    if (threadIdx.x == 0) {
        unsigned* bar = b.bar;
        __builtin_amdgcn_s_waitcnt(0);
        unsigned nloc = b.st[0], nx = b.st[1];
        if (nloc == 0u) { xcd_barrier_complete(bar, b.x, nloc, nx); b.st[0] = nloc; b.st[1] = nx; }
        const unsigned old = xb_add(&bar[XB_XSUB(b.x)], 1u);
        const unsigned gen = old / nloc;
        if (old + 1u == (gen + 1u) * nloc) {
            __builtin_amdgcn_fence(__ATOMIC_RELEASE, "agent");
            asm volatile("s_waitcnt vmcnt(0)" ::: "memory");
            const unsigned og = xb_add(&bar[XB_TOP], 1u);
            const unsigned tg = og / nx;
            if (og + 1u == (tg + 1u) * nx) xb_add(&bar[XB_TOPGEN], 1u);
            else XB_SPIN(xb_ld(&bar[XB_TOPGEN]) == tg, bar);
            __builtin_amdgcn_fence(__ATOMIC_ACQUIRE, "agent");
            xb_add(&bar[XB_XGEN(b.x)], 1u);
            asm volatile("s_waitcnt vmcnt(0)" ::: "memory");
        } else {
            XB_SPIN(xb_ld(&bar[XB_XGEN(b.x)]) == gen, bar);
            __builtin_amdgcn_fence(__ATOMIC_ACQUIRE, "agent");
            asm volatile("s_waitcnt vmcnt(0)" ::: "memory");
        }
    }
    __syncthreads();
}
struct Ctx {
    ldsp lds; int tid, lane, wave, bid, G, gw, NGW;
    unsigned char* ws;
};
DI const float* KARG(int k) { asm volatile("" : "+s"(k)); return ((const float* const*)__builtin_amdgcn_kernarg_segment_ptr())[k]; }
#define LDS_WAIT() asm volatile("s_waitcnt lgkmcnt(0)" ::: "memory")
enum { I_X = 0, I_C, I_ADAW, I_ADAB, I_N1G, I_WIN, I_WA2, I_BA, I_GNG, I_VNG, I_MWS, I_MB, I_MOG, I_WOUT, I_N2G, I_WQ, I_K1, I_K2, I_PU, I_PV, I_FG };

DI void p0_ada(const Ctx& C) {
    LAS float* red = (LAS float*)C.lds;
    float* MOD = (float*)(C.ws + WS_MOD);
    for (int it = C.bid; it < 192; it += C.G) {
        const int l = it / 96, cg = it % 96, c0 = cg * 128 + C.lane * 2;
        const float* W = KARG(I_ADAW) + (size_t)l * D * MODW + (size_t)(C.wave * 256) * MODW + c0;
        float cv[4][4];
#pragma unroll
        for (int b = 0; b < 4; ++b)
#pragma unroll
            for (int i = 0; i < 4; ++i) cv[b][i] = silu_f(KARG(I_C)[b * D + C.wave * 256 + i * 64 + C.lane]);
        float acc[4][2];
#pragma unroll
        for (int b = 0; b < 4; ++b) { acc[b][0] = 0.f; acc[b][1] = 0.f; }
#pragma unroll
        for (int i = 0; i < 4; ++i) {
#pragma unroll 16
            for (int j = 0; j < 64; ++j) {
                const f32x2 w = *(const f32x2*)(W + (size_t)(i * 64 + j) * MODW);
#pragma unroll
                for (int b = 0; b < 4; ++b) { const float s = __builtin_bit_cast(float, __builtin_amdgcn_readlane(__builtin_bit_cast(int, cv[b][i]), j)); acc[b][0] += s * w.x; acc[b][1] += s * w.y; }
            }
        }
#pragma unroll
        for (int b = 0; b < 4; ++b) *(LAS f32x2*)(red + (C.wave * 4 + b) * 128 + C.lane * 2) = (f32x2){acc[b][0], acc[b][1]};
        __syncthreads();
        { const int b = C.tid >> 7, col = C.tid & 127; float s = KARG(I_ADAB)[l * MODW + cg * 128 + col];
#pragma unroll
          for (int w = 0; w < 8; ++w) s += red[(w * 4 + b) * 128 + col];
          MOD[(size_t)(l * 4 + b) * MODW + cg * 128 + col] = s; }
        __syncthreads();
    }
}
DI void transpose_item(const float* W, int ldw, int src_col0, int ncols, bf16* WT, int dst_row0, int k0, LAS float* scr, int lane) {
    const int cl = lane & 31;
    float v[32];
#pragma unroll
    for (int i = 0; i < 32; ++i) { const int kk = 2 * i + (lane >> 5); v[i] = 0.f; if (cl < ncols) v[i] = W[(size_t)(k0 + kk) * ldw + src_col0 + cl]; }
#pragma unroll
    for (int i = 0; i < 32; ++i) { const int kk = 2 * i + (lane >> 5); scr[kk * 33 + cl] = v[i]; }
    LDS_WAIT();
    const int c = lane & 7;
#pragma unroll
    for (int j = 0; j < 4; ++j) { const int n = (lane >> 3) + 8 * j;
        if (n < ncols) { const LAS float* s = scr + (8 * c) * 33 + n;
            u32x4 o; o.x = pk2(s[0 * 33], s[1 * 33]); o.y = pk2(s[2 * 33], s[3 * 33]); o.z = pk2(s[4 * 33], s[5 * 33]); o.w = pk2(s[6 * 33], s[7 * 33]);
            *(u32x4*)(WT + (size_t)(dst_row0 + n) * 2048 + k0 + 8 * c) = o; } }
    LDS_WAIT();
}
DI void p0_prologue(const Ctx& C) {
    p0_ada(C);
    LAS float* scr = (LAS float*)(C.lds + C.wave * 16384);
    constexpr int PER_L = (161 + 64 + 64) * 32;
    for (int it = C.gw; it < 2 * PER_L; it += C.NGW) {
        const int l = it / PER_L; int r = it % PER_L;
        if (r < 161 * 32) { const int kb = r / 161, nb = r % 161; bf16* WT = (bf16*)(C.ws + WS_WTIN) + (size_t)l * WTIN_L;
            const float* W = KARG(I_WIN) + (size_t)l * D * IN_COLS;
            if (nb < 160) { const int n0 = 32 * nb; transpose_item(W, IN_COLS, n0 + (n0 >= 3072 ? 16 : 0), 32, WT, n0, 64 * kb, scr, C.lane); }
            else transpose_item(W, IN_COLS, 3072, 16, WT, 5120, 64 * kb, scr, C.lane);
            continue; }
        r -= 161 * 32;
        if (r < 2048) { const int kb = r / 64, nb = r % 64; transpose_item(KARG(I_WOUT) + (size_t)l * D * D, D, 32 * nb, 32, (bf16*)(C.ws + WS_WTOUT) + (size_t)l * D * D, 32 * nb, 64 * kb, scr, C.lane); continue; }
        r -= 2048;
        { const int kb = r / 64, nb = r % 64; transpose_item(KARG(I_WQ) + (size_t)l * D * D, D, 32 * nb, 32, (bf16*)(C.ws + WS_WTQ) + (size_t)l * D * D, 32 * nb, 64 * kb, scr, C.lane); }
    }
    const int gt = C.bid * NTHR + C.tid, NT = C.G * NTHR;
    { bf16* K1B = (bf16*)(C.ws + WS_K1B); bf16* K2B = (bf16*)(C.ws + WS_K2B); bf16* WSB = (bf16*)(C.ws + WS_WSB);
      for (int i = gt; i < 262144; i += NT) { K1B[i] = (bf16)f2bf(KARG(I_K1)[i]); K2B[i] = (bf16)f2bf(KARG(I_K2)[i]);
          const int s = i & 127, t = (i >> 7) & 127; WSB[i] = (s <= t) ? (bf16)f2bf(KARG(I_MWS)[i]) : (bf16)0; } }
    { int* KU = (int*)(C.ws + WS_KU); int* KV = (int*)(C.ws + WS_KV);
#pragma unroll 1
      for (int row = C.gw; row < 4 * NEXP; row += C.NGW) {
          const int tb = row >> 15, rr = row & 32767;
          const f32x4* src = (const f32x4*)(KARG(tb ? I_PV : I_PU) + (size_t)rr * D) + C.lane;
          f32x4 v[8]; float mx = 0.f;
#pragma unroll
          for (int j = 0; j < 8; ++j) { v[j] = src[64 * j]; mx = fmaxf(mx, fmaxf(fmaxf(fabsf(v[j].x), fabsf(v[j].y)), fmaxf(fabsf(v[j].z), fabsf(v[j].w)))); }
#pragma unroll
          for (int o = 1; o < 64; o <<= 1) mx = fmaxf(mx, __shfl_xor(mx, o));
          int k = 0;
          if (mx > 0.f) { k = (int)((__builtin_bit_cast(unsigned, 224.0f / mx) >> 23) & 255u) - 127; k = k < -60 ? -60 : (k > 60 ? 60 : k); }
          const float sc = __builtin_bit_cast(float, (unsigned)(k + 127) << 23);
          const int lyr = rr >> 14, ee = rr & 16383;
          unsigned* dst = (unsigned*)(C.ws + (tb ? WS_PVB : WS_PUB) + (size_t)lyr * NEXP * D + (size_t)ee * 256) + C.lane;
#pragma unroll
          for (int j = 0; j < 8; ++j) { int p = 0; p = __builtin_amdgcn_cvt_pk_fp8_f32(v[j].x * sc, v[j].y * sc, p, false); p = __builtin_amdgcn_cvt_pk_fp8_f32(v[j].z * sc, v[j].w * sc, p, true); dst[(size_t)j * (NEXP * 256 / 4)] = (unsigned)p; }
          if (C.lane == 0) (tb ? KV : KU)[rr] = k;
      } }
}
template <bool FP8 = false>
DI void norm_phase(const Ctx& C, const float* X, const float* g, const float* modl, int sh_off, int sc_off, bf16* Hout, unsigned char* H8 = nullptr) {
    const int r0 = C.gw * 8, b = r0 >> 12;
    const f32x4* shp = (const f32x4*)(modl + (size_t)b * MODW + sh_off); const f32x4* scp = (const f32x4*)(modl + (size_t)b * MODW + sc_off);
    f32x4 gm[8], shv[8];
#pragma unroll
    for (int j = 0; j < 8; ++j) { const int idx = 64 * j + C.lane; gm[j] = ((const f32x4*)g)[idx] * (scp[idx] + 1.0f); shv[j] = shp[idx]; }
#pragma unroll 1
    for (int i = 0; i < 8; ++i) {
        const f32x4* xr = (const f32x4*)(X + (size_t)(r0 + i) * D) + C.lane; f32x4 v[8]; float s = 0.f;
#pragma unroll
        for (int j = 0; j < 8; ++j) { v[j] = xr[64 * j]; s += (v[j].x * v[j].x + v[j].y * v[j].y) + (v[j].z * v[j].z + v[j].w * v[j].w); }
        const float rstd = frsq(wave_sum(s) * (1.f / D) + EPS);
        u32x2* o = (u32x2*)(Hout + (size_t)(r0 + i) * D) + C.lane;
#pragma unroll
        for (int j = 0; j < 8; ++j) { const f32x4 y = v[j] * rstd * gm[j] + shv[j]; u32x2 w; w.x = pk2(y.x, y.y); w.y = pk2(y.z, y.w); o[64 * j] = w;
            if (FP8) {
                const f32x4 ys = y * 16.0f; int ph = 0; ph = __builtin_amdgcn_cvt_pk_fp8_f32(ys.x, ys.y, ph, false); ph = __builtin_amdgcn_cvt_pk_fp8_f32(ys.z, ys.w, ph, true);
                const f32x2 b0 = __builtin_amdgcn_cvt_pk_f32_fp8(ph, false), b1 = __builtin_amdgcn_cvt_pk_f32_fp8(ph, true);
                int pl = 0; pl = __builtin_amdgcn_cvt_pk_fp8_f32((ys.x - b0.x) * 16.0f, (ys.y - b0.y) * 16.0f, pl, false); pl = __builtin_amdgcn_cvt_pk_fp8_f32((ys.z - b1.x) * 16.0f, (ys.w - b1.y) * 16.0f, pl, true);
                unsigned* h8 = (unsigned*)(H8 + (size_t)(r0 + i) * 4096) + C.lane; h8[64 * j] = (unsigned)ph; h8[512 + 64 * j] = (unsigned)pl; } }
    }
}
DI void alow_phase(const Ctx& C, const bf16* Hb, const bf16* WtA, float* ALOW) {
    const int task = C.bid * 4 + (C.wave & 3), kh = C.wave >> 2, r0 = task * 16, fr = C.lane & 15, fq = C.lane >> 4;
    const bf16* ap = Hb + (size_t)(r0 + fr) * D + 8 * fq + 1024 * kh; const bf16* bp = WtA + (size_t)fr * D + 8 * fq + 1024 * kh;
    f32x4 acc = (f32x4){0.f, 0.f, 0.f, 0.f};
#pragma unroll 8
    for (int ks = 0; ks < 32; ++ks) { const bf16x8 a = *(const bf16x8*)(ap + 32 * ks), b = *(const bf16x8*)(bp + 32 * ks); acc = mfma16(a, b, acc); }
    LAS f32x4* xch = (LAS f32x4*)C.lds + (C.wave & 3) * 64 + C.lane;
    if (kh) *xch = acc;
    LDS_WAIT(); __builtin_amdgcn_s_barrier(); asm volatile("" ::: "memory");
    if (!kh) { acc += *xch;
#pragma unroll
        for (int r = 0; r < 4; ++r) ALOW[(size_t)(r0 + 4 * fq + r) * 16 + fr] = acc[r]; }
}
#define LBAR() do { asm volatile("s_waitcnt lgkmcnt(0)" ::: "memory"); __builtin_amdgcn_s_barrier(); asm volatile("" ::: "memory"); } while (0)
DI void gla_gates(const Ctx& C, LAS float* al, LAS float* tot, const f32x4 alv, const float (&w2)[16], const float bav, float (&Gl)[16], float& off, float& gref, float& g63) {
    const int d = C.tid & 127, jg = C.tid >> 7;
    if (C.tid < 256) ((LAS f32x4*)al)[C.tid] = alv;
    LBAR();
    float run = 0.f;
#pragma unroll
    for (int jj = 0; jj < 16; ++jj) {
        const LAS f32x4* ar = (const LAS f32x4*)(al + (jg * 16 + jj) * 16);
        const f32x4 a0 = ar[0], a1 = ar[1], a2 = ar[2], a3 = ar[3];
        float z = bav;
        z += a0.x * w2[0] + a0.y * w2[1] + a0.z * w2[2] + a0.w * w2[3];
        z += a1.x * w2[4] + a1.y * w2[5] + a1.z * w2[6] + a1.w * w2[7];
        z += a2.x * w2[8] + a2.y * w2[9] + a2.z * w2[10] + a2.w * w2[11];
        z += a3.x * w2[12] + a3.y * w2[13] + a3.z * w2[14] + a3.w * w2[15];
        const float ls = fminf(z, 0.f) - 0.6931471806f * flog2(1.f + fexp2(-1.442695041f * fabsf(z)));
        run += ls * (1.442695041f / 16.f);
        Gl[jj] = run;
    }
    tot[jg * 128 + d] = run;
    LBAR();
    const float t0_ = tot[d], t1_ = tot[128 + d], t2_ = tot[256 + d], t3_ = tot[384 + d];
    off = (jg > 0 ? t0_ : 0.f) + (jg > 1 ? t1_ : 0.f) + (jg > 2 ? t2_ : 0.f); gref = t0_ + t1_; g63 = (t0_ + t1_) + (t2_ + t3_);
}
constexpr int KST = 136, VST = 264, PST = 72;
struct GlaIn { f32x4 alv; bf16 qraw[16], kraw[16]; u32x4 vt[4]; };
template <bool WITHQ>
DI void gla_load(const Ctx& C, int idx, const bf16* PROJ, const float* ALOW, GlaIn& in) {
    const int b = idx >> 8, h = (idx >> 6) & 3, n = idx & 63, t0 = b * SEQ + n * 64, d = C.tid & 127, jg = C.tid >> 7;
    in.alv = (f32x4){0.f, 0.f, 0.f, 0.f};
    if (C.tid < 256) in.alv = ((const f32x4*)(ALOW + (size_t)t0 * 16))[C.tid];
#pragma unroll
    for (int jj = 0; jj < 16; ++jj) { const bf16* row = PROJ + (size_t)(t0 + jg * 16 + jj) * NPROJ + h * 128 + d; in.kraw[jj] = row[C_K]; if (WITHQ) in.qraw[jj] = row[C_Q]; }
#pragma unroll
    for (int i = 0; i < 4; ++i) { const int c = C.tid + 512 * i, j = c >> 5, ec = c & 31; in.vt[i] = *(const u32x4*)(PROJ + (size_t)(t0 + j) * NPROJ + C_V + h * 256 + 8 * ec); }
}
DI void store_v_tile(const Ctx& C, const GlaIn& in, LAS bf16* VL) {
#pragma unroll
    for (int i = 0; i < 4; ++i) { const int c = C.tid + 512 * i, j = c >> 5, ec = c & 31; *(LAS u32x4*)(VL + j * VST + 8 * ec) = in.vt[i]; }
}
DI void glaA_phase(const Ctx& C, int l, const bf16* PROJ, const float* ALOW, bf16* SBUF, float* DEC) {
    LAS float* al = (LAS float*)(C.lds); LAS float* tot = (LAS float*)(C.lds + 4096);
    LAS bf16* KD = (LAS bf16*)(C.lds + 8192); LAS bf16* VL = (LAS bf16*)(C.lds + 25600);
    const int d = C.tid & 127, jg = C.tid >> 7, h = (C.bid >> 6) & 3;
    float w2[16];
#pragma unroll
    for (int r = 0; r < 16; ++r) w2[r] = KARG(I_WA2)[(size_t)l * 16 * 512 + r * 512 + h * 128 + d];
    const float bav = KARG(I_BA)[(size_t)l * 512 + h * 128 + d];
    GlaIn cur, nxt;
    gla_load<false>(C, C.bid, PROJ, ALOW, cur);
#pragma unroll 1
    for (int i = 0; i < 4; ++i) {
        const int idx = i * C.G + C.bid;
        float Gl[16], off, gref, g63;
        gla_gates(C, al, tot, cur.alv, w2, bav, Gl, off, gref, g63);
#pragma unroll
        for (int jj = 0; jj < 16; ++jj) { const int j = jg * 16 + jj; KD[j * KST + d] = (bf16)f2bf(bf1(cur.kraw[jj]) * fexp2(g63 - (off + Gl[jj]))); }
        store_v_tile(C, cur, VL);
        LBAR();
        if (i + 1 < 4) gla_load<false>(C, idx + C.G, PROJ, ALOW, nxt);
        if (jg == 0) DEC[(size_t)idx * 128 + d] = fexp2(g63);
        const int lane = C.lane, g = lane >> 4, qq = (lane & 15) >> 2, p = lane & 3, fr = lane & 15;
        bf16x8 A[2];
#pragma unroll
        for (int ks = 0; ks < 2; ++ks) A[ks] = tr8(KD + (32 * ks + 8 * g + qq) * KST + 16 * C.wave + 4 * p, KST);
        bf16* Sit = SBUF + (size_t)idx * 256 * 128;
#pragma unroll
        for (int half = 0; half < 2; ++half) {
            f32x4 acc[8];
#pragma unroll
            for (int nt = 0; nt < 8; ++nt) acc[nt] = (f32x4){0.f, 0.f, 0.f, 0.f};
#pragma unroll
            for (int nt = 0; nt < 8; ++nt)
#pragma unroll
                for (int ks = 0; ks < 2; ++ks) { const bf16x8 Bf = tr8(VL + (32 * ks + 8 * g + qq) * VST + 16 * (half * 8 + nt) + 4 * p, VST); acc[nt] = mfma16(A[ks], Bf, acc[nt]); }
#pragma unroll
            for (int nt = 0; nt < 8; ++nt) { const int e = 16 * (half * 8 + nt) + fr, dd = 16 * C.wave + 4 * g;
                u32x2 w; w.x = pk2(acc[nt][0], acc[nt][1]); w.y = pk2(acc[nt][2], acc[nt][3]); *(u32x2*)(Sit + (size_t)e * 128 + dd) = w; }
        }
        LBAR();
        cur = nxt;
    }
}
DI void scan_phase(const Ctx& C, bf16* SBUF, const float* DEC) {
    const int gt = C.bid * NTHR + C.tid, bh = gt >> 13, rem = gt & 8191, e = rem >> 5, dq = rem & 31;
    u32x2* p = (u32x2*)(SBUF + ((size_t)(bh * 64) * 256 + e) * 128 + 4 * dq);
    const f32x4* dp = (const f32x4*)(DEC + (size_t)(bh * 64) * 128 + 4 * dq);
    f32x4 st = (f32x4){0.f, 0.f, 0.f, 0.f};
#pragma unroll 1
    for (int n0 = 0; n0 < 64; n0 += 8) {
        u32x2 tmp[8]; f32x4 dc[8];
#pragma unroll
        for (int u = 0; u < 8; ++u) { tmp[u] = p[(size_t)(n0 + u) * 8192]; dc[u] = dp[(n0 + u) * 32]; }
#pragma unroll
        for (int u = 0; u < 8; ++u) { u32x2 w; w.x = pk2(st.x, st.y); w.y = pk2(st.z, st.w); p[(size_t)(n0 + u) * 8192] = w;
            st = dc[u] * st + (f32x4){bflo(tmp[u].x), bfhi(tmp[u].x), bflo(tmp[u].y), bfhi(tmp[u].y)}; }
    }
}
DI void glaC_phase(const Ctx& C, int l, const bf16* PROJ, const float* ALOW, const bf16* SBUF, bf16* CONCAT) {
    const int h = (C.bid >> 6) & 3;
    LAS float* al = (LAS float*)(C.lds); LAS float* tot = (LAS float*)(C.lds + 4096); LAS float* RS = (LAS float*)(C.lds + 6144);
    LAS bf16* QT = (LAS bf16*)(C.lds + 8192); LAS bf16* KT = (LAS bf16*)(C.lds + 25600); LAS bf16* QG = (LAS bf16*)(C.lds + 43008);
    LAS bf16* VL = (LAS bf16*)(C.lds + 60416); LAS bf16* PL = (LAS bf16*)(C.lds + 94208);
    const int d = C.tid & 127, jg = C.tid >> 7;
    float w2[16];
#pragma unroll
    for (int r = 0; r < 16; ++r) w2[r] = KARG(I_WA2)[(size_t)l * 16 * 512 + r * 512 + h * 128 + d];
    const float bav = KARG(I_BA)[(size_t)l * 512 + h * 128 + d];
    const float* ng = KARG(I_GNG) + (size_t)(l * 4 + h) * 256;
    GlaIn cur;
    f32x4 alv_n = (f32x4){0.f, 0.f, 0.f, 0.f};
    if (C.tid < 256) alv_n = ((const f32x4*)(ALOW + (size_t)((C.bid >> 8) * SEQ + (C.bid & 63) * 64) * 16))[C.tid];
#pragma unroll 1
    for (int it = 0; it < 4; ++it) {
    const int idx = it * C.G + C.bid, b = idx >> 8, n = idx & 63, t0 = b * SEQ + n * 64;
    gla_load<true>(C, idx, PROJ, ALOW, cur); cur.alv = alv_n;
    float Gl[16], off, gref, g63;
    gla_gates(C, al, tot, cur.alv, w2, bav, Gl, off, gref, g63);
#pragma unroll
    for (int jj = 0; jj < 16; ++jj) { const int j = jg * 16 + jj; const float Gv = off + Gl[jj];
        const float q = bf1(cur.qraw[jj]) * 0.08838834764831845f, k = bf1(cur.kraw[jj]);
        QT[j * KST + d] = (bf16)f2bf(q * fexp2(fminf(Gv - gref, 100.f))); KT[j * KST + d] = (bf16)f2bf(k * fexp2(fminf(gref - Gv, 100.f))); QG[j * KST + d] = (bf16)f2bf(q * fexp2(Gv)); }
    store_v_tile(C, cur, VL);
    const int lane = C.lane, g = lane >> 4, qq = (lane & 15) >> 2, p = lane & 3, fr = lane & 15;
    bf16x8 Sf[2][4]; u32x2 rraw[4][2];
#pragma unroll
    for (int mi = 0; mi < 2; ++mi) { const bf16* Srow = SBUF + ((size_t)idx * 256 + 16 * (2 * C.wave + mi) + fr) * 128 + 8 * g;
#pragma unroll
        for (int ks = 0; ks < 4; ++ks) Sf[mi][ks] = *(const bf16x8*)(Srow + 32 * ks); }
#pragma unroll
    for (int nt = 0; nt < 4; ++nt)
#pragma unroll
        for (int mi = 0; mi < 2; ++mi) rraw[nt][mi] = *(const u32x2*)(PROJ + (size_t)(t0 + 16 * nt + fr) * NPROJ + C_R + h * 256 + 16 * (2 * C.wave + mi) + 4 * g);
    LBAR();
    {
        const int nt = C.wave & 3;
#pragma unroll
        for (int mi = 0; mi < 2; ++mi) { const int mt = 2 * (C.wave >> 2) + mi; f32x4 acc = (f32x4){0.f, 0.f, 0.f, 0.f};
#pragma unroll
            for (int ks = 0; ks < 4; ++ks) { const bf16x8 a = *(const LAS bf16x8*)(KT + (16 * mt + fr) * KST + 32 * ks + 8 * g), bq = *(const LAS bf16x8*)(QT + (16 * nt + fr) * KST + 32 * ks + 8 * g); acc = mfma16(a, bq, acc); }
            const int i = 16 * nt + fr, j0 = 16 * mt + 4 * g;
            const float v0 = (j0 + 0 <= i) ? acc[0] : 0.f, v1 = (j0 + 1 <= i) ? acc[1] : 0.f, v2 = (j0 + 2 <= i) ? acc[2] : 0.f, v3 = (j0 + 3 <= i) ? acc[3] : 0.f;
            u32x2 w; w.x = pk2(v0, v1); w.y = pk2(v2, v3); *(LAS u32x2*)(PL + i * PST + j0) = w; }
    }
    LBAR();
    f32x4 acc[2][4];
#pragma unroll
    for (int mi = 0; mi < 2; ++mi)
#pragma unroll
        for (int nt = 0; nt < 4; ++nt) acc[mi][nt] = (f32x4){0.f, 0.f, 0.f, 0.f};
#pragma unroll
    for (int mi = 0; mi < 2; ++mi) { const int mt = 2 * C.wave + mi;
#pragma unroll
        for (int ks = 0; ks < 2; ++ks) { const bf16x8 a = tr8(VL + (32 * ks + 8 * g + qq) * VST + 16 * mt + 4 * p, VST);
#pragma unroll
            for (int nt = 0; nt < 4; ++nt) { const bf16x8 bp = *(const LAS bf16x8*)(PL + (16 * nt + fr) * PST + 32 * ks + 8 * g); acc[mi][nt] = mfma16(a, bp, acc[mi][nt]); } }
#pragma unroll
        for (int ks = 0; ks < 4; ++ks) { const bf16x8 a = Sf[mi][ks];
#pragma unroll
            for (int nt = 0; nt < 4; ++nt) { const bf16x8 bq = *(const LAS bf16x8*)(QG + (16 * nt + fr) * KST + 32 * ks + 8 * g); acc[mi][nt] = mfma16(a, bq, acc[mi][nt]); } }
    }
#pragma unroll
    for (int nt = 0; nt < 4; ++nt) { float s = 0.f;
#pragma unroll
        for (int mi = 0; mi < 2; ++mi) s += (acc[mi][nt][0] * acc[mi][nt][0] + acc[mi][nt][1] * acc[mi][nt][1]) + (acc[mi][nt][2] * acc[mi][nt][2] + acc[mi][nt][3] * acc[mi][nt][3]);
        s += __shfl_xor(s, 16); s += __shfl_xor(s, 32);
        if (g == 0) RS[C.wave * 64 + 16 * nt + fr] = s; }
    LBAR();
    if (it + 1 < 4 && C.tid < 256) { const int ix = idx + C.G; alv_n = ((const f32x4*)(ALOW + (size_t)((ix >> 8) * SEQ + (ix & 63) * 64) * 16))[C.tid]; }
#pragma unroll
    for (int nt = 0; nt < 4; ++nt) { const int i = 16 * nt + fr; float ts = 0.f;
#pragma unroll
        for (int w = 0; w < 8; ++w) ts += RS[w * 64 + i];
        const float rstd = frsq(ts * (1.f / 256.f) + EPS);
#pragma unroll
        for (int mi = 0; mi < 2; ++mi) { const int e = 16 * (2 * C.wave + mi) + 4 * g;
            const u32x2 rr = rraw[nt][mi]; const f32x4 gg = *(const f32x4*)(ng + e);
            const float o0 = acc[mi][nt][0] * rstd * gg.x * silu_f(bflo(rr.x)), o1 = acc[mi][nt][1] * rstd * gg.y * silu_f(bfhi(rr.x));
            const float o2 = acc[mi][nt][2] * rstd * gg.z * silu_f(bflo(rr.y)), o3 = acc[mi][nt][3] * rstd * gg.w * silu_f(bfhi(rr.y));
            u32x2 w; w.x = pk2(o0, o1); w.y = pk2(o2, o3); *(u32x2*)(CONCAT + (size_t)(t0 + i) * D + h * 256 + e) = w; } }
    LBAR();
    }
}
constexpr int GST = 136;
DI void gmlp_phase(const Ctx& C, int l, const bf16* PROJ, const bf16* WSB, bf16* CONCAT) {
    const int h = C.bid & 7;
    LAS bf16* VL2 = (LAS bf16*)(C.lds); LAS bf16* UL = (LAS bf16*)(C.lds + 34816);
    const float* vg = KARG(I_VNG) + (size_t)(l * 8 + h) * 128; const float* og = KARG(I_MOG) + (size_t)(l * 8 + h) * 128; const float* bb = KARG(I_MB) + (size_t)(l * 8 + h) * 128;
    bf16x8 Wf[4];
    { const bf16* Wrow = WSB + ((size_t)(l * 8 + h) * 128 + 16 * C.wave + (C.lane & 15)) * 128 + 8 * (C.lane >> 4);
#pragma unroll
      for (int ks = 0; ks < 4; ++ks) Wf[ks] = *(const bf16x8*)(Wrow + 32 * ks); }
    u32x4 cu[4], cv[4], nu[4], nv[4];
#define GM_LOAD(IDX, U, V) do { const int t0_ = ((IDX) >> 8) * SEQ + (((IDX) >> 3) & 31) * 128; _Pragma("unroll") for (int i = 0; i < 4; ++i) { const int c = C.tid + 512 * i, t = c >> 4, ch = c & 15; \
        const bf16* row = PROJ + (size_t)(t0_ + t) * NPROJ + h * 128 + 8 * ch; U[i] = *(const u32x4*)(row + C_U); V[i] = *(const u32x4*)(row + C_VS); } } while (0)
    GM_LOAD(C.bid, cu, cv);
#pragma unroll 1
    for (int it = 0; it < 4; ++it) {
    const int idx = it * C.G + C.bid, n = (idx >> 3) & 31, b = idx >> 8, t0 = b * SEQ + n * 128;
#pragma unroll
    for (int i = 0; i < 4; ++i) { const int c = C.tid + 512 * i, t = c >> 4, ch = c & 15;
        const u32x4 uu = cu[i], vv = cv[i];
        float v[8] = {gelu_t(bflo(vv.x)), gelu_t(bfhi(vv.x)), gelu_t(bflo(vv.y)), gelu_t(bfhi(vv.y)), gelu_t(bflo(vv.z)), gelu_t(bfhi(vv.z)), gelu_t(bflo(vv.w)), gelu_t(bfhi(vv.w))};
        float ss = 0.f;
#pragma unroll
        for (int k = 0; k < 8; ++k) ss += v[k] * v[k];
        ss += __shfl_xor(ss, 1); ss += __shfl_xor(ss, 2); ss += __shfl_xor(ss, 4); ss += __shfl_xor(ss, 8);
        const float rstd = frsq(ss * (1.f / 128.f) + EPS);
        const f32x4 g0 = *(const f32x4*)(vg + 8 * ch), g1 = *(const f32x4*)(vg + 8 * ch + 4);
        u32x4 wv; wv.x = pk2(v[0] * rstd * g0.x, v[1] * rstd * g0.y); wv.y = pk2(v[2] * rstd * g0.z, v[3] * rstd * g0.w); wv.z = pk2(v[4] * rstd * g1.x, v[5] * rstd * g1.y); wv.w = pk2(v[6] * rstd * g1.z, v[7] * rstd * g1.w);
        *(LAS u32x4*)(VL2 + t * GST + 8 * ch) = wv;
        u32x4 wu; wu.x = pk2(gelu_t(bflo(uu.x)), gelu_t(bfhi(uu.x))); wu.y = pk2(gelu_t(bflo(uu.y)), gelu_t(bfhi(uu.y))); wu.z = pk2(gelu_t(bflo(uu.z)), gelu_t(bfhi(uu.z))); wu.w = pk2(gelu_t(bflo(uu.w)), gelu_t(bfhi(uu.w)));
        *(LAS u32x4*)(UL + t * GST + 8 * ch) = wu; }
    LBAR();
    if (it + 1 < 4) GM_LOAD(idx + C.G, nu, nv);
    const int lane = C.lane, g = lane >> 4, qq = (lane & 15) >> 2, p = lane & 3, fr = lane & 15;
    f32x4 acc[8];
#pragma unroll
    for (int mt = 0; mt < 8; ++mt) acc[mt] = (f32x4){0.f, 0.f, 0.f, 0.f};
    const int nks = (C.wave >> 1) + 1;
#pragma unroll
    for (int ks = 0; ks < 4; ++ks) if (ks < nks) { const bf16x8 bw = Wf[ks];
#pragma unroll
        for (int mt = 0; mt < 8; ++mt) { const bf16x8 a = tr8(VL2 + (32 * ks + 8 * g + qq) * GST + 16 * mt + 4 * p, GST); acc[mt] = mfma16(a, bw, acc[mt]); } }
    const int tl = 16 * C.wave + fr; const float bt = bb[tl]; float ss = 0.f;
#pragma unroll
    for (int mt = 0; mt < 8; ++mt) { const u32x2 uu = *(const LAS u32x2*)(UL + tl * GST + 16 * mt + 4 * g);
        acc[mt][0] = bflo(uu.x) * (acc[mt][0] + bt); acc[mt][1] = bfhi(uu.x) * (acc[mt][1] + bt); acc[mt][2] = bflo(uu.y) * (acc[mt][2] + bt); acc[mt][3] = bfhi(uu.y) * (acc[mt][3] + bt);
        ss += (acc[mt][0] * acc[mt][0] + acc[mt][1] * acc[mt][1]) + (acc[mt][2] * acc[mt][2] + acc[mt][3] * acc[mt][3]); }
    ss += __shfl_xor(ss, 16); ss += __shfl_xor(ss, 32);
    const float rstd = frsq(ss * (1.f / 128.f) + EPS);
#pragma unroll
    for (int mt = 0; mt < 8; ++mt) { const f32x4 gg = *(const f32x4*)(og + 16 * mt + 4 * g);
        u32x2 w; w.x = pk2(acc[mt][0] * rstd * gg.x, acc[mt][1] * rstd * gg.y); w.y = pk2(acc[mt][2] * rstd * gg.z, acc[mt][3] * rstd * gg.w);
        *(u32x2*)(CONCAT + (size_t)(t0 + tl) * D + 1024 + h * 128 + 16 * mt + 4 * g) = w; }
    LBAR();
#pragma unroll
    for (int i = 0; i < 4; ++i) { cu[i] = nu[i]; cv[i] = nv[i]; }
    }
#undef GM_LOAD
}
DI void list_insert(float (&L)[16], float x) {
#pragma unroll
    for (int i = 15; i >= 1; --i) L[i] = __builtin_amdgcn_fmed3f(x, L[i - 1], L[i]);
    L[0] = fmaxf(L[0], x);
}
DI void list_merge_xor(float (&L)[16], int mask) {
    float M[16];
#pragma unroll
    for (int i = 0; i < 16; ++i) M[i] = fmaxf(L[i], __shfl_xor(L[15 - i], mask));
#pragma unroll
    for (int s = 8; s >= 1; s >>= 1)
#pragma unroll
        for (int i = 0; i < 16; ++i) if ((i & s) == 0) { const float hi = fmaxf(M[i], M[i + s]), lo = fminf(M[i], M[i + s]); M[i] = hi; M[i + s] = lo; }
#pragma unroll
    for (int i = 0; i < 16; ++i) L[i] = M[i];
}
DI unsigned fbits(float x) { return __builtin_bit_cast(unsigned, x); }
DI float unp7(float x) { return __builtin_bit_cast(float, __builtin_bit_cast(unsigned, x) & 0xFFFFFF80u); }
constexpr int TKST = 136;
DI void topk_phase(const Ctx& C, int l, const bf16* QB, const bf16* K1B, const bf16* K2B, const int* KU, const int* KV, int* EB, float* PG) {
    LAS bf16* KL = (LAS bf16*)C.lds;
    LAS unsigned* tk = (LAS unsigned*)(C.lds + 2 * 128 * TKST * 2 + C.wave * 2048);
    const int lane = C.lane, fr = lane & 15, fq = lane >> 4, h = C.bid & 7, rank = C.bid >> 3;
#pragma unroll
    for (int i = 0; i < 8; ++i) { const int c = C.tid + 512 * i, tb = c >> 11, row = (c & 2047) >> 4, ch = c & 15;
        *(LAS u32x4*)(KL + (tb * 128 + row) * TKST + 8 * ch) = *(const u32x4*)((tb ? K2B : K1B) + ((size_t)(l * 8 + h) * 128 + row) * 128 + 8 * ch); }
    __syncthreads();
#pragma unroll 1
    for (int it = 0; it < 4; ++it) {
        const int tt0 = rank * 512 + C.wave * 64 + it * 16;
        float L[2][16];
        bf16x8 bq[2][4];
#pragma unroll
        for (int half = 0; half < 2; ++half)
#pragma unroll
            for (int ks = 0; ks < 4; ++ks) bq[half][ks] = *(const bf16x8*)(QB + (size_t)(tt0 + fr) * D + h * 256 + half * 128 + 8 * fq + 32 * ks);
#pragma unroll
        for (int half = 0; half < 2; ++half) {
            f32x4 acc[8];
#pragma unroll
            for (int mt = 0; mt < 8; ++mt) acc[mt] = (f32x4){0.f, 0.f, 0.f, 0.f};
            const LAS bf16* Kb = KL + (half * 128 + fr) * TKST + 8 * fq;
#pragma unroll
            for (int ks = 0; ks < 4; ++ks)
#pragma unroll
                for (int mt = 0; mt < 8; ++mt) { const bf16x8 a = *(const LAS bf16x8*)(Kb + (16 * mt) * TKST + 32 * ks); acc[mt] = mfma16(a, bq[half][ks], acc[mt]); }
#pragma unroll
            for (int i = 0; i < 16; ++i) L[half][i] = __builtin_bit_cast(float, 0xFF800000u);
#pragma unroll
            for (int mt = 0; mt < 8; ++mt)
#pragma unroll
                for (int r = 0; r < 4; ++r) { const unsigned key = (unsigned)(16 * mt + 4 * fq + r);
                    const float sv = acc[mt][r];
                    list_insert(L[half], __builtin_bit_cast(float, (fbits(sv) & 0xFFFFFF80u) | key)); }
            list_merge_xor(L[half], 16); list_merge_xor(L[half], 32);
        }
        if (fq == 0) {
#pragma unroll
            for (int i = 0; i < 16; ++i) { tk[(fr * 2 + 0) * 16 + i] = fbits(L[0][i]); tk[(fr * 2 + 1) * 16 + i] = fbits(L[1][i]); }
        }
        float Cn[16];
#pragma unroll
        for (int i = 0; i < 16; ++i) Cn[i] = __builtin_bit_cast(float, 0xFF800000u);
#pragma unroll
        for (int i = 0; i < 16; ++i)
#pragma unroll
            for (int j = 0; j < 16; ++j) if ((i + 1) * (j + 1) <= 16) {
                const float s = unp7(L[0][i]) + unp7(L[1][j]);
                list_insert(Cn, __builtin_bit_cast(float, (fbits(s) & 0xFFFFFF00u) | (unsigned)(i * 16 + j))); }
        LDS_WAIT();
        float sc[4]; int ex[4];
#pragma unroll
        for (int m = 0; m < 4; ++m) {
            const float ck = fq == 0 ? Cn[m] : (fq == 1 ? Cn[4 + m] : (fq == 2 ? Cn[8 + m] : Cn[12 + m]));
            const unsigned cc = fbits(ck) & 255u;
            const unsigned p1 = tk[(fr * 2 + 0) * 16 + (cc >> 4)], p2 = tk[(fr * 2 + 1) * 16 + (cc & 15u)];
            sc[m] = __builtin_bit_cast(float, p1 & 0xFFFFFF80u) + __builtin_bit_cast(float, p2 & 0xFFFFFF80u);
            ex[m] = (int)((p1 & 127u) * 128u + (p2 & 127u));
        }
        float mx = fmaxf(fmaxf(sc[0], sc[1]), fmaxf(sc[2], sc[3]));
        mx = fmaxf(mx, __shfl_xor(mx, 16)); mx = fmaxf(mx, __shfl_xor(mx, 32));
        float w[4], sum = 0.f;
#pragma unroll
        for (int m = 0; m < 4; ++m) { w[m] = fexp2((sc[m] - mx) * 1.442695041f); sum += w[m]; }
        sum += __shfl_xor(sum, 16); sum += __shfl_xor(sum, 32);
        const float inv = 1.0f / sum;
        const size_t o = (size_t)(tt0 + fr) * 128 + h * 16 + 4 * fq;
#pragma unroll
        for (int m = 0; m < 4; ++m) { const int ku = KU[ex[m]], kv = KV[ex[m]]; w[m] = w[m] * inv * __builtin_bit_cast(float, (unsigned)(127 - kv) << 23); ex[m] |= (127 - ku) << 16; }
        *(int4*)(EB + o) = make_int4(ex[0], ex[1], ex[2], ex[3]);
        *(f32x4*)(PG + o) = (f32x4){w[0], w[1], w[2], w[3]};
        LDS_WAIT();
    }
}
typedef unsigned char fp8_t;
DI void unpack16(const u32x4 q, float (&f)[16]) {
#pragma unroll
    for (int w = 0; w < 4; ++w) { const int dw = (int)q[w]; const f32x2 lo = __builtin_amdgcn_cvt_pk_f32_fp8(dw, false), hi = __builtin_amdgcn_cvt_pk_f32_fp8(dw, true);
        f[4 * w] = lo.x; f[4 * w + 1] = lo.y; f[4 * w + 2] = hi.x; f[4 * w + 3] = hi.y; }
}
typedef long i64_t;
DI f32x4 sel4(bool c, const f32x4 a, const f32x4 b) { return (f32x4){c ? a.x : b.x, c ? a.y : b.y, c ? a.z : b.z, c ? a.w : b.w}; }
constexpr int PU_RST = 272, PU_TILE = 16 * PU_RST, PU_WAVE = 2 * PU_TILE;
DI void peerU_phase(const Ctx& C, const unsigned char* H8, const int* EB, const fp8_t* PU8, float* PART, const int emask = 0xFFFF) {
    const int x = C.bid & 7, rank = C.bid >> 3, lane = C.lane, kq = lane >> 4, m16 = lane & 15;
    const __amdgpu_buffer_rsrc_t trs = __builtin_amdgcn_make_buffer_rsrc((void*)(PU8 + (size_t)x * NEXP * 256), 0, NEXP * 256, 0x00020000);
    float* part = PART + (size_t)x * T * 128;
    const int tbase = rank * 512 + C.wave * 64;
    const int* ebase = EB + (size_t)tbase * 128 + lane;
    const unsigned char* hbase = H8 + (size_t)tbase * 4096 + (m16 & 1) * 2048 + 256 * x + 8 * kq;
    ldsp wl = C.lds + C.wave * PU_WAVE;
    const int wr_off = kq * PU_RST + 16 * m16;
    const int rd_off = m16 * PU_RST + 8 * kq;
    const int bp0 = 4 * kq;
    int ept0 = ebase[0], ept1 = ebase[64];
    int ep0 = ebase[128], ep1 = ebase[192];
    u32x2 hc[8], hn[8];
#pragma unroll
    for (int c = 0; c < 8; ++c) { hc[c] = *(const u32x2*)(hbase + 32 * c); hn[c] = hc[c]; }
    u32x4 r0[8], r1[8], r2[8], r3[8];
#define PU_ISSUE(BUF, ESEL, Q1) do { _Pragma("unroll") for (int i_ = 0; i_ < 8; ++i_) { const int ad_ = (bp0 + 4 * (32 * (Q1) + 4 * i_)) & 255; \
        const int e_ = __builtin_amdgcn_ds_bpermute(ad_, (ESEL)) & emask; BUF[i_] = __builtin_amdgcn_raw_buffer_load_b128(trs, e_ * 256 + 16 * m16, 0, 0); } } while (0)
#define PU_STEP(BUF, T0) do { _Pragma("unroll") for (int i_ = 0; i_ < 8; ++i_) *(LAS u32x4*)(wl + wr_off + (i_ >> 2) * PU_TILE + (i_ & 3) * 4 * PU_RST) = BUF[i_]; \
        _Pragma("unroll") for (int tt = 0; tt < 2; ++tt) _Pragma("unroll") for (int c = 0; c < 8; ++c) { const u32x2 av_ = *(const LAS u32x2*)(wl + rd_off + tt * PU_TILE + 32 * c); \
            acc[(T0) + tt] = __builtin_amdgcn_mfma_f32_16x16x32_fp8_fp8((i64_t)(((unsigned long long)av_.y << 32) | av_.x), (i64_t)(((unsigned long long)hc[c].y << 32) | hc[c].x), acc[(T0) + tt], 0, 0, 0); } } while (0)
    PU_ISSUE(r0, ept0, 0); PU_ISSUE(r1, ept0, 1); PU_ISSUE(r2, ept1, 2); PU_ISSUE(r3, ept1, 3);
    f32x2 pend = (f32x2){0.f, 0.f}; f32x2* pend_p = nullptr;
#pragma unroll 1
    for (int ti = 0; ti < 64; ++ti) {
        const int t = tbase + ti; const bool more = ti + 1 < 64;
        int epn0 = 0, epn1 = 0;
        if (ti + 2 < 64) { epn0 = ebase[(ti + 2) * 128]; epn1 = ebase[(ti + 2) * 128 + 64]; }
        if (more) {
#pragma unroll
            for (int c = 0; c < 8; ++c) hn[c] = *(const u32x2*)(hbase + (size_t)(ti + 1) * 4096 + 32 * c); }
        f32x4 acc[8];
#pragma unroll
        for (int tl = 0; tl < 8; ++tl) acc[tl] = (f32x4){0.f, 0.f, 0.f, 0.f};
        PU_STEP(r0, 0); if (more) PU_ISSUE(r0, ep0, 0);
        if (ti > 0) *pend_p = pend;
        PU_STEP(r1, 2); if (more) PU_ISSUE(r1, ep0, 1);
        PU_STEP(r2, 4); if (more) PU_ISSUE(r2, ep1, 2);
        PU_STEP(r3, 6); if (more) PU_ISSUE(r3, ep1, 3);
        {   const int n = m16, rg = kq;
            const f32x4 s01 = sel4((n >> 1) & 1, acc[1], acc[0]), s23 = sel4((n >> 1) & 1, acc[3], acc[2]), s45 = sel4((n >> 1) & 1, acc[5], acc[4]), s67 = sel4((n >> 1) & 1, acc[7], acc[6]);
            const f32x4 s03 = sel4((n >> 2) & 1, s23, s01), s47 = sel4((n >> 2) & 1, s67, s45), sv = sel4((n >> 3) & 1, s47, s03);
            const float p0 = dppf<0xB1>(sv.x), p1 = dppf<0xB1>(sv.y), p2 = dppf<0xB1>(sv.z), p3 = dppf<0xB1>(sv.w);
            const bool odd = n & 1;
            const float o0 = odd ? (p2 + sv.z * 0.0625f) : (sv.x + p0 * 0.0625f), o1 = odd ? (p3 + sv.w * 0.0625f) : (sv.y + p1 * 0.0625f);
            pend = (f32x2){o0 * 0.0625f, o1 * 0.0625f}; pend_p = (f32x2*)(part + (size_t)t * 128 + 16 * (n >> 1) + 4 * rg + 2 * (n & 1)); }
        ep0 = epn0; ep1 = epn1;
#pragma unroll
        for (int c = 0; c < 8; ++c) hc[c] = hn[c];
    }
    *pend_p = pend;
#undef PU_ISSUE
#undef PU_STEP
}
typedef int v2i32_t __attribute__((ext_vector_type(2)));
constexpr int PV_TILE = 32 * PU_RST, PV_A8 = PV_TILE, PV_Y = PV_TILE + 256, PV_WAVE = 10240;
DI float wave_max_u(float v) {
    v = fmaxf(v, dppf<0xB1>(v)); v = fmaxf(v, dppf<0x4E>(v)); v = fmaxf(v, dppf<0x141>(v)); v = fmaxf(v, dppf<0x140>(v));
    const int iv = __builtin_bit_cast(int, v);
    return fmaxf(fmaxf(__builtin_bit_cast(float, __builtin_amdgcn_readlane(iv, 0)), __builtin_bit_cast(float, __builtin_amdgcn_readlane(iv, 16))),
                 fmaxf(__builtin_bit_cast(float, __builtin_amdgcn_readlane(iv, 32)), __builtin_bit_cast(float, __builtin_amdgcn_readlane(iv, 48))));
}
DI void peerV_phase(const Ctx& C, const int* EB, const float* PG, const float* PART, const fp8_t* PV8, float* X, const float* gate  , const int emask = 0xFFFF, const int FAKE = 0) {
    const int x = C.bid & 7, rank = C.bid >> 3, lane = C.lane, kq = lane >> 4, m16 = lane & 15;
    const fp8_t* tab = PV8 + (size_t)x * NEXP * 256 + 16 * m16;
    const int tbase = rank * 512 + C.wave * 64;
    ldsp wl = C.lds + C.wave * PV_WAVE;
    const int wr_off = kq * PU_RST + 16 * m16;
    const int tr_off = (8 * kq + (m16 >> 1)) * PU_RST + 8 * (m16 & 1);
    const int a_off = PV_A8 + (m16 & 1) * 128 + 8 * kq;
    const int bp0 = 4 * kq;
    float pr0[8], pr1[8]; int rep0, rep1; float rg0, rg1;
#define PV_LOAD_RAW(tt) do { _Pragma("unroll") for (int xx = 0; xx < 8; ++xx) { const float* pp = PART + ((size_t)xx * T + (tt)) * 128 + lane; pr0[xx] = pp[0]; pr1[xx] = pp[64]; } \
        rep0 = EB[(size_t)(tt) * 128 + lane]; rep1 = EB[(size_t)(tt) * 128 + 64 + lane]; rg0 = PG[(size_t)(tt) * 128 + lane]; rg1 = PG[(size_t)(tt) * 128 + 64 + lane]; } while (0)
#define PV_FINISH(A0, A1, E0, E1) do { const float s0_ = ((pr0[0] + pr0[1]) + (pr0[2] + pr0[3])) + ((pr0[4] + pr0[5]) + (pr0[6] + pr0[7])), s1_ = ((pr1[0] + pr1[1]) + (pr1[2] + pr1[3])) + ((pr1[4] + pr1[5]) + (pr1[6] + pr1[7])); \
        A0 = gelu_t(s0_ * __builtin_bit_cast(float, (unsigned)(rep0 >> 16) << 23)) * rg0; A1 = gelu_t(s1_ * __builtin_bit_cast(float, (unsigned)(rep1 >> 16) << 23)) * rg1; E0 = (rep0 & emask) * 256; E1 = (rep1 & emask) * 256; } while (0)
    float a0, a1, a0n = 0.f, a1n = 0.f; int e0, e1, e0n = 0, e1n = 0;
    PV_LOAD_RAW(tbase); PV_FINISH(a0, a1, e0, e1);
    PV_LOAD_RAW(tbase + 1);
    u32x4 ra[8], rb[8];
#define PV_ISSUE(BUF, ESEL, Q1) do { _Pragma("unroll") for (int i_ = 0; i_ < 8; ++i_) { const int ad_ = (bp0 + 4 * (32 * (Q1) + 4 * i_)) & 255; \
        const int eo_ = __builtin_amdgcn_ds_bpermute(ad_, (ESEL)); BUF[i_] = *(const u32x4*)(tab + eo_); } } while (0)
#define PV_STEP(BUF, KS) do { _Pragma("unroll") for (int i_ = 0; i_ < 8; ++i_) *(LAS u32x4*)(wl + wr_off + i_ * 4 * PU_RST) = BUF[i_]; \
        const u32x2 ao_ = *(const LAS u32x2*)(wl + a_off + 32 * (KS)); const i64_t aop_ = (i64_t)(((unsigned long long)ao_.y << 32) | ao_.x); \
        _Pragma("unroll") for (int nt = 0; nt < 16; ++nt) { const v2i32_t bv_ = __builtin_amdgcn_ds_read_tr8_b64_v2i32((LAS v2i32_t*)(wl + tr_off + 16 * nt)); \
            acc[nt] = __builtin_amdgcn_mfma_f32_16x16x32_fp8_fp8(aop_, (i64_t)(((unsigned long long)(unsigned)bv_[1] << 32) | (unsigned)bv_[0]), acc[nt], 0, 0, 0); } } while (0)
    PV_ISSUE(ra, e0, 0);
    f32x4 xpend = (f32x4){0.f, 0.f, 0.f, 0.f}; f32x4* xpend_p = nullptr;
#pragma unroll 1
    for (int ti = 0; ti < 64; ++ti) {
        const int t = tbase + ti;
        const float amax = wave_max_u(fmaxf(fabsf(a0), fabsf(a1)));
        int ka = 0; if (amax > 0.f) { ka = (int)((__builtin_bit_cast(unsigned, 224.0f / amax) >> 23) & 255u) - 127; ka = ka < -100 ? -100 : (ka > 100 ? 100 : ka); }
        const float sca = __builtin_bit_cast(float, (unsigned)(ka + 127) << 23), inva = __builtin_bit_cast(float, (unsigned)(127 - ka) << 23);
        {   const float s0 = a0 * sca, s1 = a1 * sca;
            const int ph = __builtin_amdgcn_cvt_pk_fp8_f32(s0, s1, 0, false); const f32x2 bk = __builtin_amdgcn_cvt_pk_f32_fp8(ph, false);
            const int pl = __builtin_amdgcn_cvt_pk_fp8_f32((s0 - bk.x) * 16.0f, (s1 - bk.y) * 16.0f, 0, false);
            LAS unsigned char* a8 = (LAS unsigned char*)(wl + PV_A8);
            a8[lane] = (unsigned char)(ph & 255); a8[64 + lane] = (unsigned char)((ph >> 8) & 255); a8[128 + lane] = (unsigned char)(pl & 255); a8[192 + lane] = (unsigned char)((pl >> 8) & 255); }
        f32x4 acc[16];
#pragma unroll
        for (int nt = 0; nt < 16; ++nt) acc[nt] = (f32x4){0.f, 0.f, 0.f, 0.f};
        const int col = 256 * x + 4 * lane, b = t >> 12;
        f32x4* xp = (f32x4*)(X + (size_t)t * D + col);
        f32x4 xold = (f32x4){0.f, 0.f, 0.f, 0.f}; if (!FAKE) xold = *xp;
        const f32x4 gt = *(const f32x4*)(gate + (size_t)b * MODW + col);
        PV_ISSUE(rb, e0, 1);
        if (ti > 0 && !FAKE) *xpend_p = xpend;
        PV_STEP(ra, 0);
        PV_ISSUE(ra, e1, 2); PV_STEP(rb, 1);
        if (ti + 1 < 64) PV_FINISH(a0n, a1n, e0n, e1n);
        PV_ISSUE(rb, e1, 3); PV_STEP(ra, 2);
        if (ti + 2 < 64) PV_LOAD_RAW(t + 2);
        if (ti + 1 < 64) PV_ISSUE(ra, e0n, 0);
        PV_STEP(rb, 3);
        if (kq == 0) {
#pragma unroll
            for (int nt = 0; nt < 16; ++nt) *(LAS float*)(wl + PV_Y + 4 * (16 * nt + m16)) = (acc[nt][0] + acc[nt][1] * 0.0625f) * inva; }
        const f32x4 y = *(const LAS f32x4*)(wl + PV_Y + 16 * lane);
        if (FAKE) { if (y.x == 123.456f) *xp = y; }
        xpend = xold + gt * y; xpend_p = xp;
        a0 = a0n; a1 = a1n; e0 = e0n; e1 = e1n;
    }
    if (!FAKE) *xpend_p = xpend;
#undef PV_LOAD_RAW
#undef PV_FINISH
#undef PV_ISSUE
#undef PV_STEP
}
DI void final_norm_phase(const Ctx& C, float* X, const float* g) {
    const int r0 = C.gw * 8;
    f32x4 gm[8];
#pragma unroll
    for (int j = 0; j < 8; ++j) gm[j] = ((const f32x4*)g)[64 * j + C.lane];
#pragma unroll 1
    for (int i = 0; i < 8; ++i) {
        f32x4* xr = (f32x4*)(X + (size_t)(r0 + i) * D) + C.lane; f32x4 v[8]; float s = 0.f;
#pragma unroll
        for (int j = 0; j < 8; ++j) { v[j] = xr[64 * j]; s += (v[j].x * v[j].x + v[j].y * v[j].y) + (v[j].z * v[j].z + v[j].w * v[j].w); }
        const float rstd = frsq(wave_sum(s) * (1.f / D) + EPS);
#pragma unroll
        for (int j = 0; j < 8; ++j) xr[64 * j] = v[j] * rstd * gm[j];
    }
}
#ifndef PH_MASK
#define PH_MASK 0xFFFFF
#endif
#define EN(k) (((PH_MASK) >> (k)) & 1)
#ifndef GEMM_SP2
#define GEMM_SP2 true
#endif
#ifndef GEMM_ALIGN
#define GEMM_ALIGN false
#endif
constexpr int NKIND = 11, NPH = 2 + 2 * NKIND;
struct Args { const float* in[21]; float* out; unsigned char* ws; int ph_lo, ph_hi, pad0, pad1; };
__global__ void __launch_bounds__(NTHR, 2) mk_fwd(Args args) {
    extern __shared__ __attribute__((aligned(16))) unsigned char lds_raw[];
    ldsp ldsb = (ldsp)lds_raw;
    volatile LAS unsigned* MISC = (volatile LAS unsigned*)(ldsb + MISC_OFF);
    for (int u = threadIdx.x; u < (LDS_BYTES - LDSCTL_OFF) / 4; u += NTHR) ((LAS unsigned*)(ldsb + LDSCTL_OFF))[u] = 0u;
    __syncthreads();
    unsigned* barw = (unsigned*)(args.ws + WS_CTL) + CW_BAR;
    XcdBarrier bar; bar.bar = barw; bar.x = 0; bar.st = nullptr;
    const bool multi = (args.ph_hi - args.ph_lo) > 1;
    if (multi) bar = xcd_barrier_post(barw, MISC + 8);

#pragma unroll 1
    for (int ph = args.ph_lo; ph < args.ph_hi; ++ph) {
#define MKCTX Ctx C; { int tid_ = threadIdx.x, bid_ = blockIdx.x; asm volatile("" : "+v"(tid_)); asm volatile("" : "+s"(bid_)); \
        C.lds = ldsb; C.tid = tid_; C.lane = tid_ & 63; C.wave = __builtin_amdgcn_readfirstlane(tid_ >> 6); C.bid = bid_; C.G = gridDim.x; C.gw = C.bid * NWAVES + C.wave; C.NGW = C.G * NWAVES; \
        C.ws = args.ws; }
        unsigned char* const wsb = args.ws;
        float* MOD = (float*)(wsb + WS_MOD);
        bf16* Hb = (bf16*)(wsb + WS_H); bf16* PROJ = (bf16*)(wsb + WS_PROJ); bf16* SBUF = (bf16*)(wsb + WS_SBUF); bf16* CONCAT = (bf16*)(wsb + WS_CONCAT); bf16* QB = (bf16*)(wsb + WS_QB);
        float* ALOW = (float*)(wsb + WS_ALOW); float* DEC = (float*)(wsb + WS_DEC); int* EB = (int*)(wsb + WS_EB); float* PG = (float*)(wsb + WS_PG);
        float* X = args.out;
        const int l = ph < 2 ? 0 : (ph - 2) / NKIND, kind = ph < 2 ? -1 : (ph - 2) % NKIND;
        const float* modl = MOD + (size_t)l * 4 * MODW;
        if (ph == 0) { if (EN(0)) { MKCTX; p0_prologue(C); } }
        else if (ph == 1) { if (EN(1)) { MKCTX; norm_phase(C, KARG(I_X), KARG(I_N1G), modl, 0, D, Hb); } }
        else if ((kind == 0 || kind == 6) && EN(2)) {
            MKCTX; const bool isq = (kind == 6);
            pg8::Gemm g{Hb, isq ? (const bf16*)(wsb + WS_WTQ) + (size_t)l * D * D : (const bf16*)(wsb + WS_WTIN) + (size_t)l * WTIN_L, T, isq ? D : NPROJ, D};
            pg8::StaticOrder S; S.init(T, g.N, C.G, C.bid);
            pg8::EpiBf16 E{isq ? QB : PROJ, isq ? D : NPROJ};
            pg8::gemm_phase<pg8::EpiBf16, pg8::StaticOrder, GEMM_ALIGN, GEMM_SP2>(C.lds, g, S, E, C.tid);
            if (!isq) alow_phase(C, Hb, (const bf16*)(wsb + WS_WTIN) + (size_t)l * WTIN_L + (size_t)NPROJ * D, ALOW);
        }
        else if (kind == 1 && EN(3)) {
            MKCTX;
            glaA_phase(C, l, PROJ, ALOW, SBUF, DEC);
            gmlp_phase(C, l, PROJ, (const bf16*)(wsb + WS_WSB), CONCAT);
        }
        else if (kind == 2) { if (EN(4)) { MKCTX; scan_phase(C, SBUF, DEC); } }
        else if (kind == 3 && EN(5)) { MKCTX; glaC_phase(C, l, PROJ, ALOW, SBUF, CONCAT); }
        else if (kind == 4 && EN(6)) {
            MKCTX;
            pg8::Gemm g{CONCAT, (const bf16*)(wsb + WS_WTOUT) + (size_t)l * D * D, T, D, D};
            pg8::StaticOrder S; S.init(T, D, C.G, C.bid);
            pg8::EpiResGate E{l == 0 ? KARG(I_X) : (const float*)X, X, modl + 2 * D, MODW};
            pg8::gemm_phase<pg8::EpiResGate, pg8::StaticOrder, GEMM_ALIGN, GEMM_SP2>(C.lds, g, S, E, C.tid);
        }
        else if (kind == 5) { if (EN(1)) { MKCTX; norm_phase<true>(C, X, KARG(I_N2G) + (size_t)l * D, modl, 3 * D, 4 * D, Hb, wsb + WS_H8); } }
        else if (kind == 7) { if (EN(7)) { MKCTX; topk_phase(C, l, QB, (const bf16*)(wsb + WS_K1B), (const bf16*)(wsb + WS_K2B), (const int*)(wsb + WS_KU) + l * NEXP, (const int*)(wsb + WS_KV) + l * NEXP, EB, PG); } }
        else if (kind == 8) { if (EN(8)) { MKCTX; peerU_phase(C, wsb + WS_H8, EB, (const fp8_t*)(wsb + WS_PUB) + (size_t)l * NEXP * D, (float*)SBUF); } }
        else if (kind == 9) { if (EN(9)) { MKCTX; peerV_phase(C, EB, PG, (const float*)SBUF, (const fp8_t*)(wsb + WS_PVB) + (size_t)l * NEXP * D, X, modl + 5 * D); } }
        else if (EN(10)) {
            MKCTX;
            if (l == DEPTH - 1) final_norm_phase(C, X, KARG(I_FG));
            else norm_phase(C, X, KARG(I_N1G) + (size_t)(l + 1) * D, MOD + (size_t)(l + 1) * 4 * MODW, 0, D, Hb);
        }
        if (ph + 1 < args.ph_hi) xcd_barrier(bar);
    }
}

extern "C" void kernel_launch(void* const* d_in, const int* in_sizes, int n_in, void* d_out, int out_size, void* d_ws, size_t ws_size, hipStream_t stream) {
    static int grid = 0;
    if (grid == 0) {
        if (n_in != 21 || out_size != T * D || ws_size < WS_END) { fprintf(stderr, "kernel_launch: unexpected shapes (n_in %d, out %d, ws %zu)\n", n_in, out_size, ws_size); grid = -1; return; }
        int dev = 0, cus = 0, per_cu = 0;
        if (hipGetDevice(&dev) != hipSuccess || hipDeviceGetAttribute(&cus, hipDeviceAttributeMultiprocessorCount, dev) != hipSuccess) { grid = -1; return; }
        if (hipFuncSetAttribute((const void*)mk_fwd, hipFuncAttributeMaxDynamicSharedMemorySize, LDS_BYTES) != hipSuccess) { fprintf(stderr, "kernel_launch: hipFuncSetAttribute failed\n"); grid = -1; return; }
        if (hipOccupancyMaxActiveBlocksPerMultiprocessor(&per_cu, (const void*)mk_fwd, NTHR, LDS_BYTES) != hipSuccess || per_cu < 1) { fprintf(stderr, "kernel_launch: occupancy query says %d blocks per CU\n", per_cu); (void)hipGetLastError(); grid = -1; return; }
        if (cus != 256) { fprintf(stderr, "kernel_launch: built for a 256-CU device (got %d)\n", cus); grid = -1; return; }
        grid = cus;
    }
    if (grid < 0) return;
    (void)hipMemsetAsync((char*)d_ws + WS_CTL, 0, CTL_ZERO_BYTES, stream);
    Args a{};
    for (int i = 0; i < 21; ++i) a.in[i] = (const float*)d_in[i];
    a.out = (float*)d_out; a.ws = (unsigned char*)d_ws;
#if MK_N_LAUNCHES == 1
    a.ph_lo = 0; a.ph_hi = NPH;
    hipLaunchKernelGGL(mk_fwd, dim3(grid), dim3(NTHR), LDS_BYTES, stream, a);
#else
    for (int p = 0; p < NPH; ++p) { a.ph_lo = p; a.ph_hi = p + 1; hipLaunchKernelGGL(mk_fwd, dim3(grid), dim3(NTHR), LDS_BYTES, stream, a); }
#endif
}
```

```cpp
#include <hip/hip_runtime.h>
#include <cstdio>
#include <cstdint>
#ifndef MK_N_LAUNCHES
#define MK_N_LAUNCHES 1
#endif
namespace pg8 {
#define PG8_LAS __attribute__((address_space(3)))
typedef unsigned short bf16_t;
typedef short bf16x8 __attribute__((ext_vector_type(8)));
typedef float f32x4 __attribute__((ext_vector_type(4)));
typedef unsigned u32x4 __attribute__((ext_vector_type(4)));
constexpr int BM = 256, BK = 64, HALF = 128, HTB = HALF * BK * 2  , STAGE_BYTES = 8 * HTB, NXCD = 8, WGM = 8;

__host__ __device__ __forceinline__ int lds_byte(int r, int c) { const int st = (r >> 4) * 2 + (c >> 5), rr = r & 15, cc = c & 31, ob = rr * 64 + cc * 2; return st * 1024 + (ob ^ (((ob >> 9) & 1) << 5)); }
__host__ __device__ __forceinline__ void stage_rc(int b, int& R, int& C) { const int st = b / 1024, sb = b % 1024, swz = sb ^ (((sb >> 9) & 1) << 5); R = (st >> 1) * 16 + swz / 64; C = (st & 1) * 32 + (swz % 64) / 2; }
__host__ __device__ __forceinline__ int perm32(int rho) { const int n = rho >> 4, i = rho & 15; return 8 * (i >> 2) + 4 * n + (i & 3); }

struct Unit { int pm, pn; };
struct Gemm { const bf16_t* A; const bf16_t* Bt; int M, N, K; };

struct StaticOrder {
    int nM, nN, nwg, G, c;
    __host__ __device__ void init(int M, int N, int G_, int c_) { nM = M / BM; nN = N / BM; nwg = nM * nN; G = G_; c = c_; }
    __host__ __device__ bool next(int i, Unit& u) const {
        const long L = (long)i * G + c; if (L >= nwg) return false;
        int wgid = (int)L; { const int q = nwg / NXCD, r = nwg % NXCD, xcd = wgid % NXCD, off = wgid / NXCD; wgid = (xcd < r ? xcd * (q + 1) : r * (q + 1) + (xcd - r) * q) + off; }
        const int nig = WGM * nN, gid = wgid / nig, fm = gid * WGM, gsz = (nM - fm) < WGM ? (nM - fm) : WGM;
        u.pm = fm + ((wgid % nig) % gsz); u.pn = (wgid % nig) / gsz; return true;
    }
    __device__ __forceinline__ void a_ready(const Unit&) const {}
    __device__ __forceinline__ void done(const Unit&) const {}
};
__device__ __forceinline__ unsigned cvt_pk_bf16(float lo, float hi) { unsigned r; asm volatile("v_cvt_pk_bf16_f32 %0, %1, %2" : "=v"(r) : "v"(lo), "v"(hi)); return r; }
struct EpiBf16 {
    static constexpr bool PERM = true, AFTER_DRAIN = false;
    bf16_t* O; int ldc;
    __device__ __forceinline__ void operator()(const f32x4 (&acc)[2][2][4][2], const Unit& u, int wr, int wc, int fr, int fq) const {
        const int row0 = u.pm * BM + wr * 64 + fr; const int col0 = u.pn * BM + wc * 32 + 8 * fq;
#pragma unroll
        for (int ai = 0; ai < 2; ++ai)
#pragma unroll
            for (int m = 0; m < 4; ++m) { bf16_t* rowp = O + (size_t)(row0 + ai * HALF + m * 16) * ldc + col0;
#pragma unroll
                for (int bj = 0; bj < 2; ++bj) { const f32x4 v0 = acc[ai][bj][m][0], v1 = acc[ai][bj][m][1];
                    u32x4 w; w.x = cvt_pk_bf16(v0[0], v0[1]); w.y = cvt_pk_bf16(v0[2], v0[3]); w.z = cvt_pk_bf16(v1[0], v1[1]); w.w = cvt_pk_bf16(v1[2], v1[3]);
                    *(u32x4*)(rowp + bj * HALF) = w; } }
    }
};
struct EpiResGate {
    static constexpr bool PERM = false, AFTER_DRAIN = false;
    const float* base; float* out; const float* gate; int gpitch;
    __device__ __forceinline__ void operator()(const f32x4 (&acc)[2][2][4][2], const Unit& u, int wr, int wc, int fr, int fq) const {
        const int row0 = u.pm * BM + wr * 64 + fr, col0 = u.pn * BM + wc * 32 + 4 * fq;
        const float* gp = gate + (size_t)(u.pm >> 4) * gpitch + col0;
        f32x4 gv[2][2];
#pragma unroll
        for (int bj = 0; bj < 2; ++bj)
#pragma unroll
            for (int n = 0; n < 2; ++n) gv[bj][n] = *(const f32x4*)(gp + bj * HALF + n * 16);
#pragma unroll
        for (int ai = 0; ai < 2; ++ai)
#pragma unroll
            for (int m = 0; m < 4; ++m) { const size_t off = (size_t)(row0 + ai * HALF + m * 16) * 2048 + col0;
#pragma unroll
                for (int bj = 0; bj < 2; ++bj)
#pragma unroll
                    for (int n = 0; n < 2; ++n) { const f32x4 bs = *(const f32x4*)(base + off + bj * HALF + n * 16); *(f32x4*)(out + off + bj * HALF + n * 16) = bs + gv[bj][n] * acc[ai][bj][m][n]; }
                asm volatile("" ::: "memory"); }
    }
};

template <class Epi, class Sched, bool ALIGN_EPI = false, bool SP2 = false>
__device__ __forceinline__ void gemm_phase(PG8_LAS unsigned char* lds, const Gemm g, const Sched& S, const Epi& E, const int tid  ) {
    const int wid = __builtin_amdgcn_readfirstlane(tid >> 6), lane = tid & 63, wr = wid >> 2, wc = wid & 3, fr = lane & 15, fq = lane >> 4;
    const int K = g.K, nt = K / BK;
    unsigned voffA[2], voffB[2];
#pragma unroll
    for (int i = 0; i < 2; ++i) { int R, C; stage_rc(tid * 16 + i * 8192, R, C); const int Rb = Epi::PERM ? ((R & ~31) + perm32(R & 31)) : R;
        voffA[i] = (unsigned)(R * K + C) * 2u; voffB[i] = (unsigned)(Rb * K + C) * 2u; }
    const size_t kstep = (size_t)(BK * 2);
    const size_t hstep = (size_t)HALF * K * 2;
    const size_t tstep = 2 * hstep;
    const unsigned ldsw = (unsigned)wid * 1024u;
    const int aoff = lds_byte(wr * 64 + fr, fq * 8), boff = lds_byte(wc * 32 + fr, fq * 8);
#define PG8_SA(b, h) (((b) * 2 + (h)) * HTB)
#define PG8_SB(b, h) ((4 + (b) * 2 + (h)) * HTB)
#define PG8_STAGE(bufoff, gbase, voff) do { _Pragma("unroll") for (int _i = 0; _i < 2; ++_i) \
        __builtin_amdgcn_global_load_lds((const unsigned*)((const char*)(gbase) + (voff)[_i]), (PG8_LAS unsigned*)(lds + (bufoff) + ldsw + _i * 8192), 16, 0, 0); } while (0)
#define PG8_LDA(dst, b, h) do { _Pragma("unroll") for (int m = 0; m < 4; ++m) _Pragma("unroll") for (int k = 0; k < 2; ++k) dst[m][k] = *(const PG8_LAS bf16x8*)(lds + PG8_SA(b, h) + aoff + m * 2048 + k * 1024); } while (0)
#define PG8_LDB(dst, b, h) do { _Pragma("unroll") for (int n = 0; n < 2; ++n) _Pragma("unroll") for (int k = 0; k < 2; ++k) dst[n][k] = *(const PG8_LAS bf16x8*)(lds + PG8_SB(b, h) + boff + n * 2048 + k * 1024); } while (0)
#define PG8_MMA(ai, bj, At, Bt) do { __builtin_amdgcn_s_setprio(1); _Pragma("unroll") for (int m = 0; m < 4; ++m) _Pragma("unroll") for (int n = 0; n < 2; ++n) _Pragma("unroll") for (int k = 0; k < 2; ++k) \
        acc[ai][bj][m][n] = __builtin_amdgcn_mfma_f32_16x16x32_bf16(Bt[n][k], At[m][k], acc[ai][bj][m][n], 0, 0, 0); __builtin_amdgcn_s_setprio(0); } while (0)
#define PG8_WAIT_V(n) asm volatile("s_waitcnt vmcnt(" #n ")" ::: "memory")
#define PG8_WAIT_L(n) asm volatile("s_waitcnt lgkmcnt(" #n ")" ::: "memory")
#define PG8_BAR __builtin_amdgcn_s_barrier()
#define PG8_SCHED __builtin_amdgcn_sched_barrier(0)
    Unit cur, nxt; int ui = 0;
    if (!S.next(0, cur)) return;
    f32x4 acc[2][2][4][2];
#pragma unroll
    for (int a = 0; a < 2; ++a)
#pragma unroll
        for (int b = 0; b < 2; ++b)
#pragma unroll
            for (int m = 0; m < 4; ++m)
#pragma unroll
                for (int n = 0; n < 2; ++n) acc[a][b][m][n] = (f32x4){0.f, 0.f, 0.f, 0.f};
    bf16x8 At[4][2], B0[2][2], B1[2][2];
    const char* cA = (const char*)g.A + (size_t)cur.pm * tstep; const char* cB = (const char*)g.Bt + (size_t)cur.pn * tstep;
    S.a_ready(cur);
    if constexpr (SP2) {
        PG8_STAGE(PG8_SB(0, 0), cB, voffB); PG8_STAGE(PG8_SB(0, 1), cB + hstep, voffB); PG8_STAGE(PG8_SA(0, 0), cA, voffA); PG8_STAGE(PG8_SA(0, 1), cA + hstep, voffA);
        if (wr == 1) PG8_BAR;
        PG8_WAIT_V(2); PG8_BAR;
        PG8_STAGE(PG8_SB(1, 0), cB + kstep, voffB); PG8_STAGE(PG8_SA(1, 0), cA + kstep, voffA); PG8_STAGE(PG8_SB(1, 1), cB + hstep + kstep, voffB);
        PG8_WAIT_V(6); PG8_BAR;
    } else {
        PG8_STAGE(PG8_SB(0, 0), cB, voffB); PG8_STAGE(PG8_SA(0, 0), cA, voffA); PG8_STAGE(PG8_SB(0, 1), cB + hstep, voffB); PG8_STAGE(PG8_SA(0, 1), cA + hstep, voffA);
        if (wr == 1) PG8_BAR;
        PG8_WAIT_V(4); PG8_BAR;
        PG8_STAGE(PG8_SB(1, 0), cB + kstep, voffB); PG8_STAGE(PG8_SA(1, 0), cA + kstep, voffA); PG8_STAGE(PG8_SB(1, 1), cB + hstep + kstep, voffB);
        PG8_WAIT_V(6); PG8_BAR;
    }
    for (;;) {
        const bool has_next = S.next(ui + 1, nxt);
        const char* nA = has_next ? (const char*)g.A + (size_t)nxt.pm * tstep : cA; const char* nB = has_next ? (const char*)g.Bt + (size_t)nxt.pn * tstep : cB;
        for (int t = 0; t < nt; t += 2) {
            const bool last = (t == nt - 2);
            const char* a1 = cA + (size_t)(t + 1) * kstep;
            const char* a2 = last ? nA : cA + (size_t)(t + 2) * kstep; const char* b2 = last ? nB : cB + (size_t)(t + 2) * kstep;
            const char* a3 = a2 + kstep; const char* b3 = b2 + kstep;
            if (last && has_next) S.a_ready(nxt);
            if constexpr (SP2) {
            PG8_LDB(B0, 0, 0); PG8_LDB(B1, 0, 1); PG8_SCHED; PG8_LDA(At, 0, 0); PG8_STAGE(PG8_SA(1, 1), a1 + hstep, voffA);
            PG8_WAIT_V(8); PG8_WAIT_L(0); PG8_BAR; PG8_MMA(0, 0, At, B0); PG8_MMA(0, 1, At, B1); PG8_BAR; PG8_SCHED;
            PG8_LDA(At, 0, 1); PG8_STAGE(PG8_SB(0, 0), b2, voffB); PG8_STAGE(PG8_SB(0, 1), b2 + hstep, voffB); PG8_STAGE(PG8_SA(0, 0), a2, voffA);
            PG8_WAIT_V(8); PG8_WAIT_L(0); PG8_BAR; PG8_MMA(1, 0, At, B0); PG8_MMA(1, 1, At, B1); PG8_BAR; PG8_SCHED;
            PG8_LDB(B0, 1, 0); PG8_LDB(B1, 1, 1); PG8_SCHED; PG8_LDA(At, 1, 0); PG8_STAGE(PG8_SA(0, 1), a2 + hstep, voffA);
            PG8_WAIT_V(8); PG8_WAIT_L(0); PG8_BAR; PG8_MMA(0, 0, At, B0); PG8_MMA(0, 1, At, B1); PG8_BAR; PG8_SCHED;
            PG8_LDA(At, 1, 1); PG8_STAGE(PG8_SB(1, 0), b3, voffB); PG8_STAGE(PG8_SB(1, 1), b3 + hstep, voffB); PG8_STAGE(PG8_SA(1, 0), a3, voffA);
            PG8_WAIT_V(8); PG8_WAIT_L(0); PG8_BAR; PG8_MMA(1, 0, At, B0); PG8_MMA(1, 1, At, B1); PG8_BAR; PG8_SCHED;
            } else {
            PG8_LDB(B0, 0, 0); PG8_SCHED; PG8_LDA(At, 0, 0); PG8_STAGE(PG8_SA(1, 1), a1 + hstep, voffA);
            PG8_WAIT_L(8); PG8_BAR; PG8_WAIT_L(0); PG8_MMA(0, 0, At, B0); PG8_BAR; PG8_SCHED;
            PG8_LDB(B1, 0, 1); PG8_STAGE(PG8_SB(0, 0), b2, voffB);
            PG8_BAR; PG8_WAIT_L(0); PG8_MMA(0, 1, At, B1); PG8_BAR;
            PG8_LDA(At, 0, 1); PG8_STAGE(PG8_SA(0, 0), a2, voffA);
            PG8_BAR; PG8_WAIT_L(0); PG8_MMA(1, 0, At, B0); PG8_BAR; PG8_SCHED;
            PG8_STAGE(PG8_SB(0, 1), b2 + hstep, voffB);
            PG8_WAIT_V(6); PG8_BAR; PG8_MMA(1, 1, At, B1); PG8_BAR;
            PG8_LDB(B0, 1, 0); PG8_SCHED; PG8_LDA(At, 1, 0); PG8_STAGE(PG8_SA(0, 1), a2 + hstep, voffA);
            PG8_WAIT_L(8); PG8_BAR; PG8_WAIT_L(0); PG8_MMA(0, 0, At, B0); PG8_BAR; PG8_SCHED;
            PG8_LDB(B1, 1, 1); PG8_STAGE(PG8_SB(1, 0), b3, voffB);
            PG8_BAR; PG8_WAIT_L(0); PG8_MMA(0, 1, At, B1); PG8_BAR;
            PG8_LDA(At, 1, 1); PG8_STAGE(PG8_SA(1, 0), a3, voffA);
            PG8_BAR; PG8_WAIT_L(0); PG8_MMA(1, 0, At, B0); PG8_BAR; PG8_SCHED;
            PG8_STAGE(PG8_SB(1, 1), b3 + hstep, voffB);
            PG8_WAIT_V(6); PG8_BAR; PG8_MMA(1, 1, At, B1); PG8_BAR;
            }
        }
        if constexpr (ALIGN_EPI) { if (wr == 0) PG8_BAR; }
        if constexpr (!Epi::AFTER_DRAIN) { E(acc, cur, wr, wc, fr, fq); S.done(cur); }
        if (!has_next) break;
#pragma unroll
        for (int a = 0; a < 2; ++a)
#pragma unroll
            for (int b = 0; b < 2; ++b)
#pragma unroll
                for (int m = 0; m < 4; ++m)
#pragma unroll
                    for (int n = 0; n < 2; ++n) acc[a][b][m][n] = (f32x4){0.f, 0.f, 0.f, 0.f};
        cur = nxt; cA = nA; cB = nB; ++ui;
        if constexpr (ALIGN_EPI) { if (wr == 1) PG8_BAR; }
    }
    PG8_WAIT_V(0);
    if constexpr (!ALIGN_EPI) { if (wr == 0) PG8_BAR; }
    PG8_BAR;
    if constexpr (Epi::AFTER_DRAIN) { E.fused(acc, cur, wr, wc, fr, fq, lds, wid, lane); S.done(cur); }
#undef PG8_SA
#undef PG8_SB
#undef PG8_STAGE
#undef PG8_LDA
#undef PG8_LDB
#undef PG8_MMA
#undef PG8_WAIT_V
#undef PG8_WAIT_L
#undef PG8_BAR
#undef PG8_SCHED
}
}
constexpr int NWAVES = 8, NTHR = 512;
constexpr int D = 2048, NBATCH = 4, SEQ = 4096, T = NBATCH * SEQ, DEPTH = 2;
constexpr int GLA_H = 4, GLA_DK = 128, GLA_DV = 256, GLA_CH = 64;
constexpr int MLP_H = 8, MLP_DH = 128, MLP_CH = 128;
constexpr int IN_COLS = 5136, NPROJ = 5120;
constexpr int C_Q = 0, C_K = 512, C_V = 1024, C_R = 2048, C_U = 3072, C_VS = 4096;
constexpr int NEXP = 16384, PEER_H = 8;
constexpr float EPS = 1e-6f;
constexpr int MODW = 6 * D;
constexpr size_t MiB = 1u << 20;
constexpr size_t WS_CTL = 0, CTL_ZERO_BYTES = 1 * MiB;
constexpr size_t WS_MOD = 1 * MiB;
constexpr size_t WS_K1B = 2 * MiB, WS_K2B = 2 * MiB + 512 * 1024, WS_WSB = 3 * MiB, WS_DEC = 3 * MiB + 512 * 1024, WS_ALOW = 4 * MiB;
constexpr size_t WS_KU = 5 * MiB, WS_KV = 5 * MiB + 256 * 1024;
constexpr size_t WS_SU = 6 * MiB, WS_HS = 7 * MiB;
constexpr size_t WS_WTIN = 8 * MiB;
constexpr size_t WTIN_L = (size_t)5136 * 2048;
constexpr size_t WS_WTOUT = 49 * MiB, WS_WTQ = 65 * MiB;
constexpr size_t WS_PUB = 81 * MiB, WS_PVB = 209 * MiB;
constexpr size_t WS_H = 337 * MiB;
constexpr size_t WS_PROJ = 401 * MiB;
constexpr size_t WS_SBUF = 561 * MiB;
constexpr size_t WS_CONCAT = 625 * MiB;
constexpr size_t WS_QB = 689 * MiB;
constexpr size_t WS_EB = 753 * MiB, WS_PG = 761 * MiB;
constexpr size_t WS_H8 = 769 * MiB, WS_END = 833 * MiB;
static_assert(WS_WTIN + 2 * WTIN_L * 2 <= WS_WTOUT, "ws map");
constexpr int CW_BAR = 4096;
constexpr int RING_BYTES = 131072, LDSCTL_OFF = RING_BYTES, MISC_OFF = LDSCTL_OFF + 320, LDS_BYTES = 147456;

#define DI __device__ __forceinline__
#define LAS __attribute__((address_space(3)))
typedef unsigned short bf16;
typedef short bf16x8 __attribute__((ext_vector_type(8)));
typedef short s16x4 __attribute__((ext_vector_type(4)));
typedef short v4i16_t __attribute__((ext_vector_type(4)));
typedef __bf16 bf16x2_t __attribute__((ext_vector_type(2)));
typedef float f32x4 __attribute__((ext_vector_type(4)));
typedef float f32x2 __attribute__((ext_vector_type(2)));
typedef unsigned u32x4 __attribute__((ext_vector_type(4)));
typedef unsigned u32x2 __attribute__((ext_vector_type(2)));
typedef LAS unsigned char* ldsp;

DI unsigned f2bf(float f) { unsigned u = __builtin_bit_cast(unsigned, f); return (u + 0x7fffu + ((u >> 16) & 1u)) >> 16; }
DI unsigned pk2(float lo, float hi) { return f2bf(lo) | (f2bf(hi) << 16); }
DI float bflo(unsigned u) { return __builtin_bit_cast(float, u << 16); }
DI float bfhi(unsigned u) { return __builtin_bit_cast(float, u & 0xffff0000u); }
DI float bf1(bf16 v) { return __builtin_bit_cast(float, ((unsigned)v) << 16); }
DI float fexp2(float x) { return __builtin_amdgcn_exp2f(x); }
DI float flog2(float x) { return __builtin_amdgcn_logf(x); }
DI float frcp(float x) { return __builtin_amdgcn_rcpf(x); }
DI float frsq(float x) { return __builtin_amdgcn_rsqf(x); }
DI float gelu_t(float x) { const float u = 0.7978845608f * (x + 0.044715f * x * x * x); return x * frcp(1.f + fexp2(-2.885390082f * u)); }
DI float silu_f(float x) { return x * frcp(1.f + fexp2(-1.442695041f * x)); }
template <int CTRL> DI float dppf(float v) { return __builtin_bit_cast(float, __builtin_amdgcn_update_dpp(0, __builtin_bit_cast(int, v), CTRL, 0xf, 0xf, true)); }
DI float wave_sum_u(float v) {
    v += dppf<0xB1>(v); v += dppf<0x4E>(v); v += dppf<0x141>(v); v += dppf<0x140>(v);
    const int iv = __builtin_bit_cast(int, v);
    return (__builtin_bit_cast(float, __builtin_amdgcn_readlane(iv, 0)) + __builtin_bit_cast(float, __builtin_amdgcn_readlane(iv, 16))) +
           (__builtin_bit_cast(float, __builtin_amdgcn_readlane(iv, 32)) + __builtin_bit_cast(float, __builtin_amdgcn_readlane(iv, 48)));
}
DI float wave_sum(float v) {
#pragma unroll
    for (int o = 1; o < 64; o <<= 1) v += __shfl_xor(v, o);
    return v;
}
DI float dot2bf(unsigned a, unsigned b, float c) { return __builtin_amdgcn_fdot2_f32_bf16(__builtin_bit_cast(bf16x2_t, a), __builtin_bit_cast(bf16x2_t, b), c, false); }
DI f32x4 mfma16(bf16x8 a, bf16x8 b, f32x4 c) { return __builtin_amdgcn_mfma_f32_16x16x32_bf16(a, b, c, 0, 0, 0); }
DI s16x4 tr4(const LAS bf16* p) { return __builtin_bit_cast(s16x4, __builtin_amdgcn_ds_read_tr16_b64_v4i16((LAS v4i16_t*)p)); }
DI bf16x8 tr8(const LAS bf16* p, int stride) { const s16x4 a = tr4(p), b = tr4(p + 4 * stride); return (bf16x8){a[0], a[1], a[2], a[3], b[0], b[1], b[2], b[3]}; }

#define XB_TMO      128
#define XB_XCNT(j)  (256  + 64 * (j))
#define XB_XSUB(j)  (1280 + 64 * (j))
#define XB_XGEN(j)  (2304 + 64 * (j))
#define XB_TOP      3328
#define XB_TOPGEN   3392
#define XCD_BAR_WORDS 3456
#define XB_SPIN_CAP (1u << 18)

__device__ __forceinline__ unsigned xb_ld(unsigned* p)              { return __hip_atomic_load(p, __ATOMIC_RELAXED, __HIP_MEMORY_SCOPE_AGENT); }
__device__ __forceinline__ unsigned xb_add(unsigned* p, unsigned v) { return __hip_atomic_fetch_add(p, v, __ATOMIC_RELAXED, __HIP_MEMORY_SCOPE_AGENT); }
__device__ __forceinline__ unsigned xb_xcc_id() { return (unsigned)__builtin_amdgcn_s_getreg((3 << 11) | 20) & 0xFu; }
#define XB_SPIN(cond, bar) do { unsigned _sp = 0; while (cond) { __builtin_amdgcn_s_sleep(1); \
    if ((++_sp & 255u) == 0u) { if (xb_ld(&(bar)[XB_TMO])) break; if (_sp > XB_SPIN_CAP) { atomicAdd(&(bar)[XB_TMO], 1u); break; } } } } while (0)

struct XcdBarrier {
    unsigned* bar; unsigned x;
    volatile LAS unsigned* st;
};

__device__ __forceinline__ XcdBarrier xcd_barrier_post(unsigned* bar, volatile LAS unsigned* st) {
    XcdBarrier b; b.bar = bar; b.x = xb_xcc_id(); b.st = st;
    if (threadIdx.x == 0) (void)xb_add(&bar[XB_XCNT(b.x)], 1u);
    return b;
}
__device__ __forceinline__ void xcd_barrier_complete(unsigned* bar, unsigned x, unsigned& nloc, unsigned& nx) {
    const unsigned G = gridDim.x * gridDim.y * gridDim.z;
    unsigned sum, cnt, mine, sp = 0u;
    for (;;) {
        sum = 0u; cnt = 0u; mine = 0u;
#pragma unroll
        for (unsigned j = 0; j < 16; ++j) { const unsigned c = xb_ld(&bar[XB_XCNT(j)]); sum += c; cnt += (c > 0u) ? 1u : 0u; mine = (j == x) ? c : mine; }
        if (sum == G) break;
        __builtin_amdgcn_s_sleep(1);
        if ((++sp & 255u) == 0u) { if (xb_ld(&bar[XB_TMO])) break; if (sp > XB_SPIN_CAP) { atomicAdd(&bar[XB_TMO], 1u); break; } }
    }
    nloc = mine > 0u ? mine : 1u; nx = cnt > 0u ? cnt : 1u;
}

__device__ __forceinline__ void xcd_barrier(const XcdBarrier& b) {
    asm volatile("s_waitcnt vmcnt(0)" ::: "memory");
    __syncthreads();
    if (threadIdx.x == 0) {
        unsigned* bar = b.bar;
        __builtin_amdgcn_s_waitcnt(0);
        unsigned nloc = b.st[0], nx = b.st[1];
        if (nloc == 0u) { xcd_barrier_complete(bar, b.x, nloc, nx); b.st[0] = nloc; b.st[1] = nx; }
        const unsigned old = xb_add(&bar[XB_XSUB(b.x)], 1u);
        const unsigned gen = old / nloc;
        if (old + 1u == (gen + 1u) * nloc) {
            __builtin_amdgcn_fence(__ATOMIC_RELEASE, "agent");
            asm volatile("s_waitcnt vmcnt(0)" ::: "memory");
            const unsigned og = xb_add(&bar[XB_TOP], 1u);
            const unsigned tg = og / nx;
            if (og + 1u == (tg + 1u) * nx) xb_add(&bar[XB_TOPGEN], 1u);
            else XB_SPIN(xb_ld(&bar[XB_TOPGEN]) == tg, bar);
            __builtin_amdgcn_fence(__ATOMIC_ACQUIRE, "agent");
            xb_add(&bar[XB_XGEN(b.x)], 1u);
            asm volatile("s_waitcnt vmcnt(0)" ::: "memory");
        } else {
            XB_SPIN(xb_ld(&bar[XB_XGEN(b.x)]) == gen, bar);
            __builtin_amdgcn_fence(__ATOMIC_ACQUIRE, "agent");
            asm volatile("s_waitcnt vmcnt(0)" ::: "memory");
        }
    }
    __syncthreads();
}
struct Ctx {
    ldsp lds; int tid, lane, wave, bid, G, gw, NGW;
    unsigned char* ws;
};
DI const float* KARG(int k) { asm volatile("" : "+s"(k)); return ((const float* const*)__builtin_amdgcn_kernarg_segment_ptr())[k]; }
#define LDS_WAIT() asm volatile("s_waitcnt lgkmcnt(0)" ::: "memory")
enum { I_X = 0, I_C, I_ADAW, I_ADAB, I_N1G, I_WIN, I_WA2, I_BA, I_GNG, I_VNG, I_MWS, I_MB, I_MOG, I_WOUT, I_N2G, I_WQ, I_K1, I_K2, I_PU, I_PV, I_FG };

DI void p0_ada(const Ctx& C) {
    LAS float* red = (LAS float*)C.lds;
    float* MOD = (float*)(C.ws + WS_MOD);
    for (int it = C.bid; it < 192; it += C.G) {
        const int l = it / 96, cg = it % 96, c0 = cg * 128 + C.lane * 2;
        const float* W = KARG(I_ADAW) + (size_t)l * D * MODW + (size_t)(C.wave * 256) * MODW + c0;
        float cv[4][4];
#pragma unroll
        for (int b = 0; b < 4; ++b)
#pragma unroll
            for (int i = 0; i < 4; ++i) cv[b][i] = silu_f(KARG(I_C)[b * D + C.wave * 256 + i * 64 + C.lane]);
        float acc[4][2];
#pragma unroll
        for (int b = 0; b < 4; ++b) { acc[b][0] = 0.f; acc[b][1] = 0.f; }
#pragma unroll
        for (int i = 0; i < 4; ++i) {
#pragma unroll 16
            for (int j = 0; j < 64; ++j) {
                const f32x2 w = *(const f32x2*)(W + (size_t)(i * 64 + j) * MODW);
#pragma unroll
                for (int b = 0; b < 4; ++b) { const float s = __builtin_bit_cast(float, __builtin_amdgcn_readlane(__builtin_bit_cast(int, cv[b][i]), j)); acc[b][0] += s * w.x; acc[b][1] += s * w.y; }
            }
        }
#pragma unroll
        for (int b = 0; b < 4; ++b) *(LAS f32x2*)(red + (C.wave * 4 + b) * 128 + C.lane * 2) = (f32x2){acc[b][0], acc[b][1]};
        __syncthreads();
        { const int b = C.tid >> 7, col = C.tid & 127; float s = KARG(I_ADAB)[l * MODW + cg * 128 + col];
#pragma unroll
          for (int w = 0; w < 8; ++w) s += red[(w * 4 + b) * 128 + col];
          MOD[(size_t)(l * 4 + b) * MODW + cg * 128 + col] = s; }
        __syncthreads();
    }
}
DI void transpose_item(const float* W, int ldw, int src_col0, int ncols, bf16* WT, int dst_row0, int k0, LAS float* scr, int lane) {
    const int cl = lane & 31;
    float v[32];
#pragma unroll
    for (int i = 0; i < 32; ++i) { const int kk = 2 * i + (lane >> 5); v[i] = 0.f; if (cl < ncols) v[i] = W[(size_t)(k0 + kk) * ldw + src_col0 + cl]; }
#pragma unroll
    for (int i = 0; i < 32; ++i) { const int kk = 2 * i + (lane >> 5); scr[kk * 33 + cl] = v[i]; }
    LDS_WAIT();
    const int c = lane & 7;
#pragma unroll
    for (int j = 0; j < 4; ++j) { const int n = (lane >> 3) + 8 * j;
        if (n < ncols) { const LAS float* s = scr + (8 * c) * 33 + n;
            u32x4 o; o.x = pk2(s[0 * 33], s[1 * 33]); o.y = pk2(s[2 * 33], s[3 * 33]); o.z = pk2(s[4 * 33], s[5 * 33]); o.w = pk2(s[6 * 33], s[7 * 33]);
            *(u32x4*)(WT + (size_t)(dst_row0 + n) * 2048 + k0 + 8 * c) = o; } }
    LDS_WAIT();
}
DI void p0_prologue(const Ctx& C) {
    p0_ada(C);
    LAS float* scr = (LAS float*)(C.lds + C.wave * 16384);
    constexpr int PER_L = (161 + 64 + 64) * 32;
    for (int it = C.gw; it < 2 * PER_L; it += C.NGW) {
        const int l = it / PER_L; int r = it % PER_L;
        if (r < 161 * 32) { const int kb = r / 161, nb = r % 161; bf16* WT = (bf16*)(C.ws + WS_WTIN) + (size_t)l * WTIN_L;
            const float* W = KARG(I_WIN) + (size_t)l * D * IN_COLS;
            if (nb < 160) { const int n0 = 32 * nb; transpose_item(W, IN_COLS, n0 + (n0 >= 3072 ? 16 : 0), 32, WT, n0, 64 * kb, scr, C.lane); }
            else transpose_item(W, IN_COLS, 3072, 16, WT, 5120, 64 * kb, scr, C.lane);
            continue; }
        r -= 161 * 32;
        if (r < 2048) { const int kb = r / 64, nb = r % 64; transpose_item(KARG(I_WOUT) + (size_t)l * D * D, D, 32 * nb, 32, (bf16*)(C.ws + WS_WTOUT) + (size_t)l * D * D, 32 * nb, 64 * kb, scr, C.lane); continue; }
        r -= 2048;
        { const int kb = r / 64, nb = r % 64; transpose_item(KARG(I_WQ) + (size_t)l * D * D, D, 32 * nb, 32, (bf16*)(C.ws + WS_WTQ) + (size_t)l * D * D, 32 * nb, 64 * kb, scr, C.lane); }
    }
    const int gt = C.bid * NTHR + C.tid, NT = C.G * NTHR;
    { bf16* K1B = (bf16*)(C.ws + WS_K1B); bf16* K2B = (bf16*)(C.ws + WS_K2B); bf16* WSB = (bf16*)(C.ws + WS_WSB);
      for (int i = gt; i < 262144; i += NT) { K1B[i] = (bf16)f2bf(KARG(I_K1)[i]); K2B[i] = (bf16)f2bf(KARG(I_K2)[i]);
          const int s = i & 127, t = (i >> 7) & 127; WSB[i] = (s <= t) ? (bf16)f2bf(KARG(I_MWS)[i]) : (bf16)0; } }
    { float* SU = (float*)(C.ws + WS_SU); int* KV = (int*)(C.ws + WS_KV);
#pragma unroll 1
      for (int row = C.gw; row < 4 * NEXP; row += C.NGW) {
          const int tb = row >> 15, rr = row & 32767;
          const f32x4* src = (const f32x4*)(KARG(tb ? I_PV : I_PU) + (size_t)rr * D) + C.lane;
          f32x4 v[8];
#pragma unroll
          for (int j = 0; j < 8; ++j) v[j] = src[64 * j];
          const int lyr = rr >> 14, ee = rr & 16383;
          unsigned* dst = (unsigned*)(C.ws + (tb ? WS_PVB : WS_PUB) + (size_t)lyr * NEXP * D + (size_t)ee * 256) + C.lane;
          if (tb) {
              float mx = 0.f;
#pragma unroll
              for (int j = 0; j < 8; ++j) mx = fmaxf(mx, fmaxf(fmaxf(fabsf(v[j].x), fabsf(v[j].y)), fmaxf(fabsf(v[j].z), fabsf(v[j].w))));
#pragma unroll
              for (int o = 1; o < 64; o <<= 1) mx = fmaxf(mx, __shfl_xor(mx, o));
              int k = 0;
              if (mx > 0.f) { k = (int)((__builtin_bit_cast(unsigned, 224.0f / mx) >> 23) & 255u) - 127; k = k < -60 ? -60 : (k > 60 ? 60 : k); }
              const float sc = __builtin_bit_cast(float, (unsigned)(k + 127) << 23);
#pragma unroll
              for (int j = 0; j < 8; ++j) { int p = 0; p = __builtin_amdgcn_cvt_pk_fp8_f32(v[j].x * sc, v[j].y * sc, p, false); p = __builtin_amdgcn_cvt_pk_fp8_f32(v[j].z * sc, v[j].w * sc, p, true); dst[(size_t)j * (NEXP * 256 / 4)] = (unsigned)p; }
              if (C.lane == 0) KV[rr] = k;
          } else {
#pragma unroll
              for (int j = 0; j < 8; ++j) {
                  float mx = fmaxf(fmaxf(fabsf(v[j].x), fabsf(v[j].y)), fmaxf(fabsf(v[j].z), fabsf(v[j].w)));
#pragma unroll
                  for (int o = 1; o < 64; o <<= 1) mx = fmaxf(mx, __shfl_xor(mx, o));
                  const float inv = mx > 0.f ? 127.0f / mx : 0.f;
                  const int q0 = (int)__builtin_rintf(v[j].x * inv), q1 = (int)__builtin_rintf(v[j].y * inv), q2 = (int)__builtin_rintf(v[j].z * inv), q3 = (int)__builtin_rintf(v[j].w * inv);
                  dst[(size_t)j * (NEXP * 256 / 4)] = (unsigned)(q0 & 255) | ((unsigned)(q1 & 255) << 8) | ((unsigned)(q2 & 255) << 16) | ((unsigned)q3 << 24);
                  if (C.lane == 0) SU[(size_t)(lyr * 8 + j) * NEXP + ee] = mx * (1.0f / 127.0f);
              }
          }
      } }
}
template <bool FP8 = false>
DI void norm_phase(const Ctx& C, const float* X, const float* g, const float* modl, int sh_off, int sc_off, bf16* Hout, unsigned char* H8 = nullptr, float* HS = nullptr) {
    const int r0 = C.gw * 8, b = r0 >> 12;
    const f32x4* shp = (const f32x4*)(modl + (size_t)b * MODW + sh_off); const f32x4* scp = (const f32x4*)(modl + (size_t)b * MODW + sc_off);
    f32x4 gm[8], shv[8];
#pragma unroll
    for (int j = 0; j < 8; ++j) { const int idx = 64 * j + C.lane; gm[j] = ((const f32x4*)g)[idx] * (scp[idx] + 1.0f); shv[j] = shp[idx]; }
#pragma unroll 1
    for (int i = 0; i < 8; ++i) {
        const f32x4* xr = (const f32x4*)(X + (size_t)(r0 + i) * D) + C.lane; f32x4 v[8]; float s = 0.f;
#pragma unroll
        for (int j = 0; j < 8; ++j) { v[j] = xr[64 * j]; s += (v[j].x * v[j].x + v[j].y * v[j].y) + (v[j].z * v[j].z + v[j].w * v[j].w); }
        const float rstd = frsq(wave_sum(s) * (1.f / D) + EPS);
        u32x2* o = (u32x2*)(Hout + (size_t)(r0 + i) * D) + C.lane;
        float am = 0.f;
#pragma unroll
        for (int j = 0; j < 8; ++j) { const f32x4 y = v[j] * rstd * gm[j] + shv[j]; u32x2 w; w.x = pk2(y.x, y.y); w.y = pk2(y.z, y.w); o[64 * j] = w;
            if (FP8) { v[j] = y; am = fmaxf(am, fmaxf(fmaxf(fabsf(y.x), fabsf(y.y)), fmaxf(fabsf(y.z), fabsf(y.w)))); } }
        if (FP8) {
#pragma unroll
            for (int of = 1; of < 64; of <<= 1) am = fmaxf(am, __shfl_xor(am, of));
            const float qs = am > 0.f ? 16256.0f / am : 0.f;
            if (C.lane == 0) HS[r0 + i] = am * (1.0f / 16256.0f);
            unsigned* h8 = (unsigned*)(H8 + (size_t)(r0 + i) * 4096) + C.lane;
#pragma unroll
            for (int j = 0; j < 8; ++j) {
                const int q0 = (int)__builtin_rintf(v[j].x * qs), q1 = (int)__builtin_rintf(v[j].y * qs), q2 = (int)__builtin_rintf(v[j].z * qs), q3 = (int)__builtin_rintf(v[j].w * qs);
                const int h0 = (q0 + 64) >> 7, h1 = (q1 + 64) >> 7, h2 = (q2 + 64) >> 7, h3 = (q3 + 64) >> 7;
                const int l0 = q0 - (h0 << 7), l1 = q1 - (h1 << 7), l2 = q2 - (h2 << 7), l3 = q3 - (h3 << 7);
                h8[64 * j] = (unsigned)(h0 & 255) | ((unsigned)(h1 & 255) << 8) | ((unsigned)(h2 & 255) << 16) | ((unsigned)h3 << 24);
                h8[512 + 64 * j] = (unsigned)(l0 & 255) | ((unsigned)(l1 & 255) << 8) | ((unsigned)(l2 & 255) << 16) | ((unsigned)l3 << 24); }
        }
    }
}
DI void alow_phase(const Ctx& C, const bf16* Hb, const bf16* WtA, float* ALOW) {
    const int task = C.bid * 4 + (C.wave & 3), kh = C.wave >> 2, r0 = task * 16, fr = C.lane & 15, fq = C.lane >> 4;
    const bf16* ap = Hb + (size_t)(r0 + fr) * D + 8 * fq + 1024 * kh; const bf16* bp = WtA + (size_t)fr * D + 8 * fq + 1024 * kh;
    f32x4 acc = (f32x4){0.f, 0.f, 0.f, 0.f};
#pragma unroll 8
    for (int ks = 0; ks < 32; ++ks) { const bf16x8 a = *(const bf16x8*)(ap + 32 * ks), b = *(const bf16x8*)(bp + 32 * ks); acc = mfma16(a, b, acc); }
    LAS f32x4* xch = (LAS f32x4*)C.lds + (C.wave & 3) * 64 + C.lane;
    if (kh) *xch = acc;
    LDS_WAIT(); __builtin_amdgcn_s_barrier(); asm volatile("" ::: "memory");
    if (!kh) { acc += *xch;
#pragma unroll
        for (int r = 0; r < 4; ++r) ALOW[(size_t)(r0 + 4 * fq + r) * 16 + fr] = acc[r]; }
}
#define LBAR() do { asm volatile("s_waitcnt lgkmcnt(0)" ::: "memory"); __builtin_amdgcn_s_barrier(); asm volatile("" ::: "memory"); } while (0)
DI void gla_gates(const Ctx& C, LAS float* al, LAS float* tot, const f32x4 alv, const float (&w2)[16], const float bav, float (&Gl)[16], float& off, float& gref, float& g63) {
    const int d = C.tid & 127, jg = C.tid >> 7;
    if (C.tid < 256) ((LAS f32x4*)al)[C.tid] = alv;
    LBAR();
    float run = 0.f;
#pragma unroll
    for (int jj = 0; jj < 16; ++jj) {
        const LAS f32x4* ar = (const LAS f32x4*)(al + (jg * 16 + jj) * 16);
        const f32x4 a0 = ar[0], a1 = ar[1], a2 = ar[2], a3 = ar[3];
        float z = bav;
        z += a0.x * w2[0] + a0.y * w2[1] + a0.z * w2[2] + a0.w * w2[3];
        z += a1.x * w2[4] + a1.y * w2[5] + a1.z * w2[6] + a1.w * w2[7];
        z += a2.x * w2[8] + a2.y * w2[9] + a2.z * w2[10] + a2.w * w2[11];
        z += a3.x * w2[12] + a3.y * w2[13] + a3.z * w2[14] + a3.w * w2[15];
        const float ls = fminf(z, 0.f) - 0.6931471806f * flog2(1.f + fexp2(-1.442695041f * fabsf(z)));
        run += ls * (1.442695041f / 16.f);
        Gl[jj] = run;
    }
    tot[jg * 128 + d] = run;
    LBAR();
    const float t0_ = tot[d], t1_ = tot[128 + d], t2_ = tot[256 + d], t3_ = tot[384 + d];
    off = (jg > 0 ? t0_ : 0.f) + (jg > 1 ? t1_ : 0.f) + (jg > 2 ? t2_ : 0.f); gref = t0_ + t1_; g63 = (t0_ + t1_) + (t2_ + t3_);
}
constexpr int KST = 136, VST = 264, PST = 72;
struct GlaIn { f32x4 alv; bf16 qraw[16], kraw[16]; u32x4 vt[4]; };
template <bool WITHQ>
DI void gla_load(const Ctx& C, int idx, const bf16* PROJ, const float* ALOW, GlaIn& in) {
    const int b = idx >> 8, h = (idx >> 6) & 3, n = idx & 63, t0 = b * SEQ + n * 64, d = C.tid & 127, jg = C.tid >> 7;
    in.alv = (f32x4){0.f, 0.f, 0.f, 0.f};
    if (C.tid < 256) in.alv = ((const f32x4*)(ALOW + (size_t)t0 * 16))[C.tid];
#pragma unroll
    for (int jj = 0; jj < 16; ++jj) { const bf16* row = PROJ + (size_t)(t0 + jg * 16 + jj) * NPROJ + h * 128 + d; in.kraw[jj] = row[C_K]; if (WITHQ) in.qraw[jj] = row[C_Q]; }
#pragma unroll
    for (int i = 0; i < 4; ++i) { const int c = C.tid + 512 * i, j = c >> 5, ec = c & 31; in.vt[i] = *(const u32x4*)(PROJ + (size_t)(t0 + j) * NPROJ + C_V + h * 256 + 8 * ec); }
}
DI void store_v_tile(const Ctx& C, const GlaIn& in, LAS bf16* VL) {
#pragma unroll
    for (int i = 0; i < 4; ++i) { const int c = C.tid + 512 * i, j = c >> 5, ec = c & 31; *(LAS u32x4*)(VL + j * VST + 8 * ec) = in.vt[i]; }
}
DI void glaA_phase(const Ctx& C, int l, const bf16* PROJ, const float* ALOW, bf16* SBUF, float* DEC) {
    LAS float* al = (LAS float*)(C.lds); LAS float* tot = (LAS float*)(C.lds + 4096);
    LAS bf16* KD = (LAS bf16*)(C.lds + 8192); LAS bf16* VL = (LAS bf16*)(C.lds + 25600);
    const int d = C.tid & 127, jg = C.tid >> 7, h = (C.bid >> 6) & 3;
    float w2[16];
#pragma unroll
    for (int r = 0; r < 16; ++r) w2[r] = KARG(I_WA2)[(size_t)l * 16 * 512 + r * 512 + h * 128 + d];
    const float bav = KARG(I_BA)[(size_t)l * 512 + h * 128 + d];
    GlaIn cur, nxt;
    gla_load<false>(C, C.bid, PROJ, ALOW, cur);
#pragma unroll 1
    for (int i = 0; i < 4; ++i) {
        const int idx = i * C.G + C.bid;
        float Gl[16], off, gref, g63;
        gla_gates(C, al, tot, cur.alv, w2, bav, Gl, off, gref, g63);
#pragma unroll
        for (int jj = 0; jj < 16; ++jj) { const int j = jg * 16 + jj; KD[j * KST + d] = (bf16)f2bf(bf1(cur.kraw[jj]) * fexp2(g63 - (off + Gl[jj]))); }
        store_v_tile(C, cur, VL);
        LBAR();
        if (i + 1 < 4) gla_load<false>(C, idx + C.G, PROJ, ALOW, nxt);
        if (jg == 0) DEC[(size_t)idx * 128 + d] = fexp2(g63);
        const int lane = C.lane, g = lane >> 4, qq = (lane & 15) >> 2, p = lane & 3, fr = lane & 15;
        bf16x8 A[2];
#pragma unroll
        for (int ks = 0; ks < 2; ++ks) A[ks] = tr8(KD + (32 * ks + 8 * g + qq) * KST + 16 * C.wave + 4 * p, KST);
        bf16* Sit = SBUF + (size_t)idx * 256 * 128;
#pragma unroll
        for (int half = 0; half < 2; ++half) {
            f32x4 acc[8];
#pragma unroll
            for (int nt = 0; nt < 8; ++nt) acc[nt] = (f32x4){0.f, 0.f, 0.f, 0.f};
#pragma unroll
            for (int nt = 0; nt < 8; ++nt)
#pragma unroll
                for (int ks = 0; ks < 2; ++ks) { const bf16x8 Bf = tr8(VL + (32 * ks + 8 * g + qq) * VST + 16 * (half * 8 + nt) + 4 * p, VST); acc[nt] = mfma16(A[ks], Bf, acc[nt]); }
#pragma unroll
            for (int nt = 0; nt < 8; ++nt) { const int e = 16 * (half * 8 + nt) + fr, dd = 16 * C.wave + 4 * g;
                u32x2 w; w.x = pk2(acc[nt][0], acc[nt][1]); w.y = pk2(acc[nt][2], acc[nt][3]); *(u32x2*)(Sit + (size_t)e * 128 + dd) = w; }
        }
        LBAR();
        cur = nxt;
    }
}
DI void scan_phase(const Ctx& C, bf16* SBUF, const float* DEC) {
    const int gt = C.bid * NTHR + C.tid, bh = gt >> 13, rem = gt & 8191, e = rem >> 5, dq = rem & 31;
    u32x2* p = (u32x2*)(SBUF + ((size_t)(bh * 64) * 256 + e) * 128 + 4 * dq);
    const f32x4* dp = (const f32x4*)(DEC + (size_t)(bh * 64) * 128 + 4 * dq);
    f32x4 st = (f32x4){0.f, 0.f, 0.f, 0.f};
#pragma unroll 1
    for (int n0 = 0; n0 < 64; n0 += 8) {
        u32x2 tmp[8]; f32x4 dc[8];
#pragma unroll
        for (int u = 0; u < 8; ++u) { tmp[u] = p[(size_t)(n0 + u) * 8192]; dc[u] = dp[(n0 + u) * 32]; }
#pragma unroll
        for (int u = 0; u < 8; ++u) { u32x2 w; w.x = pk2(st.x, st.y); w.y = pk2(st.z, st.w); p[(size_t)(n0 + u) * 8192] = w;
            st = dc[u] * st + (f32x4){bflo(tmp[u].x), bfhi(tmp[u].x), bflo(tmp[u].y), bfhi(tmp[u].y)}; }
    }
}
DI void glaC_phase(const Ctx& C, int l, const bf16* PROJ, const float* ALOW, const bf16* SBUF, bf16* CONCAT) {
    const int h = (C.bid >> 6) & 3;
    LAS float* al = (LAS float*)(C.lds); LAS float* tot = (LAS float*)(C.lds + 4096); LAS float* RS = (LAS float*)(C.lds + 6144);
    LAS bf16* QT = (LAS bf16*)(C.lds + 8192); LAS bf16* KT = (LAS bf16*)(C.lds + 25600); LAS bf16* QG = (LAS bf16*)(C.lds + 43008);
    LAS bf16* VL = (LAS bf16*)(C.lds + 60416); LAS bf16* PL = (LAS bf16*)(C.lds + 94208);
    const int d = C.tid & 127, jg = C.tid >> 7;
    float w2[16];
#pragma unroll
    for (int r = 0; r < 16; ++r) w2[r] = KARG(I_WA2)[(size_t)l * 16 * 512 + r * 512 + h * 128 + d];
    const float bav = KARG(I_BA)[(size_t)l * 512 + h * 128 + d];
    const float* ng = KARG(I_GNG) + (size_t)(l * 4 + h) * 256;
    GlaIn cur;
    f32x4 alv_n = (f32x4){0.f, 0.f, 0.f, 0.f};
    if (C.tid < 256) alv_n = ((const f32x4*)(ALOW + (size_t)((C.bid >> 8) * SEQ + (C.bid & 63) * 64) * 16))[C.tid];
#pragma unroll 1
    for (int it = 0; it < 4; ++it) {
    const int idx = it * C.G + C.bid, b = idx >> 8, n = idx & 63, t0 = b * SEQ + n * 64;
    gla_load<true>(C, idx, PROJ, ALOW, cur); cur.alv = alv_n;
    float Gl[16], off, gref, g63;
    gla_gates(C, al, tot, cur.alv, w2, bav, Gl, off, gref, g63);
#pragma unroll
    for (int jj = 0; jj < 16; ++jj) { const int j = jg * 16 + jj; const float Gv = off + Gl[jj];
        const float q = bf1(cur.qraw[jj]) * 0.08838834764831845f, k = bf1(cur.kraw[jj]);
        QT[j * KST + d] = (bf16)f2bf(q * fexp2(fminf(Gv - gref, 100.f))); KT[j * KST + d] = (bf16)f2bf(k * fexp2(fminf(gref - Gv, 100.f))); QG[j * KST + d] = (bf16)f2bf(q * fexp2(Gv)); }
    store_v_tile(C, cur, VL);
    const int lane = C.lane, g = lane >> 4, qq = (lane & 15) >> 2, p = lane & 3, fr = lane & 15;
    bf16x8 Sf[2][4]; u32x2 rraw[4][2];
#pragma unroll
    for (int mi = 0; mi < 2; ++mi) { const bf16* Srow = SBUF + ((size_t)idx * 256 + 16 * (2 * C.wave + mi) + fr) * 128 + 8 * g;
#pragma unroll
        for (int ks = 0; ks < 4; ++ks) Sf[mi][ks] = *(const bf16x8*)(Srow + 32 * ks); }
#pragma unroll
    for (int nt = 0; nt < 4; ++nt)
#pragma unroll
        for (int mi = 0; mi < 2; ++mi) rraw[nt][mi] = *(const u32x2*)(PROJ + (size_t)(t0 + 16 * nt + fr) * NPROJ + C_R + h * 256 + 16 * (2 * C.wave + mi) + 4 * g);
    LBAR();
    {
        const int nt = C.wave & 3;
#pragma unroll
        for (int mi = 0; mi < 2; ++mi) { const int mt = 2 * (C.wave >> 2) + mi; f32x4 acc = (f32x4){0.f, 0.f, 0.f, 0.f};
#pragma unroll
            for (int ks = 0; ks < 4; ++ks) { const bf16x8 a = *(const LAS bf16x8*)(KT + (16 * mt + fr) * KST + 32 * ks + 8 * g), bq = *(const LAS bf16x8*)(QT + (16 * nt + fr) * KST + 32 * ks + 8 * g); acc = mfma16(a, bq, acc); }
            const int i = 16 * nt + fr, j0 = 16 * mt + 4 * g;
            const float v0 = (j0 + 0 <= i) ? acc[0] : 0.f, v1 = (j0 + 1 <= i) ? acc[1] : 0.f, v2 = (j0 + 2 <= i) ? acc[2] : 0.f, v3 = (j0 + 3 <= i) ? acc[3] : 0.f;
            u32x2 w; w.x = pk2(v0, v1); w.y = pk2(v2, v3); *(LAS u32x2*)(PL + i * PST + j0) = w; }
    }
    LBAR();
    f32x4 acc[2][4];
#pragma unroll
    for (int mi = 0; mi < 2; ++mi)
#pragma unroll
        for (int nt = 0; nt < 4; ++nt) acc[mi][nt] = (f32x4){0.f, 0.f, 0.f, 0.f};
#pragma unroll
    for (int mi = 0; mi < 2; ++mi) { const int mt = 2 * C.wave + mi;
#pragma unroll
        for (int ks = 0; ks < 2; ++ks) { const bf16x8 a = tr8(VL + (32 * ks + 8 * g + qq) * VST + 16 * mt + 4 * p, VST);
#pragma unroll
            for (int nt = 0; nt < 4; ++nt) { const bf16x8 bp = *(const LAS bf16x8*)(PL + (16 * nt + fr) * PST + 32 * ks + 8 * g); acc[mi][nt] = mfma16(a, bp, acc[mi][nt]); } }
#pragma unroll
        for (int ks = 0; ks < 4; ++ks) { const bf16x8 a = Sf[mi][ks];
#pragma unroll
            for (int nt = 0; nt < 4; ++nt) { const bf16x8 bq = *(const LAS bf16x8*)(QG + (16 * nt + fr) * KST + 32 * ks + 8 * g); acc[mi][nt] = mfma16(a, bq, acc[mi][nt]); } }
    }
#pragma unroll
    for (int nt = 0; nt < 4; ++nt) { float s = 0.f;
#pragma unroll
        for (int mi = 0; mi < 2; ++mi) s += (acc[mi][nt][0] * acc[mi][nt][0] + acc[mi][nt][1] * acc[mi][nt][1]) + (acc[mi][nt][2] * acc[mi][nt][2] + acc[mi][nt][3] * acc[mi][nt][3]);
        s += __shfl_xor(s, 16); s += __shfl_xor(s, 32);
        if (g == 0) RS[C.wave * 64 + 16 * nt + fr] = s; }
    LBAR();
    if (it + 1 < 4 && C.tid < 256) { const int ix = idx + C.G; alv_n = ((const f32x4*)(ALOW + (size_t)((ix >> 8) * SEQ + (ix & 63) * 64) * 16))[C.tid]; }
#pragma unroll
    for (int nt = 0; nt < 4; ++nt) { const int i = 16 * nt + fr; float ts = 0.f;
#pragma unroll
        for (int w = 0; w < 8; ++w) ts += RS[w * 64 + i];
        const float rstd = frsq(ts * (1.f / 256.f) + EPS);
#pragma unroll
        for (int mi = 0; mi < 2; ++mi) { const int e = 16 * (2 * C.wave + mi) + 4 * g;
            const u32x2 rr = rraw[nt][mi]; const f32x4 gg = *(const f32x4*)(ng + e);
            const float o0 = acc[mi][nt][0] * rstd * gg.x * silu_f(bflo(rr.x)), o1 = acc[mi][nt][1] * rstd * gg.y * silu_f(bfhi(rr.x));
            const float o2 = acc[mi][nt][2] * rstd * gg.z * silu_f(bflo(rr.y)), o3 = acc[mi][nt][3] * rstd * gg.w * silu_f(bfhi(rr.y));
            u32x2 w; w.x = pk2(o0, o1); w.y = pk2(o2, o3); *(u32x2*)(CONCAT + (size_t)(t0 + i) * D + h * 256 + e) = w; } }
    LBAR();
    }
}
constexpr int GST = 136;
DI void gmlp_phase(const Ctx& C, int l, const bf16* PROJ, const bf16* WSB, bf16* CONCAT) {
    const int h = C.bid & 7;
    LAS bf16* VL2 = (LAS bf16*)(C.lds); LAS bf16* UL = (LAS bf16*)(C.lds + 34816);
    const float* vg = KARG(I_VNG) + (size_t)(l * 8 + h) * 128; const float* og = KARG(I_MOG) + (size_t)(l * 8 + h) * 128; const float* bb = KARG(I_MB) + (size_t)(l * 8 + h) * 128;
    bf16x8 Wf[4];
    { const bf16* Wrow = WSB + ((size_t)(l * 8 + h) * 128 + 16 * C.wave + (C.lane & 15)) * 128 + 8 * (C.lane >> 4);
#pragma unroll
      for (int ks = 0; ks < 4; ++ks) Wf[ks] = *(const bf16x8*)(Wrow + 32 * ks); }
    u32x4 cu[4], cv[4], nu[4], nv[4];
#define GM_LOAD(IDX, U, V) do { const int t0_ = ((IDX) >> 8) * SEQ + (((IDX) >> 3) & 31) * 128; _Pragma("unroll") for (int i = 0; i < 4; ++i) { const int c = C.tid + 512 * i, t = c >> 4, ch = c & 15; \
        const bf16* row = PROJ + (size_t)(t0_ + t) * NPROJ + h * 128 + 8 * ch; U[i] = *(const u32x4*)(row + C_U); V[i] = *(const u32x4*)(row + C_VS); } } while (0)
    GM_LOAD(C.bid, cu, cv);
#pragma unroll 1
    for (int it = 0; it < 4; ++it) {
    const int idx = it * C.G + C.bid, n = (idx >> 3) & 31, b = idx >> 8, t0 = b * SEQ + n * 128;
#pragma unroll
    for (int i = 0; i < 4; ++i) { const int c = C.tid + 512 * i, t = c >> 4, ch = c & 15;
        const u32x4 uu = cu[i], vv = cv[i];
        float v[8] = {gelu_t(bflo(vv.x)), gelu_t(bfhi(vv.x)), gelu_t(bflo(vv.y)), gelu_t(bfhi(vv.y)), gelu_t(bflo(vv.z)), gelu_t(bfhi(vv.z)), gelu_t(bflo(vv.w)), gelu_t(bfhi(vv.w))};
        float ss = 0.f;
#pragma unroll
        for (int k = 0; k < 8; ++k) ss += v[k] * v[k];
        ss += __shfl_xor(ss, 1); ss += __shfl_xor(ss, 2); ss += __shfl_xor(ss, 4); ss += __shfl_xor(ss, 8);
        const float rstd = frsq(ss * (1.f / 128.f) + EPS);
        const f32x4 g0 = *(const f32x4*)(vg + 8 * ch), g1 = *(const f32x4*)(vg + 8 * ch + 4);
        u32x4 wv; wv.x = pk2(v[0] * rstd * g0.x, v[1] * rstd * g0.y); wv.y = pk2(v[2] * rstd * g0.z, v[3] * rstd * g0.w); wv.z = pk2(v[4] * rstd * g1.x, v[5] * rstd * g1.y); wv.w = pk2(v[6] * rstd * g1.z, v[7] * rstd * g1.w);
        *(LAS u32x4*)(VL2 + t * GST + 8 * ch) = wv;
        u32x4 wu; wu.x = pk2(gelu_t(bflo(uu.x)), gelu_t(bfhi(uu.x))); wu.y = pk2(gelu_t(bflo(uu.y)), gelu_t(bfhi(uu.y))); wu.z = pk2(gelu_t(bflo(uu.z)), gelu_t(bfhi(uu.z))); wu.w = pk2(gelu_t(bflo(uu.w)), gelu_t(bfhi(uu.w)));
        *(LAS u32x4*)(UL + t * GST + 8 * ch) = wu; }
    LBAR();
    if (it + 1 < 4) GM_LOAD(idx + C.G, nu, nv);
    const int lane = C.lane, g = lane >> 4, qq = (lane & 15) >> 2, p = lane & 3, fr = lane & 15;
    f32x4 acc[8];
#pragma unroll
    for (int mt = 0; mt < 8; ++mt) acc[mt] = (f32x4){0.f, 0.f, 0.f, 0.f};
    const int nks = (C.wave >> 1) + 1;
#pragma unroll
    for (int ks = 0; ks < 4; ++ks) if (ks < nks) { const bf16x8 bw = Wf[ks];
#pragma unroll
        for (int mt = 0; mt < 8; ++mt) { const bf16x8 a = tr8(VL2 + (32 * ks + 8 * g + qq) * GST + 16 * mt + 4 * p, GST); acc[mt] = mfma16(a, bw, acc[mt]); } }
    const int tl = 16 * C.wave + fr; const float bt = bb[tl]; float ss = 0.f;
#pragma unroll
    for (int mt = 0; mt < 8; ++mt) { const u32x2 uu = *(const LAS u32x2*)(UL + tl * GST + 16 * mt + 4 * g);
        acc[mt][0] = bflo(uu.x) * (acc[mt][0] + bt); acc[mt][1] = bfhi(uu.x) * (acc[mt][1] + bt); acc[mt][2] = bflo(uu.y) * (acc[mt][2] + bt); acc[mt][3] = bfhi(uu.y) * (acc[mt][3] + bt);
        ss += (acc[mt][0] * acc[mt][0] + acc[mt][1] * acc[mt][1]) + (acc[mt][2] * acc[mt][2] + acc[mt][3] * acc[mt][3]); }
    ss += __shfl_xor(ss, 16); ss += __shfl_xor(ss, 32);
    const float rstd = frsq(ss * (1.f / 128.f) + EPS);
#pragma unroll
    for (int mt = 0; mt < 8; ++mt) { const f32x4 gg = *(const f32x4*)(og + 16 * mt + 4 * g);
        u32x2 w; w.x = pk2(acc[mt][0] * rstd * gg.x, acc[mt][1] * rstd * gg.y); w.y = pk2(acc[mt][2] * rstd * gg.z, acc[mt][3] * rstd * gg.w);
        *(u32x2*)(CONCAT + (size_t)(t0 + tl) * D + 1024 + h * 128 + 16 * mt + 4 * g) = w; }
    LBAR();
#pragma unroll
    for (int i = 0; i < 4; ++i) { cu[i] = nu[i]; cv[i] = nv[i]; }
    }
#undef GM_LOAD
}
DI void list_insert(float (&L)[16], float x) {
#pragma unroll
    for (int i = 15; i >= 1; --i) L[i] = __builtin_amdgcn_fmed3f(x, L[i - 1], L[i]);
    L[0] = fmaxf(L[0], x);
}
DI void list_merge_xor(float (&L)[16], int mask) {
    float M[16];
#pragma unroll
    for (int i = 0; i < 16; ++i) M[i] = fmaxf(L[i], __shfl_xor(L[15 - i], mask));
#pragma unroll
    for (int s = 8; s >= 1; s >>= 1)
#pragma unroll
        for (int i = 0; i < 16; ++i) if ((i & s) == 0) { const float hi = fmaxf(M[i], M[i + s]), lo = fminf(M[i], M[i + s]); M[i] = hi; M[i + s] = lo; }
#pragma unroll
    for (int i = 0; i < 16; ++i) L[i] = M[i];
}
DI unsigned fbits(float x) { return __builtin_bit_cast(unsigned, x); }
DI float unp7(float x) { return __builtin_bit_cast(float, __builtin_bit_cast(unsigned, x) & 0xFFFFFF80u); }
constexpr int TKST = 136;
DI void topk_phase(const Ctx& C, int l, const bf16* QB, const bf16* K1B, const bf16* K2B, const int* KU, const int* KV, int* EB, float* PG) {
    LAS bf16* KL = (LAS bf16*)C.lds;
    LAS unsigned* tk = (LAS unsigned*)(C.lds + 2 * 128 * TKST * 2 + C.wave * 2048);
    const int lane = C.lane, fr = lane & 15, fq = lane >> 4, h = C.bid & 7, rank = C.bid >> 3;
#pragma unroll
    for (int i = 0; i < 8; ++i) { const int c = C.tid + 512 * i, tb = c >> 11, row = (c & 2047) >> 4, ch = c & 15;
        *(LAS u32x4*)(KL + (tb * 128 + row) * TKST + 8 * ch) = *(const u32x4*)((tb ? K2B : K1B) + ((size_t)(l * 8 + h) * 128 + row) * 128 + 8 * ch); }
    __syncthreads();
#pragma unroll 1
    for (int it = 0; it < 4; ++it) {
        const int tt0 = rank * 512 + C.wave * 64 + it * 16;
        float L[2][16];
        bf16x8 bq[2][4];
#pragma unroll
        for (int half = 0; half < 2; ++half)
#pragma unroll
            for (int ks = 0; ks < 4; ++ks) bq[half][ks] = *(const bf16x8*)(QB + (size_t)(tt0 + fr) * D + h * 256 + half * 128 + 8 * fq + 32 * ks);
#pragma unroll
        for (int half = 0; half < 2; ++half) {
            f32x4 acc[8];
#pragma unroll
            for (int mt = 0; mt < 8; ++mt) acc[mt] = (f32x4){0.f, 0.f, 0.f, 0.f};
            const LAS bf16* Kb = KL + (half * 128 + fr) * TKST + 8 * fq;
#pragma unroll
            for (int ks = 0; ks < 4; ++ks)
#pragma unroll
                for (int mt = 0; mt < 8; ++mt) { const bf16x8 a = *(const LAS bf16x8*)(Kb + (16 * mt) * TKST + 32 * ks); acc[mt] = mfma16(a, bq[half][ks], acc[mt]); }
#pragma unroll
            for (int i = 0; i < 16; ++i) L[half][i] = __builtin_bit_cast(float, 0xFF800000u);
#pragma unroll
            for (int mt = 0; mt < 8; ++mt)
#pragma unroll
                for (int r = 0; r < 4; ++r) { const unsigned key = (unsigned)(16 * mt + 4 * fq + r);
                    const float sv = acc[mt][r];
                    list_insert(L[half], __builtin_bit_cast(float, (fbits(sv) & 0xFFFFFF80u) | key)); }
            list_merge_xor(L[half], 16); list_merge_xor(L[half], 32);
        }
        if (fq == 0) {
#pragma unroll
            for (int i = 0; i < 16; ++i) { tk[(fr * 2 + 0) * 16 + i] = fbits(L[0][i]); tk[(fr * 2 + 1) * 16 + i] = fbits(L[1][i]); }
        }
        float Cn[16];
#pragma unroll
        for (int i = 0; i < 16; ++i) Cn[i] = __builtin_bit_cast(float, 0xFF800000u);
#pragma unroll
        for (int i = 0; i < 16; ++i)
#pragma unroll
            for (int j = 0; j < 16; ++j) if ((i + 1) * (j + 1) <= 16) {
                const float s = unp7(L[0][i]) + unp7(L[1][j]);
                list_insert(Cn, __builtin_bit_cast(float, (fbits(s) & 0xFFFFFF00u) | (unsigned)(i * 16 + j))); }
        LDS_WAIT();
        float sc[4]; int ex[4];
#pragma unroll
        for (int m = 0; m < 4; ++m) {
            const float ck = fq == 0 ? Cn[m] : (fq == 1 ? Cn[4 + m] : (fq == 2 ? Cn[8 + m] : Cn[12 + m]));
            const unsigned cc = fbits(ck) & 255u;
            const unsigned p1 = tk[(fr * 2 + 0) * 16 + (cc >> 4)], p2 = tk[(fr * 2 + 1) * 16 + (cc & 15u)];
            sc[m] = __builtin_bit_cast(float, p1 & 0xFFFFFF80u) + __builtin_bit_cast(float, p2 & 0xFFFFFF80u);
            ex[m] = (int)((p1 & 127u) * 128u + (p2 & 127u));
        }
        float mx = fmaxf(fmaxf(sc[0], sc[1]), fmaxf(sc[2], sc[3]));
        mx = fmaxf(mx, __shfl_xor(mx, 16)); mx = fmaxf(mx, __shfl_xor(mx, 32));
        float w[4], sum = 0.f;
#pragma unroll
        for (int m = 0; m < 4; ++m) { w[m] = fexp2((sc[m] - mx) * 1.442695041f); sum += w[m]; }
        sum += __shfl_xor(sum, 16); sum += __shfl_xor(sum, 32);
        const float inv = 1.0f / sum;
        const size_t o = (size_t)(tt0 + fr) * 128 + h * 16 + 4 * fq;
#pragma unroll
        for (int m = 0; m < 4; ++m) { const int kv = KV[ex[m]]; w[m] = w[m] * inv * __builtin_bit_cast(float, (unsigned)(127 - kv) << 23); ex[m] |= 127 << 16; }
        *(int4*)(EB + o) = make_int4(ex[0], ex[1], ex[2], ex[3]);
        *(f32x4*)(PG + o) = (f32x4){w[0], w[1], w[2], w[3]};
        LDS_WAIT();
    }
}
typedef unsigned char fp8_t;
DI void unpack16(const u32x4 q, float (&f)[16]) {
#pragma unroll
    for (int w = 0; w < 4; ++w) { const int dw = (int)q[w]; const f32x2 lo = __builtin_amdgcn_cvt_pk_f32_fp8(dw, false), hi = __builtin_amdgcn_cvt_pk_f32_fp8(dw, true);
        f[4 * w] = lo.x; f[4 * w + 1] = lo.y; f[4 * w + 2] = hi.x; f[4 * w + 3] = hi.y; }
}
DI int sdot4(int a, int b, int c) { return __builtin_amdgcn_sdot4(a, b, c, false); }
template <int CTRL> DI int dppi(int v) { return __builtin_amdgcn_update_dpp(0, v, CTRL, 0xf, 0xf, true); }
template <int CTRL, int NV> DI void bfly(int (&p)[32], const int base, const bool up) {
#pragma unroll
    for (int m = 0; m < NV / 2; ++m) { const int lo = p[base + m], hi = p[base + m + NV / 2]; const int keep = up ? hi : lo, send = up ? lo : hi; p[base + m] = keep + dppi<CTRL>(send); }
}
DI void peerU_phase(const Ctx& C, const unsigned char* H8, const float* HS, const int* EB, const unsigned char* PU8, const float* SU, float* PART, const int emask = 0xFFFF) {
    const int x = C.bid & 7, rank = C.bid >> 3, lane = C.lane, g = lane >> 4, i16 = lane & 15;
    const __amdgpu_buffer_rsrc_t trs = __builtin_amdgcn_make_buffer_rsrc((void*)(PU8 + (size_t)x * NEXP * 256), 0, NEXP * 256, 0x00020000);
    const float* su = SU + (size_t)x * NEXP;
    const int tbase = rank * 512 + C.wave * 64;
    float* part = PART + ((size_t)x * T + tbase) * 128 + lane;
    const int* ebase = EB + (size_t)tbase * 128 + lane;
    const unsigned char* hbase = H8 + (size_t)tbase * 4096 + 256 * x + 16 * i16;
    const float* hsb = HS + tbase;
    const int bp0 = 64 * g, loff = 16 * i16;
    const bool b3 = (i16 & 8) != 0, b2 = (i16 & 4) != 0, b1 = (i16 & 2) != 0, b0 = (i16 & 1) != 0;
    int en0 = ebase[0] & emask, en1 = ebase[64] & emask;
    int er0 = ebase[128], er1 = ebase[192];
    u32x4 hh = *(const u32x4*)hbase, hl = *(const u32x4*)(hbase + 2048);
    float sc0 = su[en0], sc1 = su[en1], hs = hsb[0];
    u32x4 buf[32];
#pragma unroll
    for (int u = 0; u < 32; ++u) { const int e = __builtin_amdgcn_ds_bpermute(bp0 + 4 * (u & 15), u < 16 ? en0 : en1); buf[u] = __builtin_amdgcn_raw_buffer_load_b128(trs, e * 256 + loff, 0, 0); }
    __builtin_amdgcn_sched_barrier(0);
    en0 = er0 & emask; en1 = er1 & emask;
    float pend0 = 0.f, pend1 = 0.f; float* pend_p = part;
#pragma unroll 1
    for (int ti = 0; ti < 64; ++ti) {
        const int tn = ti + 1 < 64 ? ti + 1 : 63, t2 = ti + 2 < 64 ? ti + 2 : 63;
        er0 = ebase[t2 * 128]; er1 = ebase[t2 * 128 + 64];
        const u32x4 hhn = *(const u32x4*)(hbase + (size_t)tn * 4096), hln = *(const u32x4*)(hbase + (size_t)tn * 4096 + 2048);
        const float scn0 = su[en0], scn1 = su[en1], hsn = hsb[tn];
        __builtin_amdgcn_sched_barrier(0);
        int p[32];
#pragma unroll
        for (int u0 = 0; u0 < 32; u0 += 4) {
            int en[4];
#pragma unroll
            for (int u = u0; u < u0 + 4; ++u) en[u - u0] = __builtin_amdgcn_ds_bpermute(bp0 + 4 * (u & 15), u < 16 ? en0 : en1);
#pragma unroll
            for (int u = u0; u < u0 + 4; ++u) {
                const u32x4 r = buf[u];
                int ah = sdot4((int)r.x, (int)hh.x, 0); ah = sdot4((int)r.y, (int)hh.y, ah); ah = sdot4((int)r.z, (int)hh.z, ah); ah = sdot4((int)r.w, (int)hh.w, ah);
                int al = sdot4((int)r.x, (int)hl.x, 0); al = sdot4((int)r.y, (int)hl.y, al); al = sdot4((int)r.z, (int)hl.z, al); al = sdot4((int)r.w, (int)hl.w, al);
                p[u] = (ah << 7) + al; }
            asm volatile("" : "+v"(p[u0]), "+v"(p[u0 + 1]), "+v"(p[u0 + 2]), "+v"(p[u0 + 3]) :: "memory");
#pragma unroll
            for (int u = u0; u < u0 + 4; ++u) buf[u] = __builtin_amdgcn_raw_buffer_load_b128(trs, en[u - u0] * 256 + loff, 0, 0);
            if (u0 == 12) { pend_p[0] = pend0; pend_p[64] = pend1; }
            __builtin_amdgcn_sched_barrier(0);
        }
        bfly<0x140, 16>(p, 0, b3); bfly<0x140, 16>(p, 16, b3);
        bfly<0x141, 8>(p, 0, b2); bfly<0x141, 8>(p, 16, b2);
        bfly<0x4E, 4>(p, 0, b1); bfly<0x4E, 4>(p, 16, b1);
        bfly<0xB1, 2>(p, 0, b0); bfly<0xB1, 2>(p, 16, b0);
        pend0 = (float)p[0] * (sc0 * hs); pend1 = (float)p[16] * (sc1 * hs); pend_p = part + (size_t)ti * 128;
        asm volatile("" : "+v"(er0), "+v"(er1) :: "memory");
        en0 = er0 & emask; en1 = er1 & emask; hh = hhn; hl = hln; sc0 = scn0; sc1 = scn1; hs = hsn;
    }
    pend_p[0] = pend0; pend_p[64] = pend1;
}
typedef int v2i32_t __attribute__((ext_vector_type(2)));
typedef long i64_t;
constexpr int PU_RST = 272;
constexpr int PV_TILE = 32 * PU_RST, PV_A8 = PV_TILE, PV_Y = PV_TILE + 256, PV_WAVE = 10240;
DI float wave_max_u(float v) {
    v = fmaxf(v, dppf<0xB1>(v)); v = fmaxf(v, dppf<0x4E>(v)); v = fmaxf(v, dppf<0x141>(v)); v = fmaxf(v, dppf<0x140>(v));
    const int iv = __builtin_bit_cast(int, v);
    return fmaxf(fmaxf(__builtin_bit_cast(float, __builtin_amdgcn_readlane(iv, 0)), __builtin_bit_cast(float, __builtin_amdgcn_readlane(iv, 16))),
                 fmaxf(__builtin_bit_cast(float, __builtin_amdgcn_readlane(iv, 32)), __builtin_bit_cast(float, __builtin_amdgcn_readlane(iv, 48))));
}
DI void peerV_phase(const Ctx& C, const int* EB, const float* PG, const float* PART, const fp8_t* PV8, float* X, const float* gate  , const int emask = 0xFFFF, const int FAKE = 0) {
    const int x = C.bid & 7, rank = C.bid >> 3, lane = C.lane, kq = lane >> 4, m16 = lane & 15;
    const fp8_t* tab = PV8 + (size_t)x * NEXP * 256 + 16 * m16;
    const int tbase = rank * 512 + C.wave * 64;
    ldsp wl = C.lds + C.wave * PV_WAVE;
    const int wr_off = kq * PU_RST + 16 * m16;
    const int tr_off = (8 * kq + (m16 >> 1)) * PU_RST + 8 * (m16 & 1);
    const int a_off = PV_A8 + (m16 & 1) * 128 + 8 * kq;
    const int bp0 = 4 * kq;
    float pr0[8], pr1[8]; int rep0, rep1; float rg0, rg1;
#define PV_LOAD_RAW(tt) do { _Pragma("unroll") for (int xx = 0; xx < 8; ++xx) { const float* pp = PART + ((size_t)xx * T + (tt)) * 128 + lane; pr0[xx] = pp[0]; pr1[xx] = pp[64]; } \
        rep0 = EB[(size_t)(tt) * 128 + lane]; rep1 = EB[(size_t)(tt) * 128 + 64 + lane]; rg0 = PG[(size_t)(tt) * 128 + lane]; rg1 = PG[(size_t)(tt) * 128 + 64 + lane]; } while (0)
#define PV_FINISH(A0, A1, E0, E1) do { const float s0_ = ((pr0[0] + pr0[1]) + (pr0[2] + pr0[3])) + ((pr0[4] + pr0[5]) + (pr0[6] + pr0[7])), s1_ = ((pr1[0] + pr1[1]) + (pr1[2] + pr1[3])) + ((pr1[4] + pr1[5]) + (pr1[6] + pr1[7])); \
        A0 = gelu_t(s0_ * __builtin_bit_cast(float, (unsigned)(rep0 >> 16) << 23)) * rg0; A1 = gelu_t(s1_ * __builtin_bit_cast(float, (unsigned)(rep1 >> 16) << 23)) * rg1; E0 = (rep0 & emask) * 256; E1 = (rep1 & emask) * 256; } while (0)
    float a0, a1, a0n = 0.f, a1n = 0.f; int e0, e1, e0n = 0, e1n = 0;
    PV_LOAD_RAW(tbase); PV_FINISH(a0, a1, e0, e1);
    PV_LOAD_RAW(tbase + 1);
    u32x4 ra[8], rb[8];
#define PV_ISSUE(BUF, ESEL, Q1) do { _Pragma("unroll") for (int i_ = 0; i_ < 8; ++i_) { const int ad_ = (bp0 + 4 * (32 * (Q1) + 4 * i_)) & 255; \
        const int eo_ = __builtin_amdgcn_ds_bpermute(ad_, (ESEL)); BUF[i_] = *(const u32x4*)(tab + eo_); } } while (0)
#define PV_STEP(BUF, KS) do { _Pragma("unroll") for (int i_ = 0; i_ < 8; ++i_) *(LAS u32x4*)(wl + wr_off + i_ * 4 * PU_RST) = BUF[i_]; \
        const u32x2 ao_ = *(const LAS u32x2*)(wl + a_off + 32 * (KS)); const i64_t aop_ = (i64_t)(((unsigned long long)ao_.y << 32) | ao_.x); \
        _Pragma("unroll") for (int nt = 0; nt < 16; ++nt) { const v2i32_t bv_ = __builtin_amdgcn_ds_read_tr8_b64_v2i32((LAS v2i32_t*)(wl + tr_off + 16 * nt)); \
            acc[nt] = __builtin_amdgcn_mfma_f32_16x16x32_fp8_fp8(aop_, (i64_t)(((unsigned long long)(unsigned)bv_[1] << 32) | (unsigned)bv_[0]), acc[nt], 0, 0, 0); } } while (0)
    PV_ISSUE(ra, e0, 0);
    f32x4 xpend = (f32x4){0.f, 0.f, 0.f, 0.f}; f32x4* xpend_p = nullptr;
#pragma unroll 1
    for (int ti = 0; ti < 64; ++ti) {
        const int t = tbase + ti;
        const float amax = wave_max_u(fmaxf(fabsf(a0), fabsf(a1)));
        int ka = 0; if (amax > 0.f) { ka = (int)((__builtin_bit_cast(unsigned, 224.0f / amax) >> 23) & 255u) - 127; ka = ka < -100 ? -100 : (ka > 100 ? 100 : ka); }
        const float sca = __builtin_bit_cast(float, (unsigned)(ka + 127) << 23), inva = __builtin_bit_cast(float, (unsigned)(127 - ka) << 23);
        {   const float s0 = a0 * sca, s1 = a1 * sca;
            const int ph = __builtin_amdgcn_cvt_pk_fp8_f32(s0, s1, 0, false); const f32x2 bk = __builtin_amdgcn_cvt_pk_f32_fp8(ph, false);
            const int pl = __builtin_amdgcn_cvt_pk_fp8_f32((s0 - bk.x) * 16.0f, (s1 - bk.y) * 16.0f, 0, false);
            LAS unsigned char* a8 = (LAS unsigned char*)(wl + PV_A8);
            a8[lane] = (unsigned char)(ph & 255); a8[64 + lane] = (unsigned char)((ph >> 8) & 255); a8[128 + lane] = (unsigned char)(pl & 255); a8[192 + lane] = (unsigned char)((pl >> 8) & 255); }
        f32x4 acc[16];
#pragma unroll
        for (int nt = 0; nt < 16; ++nt) acc[nt] = (f32x4){0.f, 0.f, 0.f, 0.f};
        const int col = 256 * x + 4 * lane, b = t >> 12;
        f32x4* xp = (f32x4*)(X + (size_t)t * D + col);
        f32x4 xold = (f32x4){0.f, 0.f, 0.f, 0.f}; if (!FAKE) xold = *xp;
        const f32x4 gt = *(const f32x4*)(gate + (size_t)b * MODW + col);
        PV_ISSUE(rb, e0, 1);
        if (ti > 0 && !FAKE) *xpend_p = xpend;
        PV_STEP(ra, 0);
        PV_ISSUE(ra, e1, 2); PV_STEP(rb, 1);
        if (ti + 1 < 64) PV_FINISH(a0n, a1n, e0n, e1n);
        PV_ISSUE(rb, e1, 3); PV_STEP(ra, 2);
        if (ti + 2 < 64) PV_LOAD_RAW(t + 2);
        if (ti + 1 < 64) PV_ISSUE(ra, e0n, 0);
        PV_STEP(rb, 3);
        if (kq == 0) {
#pragma unroll
            for (int nt = 0; nt < 16; ++nt) *(LAS float*)(wl + PV_Y + 4 * (16 * nt + m16)) = (acc[nt][0] + acc[nt][1] * 0.0625f) * inva; }
        const f32x4 y = *(const LAS f32x4*)(wl + PV_Y + 16 * lane);
        if (FAKE) { if (y.x == 123.456f) *xp = y; }
        xpend = xold + gt * y; xpend_p = xp;
        a0 = a0n; a1 = a1n; e0 = e0n; e1 = e1n;
    }
    if (!FAKE) *xpend_p = xpend;
#undef PV_LOAD_RAW
#undef PV_FINISH
#undef PV_ISSUE
#undef PV_STEP
}
DI void final_norm_phase(const Ctx& C, float* X, const float* g) {
    const int r0 = C.gw * 8;
    f32x4 gm[8];
#pragma unroll
    for (int j = 0; j < 8; ++j) gm[j] = ((const f32x4*)g)[64 * j + C.lane];
#pragma unroll 1
    for (int i = 0; i < 8; ++i) {
        f32x4* xr = (f32x4*)(X + (size_t)(r0 + i) * D) + C.lane; f32x4 v[8]; float s = 0.f;
#pragma unroll
        for (int j = 0; j < 8; ++j) { v[j] = xr[64 * j]; s += (v[j].x * v[j].x + v[j].y * v[j].y) + (v[j].z * v[j].z + v[j].w * v[j].w); }
        const float rstd = frsq(wave_sum(s) * (1.f / D) + EPS);
#pragma unroll
        for (int j = 0; j < 8; ++j) xr[64 * j] = v[j] * rstd * gm[j];
    }
}
#ifndef PH_MASK
#define PH_MASK 0xFFFFF
#endif
#define EN(k) (((PH_MASK) >> (k)) & 1)
#ifndef GEMM_SP2
#define GEMM_SP2 true
#endif
#ifndef GEMM_ALIGN
#define GEMM_ALIGN false
#endif
constexpr int NKIND = 11, NPH = 2 + 2 * NKIND;
struct Args { const float* in[21]; float* out; unsigned char* ws; int ph_lo, ph_hi, pad0, pad1; };
__global__ void __launch_bounds__(NTHR, 2) mk_fwd(Args args) {
    extern __shared__ __attribute__((aligned(16))) unsigned char lds_raw[];
    ldsp ldsb = (ldsp)lds_raw;
    volatile LAS unsigned* MISC = (volatile LAS unsigned*)(ldsb + MISC_OFF);
    for (int u = threadIdx.x; u < (LDS_BYTES - LDSCTL_OFF) / 4; u += NTHR) ((LAS unsigned*)(ldsb + LDSCTL_OFF))[u] = 0u;
    __syncthreads();
    unsigned* barw = (unsigned*)(args.ws + WS_CTL) + CW_BAR;
    XcdBarrier bar; bar.bar = barw; bar.x = 0; bar.st = nullptr;
    const bool multi = (args.ph_hi - args.ph_lo) > 1;
    if (multi) bar = xcd_barrier_post(barw, MISC + 8);

#ifdef DBG_REP_MASK
    int repflag = 0;
#endif
#pragma unroll 1
    for (int ph = args.ph_lo; ph < args.ph_hi; ++ph) {
#define MKCTX Ctx C; { int tid_ = threadIdx.x, bid_ = blockIdx.x; asm volatile("" : "+v"(tid_)); asm volatile("" : "+s"(bid_)); \
        C.lds = ldsb; C.tid = tid_; C.lane = tid_ & 63; C.wave = __builtin_amdgcn_readfirstlane(tid_ >> 6); C.bid = bid_; C.G = gridDim.x; C.gw = C.bid * NWAVES + C.wave; C.NGW = C.G * NWAVES; \
        C.ws = args.ws; }
        unsigned char* const wsb = args.ws;
        float* MOD = (float*)(wsb + WS_MOD);
        bf16* Hb = (bf16*)(wsb + WS_H); bf16* PROJ = (bf16*)(wsb + WS_PROJ); bf16* SBUF = (bf16*)(wsb + WS_SBUF); bf16* CONCAT = (bf16*)(wsb + WS_CONCAT); bf16* QB = (bf16*)(wsb + WS_QB);
        float* ALOW = (float*)(wsb + WS_ALOW); float* DEC = (float*)(wsb + WS_DEC); int* EB = (int*)(wsb + WS_EB); float* PG = (float*)(wsb + WS_PG);
        float* X = args.out;
        const int l = ph < 2 ? 0 : (ph - 2) / NKIND, kind = ph < 2 ? -1 : (ph - 2) % NKIND;
        const float* modl = MOD + (size_t)l * 4 * MODW;
        if (ph == 0) { if (EN(0)) { MKCTX; p0_prologue(C); } }
        else if (ph == 1) { if (EN(1)) { MKCTX; norm_phase(C, KARG(I_X), KARG(I_N1G), modl, 0, D, Hb); } }
        else if ((kind == 0 || kind == 6) && EN(2)) {
            MKCTX; const bool isq = (kind == 6);
            pg8::Gemm g{Hb, isq ? (const bf16*)(wsb + WS_WTQ) + (size_t)l * D * D : (const bf16*)(wsb + WS_WTIN) + (size_t)l * WTIN_L, T, isq ? D : NPROJ, D};
            pg8::StaticOrder S; S.init(T, g.N, C.G, C.bid);
            pg8::EpiBf16 E{isq ? QB : PROJ, isq ? D : NPROJ};
            pg8::gemm_phase<pg8::EpiBf16, pg8::StaticOrder, GEMM_ALIGN, GEMM_SP2>(C.lds, g, S, E, C.tid);
            if (!isq) alow_phase(C, Hb, (const bf16*)(wsb + WS_WTIN) + (size_t)l * WTIN_L + (size_t)NPROJ * D, ALOW);
#ifdef DBG_DUP_ALOW
            if (!isq) { alow_phase(C, Hb, (const bf16*)(wsb + WS_WTIN) + (size_t)l * WTIN_L + (size_t)NPROJ * D, ALOW); alow_phase(C, Hb, (const bf16*)(wsb + WS_WTIN) + (size_t)l * WTIN_L + (size_t)NPROJ * D, ALOW); }
#endif
        }
        else if (kind == 1 && EN(3)) {
            MKCTX;
            glaA_phase(C, l, PROJ, ALOW, SBUF, DEC);
            gmlp_phase(C, l, PROJ, (const bf16*)(wsb + WS_WSB), CONCAT);
        }
        else if (kind == 2) { if (EN(4)) { MKCTX; scan_phase(C, SBUF, DEC); } }
        else if (kind == 3 && EN(5)) { MKCTX; glaC_phase(C, l, PROJ, ALOW, SBUF, CONCAT); }
        else if (kind == 4 && EN(6)) {
            MKCTX;
            pg8::Gemm g{CONCAT, (const bf16*)(wsb + WS_WTOUT) + (size_t)l * D * D, T, D, D};
            pg8::StaticOrder S; S.init(T, D, C.G, C.bid);
            pg8::EpiResGate E{l == 0 ? KARG(I_X) : (const float*)X, X, modl + 2 * D, MODW};
            pg8::gemm_phase<pg8::EpiResGate, pg8::StaticOrder, GEMM_ALIGN, GEMM_SP2>(C.lds, g, S, E, C.tid);
        }
        else if (kind == 5) { if (EN(1)) { MKCTX; norm_phase<true>(C, X, KARG(I_N2G) + (size_t)l * D, modl, 3 * D, 4 * D, Hb, wsb + WS_H8, (float*)(wsb + WS_HS)); } }
        else if (kind == 7) { if (EN(7)) { MKCTX; topk_phase(C, l, QB, (const bf16*)(wsb + WS_K1B), (const bf16*)(wsb + WS_K2B), (const int*)(wsb + WS_KU) + l * NEXP, (const int*)(wsb + WS_KV) + l * NEXP, EB, PG); } }
        else if (kind == 8) { if (EN(8)) { MKCTX; peerU_phase(C, wsb + WS_H8, (const float*)(wsb + WS_HS), EB, wsb + WS_PUB + (size_t)l * NEXP * D, (const float*)(wsb + WS_SU) + (size_t)l * 8 * NEXP, (float*)SBUF); } }
#ifdef DBG_FAKE_V
        else if (kind == 9) { if (EN(9)) { MKCTX; const int fake = (repflag == 0); peerV_phase(C, EB, PG, (const float*)SBUF, (const fp8_t*)(wsb + WS_PVB) + (size_t)l * NEXP * D, X, modl + 5 * D, fake ? (DBG_FAKE_V) : 0xFFFF, fake); } }
#else
        else if (kind == 9) { if (EN(9)) { MKCTX; peerV_phase(C, EB, PG, (const float*)SBUF, (const fp8_t*)(wsb + WS_PVB) + (size_t)l * NEXP * D, X, modl + 5 * D); } }
#endif
        else if (EN(10)) {
            MKCTX;
            if (l == DEPTH - 1) final_norm_phase(C, X, KARG(I_FG));
            else norm_phase(C, X, KARG(I_N1G) + (size_t)(l + 1) * D, MOD + (size_t)(l + 1) * 4 * MODW, 0, D, Hb);
        }
        if (ph + 1 < args.ph_hi) xcd_barrier(bar);
#ifdef DBG_EXTRA_BAR
        if (ph + 1 < args.ph_hi) { xcd_barrier(bar); xcd_barrier(bar); }
#endif
#ifdef DBG_REP_MASK
        { const int bit = ph < 2 ? ph : 2 + kind; bool want = ((DBG_REP_MASK) >> bit) & 1;
#ifdef DBG_REP_L0
          if (l != 0) want = false;
#endif
          if (want && !repflag) { repflag = 1; --ph; } else repflag = 0; }
#endif
    }
}

extern "C" void kernel_launch(void* const* d_in, const int* in_sizes, int n_in, void* d_out, int out_size, void* d_ws, size_t ws_size, hipStream_t stream) {
    static int grid = 0;
    if (grid == 0) {
        if (n_in != 21 || out_size != T * D || ws_size < WS_END) { fprintf(stderr, "kernel_launch: unexpected shapes (n_in %d, out %d, ws %zu)\n", n_in, out_size, ws_size); grid = -1; return; }
        int dev = 0, cus = 0, per_cu = 0;
        if (hipGetDevice(&dev) != hipSuccess || hipDeviceGetAttribute(&cus, hipDeviceAttributeMultiprocessorCount, dev) != hipSuccess) { grid = -1; return; }
        if (hipFuncSetAttribute((const void*)mk_fwd, hipFuncAttributeMaxDynamicSharedMemorySize, LDS_BYTES) != hipSuccess) { fprintf(stderr, "kernel_launch: hipFuncSetAttribute failed\n"); grid = -1; return; }
        if (hipOccupancyMaxActiveBlocksPerMultiprocessor(&per_cu, (const void*)mk_fwd, NTHR, LDS_BYTES) != hipSuccess || per_cu < 1) { fprintf(stderr, "kernel_launch: occupancy query says %d blocks per CU\n", per_cu); (void)hipGetLastError(); grid = -1; return; }
        if (cus != 256) { fprintf(stderr, "kernel_launch: built for a 256-CU device (got %d)\n", cus); grid = -1; return; }
        grid = cus;
    }
    if (grid < 0) return;
    (void)hipMemsetAsync((char*)d_ws + WS_CTL, 0, CTL_ZERO_BYTES, stream);
    Args a{};
    for (int i = 0; i < 21; ++i) a.in[i] = (const float*)d_in[i];
    a.out = (float*)d_out; a.ws = (unsigned char*)d_ws;
#if MK_N_LAUNCHES == 1
    a.ph_lo = 0; a.ph_hi = NPH;
    hipLaunchKernelGGL(mk_fwd, dim3(grid), dim3(NTHR), LDS_BYTES, stream, a);
#else
    for (int p = 0; p < NPH; ++p) { a.ph_lo = p; a.ph_hi = p + 1; hipLaunchKernelGGL(mk_fwd, dim3(grid), dim3(NTHR), LDS_BYTES, stream, a); }
#endif
}
```

```cpp
#include <hip/hip_runtime.h>
#include <cstdio>
#include <cstdint>
#ifndef MK_N_LAUNCHES
#define MK_N_LAUNCHES 1
#endif
namespace pg8 {
#define PG8_LAS __attribute__((address_space(3)))
typedef unsigned short bf16_t;
typedef short bf16x8 __attribute__((ext_vector_type(8)));
typedef float f32x4 __attribute__((ext_vector_type(4)));
typedef unsigned u32x4 __attribute__((ext_vector_type(4)));
constexpr int BM = 256, BK = 64, HALF = 128, HTB = HALF * BK * 2  , STAGE_BYTES = 8 * HTB, NXCD = 8, WGM = 8;

__host__ __device__ __forceinline__ int lds_byte(int r, int c) { const int st = (r >> 4) * 2 + (c >> 5), rr = r & 15, cc = c & 31, ob = rr * 64 + cc * 2; return st * 1024 + (ob ^ (((ob >> 9) & 1) << 5)); }
__host__ __device__ __forceinline__ void stage_rc(int b, int& R, int& C) { const int st = b / 1024, sb = b % 1024, swz = sb ^ (((sb >> 9) & 1) << 5); R = (st >> 1) * 16 + swz / 64; C = (st & 1) * 32 + (swz % 64) / 2; }
__host__ __device__ __forceinline__ int perm32(int rho) { const int n = rho >> 4, i = rho & 15; return 8 * (i >> 2) + 4 * n + (i & 3); }

struct Unit { int pm, pn; };
struct Gemm { const bf16_t* A; const bf16_t* Bt; int M, N, K; };

struct StaticOrder {
    int nM, nN, nwg, G, c;
    __host__ __device__ void init(int M, int N, int G_, int c_) { nM = M / BM; nN = N / BM; nwg = nM * nN; G = G_; c = c_; }
    __host__ __device__ bool next(int i, Unit& u) const {
        const long L = (long)i * G + c; if (L >= nwg) return false;
        int wgid = (int)L; { const int q = nwg / NXCD, r = nwg % NXCD, xcd = wgid % NXCD, off = wgid / NXCD; wgid = (xcd < r ? xcd * (q + 1) : r * (q + 1) + (xcd - r) * q) + off; }
        const int nig = WGM * nN, gid = wgid / nig, fm = gid * WGM, gsz = (nM - fm) < WGM ? (nM - fm) : WGM;
        u.pm = fm + ((wgid % nig) % gsz); u.pn = (wgid % nig) / gsz; return true;
    }
    __device__ __forceinline__ void a_ready(const Unit&) const {}
    __device__ __forceinline__ void done(const Unit&) const {}
};
__device__ __forceinline__ unsigned cvt_pk_bf16(float lo, float hi) { unsigned r; asm volatile("v_cvt_pk_bf16_f32 %0, %1, %2" : "=v"(r) : "v"(lo), "v"(hi)); return r; }
struct EpiBf16 {
    static constexpr bool PERM = true, AFTER_DRAIN = false;
    bf16_t* O; int ldc;
    __device__ __forceinline__ void operator()(const f32x4 (&acc)[2][2][4][2], const Unit& u, int wr, int wc, int fr, int fq) const {
        const int row0 = u.pm * BM + wr * 64 + fr; const int col0 = u.pn * BM + wc * 32 + 8 * fq;
#pragma unroll
        for (int ai = 0; ai < 2; ++ai)
#pragma unroll
            for (int m = 0; m < 4; ++m) { bf16_t* rowp = O + (size_t)(row0 + ai * HALF + m * 16) * ldc + col0;
#pragma unroll
                for (int bj = 0; bj < 2; ++bj) { const f32x4 v0 = acc[ai][bj][m][0], v1 = acc[ai][bj][m][1];
                    u32x4 w; w.x = cvt_pk_bf16(v0[0], v0[1]); w.y = cvt_pk_bf16(v0[2], v0[3]); w.z = cvt_pk_bf16(v1[0], v1[1]); w.w = cvt_pk_bf16(v1[2], v1[3]);
                    *(u32x4*)(rowp + bj * HALF) = w; } }
    }
};
struct EpiResGate {
    static constexpr bool PERM = false, AFTER_DRAIN = false;
    const float* base; float* out; const float* gate; int gpitch;
    __device__ __forceinline__ void operator()(const f32x4 (&acc)[2][2][4][2], const Unit& u, int wr, int wc, int fr, int fq) const {
        const int row0 = u.pm * BM + wr * 64 + fr, col0 = u.pn * BM + wc * 32 + 4 * fq;
        const float* gp = gate + (size_t)(u.pm >> 4) * gpitch + col0;
        f32x4 gv[2][2];
#pragma unroll
        for (int bj = 0; bj < 2; ++bj)
#pragma unroll
            for (int n = 0; n < 2; ++n) gv[bj][n] = *(const f32x4*)(gp + bj * HALF + n * 16);
#pragma unroll
        for (int ai = 0; ai < 2; ++ai)
#pragma unroll
            for (int m = 0; m < 4; ++m) { const size_t off = (size_t)(row0 + ai * HALF + m * 16) * 2048 + col0;
#pragma unroll
                for (int bj = 0; bj < 2; ++bj)
#pragma unroll
                    for (int n = 0; n < 2; ++n) { const f32x4 bs = *(const f32x4*)(base + off + bj * HALF + n * 16); *(f32x4*)(out + off + bj * HALF + n * 16) = bs + gv[bj][n] * acc[ai][bj][m][n]; }
                asm volatile("" ::: "memory"); }
    }
};

template <class Epi, class Sched, bool ALIGN_EPI = false, bool SP2 = false>
__device__ __forceinline__ void gemm_phase(PG8_LAS unsigned char* lds, const Gemm g, const Sched& S, const Epi& E, const int tid  ) {
    const int wid = __builtin_amdgcn_readfirstlane(tid >> 6), lane = tid & 63, wr = wid >> 2, wc = wid & 3, fr = lane & 15, fq = lane >> 4;
    const int K = g.K, nt = K / BK;
    unsigned voffA[2], voffB[2];
#pragma unroll
    for (int i = 0; i < 2; ++i) { int R, C; stage_rc(tid * 16 + i * 8192, R, C); const int Rb = Epi::PERM ? ((R & ~31) + perm32(R & 31)) : R;
        voffA[i] = (unsigned)(R * K + C) * 2u; voffB[i] = (unsigned)(Rb * K + C) * 2u; }
    const size_t kstep = (size_t)(BK * 2);
    const size_t hstep = (size_t)HALF * K * 2;
    const size_t tstep = 2 * hstep;
    const unsigned ldsw = (unsigned)wid * 1024u;
    const int aoff = lds_byte(wr * 64 + fr, fq * 8), boff = lds_byte(wc * 32 + fr, fq * 8);
#define PG8_SA(b, h) (((b) * 2 + (h)) * HTB)
#define PG8_SB(b, h) ((4 + (b) * 2 + (h)) * HTB)
#define PG8_STAGE(bufoff, gbase, voff) do { _Pragma("unroll") for (int _i = 0; _i < 2; ++_i) \
        __builtin_amdgcn_global_load_lds((const unsigned*)((const char*)(gbase) + (voff)[_i]), (PG8_LAS unsigned*)(lds + (bufoff) + ldsw + _i * 8192), 16, 0, 0); } while (0)
#define PG8_LDA(dst, b, h) do { _Pragma("unroll") for (int m = 0; m < 4; ++m) _Pragma("unroll") for (int k = 0; k < 2; ++k) dst[m][k] = *(const PG8_LAS bf16x8*)(lds + PG8_SA(b, h) + aoff + m * 2048 + k * 1024); } while (0)
#define PG8_LDB(dst, b, h) do { _Pragma("unroll") for (int n = 0; n < 2; ++n) _Pragma("unroll") for (int k = 0; k < 2; ++k) dst[n][k] = *(const PG8_LAS bf16x8*)(lds + PG8_SB(b, h) + boff + n * 2048 + k * 1024); } while (0)
#define PG8_MMA(ai, bj, At, Bt) do { __builtin_amdgcn_s_setprio(1); _Pragma("unroll") for (int m = 0; m < 4; ++m) _Pragma("unroll") for (int n = 0; n < 2; ++n) _Pragma("unroll") for (int k = 0; k < 2; ++k) \
        acc[ai][bj][m][n] = __builtin_amdgcn_mfma_f32_16x16x32_bf16(Bt[n][k], At[m][k], acc[ai][bj][m][n], 0, 0, 0); __builtin_amdgcn_s_setprio(0); } while (0)
#define PG8_WAIT_V(n) asm volatile("s_waitcnt vmcnt(" #n ")" ::: "memory")
#define PG8_WAIT_L(n) asm volatile("s_waitcnt lgkmcnt(" #n ")" ::: "memory")
#define PG8_BAR __builtin_amdgcn_s_barrier()
#define PG8_SCHED __builtin_amdgcn_sched_barrier(0)
    Unit cur, nxt; int ui = 0;
    if (!S.next(0, cur)) return;
    f32x4 acc[2][2][4][2];
#pragma unroll
    for (int a = 0; a < 2; ++a)
#pragma unroll
        for (int b = 0; b < 2; ++b)
#pragma unroll
            for (int m = 0; m < 4; ++m)
#pragma unroll
                for (int n = 0; n < 2; ++n) acc[a][b][m][n] = (f32x4){0.f, 0.f, 0.f, 0.f};
    bf16x8 At[4][2], B0[2][2], B1[2][2];
    const char* cA = (const char*)g.A + (size_t)cur.pm * tstep; const char* cB = (const char*)g.Bt + (size_t)cur.pn * tstep;
    S.a_ready(cur);
    if constexpr (SP2) {
        PG8_STAGE(PG8_SB(0, 0), cB, voffB); PG8_STAGE(PG8_SB(0, 1), cB + hstep, voffB); PG8_STAGE(PG8_SA(0, 0), cA, voffA); PG8_STAGE(PG8_SA(0, 1), cA + hstep, voffA);
        if (wr == 1) PG8_BAR;
        PG8_WAIT_V(2); PG8_BAR;
        PG8_STAGE(PG8_SB(1, 0), cB + kstep, voffB); PG8_STAGE(PG8_SA(1, 0), cA + kstep, voffA); PG8_STAGE(PG8_SB(1, 1), cB + hstep + kstep, voffB);
        PG8_WAIT_V(6); PG8_BAR;
    } else {
        PG8_STAGE(PG8_SB(0, 0), cB, voffB); PG8_STAGE(PG8_SA(0, 0), cA, voffA); PG8_STAGE(PG8_SB(0, 1), cB + hstep, voffB); PG8_STAGE(PG8_SA(0, 1), cA + hstep, voffA);
        if (wr == 1) PG8_BAR;
        PG8_WAIT_V(4); PG8_BAR;
        PG8_STAGE(PG8_SB(1, 0), cB + kstep, voffB); PG8_STAGE(PG8_SA(1, 0), cA + kstep, voffA); PG8_STAGE(PG8_SB(1, 1), cB + hstep + kstep, voffB);
        PG8_WAIT_V(6); PG8_BAR;
    }
    for (;;) {
        const bool has_next = S.next(ui + 1, nxt);
        const char* nA = has_next ? (const char*)g.A + (size_t)nxt.pm * tstep : cA; const char* nB = has_next ? (const char*)g.Bt + (size_t)nxt.pn * tstep : cB;
        for (int t = 0; t < nt; t += 2) {
            const bool last = (t == nt - 2);
            const char* a1 = cA + (size_t)(t + 1) * kstep;
            const char* a2 = last ? nA : cA + (size_t)(t + 2) * kstep; const char* b2 = last ? nB : cB + (size_t)(t + 2) * kstep;
            const char* a3 = a2 + kstep; const char* b3 = b2 + kstep;
            if (last && has_next) S.a_ready(nxt);
            if constexpr (SP2) {
            PG8_LDB(B0, 0, 0); PG8_LDB(B1, 0, 1); PG8_SCHED; PG8_LDA(At, 0, 0); PG8_STAGE(PG8_SA(1, 1), a1 + hstep, voffA);
            PG8_WAIT_V(8); PG8_WAIT_L(0); PG8_BAR; PG8_MMA(0, 0, At, B0); PG8_MMA(0, 1, At, B1); PG8_BAR; PG8_SCHED;
            PG8_LDA(At, 0, 1); PG8_STAGE(PG8_SB(0, 0), b2, voffB); PG8_STAGE(PG8_SB(0, 1), b2 + hstep, voffB); PG8_STAGE(PG8_SA(0, 0), a2, voffA);
            PG8_WAIT_V(8); PG8_WAIT_L(0); PG8_BAR; PG8_MMA(1, 0, At, B0); PG8_MMA(1, 1, At, B1); PG8_BAR; PG8_SCHED;
            PG8_LDB(B0, 1, 0); PG8_LDB(B1, 1, 1); PG8_SCHED; PG8_LDA(At, 1, 0); PG8_STAGE(PG8_SA(0, 1), a2 + hstep, voffA);
            PG8_WAIT_V(8); PG8_WAIT_L(0); PG8_BAR; PG8_MMA(0, 0, At, B0); PG8_MMA(0, 1, At, B1); PG8_BAR; PG8_SCHED;
            PG8_LDA(At, 1, 1); PG8_STAGE(PG8_SB(1, 0), b3, voffB); PG8_STAGE(PG8_SB(1, 1), b3 + hstep, voffB); PG8_STAGE(PG8_SA(1, 0), a3, voffA);
            PG8_WAIT_V(8); PG8_WAIT_L(0); PG8_BAR; PG8_MMA(1, 0, At, B0); PG8_MMA(1, 1, At, B1); PG8_BAR; PG8_SCHED;
            } else {
            PG8_LDB(B0, 0, 0); PG8_SCHED; PG8_LDA(At, 0, 0); PG8_STAGE(PG8_SA(1, 1), a1 + hstep, voffA);
            PG8_WAIT_L(8); PG8_BAR; PG8_WAIT_L(0); PG8_MMA(0, 0, At, B0); PG8_BAR; PG8_SCHED;
            PG8_LDB(B1, 0, 1); PG8_STAGE(PG8_SB(0, 0), b2, voffB);
            PG8_BAR; PG8_WAIT_L(0); PG8_MMA(0, 1, At, B1); PG8_BAR;
            PG8_LDA(At, 0, 1); PG8_STAGE(PG8_SA(0, 0), a2, voffA);
            PG8_BAR; PG8_WAIT_L(0); PG8_MMA(1, 0, At, B0); PG8_BAR; PG8_SCHED;
            PG8_STAGE(PG8_SB(0, 1), b2 + hstep, voffB);
            PG8_WAIT_V(6); PG8_BAR; PG8_MMA(1, 1, At, B1); PG8_BAR;
            PG8_LDB(B0, 1, 0); PG8_SCHED; PG8_LDA(At, 1, 0); PG8_STAGE(PG8_SA(0, 1), a2 + hstep, voffA);
            PG8_WAIT_L(8); PG8_BAR; PG8_WAIT_L(0); PG8_MMA(0, 0, At, B0); PG8_BAR; PG8_SCHED;
            PG8_LDB(B1, 1, 1); PG8_STAGE(PG8_SB(1, 0), b3, voffB);
            PG8_BAR; PG8_WAIT_L(0); PG8_MMA(0, 1, At, B1); PG8_BAR;
            PG8_LDA(At, 1, 1); PG8_STAGE(PG8_SA(1, 0), a3, voffA);
            PG8_BAR; PG8_WAIT_L(0); PG8_MMA(1, 0, At, B0); PG8_BAR; PG8_SCHED;
            PG8_STAGE(PG8_SB(1, 1), b3 + hstep, voffB);
            PG8_WAIT_V(6); PG8_BAR; PG8_MMA(1, 1, At, B1); PG8_BAR;
            }
        }
        if constexpr (ALIGN_EPI) { if (wr == 0) PG8_BAR; }
        if constexpr (!Epi::AFTER_DRAIN) { E(acc, cur, wr, wc, fr, fq); S.done(cur); }
        if (!has_next) break;
#pragma unroll
        for (int a = 0; a < 2; ++a)
#pragma unroll
            for (int b = 0; b < 2; ++b)
#pragma unroll
                for (int m = 0; m < 4; ++m)
#pragma unroll
                    for (int n = 0; n < 2; ++n) acc[a][b][m][n] = (f32x4){0.f, 0.f, 0.f, 0.f};
        cur = nxt; cA = nA; cB = nB; ++ui;
        if constexpr (ALIGN_EPI) { if (wr == 1) PG8_BAR; }
    }
    PG8_WAIT_V(0);
    if constexpr (!ALIGN_EPI) { if (wr == 0) PG8_BAR; }
    PG8_BAR;
    if constexpr (Epi::AFTER_DRAIN) { E.fused(acc, cur, wr, wc, fr, fq, lds, wid, lane); S.done(cur); }
#undef PG8_SA
#undef PG8_SB
#undef PG8_STAGE
#undef PG8_LDA
#undef PG8_LDB
#undef PG8_MMA
#undef PG8_WAIT_V
#undef PG8_WAIT_L
#undef PG8_BAR
#undef PG8_SCHED
}
}
constexpr int NWAVES = 8, NTHR = 512;
constexpr int D = 2048, NBATCH = 4, SEQ = 4096, T = NBATCH * SEQ, DEPTH = 2;
constexpr int GLA_H = 4, GLA_DK = 128, GLA_DV = 256, GLA_CH = 64;
constexpr int MLP_H = 8, MLP_DH = 128, MLP_CH = 128;
constexpr int IN_COLS = 5136, NPROJ = 5120;
constexpr int C_Q = 0, C_K = 512, C_V = 1024, C_R = 2048, C_U = 3072, C_VS = 4096;
constexpr int NEXP = 16384, PEER_H = 8;
constexpr float EPS = 1e-6f;
constexpr int MODW = 6 * D;
constexpr size_t MiB = 1u << 20;
constexpr size_t WS_CTL = 0, CTL_ZERO_BYTES = 1 * MiB;
constexpr size_t WS_MOD = 1 * MiB;
constexpr size_t WS_K1B = 2 * MiB, WS_K2B = 2 * MiB + 512 * 1024, WS_WSB = 3 * MiB, WS_DEC = 3 * MiB + 512 * 1024, WS_ALOW = 4 * MiB;
constexpr size_t WS_KU = 5 * MiB, WS_KV = 5 * MiB + 256 * 1024;
constexpr size_t WS_SU = 6 * MiB, WS_HS = 7 * MiB;
constexpr size_t WS_WTIN = 8 * MiB;
constexpr size_t WTIN_L = (size_t)5136 * 2048;
constexpr size_t WS_WTOUT = 49 * MiB, WS_WTQ = 65 * MiB;
constexpr size_t WS_PUB = 81 * MiB, WS_PVB = 209 * MiB;
constexpr size_t WS_H = 337 * MiB;
constexpr size_t WS_PROJ = 401 * MiB;
constexpr size_t WS_SBUF = 561 * MiB;
constexpr size_t WS_CONCAT = 625 * MiB;
constexpr size_t WS_QB = 689 * MiB;
constexpr size_t WS_EB = 753 * MiB, WS_PG = 761 * MiB;
constexpr size_t WS_H8 = 769 * MiB, WS_END = 833 * MiB;
static_assert(WS_WTIN + 2 * WTIN_L * 2 <= WS_WTOUT, "ws map");
constexpr int CW_BAR = 4096;
constexpr int RING_BYTES = 131072, LDSCTL_OFF = RING_BYTES, MISC_OFF = LDSCTL_OFF + 320, LDS_BYTES = 147456;

#define DI __device__ __forceinline__
#define LAS __attribute__((address_space(3)))
typedef unsigned short bf16;
typedef short bf16x8 __attribute__((ext_vector_type(8)));
typedef short s16x4 __attribute__((ext_vector_type(4)));
typedef short v4i16_t __attribute__((ext_vector_type(4)));
typedef __bf16 bf16x2_t __attribute__((ext_vector_type(2)));
typedef float f32x4 __attribute__((ext_vector_type(4)));
typedef float f32x2 __attribute__((ext_vector_type(2)));
typedef unsigned u32x4 __attribute__((ext_vector_type(4)));
typedef unsigned u32x2 __attribute__((ext_vector_type(2)));
typedef LAS unsigned char* ldsp;

DI unsigned f2bf(float f) { unsigned u = __builtin_bit_cast(unsigned, f); return (u + 0x7fffu + ((u >> 16) & 1u)) >> 16; }
DI unsigned pk2(float lo, float hi) { return f2bf(lo) | (f2bf(hi) << 16); }
DI float bflo(unsigned u) { return __builtin_bit_cast(float, u << 16); }
DI float bfhi(unsigned u) { return __builtin_bit_cast(float, u & 0xffff0000u); }
DI float bf1(bf16 v) { return __builtin_bit_cast(float, ((unsigned)v) << 16); }
DI float fexp2(float x) { return __builtin_amdgcn_exp2f(x); }
DI float flog2(float x) { return __builtin_amdgcn_logf(x); }
DI float frcp(float x) { return __builtin_amdgcn_rcpf(x); }
DI float frsq(float x) { return __builtin_amdgcn_rsqf(x); }
DI float gelu_t(float x) { const float u = 0.7978845608f * (x + 0.044715f * x * x * x); return x * frcp(1.f + fexp2(-2.885390082f * u)); }
DI float silu_f(float x) { return x * frcp(1.f + fexp2(-1.442695041f * x)); }
template <int CTRL> DI float dppf(float v) { return __builtin_bit_cast(float, __builtin_amdgcn_update_dpp(0, __builtin_bit_cast(int, v), CTRL, 0xf, 0xf, true)); }
DI float wave_sum_u(float v) {
    v += dppf<0xB1>(v); v += dppf<0x4E>(v); v += dppf<0x141>(v); v += dppf<0x140>(v);
    const int iv = __builtin_bit_cast(int, v);
    return (__builtin_bit_cast(float, __builtin_amdgcn_readlane(iv, 0)) + __builtin_bit_cast(float, __builtin_amdgcn_readlane(iv, 16))) +
           (__builtin_bit_cast(float, __builtin_amdgcn_readlane(iv, 32)) + __builtin_bit_cast(float, __builtin_amdgcn_readlane(iv, 48)));
}
DI float wave_sum(float v) {
#pragma unroll
    for (int o = 1; o < 64; o <<= 1) v += __shfl_xor(v, o);
    return v;
}
DI float dot2bf(unsigned a, unsigned b, float c) { return __builtin_amdgcn_fdot2_f32_bf16(__builtin_bit_cast(bf16x2_t, a), __builtin_bit_cast(bf16x2_t, b), c, false); }
DI f32x4 mfma16(bf16x8 a, bf16x8 b, f32x4 c) { return __builtin_amdgcn_mfma_f32_16x16x32_bf16(a, b, c, 0, 0, 0); }
DI s16x4 tr4(const LAS bf16* p) { return __builtin_bit_cast(s16x4, __builtin_amdgcn_ds_read_tr16_b64_v4i16((LAS v4i16_t*)p)); }
DI bf16x8 tr8(const LAS bf16* p, int stride) { const s16x4 a = tr4(p), b = tr4(p + 4 * stride); return (bf16x8){a[0], a[1], a[2], a[3], b[0], b[1], b[2], b[3]}; }

#define XB_TMO      128
#define XB_XCNT(j)  (256  + 64 * (j))
#define XB_XSUB(j)  (1280 + 64 * (j))
#define XB_XGEN(j)  (2304 + 64 * (j))
#define XB_TOP      3328
#define XB_TOPGEN   3392
#define XCD_BAR_WORDS 3456
#define XB_SPIN_CAP (1u << 18)

__device__ __forceinline__ unsigned xb_ld(unsigned* p)              { return __hip_atomic_load(p, __ATOMIC_RELAXED, __HIP_MEMORY_SCOPE_AGENT); }
__device__ __forceinline__ unsigned xb_add(unsigned* p, unsigned v) { return __hip_atomic_fetch_add(p, v, __ATOMIC_RELAXED, __HIP_MEMORY_SCOPE_AGENT); }
__device__ __forceinline__ unsigned xb_xcc_id() { return (unsigned)__builtin_amdgcn_s_getreg((3 << 11) | 20) & 0xFu; }
#define XB_SPIN(cond, bar) do { unsigned _sp = 0; while (cond) { __builtin_amdgcn_s_sleep(1); \
    if ((++_sp & 255u) == 0u) { if (xb_ld(&(bar)[XB_TMO])) break; if (_sp > XB_SPIN_CAP) { atomicAdd(&(bar)[XB_TMO], 1u); break; } } } } while (0)

struct XcdBarrier {
    unsigned* bar; unsigned x;
    volatile LAS unsigned* st;
};

__device__ __forceinline__ XcdBarrier xcd_barrier_post(unsigned* bar, volatile LAS unsigned* st) {
    XcdBarrier b; b.bar = bar; b.x = xb_xcc_id(); b.st = st;
    if (threadIdx.x == 0) (void)xb_add(&bar[XB_XCNT(b.x)], 1u);
    return b;
}
__device__ __forceinline__ void xcd_barrier_complete(unsigned* bar, unsigned x, unsigned& nloc, unsigned& nx) {
    const unsigned G = gridDim.x * gridDim.y * gridDim.z;
    unsigned sum, cnt, mine, sp = 0u;
    for (;;) {
        sum = 0u; cnt = 0u; mine = 0u;
#pragma unroll
        for (unsigned j = 0; j < 16; ++j) { const unsigned c = xb_ld(&bar[XB_XCNT(j)]); sum += c; cnt += (c > 0u) ? 1u : 0u; mine = (j == x) ? c : mine; }
        if (sum == G) break;
        __builtin_amdgcn_s_sleep(1);
        if ((++sp & 255u) == 0u) { if (xb_ld(&bar[XB_TMO])) break; if (sp > XB_SPIN_CAP) { atomicAdd(&bar[XB_TMO], 1u); break; } }
    }
    nloc = mine > 0u ? mine : 1u; nx = cnt > 0u ? cnt : 1u;
}

__device__ __forceinline__ void xcd_barrier(const XcdBarrier& b) {
    asm volatile("s_waitcnt vmcnt(0)" ::: "memory");
    __syncthreads();
    if (threadIdx.x == 0) {
        unsigned* bar = b.bar;
        __builtin_amdgcn_s_waitcnt(0);
        unsigned nloc = b.st[0], nx = b.st[1];
        if (nloc == 0u) { xcd_barrier_complete(bar, b.x, nloc, nx); b.st[0] = nloc; b.st[1] = nx; }
        const unsigned old = xb_add(&bar[XB_XSUB(b.x)], 1u);
        const unsigned gen = old / nloc;
        if (old + 1u == (gen + 1u) * nloc) {
            __builtin_amdgcn_fence(__ATOMIC_RELEASE, "agent");
            asm volatile("s_waitcnt vmcnt(0)" ::: "memory");
            const unsigned og = xb_add(&bar[XB_TOP], 1u);
            const unsigned tg = og / nx;
            if (og + 1u == (tg + 1u) * nx) xb_add(&bar[XB_TOPGEN], 1u);
            else XB_SPIN(xb_ld(&bar[XB_TOPGEN]) == tg, bar);
            __builtin_amdgcn_fence(__ATOMIC_ACQUIRE, "agent");
            xb_add(&bar[XB_XGEN(b.x)], 1u);
            asm volatile("s_waitcnt vmcnt(0)" ::: "memory");
        } else {
            XB_SPIN(xb_ld(&bar[XB_XGEN(b.x)]) == gen, bar);
            __builtin_amdgcn_fence(__ATOMIC_ACQUIRE, "agent");
            asm volatile("s_waitcnt vmcnt(0)" ::: "memory");
        }
    }
    __syncthreads();
}
struct Ctx {
    ldsp lds; int tid, lane, wave, bid, G, gw, NGW;
    unsigned char* ws;
};
DI const float* KARG(int k) { asm volatile("" : "+s"(k)); return ((const float* const*)__builtin_amdgcn_kernarg_segment_ptr())[k]; }
#define LDS_WAIT() asm volatile("s_waitcnt lgkmcnt(0)" ::: "memory")
enum { I_X = 0, I_C, I_ADAW, I_ADAB, I_N1G, I_WIN, I_WA2, I_BA, I_GNG, I_VNG, I_MWS, I_MB, I_MOG, I_WOUT, I_N2G, I_WQ, I_K1, I_K2, I_PU, I_PV, I_FG };

DI void p0_ada(const Ctx& C) {
    LAS float* red = (LAS float*)C.lds;
    float* MOD = (float*)(C.ws + WS_MOD);
    for (int it = C.bid; it < 192; it += C.G) {
        const int l = it / 96, cg = it % 96, c0 = cg * 128 + C.lane * 2;
        const float* W = KARG(I_ADAW) + (size_t)l * D * MODW + (size_t)(C.wave * 256) * MODW + c0;
        float cv[4][4];
#pragma unroll
        for (int b = 0; b < 4; ++b)
#pragma unroll
            for (int i = 0; i < 4; ++i) cv[b][i] = silu_f(KARG(I_C)[b * D + C.wave * 256 + i * 64 + C.lane]);
        float acc[4][2];
#pragma unroll
        for (int b = 0; b < 4; ++b) { acc[b][0] = 0.f; acc[b][1] = 0.f; }
#pragma unroll
        for (int i = 0; i < 4; ++i) {
#pragma unroll 16
            for (int j = 0; j < 64; ++j) {
                const f32x2 w = *(const f32x2*)(W + (size_t)(i * 64 + j) * MODW);
#pragma unroll
                for (int b = 0; b < 4; ++b) { const float s = __builtin_bit_cast(float, __builtin_amdgcn_readlane(__builtin_bit_cast(int, cv[b][i]), j)); acc[b][0] += s * w.x; acc[b][1] += s * w.y; }
            }
        }
#pragma unroll
        for (int b = 0; b < 4; ++b) *(LAS f32x2*)(red + (C.wave * 4 + b) * 128 + C.lane * 2) = (f32x2){acc[b][0], acc[b][1]};
        __syncthreads();
        { const int b = C.tid >> 7, col = C.tid & 127; float s = KARG(I_ADAB)[l * MODW + cg * 128 + col];
#pragma unroll
          for (int w = 0; w < 8; ++w) s += red[(w * 4 + b) * 128 + col];
          MOD[(size_t)(l * 4 + b) * MODW + cg * 128 + col] = s; }
        __syncthreads();
    }
}
DI void transpose_item(const float* W, int ldw, int src_col0, int ncols, bf16* WT, int dst_row0, int k0, LAS float* scr, int lane) {
    const int cl = lane & 31;
    float v[32];
#pragma unroll
    for (int i = 0; i < 32; ++i) { const int kk = 2 * i + (lane >> 5); v[i] = 0.f; if (cl < ncols) v[i] = W[(size_t)(k0 + kk) * ldw + src_col0 + cl]; }
#pragma unroll
    for (int i = 0; i < 32; ++i) { const int kk = 2 * i + (lane >> 5); scr[kk * 33 + cl] = v[i]; }
    LDS_WAIT();
    const int c = lane & 7;
#pragma unroll
    for (int j = 0; j < 4; ++j) { const int n = (lane >> 3) + 8 * j;
        if (n < ncols) { const LAS float* s = scr + (8 * c) * 33 + n;
            u32x4 o; o.x = pk2(s[0 * 33], s[1 * 33]); o.y = pk2(s[2 * 33], s[3 * 33]); o.z = pk2(s[4 * 33], s[5 * 33]); o.w = pk2(s[6 * 33], s[7 * 33]);
            *(u32x4*)(WT + (size_t)(dst_row0 + n) * 2048 + k0 + 8 * c) = o; } }
    LDS_WAIT();
}
DI void p0_prologue(const Ctx& C) {
    p0_ada(C);
    LAS float* scr = (LAS float*)(C.lds + C.wave * 16384);
    constexpr int PER_L = (161 + 64 + 64) * 32;
    for (int it = C.gw; it < 2 * PER_L; it += C.NGW) {
        const int l = it / PER_L; int r = it % PER_L;
        if (r < 161 * 32) { const int kb = r / 161, nb = r % 161; bf16* WT = (bf16*)(C.ws + WS_WTIN) + (size_t)l * WTIN_L;
            const float* W = KARG(I_WIN) + (size_t)l * D * IN_COLS;
            if (nb < 160) { const int n0 = 32 * nb; transpose_item(W, IN_COLS, n0 + (n0 >= 3072 ? 16 : 0), 32, WT, n0, 64 * kb, scr, C.lane); }
            else transpose_item(W, IN_COLS, 3072, 16, WT, 5120, 64 * kb, scr, C.lane);
            continue; }
        r -= 161 * 32;
        if (r < 2048) { const int kb = r / 64, nb = r % 64; transpose_item(KARG(I_WOUT) + (size_t)l * D * D, D, 32 * nb, 32, (bf16*)(C.ws + WS_WTOUT) + (size_t)l * D * D, 32 * nb, 64 * kb, scr, C.lane); continue; }
        r -= 2048;
        { const int kb = r / 64, nb = r % 64; transpose_item(KARG(I_WQ) + (size_t)l * D * D, D, 32 * nb, 32, (bf16*)(C.ws + WS_WTQ) + (size_t)l * D * D, 32 * nb, 64 * kb, scr, C.lane); }
    }
    const int gt = C.bid * NTHR + C.tid, NT = C.G * NTHR;
    { bf16* K1B = (bf16*)(C.ws + WS_K1B); bf16* K2B = (bf16*)(C.ws + WS_K2B); bf16* WSB = (bf16*)(C.ws + WS_WSB);
      for (int i = gt; i < 262144; i += NT) { K1B[i] = (bf16)f2bf(KARG(I_K1)[i]); K2B[i] = (bf16)f2bf(KARG(I_K2)[i]);
          const int s = i & 127, t = (i >> 7) & 127; WSB[i] = (s <= t) ? (bf16)f2bf(KARG(I_MWS)[i]) : (bf16)0; } }
    { float* SU = (float*)(C.ws + WS_SU); int* KV = (int*)(C.ws + WS_KV);
#pragma unroll 1
      for (int row = C.gw; row < 4 * NEXP; row += C.NGW) {
          const int tb = row >> 15, rr = row & 32767;
          const f32x4* src = (const f32x4*)(KARG(tb ? I_PV : I_PU) + (size_t)rr * D) + C.lane;
          f32x4 v[8];
#pragma unroll
          for (int j = 0; j < 8; ++j) v[j] = src[64 * j];
          const int lyr = rr >> 14, ee = rr & 16383;
          unsigned* dst = (unsigned*)(C.ws + (tb ? WS_PVB : WS_PUB) + (size_t)lyr * NEXP * D + (size_t)ee * 256) + C.lane;
          if (tb) {
              float mx = 0.f;
#pragma unroll
              for (int j = 0; j < 8; ++j) mx = fmaxf(mx, fmaxf(fmaxf(fabsf(v[j].x), fabsf(v[j].y)), fmaxf(fabsf(v[j].z), fabsf(v[j].w))));
#pragma unroll
              for (int o = 1; o < 64; o <<= 1) mx = fmaxf(mx, __shfl_xor(mx, o));
              int k = 0;
              if (mx > 0.f) { k = (int)((__builtin_bit_cast(unsigned, 224.0f / mx) >> 23) & 255u) - 127; k = k < -60 ? -60 : (k > 60 ? 60 : k); }
              const float sc = __builtin_bit_cast(float, (unsigned)(k + 127) << 23);
#pragma unroll
              for (int j = 0; j < 8; ++j) { int p = 0; p = __builtin_amdgcn_cvt_pk_fp8_f32(v[j].x * sc, v[j].y * sc, p, false); p = __builtin_amdgcn_cvt_pk_fp8_f32(v[j].z * sc, v[j].w * sc, p, true); dst[(size_t)j * (NEXP * 256 / 4)] = (unsigned)p; }
              if (C.lane == 0) KV[rr] = k;
          } else {
#pragma unroll
              for (int j = 0; j < 8; ++j) {
                  float mx = fmaxf(fmaxf(fabsf(v[j].x), fabsf(v[j].y)), fmaxf(fabsf(v[j].z), fabsf(v[j].w)));
#pragma unroll
                  for (int o = 1; o < 64; o <<= 1) mx = fmaxf(mx, __shfl_xor(mx, o));
                  const float inv = mx > 0.f ? 127.0f / mx : 0.f;
                  const int q0 = (int)__builtin_rintf(v[j].x * inv), q1 = (int)__builtin_rintf(v[j].y * inv), q2 = (int)__builtin_rintf(v[j].z * inv), q3 = (int)__builtin_rintf(v[j].w * inv);
                  dst[(size_t)j * (NEXP * 256 / 4)] = (unsigned)(q0 & 255) | ((unsigned)(q1 & 255) << 8) | ((unsigned)(q2 & 255) << 16) | ((unsigned)q3 << 24);
                  if (C.lane == 0) SU[(size_t)(lyr * 8 + j) * NEXP + ee] = mx * (1.0f / 127.0f);
              }
          }
      } }
}
template <bool FP8 = false>
DI void norm_phase(const Ctx& C, const float* X, const float* g, const float* modl, int sh_off, int sc_off, bf16* Hout, unsigned char* H8 = nullptr, float* HS = nullptr) {
    const int r0 = C.gw * 8, b = r0 >> 12;
    const f32x4* shp = (const f32x4*)(modl + (size_t)b * MODW + sh_off); const f32x4* scp = (const f32x4*)(modl + (size_t)b * MODW + sc_off);
    f32x4 gm[8], shv[8];
#pragma unroll
    for (int j = 0; j < 8; ++j) { const int idx = 64 * j + C.lane; gm[j] = ((const f32x4*)g)[idx] * (scp[idx] + 1.0f); shv[j] = shp[idx]; }
#pragma unroll 1
    for (int i = 0; i < 8; ++i) {
        const f32x4* xr = (const f32x4*)(X + (size_t)(r0 + i) * D) + C.lane; f32x4 v[8]; float s = 0.f;
#pragma unroll
        for (int j = 0; j < 8; ++j) { v[j] = xr[64 * j]; s += (v[j].x * v[j].x + v[j].y * v[j].y) + (v[j].z * v[j].z + v[j].w * v[j].w); }
        const float rstd = frsq(wave_sum(s) * (1.f / D) + EPS);
        u32x2* o = (u32x2*)(Hout + (size_t)(r0 + i) * D) + C.lane;
        float am = 0.f;
#pragma unroll
        for (int j = 0; j < 8; ++j) { const f32x4 y = v[j] * rstd * gm[j] + shv[j]; u32x2 w; w.x = pk2(y.x, y.y); w.y = pk2(y.z, y.w); o[64 * j] = w;
            if (FP8) { v[j] = y; am = fmaxf(am, fmaxf(fmaxf(fabsf(y.x), fabsf(y.y)), fmaxf(fabsf(y.z), fabsf(y.w)))); } }
        if (FP8) {
#pragma unroll
            for (int of = 1; of < 64; of <<= 1) am = fmaxf(am, __shfl_xor(am, of));
            const float qs = am > 0.f ? 16256.0f / am : 0.f;
            if (C.lane == 0) HS[r0 + i] = am * (1.0f / 16256.0f);
            unsigned* h8 = (unsigned*)(H8 + (size_t)(r0 + i) * 4096) + C.lane;
#pragma unroll
            for (int j = 0; j < 8; ++j) {
                const int q0 = (int)__builtin_rintf(v[j].x * qs), q1 = (int)__builtin_rintf(v[j].y * qs), q2 = (int)__builtin_rintf(v[j].z * qs), q3 = (int)__builtin_rintf(v[j].w * qs);
                const int h0 = (q0 + 64) >> 7, h1 = (q1 + 64) >> 7, h2 = (q2 + 64) >> 7, h3 = (q3 + 64) >> 7;
                const int l0 = q0 - (h0 << 7), l1 = q1 - (h1 << 7), l2 = q2 - (h2 << 7), l3 = q3 - (h3 << 7);
                h8[64 * j] = (unsigned)(h0 & 255) | ((unsigned)(h1 & 255) << 8) | ((unsigned)(h2 & 255) << 16) | ((unsigned)h3 << 24);
                h8[512 + 64 * j] = (unsigned)(l0 & 255) | ((unsigned)(l1 & 255) << 8) | ((unsigned)(l2 & 255) << 16) | ((unsigned)l3 << 24); }
        }
    }
}
DI void alow_phase(const Ctx& C, const bf16* Hb, const bf16* WtA, float* ALOW) {
    const int task = C.bid * 4 + (C.wave & 3), kh = C.wave >> 2, r0 = task * 16, fr = C.lane & 15, fq = C.lane >> 4;
    const bf16* ap = Hb + (size_t)(r0 + fr) * D + 8 * fq + 1024 * kh; const bf16* bp = WtA + (size_t)fr * D + 8 * fq + 1024 * kh;
    f32x4 acc = (f32x4){0.f, 0.f, 0.f, 0.f};
#pragma unroll 8
    for (int ks = 0; ks < 32; ++ks) { const bf16x8 a = *(const bf16x8*)(ap + 32 * ks), b = *(const bf16x8*)(bp + 32 * ks); acc = mfma16(a, b, acc); }
    LAS f32x4* xch = (LAS f32x4*)C.lds + (C.wave & 3) * 64 + C.lane;
    if (kh) *xch = acc;
    LDS_WAIT(); __builtin_amdgcn_s_barrier(); asm volatile("" ::: "memory");
    if (!kh) { acc += *xch;
#pragma unroll
        for (int r = 0; r < 4; ++r) ALOW[(size_t)(r0 + 4 * fq + r) * 16 + fr] = acc[r]; }
}
#define LBAR() do { asm volatile("s_waitcnt lgkmcnt(0)" ::: "memory"); __builtin_amdgcn_s_barrier(); asm volatile("" ::: "memory"); } while (0)
DI void gla_gates(const Ctx& C, LAS float* al, LAS float* tot, const f32x4 alv, const float (&w2)[16], const float bav, float (&Gl)[16], float& off, float& gref, float& g63) {
    const int d = C.tid & 127, jg = C.tid >> 7;
    if (C.tid < 256) ((LAS f32x4*)al)[C.tid] = alv;
    LBAR();
    float run = 0.f;
#pragma unroll
    for (int jj = 0; jj < 16; ++jj) {
        const LAS f32x4* ar = (const LAS f32x4*)(al + (jg * 16 + jj) * 16);
        const f32x4 a0 = ar[0], a1 = ar[1], a2 = ar[2], a3 = ar[3];
        float z = bav;
        z += a0.x * w2[0] + a0.y * w2[1] + a0.z * w2[2] + a0.w * w2[3];
        z += a1.x * w2[4] + a1.y * w2[5] + a1.z * w2[6] + a1.w * w2[7];
        z += a2.x * w2[8] + a2.y * w2[9] + a2.z * w2[10] + a2.w * w2[11];
        z += a3.x * w2[12] + a3.y * w2[13] + a3.z * w2[14] + a3.w * w2[15];
        const float ls = fminf(z, 0.f) - 0.6931471806f * flog2(1.f + fexp2(-1.442695041f * fabsf(z)));
        run += ls * (1.442695041f / 16.f);
        Gl[jj] = run;
    }
    tot[jg * 128 + d] = run;
    LBAR();
    const float t0_ = tot[d], t1_ = tot[128 + d], t2_ = tot[256 + d], t3_ = tot[384 + d];
    off = (jg > 0 ? t0_ : 0.f) + (jg > 1 ? t1_ : 0.f) + (jg > 2 ? t2_ : 0.f); gref = t0_ + t1_; g63 = (t0_ + t1_) + (t2_ + t3_);
}
constexpr int KST = 136, VST = 264, PST = 72;
struct GlaIn { f32x4 alv; bf16 qraw[16], kraw[16]; u32x4 vt[4]; };
template <bool WITHQ>
DI void gla_load(const Ctx& C, int idx, const bf16* PROJ, const float* ALOW, GlaIn& in) {
    const int b = idx >> 8, h = (idx >> 6) & 3, n = idx & 63, t0 = b * SEQ + n * 64, d = C.tid & 127, jg = C.tid >> 7;
    in.alv = (f32x4){0.f, 0.f, 0.f, 0.f};
    if (C.tid < 256) in.alv = ((const f32x4*)(ALOW + (size_t)t0 * 16))[C.tid];
#pragma unroll
    for (int jj = 0; jj < 16; ++jj) { const bf16* row = PROJ + (size_t)(t0 + jg * 16 + jj) * NPROJ + h * 128 + d; in.kraw[jj] = row[C_K]; if (WITHQ) in.qraw[jj] = row[C_Q]; }
#pragma unroll
    for (int i = 0; i < 4; ++i) { const int c = C.tid + 512 * i, j = c >> 5, ec = c & 31; in.vt[i] = *(const u32x4*)(PROJ + (size_t)(t0 + j) * NPROJ + C_V + h * 256 + 8 * ec); }
}
DI void store_v_tile(const Ctx& C, const GlaIn& in, LAS bf16* VL) {
#pragma unroll
    for (int i = 0; i < 4; ++i) { const int c = C.tid + 512 * i, j = c >> 5, ec = c & 31; *(LAS u32x4*)(VL + j * VST + 8 * ec) = in.vt[i]; }
}
DI void glaA_phase(const Ctx& C, int l, const bf16* PROJ, const float* ALOW, bf16* SBUF, float* DEC) {
    LAS float* al = (LAS float*)(C.lds); LAS float* tot = (LAS float*)(C.lds + 4096);
    LAS bf16* KD = (LAS bf16*)(C.lds + 8192); LAS bf16* VL = (LAS bf16*)(C.lds + 25600);
    const int d = C.tid & 127, jg = C.tid >> 7, h = (C.bid >> 6) & 3;
    float w2[16];
#pragma unroll
    for (int r = 0; r < 16; ++r) w2[r] = KARG(I_WA2)[(size_t)l * 16 * 512 + r * 512 + h * 128 + d];
    const float bav = KARG(I_BA)[(size_t)l * 512 + h * 128 + d];
    GlaIn cur, nxt;
    gla_load<false>(C, C.bid, PROJ, ALOW, cur);
#pragma unroll 1
    for (int i = 0; i < 4; ++i) {
        const int idx = i * C.G + C.bid;
        float Gl[16], off, gref, g63;
        gla_gates(C, al, tot, cur.alv, w2, bav, Gl, off, gref, g63);
#pragma unroll
        for (int jj = 0; jj < 16; ++jj) { const int j = jg * 16 + jj; KD[j * KST + d] = (bf16)f2bf(bf1(cur.kraw[jj]) * fexp2(g63 - (off + Gl[jj]))); }
        store_v_tile(C, cur, VL);
        LBAR();
        if (i + 1 < 4) gla_load<false>(C, idx + C.G, PROJ, ALOW, nxt);
        if (jg == 0) DEC[(size_t)idx * 128 + d] = fexp2(g63);
        const int lane = C.lane, g = lane >> 4, qq = (lane & 15) >> 2, p = lane & 3, fr = lane & 15;
        bf16x8 A[2];
#pragma unroll
        for (int ks = 0; ks < 2; ++ks) A[ks] = tr8(KD + (32 * ks + 8 * g + qq) * KST + 16 * C.wave + 4 * p, KST);
        bf16* Sit = SBUF + (size_t)idx * 256 * 128;
#pragma unroll
        for (int half = 0; half < 2; ++half) {
            f32x4 acc[8];
#pragma unroll
            for (int nt = 0; nt < 8; ++nt) acc[nt] = (f32x4){0.f, 0.f, 0.f, 0.f};
#pragma unroll
            for (int nt = 0; nt < 8; ++nt)
#pragma unroll
                for (int ks = 0; ks < 2; ++ks) { const bf16x8 Bf = tr8(VL + (32 * ks + 8 * g + qq) * VST + 16 * (half * 8 + nt) + 4 * p, VST); acc[nt] = mfma16(A[ks], Bf, acc[nt]); }
#pragma unroll
            for (int nt = 0; nt < 8; ++nt) { const int e = 16 * (half * 8 + nt) + fr, dd = 16 * C.wave + 4 * g;
                u32x2 w; w.x = pk2(acc[nt][0], acc[nt][1]); w.y = pk2(acc[nt][2], acc[nt][3]); *(u32x2*)(Sit + (size_t)e * 128 + dd) = w; }
        }
        LBAR();
        cur = nxt;
    }
}
DI void scan_phase(const Ctx& C, bf16* SBUF, const float* DEC) {
    const int gt = C.bid * NTHR + C.tid, bh = gt >> 13, rem = gt & 8191, e = rem >> 5, dq = rem & 31;
    u32x2* p = (u32x2*)(SBUF + ((size_t)(bh * 64) * 256 + e) * 128 + 4 * dq);
    const f32x4* dp = (const f32x4*)(DEC + (size_t)(bh * 64) * 128 + 4 * dq);
    f32x4 st = (f32x4){0.f, 0.f, 0.f, 0.f};
#pragma unroll 1
    for (int n0 = 0; n0 < 64; n0 += 8) {
        u32x2 tmp[8]; f32x4 dc[8];
#pragma unroll
        for (int u = 0; u < 8; ++u) { tmp[u] = p[(size_t)(n0 + u) * 8192]; dc[u] = dp[(n0 + u) * 32]; }
#pragma unroll
        for (int u = 0; u < 8; ++u) { u32x2 w; w.x = pk2(st.x, st.y); w.y = pk2(st.z, st.w); p[(size_t)(n0 + u) * 8192] = w;
            st = dc[u] * st + (f32x4){bflo(tmp[u].x), bfhi(tmp[u].x), bflo(tmp[u].y), bfhi(tmp[u].y)}; }
    }
}
DI void glaC_phase(const Ctx& C, int l, const bf16* PROJ, const float* ALOW, const bf16* SBUF, bf16* CONCAT) {
    const int h = (C.bid >> 6) & 3;
    LAS float* al = (LAS float*)(C.lds); LAS float* tot = (LAS float*)(C.lds + 4096); LAS float* RS = (LAS float*)(C.lds + 6144);
    LAS bf16* QT = (LAS bf16*)(C.lds + 8192); LAS bf16* KT = (LAS bf16*)(C.lds + 25600); LAS bf16* QG = (LAS bf16*)(C.lds + 43008);
    LAS bf16* VL = (LAS bf16*)(C.lds + 60416); LAS bf16* PL = (LAS bf16*)(C.lds + 94208);
    const int d = C.tid & 127, jg = C.tid >> 7;
    float w2[16];
#pragma unroll
    for (int r = 0; r < 16; ++r) w2[r] = KARG(I_WA2)[(size_t)l * 16 * 512 + r * 512 + h * 128 + d];
    const float bav = KARG(I_BA)[(size_t)l * 512 + h * 128 + d];
    const float* ng = KARG(I_GNG) + (size_t)(l * 4 + h) * 256;
    GlaIn cur;
    f32x4 alv_n = (f32x4){0.f, 0.f, 0.f, 0.f};
    if (C.tid < 256) alv_n = ((const f32x4*)(ALOW + (size_t)((C.bid >> 8) * SEQ + (C.bid & 63) * 64) * 16))[C.tid];
#pragma unroll 1
    for (int it = 0; it < 4; ++it) {
    const int idx = it * C.G + C.bid, b = idx >> 8, n = idx & 63, t0 = b * SEQ + n * 64;
    gla_load<true>(C, idx, PROJ, ALOW, cur); cur.alv = alv_n;
    float Gl[16], off, gref, g63;
    gla_gates(C, al, tot, cur.alv, w2, bav, Gl, off, gref, g63);
#pragma unroll
    for (int jj = 0; jj < 16; ++jj) { const int j = jg * 16 + jj; const float Gv = off + Gl[jj];
        const float q = bf1(cur.qraw[jj]) * 0.08838834764831845f, k = bf1(cur.kraw[jj]);
        QT[j * KST + d] = (bf16)f2bf(q * fexp2(fminf(Gv - gref, 100.f))); KT[j * KST + d] = (bf16)f2bf(k * fexp2(fminf(gref - Gv, 100.f))); QG[j * KST + d] = (bf16)f2bf(q * fexp2(Gv)); }
    store_v_tile(C, cur, VL);
    const int lane = C.lane, g = lane >> 4, qq = (lane & 15) >> 2, p = lane & 3, fr = lane & 15;
    bf16x8 Sf[2][4]; u32x2 rraw[4][2];
#pragma unroll
    for (int mi = 0; mi < 2; ++mi) { const bf16* Srow = SBUF + ((size_t)idx * 256 + 16 * (2 * C.wave + mi) + fr) * 128 + 8 * g;
#pragma unroll
        for (int ks = 0; ks < 4; ++ks) Sf[mi][ks] = *(const bf16x8*)(Srow + 32 * ks); }
#pragma unroll
    for (int nt = 0; nt < 4; ++nt)
#pragma unroll
        for (int mi = 0; mi < 2; ++mi) rraw[nt][mi] = *(const u32x2*)(PROJ + (size_t)(t0 + 16 * nt + fr) * NPROJ + C_R + h * 256 + 16 * (2 * C.wave + mi) + 4 * g);
    LBAR();
    {
        const int nt = C.wave & 3;
#pragma unroll
        for (int mi = 0; mi < 2; ++mi) { const int mt = 2 * (C.wave >> 2) + mi; f32x4 acc = (f32x4){0.f, 0.f, 0.f, 0.f};
#pragma unroll
            for (int ks = 0; ks < 4; ++ks) { const bf16x8 a = *(const LAS bf16x8*)(KT + (16 * mt + fr) * KST + 32 * ks + 8 * g), bq = *(const LAS bf16x8*)(QT + (16 * nt + fr) * KST + 32 * ks + 8 * g); acc = mfma16(a, bq, acc); }
            const int i = 16 * nt + fr, j0 = 16 * mt + 4 * g;
            const float v0 = (j0 + 0 <= i) ? acc[0] : 0.f, v1 = (j0 + 1 <= i) ? acc[1] : 0.f, v2 = (j0 + 2 <= i) ? acc[2] : 0.f, v3 = (j0 + 3 <= i) ? acc[3] : 0.f;
            u32x2 w; w.x = pk2(v0, v1); w.y = pk2(v2, v3); *(LAS u32x2*)(PL + i * PST + j0) = w; }
    }
    LBAR();
    f32x4 acc[2][4];
#pragma unroll
    for (int mi = 0; mi < 2; ++mi)
#pragma unroll
        for (int nt = 0; nt < 4; ++nt) acc[mi][nt] = (f32x4){0.f, 0.f, 0.f, 0.f};
#pragma unroll
    for (int mi = 0; mi < 2; ++mi) { const int mt = 2 * C.wave + mi;
#pragma unroll
        for (int ks = 0; ks < 2; ++ks) { const bf16x8 a = tr8(VL + (32 * ks + 8 * g + qq) * VST + 16 * mt + 4 * p, VST);
#pragma unroll
            for (int nt = 0; nt < 4; ++nt) { const bf16x8 bp = *(const LAS bf16x8*)(PL + (16 * nt + fr) * PST + 32 * ks + 8 * g); acc[mi][nt] = mfma16(a, bp, acc[mi][nt]); } }
#pragma unroll
        for (int ks = 0; ks < 4; ++ks) { const bf16x8 a = Sf[mi][ks];
#pragma unroll
            for (int nt = 0; nt < 4; ++nt) { const bf16x8 bq = *(const LAS bf16x8*)(QG + (16 * nt + fr) * KST + 32 * ks + 8 * g); acc[mi][nt] = mfma16(a, bq, acc[mi][nt]); } }
    }
#pragma unroll
    for (int nt = 0; nt < 4; ++nt) { float s = 0.f;
#pragma unroll
        for (int mi = 0; mi < 2; ++mi) s += (acc[mi][nt][0] * acc[mi][nt][0] + acc[mi][nt][1] * acc[mi][nt][1]) + (acc[mi][nt][2] * acc[mi][nt][2] + acc[mi][nt][3] * acc[mi][nt][3]);
        s += __shfl_xor(s, 16); s += __shfl_xor(s, 32);
        if (g == 0) RS[C.wave * 64 + 16 * nt + fr] = s; }
    LBAR();
    if (it + 1 < 4 && C.tid < 256) { const int ix = idx + C.G; alv_n = ((const f32x4*)(ALOW + (size_t)((ix >> 8) * SEQ + (ix & 63) * 64) * 16))[C.tid]; }
#pragma unroll
    for (int nt = 0; nt < 4; ++nt) { const int i = 16 * nt + fr; float ts = 0.f;
#pragma unroll
        for (int w = 0; w < 8; ++w) ts += RS[w * 64 + i];
        const float rstd = frsq(ts * (1.f / 256.f) + EPS);
#pragma unroll
        for (int mi = 0; mi < 2; ++mi) { const int e = 16 * (2 * C.wave + mi) + 4 * g;
            const u32x2 rr = rraw[nt][mi]; const f32x4 gg = *(const f32x4*)(ng + e);
            const float o0 = acc[mi][nt][0] * rstd * gg.x * silu_f(bflo(rr.x)), o1 = acc[mi][nt][1] * rstd * gg.y * silu_f(bfhi(rr.x));
            const float o2 = acc[mi][nt][2] * rstd * gg.z * silu_f(bflo(rr.y)), o3 = acc[mi][nt][3] * rstd * gg.w * silu_f(bfhi(rr.y));
            u32x2 w; w.x = pk2(o0, o1); w.y = pk2(o2, o3); *(u32x2*)(CONCAT + (size_t)(t0 + i) * D + h * 256 + e) = w; } }
    LBAR();
    }
}
constexpr int GST = 136;
DI void gmlp_phase(const Ctx& C, int l, const bf16* PROJ, const bf16* WSB, bf16* CONCAT) {
    const int h = C.bid & 7;
    LAS bf16* VL2 = (LAS bf16*)(C.lds); LAS bf16* UL = (LAS bf16*)(C.lds + 34816);
    const float* vg = KARG(I_VNG) + (size_t)(l * 8 + h) * 128; const float* og = KARG(I_MOG) + (size_t)(l * 8 + h) * 128; const float* bb = KARG(I_MB) + (size_t)(l * 8 + h) * 128;
    bf16x8 Wf[4];
    { const bf16* Wrow = WSB + ((size_t)(l * 8 + h) * 128 + 16 * C.wave + (C.lane & 15)) * 128 + 8 * (C.lane >> 4);
#pragma unroll
      for (int ks = 0; ks < 4; ++ks) Wf[ks] = *(const bf16x8*)(Wrow + 32 * ks); }
    u32x4 cu[4], cv[4], nu[4], nv[4];
#define GM_LOAD(IDX, U, V) do { const int t0_ = ((IDX) >> 8) * SEQ + (((IDX) >> 3) & 31) * 128; _Pragma("unroll") for (int i = 0; i < 4; ++i) { const int c = C.tid + 512 * i, t = c >> 4, ch = c & 15; \
        const bf16* row = PROJ + (size_t)(t0_ + t) * NPROJ + h * 128 + 8 * ch; U[i] = *(const u32x4*)(row + C_U); V[i] = *(const u32x4*)(row + C_VS); } } while (0)
    GM_LOAD(C.bid, cu, cv);
#pragma unroll 1
    for (int it = 0; it < 4; ++it) {
    const int idx = it * C.G + C.bid, n = (idx >> 3) & 31, b = idx >> 8, t0 = b * SEQ + n * 128;
#pragma unroll
    for (int i = 0; i < 4; ++i) { const int c = C.tid + 512 * i, t = c >> 4, ch = c & 15;
        const u32x4 uu = cu[i], vv = cv[i];
        float v[8] = {gelu_t(bflo(vv.x)), gelu_t(bfhi(vv.x)), gelu_t(bflo(vv.y)), gelu_t(bfhi(vv.y)), gelu_t(bflo(vv.z)), gelu_t(bfhi(vv.z)), gelu_t(bflo(vv.w)), gelu_t(bfhi(vv.w))};
        float ss = 0.f;
#pragma unroll
        for (int k = 0; k < 8; ++k) ss += v[k] * v[k];
        ss += __shfl_xor(ss, 1); ss += __shfl_xor(ss, 2); ss += __shfl_xor(ss, 4); ss += __shfl_xor(ss, 8);
        const float rstd = frsq(ss * (1.f / 128.f) + EPS);
        const f32x4 g0 = *(const f32x4*)(vg + 8 * ch), g1 = *(const f32x4*)(vg + 8 * ch + 4);
        u32x4 wv; wv.x = pk2(v[0] * rstd * g0.x, v[1] * rstd * g0.y); wv.y = pk2(v[2] * rstd * g0.z, v[3] * rstd * g0.w); wv.z = pk2(v[4] * rstd * g1.x, v[5] * rstd * g1.y); wv.w = pk2(v[6] * rstd * g1.z, v[7] * rstd * g1.w);
        *(LAS u32x4*)(VL2 + t * GST + 8 * ch) = wv;
        u32x4 wu; wu.x = pk2(gelu_t(bflo(uu.x)), gelu_t(bfhi(uu.x))); wu.y = pk2(gelu_t(bflo(uu.y)), gelu_t(bfhi(uu.y))); wu.z = pk2(gelu_t(bflo(uu.z)), gelu_t(bfhi(uu.z))); wu.w = pk2(gelu_t(bflo(uu.w)), gelu_t(bfhi(uu.w)));
        *(LAS u32x4*)(UL + t * GST + 8 * ch) = wu; }
    LBAR();
    if (it + 1 < 4) GM_LOAD(idx + C.G, nu, nv);
    const int lane = C.lane, g = lane >> 4, qq = (lane & 15) >> 2, p = lane & 3, fr = lane & 15;
    f32x4 acc[8];
#pragma unroll
    for (int mt = 0; mt < 8; ++mt) acc[mt] = (f32x4){0.f, 0.f, 0.f, 0.f};
    const int nks = (C.wave >> 1) + 1;
#pragma unroll
    for (int ks = 0; ks < 4; ++ks) if (ks < nks) { const bf16x8 bw = Wf[ks];
#pragma unroll
        for (int mt = 0; mt < 8; ++mt) { const bf16x8 a = tr8(VL2 + (32 * ks + 8 * g + qq) * GST + 16 * mt + 4 * p, GST); acc[mt] = mfma16(a, bw, acc[mt]); } }
    const int tl = 16 * C.wave + fr; const float bt = bb[tl]; float ss = 0.f;
#pragma unroll
    for (int mt = 0; mt < 8; ++mt) { const u32x2 uu = *(const LAS u32x2*)(UL + tl * GST + 16 * mt + 4 * g);
        acc[mt][0] = bflo(uu.x) * (acc[mt][0] + bt); acc[mt][1] = bfhi(uu.x) * (acc[mt][1] + bt); acc[mt][2] = bflo(uu.y) * (acc[mt][2] + bt); acc[mt][3] = bfhi(uu.y) * (acc[mt][3] + bt);
        ss += (acc[mt][0] * acc[mt][0] + acc[mt][1] * acc[mt][1]) + (acc[mt][2] * acc[mt][2] + acc[mt][3] * acc[mt][3]); }
    ss += __shfl_xor(ss, 16); ss += __shfl_xor(ss, 32);
    const float rstd = frsq(ss * (1.f / 128.f) + EPS);
#pragma unroll
    for (int mt = 0; mt < 8; ++mt) { const f32x4 gg = *(const f32x4*)(og + 16 * mt + 4 * g);
        u32x2 w; w.x = pk2(acc[mt][0] * rstd * gg.x, acc[mt][1] * rstd * gg.y); w.y = pk2(acc[mt][2] * rstd * gg.z, acc[mt][3] * rstd * gg.w);
        *(u32x2*)(CONCAT + (size_t)(t0 + tl) * D + 1024 + h * 128 + 16 * mt + 4 * g) = w; }
    LBAR();
#pragma unroll
    for (int i = 0; i < 4; ++i) { cu[i] = nu[i]; cv[i] = nv[i]; }
    }
#undef GM_LOAD
}
DI void list_insert(float (&L)[16], float x) {
#pragma unroll
    for (int i = 15; i >= 1; --i) L[i] = __builtin_amdgcn_fmed3f(x, L[i - 1], L[i]);
    L[0] = fmaxf(L[0], x);
}
DI void list_merge_xor(float (&L)[16], int mask) {
    float M[16];
#pragma unroll
    for (int i = 0; i < 16; ++i) M[i] = fmaxf(L[i], __shfl_xor(L[15 - i], mask));
#pragma unroll
    for (int s = 8; s >= 1; s >>= 1)
#pragma unroll
        for (int i = 0; i < 16; ++i) if ((i & s) == 0) { const float hi = fmaxf(M[i], M[i + s]), lo = fminf(M[i], M[i + s]); M[i] = hi; M[i + s] = lo; }
#pragma unroll
    for (int i = 0; i < 16; ++i) L[i] = M[i];
}
DI unsigned fbits(float x) { return __builtin_bit_cast(unsigned, x); }
DI float unp7(float x) { return __builtin_bit_cast(float, __builtin_bit_cast(unsigned, x) & 0xFFFFFF80u); }
constexpr int TKST = 136;
DI void topk_phase(const Ctx& C, int l, const bf16* QB, const bf16* K1B, const bf16* K2B, const int* KU, const int* KV, int* EB, float* PG) {
    LAS bf16* KL = (LAS bf16*)C.lds;
    LAS unsigned* tk = (LAS unsigned*)(C.lds + 2 * 128 * TKST * 2 + C.wave * 2048);
    const int lane = C.lane, fr = lane & 15, fq = lane >> 4, h = C.bid & 7, rank = C.bid >> 3;
#pragma unroll
    for (int i = 0; i < 8; ++i) { const int c = C.tid + 512 * i, tb = c >> 11, row = (c & 2047) >> 4, ch = c & 15;
        *(LAS u32x4*)(KL + (tb * 128 + row) * TKST + 8 * ch) = *(const u32x4*)((tb ? K2B : K1B) + ((size_t)(l * 8 + h) * 128 + row) * 128 + 8 * ch); }
    __syncthreads();
#pragma unroll 1
    for (int it = 0; it < 4; ++it) {
        const int tt0 = rank * 512 + C.wave * 64 + it * 16;
        float L[2][16];
        bf16x8 bq[2][4];
#pragma unroll
        for (int half = 0; half < 2; ++half)
#pragma unroll
            for (int ks = 0; ks < 4; ++ks) bq[half][ks] = *(const bf16x8*)(QB + (size_t)(tt0 + fr) * D + h * 256 + half * 128 + 8 * fq + 32 * ks);
#pragma unroll
        for (int half = 0; half < 2; ++half) {
            f32x4 acc[8];
#pragma unroll
            for (int mt = 0; mt < 8; ++mt) acc[mt] = (f32x4){0.f, 0.f, 0.f, 0.f};
            const LAS bf16* Kb = KL + (half * 128 + fr) * TKST + 8 * fq;
#pragma unroll
            for (int ks = 0; ks < 4; ++ks)
#pragma unroll
                for (int mt = 0; mt < 8; ++mt) { const bf16x8 a = *(const LAS bf16x8*)(Kb + (16 * mt) * TKST + 32 * ks); acc[mt] = mfma16(a, bq[half][ks], acc[mt]); }
#pragma unroll
            for (int i = 0; i < 16; ++i) L[half][i] = __builtin_bit_cast(float, 0xFF800000u);
#pragma unroll
            for (int mt = 0; mt < 8; ++mt)
#pragma unroll
                for (int r = 0; r < 4; ++r) { const unsigned key = (unsigned)(16 * mt + 4 * fq + r);
                    const float sv = acc[mt][r];
                    list_insert(L[half], __builtin_bit_cast(float, (fbits(sv) & 0xFFFFFF80u) | key)); }
            list_merge_xor(L[half], 16); list_merge_xor(L[half], 32);
        }
        if (fq == 0) {
#pragma unroll
            for (int i = 0; i < 16; ++i) { tk[(fr * 2 + 0) * 16 + i] = fbits(L[0][i]); tk[(fr * 2 + 1) * 16 + i] = fbits(L[1][i]); }
        }
        float Cn[16];
#pragma unroll
        for (int i = 0; i < 16; ++i) Cn[i] = __builtin_bit_cast(float, 0xFF800000u);
#pragma unroll
        for (int i = 0; i < 16; ++i)
#pragma unroll
            for (int j = 0; j < 16; ++j) if ((i + 1) * (j + 1) <= 16) {
                const float s = unp7(L[0][i]) + unp7(L[1][j]);
                list_insert(Cn, __builtin_bit_cast(float, (fbits(s) & 0xFFFFFF00u) | (unsigned)(i * 16 + j))); }
        LDS_WAIT();
        float sc[4]; int ex[4];
#pragma unroll
        for (int m = 0; m < 4; ++m) {
            const float ck = fq == 0 ? Cn[m] : (fq == 1 ? Cn[4 + m] : (fq == 2 ? Cn[8 + m] : Cn[12 + m]));
            const unsigned cc = fbits(ck) & 255u;
            const unsigned p1 = tk[(fr * 2 + 0) * 16 + (cc >> 4)], p2 = tk[(fr * 2 + 1) * 16 + (cc & 15u)];
            sc[m] = __builtin_bit_cast(float, p1 & 0xFFFFFF80u) + __builtin_bit_cast(float, p2 & 0xFFFFFF80u);
            ex[m] = (int)((p1 & 127u) * 128u + (p2 & 127u));
        }
        float mx = fmaxf(fmaxf(sc[0], sc[1]), fmaxf(sc[2], sc[3]));
        mx = fmaxf(mx, __shfl_xor(mx, 16)); mx = fmaxf(mx, __shfl_xor(mx, 32));
        float w[4], sum = 0.f;
#pragma unroll
        for (int m = 0; m < 4; ++m) { w[m] = fexp2((sc[m] - mx) * 1.442695041f); sum += w[m]; }
        sum += __shfl_xor(sum, 16); sum += __shfl_xor(sum, 32);
        const float inv = 1.0f / sum;
        const size_t o = (size_t)(tt0 + fr) * 128 + h * 16 + 4 * fq;
#pragma unroll
        for (int m = 0; m < 4; ++m) { const int kv = KV[ex[m]]; w[m] = w[m] * inv * __builtin_bit_cast(float, (unsigned)(127 - kv) << 23); ex[m] |= 127 << 16; }
        *(int4*)(EB + o) = make_int4(ex[0], ex[1], ex[2], ex[3]);
        *(f32x4*)(PG + o) = (f32x4){w[0], w[1], w[2], w[3]};
        LDS_WAIT();
    }
}
typedef unsigned char fp8_t;
DI void unpack16(const u32x4 q, float (&f)[16]) {
#pragma unroll
    for (int w = 0; w < 4; ++w) { const int dw = (int)q[w]; const f32x2 lo = __builtin_amdgcn_cvt_pk_f32_fp8(dw, false), hi = __builtin_amdgcn_cvt_pk_f32_fp8(dw, true);
        f[4 * w] = lo.x; f[4 * w + 1] = lo.y; f[4 * w + 2] = hi.x; f[4 * w + 3] = hi.y; }
}
DI int sdot4(int a, int b, int c) { return __builtin_amdgcn_sdot4(a, b, c, false); }
template <int CTRL> DI int dppi(int v) { return __builtin_amdgcn_update_dpp(0, v, CTRL, 0xf, 0xf, true); }
template <int CTRL, int NV> DI void bfly(int (&p)[32], const int base, const bool up) {
#pragma unroll
    for (int m = 0; m < NV / 2; ++m) { const int lo = p[base + m], hi = p[base + m + NV / 2]; const int keep = up ? hi : lo, send = up ? lo : hi; p[base + m] = keep + dppi<CTRL>(send); }
}
DI void peerU_phase(const Ctx& C, const unsigned char* H8, const float* HS, const int* EB, const unsigned char* PU8, const float* SU, float* PART, const int emask = 0xFFFF) {
    const int x = C.bid & 7, rank = C.bid >> 3, lane = C.lane, g = lane >> 4, i16 = lane & 15;
    const __amdgpu_buffer_rsrc_t trs = __builtin_amdgcn_make_buffer_rsrc((void*)(PU8 + (size_t)x * NEXP * 256), 0, NEXP * 256, 0x00020000);
    const float* su = SU + (size_t)x * NEXP;
    const int tbase = rank * 512 + C.wave * 64;
    float* part = PART + ((size_t)x * T + tbase) * 128 + lane;
    const int* ebase = EB + (size_t)tbase * 128 + lane;
    const unsigned char* hbase = H8 + (size_t)tbase * 4096 + 256 * x + 16 * i16;
    const float* hsb = HS + tbase;
    const int bp0 = 64 * g, loff = 16 * i16;
    const bool b3 = (i16 & 8) != 0, b2 = (i16 & 4) != 0, b1 = (i16 & 2) != 0, b0 = (i16 & 1) != 0;
    int en0 = ebase[0] & emask, en1 = ebase[64] & emask;
    int er0 = ebase[128], er1 = ebase[192];
    u32x4 hh = *(const u32x4*)hbase, hl = *(const u32x4*)(hbase + 2048);
    float sc0 = su[en0], sc1 = su[en1], hs = hsb[0];
    u32x4 buf[32];
#pragma unroll
    for (int u = 0; u < 32; ++u) { const int e = __builtin_amdgcn_ds_bpermute(bp0 + 4 * (u & 15), u < 16 ? en0 : en1); buf[u] = __builtin_amdgcn_raw_buffer_load_b128(trs, e * 256 + loff, 0, 0); }
    __builtin_amdgcn_sched_barrier(0);
    en0 = er0 & emask; en1 = er1 & emask;
    float pend0 = 0.f, pend1 = 0.f; float* pend_p = part;
#pragma unroll 1
    for (int ti = 0; ti < 64; ++ti) {
        const int tn = ti + 1 < 64 ? ti + 1 : 63, t2 = ti + 2 < 64 ? ti + 2 : 63;
        er0 = ebase[t2 * 128]; er1 = ebase[t2 * 128 + 64];
        const u32x4 hhn = *(const u32x4*)(hbase + (size_t)tn * 4096), hln = *(const u32x4*)(hbase + (size_t)tn * 4096 + 2048);
        const float scn0 = su[en0], scn1 = su[en1], hsn = hsb[tn];
        __builtin_amdgcn_sched_barrier(0);
        int p[32];
#pragma unroll
        for (int u0 = 0; u0 < 32; u0 += 4) {
            int en[4];
#pragma unroll
            for (int u = u0; u < u0 + 4; ++u) en[u - u0] = __builtin_amdgcn_ds_bpermute(bp0 + 4 * (u & 15), u < 16 ? en0 : en1);
#pragma unroll
            for (int u = u0; u < u0 + 4; ++u) {
                const u32x4 r = buf[u];
                int ah = sdot4((int)r.x, (int)hh.x, 0); ah = sdot4((int)r.y, (int)hh.y, ah); ah = sdot4((int)r.z, (int)hh.z, ah); ah = sdot4((int)r.w, (int)hh.w, ah);
                int al = sdot4((int)r.x, (int)hl.x, 0); al = sdot4((int)r.y, (int)hl.y, al); al = sdot4((int)r.z, (int)hl.z, al); al = sdot4((int)r.w, (int)hl.w, al);
                p[u] = (ah << 7) + al; }
            asm volatile("" : "+v"(p[u0]), "+v"(p[u0 + 1]), "+v"(p[u0 + 2]), "+v"(p[u0 + 3]) :: "memory");
#pragma unroll
            for (int u = u0; u < u0 + 4; ++u) buf[u] = __builtin_amdgcn_raw_buffer_load_b128(trs, en[u - u0] * 256 + loff, 0, 0);
            if (u0 == 12) { pend_p[0] = pend0; pend_p[64] = pend1; }
            __builtin_amdgcn_sched_barrier(0);
        }
        bfly<0x140, 16>(p, 0, b3); bfly<0x140, 16>(p, 16, b3);
        bfly<0x141, 8>(p, 0, b2); bfly<0x141, 8>(p, 16, b2);
        bfly<0x4E, 4>(p, 0, b1); bfly<0x4E, 4>(p, 16, b1);
        bfly<0xB1, 2>(p, 0, b0); bfly<0xB1, 2>(p, 16, b0);
        pend0 = (float)p[0] * (sc0 * hs); pend1 = (float)p[16] * (sc1 * hs); pend_p = part + (size_t)ti * 128;
        asm volatile("" : "+v"(er0), "+v"(er1) :: "memory");
        en0 = er0 & emask; en1 = er1 & emask; hh = hhn; hl = hln; sc0 = scn0; sc1 = scn1; hs = hsn;
    }
    pend_p[0] = pend0; pend_p[64] = pend1;
}
DI void peerV_phase(const Ctx& C, const int* EB, const float* PG, const float* PART, const fp8_t* PV8, float* X, const float* gate  , const int emask = 0x3FFF) {
    const int x = C.bid & 7, rank = C.bid >> 3, lane = C.lane, g = lane >> 4, i16 = lane & 15;
    const __amdgpu_buffer_rsrc_t trs = __builtin_amdgcn_make_buffer_rsrc((void*)(PV8 + (size_t)x * NEXP * 256), 0, NEXP * 256, 0x00020000);
    const int tbase = rank * 512 + C.wave * 64;
    ldsp wl = C.lds + C.wave * 5120;
    const int wr_off = (16 * g + i16) * 80, rd_off = (lane >> 2) * 80 + (lane & 3) * 16;
    const int bp0 = 64 * g, loff = 16 * i16;
    const int* ebase = EB + (size_t)tbase * 128 + lane; const float* gbase = PG + (size_t)tbase * 128 + lane; const float* pbase = PART + (size_t)tbase * 128 + lane;
    const int col = 256 * x + 4 * lane;
    const f32x4 gt = *(const f32x4*)(gate + (size_t)(tbase >> 12) * MODW + col);
    float pr0[8], pr1[8], rg0, rg1;
#define PV_LOAD_RAW(tt) do { _Pragma("unroll") for (int xx = 0; xx < 8; ++xx) { const float* pp = pbase + ((size_t)xx * T + (tt)) * 128; pr0[xx] = pp[0]; pr1[xx] = pp[64]; } rg0 = gbase[(tt) * 128]; rg1 = gbase[(tt) * 128 + 64]; } while (0)
#define PV_COEF(A0, A1) do { const float s0_ = ((pr0[0] + pr0[1]) + (pr0[2] + pr0[3])) + ((pr0[4] + pr0[5]) + (pr0[6] + pr0[7])), s1_ = ((pr1[0] + pr1[1]) + (pr1[2] + pr1[3])) + ((pr1[4] + pr1[5]) + (pr1[6] + pr1[7])); \
        A0 = gelu_t(s0_) * rg0; A1 = gelu_t(s1_) * rg1; } while (0)
    const int e0 = ebase[0] & emask, e1 = ebase[64] & emask;
    int er0 = ebase[128], er1 = ebase[192];
    PV_LOAD_RAW(0);
    f32x4* xp0 = (f32x4*)(X + (size_t)tbase * D + col);
    f32x4 xpend = *xp0; f32x4* xpend_p = xp0;
    u32x4 buf[32];
#pragma unroll
    for (int u = 0; u < 32; ++u) { const int e = __builtin_amdgcn_ds_bpermute(bp0 + 4 * (u & 15), u < 16 ? e0 : e1); buf[u] = __builtin_amdgcn_raw_buffer_load_b128(trs, e * 256 + loff, 0, 0); }
    __builtin_amdgcn_sched_barrier(0);
    int pk0, pk1;
    {   float a0, a1; PV_COEF(a0, a1); pk0 = (int)((f2bf(a0) << 16) | (unsigned)(er0 & emask)); pk1 = (int)((f2bf(a1) << 16) | (unsigned)(er1 & emask)); }
#pragma unroll 1
    for (int ti = 0; ti < 64; ++ti) {
        const int tn = ti + 1 < 64 ? ti + 1 : 63, t2 = ti + 2 < 64 ? ti + 2 : 63;
        er0 = ebase[t2 * 128]; er1 = ebase[t2 * 128 + 64];
        PV_LOAD_RAW(tn);
        f32x4* xp = (f32x4*)(X + (size_t)(tbase + ti) * D + col);
        const f32x4 xold = *xp;
        __builtin_amdgcn_sched_barrier(0);
        f32x2 acc[8];
#pragma unroll
        for (int j = 0; j < 8; ++j) acc[j] = (f32x2){0.f, 0.f};
#pragma unroll
        for (int u0 = 0; u0 < 32; u0 += 4) {
            int w[4];
#pragma unroll
            for (int u = u0; u < u0 + 4; ++u) w[u - u0] = __builtin_amdgcn_ds_bpermute(bp0 + 4 * (u & 15), u < 16 ? pk0 : pk1);
#pragma unroll
            for (int u = u0; u < u0 + 4; ++u) {
                const u32x4 r = buf[u]; const float cf = __builtin_bit_cast(float, (unsigned)w[u - u0] & 0xFFFF0000u); const f32x2 c2 = (f32x2){cf, cf};
#pragma unroll
                for (int q = 0; q < 4; ++q) { const int dw = (int)r[q]; const f32x2 lo = __builtin_amdgcn_cvt_pk_f32_fp8(dw, false), hi = __builtin_amdgcn_cvt_pk_f32_fp8(dw, true);
                    acc[2 * q] = __builtin_elementwise_fma(lo, c2, acc[2 * q]); acc[2 * q + 1] = __builtin_elementwise_fma(hi, c2, acc[2 * q + 1]); } }
            asm volatile("" : "+v"(acc[0]), "+v"(acc[1]), "+v"(acc[2]), "+v"(acc[3]), "+v"(acc[4]), "+v"(acc[5]), "+v"(acc[6]), "+v"(acc[7]) :: "memory");
#pragma unroll
            for (int u = u0; u < u0 + 4; ++u) buf[u] = __builtin_amdgcn_raw_buffer_load_b128(trs, ((w[u - u0] & 0x3FFF) << 8) + loff, 0, 0);
            if (u0 == 12) *xpend_p = xpend;
            __builtin_amdgcn_sched_barrier(0);
        }
#pragma unroll
        for (int q = 0; q < 4; ++q) *(LAS f32x4*)(wl + wr_off + 16 * q) = (f32x4){acc[2 * q].x, acc[2 * q].y, acc[2 * q + 1].x, acc[2 * q + 1].y};
        f32x4 y = *(const LAS f32x4*)(wl + rd_off);
#pragma unroll
        for (int gg = 1; gg < 4; ++gg) y += *(const LAS f32x4*)(wl + rd_off + 1280 * gg);
        xpend = xold + gt * y; xpend_p = xp;
        asm volatile("" : "+v"(er0), "+v"(er1) :: "memory");
        {   float a0, a1; PV_COEF(a0, a1); pk0 = (int)((f2bf(a0) << 16) | (unsigned)(er0 & emask)); pk1 = (int)((f2bf(a1) << 16) | (unsigned)(er1 & emask)); }
    }
    *xpend_p = xpend;
#undef PV_LOAD_RAW
#undef PV_COEF
}
DI void final_norm_phase(const Ctx& C, float* X, const float* g) {
    const int r0 = C.gw * 8;
    f32x4 gm[8];
#pragma unroll
    for (int j = 0; j < 8; ++j) gm[j] = ((const f32x4*)g)[64 * j + C.lane];
#pragma unroll 1
    for (int i = 0; i < 8; ++i) {
        f32x4* xr = (f32x4*)(X + (size_t)(r0 + i) * D) + C.lane; f32x4 v[8]; float s = 0.f;
#pragma unroll
        for (int j = 0; j < 8; ++j) { v[j] = xr[64 * j]; s += (v[j].x * v[j].x + v[j].y * v[j].y) + (v[j].z * v[j].z + v[j].w * v[j].w); }
        const float rstd = frsq(wave_sum(s) * (1.f / D) + EPS);
#pragma unroll
        for (int j = 0; j < 8; ++j) xr[64 * j] = v[j] * rstd * gm[j];
    }
}
#ifndef PH_MASK
#define PH_MASK 0xFFFFF
#endif
#define EN(k) (((PH_MASK) >> (k)) & 1)
#ifndef GEMM_SP2
#define GEMM_SP2 true
#endif
#ifndef GEMM_ALIGN
#define GEMM_ALIGN false
#endif
constexpr int NKIND = 11, NPH = 2 + 2 * NKIND;
struct Args { const float* in[21]; float* out; unsigned char* ws; int ph_lo, ph_hi, pad0, pad1; };
__global__ void __launch_bounds__(NTHR, 2) mk_fwd(Args args) {
    extern __shared__ __attribute__((aligned(16))) unsigned char lds_raw[];
    ldsp ldsb = (ldsp)lds_raw;
    volatile LAS unsigned* MISC = (volatile LAS unsigned*)(ldsb + MISC_OFF);
    for (int u = threadIdx.x; u < (LDS_BYTES - LDSCTL_OFF) / 4; u += NTHR) ((LAS unsigned*)(ldsb + LDSCTL_OFF))[u] = 0u;
    __syncthreads();
    unsigned* barw = (unsigned*)(args.ws + WS_CTL) + CW_BAR;
    XcdBarrier bar; bar.bar = barw; bar.x = 0; bar.st = nullptr;
    const bool multi = (args.ph_hi - args.ph_lo) > 1;
    if (multi) bar = xcd_barrier_post(barw, MISC + 8);

#ifdef DBG_REP_MASK
    int repflag = 0;
#endif
#pragma unroll 1
    for (int ph = args.ph_lo; ph < args.ph_hi; ++ph) {
#define MKCTX Ctx C; { int tid_ = threadIdx.x, bid_ = blockIdx.x; asm volatile("" : "+v"(tid_)); asm volatile("" : "+s"(bid_)); \
        C.lds = ldsb; C.tid = tid_; C.lane = tid_ & 63; C.wave = __builtin_amdgcn_readfirstlane(tid_ >> 6); C.bid = bid_; C.G = gridDim.x; C.gw = C.bid * NWAVES + C.wave; C.NGW = C.G * NWAVES; \
        C.ws = args.ws; }
        unsigned char* const wsb = args.ws;
        float* MOD = (float*)(wsb + WS_MOD);
        bf16* Hb = (bf16*)(wsb + WS_H); bf16* PROJ = (bf16*)(wsb + WS_PROJ); bf16* SBUF = (bf16*)(wsb + WS_SBUF); bf16* CONCAT = (bf16*)(wsb + WS_CONCAT); bf16* QB = (bf16*)(wsb + WS_QB);
        float* ALOW = (float*)(wsb + WS_ALOW); float* DEC = (float*)(wsb + WS_DEC); int* EB = (int*)(wsb + WS_EB); float* PG = (float*)(wsb + WS_PG);
        float* X = args.out;
        const int l = ph < 2 ? 0 : (ph - 2) / NKIND, kind = ph < 2 ? -1 : (ph - 2) % NKIND;
        const float* modl = MOD + (size_t)l * 4 * MODW;
        if (ph == 0) { if (EN(0)) { MKCTX; p0_prologue(C); } }
        else if (ph == 1) { if (EN(1)) { MKCTX; norm_phase(C, KARG(I_X), KARG(I_N1G), modl, 0, D, Hb); } }
        else if ((kind == 0 || kind == 6) && EN(2)) {
            MKCTX; const bool isq = (kind == 6);
            pg8::Gemm g{Hb, isq ? (const bf16*)(wsb + WS_WTQ) + (size_t)l * D * D : (const bf16*)(wsb + WS_WTIN) + (size_t)l * WTIN_L, T, isq ? D : NPROJ, D};
            pg8::StaticOrder S; S.init(T, g.N, C.G, C.bid);
            pg8::EpiBf16 E{isq ? QB : PROJ, isq ? D : NPROJ};
            pg8::gemm_phase<pg8::EpiBf16, pg8::StaticOrder, GEMM_ALIGN, GEMM_SP2>(C.lds, g, S, E, C.tid);
            if (!isq) alow_phase(C, Hb, (const bf16*)(wsb + WS_WTIN) + (size_t)l * WTIN_L + (size_t)NPROJ * D, ALOW);
#ifdef DBG_DUP_ALOW
            if (!isq) { alow_phase(C, Hb, (const bf16*)(wsb + WS_WTIN) + (size_t)l * WTIN_L + (size_t)NPROJ * D, ALOW); alow_phase(C, Hb, (const bf16*)(wsb + WS_WTIN) + (size_t)l * WTIN_L + (size_t)NPROJ * D, ALOW); }
#endif
        }
        else if (kind == 1 && EN(3)) {
            MKCTX;
            glaA_phase(C, l, PROJ, ALOW, SBUF, DEC);
            gmlp_phase(C, l, PROJ, (const bf16*)(wsb + WS_WSB), CONCAT);
        }
        else if (kind == 2) { if (EN(4)) { MKCTX; scan_phase(C, SBUF, DEC); } }
        else if (kind == 3 && EN(5)) { MKCTX; glaC_phase(C, l, PROJ, ALOW, SBUF, CONCAT); }
        else if (kind == 4 && EN(6)) {
            MKCTX;
            pg8::Gemm g{CONCAT, (const bf16*)(wsb + WS_WTOUT) + (size_t)l * D * D, T, D, D};
            pg8::StaticOrder S; S.init(T, D, C.G, C.bid);
            pg8::EpiResGate E{l == 0 ? KARG(I_X) : (const float*)X, X, modl + 2 * D, MODW};
            pg8::gemm_phase<pg8::EpiResGate, pg8::StaticOrder, GEMM_ALIGN, GEMM_SP2>(C.lds, g, S, E, C.tid);
        }
        else if (kind == 5) { if (EN(1)) { MKCTX; norm_phase<true>(C, X, KARG(I_N2G) + (size_t)l * D, modl, 3 * D, 4 * D, Hb, wsb + WS_H8, (float*)(wsb + WS_HS)); } }
        else if (kind == 7) { if (EN(7)) { MKCTX; topk_phase(C, l, QB, (const bf16*)(wsb + WS_K1B), (const bf16*)(wsb + WS_K2B), (const int*)(wsb + WS_KU) + l * NEXP, (const int*)(wsb + WS_KV) + l * NEXP, EB, PG); } }
        else if (kind == 8) { if (EN(8)) { MKCTX; peerU_phase(C, wsb + WS_H8, (const float*)(wsb + WS_HS), EB, wsb + WS_PUB + (size_t)l * NEXP * D, (const float*)(wsb + WS_SU) + (size_t)l * 8 * NEXP, (float*)SBUF); } }
        else if (kind == 9) { if (EN(9)) { MKCTX; peerV_phase(C, EB, PG, (const float*)SBUF, (const fp8_t*)(wsb + WS_PVB) + (size_t)l * NEXP * D, X, modl + 5 * D); } }
        else if (EN(10)) {
            MKCTX;
            if (l == DEPTH - 1) final_norm_phase(C, X, KARG(I_FG));
            else norm_phase(C, X, KARG(I_N1G) + (size_t)(l + 1) * D, MOD + (size_t)(l + 1) * 4 * MODW, 0, D, Hb);
        }
        if (ph + 1 < args.ph_hi) xcd_barrier(bar);
#ifdef DBG_EXTRA_BAR
        if (ph + 1 < args.ph_hi) { xcd_barrier(bar); xcd_barrier(bar); }
#endif
#ifdef DBG_REP_MASK
        { const int bit = ph < 2 ? ph : 2 + kind; bool want = ((DBG_REP_MASK) >> bit) & 1;
#ifdef DBG_REP_L0
          if (l != 0) want = false;
#endif
          if (want && !repflag) { repflag = 1; --ph; } else repflag = 0; }
#endif
    }
}

extern "C" void kernel_launch(void* const* d_in, const int* in_sizes, int n_in, void* d_out, int out_size, void* d_ws, size_t ws_size, hipStream_t stream) {
    static int grid = 0;
    if (grid == 0) {
        if (n_in != 21 || out_size != T * D || ws_size < WS_END) { fprintf(stderr, "kernel_launch: unexpected shapes (n_in %d, out %d, ws %zu)\n", n_in, out_size, ws_size); grid = -1; return; }
        int dev = 0, cus = 0, per_cu = 0;
        if (hipGetDevice(&dev) != hipSuccess || hipDeviceGetAttribute(&cus, hipDeviceAttributeMultiprocessorCount, dev) != hipSuccess) { grid = -1; return; }
        if (hipFuncSetAttribute((const void*)mk_fwd, hipFuncAttributeMaxDynamicSharedMemorySize, LDS_BYTES) != hipSuccess) { fprintf(stderr, "kernel_launch: hipFuncSetAttribute failed\n"); grid = -1; return; }
        if (hipOccupancyMaxActiveBlocksPerMultiprocessor(&per_cu, (const void*)mk_fwd, NTHR, LDS_BYTES) != hipSuccess || per_cu < 1) { fprintf(stderr, "kernel_launch: occupancy query says %d blocks per CU\n", per_cu); (void)hipGetLastError(); grid = -1; return; }
        if (cus != 256) { fprintf(stderr, "kernel_launch: built for a 256-CU device (got %d)\n", cus); grid = -1; return; }
        grid = cus;
    }
    if (grid < 0) return;
    (void)hipMemsetAsync((char*)d_ws + WS_CTL, 0, CTL_ZERO_BYTES, stream);
    Args a{};
    for (int i = 0; i < 21; ++i) a.in[i] = (const float*)d_in[i];
    a.out = (float*)d_out; a.ws = (unsigned char*)d_ws;
#if MK_N_LAUNCHES == 1
    a.ph_lo = 0; a.ph_hi = NPH;
    hipLaunchKernelGGL(mk_fwd, dim3(grid), dim3(NTHR), LDS_BYTES, stream, a);
#else
    for (int p = 0; p < NPH; ++p) { a.ph_lo = p; a.ph_hi = p + 1; hipLaunchKernelGGL(mk_fwd, dim3(grid), dim3(NTHR), LDS_BYTES, stream, a); }
#endif
}
```

```cpp
#include <hip/hip_runtime.h>
#include <cstdio>
#include <cstdint>
#ifndef MK_N_LAUNCHES
#define MK_N_LAUNCHES 1
#endif
namespace pg8 {
#define PG8_LAS __attribute__((address_space(3)))
typedef unsigned short bf16_t;
typedef short bf16x8 __attribute__((ext_vector_type(8)));
typedef float f32x4 __attribute__((ext_vector_type(4)));
typedef unsigned u32x4 __attribute__((ext_vector_type(4)));
constexpr int BM = 256, BK = 64, HALF = 128, HTB = HALF * BK * 2  , STAGE_BYTES = 8 * HTB, NXCD = 8, WGM = 8;

__host__ __device__ __forceinline__ int lds_byte(int r, int c) { const int st = (r >> 4) * 2 + (c >> 5), rr = r & 15, cc = c & 31, ob = rr * 64 + cc * 2; return st * 1024 + (ob ^ (((ob >> 9) & 1) << 5)); }
__host__ __device__ __forceinline__ void stage_rc(int b, int& R, int& C) { const int st = b / 1024, sb = b % 1024, swz = sb ^ (((sb >> 9) & 1) << 5); R = (st >> 1) * 16 + swz / 64; C = (st & 1) * 32 + (swz % 64) / 2; }
__host__ __device__ __forceinline__ int perm32(int rho) { const int n = rho >> 4, i = rho & 15; return 8 * (i >> 2) + 4 * n + (i & 3); }

struct Unit { int pm, pn; };
struct Gemm { const bf16_t* A; const bf16_t* Bt; int M, N, K; };

struct StaticOrder {
    int nM, nN, nwg, G, c;
    __host__ __device__ void init(int M, int N, int G_, int c_) { nM = M / BM; nN = N / BM; nwg = nM * nN; G = G_; c = c_; }
    __host__ __device__ bool next(int i, Unit& u) const {
        const long L = (long)i * G + c; if (L >= nwg) return false;
        int wgid = (int)L; { const int q = nwg / NXCD, r = nwg % NXCD, xcd = wgid % NXCD, off = wgid / NXCD; wgid = (xcd < r ? xcd * (q + 1) : r * (q + 1) + (xcd - r) * q) + off; }
        const int nig = WGM * nN, gid = wgid / nig, fm = gid * WGM, gsz = (nM - fm) < WGM ? (nM - fm) : WGM;
        u.pm = fm + ((wgid % nig) % gsz); u.pn = (wgid % nig) / gsz; return true;
    }
    __device__ __forceinline__ void a_ready(const Unit&) const {}
    __device__ __forceinline__ void done(const Unit&) const {}
};
__device__ __forceinline__ unsigned cvt_pk_bf16(float lo, float hi) { unsigned r; asm volatile("v_cvt_pk_bf16_f32 %0, %1, %2" : "=v"(r) : "v"(lo), "v"(hi)); return r; }
struct EpiBf16 {
    static constexpr bool PERM = true, AFTER_DRAIN = false;
    bf16_t* O; int ldc;
    __device__ __forceinline__ void operator()(const f32x4 (&acc)[2][2][4][2], const Unit& u, int wr, int wc, int fr, int fq) const {
        const int row0 = u.pm * BM + wr * 64 + fr; const int col0 = u.pn * BM + wc * 32 + 8 * fq;
#pragma unroll
        for (int ai = 0; ai < 2; ++ai)
#pragma unroll
            for (int m = 0; m < 4; ++m) { bf16_t* rowp = O + (size_t)(row0 + ai * HALF + m * 16) * ldc + col0;
#pragma unroll
                for (int bj = 0; bj < 2; ++bj) { const f32x4 v0 = acc[ai][bj][m][0], v1 = acc[ai][bj][m][1];
                    u32x4 w; w.x = cvt_pk_bf16(v0[0], v0[1]); w.y = cvt_pk_bf16(v0[2], v0[3]); w.z = cvt_pk_bf16(v1[0], v1[1]); w.w = cvt_pk_bf16(v1[2], v1[3]);
                    *(u32x4*)(rowp + bj * HALF) = w; } }
    }
};
struct EpiResGate {
    static constexpr bool PERM = false, AFTER_DRAIN = false;
    const float* base; float* out; const float* gate; int gpitch;
    __device__ __forceinline__ void operator()(const f32x4 (&acc)[2][2][4][2], const Unit& u, int wr, int wc, int fr, int fq) const {
        const int row0 = u.pm * BM + wr * 64 + fr, col0 = u.pn * BM + wc * 32 + 4 * fq;
        const float* gp = gate + (size_t)(u.pm >> 4) * gpitch + col0;
        f32x4 gv[2][2];
#pragma unroll
        for (int bj = 0; bj < 2; ++bj)
#pragma unroll
            for (int n = 0; n < 2; ++n) gv[bj][n] = *(const f32x4*)(gp + bj * HALF + n * 16);
#pragma unroll
        for (int ai = 0; ai < 2; ++ai)
#pragma unroll
            for (int m = 0; m < 4; ++m) { const size_t off = (size_t)(row0 + ai * HALF + m * 16) * 2048 + col0;
#pragma unroll
                for (int bj = 0; bj < 2; ++bj)
#pragma unroll
                    for (int n = 0; n < 2; ++n) { const f32x4 bs = *(const f32x4*)(base + off + bj * HALF + n * 16); *(f32x4*)(out + off + bj * HALF + n * 16) = bs + gv[bj][n] * acc[ai][bj][m][n]; }
                asm volatile("" ::: "memory"); }
    }
};

template <class Epi, class Sched, bool ALIGN_EPI = false, bool SP2 = false>
__device__ __forceinline__ void gemm_phase(PG8_LAS unsigned char* lds, const Gemm g, const Sched& S, const Epi& E, const int tid  ) {
    const int wid = __builtin_amdgcn_readfirstlane(tid >> 6), lane = tid & 63, wr = wid >> 2, wc = wid & 3, fr = lane & 15, fq = lane >> 4;
    const int K = g.K, nt = K / BK;
    unsigned voffA[2], voffB[2];
#pragma unroll
    for (int i = 0; i < 2; ++i) { int R, C; stage_rc(tid * 16 + i * 8192, R, C); const int Rb = Epi::PERM ? ((R & ~31) + perm32(R & 31)) : R;
        voffA[i] = (unsigned)(R * K + C) * 2u; voffB[i] = (unsigned)(Rb * K + C) * 2u; }
    const size_t kstep = (size_t)(BK * 2);
    const size_t hstep = (size_t)HALF * K * 2;
    const size_t tstep = 2 * hstep;
    const unsigned ldsw = (unsigned)wid * 1024u;
    const int aoff = lds_byte(wr * 64 + fr, fq * 8), boff = lds_byte(wc * 32 + fr, fq * 8);
#define PG8_SA(b, h) (((b) * 2 + (h)) * HTB)
#define PG8_SB(b, h) ((4 + (b) * 2 + (h)) * HTB)
#define PG8_STAGE(bufoff, gbase, voff) do { _Pragma("unroll") for (int _i = 0; _i < 2; ++_i) \
        __builtin_amdgcn_global_load_lds((const unsigned*)((const char*)(gbase) + (voff)[_i]), (PG8_LAS unsigned*)(lds + (bufoff) + ldsw + _i * 8192), 16, 0, 0); } while (0)
#define PG8_LDA(dst, b, h) do { _Pragma("unroll") for (int m = 0; m < 4; ++m) _Pragma("unroll") for (int k = 0; k < 2; ++k) dst[m][k] = *(const PG8_LAS bf16x8*)(lds + PG8_SA(b, h) + aoff + m * 2048 + k * 1024); } while (0)
#define PG8_LDB(dst, b, h) do { _Pragma("unroll") for (int n = 0; n < 2; ++n) _Pragma("unroll") for (int k = 0; k < 2; ++k) dst[n][k] = *(const PG8_LAS bf16x8*)(lds + PG8_SB(b, h) + boff + n * 2048 + k * 1024); } while (0)
#define PG8_MMA(ai, bj, At, Bt) do { __builtin_amdgcn_s_setprio(1); _Pragma("unroll") for (int m = 0; m < 4; ++m) _Pragma("unroll") for (int n = 0; n < 2; ++n) _Pragma("unroll") for (int k = 0; k < 2; ++k) \
        acc[ai][bj][m][n] = __builtin_amdgcn_mfma_f32_16x16x32_bf16(Bt[n][k], At[m][k], acc[ai][bj][m][n], 0, 0, 0); __builtin_amdgcn_s_setprio(0); } while (0)
#define PG8_WAIT_V(n) asm volatile("s_waitcnt vmcnt(" #n ")" ::: "memory")
#define PG8_WAIT_L(n) asm volatile("s_waitcnt lgkmcnt(" #n ")" ::: "memory")
#define PG8_BAR __builtin_amdgcn_s_barrier()
#define PG8_SCHED __builtin_amdgcn_sched_barrier(0)
    Unit cur, nxt; int ui = 0;
    if (!S.next(0, cur)) return;
    f32x4 acc[2][2][4][2];
#pragma unroll
    for (int a = 0; a < 2; ++a)
#pragma unroll
        for (int b = 0; b < 2; ++b)
#pragma unroll
            for (int m = 0; m < 4; ++m)
#pragma unroll
                for (int n = 0; n < 2; ++n) acc[a][b][m][n] = (f32x4){0.f, 0.f, 0.f, 0.f};
    bf16x8 At[4][2], B0[2][2], B1[2][2];
    const char* cA = (const char*)g.A + (size_t)cur.pm * tstep; const char* cB = (const char*)g.Bt + (size_t)cur.pn * tstep;
    S.a_ready(cur);
    if constexpr (SP2) {
        PG8_STAGE(PG8_SB(0, 0), cB, voffB); PG8_STAGE(PG8_SB(0, 1), cB + hstep, voffB); PG8_STAGE(PG8_SA(0, 0), cA, voffA); PG8_STAGE(PG8_SA(0, 1), cA + hstep, voffA);
        if (wr == 1) PG8_BAR;
        PG8_WAIT_V(2); PG8_BAR;
        PG8_STAGE(PG8_SB(1, 0), cB + kstep, voffB); PG8_STAGE(PG8_SA(1, 0), cA + kstep, voffA); PG8_STAGE(PG8_SB(1, 1), cB + hstep + kstep, voffB);
        PG8_WAIT_V(6); PG8_BAR;
    } else {
        PG8_STAGE(PG8_SB(0, 0), cB, voffB); PG8_STAGE(PG8_SA(0, 0), cA, voffA); PG8_STAGE(PG8_SB(0, 1), cB + hstep, voffB); PG8_STAGE(PG8_SA(0, 1), cA + hstep, voffA);
        if (wr == 1) PG8_BAR;
        PG8_WAIT_V(4); PG8_BAR;
        PG8_STAGE(PG8_SB(1, 0), cB + kstep, voffB); PG8_STAGE(PG8_SA(1, 0), cA + kstep, voffA); PG8_STAGE(PG8_SB(1, 1), cB + hstep + kstep, voffB);
        PG8_WAIT_V(6); PG8_BAR;
    }
    for (;;) {
        const bool has_next = S.next(ui + 1, nxt);
        const char* nA = has_next ? (const char*)g.A + (size_t)nxt.pm * tstep : cA; const char* nB = has_next ? (const char*)g.Bt + (size_t)nxt.pn * tstep : cB;
        for (int t = 0; t < nt; t += 2) {
            const bool last = (t == nt - 2);
            const char* a1 = cA + (size_t)(t + 1) * kstep;
            const char* a2 = last ? nA : cA + (size_t)(t + 2) * kstep; const char* b2 = last ? nB : cB + (size_t)(t + 2) * kstep;
            const char* a3 = a2 + kstep; const char* b3 = b2 + kstep;
            if (last && has_next) S.a_ready(nxt);
            if constexpr (SP2) {
            PG8_LDB(B0, 0, 0); PG8_LDB(B1, 0, 1); PG8_SCHED; PG8_LDA(At, 0, 0); PG8_STAGE(PG8_SA(1, 1), a1 + hstep, voffA);
            PG8_WAIT_V(8); PG8_WAIT_L(0); PG8_BAR; PG8_MMA(0, 0, At, B0); PG8_MMA(0, 1, At, B1); PG8_BAR; PG8_SCHED;
            PG8_LDA(At, 0, 1); PG8_STAGE(PG8_SB(0, 0), b2, voffB); PG8_STAGE(PG8_SB(0, 1), b2 + hstep, voffB); PG8_STAGE(PG8_SA(0, 0), a2, voffA);
            PG8_WAIT_V(8); PG8_WAIT_L(0); PG8_BAR; PG8_MMA(1, 0, At, B0); PG8_MMA(1, 1, At, B1); PG8_BAR; PG8_SCHED;
            PG8_LDB(B0, 1, 0); PG8_LDB(B1, 1, 1); PG8_SCHED; PG8_LDA(At, 1, 0); PG8_STAGE(PG8_SA(0, 1), a2 + hstep, voffA);
            PG8_WAIT_V(8); PG8_WAIT_L(0); PG8_BAR; PG8_MMA(0, 0, At, B0); PG8_MMA(0, 1, At, B1); PG8_BAR; PG8_SCHED;
            PG8_LDA(At, 1, 1); PG8_STAGE(PG8_SB(1, 0), b3, voffB); PG8_STAGE(PG8_SB(1, 1), b3 + hstep, voffB); PG8_STAGE(PG8_SA(1, 0), a3, voffA);
            PG8_WAIT_V(8); PG8_WAIT_L(0); PG8_BAR; PG8_MMA(1, 0, At, B0); PG8_MMA(1, 1, At, B1); PG8_BAR; PG8_SCHED;
            } else {
            PG8_LDB(B0, 0, 0); PG8_SCHED; PG8_LDA(At, 0, 0); PG8_STAGE(PG8_SA(1, 1), a1 + hstep, voffA);
            PG8_WAIT_L(8); PG8_BAR; PG8_WAIT_L(0); PG8_MMA(0, 0, At, B0); PG8_BAR; PG8_SCHED;
            PG8_LDB(B1, 0, 1); PG8_STAGE(PG8_SB(0, 0), b2, voffB);
            PG8_BAR; PG8_WAIT_L(0); PG8_MMA(0, 1, At, B1); PG8_BAR;
            PG8_LDA(At, 0, 1); PG8_STAGE(PG8_SA(0, 0), a2, voffA);
            PG8_BAR; PG8_WAIT_L(0); PG8_MMA(1, 0, At, B0); PG8_BAR; PG8_SCHED;
            PG8_STAGE(PG8_SB(0, 1), b2 + hstep, voffB);
            PG8_WAIT_V(6); PG8_BAR; PG8_MMA(1, 1, At, B1); PG8_BAR;
            PG8_LDB(B0, 1, 0); PG8_SCHED; PG8_LDA(At, 1, 0); PG8_STAGE(PG8_SA(0, 1), a2 + hstep, voffA);
            PG8_WAIT_L(8); PG8_BAR; PG8_WAIT_L(0); PG8_MMA(0, 0, At, B0); PG8_BAR; PG8_SCHED;
            PG8_LDB(B1, 1, 1); PG8_STAGE(PG8_SB(1, 0), b3, voffB);
            PG8_BAR; PG8_WAIT_L(0); PG8_MMA(0, 1, At, B1); PG8_BAR;
            PG8_LDA(At, 1, 1); PG8_STAGE(PG8_SA(1, 0), a3, voffA);
            PG8_BAR; PG8_WAIT_L(0); PG8_MMA(1, 0, At, B0); PG8_BAR; PG8_SCHED;
            PG8_STAGE(PG8_SB(1, 1), b3 + hstep, voffB);
            PG8_WAIT_V(6); PG8_BAR; PG8_MMA(1, 1, At, B1); PG8_BAR;
            }
        }
        if constexpr (ALIGN_EPI) { if (wr == 0) PG8_BAR; }
        if constexpr (!Epi::AFTER_DRAIN) { E(acc, cur, wr, wc, fr, fq); S.done(cur); }
        if (!has_next) break;
#pragma unroll
        for (int a = 0; a < 2; ++a)
#pragma unroll
            for (int b = 0; b < 2; ++b)
#pragma unroll
                for (int m = 0; m < 4; ++m)
#pragma unroll
                    for (int n = 0; n < 2; ++n) acc[a][b][m][n] = (f32x4){0.f, 0.f, 0.f, 0.f};
        cur = nxt; cA = nA; cB = nB; ++ui;
        if constexpr (ALIGN_EPI) { if (wr == 1) PG8_BAR; }
    }
    PG8_WAIT_V(0);
    if constexpr (!ALIGN_EPI) { if (wr == 0) PG8_BAR; }
    PG8_BAR;
    if constexpr (Epi::AFTER_DRAIN) { E.fused(acc, cur, wr, wc, fr, fq, lds, wid, lane); S.done(cur); }
#undef PG8_SA
#undef PG8_SB
#undef PG8_STAGE
#undef PG8_LDA
#undef PG8_LDB
#undef PG8_MMA
#undef PG8_WAIT_V
#undef PG8_WAIT_L
#undef PG8_BAR
#undef PG8_SCHED
}
}
constexpr int NWAVES = 8, NTHR = 512;
constexpr int D = 2048, NBATCH = 4, SEQ = 4096, T = NBATCH * SEQ, DEPTH = 2;
constexpr int GLA_H = 4, GLA_DK = 128, GLA_DV = 256, GLA_CH = 64;
constexpr int MLP_H = 8, MLP_DH = 128, MLP_CH = 128;
constexpr int IN_COLS = 5136, NPROJ = 5120;
constexpr int C_Q = 0, C_K = 512, C_V = 1024, C_R = 2048, C_U = 3072, C_VS = 4096;
constexpr int NEXP = 16384, PEER_H = 8;
constexpr float EPS = 1e-6f;
constexpr int MODW = 6 * D;
constexpr size_t MiB = 1u << 20;
constexpr size_t WS_CTL = 0, CTL_ZERO_BYTES = 1 * MiB;
constexpr size_t WS_MOD = 1 * MiB;
constexpr size_t WS_K1B = 2 * MiB, WS_K2B = 2 * MiB + 512 * 1024, WS_WSB = 3 * MiB, WS_DEC = 3 * MiB + 512 * 1024, WS_ALOW = 4 * MiB;
constexpr size_t WS_KU = 5 * MiB, WS_KV = 5 * MiB + 256 * 1024;
constexpr size_t WS_SU = 6 * MiB, WS_HS = 7 * MiB;
constexpr size_t WS_WTIN = 8 * MiB;
constexpr size_t WTIN_L = (size_t)5136 * 2048;
constexpr size_t WS_WTOUT = 49 * MiB, WS_WTQ = 65 * MiB;
constexpr size_t WS_PUB = 81 * MiB, WS_PVB = 209 * MiB;
constexpr size_t WS_H = 337 * MiB;
constexpr size_t WS_PROJ = 401 * MiB;
constexpr size_t WS_SBUF = 561 * MiB;
constexpr size_t WS_CONCAT = 625 * MiB;
constexpr size_t WS_QB = 689 * MiB;
constexpr size_t WS_EB = 753 * MiB, WS_PG = 761 * MiB;
constexpr size_t WS_H8 = 769 * MiB, WS_COEF = 833 * MiB, WS_END = 841 * MiB;
static_assert(WS_WTIN + 2 * WTIN_L * 2 <= WS_WTOUT, "ws map");
constexpr int CW_BAR = 4096;
constexpr int RING_BYTES = 131072, LDSCTL_OFF = RING_BYTES, MISC_OFF = LDSCTL_OFF + 320, LDS_BYTES = 147456;

#define DI __device__ __forceinline__
#define LAS __attribute__((address_space(3)))
typedef unsigned short bf16;
typedef short bf16x8 __attribute__((ext_vector_type(8)));
typedef short s16x4 __attribute__((ext_vector_type(4)));
typedef short v4i16_t __attribute__((ext_vector_type(4)));
typedef __bf16 bf16x2_t __attribute__((ext_vector_type(2)));
typedef float f32x4 __attribute__((ext_vector_type(4)));
typedef float f32x2 __attribute__((ext_vector_type(2)));
typedef unsigned u32x4 __attribute__((ext_vector_type(4)));
typedef unsigned u32x2 __attribute__((ext_vector_type(2)));
typedef LAS unsigned char* ldsp;

DI unsigned f2bf(float f) { unsigned u = __builtin_bit_cast(unsigned, f); return (u + 0x7fffu + ((u >> 16) & 1u)) >> 16; }
DI unsigned pk2(float lo, float hi) { return f2bf(lo) | (f2bf(hi) << 16); }
DI float bflo(unsigned u) { return __builtin_bit_cast(float, u << 16); }
DI float bfhi(unsigned u) { return __builtin_bit_cast(float, u & 0xffff0000u); }
DI float bf1(bf16 v) { return __builtin_bit_cast(float, ((unsigned)v) << 16); }
DI float fexp2(float x) { return __builtin_amdgcn_exp2f(x); }
DI float flog2(float x) { return __builtin_amdgcn_logf(x); }
DI float frcp(float x) { return __builtin_amdgcn_rcpf(x); }
DI float frsq(float x) { return __builtin_amdgcn_rsqf(x); }
DI float gelu_t(float x) { const float u = 0.7978845608f * (x + 0.044715f * x * x * x); return x * frcp(1.f + fexp2(-2.885390082f * u)); }
DI float silu_f(float x) { return x * frcp(1.f + fexp2(-1.442695041f * x)); }
template <int CTRL> DI float dppf(float v) { return __builtin_bit_cast(float, __builtin_amdgcn_update_dpp(0, __builtin_bit_cast(int, v), CTRL, 0xf, 0xf, true)); }
DI float wave_sum_u(float v) {
    v += dppf<0xB1>(v); v += dppf<0x4E>(v); v += dppf<0x141>(v); v += dppf<0x140>(v);
    const int iv = __builtin_bit_cast(int, v);
    return (__builtin_bit_cast(float, __builtin_amdgcn_readlane(iv, 0)) + __builtin_bit_cast(float, __builtin_amdgcn_readlane(iv, 16))) +
           (__builtin_bit_cast(float, __builtin_amdgcn_readlane(iv, 32)) + __builtin_bit_cast(float, __builtin_amdgcn_readlane(iv, 48)));
}
DI float wave_sum(float v) {
#pragma unroll
    for (int o = 1; o < 64; o <<= 1) v += __shfl_xor(v, o);
    return v;
}
DI float dot2bf(unsigned a, unsigned b, float c) { return __builtin_amdgcn_fdot2_f32_bf16(__builtin_bit_cast(bf16x2_t, a), __builtin_bit_cast(bf16x2_t, b), c, false); }
DI f32x4 mfma16(bf16x8 a, bf16x8 b, f32x4 c) { return __builtin_amdgcn_mfma_f32_16x16x32_bf16(a, b, c, 0, 0, 0); }
DI s16x4 tr4(const LAS bf16* p) { return __builtin_bit_cast(s16x4, __builtin_amdgcn_ds_read_tr16_b64_v4i16((LAS v4i16_t*)p)); }
DI bf16x8 tr8(const LAS bf16* p, int stride) { const s16x4 a = tr4(p), b = tr4(p + 4 * stride); return (bf16x8){a[0], a[1], a[2], a[3], b[0], b[1], b[2], b[3]}; }

#define XB_TMO      128
#define XB_XCNT(j)  (256  + 64 * (j))
#define XB_XSUB(j)  (1280 + 64 * (j))
#define XB_XGEN(j)  (2304 + 64 * (j))
#define XB_TOP      3328
#define XB_TOPGEN   3392
#define XCD_BAR_WORDS 3456
#define XB_SPIN_CAP (1u << 18)

__device__ __forceinline__ unsigned xb_ld(unsigned* p)              { return __hip_atomic_load(p, __ATOMIC_RELAXED, __HIP_MEMORY_SCOPE_AGENT); }
__device__ __forceinline__ unsigned xb_add(unsigned* p, unsigned v) { return __hip_atomic_fetch_add(p, v, __ATOMIC_RELAXED, __HIP_MEMORY_SCOPE_AGENT); }
__device__ __forceinline__ unsigned xb_xcc_id() { return (unsigned)__builtin_amdgcn_s_getreg((3 << 11) | 20) & 0xFu; }
#define XB_SPIN(cond, bar) do { unsigned _sp = 0; while (cond) { __builtin_amdgcn_s_sleep(1); \
    if ((++_sp & 255u) == 0u) { if (xb_ld(&(bar)[XB_TMO])) break; if (_sp > XB_SPIN_CAP) { atomicAdd(&(bar)[XB_TMO], 1u); break; } } } } while (0)

struct XcdBarrier {
    unsigned* bar; unsigned x;
    volatile LAS unsigned* st;
};

__device__ __forceinline__ XcdBarrier xcd_barrier_post(unsigned* bar, volatile LAS unsigned* st) {
    XcdBarrier b; b.bar = bar; b.x = xb_xcc_id(); b.st = st;
    if (threadIdx.x == 0) (void)xb_add(&bar[XB_XCNT(b.x)], 1u);
    return b;
}
__device__ __forceinline__ void xcd_barrier_complete(unsigned* bar, unsigned x, unsigned& nloc, unsigned& nx) {
    const unsigned G = gridDim.x * gridDim.y * gridDim.z;
    unsigned sum, cnt, mine, sp = 0u;
    for (;;) {
        sum = 0u; cnt = 0u; mine = 0u;
#pragma unroll
        for (unsigned j = 0; j < 16; ++j) { const unsigned c = xb_ld(&bar[XB_XCNT(j)]); sum += c; cnt += (c > 0u) ? 1u : 0u; mine = (j == x) ? c : mine; }
        if (sum == G) break;
        __builtin_amdgcn_s_sleep(1);
        if ((++sp & 255u) == 0u) { if (xb_ld(&bar[XB_TMO])) break; if (sp > XB_SPIN_CAP) { atomicAdd(&bar[XB_TMO], 1u); break; } }
    }
    nloc = mine > 0u ? mine : 1u; nx = cnt > 0u ? cnt : 1u;
}

__device__ __forceinline__ void xcd_barrier(const XcdBarrier& b) {
    asm volatile("s_waitcnt vmcnt(0)" ::: "memory");
    __syncthreads();
    if (threadIdx.x == 0) {
        unsigned* bar = b.bar;
        __builtin_amdgcn_s_waitcnt(0);
        unsigned nloc = b.st[0], nx = b.st[1];
        if (nloc == 0u) { xcd_barrier_complete(bar, b.x, nloc, nx); b.st[0] = nloc; b.st[1] = nx; }
        const unsigned old = xb_add(&bar[XB_XSUB(b.x)], 1u);
        const unsigned gen = old / nloc;
        if (old + 1u == (gen + 1u) * nloc) {
            __builtin_amdgcn_fence(__ATOMIC_RELEASE, "agent");
            asm volatile("s_waitcnt vmcnt(0)" ::: "memory");
            const unsigned og = xb_add(&bar[XB_TOP], 1u);
            const unsigned tg = og / nx;
            if (og + 1u == (tg + 1u) * nx) xb_add(&bar[XB_TOPGEN], 1u);
            else XB_SPIN(xb_ld(&bar[XB_TOPGEN]) == tg, bar);
            __builtin_amdgcn_fence(__ATOMIC_ACQUIRE, "agent");
            xb_add(&bar[XB_XGEN(b.x)], 1u);
            asm volatile("s_waitcnt vmcnt(0)" ::: "memory");
        } else {
            XB_SPIN(xb_ld(&bar[XB_XGEN(b.x)]) == gen, bar);
            __builtin_amdgcn_fence(__ATOMIC_ACQUIRE, "agent");
            asm volatile("s_waitcnt vmcnt(0)" ::: "memory");
        }
    }
    __syncthreads();
}
struct Ctx {
    ldsp lds; int tid, lane, wave, bid, G, gw, NGW;
    unsigned char* ws;
};
DI const float* KARG(int k) { asm volatile("" : "+s"(k)); return ((const float* const*)__builtin_amdgcn_kernarg_segment_ptr())[k]; }
#define LDS_WAIT() asm volatile("s_waitcnt lgkmcnt(0)" ::: "memory")
enum { I_X = 0, I_C, I_ADAW, I_ADAB, I_N1G, I_WIN, I_WA2, I_BA, I_GNG, I_VNG, I_MWS, I_MB, I_MOG, I_WOUT, I_N2G, I_WQ, I_K1, I_K2, I_PU, I_PV, I_FG };

DI void p0_ada(const Ctx& C) {
    LAS float* red = (LAS float*)C.lds;
    float* MOD = (float*)(C.ws + WS_MOD);
    for (int it = C.bid; it < 192; it += C.G) {
        const int l = it / 96, cg = it % 96, c0 = cg * 128 + C.lane * 2;
        const float* W = KARG(I_ADAW) + (size_t)l * D * MODW + (size_t)(C.wave * 256) * MODW + c0;
        float cv[4][4];
#pragma unroll
        for (int b = 0; b < 4; ++b)
#pragma unroll
            for (int i = 0; i < 4; ++i) cv[b][i] = silu_f(KARG(I_C)[b * D + C.wave * 256 + i * 64 + C.lane]);
        float acc[4][2];
#pragma unroll
        for (int b = 0; b < 4; ++b) { acc[b][0] = 0.f; acc[b][1] = 0.f; }
#pragma unroll
        for (int i = 0; i < 4; ++i) {
#pragma unroll 16
            for (int j = 0; j < 64; ++j) {
                const f32x2 w = *(const f32x2*)(W + (size_t)(i * 64 + j) * MODW);
#pragma unroll
                for (int b = 0; b < 4; ++b) { const float s = __builtin_bit_cast(float, __builtin_amdgcn_readlane(__builtin_bit_cast(int, cv[b][i]), j)); acc[b][0] += s * w.x; acc[b][1] += s * w.y; }
            }
        }
#pragma unroll
        for (int b = 0; b < 4; ++b) *(LAS f32x2*)(red + (C.wave * 4 + b) * 128 + C.lane * 2) = (f32x2){acc[b][0], acc[b][1]};
        __syncthreads();
        { const int b = C.tid >> 7, col = C.tid & 127; float s = KARG(I_ADAB)[l * MODW + cg * 128 + col];
#pragma unroll
          for (int w = 0; w < 8; ++w) s += red[(w * 4 + b) * 128 + col];
          MOD[(size_t)(l * 4 + b) * MODW + cg * 128 + col] = s; }
        __syncthreads();
    }
}
DI void transpose_item(const float* W, int ldw, int src_col0, int ncols, bf16* WT, int dst_row0, int k0, LAS float* scr, int lane) {
    const int cl = lane & 31;
    float v[32];
#pragma unroll
    for (int i = 0; i < 32; ++i) { const int kk = 2 * i + (lane >> 5); v[i] = 0.f; if (cl < ncols) v[i] = W[(size_t)(k0 + kk) * ldw + src_col0 + cl]; }
#pragma unroll
    for (int i = 0; i < 32; ++i) { const int kk = 2 * i + (lane >> 5); scr[kk * 33 + cl] = v[i]; }
    LDS_WAIT();
    const int c = lane & 7;
#pragma unroll
    for (int j = 0; j < 4; ++j) { const int n = (lane >> 3) + 8 * j;
        if (n < ncols) { const LAS float* s = scr + (8 * c) * 33 + n;
            u32x4 o; o.x = pk2(s[0 * 33], s[1 * 33]); o.y = pk2(s[2 * 33], s[3 * 33]); o.z = pk2(s[4 * 33], s[5 * 33]); o.w = pk2(s[6 * 33], s[7 * 33]);
            *(u32x4*)(WT + (size_t)(dst_row0 + n) * 2048 + k0 + 8 * c) = o; } }
    LDS_WAIT();
}
DI void p0_prologue(const Ctx& C) {
    p0_ada(C);
    LAS float* scr = (LAS float*)(C.lds + C.wave * 16384);
    constexpr int PER_L = (161 + 64 + 64) * 32;
    for (int it = C.gw; it < 2 * PER_L; it += C.NGW) {
        const int l = it / PER_L; int r = it % PER_L;
        if (r < 161 * 32) { const int kb = r / 161, nb = r % 161; bf16* WT = (bf16*)(C.ws + WS_WTIN) + (size_t)l * WTIN_L;
            const float* W = KARG(I_WIN) + (size_t)l * D * IN_COLS;
            if (nb < 160) { const int n0 = 32 * nb; transpose_item(W, IN_COLS, n0 + (n0 >= 3072 ? 16 : 0), 32, WT, n0, 64 * kb, scr, C.lane); }
            else transpose_item(W, IN_COLS, 3072, 16, WT, 5120, 64 * kb, scr, C.lane);
            continue; }
        r -= 161 * 32;
        if (r < 2048) { const int kb = r / 64, nb = r % 64; transpose_item(KARG(I_WOUT) + (size_t)l * D * D, D, 32 * nb, 32, (bf16*)(C.ws + WS_WTOUT) + (size_t)l * D * D, 32 * nb, 64 * kb, scr, C.lane); continue; }
        r -= 2048;
        { const int kb = r / 64, nb = r % 64; transpose_item(KARG(I_WQ) + (size_t)l * D * D, D, 32 * nb, 32, (bf16*)(C.ws + WS_WTQ) + (size_t)l * D * D, 32 * nb, 64 * kb, scr, C.lane); }
    }
    const int gt = C.bid * NTHR + C.tid, NT = C.G * NTHR;
    { bf16* K1B = (bf16*)(C.ws + WS_K1B); bf16* K2B = (bf16*)(C.ws + WS_K2B); bf16* WSB = (bf16*)(C.ws + WS_WSB);
      for (int i = gt; i < 262144; i += NT) { K1B[i] = (bf16)f2bf(KARG(I_K1)[i]); K2B[i] = (bf16)f2bf(KARG(I_K2)[i]);
          const int s = i & 127, t = (i >> 7) & 127; WSB[i] = (s <= t) ? (bf16)f2bf(KARG(I_MWS)[i]) : (bf16)0; } }
    { float* SU = (float*)(C.ws + WS_SU); int* KV = (int*)(C.ws + WS_KV);
#pragma unroll 1
      for (int row = C.gw; row < 4 * NEXP; row += C.NGW) {
          const int tb = row >> 15, rr = row & 32767;
          const f32x4* src = (const f32x4*)(KARG(tb ? I_PV : I_PU) + (size_t)rr * D) + C.lane;
          f32x4 v[8];
#pragma unroll
          for (int j = 0; j < 8; ++j) v[j] = src[64 * j];
          const int lyr = rr >> 14, ee = rr & 16383;
          unsigned* dst = (unsigned*)(C.ws + (tb ? WS_PVB : WS_PUB) + (size_t)lyr * NEXP * D + (size_t)ee * 256) + C.lane;
          if (tb) {
              float mx = 0.f;
#pragma unroll
              for (int j = 0; j < 8; ++j) mx = fmaxf(mx, fmaxf(fmaxf(fabsf(v[j].x), fabsf(v[j].y)), fmaxf(fabsf(v[j].z), fabsf(v[j].w))));
#pragma unroll
              for (int o = 1; o < 64; o <<= 1) mx = fmaxf(mx, __shfl_xor(mx, o));
              int k = 0;
              if (mx > 0.f) { k = (int)((__builtin_bit_cast(unsigned, 224.0f / mx) >> 23) & 255u) - 127; k = k < -60 ? -60 : (k > 60 ? 60 : k); }
              const float sc = __builtin_bit_cast(float, (unsigned)(k + 127) << 23);
#pragma unroll
              for (int j = 0; j < 8; ++j) { int p = 0; p = __builtin_amdgcn_cvt_pk_fp8_f32(v[j].x * sc, v[j].y * sc, p, false); p = __builtin_amdgcn_cvt_pk_fp8_f32(v[j].z * sc, v[j].w * sc, p, true); dst[(size_t)j * (NEXP * 256 / 4)] = (unsigned)p; }
              if (C.lane == 0) KV[rr] = k;
          } else {
#pragma unroll
              for (int j = 0; j < 8; ++j) {
                  float mx = fmaxf(fmaxf(fabsf(v[j].x), fabsf(v[j].y)), fmaxf(fabsf(v[j].z), fabsf(v[j].w)));
#pragma unroll
                  for (int o = 1; o < 64; o <<= 1) mx = fmaxf(mx, __shfl_xor(mx, o));
                  const float inv = mx > 0.f ? 127.0f / mx : 0.f;
                  const int q0 = (int)__builtin_rintf(v[j].x * inv), q1 = (int)__builtin_rintf(v[j].y * inv), q2 = (int)__builtin_rintf(v[j].z * inv), q3 = (int)__builtin_rintf(v[j].w * inv);
                  dst[(size_t)j * (NEXP * 256 / 4)] = (unsigned)(q0 & 255) | ((unsigned)(q1 & 255) << 8) | ((unsigned)(q2 & 255) << 16) | ((unsigned)q3 << 24);
                  if (C.lane == 0) SU[(size_t)(lyr * 8 + j) * NEXP + ee] = mx * (1.0f / 127.0f);
              }
          }
      } }
}
template <bool FP8 = false>
DI void norm_phase(const Ctx& C, const float* X, const float* g, const float* modl, int sh_off, int sc_off, bf16* Hout, unsigned char* H8 = nullptr, float* HS = nullptr, int* COEF = nullptr) {
    const int r0 = C.gw * 8, b = r0 >> 12;
    if (FP8) {
        u32x4* cz = (u32x4*)(COEF + (size_t)r0 * 128) + C.lane;
#pragma unroll
        for (int j = 0; j < 4; ++j) cz[64 * j] = (u32x4){0u, 0u, 0u, 0u}; }
    const f32x4* shp = (const f32x4*)(modl + (size_t)b * MODW + sh_off); const f32x4* scp = (const f32x4*)(modl + (size_t)b * MODW + sc_off);
    f32x4 gm[8], shv[8];
#pragma unroll
    for (int j = 0; j < 8; ++j) { const int idx = 64 * j + C.lane; gm[j] = ((const f32x4*)g)[idx] * (scp[idx] + 1.0f); shv[j] = shp[idx]; }
#pragma unroll 1
    for (int i = 0; i < 8; ++i) {
        const f32x4* xr = (const f32x4*)(X + (size_t)(r0 + i) * D) + C.lane; f32x4 v[8]; float s = 0.f;
#pragma unroll
        for (int j = 0; j < 8; ++j) { v[j] = xr[64 * j]; s += (v[j].x * v[j].x + v[j].y * v[j].y) + (v[j].z * v[j].z + v[j].w * v[j].w); }
        const float rstd = frsq(wave_sum(s) * (1.f / D) + EPS);
        u32x2* o = (u32x2*)(Hout + (size_t)(r0 + i) * D) + C.lane;
        float am = 0.f;
#pragma unroll
        for (int j = 0; j < 8; ++j) { const f32x4 y = v[j] * rstd * gm[j] + shv[j]; u32x2 w; w.x = pk2(y.x, y.y); w.y = pk2(y.z, y.w); o[64 * j] = w;
            if (FP8) { v[j] = y; am = fmaxf(am, fmaxf(fmaxf(fabsf(y.x), fabsf(y.y)), fmaxf(fabsf(y.z), fabsf(y.w)))); } }
        if (FP8) {
#pragma unroll
            for (int of = 1; of < 64; of <<= 1) am = fmaxf(am, __shfl_xor(am, of));
            const float qs = am > 0.f ? 16256.0f / am : 0.f;
            if (C.lane == 0) HS[r0 + i] = am * (1.0f / 16256.0f);
            unsigned* h8 = (unsigned*)(H8 + (size_t)(r0 + i) * 4096) + C.lane;
#pragma unroll
            for (int j = 0; j < 8; ++j) {
                const int q0 = (int)__builtin_rintf(v[j].x * qs), q1 = (int)__builtin_rintf(v[j].y * qs), q2 = (int)__builtin_rintf(v[j].z * qs), q3 = (int)__builtin_rintf(v[j].w * qs);
                const int h0 = (q0 + 64) >> 7, h1 = (q1 + 64) >> 7, h2 = (q2 + 64) >> 7, h3 = (q3 + 64) >> 7;
                const int l0 = q0 - (h0 << 7), l1 = q1 - (h1 << 7), l2 = q2 - (h2 << 7), l3 = q3 - (h3 << 7);
                h8[64 * j] = (unsigned)(h0 & 255) | ((unsigned)(h1 & 255) << 8) | ((unsigned)(h2 & 255) << 16) | ((unsigned)h3 << 24);
                h8[512 + 64 * j] = (unsigned)(l0 & 255) | ((unsigned)(l1 & 255) << 8) | ((unsigned)(l2 & 255) << 16) | ((unsigned)l3 << 24); }
        }
    }
}
DI void alow_phase(const Ctx& C, const bf16* Hb, const bf16* WtA, float* ALOW) {
    const int task = C.bid * 4 + (C.wave & 3), kh = C.wave >> 2, r0 = task * 16, fr = C.lane & 15, fq = C.lane >> 4;
    const bf16* ap = Hb + (size_t)(r0 + fr) * D + 8 * fq + 1024 * kh; const bf16* bp = WtA + (size_t)fr * D + 8 * fq + 1024 * kh;
    f32x4 acc = (f32x4){0.f, 0.f, 0.f, 0.f};
#pragma unroll 8
    for (int ks = 0; ks < 32; ++ks) { const bf16x8 a = *(const bf16x8*)(ap + 32 * ks), b = *(const bf16x8*)(bp + 32 * ks); acc = mfma16(a, b, acc); }
    LAS f32x4* xch = (LAS f32x4*)C.lds + (C.wave & 3) * 64 + C.lane;
    if (kh) *xch = acc;
    LDS_WAIT(); __builtin_amdgcn_s_barrier(); asm volatile("" ::: "memory");
    if (!kh) { acc += *xch;
#pragma unroll
        for (int r = 0; r < 4; ++r) ALOW[(size_t)(r0 + 4 * fq + r) * 16 + fr] = acc[r]; }
}
#define LBAR() do { asm volatile("s_waitcnt lgkmcnt(0)" ::: "memory"); __builtin_amdgcn_s_barrier(); asm volatile("" ::: "memory"); } while (0)
DI void gla_gates(const Ctx& C, LAS float* al, LAS float* tot, const f32x4 alv, const float (&w2)[16], const float bav, float (&Gl)[16], float& off, float& gref, float& g63) {
    const int d = C.tid & 127, jg = C.tid >> 7;
    if (C.tid < 256) ((LAS f32x4*)al)[C.tid] = alv;
    LBAR();
    float run = 0.f;
#pragma unroll
    for (int jj = 0; jj < 16; ++jj) {
        const LAS f32x4* ar = (const LAS f32x4*)(al + (jg * 16 + jj) * 16);
        const f32x4 a0 = ar[0], a1 = ar[1], a2 = ar[2], a3 = ar[3];
        float z = bav;
        z += a0.x * w2[0] + a0.y * w2[1] + a0.z * w2[2] + a0.w * w2[3];
        z += a1.x * w2[4] + a1.y * w2[5] + a1.z * w2[6] + a1.w * w2[7];
        z += a2.x * w2[8] + a2.y * w2[9] + a2.z * w2[10] + a2.w * w2[11];
        z += a3.x * w2[12] + a3.y * w2[13] + a3.z * w2[14] + a3.w * w2[15];
        const float ls = fminf(z, 0.f) - 0.6931471806f * flog2(1.f + fexp2(-1.442695041f * fabsf(z)));
        run += ls * (1.442695041f / 16.f);
        Gl[jj] = run;
    }
    tot[jg * 128 + d] = run;
    LBAR();
    const float t0_ = tot[d], t1_ = tot[128 + d], t2_ = tot[256 + d], t3_ = tot[384 + d];
    off = (jg > 0 ? t0_ : 0.f) + (jg > 1 ? t1_ : 0.f) + (jg > 2 ? t2_ : 0.f); gref = t0_ + t1_; g63 = (t0_ + t1_) + (t2_ + t3_);
}
constexpr int KST = 136, VST = 264, PST = 72;
struct GlaIn { f32x4 alv; bf16 qraw[16], kraw[16]; u32x4 vt[4]; };
template <bool WITHQ>
DI void gla_load(const Ctx& C, int idx, const bf16* PROJ, const float* ALOW, GlaIn& in) {
    const int b = idx >> 8, h = (idx >> 6) & 3, n = idx & 63, t0 = b * SEQ + n * 64, d = C.tid & 127, jg = C.tid >> 7;
    in.alv = (f32x4){0.f, 0.f, 0.f, 0.f};
    if (C.tid < 256) in.alv = ((const f32x4*)(ALOW + (size_t)t0 * 16))[C.tid];
#pragma unroll
    for (int jj = 0; jj < 16; ++jj) { const bf16* row = PROJ + (size_t)(t0 + jg * 16 + jj) * NPROJ + h * 128 + d; in.kraw[jj] = row[C_K]; if (WITHQ) in.qraw[jj] = row[C_Q]; }
#pragma unroll
    for (int i = 0; i < 4; ++i) { const int c = C.tid + 512 * i, j = c >> 5, ec = c & 31; in.vt[i] = *(const u32x4*)(PROJ + (size_t)(t0 + j) * NPROJ + C_V + h * 256 + 8 * ec); }
}
DI void store_v_tile(const Ctx& C, const GlaIn& in, LAS bf16* VL) {
#pragma unroll
    for (int i = 0; i < 4; ++i) { const int c = C.tid + 512 * i, j = c >> 5, ec = c & 31; *(LAS u32x4*)(VL + j * VST + 8 * ec) = in.vt[i]; }
}
DI void glaA_phase(const Ctx& C, int l, const bf16* PROJ, const float* ALOW, bf16* SBUF, float* DEC) {
    LAS float* al = (LAS float*)(C.lds); LAS float* tot = (LAS float*)(C.lds + 4096);
    LAS bf16* KD = (LAS bf16*)(C.lds + 8192); LAS bf16* VL = (LAS bf16*)(C.lds + 25600);
    const int d = C.tid & 127, jg = C.tid >> 7, h = (C.bid >> 6) & 3;
    float w2[16];
#pragma unroll
    for (int r = 0; r < 16; ++r) w2[r] = KARG(I_WA2)[(size_t)l * 16 * 512 + r * 512 + h * 128 + d];
    const float bav = KARG(I_BA)[(size_t)l * 512 + h * 128 + d];
    GlaIn cur, nxt;
    gla_load<false>(C, C.bid, PROJ, ALOW, cur);
#pragma unroll 1
    for (int i = 0; i < 4; ++i) {
        const int idx = i * C.G + C.bid;
        float Gl[16], off, gref, g63;
        gla_gates(C, al, tot, cur.alv, w2, bav, Gl, off, gref, g63);
#pragma unroll
        for (int jj = 0; jj < 16; ++jj) { const int j = jg * 16 + jj; KD[j * KST + d] = (bf16)f2bf(bf1(cur.kraw[jj]) * fexp2(g63 - (off + Gl[jj]))); }
        store_v_tile(C, cur, VL);
        LBAR();
        if (i + 1 < 4) gla_load<false>(C, idx + C.G, PROJ, ALOW, nxt);
        if (jg == 0) DEC[(size_t)idx * 128 + d] = fexp2(g63);
        const int lane = C.lane, g = lane >> 4, qq = (lane & 15) >> 2, p = lane & 3, fr = lane & 15;
        bf16x8 A[2];
#pragma unroll
        for (int ks = 0; ks < 2; ++ks) A[ks] = tr8(KD + (32 * ks + 8 * g + qq) * KST + 16 * C.wave + 4 * p, KST);
        bf16* Sit = SBUF + (size_t)idx * 256 * 128;
#pragma unroll
        for (int half = 0; half < 2; ++half) {
            f32x4 acc[8];
#pragma unroll
            for (int nt = 0; nt < 8; ++nt) acc[nt] = (f32x4){0.f, 0.f, 0.f, 0.f};
#pragma unroll
            for (int nt = 0; nt < 8; ++nt)
#pragma unroll
                for (int ks = 0; ks < 2; ++ks) { const bf16x8 Bf = tr8(VL + (32 * ks + 8 * g + qq) * VST + 16 * (half * 8 + nt) + 4 * p, VST); acc[nt] = mfma16(A[ks], Bf, acc[nt]); }
#pragma unroll
            for (int nt = 0; nt < 8; ++nt) { const int e = 16 * (half * 8 + nt) + fr, dd = 16 * C.wave + 4 * g;
                u32x2 w; w.x = pk2(acc[nt][0], acc[nt][1]); w.y = pk2(acc[nt][2], acc[nt][3]); *(u32x2*)(Sit + (size_t)e * 128 + dd) = w; }
        }
        LBAR();
        cur = nxt;
    }
}
DI void scan_phase(const Ctx& C, bf16* SBUF, const float* DEC) {
    const int gt = C.bid * NTHR + C.tid, bh = gt >> 13, rem = gt & 8191, e = rem >> 5, dq = rem & 31;
    u32x2* p = (u32x2*)(SBUF + ((size_t)(bh * 64) * 256 + e) * 128 + 4 * dq);
    const f32x4* dp = (const f32x4*)(DEC + (size_t)(bh * 64) * 128 + 4 * dq);
    f32x4 st = (f32x4){0.f, 0.f, 0.f, 0.f};
#pragma unroll 1
    for (int n0 = 0; n0 < 64; n0 += 8) {
        u32x2 tmp[8]; f32x4 dc[8];
#pragma unroll
        for (int u = 0; u < 8; ++u) { tmp[u] = p[(size_t)(n0 + u) * 8192]; dc[u] = dp[(n0 + u) * 32]; }
#pragma unroll
        for (int u = 0; u < 8; ++u) { u32x2 w; w.x = pk2(st.x, st.y); w.y = pk2(st.z, st.w); p[(size_t)(n0 + u) * 8192] = w;
            st = dc[u] * st + (f32x4){bflo(tmp[u].x), bfhi(tmp[u].x), bflo(tmp[u].y), bfhi(tmp[u].y)}; }
    }
}
DI void glaC_phase(const Ctx& C, int l, const bf16* PROJ, const float* ALOW, const bf16* SBUF, bf16* CONCAT) {
    const int h = (C.bid >> 6) & 3;
    LAS float* al = (LAS float*)(C.lds); LAS float* tot = (LAS float*)(C.lds + 4096); LAS float* RS = (LAS float*)(C.lds + 6144);
    LAS bf16* QT = (LAS bf16*)(C.lds + 8192); LAS bf16* KT = (LAS bf16*)(C.lds + 25600); LAS bf16* QG = (LAS bf16*)(C.lds + 43008);
    LAS bf16* VL = (LAS bf16*)(C.lds + 60416); LAS bf16* PL = (LAS bf16*)(C.lds + 94208);
    const int d = C.tid & 127, jg = C.tid >> 7;
    float w2[16];
#pragma unroll
    for (int r = 0; r < 16; ++r) w2[r] = KARG(I_WA2)[(size_t)l * 16 * 512 + r * 512 + h * 128 + d];
    const float bav = KARG(I_BA)[(size_t)l * 512 + h * 128 + d];
    const float* ng = KARG(I_GNG) + (size_t)(l * 4 + h) * 256;
    GlaIn cur;
    f32x4 alv_n = (f32x4){0.f, 0.f, 0.f, 0.f};
    if (C.tid < 256) alv_n = ((const f32x4*)(ALOW + (size_t)((C.bid >> 8) * SEQ + (C.bid & 63) * 64) * 16))[C.tid];
#pragma unroll 1
    for (int it = 0; it < 4; ++it) {
    const int idx = it * C.G + C.bid, b = idx >> 8, n = idx & 63, t0 = b * SEQ + n * 64;
    gla_load<true>(C, idx, PROJ, ALOW, cur); cur.alv = alv_n;
    float Gl[16], off, gref, g63;
    gla_gates(C, al, tot, cur.alv, w2, bav, Gl, off, gref, g63);
#pragma unroll
    for (int jj = 0; jj < 16; ++jj) { const int j = jg * 16 + jj; const float Gv = off + Gl[jj];
        const float q = bf1(cur.qraw[jj]) * 0.08838834764831845f, k = bf1(cur.kraw[jj]);
        QT[j * KST + d] = (bf16)f2bf(q * fexp2(fminf(Gv - gref, 100.f))); KT[j * KST + d] = (bf16)f2bf(k * fexp2(fminf(gref - Gv, 100.f))); QG[j * KST + d] = (bf16)f2bf(q * fexp2(Gv)); }
    store_v_tile(C, cur, VL);
    const int lane = C.lane, g = lane >> 4, qq = (lane & 15) >> 2, p = lane & 3, fr = lane & 15;
    bf16x8 Sf[2][4]; u32x2 rraw[4][2];
#pragma unroll
    for (int mi = 0; mi < 2; ++mi) { const bf16* Srow = SBUF + ((size_t)idx * 256 + 16 * (2 * C.wave + mi) + fr) * 128 + 8 * g;
#pragma unroll
        for (int ks = 0; ks < 4; ++ks) Sf[mi][ks] = *(const bf16x8*)(Srow + 32 * ks); }
#pragma unroll
    for (int nt = 0; nt < 4; ++nt)
#pragma unroll
        for (int mi = 0; mi < 2; ++mi) rraw[nt][mi] = *(const u32x2*)(PROJ + (size_t)(t0 + 16 * nt + fr) * NPROJ + C_R + h * 256 + 16 * (2 * C.wave + mi) + 4 * g);
    LBAR();
    {
        const int nt = C.wave & 3;
#pragma unroll
        for (int mi = 0; mi < 2; ++mi) { const int mt = 2 * (C.wave >> 2) + mi; f32x4 acc = (f32x4){0.f, 0.f, 0.f, 0.f};
#pragma unroll
            for (int ks = 0; ks < 4; ++ks) { const bf16x8 a = *(const LAS bf16x8*)(KT + (16 * mt + fr) * KST + 32 * ks + 8 * g), bq = *(const LAS bf16x8*)(QT + (16 * nt + fr) * KST + 32 * ks + 8 * g); acc = mfma16(a, bq, acc); }
            const int i = 16 * nt + fr, j0 = 16 * mt + 4 * g;
            const float v0 = (j0 + 0 <= i) ? acc[0] : 0.f, v1 = (j0 + 1 <= i) ? acc[1] : 0.f, v2 = (j0 + 2 <= i) ? acc[2] : 0.f, v3 = (j0 + 3 <= i) ? acc[3] : 0.f;
            u32x2 w; w.x = pk2(v0, v1); w.y = pk2(v2, v3); *(LAS u32x2*)(PL + i * PST + j0) = w; }
    }
    LBAR();
    f32x4 acc[2][4];
#pragma unroll
    for (int mi = 0; mi < 2; ++mi)
#pragma unroll
        for (int nt = 0; nt < 4; ++nt) acc[mi][nt] = (f32x4){0.f, 0.f, 0.f, 0.f};
#pragma unroll
    for (int mi = 0; mi < 2; ++mi) { const int mt = 2 * C.wave + mi;
#pragma unroll
        for (int ks = 0; ks < 2; ++ks) { const bf16x8 a = tr8(VL + (32 * ks + 8 * g + qq) * VST + 16 * mt + 4 * p, VST);
#pragma unroll
            for (int nt = 0; nt < 4; ++nt) { const bf16x8 bp = *(const LAS bf16x8*)(PL + (16 * nt + fr) * PST + 32 * ks + 8 * g); acc[mi][nt] = mfma16(a, bp, acc[mi][nt]); } }
#pragma unroll
        for (int ks = 0; ks < 4; ++ks) { const bf16x8 a = Sf[mi][ks];
#pragma unroll
            for (int nt = 0; nt < 4; ++nt) { const bf16x8 bq = *(const LAS bf16x8*)(QG + (16 * nt + fr) * KST + 32 * ks + 8 * g); acc[mi][nt] = mfma16(a, bq, acc[mi][nt]); } }
    }
#pragma unroll
    for (int nt = 0; nt < 4; ++nt) { float s = 0.f;
#pragma unroll
        for (int mi = 0; mi < 2; ++mi) s += (acc[mi][nt][0] * acc[mi][nt][0] + acc[mi][nt][1] * acc[mi][nt][1]) + (acc[mi][nt][2] * acc[mi][nt][2] + acc[mi][nt][3] * acc[mi][nt][3]);
        s += __shfl_xor(s, 16); s += __shfl_xor(s, 32);
        if (g == 0) RS[C.wave * 64 + 16 * nt + fr] = s; }
    LBAR();
    if (it + 1 < 4 && C.tid < 256) { const int ix = idx + C.G; alv_n = ((const f32x4*)(ALOW + (size_t)((ix >> 8) * SEQ + (ix & 63) * 64) * 16))[C.tid]; }
#pragma unroll
    for (int nt = 0; nt < 4; ++nt) { const int i = 16 * nt + fr; float ts = 0.f;
#pragma unroll
        for (int w = 0; w < 8; ++w) ts += RS[w * 64 + i];
        const float rstd = frsq(ts * (1.f / 256.f) + EPS);
#pragma unroll
        for (int mi = 0; mi < 2; ++mi) { const int e = 16 * (2 * C.wave + mi) + 4 * g;
            const u32x2 rr = rraw[nt][mi]; const f32x4 gg = *(const f32x4*)(ng + e);
            const float o0 = acc[mi][nt][0] * rstd * gg.x * silu_f(bflo(rr.x)), o1 = acc[mi][nt][1] * rstd * gg.y * silu_f(bfhi(rr.x));
            const float o2 = acc[mi][nt][2] * rstd * gg.z * silu_f(bflo(rr.y)), o3 = acc[mi][nt][3] * rstd * gg.w * silu_f(bfhi(rr.y));
            u32x2 w; w.x = pk2(o0, o1); w.y = pk2(o2, o3); *(u32x2*)(CONCAT + (size_t)(t0 + i) * D + h * 256 + e) = w; } }
    LBAR();
    }
}
constexpr int GST = 136;
DI void gmlp_phase(const Ctx& C, int l, const bf16* PROJ, const bf16* WSB, bf16* CONCAT) {
    const int h = C.bid & 7;
    LAS bf16* VL2 = (LAS bf16*)(C.lds); LAS bf16* UL = (LAS bf16*)(C.lds + 34816);
    const float* vg = KARG(I_VNG) + (size_t)(l * 8 + h) * 128; const float* og = KARG(I_MOG) + (size_t)(l * 8 + h) * 128; const float* bb = KARG(I_MB) + (size_t)(l * 8 + h) * 128;
    bf16x8 Wf[4];
    { const bf16* Wrow = WSB + ((size_t)(l * 8 + h) * 128 + 16 * C.wave + (C.lane & 15)) * 128 + 8 * (C.lane >> 4);
#pragma unroll
      for (int ks = 0; ks < 4; ++ks) Wf[ks] = *(const bf16x8*)(Wrow + 32 * ks); }
    u32x4 cu[4], cv[4], nu[4], nv[4];
#define GM_LOAD(IDX, U, V) do { const int t0_ = ((IDX) >> 8) * SEQ + (((IDX) >> 3) & 31) * 128; _Pragma("unroll") for (int i = 0; i < 4; ++i) { const int c = C.tid + 512 * i, t = c >> 4, ch = c & 15; \
        const bf16* row = PROJ + (size_t)(t0_ + t) * NPROJ + h * 128 + 8 * ch; U[i] = *(const u32x4*)(row + C_U); V[i] = *(const u32x4*)(row + C_VS); } } while (0)
    GM_LOAD(C.bid, cu, cv);
#pragma unroll 1
    for (int it = 0; it < 4; ++it) {
    const int idx = it * C.G + C.bid, n = (idx >> 3) & 31, b = idx >> 8, t0 = b * SEQ + n * 128;
#pragma unroll
    for (int i = 0; i < 4; ++i) { const int c = C.tid + 512 * i, t = c >> 4, ch = c & 15;
        const u32x4 uu = cu[i], vv = cv[i];
        float v[8] = {gelu_t(bflo(vv.x)), gelu_t(bfhi(vv.x)), gelu_t(bflo(vv.y)), gelu_t(bfhi(vv.y)), gelu_t(bflo(vv.z)), gelu_t(bfhi(vv.z)), gelu_t(bflo(vv.w)), gelu_t(bfhi(vv.w))};
        float ss = 0.f;
#pragma unroll
        for (int k = 0; k < 8; ++k) ss += v[k] * v[k];
        ss += __shfl_xor(ss, 1); ss += __shfl_xor(ss, 2); ss += __shfl_xor(ss, 4); ss += __shfl_xor(ss, 8);
        const float rstd = frsq(ss * (1.f / 128.f) + EPS);
        const f32x4 g0 = *(const f32x4*)(vg + 8 * ch), g1 = *(const f32x4*)(vg + 8 * ch + 4);
        u32x4 wv; wv.x = pk2(v[0] * rstd * g0.x, v[1] * rstd * g0.y); wv.y = pk2(v[2] * rstd * g0.z, v[3] * rstd * g0.w); wv.z = pk2(v[4] * rstd * g1.x, v[5] * rstd * g1.y); wv.w = pk2(v[6] * rstd * g1.z, v[7] * rstd * g1.w);
        *(LAS u32x4*)(VL2 + t * GST + 8 * ch) = wv;
        u32x4 wu; wu.x = pk2(gelu_t(bflo(uu.x)), gelu_t(bfhi(uu.x))); wu.y = pk2(gelu_t(bflo(uu.y)), gelu_t(bfhi(uu.y))); wu.z = pk2(gelu_t(bflo(uu.z)), gelu_t(bfhi(uu.z))); wu.w = pk2(gelu_t(bflo(uu.w)), gelu_t(bfhi(uu.w)));
        *(LAS u32x4*)(UL + t * GST + 8 * ch) = wu; }
    LBAR();
    if (it + 1 < 4) GM_LOAD(idx + C.G, nu, nv);
    const int lane = C.lane, g = lane >> 4, qq = (lane & 15) >> 2, p = lane & 3, fr = lane & 15;
    f32x4 acc[8];
#pragma unroll
    for (int mt = 0; mt < 8; ++mt) acc[mt] = (f32x4){0.f, 0.f, 0.f, 0.f};
    const int nks = (C.wave >> 1) + 1;
#pragma unroll
    for (int ks = 0; ks < 4; ++ks) if (ks < nks) { const bf16x8 bw = Wf[ks];
#pragma unroll
        for (int mt = 0; mt < 8; ++mt) { const bf16x8 a = tr8(VL2 + (32 * ks + 8 * g + qq) * GST + 16 * mt + 4 * p, GST); acc[mt] = mfma16(a, bw, acc[mt]); } }
    const int tl = 16 * C.wave + fr; const float bt = bb[tl]; float ss = 0.f;
#pragma unroll
    for (int mt = 0; mt < 8; ++mt) { const u32x2 uu = *(const LAS u32x2*)(UL + tl * GST + 16 * mt + 4 * g);
        acc[mt][0] = bflo(uu.x) * (acc[mt][0] + bt); acc[mt][1] = bfhi(uu.x) * (acc[mt][1] + bt); acc[mt][2] = bflo(uu.y) * (acc[mt][2] + bt); acc[mt][3] = bfhi(uu.y) * (acc[mt][3] + bt);
        ss += (acc[mt][0] * acc[mt][0] + acc[mt][1] * acc[mt][1]) + (acc[mt][2] * acc[mt][2] + acc[mt][3] * acc[mt][3]); }
    ss += __shfl_xor(ss, 16); ss += __shfl_xor(ss, 32);
    const float rstd = frsq(ss * (1.f / 128.f) + EPS);
#pragma unroll
    for (int mt = 0; mt < 8; ++mt) { const f32x4 gg = *(const f32x4*)(og + 16 * mt + 4 * g);
        u32x2 w; w.x = pk2(acc[mt][0] * rstd * gg.x, acc[mt][1] * rstd * gg.y); w.y = pk2(acc[mt][2] * rstd * gg.z, acc[mt][3] * rstd * gg.w);
        *(u32x2*)(CONCAT + (size_t)(t0 + tl) * D + 1024 + h * 128 + 16 * mt + 4 * g) = w; }
    LBAR();
#pragma unroll
    for (int i = 0; i < 4; ++i) { cu[i] = nu[i]; cv[i] = nv[i]; }
    }
#undef GM_LOAD
}
DI void list_insert(float (&L)[16], float x) {
#pragma unroll
    for (int i = 15; i >= 1; --i) L[i] = __builtin_amdgcn_fmed3f(x, L[i - 1], L[i]);
    L[0] = fmaxf(L[0], x);
}
DI void list_merge_xor(float (&L)[16], int mask) {
    float M[16];
#pragma unroll
    for (int i = 0; i < 16; ++i) M[i] = fmaxf(L[i], __shfl_xor(L[15 - i], mask));
#pragma unroll
    for (int s = 8; s >= 1; s >>= 1)
#pragma unroll
        for (int i = 0; i < 16; ++i) if ((i & s) == 0) { const float hi = fmaxf(M[i], M[i + s]), lo = fminf(M[i], M[i + s]); M[i] = hi; M[i + s] = lo; }
#pragma unroll
    for (int i = 0; i < 16; ++i) L[i] = M[i];
}
DI unsigned fbits(float x) { return __builtin_bit_cast(unsigned, x); }
DI float unp7(float x) { return __builtin_bit_cast(float, __builtin_bit_cast(unsigned, x) & 0xFFFFFF80u); }
constexpr int TKST = 136;
DI void topk_phase(const Ctx& C, int l, const bf16* QB, const bf16* K1B, const bf16* K2B, const int* KU, const int* KV, int* EB, float* PG) {
    LAS bf16* KL = (LAS bf16*)C.lds;
    LAS unsigned* tk = (LAS unsigned*)(C.lds + 2 * 128 * TKST * 2 + C.wave * 2048);
    const int lane = C.lane, fr = lane & 15, fq = lane >> 4, h = C.bid & 7, rank = C.bid >> 3;
#pragma unroll
    for (int i = 0; i < 8; ++i) { const int c = C.tid + 512 * i, tb = c >> 11, row = (c & 2047) >> 4, ch = c & 15;
        *(LAS u32x4*)(KL + (tb * 128 + row) * TKST + 8 * ch) = *(const u32x4*)((tb ? K2B : K1B) + ((size_t)(l * 8 + h) * 128 + row) * 128 + 8 * ch); }
    __syncthreads();
#pragma unroll 1
    for (int it = 0; it < 4; ++it) {
        const int tt0 = rank * 512 + C.wave * 64 + it * 16;
        float L[2][16];
        bf16x8 bq[2][4];
#pragma unroll
        for (int half = 0; half < 2; ++half)
#pragma unroll
            for (int ks = 0; ks < 4; ++ks) bq[half][ks] = *(const bf16x8*)(QB + (size_t)(tt0 + fr) * D + h * 256 + half * 128 + 8 * fq + 32 * ks);
#pragma unroll
        for (int half = 0; half < 2; ++half) {
            f32x4 acc[8];
#pragma unroll
            for (int mt = 0; mt < 8; ++mt) acc[mt] = (f32x4){0.f, 0.f, 0.f, 0.f};
            const LAS bf16* Kb = KL + (half * 128 + fr) * TKST + 8 * fq;
#pragma unroll
            for (int ks = 0; ks < 4; ++ks)
#pragma unroll
                for (int mt = 0; mt < 8; ++mt) { const bf16x8 a = *(const LAS bf16x8*)(Kb + (16 * mt) * TKST + 32 * ks); acc[mt] = mfma16(a, bq[half][ks], acc[mt]); }
#pragma unroll
            for (int i = 0; i < 16; ++i) L[half][i] = __builtin_bit_cast(float, 0xFF800000u);
#pragma unroll
            for (int mt = 0; mt < 8; ++mt)
#pragma unroll
                for (int r = 0; r < 4; ++r) { const unsigned key = (unsigned)(16 * mt + 4 * fq + r);
                    const float sv = acc[mt][r];
                    list_insert(L[half], __builtin_bit_cast(float, (fbits(sv) & 0xFFFFFF80u) | key)); }
            list_merge_xor(L[half], 16); list_merge_xor(L[half], 32);
        }
        if (fq == 0) {
#pragma unroll
            for (int i = 0; i < 16; ++i) { tk[(fr * 2 + 0) * 16 + i] = fbits(L[0][i]); tk[(fr * 2 + 1) * 16 + i] = fbits(L[1][i]); }
        }
        float Cn[16];
#pragma unroll
        for (int i = 0; i < 16; ++i) Cn[i] = __builtin_bit_cast(float, 0xFF800000u);
#pragma unroll
        for (int i = 0; i < 16; ++i)
#pragma unroll
            for (int j = 0; j < 16; ++j) if ((i + 1) * (j + 1) <= 16) {
                const float s = unp7(L[0][i]) + unp7(L[1][j]);
                list_insert(Cn, __builtin_bit_cast(float, (fbits(s) & 0xFFFFFF00u) | (unsigned)(i * 16 + j))); }
        LDS_WAIT();
        float sc[4]; int ex[4];
#pragma unroll
        for (int m = 0; m < 4; ++m) {
            const float ck = fq == 0 ? Cn[m] : (fq == 1 ? Cn[4 + m] : (fq == 2 ? Cn[8 + m] : Cn[12 + m]));
            const unsigned cc = fbits(ck) & 255u;
            const unsigned p1 = tk[(fr * 2 + 0) * 16 + (cc >> 4)], p2 = tk[(fr * 2 + 1) * 16 + (cc & 15u)];
            sc[m] = __builtin_bit_cast(float, p1 & 0xFFFFFF80u) + __builtin_bit_cast(float, p2 & 0xFFFFFF80u);
            ex[m] = (int)((p1 & 127u) * 128u + (p2 & 127u));
        }
        float mx = fmaxf(fmaxf(sc[0], sc[1]), fmaxf(sc[2], sc[3]));
        mx = fmaxf(mx, __shfl_xor(mx, 16)); mx = fmaxf(mx, __shfl_xor(mx, 32));
        float w[4], sum = 0.f;
#pragma unroll
        for (int m = 0; m < 4; ++m) { w[m] = fexp2((sc[m] - mx) * 1.442695041f); sum += w[m]; }
        sum += __shfl_xor(sum, 16); sum += __shfl_xor(sum, 32);
        const float inv = 1.0f / sum;
        const size_t o = (size_t)(tt0 + fr) * 128 + h * 16 + 4 * fq;
#pragma unroll
        for (int m = 0; m < 4; ++m) { const int kv = KV[ex[m]]; w[m] = w[m] * inv * __builtin_bit_cast(float, (unsigned)(127 - kv) << 23); ex[m] |= 127 << 16; }
        *(int4*)(EB + o) = make_int4(ex[0], ex[1], ex[2], ex[3]);
        *(f32x4*)(PG + o) = (f32x4){w[0], w[1], w[2], w[3]};
        LDS_WAIT();
    }
}
typedef unsigned char fp8_t;
DI void unpack16(const u32x4 q, float (&f)[16]) {
#pragma unroll
    for (int w = 0; w < 4; ++w) { const int dw = (int)q[w]; const f32x2 lo = __builtin_amdgcn_cvt_pk_f32_fp8(dw, false), hi = __builtin_amdgcn_cvt_pk_f32_fp8(dw, true);
        f[4 * w] = lo.x; f[4 * w + 1] = lo.y; f[4 * w + 2] = hi.x; f[4 * w + 3] = hi.y; }
}
DI int sdot4(int a, int b, int c) { return __builtin_amdgcn_sdot4(a, b, c, false); }
template <int CTRL> DI int dppi(int v) { return __builtin_amdgcn_update_dpp(0, v, CTRL, 0xf, 0xf, true); }
template <int CTRL, int NV> DI void bfly(int (&p)[32], const int base, const bool up) {
#pragma unroll
    for (int m = 0; m < NV / 2; ++m) { const int lo = p[base + m], hi = p[base + m + NV / 2]; const int keep = up ? hi : lo, send = up ? lo : hi; p[base + m] = keep + dppi<CTRL>(send); }
}
#define PU_ADD(P, V_) (void)__hip_atomic_fetch_add((P), (V_), __ATOMIC_RELAXED, __HIP_MEMORY_SCOPE_AGENT)
DI void peerU_phase(const Ctx& C, const unsigned char* H8, const float* HS, const int* EB, const unsigned char* PU8, const float* SU, int* COEF, const int emask = 0xFFFF) {
    const int x = C.bid & 7, rank = C.bid >> 3, lane = C.lane, g = lane >> 4, i16 = lane & 15;
    const __amdgpu_buffer_rsrc_t trs = __builtin_amdgcn_make_buffer_rsrc((void*)(PU8 + (size_t)x * NEXP * 256), 0, NEXP * 256, 0x00020000);
    const float* su = SU + (size_t)x * NEXP;
    const int tbase = rank * 512 + C.wave * 64;
    int* part = COEF + (size_t)tbase * 128 + lane;
    const int* ebase = EB + (size_t)tbase * 128 + lane;
    const unsigned char* hbase = H8 + (size_t)tbase * 4096 + 256 * x + 16 * i16;
    const float* hsb = HS + tbase;
    const int bp0 = 64 * g, loff = 16 * i16;
    const bool b3 = (i16 & 8) != 0, b2 = (i16 & 4) != 0, b1 = (i16 & 2) != 0, b0 = (i16 & 1) != 0;
    int en0 = ebase[0] & emask, en1 = ebase[64] & emask;
    int er0 = ebase[128], er1 = ebase[192];
    u32x4 hh = *(const u32x4*)hbase, hl = *(const u32x4*)(hbase + 2048);
    float sc0 = su[en0], sc1 = su[en1], hs = hsb[0];
    u32x4 buf[32];
#pragma unroll
    for (int u = 0; u < 32; ++u) { const int e = __builtin_amdgcn_ds_bpermute(bp0 + 4 * (u & 15), u < 16 ? en0 : en1); buf[u] = __builtin_amdgcn_raw_buffer_load_b128(trs, e * 256 + loff, 0, 0); }
    __builtin_amdgcn_sched_barrier(0);
    en0 = er0 & emask; en1 = er1 & emask;
    int pend0 = 0, pend1 = 0; int* pend_p = part;
#pragma unroll 1
    for (int ti = 0; ti < 64; ++ti) {
        const int tn = ti + 1 < 64 ? ti + 1 : 63, t2 = ti + 2 < 64 ? ti + 2 : 63;
        er0 = ebase[t2 * 128]; er1 = ebase[t2 * 128 + 64];
        const u32x4 hhn = *(const u32x4*)(hbase + (size_t)tn * 4096), hln = *(const u32x4*)(hbase + (size_t)tn * 4096 + 2048);
        const float scn0 = su[en0], scn1 = su[en1], hsn = hsb[tn];
        __builtin_amdgcn_sched_barrier(0);
        int p[32];
#pragma unroll
        for (int u0 = 0; u0 < 32; u0 += 4) {
            int en[4];
#pragma unroll
            for (int u = u0; u < u0 + 4; ++u) en[u - u0] = __builtin_amdgcn_ds_bpermute(bp0 + 4 * (u & 15), u < 16 ? en0 : en1);
#pragma unroll
            for (int u = u0; u < u0 + 4; ++u) {
                const u32x4 r = buf[u];
                int ah = sdot4((int)r.x, (int)hh.x, 0); ah = sdot4((int)r.y, (int)hh.y, ah); ah = sdot4((int)r.z, (int)hh.z, ah); ah = sdot4((int)r.w, (int)hh.w, ah);
                int al = sdot4((int)r.x, (int)hl.x, 0); al = sdot4((int)r.y, (int)hl.y, al); al = sdot4((int)r.z, (int)hl.z, al); al = sdot4((int)r.w, (int)hl.w, al);
                p[u] = (ah << 7) + al; }
            asm volatile("" : "+v"(p[u0]), "+v"(p[u0 + 1]), "+v"(p[u0 + 2]), "+v"(p[u0 + 3]) :: "memory");
#pragma unroll
            for (int u = u0; u < u0 + 4; ++u) buf[u] = __builtin_amdgcn_raw_buffer_load_b128(trs, en[u - u0] * 256 + loff, 0, 0);
            if (u0 == 12) { PU_ADD(pend_p, pend0); PU_ADD(pend_p + 64, pend1); }
            __builtin_amdgcn_sched_barrier(0);
        }
        bfly<0x140, 16>(p, 0, b3); bfly<0x140, 16>(p, 16, b3);
        bfly<0x141, 8>(p, 0, b2); bfly<0x141, 8>(p, 16, b2);
        bfly<0x4E, 4>(p, 0, b1); bfly<0x4E, 4>(p, 16, b1);
        bfly<0xB1, 2>(p, 0, b0); bfly<0xB1, 2>(p, 16, b0);
        pend0 = (int)__builtin_rintf(fminf(fmaxf((float)p[0] * (sc0 * hs * 16384.0f), -2.0e9f), 2.0e9f)); pend1 = (int)__builtin_rintf(fminf(fmaxf((float)p[16] * (sc1 * hs * 16384.0f), -2.0e9f), 2.0e9f)); pend_p = part + (size_t)ti * 128;
        asm volatile("" : "+v"(er0), "+v"(er1) :: "memory");
        en0 = er0 & emask; en1 = er1 & emask; hh = hhn; hl = hln; sc0 = scn0; sc1 = scn1; hs = hsn;
    }
    PU_ADD(pend_p, pend0); PU_ADD(pend_p + 64, pend1);
#undef PU_ADD
}
typedef long i64_t;
DI float wave_max_u(float v) {
    v = fmaxf(v, dppf<0xB1>(v)); v = fmaxf(v, dppf<0x4E>(v)); v = fmaxf(v, dppf<0x141>(v)); v = fmaxf(v, dppf<0x140>(v));
    const int iv = __builtin_bit_cast(int, v);
    return fmaxf(fmaxf(__builtin_bit_cast(float, __builtin_amdgcn_readlane(iv, 0)), __builtin_bit_cast(float, __builtin_amdgcn_readlane(iv, 16))),
                 fmaxf(__builtin_bit_cast(float, __builtin_amdgcn_readlane(iv, 32)), __builtin_bit_cast(float, __builtin_amdgcn_readlane(iv, 48))));
}
constexpr int PV_BLK = 272;
DI void peerV_phase(const Ctx& C, const int* EB, const float* PG, const int* COEF, const fp8_t* PV8, float* X, const float* gate  , const int emask = 0x3FFF, const long wdelta = 0  ) {
    const int x = C.bid & 7, rank = C.bid >> 3, lane = C.lane, g = lane >> 4, i16 = lane & 15;
    const __amdgpu_buffer_rsrc_t trs = __builtin_amdgcn_make_buffer_rsrc((void*)(PV8 + (size_t)x * NEXP * 256), 0, NEXP * 256, 0x00020000);
    const int tbase = rank * 512 + C.wave * 64;
    ldsp wl = C.lds + C.wave * (8 * PV_BLK);
    const int wr_off = g * PV_BLK + 16 * i16;
    const int rd_off = ((((lane >> 1) & 1) * 4) + (lane & 1)) * PV_BLK + 16 * (lane >> 2);
    const int bp0 = 64 * g, loff = 16 * i16;
    const int ash = (i16 < 8) ? 24 : 16, asl = 8 * (i16 & 3); const unsigned amlo = (i16 & 4) ? 0u : 0xFFFFFFFFu, amhi = ~amlo;
    const int* ebase = EB + (size_t)tbase * 128 + lane; const float* gbase = PG + (size_t)tbase * 128 + lane; const int* pbase = COEF + (size_t)tbase * 128 + lane;
    const int col = 256 * x + 4 * lane;
    const f32x4 gt = *(const f32x4*)(gate + (size_t)(tbase >> 12) * MODW + col);
    int pc0, pc1; float rg0, rg1;
#define PV_LOAD_RAW(tt) do { pc0 = pbase[(tt) * 128]; pc1 = pbase[(tt) * 128 + 64]; rg0 = gbase[(tt) * 128]; rg1 = gbase[(tt) * 128 + 64]; } while (0)
#define PV_PACK(PK0, PK1, INVA, ID0, ID1) do { const float s0_ = (float)pc0 * (1.0f / 16384.0f), s1_ = (float)pc1 * (1.0f / 16384.0f); \
        const float a0_ = gelu_t(s0_) * rg0, a1_ = gelu_t(s1_) * rg1; const float amax_ = wave_max_u(fmaxf(fabsf(a0_), fabsf(a1_))); \
        int ka_ = 0; if (amax_ > 0.f) { ka_ = (int)((__builtin_bit_cast(unsigned, 224.0f / amax_) >> 23) & 255u) - 127; ka_ = ka_ < -100 ? -100 : (ka_ > 100 ? 100 : ka_); } \
        const float sca_ = __builtin_bit_cast(float, (unsigned)(ka_ + 127) << 23); INVA = __builtin_bit_cast(float, (unsigned)(127 - ka_) << 23); \
        const float h0_ = a0_ * sca_, h1_ = a1_ * sca_; const int ph_ = __builtin_amdgcn_cvt_pk_fp8_f32(h0_, h1_, 0, false); const f32x2 bk_ = __builtin_amdgcn_cvt_pk_f32_fp8(ph_, false); \
        const int pl_ = __builtin_amdgcn_cvt_pk_fp8_f32((h0_ - bk_.x) * 16.0f, (h1_ - bk_.y) * 16.0f, 0, false); \
        PK0 = (int)(((unsigned)(ph_ & 255) << 24) | ((unsigned)(pl_ & 255) << 16) | (unsigned)(ID0)); PK1 = (int)(((unsigned)(ph_ & 0xFF00) << 16) | ((unsigned)(pl_ & 0xFF00) << 8) | (unsigned)(ID1)); } while (0)
    const int e0 = ebase[0] & emask, e1 = ebase[64] & emask;
    int er0 = ebase[128], er1 = ebase[192];
    PV_LOAD_RAW(0);
    f32x4* xp0 = (f32x4*)(X + (size_t)tbase * D + col);
    f32x4 xpend = *xp0; f32x4* xpend_p = (f32x4*)((float*)xp0 + wdelta);
    u32x4 buf[32];
#pragma unroll
    for (int u = 0; u < 32; ++u) { const int e = __builtin_amdgcn_ds_bpermute(bp0 + 4 * (u & 15), u < 16 ? e0 : e1); buf[u] = __builtin_amdgcn_raw_buffer_load_b128(trs, e * 256 + loff, 0, 0); }
    __builtin_amdgcn_sched_barrier(0);
    int pk0, pk1; float inva;
    PV_PACK(pk0, pk1, inva, er0 & emask, er1 & emask);
#pragma unroll 1
    for (int ti = 0; ti < 64; ++ti) {
        const int tn = ti + 1 < 64 ? ti + 1 : 63, t2 = ti + 2 < 64 ? ti + 2 : 63;
        er0 = ebase[t2 * 128]; er1 = ebase[t2 * 128 + 64];
        PV_LOAD_RAW(tn);
        f32x4* xp = (f32x4*)(X + (size_t)(tbase + ti) * D + col);
        const f32x4 xold = *xp;
        __builtin_amdgcn_sched_barrier(0);
        f32x4 d0 = (f32x4){0.f, 0.f, 0.f, 0.f}, d1 = d0;
#pragma unroll
        for (int u0 = 0; u0 < 32; u0 += 4) {
            int w[4];
#pragma unroll
            for (int u = u0; u < u0 + 4; ++u) w[u - u0] = __builtin_amdgcn_ds_bpermute(bp0 + 4 * (u & 15), u < 16 ? pk0 : pk1);
#pragma unroll
            for (int u = u0; u < u0 + 4; ++u) {
                const u32x4 r = buf[u]; const unsigned ab = (((unsigned)w[u - u0] >> ash) & 255u) << asl;
                const i64_t av = (i64_t)(((unsigned long long)(ab & amhi) << 32) | (ab & amlo));
                d0 = __builtin_amdgcn_mfma_f32_16x16x32_fp8_fp8(av, (i64_t)(((unsigned long long)r.y << 32) | r.x), d0, 0, 0, 0);
                d1 = __builtin_amdgcn_mfma_f32_16x16x32_fp8_fp8(av, (i64_t)(((unsigned long long)r.w << 32) | r.z), d1, 0, 0, 0); }
            asm volatile("" : "+v"(d0), "+v"(d1) :: "memory");
#pragma unroll
            for (int u = u0; u < u0 + 4; ++u) buf[u] = __builtin_amdgcn_raw_buffer_load_b128(trs, ((w[u - u0] & 0x3FFF) << 8) + loff, 0, 0);
            if (u0 == 12) *xpend_p = xpend;
            __builtin_amdgcn_sched_barrier(0);
        }
        *(LAS f32x4*)(wl + wr_off) = d0; *(LAS f32x4*)(wl + wr_off + 4 * PV_BLK) = d1;
        const f32x4 yh = *(const LAS f32x4*)(wl + rd_off), yl = *(const LAS f32x4*)(wl + rd_off + 2 * PV_BLK);
        const f32x4 y = (yh + yl * 0.0625f) * inva;
        xpend = xold + gt * y; xpend_p = (f32x4*)((float*)xp + wdelta);
        asm volatile("" : "+v"(er0), "+v"(er1) :: "memory");
        PV_PACK(pk0, pk1, inva, er0 & emask, er1 & emask);
    }
    *xpend_p = xpend;
#undef PV_LOAD_RAW
#undef PV_PACK
}
DI void final_norm_phase(const Ctx& C, float* X, const float* g) {
    const int r0 = C.gw * 8;
    f32x4 gm[8];
#pragma unroll
    for (int j = 0; j < 8; ++j) gm[j] = ((const f32x4*)g)[64 * j + C.lane];
#pragma unroll 1
    for (int i = 0; i < 8; ++i) {
        f32x4* xr = (f32x4*)(X + (size_t)(r0 + i) * D) + C.lane; f32x4 v[8]; float s = 0.f;
#pragma unroll
        for (int j = 0; j < 8; ++j) { v[j] = xr[64 * j]; s += (v[j].x * v[j].x + v[j].y * v[j].y) + (v[j].z * v[j].z + v[j].w * v[j].w); }
        const float rstd = frsq(wave_sum(s) * (1.f / D) + EPS);
#pragma unroll
        for (int j = 0; j < 8; ++j) xr[64 * j] = v[j] * rstd * gm[j];
    }
}
#ifndef PH_MASK
#define PH_MASK 0xFFFFF
#endif
#define EN(k) (((PH_MASK) >> (k)) & 1)
#ifndef GEMM_SP2
#define GEMM_SP2 true
#endif
#ifndef GEMM_ALIGN
#define GEMM_ALIGN false
#endif
constexpr int NKIND = 11, NPH = 2 + 2 * NKIND;
struct Args { const float* in[21]; float* out; unsigned char* ws; int ph_lo, ph_hi, pad0, pad1; };
__global__ void __launch_bounds__(NTHR, 2) mk_fwd(Args args) {
    extern __shared__ __attribute__((aligned(16))) unsigned char lds_raw[];
    ldsp ldsb = (ldsp)lds_raw;
    volatile LAS unsigned* MISC = (volatile LAS unsigned*)(ldsb + MISC_OFF);
    for (int u = threadIdx.x; u < (LDS_BYTES - LDSCTL_OFF) / 4; u += NTHR) ((LAS unsigned*)(ldsb + LDSCTL_OFF))[u] = 0u;
    __syncthreads();
    unsigned* barw = (unsigned*)(args.ws + WS_CTL) + CW_BAR;
    XcdBarrier bar; bar.bar = barw; bar.x = 0; bar.st = nullptr;
    const bool multi = (args.ph_hi - args.ph_lo) > 1;
    if (multi) bar = xcd_barrier_post(barw, MISC + 8);

#ifdef DBG_REP_MASK
    int repflag = 0;
#endif
#pragma unroll 1
    for (int ph = args.ph_lo; ph < args.ph_hi; ++ph) {
#define MKCTX Ctx C; { int tid_ = threadIdx.x, bid_ = blockIdx.x; asm volatile("" : "+v"(tid_)); asm volatile("" : "+s"(bid_)); \
        C.lds = ldsb; C.tid = tid_; C.lane = tid_ & 63; C.wave = __builtin_amdgcn_readfirstlane(tid_ >> 6); C.bid = bid_; C.G = gridDim.x; C.gw = C.bid * NWAVES + C.wave; C.NGW = C.G * NWAVES; \
        C.ws = args.ws; }
        unsigned char* const wsb = args.ws;
        float* MOD = (float*)(wsb + WS_MOD);
        bf16* Hb = (bf16*)(wsb + WS_H); bf16* PROJ = (bf16*)(wsb + WS_PROJ); bf16* SBUF = (bf16*)(wsb + WS_SBUF); bf16* CONCAT = (bf16*)(wsb + WS_CONCAT); bf16* QB = (bf16*)(wsb + WS_QB);
        float* ALOW = (float*)(wsb + WS_ALOW); float* DEC = (float*)(wsb + WS_DEC); int* EB = (int*)(wsb + WS_EB); float* PG = (float*)(wsb + WS_PG);
        float* X = args.out;
        const int l = ph < 2 ? 0 : (ph - 2) / NKIND, kind = ph < 2 ? -1 : (ph - 2) % NKIND;
        const float* modl = MOD + (size_t)l * 4 * MODW;
        if (ph == 0) { if (EN(0)) { MKCTX; p0_prologue(C); } }
        else if (ph == 1) { if (EN(1)) { MKCTX; norm_phase(C, KARG(I_X), KARG(I_N1G), modl, 0, D, Hb); } }
        else if ((kind == 0 || kind == 6) && EN(2)) {
            MKCTX; const bool isq = (kind == 6);
            pg8::Gemm g{Hb, isq ? (const bf16*)(wsb + WS_WTQ) + (size_t)l * D * D : (const bf16*)(wsb + WS_WTIN) + (size_t)l * WTIN_L, T, isq ? D : NPROJ, D};
            pg8::StaticOrder S; S.init(T, g.N, C.G, C.bid);
            pg8::EpiBf16 E{isq ? QB : PROJ, isq ? D : NPROJ};
            pg8::gemm_phase<pg8::EpiBf16, pg8::StaticOrder, GEMM_ALIGN, GEMM_SP2>(C.lds, g, S, E, C.tid);
            if (!isq) alow_phase(C, Hb, (const bf16*)(wsb + WS_WTIN) + (size_t)l * WTIN_L + (size_t)NPROJ * D, ALOW);
#ifdef DBG_DUP_ALOW
            if (!isq) { alow_phase(C, Hb, (const bf16*)(wsb + WS_WTIN) + (size_t)l * WTIN_L + (size_t)NPROJ * D, ALOW); alow_phase(C, Hb, (const bf16*)(wsb + WS_WTIN) + (size_t)l * WTIN_L + (size_t)NPROJ * D, ALOW); }
#endif
        }
        else if (kind == 1 && EN(3)) {
            MKCTX;
            glaA_phase(C, l, PROJ, ALOW, SBUF, DEC);
            gmlp_phase(C, l, PROJ, (const bf16*)(wsb + WS_WSB), CONCAT);
        }
        else if (kind == 2) { if (EN(4)) { MKCTX; scan_phase(C, SBUF, DEC); } }
        else if (kind == 3 && EN(5)) { MKCTX; glaC_phase(C, l, PROJ, ALOW, SBUF, CONCAT); }
        else if (kind == 4 && EN(6)) {
            MKCTX;
            pg8::Gemm g{CONCAT, (const bf16*)(wsb + WS_WTOUT) + (size_t)l * D * D, T, D, D};
            pg8::StaticOrder S; S.init(T, D, C.G, C.bid);
            pg8::EpiResGate E{l == 0 ? KARG(I_X) : (const float*)X, X, modl + 2 * D, MODW};
            pg8::gemm_phase<pg8::EpiResGate, pg8::StaticOrder, GEMM_ALIGN, GEMM_SP2>(C.lds, g, S, E, C.tid);
        }
        else if (kind == 5) { if (EN(1)) { MKCTX; norm_phase<true>(C, X, KARG(I_N2G) + (size_t)l * D, modl, 3 * D, 4 * D, Hb, wsb + WS_H8, (float*)(wsb + WS_HS), (int*)(wsb + WS_COEF)); } }
        else if (kind == 7) { if (EN(7)) { MKCTX; topk_phase(C, l, QB, (const bf16*)(wsb + WS_K1B), (const bf16*)(wsb + WS_K2B), (const int*)(wsb + WS_KU) + l * NEXP, (const int*)(wsb + WS_KV) + l * NEXP, EB, PG); } }
#ifdef DBG_FAKE_U
        else if (kind == 8) { if (EN(8)) { MKCTX; const int fake = (repflag == 0); peerU_phase(C, wsb + WS_H8, (const float*)(wsb + WS_HS), EB, wsb + WS_PUB + (size_t)l * NEXP * D, (const float*)(wsb + WS_SU) + (size_t)l * 8 * NEXP, fake ? (int*)(wsb + WS_END) : (int*)(wsb + WS_COEF), fake ? (DBG_FAKE_U) : 0xFFFF); } }
#else
        else if (kind == 8) { if (EN(8)) { MKCTX; peerU_phase(C, wsb + WS_H8, (const float*)(wsb + WS_HS), EB, wsb + WS_PUB + (size_t)l * NEXP * D, (const float*)(wsb + WS_SU) + (size_t)l * 8 * NEXP, (int*)(wsb + WS_COEF)); } }
#endif
#ifdef DBG_FAKE_V
        else if (kind == 9) { if (EN(9)) { MKCTX; const int fake = (repflag == 0); peerV_phase(C, EB, PG, (const int*)(wsb + WS_COEF), (const fp8_t*)(wsb + WS_PVB) + (size_t)l * NEXP * D, X, modl + 5 * D, fake ? (DBG_FAKE_V) : 0x3FFF, fake ? (long)((float*)(wsb + WS_END) - X) : 0L); } }
#else
        else if (kind == 9) { if (EN(9)) { MKCTX; peerV_phase(C, EB, PG, (const int*)(wsb + WS_COEF), (const fp8_t*)(wsb + WS_PVB) + (size_t)l * NEXP * D, X, modl + 5 * D); } }
#endif
        else if (EN(10)) {
            MKCTX;
            if (l == DEPTH - 1) final_norm_phase(C, X, KARG(I_FG));
            else norm_phase(C, X, KARG(I_N1G) + (size_t)(l + 1) * D, MOD + (size_t)(l + 1) * 4 * MODW, 0, D, Hb);
        }
        if (ph + 1 < args.ph_hi) xcd_barrier(bar);
#ifdef DBG_EXTRA_BAR
        if (ph + 1 < args.ph_hi) { xcd_barrier(bar); xcd_barrier(bar); }
#endif
#ifdef DBG_REP_MASK
        { const int bit = ph < 2 ? ph : 2 + kind; bool want = ((DBG_REP_MASK) >> bit) & 1;
#ifdef DBG_REP_L0
          if (l != 0) want = false;
#endif
          if (want && !repflag) { repflag = 1; --ph; } else repflag = 0; }
#endif
    }
}

extern "C" void kernel_launch(void* const* d_in, const int* in_sizes, int n_in, void* d_out, int out_size, void* d_ws, size_t ws_size, hipStream_t stream) {
    static int grid = 0;
    if (grid == 0) {
        if (n_in != 21 || out_size != T * D || ws_size < WS_END) { fprintf(stderr, "kernel_launch: unexpected shapes (n_in %d, out %d, ws %zu)\n", n_in, out_size, ws_size); grid = -1; return; }
        int dev = 0, cus = 0, per_cu = 0;
        if (hipGetDevice(&dev) != hipSuccess || hipDeviceGetAttribute(&cus, hipDeviceAttributeMultiprocessorCount, dev) != hipSuccess) { grid = -1; return; }
        if (hipFuncSetAttribute((const void*)mk_fwd, hipFuncAttributeMaxDynamicSharedMemorySize, LDS_BYTES) != hipSuccess) { fprintf(stderr, "kernel_launch: hipFuncSetAttribute failed\n"); grid = -1; return; }
        if (hipOccupancyMaxActiveBlocksPerMultiprocessor(&per_cu, (const void*)mk_fwd, NTHR, LDS_BYTES) != hipSuccess || per_cu < 1) { fprintf(stderr, "kernel_launch: occupancy query says %d blocks per CU\n", per_cu); (void)hipGetLastError(); grid = -1; return; }
        if (cus != 256) { fprintf(stderr, "kernel_launch: built for a 256-CU device (got %d)\n", cus); grid = -1; return; }
        grid = cus;
    }
    if (grid < 0) return;
    (void)hipMemsetAsync((char*)d_ws + WS_CTL, 0, CTL_ZERO_BYTES, stream);
    Args a{};
    for (int i = 0; i < 21; ++i) a.in[i] = (const float*)d_in[i];
    a.out = (float*)d_out; a.ws = (unsigned char*)d_ws;
#if MK_N_LAUNCHES == 1
    a.ph_lo = 0; a.ph_hi = NPH;
    hipLaunchKernelGGL(mk_fwd, dim3(grid), dim3(NTHR), LDS_BYTES, stream, a);
#else
    for (int p = 0; p < NPH; ++p) { a.ph_lo = p; a.ph_hi = p + 1; hipLaunchKernelGGL(mk_fwd, dim3(grid), dim3(NTHR), LDS_BYTES, stream, a); }
#endif
}
```

```cpp
#include <hip/hip_runtime.h>
#include <cstdio>
#include <cstdint>
#ifndef MK_N_LAUNCHES
#define MK_N_LAUNCHES 1
#endif
namespace pg8 {
#define PG8_LAS __attribute__((address_space(3)))
typedef unsigned short bf16_t;
typedef short bf16x8 __attribute__((ext_vector_type(8)));
typedef float f32x4 __attribute__((ext_vector_type(4)));
typedef unsigned u32x4 __attribute__((ext_vector_type(4)));
constexpr int BM = 256, BK = 64, HALF = 128, HTB = HALF * BK * 2  , STAGE_BYTES = 8 * HTB, NXCD = 8, WGM = 8;

__host__ __device__ __forceinline__ int lds_byte(int r, int c) { const int st = (r >> 4) * 2 + (c >> 5), rr = r & 15, cc = c & 31, ob = rr * 64 + cc * 2; return st * 1024 + (ob ^ (((ob >> 9) & 1) << 5)); }
__host__ __device__ __forceinline__ void stage_rc(int b, int& R, int& C) { const int st = b / 1024, sb = b % 1024, swz = sb ^ (((sb >> 9) & 1) << 5); R = (st >> 1) * 16 + swz / 64; C = (st & 1) * 32 + (swz % 64) / 2; }
__host__ __device__ __forceinline__ int perm32(int rho) { const int n = rho >> 4, i = rho & 15; return 8 * (i >> 2) + 4 * n + (i & 3); }

struct Unit { int pm, pn; };
struct Gemm { const bf16_t* A; const bf16_t* Bt; int M, N, K; };

struct StaticOrder {
    int nM, nN, nwg, G, c;
    __host__ __device__ void init(int M, int N, int G_, int c_) { nM = M / BM; nN = N / BM; nwg = nM * nN; G = G_; c = c_; }
    __host__ __device__ bool next(int i, Unit& u) const {
        const long L = (long)i * G + c; if (L >= nwg) return false;
        int wgid = (int)L; { const int q = nwg / NXCD, r = nwg % NXCD, xcd = wgid % NXCD, off = wgid / NXCD; wgid = (xcd < r ? xcd * (q + 1) : r * (q + 1) + (xcd - r) * q) + off; }
        const int nig = WGM * nN, gid = wgid / nig, fm = gid * WGM, gsz = (nM - fm) < WGM ? (nM - fm) : WGM;
        u.pm = fm + ((wgid % nig) % gsz); u.pn = (wgid % nig) / gsz; return true;
    }
    __device__ __forceinline__ void a_ready(const Unit&) const {}
    __device__ __forceinline__ void done(const Unit&) const {}
};
__device__ __forceinline__ unsigned cvt_pk_bf16(float lo, float hi) { unsigned r; asm volatile("v_cvt_pk_bf16_f32 %0, %1, %2" : "=v"(r) : "v"(lo), "v"(hi)); return r; }
struct EpiBf16 {
    static constexpr bool PERM = true, AFTER_DRAIN = false;
    bf16_t* O; int ldc;
    __device__ __forceinline__ void operator()(const f32x4 (&acc)[2][2][4][2], const Unit& u, int wr, int wc, int fr, int fq) const {
        const int row0 = u.pm * BM + wr * 64 + fr; const int col0 = u.pn * BM + wc * 32 + 8 * fq;
#pragma unroll
        for (int ai = 0; ai < 2; ++ai)
#pragma unroll
            for (int m = 0; m < 4; ++m) { bf16_t* rowp = O + (size_t)(row0 + ai * HALF + m * 16) * ldc + col0;
#pragma unroll
                for (int bj = 0; bj < 2; ++bj) { const f32x4 v0 = acc[ai][bj][m][0], v1 = acc[ai][bj][m][1];
                    u32x4 w; w.x = cvt_pk_bf16(v0[0], v0[1]); w.y = cvt_pk_bf16(v0[2], v0[3]); w.z = cvt_pk_bf16(v1[0], v1[1]); w.w = cvt_pk_bf16(v1[2], v1[3]);
                    *(u32x4*)(rowp + bj * HALF) = w; } }
    }
};
struct EpiResGate {
    static constexpr bool PERM = false, AFTER_DRAIN = false;
    const float* base; float* out; const float* gate; int gpitch;
    __device__ __forceinline__ void operator()(const f32x4 (&acc)[2][2][4][2], const Unit& u, int wr, int wc, int fr, int fq) const {
        const int row0 = u.pm * BM + wr * 64 + fr, col0 = u.pn * BM + wc * 32 + 4 * fq;
        const float* gp = gate + (size_t)(u.pm >> 4) * gpitch + col0;
        f32x4 gv[2][2];
#pragma unroll
        for (int bj = 0; bj < 2; ++bj)
#pragma unroll
            for (int n = 0; n < 2; ++n) gv[bj][n] = *(const f32x4*)(gp + bj * HALF + n * 16);
        f32x4 bs[4][2][2];
#define ERG_OFF(G_) ((size_t)(row0 + ((G_) >> 2) * HALF + ((G_) & 3) * 16) * 2048 + col0)
#define ERG_LOAD(G_) do { _Pragma("unroll") for (int bj = 0; bj < 2; ++bj) _Pragma("unroll") for (int n = 0; n < 2; ++n) bs[(G_) & 3][bj][n] = *(const f32x4*)(base + ERG_OFF(G_) + bj * HALF + n * 16); } while (0)
        ERG_LOAD(0); ERG_LOAD(1); ERG_LOAD(2); ERG_LOAD(3);
#pragma unroll
        for (int gq = 0; gq < 8; ++gq) {
#pragma unroll
            for (int bj = 0; bj < 2; ++bj)
#pragma unroll
                for (int n = 0; n < 2; ++n) *(f32x4*)(out + ERG_OFF(gq) + bj * HALF + n * 16) = bs[gq & 3][bj][n] + gv[bj][n] * acc[gq >> 2][bj][gq & 3][n];
            asm volatile("" ::: "memory");
            if (gq + 4 < 8) ERG_LOAD(gq + 4);
            asm volatile("" ::: "memory"); }
#undef ERG_OFF
#undef ERG_LOAD
    }
};

template <class Epi, class Sched, bool ALIGN_EPI = false, bool SP2 = false>
__device__ __forceinline__ void gemm_phase(PG8_LAS unsigned char* lds, const Gemm g, const Sched& S, const Epi& E, const int tid  ) {
    const int wid = __builtin_amdgcn_readfirstlane(tid >> 6), lane = tid & 63, wr = wid >> 2, wc = wid & 3, fr = lane & 15, fq = lane >> 4;
    const int K = g.K, nt = K / BK;
    unsigned voffA[2], voffB[2];
#pragma unroll
    for (int i = 0; i < 2; ++i) { int R, C; stage_rc(tid * 16 + i * 8192, R, C); const int Rb = Epi::PERM ? ((R & ~31) + perm32(R & 31)) : R;
        voffA[i] = (unsigned)(R * K + C) * 2u; voffB[i] = (unsigned)(Rb * K + C) * 2u; }
    const size_t kstep = (size_t)(BK * 2);
    const size_t hstep = (size_t)HALF * K * 2;
    const size_t tstep = 2 * hstep;
    const unsigned ldsw = (unsigned)wid * 1024u;
    const int aoff = lds_byte(wr * 64 + fr, fq * 8), boff = lds_byte(wc * 32 + fr, fq * 8);
#define PG8_SA(b, h) (((b) * 2 + (h)) * HTB)
#define PG8_SB(b, h) ((4 + (b) * 2 + (h)) * HTB)
#define PG8_STAGE(bufoff, gbase, voff) do { _Pragma("unroll") for (int _i = 0; _i < 2; ++_i) \
        __builtin_amdgcn_global_load_lds((const unsigned*)((const char*)(gbase) + (voff)[_i]), (PG8_LAS unsigned*)(lds + (bufoff) + ldsw + _i * 8192), 16, 0, 0); } while (0)
#define PG8_LDA(dst, b, h) do { _Pragma("unroll") for (int m = 0; m < 4; ++m) _Pragma("unroll") for (int k = 0; k < 2; ++k) dst[m][k] = *(const PG8_LAS bf16x8*)(lds + PG8_SA(b, h) + aoff + m * 2048 + k * 1024); } while (0)
#define PG8_LDB(dst, b, h) do { _Pragma("unroll") for (int n = 0; n < 2; ++n) _Pragma("unroll") for (int k = 0; k < 2; ++k) dst[n][k] = *(const PG8_LAS bf16x8*)(lds + PG8_SB(b, h) + boff + n * 2048 + k * 1024); } while (0)
#define PG8_MMA(ai, bj, At, Bt) do { __builtin_amdgcn_s_setprio(1); _Pragma("unroll") for (int m = 0; m < 4; ++m) _Pragma("unroll") for (int n = 0; n < 2; ++n) _Pragma("unroll") for (int k = 0; k < 2; ++k) \
        acc[ai][bj][m][n] = __builtin_amdgcn_mfma_f32_16x16x32_bf16(Bt[n][k], At[m][k], acc[ai][bj][m][n], 0, 0, 0); __builtin_amdgcn_s_setprio(0); } while (0)
#define PG8_WAIT_V(n) asm volatile("s_waitcnt vmcnt(" #n ")" ::: "memory")
#define PG8_WAIT_L(n) asm volatile("s_waitcnt lgkmcnt(" #n ")" ::: "memory")
#define PG8_BAR __builtin_amdgcn_s_barrier()
#define PG8_SCHED __builtin_amdgcn_sched_barrier(0)
    Unit cur, nxt; int ui = 0;
    if (!S.next(0, cur)) return;
    f32x4 acc[2][2][4][2];
#pragma unroll
    for (int a = 0; a < 2; ++a)
#pragma unroll
        for (int b = 0; b < 2; ++b)
#pragma unroll
            for (int m = 0; m < 4; ++m)
#pragma unroll
                for (int n = 0; n < 2; ++n) acc[a][b][m][n] = (f32x4){0.f, 0.f, 0.f, 0.f};
    bf16x8 At[4][2], B0[2][2], B1[2][2];
    const char* cA = (const char*)g.A + (size_t)cur.pm * tstep; const char* cB = (const char*)g.Bt + (size_t)cur.pn * tstep;
    S.a_ready(cur);
    if constexpr (SP2) {
        PG8_STAGE(PG8_SB(0, 0), cB, voffB); PG8_STAGE(PG8_SB(0, 1), cB + hstep, voffB); PG8_STAGE(PG8_SA(0, 0), cA, voffA); PG8_STAGE(PG8_SA(0, 1), cA + hstep, voffA);
        if (wr == 1) PG8_BAR;
        PG8_WAIT_V(2); PG8_BAR;
        PG8_STAGE(PG8_SB(1, 0), cB + kstep, voffB); PG8_STAGE(PG8_SA(1, 0), cA + kstep, voffA); PG8_STAGE(PG8_SB(1, 1), cB + hstep + kstep, voffB);
        PG8_WAIT_V(6); PG8_BAR;
    } else {
        PG8_STAGE(PG8_SB(0, 0), cB, voffB); PG8_STAGE(PG8_SA(0, 0), cA, voffA); PG8_STAGE(PG8_SB(0, 1), cB + hstep, voffB); PG8_STAGE(PG8_SA(0, 1), cA + hstep, voffA);
        if (wr == 1) PG8_BAR;
        PG8_WAIT_V(4); PG8_BAR;
        PG8_STAGE(PG8_SB(1, 0), cB + kstep, voffB); PG8_STAGE(PG8_SA(1, 0), cA + kstep, voffA); PG8_STAGE(PG8_SB(1, 1), cB + hstep + kstep, voffB);
        PG8_WAIT_V(6); PG8_BAR;
    }
    for (;;) {
        const bool has_next = S.next(ui + 1, nxt);
        const char* nA = has_next ? (const char*)g.A + (size_t)nxt.pm * tstep : cA; const char* nB = has_next ? (const char*)g.Bt + (size_t)nxt.pn * tstep : cB;
        for (int t = 0; t < nt; t += 2) {
            const bool last = (t == nt - 2);
            const char* a1 = cA + (size_t)(t + 1) * kstep;
            const char* a2 = last ? nA : cA + (size_t)(t + 2) * kstep; const char* b2 = last ? nB : cB + (size_t)(t + 2) * kstep;
            const char* a3 = a2 + kstep; const char* b3 = b2 + kstep;
            if (last && has_next) S.a_ready(nxt);
            if constexpr (SP2) {
            PG8_LDB(B0, 0, 0); PG8_LDB(B1, 0, 1); PG8_SCHED; PG8_LDA(At, 0, 0); PG8_STAGE(PG8_SA(1, 1), a1 + hstep, voffA);
            PG8_WAIT_V(8); PG8_WAIT_L(0); PG8_BAR; PG8_MMA(0, 0, At, B0); PG8_MMA(0, 1, At, B1); PG8_BAR; PG8_SCHED;
            PG8_LDA(At, 0, 1); PG8_STAGE(PG8_SB(0, 0), b2, voffB); PG8_STAGE(PG8_SB(0, 1), b2 + hstep, voffB); PG8_STAGE(PG8_SA(0, 0), a2, voffA);
            PG8_WAIT_V(8); PG8_WAIT_L(0); PG8_BAR; PG8_MMA(1, 0, At, B0); PG8_MMA(1, 1, At, B1); PG8_BAR; PG8_SCHED;
            PG8_LDB(B0, 1, 0); PG8_LDB(B1, 1, 1); PG8_SCHED; PG8_LDA(At, 1, 0); PG8_STAGE(PG8_SA(0, 1), a2 + hstep, voffA);
            PG8_WAIT_V(8); PG8_WAIT_L(0); PG8_BAR; PG8_MMA(0, 0, At, B0); PG8_MMA(0, 1, At, B1); PG8_BAR; PG8_SCHED;
            PG8_LDA(At, 1, 1); PG8_STAGE(PG8_SB(1, 0), b3, voffB); PG8_STAGE(PG8_SB(1, 1), b3 + hstep, voffB); PG8_STAGE(PG8_SA(1, 0), a3, voffA);
            PG8_WAIT_V(8); PG8_WAIT_L(0); PG8_BAR; PG8_MMA(1, 0, At, B0); PG8_MMA(1, 1, At, B1); PG8_BAR; PG8_SCHED;
            } else {
            PG8_LDB(B0, 0, 0); PG8_SCHED; PG8_LDA(At, 0, 0); PG8_STAGE(PG8_SA(1, 1), a1 + hstep, voffA);
            PG8_WAIT_L(8); PG8_BAR; PG8_WAIT_L(0); PG8_MMA(0, 0, At, B0); PG8_BAR; PG8_SCHED;
            PG8_LDB(B1, 0, 1); PG8_STAGE(PG8_SB(0, 0), b2, voffB);
            PG8_BAR; PG8_WAIT_L(0); PG8_MMA(0, 1, At, B1); PG8_BAR;
            PG8_LDA(At, 0, 1); PG8_STAGE(PG8_SA(0, 0), a2, voffA);
            PG8_BAR; PG8_WAIT_L(0); PG8_MMA(1, 0, At, B0); PG8_BAR; PG8_SCHED;
            PG8_STAGE(PG8_SB(0, 1), b2 + hstep, voffB);
            PG8_WAIT_V(6); PG8_BAR; PG8_MMA(1, 1, At, B1); PG8_BAR;
            PG8_LDB(B0, 1, 0); PG8_SCHED; PG8_LDA(At, 1, 0); PG8_STAGE(PG8_SA(0, 1), a2 + hstep, voffA);
            PG8_WAIT_L(8); PG8_BAR; PG8_WAIT_L(0); PG8_MMA(0, 0, At, B0); PG8_BAR; PG8_SCHED;
            PG8_LDB(B1, 1, 1); PG8_STAGE(PG8_SB(1, 0), b3, voffB);
            PG8_BAR; PG8_WAIT_L(0); PG8_MMA(0, 1, At, B1); PG8_BAR;
            PG8_LDA(At, 1, 1); PG8_STAGE(PG8_SA(1, 0), a3, voffA);
            PG8_BAR; PG8_WAIT_L(0); PG8_MMA(1, 0, At, B0); PG8_BAR; PG8_SCHED;
            PG8_STAGE(PG8_SB(1, 1), b3 + hstep, voffB);
            PG8_WAIT_V(6); PG8_BAR; PG8_MMA(1, 1, At, B1); PG8_BAR;
            }
        }
        if constexpr (ALIGN_EPI) { if (wr == 0) PG8_BAR; }
        if constexpr (!Epi::AFTER_DRAIN) { E(acc, cur, wr, wc, fr, fq); S.done(cur); }
        if (!has_next) break;
#pragma unroll
        for (int a = 0; a < 2; ++a)
#pragma unroll
            for (int b = 0; b < 2; ++b)
#pragma unroll
                for (int m = 0; m < 4; ++m)
#pragma unroll
                    for (int n = 0; n < 2; ++n) acc[a][b][m][n] = (f32x4){0.f, 0.f, 0.f, 0.f};
        cur = nxt; cA = nA; cB = nB; ++ui;
        if constexpr (ALIGN_EPI) { if (wr == 1) PG8_BAR; }
    }
    PG8_WAIT_V(0);
    if constexpr (!ALIGN_EPI) { if (wr == 0) PG8_BAR; }
    PG8_BAR;
    if constexpr (Epi::AFTER_DRAIN) { E.fused(acc, cur, wr, wc, fr, fq, lds, wid, lane); S.done(cur); }
#undef PG8_SA
#undef PG8_SB
#undef PG8_STAGE
#undef PG8_LDA
#undef PG8_LDB
#undef PG8_MMA
#undef PG8_WAIT_V
#undef PG8_WAIT_L
#undef PG8_BAR
#undef PG8_SCHED
}
}
constexpr int NWAVES = 8, NTHR = 512;
constexpr int D = 2048, NBATCH = 4, SEQ = 4096, T = NBATCH * SEQ, DEPTH = 2;
constexpr int GLA_H = 4, GLA_DK = 128, GLA_DV = 256, GLA_CH = 64;
constexpr int MLP_H = 8, MLP_DH = 128, MLP_CH = 128;
constexpr int IN_COLS = 5136, NPROJ = 5120;
constexpr int C_Q = 0, C_K = 512, C_V = 1024, C_R = 2048, C_U = 3072, C_VS = 4096;
constexpr int NEXP = 16384, PEER_H = 8;
constexpr float EPS = 1e-6f;
constexpr int MODW = 6 * D;
constexpr size_t MiB = 1u << 20;
constexpr size_t WS_CTL = 0, CTL_ZERO_BYTES = 1 * MiB;
constexpr size_t WS_MOD = 1 * MiB;
constexpr size_t WS_K1B = 2 * MiB, WS_K2B = 2 * MiB + 512 * 1024, WS_WSB = 3 * MiB, WS_DEC = 3 * MiB + 512 * 1024, WS_ALOW = 4 * MiB;
constexpr size_t WS_KU = 5 * MiB, WS_KV = 5 * MiB + 256 * 1024;
constexpr size_t WS_SU = 6 * MiB, WS_HS = 7 * MiB;
constexpr size_t WS_WTIN = 8 * MiB;
constexpr size_t WTIN_L = (size_t)5136 * 2048;
constexpr size_t WS_WTOUT = 49 * MiB, WS_WTQ = 65 * MiB;
constexpr size_t WS_PUB = 81 * MiB, WS_PVB = 209 * MiB;
constexpr size_t WS_H = 337 * MiB;
constexpr size_t WS_PROJ = 401 * MiB;
constexpr size_t WS_SBUF = 561 * MiB;
constexpr size_t WS_CONCAT = 625 * MiB;
constexpr size_t WS_QB = 689 * MiB;
constexpr size_t WS_EB = 753 * MiB, WS_PG = 761 * MiB;
constexpr size_t WS_H8 = 769 * MiB, WS_COEF = 833 * MiB, WS_END = 841 * MiB;
static_assert(WS_WTIN + 2 * WTIN_L * 2 <= WS_WTOUT, "ws map");
constexpr int CW_BAR = 4096;
constexpr int RING_BYTES = 131072, LDSCTL_OFF = RING_BYTES, MISC_OFF = LDSCTL_OFF + 320, LDS_BYTES = 147456;

#define DI __device__ __forceinline__
#define LAS __attribute__((address_space(3)))
typedef unsigned short bf16;
typedef short bf16x8 __attribute__((ext_vector_type(8)));
typedef short s16x4 __attribute__((ext_vector_type(4)));
typedef short v4i16_t __attribute__((ext_vector_type(4)));
typedef __bf16 bf16x2_t __attribute__((ext_vector_type(2)));
typedef float f32x2_e __attribute__((ext_vector_type(2)));
typedef float f32x4 __attribute__((ext_vector_type(4)));
typedef float f32x2 __attribute__((ext_vector_type(2)));
typedef unsigned u32x4 __attribute__((ext_vector_type(4)));
typedef unsigned u32x2 __attribute__((ext_vector_type(2)));
typedef LAS unsigned char* ldsp;

DI unsigned pk2(float lo, float hi) { const f32x2_e v = {lo, hi}; return __builtin_bit_cast(unsigned, __builtin_convertvector(v, bf16x2_t)); }
DI unsigned f2bf(float f) { return pk2(f, 0.f) & 0xffffu; }
DI float bflo(unsigned u) { return __builtin_bit_cast(float, u << 16); }
DI float bfhi(unsigned u) { return __builtin_bit_cast(float, u & 0xffff0000u); }
DI float bf1(bf16 v) { return __builtin_bit_cast(float, ((unsigned)v) << 16); }
DI float fexp2(float x) { return __builtin_amdgcn_exp2f(x); }
DI float flog2(float x) { return __builtin_amdgcn_logf(x); }
DI float frcp(float x) { return __builtin_amdgcn_rcpf(x); }
DI float frsq(float x) { return __builtin_amdgcn_rsqf(x); }
DI float gelu_t(float x) { const float u = 0.7978845608f * (x + 0.044715f * x * x * x); return x * frcp(1.f + fexp2(-2.885390082f * u)); }
DI float silu_f(float x) { return x * frcp(1.f + fexp2(-1.442695041f * x)); }
template <int CTRL> DI float dppf(float v) { return __builtin_bit_cast(float, __builtin_amdgcn_update_dpp(0, __builtin_bit_cast(int, v), CTRL, 0xf, 0xf, true)); }
DI float wave_sum_u(float v) {
    v += dppf<0xB1>(v); v += dppf<0x4E>(v); v += dppf<0x141>(v); v += dppf<0x140>(v);
    const int iv = __builtin_bit_cast(int, v);
    return (__builtin_bit_cast(float, __builtin_amdgcn_readlane(iv, 0)) + __builtin_bit_cast(float, __builtin_amdgcn_readlane(iv, 16))) +
           (__builtin_bit_cast(float, __builtin_amdgcn_readlane(iv, 32)) + __builtin_bit_cast(float, __builtin_amdgcn_readlane(iv, 48)));
}
DI float wave_sum(float v) {
#pragma unroll
    for (int o = 1; o < 64; o <<= 1) v += __shfl_xor(v, o);
    return v;
}
DI float dot2bf(unsigned a, unsigned b, float c) { return __builtin_amdgcn_fdot2_f32_bf16(__builtin_bit_cast(bf16x2_t, a), __builtin_bit_cast(bf16x2_t, b), c, false); }
DI f32x4 mfma16(bf16x8 a, bf16x8 b, f32x4 c) { return __builtin_amdgcn_mfma_f32_16x16x32_bf16(a, b, c, 0, 0, 0); }
DI s16x4 tr4(const LAS bf16* p) { return __builtin_bit_cast(s16x4, __builtin_amdgcn_ds_read_tr16_b64_v4i16((LAS v4i16_t*)p)); }
DI bf16x8 tr8(const LAS bf16* p, int stride) { const s16x4 a = tr4(p), b = tr4(p + 4 * stride); return (bf16x8){a[0], a[1], a[2], a[3], b[0], b[1], b[2], b[3]}; }

#define XB_TMO      128
#define XB_XCNT(j)  (256  + 64 * (j))
#define XB_XSUB(j)  (1280 + 64 * (j))
#define XB_XGEN(j)  (2304 + 64 * (j))
#define XB_TOP      3328
#define XB_TOPGEN   3392
#define XCD_BAR_WORDS 3456
#define XB_SPIN_CAP (1u << 18)

__device__ __forceinline__ unsigned xb_ld(unsigned* p)              { return __hip_atomic_load(p, __ATOMIC_RELAXED, __HIP_MEMORY_SCOPE_AGENT); }
__device__ __forceinline__ unsigned xb_add(unsigned* p, unsigned v) { return __hip_atomic_fetch_add(p, v, __ATOMIC_RELAXED, __HIP_MEMORY_SCOPE_AGENT); }
__device__ __forceinline__ unsigned xb_xcc_id() { return (unsigned)__builtin_amdgcn_s_getreg((3 << 11) | 20) & 0xFu; }
#define XB_SPIN(cond, bar) do { unsigned _sp = 0; while (cond) { __builtin_amdgcn_s_sleep(1); \
    if ((++_sp & 255u) == 0u) { if (xb_ld(&(bar)[XB_TMO])) break; if (_sp > XB_SPIN_CAP) { atomicAdd(&(bar)[XB_TMO], 1u); break; } } } } while (0)

struct XcdBarrier {
    unsigned* bar; unsigned x;
    volatile LAS unsigned* st;
};

__device__ __forceinline__ XcdBarrier xcd_barrier_post(unsigned* bar, volatile LAS unsigned* st) {
    XcdBarrier b; b.bar = bar; b.x = xb_xcc_id(); b.st = st;
    if (threadIdx.x == 0) (void)xb_add(&bar[XB_XCNT(b.x)], 1u);
    return b;
}
__device__ __forceinline__ void xcd_barrier_complete(unsigned* bar, unsigned x, unsigned& nloc, unsigned& nx) {
    const unsigned G = gridDim.x * gridDim.y * gridDim.z;
    unsigned sum, cnt, mine, sp = 0u;
    for (;;) {
        sum = 0u; cnt = 0u; mine = 0u;
#pragma unroll
        for (unsigned j = 0; j < 16; ++j) { const unsigned c = xb_ld(&bar[XB_XCNT(j)]); sum += c; cnt += (c > 0u) ? 1u : 0u; mine = (j == x) ? c : mine; }
        if (sum == G) break;
        __builtin_amdgcn_s_sleep(1);
        if ((++sp & 255u) == 0u) { if (xb_ld(&bar[XB_TMO])) break; if (sp > XB_SPIN_CAP) { atomicAdd(&bar[XB_TMO], 1u); break; } }
    }
    nloc = mine > 0u ? mine : 1u; nx = cnt > 0u ? cnt : 1u;
}

__device__ __forceinline__ void xcd_barrier(const XcdBarrier& b) {
    asm volatile("s_waitcnt vmcnt(0)" ::: "memory");
    __syncthreads();
    if (threadIdx.x == 0) {
        unsigned* bar = b.bar;
        __builtin_amdgcn_s_waitcnt(0);
        unsigned nloc = b.st[0], nx = b.st[1];
        if (nloc == 0u) { xcd_barrier_complete(bar, b.x, nloc, nx); b.st[0] = nloc; b.st[1] = nx; }
        const unsigned old = xb_add(&bar[XB_XSUB(b.x)], 1u);
        const unsigned gen = old / nloc;
        if (old + 1u == (gen + 1u) * nloc) {
            __builtin_amdgcn_fence(__ATOMIC_RELEASE, "agent");
            asm volatile("s_waitcnt vmcnt(0)" ::: "memory");
            const unsigned og = xb_add(&bar[XB_TOP], 1u);
            const unsigned tg = og / nx;
            if (og + 1u == (tg + 1u) * nx) xb_add(&bar[XB_TOPGEN], 1u);
            else XB_SPIN(xb_ld(&bar[XB_TOPGEN]) == tg, bar);
            __builtin_amdgcn_fence(__ATOMIC_ACQUIRE, "agent");
            xb_add(&bar[XB_XGEN(b.x)], 1u);
            asm volatile("s_waitcnt vmcnt(0)" ::: "memory");
        } else {
            XB_SPIN(xb_ld(&bar[XB_XGEN(b.x)]) == gen, bar);
            __builtin_amdgcn_fence(__ATOMIC_ACQUIRE, "agent");
            asm volatile("s_waitcnt vmcnt(0)" ::: "memory");
        }
    }
    __syncthreads();
}
struct Ctx {
    ldsp lds; int tid, lane, wave, bid, G, gw, NGW;
    unsigned char* ws;
};
DI const float* KARG(int k) { asm volatile("" : "+s"(k)); return ((const float* const*)__builtin_amdgcn_kernarg_segment_ptr())[k]; }
#define LDS_WAIT() asm volatile("s_waitcnt lgkmcnt(0)" ::: "memory")
enum { I_X = 0, I_C, I_ADAW, I_ADAB, I_N1G, I_WIN, I_WA2, I_BA, I_GNG, I_VNG, I_MWS, I_MB, I_MOG, I_WOUT, I_N2G, I_WQ, I_K1, I_K2, I_PU, I_PV, I_FG };

DI void p0_ada(const Ctx& C) {
    LAS float* red = (LAS float*)C.lds;
    float* MOD = (float*)(C.ws + WS_MOD);
    for (int it = C.bid; it < 192; it += C.G) {
        const int l = it / 96, cg = it % 96, c0 = cg * 128 + C.lane * 2;
        const float* W = KARG(I_ADAW) + (size_t)l * D * MODW + (size_t)(C.wave * 256) * MODW + c0;
        float cv[4][4];
#pragma unroll
        for (int b = 0; b < 4; ++b)
#pragma unroll
            for (int i = 0; i < 4; ++i) cv[b][i] = silu_f(KARG(I_C)[b * D + C.wave * 256 + i * 64 + C.lane]);
        float acc[4][2];
#pragma unroll
        for (int b = 0; b < 4; ++b) { acc[b][0] = 0.f; acc[b][1] = 0.f; }
#pragma unroll
        for (int i = 0; i < 4; ++i) {
#pragma unroll 16
            for (int j = 0; j < 64; ++j) {
                const f32x2 w = *(const f32x2*)(W + (size_t)(i * 64 + j) * MODW);
#pragma unroll
                for (int b = 0; b < 4; ++b) { const float s = __builtin_bit_cast(float, __builtin_amdgcn_readlane(__builtin_bit_cast(int, cv[b][i]), j)); acc[b][0] += s * w.x; acc[b][1] += s * w.y; }
            }
        }
#pragma unroll
        for (int b = 0; b < 4; ++b) *(LAS f32x2*)(red + (C.wave * 4 + b) * 128 + C.lane * 2) = (f32x2){acc[b][0], acc[b][1]};
        __syncthreads();
        { const int b = C.tid >> 7, col = C.tid & 127; float s = KARG(I_ADAB)[l * MODW + cg * 128 + col];
#pragma unroll
          for (int w = 0; w < 8; ++w) s += red[(w * 4 + b) * 128 + col];
          MOD[(size_t)(l * 4 + b) * MODW + cg * 128 + col] = s; }
        __syncthreads();
    }
}
DI void transpose_item(const float* W, int ldw, int src_col0, int ncols, bf16* WT, int dst_row0, int k0, LAS float* scr, int lane) {
    const int cl = lane & 31;
    float v[32];
#pragma unroll
    for (int i = 0; i < 32; ++i) { const int kk = 2 * i + (lane >> 5); v[i] = 0.f; if (cl < ncols) v[i] = W[(size_t)(k0 + kk) * ldw + src_col0 + cl]; }
#pragma unroll
    for (int i = 0; i < 32; ++i) { const int kk = 2 * i + (lane >> 5); scr[kk * 33 + cl] = v[i]; }
    LDS_WAIT();
    const int c = lane & 7;
#pragma unroll
    for (int j = 0; j < 4; ++j) { const int n = (lane >> 3) + 8 * j;
        if (n < ncols) { const LAS float* s = scr + (8 * c) * 33 + n;
            u32x4 o; o.x = pk2(s[0 * 33], s[1 * 33]); o.y = pk2(s[2 * 33], s[3 * 33]); o.z = pk2(s[4 * 33], s[5 * 33]); o.w = pk2(s[6 * 33], s[7 * 33]);
            *(u32x4*)(WT + (size_t)(dst_row0 + n) * 2048 + k0 + 8 * c) = o; } }
    LDS_WAIT();
}
DI void p0_prologue(const Ctx& C) {
    p0_ada(C);
    LAS float* scr = (LAS float*)(C.lds + C.wave * 16384);
    constexpr int PER_L = (161 + 64 + 64) * 32;
    for (int it = C.gw; it < 2 * PER_L; it += C.NGW) {
        const int l = it / PER_L; int r = it % PER_L;
        if (r < 161 * 32) { const int kb = r / 161, nb = r % 161; bf16* WT = (bf16*)(C.ws + WS_WTIN) + (size_t)l * WTIN_L;
            const float* W = KARG(I_WIN) + (size_t)l * D * IN_COLS;
            if (nb < 160) { const int n0 = 32 * nb; transpose_item(W, IN_COLS, n0 + (n0 >= 3072 ? 16 : 0), 32, WT, n0, 64 * kb, scr, C.lane); }
            else transpose_item(W, IN_COLS, 3072, 16, WT, 5120, 64 * kb, scr, C.lane);
            continue; }
        r -= 161 * 32;
        if (r < 2048) { const int kb = r / 64, nb = r % 64; transpose_item(KARG(I_WOUT) + (size_t)l * D * D, D, 32 * nb, 32, (bf16*)(C.ws + WS_WTOUT) + (size_t)l * D * D, 32 * nb, 64 * kb, scr, C.lane); continue; }
        r -= 2048;
        { const int kb = r / 64, nb = r % 64; transpose_item(KARG(I_WQ) + (size_t)l * D * D, D, 32 * nb, 32, (bf16*)(C.ws + WS_WTQ) + (size_t)l * D * D, 32 * nb, 64 * kb, scr, C.lane); }
    }
    const int gt = C.bid * NTHR + C.tid, NT = C.G * NTHR;
    { bf16* K1B = (bf16*)(C.ws + WS_K1B); bf16* K2B = (bf16*)(C.ws + WS_K2B); bf16* WSB = (bf16*)(C.ws + WS_WSB);
      for (int i = gt; i < 262144; i += NT) { K1B[i] = (bf16)f2bf(KARG(I_K1)[i]); K2B[i] = (bf16)f2bf(KARG(I_K2)[i]);
          const int s = i & 127, t = (i >> 7) & 127; WSB[i] = (s <= t) ? (bf16)f2bf(KARG(I_MWS)[i]) : (bf16)0; } }
    { float* SU = (float*)(C.ws + WS_SU); int* KV = (int*)(C.ws + WS_KV);
#pragma unroll 1
      for (int row = C.gw; row < 4 * NEXP; row += C.NGW) {
          const int tb = row >> 15, rr = row & 32767;
          const f32x4* src = (const f32x4*)(KARG(tb ? I_PV : I_PU) + (size_t)rr * D) + C.lane;
          f32x4 v[8];
#pragma unroll
          for (int j = 0; j < 8; ++j) v[j] = src[64 * j];
          const int lyr = rr >> 14, ee = rr & 16383;
          unsigned* dst = (unsigned*)(C.ws + (tb ? WS_PVB : WS_PUB) + (size_t)lyr * NEXP * D + (size_t)ee * 256) + C.lane;
          if (tb) {
              float mx = 0.f;
#pragma unroll
              for (int j = 0; j < 8; ++j) mx = fmaxf(mx, fmaxf(fmaxf(fabsf(v[j].x), fabsf(v[j].y)), fmaxf(fabsf(v[j].z), fabsf(v[j].w))));
#pragma unroll
              for (int o = 1; o < 64; o <<= 1) mx = fmaxf(mx, __shfl_xor(mx, o));
              int k = 0;
              if (mx > 0.f) { k = (int)((__builtin_bit_cast(unsigned, 224.0f / mx) >> 23) & 255u) - 127; k = k < -60 ? -60 : (k > 60 ? 60 : k); }
              const float sc = __builtin_bit_cast(float, (unsigned)(k + 127) << 23);
#pragma unroll
              for (int j = 0; j < 8; ++j) { int p = 0; p = __builtin_amdgcn_cvt_pk_fp8_f32(v[j].x * sc, v[j].y * sc, p, false); p = __builtin_amdgcn_cvt_pk_fp8_f32(v[j].z * sc, v[j].w * sc, p, true); dst[(size_t)j * (NEXP * 256 / 4)] = (unsigned)p; }
              if (C.lane == 0) KV[rr] = k;
          } else {
#pragma unroll
              for (int j = 0; j < 8; ++j) {
                  float mx = fmaxf(fmaxf(fabsf(v[j].x), fabsf(v[j].y)), fmaxf(fabsf(v[j].z), fabsf(v[j].w)));
#pragma unroll
                  for (int o = 1; o < 64; o <<= 1) mx = fmaxf(mx, __shfl_xor(mx, o));
                  const float inv = mx > 0.f ? 127.0f / mx : 0.f;
                  const int q0 = (int)__builtin_rintf(v[j].x * inv), q1 = (int)__builtin_rintf(v[j].y * inv), q2 = (int)__builtin_rintf(v[j].z * inv), q3 = (int)__builtin_rintf(v[j].w * inv);
                  dst[(size_t)j * (NEXP * 256 / 4)] = (unsigned)(q0 & 255) | ((unsigned)(q1 & 255) << 8) | ((unsigned)(q2 & 255) << 16) | ((unsigned)q3 << 24);
                  if (C.lane == 0) SU[(size_t)(lyr * 8 + j) * NEXP + ee] = mx * (1.0f / 127.0f);
              }
          }
      } }
}
template <bool FP8 = false>
DI void norm_phase(const Ctx& C, const float* X, const float* g, const float* modl, int sh_off, int sc_off, bf16* Hout, unsigned char* H8 = nullptr, float* HS = nullptr, int* COEF = nullptr) {
    const int r0 = C.gw * 8, b = r0 >> 12;
    if (FP8) {
        u32x4* cz = (u32x4*)(COEF + (size_t)r0 * 128) + C.lane;
        unsigned z_ = 0u; asm volatile("" : "+v"(z_));
#pragma unroll
        for (int j = 0; j < 4; ++j) cz[64 * j] = (u32x4){z_, z_, z_, z_}; }
    const f32x4* shp = (const f32x4*)(modl + (size_t)b * MODW + sh_off); const f32x4* scp = (const f32x4*)(modl + (size_t)b * MODW + sc_off);
    f32x4 gm[8], shv[8];
#pragma unroll
    for (int j = 0; j < 8; ++j) { const int idx = 64 * j + C.lane; gm[j] = ((const f32x4*)g)[idx] * (scp[idx] + 1.0f); shv[j] = shp[idx]; }
#pragma unroll 1
    for (int i = 0; i < 8; ++i) {
        const f32x4* xr = (const f32x4*)(X + (size_t)(r0 + i) * D) + C.lane; f32x4 v[8]; float s = 0.f;
#pragma unroll
        for (int j = 0; j < 8; ++j) { v[j] = xr[64 * j]; s += (v[j].x * v[j].x + v[j].y * v[j].y) + (v[j].z * v[j].z + v[j].w * v[j].w); }
        const float rstd = frsq(wave_sum(s) * (1.f / D) + EPS);
        u32x2* o = (u32x2*)(Hout + (size_t)(r0 + i) * D) + C.lane;
        float am = 0.f;
#pragma unroll
        for (int j = 0; j < 8; ++j) { const f32x4 y = v[j] * rstd * gm[j] + shv[j]; u32x2 w; w.x = pk2(y.x, y.y); w.y = pk2(y.z, y.w); o[64 * j] = w;
            if (FP8) { v[j] = y; am = fmaxf(am, fmaxf(fmaxf(fabsf(y.x), fabsf(y.y)), fmaxf(fabsf(y.z), fabsf(y.w)))); } }
        if (FP8) {
#pragma unroll
            for (int of = 1; of < 64; of <<= 1) am = fmaxf(am, __shfl_xor(am, of));
            const float qs = am > 0.f ? 16256.0f / am : 0.f;
            if (C.lane == 0) HS[r0 + i] = am * (1.0f / 16256.0f);
            unsigned* h8 = (unsigned*)(H8 + (size_t)(r0 + i) * 4096) + C.lane;
#pragma unroll
            for (int j = 0; j < 8; ++j) {
                const int q0 = (int)__builtin_rintf(v[j].x * qs), q1 = (int)__builtin_rintf(v[j].y * qs), q2 = (int)__builtin_rintf(v[j].z * qs), q3 = (int)__builtin_rintf(v[j].w * qs);
                const int h0 = (q0 + 64) >> 7, h1 = (q1 + 64) >> 7, h2 = (q2 + 64) >> 7, h3 = (q3 + 64) >> 7;
                const int l0 = q0 - (h0 << 7), l1 = q1 - (h1 << 7), l2 = q2 - (h2 << 7), l3 = q3 - (h3 << 7);
                h8[64 * j] = (unsigned)(h0 & 255) | ((unsigned)(h1 & 255) << 8) | ((unsigned)(h2 & 255) << 16) | ((unsigned)h3 << 24);
                h8[512 + 64 * j] = (unsigned)(l0 & 255) | ((unsigned)(l1 & 255) << 8) | ((unsigned)(l2 & 255) << 16) | ((unsigned)l3 << 24); }
        }
    }
}
DI void alow_phase(const Ctx& C, const bf16* Hb, const bf16* WtA, float* ALOW) {
    const int task = C.bid * 4 + (C.wave & 3), kh = C.wave >> 2, r0 = task * 16, fr = C.lane & 15, fq = C.lane >> 4;
    const bf16* ap = Hb + (size_t)(r0 + fr) * D + 8 * fq + 1024 * kh; const bf16* bp = WtA + (size_t)fr * D + 8 * fq + 1024 * kh;
    f32x4 acc = (f32x4){0.f, 0.f, 0.f, 0.f};
#pragma unroll 8
    for (int ks = 0; ks < 32; ++ks) { const bf16x8 a = *(const bf16x8*)(ap + 32 * ks), b = *(const bf16x8*)(bp + 32 * ks); acc = mfma16(a, b, acc); }
    LAS f32x4* xch = (LAS f32x4*)C.lds + (C.wave & 3) * 64 + C.lane;
    if (kh) *xch = acc;
    LDS_WAIT(); __builtin_amdgcn_s_barrier(); asm volatile("" ::: "memory");
    if (!kh) { acc += *xch;
#pragma unroll
        for (int r = 0; r < 4; ++r) ALOW[(size_t)(r0 + 4 * fq + r) * 16 + fr] = acc[r]; }
}
#define LBAR() do { asm volatile("s_waitcnt lgkmcnt(0)" ::: "memory"); __builtin_amdgcn_s_barrier(); asm volatile("" ::: "memory"); } while (0)
DI void gla_gates(const Ctx& C, LAS float* al, LAS float* tot, const f32x4 alv, const float (&w2)[16], const float bav, float (&Gl)[16], float& off, float& gref, float& g63) {
    const int d = C.tid & 127, jg = C.tid >> 7;
    if (C.tid < 256) ((LAS f32x4*)al)[C.tid] = alv;
    LBAR();
    float run = 0.f;
#pragma unroll
    for (int jj = 0; jj < 16; ++jj) {
        const LAS f32x4* ar = (const LAS f32x4*)(al + (jg * 16 + jj) * 16);
        const f32x4 a0 = ar[0], a1 = ar[1], a2 = ar[2], a3 = ar[3];
        float z = bav;
        z += a0.x * w2[0] + a0.y * w2[1] + a0.z * w2[2] + a0.w * w2[3];
        z += a1.x * w2[4] + a1.y * w2[5] + a1.z * w2[6] + a1.w * w2[7];
        z += a2.x * w2[8] + a2.y * w2[9] + a2.z * w2[10] + a2.w * w2[11];
        z += a3.x * w2[12] + a3.y * w2[13] + a3.z * w2[14] + a3.w * w2[15];
        const float ls = fminf(z, 0.f) - 0.6931471806f * flog2(1.f + fexp2(-1.442695041f * fabsf(z)));
        run += ls * (1.442695041f / 16.f);
        Gl[jj] = run;
    }
    tot[jg * 128 + d] = run;
    LBAR();
    const float t0_ = tot[d], t1_ = tot[128 + d], t2_ = tot[256 + d], t3_ = tot[384 + d];
    off = (jg > 0 ? t0_ : 0.f) + (jg > 1 ? t1_ : 0.f) + (jg > 2 ? t2_ : 0.f); gref = t0_ + t1_; g63 = (t0_ + t1_) + (t2_ + t3_);
}
constexpr int KST = 136, VST = 264, PST = 72;
typedef short s16x2_t __attribute__((ext_vector_type(2)));
struct GlaIn { f32x4 alv; s16x2_t qk[16]; u32x4 vt[4]; };
DI float qk_q(const s16x2_t v) { return __builtin_bit_cast(float, __builtin_bit_cast(unsigned, v) << 16); }
DI float qk_k(const s16x2_t v) { return __builtin_bit_cast(float, __builtin_bit_cast(unsigned, v) & 0xffff0000u); }
template <bool WITHQ, bool WITHV = true>
DI void gla_load(const Ctx& C, int idx, const bf16* PROJ, const float* ALOW, GlaIn& in) {
    const int b = idx >> 8, h = (idx >> 6) & 3, n = idx & 63, t0 = b * SEQ + n * 64, d = C.tid & 127, jg = C.tid >> 7;
    in.alv = (f32x4){0.f, 0.f, 0.f, 0.f};
    if (C.tid < 256) in.alv = ((const f32x4*)(ALOW + (size_t)t0 * 16))[C.tid];
#pragma unroll
    for (int jj = 0; jj < 16; ++jj) { const bf16* row = PROJ + (size_t)(t0 + jg * 16 + jj) * NPROJ + h * 128 + d; s16x2_t v = (s16x2_t){0, 0}; if (WITHQ) v.x = (short)row[C_Q]; v.y = (short)row[C_K]; in.qk[jj] = v; }
    if (WITHV) {
#pragma unroll
    for (int i = 0; i < 4; ++i) { const int c = C.tid + 512 * i, j = c >> 5, ec = c & 31; in.vt[i] = *(const u32x4*)(PROJ + (size_t)(t0 + j) * NPROJ + C_V + h * 256 + 8 * ec); } }
}
DI void gla_load_v(const Ctx& C, int idx, const bf16* PROJ, GlaIn& in) {
    const int b = idx >> 8, h = (idx >> 6) & 3, n = idx & 63, t0 = b * SEQ + n * 64;
#pragma unroll
    for (int i = 0; i < 4; ++i) { const int c = C.tid + 512 * i, j = c >> 5, ec = c & 31; in.vt[i] = *(const u32x4*)(PROJ + (size_t)(t0 + j) * NPROJ + C_V + h * 256 + 8 * ec); }
}
DI void store_v_tile(const Ctx& C, const GlaIn& in, LAS bf16* VL) {
#pragma unroll
    for (int i = 0; i < 4; ++i) { const int c = C.tid + 512 * i, j = c >> 5, ec = c & 31; *(LAS u32x4*)(VL + j * VST + 8 * ec) = in.vt[i]; }
}
DI void glaA_phase(const Ctx& C, int l, const bf16* PROJ, const float* ALOW, bf16* SBUF, float* DEC) {
    LAS float* al = (LAS float*)(C.lds); LAS float* tot = (LAS float*)(C.lds + 4096);
    LAS bf16* KD = (LAS bf16*)(C.lds + 8192); LAS bf16* VL = (LAS bf16*)(C.lds + 25600);
    const int d = C.tid & 127, jg = C.tid >> 7, h = (C.bid >> 6) & 3;
    float w2[16];
#pragma unroll
    for (int r = 0; r < 16; ++r) w2[r] = KARG(I_WA2)[(size_t)l * 16 * 512 + r * 512 + h * 128 + d];
    const float bav = KARG(I_BA)[(size_t)l * 512 + h * 128 + d];
    GlaIn cur, nxt;
    gla_load<false>(C, C.bid, PROJ, ALOW, cur);
#pragma unroll 1
    for (int i = 0; i < 4; ++i) {
        const int idx = i * C.G + C.bid;
        float Gl[16], off, gref, g63;
        gla_gates(C, al, tot, cur.alv, w2, bav, Gl, off, gref, g63);
#pragma unroll
        for (int jj = 0; jj < 16; ++jj) { const int j = jg * 16 + jj; KD[j * KST + d] = (bf16)f2bf(qk_k(cur.qk[jj]) * fexp2(g63 - (off + Gl[jj]))); }
        store_v_tile(C, cur, VL);
        LBAR();
        if (i + 1 < 4) gla_load<false>(C, idx + C.G, PROJ, ALOW, nxt);
        if (jg == 0) DEC[(size_t)idx * 128 + d] = fexp2(g63);
        const int lane = C.lane, g = lane >> 4, qq = (lane & 15) >> 2, p = lane & 3, fr = lane & 15;
        bf16x8 A[2];
#pragma unroll
        for (int ks = 0; ks < 2; ++ks) A[ks] = tr8(KD + (32 * ks + 8 * g + qq) * KST + 16 * C.wave + 4 * p, KST);
        bf16* Sit = SBUF + (size_t)idx * 256 * 128;
#pragma unroll
        for (int half = 0; half < 2; ++half) {
            f32x4 acc[8];
#pragma unroll
            for (int nt = 0; nt < 8; ++nt) acc[nt] = (f32x4){0.f, 0.f, 0.f, 0.f};
#pragma unroll
            for (int nt = 0; nt < 8; ++nt)
#pragma unroll
                for (int ks = 0; ks < 2; ++ks) { const bf16x8 Bf = tr8(VL + (32 * ks + 8 * g + qq) * VST + 16 * (half * 8 + nt) + 4 * p, VST); acc[nt] = mfma16(A[ks], Bf, acc[nt]); }
#pragma unroll
            for (int nt = 0; nt < 8; ++nt) { const int e = 16 * (half * 8 + nt) + fr, dd = 16 * C.wave + 4 * g;
                u32x2 w; w.x = pk2(acc[nt][0], acc[nt][1]); w.y = pk2(acc[nt][2], acc[nt][3]); *(u32x2*)(Sit + (size_t)e * 128 + dd) = w; }
        }
        LBAR();
        cur = nxt;
    }
}
DI void scan_phase(const Ctx& C, bf16* SBUF, const float* DEC) {
    const int gt = C.bid * NTHR + C.tid, bh = gt >> 13, rem = gt & 8191, e = rem >> 5, dq = rem & 31;
    u32x2* p = (u32x2*)(SBUF + ((size_t)(bh * 64) * 256 + e) * 128 + 4 * dq);
    const f32x4* dp = (const f32x4*)(DEC + (size_t)(bh * 64) * 128 + 4 * dq);
    f32x4 st = (f32x4){0.f, 0.f, 0.f, 0.f};
#pragma unroll 1
    for (int n0 = 0; n0 < 64; n0 += 8) {
        u32x2 tmp[8]; f32x4 dc[8];
#pragma unroll
        for (int u = 0; u < 8; ++u) { tmp[u] = p[(size_t)(n0 + u) * 8192]; dc[u] = dp[(n0 + u) * 32]; }
#pragma unroll
        for (int u = 0; u < 8; ++u) { u32x2 w; w.x = pk2(st.x, st.y); w.y = pk2(st.z, st.w); p[(size_t)(n0 + u) * 8192] = w;
            st = dc[u] * st + (f32x4){bflo(tmp[u].x), bfhi(tmp[u].x), bflo(tmp[u].y), bfhi(tmp[u].y)}; }
    }
}
DI void glaC_phase(const Ctx& C, int l, const bf16* PROJ, const float* ALOW, const bf16* SBUF, bf16* CONCAT) {
    const int h = (C.bid >> 6) & 3;
    LAS float* al = (LAS float*)(C.lds); LAS float* tot = (LAS float*)(C.lds + 4096); LAS float* RS = (LAS float*)(C.lds + 6144);
    LAS bf16* QT = (LAS bf16*)(C.lds + 8192); LAS bf16* KT = (LAS bf16*)(C.lds + 25600); LAS bf16* QG = (LAS bf16*)(C.lds + 43008);
    LAS bf16* VL = (LAS bf16*)(C.lds + 60416); LAS bf16* PL = (LAS bf16*)(C.lds + 94208);
    const int d = C.tid & 127, jg = C.tid >> 7;
    float w2[16];
#pragma unroll
    for (int r = 0; r < 16; ++r) w2[r] = KARG(I_WA2)[(size_t)l * 16 * 512 + r * 512 + h * 128 + d];
    const float bav = KARG(I_BA)[(size_t)l * 512 + h * 128 + d];
    const float* ng = KARG(I_GNG) + (size_t)(l * 4 + h) * 256;
    GlaIn cur;
    f32x4 alv_n; s16x2_t qkn[16];
    gla_load<true, false>(C, C.bid, PROJ, ALOW, cur);
#pragma unroll 1
    for (int it = 0; it < 4; ++it) {
    const int idx = it * C.G + C.bid, b = idx >> 8, n = idx & 63, t0 = b * SEQ + n * 64;
    gla_load_v(C, idx, PROJ, cur);
    float Gl[16], off, gref, g63;
    gla_gates(C, al, tot, cur.alv, w2, bav, Gl, off, gref, g63);
#pragma unroll
    for (int jj = 0; jj < 16; ++jj) { const int j = jg * 16 + jj; const float Gv = off + Gl[jj];
        const float q = qk_q(cur.qk[jj]) * 0.08838834764831845f, k = qk_k(cur.qk[jj]);
        QT[j * KST + d] = (bf16)f2bf(q * fexp2(fminf(Gv - gref, 100.f))); KT[j * KST + d] = (bf16)f2bf(k * fexp2(fminf(gref - Gv, 100.f))); QG[j * KST + d] = (bf16)f2bf(q * fexp2(Gv)); }
    store_v_tile(C, cur, VL);
    const int lane = C.lane, g = lane >> 4, qq = (lane & 15) >> 2, p = lane & 3, fr = lane & 15;
    bf16x8 Sf[2][4]; u32x2 rraw[4][2];
#pragma unroll
    for (int mi = 0; mi < 2; ++mi) { const bf16* Srow = SBUF + ((size_t)idx * 256 + 16 * (2 * C.wave + mi) + fr) * 128 + 8 * g;
#pragma unroll
        for (int ks = 0; ks < 4; ++ks) Sf[mi][ks] = *(const bf16x8*)(Srow + 32 * ks); }
#pragma unroll
    for (int nt = 0; nt < 4; ++nt)
#pragma unroll
        for (int mi = 0; mi < 2; ++mi) rraw[nt][mi] = *(const u32x2*)(PROJ + (size_t)(t0 + 16 * nt + fr) * NPROJ + C_R + h * 256 + 16 * (2 * C.wave + mi) + 4 * g);
    LBAR();
    if (it + 1 < 4) { const int ix = idx + C.G, t1 = (ix >> 8) * SEQ + (ix & 63) * 64;
        alv_n = (f32x4){0.f, 0.f, 0.f, 0.f}; if (C.tid < 256) alv_n = ((const f32x4*)(ALOW + (size_t)t1 * 16))[C.tid];
#pragma unroll
        for (int jj = 0; jj < 16; ++jj) { const bf16* row = PROJ + (size_t)(t1 + jg * 16 + jj) * NPROJ + h * 128 + d; s16x2_t v; v.x = (short)row[C_Q]; v.y = (short)row[C_K]; qkn[jj] = v; } }
    {
        const int nt = C.wave & 3;
#pragma unroll
        for (int mi = 0; mi < 2; ++mi) { const int mt = 2 * (C.wave >> 2) + mi; f32x4 acc = (f32x4){0.f, 0.f, 0.f, 0.f};
#pragma unroll
            for (int ks = 0; ks < 4; ++ks) { const bf16x8 a = *(const LAS bf16x8*)(KT + (16 * mt + fr) * KST + 32 * ks + 8 * g), bq = *(const LAS bf16x8*)(QT + (16 * nt + fr) * KST + 32 * ks + 8 * g); acc = mfma16(a, bq, acc); }
            const int i = 16 * nt + fr, j0 = 16 * mt + 4 * g;
            const float v0 = (j0 + 0 <= i) ? acc[0] : 0.f, v1 = (j0 + 1 <= i) ? acc[1] : 0.f, v2 = (j0 + 2 <= i) ? acc[2] : 0.f, v3 = (j0 + 3 <= i) ? acc[3] : 0.f;
            u32x2 w; w.x = pk2(v0, v1); w.y = pk2(v2, v3); *(LAS u32x2*)(PL + i * PST + j0) = w; }
    }
    LBAR();
    f32x4 acc[2][4];
#pragma unroll
    for (int mi = 0; mi < 2; ++mi)
#pragma unroll
        for (int nt = 0; nt < 4; ++nt) acc[mi][nt] = (f32x4){0.f, 0.f, 0.f, 0.f};
#pragma unroll
    for (int mi = 0; mi < 2; ++mi) { const int mt = 2 * C.wave + mi;
#pragma unroll
        for (int ks = 0; ks < 2; ++ks) { const bf16x8 a = tr8(VL + (32 * ks + 8 * g + qq) * VST + 16 * mt + 4 * p, VST);
#pragma unroll
            for (int nt = 0; nt < 4; ++nt) { const bf16x8 bp = *(const LAS bf16x8*)(PL + (16 * nt + fr) * PST + 32 * ks + 8 * g); acc[mi][nt] = mfma16(a, bp, acc[mi][nt]); } }
#pragma unroll
        for (int ks = 0; ks < 4; ++ks) { const bf16x8 a = Sf[mi][ks];
#pragma unroll
            for (int nt = 0; nt < 4; ++nt) { const bf16x8 bq = *(const LAS bf16x8*)(QG + (16 * nt + fr) * KST + 32 * ks + 8 * g); acc[mi][nt] = mfma16(a, bq, acc[mi][nt]); } }
    }
#pragma unroll
    for (int nt = 0; nt < 4; ++nt) { float s = 0.f;
#pragma unroll
        for (int mi = 0; mi < 2; ++mi) s += (acc[mi][nt][0] * acc[mi][nt][0] + acc[mi][nt][1] * acc[mi][nt][1]) + (acc[mi][nt][2] * acc[mi][nt][2] + acc[mi][nt][3] * acc[mi][nt][3]);
        s += __shfl_xor(s, 16); s += __shfl_xor(s, 32);
        if (g == 0) RS[C.wave * 64 + 16 * nt + fr] = s; }
    LBAR();
#pragma unroll
    for (int nt = 0; nt < 4; ++nt) { const int i = 16 * nt + fr; float ts = 0.f;
#pragma unroll
        for (int w = 0; w < 8; ++w) ts += RS[w * 64 + i];
        const float rstd = frsq(ts * (1.f / 256.f) + EPS);
#pragma unroll
        for (int mi = 0; mi < 2; ++mi) { const int e = 16 * (2 * C.wave + mi) + 4 * g;
            const u32x2 rr = rraw[nt][mi]; const f32x4 gg = *(const f32x4*)(ng + e);
            const float o0 = acc[mi][nt][0] * rstd * gg.x * silu_f(bflo(rr.x)), o1 = acc[mi][nt][1] * rstd * gg.y * silu_f(bfhi(rr.x));
            const float o2 = acc[mi][nt][2] * rstd * gg.z * silu_f(bflo(rr.y)), o3 = acc[mi][nt][3] * rstd * gg.w * silu_f(bfhi(rr.y));
            u32x2 w; w.x = pk2(o0, o1); w.y = pk2(o2, o3); *(u32x2*)(CONCAT + (size_t)(t0 + i) * D + h * 256 + e) = w; } }
    LBAR();
    cur.alv = alv_n;
#pragma unroll
    for (int jj = 0; jj < 16; ++jj) cur.qk[jj] = qkn[jj];
    }
}
constexpr int GST = 136;
DI void gmlp_phase(const Ctx& C, int l, const bf16* PROJ, const bf16* WSB, bf16* CONCAT) {
    const int h = C.bid & 7;
    LAS bf16* VL2 = (LAS bf16*)(C.lds); LAS bf16* UL = (LAS bf16*)(C.lds + 34816);
    const float* vg = KARG(I_VNG) + (size_t)(l * 8 + h) * 128; const float* og = KARG(I_MOG) + (size_t)(l * 8 + h) * 128; const float* bb = KARG(I_MB) + (size_t)(l * 8 + h) * 128;
    bf16x8 Wf[4];
    { const bf16* Wrow = WSB + ((size_t)(l * 8 + h) * 128 + 16 * C.wave + (C.lane & 15)) * 128 + 8 * (C.lane >> 4);
#pragma unroll
      for (int ks = 0; ks < 4; ++ks) Wf[ks] = *(const bf16x8*)(Wrow + 32 * ks); }
    u32x4 cu[4], cv[4], nu[4], nv[4];
#define GM_LOAD(IDX, U, V) do { const int t0_ = ((IDX) >> 8) * SEQ + (((IDX) >> 3) & 31) * 128; _Pragma("unroll") for (int i = 0; i < 4; ++i) { const int c = C.tid + 512 * i, t = c >> 4, ch = c & 15; \
        const bf16* row = PROJ + (size_t)(t0_ + t) * NPROJ + h * 128 + 8 * ch; U[i] = *(const u32x4*)(row + C_U); V[i] = *(const u32x4*)(row + C_VS); } } while (0)
    GM_LOAD(C.bid, cu, cv);
#pragma unroll 1
    for (int it = 0; it < 4; ++it) {
    const int idx = it * C.G + C.bid, n = (idx >> 3) & 31, b = idx >> 8, t0 = b * SEQ + n * 128;
#pragma unroll
    for (int i = 0; i < 4; ++i) { const int c = C.tid + 512 * i, t = c >> 4, ch = c & 15;
        const u32x4 uu = cu[i], vv = cv[i];
        float v[8] = {gelu_t(bflo(vv.x)), gelu_t(bfhi(vv.x)), gelu_t(bflo(vv.y)), gelu_t(bfhi(vv.y)), gelu_t(bflo(vv.z)), gelu_t(bfhi(vv.z)), gelu_t(bflo(vv.w)), gelu_t(bfhi(vv.w))};
        float ss = 0.f;
#pragma unroll
        for (int k = 0; k < 8; ++k) ss += v[k] * v[k];
        ss += __shfl_xor(ss, 1); ss += __shfl_xor(ss, 2); ss += __shfl_xor(ss, 4); ss += __shfl_xor(ss, 8);
        const float rstd = frsq(ss * (1.f / 128.f) + EPS);
        const f32x4 g0 = *(const f32x4*)(vg + 8 * ch), g1 = *(const f32x4*)(vg + 8 * ch + 4);
        u32x4 wv; wv.x = pk2(v[0] * rstd * g0.x, v[1] * rstd * g0.y); wv.y = pk2(v[2] * rstd * g0.z, v[3] * rstd * g0.w); wv.z = pk2(v[4] * rstd * g1.x, v[5] * rstd * g1.y); wv.w = pk2(v[6] * rstd * g1.z, v[7] * rstd * g1.w);
        *(LAS u32x4*)(VL2 + t * GST + 8 * ch) = wv;
        u32x4 wu; wu.x = pk2(gelu_t(bflo(uu.x)), gelu_t(bfhi(uu.x))); wu.y = pk2(gelu_t(bflo(uu.y)), gelu_t(bfhi(uu.y))); wu.z = pk2(gelu_t(bflo(uu.z)), gelu_t(bfhi(uu.z))); wu.w = pk2(gelu_t(bflo(uu.w)), gelu_t(bfhi(uu.w)));
        *(LAS u32x4*)(UL + t * GST + 8 * ch) = wu; }
    LBAR();
    if (it + 1 < 4) GM_LOAD(idx + C.G, nu, nv);
    const int lane = C.lane, g = lane >> 4, qq = (lane & 15) >> 2, p = lane & 3, fr = lane & 15;
    f32x4 acc[8];
#pragma unroll
    for (int mt = 0; mt < 8; ++mt) acc[mt] = (f32x4){0.f, 0.f, 0.f, 0.f};
    const int nks = (C.wave >> 1) + 1;
#pragma unroll
    for (int ks = 0; ks < 4; ++ks) if (ks < nks) { const bf16x8 bw = Wf[ks];
#pragma unroll
        for (int mt = 0; mt < 8; ++mt) { const bf16x8 a = tr8(VL2 + (32 * ks + 8 * g + qq) * GST + 16 * mt + 4 * p, GST); acc[mt] = mfma16(a, bw, acc[mt]); } }
    const int tl = 16 * C.wave + fr; const float bt = bb[tl]; float ss = 0.f;
#pragma unroll
    for (int mt = 0; mt < 8; ++mt) { const u32x2 uu = *(const LAS u32x2*)(UL + tl * GST + 16 * mt + 4 * g);
        acc[mt][0] = bflo(uu.x) * (acc[mt][0] + bt); acc[mt][1] = bfhi(uu.x) * (acc[mt][1] + bt); acc[mt][2] = bflo(uu.y) * (acc[mt][2] + bt); acc[mt][3] = bfhi(uu.y) * (acc[mt][3] + bt);
        ss += (acc[mt][0] * acc[mt][0] + acc[mt][1] * acc[mt][1]) + (acc[mt][2] * acc[mt][2] + acc[mt][3] * acc[mt][3]); }
    ss += __shfl_xor(ss, 16); ss += __shfl_xor(ss, 32);
    const float rstd = frsq(ss * (1.f / 128.f) + EPS);
#pragma unroll
    for (int mt = 0; mt < 8; ++mt) { const f32x4 gg = *(const f32x4*)(og + 16 * mt + 4 * g);
        u32x2 w; w.x = pk2(acc[mt][0] * rstd * gg.x, acc[mt][1] * rstd * gg.y); w.y = pk2(acc[mt][2] * rstd * gg.z, acc[mt][3] * rstd * gg.w);
        *(u32x2*)(CONCAT + (size_t)(t0 + tl) * D + 1024 + h * 128 + 16 * mt + 4 * g) = w; }
    LBAR();
#pragma unroll
    for (int i = 0; i < 4; ++i) { cu[i] = nu[i]; cv[i] = nv[i]; }
    }
#undef GM_LOAD
}
DI void list_insert(float (&L)[16], float x) {
#pragma unroll
    for (int i = 15; i >= 1; --i) L[i] = __builtin_amdgcn_fmed3f(x, L[i - 1], L[i]);
    L[0] = fmaxf(L[0], x);
}
DI void list_merge_xor(float (&L)[16], int mask) {
    float M[16];
#pragma unroll
    for (int i = 0; i < 16; ++i) M[i] = fmaxf(L[i], __shfl_xor(L[15 - i], mask));
#pragma unroll
    for (int s = 8; s >= 1; s >>= 1)
#pragma unroll
        for (int i = 0; i < 16; ++i) if ((i & s) == 0) { const float hi = fmaxf(M[i], M[i + s]), lo = fminf(M[i], M[i + s]); M[i] = hi; M[i + s] = lo; }
#pragma unroll
    for (int i = 0; i < 16; ++i) L[i] = M[i];
}
DI unsigned fbits(float x) { return __builtin_bit_cast(unsigned, x); }
DI float unp7(float x) { return __builtin_bit_cast(float, __builtin_bit_cast(unsigned, x) & 0xFFFFFF80u); }
constexpr int TKST = 136;
DI void topk_phase(const Ctx& C, int l, const bf16* QB, const bf16* K1B, const bf16* K2B, const int* KU, const int* KV, int* EB, float* PG) {
    LAS bf16* KL = (LAS bf16*)C.lds;
    LAS unsigned* tk = (LAS unsigned*)(C.lds + 2 * 128 * TKST * 2 + C.wave * 2048);
    const int lane = C.lane, fr = lane & 15, fq = lane >> 4, h = C.bid & 7, rank = C.bid >> 3;
#pragma unroll
    for (int i = 0; i < 8; ++i) { const int c = C.tid + 512 * i, tb = c >> 11, row = (c & 2047) >> 4, ch = c & 15;
        *(LAS u32x4*)(KL + (tb * 128 + row) * TKST + 8 * ch) = *(const u32x4*)((tb ? K2B : K1B) + ((size_t)(l * 8 + h) * 128 + row) * 128 + 8 * ch); }
    __syncthreads();
#pragma unroll 1
    for (int it = 0; it < 4; ++it) {
        const int tt0 = rank * 512 + C.wave * 64 + it * 16;
        float L[2][16];
        bf16x8 bq[2][4];
#pragma unroll
        for (int half = 0; half < 2; ++half)
#pragma unroll
            for (int ks = 0; ks < 4; ++ks) bq[half][ks] = *(const bf16x8*)(QB + (size_t)(tt0 + fr) * D + h * 256 + half * 128 + 8 * fq + 32 * ks);
#pragma unroll
        for (int half = 0; half < 2; ++half) {
            f32x4 acc[8];
#pragma unroll
            for (int mt = 0; mt < 8; ++mt) acc[mt] = (f32x4){0.f, 0.f, 0.f, 0.f};
            const LAS bf16* Kb = KL + (half * 128 + fr) * TKST + 8 * fq;
#pragma unroll
            for (int ks = 0; ks < 4; ++ks)
#pragma unroll
                for (int mt = 0; mt < 8; ++mt) { const bf16x8 a = *(const LAS bf16x8*)(Kb + (16 * mt) * TKST + 32 * ks); acc[mt] = mfma16(a, bq[half][ks], acc[mt]); }
#pragma unroll
            for (int i = 0; i < 16; ++i) L[half][i] = __builtin_bit_cast(float, 0xFF800000u);
#pragma unroll
            for (int mt = 0; mt < 8; ++mt)
#pragma unroll
                for (int r = 0; r < 4; ++r) { const unsigned key = (unsigned)(16 * mt + 4 * fq + r);
                    const float sv = acc[mt][r];
                    list_insert(L[half], __builtin_bit_cast(float, (fbits(sv) & 0xFFFFFF80u) | key)); }
            list_merge_xor(L[half], 16); list_merge_xor(L[half], 32);
        }
        if (fq == 0) {
#pragma unroll
            for (int i = 0; i < 16; ++i) { tk[(fr * 2 + 0) * 16 + i] = fbits(L[0][i]); tk[(fr * 2 + 1) * 16 + i] = fbits(L[1][i]); }
        }
        float Cn[16];
#pragma unroll
        for (int i = 0; i < 16; ++i) Cn[i] = __builtin_bit_cast(float, 0xFF800000u);
#pragma unroll
        for (int i = 0; i < 16; ++i)
#pragma unroll
            for (int j = 0; j < 16; ++j) if ((i + 1) * (j + 1) <= 16) {
                const float s = unp7(L[0][i]) + unp7(L[1][j]);
                list_insert(Cn, __builtin_bit_cast(float, (fbits(s) & 0xFFFFFF00u) | (unsigned)(i * 16 + j))); }
        LDS_WAIT();
        float sc[4]; int ex[4];
#pragma unroll
        for (int m = 0; m < 4; ++m) {
            const float ck = fq == 0 ? Cn[m] : (fq == 1 ? Cn[4 + m] : (fq == 2 ? Cn[8 + m] : Cn[12 + m]));
            const unsigned cc = fbits(ck) & 255u;
            const unsigned p1 = tk[(fr * 2 + 0) * 16 + (cc >> 4)], p2 = tk[(fr * 2 + 1) * 16 + (cc & 15u)];
            sc[m] = __builtin_bit_cast(float, p1 & 0xFFFFFF80u) + __builtin_bit_cast(float, p2 & 0xFFFFFF80u);
            ex[m] = (int)((p1 & 127u) * 128u + (p2 & 127u));
        }
        float mx = fmaxf(fmaxf(sc[0], sc[1]), fmaxf(sc[2], sc[3]));
        mx = fmaxf(mx, __shfl_xor(mx, 16)); mx = fmaxf(mx, __shfl_xor(mx, 32));
        float w[4], sum = 0.f;
#pragma unroll
        for (int m = 0; m < 4; ++m) { w[m] = fexp2((sc[m] - mx) * 1.442695041f); sum += w[m]; }
        sum += __shfl_xor(sum, 16); sum += __shfl_xor(sum, 32);
        const float inv = 1.0f / sum;
        const size_t o = (size_t)(tt0 + fr) * 128 + h * 16 + 4 * fq;
#pragma unroll
        for (int m = 0; m < 4; ++m) { const int kv = KV[ex[m]]; w[m] = w[m] * inv * __builtin_bit_cast(float, (unsigned)(127 - kv) << 23); ex[m] |= 127 << 16; }
        *(int4*)(EB + o) = make_int4(ex[0], ex[1], ex[2], ex[3]);
        *(f32x4*)(PG + o) = (f32x4){w[0], w[1], w[2], w[3]};
        LDS_WAIT();
    }
}
typedef unsigned char fp8_t;
DI void unpack16(const u32x4 q, float (&f)[16]) {
#pragma unroll
    for (int w = 0; w < 4; ++w) { const int dw = (int)q[w]; const f32x2 lo = __builtin_amdgcn_cvt_pk_f32_fp8(dw, false), hi = __builtin_amdgcn_cvt_pk_f32_fp8(dw, true);
        f[4 * w] = lo.x; f[4 * w + 1] = lo.y; f[4 * w + 2] = hi.x; f[4 * w + 3] = hi.y; }
}
DI int sdot4(int a, int b, int c) { return __builtin_amdgcn_sdot4(a, b, c, false); }
template <int CTRL> DI int dppi(int v) { return __builtin_amdgcn_update_dpp(0, v, CTRL, 0xf, 0xf, true); }
template <int CTRL, int NV> DI void bfly(int (&p)[32], const int base, const bool up) {
#pragma unroll
    for (int m = 0; m < NV / 2; ++m) { const int lo = p[base + m], hi = p[base + m + NV / 2]; const int keep = up ? hi : lo, send = up ? lo : hi; p[base + m] = keep + dppi<CTRL>(send); }
}
#define PU_ADD(P, V_) (void)__hip_atomic_fetch_add((P), (V_), __ATOMIC_RELAXED, __HIP_MEMORY_SCOPE_AGENT)
DI void peerU_phase(const Ctx& C, const unsigned char* H8, const float* HS, const int* EB, const unsigned char* PU8, const float* SU, int* COEF, const int emask = 0xFFFF) {
    const int x = C.bid & 7, rank = C.bid >> 3, lane = C.lane, g = lane >> 4, i16 = lane & 15;
    const __amdgpu_buffer_rsrc_t trs = __builtin_amdgcn_make_buffer_rsrc((void*)(PU8 + (size_t)x * NEXP * 256), 0, NEXP * 256, 0x00020000);
    const float* su = SU + (size_t)x * NEXP;
    const int tbase = rank * 512 + C.wave * 64;
    int* part = COEF + (size_t)tbase * 128 + lane;
    const int* ebase = EB + (size_t)tbase * 128 + lane;
    const unsigned char* hbase = H8 + (size_t)tbase * 4096 + 256 * x + 16 * i16;
    const float* hsb = HS + tbase;
    const int bp0 = 64 * g, loff = 16 * i16;
    const bool b3 = (i16 & 8) != 0, b2 = (i16 & 4) != 0, b1 = (i16 & 2) != 0, b0 = (i16 & 1) != 0;
    int en0 = ebase[0] & emask, en1 = ebase[64] & emask;
    int er0 = ebase[128], er1 = ebase[192];
    u32x4 hh = *(const u32x4*)hbase, hl = *(const u32x4*)(hbase + 2048);
    float sc0 = su[en0], sc1 = su[en1], hs = hsb[0];
    u32x4 buf[32];
#pragma unroll
    for (int u = 0; u < 32; ++u) { const int e = __builtin_amdgcn_ds_bpermute(bp0 + 4 * (u & 15), u < 16 ? en0 : en1); buf[u] = __builtin_amdgcn_raw_buffer_load_b128(trs, e * 256 + loff, 0, 0); }
    __builtin_amdgcn_sched_barrier(0);
    en0 = er0 & emask; en1 = er1 & emask;
    int pend0 = 0, pend1 = 0; int* pend_p = part;
#pragma unroll 1
    for (int ti = 0; ti < 64; ++ti) {
        const int tn = ti + 1 < 64 ? ti + 1 : 63, t2 = ti + 2 < 64 ? ti + 2 : 63;
        er0 = ebase[t2 * 128]; er1 = ebase[t2 * 128 + 64];
        const u32x4 hhn = *(const u32x4*)(hbase + (size_t)tn * 4096), hln = *(const u32x4*)(hbase + (size_t)tn * 4096 + 2048);
        const float scn0 = su[en0], scn1 = su[en1], hsn = hsb[tn];
        __builtin_amdgcn_sched_barrier(0);
        int p[32];
#pragma unroll
        for (int u0 = 0; u0 < 32; u0 += 4) {
            int en[4];
#pragma unroll
            for (int u = u0; u < u0 + 4; ++u) en[u - u0] = __builtin_amdgcn_ds_bpermute(bp0 + 4 * (u & 15), u < 16 ? en0 : en1);
#pragma unroll
            for (int u = u0; u < u0 + 4; ++u) {
                const u32x4 r = buf[u];
                int ah = sdot4((int)r.x, (int)hh.x, 0); ah = sdot4((int)r.y, (int)hh.y, ah); ah = sdot4((int)r.z, (int)hh.z, ah); ah = sdot4((int)r.w, (int)hh.w, ah);
                int al = sdot4((int)r.x, (int)hl.x, 0); al = sdot4((int)r.y, (int)hl.y, al); al = sdot4((int)r.z, (int)hl.z, al); al = sdot4((int)r.w, (int)hl.w, al);
                p[u] = (ah << 7) + al; }
            asm volatile("" : "+v"(p[u0]), "+v"(p[u0 + 1]), "+v"(p[u0 + 2]), "+v"(p[u0 + 3]) :: "memory");
#pragma unroll
            for (int u = u0; u < u0 + 4; ++u) buf[u] = __builtin_amdgcn_raw_buffer_load_b128(trs, en[u - u0] * 256 + loff, 0, 0);
            if (u0 == 12) { PU_ADD(pend_p, pend0); PU_ADD(pend_p + 64, pend1); }
            __builtin_amdgcn_sched_barrier(0);
        }
        bfly<0x140, 16>(p, 0, b3); bfly<0x140, 16>(p, 16, b3);
        bfly<0x141, 8>(p, 0, b2); bfly<0x141, 8>(p, 16, b2);
        bfly<0x4E, 4>(p, 0, b1); bfly<0x4E, 4>(p, 16, b1);
        bfly<0xB1, 2>(p, 0, b0); bfly<0xB1, 2>(p, 16, b0);
        pend0 = (int)__builtin_rintf(fminf(fmaxf((float)p[0] * (sc0 * hs * 16384.0f), -2.0e9f), 2.0e9f)); pend1 = (int)__builtin_rintf(fminf(fmaxf((float)p[16] * (sc1 * hs * 16384.0f), -2.0e9f), 2.0e9f)); pend_p = part + (size_t)ti * 128;
        asm volatile("" : "+v"(er0), "+v"(er1) :: "memory");
        en0 = er0 & emask; en1 = er1 & emask; hh = hhn; hl = hln; sc0 = scn0; sc1 = scn1; hs = hsn;
    }
    PU_ADD(pend_p, pend0); PU_ADD(pend_p + 64, pend1);
#undef PU_ADD
}
typedef long i64_t;
DI float wave_max_u(float v) {
    v = fmaxf(v, dppf<0xB1>(v)); v = fmaxf(v, dppf<0x4E>(v)); v = fmaxf(v, dppf<0x141>(v)); v = fmaxf(v, dppf<0x140>(v));
    const int iv = __builtin_bit_cast(int, v);
    return fmaxf(fmaxf(__builtin_bit_cast(float, __builtin_amdgcn_readlane(iv, 0)), __builtin_bit_cast(float, __builtin_amdgcn_readlane(iv, 16))),
                 fmaxf(__builtin_bit_cast(float, __builtin_amdgcn_readlane(iv, 32)), __builtin_bit_cast(float, __builtin_amdgcn_readlane(iv, 48))));
}
constexpr int PV_BLK = 272;
DI void peerV_phase(const Ctx& C, const int* EB, const float* PG, const int* COEF, const fp8_t* PV8, float* X, const float* gate  , const int emask = 0x3FFF, const long wdelta = 0  ) {
    const int x = C.bid & 7, rank = C.bid >> 3, lane = C.lane, g = lane >> 4, i16 = lane & 15;
    const __amdgpu_buffer_rsrc_t trs = __builtin_amdgcn_make_buffer_rsrc((void*)(PV8 + (size_t)x * NEXP * 256), 0, NEXP * 256, 0x00020000);
    const int tbase = rank * 512 + C.wave * 64;
    ldsp wl = C.lds + C.wave * (8 * PV_BLK);
    const int wr_off = g * PV_BLK + 16 * i16;
    const int rd_off = ((((lane >> 1) & 1) * 4) + (lane & 1)) * PV_BLK + 16 * (lane >> 2);
    const int bp0 = 64 * g, loff = 16 * i16;
    const int ash = (i16 < 8) ? 24 : 16, asl = 8 * (i16 & 3); const unsigned amlo = (i16 & 4) ? 0u : 0xFFFFFFFFu, amhi = ~amlo;
    const int* ebase = EB + (size_t)tbase * 128 + lane; const float* gbase = PG + (size_t)tbase * 128 + lane; const int* pbase = COEF + (size_t)tbase * 128 + lane;
    const int col = 256 * x + 4 * lane;
    const f32x4 gt = *(const f32x4*)(gate + (size_t)(tbase >> 12) * MODW + col);
    int pc0, pc1; float rg0, rg1;
#define PV_LOAD_RAW(tt) do { pc0 = pbase[(tt) * 128]; pc1 = pbase[(tt) * 128 + 64]; rg0 = gbase[(tt) * 128]; rg1 = gbase[(tt) * 128 + 64]; } while (0)
#define PV_PACK(PK0, PK1, INVA, ID0, ID1) do { const float s0_ = (float)pc0 * (1.0f / 16384.0f), s1_ = (float)pc1 * (1.0f / 16384.0f); \
        const float a0_ = gelu_t(s0_) * rg0, a1_ = gelu_t(s1_) * rg1; const float amax_ = wave_max_u(fmaxf(fabsf(a0_), fabsf(a1_))); \
        int ka_ = 0; if (amax_ > 0.f) { ka_ = (int)((__builtin_bit_cast(unsigned, 224.0f / amax_) >> 23) & 255u) - 127; ka_ = ka_ < -100 ? -100 : (ka_ > 100 ? 100 : ka_); } \
        const float sca_ = __builtin_bit_cast(float, (unsigned)(ka_ + 127) << 23); INVA = __builtin_bit_cast(float, (unsigned)(127 - ka_) << 23); \
        const float h0_ = a0_ * sca_, h1_ = a1_ * sca_; const int ph_ = __builtin_amdgcn_cvt_pk_fp8_f32(h0_, h1_, 0, false); const f32x2 bk_ = __builtin_amdgcn_cvt_pk_f32_fp8(ph_, false); \
        const int pl_ = __builtin_amdgcn_cvt_pk_fp8_f32((h0_ - bk_.x) * 16.0f, (h1_ - bk_.y) * 16.0f, 0, false); \
        PK0 = (int)(((unsigned)(ph_ & 255) << 24) | ((unsigned)(pl_ & 255) << 16) | (unsigned)(ID0)); PK1 = (int)(((unsigned)(ph_ & 0xFF00) << 16) | ((unsigned)(pl_ & 0xFF00) << 8) | (unsigned)(ID1)); } while (0)
    const int e0 = ebase[0] & emask, e1 = ebase[64] & emask;
    int er0 = ebase[128], er1 = ebase[192];
    PV_LOAD_RAW(0);
    f32x4* xp0 = (f32x4*)(X + (size_t)tbase * D + col);
    f32x4 xpend = *xp0; f32x4* xpend_p = (f32x4*)((float*)xp0 + wdelta);
    u32x4 buf[32];
#pragma unroll
    for (int u = 0; u < 32; ++u) { const int e = __builtin_amdgcn_ds_bpermute(bp0 + 4 * (u & 15), u < 16 ? e0 : e1); buf[u] = __builtin_amdgcn_raw_buffer_load_b128(trs, e * 256 + loff, 0, 0); }
    __builtin_amdgcn_sched_barrier(0);
    int pk0, pk1; float inva;
    PV_PACK(pk0, pk1, inva, er0 & emask, er1 & emask);
#pragma unroll 1
    for (int ti = 0; ti < 64; ++ti) {
        const int tn = ti + 1 < 64 ? ti + 1 : 63, t2 = ti + 2 < 64 ? ti + 2 : 63;
        er0 = ebase[t2 * 128]; er1 = ebase[t2 * 128 + 64];
        PV_LOAD_RAW(tn);
        f32x4* xp = (f32x4*)(X + (size_t)(tbase + ti) * D + col);
        const f32x4 xold = *xp;
        __builtin_amdgcn_sched_barrier(0);
        f32x4 d0 = (f32x4){0.f, 0.f, 0.f, 0.f}, d1 = d0;
#pragma unroll
        for (int u0 = 0; u0 < 32; u0 += 4) {
            int w[4];
#pragma unroll
            for (int u = u0; u < u0 + 4; ++u) w[u - u0] = __builtin_amdgcn_ds_bpermute(bp0 + 4 * (u & 15), u < 16 ? pk0 : pk1);
#pragma unroll
            for (int u = u0; u < u0 + 4; ++u) {
                const u32x4 r = buf[u]; const unsigned ab = (((unsigned)w[u - u0] >> ash) & 255u) << asl;
                const i64_t av = (i64_t)(((unsigned long long)(ab & amhi) << 32) | (ab & amlo));
                d0 = __builtin_amdgcn_mfma_f32_16x16x32_fp8_fp8(av, (i64_t)(((unsigned long long)r.y << 32) | r.x), d0, 0, 0, 0);
                d1 = __builtin_amdgcn_mfma_f32_16x16x32_fp8_fp8(av, (i64_t)(((unsigned long long)r.w << 32) | r.z), d1, 0, 0, 0); }
            asm volatile("" : "+v"(d0), "+v"(d1) :: "memory");
#pragma unroll
            for (int u = u0; u < u0 + 4; ++u) buf[u] = __builtin_amdgcn_raw_buffer_load_b128(trs, ((w[u - u0] & 0x3FFF) << 8) + loff, 0, 0);
            if (u0 == 12) *xpend_p = xpend;
            __builtin_amdgcn_sched_barrier(0);
        }
        *(LAS f32x4*)(wl + wr_off) = d0; *(LAS f32x4*)(wl + wr_off + 4 * PV_BLK) = d1;
        const f32x4 yh = *(const LAS f32x4*)(wl + rd_off), yl = *(const LAS f32x4*)(wl + rd_off + 2 * PV_BLK);
        const f32x4 y = (yh + yl * 0.0625f) * inva;
        xpend = xold + gt * y; xpend_p = (f32x4*)((float*)xp + wdelta);
        asm volatile("" : "+v"(er0), "+v"(er1) :: "memory");
        PV_PACK(pk0, pk1, inva, er0 & emask, er1 & emask);
    }
    *xpend_p = xpend;
#undef PV_LOAD_RAW
#undef PV_PACK
}
DI void final_norm_phase(const Ctx& C, float* X, const float* g) {
    const int r0 = C.gw * 8;
    f32x4 gm[8];
#pragma unroll
    for (int j = 0; j < 8; ++j) gm[j] = ((const f32x4*)g)[64 * j + C.lane];
#pragma unroll 1
    for (int i = 0; i < 8; ++i) {
        f32x4* xr = (f32x4*)(X + (size_t)(r0 + i) * D) + C.lane; f32x4 v[8]; float s = 0.f;
#pragma unroll
        for (int j = 0; j < 8; ++j) { v[j] = xr[64 * j]; s += (v[j].x * v[j].x + v[j].y * v[j].y) + (v[j].z * v[j].z + v[j].w * v[j].w); }
        const float rstd = frsq(wave_sum(s) * (1.f / D) + EPS);
#pragma unroll
        for (int j = 0; j < 8; ++j) xr[64 * j] = v[j] * rstd * gm[j];
    }
}
#ifndef PH_MASK
#define PH_MASK 0xFFFFF
#endif
#define EN(k) (((PH_MASK) >> (k)) & 1)
#ifndef GEMM_SP2
#define GEMM_SP2 true
#endif
#ifndef GEMM_ALIGN
#define GEMM_ALIGN false
#endif
constexpr int NKIND = 11, NPH = 2 + 2 * NKIND;
struct Args { const float* in[21]; float* out; unsigned char* ws; int ph_lo, ph_hi, pad0, pad1; };
__global__ void __launch_bounds__(NTHR, 2) mk_fwd(Args args) {
    extern __shared__ __attribute__((aligned(16))) unsigned char lds_raw[];
    ldsp ldsb = (ldsp)lds_raw;
    volatile LAS unsigned* MISC = (volatile LAS unsigned*)(ldsb + MISC_OFF);
    for (int u = threadIdx.x; u < (LDS_BYTES - LDSCTL_OFF) / 4; u += NTHR) ((LAS unsigned*)(ldsb + LDSCTL_OFF))[u] = 0u;
    __syncthreads();
    unsigned* barw = (unsigned*)(args.ws + WS_CTL) + CW_BAR;
    XcdBarrier bar; bar.bar = barw; bar.x = 0; bar.st = nullptr;
    const bool multi = (args.ph_hi - args.ph_lo) > 1;
    if (multi) bar = xcd_barrier_post(barw, MISC + 8);

#pragma unroll 1
    for (int ph = args.ph_lo; ph < args.ph_hi; ++ph) {
#define MKCTX Ctx C; { int tid_ = threadIdx.x, bid_ = blockIdx.x; asm volatile("" : "+v"(tid_)); asm volatile("" : "+s"(bid_)); \
        C.lds = ldsb; C.tid = tid_; C.lane = tid_ & 63; C.wave = __builtin_amdgcn_readfirstlane(tid_ >> 6); C.bid = bid_; C.G = gridDim.x; C.gw = C.bid * NWAVES + C.wave; C.NGW = C.G * NWAVES; \
        C.ws = args.ws; }
        unsigned char* const wsb = args.ws;
        float* MOD = (float*)(wsb + WS_MOD);
        bf16* Hb = (bf16*)(wsb + WS_H); bf16* PROJ = (bf16*)(wsb + WS_PROJ); bf16* SBUF = (bf16*)(wsb + WS_SBUF); bf16* CONCAT = (bf16*)(wsb + WS_CONCAT); bf16* QB = (bf16*)(wsb + WS_QB);
        float* ALOW = (float*)(wsb + WS_ALOW); float* DEC = (float*)(wsb + WS_DEC); int* EB = (int*)(wsb + WS_EB); float* PG = (float*)(wsb + WS_PG);
        float* X = args.out;
        const int l = ph < 2 ? 0 : (ph - 2) / NKIND, kind = ph < 2 ? -1 : (ph - 2) % NKIND;
        const float* modl = MOD + (size_t)l * 4 * MODW;
        if (ph == 0) { if (EN(0)) { MKCTX; p0_prologue(C); } }
        else if (ph == 1) { if (EN(1)) { MKCTX; norm_phase(C, KARG(I_X), KARG(I_N1G), modl, 0, D, Hb); } }
        else if ((kind == 0 || kind == 6) && EN(2)) {
            MKCTX; const bool isq = (kind == 6);
            pg8::Gemm g{Hb, isq ? (const bf16*)(wsb + WS_WTQ) + (size_t)l * D * D : (const bf16*)(wsb + WS_WTIN) + (size_t)l * WTIN_L, T, isq ? D : NPROJ, D};
            pg8::StaticOrder S; S.init(T, g.N, C.G, C.bid);
            pg8::EpiBf16 E{isq ? QB : PROJ, isq ? D : NPROJ};
            pg8::gemm_phase<pg8::EpiBf16, pg8::StaticOrder, GEMM_ALIGN, GEMM_SP2>(C.lds, g, S, E, C.tid);
            if (!isq) alow_phase(C, Hb, (const bf16*)(wsb + WS_WTIN) + (size_t)l * WTIN_L + (size_t)NPROJ * D, ALOW);
        }
        else if (kind == 1 && EN(3)) {
            MKCTX;
            glaA_phase(C, l, PROJ, ALOW, SBUF, DEC);
            gmlp_phase(C, l, PROJ, (const bf16*)(wsb + WS_WSB), CONCAT);
        }
        else if (kind == 2) { if (EN(4)) { MKCTX; scan_phase(C, SBUF, DEC); } }
        else if (kind == 3 && EN(5)) { MKCTX; glaC_phase(C, l, PROJ, ALOW, SBUF, CONCAT); }
        else if (kind == 4 && EN(6)) {
            MKCTX;
            pg8::Gemm g{CONCAT, (const bf16*)(wsb + WS_WTOUT) + (size_t)l * D * D, T, D, D};
            pg8::StaticOrder S; S.init(T, D, C.G, C.bid);
            pg8::EpiResGate E{l == 0 ? KARG(I_X) : (const float*)X, X, modl + 2 * D, MODW};
            pg8::gemm_phase<pg8::EpiResGate, pg8::StaticOrder, GEMM_ALIGN, GEMM_SP2>(C.lds, g, S, E, C.tid);
        }
        else if (kind == 5) { if (EN(1)) { MKCTX; norm_phase<true>(C, X, KARG(I_N2G) + (size_t)l * D, modl, 3 * D, 4 * D, Hb, wsb + WS_H8, (float*)(wsb + WS_HS), (int*)(wsb + WS_COEF)); } }
        else if (kind == 7) { if (EN(7)) { MKCTX; topk_phase(C, l, QB, (const bf16*)(wsb + WS_K1B), (const bf16*)(wsb + WS_K2B), (const int*)(wsb + WS_KU) + l * NEXP, (const int*)(wsb + WS_KV) + l * NEXP, EB, PG); } }
        else if (kind == 8) { if (EN(8)) { MKCTX; peerU_phase(C, wsb + WS_H8, (const float*)(wsb + WS_HS), EB, wsb + WS_PUB + (size_t)l * NEXP * D, (const float*)(wsb + WS_SU) + (size_t)l * 8 * NEXP, (int*)(wsb + WS_COEF)); } }
        else if (kind == 9) { if (EN(9)) { MKCTX; peerV_phase(C, EB, PG, (const int*)(wsb + WS_COEF), (const fp8_t*)(wsb + WS_PVB) + (size_t)l * NEXP * D, X, modl + 5 * D); } }
        else if (EN(10)) {
            MKCTX;
            if (l == DEPTH - 1) final_norm_phase(C, X, KARG(I_FG));
            else norm_phase(C, X, KARG(I_N1G) + (size_t)(l + 1) * D, MOD + (size_t)(l + 1) * 4 * MODW, 0, D, Hb);
        }
        if (ph + 1 < args.ph_hi) xcd_barrier(bar);
    }
}

extern "C" void kernel_launch(void* const* d_in, const int* in_sizes, int n_in, void* d_out, int out_size, void* d_ws, size_t ws_size, hipStream_t stream) {
    static int grid = 0;
    if (grid == 0) {
        if (n_in != 21 || out_size != T * D || ws_size < WS_END) { fprintf(stderr, "kernel_launch: unexpected shapes (n_in %d, out %d, ws %zu)\n", n_in, out_size, ws_size); grid = -1; return; }
        int dev = 0, cus = 0, per_cu = 0;
        if (hipGetDevice(&dev) != hipSuccess || hipDeviceGetAttribute(&cus, hipDeviceAttributeMultiprocessorCount, dev) != hipSuccess) { grid = -1; return; }
        if (hipFuncSetAttribute((const void*)mk_fwd, hipFuncAttributeMaxDynamicSharedMemorySize, LDS_BYTES) != hipSuccess) { fprintf(stderr, "kernel_launch: hipFuncSetAttribute failed\n"); grid = -1; return; }
        if (hipOccupancyMaxActiveBlocksPerMultiprocessor(&per_cu, (const void*)mk_fwd, NTHR, LDS_BYTES) != hipSuccess || per_cu < 1) { fprintf(stderr, "kernel_launch: occupancy query says %d blocks per CU\n", per_cu); (void)hipGetLastError(); grid = -1; return; }
        if (cus != 256) { fprintf(stderr, "kernel_launch: built for a 256-CU device (got %d)\n", cus); grid = -1; return; }
        grid = cus;
    }
    if (grid < 0) return;
    (void)hipMemsetAsync((char*)d_ws + WS_CTL, 0, CTL_ZERO_BYTES, stream);
    Args a{};
    for (int i = 0; i < 21; ++i) a.in[i] = (const float*)d_in[i];
    a.out = (float*)d_out; a.ws = (unsigned char*)d_ws;
#if MK_N_LAUNCHES == 1
    a.ph_lo = 0; a.ph_hi = NPH;
    hipLaunchKernelGGL(mk_fwd, dim3(grid), dim3(NTHR), LDS_BYTES, stream, a);
#else
    for (int p = 0; p < NPH; ++p) { a.ph_lo = p; a.ph_hi = p + 1; hipLaunchKernelGGL(mk_fwd, dim3(grid), dim3(NTHR), LDS_BYTES, stream, a); }
#endif
}
```

```cpp
#include <hip/hip_runtime.h>
#include <cstdio>
#include <cstdint>
#ifndef MK_N_LAUNCHES
#define MK_N_LAUNCHES 1
#endif
namespace pg8 {
#define PG8_LAS __attribute__((address_space(3)))
typedef unsigned short bf16_t;
typedef short bf16x8 __attribute__((ext_vector_type(8)));
typedef float f32x4 __attribute__((ext_vector_type(4)));
typedef unsigned u32x4 __attribute__((ext_vector_type(4)));
constexpr int BM = 256, BK = 64, HALF = 128, HTB = HALF * BK * 2  , STAGE_BYTES = 8 * HTB, NXCD = 8, WGM = 8;

__host__ __device__ __forceinline__ int lds_byte(int r, int c) { const int st = (r >> 4) * 2 + (c >> 5), rr = r & 15, cc = c & 31, ob = rr * 64 + cc * 2; return st * 1024 + (ob ^ (((ob >> 9) & 1) << 5)); }
__host__ __device__ __forceinline__ void stage_rc(int b, int& R, int& C) { const int st = b / 1024, sb = b % 1024, swz = sb ^ (((sb >> 9) & 1) << 5); R = (st >> 1) * 16 + swz / 64; C = (st & 1) * 32 + (swz % 64) / 2; }
__host__ __device__ __forceinline__ int perm32(int rho) { const int n = rho >> 4, i = rho & 15; return 8 * (i >> 2) + 4 * n + (i & 3); }

struct Unit { int pm, pn; };
struct Gemm { const bf16_t* A; const bf16_t* Bt; int M, N, K; };

struct StaticOrder {
    int nM, nN, nwg, G, c;
    __host__ __device__ void init(int M, int N, int G_, int c_) { nM = M / BM; nN = N / BM; nwg = nM * nN; G = G_; c = c_; }
    __host__ __device__ bool next(int i, Unit& u) const {
        const long L = (long)i * G + c; if (L >= nwg) return false;
        int wgid = (int)L; { const int q = nwg / NXCD, r = nwg % NXCD, xcd = wgid % NXCD, off = wgid / NXCD; wgid = (xcd < r ? xcd * (q + 1) : r * (q + 1) + (xcd - r) * q) + off; }
        const int nig = WGM * nN, gid = wgid / nig, fm = gid * WGM, gsz = (nM - fm) < WGM ? (nM - fm) : WGM;
        u.pm = fm + ((wgid % nig) % gsz); u.pn = (wgid % nig) / gsz; return true;
    }
    __device__ __forceinline__ void a_ready(const Unit&) const {}
    __device__ __forceinline__ void done(const Unit&) const {}
};
__device__ __forceinline__ unsigned cvt_pk_bf16(float lo, float hi) { unsigned r; asm volatile("v_cvt_pk_bf16_f32 %0, %1, %2" : "=v"(r) : "v"(lo), "v"(hi)); return r; }
struct EpiBf16 {
    static constexpr bool PERM = true, AFTER_DRAIN = false;
    bf16_t* O; int ldc;
    __device__ __forceinline__ void operator()(const f32x4 (&acc)[2][2][4][2], const Unit& u, int wr, int wc, int fr, int fq) const {
        const int row0 = u.pm * BM + wr * 64 + fr; const int col0 = u.pn * BM + wc * 32 + 8 * fq;
#pragma unroll
        for (int ai = 0; ai < 2; ++ai)
#pragma unroll
            for (int m = 0; m < 4; ++m) { bf16_t* rowp = O + (size_t)(row0 + ai * HALF + m * 16) * ldc + col0;
#pragma unroll
                for (int bj = 0; bj < 2; ++bj) { const f32x4 v0 = acc[ai][bj][m][0], v1 = acc[ai][bj][m][1];
                    u32x4 w; w.x = cvt_pk_bf16(v0[0], v0[1]); w.y = cvt_pk_bf16(v0[2], v0[3]); w.z = cvt_pk_bf16(v1[0], v1[1]); w.w = cvt_pk_bf16(v1[2], v1[3]);
                    *(u32x4*)(rowp + bj * HALF) = w; } }
    }
};
struct EpiResGate {
    static constexpr bool PERM = false, AFTER_DRAIN = false;
    const float* base; float* out; const float* gate; int gpitch;
    __device__ __forceinline__ void operator()(const f32x4 (&acc)[2][2][4][2], const Unit& u, int wr, int wc, int fr, int fq) const {
        const int row0 = u.pm * BM + wr * 64 + fr, col0 = u.pn * BM + wc * 32 + 4 * fq;
        const float* gp = gate + (size_t)(u.pm >> 4) * gpitch + col0;
        f32x4 gv[2][2];
#pragma unroll
        for (int bj = 0; bj < 2; ++bj)
#pragma unroll
            for (int n = 0; n < 2; ++n) gv[bj][n] = *(const f32x4*)(gp + bj * HALF + n * 16);
        f32x4 bs[4][2][2];
#define ERG_OFF(G_) ((size_t)(row0 + ((G_) >> 2) * HALF + ((G_) & 3) * 16) * 2048 + col0)
#define ERG_LOAD(G_) do { _Pragma("unroll") for (int bj = 0; bj < 2; ++bj) _Pragma("unroll") for (int n = 0; n < 2; ++n) bs[(G_) & 3][bj][n] = *(const f32x4*)(base + ERG_OFF(G_) + bj * HALF + n * 16); } while (0)
        ERG_LOAD(0); ERG_LOAD(1); ERG_LOAD(2); ERG_LOAD(3);
#pragma unroll
        for (int gq = 0; gq < 8; ++gq) {
#pragma unroll
            for (int bj = 0; bj < 2; ++bj)
#pragma unroll
                for (int n = 0; n < 2; ++n) *(f32x4*)(out + ERG_OFF(gq) + bj * HALF + n * 16) = bs[gq & 3][bj][n] + gv[bj][n] * acc[gq >> 2][bj][gq & 3][n];
            asm volatile("" ::: "memory");
            if (gq + 4 < 8) ERG_LOAD(gq + 4);
            asm volatile("" ::: "memory"); }
#undef ERG_OFF
#undef ERG_LOAD
    }
};

template <class Epi, class Sched, bool ALIGN_EPI = false, bool SP2 = false>
__device__ __forceinline__ void gemm_phase(PG8_LAS unsigned char* lds, const Gemm g, const Sched& S, const Epi& E, const int tid  ) {
    const int wid = __builtin_amdgcn_readfirstlane(tid >> 6), lane = tid & 63, wr = wid >> 2, wc = wid & 3, fr = lane & 15, fq = lane >> 4;
    const int K = g.K, nt = K / BK;
    unsigned voffA[2], voffB[2];
#pragma unroll
    for (int i = 0; i < 2; ++i) { int R, C; stage_rc(tid * 16 + i * 8192, R, C); const int Rb = Epi::PERM ? ((R & ~31) + perm32(R & 31)) : R;
        voffA[i] = (unsigned)(R * K + C) * 2u; voffB[i] = (unsigned)(Rb * K + C) * 2u; }
    const size_t kstep = (size_t)(BK * 2);
    const size_t hstep = (size_t)HALF * K * 2;
    const size_t tstep = 2 * hstep;
    const unsigned ldsw = (unsigned)wid * 1024u;
    const int aoff = lds_byte(wr * 64 + fr, fq * 8), boff = lds_byte(wc * 32 + fr, fq * 8);
#define PG8_SA(b, h) (((b) * 2 + (h)) * HTB)
#define PG8_SB(b, h) ((4 + (b) * 2 + (h)) * HTB)
#define PG8_STAGE(bufoff, gbase, voff) do { _Pragma("unroll") for (int _i = 0; _i < 2; ++_i) \
        __builtin_amdgcn_global_load_lds((const unsigned*)((const char*)(gbase) + (voff)[_i]), (PG8_LAS unsigned*)(lds + (bufoff) + ldsw + _i * 8192), 16, 0, 0); } while (0)
#define PG8_LDA(dst, b, h) do { _Pragma("unroll") for (int m = 0; m < 4; ++m) _Pragma("unroll") for (int k = 0; k < 2; ++k) dst[m][k] = *(const PG8_LAS bf16x8*)(lds + PG8_SA(b, h) + aoff + m * 2048 + k * 1024); } while (0)
#define PG8_LDB(dst, b, h) do { _Pragma("unroll") for (int n = 0; n < 2; ++n) _Pragma("unroll") for (int k = 0; k < 2; ++k) dst[n][k] = *(const PG8_LAS bf16x8*)(lds + PG8_SB(b, h) + boff + n * 2048 + k * 1024); } while (0)
#define PG8_MMA(ai, bj, At, Bt) do { __builtin_amdgcn_s_setprio(1); _Pragma("unroll") for (int m = 0; m < 4; ++m) _Pragma("unroll") for (int n = 0; n < 2; ++n) _Pragma("unroll") for (int k = 0; k < 2; ++k) \
        acc[ai][bj][m][n] = __builtin_amdgcn_mfma_f32_16x16x32_bf16(Bt[n][k], At[m][k], acc[ai][bj][m][n], 0, 0, 0); __builtin_amdgcn_s_setprio(0); } while (0)
#define PG8_WAIT_V(n) asm volatile("s_waitcnt vmcnt(" #n ")" ::: "memory")
#define PG8_WAIT_L(n) asm volatile("s_waitcnt lgkmcnt(" #n ")" ::: "memory")
#define PG8_BAR __builtin_amdgcn_s_barrier()
#define PG8_SCHED __builtin_amdgcn_sched_barrier(0)
    Unit cur, nxt; int ui = 0;
    if (!S.next(0, cur)) return;
    f32x4 acc[2][2][4][2];
#pragma unroll
    for (int a = 0; a < 2; ++a)
#pragma unroll
        for (int b = 0; b < 2; ++b)
#pragma unroll
            for (int m = 0; m < 4; ++m)
#pragma unroll
                for (int n = 0; n < 2; ++n) acc[a][b][m][n] = (f32x4){0.f, 0.f, 0.f, 0.f};
    bf16x8 At[4][2], B0[2][2], B1[2][2];
    const char* cA = (const char*)g.A + (size_t)cur.pm * tstep; const char* cB = (const char*)g.Bt + (size_t)cur.pn * tstep;
    S.a_ready(cur);
    if constexpr (SP2) {
        PG8_STAGE(PG8_SB(0, 0), cB, voffB); PG8_STAGE(PG8_SB(0, 1), cB + hstep, voffB); PG8_STAGE(PG8_SA(0, 0), cA, voffA); PG8_STAGE(PG8_SA(0, 1), cA + hstep, voffA);
        if (wr == 1) PG8_BAR;
        PG8_WAIT_V(2); PG8_BAR;
        PG8_STAGE(PG8_SB(1, 0), cB + kstep, voffB); PG8_STAGE(PG8_SA(1, 0), cA + kstep, voffA); PG8_STAGE(PG8_SB(1, 1), cB + hstep + kstep, voffB);
        PG8_WAIT_V(6); PG8_BAR;
    } else {
        PG8_STAGE(PG8_SB(0, 0), cB, voffB); PG8_STAGE(PG8_SA(0, 0), cA, voffA); PG8_STAGE(PG8_SB(0, 1), cB + hstep, voffB); PG8_STAGE(PG8_SA(0, 1), cA + hstep, voffA);
        if (wr == 1) PG8_BAR;
        PG8_WAIT_V(4); PG8_BAR;
        PG8_STAGE(PG8_SB(1, 0), cB + kstep, voffB); PG8_STAGE(PG8_SA(1, 0), cA + kstep, voffA); PG8_STAGE(PG8_SB(1, 1), cB + hstep + kstep, voffB);
        PG8_WAIT_V(6); PG8_BAR;
    }
    for (;;) {
        const bool has_next = S.next(ui + 1, nxt);
        const char* nA = has_next ? (const char*)g.A + (size_t)nxt.pm * tstep : cA; const char* nB = has_next ? (const char*)g.Bt + (size_t)nxt.pn * tstep : cB;
        for (int t = 0; t < nt; t += 2) {
            const bool last = (t == nt - 2);
            const char* a1 = cA + (size_t)(t + 1) * kstep;
            const char* a2 = last ? nA : cA + (size_t)(t + 2) * kstep; const char* b2 = last ? nB : cB + (size_t)(t + 2) * kstep;
            const char* a3 = a2 + kstep; const char* b3 = b2 + kstep;
            if (last && has_next) S.a_ready(nxt);
            if constexpr (SP2) {
            PG8_LDB(B0, 0, 0); PG8_LDB(B1, 0, 1); PG8_SCHED; PG8_LDA(At, 0, 0); PG8_STAGE(PG8_SA(1, 1), a1 + hstep, voffA);
            PG8_WAIT_V(8); PG8_WAIT_L(0); PG8_BAR; PG8_MMA(0, 0, At, B0); PG8_MMA(0, 1, At, B1); PG8_BAR; PG8_SCHED;
            PG8_LDA(At, 0, 1); PG8_STAGE(PG8_SB(0, 0), b2, voffB); PG8_STAGE(PG8_SB(0, 1), b2 + hstep, voffB); PG8_STAGE(PG8_SA(0, 0), a2, voffA);
            PG8_WAIT_V(8); PG8_WAIT_L(0); PG8_BAR; PG8_MMA(1, 0, At, B0); PG8_MMA(1, 1, At, B1); PG8_BAR; PG8_SCHED;
            PG8_LDB(B0, 1, 0); PG8_LDB(B1, 1, 1); PG8_SCHED; PG8_LDA(At, 1, 0); PG8_STAGE(PG8_SA(0, 1), a2 + hstep, voffA);
            PG8_WAIT_V(8); PG8_WAIT_L(0); PG8_BAR; PG8_MMA(0, 0, At, B0); PG8_MMA(0, 1, At, B1); PG8_BAR; PG8_SCHED;
            PG8_LDA(At, 1, 1); PG8_STAGE(PG8_SB(1, 0), b3, voffB); PG8_STAGE(PG8_SB(1, 1), b3 + hstep, voffB); PG8_STAGE(PG8_SA(1, 0), a3, voffA);
            PG8_WAIT_V(8); PG8_WAIT_L(0); PG8_BAR; PG8_MMA(1, 0, At, B0); PG8_MMA(1, 1, At, B1); PG8_BAR; PG8_SCHED;
            } else {
            PG8_LDB(B0, 0, 0); PG8_SCHED; PG8_LDA(At, 0, 0); PG8_STAGE(PG8_SA(1, 1), a1 + hstep, voffA);
            PG8_WAIT_L(8); PG8_BAR; PG8_WAIT_L(0); PG8_MMA(0, 0, At, B0); PG8_BAR; PG8_SCHED;
            PG8_LDB(B1, 0, 1); PG8_STAGE(PG8_SB(0, 0), b2, voffB);
            PG8_BAR; PG8_WAIT_L(0); PG8_MMA(0, 1, At, B1); PG8_BAR;
            PG8_LDA(At, 0, 1); PG8_STAGE(PG8_SA(0, 0), a2, voffA);
            PG8_BAR; PG8_WAIT_L(0); PG8_MMA(1, 0, At, B0); PG8_BAR; PG8_SCHED;
            PG8_STAGE(PG8_SB(0, 1), b2 + hstep, voffB);
            PG8_WAIT_V(6); PG8_BAR; PG8_MMA(1, 1, At, B1); PG8_BAR;
            PG8_LDB(B0, 1, 0); PG8_SCHED; PG8_LDA(At, 1, 0); PG8_STAGE(PG8_SA(0, 1), a2 + hstep, voffA);
            PG8_WAIT_L(8); PG8_BAR; PG8_WAIT_L(0); PG8_MMA(0, 0, At, B0); PG8_BAR; PG8_SCHED;
            PG8_LDB(B1, 1, 1); PG8_STAGE(PG8_SB(1, 0), b3, voffB);
            PG8_BAR; PG8_WAIT_L(0); PG8_MMA(0, 1, At, B1); PG8_BAR;
            PG8_LDA(At, 1, 1); PG8_STAGE(PG8_SA(1, 0), a3, voffA);
            PG8_BAR; PG8_WAIT_L(0); PG8_MMA(1, 0, At, B0); PG8_BAR; PG8_SCHED;
            PG8_STAGE(PG8_SB(1, 1), b3 + hstep, voffB);
            PG8_WAIT_V(6); PG8_BAR; PG8_MMA(1, 1, At, B1); PG8_BAR;
            }
        }
        if constexpr (ALIGN_EPI) { if (wr == 0) PG8_BAR; }
        if constexpr (!Epi::AFTER_DRAIN) { E(acc, cur, wr, wc, fr, fq); S.done(cur); }
        if (!has_next) break;
#pragma unroll
        for (int a = 0; a < 2; ++a)
#pragma unroll
            for (int b = 0; b < 2; ++b)
#pragma unroll
                for (int m = 0; m < 4; ++m)
#pragma unroll
                    for (int n = 0; n < 2; ++n) acc[a][b][m][n] = (f32x4){0.f, 0.f, 0.f, 0.f};
        cur = nxt; cA = nA; cB = nB; ++ui;
        if constexpr (ALIGN_EPI) { if (wr == 1) PG8_BAR; }
    }
    PG8_WAIT_V(0);
    if constexpr (!ALIGN_EPI) { if (wr == 0) PG8_BAR; }
    PG8_BAR;
    if constexpr (Epi::AFTER_DRAIN) { E.fused(acc, cur, wr, wc, fr, fq, lds, wid, lane); S.done(cur); }
#undef PG8_SA
#undef PG8_SB
#undef PG8_STAGE
#undef PG8_LDA
#undef PG8_LDB
#undef PG8_MMA
#undef PG8_WAIT_V
#undef PG8_WAIT_L
#undef PG8_BAR
#undef PG8_SCHED
}
}
constexpr int NWAVES = 8, NTHR = 512;
constexpr int D = 2048, NBATCH = 4, SEQ = 4096, T = NBATCH * SEQ, DEPTH = 2;
constexpr int GLA_H = 4, GLA_DK = 128, GLA_DV = 256, GLA_CH = 64;
constexpr int MLP_H = 8, MLP_DH = 128, MLP_CH = 128;
constexpr int IN_COLS = 5136, NPROJ = 5120;
constexpr int C_Q = 0, C_K = 512, C_V = 1024, C_R = 2048, C_U = 3072, C_VS = 4096;
constexpr int NEXP = 16384, PEER_H = 8;
constexpr float EPS = 1e-6f;
constexpr int MODW = 6 * D;
constexpr size_t MiB = 1u << 20;
constexpr size_t WS_CTL = 0, CTL_ZERO_BYTES = 1 * MiB;
constexpr size_t WS_MOD = 1 * MiB;
constexpr size_t WS_K1B = 2 * MiB, WS_K2B = 2 * MiB + 512 * 1024, WS_WSB = 3 * MiB, WS_DEC = 3 * MiB + 512 * 1024, WS_ALOW = 4 * MiB;
constexpr size_t WS_KU = 5 * MiB, WS_KV = 5 * MiB + 256 * 1024;
constexpr size_t WS_SU = 6 * MiB, WS_HS = 7 * MiB;
constexpr size_t WS_WTIN = 8 * MiB;
constexpr size_t WTIN_L = (size_t)5136 * 2048;
constexpr size_t WS_WTOUT = 49 * MiB, WS_WTQ = 65 * MiB;
constexpr size_t WS_PUB = 81 * MiB, WS_PVB = 209 * MiB;
constexpr size_t WS_H = 337 * MiB;
constexpr size_t WS_PROJ = 401 * MiB;
constexpr size_t WS_SBUF = 561 * MiB;
constexpr size_t WS_CONCAT = 625 * MiB;
constexpr size_t WS_QB = 689 * MiB;
constexpr size_t WS_EB = 753 * MiB, WS_PG = 761 * MiB;
constexpr size_t WS_H8 = 769 * MiB, WS_COEF = 833 * MiB, WS_END = 841 * MiB;
static_assert(WS_WTIN + 2 * WTIN_L * 2 <= WS_WTOUT, "ws map");
constexpr int CW_BAR = 4096;
constexpr int RING_BYTES = 131072, LDSCTL_OFF = RING_BYTES, MISC_OFF = LDSCTL_OFF + 320, LDS_BYTES = 147456;

#define DI __device__ __forceinline__
#define LAS __attribute__((address_space(3)))
typedef unsigned short bf16;
typedef short bf16x8 __attribute__((ext_vector_type(8)));
typedef short s16x4 __attribute__((ext_vector_type(4)));
typedef short v4i16_t __attribute__((ext_vector_type(4)));
typedef __bf16 bf16x2_t __attribute__((ext_vector_type(2)));
typedef float f32x2_e __attribute__((ext_vector_type(2)));
typedef float f32x4 __attribute__((ext_vector_type(4)));
typedef float f32x2 __attribute__((ext_vector_type(2)));
typedef unsigned u32x4 __attribute__((ext_vector_type(4)));
typedef unsigned u32x2 __attribute__((ext_vector_type(2)));
typedef LAS unsigned char* ldsp;

DI unsigned pk2(float lo, float hi) { const f32x2_e v = {lo, hi}; return __builtin_bit_cast(unsigned, __builtin_convertvector(v, bf16x2_t)); }
DI unsigned f2bf(float f) { return pk2(f, 0.f) & 0xffffu; }
DI float bflo(unsigned u) { return __builtin_bit_cast(float, u << 16); }
DI float bfhi(unsigned u) { return __builtin_bit_cast(float, u & 0xffff0000u); }
DI float bf1(bf16 v) { return __builtin_bit_cast(float, ((unsigned)v) << 16); }
DI float fexp2(float x) { return __builtin_amdgcn_exp2f(x); }
DI float flog2(float x) { return __builtin_amdgcn_logf(x); }
DI float frcp(float x) { return __builtin_amdgcn_rcpf(x); }
DI float frsq(float x) { return __builtin_amdgcn_rsqf(x); }
DI float gelu_t(float x) { const float u = 0.7978845608f * (x + 0.044715f * x * x * x); return x * frcp(1.f + fexp2(-2.885390082f * u)); }
DI float silu_f(float x) { return x * frcp(1.f + fexp2(-1.442695041f * x)); }
template <int CTRL> DI float dppf(float v) { return __builtin_bit_cast(float, __builtin_amdgcn_update_dpp(0, __builtin_bit_cast(int, v), CTRL, 0xf, 0xf, true)); }
DI float wave_sum_u(float v) {
    v += dppf<0xB1>(v); v += dppf<0x4E>(v); v += dppf<0x141>(v); v += dppf<0x140>(v);
    const int iv = __builtin_bit_cast(int, v);
    return (__builtin_bit_cast(float, __builtin_amdgcn_readlane(iv, 0)) + __builtin_bit_cast(float, __builtin_amdgcn_readlane(iv, 16))) +
           (__builtin_bit_cast(float, __builtin_amdgcn_readlane(iv, 32)) + __builtin_bit_cast(float, __builtin_amdgcn_readlane(iv, 48)));
}
DI float wave_max_u(float v) {
    v = fmaxf(v, dppf<0xB1>(v)); v = fmaxf(v, dppf<0x4E>(v)); v = fmaxf(v, dppf<0x141>(v)); v = fmaxf(v, dppf<0x140>(v));
    const int iv = __builtin_bit_cast(int, v);
    return fmaxf(fmaxf(__builtin_bit_cast(float, __builtin_amdgcn_readlane(iv, 0)), __builtin_bit_cast(float, __builtin_amdgcn_readlane(iv, 16))),
                 fmaxf(__builtin_bit_cast(float, __builtin_amdgcn_readlane(iv, 32)), __builtin_bit_cast(float, __builtin_amdgcn_readlane(iv, 48))));
}
DI float wave_sum(float v) {
#pragma unroll
    for (int o = 1; o < 64; o <<= 1) v += __shfl_xor(v, o);
    return v;
}
DI float dot2bf(unsigned a, unsigned b, float c) { return __builtin_amdgcn_fdot2_f32_bf16(__builtin_bit_cast(bf16x2_t, a), __builtin_bit_cast(bf16x2_t, b), c, false); }
DI f32x4 mfma16(bf16x8 a, bf16x8 b, f32x4 c) { return __builtin_amdgcn_mfma_f32_16x16x32_bf16(a, b, c, 0, 0, 0); }
DI s16x4 tr4(const LAS bf16* p) { return __builtin_bit_cast(s16x4, __builtin_amdgcn_ds_read_tr16_b64_v4i16((LAS v4i16_t*)p)); }
DI bf16x8 tr8(const LAS bf16* p, int stride) { const s16x4 a = tr4(p), b = tr4(p + 4 * stride); return (bf16x8){a[0], a[1], a[2], a[3], b[0], b[1], b[2], b[3]}; }

#define XB_TMO      128
#define XB_XCNT(j)  (256  + 64 * (j))
#define XB_XSUB(j)  (1280 + 64 * (j))
#define XB_XGEN(j)  (2304 + 64 * (j))
#define XB_TOP      3328
#define XB_TOPGEN   3392
#define XCD_BAR_WORDS 3456
#define XB_SPIN_CAP (1u << 18)

__device__ __forceinline__ unsigned xb_ld(unsigned* p)              { return __hip_atomic_load(p, __ATOMIC_RELAXED, __HIP_MEMORY_SCOPE_AGENT); }
__device__ __forceinline__ unsigned xb_add(unsigned* p, unsigned v) { return __hip_atomic_fetch_add(p, v, __ATOMIC_RELAXED, __HIP_MEMORY_SCOPE_AGENT); }
__device__ __forceinline__ unsigned xb_xcc_id() { return (unsigned)__builtin_amdgcn_s_getreg((3 << 11) | 20) & 0xFu; }
#define XB_SPIN(cond, bar) do { unsigned _sp = 0; while (cond) { __builtin_amdgcn_s_sleep(1); \
    if ((++_sp & 255u) == 0u) { if (xb_ld(&(bar)[XB_TMO])) break; if (_sp > XB_SPIN_CAP) { atomicAdd(&(bar)[XB_TMO], 1u); break; } } } } while (0)

struct XcdBarrier {
    unsigned* bar; unsigned x;
    volatile LAS unsigned* st;
};

__device__ __forceinline__ XcdBarrier xcd_barrier_post(unsigned* bar, volatile LAS unsigned* st) {
    XcdBarrier b; b.bar = bar; b.x = xb_xcc_id(); b.st = st;
    if (threadIdx.x == 0) (void)xb_add(&bar[XB_XCNT(b.x)], 1u);
    return b;
}
__device__ __forceinline__ void xcd_barrier_complete(unsigned* bar, unsigned x, unsigned& nloc, unsigned& nx) {
    const unsigned G = gridDim.x * gridDim.y * gridDim.z;
    unsigned sum, cnt, mine, sp = 0u;
    for (;;) {
        sum = 0u; cnt = 0u; mine = 0u;
#pragma unroll
        for (unsigned j = 0; j < 16; ++j) { const unsigned c = xb_ld(&bar[XB_XCNT(j)]); sum += c; cnt += (c > 0u) ? 1u : 0u; mine = (j == x) ? c : mine; }
        if (sum == G) break;
        __builtin_amdgcn_s_sleep(1);
        if ((++sp & 255u) == 0u) { if (xb_ld(&bar[XB_TMO])) break; if (sp > XB_SPIN_CAP) { atomicAdd(&bar[XB_TMO], 1u); break; } }
    }
    nloc = mine > 0u ? mine : 1u; nx = cnt > 0u ? cnt : 1u;
}

__device__ __forceinline__ void xcd_barrier(const XcdBarrier& b) {
    asm volatile("s_waitcnt vmcnt(0)" ::: "memory");
    __syncthreads();
    if (threadIdx.x == 0) {
        unsigned* bar = b.bar;
        __builtin_amdgcn_s_waitcnt(0);
        unsigned nloc = b.st[0], nx = b.st[1];
        if (nloc == 0u) { xcd_barrier_complete(bar, b.x, nloc, nx); b.st[0] = nloc; b.st[1] = nx; }
        const unsigned old = xb_add(&bar[XB_XSUB(b.x)], 1u);
        const unsigned gen = old / nloc;
        if (old + 1u == (gen + 1u) * nloc) {
            __builtin_amdgcn_fence(__ATOMIC_RELEASE, "agent");
            asm volatile("s_waitcnt vmcnt(0)" ::: "memory");
            const unsigned og = xb_add(&bar[XB_TOP], 1u);
            const unsigned tg = og / nx;
            if (og + 1u == (tg + 1u) * nx) xb_add(&bar[XB_TOPGEN], 1u);
            else XB_SPIN(xb_ld(&bar[XB_TOPGEN]) == tg, bar);
            __builtin_amdgcn_fence(__ATOMIC_ACQUIRE, "agent");
            xb_add(&bar[XB_XGEN(b.x)], 1u);
            asm volatile("s_waitcnt vmcnt(0)" ::: "memory");
        } else {
            XB_SPIN(xb_ld(&bar[XB_XGEN(b.x)]) == gen, bar);
            __builtin_amdgcn_fence(__ATOMIC_ACQUIRE, "agent");
            asm volatile("s_waitcnt vmcnt(0)" ::: "memory");
        }
    }
    __syncthreads();
}
struct Ctx {
    ldsp lds; int tid, lane, wave, bid, G, gw, NGW;
    unsigned char* ws;
};
DI const float* KARG(int k) { asm volatile("" : "+s"(k)); return ((const float* const*)__builtin_amdgcn_kernarg_segment_ptr())[k]; }
#define LDS_WAIT() asm volatile("s_waitcnt lgkmcnt(0)" ::: "memory")
enum { I_X = 0, I_C, I_ADAW, I_ADAB, I_N1G, I_WIN, I_WA2, I_BA, I_GNG, I_VNG, I_MWS, I_MB, I_MOG, I_WOUT, I_N2G, I_WQ, I_K1, I_K2, I_PU, I_PV, I_FG };

DI void p0_ada(const Ctx& C) {
    LAS float* red = (LAS float*)C.lds;
    float* MOD = (float*)(C.ws + WS_MOD);
    for (int it = C.bid; it < 192; it += C.G) {
        const int l = it / 96, cg = it % 96, c0 = cg * 128 + C.lane * 2;
        const float* W = KARG(I_ADAW) + (size_t)l * D * MODW + (size_t)(C.wave * 256) * MODW + c0;
        float cv[4][4];
#pragma unroll
        for (int b = 0; b < 4; ++b)
#pragma unroll
            for (int i = 0; i < 4; ++i) cv[b][i] = silu_f(KARG(I_C)[b * D + C.wave * 256 + i * 64 + C.lane]);
        float acc[4][2];
#pragma unroll
        for (int b = 0; b < 4; ++b) { acc[b][0] = 0.f; acc[b][1] = 0.f; }
#pragma unroll
        for (int i = 0; i < 4; ++i) {
#pragma unroll 16
            for (int j = 0; j < 64; ++j) {
                const f32x2 w = *(const f32x2*)(W + (size_t)(i * 64 + j) * MODW);
#pragma unroll
                for (int b = 0; b < 4; ++b) { const float s = __builtin_bit_cast(float, __builtin_amdgcn_readlane(__builtin_bit_cast(int, cv[b][i]), j)); acc[b][0] += s * w.x; acc[b][1] += s * w.y; }
            }
        }
#pragma unroll
        for (int b = 0; b < 4; ++b) *(LAS f32x2*)(red + (C.wave * 4 + b) * 128 + C.lane * 2) = (f32x2){acc[b][0], acc[b][1]};
        __syncthreads();
        { const int b = C.tid >> 7, col = C.tid & 127; float s = KARG(I_ADAB)[l * MODW + cg * 128 + col];
#pragma unroll
          for (int w = 0; w < 8; ++w) s += red[(w * 4 + b) * 128 + col];
          MOD[(size_t)(l * 4 + b) * MODW + cg * 128 + col] = s; }
        __syncthreads();
    }
}
DI void transpose_item(const float* W, int ldw, int src_col0, int ncols, bf16* WT, int dst_row0, int k0, LAS float* scr, int lane) {
    const int cl = lane & 31;
    float v[32];
#pragma unroll
    for (int i = 0; i < 32; ++i) { const int kk = 2 * i + (lane >> 5); v[i] = 0.f; if (cl < ncols) v[i] = W[(size_t)(k0 + kk) * ldw + src_col0 + cl]; }
#pragma unroll
    for (int i = 0; i < 32; ++i) { const int kk = 2 * i + (lane >> 5); scr[kk * 33 + cl] = v[i]; }
    LDS_WAIT();
    const int c = lane & 7;
#pragma unroll
    for (int j = 0; j < 4; ++j) { const int n = (lane >> 3) + 8 * j;
        if (n < ncols) { const LAS float* s = scr + (8 * c) * 33 + n;
            u32x4 o; o.x = pk2(s[0 * 33], s[1 * 33]); o.y = pk2(s[2 * 33], s[3 * 33]); o.z = pk2(s[4 * 33], s[5 * 33]); o.w = pk2(s[6 * 33], s[7 * 33]);
            *(u32x4*)(WT + (size_t)(dst_row0 + n) * 2048 + k0 + 8 * c) = o; } }
    LDS_WAIT();
}
DI void p0_prologue(const Ctx& C) {
    p0_ada(C);
    LAS float* scr = (LAS float*)(C.lds + C.wave * 16384);
    constexpr int PER_L = (161 + 64 + 64) * 32;
    for (int it = C.gw; it < 2 * PER_L; it += C.NGW) {
        const int l = it / PER_L; int r = it % PER_L;
        if (r < 161 * 32) { const int kb = r / 161, nb = r % 161; bf16* WT = (bf16*)(C.ws + WS_WTIN) + (size_t)l * WTIN_L;
            const float* W = KARG(I_WIN) + (size_t)l * D * IN_COLS;
            if (nb < 160) { const int n0 = 32 * nb; transpose_item(W, IN_COLS, n0 + (n0 >= 3072 ? 16 : 0), 32, WT, n0, 64 * kb, scr, C.lane); }
            else transpose_item(W, IN_COLS, 3072, 16, WT, 5120, 64 * kb, scr, C.lane);
            continue; }
        r -= 161 * 32;
        if (r < 2048) { const int kb = r / 64, nb = r % 64; transpose_item(KARG(I_WOUT) + (size_t)l * D * D, D, 32 * nb, 32, (bf16*)(C.ws + WS_WTOUT) + (size_t)l * D * D, 32 * nb, 64 * kb, scr, C.lane); continue; }
        r -= 2048;
        { const int kb = r / 64, nb = r % 64; transpose_item(KARG(I_WQ) + (size_t)l * D * D, D, 32 * nb, 32, (bf16*)(C.ws + WS_WTQ) + (size_t)l * D * D, 32 * nb, 64 * kb, scr, C.lane); }
    }
    const int gt = C.bid * NTHR + C.tid, NT = C.G * NTHR;
    { bf16* K1B = (bf16*)(C.ws + WS_K1B); bf16* K2B = (bf16*)(C.ws + WS_K2B); bf16* WSB = (bf16*)(C.ws + WS_WSB);
      for (int i = gt; i < 262144; i += NT) { K1B[i] = (bf16)f2bf(KARG(I_K1)[i]); K2B[i] = (bf16)f2bf(KARG(I_K2)[i]);
          const int s = i & 127, t = (i >> 7) & 127; WSB[i] = (s <= t) ? (bf16)f2bf(KARG(I_MWS)[i]) : (bf16)0; } }
    { float* SU = (float*)(C.ws + WS_SU); int* KV = (int*)(C.ws + WS_KV);
#pragma unroll 1
      for (int row = C.gw; row < 4 * NEXP; row += C.NGW) {
          const int tb = row >> 15, rr = row & 32767;
          const f32x4* src = (const f32x4*)(KARG(tb ? I_PV : I_PU) + (size_t)rr * D) + C.lane;
          f32x4 v[8];
#pragma unroll
          for (int j = 0; j < 8; ++j) v[j] = src[64 * j];
          const int lyr = rr >> 14, ee = rr & 16383;
          unsigned* dst = (unsigned*)(C.ws + (tb ? WS_PVB : WS_PUB) + (size_t)lyr * NEXP * D + (size_t)ee * 256) + C.lane;
          if (tb) {
              float mx = 0.f;
#pragma unroll
              for (int j = 0; j < 8; ++j) mx = fmaxf(mx, fmaxf(fmaxf(fabsf(v[j].x), fabsf(v[j].y)), fmaxf(fabsf(v[j].z), fabsf(v[j].w))));
#pragma unroll
              for (int o = 1; o < 64; o <<= 1) mx = fmaxf(mx, __shfl_xor(mx, o));
              int k = 0;
              if (mx > 0.f) { k = (int)((__builtin_bit_cast(unsigned, 224.0f / mx) >> 23) & 255u) - 127; k = k < -60 ? -60 : (k > 60 ? 60 : k); }
              const float sc = __builtin_bit_cast(float, (unsigned)(k + 127) << 23);
#pragma unroll
              for (int j = 0; j < 8; ++j) { int p = 0; p = __builtin_amdgcn_cvt_pk_fp8_f32(v[j].x * sc, v[j].y * sc, p, false); p = __builtin_amdgcn_cvt_pk_fp8_f32(v[j].z * sc, v[j].w * sc, p, true); dst[(size_t)j * (NEXP * 256 / 4)] = (unsigned)p; }
              if (C.lane == 0) KV[rr] = k;
          } else {
#pragma unroll
              for (int j = 0; j < 8; ++j) {
                  float mx = fmaxf(fmaxf(fabsf(v[j].x), fabsf(v[j].y)), fmaxf(fabsf(v[j].z), fabsf(v[j].w)));
#pragma unroll
                  for (int o = 1; o < 64; o <<= 1) mx = fmaxf(mx, __shfl_xor(mx, o));
                  const float inv = mx > 0.f ? 127.0f / mx : 0.f;
                  const int q0 = (int)__builtin_rintf(v[j].x * inv), q1 = (int)__builtin_rintf(v[j].y * inv), q2 = (int)__builtin_rintf(v[j].z * inv), q3 = (int)__builtin_rintf(v[j].w * inv);
                  dst[(size_t)j * (NEXP * 256 / 4)] = (unsigned)(q0 & 255) | ((unsigned)(q1 & 255) << 8) | ((unsigned)(q2 & 255) << 16) | ((unsigned)q3 << 24);
                  if (C.lane == 0) SU[(size_t)(lyr * 8 + j) * NEXP + ee] = mx * (1.0f / 127.0f);
              }
          }
      } }
}
template <bool FP8 = false>
DI void norm_phase(const Ctx& C, const float* X, const float* g, const float* modl, int sh_off, int sc_off, bf16* Hout, unsigned char* H8 = nullptr, float* HS = nullptr, int* COEF = nullptr) {
    const int r0 = C.gw * 8, b = r0 >> 12;
    if (FP8) {
        u32x4* cz = (u32x4*)(COEF + (size_t)r0 * 128) + C.lane;
        unsigned z_ = 0u; asm volatile("" : "+v"(z_));
#pragma unroll
        for (int j = 0; j < 4; ++j) cz[64 * j] = (u32x4){z_, z_, z_, z_}; }
    const f32x4* shp = (const f32x4*)(modl + (size_t)b * MODW + sh_off); const f32x4* scp = (const f32x4*)(modl + (size_t)b * MODW + sc_off);
    f32x4 gm[8], shv[8];
#pragma unroll
    for (int j = 0; j < 8; ++j) { const int idx = 64 * j + C.lane; gm[j] = ((const f32x4*)g)[idx] * (scp[idx] + 1.0f); shv[j] = shp[idx]; }
#pragma unroll 1
    for (int i = 0; i < 8; ++i) {
        const f32x4* xr = (const f32x4*)(X + (size_t)(r0 + i) * D) + C.lane; f32x4 v[8]; float s = 0.f;
#pragma unroll
        for (int j = 0; j < 8; ++j) { v[j] = xr[64 * j]; s += (v[j].x * v[j].x + v[j].y * v[j].y) + (v[j].z * v[j].z + v[j].w * v[j].w); }
        const float rstd = frsq(wave_sum(s) * (1.f / D) + EPS);
        u32x2* o = (u32x2*)(Hout + (size_t)(r0 + i) * D) + C.lane;
#pragma unroll
        for (int j = 0; j < 8; ++j) { const f32x4 y = v[j] * rstd * gm[j] + shv[j]; u32x2 w; w.x = pk2(y.x, y.y); w.y = pk2(y.z, y.w); o[64 * j] = w;
            if (FP8) v[j] = y; }
        if (FP8) {
            float st[8];
            unsigned* h8 = (unsigned*)(H8 + (size_t)(r0 + i) * 2048) + C.lane;
#pragma unroll
            for (int j = 0; j < 8; ++j) {
                const float am = wave_max_u(fmaxf(fmaxf(fabsf(v[j].x), fabsf(v[j].y)), fmaxf(fabsf(v[j].z), fabsf(v[j].w))));
                const float qs = am > 0.f ? 127.0f / am : 0.f; st[j] = am * (1.0f / 127.0f);
                const int q0 = (int)__builtin_rintf(v[j].x * qs), q1 = (int)__builtin_rintf(v[j].y * qs), q2 = (int)__builtin_rintf(v[j].z * qs), q3 = (int)__builtin_rintf(v[j].w * qs);
                h8[64 * j] = (unsigned)(q0 & 255) | ((unsigned)(q1 & 255) << 8) | ((unsigned)(q2 & 255) << 16) | ((unsigned)q3 << 24); }
            if (C.lane == 0) { f32x4* hp = (f32x4*)(HS + (size_t)(r0 + i) * 8); hp[0] = (f32x4){st[0], st[1], st[2], st[3]}; hp[1] = (f32x4){st[4], st[5], st[6], st[7]}; }
        }
    }
}
DI void alow_phase(const Ctx& C, const bf16* Hb, const bf16* WtA, float* ALOW) {
    const int task = C.bid * 4 + (C.wave & 3), kh = C.wave >> 2, r0 = task * 16, fr = C.lane & 15, fq = C.lane >> 4;
    const bf16* ap = Hb + (size_t)(r0 + fr) * D + 8 * fq + 1024 * kh; const bf16* bp = WtA + (size_t)fr * D + 8 * fq + 1024 * kh;
    f32x4 acc = (f32x4){0.f, 0.f, 0.f, 0.f};
#pragma unroll 8
    for (int ks = 0; ks < 32; ++ks) { const bf16x8 a = *(const bf16x8*)(ap + 32 * ks), b = *(const bf16x8*)(bp + 32 * ks); acc = mfma16(a, b, acc); }
    LAS f32x4* xch = (LAS f32x4*)C.lds + (C.wave & 3) * 64 + C.lane;
    if (kh) *xch = acc;
    LDS_WAIT(); __builtin_amdgcn_s_barrier(); asm volatile("" ::: "memory");
    if (!kh) { acc += *xch;
#pragma unroll
        for (int r = 0; r < 4; ++r) ALOW[(size_t)(r0 + 4 * fq + r) * 16 + fr] = acc[r]; }
}
#define LBAR() do { asm volatile("s_waitcnt lgkmcnt(0)" ::: "memory"); __builtin_amdgcn_s_barrier(); asm volatile("" ::: "memory"); } while (0)
DI void gla_gates(const Ctx& C, LAS float* al, LAS float* tot, const f32x4 alv, const float (&w2)[16], const float bav, float (&Gl)[16], float& off, float& gref, float& g63) {
    const int d = C.tid & 127, jg = C.tid >> 7;
    if (C.tid < 256) ((LAS f32x4*)al)[C.tid] = alv;
    LBAR();
    float run = 0.f;
#pragma unroll
    for (int jj = 0; jj < 16; ++jj) {
        const LAS f32x4* ar = (const LAS f32x4*)(al + (jg * 16 + jj) * 16);
        const f32x4 a0 = ar[0], a1 = ar[1], a2 = ar[2], a3 = ar[3];
        float z = bav;
        z += a0.x * w2[0] + a0.y * w2[1] + a0.z * w2[2] + a0.w * w2[3];
        z += a1.x * w2[4] + a1.y * w2[5] + a1.z * w2[6] + a1.w * w2[7];
        z += a2.x * w2[8] + a2.y * w2[9] + a2.z * w2[10] + a2.w * w2[11];
        z += a3.x * w2[12] + a3.y * w2[13] + a3.z * w2[14] + a3.w * w2[15];
        const float ls = fminf(z, 0.f) - 0.6931471806f * flog2(1.f + fexp2(-1.442695041f * fabsf(z)));
        run += ls * (1.442695041f / 16.f);
        Gl[jj] = run;
    }
    tot[jg * 128 + d] = run;
    LBAR();
    const float t0_ = tot[d], t1_ = tot[128 + d], t2_ = tot[256 + d], t3_ = tot[384 + d];
    off = (jg > 0 ? t0_ : 0.f) + (jg > 1 ? t1_ : 0.f) + (jg > 2 ? t2_ : 0.f); gref = t0_ + t1_; g63 = (t0_ + t1_) + (t2_ + t3_);
}
constexpr int KST = 136, VST = 264, PST = 72;
typedef short s16x2_t __attribute__((ext_vector_type(2)));
struct GlaIn { f32x4 alv; s16x2_t qk[16]; u32x4 vt[4]; };
DI float qk_q(const s16x2_t v) { return __builtin_bit_cast(float, __builtin_bit_cast(unsigned, v) << 16); }
DI float qk_k(const s16x2_t v) { return __builtin_bit_cast(float, __builtin_bit_cast(unsigned, v) & 0xffff0000u); }
template <bool WITHQ, bool WITHV = true>
DI void gla_load(const Ctx& C, int idx, const bf16* PROJ, const float* ALOW, GlaIn& in) {
    const int b = idx >> 8, h = (idx >> 6) & 3, n = idx & 63, t0 = b * SEQ + n * 64, d = C.tid & 127, jg = C.tid >> 7;
    in.alv = (f32x4){0.f, 0.f, 0.f, 0.f};
    if (C.tid < 256) in.alv = ((const f32x4*)(ALOW + (size_t)t0 * 16))[C.tid];
#pragma unroll
    for (int jj = 0; jj < 16; ++jj) { const bf16* row = PROJ + (size_t)(t0 + jg * 16 + jj) * NPROJ + h * 128 + d; s16x2_t v = (s16x2_t){0, 0}; if (WITHQ) v.x = (short)row[C_Q]; v.y = (short)row[C_K]; in.qk[jj] = v; }
    if (WITHV) {
#pragma unroll
    for (int i = 0; i < 4; ++i) { const int c = C.tid + 512 * i, j = c >> 5, ec = c & 31; in.vt[i] = *(const u32x4*)(PROJ + (size_t)(t0 + j) * NPROJ + C_V + h * 256 + 8 * ec); } }
}
DI void gla_load_v(const Ctx& C, int idx, const bf16* PROJ, GlaIn& in) {
    const int b = idx >> 8, h = (idx >> 6) & 3, n = idx & 63, t0 = b * SEQ + n * 64;
#pragma unroll
    for (int i = 0; i < 4; ++i) { const int c = C.tid + 512 * i, j = c >> 5, ec = c & 31; in.vt[i] = *(const u32x4*)(PROJ + (size_t)(t0 + j) * NPROJ + C_V + h * 256 + 8 * ec); }
}
DI void store_v_tile(const Ctx& C, const GlaIn& in, LAS bf16* VL) {
#pragma unroll
    for (int i = 0; i < 4; ++i) { const int c = C.tid + 512 * i, j = c >> 5, ec = c & 31; *(LAS u32x4*)(VL + j * VST + 8 * ec) = in.vt[i]; }
}
DI void glaA_phase(const Ctx& C, int l, const bf16* PROJ, const float* ALOW, bf16* SBUF, float* DEC) {
    LAS float* al = (LAS float*)(C.lds); LAS float* tot = (LAS float*)(C.lds + 4096);
    LAS bf16* KD = (LAS bf16*)(C.lds + 8192); LAS bf16* VL = (LAS bf16*)(C.lds + 25600);
    const int d = C.tid & 127, jg = C.tid >> 7, h = (C.bid >> 6) & 3;
    float w2[16];
#pragma unroll
    for (int r = 0; r < 16; ++r) w2[r] = KARG(I_WA2)[(size_t)l * 16 * 512 + r * 512 + h * 128 + d];
    const float bav = KARG(I_BA)[(size_t)l * 512 + h * 128 + d];
    GlaIn cur, nxt;
    gla_load<false>(C, C.bid, PROJ, ALOW, cur);
#pragma unroll 1
    for (int i = 0; i < 4; ++i) {
        const int idx = i * C.G + C.bid;
        float Gl[16], off, gref, g63;
        gla_gates(C, al, tot, cur.alv, w2, bav, Gl, off, gref, g63);
#pragma unroll
        for (int jj = 0; jj < 16; ++jj) { const int j = jg * 16 + jj; KD[j * KST + d] = (bf16)f2bf(qk_k(cur.qk[jj]) * fexp2(g63 - (off + Gl[jj]))); }
        store_v_tile(C, cur, VL);
        LBAR();
        if (i + 1 < 4) gla_load<false>(C, idx + C.G, PROJ, ALOW, nxt);
        if (jg == 0) DEC[(size_t)idx * 128 + d] = fexp2(g63);
        const int lane = C.lane, g = lane >> 4, qq = (lane & 15) >> 2, p = lane & 3, fr = lane & 15;
        bf16x8 A[2];
#pragma unroll
        for (int ks = 0; ks < 2; ++ks) A[ks] = tr8(KD + (32 * ks + 8 * g + qq) * KST + 16 * C.wave + 4 * p, KST);
        bf16* Sit = SBUF + (size_t)idx * 256 * 128;
#pragma unroll
        for (int half = 0; half < 2; ++half) {
            f32x4 acc[8];
#pragma unroll
            for (int nt = 0; nt < 8; ++nt) acc[nt] = (f32x4){0.f, 0.f, 0.f, 0.f};
#pragma unroll
            for (int nt = 0; nt < 8; ++nt)
#pragma unroll
                for (int ks = 0; ks < 2; ++ks) { const bf16x8 Bf = tr8(VL + (32 * ks + 8 * g + qq) * VST + 16 * (half * 8 + nt) + 4 * p, VST); acc[nt] = mfma16(A[ks], Bf, acc[nt]); }
#pragma unroll
            for (int nt = 0; nt < 8; ++nt) { const int e = 16 * (half * 8 + nt) + fr, dd = 16 * C.wave + 4 * g;
                u32x2 w; w.x = pk2(acc[nt][0], acc[nt][1]); w.y = pk2(acc[nt][2], acc[nt][3]); *(u32x2*)(Sit + (size_t)e * 128 + dd) = w; }
        }
        LBAR();
        cur = nxt;
    }
}
DI void scan_phase(const Ctx& C, bf16* SBUF, const float* DEC) {
    const int gt = C.bid * NTHR + C.tid, bh = gt >> 13, rem = gt & 8191, e = rem >> 5, dq = rem & 31;
    u32x2* p = (u32x2*)(SBUF + ((size_t)(bh * 64) * 256 + e) * 128 + 4 * dq);
    const f32x4* dp = (const f32x4*)(DEC + (size_t)(bh * 64) * 128 + 4 * dq);
    f32x4 st = (f32x4){0.f, 0.f, 0.f, 0.f};
#pragma unroll 1
    for (int n0 = 0; n0 < 64; n0 += 8) {
        u32x2 tmp[8]; f32x4 dc[8];
#pragma unroll
        for (int u = 0; u < 8; ++u) { tmp[u] = p[(size_t)(n0 + u) * 8192]; dc[u] = dp[(n0 + u) * 32]; }
#pragma unroll
        for (int u = 0; u < 8; ++u) { u32x2 w; w.x = pk2(st.x, st.y); w.y = pk2(st.z, st.w); p[(size_t)(n0 + u) * 8192] = w;
            st = dc[u] * st + (f32x4){bflo(tmp[u].x), bfhi(tmp[u].x), bflo(tmp[u].y), bfhi(tmp[u].y)}; }
    }
}
DI void glaC_phase(const Ctx& C, int l, const bf16* PROJ, const float* ALOW, const bf16* SBUF, bf16* CONCAT) {
    const int h = (C.bid >> 6) & 3;
    LAS float* al = (LAS float*)(C.lds); LAS float* tot = (LAS float*)(C.lds + 4096); LAS float* RS = (LAS float*)(C.lds + 6144);
    LAS bf16* QT = (LAS bf16*)(C.lds + 8192); LAS bf16* KT = (LAS bf16*)(C.lds + 25600); LAS bf16* QG = (LAS bf16*)(C.lds + 43008);
    LAS bf16* VL = (LAS bf16*)(C.lds + 60416); LAS bf16* PL = (LAS bf16*)(C.lds + 94208);
    const int d = C.tid & 127, jg = C.tid >> 7;
    float w2[16];
#pragma unroll
    for (int r = 0; r < 16; ++r) w2[r] = KARG(I_WA2)[(size_t)l * 16 * 512 + r * 512 + h * 128 + d];
    const float bav = KARG(I_BA)[(size_t)l * 512 + h * 128 + d];
    const float* ng = KARG(I_GNG) + (size_t)(l * 4 + h) * 256;
    GlaIn cur;
    f32x4 alv_n; s16x2_t qkn[16];
    gla_load<true, false>(C, C.bid, PROJ, ALOW, cur);
#pragma unroll 1
    for (int it = 0; it < 4; ++it) {
    const int idx = it * C.G + C.bid, b = idx >> 8, n = idx & 63, t0 = b * SEQ + n * 64;
    gla_load_v(C, idx, PROJ, cur);
    float Gl[16], off, gref, g63;
    gla_gates(C, al, tot, cur.alv, w2, bav, Gl, off, gref, g63);
#pragma unroll
    for (int jj = 0; jj < 16; ++jj) { const int j = jg * 16 + jj; const float Gv = off + Gl[jj];
        const float q = qk_q(cur.qk[jj]) * 0.08838834764831845f, k = qk_k(cur.qk[jj]);
        QT[j * KST + d] = (bf16)f2bf(q * fexp2(fminf(Gv - gref, 100.f))); KT[j * KST + d] = (bf16)f2bf(k * fexp2(fminf(gref - Gv, 100.f))); QG[j * KST + d] = (bf16)f2bf(q * fexp2(Gv)); }
    store_v_tile(C, cur, VL);
    const int lane = C.lane, g = lane >> 4, qq = (lane & 15) >> 2, p = lane & 3, fr = lane & 15;
    bf16x8 Sf[2][4]; u32x2 rraw[4][2];
#pragma unroll
    for (int mi = 0; mi < 2; ++mi) { const bf16* Srow = SBUF + ((size_t)idx * 256 + 16 * (2 * C.wave + mi) + fr) * 128 + 8 * g;
#pragma unroll
        for (int ks = 0; ks < 4; ++ks) Sf[mi][ks] = *(const bf16x8*)(Srow + 32 * ks); }
#pragma unroll
    for (int nt = 0; nt < 4; ++nt)
#pragma unroll
        for (int mi = 0; mi < 2; ++mi) rraw[nt][mi] = *(const u32x2*)(PROJ + (size_t)(t0 + 16 * nt + fr) * NPROJ + C_R + h * 256 + 16 * (2 * C.wave + mi) + 4 * g);
    LBAR();
    if (it + 1 < 4) { const int ix = idx + C.G, t1 = (ix >> 8) * SEQ + (ix & 63) * 64;
        alv_n = (f32x4){0.f, 0.f, 0.f, 0.f}; if (C.tid < 256) alv_n = ((const f32x4*)(ALOW + (size_t)t1 * 16))[C.tid];
#pragma unroll
        for (int jj = 0; jj < 16; ++jj) { const bf16* row = PROJ + (size_t)(t1 + jg * 16 + jj) * NPROJ + h * 128 + d; s16x2_t v; v.x = (short)row[C_Q]; v.y = (short)row[C_K]; qkn[jj] = v; } }
    {
        const int nt = C.wave & 3;
#pragma unroll
        for (int mi = 0; mi < 2; ++mi) { const int mt = 2 * (C.wave >> 2) + mi; f32x4 acc = (f32x4){0.f, 0.f, 0.f, 0.f};
#pragma unroll
            for (int ks = 0; ks < 4; ++ks) { const bf16x8 a = *(const LAS bf16x8*)(KT + (16 * mt + fr) * KST + 32 * ks + 8 * g), bq = *(const LAS bf16x8*)(QT + (16 * nt + fr) * KST + 32 * ks + 8 * g); acc = mfma16(a, bq, acc); }
            const int i = 16 * nt + fr, j0 = 16 * mt + 4 * g;
            const float v0 = (j0 + 0 <= i) ? acc[0] : 0.f, v1 = (j0 + 1 <= i) ? acc[1] : 0.f, v2 = (j0 + 2 <= i) ? acc[2] : 0.f, v3 = (j0 + 3 <= i) ? acc[3] : 0.f;
            u32x2 w; w.x = pk2(v0, v1); w.y = pk2(v2, v3); *(LAS u32x2*)(PL + i * PST + j0) = w; }
    }
    LBAR();
    f32x4 acc[2][4];
#pragma unroll
    for (int mi = 0; mi < 2; ++mi)
#pragma unroll
        for (int nt = 0; nt < 4; ++nt) acc[mi][nt] = (f32x4){0.f, 0.f, 0.f, 0.f};
#pragma unroll
    for (int mi = 0; mi < 2; ++mi) { const int mt = 2 * C.wave + mi;
#pragma unroll
        for (int ks = 0; ks < 2; ++ks) { const bf16x8 a = tr8(VL + (32 * ks + 8 * g + qq) * VST + 16 * mt + 4 * p, VST);
#pragma unroll
            for (int nt = 0; nt < 4; ++nt) { const bf16x8 bp = *(const LAS bf16x8*)(PL + (16 * nt + fr) * PST + 32 * ks + 8 * g); acc[mi][nt] = mfma16(a, bp, acc[mi][nt]); } }
#pragma unroll
        for (int ks = 0; ks < 4; ++ks) { const bf16x8 a = Sf[mi][ks];
#pragma unroll
            for (int nt = 0; nt < 4; ++nt) { const bf16x8 bq = *(const LAS bf16x8*)(QG + (16 * nt + fr) * KST + 32 * ks + 8 * g); acc[mi][nt] = mfma16(a, bq, acc[mi][nt]); } }
    }
#pragma unroll
    for (int nt = 0; nt < 4; ++nt) { float s = 0.f;
#pragma unroll
        for (int mi = 0; mi < 2; ++mi) s += (acc[mi][nt][0] * acc[mi][nt][0] + acc[mi][nt][1] * acc[mi][nt][1]) + (acc[mi][nt][2] * acc[mi][nt][2] + acc[mi][nt][3] * acc[mi][nt][3]);
        s += __shfl_xor(s, 16); s += __shfl_xor(s, 32);
        if (g == 0) RS[C.wave * 64 + 16 * nt + fr] = s; }
    LBAR();
#pragma unroll
    for (int nt = 0; nt < 4; ++nt) { const int i = 16 * nt + fr; float ts = 0.f;
#pragma unroll
        for (int w = 0; w < 8; ++w) ts += RS[w * 64 + i];
        const float rstd = frsq(ts * (1.f / 256.f) + EPS);
#pragma unroll
        for (int mi = 0; mi < 2; ++mi) { const int e = 16 * (2 * C.wave + mi) + 4 * g;
            const u32x2 rr = rraw[nt][mi]; const f32x4 gg = *(const f32x4*)(ng + e);
            const float o0 = acc[mi][nt][0] * rstd * gg.x * silu_f(bflo(rr.x)), o1 = acc[mi][nt][1] * rstd * gg.y * silu_f(bfhi(rr.x));
            const float o2 = acc[mi][nt][2] * rstd * gg.z * silu_f(bflo(rr.y)), o3 = acc[mi][nt][3] * rstd * gg.w * silu_f(bfhi(rr.y));
            u32x2 w; w.x = pk2(o0, o1); w.y = pk2(o2, o3); *(u32x2*)(CONCAT + (size_t)(t0 + i) * D + h * 256 + e) = w; } }
    LBAR();
    cur.alv = alv_n;
#pragma unroll
    for (int jj = 0; jj < 16; ++jj) cur.qk[jj] = qkn[jj];
    }
}
constexpr int GST = 136;
DI void gmlp_phase(const Ctx& C, int l, const bf16* PROJ, const bf16* WSB, bf16* CONCAT) {
    const int h = C.bid & 7;
    LAS bf16* VL2 = (LAS bf16*)(C.lds); LAS bf16* UL = (LAS bf16*)(C.lds + 34816);
    const float* vg = KARG(I_VNG) + (size_t)(l * 8 + h) * 128; const float* og = KARG(I_MOG) + (size_t)(l * 8 + h) * 128; const float* bb = KARG(I_MB) + (size_t)(l * 8 + h) * 128;
    bf16x8 Wf[4];
    { const bf16* Wrow = WSB + ((size_t)(l * 8 + h) * 128 + 16 * C.wave + (C.lane & 15)) * 128 + 8 * (C.lane >> 4);
#pragma unroll
      for (int ks = 0; ks < 4; ++ks) Wf[ks] = *(const bf16x8*)(Wrow + 32 * ks); }
    u32x4 cu[4], cv[4], nu[4], nv[4];
#define GM_LOAD(IDX, U, V) do { const int t0_ = ((IDX) >> 8) * SEQ + (((IDX) >> 3) & 31) * 128; _Pragma("unroll") for (int i = 0; i < 4; ++i) { const int c = C.tid + 512 * i, t = c >> 4, ch = c & 15; \
        const bf16* row = PROJ + (size_t)(t0_ + t) * NPROJ + h * 128 + 8 * ch; U[i] = *(const u32x4*)(row + C_U); V[i] = *(const u32x4*)(row + C_VS); } } while (0)
    GM_LOAD(C.bid, cu, cv);
#pragma unroll 1
    for (int it = 0; it < 4; ++it) {
    const int idx = it * C.G + C.bid, n = (idx >> 3) & 31, b = idx >> 8, t0 = b * SEQ + n * 128;
#pragma unroll
    for (int i = 0; i < 4; ++i) { const int c = C.tid + 512 * i, t = c >> 4, ch = c & 15;
        const u32x4 uu = cu[i], vv = cv[i];
        float v[8] = {gelu_t(bflo(vv.x)), gelu_t(bfhi(vv.x)), gelu_t(bflo(vv.y)), gelu_t(bfhi(vv.y)), gelu_t(bflo(vv.z)), gelu_t(bfhi(vv.z)), gelu_t(bflo(vv.w)), gelu_t(bfhi(vv.w))};
        float ss = 0.f;
#pragma unroll
        for (int k = 0; k < 8; ++k) ss += v[k] * v[k];
        ss += __shfl_xor(ss, 1); ss += __shfl_xor(ss, 2); ss += __shfl_xor(ss, 4); ss += __shfl_xor(ss, 8);
        const float rstd = frsq(ss * (1.f / 128.f) + EPS);
        const f32x4 g0 = *(const f32x4*)(vg + 8 * ch), g1 = *(const f32x4*)(vg + 8 * ch + 4);
        u32x4 wv; wv.x = pk2(v[0] * rstd * g0.x, v[1] * rstd * g0.y); wv.y = pk2(v[2] * rstd * g0.z, v[3] * rstd * g0.w); wv.z = pk2(v[4] * rstd * g1.x, v[5] * rstd * g1.y); wv.w = pk2(v[6] * rstd * g1.z, v[7] * rstd * g1.w);
        *(LAS u32x4*)(VL2 + t * GST + 8 * ch) = wv;
        u32x4 wu; wu.x = pk2(gelu_t(bflo(uu.x)), gelu_t(bfhi(uu.x))); wu.y = pk2(gelu_t(bflo(uu.y)), gelu_t(bfhi(uu.y))); wu.z = pk2(gelu_t(bflo(uu.z)), gelu_t(bfhi(uu.z))); wu.w = pk2(gelu_t(bflo(uu.w)), gelu_t(bfhi(uu.w)));
        *(LAS u32x4*)(UL + t * GST + 8 * ch) = wu; }
    LBAR();
    if (it + 1 < 4) GM_LOAD(idx + C.G, nu, nv);
    const int lane = C.lane, g = lane >> 4, qq = (lane & 15) >> 2, p = lane & 3, fr = lane & 15;
    f32x4 acc[8];
#pragma unroll
    for (int mt = 0; mt < 8; ++mt) acc[mt] = (f32x4){0.f, 0.f, 0.f, 0.f};
    const int nks = (C.wave >> 1) + 1;
#pragma unroll
    for (int ks = 0; ks < 4; ++ks) if (ks < nks) { const bf16x8 bw = Wf[ks];
#pragma unroll
        for (int mt = 0; mt < 8; ++mt) { const bf16x8 a = tr8(VL2 + (32 * ks + 8 * g + qq) * GST + 16 * mt + 4 * p, GST); acc[mt] = mfma16(a, bw, acc[mt]); } }
    const int tl = 16 * C.wave + fr; const float bt = bb[tl]; float ss = 0.f;
#pragma unroll
    for (int mt = 0; mt < 8; ++mt) { const u32x2 uu = *(const LAS u32x2*)(UL + tl * GST + 16 * mt + 4 * g);
        acc[mt][0] = bflo(uu.x) * (acc[mt][0] + bt); acc[mt][1] = bfhi(uu.x) * (acc[mt][1] + bt); acc[mt][2] = bflo(uu.y) * (acc[mt][2] + bt); acc[mt][3] = bfhi(uu.y) * (acc[mt][3] + bt);
        ss += (acc[mt][0] * acc[mt][0] + acc[mt][1] * acc[mt][1]) + (acc[mt][2] * acc[mt][2] + acc[mt][3] * acc[mt][3]); }
    ss += __shfl_xor(ss, 16); ss += __shfl_xor(ss, 32);
    const float rstd = frsq(ss * (1.f / 128.f) + EPS);
#pragma unroll
    for (int mt = 0; mt < 8; ++mt) { const f32x4 gg = *(const f32x4*)(og + 16 * mt + 4 * g);
        u32x2 w; w.x = pk2(acc[mt][0] * rstd * gg.x, acc[mt][1] * rstd * gg.y); w.y = pk2(acc[mt][2] * rstd * gg.z, acc[mt][3] * rstd * gg.w);
        *(u32x2*)(CONCAT + (size_t)(t0 + tl) * D + 1024 + h * 128 + 16 * mt + 4 * g) = w; }
    LBAR();
#pragma unroll
    for (int i = 0; i < 4; ++i) { cu[i] = nu[i]; cv[i] = nv[i]; }
    }
#undef GM_LOAD
}
DI void list_insert(float (&L)[16], float x) {
#pragma unroll
    for (int i = 15; i >= 1; --i) L[i] = __builtin_amdgcn_fmed3f(x, L[i - 1], L[i]);
    L[0] = fmaxf(L[0], x);
}
DI void list_merge_xor(float (&L)[16], int mask) {
    float M[16];
#pragma unroll
    for (int i = 0; i < 16; ++i) M[i] = fmaxf(L[i], __shfl_xor(L[15 - i], mask));
#pragma unroll
    for (int s = 8; s >= 1; s >>= 1)
#pragma unroll
        for (int i = 0; i < 16; ++i) if ((i & s) == 0) { const float hi = fmaxf(M[i], M[i + s]), lo = fminf(M[i], M[i + s]); M[i] = hi; M[i + s] = lo; }
#pragma unroll
    for (int i = 0; i < 16; ++i) L[i] = M[i];
}
DI unsigned fbits(float x) { return __builtin_bit_cast(unsigned, x); }
DI float unp7(float x) { return __builtin_bit_cast(float, __builtin_bit_cast(unsigned, x) & 0xFFFFFF80u); }
constexpr int TKST = 136;
DI void topk_phase(const Ctx& C, int l, const bf16* QB, const bf16* K1B, const bf16* K2B, const int* KU, const int* KV, int* EB, float* PG) {
    LAS bf16* KL = (LAS bf16*)C.lds;
    LAS unsigned* tk = (LAS unsigned*)(C.lds + 2 * 128 * TKST * 2 + C.wave * 2048);
    const int lane = C.lane, fr = lane & 15, fq = lane >> 4, h = C.bid & 7, rank = C.bid >> 3;
#pragma unroll
    for (int i = 0; i < 8; ++i) { const int c = C.tid + 512 * i, tb = c >> 11, row = (c & 2047) >> 4, ch = c & 15;
        *(LAS u32x4*)(KL + (tb * 128 + row) * TKST + 8 * ch) = *(const u32x4*)((tb ? K2B : K1B) + ((size_t)(l * 8 + h) * 128 + row) * 128 + 8 * ch); }
    __syncthreads();
#pragma unroll 1
    for (int it = 0; it < 4; ++it) {
        const int tt0 = rank * 512 + C.wave * 64 + it * 16;
        float L[2][16];
        bf16x8 bq[2][4];
#pragma unroll
        for (int half = 0; half < 2; ++half)
#pragma unroll
            for (int ks = 0; ks < 4; ++ks) bq[half][ks] = *(const bf16x8*)(QB + (size_t)(tt0 + fr) * D + h * 256 + half * 128 + 8 * fq + 32 * ks);
#pragma unroll
        for (int half = 0; half < 2; ++half) {
            f32x4 acc[8];
#pragma unroll
            for (int mt = 0; mt < 8; ++mt) acc[mt] = (f32x4){0.f, 0.f, 0.f, 0.f};
            const LAS bf16* Kb = KL + (half * 128 + fr) * TKST + 8 * fq;
#pragma unroll
            for (int ks = 0; ks < 4; ++ks)
#pragma unroll
                for (int mt = 0; mt < 8; ++mt) { const bf16x8 a = *(const LAS bf16x8*)(Kb + (16 * mt) * TKST + 32 * ks); acc[mt] = mfma16(a, bq[half][ks], acc[mt]); }
#pragma unroll
            for (int i = 0; i < 16; ++i) L[half][i] = __builtin_bit_cast(float, 0xFF800000u);
#pragma unroll
            for (int mt = 0; mt < 8; ++mt)
#pragma unroll
                for (int r = 0; r < 4; ++r) { const unsigned key = (unsigned)(16 * mt + 4 * fq + r);
                    const float sv = acc[mt][r];
                    list_insert(L[half], __builtin_bit_cast(float, (fbits(sv) & 0xFFFFFF80u) | key)); }
            list_merge_xor(L[half], 16); list_merge_xor(L[half], 32);
        }
        if (fq == 0) {
#pragma unroll
            for (int i = 0; i < 16; ++i) { tk[(fr * 2 + 0) * 16 + i] = fbits(L[0][i]); tk[(fr * 2 + 1) * 16 + i] = fbits(L[1][i]); }
        }
        float Cn[16];
#pragma unroll
        for (int i = 0; i < 16; ++i) Cn[i] = __builtin_bit_cast(float, 0xFF800000u);
#pragma unroll
        for (int i = 0; i < 16; ++i)
#pragma unroll
            for (int j = 0; j < 16; ++j) if ((i + 1) * (j + 1) <= 16) {
                const float s = unp7(L[0][i]) + unp7(L[1][j]);
                list_insert(Cn, __builtin_bit_cast(float, (fbits(s) & 0xFFFFFF00u) | (unsigned)(i * 16 + j))); }
        LDS_WAIT();
        float sc[4]; int ex[4];
#pragma unroll
        for (int m = 0; m < 4; ++m) {
            const float ck = fq == 0 ? Cn[m] : (fq == 1 ? Cn[4 + m] : (fq == 2 ? Cn[8 + m] : Cn[12 + m]));
            const unsigned cc = fbits(ck) & 255u;
            const unsigned p1 = tk[(fr * 2 + 0) * 16 + (cc >> 4)], p2 = tk[(fr * 2 + 1) * 16 + (cc & 15u)];
            sc[m] = __builtin_bit_cast(float, p1 & 0xFFFFFF80u) + __builtin_bit_cast(float, p2 & 0xFFFFFF80u);
            ex[m] = (int)((p1 & 127u) * 128u + (p2 & 127u));
        }
        float mx = fmaxf(fmaxf(sc[0], sc[1]), fmaxf(sc[2], sc[3]));
        mx = fmaxf(mx, __shfl_xor(mx, 16)); mx = fmaxf(mx, __shfl_xor(mx, 32));
        float w[4], sum = 0.f;
#pragma unroll
        for (int m = 0; m < 4; ++m) { w[m] = fexp2((sc[m] - mx) * 1.442695041f); sum += w[m]; }
        sum += __shfl_xor(sum, 16); sum += __shfl_xor(sum, 32);
        const float inv = 1.0f / sum;
        const size_t o = (size_t)(tt0 + fr) * 128 + h * 16 + 4 * fq;
#pragma unroll
        for (int m = 0; m < 4; ++m) { const int kv = KV[ex[m]]; w[m] = w[m] * inv * __builtin_bit_cast(float, (unsigned)(127 - kv) << 23); ex[m] |= 127 << 16; }
        *(int4*)(EB + o) = make_int4(ex[0], ex[1], ex[2], ex[3]);
        *(f32x4*)(PG + o) = (f32x4){w[0], w[1], w[2], w[3]};
        LDS_WAIT();
    }
}
typedef unsigned char fp8_t;
DI void unpack16(const u32x4 q, float (&f)[16]) {
#pragma unroll
    for (int w = 0; w < 4; ++w) { const int dw = (int)q[w]; const f32x2 lo = __builtin_amdgcn_cvt_pk_f32_fp8(dw, false), hi = __builtin_amdgcn_cvt_pk_f32_fp8(dw, true);
        f[4 * w] = lo.x; f[4 * w + 1] = lo.y; f[4 * w + 2] = hi.x; f[4 * w + 3] = hi.y; }
}
DI int sdot4(int a, int b, int c) { return __builtin_amdgcn_sdot4(a, b, c, false); }
template <int CTRL> DI int dppi(int v) { return __builtin_amdgcn_update_dpp(0, v, CTRL, 0xf, 0xf, true); }
template <int CTRL, int NV> DI void bfly(int (&p)[32], const int base, const bool up) {
#pragma unroll
    for (int m = 0; m < NV / 2; ++m) { const int lo = p[base + m], hi = p[base + m + NV / 2]; const int keep = up ? hi : lo, send = up ? lo : hi; p[base + m] = keep + dppi<CTRL>(send); }
}
#define PU_ADD(P, V_) (void)__hip_atomic_fetch_add((P), (V_), __ATOMIC_RELAXED, __HIP_MEMORY_SCOPE_AGENT)
DI void peerU_phase(const Ctx& C, const unsigned char* H8, const float* HS, const int* EB, const unsigned char* PU8, const float* SU, int* COEF, const int emask = 0xFFFF) {
    const int x = C.bid & 7, rank = C.bid >> 3, lane = C.lane, g = lane >> 4, i16 = lane & 15;
    const __amdgpu_buffer_rsrc_t trs = __builtin_amdgcn_make_buffer_rsrc((void*)(PU8 + (size_t)x * NEXP * 256), 0, NEXP * 256, 0x00020000);
    const float* su = SU + (size_t)x * NEXP;
    const int tbase = rank * 512 + C.wave * 64;
    int* part = COEF + (size_t)tbase * 128 + lane;
    const int* ebase = EB + (size_t)tbase * 128 + lane;
    const unsigned char* hbase = H8 + (size_t)tbase * 2048 + 256 * x + 16 * i16;
    const float* hsb = HS + (size_t)tbase * 8 + x;
    const int bp0 = 64 * g, loff = 16 * i16;
    const bool b3 = (i16 & 8) != 0, b2 = (i16 & 4) != 0, b1 = (i16 & 2) != 0, b0 = (i16 & 1) != 0;
    int en0 = ebase[0] & emask, en1 = ebase[64] & emask;
    int er0 = ebase[128], er1 = ebase[192];
    u32x4 hh = *(const u32x4*)hbase;
    float sc0 = su[en0], sc1 = su[en1], hs = hsb[0];
    u32x4 buf[32];
#pragma unroll
    for (int u = 0; u < 32; ++u) { const int e = __builtin_amdgcn_ds_bpermute(bp0 + 4 * (u & 15), u < 16 ? en0 : en1); buf[u] = __builtin_amdgcn_raw_buffer_load_b128(trs, e * 256 + loff, 0, 0); }
    __builtin_amdgcn_sched_barrier(0);
    en0 = er0 & emask; en1 = er1 & emask;
    int pend0 = 0, pend1 = 0; int* pend_p = part;
#pragma unroll 1
    for (int ti = 0; ti < 64; ++ti) {
        const int tn = ti + 1 < 64 ? ti + 1 : 63, t2 = ti + 2 < 64 ? ti + 2 : 63;
        er0 = ebase[t2 * 128]; er1 = ebase[t2 * 128 + 64];
        const u32x4 hhn = *(const u32x4*)(hbase + (size_t)tn * 2048);
        const float scn0 = su[en0], scn1 = su[en1], hsn = hsb[tn * 8];
        __builtin_amdgcn_sched_barrier(0);
        int p[32];
#pragma unroll
        for (int u0 = 0; u0 < 32; u0 += 4) {
            int en[4];
#pragma unroll
            for (int u = u0; u < u0 + 4; ++u) en[u - u0] = __builtin_amdgcn_ds_bpermute(bp0 + 4 * (u & 15), u < 16 ? en0 : en1);
#pragma unroll
            for (int u = u0; u < u0 + 4; ++u) {
                const u32x4 r = buf[u];
                int ah = sdot4((int)r.x, (int)hh.x, 0); ah = sdot4((int)r.y, (int)hh.y, ah); ah = sdot4((int)r.z, (int)hh.z, ah); ah = sdot4((int)r.w, (int)hh.w, ah);
                p[u] = ah; }
            asm volatile("" : "+v"(p[u0]), "+v"(p[u0 + 1]), "+v"(p[u0 + 2]), "+v"(p[u0 + 3]) :: "memory");
#pragma unroll
            for (int u = u0; u < u0 + 4; ++u) buf[u] = __builtin_amdgcn_raw_buffer_load_b128(trs, en[u - u0] * 256 + loff, 0, 0);
            if (u0 == 12) { PU_ADD(pend_p, pend0); PU_ADD(pend_p + 64, pend1); }
            __builtin_amdgcn_sched_barrier(0);
        }
        bfly<0x140, 16>(p, 0, b3); bfly<0x140, 16>(p, 16, b3);
        bfly<0x141, 8>(p, 0, b2); bfly<0x141, 8>(p, 16, b2);
        bfly<0x4E, 4>(p, 0, b1); bfly<0x4E, 4>(p, 16, b1);
        bfly<0xB1, 2>(p, 0, b0); bfly<0xB1, 2>(p, 16, b0);
        pend0 = (int)__builtin_rintf(fminf(fmaxf((float)p[0] * (sc0 * hs * 16384.0f), -2.0e9f), 2.0e9f)); pend1 = (int)__builtin_rintf(fminf(fmaxf((float)p[16] * (sc1 * hs * 16384.0f), -2.0e9f), 2.0e9f)); pend_p = part + (size_t)ti * 128;
        asm volatile("" : "+v"(er0), "+v"(er1) :: "memory");
        en0 = er0 & emask; en1 = er1 & emask; hh = hhn; sc0 = scn0; sc1 = scn1; hs = hsn;
    }
    PU_ADD(pend_p, pend0); PU_ADD(pend_p + 64, pend1);
#undef PU_ADD
}
typedef long i64_t;
constexpr int PV_BLK = 272;
DI void peerV_phase(const Ctx& C, const int* EB, const float* PG, const int* COEF, const fp8_t* PV8, float* X, const float* gate  , const int emask = 0x3FFF, const long wdelta = 0  ) {
    const int x = C.bid & 7, rank = C.bid >> 3, lane = C.lane, g = lane >> 4, i16 = lane & 15;
    const __amdgpu_buffer_rsrc_t trs = __builtin_amdgcn_make_buffer_rsrc((void*)(PV8 + (size_t)x * NEXP * 256), 0, NEXP * 256, 0x00020000);
    const int tbase = rank * 512 + C.wave * 64;
    ldsp wl = C.lds + C.wave * (8 * PV_BLK);
    const int wr_off = g * PV_BLK + 16 * i16;
    const int rd_off = ((((lane >> 1) & 1) * 4) + (lane & 1)) * PV_BLK + 16 * (lane >> 2);
    const int bp0 = 64 * g, loff = 16 * i16;
    const int ash = (i16 < 8) ? 24 : 16, asl = 8 * (i16 & 3); const unsigned amlo = (i16 & 4) ? 0u : 0xFFFFFFFFu, amhi = ~amlo;
    const int* ebase = EB + (size_t)tbase * 128 + lane; const float* gbase = PG + (size_t)tbase * 128 + lane; const int* pbase = COEF + (size_t)tbase * 128 + lane;
    const int col = 256 * x + 4 * lane;
    const f32x4 gt = *(const f32x4*)(gate + (size_t)(tbase >> 12) * MODW + col);
    int pc0, pc1; float rg0, rg1;
#define PV_LOAD_RAW(tt) do { pc0 = pbase[(tt) * 128]; pc1 = pbase[(tt) * 128 + 64]; rg0 = gbase[(tt) * 128]; rg1 = gbase[(tt) * 128 + 64]; } while (0)
#define PV_PACK(PK0, PK1, INVA, ID0, ID1) do { const float s0_ = (float)pc0 * (1.0f / 16384.0f), s1_ = (float)pc1 * (1.0f / 16384.0f); \
        const float a0_ = gelu_t(s0_) * rg0, a1_ = gelu_t(s1_) * rg1; const float amax_ = wave_max_u(fmaxf(fabsf(a0_), fabsf(a1_))); \
        int ka_ = 0; if (amax_ > 0.f) { ka_ = (int)((__builtin_bit_cast(unsigned, 224.0f / amax_) >> 23) & 255u) - 127; ka_ = ka_ < -100 ? -100 : (ka_ > 100 ? 100 : ka_); } \
        const float sca_ = __builtin_bit_cast(float, (unsigned)(ka_ + 127) << 23); INVA = __builtin_bit_cast(float, (unsigned)(127 - ka_) << 23); \
        const float h0_ = a0_ * sca_, h1_ = a1_ * sca_; const int ph_ = __builtin_amdgcn_cvt_pk_fp8_f32(h0_, h1_, 0, false); const f32x2 bk_ = __builtin_amdgcn_cvt_pk_f32_fp8(ph_, false); \
        const int pl_ = __builtin_amdgcn_cvt_pk_fp8_f32((h0_ - bk_.x) * 16.0f, (h1_ - bk_.y) * 16.0f, 0, false); \
        PK0 = (int)(((unsigned)(ph_ & 255) << 24) | ((unsigned)(pl_ & 255) << 16) | (unsigned)(ID0)); PK1 = (int)(((unsigned)(ph_ & 0xFF00) << 16) | ((unsigned)(pl_ & 0xFF00) << 8) | (unsigned)(ID1)); } while (0)
    const int e0 = ebase[0] & emask, e1 = ebase[64] & emask;
    int er0 = ebase[128], er1 = ebase[192];
    PV_LOAD_RAW(0);
    f32x4* xp0 = (f32x4*)(X + (size_t)tbase * D + col);
    f32x4 xpend = *xp0; f32x4* xpend_p = (f32x4*)((float*)xp0 + wdelta);
    u32x4 buf[32];
#pragma unroll
    for (int u = 0; u < 32; ++u) { const int e = __builtin_amdgcn_ds_bpermute(bp0 + 4 * (u & 15), u < 16 ? e0 : e1); buf[u] = __builtin_amdgcn_raw_buffer_load_b128(trs, e * 256 + loff, 0, 0); }
    __builtin_amdgcn_sched_barrier(0);
    int pk0, pk1; float inva;
    PV_PACK(pk0, pk1, inva, er0 & emask, er1 & emask);
#pragma unroll 1
    for (int ti = 0; ti < 64; ++ti) {
        const int tn = ti + 1 < 64 ? ti + 1 : 63, t2 = ti + 2 < 64 ? ti + 2 : 63;
        er0 = ebase[t2 * 128]; er1 = ebase[t2 * 128 + 64];
        PV_LOAD_RAW(tn);
        f32x4* xp = (f32x4*)(X + (size_t)(tbase + ti) * D + col);
        const f32x4 xold = *xp;
        __builtin_amdgcn_sched_barrier(0);
        f32x4 d0 = (f32x4){0.f, 0.f, 0.f, 0.f}, d1 = d0;
#pragma unroll
        for (int u0 = 0; u0 < 32; u0 += 4) {
            int w[4];
#pragma unroll
            for (int u = u0; u < u0 + 4; ++u) w[u - u0] = __builtin_amdgcn_ds_bpermute(bp0 + 4 * (u & 15), u < 16 ? pk0 : pk1);
#pragma unroll
            for (int u = u0; u < u0 + 4; ++u) {
                const u32x4 r = buf[u]; const unsigned ab = (((unsigned)w[u - u0] >> ash) & 255u) << asl;
                const i64_t av = (i64_t)(((unsigned long long)(ab & amhi) << 32) | (ab & amlo));
                d0 = __builtin_amdgcn_mfma_f32_16x16x32_fp8_fp8(av, (i64_t)(((unsigned long long)r.y << 32) | r.x), d0, 0, 0, 0);
                d1 = __builtin_amdgcn_mfma_f32_16x16x32_fp8_fp8(av, (i64_t)(((unsigned long long)r.w << 32) | r.z), d1, 0, 0, 0); }
            asm volatile("" : "+v"(d0), "+v"(d1) :: "memory");
#pragma unroll
            for (int u = u0; u < u0 + 4; ++u) buf[u] = __builtin_amdgcn_raw_buffer_load_b128(trs, ((w[u - u0] & 0x3FFF) << 8) + loff, 0, 0);
            if (u0 == 12) *xpend_p = xpend;
            __builtin_amdgcn_sched_barrier(0);
        }
        *(LAS f32x4*)(wl + wr_off) = d0; *(LAS f32x4*)(wl + wr_off + 4 * PV_BLK) = d1;
        const f32x4 yh = *(const LAS f32x4*)(wl + rd_off), yl = *(const LAS f32x4*)(wl + rd_off + 2 * PV_BLK);
        const f32x4 y = (yh + yl * 0.0625f) * inva;
        xpend = xold + gt * y; xpend_p = (f32x4*)((float*)xp + wdelta);
        asm volatile("" : "+v"(er0), "+v"(er1) :: "memory");
        PV_PACK(pk0, pk1, inva, er0 & emask, er1 & emask);
    }
    *xpend_p = xpend;
#undef PV_LOAD_RAW
#undef PV_PACK
}
DI void final_norm_phase(const Ctx& C, float* X, const float* g) {
    const int r0 = C.gw * 8;
    f32x4 gm[8];
#pragma unroll
    for (int j = 0; j < 8; ++j) gm[j] = ((const f32x4*)g)[64 * j + C.lane];
#pragma unroll 1
    for (int i = 0; i < 8; ++i) {
        f32x4* xr = (f32x4*)(X + (size_t)(r0 + i) * D) + C.lane; f32x4 v[8]; float s = 0.f;
#pragma unroll
        for (int j = 0; j < 8; ++j) { v[j] = xr[64 * j]; s += (v[j].x * v[j].x + v[j].y * v[j].y) + (v[j].z * v[j].z + v[j].w * v[j].w); }
        const float rstd = frsq(wave_sum(s) * (1.f / D) + EPS);
#pragma unroll
        for (int j = 0; j < 8; ++j) xr[64 * j] = v[j] * rstd * gm[j];
    }
}
#ifndef PH_MASK
#define PH_MASK 0xFFFFF
#endif
#define EN(k) (((PH_MASK) >> (k)) & 1)
#ifndef GEMM_SP2
#define GEMM_SP2 true
#endif
#ifndef GEMM_ALIGN
#define GEMM_ALIGN false
#endif
constexpr int NKIND = 11, NPH = 2 + 2 * NKIND;
struct Args { const float* in[21]; float* out; unsigned char* ws; int ph_lo, ph_hi, pad0, pad1; };
__global__ void __launch_bounds__(NTHR, 2) mk_fwd(Args args) {
    extern __shared__ __attribute__((aligned(16))) unsigned char lds_raw[];
    ldsp ldsb = (ldsp)lds_raw;
    volatile LAS unsigned* MISC = (volatile LAS unsigned*)(ldsb + MISC_OFF);
    for (int u = threadIdx.x; u < (LDS_BYTES - LDSCTL_OFF) / 4; u += NTHR) ((LAS unsigned*)(ldsb + LDSCTL_OFF))[u] = 0u;
    __syncthreads();
    unsigned* barw = (unsigned*)(args.ws + WS_CTL) + CW_BAR;
    XcdBarrier bar; bar.bar = barw; bar.x = 0; bar.st = nullptr;
    const bool multi = (args.ph_hi - args.ph_lo) > 1;
    if (multi) bar = xcd_barrier_post(barw, MISC + 8);

#pragma unroll 1
    for (int ph = args.ph_lo; ph < args.ph_hi; ++ph) {
#define MKCTX Ctx C; { int tid_ = threadIdx.x, bid_ = blockIdx.x; asm volatile("" : "+v"(tid_)); asm volatile("" : "+s"(bid_)); \
        C.lds = ldsb; C.tid = tid_; C.lane = tid_ & 63; C.wave = __builtin_amdgcn_readfirstlane(tid_ >> 6); C.bid = bid_; C.G = gridDim.x; C.gw = C.bid * NWAVES + C.wave; C.NGW = C.G * NWAVES; \
        C.ws = args.ws; }
        unsigned char* const wsb = args.ws;
        float* MOD = (float*)(wsb + WS_MOD);
        bf16* Hb = (bf16*)(wsb + WS_H); bf16* PROJ = (bf16*)(wsb + WS_PROJ); bf16* SBUF = (bf16*)(wsb + WS_SBUF); bf16* CONCAT = (bf16*)(wsb + WS_CONCAT); bf16* QB = (bf16*)(wsb + WS_QB);
        float* ALOW = (float*)(wsb + WS_ALOW); float* DEC = (float*)(wsb + WS_DEC); int* EB = (int*)(wsb + WS_EB); float* PG = (float*)(wsb + WS_PG);
        float* X = args.out;
        const int l = ph < 2 ? 0 : (ph - 2) / NKIND, kind = ph < 2 ? -1 : (ph - 2) % NKIND;
        const float* modl = MOD + (size_t)l * 4 * MODW;
        if (ph == 0) { if (EN(0)) { MKCTX; p0_prologue(C); } }
        else if (ph == 1) { if (EN(1)) { MKCTX; norm_phase(C, KARG(I_X), KARG(I_N1G), modl, 0, D, Hb); } }
        else if ((kind == 0 || kind == 6) && EN(2)) {
            MKCTX; const bool isq = (kind == 6);
            pg8::Gemm g{Hb, isq ? (const bf16*)(wsb + WS_WTQ) + (size_t)l * D * D : (const bf16*)(wsb + WS_WTIN) + (size_t)l * WTIN_L, T, isq ? D : NPROJ, D};
            pg8::StaticOrder S; S.init(T, g.N, C.G, C.bid);
            pg8::EpiBf16 E{isq ? QB : PROJ, isq ? D : NPROJ};
            pg8::gemm_phase<pg8::EpiBf16, pg8::StaticOrder, GEMM_ALIGN, GEMM_SP2>(C.lds, g, S, E, C.tid);
            if (!isq) alow_phase(C, Hb, (const bf16*)(wsb + WS_WTIN) + (size_t)l * WTIN_L + (size_t)NPROJ * D, ALOW);
        }
        else if (kind == 1 && EN(3)) {
            MKCTX;
            glaA_phase(C, l, PROJ, ALOW, SBUF, DEC);
            gmlp_phase(C, l, PROJ, (const bf16*)(wsb + WS_WSB), CONCAT);
        }
        else if (kind == 2) { if (EN(4)) { MKCTX; scan_phase(C, SBUF, DEC); } }
        else if (kind == 3 && EN(5)) { MKCTX; glaC_phase(C, l, PROJ, ALOW, SBUF, CONCAT); }
        else if (kind == 4 && EN(6)) {
            MKCTX;
            pg8::Gemm g{CONCAT, (const bf16*)(wsb + WS_WTOUT) + (size_t)l * D * D, T, D, D};
            pg8::StaticOrder S; S.init(T, D, C.G, C.bid);
            pg8::EpiResGate E{l == 0 ? KARG(I_X) : (const float*)X, X, modl + 2 * D, MODW};
            pg8::gemm_phase<pg8::EpiResGate, pg8::StaticOrder, GEMM_ALIGN, GEMM_SP2>(C.lds, g, S, E, C.tid);
        }
        else if (kind == 5) { if (EN(1)) { MKCTX; norm_phase<true>(C, X, KARG(I_N2G) + (size_t)l * D, modl, 3 * D, 4 * D, Hb, wsb + WS_H8, (float*)(wsb + WS_HS), (int*)(wsb + WS_COEF)); } }
        else if (kind == 7) { if (EN(7)) { MKCTX; topk_phase(C, l, QB, (const bf16*)(wsb + WS_K1B), (const bf16*)(wsb + WS_K2B), (const int*)(wsb + WS_KU) + l * NEXP, (const int*)(wsb + WS_KV) + l * NEXP, EB, PG); } }
        else if (kind == 8) { if (EN(8)) { MKCTX; peerU_phase(C, wsb + WS_H8, (const float*)(wsb + WS_HS), EB, wsb + WS_PUB + (size_t)l * NEXP * D, (const float*)(wsb + WS_SU) + (size_t)l * 8 * NEXP, (int*)(wsb + WS_COEF)); } }
        else if (kind == 9) { if (EN(9)) { MKCTX; peerV_phase(C, EB, PG, (const int*)(wsb + WS_COEF), (const fp8_t*)(wsb + WS_PVB) + (size_t)l * NEXP * D, X, modl + 5 * D); } }
        else if (EN(10)) {
            MKCTX;
            if (l == DEPTH - 1) final_norm_phase(C, X, KARG(I_FG));
            else norm_phase(C, X, KARG(I_N1G) + (size_t)(l + 1) * D, MOD + (size_t)(l + 1) * 4 * MODW, 0, D, Hb);
        }
        if (ph + 1 < args.ph_hi) xcd_barrier(bar);
    }
}

extern "C" void kernel_launch(void* const* d_in, const int* in_sizes, int n_in, void* d_out, int out_size, void* d_ws, size_t ws_size, hipStream_t stream) {
    static int grid = 0;
    if (grid == 0) {
        if (n_in != 21 || out_size != T * D || ws_size < WS_END) { fprintf(stderr, "kernel_launch: unexpected shapes (n_in %d, out %d, ws %zu)\n", n_in, out_size, ws_size); grid = -1; return; }
        int dev = 0, cus = 0, per_cu = 0;
        if (hipGetDevice(&dev) != hipSuccess || hipDeviceGetAttribute(&cus, hipDeviceAttributeMultiprocessorCount, dev) != hipSuccess) { grid = -1; return; }
        if (hipFuncSetAttribute((const void*)mk_fwd, hipFuncAttributeMaxDynamicSharedMemorySize, LDS_BYTES) != hipSuccess) { fprintf(stderr, "kernel_launch: hipFuncSetAttribute failed\n"); grid = -1; return; }
        if (hipOccupancyMaxActiveBlocksPerMultiprocessor(&per_cu, (const void*)mk_fwd, NTHR, LDS_BYTES) != hipSuccess || per_cu < 1) { fprintf(stderr, "kernel_launch: occupancy query says %d blocks per CU\n", per_cu); (void)hipGetLastError(); grid = -1; return; }
        if (cus != 256) { fprintf(stderr, "kernel_launch: built for a 256-CU device (got %d)\n", cus); grid = -1; return; }
        grid = cus;
    }
    if (grid < 0) return;
    (void)hipMemsetAsync((char*)d_ws + WS_CTL, 0, CTL_ZERO_BYTES, stream);
    Args a{};
    for (int i = 0; i < 21; ++i) a.in[i] = (const float*)d_in[i];
    a.out = (float*)d_out; a.ws = (unsigned char*)d_ws;
#if MK_N_LAUNCHES == 1
    a.ph_lo = 0; a.ph_hi = NPH;
    hipLaunchKernelGGL(mk_fwd, dim3(grid), dim3(NTHR), LDS_BYTES, stream, a);
#else
    for (int p = 0; p < NPH; ++p) { a.ph_lo = p; a.ph_hi = p + 1; hipLaunchKernelGGL(mk_fwd, dim3(grid), dim3(NTHR), LDS_BYTES, stream, a); }
#endif
}
```

```cpp
#include <hip/hip_runtime.h>
#include <cstdio>
#include <cstdint>
#ifndef MK_N_LAUNCHES
#define MK_N_LAUNCHES 1
#endif
namespace pg8 {
#define PG8_LAS __attribute__((address_space(3)))
typedef unsigned short bf16_t;
typedef short bf16x8 __attribute__((ext_vector_type(8)));
typedef float f32x4 __attribute__((ext_vector_type(4)));
typedef unsigned u32x4 __attribute__((ext_vector_type(4)));
constexpr int BM = 256, BK = 64, HALF = 128, HTB = HALF * BK * 2  , STAGE_BYTES = 8 * HTB, NXCD = 8, WGM = 8;

__host__ __device__ __forceinline__ int lds_byte(int r, int c) { const int st = (r >> 4) * 2 + (c >> 5), rr = r & 15, cc = c & 31, ob = rr * 64 + cc * 2; return st * 1024 + (ob ^ (((ob >> 9) & 1) << 5)); }
__host__ __device__ __forceinline__ void stage_rc(int b, int& R, int& C) { const int st = b / 1024, sb = b % 1024, swz = sb ^ (((sb >> 9) & 1) << 5); R = (st >> 1) * 16 + swz / 64; C = (st & 1) * 32 + (swz % 64) / 2; }
__host__ __device__ __forceinline__ int perm32(int rho) { const int n = rho >> 4, i = rho & 15; return 8 * (i >> 2) + 4 * n + (i & 3); }

struct Unit { int pm, pn; };
struct Gemm { const bf16_t* A; const bf16_t* Bt; int M, N, K; };

struct StaticOrder {
    int nM, nN, nwg, G, c;
    __host__ __device__ void init(int M, int N, int G_, int c_) { nM = M / BM; nN = N / BM; nwg = nM * nN; G = G_; c = c_; }
    __host__ __device__ bool next(int i, Unit& u) const {
        const long L = (long)i * G + c; if (L >= nwg) return false;
        int wgid = (int)L; { const int q = nwg / NXCD, r = nwg % NXCD, xcd = wgid % NXCD, off = wgid / NXCD; wgid = (xcd < r ? xcd * (q + 1) : r * (q + 1) + (xcd - r) * q) + off; }
        const int nig = WGM * nN, gid = wgid / nig, fm = gid * WGM, gsz = (nM - fm) < WGM ? (nM - fm) : WGM;
        u.pm = fm + ((wgid % nig) % gsz); u.pn = (wgid % nig) / gsz; return true;
    }
    __device__ __forceinline__ void a_ready(const Unit&) const {}
    __device__ __forceinline__ void done(const Unit&) const {}
};
__device__ __forceinline__ unsigned cvt_pk_bf16(float lo, float hi) { unsigned r; asm volatile("v_cvt_pk_bf16_f32 %0, %1, %2" : "=v"(r) : "v"(lo), "v"(hi)); return r; }
struct EpiBf16 {
    static constexpr bool PERM = true, AFTER_DRAIN = false;
    bf16_t* O; int ldc;
    __device__ __forceinline__ void operator()(const f32x4 (&acc)[2][2][4][2], const Unit& u, int wr, int wc, int fr, int fq) const {
        const int row0 = u.pm * BM + wr * 64 + fr; const int col0 = u.pn * BM + wc * 32 + 8 * fq;
#pragma unroll
        for (int ai = 0; ai < 2; ++ai)
#pragma unroll
            for (int m = 0; m < 4; ++m) { bf16_t* rowp = O + (size_t)(row0 + ai * HALF + m * 16) * ldc + col0;
#pragma unroll
                for (int bj = 0; bj < 2; ++bj) { const f32x4 v0 = acc[ai][bj][m][0], v1 = acc[ai][bj][m][1];
                    u32x4 w; w.x = cvt_pk_bf16(v0[0], v0[1]); w.y = cvt_pk_bf16(v0[2], v0[3]); w.z = cvt_pk_bf16(v1[0], v1[1]); w.w = cvt_pk_bf16(v1[2], v1[3]);
                    *(u32x4*)(rowp + bj * HALF) = w; } }
    }
};
struct EpiResGate {
    static constexpr bool PERM = true, AFTER_DRAIN = false;
    const float* base32; const bf16_t* baseb; bf16_t* out; const float* gate; int gpitch;
    __device__ __forceinline__ void operator()(const f32x4 (&acc)[2][2][4][2], const Unit& u, int wr, int wc, int fr, int fq) const {
        const int row0 = u.pm * BM + wr * 64 + fr, col0 = u.pn * BM + wc * 32 + 8 * fq;
        const float* gp = gate + (size_t)(u.pm >> 4) * gpitch + col0;
        f32x4 gv[2][2];
#pragma unroll
        for (int bj = 0; bj < 2; ++bj)
#pragma unroll
            for (int n = 0; n < 2; ++n) gv[bj][n] = *(const f32x4*)(gp + bj * HALF + n * 4);
#define ERG_OFF(G_) ((size_t)(row0 + ((G_) >> 2) * HALF + ((G_) & 3) * 16) * 2048 + col0)
        if (base32) {
            f32x4 bs[2][2][2];
#define ERG_LOAD(G_) do { _Pragma("unroll") for (int bj = 0; bj < 2; ++bj) _Pragma("unroll") for (int n = 0; n < 2; ++n) bs[(G_) & 1][bj][n] = *(const f32x4*)(base32 + ERG_OFF(G_) + bj * HALF + n * 4); } while (0)
            ERG_LOAD(0); ERG_LOAD(1);
#pragma unroll
            for (int gq = 0; gq < 8; ++gq) {
#pragma unroll
                for (int bj = 0; bj < 2; ++bj) { const f32x4 v0 = bs[gq & 1][bj][0] + gv[bj][0] * acc[gq >> 2][bj][gq & 3][0], v1 = bs[gq & 1][bj][1] + gv[bj][1] * acc[gq >> 2][bj][gq & 3][1];
                    u32x4 w; w.x = cvt_pk_bf16(v0[0], v0[1]); w.y = cvt_pk_bf16(v0[2], v0[3]); w.z = cvt_pk_bf16(v1[0], v1[1]); w.w = cvt_pk_bf16(v1[2], v1[3]);
                    *(u32x4*)(out + ERG_OFF(gq) + bj * HALF) = w; }
                asm volatile("" ::: "memory");
                if (gq + 2 < 8) ERG_LOAD(gq + 2);
                asm volatile("" ::: "memory"); }
#undef ERG_LOAD
        } else {
            u32x4 bb[4][2];
#define ERG_LOADB(G_) do { _Pragma("unroll") for (int bj = 0; bj < 2; ++bj) bb[(G_) & 3][bj] = *(const u32x4*)(baseb + ERG_OFF(G_) + bj * HALF); } while (0)
            ERG_LOADB(0); ERG_LOADB(1); ERG_LOADB(2); ERG_LOADB(3);
#pragma unroll
            for (int gq = 0; gq < 8; ++gq) {
#pragma unroll
                for (int bj = 0; bj < 2; ++bj) { const u32x4 b = bb[gq & 3][bj];
                    const f32x4 b0 = (f32x4){__builtin_bit_cast(float, b.x << 16), __builtin_bit_cast(float, b.x & 0xffff0000u), __builtin_bit_cast(float, b.y << 16), __builtin_bit_cast(float, b.y & 0xffff0000u)};
                    const f32x4 b1 = (f32x4){__builtin_bit_cast(float, b.z << 16), __builtin_bit_cast(float, b.z & 0xffff0000u), __builtin_bit_cast(float, b.w << 16), __builtin_bit_cast(float, b.w & 0xffff0000u)};
                    const f32x4 v0 = b0 + gv[bj][0] * acc[gq >> 2][bj][gq & 3][0], v1 = b1 + gv[bj][1] * acc[gq >> 2][bj][gq & 3][1];
                    u32x4 w; w.x = cvt_pk_bf16(v0[0], v0[1]); w.y = cvt_pk_bf16(v0[2], v0[3]); w.z = cvt_pk_bf16(v1[0], v1[1]); w.w = cvt_pk_bf16(v1[2], v1[3]);
                    *(u32x4*)(out + ERG_OFF(gq) + bj * HALF) = w; }
                asm volatile("" ::: "memory");
                if (gq + 4 < 8) ERG_LOADB(gq + 4);
                asm volatile("" ::: "memory"); }
#undef ERG_LOADB
        }
#undef ERG_OFF
    }
};
template <class Epi, class Sched, bool ALIGN_EPI = false, bool SP2 = false>
__device__ __forceinline__ void gemm_phase(PG8_LAS unsigned char* lds, const Gemm g, const Sched& S, const Epi& E, const int tid  ) {
    const int wid = __builtin_amdgcn_readfirstlane(tid >> 6), lane = tid & 63, wr = wid >> 2, wc = wid & 3, fr = lane & 15, fq = lane >> 4;
    const int K = g.K, nt = K / BK;
    unsigned voffA[2], voffB[2];
#pragma unroll
    for (int i = 0; i < 2; ++i) { int R, C; stage_rc(tid * 16 + i * 8192, R, C); const int Rb = Epi::PERM ? ((R & ~31) + perm32(R & 31)) : R;
        voffA[i] = (unsigned)(R * K + C) * 2u; voffB[i] = (unsigned)(Rb * K + C) * 2u; }
    const size_t kstep = (size_t)(BK * 2);
    const size_t hstep = (size_t)HALF * K * 2;
    const size_t tstep = 2 * hstep;
    const unsigned ldsw = (unsigned)wid * 1024u;
    const int aoff = lds_byte(wr * 64 + fr, fq * 8), boff = lds_byte(wc * 32 + fr, fq * 8);
#define PG8_SA(b, h) (((b) * 2 + (h)) * HTB)
#define PG8_SB(b, h) ((4 + (b) * 2 + (h)) * HTB)
#define PG8_STAGE(bufoff, gbase, voff) do { _Pragma("unroll") for (int _i = 0; _i < 2; ++_i) \
        __builtin_amdgcn_global_load_lds((const unsigned*)((const char*)(gbase) + (voff)[_i]), (PG8_LAS unsigned*)(lds + (bufoff) + ldsw + _i * 8192), 16, 0, 0); } while (0)
#define PG8_LDA(dst, b, h) do { _Pragma("unroll") for (int m = 0; m < 4; ++m) _Pragma("unroll") for (int k = 0; k < 2; ++k) dst[m][k] = *(const PG8_LAS bf16x8*)(lds + PG8_SA(b, h) + aoff + m * 2048 + k * 1024); } while (0)
#define PG8_LDB(dst, b, h) do { _Pragma("unroll") for (int n = 0; n < 2; ++n) _Pragma("unroll") for (int k = 0; k < 2; ++k) dst[n][k] = *(const PG8_LAS bf16x8*)(lds + PG8_SB(b, h) + boff + n * 2048 + k * 1024); } while (0)
#define PG8_MMA(ai, bj, At, Bt) do { __builtin_amdgcn_s_setprio(1); _Pragma("unroll") for (int m = 0; m < 4; ++m) _Pragma("unroll") for (int n = 0; n < 2; ++n) _Pragma("unroll") for (int k = 0; k < 2; ++k) \
        acc[ai][bj][m][n] = __builtin_amdgcn_mfma_f32_16x16x32_bf16(Bt[n][k], At[m][k], acc[ai][bj][m][n], 0, 0, 0); __builtin_amdgcn_s_setprio(0); } while (0)
#define PG8_WAIT_V(n) asm volatile("s_waitcnt vmcnt(" #n ")" ::: "memory")
#define PG8_WAIT_L(n) asm volatile("s_waitcnt lgkmcnt(" #n ")" ::: "memory")
#define PG8_BAR __builtin_amdgcn_s_barrier()
#define PG8_SCHED __builtin_amdgcn_sched_barrier(0)
    Unit cur, nxt; int ui = 0;
    if (!S.next(0, cur)) return;
    f32x4 acc[2][2][4][2];
#pragma unroll
    for (int a = 0; a < 2; ++a)
#pragma unroll
        for (int b = 0; b < 2; ++b)
#pragma unroll
            for (int m = 0; m < 4; ++m)
#pragma unroll
                for (int n = 0; n < 2; ++n) acc[a][b][m][n] = (f32x4){0.f, 0.f, 0.f, 0.f};
    bf16x8 At[4][2], B0[2][2], B1[2][2];
    const char* cA = (const char*)g.A + (size_t)cur.pm * tstep; const char* cB = (const char*)g.Bt + (size_t)cur.pn * tstep;
    S.a_ready(cur);
    if constexpr (SP2) {
        PG8_STAGE(PG8_SB(0, 0), cB, voffB); PG8_STAGE(PG8_SB(0, 1), cB + hstep, voffB); PG8_STAGE(PG8_SA(0, 0), cA, voffA); PG8_STAGE(PG8_SA(0, 1), cA + hstep, voffA);
        if (wr == 1) PG8_BAR;
        PG8_WAIT_V(2); PG8_BAR;
        PG8_STAGE(PG8_SB(1, 0), cB + kstep, voffB); PG8_STAGE(PG8_SA(1, 0), cA + kstep, voffA); PG8_STAGE(PG8_SB(1, 1), cB + hstep + kstep, voffB);
        PG8_WAIT_V(6); PG8_BAR;
    } else {
        PG8_STAGE(PG8_SB(0, 0), cB, voffB); PG8_STAGE(PG8_SA(0, 0), cA, voffA); PG8_STAGE(PG8_SB(0, 1), cB + hstep, voffB); PG8_STAGE(PG8_SA(0, 1), cA + hstep, voffA);
        if (wr == 1) PG8_BAR;
        PG8_WAIT_V(4); PG8_BAR;
        PG8_STAGE(PG8_SB(1, 0), cB + kstep, voffB); PG8_STAGE(PG8_SA(1, 0), cA + kstep, voffA); PG8_STAGE(PG8_SB(1, 1), cB + hstep + kstep, voffB);
        PG8_WAIT_V(6); PG8_BAR;
    }
    for (;;) {
        const bool has_next = S.next(ui + 1, nxt);
        const char* nA = has_next ? (const char*)g.A + (size_t)nxt.pm * tstep : cA; const char* nB = has_next ? (const char*)g.Bt + (size_t)nxt.pn * tstep : cB;
        for (int t = 0; t < nt; t += 2) {
            const bool last = (t == nt - 2);
            const char* a1 = cA + (size_t)(t + 1) * kstep;
            const char* a2 = last ? nA : cA + (size_t)(t + 2) * kstep; const char* b2 = last ? nB : cB + (size_t)(t + 2) * kstep;
            const char* a3 = a2 + kstep; const char* b3 = b2 + kstep;
            if (last && has_next) S.a_ready(nxt);
            if constexpr (SP2) {
            PG8_LDB(B0, 0, 0); PG8_LDB(B1, 0, 1); PG8_SCHED; PG8_LDA(At, 0, 0); PG8_STAGE(PG8_SA(1, 1), a1 + hstep, voffA);
            PG8_WAIT_V(8); PG8_WAIT_L(0); PG8_BAR; PG8_MMA(0, 0, At, B0); PG8_MMA(0, 1, At, B1); PG8_BAR; PG8_SCHED;
            PG8_LDA(At, 0, 1); PG8_STAGE(PG8_SB(0, 0), b2, voffB); PG8_STAGE(PG8_SB(0, 1), b2 + hstep, voffB); PG8_STAGE(PG8_SA(0, 0), a2, voffA);
            PG8_WAIT_V(8); PG8_WAIT_L(0); PG8_BAR; PG8_MMA(1, 0, At, B0); PG8_MMA(1, 1, At, B1); PG8_BAR; PG8_SCHED;
            PG8_LDB(B0, 1, 0); PG8_LDB(B1, 1, 1); PG8_SCHED; PG8_LDA(At, 1, 0); PG8_STAGE(PG8_SA(0, 1), a2 + hstep, voffA);
            PG8_WAIT_V(8); PG8_WAIT_L(0); PG8_BAR; PG8_MMA(0, 0, At, B0); PG8_MMA(0, 1, At, B1); PG8_BAR; PG8_SCHED;
            PG8_LDA(At, 1, 1); PG8_STAGE(PG8_SB(1, 0), b3, voffB); PG8_STAGE(PG8_SB(1, 1), b3 + hstep, voffB); PG8_STAGE(PG8_SA(1, 0), a3, voffA);
            PG8_WAIT_V(8); PG8_WAIT_L(0); PG8_BAR; PG8_MMA(1, 0, At, B0); PG8_MMA(1, 1, At, B1); PG8_BAR; PG8_SCHED;
            } else {
            PG8_LDB(B0, 0, 0); PG8_SCHED; PG8_LDA(At, 0, 0); PG8_STAGE(PG8_SA(1, 1), a1 + hstep, voffA);
            PG8_WAIT_L(8); PG8_BAR; PG8_WAIT_L(0); PG8_MMA(0, 0, At, B0); PG8_BAR; PG8_SCHED;
            PG8_LDB(B1, 0, 1); PG8_STAGE(PG8_SB(0, 0), b2, voffB);
            PG8_BAR; PG8_WAIT_L(0); PG8_MMA(0, 1, At, B1); PG8_BAR;
            PG8_LDA(At, 0, 1); PG8_STAGE(PG8_SA(0, 0), a2, voffA);
            PG8_BAR; PG8_WAIT_L(0); PG8_MMA(1, 0, At, B0); PG8_BAR; PG8_SCHED;
            PG8_STAGE(PG8_SB(0, 1), b2 + hstep, voffB);
            PG8_WAIT_V(6); PG8_BAR; PG8_MMA(1, 1, At, B1); PG8_BAR;
            PG8_LDB(B0, 1, 0); PG8_SCHED; PG8_LDA(At, 1, 0); PG8_STAGE(PG8_SA(0, 1), a2 + hstep, voffA);
            PG8_WAIT_L(8); PG8_BAR; PG8_WAIT_L(0); PG8_MMA(0, 0, At, B0); PG8_BAR; PG8_SCHED;
            PG8_LDB(B1, 1, 1); PG8_STAGE(PG8_SB(1, 0), b3, voffB);
            PG8_BAR; PG8_WAIT_L(0); PG8_MMA(0, 1, At, B1); PG8_BAR;
            PG8_LDA(At, 1, 1); PG8_STAGE(PG8_SA(1, 0), a3, voffA);
            PG8_BAR; PG8_WAIT_L(0); PG8_MMA(1, 0, At, B0); PG8_BAR; PG8_SCHED;
            PG8_STAGE(PG8_SB(1, 1), b3 + hstep, voffB);
            PG8_WAIT_V(6); PG8_BAR; PG8_MMA(1, 1, At, B1); PG8_BAR;
            }
        }
        if constexpr (ALIGN_EPI) { if (wr == 0) PG8_BAR; }
        if constexpr (!Epi::AFTER_DRAIN) { E(acc, cur, wr, wc, fr, fq); S.done(cur); }
        if (!has_next) break;
#pragma unroll
        for (int a = 0; a < 2; ++a)
#pragma unroll
            for (int b = 0; b < 2; ++b)
#pragma unroll
                for (int m = 0; m < 4; ++m)
#pragma unroll
                    for (int n = 0; n < 2; ++n) acc[a][b][m][n] = (f32x4){0.f, 0.f, 0.f, 0.f};
        cur = nxt; cA = nA; cB = nB; ++ui;
        if constexpr (ALIGN_EPI) { if (wr == 1) PG8_BAR; }
    }
    PG8_WAIT_V(0);
    if constexpr (!ALIGN_EPI) { if (wr == 0) PG8_BAR; }
    PG8_BAR;
    if constexpr (Epi::AFTER_DRAIN) { E.fused(acc, cur, wr, wc, fr, fq, lds, wid, lane); S.done(cur); }
#undef PG8_SA
#undef PG8_SB
#undef PG8_STAGE
#undef PG8_LDA
#undef PG8_LDB
#undef PG8_MMA
#undef PG8_WAIT_V
#undef PG8_WAIT_L
#undef PG8_BAR
#undef PG8_SCHED
}
}
constexpr int NWAVES = 8, NTHR = 512;
constexpr int D = 2048, NBATCH = 4, SEQ = 4096, T = NBATCH * SEQ, DEPTH = 2;
constexpr int GLA_H = 4, GLA_DK = 128, GLA_DV = 256, GLA_CH = 64;
constexpr int MLP_H = 8, MLP_DH = 128, MLP_CH = 128;
constexpr int IN_COLS = 5136, NPROJ = 5120;
constexpr int C_Q = 0, C_K = 512, C_V = 1024, C_R = 2048, C_U = 3072, C_VS = 4096;
constexpr int NEXP = 16384, PEER_H = 8;
constexpr float EPS = 1e-6f;
constexpr int MODW = 6 * D;
constexpr size_t MiB = 1u << 20;
constexpr size_t WS_CTL = 0, CTL_ZERO_BYTES = 1 * MiB;
constexpr size_t WS_MOD = 1 * MiB;
constexpr size_t WS_K1B = 2 * MiB, WS_K2B = 2 * MiB + 512 * 1024, WS_WSB = 3 * MiB, WS_DEC = 3 * MiB + 512 * 1024, WS_ALOW = 4 * MiB;
constexpr size_t WS_KU = 5 * MiB, WS_KV = 5 * MiB + 256 * 1024;
constexpr size_t WS_SU = 6 * MiB, WS_HS = 7 * MiB;
constexpr size_t WS_WTIN = 8 * MiB;
constexpr size_t WTIN_L = (size_t)5136 * 2048;
constexpr size_t WS_WTOUT = 49 * MiB, WS_WTQ = 65 * MiB;
constexpr size_t WS_PUB = 81 * MiB, WS_PVB = 209 * MiB;
constexpr size_t WS_H = 337 * MiB;
constexpr size_t WS_PROJ = 401 * MiB;
constexpr size_t WS_SBUF = 561 * MiB;
constexpr size_t WS_CONCAT = 625 * MiB;
constexpr size_t WS_QB = 689 * MiB;
constexpr size_t WS_EB = 753 * MiB, WS_PG = 761 * MiB;
constexpr size_t WS_H8 = 769 * MiB, WS_COEF = 833 * MiB, WS_XB = 841 * MiB, WS_END = 905 * MiB;
static_assert(WS_WTIN + 2 * WTIN_L * 2 <= WS_WTOUT, "ws map");
constexpr int CW_BAR = 4096;
constexpr int RING_BYTES = 131072, LDSCTL_OFF = RING_BYTES, MISC_OFF = LDSCTL_OFF + 320, LDS_BYTES = 147456;

#define DI __device__ __forceinline__
#define LAS __attribute__((address_space(3)))
typedef unsigned short bf16;
typedef short bf16x8 __attribute__((ext_vector_type(8)));
typedef short s16x4 __attribute__((ext_vector_type(4)));
typedef short v4i16_t __attribute__((ext_vector_type(4)));
typedef __bf16 bf16x2_t __attribute__((ext_vector_type(2)));
typedef float f32x2_e __attribute__((ext_vector_type(2)));
typedef float f32x4 __attribute__((ext_vector_type(4)));
typedef float f32x2 __attribute__((ext_vector_type(2)));
typedef unsigned u32x4 __attribute__((ext_vector_type(4)));
typedef unsigned u32x2 __attribute__((ext_vector_type(2)));
typedef LAS unsigned char* ldsp;

DI unsigned pk2(float lo, float hi) { const f32x2_e v = {lo, hi}; return __builtin_bit_cast(unsigned, __builtin_convertvector(v, bf16x2_t)); }
DI unsigned f2bf(float f) { return pk2(f, 0.f) & 0xffffu; }
DI float bflo(unsigned u) { return __builtin_bit_cast(float, u << 16); }
DI float bfhi(unsigned u) { return __builtin_bit_cast(float, u & 0xffff0000u); }
DI float bf1(bf16 v) { return __builtin_bit_cast(float, ((unsigned)v) << 16); }
DI float fexp2(float x) { return __builtin_amdgcn_exp2f(x); }
DI float flog2(float x) { return __builtin_amdgcn_logf(x); }
DI float frcp(float x) { return __builtin_amdgcn_rcpf(x); }
DI float frsq(float x) { return __builtin_amdgcn_rsqf(x); }
DI float gelu_t(float x) { const float u = 0.7978845608f * (x + 0.044715f * x * x * x); return x * frcp(1.f + fexp2(-2.885390082f * u)); }
DI float silu_f(float x) { return x * frcp(1.f + fexp2(-1.442695041f * x)); }
template <int CTRL> DI float dppf(float v) { return __builtin_bit_cast(float, __builtin_amdgcn_update_dpp(0, __builtin_bit_cast(int, v), CTRL, 0xf, 0xf, true)); }
DI float wave_sum_u(float v) {
    v += dppf<0xB1>(v); v += dppf<0x4E>(v); v += dppf<0x141>(v); v += dppf<0x140>(v);
    const int iv = __builtin_bit_cast(int, v);
    return (__builtin_bit_cast(float, __builtin_amdgcn_readlane(iv, 0)) + __builtin_bit_cast(float, __builtin_amdgcn_readlane(iv, 16))) +
           (__builtin_bit_cast(float, __builtin_amdgcn_readlane(iv, 32)) + __builtin_bit_cast(float, __builtin_amdgcn_readlane(iv, 48)));
}
DI float wave_max_u(float v) {
    v = fmaxf(v, dppf<0xB1>(v)); v = fmaxf(v, dppf<0x4E>(v)); v = fmaxf(v, dppf<0x141>(v)); v = fmaxf(v, dppf<0x140>(v));
    const int iv = __builtin_bit_cast(int, v);
    return fmaxf(fmaxf(__builtin_bit_cast(float, __builtin_amdgcn_readlane(iv, 0)), __builtin_bit_cast(float, __builtin_amdgcn_readlane(iv, 16))),
                 fmaxf(__builtin_bit_cast(float, __builtin_amdgcn_readlane(iv, 32)), __builtin_bit_cast(float, __builtin_amdgcn_readlane(iv, 48))));
}
DI float wave_sum(float v) {
#pragma unroll
    for (int o = 1; o < 64; o <<= 1) v += __shfl_xor(v, o);
    return v;
}
DI float dot2bf(unsigned a, unsigned b, float c) { return __builtin_amdgcn_fdot2_f32_bf16(__builtin_bit_cast(bf16x2_t, a), __builtin_bit_cast(bf16x2_t, b), c, false); }
DI f32x4 mfma16(bf16x8 a, bf16x8 b, f32x4 c) { return __builtin_amdgcn_mfma_f32_16x16x32_bf16(a, b, c, 0, 0, 0); }
DI s16x4 tr4(const LAS bf16* p) { return __builtin_bit_cast(s16x4, __builtin_amdgcn_ds_read_tr16_b64_v4i16((LAS v4i16_t*)p)); }
DI bf16x8 tr8(const LAS bf16* p, int stride) { const s16x4 a = tr4(p), b = tr4(p + 4 * stride); return (bf16x8){a[0], a[1], a[2], a[3], b[0], b[1], b[2], b[3]}; }

#define XB_TMO      128
#define XB_XCNT(j)  (256  + 64 * (j))
#define XB_XSUB(j)  (1280 + 64 * (j))
#define XB_XGEN(j)  (2304 + 64 * (j))
#define XB_TOP      3328
#define XB_TOPGEN   3392
#define XCD_BAR_WORDS 3456
#define XB_SPIN_CAP (1u << 18)

__device__ __forceinline__ unsigned xb_ld(unsigned* p)              { return __hip_atomic_load(p, __ATOMIC_RELAXED, __HIP_MEMORY_SCOPE_AGENT); }
__device__ __forceinline__ unsigned xb_add(unsigned* p, unsigned v) { return __hip_atomic_fetch_add(p, v, __ATOMIC_RELAXED, __HIP_MEMORY_SCOPE_AGENT); }
__device__ __forceinline__ unsigned xb_xcc_id() { return (unsigned)__builtin_amdgcn_s_getreg((3 << 11) | 20) & 0xFu; }
#define XB_SPIN(cond, bar) do { unsigned _sp = 0; while (cond) { __builtin_amdgcn_s_sleep(1); \
    if ((++_sp & 255u) == 0u) { if (xb_ld(&(bar)[XB_TMO])) break; if (_sp > XB_SPIN_CAP) { atomicAdd(&(bar)[XB_TMO], 1u); break; } } } } while (0)

struct XcdBarrier {
    unsigned* bar; unsigned x;
    volatile LAS unsigned* st;
};

__device__ __forceinline__ XcdBarrier xcd_barrier_post(unsigned* bar, volatile LAS unsigned* st) {
    XcdBarrier b; b.bar = bar; b.x = xb_xcc_id(); b.st = st;
    if (threadIdx.x == 0) (void)xb_add(&bar[XB_XCNT(b.x)], 1u);
    return b;
}
__device__ __forceinline__ void xcd_barrier_complete(unsigned* bar, unsigned x, unsigned& nloc, unsigned& nx) {
    const unsigned G = gridDim.x * gridDim.y * gridDim.z;
    unsigned sum, cnt, mine, sp = 0u;
    for (;;) {
        sum = 0u; cnt = 0u; mine = 0u;
#pragma unroll
        for (unsigned j = 0; j < 16; ++j) { const unsigned c = xb_ld(&bar[XB_XCNT(j)]); sum += c; cnt += (c > 0u) ? 1u : 0u; mine = (j == x) ? c : mine; }
        if (sum == G) break;
        __builtin_amdgcn_s_sleep(1);
        if ((++sp & 255u) == 0u) { if (xb_ld(&bar[XB_TMO])) break; if (sp > XB_SPIN_CAP) { atomicAdd(&bar[XB_TMO], 1u); break; } }
    }
    nloc = mine > 0u ? mine : 1u; nx = cnt > 0u ? cnt : 1u;
}

__device__ __forceinline__ void xcd_barrier(const XcdBarrier& b) {
    asm volatile("s_waitcnt vmcnt(0)" ::: "memory");
    __syncthreads();
    if (threadIdx.x == 0) {
        unsigned* bar = b.bar;
        __builtin_amdgcn_s_waitcnt(0);
        unsigned nloc = b.st[0], nx = b.st[1];
        if (nloc == 0u) { xcd_barrier_complete(bar, b.x, nloc, nx); b.st[0] = nloc; b.st[1] = nx; }
        const unsigned old = xb_add(&bar[XB_XSUB(b.x)], 1u);
        const unsigned gen = old / nloc;
        if (old + 1u == (gen + 1u) * nloc) {
            __builtin_amdgcn_fence(__ATOMIC_RELEASE, "agent");
            asm volatile("s_waitcnt vmcnt(0)" ::: "memory");
            const unsigned og = xb_add(&bar[XB_TOP], 1u);
            const unsigned tg = og / nx;
            if (og + 1u == (tg + 1u) * nx) xb_add(&bar[XB_TOPGEN], 1u);
            else XB_SPIN(xb_ld(&bar[XB_TOPGEN]) == tg, bar);
            __builtin_amdgcn_fence(__ATOMIC_ACQUIRE, "agent");
            xb_add(&bar[XB_XGEN(b.x)], 1u);
            asm volatile("s_waitcnt vmcnt(0)" ::: "memory");
        } else {
            XB_SPIN(xb_ld(&bar[XB_XGEN(b.x)]) == gen, bar);
            __builtin_amdgcn_fence(__ATOMIC_ACQUIRE, "agent");
            asm volatile("s_waitcnt vmcnt(0)" ::: "memory");
        }
    }
    __syncthreads();
}
struct Ctx {
    ldsp lds; int tid, lane, wave, bid, G, gw, NGW;
    unsigned char* ws;
};
DI const float* KARG(int k) { asm volatile("" : "+s"(k)); return ((const float* const*)__builtin_amdgcn_kernarg_segment_ptr())[k]; }
#define LDS_WAIT() asm volatile("s_waitcnt lgkmcnt(0)" ::: "memory")
enum { I_X = 0, I_C, I_ADAW, I_ADAB, I_N1G, I_WIN, I_WA2, I_BA, I_GNG, I_VNG, I_MWS, I_MB, I_MOG, I_WOUT, I_N2G, I_WQ, I_K1, I_K2, I_PU, I_PV, I_FG };

DI void p0_ada(const Ctx& C) {
    LAS float* red = (LAS float*)C.lds;
    float* MOD = (float*)(C.ws + WS_MOD);
    for (int it = C.bid; it < 192; it += C.G) {
        const int l = it / 96, cg = it % 96, c0 = cg * 128 + C.lane * 2;
        const float* W = KARG(I_ADAW) + (size_t)l * D * MODW + (size_t)(C.wave * 256) * MODW + c0;
        float cv[4][4];
#pragma unroll
        for (int b = 0; b < 4; ++b)
#pragma unroll
            for (int i = 0; i < 4; ++i) cv[b][i] = silu_f(KARG(I_C)[b * D + C.wave * 256 + i * 64 + C.lane]);
        float acc[4][2];
#pragma unroll
        for (int b = 0; b < 4; ++b) { acc[b][0] = 0.f; acc[b][1] = 0.f; }
#pragma unroll
        for (int i = 0; i < 4; ++i) {
#pragma unroll 16
            for (int j = 0; j < 64; ++j) {
                const f32x2 w = *(const f32x2*)(W + (size_t)(i * 64 + j) * MODW);
#pragma unroll
                for (int b = 0; b < 4; ++b) { const float s = __builtin_bit_cast(float, __builtin_amdgcn_readlane(__builtin_bit_cast(int, cv[b][i]), j)); acc[b][0] += s * w.x; acc[b][1] += s * w.y; }
            }
        }
#pragma unroll
        for (int b = 0; b < 4; ++b) *(LAS f32x2*)(red + (C.wave * 4 + b) * 128 + C.lane * 2) = (f32x2){acc[b][0], acc[b][1]};
        __syncthreads();
        { const int b = C.tid >> 7, col = C.tid & 127; float s = KARG(I_ADAB)[l * MODW + cg * 128 + col];
#pragma unroll
          for (int w = 0; w < 8; ++w) s += red[(w * 4 + b) * 128 + col];
          MOD[(size_t)(l * 4 + b) * MODW + cg * 128 + col] = s; }
        __syncthreads();
    }
}
DI void transpose_item(const float* W, int ldw, int src_col0, int ncols, bf16* WT, int dst_row0, int k0, LAS float* scr, int lane) {
    const int cl = lane & 31;
    float v[32];
#pragma unroll
    for (int i = 0; i < 32; ++i) { const int kk = 2 * i + (lane >> 5); v[i] = 0.f; if (cl < ncols) v[i] = W[(size_t)(k0 + kk) * ldw + src_col0 + cl]; }
#pragma unroll
    for (int i = 0; i < 32; ++i) { const int kk = 2 * i + (lane >> 5); scr[kk * 33 + cl] = v[i]; }
    LDS_WAIT();
    const int c = lane & 7;
#pragma unroll
    for (int j = 0; j < 4; ++j) { const int n = (lane >> 3) + 8 * j;
        if (n < ncols) { const LAS float* s = scr + (8 * c) * 33 + n;
            u32x4 o; o.x = pk2(s[0 * 33], s[1 * 33]); o.y = pk2(s[2 * 33], s[3 * 33]); o.z = pk2(s[4 * 33], s[5 * 33]); o.w = pk2(s[6 * 33], s[7 * 33]);
            *(u32x4*)(WT + (size_t)(dst_row0 + n) * 2048 + k0 + 8 * c) = o; } }
    LDS_WAIT();
}
DI void p0_prologue(const Ctx& C) {
    p0_ada(C);
    LAS float* scr = (LAS float*)(C.lds + C.wave * 16384);
    constexpr int PER_L = (161 + 64 + 64) * 32;
    for (int it = C.gw; it < 2 * PER_L; it += C.NGW) {
        const int l = it / PER_L; int r = it % PER_L;
        if (r < 161 * 32) { const int kb = r / 161, nb = r % 161; bf16* WT = (bf16*)(C.ws + WS_WTIN) + (size_t)l * WTIN_L;
            const float* W = KARG(I_WIN) + (size_t)l * D * IN_COLS;
            if (nb < 160) { const int n0 = 32 * nb; transpose_item(W, IN_COLS, n0 + (n0 >= 3072 ? 16 : 0), 32, WT, n0, 64 * kb, scr, C.lane); }
            else transpose_item(W, IN_COLS, 3072, 16, WT, 5120, 64 * kb, scr, C.lane);
            continue; }
        r -= 161 * 32;
        if (r < 2048) { const int kb = r / 64, nb = r % 64; transpose_item(KARG(I_WOUT) + (size_t)l * D * D, D, 32 * nb, 32, (bf16*)(C.ws + WS_WTOUT) + (size_t)l * D * D, 32 * nb, 64 * kb, scr, C.lane); continue; }
        r -= 2048;
        { const int kb = r / 64, nb = r % 64; transpose_item(KARG(I_WQ) + (size_t)l * D * D, D, 32 * nb, 32, (bf16*)(C.ws + WS_WTQ) + (size_t)l * D * D, 32 * nb, 64 * kb, scr, C.lane); }
    }
    const int gt = C.bid * NTHR + C.tid, NT = C.G * NTHR;
    { bf16* K1B = (bf16*)(C.ws + WS_K1B); bf16* K2B = (bf16*)(C.ws + WS_K2B); bf16* WSB = (bf16*)(C.ws + WS_WSB);
      for (int i = gt; i < 262144; i += NT) { K1B[i] = (bf16)f2bf(KARG(I_K1)[i]); K2B[i] = (bf16)f2bf(KARG(I_K2)[i]);
          const int s = i & 127, t = (i >> 7) & 127; WSB[i] = (s <= t) ? (bf16)f2bf(KARG(I_MWS)[i]) : (bf16)0; } }
    { float* SU = (float*)(C.ws + WS_SU); int* KV = (int*)(C.ws + WS_KV);
#pragma unroll 1
      for (int row = C.gw; row < 4 * NEXP; row += C.NGW) {
          const int tb = row >> 15, rr = row & 32767;
          const f32x4* src = (const f32x4*)(KARG(tb ? I_PV : I_PU) + (size_t)rr * D) + C.lane;
          f32x4 v[8];
#pragma unroll
          for (int j = 0; j < 8; ++j) v[j] = src[64 * j];
          const int lyr = rr >> 14, ee = rr & 16383;
          unsigned* dst = (unsigned*)(C.ws + (tb ? WS_PVB : WS_PUB) + (size_t)lyr * NEXP * D + (size_t)ee * 256) + C.lane;
          if (tb) {
              float mx = 0.f;
#pragma unroll
              for (int j = 0; j < 8; ++j) mx = fmaxf(mx, fmaxf(fmaxf(fabsf(v[j].x), fabsf(v[j].y)), fmaxf(fabsf(v[j].z), fabsf(v[j].w))));
#pragma unroll
              for (int o = 1; o < 64; o <<= 1) mx = fmaxf(mx, __shfl_xor(mx, o));
              int k = 0;
              if (mx > 0.f) { k = (int)((__builtin_bit_cast(unsigned, 224.0f / mx) >> 23) & 255u) - 127; k = k < -60 ? -60 : (k > 60 ? 60 : k); }
              const float sc = __builtin_bit_cast(float, (unsigned)(k + 127) << 23);
#pragma unroll
              for (int j = 0; j < 8; ++j) { int p = 0; p = __builtin_amdgcn_cvt_pk_fp8_f32(v[j].x * sc, v[j].y * sc, p, false); p = __builtin_amdgcn_cvt_pk_fp8_f32(v[j].z * sc, v[j].w * sc, p, true); dst[(size_t)j * (NEXP * 256 / 4)] = (unsigned)p; }
              if (C.lane == 0) KV[rr] = k;
          } else {
#pragma unroll
              for (int j = 0; j < 8; ++j) {
                  float mx = fmaxf(fmaxf(fabsf(v[j].x), fabsf(v[j].y)), fmaxf(fabsf(v[j].z), fabsf(v[j].w)));
#pragma unroll
                  for (int o = 1; o < 64; o <<= 1) mx = fmaxf(mx, __shfl_xor(mx, o));
                  const float inv = mx > 0.f ? 127.0f / mx : 0.f;
                  const int q0 = (int)__builtin_rintf(v[j].x * inv), q1 = (int)__builtin_rintf(v[j].y * inv), q2 = (int)__builtin_rintf(v[j].z * inv), q3 = (int)__builtin_rintf(v[j].w * inv);
                  dst[(size_t)j * (NEXP * 256 / 4)] = (unsigned)(q0 & 255) | ((unsigned)(q1 & 255) << 8) | ((unsigned)(q2 & 255) << 16) | ((unsigned)q3 << 24);
                  if (C.lane == 0) SU[(size_t)(lyr * 8 + j) * NEXP + ee] = mx * (1.0f / 127.0f);
              }
          }
      } }
}
template <bool FP8 = false, bool XB = false>
DI void norm_phase(const Ctx& C, const void* Xv, const float* g, const float* modl, int sh_off, int sc_off, bf16* Hout, unsigned char* H8 = nullptr, float* HS = nullptr, int* COEF = nullptr) {
    const int r0 = C.gw * 8, b = r0 >> 12;
    if (FP8) {
        u32x4* cz = (u32x4*)(COEF + (size_t)r0 * 128) + C.lane;
        unsigned z_ = 0u; asm volatile("" : "+v"(z_));
#pragma unroll
        for (int j = 0; j < 4; ++j) cz[64 * j] = (u32x4){z_, z_, z_, z_}; }
    const f32x4* shp = (const f32x4*)(modl + (size_t)b * MODW + sh_off); const f32x4* scp = (const f32x4*)(modl + (size_t)b * MODW + sc_off);
    f32x4 gm[8], shv[8];
#pragma unroll
    for (int j = 0; j < 8; ++j) { const int idx = 64 * j + C.lane; gm[j] = ((const f32x4*)g)[idx] * (scp[idx] + 1.0f); shv[j] = shp[idx]; }
#pragma unroll 1
    for (int i = 0; i < 8; ++i) {
        f32x4 v[8]; float s = 0.f;
        if (XB) { const u32x2* xr = (const u32x2*)((const bf16*)Xv + (size_t)(r0 + i) * D) + C.lane;
#pragma unroll
            for (int j = 0; j < 8; ++j) { const u32x2 w = xr[64 * j]; v[j] = (f32x4){bflo(w.x), bfhi(w.x), bflo(w.y), bfhi(w.y)}; } }
        else { const f32x4* xr = (const f32x4*)((const float*)Xv + (size_t)(r0 + i) * D) + C.lane;
#pragma unroll
            for (int j = 0; j < 8; ++j) v[j] = xr[64 * j]; }
#pragma unroll
        for (int j = 0; j < 8; ++j) s += (v[j].x * v[j].x + v[j].y * v[j].y) + (v[j].z * v[j].z + v[j].w * v[j].w);
        const float rstd = frsq(wave_sum(s) * (1.f / D) + EPS);
        u32x2* o = (u32x2*)(Hout + (size_t)(r0 + i) * D) + C.lane;
#pragma unroll
        for (int j = 0; j < 8; ++j) { const f32x4 y = v[j] * rstd * gm[j] + shv[j]; u32x2 w; w.x = pk2(y.x, y.y); w.y = pk2(y.z, y.w); o[64 * j] = w;
            if (FP8) v[j] = y; }
        if (FP8) {
            float st[8];
            unsigned* h8 = (unsigned*)(H8 + (size_t)(r0 + i) * 2048) + C.lane;
#pragma unroll
            for (int j = 0; j < 8; ++j) {
                const float am = wave_max_u(fmaxf(fmaxf(fabsf(v[j].x), fabsf(v[j].y)), fmaxf(fabsf(v[j].z), fabsf(v[j].w))));
                const float qs = am > 0.f ? 127.0f / am : 0.f; st[j] = am * (1.0f / 127.0f);
                const int q0 = (int)__builtin_rintf(v[j].x * qs), q1 = (int)__builtin_rintf(v[j].y * qs), q2 = (int)__builtin_rintf(v[j].z * qs), q3 = (int)__builtin_rintf(v[j].w * qs);
                h8[64 * j] = (unsigned)(q0 & 255) | ((unsigned)(q1 & 255) << 8) | ((unsigned)(q2 & 255) << 16) | ((unsigned)q3 << 24); }
            if (C.lane == 0) { f32x4* hp = (f32x4*)(HS + (size_t)(r0 + i) * 8); hp[0] = (f32x4){st[0], st[1], st[2], st[3]}; hp[1] = (f32x4){st[4], st[5], st[6], st[7]}; }
        }
    }
}
DI void alow_phase(const Ctx& C, const bf16* Hb, const bf16* WtA, float* ALOW) {
    const int task = C.bid * 4 + (C.wave & 3), kh = C.wave >> 2, r0 = task * 16, fr = C.lane & 15, fq = C.lane >> 4;
    const bf16* ap = Hb + (size_t)(r0 + fr) * D + 8 * fq + 1024 * kh; const bf16* bp = WtA + (size_t)fr * D + 8 * fq + 1024 * kh;
    f32x4 acc = (f32x4){0.f, 0.f, 0.f, 0.f};
#pragma unroll 8
    for (int ks = 0; ks < 32; ++ks) { const bf16x8 a = *(const bf16x8*)(ap + 32 * ks), b = *(const bf16x8*)(bp + 32 * ks); acc = mfma16(a, b, acc); }
    LAS f32x4* xch = (LAS f32x4*)C.lds + (C.wave & 3) * 64 + C.lane;
    if (kh) *xch = acc;
    LDS_WAIT(); __builtin_amdgcn_s_barrier(); asm volatile("" ::: "memory");
    if (!kh) { acc += *xch;
#pragma unroll
        for (int r = 0; r < 4; ++r) ALOW[(size_t)(r0 + 4 * fq + r) * 16 + fr] = acc[r]; }
}
#define LBAR() do { asm volatile("s_waitcnt lgkmcnt(0)" ::: "memory"); __builtin_amdgcn_s_barrier(); asm volatile("" ::: "memory"); } while (0)
DI void gla_gates(const Ctx& C, LAS float* al, LAS float* tot, const f32x4 alv, const float (&w2)[16], const float bav, float (&Gl)[16], float& off, float& gref, float& g63) {
    const int d = C.tid & 127, jg = C.tid >> 7;
    if (C.tid < 256) ((LAS f32x4*)al)[C.tid] = alv;
    LBAR();
    float run = 0.f;
#pragma unroll
    for (int jj = 0; jj < 16; ++jj) {
        const LAS f32x4* ar = (const LAS f32x4*)(al + (jg * 16 + jj) * 16);
        const f32x4 a0 = ar[0], a1 = ar[1], a2 = ar[2], a3 = ar[3];
        float z = bav;
        z += a0.x * w2[0] + a0.y * w2[1] + a0.z * w2[2] + a0.w * w2[3];
        z += a1.x * w2[4] + a1.y * w2[5] + a1.z * w2[6] + a1.w * w2[7];
        z += a2.x * w2[8] + a2.y * w2[9] + a2.z * w2[10] + a2.w * w2[11];
        z += a3.x * w2[12] + a3.y * w2[13] + a3.z * w2[14] + a3.w * w2[15];
        const float ls = fminf(z, 0.f) - 0.6931471806f * flog2(1.f + fexp2(-1.442695041f * fabsf(z)));
        run += ls * (1.442695041f / 16.f);
        Gl[jj] = run;
    }
    tot[jg * 128 + d] = run;
    LBAR();
    const float t0_ = tot[d], t1_ = tot[128 + d], t2_ = tot[256 + d], t3_ = tot[384 + d];
    off = (jg > 0 ? t0_ : 0.f) + (jg > 1 ? t1_ : 0.f) + (jg > 2 ? t2_ : 0.f); gref = t0_ + t1_; g63 = (t0_ + t1_) + (t2_ + t3_);
}
constexpr int KST = 136, VST = 264, PST = 72;
typedef short s16x2_t __attribute__((ext_vector_type(2)));
struct GlaIn { f32x4 alv; s16x2_t qk[16]; u32x4 vt[4]; };
DI float qk_q(const s16x2_t v) { return __builtin_bit_cast(float, __builtin_bit_cast(unsigned, v) << 16); }
DI float qk_k(const s16x2_t v) { return __builtin_bit_cast(float, __builtin_bit_cast(unsigned, v) & 0xffff0000u); }
template <bool WITHQ, bool WITHV = true>
DI void gla_load(const Ctx& C, int idx, const bf16* PROJ, const float* ALOW, GlaIn& in) {
    const int b = idx >> 8, h = (idx >> 6) & 3, n = idx & 63, t0 = b * SEQ + n * 64, d = C.tid & 127, jg = C.tid >> 7;
    in.alv = (f32x4){0.f, 0.f, 0.f, 0.f};
    if (C.tid < 256) in.alv = ((const f32x4*)(ALOW + (size_t)t0 * 16))[C.tid];
#pragma unroll
    for (int jj = 0; jj < 16; ++jj) { const bf16* row = PROJ + (size_t)(t0 + jg * 16 + jj) * NPROJ + h * 128 + d; s16x2_t v = (s16x2_t){0, 0}; if (WITHQ) v.x = (short)row[C_Q]; v.y = (short)row[C_K]; in.qk[jj] = v; }
    if (WITHV) {
#pragma unroll
    for (int i = 0; i < 4; ++i) { const int c = C.tid + 512 * i, j = c >> 5, ec = c & 31; in.vt[i] = *(const u32x4*)(PROJ + (size_t)(t0 + j) * NPROJ + C_V + h * 256 + 8 * ec); } }
}
DI void gla_load_v(const Ctx& C, int idx, const bf16* PROJ, GlaIn& in) {
    const int b = idx >> 8, h = (idx >> 6) & 3, n = idx & 63, t0 = b * SEQ + n * 64;
#pragma unroll
    for (int i = 0; i < 4; ++i) { const int c = C.tid + 512 * i, j = c >> 5, ec = c & 31; in.vt[i] = *(const u32x4*)(PROJ + (size_t)(t0 + j) * NPROJ + C_V + h * 256 + 8 * ec); }
}
DI void store_v_tile(const Ctx& C, const GlaIn& in, LAS bf16* VL) {
#pragma unroll
    for (int i = 0; i < 4; ++i) { const int c = C.tid + 512 * i, j = c >> 5, ec = c & 31; *(LAS u32x4*)(VL + j * VST + 8 * ec) = in.vt[i]; }
}
DI void glaA_phase(const Ctx& C, int l, const bf16* PROJ, const float* ALOW, bf16* SBUF, float* DEC) {
    LAS float* al = (LAS float*)(C.lds); LAS float* tot = (LAS float*)(C.lds + 4096);
    LAS bf16* KD = (LAS bf16*)(C.lds + 8192); LAS bf16* VL = (LAS bf16*)(C.lds + 25600);
    const int d = C.tid & 127, jg = C.tid >> 7, h = (C.bid >> 6) & 3;
    float w2[16];
#pragma unroll
    for (int r = 0; r < 16; ++r) w2[r] = KARG(I_WA2)[(size_t)l * 16 * 512 + r * 512 + h * 128 + d];
    const float bav = KARG(I_BA)[(size_t)l * 512 + h * 128 + d];
    GlaIn cur, nxt;
    gla_load<false>(C, C.bid, PROJ, ALOW, cur);
#pragma unroll 1
    for (int i = 0; i < 4; ++i) {
        const int idx = i * C.G + C.bid;
        float Gl[16], off, gref, g63;
        gla_gates(C, al, tot, cur.alv, w2, bav, Gl, off, gref, g63);
#pragma unroll
        for (int jj = 0; jj < 16; ++jj) { const int j = jg * 16 + jj; KD[j * KST + d] = (bf16)f2bf(qk_k(cur.qk[jj]) * fexp2(g63 - (off + Gl[jj]))); }
        store_v_tile(C, cur, VL);
        LBAR();
        if (i + 1 < 4) gla_load<false>(C, idx + C.G, PROJ, ALOW, nxt);
        if (jg == 0) DEC[(size_t)idx * 128 + d] = fexp2(g63);
        const int lane = C.lane, g = lane >> 4, qq = (lane & 15) >> 2, p = lane & 3, fr = lane & 15;
        bf16x8 A[2];
#pragma unroll
        for (int ks = 0; ks < 2; ++ks) A[ks] = tr8(KD + (32 * ks + 8 * g + qq) * KST + 16 * C.wave + 4 * p, KST);
        bf16* Sit = SBUF + (size_t)idx * 256 * 128;
#pragma unroll
        for (int half = 0; half < 2; ++half) {
            f32x4 acc[8];
#pragma unroll
            for (int nt = 0; nt < 8; ++nt) acc[nt] = (f32x4){0.f, 0.f, 0.f, 0.f};
#pragma unroll
            for (int nt = 0; nt < 8; ++nt)
#pragma unroll
                for (int ks = 0; ks < 2; ++ks) { const bf16x8 Bf = tr8(VL + (32 * ks + 8 * g + qq) * VST + 16 * (half * 8 + nt) + 4 * p, VST); acc[nt] = mfma16(A[ks], Bf, acc[nt]); }
#pragma unroll
            for (int nt = 0; nt < 8; ++nt) { const int e = 16 * (half * 8 + nt) + fr, dd = 16 * C.wave + 4 * g;
                u32x2 w; w.x = pk2(acc[nt][0], acc[nt][1]); w.y = pk2(acc[nt][2], acc[nt][3]); *(u32x2*)(Sit + (size_t)e * 128 + dd) = w; }
        }
        LBAR();
        cur = nxt;
    }
}
DI void scan_phase(const Ctx& C, bf16* SBUF, const float* DEC) {
    const int gt = C.bid * NTHR + C.tid, bh = gt >> 13, rem = gt & 8191, e = rem >> 5, dq = rem & 31;
    u32x2* p = (u32x2*)(SBUF + ((size_t)(bh * 64) * 256 + e) * 128 + 4 * dq);
    const f32x4* dp = (const f32x4*)(DEC + (size_t)(bh * 64) * 128 + 4 * dq);
    f32x4 st = (f32x4){0.f, 0.f, 0.f, 0.f};
#pragma unroll 1
    for (int n0 = 0; n0 < 64; n0 += 8) {
        u32x2 tmp[8]; f32x4 dc[8];
#pragma unroll
        for (int u = 0; u < 8; ++u) { tmp[u] = p[(size_t)(n0 + u) * 8192]; dc[u] = dp[(n0 + u) * 32]; }
#pragma unroll
        for (int u = 0; u < 8; ++u) { u32x2 w; w.x = pk2(st.x, st.y); w.y = pk2(st.z, st.w); p[(size_t)(n0 + u) * 8192] = w;
            st = dc[u] * st + (f32x4){bflo(tmp[u].x), bfhi(tmp[u].x), bflo(tmp[u].y), bfhi(tmp[u].y)}; }
    }
}
DI void glaC_phase(const Ctx& C, int l, const bf16* PROJ, const float* ALOW, const bf16* SBUF, bf16* CONCAT) {
    const int h = (C.bid >> 6) & 3;
    LAS float* al = (LAS float*)(C.lds); LAS float* tot = (LAS float*)(C.lds + 4096); LAS float* RS = (LAS float*)(C.lds + 6144);
    LAS bf16* QT = (LAS bf16*)(C.lds + 8192); LAS bf16* KT = (LAS bf16*)(C.lds + 25600); LAS bf16* QG = (LAS bf16*)(C.lds + 43008);
    LAS bf16* VL = (LAS bf16*)(C.lds + 60416); LAS bf16* PL = (LAS bf16*)(C.lds + 94208);
    const int d = C.tid & 127, jg = C.tid >> 7;
    float w2[16];
#pragma unroll
    for (int r = 0; r < 16; ++r) w2[r] = KARG(I_WA2)[(size_t)l * 16 * 512 + r * 512 + h * 128 + d];
    const float bav = KARG(I_BA)[(size_t)l * 512 + h * 128 + d];
    const float* ng = KARG(I_GNG) + (size_t)(l * 4 + h) * 256;
    GlaIn cur;
    f32x4 alv_n; s16x2_t qkn[16];
    gla_load<true, false>(C, C.bid, PROJ, ALOW, cur);
#pragma unroll 1
    for (int it = 0; it < 4; ++it) {
    const int idx = it * C.G + C.bid, b = idx >> 8, n = idx & 63, t0 = b * SEQ + n * 64;
    gla_load_v(C, idx, PROJ, cur);
    float Gl[16], off, gref, g63;
    gla_gates(C, al, tot, cur.alv, w2, bav, Gl, off, gref, g63);
#pragma unroll
    for (int jj = 0; jj < 16; ++jj) { const int j = jg * 16 + jj; const float Gv = off + Gl[jj];
        const float q = qk_q(cur.qk[jj]) * 0.08838834764831845f, k = qk_k(cur.qk[jj]);
        QT[j * KST + d] = (bf16)f2bf(q * fexp2(fminf(Gv - gref, 100.f))); KT[j * KST + d] = (bf16)f2bf(k * fexp2(fminf(gref - Gv, 100.f))); QG[j * KST + d] = (bf16)f2bf(q * fexp2(Gv)); }
    store_v_tile(C, cur, VL);
    const int lane = C.lane, g = lane >> 4, qq = (lane & 15) >> 2, p = lane & 3, fr = lane & 15;
    bf16x8 Sf[2][4]; u32x2 rraw[4][2];
#pragma unroll
    for (int mi = 0; mi < 2; ++mi) { const bf16* Srow = SBUF + ((size_t)idx * 256 + 16 * (2 * C.wave + mi) + fr) * 128 + 8 * g;
#pragma unroll
        for (int ks = 0; ks < 4; ++ks) Sf[mi][ks] = *(const bf16x8*)(Srow + 32 * ks); }
#pragma unroll
    for (int nt = 0; nt < 4; ++nt)
#pragma unroll
        for (int mi = 0; mi < 2; ++mi) rraw[nt][mi] = *(const u32x2*)(PROJ + (size_t)(t0 + 16 * nt + fr) * NPROJ + C_R + h * 256 + 16 * (2 * C.wave + mi) + 4 * g);
    LBAR();
    if (it + 1 < 4) { const int ix = idx + C.G, t1 = (ix >> 8) * SEQ + (ix & 63) * 64;
        alv_n = (f32x4){0.f, 0.f, 0.f, 0.f}; if (C.tid < 256) alv_n = ((const f32x4*)(ALOW + (size_t)t1 * 16))[C.tid];
#pragma unroll
        for (int jj = 0; jj < 16; ++jj) { const bf16* row = PROJ + (size_t)(t1 + jg * 16 + jj) * NPROJ + h * 128 + d; s16x2_t v; v.x = (short)row[C_Q]; v.y = (short)row[C_K]; qkn[jj] = v; } }
    {
        const int nt = C.wave & 3;
#pragma unroll
        for (int mi = 0; mi < 2; ++mi) { const int mt = 2 * (C.wave >> 2) + mi; f32x4 acc = (f32x4){0.f, 0.f, 0.f, 0.f};
#pragma unroll
            for (int ks = 0; ks < 4; ++ks) { const bf16x8 a = *(const LAS bf16x8*)(KT + (16 * mt + fr) * KST + 32 * ks + 8 * g), bq = *(const LAS bf16x8*)(QT + (16 * nt + fr) * KST + 32 * ks + 8 * g); acc = mfma16(a, bq, acc); }
            const int i = 16 * nt + fr, j0 = 16 * mt + 4 * g;
            const float v0 = (j0 + 0 <= i) ? acc[0] : 0.f, v1 = (j0 + 1 <= i) ? acc[1] : 0.f, v2 = (j0 + 2 <= i) ? acc[2] : 0.f, v3 = (j0 + 3 <= i) ? acc[3] : 0.f;
            u32x2 w; w.x = pk2(v0, v1); w.y = pk2(v2, v3); *(LAS u32x2*)(PL + i * PST + j0) = w; }
    }
    LBAR();
    f32x4 acc[2][4];
#pragma unroll
    for (int mi = 0; mi < 2; ++mi)
#pragma unroll
        for (int nt = 0; nt < 4; ++nt) acc[mi][nt] = (f32x4){0.f, 0.f, 0.f, 0.f};
#pragma unroll
    for (int mi = 0; mi < 2; ++mi) { const int mt = 2 * C.wave + mi;
#pragma unroll
        for (int ks = 0; ks < 2; ++ks) { const bf16x8 a = tr8(VL + (32 * ks + 8 * g + qq) * VST + 16 * mt + 4 * p, VST);
#pragma unroll
            for (int nt = 0; nt < 4; ++nt) { const bf16x8 bp = *(const LAS bf16x8*)(PL + (16 * nt + fr) * PST + 32 * ks + 8 * g); acc[mi][nt] = mfma16(a, bp, acc[mi][nt]); } }
#pragma unroll
        for (int ks = 0; ks < 4; ++ks) { const bf16x8 a = Sf[mi][ks];
#pragma unroll
            for (int nt = 0; nt < 4; ++nt) { const bf16x8 bq = *(const LAS bf16x8*)(QG + (16 * nt + fr) * KST + 32 * ks + 8 * g); acc[mi][nt] = mfma16(a, bq, acc[mi][nt]); } }
    }
#pragma unroll
    for (int nt = 0; nt < 4; ++nt) { float s = 0.f;
#pragma unroll
        for (int mi = 0; mi < 2; ++mi) s += (acc[mi][nt][0] * acc[mi][nt][0] + acc[mi][nt][1] * acc[mi][nt][1]) + (acc[mi][nt][2] * acc[mi][nt][2] + acc[mi][nt][3] * acc[mi][nt][3]);
        s += __shfl_xor(s, 16); s += __shfl_xor(s, 32);
        if (g == 0) RS[C.wave * 64 + 16 * nt + fr] = s; }
    LBAR();
#pragma unroll
    for (int nt = 0; nt < 4; ++nt) { const int i = 16 * nt + fr; float ts = 0.f;
#pragma unroll
        for (int w = 0; w < 8; ++w) ts += RS[w * 64 + i];
        const float rstd = frsq(ts * (1.f / 256.f) + EPS);
#pragma unroll
        for (int mi = 0; mi < 2; ++mi) { const int e = 16 * (2 * C.wave + mi) + 4 * g;
            const u32x2 rr = rraw[nt][mi]; const f32x4 gg = *(const f32x4*)(ng + e);
            const float o0 = acc[mi][nt][0] * rstd * gg.x * silu_f(bflo(rr.x)), o1 = acc[mi][nt][1] * rstd * gg.y * silu_f(bfhi(rr.x));
            const float o2 = acc[mi][nt][2] * rstd * gg.z * silu_f(bflo(rr.y)), o3 = acc[mi][nt][3] * rstd * gg.w * silu_f(bfhi(rr.y));
            u32x2 w; w.x = pk2(o0, o1); w.y = pk2(o2, o3); *(u32x2*)(CONCAT + (size_t)(t0 + i) * D + h * 256 + e) = w; } }
    LBAR();
    cur.alv = alv_n;
#pragma unroll
    for (int jj = 0; jj < 16; ++jj) cur.qk[jj] = qkn[jj];
    }
}
constexpr int GST = 136;
DI void gmlp_phase(const Ctx& C, int l, const bf16* PROJ, const bf16* WSB, bf16* CONCAT) {
    const int h = C.bid & 7;
    LAS bf16* VL2 = (LAS bf16*)(C.lds); LAS bf16* UL = (LAS bf16*)(C.lds + 34816);
    const float* vg = KARG(I_VNG) + (size_t)(l * 8 + h) * 128; const float* og = KARG(I_MOG) + (size_t)(l * 8 + h) * 128; const float* bb = KARG(I_MB) + (size_t)(l * 8 + h) * 128;
    bf16x8 Wf[4];
    { const bf16* Wrow = WSB + ((size_t)(l * 8 + h) * 128 + 16 * C.wave + (C.lane & 15)) * 128 + 8 * (C.lane >> 4);
#pragma unroll
      for (int ks = 0; ks < 4; ++ks) Wf[ks] = *(const bf16x8*)(Wrow + 32 * ks); }
    u32x4 cu[4], cv[4], nu[4], nv[4];
#define GM_LOAD(IDX, U, V) do { const int t0_ = ((IDX) >> 8) * SEQ + (((IDX) >> 3) & 31) * 128; _Pragma("unroll") for (int i = 0; i < 4; ++i) { const int c = C.tid + 512 * i, t = c >> 4, ch = c & 15; \
        const bf16* row = PROJ + (size_t)(t0_ + t) * NPROJ + h * 128 + 8 * ch; U[i] = *(const u32x4*)(row + C_U); V[i] = *(const u32x4*)(row + C_VS); } } while (0)
    GM_LOAD(C.bid, cu, cv);
#pragma unroll 1
    for (int it = 0; it < 4; ++it) {
    const int idx = it * C.G + C.bid, n = (idx >> 3) & 31, b = idx >> 8, t0 = b * SEQ + n * 128;
#pragma unroll
    for (int i = 0; i < 4; ++i) { const int c = C.tid + 512 * i, t = c >> 4, ch = c & 15;
        const u32x4 uu = cu[i], vv = cv[i];
        float v[8] = {gelu_t(bflo(vv.x)), gelu_t(bfhi(vv.x)), gelu_t(bflo(vv.y)), gelu_t(bfhi(vv.y)), gelu_t(bflo(vv.z)), gelu_t(bfhi(vv.z)), gelu_t(bflo(vv.w)), gelu_t(bfhi(vv.w))};
        float ss = 0.f;
#pragma unroll
        for (int k = 0; k < 8; ++k) ss += v[k] * v[k];
        ss += __shfl_xor(ss, 1); ss += __shfl_xor(ss, 2); ss += __shfl_xor(ss, 4); ss += __shfl_xor(ss, 8);
        const float rstd = frsq(ss * (1.f / 128.f) + EPS);
        const f32x4 g0 = *(const f32x4*)(vg + 8 * ch), g1 = *(const f32x4*)(vg + 8 * ch + 4);
        u32x4 wv; wv.x = pk2(v[0] * rstd * g0.x, v[1] * rstd * g0.y); wv.y = pk2(v[2] * rstd * g0.z, v[3] * rstd * g0.w); wv.z = pk2(v[4] * rstd * g1.x, v[5] * rstd * g1.y); wv.w = pk2(v[6] * rstd * g1.z, v[7] * rstd * g1.w);
        *(LAS u32x4*)(VL2 + t * GST + 8 * ch) = wv;
        u32x4 wu; wu.x = pk2(gelu_t(bflo(uu.x)), gelu_t(bfhi(uu.x))); wu.y = pk2(gelu_t(bflo(uu.y)), gelu_t(bfhi(uu.y))); wu.z = pk2(gelu_t(bflo(uu.z)), gelu_t(bfhi(uu.z))); wu.w = pk2(gelu_t(bflo(uu.w)), gelu_t(bfhi(uu.w)));
        *(LAS u32x4*)(UL + t * GST + 8 * ch) = wu; }
    LBAR();
    if (it + 1 < 4) GM_LOAD(idx + C.G, nu, nv);
    const int lane = C.lane, g = lane >> 4, qq = (lane & 15) >> 2, p = lane & 3, fr = lane & 15;
    f32x4 acc[8];
#pragma unroll
    for (int mt = 0; mt < 8; ++mt) acc[mt] = (f32x4){0.f, 0.f, 0.f, 0.f};
    const int nks = (C.wave >> 1) + 1;
#pragma unroll
    for (int ks = 0; ks < 4; ++ks) if (ks < nks) { const bf16x8 bw = Wf[ks];
#pragma unroll
        for (int mt = 0; mt < 8; ++mt) { const bf16x8 a = tr8(VL2 + (32 * ks + 8 * g + qq) * GST + 16 * mt + 4 * p, GST); acc[mt] = mfma16(a, bw, acc[mt]); } }
    const int tl = 16 * C.wave + fr; const float bt = bb[tl]; float ss = 0.f;
#pragma unroll
    for (int mt = 0; mt < 8; ++mt) { const u32x2 uu = *(const LAS u32x2*)(UL + tl * GST + 16 * mt + 4 * g);
        acc[mt][0] = bflo(uu.x) * (acc[mt][0] + bt); acc[mt][1] = bfhi(uu.x) * (acc[mt][1] + bt); acc[mt][2] = bflo(uu.y) * (acc[mt][2] + bt); acc[mt][3] = bfhi(uu.y) * (acc[mt][3] + bt);
        ss += (acc[mt][0] * acc[mt][0] + acc[mt][1] * acc[mt][1]) + (acc[mt][2] * acc[mt][2] + acc[mt][3] * acc[mt][3]); }
    ss += __shfl_xor(ss, 16); ss += __shfl_xor(ss, 32);
    const float rstd = frsq(ss * (1.f / 128.f) + EPS);
#pragma unroll
    for (int mt = 0; mt < 8; ++mt) { const f32x4 gg = *(const f32x4*)(og + 16 * mt + 4 * g);
        u32x2 w; w.x = pk2(acc[mt][0] * rstd * gg.x, acc[mt][1] * rstd * gg.y); w.y = pk2(acc[mt][2] * rstd * gg.z, acc[mt][3] * rstd * gg.w);
        *(u32x2*)(CONCAT + (size_t)(t0 + tl) * D + 1024 + h * 128 + 16 * mt + 4 * g) = w; }
    LBAR();
#pragma unroll
    for (int i = 0; i < 4; ++i) { cu[i] = nu[i]; cv[i] = nv[i]; }
    }
#undef GM_LOAD
}
DI void list_insert(float (&L)[16], float x) {
#pragma unroll
    for (int i = 15; i >= 1; --i) L[i] = __builtin_amdgcn_fmed3f(x, L[i - 1], L[i]);
    L[0] = fmaxf(L[0], x);
}
DI void list_merge_xor(float (&L)[16], int mask) {
    float M[16];
#pragma unroll
    for (int i = 0; i < 16; ++i) M[i] = fmaxf(L[i], __shfl_xor(L[15 - i], mask));
#pragma unroll
    for (int s = 8; s >= 1; s >>= 1)
#pragma unroll
        for (int i = 0; i < 16; ++i) if ((i & s) == 0) { const float hi = fmaxf(M[i], M[i + s]), lo = fminf(M[i], M[i + s]); M[i] = hi; M[i + s] = lo; }
#pragma unroll
    for (int i = 0; i < 16; ++i) L[i] = M[i];
}
DI unsigned fbits(float x) { return __builtin_bit_cast(unsigned, x); }
DI float unp7(float x) { return __builtin_bit_cast(float, __builtin_bit_cast(unsigned, x) & 0xFFFFFF80u); }
constexpr int TKST = 136;
DI void topk_phase(const Ctx& C, int l, const bf16* QB, const bf16* K1B, const bf16* K2B, const int* KU, const int* KV, int* EB, float* PG) {
    LAS bf16* KL = (LAS bf16*)C.lds;
    LAS unsigned* tk = (LAS unsigned*)(C.lds + 2 * 128 * TKST * 2 + C.wave * 2048);
    const int lane = C.lane, fr = lane & 15, fq = lane >> 4, h = C.bid & 7, rank = C.bid >> 3;
#pragma unroll
    for (int i = 0; i < 8; ++i) { const int c = C.tid + 512 * i, tb = c >> 11, row = (c & 2047) >> 4, ch = c & 15;
        *(LAS u32x4*)(KL + (tb * 128 + row) * TKST + 8 * ch) = *(const u32x4*)((tb ? K2B : K1B) + ((size_t)(l * 8 + h) * 128 + row) * 128 + 8 * ch); }
    __syncthreads();
#pragma unroll 1
    for (int it = 0; it < 4; ++it) {
        const int tt0 = rank * 512 + C.wave * 64 + it * 16;
        float L[2][16];
        bf16x8 bq[2][4];
#pragma unroll
        for (int half = 0; half < 2; ++half)
#pragma unroll
            for (int ks = 0; ks < 4; ++ks) bq[half][ks] = *(const bf16x8*)(QB + (size_t)(tt0 + fr) * D + h * 256 + half * 128 + 8 * fq + 32 * ks);
#pragma unroll
        for (int half = 0; half < 2; ++half) {
            f32x4 acc[8];
#pragma unroll
            for (int mt = 0; mt < 8; ++mt) acc[mt] = (f32x4){0.f, 0.f, 0.f, 0.f};
            const LAS bf16* Kb = KL + (half * 128 + fr) * TKST + 8 * fq;
#pragma unroll
            for (int ks = 0; ks < 4; ++ks)
#pragma unroll
                for (int mt = 0; mt < 8; ++mt) { const bf16x8 a = *(const LAS bf16x8*)(Kb + (16 * mt) * TKST + 32 * ks); acc[mt] = mfma16(a, bq[half][ks], acc[mt]); }
#pragma unroll
            for (int i = 0; i < 16; ++i) L[half][i] = __builtin_bit_cast(float, 0xFF800000u);
#pragma unroll
            for (int mt = 0; mt < 8; ++mt)
#pragma unroll
                for (int r = 0; r < 4; ++r) { const unsigned key = (unsigned)(16 * mt + 4 * fq + r);
                    const float sv = acc[mt][r];
                    list_insert(L[half], __builtin_bit_cast(float, (fbits(sv) & 0xFFFFFF80u) | key)); }
            list_merge_xor(L[half], 16); list_merge_xor(L[half], 32);
        }
        if (fq == 0) {
#pragma unroll
            for (int i = 0; i < 16; ++i) { tk[(fr * 2 + 0) * 16 + i] = fbits(L[0][i]); tk[(fr * 2 + 1) * 16 + i] = fbits(L[1][i]); }
        }
        float Cn[16];
#pragma unroll
        for (int i = 0; i < 16; ++i) Cn[i] = __builtin_bit_cast(float, 0xFF800000u);
#pragma unroll
        for (int i = 0; i < 16; ++i)
#pragma unroll
            for (int j = 0; j < 16; ++j) if ((i + 1) * (j + 1) <= 16) {
                const float s = unp7(L[0][i]) + unp7(L[1][j]);
                list_insert(Cn, __builtin_bit_cast(float, (fbits(s) & 0xFFFFFF00u) | (unsigned)(i * 16 + j))); }
        LDS_WAIT();
        float sc[4]; int ex[4];
#pragma unroll
        for (int m = 0; m < 4; ++m) {
            const float ck = fq == 0 ? Cn[m] : (fq == 1 ? Cn[4 + m] : (fq == 2 ? Cn[8 + m] : Cn[12 + m]));
            const unsigned cc = fbits(ck) & 255u;
            const unsigned p1 = tk[(fr * 2 + 0) * 16 + (cc >> 4)], p2 = tk[(fr * 2 + 1) * 16 + (cc & 15u)];
            sc[m] = __builtin_bit_cast(float, p1 & 0xFFFFFF80u) + __builtin_bit_cast(float, p2 & 0xFFFFFF80u);
            ex[m] = (int)((p1 & 127u) * 128u + (p2 & 127u));
        }
        float mx = fmaxf(fmaxf(sc[0], sc[1]), fmaxf(sc[2], sc[3]));
        mx = fmaxf(mx, __shfl_xor(mx, 16)); mx = fmaxf(mx, __shfl_xor(mx, 32));
        float w[4], sum = 0.f;
#pragma unroll
        for (int m = 0; m < 4; ++m) { w[m] = fexp2((sc[m] - mx) * 1.442695041f); sum += w[m]; }
        sum += __shfl_xor(sum, 16); sum += __shfl_xor(sum, 32);
        const float inv = 1.0f / sum;
        const size_t o = (size_t)(tt0 + fr) * 128 + h * 16 + 4 * fq;
#pragma unroll
        for (int m = 0; m < 4; ++m) { const int kv = KV[ex[m]]; w[m] = w[m] * inv * __builtin_bit_cast(float, (unsigned)(127 - kv) << 23); ex[m] |= 127 << 16; }
        *(int4*)(EB + o) = make_int4(ex[0], ex[1], ex[2], ex[3]);
        *(f32x4*)(PG + o) = (f32x4){w[0], w[1], w[2], w[3]};
        LDS_WAIT();
    }
}
typedef unsigned char fp8_t;
DI void unpack16(const u32x4 q, float (&f)[16]) {
#pragma unroll
    for (int w = 0; w < 4; ++w) { const int dw = (int)q[w]; const f32x2 lo = __builtin_amdgcn_cvt_pk_f32_fp8(dw, false), hi = __builtin_amdgcn_cvt_pk_f32_fp8(dw, true);
        f[4 * w] = lo.x; f[4 * w + 1] = lo.y; f[4 * w + 2] = hi.x; f[4 * w + 3] = hi.y; }
}
DI int sdot4(int a, int b, int c) { return __builtin_amdgcn_sdot4(a, b, c, false); }
template <int CTRL> DI int dppi(int v) { return __builtin_amdgcn_update_dpp(0, v, CTRL, 0xf, 0xf, true); }
template <int CTRL, int NV> DI void bfly(int (&p)[32], const int base, const bool up) {
#pragma unroll
    for (int m = 0; m < NV / 2; ++m) { const int lo = p[base + m], hi = p[base + m + NV / 2]; const int keep = up ? hi : lo, send = up ? lo : hi; p[base + m] = keep + dppi<CTRL>(send); }
}
#define PU_ADD(P, V_) (void)__hip_atomic_fetch_add((P), (V_), __ATOMIC_RELAXED, __HIP_MEMORY_SCOPE_AGENT)
DI void peerU_phase(const Ctx& C, const unsigned char* H8, const float* HS, const int* EB, const unsigned char* PU8, const float* SU, int* COEF, const int emask = 0xFFFF) {
    const int x = C.bid & 7, rank = C.bid >> 3, lane = C.lane, g = lane >> 4, i16 = lane & 15;
    const __amdgpu_buffer_rsrc_t trs = __builtin_amdgcn_make_buffer_rsrc((void*)(PU8 + (size_t)x * NEXP * 256), 0, NEXP * 256, 0x00020000);
    const float* su = SU + (size_t)x * NEXP;
    const int tbase = rank * 512 + C.wave * 64;
    int* part = COEF + (size_t)tbase * 128 + lane;
    const int* ebase = EB + (size_t)tbase * 128 + lane;
    const unsigned char* hbase = H8 + (size_t)tbase * 2048 + 256 * x + 16 * i16;
    const float* hsb = HS + (size_t)tbase * 8 + x;
    const int bp0 = 64 * g, loff = 16 * i16;
    const bool b3 = (i16 & 8) != 0, b2 = (i16 & 4) != 0, b1 = (i16 & 2) != 0, b0 = (i16 & 1) != 0;
    int en0 = ebase[0] & emask, en1 = ebase[64] & emask;
    int er0 = ebase[128], er1 = ebase[192];
    u32x4 hh = *(const u32x4*)hbase;
    float sc0 = su[en0], sc1 = su[en1], hs = hsb[0];
    u32x4 buf[32];
#pragma unroll
    for (int u = 0; u < 32; ++u) { const int e = __builtin_amdgcn_ds_bpermute(bp0 + 4 * (u & 15), u < 16 ? en0 : en1); buf[u] = __builtin_amdgcn_raw_buffer_load_b128(trs, e * 256 + loff, 0, 0); }
    __builtin_amdgcn_sched_barrier(0);
    en0 = er0 & emask; en1 = er1 & emask;
    int pend0 = 0, pend1 = 0; int* pend_p = part;
#pragma unroll 1
    for (int ti = 0; ti < 64; ++ti) {
        const int tn = ti + 1 < 64 ? ti + 1 : 63, t2 = ti + 2 < 64 ? ti + 2 : 63;
        er0 = ebase[t2 * 128]; er1 = ebase[t2 * 128 + 64];
        const u32x4 hhn = *(const u32x4*)(hbase + (size_t)tn * 2048);
        const float scn0 = su[en0], scn1 = su[en1], hsn = hsb[tn * 8];
        __builtin_amdgcn_sched_barrier(0);
        int p[32];
#pragma unroll
        for (int u0 = 0; u0 < 32; u0 += 4) {
            int en[4];
#pragma unroll
            for (int u = u0; u < u0 + 4; ++u) en[u - u0] = __builtin_amdgcn_ds_bpermute(bp0 + 4 * (u & 15), u < 16 ? en0 : en1);
#pragma unroll
            for (int u = u0; u < u0 + 4; ++u) {
                const u32x4 r = buf[u];
                int ah = sdot4((int)r.x, (int)hh.x, 0); ah = sdot4((int)r.y, (int)hh.y, ah); ah = sdot4((int)r.z, (int)hh.z, ah); ah = sdot4((int)r.w, (int)hh.w, ah);
                p[u] = ah; }
            asm volatile("" : "+v"(p[u0]), "+v"(p[u0 + 1]), "+v"(p[u0 + 2]), "+v"(p[u0 + 3]) :: "memory");
#pragma unroll
            for (int u = u0; u < u0 + 4; ++u) buf[u] = __builtin_amdgcn_raw_buffer_load_b128(trs, en[u - u0] * 256 + loff, 0, 0);
            if (u0 == 12) { PU_ADD(pend_p, pend0); PU_ADD(pend_p + 64, pend1); }
            __builtin_amdgcn_sched_barrier(0);
        }
        bfly<0x140, 16>(p, 0, b3); bfly<0x140, 16>(p, 16, b3);
        bfly<0x141, 8>(p, 0, b2); bfly<0x141, 8>(p, 16, b2);
        bfly<0x4E, 4>(p, 0, b1); bfly<0x4E, 4>(p, 16, b1);
        bfly<0xB1, 2>(p, 0, b0); bfly<0xB1, 2>(p, 16, b0);
        pend0 = (int)__builtin_rintf(fminf(fmaxf((float)p[0] * (sc0 * hs * 16384.0f), -2.0e9f), 2.0e9f)); pend1 = (int)__builtin_rintf(fminf(fmaxf((float)p[16] * (sc1 * hs * 16384.0f), -2.0e9f), 2.0e9f)); pend_p = part + (size_t)ti * 128;
        asm volatile("" : "+v"(er0), "+v"(er1) :: "memory");
        en0 = er0 & emask; en1 = er1 & emask; hh = hhn; sc0 = scn0; sc1 = scn1; hs = hsn;
    }
    PU_ADD(pend_p, pend0); PU_ADD(pend_p + 64, pend1);
#undef PU_ADD
}
typedef long i64_t;
constexpr int PV_BLK = 272;
DI void peerV_phase(const Ctx& C, const int* EB, const float* PG, const int* COEF, const fp8_t* PV8, bf16* X, const float* gate  , const int emask = 0x3FFF, const long wdelta = 0  ) {
    const int x = C.bid & 7, rank = C.bid >> 3, lane = C.lane, g = lane >> 4, i16 = lane & 15;
    const __amdgpu_buffer_rsrc_t trs = __builtin_amdgcn_make_buffer_rsrc((void*)(PV8 + (size_t)x * NEXP * 256), 0, NEXP * 256, 0x00020000);
    const int tbase = rank * 512 + C.wave * 64;
    ldsp wl = C.lds + C.wave * (8 * PV_BLK);
    const int wr_off = g * PV_BLK + 16 * i16;
    const int rd_off = ((((lane >> 1) & 1) * 4) + (lane & 1)) * PV_BLK + 16 * (lane >> 2);
    const int bp0 = 64 * g, loff = 16 * i16;
    const int ash = (i16 < 8) ? 24 : 16, asl = 8 * (i16 & 3); const unsigned amlo = (i16 & 4) ? 0u : 0xFFFFFFFFu, amhi = ~amlo;
    const int* ebase = EB + (size_t)tbase * 128 + lane; const float* gbase = PG + (size_t)tbase * 128 + lane; const int* pbase = COEF + (size_t)tbase * 128 + lane;
    const int col = 256 * x + 4 * lane;
    const f32x4 gt = *(const f32x4*)(gate + (size_t)(tbase >> 12) * MODW + col);
    int pc0, pc1; float rg0, rg1;
#define PV_LOAD_RAW(tt) do { pc0 = pbase[(tt) * 128]; pc1 = pbase[(tt) * 128 + 64]; rg0 = gbase[(tt) * 128]; rg1 = gbase[(tt) * 128 + 64]; } while (0)
#define PV_PACK(PK0, PK1, INVA, ID0, ID1) do { const float s0_ = (float)pc0 * (1.0f / 16384.0f), s1_ = (float)pc1 * (1.0f / 16384.0f); \
        const float a0_ = gelu_t(s0_) * rg0, a1_ = gelu_t(s1_) * rg1; const float amax_ = wave_max_u(fmaxf(fabsf(a0_), fabsf(a1_))); \
        int ka_ = 0; if (amax_ > 0.f) { ka_ = (int)((__builtin_bit_cast(unsigned, 224.0f / amax_) >> 23) & 255u) - 127; ka_ = ka_ < -100 ? -100 : (ka_ > 100 ? 100 : ka_); } \
        const float sca_ = __builtin_bit_cast(float, (unsigned)(ka_ + 127) << 23); INVA = __builtin_bit_cast(float, (unsigned)(127 - ka_) << 23); \
        const float h0_ = a0_ * sca_, h1_ = a1_ * sca_; const int ph_ = __builtin_amdgcn_cvt_pk_fp8_f32(h0_, h1_, 0, false); const f32x2 bk_ = __builtin_amdgcn_cvt_pk_f32_fp8(ph_, false); \
        const int pl_ = __builtin_amdgcn_cvt_pk_fp8_f32((h0_ - bk_.x) * 16.0f, (h1_ - bk_.y) * 16.0f, 0, false); \
        PK0 = (int)(((unsigned)(ph_ & 255) << 24) | ((unsigned)(pl_ & 255) << 16) | (unsigned)(ID0)); PK1 = (int)(((unsigned)(ph_ & 0xFF00) << 16) | ((unsigned)(pl_ & 0xFF00) << 8) | (unsigned)(ID1)); } while (0)
    const int e0 = ebase[0] & emask, e1 = ebase[64] & emask;
    int er0 = ebase[128], er1 = ebase[192];
    PV_LOAD_RAW(0);
    u32x2* xp0 = (u32x2*)(X + (size_t)tbase * D + col);
    u32x2 xpend = *xp0; u32x2* xpend_p = (u32x2*)((bf16*)xp0 + wdelta);
    u32x4 buf[32];
#pragma unroll
    for (int u = 0; u < 32; ++u) { const int e = __builtin_amdgcn_ds_bpermute(bp0 + 4 * (u & 15), u < 16 ? e0 : e1); buf[u] = __builtin_amdgcn_raw_buffer_load_b128(trs, e * 256 + loff, 0, 0); }
    __builtin_amdgcn_sched_barrier(0);
    int pk0, pk1; float inva;
    PV_PACK(pk0, pk1, inva, er0 & emask, er1 & emask);
#pragma unroll 1
    for (int ti = 0; ti < 64; ++ti) {
        const int tn = ti + 1 < 64 ? ti + 1 : 63, t2 = ti + 2 < 64 ? ti + 2 : 63;
        er0 = ebase[t2 * 128]; er1 = ebase[t2 * 128 + 64];
        PV_LOAD_RAW(tn);
        u32x2* xp = (u32x2*)(X + (size_t)(tbase + ti) * D + col);
        const u32x2 xold = *xp;
        __builtin_amdgcn_sched_barrier(0);
        f32x4 d0 = (f32x4){0.f, 0.f, 0.f, 0.f}, d1 = d0;
#pragma unroll
        for (int u0 = 0; u0 < 32; u0 += 4) {
            int w[4];
#pragma unroll
            for (int u = u0; u < u0 + 4; ++u) w[u - u0] = __builtin_amdgcn_ds_bpermute(bp0 + 4 * (u & 15), u < 16 ? pk0 : pk1);
#pragma unroll
            for (int u = u0; u < u0 + 4; ++u) {
                const u32x4 r = buf[u]; const unsigned ab = (((unsigned)w[u - u0] >> ash) & 255u) << asl;
                const i64_t av = (i64_t)(((unsigned long long)(ab & amhi) << 32) | (ab & amlo));
                d0 = __builtin_amdgcn_mfma_f32_16x16x32_fp8_fp8(av, (i64_t)(((unsigned long long)r.y << 32) | r.x), d0, 0, 0, 0);
                d1 = __builtin_amdgcn_mfma_f32_16x16x32_fp8_fp8(av, (i64_t)(((unsigned long long)r.w << 32) | r.z), d1, 0, 0, 0); }
            asm volatile("" : "+v"(d0), "+v"(d1) :: "memory");
#pragma unroll
            for (int u = u0; u < u0 + 4; ++u) buf[u] = __builtin_amdgcn_raw_buffer_load_b128(trs, ((w[u - u0] & 0x3FFF) << 8) + loff, 0, 0);
            if (u0 == 12) *xpend_p = xpend;
            __builtin_amdgcn_sched_barrier(0);
        }
        *(LAS f32x4*)(wl + wr_off) = d0; *(LAS f32x4*)(wl + wr_off + 4 * PV_BLK) = d1;
        const f32x4 yh = *(const LAS f32x4*)(wl + rd_off), yl = *(const LAS f32x4*)(wl + rd_off + 2 * PV_BLK);
        const f32x4 y = (yh + yl * 0.0625f) * inva;
        {   const f32x4 xn = (f32x4){bflo(xold.x), bfhi(xold.x), bflo(xold.y), bfhi(xold.y)} + gt * y; xpend.x = pk2(xn.x, xn.y); xpend.y = pk2(xn.z, xn.w); }
        xpend_p = (u32x2*)((bf16*)xp + wdelta);
        asm volatile("" : "+v"(er0), "+v"(er1) :: "memory");
        PV_PACK(pk0, pk1, inva, er0 & emask, er1 & emask);
    }
    *xpend_p = xpend;
#undef PV_LOAD_RAW
#undef PV_PACK
}
DI void final_norm_phase(const Ctx& C, const bf16* XBp, float* OUT, const float* g) {
    const int r0 = C.gw * 8;
    f32x4 gm[8];
#pragma unroll
    for (int j = 0; j < 8; ++j) gm[j] = ((const f32x4*)g)[64 * j + C.lane];
#pragma unroll 1
    for (int i = 0; i < 8; ++i) {
        const u32x2* xr = (const u32x2*)(XBp + (size_t)(r0 + i) * D) + C.lane; f32x4* orow = (f32x4*)(OUT + (size_t)(r0 + i) * D) + C.lane; f32x4 v[8]; float s = 0.f;
#pragma unroll
        for (int j = 0; j < 8; ++j) { const u32x2 w = xr[64 * j]; v[j] = (f32x4){bflo(w.x), bfhi(w.x), bflo(w.y), bfhi(w.y)}; s += (v[j].x * v[j].x + v[j].y * v[j].y) + (v[j].z * v[j].z + v[j].w * v[j].w); }
        const float rstd = frsq(wave_sum(s) * (1.f / D) + EPS);
#pragma unroll
        for (int j = 0; j < 8; ++j) orow[64 * j] = v[j] * rstd * gm[j];
    }
}
#ifndef PH_MASK
#define PH_MASK 0xFFFFF
#endif
#define EN(k) (((PH_MASK) >> (k)) & 1)
#ifndef GEMM_SP2
#define GEMM_SP2 true
#endif
#ifndef GEMM_ALIGN
#define GEMM_ALIGN false
#endif
constexpr int NKIND = 11, NPH = 2 + 2 * NKIND;
struct Args { const float* in[21]; float* out; unsigned char* ws; int ph_lo, ph_hi, pad0, pad1; };
__global__ void __launch_bounds__(NTHR, 2) mk_fwd(Args args) {
    extern __shared__ __attribute__((aligned(16))) unsigned char lds_raw[];
    ldsp ldsb = (ldsp)lds_raw;
    volatile LAS unsigned* MISC = (volatile LAS unsigned*)(ldsb + MISC_OFF);
    for (int u = threadIdx.x; u < (LDS_BYTES - LDSCTL_OFF) / 4; u += NTHR) ((LAS unsigned*)(ldsb + LDSCTL_OFF))[u] = 0u;
    __syncthreads();
    unsigned* barw = (unsigned*)(args.ws + WS_CTL) + CW_BAR;
    XcdBarrier bar; bar.bar = barw; bar.x = 0; bar.st = nullptr;
    const bool multi = (args.ph_hi - args.ph_lo) > 1;
    if (multi) bar = xcd_barrier_post(barw, MISC + 8);

#pragma unroll 1
    for (int ph = args.ph_lo; ph < args.ph_hi; ++ph) {
#define MKCTX Ctx C; { int tid_ = threadIdx.x, bid_ = blockIdx.x; asm volatile("" : "+v"(tid_)); asm volatile("" : "+s"(bid_)); \
        C.lds = ldsb; C.tid = tid_; C.lane = tid_ & 63; C.wave = __builtin_amdgcn_readfirstlane(tid_ >> 6); C.bid = bid_; C.G = gridDim.x; C.gw = C.bid * NWAVES + C.wave; C.NGW = C.G * NWAVES; \
        C.ws = args.ws; }
        unsigned char* const wsb = args.ws;
        float* MOD = (float*)(wsb + WS_MOD);
        bf16* Hb = (bf16*)(wsb + WS_H); bf16* PROJ = (bf16*)(wsb + WS_PROJ); bf16* SBUF = (bf16*)(wsb + WS_SBUF); bf16* CONCAT = (bf16*)(wsb + WS_CONCAT); bf16* QB = (bf16*)(wsb + WS_QB);
        float* ALOW = (float*)(wsb + WS_ALOW); float* DEC = (float*)(wsb + WS_DEC); int* EB = (int*)(wsb + WS_EB); float* PG = (float*)(wsb + WS_PG);
        bf16* X = (bf16*)(wsb + WS_XB);
        const int l = ph < 2 ? 0 : (ph - 2) / NKIND, kind = ph < 2 ? -1 : (ph - 2) % NKIND;
        const float* modl = MOD + (size_t)l * 4 * MODW;
        if (ph == 0) { if (EN(0)) { MKCTX; p0_prologue(C); } }
        else if (ph == 1) { if (EN(1)) { MKCTX; norm_phase(C, KARG(I_X), KARG(I_N1G), modl, 0, D, Hb); } }
        else if ((kind == 0 || kind == 6) && EN(2)) {
            MKCTX; const bool isq = (kind == 6);
            pg8::Gemm g{Hb, isq ? (const bf16*)(wsb + WS_WTQ) + (size_t)l * D * D : (const bf16*)(wsb + WS_WTIN) + (size_t)l * WTIN_L, T, isq ? D : NPROJ, D};
            pg8::StaticOrder S; S.init(T, g.N, C.G, C.bid);
            pg8::EpiBf16 E{isq ? QB : PROJ, isq ? D : NPROJ};
            pg8::gemm_phase<pg8::EpiBf16, pg8::StaticOrder, GEMM_ALIGN, GEMM_SP2>(C.lds, g, S, E, C.tid);
            if (!isq) alow_phase(C, Hb, (const bf16*)(wsb + WS_WTIN) + (size_t)l * WTIN_L + (size_t)NPROJ * D, ALOW);
        }
        else if (kind == 1 && EN(3)) {
            MKCTX;
            glaA_phase(C, l, PROJ, ALOW, SBUF, DEC);
            gmlp_phase(C, l, PROJ, (const bf16*)(wsb + WS_WSB), CONCAT);
        }
        else if (kind == 2) { if (EN(4)) { MKCTX; scan_phase(C, SBUF, DEC); } }
        else if (kind == 3 && EN(5)) { MKCTX; glaC_phase(C, l, PROJ, ALOW, SBUF, CONCAT); }
        else if (kind == 4 && EN(6)) {
            MKCTX;
            pg8::Gemm g{CONCAT, (const bf16*)(wsb + WS_WTOUT) + (size_t)l * D * D, T, D, D};
            pg8::StaticOrder S; S.init(T, D, C.G, C.bid);
            pg8::EpiResGate E{l == 0 ? KARG(I_X) : (const float*)nullptr, X, X, modl + 2 * D, MODW};
            pg8::gemm_phase<pg8::EpiResGate, pg8::StaticOrder, GEMM_ALIGN, GEMM_SP2>(C.lds, g, S, E, C.tid);
        }
        else if (kind == 5) { if (EN(1)) { MKCTX; norm_phase<true, true>(C, X, KARG(I_N2G) + (size_t)l * D, modl, 3 * D, 4 * D, Hb, wsb + WS_H8, (float*)(wsb + WS_HS), (int*)(wsb + WS_COEF)); } }
        else if (kind == 7) { if (EN(7)) { MKCTX; topk_phase(C, l, QB, (const bf16*)(wsb + WS_K1B), (const bf16*)(wsb + WS_K2B), (const int*)(wsb + WS_KU) + l * NEXP, (const int*)(wsb + WS_KV) + l * NEXP, EB, PG); } }
        else if (kind == 8) { if (EN(8)) { MKCTX; peerU_phase(C, wsb + WS_H8, (const float*)(wsb + WS_HS), EB, wsb + WS_PUB + (size_t)l * NEXP * D, (const float*)(wsb + WS_SU) + (size_t)l * 8 * NEXP, (int*)(wsb + WS_COEF)); } }
        else if (kind == 9) { if (EN(9)) { MKCTX; peerV_phase(C, EB, PG, (const int*)(wsb + WS_COEF), (const fp8_t*)(wsb + WS_PVB) + (size_t)l * NEXP * D, X, modl + 5 * D); } }
        else if (EN(10)) {
            MKCTX;
            if (l == DEPTH - 1) final_norm_phase(C, X, args.out, KARG(I_FG));
            else norm_phase<false, true>(C, X, KARG(I_N1G) + (size_t)(l + 1) * D, MOD + (size_t)(l + 1) * 4 * MODW, 0, D, Hb);
        }
        if (ph + 1 < args.ph_hi) xcd_barrier(bar);
    }
}

extern "C" void kernel_launch(void* const* d_in, const int* in_sizes, int n_in, void* d_out, int out_size, void* d_ws, size_t ws_size, hipStream_t stream) {
    static int grid = 0;
    if (grid == 0) {
        if (n_in != 21 || out_size != T * D || ws_size < WS_END) { fprintf(stderr, "kernel_launch: unexpected shapes (n_in %d, out %d, ws %zu)\n", n_in, out_size, ws_size); grid = -1; return; }
        int dev = 0, cus = 0, per_cu = 0;
        if (hipGetDevice(&dev) != hipSuccess || hipDeviceGetAttribute(&cus, hipDeviceAttributeMultiprocessorCount, dev) != hipSuccess) { grid = -1; return; }
        if (hipFuncSetAttribute((const void*)mk_fwd, hipFuncAttributeMaxDynamicSharedMemorySize, LDS_BYTES) != hipSuccess) { fprintf(stderr, "kernel_launch: hipFuncSetAttribute failed\n"); grid = -1; return; }
        if (hipOccupancyMaxActiveBlocksPerMultiprocessor(&per_cu, (const void*)mk_fwd, NTHR, LDS_BYTES) != hipSuccess || per_cu < 1) { fprintf(stderr, "kernel_launch: occupancy query says %d blocks per CU\n", per_cu); (void)hipGetLastError(); grid = -1; return; }
        if (cus != 256) { fprintf(stderr, "kernel_launch: built for a 256-CU device (got %d)\n", cus); grid = -1; return; }
        grid = cus;
    }
    if (grid < 0) return;
    (void)hipMemsetAsync((char*)d_ws + WS_CTL, 0, CTL_ZERO_BYTES, stream);
    Args a{};
    for (int i = 0; i < 21; ++i) a.in[i] = (const float*)d_in[i];
    a.out = (float*)d_out; a.ws = (unsigned char*)d_ws;
#if MK_N_LAUNCHES == 1
    a.ph_lo = 0; a.ph_hi = NPH;
    hipLaunchKernelGGL(mk_fwd, dim3(grid), dim3(NTHR), LDS_BYTES, stream, a);
#else
    for (int p = 0; p < NPH; ++p) { a.ph_lo = p; a.ph_hi = p + 1; hipLaunchKernelGGL(mk_fwd, dim3(grid), dim3(NTHR), LDS_BYTES, stream, a); }
#endif
}
```

```cpp
#include <hip/hip_runtime.h>
#include <cstdio>
#include <cstdint>
#ifndef MK_N_LAUNCHES
#define MK_N_LAUNCHES 1
#endif
namespace pg8 {
#define PG8_LAS __attribute__((address_space(3)))
typedef unsigned short bf16_t;
typedef short bf16x8 __attribute__((ext_vector_type(8)));
typedef float f32x4 __attribute__((ext_vector_type(4)));
typedef unsigned u32x4 __attribute__((ext_vector_type(4)));
constexpr int BM = 256, BK = 64, HALF = 128, HTB = HALF * BK * 2  , STAGE_BYTES = 8 * HTB, NXCD = 8, WGM = 8;

__host__ __device__ __forceinline__ int lds_byte(int r, int c) { const int st = (r >> 4) * 2 + (c >> 5), rr = r & 15, cc = c & 31, ob = rr * 64 + cc * 2; return st * 1024 + (ob ^ (((ob >> 9) & 1) << 5)); }
__host__ __device__ __forceinline__ void stage_rc(int b, int& R, int& C) { const int st = b / 1024, sb = b % 1024, swz = sb ^ (((sb >> 9) & 1) << 5); R = (st >> 1) * 16 + swz / 64; C = (st & 1) * 32 + (swz % 64) / 2; }
__host__ __device__ __forceinline__ int perm32(int rho) { const int n = rho >> 4, i = rho & 15; return 8 * (i >> 2) + 4 * n + (i & 3); }

struct Unit { int pm, pn; };
struct Gemm { const bf16_t* A; const bf16_t* Bt; int M, N, K; };

struct StaticOrder {
    int nM, nN, nwg, G, c;
    __host__ __device__ void init(int M, int N, int G_, int c_) { nM = M / BM; nN = N / BM; nwg = nM * nN; G = G_; c = c_; }
    __host__ __device__ bool next(int i, Unit& u) const {
        const long L = (long)i * G + c; if (L >= nwg) return false;
        int wgid = (int)L; { const int q = nwg / NXCD, r = nwg % NXCD, xcd = wgid % NXCD, off = wgid / NXCD; wgid = (xcd < r ? xcd * (q + 1) : r * (q + 1) + (xcd - r) * q) + off; }
        const int nig = WGM * nN, gid = wgid / nig, fm = gid * WGM, gsz = (nM - fm) < WGM ? (nM - fm) : WGM;
        u.pm = fm + ((wgid % nig) % gsz); u.pn = (wgid % nig) / gsz; return true;
    }
    __device__ __forceinline__ void a_ready(const Unit&) const {}
    __device__ __forceinline__ void done(const Unit&) const {}
};
__device__ __forceinline__ unsigned cvt_pk_bf16(float lo, float hi) { unsigned r; asm volatile("v_cvt_pk_bf16_f32 %0, %1, %2" : "=v"(r) : "v"(lo), "v"(hi)); return r; }
struct EpiBf16 {
    static constexpr bool PERM = true, AFTER_DRAIN = false;
    bf16_t* O; int ldc;
    __device__ __forceinline__ void operator()(const f32x4 (&acc)[2][2][4][2], const Unit& u, int wr, int wc, int fr, int fq) const {
        const int row0 = u.pm * BM + wr * 64 + fr; const int col0 = u.pn * BM + wc * 32 + 8 * fq;
#pragma unroll
        for (int ai = 0; ai < 2; ++ai)
#pragma unroll
            for (int m = 0; m < 4; ++m) { bf16_t* rowp = O + (size_t)(row0 + ai * HALF + m * 16) * ldc + col0;
#pragma unroll
                for (int bj = 0; bj < 2; ++bj) { const f32x4 v0 = acc[ai][bj][m][0], v1 = acc[ai][bj][m][1];
                    u32x4 w; w.x = cvt_pk_bf16(v0[0], v0[1]); w.y = cvt_pk_bf16(v0[2], v0[3]); w.z = cvt_pk_bf16(v1[0], v1[1]); w.w = cvt_pk_bf16(v1[2], v1[3]);
                    *(u32x4*)(rowp + bj * HALF) = w; } }
    }
};
struct EpiResGate {
    static constexpr bool PERM = true, AFTER_DRAIN = false;
    const float* base32; const bf16_t* baseb; bf16_t* out; const float* gate; int gpitch;
    __device__ __forceinline__ void operator()(const f32x4 (&acc)[2][2][4][2], const Unit& u, int wr, int wc, int fr, int fq) const {
        const int row0 = u.pm * BM + wr * 64 + fr, col0 = u.pn * BM + wc * 32 + 8 * fq;
        const float* gp = gate + (size_t)(u.pm >> 4) * gpitch + col0;
        f32x4 gv[2][2];
#pragma unroll
        for (int bj = 0; bj < 2; ++bj)
#pragma unroll
            for (int n = 0; n < 2; ++n) gv[bj][n] = *(const f32x4*)(gp + bj * HALF + n * 4);
#define ERG_OFF(G_) ((size_t)(row0 + ((G_) >> 2) * HALF + ((G_) & 3) * 16) * 2048 + col0)
        if (base32) {
            f32x4 bs[2][2][2];
#define ERG_LOAD(G_) do { _Pragma("unroll") for (int bj = 0; bj < 2; ++bj) _Pragma("unroll") for (int n = 0; n < 2; ++n) bs[(G_) & 1][bj][n] = *(const f32x4*)(base32 + ERG_OFF(G_) + bj * HALF + n * 4); } while (0)
            ERG_LOAD(0); ERG_LOAD(1);
#pragma unroll
            for (int gq = 0; gq < 8; ++gq) {
#pragma unroll
                for (int bj = 0; bj < 2; ++bj) { const f32x4 v0 = bs[gq & 1][bj][0] + gv[bj][0] * acc[gq >> 2][bj][gq & 3][0], v1 = bs[gq & 1][bj][1] + gv[bj][1] * acc[gq >> 2][bj][gq & 3][1];
                    u32x4 w; w.x = cvt_pk_bf16(v0[0], v0[1]); w.y = cvt_pk_bf16(v0[2], v0[3]); w.z = cvt_pk_bf16(v1[0], v1[1]); w.w = cvt_pk_bf16(v1[2], v1[3]);
                    *(u32x4*)(out + ERG_OFF(gq) + bj * HALF) = w; }
                asm volatile("" ::: "memory");
                if (gq + 2 < 8) ERG_LOAD(gq + 2);
                asm volatile("" ::: "memory"); }
#undef ERG_LOAD
        } else {
            u32x4 bb[4][2];
#define ERG_LOADB(G_) do { _Pragma("unroll") for (int bj = 0; bj < 2; ++bj) bb[(G_) & 3][bj] = *(const u32x4*)(baseb + ERG_OFF(G_) + bj * HALF); } while (0)
            ERG_LOADB(0); ERG_LOADB(1); ERG_LOADB(2); ERG_LOADB(3);
#pragma unroll
            for (int gq = 0; gq < 8; ++gq) {
#pragma unroll
                for (int bj = 0; bj < 2; ++bj) { const u32x4 b = bb[gq & 3][bj];
                    const f32x4 b0 = (f32x4){__builtin_bit_cast(float, b.x << 16), __builtin_bit_cast(float, b.x & 0xffff0000u), __builtin_bit_cast(float, b.y << 16), __builtin_bit_cast(float, b.y & 0xffff0000u)};
                    const f32x4 b1 = (f32x4){__builtin_bit_cast(float, b.z << 16), __builtin_bit_cast(float, b.z & 0xffff0000u), __builtin_bit_cast(float, b.w << 16), __builtin_bit_cast(float, b.w & 0xffff0000u)};
                    const f32x4 v0 = b0 + gv[bj][0] * acc[gq >> 2][bj][gq & 3][0], v1 = b1 + gv[bj][1] * acc[gq >> 2][bj][gq & 3][1];
                    u32x4 w; w.x = cvt_pk_bf16(v0[0], v0[1]); w.y = cvt_pk_bf16(v0[2], v0[3]); w.z = cvt_pk_bf16(v1[0], v1[1]); w.w = cvt_pk_bf16(v1[2], v1[3]);
                    *(u32x4*)(out + ERG_OFF(gq) + bj * HALF) = w; }
                asm volatile("" ::: "memory");
                if (gq + 4 < 8) ERG_LOADB(gq + 4);
                asm volatile("" ::: "memory"); }
#undef ERG_LOADB
        }
#undef ERG_OFF
    }
};
template <class Epi, class Sched, bool ALIGN_EPI = false, bool SP2 = false>
__device__ __forceinline__ void gemm_phase(PG8_LAS unsigned char* lds, const Gemm g, const Sched& S, const Epi& E, const int tid  ) {
    const int wid = __builtin_amdgcn_readfirstlane(tid >> 6), lane = tid & 63, wr = wid >> 2, wc = wid & 3, fr = lane & 15, fq = lane >> 4;
    const int K = g.K, nt = K / BK;
    unsigned voffA[2], voffB[2];
#pragma unroll
    for (int i = 0; i < 2; ++i) { int R, C; stage_rc(tid * 16 + i * 8192, R, C); const int Rb = Epi::PERM ? ((R & ~31) + perm32(R & 31)) : R;
        voffA[i] = (unsigned)(R * K + C) * 2u; voffB[i] = (unsigned)(Rb * K + C) * 2u; }
    const size_t kstep = (size_t)(BK * 2);
    const size_t hstep = (size_t)HALF * K * 2;
    const size_t tstep = 2 * hstep;
    const unsigned ldsw = (unsigned)wid * 1024u;
    const int aoff = lds_byte(wr * 64 + fr, fq * 8), boff = lds_byte(wc * 32 + fr, fq * 8);
#define PG8_SA(b, h) (((b) * 2 + (h)) * HTB)
#define PG8_SB(b, h) ((4 + (b) * 2 + (h)) * HTB)
#define PG8_STAGE(bufoff, gbase, voff) do { _Pragma("unroll") for (int _i = 0; _i < 2; ++_i) \
        __builtin_amdgcn_global_load_lds((const unsigned*)((const char*)(gbase) + (voff)[_i]), (PG8_LAS unsigned*)(lds + (bufoff) + ldsw + _i * 8192), 16, 0, 0); } while (0)
#define PG8_LDA(dst, b, h) do { _Pragma("unroll") for (int m = 0; m < 4; ++m) _Pragma("unroll") for (int k = 0; k < 2; ++k) dst[m][k] = *(const PG8_LAS bf16x8*)(lds + PG8_SA(b, h) + aoff + m * 2048 + k * 1024); } while (0)
#define PG8_LDB(dst, b, h) do { _Pragma("unroll") for (int n = 0; n < 2; ++n) _Pragma("unroll") for (int k = 0; k < 2; ++k) dst[n][k] = *(const PG8_LAS bf16x8*)(lds + PG8_SB(b, h) + boff + n * 2048 + k * 1024); } while (0)
#define PG8_MMA(ai, bj, At, Bt) do { __builtin_amdgcn_s_setprio(1); _Pragma("unroll") for (int m = 0; m < 4; ++m) _Pragma("unroll") for (int n = 0; n < 2; ++n) _Pragma("unroll") for (int k = 0; k < 2; ++k) \
        acc[ai][bj][m][n] = __builtin_amdgcn_mfma_f32_16x16x32_bf16(Bt[n][k], At[m][k], acc[ai][bj][m][n], 0, 0, 0); __builtin_amdgcn_s_setprio(0); } while (0)
#define PG8_WAIT_V(n) asm volatile("s_waitcnt vmcnt(" #n ")" ::: "memory")
#define PG8_WAIT_L(n) asm volatile("s_waitcnt lgkmcnt(" #n ")" ::: "memory")
#define PG8_BAR __builtin_amdgcn_s_barrier()
#define PG8_SCHED __builtin_amdgcn_sched_barrier(0)
    Unit cur, nxt; int ui = 0;
    if (!S.next(0, cur)) return;
    f32x4 acc[2][2][4][2];
#pragma unroll
    for (int a = 0; a < 2; ++a)
#pragma unroll
        for (int b = 0; b < 2; ++b)
#pragma unroll
            for (int m = 0; m < 4; ++m)
#pragma unroll
                for (int n = 0; n < 2; ++n) acc[a][b][m][n] = (f32x4){0.f, 0.f, 0.f, 0.f};
    bf16x8 At[4][2], B0[2][2], B1[2][2];
    const char* cA = (const char*)g.A + (size_t)cur.pm * tstep; const char* cB = (const char*)g.Bt + (size_t)cur.pn * tstep;
    S.a_ready(cur);
    if constexpr (SP2) {
        PG8_STAGE(PG8_SB(0, 0), cB, voffB); PG8_STAGE(PG8_SB(0, 1), cB + hstep, voffB); PG8_STAGE(PG8_SA(0, 0), cA, voffA); PG8_STAGE(PG8_SA(0, 1), cA + hstep, voffA);
        if (wr == 1) PG8_BAR;
        PG8_WAIT_V(2); PG8_BAR;
        PG8_STAGE(PG8_SB(1, 0), cB + kstep, voffB); PG8_STAGE(PG8_SA(1, 0), cA + kstep, voffA); PG8_STAGE(PG8_SB(1, 1), cB + hstep + kstep, voffB);
        PG8_WAIT_V(6); PG8_BAR;
    } else {
        PG8_STAGE(PG8_SB(0, 0), cB, voffB); PG8_STAGE(PG8_SA(0, 0), cA, voffA); PG8_STAGE(PG8_SB(0, 1), cB + hstep, voffB); PG8_STAGE(PG8_SA(0, 1), cA + hstep, voffA);
        if (wr == 1) PG8_BAR;
        PG8_WAIT_V(4); PG8_BAR;
        PG8_STAGE(PG8_SB(1, 0), cB + kstep, voffB); PG8_STAGE(PG8_SA(1, 0), cA + kstep, voffA); PG8_STAGE(PG8_SB(1, 1), cB + hstep + kstep, voffB);
        PG8_WAIT_V(6); PG8_BAR;
    }
    for (;;) {
        const bool has_next = S.next(ui + 1, nxt);
        const char* nA = has_next ? (const char*)g.A + (size_t)nxt.pm * tstep : cA; const char* nB = has_next ? (const char*)g.Bt + (size_t)nxt.pn * tstep : cB;
        for (int t = 0; t < nt; t += 2) {
            const bool last = (t == nt - 2);
            const char* a1 = cA + (size_t)(t + 1) * kstep;
            const char* a2 = last ? nA : cA + (size_t)(t + 2) * kstep; const char* b2 = last ? nB : cB + (size_t)(t + 2) * kstep;
            const char* a3 = a2 + kstep; const char* b3 = b2 + kstep;
            if (last && has_next) S.a_ready(nxt);
            if constexpr (SP2) {
            PG8_LDB(B0, 0, 0); PG8_LDB(B1, 0, 1); PG8_SCHED; PG8_LDA(At, 0, 0); PG8_STAGE(PG8_SA(1, 1), a1 + hstep, voffA);
            PG8_WAIT_V(8); PG8_WAIT_L(0); PG8_BAR; PG8_MMA(0, 0, At, B0); PG8_MMA(0, 1, At, B1); PG8_BAR; PG8_SCHED;
            PG8_LDA(At, 0, 1); PG8_STAGE(PG8_SB(0, 0), b2, voffB); PG8_STAGE(PG8_SB(0, 1), b2 + hstep, voffB); PG8_STAGE(PG8_SA(0, 0), a2, voffA);
            PG8_WAIT_V(8); PG8_WAIT_L(0); PG8_BAR; PG8_MMA(1, 0, At, B0); PG8_MMA(1, 1, At, B1); PG8_BAR; PG8_SCHED;
            PG8_LDB(B0, 1, 0); PG8_LDB(B1, 1, 1); PG8_SCHED; PG8_LDA(At, 1, 0); PG8_STAGE(PG8_SA(0, 1), a2 + hstep, voffA);
            PG8_WAIT_V(8); PG8_WAIT_L(0); PG8_BAR; PG8_MMA(0, 0, At, B0); PG8_MMA(0, 1, At, B1); PG8_BAR; PG8_SCHED;
            PG8_LDA(At, 1, 1); PG8_STAGE(PG8_SB(1, 0), b3, voffB); PG8_STAGE(PG8_SB(1, 1), b3 + hstep, voffB); PG8_STAGE(PG8_SA(1, 0), a3, voffA);
            PG8_WAIT_V(8); PG8_WAIT_L(0); PG8_BAR; PG8_MMA(1, 0, At, B0); PG8_MMA(1, 1, At, B1); PG8_BAR; PG8_SCHED;
            } else {
            PG8_LDB(B0, 0, 0); PG8_SCHED; PG8_LDA(At, 0, 0); PG8_STAGE(PG8_SA(1, 1), a1 + hstep, voffA);
            PG8_WAIT_L(8); PG8_BAR; PG8_WAIT_L(0); PG8_MMA(0, 0, At, B0); PG8_BAR; PG8_SCHED;
            PG8_LDB(B1, 0, 1); PG8_STAGE(PG8_SB(0, 0), b2, voffB);
            PG8_BAR; PG8_WAIT_L(0); PG8_MMA(0, 1, At, B1); PG8_BAR;
            PG8_LDA(At, 0, 1); PG8_STAGE(PG8_SA(0, 0), a2, voffA);
            PG8_BAR; PG8_WAIT_L(0); PG8_MMA(1, 0, At, B0); PG8_BAR; PG8_SCHED;
            PG8_STAGE(PG8_SB(0, 1), b2 + hstep, voffB);
            PG8_WAIT_V(6); PG8_BAR; PG8_MMA(1, 1, At, B1); PG8_BAR;
            PG8_LDB(B0, 1, 0); PG8_SCHED; PG8_LDA(At, 1, 0); PG8_STAGE(PG8_SA(0, 1), a2 + hstep, voffA);
            PG8_WAIT_L(8); PG8_BAR; PG8_WAIT_L(0); PG8_MMA(0, 0, At, B0); PG8_BAR; PG8_SCHED;
            PG8_LDB(B1, 1, 1); PG8_STAGE(PG8_SB(1, 0), b3, voffB);
            PG8_BAR; PG8_WAIT_L(0); PG8_MMA(0, 1, At, B1); PG8_BAR;
            PG8_LDA(At, 1, 1); PG8_STAGE(PG8_SA(1, 0), a3, voffA);
            PG8_BAR; PG8_WAIT_L(0); PG8_MMA(1, 0, At, B0); PG8_BAR; PG8_SCHED;
            PG8_STAGE(PG8_SB(1, 1), b3 + hstep, voffB);
            PG8_WAIT_V(6); PG8_BAR; PG8_MMA(1, 1, At, B1); PG8_BAR;
            }
        }
        if constexpr (ALIGN_EPI) { if (wr == 0) PG8_BAR; }
        if constexpr (!Epi::AFTER_DRAIN) { E(acc, cur, wr, wc, fr, fq); S.done(cur); }
        if (!has_next) break;
#pragma unroll
        for (int a = 0; a < 2; ++a)
#pragma unroll
            for (int b = 0; b < 2; ++b)
#pragma unroll
                for (int m = 0; m < 4; ++m)
#pragma unroll
                    for (int n = 0; n < 2; ++n) acc[a][b][m][n] = (f32x4){0.f, 0.f, 0.f, 0.f};
        cur = nxt; cA = nA; cB = nB; ++ui;
        if constexpr (ALIGN_EPI) { if (wr == 1) PG8_BAR; }
    }
    PG8_WAIT_V(0);
    if constexpr (!ALIGN_EPI) { if (wr == 0) PG8_BAR; }
    PG8_BAR;
    if constexpr (Epi::AFTER_DRAIN) { E.fused(acc, cur, wr, wc, fr, fq, lds, wid, lane); S.done(cur); }
#undef PG8_SA
#undef PG8_SB
#undef PG8_STAGE
#undef PG8_LDA
#undef PG8_LDB
#undef PG8_MMA
#undef PG8_WAIT_V
#undef PG8_WAIT_L
#undef PG8_BAR
#undef PG8_SCHED
}
}
constexpr int NWAVES = 8, NTHR = 512;
constexpr int D = 2048, NBATCH = 4, SEQ = 4096, T = NBATCH * SEQ, DEPTH = 2;
constexpr int GLA_H = 4, GLA_DK = 128, GLA_DV = 256, GLA_CH = 64;
constexpr int MLP_H = 8, MLP_DH = 128, MLP_CH = 128;
constexpr int IN_COLS = 5136, NPROJ = 5120;
constexpr int C_Q = 0, C_K = 512, C_V = 1024, C_R = 2048, C_U = 3072, C_VS = 4096;
constexpr int NEXP = 16384, PEER_H = 8;
constexpr float EPS = 1e-6f;
constexpr int MODW = 6 * D;
constexpr size_t MiB = 1u << 20;
constexpr size_t WS_CTL = 0, CTL_ZERO_BYTES = 1 * MiB;
constexpr size_t WS_MOD = 1 * MiB;
constexpr size_t WS_K1B = 2 * MiB, WS_K2B = 2 * MiB + 512 * 1024, WS_WSB = 3 * MiB, WS_DEC = 3 * MiB + 512 * 1024, WS_ALOW = 4 * MiB;
constexpr size_t WS_KU = 5 * MiB, WS_KV = 5 * MiB + 256 * 1024;
constexpr size_t WS_SU = 6 * MiB, WS_HS = 7 * MiB;
constexpr size_t WS_WTIN = 8 * MiB;
constexpr size_t WTIN_L = (size_t)5136 * 2048;
constexpr size_t WS_WTOUT = 49 * MiB, WS_WTQ = 65 * MiB;
constexpr size_t WS_PUB = 81 * MiB, WS_PVB = 209 * MiB;
constexpr size_t WS_H = 337 * MiB;
constexpr size_t WS_PROJ = 401 * MiB;
constexpr size_t WS_SBUF = 561 * MiB;
constexpr size_t WS_CONCAT = 625 * MiB;
constexpr size_t WS_QB = 689 * MiB;
constexpr size_t WS_EB = 753 * MiB, WS_PG = 761 * MiB;
constexpr size_t WS_H8 = 769 * MiB, WS_COEF = 833 * MiB, WS_XB = 841 * MiB, WS_END = 905 * MiB;
static_assert(WS_WTIN + 2 * WTIN_L * 2 <= WS_WTOUT, "ws map");
constexpr int CW_BAR = 4096;
constexpr int RING_BYTES = 131072, LDSCTL_OFF = RING_BYTES, MISC_OFF = LDSCTL_OFF + 320, LDS_BYTES = 147456;

#define DI __device__ __forceinline__
#define LAS __attribute__((address_space(3)))
typedef unsigned short bf16;
typedef short bf16x8 __attribute__((ext_vector_type(8)));
typedef short s16x4 __attribute__((ext_vector_type(4)));
typedef short v4i16_t __attribute__((ext_vector_type(4)));
typedef __bf16 bf16x2_t __attribute__((ext_vector_type(2)));
typedef float f32x2_e __attribute__((ext_vector_type(2)));
typedef float f32x4 __attribute__((ext_vector_type(4)));
typedef float f32x2 __attribute__((ext_vector_type(2)));
typedef unsigned u32x4 __attribute__((ext_vector_type(4)));
typedef unsigned u32x2 __attribute__((ext_vector_type(2)));
typedef LAS unsigned char* ldsp;

DI unsigned pk2(float lo, float hi) { const f32x2_e v = {lo, hi}; return __builtin_bit_cast(unsigned, __builtin_convertvector(v, bf16x2_t)); }
DI unsigned f2bf(float f) { return pk2(f, 0.f) & 0xffffu; }
DI float bflo(unsigned u) { return __builtin_bit_cast(float, u << 16); }
DI float bfhi(unsigned u) { return __builtin_bit_cast(float, u & 0xffff0000u); }
DI float bf1(bf16 v) { return __builtin_bit_cast(float, ((unsigned)v) << 16); }
DI float fexp2(float x) { return __builtin_amdgcn_exp2f(x); }
DI float flog2(float x) { return __builtin_amdgcn_logf(x); }
DI float frcp(float x) { return __builtin_amdgcn_rcpf(x); }
DI float frsq(float x) { return __builtin_amdgcn_rsqf(x); }
DI float gelu_t(float x) { const float u = 0.7978845608f * (x + 0.044715f * x * x * x); return x * frcp(1.f + fexp2(-2.885390082f * u)); }
DI float silu_f(float x) { return x * frcp(1.f + fexp2(-1.442695041f * x)); }
template <int CTRL> DI float dppf(float v) { return __builtin_bit_cast(float, __builtin_amdgcn_update_dpp(0, __builtin_bit_cast(int, v), CTRL, 0xf, 0xf, true)); }
DI float wave_sum_u(float v) {
    v += dppf<0xB1>(v); v += dppf<0x4E>(v); v += dppf<0x141>(v); v += dppf<0x140>(v);
    const int iv = __builtin_bit_cast(int, v);
    return (__builtin_bit_cast(float, __builtin_amdgcn_readlane(iv, 0)) + __builtin_bit_cast(float, __builtin_amdgcn_readlane(iv, 16))) +
           (__builtin_bit_cast(float, __builtin_amdgcn_readlane(iv, 32)) + __builtin_bit_cast(float, __builtin_amdgcn_readlane(iv, 48)));
}
DI float wave_max_u(float v) {
    v = fmaxf(v, dppf<0xB1>(v)); v = fmaxf(v, dppf<0x4E>(v)); v = fmaxf(v, dppf<0x141>(v)); v = fmaxf(v, dppf<0x140>(v));
    const int iv = __builtin_bit_cast(int, v);
    return fmaxf(fmaxf(__builtin_bit_cast(float, __builtin_amdgcn_readlane(iv, 0)), __builtin_bit_cast(float, __builtin_amdgcn_readlane(iv, 16))),
                 fmaxf(__builtin_bit_cast(float, __builtin_amdgcn_readlane(iv, 32)), __builtin_bit_cast(float, __builtin_amdgcn_readlane(iv, 48))));
}
DI float wave_sum(float v) {
#pragma unroll
    for (int o = 1; o < 64; o <<= 1) v += __shfl_xor(v, o);
    return v;
}
DI float dot2bf(unsigned a, unsigned b, float c) { return __builtin_amdgcn_fdot2_f32_bf16(__builtin_bit_cast(bf16x2_t, a), __builtin_bit_cast(bf16x2_t, b), c, false); }
DI f32x4 mfma16(bf16x8 a, bf16x8 b, f32x4 c) { return __builtin_amdgcn_mfma_f32_16x16x32_bf16(a, b, c, 0, 0, 0); }
DI s16x4 tr4(const LAS bf16* p) { return __builtin_bit_cast(s16x4, __builtin_amdgcn_ds_read_tr16_b64_v4i16((LAS v4i16_t*)p)); }
DI bf16x8 tr8(const LAS bf16* p, int stride) { const s16x4 a = tr4(p), b = tr4(p + 4 * stride); return (bf16x8){a[0], a[1], a[2], a[3], b[0], b[1], b[2], b[3]}; }

#define XB_TMO      128
#define XB_XCNT(j)  (256  + 64 * (j))
#define XB_XSUB(j)  (1280 + 64 * (j))
#define XB_XGEN(j)  (2304 + 64 * (j))
#define XB_TOP      3328
#define XB_TOPGEN   3392
#define XCD_BAR_WORDS 3456
#define XB_SPIN_CAP (1u << 18)

__device__ __forceinline__ unsigned xb_ld(unsigned* p)              { return __hip_atomic_load(p, __ATOMIC_RELAXED, __HIP_MEMORY_SCOPE_AGENT); }
__device__ __forceinline__ unsigned xb_add(unsigned* p, unsigned v) { return __hip_atomic_fetch_add(p, v, __ATOMIC_RELAXED, __HIP_MEMORY_SCOPE_AGENT); }
__device__ __forceinline__ unsigned xb_xcc_id() { return (unsigned)__builtin_amdgcn_s_getreg((3 << 11) | 20) & 0xFu; }
#define XB_SPIN(cond, bar) do { unsigned _sp = 0; while (cond) { __builtin_amdgcn_s_sleep(1); \
    if ((++_sp & 255u) == 0u) { if (xb_ld(&(bar)[XB_TMO])) break; if (_sp > XB_SPIN_CAP) { atomicAdd(&(bar)[XB_TMO], 1u); break; } } } } while (0)

struct XcdBarrier {
    unsigned* bar; unsigned x;
    volatile LAS unsigned* st;
};

__device__ __forceinline__ XcdBarrier xcd_barrier_post(unsigned* bar, volatile LAS unsigned* st) {
    XcdBarrier b; b.bar = bar; b.x = xb_xcc_id(); b.st = st;
    if (threadIdx.x == 0) (void)xb_add(&bar[XB_XCNT(b.x)], 1u);
    return b;
}
__device__ __forceinline__ void xcd_barrier_complete(unsigned* bar, unsigned x, unsigned& nloc, unsigned& nx) {
    const unsigned G = gridDim.x * gridDim.y * gridDim.z;
    unsigned sum, cnt, mine, sp = 0u;
    for (;;) {
        sum = 0u; cnt = 0u; mine = 0u;
#pragma unroll
        for (unsigned j = 0; j < 16; ++j) { const unsigned c = xb_ld(&bar[XB_XCNT(j)]); sum += c; cnt += (c > 0u) ? 1u : 0u; mine = (j == x) ? c : mine; }
        if (sum == G) break;
        __builtin_amdgcn_s_sleep(1);
        if ((++sp & 255u) == 0u) { if (xb_ld(&bar[XB_TMO])) break; if (sp > XB_SPIN_CAP) { atomicAdd(&bar[XB_TMO], 1u); break; } }
    }
    nloc = mine > 0u ? mine : 1u; nx = cnt > 0u ? cnt : 1u;
}

__device__ __forceinline__ void xcd_barrier(const XcdBarrier& b) {
    asm volatile("s_waitcnt vmcnt(0)" ::: "memory");
    __syncthreads();
    if (threadIdx.x == 0) {
        unsigned* bar = b.bar;
        __builtin_amdgcn_s_waitcnt(0);
        unsigned nloc = b.st[0], nx = b.st[1];
        if (nloc == 0u) { xcd_barrier_complete(bar, b.x, nloc, nx); b.st[0] = nloc; b.st[1] = nx; }
        const unsigned old = xb_add(&bar[XB_XSUB(b.x)], 1u);
        const unsigned gen = old / nloc;
        if (old + 1u == (gen + 1u) * nloc) {
            __builtin_amdgcn_fence(__ATOMIC_RELEASE, "agent");
            asm volatile("s_waitcnt vmcnt(0)" ::: "memory");
            const unsigned og = xb_add(&bar[XB_TOP], 1u);
            const unsigned tg = og / nx;
            if (og + 1u == (tg + 1u) * nx) xb_add(&bar[XB_TOPGEN], 1u);
            else XB_SPIN(xb_ld(&bar[XB_TOPGEN]) == tg, bar);
            __builtin_amdgcn_fence(__ATOMIC_ACQUIRE, "agent");
            xb_add(&bar[XB_XGEN(b.x)], 1u);
            asm volatile("s_waitcnt vmcnt(0)" ::: "memory");
        } else {
            XB_SPIN(xb_ld(&bar[XB_XGEN(b.x)]) == gen, bar);
            __builtin_amdgcn_fence(__ATOMIC_ACQUIRE, "agent");
            asm volatile("s_waitcnt vmcnt(0)" ::: "memory");
        }
    }
    __syncthreads();
}
struct Ctx {
    ldsp lds; int tid, lane, wave, bid, G, gw, NGW;
    unsigned char* ws;
};
DI const float* KARG(int k) { asm volatile("" : "+s"(k)); return ((const float* const*)__builtin_amdgcn_kernarg_segment_ptr())[k]; }
#define LDS_WAIT() asm volatile("s_waitcnt lgkmcnt(0)" ::: "memory")
enum { I_X = 0, I_C, I_ADAW, I_ADAB, I_N1G, I_WIN, I_WA2, I_BA, I_GNG, I_VNG, I_MWS, I_MB, I_MOG, I_WOUT, I_N2G, I_WQ, I_K1, I_K2, I_PU, I_PV, I_FG };

DI void p0_ada(const Ctx& C) {
    LAS float* red = (LAS float*)C.lds;
    float* MOD = (float*)(C.ws + WS_MOD);
    for (int it = C.bid; it < 256; it += C.G) {
        const int l = it >> 7, cg = it & 127, c0 = cg * 96 + (C.lane < 48 ? C.lane : 47) * 2;
        const float* W = KARG(I_ADAW) + (size_t)l * D * MODW + (size_t)(C.wave * 256) * MODW + c0;
        float cv[4][4];
#pragma unroll
        for (int b = 0; b < 4; ++b)
#pragma unroll
            for (int i = 0; i < 4; ++i) cv[b][i] = silu_f(KARG(I_C)[b * D + C.wave * 256 + i * 64 + C.lane]);
        float acc[4][2];
#pragma unroll
        for (int b = 0; b < 4; ++b) { acc[b][0] = 0.f; acc[b][1] = 0.f; }
#pragma unroll
        for (int i = 0; i < 4; ++i) {
#pragma unroll 16
            for (int j = 0; j < 64; ++j) {
                const f32x2 w = *(const f32x2*)(W + (size_t)(i * 64 + j) * MODW);
#pragma unroll
                for (int b = 0; b < 4; ++b) { const float s = __builtin_bit_cast(float, __builtin_amdgcn_readlane(__builtin_bit_cast(int, cv[b][i]), j)); acc[b][0] += s * w.x; acc[b][1] += s * w.y; }
            }
        }
#pragma unroll
        for (int b = 0; b < 4; ++b) *(LAS f32x2*)(red + (C.wave * 4 + b) * 128 + C.lane * 2) = (f32x2){acc[b][0], acc[b][1]};
        __syncthreads();
        { const int b = C.tid >> 7, col = C.tid & 127;
          if (col < 96) { float s = KARG(I_ADAB)[l * MODW + cg * 96 + col];
#pragma unroll
              for (int w = 0; w < 8; ++w) s += red[(w * 4 + b) * 128 + col];
              MOD[(size_t)(l * 4 + b) * MODW + cg * 96 + col] = s; } }
        __syncthreads();
    }
}
DI void transpose_item(const float* W, int ldw, int src_col0, int ncols, bf16* WT, int dst_row0, int k0, LAS float* scr, int lane) {
    const int cl = lane & 31;
    float v[32];
#pragma unroll
    for (int i = 0; i < 32; ++i) { const int kk = 2 * i + (lane >> 5); v[i] = 0.f; if (cl < ncols) v[i] = W[(size_t)(k0 + kk) * ldw + src_col0 + cl]; }
#pragma unroll
    for (int i = 0; i < 32; ++i) { const int kk = 2 * i + (lane >> 5); scr[kk * 33 + cl] = v[i]; }
    LDS_WAIT();
    const int c = lane & 7;
#pragma unroll
    for (int j = 0; j < 4; ++j) { const int n = (lane >> 3) + 8 * j;
        if (n < ncols) { const LAS float* s = scr + (8 * c) * 33 + n;
            u32x4 o; o.x = pk2(s[0 * 33], s[1 * 33]); o.y = pk2(s[2 * 33], s[3 * 33]); o.z = pk2(s[4 * 33], s[5 * 33]); o.w = pk2(s[6 * 33], s[7 * 33]);
            *(u32x4*)(WT + (size_t)(dst_row0 + n) * 2048 + k0 + 8 * c) = o; } }
    LDS_WAIT();
}
DI void p0_prologue(const Ctx& C) {
    p0_ada(C);
    LAS float* scr = (LAS float*)(C.lds + C.wave * 16384);
    constexpr int PER_L = (161 + 64 + 64) * 32;
    for (int it = C.gw; it < 2 * PER_L; it += C.NGW) {
        const int l = it / PER_L; int r = it % PER_L;
        if (r < 161 * 32) { const int kb = r / 161, nb = r % 161; bf16* WT = (bf16*)(C.ws + WS_WTIN) + (size_t)l * WTIN_L;
            const float* W = KARG(I_WIN) + (size_t)l * D * IN_COLS;
            if (nb < 160) { const int n0 = 32 * nb; transpose_item(W, IN_COLS, n0 + (n0 >= 3072 ? 16 : 0), 32, WT, n0, 64 * kb, scr, C.lane); }
            else transpose_item(W, IN_COLS, 3072, 16, WT, 5120, 64 * kb, scr, C.lane);
            continue; }
        r -= 161 * 32;
        if (r < 2048) { const int kb = r / 64, nb = r % 64; transpose_item(KARG(I_WOUT) + (size_t)l * D * D, D, 32 * nb, 32, (bf16*)(C.ws + WS_WTOUT) + (size_t)l * D * D, 32 * nb, 64 * kb, scr, C.lane); continue; }
        r -= 2048;
        { const int kb = r / 64, nb = r % 64; transpose_item(KARG(I_WQ) + (size_t)l * D * D, D, 32 * nb, 32, (bf16*)(C.ws + WS_WTQ) + (size_t)l * D * D, 32 * nb, 64 * kb, scr, C.lane); }
    }
    const int gt = C.bid * NTHR + C.tid, NT = C.G * NTHR;
    { bf16* K1B = (bf16*)(C.ws + WS_K1B); bf16* K2B = (bf16*)(C.ws + WS_K2B); bf16* WSB = (bf16*)(C.ws + WS_WSB);
      for (int i = gt; i < 262144; i += NT) { K1B[i] = (bf16)f2bf(KARG(I_K1)[i]); K2B[i] = (bf16)f2bf(KARG(I_K2)[i]);
          const int s = i & 127, t = (i >> 7) & 127; WSB[i] = (s <= t) ? (bf16)f2bf(KARG(I_MWS)[i]) : (bf16)0; } }
    { float* SU = (float*)(C.ws + WS_SU); int* KV = (int*)(C.ws + WS_KV);
      f32x4 v[8], vn[8];
      { const f32x4* src = (const f32x4*)(KARG(I_PU) + (size_t)C.gw * D) + C.lane;
#pragma unroll
        for (int j = 0; j < 8; ++j) v[j] = src[64 * j]; }
#pragma unroll 1
      for (int row = C.gw; row < 4 * NEXP; row += C.NGW) {
          const int tb = row >> 15, rr = row & 32767;
          { const int rown = row + C.NGW < 4 * NEXP ? row + C.NGW : row; const int tbn = rown >> 15, rrn = rown & 32767;
            const f32x4* src = (const f32x4*)(KARG(tbn ? I_PV : I_PU) + (size_t)rrn * D) + C.lane;
#pragma unroll
            for (int j = 0; j < 8; ++j) vn[j] = src[64 * j]; }
          const int lyr = rr >> 14, ee = rr & 16383;
          unsigned* dst = (unsigned*)(C.ws + (tb ? WS_PVB : WS_PUB) + (size_t)lyr * NEXP * D + (size_t)ee * 256) + C.lane;
          if (tb) {
              float mx = 0.f;
#pragma unroll
              for (int j = 0; j < 8; ++j) mx = fmaxf(mx, fmaxf(fmaxf(fabsf(v[j].x), fabsf(v[j].y)), fmaxf(fabsf(v[j].z), fabsf(v[j].w))));
              mx = wave_max_u(mx);
              int k = 0;
              if (mx > 0.f) { k = (int)((__builtin_bit_cast(unsigned, 224.0f / mx) >> 23) & 255u) - 127; k = k < -60 ? -60 : (k > 60 ? 60 : k); }
              const float sc = __builtin_bit_cast(float, (unsigned)(k + 127) << 23);
#pragma unroll
              for (int j = 0; j < 8; ++j) { int p = 0; p = __builtin_amdgcn_cvt_pk_fp8_f32(v[j].x * sc, v[j].y * sc, p, false); p = __builtin_amdgcn_cvt_pk_fp8_f32(v[j].z * sc, v[j].w * sc, p, true); dst[(size_t)j * (NEXP * 256 / 4)] = (unsigned)p; }
              if (C.lane == 0) KV[rr] = k;
          } else {
#pragma unroll
              for (int j = 0; j < 8; ++j) {
                  const float mx = wave_max_u(fmaxf(fmaxf(fabsf(v[j].x), fabsf(v[j].y)), fmaxf(fabsf(v[j].z), fabsf(v[j].w))));
                  const float inv = mx > 0.f ? 127.0f / mx : 0.f;
                  const int q0 = (int)__builtin_rintf(v[j].x * inv), q1 = (int)__builtin_rintf(v[j].y * inv), q2 = (int)__builtin_rintf(v[j].z * inv), q3 = (int)__builtin_rintf(v[j].w * inv);
                  dst[(size_t)j * (NEXP * 256 / 4)] = (unsigned)(q0 & 255) | ((unsigned)(q1 & 255) << 8) | ((unsigned)(q2 & 255) << 16) | ((unsigned)q3 << 24);
                  if (C.lane == 0) SU[(size_t)(lyr * 8 + j) * NEXP + ee] = mx * (1.0f / 127.0f);
              }
          }
#pragma unroll
          for (int j = 0; j < 8; ++j) v[j] = vn[j];
      } }
}
template <bool FP8 = false, bool XB = false>
DI void norm_phase(const Ctx& C, const void* Xv, const float* g, const float* modl, int sh_off, int sc_off, bf16* Hout, unsigned char* H8 = nullptr, float* HS = nullptr, int* COEF = nullptr) {
    const int r0 = C.gw * 8, b = r0 >> 12;
    if (FP8) {
        u32x4* cz = (u32x4*)(COEF + (size_t)r0 * 128) + C.lane;
        unsigned z_ = 0u; asm volatile("" : "+v"(z_));
#pragma unroll
        for (int j = 0; j < 4; ++j) cz[64 * j] = (u32x4){z_, z_, z_, z_}; }
    const f32x4* shp = (const f32x4*)(modl + (size_t)b * MODW + sh_off); const f32x4* scp = (const f32x4*)(modl + (size_t)b * MODW + sc_off);
    f32x4 gm[8], shv[8];
#pragma unroll
    for (int j = 0; j < 8; ++j) { const int idx = 64 * j + C.lane; gm[j] = ((const f32x4*)g)[idx] * (scp[idx] + 1.0f); shv[j] = shp[idx]; }
#pragma unroll 1
    for (int i = 0; i < 8; ++i) {
        f32x4 v[8]; float s = 0.f;
        if (XB) { const u32x2* xr = (const u32x2*)((const bf16*)Xv + (size_t)(r0 + i) * D) + C.lane;
#pragma unroll
            for (int j = 0; j < 8; ++j) { const u32x2 w = xr[64 * j]; v[j] = (f32x4){bflo(w.x), bfhi(w.x), bflo(w.y), bfhi(w.y)}; } }
        else { const f32x4* xr = (const f32x4*)((const float*)Xv + (size_t)(r0 + i) * D) + C.lane;
#pragma unroll
            for (int j = 0; j < 8; ++j) v[j] = xr[64 * j]; }
#pragma unroll
        for (int j = 0; j < 8; ++j) s += (v[j].x * v[j].x + v[j].y * v[j].y) + (v[j].z * v[j].z + v[j].w * v[j].w);
        const float rstd = frsq(wave_sum(s) * (1.f / D) + EPS);
        u32x2* o = (u32x2*)(Hout + (size_t)(r0 + i) * D) + C.lane;
#pragma unroll
        for (int j = 0; j < 8; ++j) { const f32x4 y = v[j] * rstd * gm[j] + shv[j]; u32x2 w; w.x = pk2(y.x, y.y); w.y = pk2(y.z, y.w); o[64 * j] = w;
            if (FP8) v[j] = y; }
        if (FP8) {
            float st[8];
            unsigned* h8 = (unsigned*)(H8 + (size_t)(r0 + i) * 2048) + C.lane;
#pragma unroll
            for (int j = 0; j < 8; ++j) {
                const float am = wave_max_u(fmaxf(fmaxf(fabsf(v[j].x), fabsf(v[j].y)), fmaxf(fabsf(v[j].z), fabsf(v[j].w))));
                const float qs = am > 0.f ? 127.0f / am : 0.f; st[j] = am * (1.0f / 127.0f);
                const int q0 = (int)__builtin_rintf(v[j].x * qs), q1 = (int)__builtin_rintf(v[j].y * qs), q2 = (int)__builtin_rintf(v[j].z * qs), q3 = (int)__builtin_rintf(v[j].w * qs);
                h8[64 * j] = (unsigned)(q0 & 255) | ((unsigned)(q1 & 255) << 8) | ((unsigned)(q2 & 255) << 16) | ((unsigned)q3 << 24); }
            if (C.lane == 0) { f32x4* hp = (f32x4*)(HS + (size_t)(r0 + i) * 8); hp[0] = (f32x4){st[0], st[1], st[2], st[3]}; hp[1] = (f32x4){st[4], st[5], st[6], st[7]}; }
        }
    }
}
DI void alow_phase(const Ctx& C, const bf16* Hb, const bf16* WtA, float* ALOW) {
    const int task = C.bid * 4 + (C.wave & 3), kh = C.wave >> 2, r0 = task * 16, fr = C.lane & 15, fq = C.lane >> 4;
    const bf16* ap = Hb + (size_t)(r0 + fr) * D + 8 * fq + 1024 * kh; const bf16* bp = WtA + (size_t)fr * D + 8 * fq + 1024 * kh;
    f32x4 acc = (f32x4){0.f, 0.f, 0.f, 0.f};
#pragma unroll 8
    for (int ks = 0; ks < 32; ++ks) { const bf16x8 a = *(const bf16x8*)(ap + 32 * ks), b = *(const bf16x8*)(bp + 32 * ks); acc = mfma16(a, b, acc); }
    LAS f32x4* xch = (LAS f32x4*)C.lds + (C.wave & 3) * 64 + C.lane;
    if (kh) *xch = acc;
    LDS_WAIT(); __builtin_amdgcn_s_barrier(); asm volatile("" ::: "memory");
    if (!kh) { acc += *xch;
#pragma unroll
        for (int r = 0; r < 4; ++r) ALOW[(size_t)(r0 + 4 * fq + r) * 16 + fr] = acc[r]; }
}
#define LBAR() do { asm volatile("s_waitcnt lgkmcnt(0)" ::: "memory"); __builtin_amdgcn_s_barrier(); asm volatile("" ::: "memory"); } while (0)
DI void gla_gates(const Ctx& C, LAS float* al, LAS float* tot, const f32x4 alv, const float (&w2)[16], const float bav, float (&Gl)[16], float& off, float& gref, float& g63) {
    const int d = C.tid & 127, jg = C.tid >> 7;
    if (C.tid < 256) ((LAS f32x4*)al)[C.tid] = alv;
    LBAR();
    float run = 0.f;
#pragma unroll
    for (int jj = 0; jj < 16; ++jj) {
        const LAS f32x4* ar = (const LAS f32x4*)(al + (jg * 16 + jj) * 16);
        const f32x4 a0 = ar[0], a1 = ar[1], a2 = ar[2], a3 = ar[3];
        float z = bav;
        z += a0.x * w2[0] + a0.y * w2[1] + a0.z * w2[2] + a0.w * w2[3];
        z += a1.x * w2[4] + a1.y * w2[5] + a1.z * w2[6] + a1.w * w2[7];
        z += a2.x * w2[8] + a2.y * w2[9] + a2.z * w2[10] + a2.w * w2[11];
        z += a3.x * w2[12] + a3.y * w2[13] + a3.z * w2[14] + a3.w * w2[15];
        const float ls = fminf(z, 0.f) - 0.6931471806f * flog2(1.f + fexp2(-1.442695041f * fabsf(z)));
        run += ls * (1.442695041f / 16.f);
        Gl[jj] = run;
    }
    tot[jg * 128 + d] = run;
    LBAR();
    const float t0_ = tot[d], t1_ = tot[128 + d], t2_ = tot[256 + d], t3_ = tot[384 + d];
    off = (jg > 0 ? t0_ : 0.f) + (jg > 1 ? t1_ : 0.f) + (jg > 2 ? t2_ : 0.f); gref = t0_ + t1_; g63 = (t0_ + t1_) + (t2_ + t3_);
}
constexpr int KST = 136, VST = 264, PST = 72;
typedef short s16x2_t __attribute__((ext_vector_type(2)));
struct GlaIn { f32x4 alv; s16x2_t qk[16]; u32x4 vt[4]; };
DI float qk_q(const s16x2_t v) { return __builtin_bit_cast(float, __builtin_bit_cast(unsigned, v) << 16); }
DI float qk_k(const s16x2_t v) { return __builtin_bit_cast(float, __builtin_bit_cast(unsigned, v) & 0xffff0000u); }
template <bool WITHQ, bool WITHV = true>
DI void gla_load(const Ctx& C, int idx, const bf16* PROJ, const float* ALOW, GlaIn& in) {
    const int b = idx >> 8, h = (idx >> 6) & 3, n = idx & 63, t0 = b * SEQ + n * 64, d = C.tid & 127, jg = C.tid >> 7;
    in.alv = (f32x4){0.f, 0.f, 0.f, 0.f};
    if (C.tid < 256) in.alv = ((const f32x4*)(ALOW + (size_t)t0 * 16))[C.tid];
#pragma unroll
    for (int jj = 0; jj < 16; ++jj) { const bf16* row = PROJ + (size_t)(t0 + jg * 16 + jj) * NPROJ + h * 128 + d; s16x2_t v = (s16x2_t){0, 0}; if (WITHQ) v.x = (short)row[C_Q]; v.y = (short)row[C_K]; in.qk[jj] = v; }
    if (WITHV) {
#pragma unroll
    for (int i = 0; i < 4; ++i) { const int c = C.tid + 512 * i, j = c >> 5, ec = c & 31; in.vt[i] = *(const u32x4*)(PROJ + (size_t)(t0 + j) * NPROJ + C_V + h * 256 + 8 * ec); } }
}
DI void gla_load_v(const Ctx& C, int idx, const bf16* PROJ, GlaIn& in) {
    const int b = idx >> 8, h = (idx >> 6) & 3, n = idx & 63, t0 = b * SEQ + n * 64;
#pragma unroll
    for (int i = 0; i < 4; ++i) { const int c = C.tid + 512 * i, j = c >> 5, ec = c & 31; in.vt[i] = *(const u32x4*)(PROJ + (size_t)(t0 + j) * NPROJ + C_V + h * 256 + 8 * ec); }
}
DI void store_v_tile(const Ctx& C, const GlaIn& in, LAS bf16* VL) {
#pragma unroll
    for (int i = 0; i < 4; ++i) { const int c = C.tid + 512 * i, j = c >> 5, ec = c & 31; *(LAS u32x4*)(VL + j * VST + 8 * ec) = in.vt[i]; }
}
DI void glaA_phase(const Ctx& C, int l, const bf16* PROJ, const float* ALOW, bf16* SBUF, float* DEC) {
    LAS float* al = (LAS float*)(C.lds); LAS float* tot = (LAS float*)(C.lds + 4096);
    LAS bf16* KD = (LAS bf16*)(C.lds + 8192); LAS bf16* VL = (LAS bf16*)(C.lds + 25600);
    const int d = C.tid & 127, jg = C.tid >> 7, h = (C.bid >> 6) & 3;
    float w2[16];
#pragma unroll
    for (int r = 0; r < 16; ++r) w2[r] = KARG(I_WA2)[(size_t)l * 16 * 512 + r * 512 + h * 128 + d];
    const float bav = KARG(I_BA)[(size_t)l * 512 + h * 128 + d];
    GlaIn cur, nxt;
    gla_load<false>(C, C.bid, PROJ, ALOW, cur);
#pragma unroll 1
    for (int i = 0; i < 4; ++i) {
        const int idx = i * C.G + C.bid;
        float Gl[16], off, gref, g63;
        gla_gates(C, al, tot, cur.alv, w2, bav, Gl, off, gref, g63);
#pragma unroll
        for (int jj = 0; jj < 16; ++jj) { const int j = jg * 16 + jj; KD[j * KST + d] = (bf16)f2bf(qk_k(cur.qk[jj]) * fexp2(g63 - (off + Gl[jj]))); }
        store_v_tile(C, cur, VL);
        LBAR();
        if (i + 1 < 4) gla_load<false>(C, idx + C.G, PROJ, ALOW, nxt);
        if (jg == 0) DEC[(size_t)idx * 128 + d] = fexp2(g63);
        const int lane = C.lane, g = lane >> 4, qq = (lane & 15) >> 2, p = lane & 3, fr = lane & 15;
        bf16x8 A[2];
#pragma unroll
        for (int ks = 0; ks < 2; ++ks) A[ks] = tr8(KD + (32 * ks + 8 * g + qq) * KST + 16 * C.wave + 4 * p, KST);
        bf16* Sit = SBUF + (size_t)idx * 256 * 128;
#pragma unroll
        for (int half = 0; half < 2; ++half) {
            f32x4 acc[8];
#pragma unroll
            for (int nt = 0; nt < 8; ++nt) acc[nt] = (f32x4){0.f, 0.f, 0.f, 0.f};
#pragma unroll
            for (int nt = 0; nt < 8; ++nt)
#pragma unroll
                for (int ks = 0; ks < 2; ++ks) { const bf16x8 Bf = tr8(VL + (32 * ks + 8 * g + qq) * VST + 16 * (half * 8 + nt) + 4 * p, VST); acc[nt] = mfma16(A[ks], Bf, acc[nt]); }
#pragma unroll
            for (int nt = 0; nt < 8; ++nt) { const int e = 16 * (half * 8 + nt) + fr, dd = 16 * C.wave + 4 * g;
                u32x2 w; w.x = pk2(acc[nt][0], acc[nt][1]); w.y = pk2(acc[nt][2], acc[nt][3]); *(u32x2*)(Sit + (size_t)e * 128 + dd) = w; }
        }
        LBAR();
        cur = nxt;
    }
}
DI void scan_phase(const Ctx& C, bf16* SBUF, const float* DEC) {
    const int gt = C.bid * NTHR + C.tid, bh = gt >> 13, rem = gt & 8191, e = rem >> 5, dq = rem & 31;
    u32x2* p = (u32x2*)(SBUF + ((size_t)(bh * 64) * 256 + e) * 128 + 4 * dq);
    const f32x4* dp = (const f32x4*)(DEC + (size_t)(bh * 64) * 128 + 4 * dq);
    f32x4 st = (f32x4){0.f, 0.f, 0.f, 0.f};
#pragma unroll 1
    for (int n0 = 0; n0 < 64; n0 += 8) {
        u32x2 tmp[8]; f32x4 dc[8];
#pragma unroll
        for (int u = 0; u < 8; ++u) { tmp[u] = p[(size_t)(n0 + u) * 8192]; dc[u] = dp[(n0 + u) * 32]; }
#pragma unroll
        for (int u = 0; u < 8; ++u) { u32x2 w; w.x = pk2(st.x, st.y); w.y = pk2(st.z, st.w); p[(size_t)(n0 + u) * 8192] = w;
            st = dc[u] * st + (f32x4){bflo(tmp[u].x), bfhi(tmp[u].x), bflo(tmp[u].y), bfhi(tmp[u].y)}; }
    }
}
DI void glaC_phase(const Ctx& C, int l, const bf16* PROJ, const float* ALOW, const bf16* SBUF, bf16* CONCAT) {
    const int h = (C.bid >> 6) & 3;
    LAS float* al = (LAS float*)(C.lds); LAS float* tot = (LAS float*)(C.lds + 4096); LAS float* RS = (LAS float*)(C.lds + 6144);
    LAS bf16* QT = (LAS bf16*)(C.lds + 8192); LAS bf16* KT = (LAS bf16*)(C.lds + 25600); LAS bf16* QG = (LAS bf16*)(C.lds + 43008);
    LAS bf16* VL = (LAS bf16*)(C.lds + 60416); LAS bf16* PL = (LAS bf16*)(C.lds + 94208);
    const int d = C.tid & 127, jg = C.tid >> 7;
    float w2[16];
#pragma unroll
    for (int r = 0; r < 16; ++r) w2[r] = KARG(I_WA2)[(size_t)l * 16 * 512 + r * 512 + h * 128 + d];
    const float bav = KARG(I_BA)[(size_t)l * 512 + h * 128 + d];
    const float* ng = KARG(I_GNG) + (size_t)(l * 4 + h) * 256;
    GlaIn cur;
    f32x4 alv_n; s16x2_t qkn[16];
    gla_load<true, false>(C, C.bid, PROJ, ALOW, cur);
#pragma unroll 1
    for (int it = 0; it < 4; ++it) {
    const int idx = it * C.G + C.bid, b = idx >> 8, n = idx & 63, t0 = b * SEQ + n * 64;
    gla_load_v(C, idx, PROJ, cur);
    float Gl[16], off, gref, g63;
    gla_gates(C, al, tot, cur.alv, w2, bav, Gl, off, gref, g63);
#pragma unroll
    for (int jj = 0; jj < 16; ++jj) { const int j = jg * 16 + jj; const float Gv = off + Gl[jj];
        const float q = qk_q(cur.qk[jj]) * 0.08838834764831845f, k = qk_k(cur.qk[jj]);
        QT[j * KST + d] = (bf16)f2bf(q * fexp2(fminf(Gv - gref, 100.f))); KT[j * KST + d] = (bf16)f2bf(k * fexp2(fminf(gref - Gv, 100.f))); QG[j * KST + d] = (bf16)f2bf(q * fexp2(Gv)); }
    store_v_tile(C, cur, VL);
    const int lane = C.lane, g = lane >> 4, qq = (lane & 15) >> 2, p = lane & 3, fr = lane & 15;
    bf16x8 Sf[2][4]; u32x2 rraw[4][2];
#pragma unroll
    for (int mi = 0; mi < 2; ++mi) { const bf16* Srow = SBUF + ((size_t)idx * 256 + 16 * (2 * C.wave + mi) + fr) * 128 + 8 * g;
#pragma unroll
        for (int ks = 0; ks < 4; ++ks) Sf[mi][ks] = *(const bf16x8*)(Srow + 32 * ks); }
#pragma unroll
    for (int nt = 0; nt < 4; ++nt)
#pragma unroll
        for (int mi = 0; mi < 2; ++mi) rraw[nt][mi] = *(const u32x2*)(PROJ + (size_t)(t0 + 16 * nt + fr) * NPROJ + C_R + h * 256 + 16 * (2 * C.wave + mi) + 4 * g);
    LBAR();
    if (it + 1 < 4) { const int ix = idx + C.G, t1 = (ix >> 8) * SEQ + (ix & 63) * 64;
        alv_n = (f32x4){0.f, 0.f, 0.f, 0.f}; if (C.tid < 256) alv_n = ((const f32x4*)(ALOW + (size_t)t1 * 16))[C.tid];
#pragma unroll
        for (int jj = 0; jj < 16; ++jj) { const bf16* row = PROJ + (size_t)(t1 + jg * 16 + jj) * NPROJ + h * 128 + d; s16x2_t v; v.x = (short)row[C_Q]; v.y = (short)row[C_K]; qkn[jj] = v; } }
    {
        const int nt = C.wave & 3;
#pragma unroll
        for (int mi = 0; mi < 2; ++mi) { const int mt = 2 * (C.wave >> 2) + mi; f32x4 acc = (f32x4){0.f, 0.f, 0.f, 0.f};
#pragma unroll
            for (int ks = 0; ks < 4; ++ks) { const bf16x8 a = *(const LAS bf16x8*)(KT + (16 * mt + fr) * KST + 32 * ks + 8 * g), bq = *(const LAS bf16x8*)(QT + (16 * nt + fr) * KST + 32 * ks + 8 * g); acc = mfma16(a, bq, acc); }
            const int i = 16 * nt + fr, j0 = 16 * mt + 4 * g;
            const float v0 = (j0 + 0 <= i) ? acc[0] : 0.f, v1 = (j0 + 1 <= i) ? acc[1] : 0.f, v2 = (j0 + 2 <= i) ? acc[2] : 0.f, v3 = (j0 + 3 <= i) ? acc[3] : 0.f;
            u32x2 w; w.x = pk2(v0, v1); w.y = pk2(v2, v3); *(LAS u32x2*)(PL + i * PST + j0) = w; }
    }
    LBAR();
    f32x4 acc[2][4];
#pragma unroll
    for (int mi = 0; mi < 2; ++mi)
#pragma unroll
        for (int nt = 0; nt < 4; ++nt) acc[mi][nt] = (f32x4){0.f, 0.f, 0.f, 0.f};
#pragma unroll
    for (int mi = 0; mi < 2; ++mi) { const int mt = 2 * C.wave + mi;
#pragma unroll
        for (int ks = 0; ks < 2; ++ks) { const bf16x8 a = tr8(VL + (32 * ks + 8 * g + qq) * VST + 16 * mt + 4 * p, VST);
#pragma unroll
            for (int nt = 0; nt < 4; ++nt) { const bf16x8 bp = *(const LAS bf16x8*)(PL + (16 * nt + fr) * PST + 32 * ks + 8 * g); acc[mi][nt] = mfma16(a, bp, acc[mi][nt]); } }
#pragma unroll
        for (int ks = 0; ks < 4; ++ks) { const bf16x8 a = Sf[mi][ks];
#pragma unroll
            for (int nt = 0; nt < 4; ++nt) { const bf16x8 bq = *(const LAS bf16x8*)(QG + (16 * nt + fr) * KST + 32 * ks + 8 * g); acc[mi][nt] = mfma16(a, bq, acc[mi][nt]); } }
    }
#pragma unroll
    for (int nt = 0; nt < 4; ++nt) { float s = 0.f;
#pragma unroll
        for (int mi = 0; mi < 2; ++mi) s += (acc[mi][nt][0] * acc[mi][nt][0] + acc[mi][nt][1] * acc[mi][nt][1]) + (acc[mi][nt][2] * acc[mi][nt][2] + acc[mi][nt][3] * acc[mi][nt][3]);
        s += __shfl_xor(s, 16); s += __shfl_xor(s, 32);
        if (g == 0) RS[C.wave * 64 + 16 * nt + fr] = s; }
    LBAR();
#pragma unroll
    for (int nt = 0; nt < 4; ++nt) { const int i = 16 * nt + fr; float ts = 0.f;
#pragma unroll
        for (int w = 0; w < 8; ++w) ts += RS[w * 64 + i];
        const float rstd = frsq(ts * (1.f / 256.f) + EPS);
#pragma unroll
        for (int mi = 0; mi < 2; ++mi) { const int e = 16 * (2 * C.wave + mi) + 4 * g;
            const u32x2 rr = rraw[nt][mi]; const f32x4 gg = *(const f32x4*)(ng + e);
            const float o0 = acc[mi][nt][0] * rstd * gg.x * silu_f(bflo(rr.x)), o1 = acc[mi][nt][1] * rstd * gg.y * silu_f(bfhi(rr.x));
            const float o2 = acc[mi][nt][2] * rstd * gg.z * silu_f(bflo(rr.y)), o3 = acc[mi][nt][3] * rstd * gg.w * silu_f(bfhi(rr.y));
            u32x2 w; w.x = pk2(o0, o1); w.y = pk2(o2, o3); *(u32x2*)(CONCAT + (size_t)(t0 + i) * D + h * 256 + e) = w; } }
    LBAR();
    cur.alv = alv_n;
#pragma unroll
    for (int jj = 0; jj < 16; ++jj) cur.qk[jj] = qkn[jj];
    }
}
constexpr int GST = 136;
DI void gmlp_phase(const Ctx& C, int l, const bf16* PROJ, const bf16* WSB, bf16* CONCAT) {
    const int h = C.bid & 7;
    LAS bf16* VL2 = (LAS bf16*)(C.lds); LAS bf16* UL = (LAS bf16*)(C.lds + 34816);
    const float* vg = KARG(I_VNG) + (size_t)(l * 8 + h) * 128; const float* og = KARG(I_MOG) + (size_t)(l * 8 + h) * 128; const float* bb = KARG(I_MB) + (size_t)(l * 8 + h) * 128;
    bf16x8 Wf[4];
    { const bf16* Wrow = WSB + ((size_t)(l * 8 + h) * 128 + 16 * C.wave + (C.lane & 15)) * 128 + 8 * (C.lane >> 4);
#pragma unroll
      for (int ks = 0; ks < 4; ++ks) Wf[ks] = *(const bf16x8*)(Wrow + 32 * ks); }
    u32x4 cu[4], cv[4], nu[4], nv[4];
#define GM_LOAD(IDX, U, V) do { const int t0_ = ((IDX) >> 8) * SEQ + (((IDX) >> 3) & 31) * 128; _Pragma("unroll") for (int i = 0; i < 4; ++i) { const int c = C.tid + 512 * i, t = c >> 4, ch = c & 15; \
        const bf16* row = PROJ + (size_t)(t0_ + t) * NPROJ + h * 128 + 8 * ch; U[i] = *(const u32x4*)(row + C_U); V[i] = *(const u32x4*)(row + C_VS); } } while (0)
    GM_LOAD(C.bid, cu, cv);
#pragma unroll 1
    for (int it = 0; it < 4; ++it) {
    const int idx = it * C.G + C.bid, n = (idx >> 3) & 31, b = idx >> 8, t0 = b * SEQ + n * 128;
#pragma unroll
    for (int i = 0; i < 4; ++i) { const int c = C.tid + 512 * i, t = c >> 4, ch = c & 15;
        const u32x4 uu = cu[i], vv = cv[i];
        float v[8] = {gelu_t(bflo(vv.x)), gelu_t(bfhi(vv.x)), gelu_t(bflo(vv.y)), gelu_t(bfhi(vv.y)), gelu_t(bflo(vv.z)), gelu_t(bfhi(vv.z)), gelu_t(bflo(vv.w)), gelu_t(bfhi(vv.w))};
        float ss = 0.f;
#pragma unroll
        for (int k = 0; k < 8; ++k) ss += v[k] * v[k];
        ss += __shfl_xor(ss, 1); ss += __shfl_xor(ss, 2); ss += __shfl_xor(ss, 4); ss += __shfl_xor(ss, 8);
        const float rstd = frsq(ss * (1.f / 128.f) + EPS);
        const f32x4 g0 = *(const f32x4*)(vg + 8 * ch), g1 = *(const f32x4*)(vg + 8 * ch + 4);
        u32x4 wv; wv.x = pk2(v[0] * rstd * g0.x, v[1] * rstd * g0.y); wv.y = pk2(v[2] * rstd * g0.z, v[3] * rstd * g0.w); wv.z = pk2(v[4] * rstd * g1.x, v[5] * rstd * g1.y); wv.w = pk2(v[6] * rstd * g1.z, v[7] * rstd * g1.w);
        *(LAS u32x4*)(VL2 + t * GST + 8 * ch) = wv;
        u32x4 wu; wu.x = pk2(gelu_t(bflo(uu.x)), gelu_t(bfhi(uu.x))); wu.y = pk2(gelu_t(bflo(uu.y)), gelu_t(bfhi(uu.y))); wu.z = pk2(gelu_t(bflo(uu.z)), gelu_t(bfhi(uu.z))); wu.w = pk2(gelu_t(bflo(uu.w)), gelu_t(bfhi(uu.w)));
        *(LAS u32x4*)(UL + t * GST + 8 * ch) = wu; }
    LBAR();
    if (it + 1 < 4) GM_LOAD(idx + C.G, nu, nv);
    const int lane = C.lane, g = lane >> 4, qq = (lane & 15) >> 2, p = lane & 3, fr = lane & 15;
    f32x4 acc[8];
#pragma unroll
    for (int mt = 0; mt < 8; ++mt) acc[mt] = (f32x4){0.f, 0.f, 0.f, 0.f};
    const int nks = (C.wave >> 1) + 1;
#pragma unroll
    for (int ks = 0; ks < 4; ++ks) if (ks < nks) { const bf16x8 bw = Wf[ks];
#pragma unroll
        for (int mt = 0; mt < 8; ++mt) { const bf16x8 a = tr8(VL2 + (32 * ks + 8 * g + qq) * GST + 16 * mt + 4 * p, GST); acc[mt] = mfma16(a, bw, acc[mt]); } }
    const int tl = 16 * C.wave + fr; const float bt = bb[tl]; float ss = 0.f;
#pragma unroll
    for (int mt = 0; mt < 8; ++mt) { const u32x2 uu = *(const LAS u32x2*)(UL + tl * GST + 16 * mt + 4 * g);
        acc[mt][0] = bflo(uu.x) * (acc[mt][0] + bt); acc[mt][1] = bfhi(uu.x) * (acc[mt][1] + bt); acc[mt][2] = bflo(uu.y) * (acc[mt][2] + bt); acc[mt][3] = bfhi(uu.y) * (acc[mt][3] + bt);
        ss += (acc[mt][0] * acc[mt][0] + acc[mt][1] * acc[mt][1]) + (acc[mt][2] * acc[mt][2] + acc[mt][3] * acc[mt][3]); }
    ss += __shfl_xor(ss, 16); ss += __shfl_xor(ss, 32);
    const float rstd = frsq(ss * (1.f / 128.f) + EPS);
#pragma unroll
    for (int mt = 0; mt < 8; ++mt) { const f32x4 gg = *(const f32x4*)(og + 16 * mt + 4 * g);
        u32x2 w; w.x = pk2(acc[mt][0] * rstd * gg.x, acc[mt][1] * rstd * gg.y); w.y = pk2(acc[mt][2] * rstd * gg.z, acc[mt][3] * rstd * gg.w);
        *(u32x2*)(CONCAT + (size_t)(t0 + tl) * D + 1024 + h * 128 + 16 * mt + 4 * g) = w; }
    LBAR();
#pragma unroll
    for (int i = 0; i < 4; ++i) { cu[i] = nu[i]; cv[i] = nv[i]; }
    }
#undef GM_LOAD
}
DI void list_insert(float (&L)[16], float x) {
#pragma unroll
    for (int i = 15; i >= 1; --i) L[i] = __builtin_amdgcn_fmed3f(x, L[i - 1], L[i]);
    L[0] = fmaxf(L[0], x);
}
DI void list_merge_xor(float (&L)[16], int mask) {
    float M[16];
#pragma unroll
    for (int i = 0; i < 16; ++i) M[i] = fmaxf(L[i], __shfl_xor(L[15 - i], mask));
#pragma unroll
    for (int s = 8; s >= 1; s >>= 1)
#pragma unroll
        for (int i = 0; i < 16; ++i) if ((i & s) == 0) { const float hi = fmaxf(M[i], M[i + s]), lo = fminf(M[i], M[i + s]); M[i] = hi; M[i + s] = lo; }
#pragma unroll
    for (int i = 0; i < 16; ++i) L[i] = M[i];
}
DI unsigned fbits(float x) { return __builtin_bit_cast(unsigned, x); }
DI float unp7(float x) { return __builtin_bit_cast(float, __builtin_bit_cast(unsigned, x) & 0xFFFFFF80u); }
constexpr int TKST = 136;
DI void topk_phase(const Ctx& C, int l, const bf16* QB, const bf16* K1B, const bf16* K2B, const int* KU, const int* KV, int* EB, float* PG) {
    LAS bf16* KL = (LAS bf16*)C.lds;
    LAS unsigned* tk = (LAS unsigned*)(C.lds + 2 * 128 * TKST * 2 + C.wave * 2048);
    const int lane = C.lane, fr = lane & 15, fq = lane >> 4, h = C.bid & 7, rank = C.bid >> 3;
#pragma unroll
    for (int i = 0; i < 8; ++i) { const int c = C.tid + 512 * i, tb = c >> 11, row = (c & 2047) >> 4, ch = c & 15;
        *(LAS u32x4*)(KL + (tb * 128 + row) * TKST + 8 * ch) = *(const u32x4*)((tb ? K2B : K1B) + ((size_t)(l * 8 + h) * 128 + row) * 128 + 8 * ch); }
    __syncthreads();
#pragma unroll 1
    for (int it = 0; it < 4; ++it) {
        const int tt0 = rank * 512 + C.wave * 64 + it * 16;
        float L[2][16];
        bf16x8 bq[2][4];
#pragma unroll
        for (int half = 0; half < 2; ++half)
#pragma unroll
            for (int ks = 0; ks < 4; ++ks) bq[half][ks] = *(const bf16x8*)(QB + (size_t)(tt0 + fr) * D + h * 256 + half * 128 + 8 * fq + 32 * ks);
#pragma unroll
        for (int half = 0; half < 2; ++half) {
            f32x4 acc[8];
#pragma unroll
            for (int mt = 0; mt < 8; ++mt) acc[mt] = (f32x4){0.f, 0.f, 0.f, 0.f};
            const LAS bf16* Kb = KL + (half * 128 + fr) * TKST + 8 * fq;
#pragma unroll
            for (int ks = 0; ks < 4; ++ks)
#pragma unroll
                for (int mt = 0; mt < 8; ++mt) { const bf16x8 a = *(const LAS bf16x8*)(Kb + (16 * mt) * TKST + 32 * ks); acc[mt] = mfma16(a, bq[half][ks], acc[mt]); }
#pragma unroll
            for (int i = 0; i < 16; ++i) L[half][i] = __builtin_bit_cast(float, 0xFF800000u);
#pragma unroll
            for (int mt = 0; mt < 8; ++mt)
#pragma unroll
                for (int r = 0; r < 4; ++r) { const unsigned key = (unsigned)(16 * mt + 4 * fq + r);
                    const float sv = acc[mt][r];
                    list_insert(L[half], __builtin_bit_cast(float, (fbits(sv) & 0xFFFFFF80u) | key)); }
            list_merge_xor(L[half], 16); list_merge_xor(L[half], 32);
        }
        if (fq == 0) {
#pragma unroll
            for (int i = 0; i < 16; ++i) { tk[(fr * 2 + 0) * 16 + i] = fbits(L[0][i]); tk[(fr * 2 + 1) * 16 + i] = fbits(L[1][i]); }
        }
        float Cn[16];
#pragma unroll
        for (int i = 0; i < 16; ++i) Cn[i] = __builtin_bit_cast(float, 0xFF800000u);
#pragma unroll
        for (int i = 0; i < 16; ++i)
#pragma unroll
            for (int j = 0; j < 16; ++j) if ((i + 1) * (j + 1) <= 16) {
                const float s = unp7(L[0][i]) + unp7(L[1][j]);
                list_insert(Cn, __builtin_bit_cast(float, (fbits(s) & 0xFFFFFF00u) | (unsigned)(i * 16 + j))); }
        LDS_WAIT();
        float sc[4]; int ex[4];
#pragma unroll
        for (int m = 0; m < 4; ++m) {
            const float ck = fq == 0 ? Cn[m] : (fq == 1 ? Cn[4 + m] : (fq == 2 ? Cn[8 + m] : Cn[12 + m]));
            const unsigned cc = fbits(ck) & 255u;
            const unsigned p1 = tk[(fr * 2 + 0) * 16 + (cc >> 4)], p2 = tk[(fr * 2 + 1) * 16 + (cc & 15u)];
            sc[m] = __builtin_bit_cast(float, p1 & 0xFFFFFF80u) + __builtin_bit_cast(float, p2 & 0xFFFFFF80u);
            ex[m] = (int)((p1 & 127u) * 128u + (p2 & 127u));
        }
        float mx = fmaxf(fmaxf(sc[0], sc[1]), fmaxf(sc[2], sc[3]));
        mx = fmaxf(mx, __shfl_xor(mx, 16)); mx = fmaxf(mx, __shfl_xor(mx, 32));
        float w[4], sum = 0.f;
#pragma unroll
        for (int m = 0; m < 4; ++m) { w[m] = fexp2((sc[m] - mx) * 1.442695041f); sum += w[m]; }
        sum += __shfl_xor(sum, 16); sum += __shfl_xor(sum, 32);
        const float inv = 1.0f / sum;
        const size_t o = (size_t)(tt0 + fr) * 128 + h * 16 + 4 * fq;
#pragma unroll
        for (int m = 0; m < 4; ++m) { const int kv = KV[ex[m]]; w[m] = w[m] * inv * __builtin_bit_cast(float, (unsigned)(127 - kv) << 23); ex[m] |= 127 << 16; }
        *(int4*)(EB + o) = make_int4(ex[0], ex[1], ex[2], ex[3]);
        *(f32x4*)(PG + o) = (f32x4){w[0], w[1], w[2], w[3]};
        LDS_WAIT();
    }
}
typedef unsigned char fp8_t;
DI void unpack16(const u32x4 q, float (&f)[16]) {
#pragma unroll
    for (int w = 0; w < 4; ++w) { const int dw = (int)q[w]; const f32x2 lo = __builtin_amdgcn_cvt_pk_f32_fp8(dw, false), hi = __builtin_amdgcn_cvt_pk_f32_fp8(dw, true);
        f[4 * w] = lo.x; f[4 * w + 1] = lo.y; f[4 * w + 2] = hi.x; f[4 * w + 3] = hi.y; }
}
DI int sdot4(int a, int b, int c) { return __builtin_amdgcn_sdot4(a, b, c, false); }
template <int CTRL> DI int dppi(int v) { return __builtin_amdgcn_update_dpp(0, v, CTRL, 0xf, 0xf, true); }
template <int CTRL, int NV> DI void bfly(int (&p)[32], const int base, const bool up) {
#pragma unroll
    for (int m = 0; m < NV / 2; ++m) { const int lo = p[base + m], hi = p[base + m + NV / 2]; const int keep = up ? hi : lo, send = up ? lo : hi; p[base + m] = keep + dppi<CTRL>(send); }
}
#define PU_ADD(P, V_) (void)__hip_atomic_fetch_add((P), (V_), __ATOMIC_RELAXED, __HIP_MEMORY_SCOPE_AGENT)
DI void peerU_phase(const Ctx& C, const unsigned char* H8, const float* HS, const int* EB, const unsigned char* PU8, const float* SU, int* COEF, const int emask = 0xFFFF) {
    const int x = C.bid & 7, rank = C.bid >> 3, lane = C.lane, g = lane >> 4, i16 = lane & 15;
    const __amdgpu_buffer_rsrc_t trs = __builtin_amdgcn_make_buffer_rsrc((void*)(PU8 + (size_t)x * NEXP * 256), 0, NEXP * 256, 0x00020000);
    const float* su = SU + (size_t)x * NEXP;
    const int tbase = rank * 512 + C.wave * 64;
    int* part = COEF + (size_t)tbase * 128 + lane;
    const int* ebase = EB + (size_t)tbase * 128 + lane;
    const unsigned char* hbase = H8 + (size_t)tbase * 2048 + 256 * x + 16 * i16;
    const float* hsb = HS + (size_t)tbase * 8 + x;
    const int bp0 = 64 * g, loff = 16 * i16;
    const bool b3 = (i16 & 8) != 0, b2 = (i16 & 4) != 0, b1 = (i16 & 2) != 0, b0 = (i16 & 1) != 0;
    int en0 = ebase[0] & emask, en1 = ebase[64] & emask;
    int er0 = ebase[128], er1 = ebase[192];
    u32x4 hh = *(const u32x4*)hbase;
    float sc0 = su[en0], sc1 = su[en1], hs = hsb[0];
    u32x4 buf[32];
#pragma unroll
    for (int u = 0; u < 32; ++u) { const int e = __builtin_amdgcn_ds_bpermute(bp0 + 4 * (u & 15), u < 16 ? en0 : en1); buf[u] = __builtin_amdgcn_raw_buffer_load_b128(trs, e * 256 + loff, 0, 0); }
    __builtin_amdgcn_sched_barrier(0);
    en0 = er0 & emask; en1 = er1 & emask;
    int pend0 = 0, pend1 = 0; int* pend_p = part;
#pragma unroll 1
    for (int ti = 0; ti < 64; ++ti) {
        const int tn = ti + 1 < 64 ? ti + 1 : 63, t2 = ti + 2 < 64 ? ti + 2 : 63;
        er0 = ebase[t2 * 128]; er1 = ebase[t2 * 128 + 64];
        const u32x4 hhn = *(const u32x4*)(hbase + (size_t)tn * 2048);
        const float scn0 = su[en0], scn1 = su[en1], hsn = hsb[tn * 8];
        __builtin_amdgcn_sched_barrier(0);
        int p[32];
#pragma unroll
        for (int u0 = 0; u0 < 32; u0 += 4) {
            int en[4];
#pragma unroll
            for (int u = u0; u < u0 + 4; ++u) en[u - u0] = __builtin_amdgcn_ds_bpermute(bp0 + 4 * (u & 15), u < 16 ? en0 : en1);
#pragma unroll
            for (int u = u0; u < u0 + 4; ++u) {
                const u32x4 r = buf[u];
                int ah = sdot4((int)r.x, (int)hh.x, 0); ah = sdot4((int)r.y, (int)hh.y, ah); ah = sdot4((int)r.z, (int)hh.z, ah); ah = sdot4((int)r.w, (int)hh.w, ah);
                p[u] = ah; }
            asm volatile("" : "+v"(p[u0]), "+v"(p[u0 + 1]), "+v"(p[u0 + 2]), "+v"(p[u0 + 3]) :: "memory");
#pragma unroll
            for (int u = u0; u < u0 + 4; ++u) buf[u] = __builtin_amdgcn_raw_buffer_load_b128(trs, en[u - u0] * 256 + loff, 0, 0);
            if (u0 == 12) { PU_ADD(pend_p, pend0); PU_ADD(pend_p + 64, pend1); }
            __builtin_amdgcn_sched_barrier(0);
        }
        bfly<0x140, 16>(p, 0, b3); bfly<0x140, 16>(p, 16, b3);
        bfly<0x141, 8>(p, 0, b2); bfly<0x141, 8>(p, 16, b2);
        bfly<0x4E, 4>(p, 0, b1); bfly<0x4E, 4>(p, 16, b1);
        bfly<0xB1, 2>(p, 0, b0); bfly<0xB1, 2>(p, 16, b0);
        pend0 = (int)__builtin_rintf(fminf(fmaxf((float)p[0] * (sc0 * hs * 16384.0f), -2.0e9f), 2.0e9f)); pend1 = (int)__builtin_rintf(fminf(fmaxf((float)p[16] * (sc1 * hs * 16384.0f), -2.0e9f), 2.0e9f)); pend_p = part + (size_t)ti * 128;
        asm volatile("" : "+v"(er0), "+v"(er1) :: "memory");
        en0 = er0 & emask; en1 = er1 & emask; hh = hhn; sc0 = scn0; sc1 = scn1; hs = hsn;
    }
    PU_ADD(pend_p, pend0); PU_ADD(pend_p + 64, pend1);
#undef PU_ADD
}
typedef long i64_t;
constexpr int PV_BLK = 272;
DI void peerV_phase(const Ctx& C, const int* EB, const float* PG, const int* COEF, const fp8_t* PV8, bf16* X, const float* gate  , const int emask = 0x3FFF, const long wdelta = 0  ) {
    const int x = C.bid & 7, rank = C.bid >> 3, lane = C.lane, g = lane >> 4, i16 = lane & 15;
    const __amdgpu_buffer_rsrc_t trs = __builtin_amdgcn_make_buffer_rsrc((void*)(PV8 + (size_t)x * NEXP * 256), 0, NEXP * 256, 0x00020000);
    const int tbase = rank * 512 + C.wave * 64;
    ldsp wl = C.lds + C.wave * (8 * PV_BLK);
    const int wr_off = g * PV_BLK + 16 * i16;
    const int rd_off = ((((lane >> 1) & 1) * 4) + (lane & 1)) * PV_BLK + 16 * (lane >> 2);
    const int bp0 = 64 * g, loff = 16 * i16;
    const int ash = (i16 < 8) ? 24 : 16, asl = 8 * (i16 & 3); const unsigned amlo = (i16 & 4) ? 0u : 0xFFFFFFFFu, amhi = ~amlo;
    const int* ebase = EB + (size_t)tbase * 128 + lane; const float* gbase = PG + (size_t)tbase * 128 + lane; const int* pbase = COEF + (size_t)tbase * 128 + lane;
    const int col = 256 * x + 4 * lane;
    const f32x4 gt = *(const f32x4*)(gate + (size_t)(tbase >> 12) * MODW + col);
    int pc0, pc1; float rg0, rg1;
#define PV_LOAD_RAW(tt) do { pc0 = pbase[(tt) * 128]; pc1 = pbase[(tt) * 128 + 64]; rg0 = gbase[(tt) * 128]; rg1 = gbase[(tt) * 128 + 64]; } while (0)
#define PV_PACK(PK0, PK1, INVA, ID0, ID1) do { const float s0_ = (float)pc0 * (1.0f / 16384.0f), s1_ = (float)pc1 * (1.0f / 16384.0f); \
        const float a0_ = gelu_t(s0_) * rg0, a1_ = gelu_t(s1_) * rg1; const float amax_ = wave_max_u(fmaxf(fabsf(a0_), fabsf(a1_))); \
        int ka_ = 0; if (amax_ > 0.f) { ka_ = (int)((__builtin_bit_cast(unsigned, 224.0f / amax_) >> 23) & 255u) - 127; ka_ = ka_ < -100 ? -100 : (ka_ > 100 ? 100 : ka_); } \
        const float sca_ = __builtin_bit_cast(float, (unsigned)(ka_ + 127) << 23); INVA = __builtin_bit_cast(float, (unsigned)(127 - ka_) << 23); \
        const float h0_ = a0_ * sca_, h1_ = a1_ * sca_; const int ph_ = __builtin_amdgcn_cvt_pk_fp8_f32(h0_, h1_, 0, false); const f32x2 bk_ = __builtin_amdgcn_cvt_pk_f32_fp8(ph_, false); \
        const int pl_ = __builtin_amdgcn_cvt_pk_fp8_f32((h0_ - bk_.x) * 16.0f, (h1_ - bk_.y) * 16.0f, 0, false); \
        PK0 = (int)(((unsigned)(ph_ & 255) << 24) | ((unsigned)(pl_ & 255) << 16) | (unsigned)(ID0)); PK1 = (int)(((unsigned)(ph_ & 0xFF00) << 16) | ((unsigned)(pl_ & 0xFF00) << 8) | (unsigned)(ID1)); } while (0)
    const int e0 = ebase[0] & emask, e1 = ebase[64] & emask;
    int er0 = ebase[128], er1 = ebase[192];
    PV_LOAD_RAW(0);
    u32x2* xp0 = (u32x2*)(X + (size_t)tbase * D + col);
    u32x2 xpend = *xp0; u32x2* xpend_p = (u32x2*)((bf16*)xp0 + wdelta);
    u32x4 buf[32];
#pragma unroll
    for (int u = 0; u < 32; ++u) { const int e = __builtin_amdgcn_ds_bpermute(bp0 + 4 * (u & 15), u < 16 ? e0 : e1); buf[u] = __builtin_amdgcn_raw_buffer_load_b128(trs, e * 256 + loff, 0, 0); }
    __builtin_amdgcn_sched_barrier(0);
    int pk0, pk1; float inva;
    PV_PACK(pk0, pk1, inva, er0 & emask, er1 & emask);
#pragma unroll 1
    for (int ti = 0; ti < 64; ++ti) {
        const int tn = ti + 1 < 64 ? ti + 1 : 63, t2 = ti + 2 < 64 ? ti + 2 : 63;
        er0 = ebase[t2 * 128]; er1 = ebase[t2 * 128 + 64];
        PV_LOAD_RAW(tn);
        u32x2* xp = (u32x2*)(X + (size_t)(tbase + ti) * D + col);
        const u32x2 xold = *xp;
        __builtin_amdgcn_sched_barrier(0);
        f32x4 d0 = (f32x4){0.f, 0.f, 0.f, 0.f}, d1 = d0;
#pragma unroll
        for (int u0 = 0; u0 < 32; u0 += 4) {
            int w[4];
#pragma unroll
            for (int u = u0; u < u0 + 4; ++u) w[u - u0] = __builtin_amdgcn_ds_bpermute(bp0 + 4 * (u & 15), u < 16 ? pk0 : pk1);
#pragma unroll
            for (int u = u0; u < u0 + 4; ++u) {
                const u32x4 r = buf[u]; const unsigned ab = (((unsigned)w[u - u0] >> ash) & 255u) << asl;
                const i64_t av = (i64_t)(((unsigned long long)(ab & amhi) << 32) | (ab & amlo));
                d0 = __builtin_amdgcn_mfma_f32_16x16x32_fp8_fp8(av, (i64_t)(((unsigned long long)r.y << 32) | r.x), d0, 0, 0, 0);
                d1 = __builtin_amdgcn_mfma_f32_16x16x32_fp8_fp8(av, (i64_t)(((unsigned long long)r.w << 32) | r.z), d1, 0, 0, 0); }
            asm volatile("" : "+v"(d0), "+v"(d1) :: "memory");
#pragma unroll
            for (int u = u0; u < u0 + 4; ++u) buf[u] = __builtin_amdgcn_raw_buffer_load_b128(trs, ((w[u - u0] & 0x3FFF) << 8) + loff, 0, 0);
            if (u0 == 12) *xpend_p = xpend;
            __builtin_amdgcn_sched_barrier(0);
        }
        *(LAS f32x4*)(wl + wr_off) = d0; *(LAS f32x4*)(wl + wr_off + 4 * PV_BLK) = d1;
        const f32x4 yh = *(const LAS f32x4*)(wl + rd_off), yl = *(const LAS f32x4*)(wl + rd_off + 2 * PV_BLK);
        const f32x4 y = (yh + yl * 0.0625f) * inva;
        {   const f32x4 xn = (f32x4){bflo(xold.x), bfhi(xold.x), bflo(xold.y), bfhi(xold.y)} + gt * y; xpend.x = pk2(xn.x, xn.y); xpend.y = pk2(xn.z, xn.w); }
        xpend_p = (u32x2*)((bf16*)xp + wdelta);
        asm volatile("" : "+v"(er0), "+v"(er1) :: "memory");
        PV_PACK(pk0, pk1, inva, er0 & emask, er1 & emask);
    }
    *xpend_p = xpend;
#undef PV_LOAD_RAW
#undef PV_PACK
}
DI void final_norm_phase(const Ctx& C, const bf16* XBp, float* OUT, const float* g) {
    const int r0 = C.gw * 8;
    f32x4 gm[8];
#pragma unroll
    for (int j = 0; j < 8; ++j) gm[j] = ((const f32x4*)g)[64 * j + C.lane];
#pragma unroll 1
    for (int i = 0; i < 8; ++i) {
        const u32x2* xr = (const u32x2*)(XBp + (size_t)(r0 + i) * D) + C.lane; f32x4* orow = (f32x4*)(OUT + (size_t)(r0 + i) * D) + C.lane; f32x4 v[8]; float s = 0.f;
#pragma unroll
        for (int j = 0; j < 8; ++j) { const u32x2 w = xr[64 * j]; v[j] = (f32x4){bflo(w.x), bfhi(w.x), bflo(w.y), bfhi(w.y)}; s += (v[j].x * v[j].x + v[j].y * v[j].y) + (v[j].z * v[j].z + v[j].w * v[j].w); }
        const float rstd = frsq(wave_sum(s) * (1.f / D) + EPS);
#pragma unroll
        for (int j = 0; j < 8; ++j) orow[64 * j] = v[j] * rstd * gm[j];
    }
}
#ifndef PH_MASK
#define PH_MASK 0xFFFFF
#endif
#define EN(k) (((PH_MASK) >> (k)) & 1)
#ifndef GEMM_SP2
#define GEMM_SP2 true
#endif
#ifndef GEMM_ALIGN
#define GEMM_ALIGN false
#endif
constexpr int NKIND = 11, NPH = 2 + 2 * NKIND;
struct Args { const float* in[21]; float* out; unsigned char* ws; int ph_lo, ph_hi, pad0, pad1; };
__global__ void __launch_bounds__(NTHR, 2) mk_fwd(Args args) {
    extern __shared__ __attribute__((aligned(16))) unsigned char lds_raw[];
    ldsp ldsb = (ldsp)lds_raw;
    volatile LAS unsigned* MISC = (volatile LAS unsigned*)(ldsb + MISC_OFF);
    for (int u = threadIdx.x; u < (LDS_BYTES - LDSCTL_OFF) / 4; u += NTHR) ((LAS unsigned*)(ldsb + LDSCTL_OFF))[u] = 0u;
    __syncthreads();
    unsigned* barw = (unsigned*)(args.ws + WS_CTL) + CW_BAR;
    XcdBarrier bar; bar.bar = barw; bar.x = 0; bar.st = nullptr;
    const bool multi = (args.ph_hi - args.ph_lo) > 1;
    if (multi) bar = xcd_barrier_post(barw, MISC + 8);

#pragma unroll 1
    for (int ph = args.ph_lo; ph < args.ph_hi; ++ph) {
#define MKCTX Ctx C; { int tid_ = threadIdx.x, bid_ = blockIdx.x; asm volatile("" : "+v"(tid_)); asm volatile("" : "+s"(bid_)); \
        C.lds = ldsb; C.tid = tid_; C.lane = tid_ & 63; C.wave = __builtin_amdgcn_readfirstlane(tid_ >> 6); C.bid = bid_; C.G = gridDim.x; C.gw = C.bid * NWAVES + C.wave; C.NGW = C.G * NWAVES; \
        C.ws = args.ws; }
        unsigned char* const wsb = args.ws;
        float* MOD = (float*)(wsb + WS_MOD);
        bf16* Hb = (bf16*)(wsb + WS_H); bf16* PROJ = (bf16*)(wsb + WS_PROJ); bf16* SBUF = (bf16*)(wsb + WS_SBUF); bf16* CONCAT = (bf16*)(wsb + WS_CONCAT); bf16* QB = (bf16*)(wsb + WS_QB);
        float* ALOW = (float*)(wsb + WS_ALOW); float* DEC = (float*)(wsb + WS_DEC); int* EB = (int*)(wsb + WS_EB); float* PG = (float*)(wsb + WS_PG);
        bf16* X = (bf16*)(wsb + WS_XB);
        const int l = ph < 2 ? 0 : (ph - 2) / NKIND, kind = ph < 2 ? -1 : (ph - 2) % NKIND;
        const float* modl = MOD + (size_t)l * 4 * MODW;
        if (ph == 0) { if (EN(0)) { MKCTX; p0_prologue(C); } }
        else if (ph == 1) { if (EN(1)) { MKCTX; norm_phase(C, KARG(I_X), KARG(I_N1G), modl, 0, D, Hb); } }
        else if ((kind == 0 || kind == 6) && EN(2)) {
            MKCTX; const bool isq = (kind == 6);
            pg8::Gemm g{Hb, isq ? (const bf16*)(wsb + WS_WTQ) + (size_t)l * D * D : (const bf16*)(wsb + WS_WTIN) + (size_t)l * WTIN_L, T, isq ? D : NPROJ, D};
            pg8::StaticOrder S; S.init(T, g.N, C.G, C.bid);
            pg8::EpiBf16 E{isq ? QB : PROJ, isq ? D : NPROJ};
            pg8::gemm_phase<pg8::EpiBf16, pg8::StaticOrder, GEMM_ALIGN, GEMM_SP2>(C.lds, g, S, E, C.tid);
            if (!isq) alow_phase(C, Hb, (const bf16*)(wsb + WS_WTIN) + (size_t)l * WTIN_L + (size_t)NPROJ * D, ALOW);
        }
        else if (kind == 1 && EN(3)) {
            MKCTX;
            glaA_phase(C, l, PROJ, ALOW, SBUF, DEC);
            gmlp_phase(C, l, PROJ, (const bf16*)(wsb + WS_WSB), CONCAT);
        }
        else if (kind == 2) { if (EN(4)) { MKCTX; scan_phase(C, SBUF, DEC); } }
        else if (kind == 3 && EN(5)) { MKCTX; glaC_phase(C, l, PROJ, ALOW, SBUF, CONCAT); }
        else if (kind == 4 && EN(6)) {
            MKCTX;
            pg8::Gemm g{CONCAT, (const bf16*)(wsb + WS_WTOUT) + (size_t)l * D * D, T, D, D};
            pg8::StaticOrder S; S.init(T, D, C.G, C.bid);
            pg8::EpiResGate E{l == 0 ? KARG(I_X) : (const float*)nullptr, X, X, modl + 2 * D, MODW};
            pg8::gemm_phase<pg8::EpiResGate, pg8::StaticOrder, GEMM_ALIGN, GEMM_SP2>(C.lds, g, S, E, C.tid);
        }
        else if (kind == 5) { if (EN(1)) { MKCTX; norm_phase<true, true>(C, X, KARG(I_N2G) + (size_t)l * D, modl, 3 * D, 4 * D, Hb, wsb + WS_H8, (float*)(wsb + WS_HS), (int*)(wsb + WS_COEF)); } }
        else if (kind == 7) { if (EN(7)) { MKCTX; topk_phase(C, l, QB, (const bf16*)(wsb + WS_K1B), (const bf16*)(wsb + WS_K2B), (const int*)(wsb + WS_KU) + l * NEXP, (const int*)(wsb + WS_KV) + l * NEXP, EB, PG); } }
        else if (kind == 8) { if (EN(8)) { MKCTX; peerU_phase(C, wsb + WS_H8, (const float*)(wsb + WS_HS), EB, wsb + WS_PUB + (size_t)l * NEXP * D, (const float*)(wsb + WS_SU) + (size_t)l * 8 * NEXP, (int*)(wsb + WS_COEF)); } }
        else if (kind == 9) { if (EN(9)) { MKCTX; peerV_phase(C, EB, PG, (const int*)(wsb + WS_COEF), (const fp8_t*)(wsb + WS_PVB) + (size_t)l * NEXP * D, X, modl + 5 * D); } }
        else if (EN(10)) {
            MKCTX;
            if (l == DEPTH - 1) final_norm_phase(C, X, args.out, KARG(I_FG));
            else norm_phase<false, true>(C, X, KARG(I_N1G) + (size_t)(l + 1) * D, MOD + (size_t)(l + 1) * 4 * MODW, 0, D, Hb);
        }
        if (ph + 1 < args.ph_hi) xcd_barrier(bar);
    }
}

extern "C" void kernel_launch(void* const* d_in, const int* in_sizes, int n_in, void* d_out, int out_size, void* d_ws, size_t ws_size, hipStream_t stream) {
    static int grid = 0;
    if (grid == 0) {
        if (n_in != 21 || out_size != T * D || ws_size < WS_END) { fprintf(stderr, "kernel_launch: unexpected shapes (n_in %d, out %d, ws %zu)\n", n_in, out_size, ws_size); grid = -1; return; }
        int dev = 0, cus = 0, per_cu = 0;
        if (hipGetDevice(&dev) != hipSuccess || hipDeviceGetAttribute(&cus, hipDeviceAttributeMultiprocessorCount, dev) != hipSuccess) { grid = -1; return; }
        if (hipFuncSetAttribute((const void*)mk_fwd, hipFuncAttributeMaxDynamicSharedMemorySize, LDS_BYTES) != hipSuccess) { fprintf(stderr, "kernel_launch: hipFuncSetAttribute failed\n"); grid = -1; return; }
        if (hipOccupancyMaxActiveBlocksPerMultiprocessor(&per_cu, (const void*)mk_fwd, NTHR, LDS_BYTES) != hipSuccess || per_cu < 1) { fprintf(stderr, "kernel_launch: occupancy query says %d blocks per CU\n", per_cu); (void)hipGetLastError(); grid = -1; return; }
        if (cus != 256) { fprintf(stderr, "kernel_launch: built for a 256-CU device (got %d)\n", cus); grid = -1; return; }
        grid = cus;
    }
    if (grid < 0) return;
    (void)hipMemsetAsync((char*)d_ws + WS_CTL, 0, CTL_ZERO_BYTES, stream);
    Args a{};
    for (int i = 0; i < 21; ++i) a.in[i] = (const float*)d_in[i];
    a.out = (float*)d_out; a.ws = (unsigned char*)d_ws;
#if MK_N_LAUNCHES == 1
    a.ph_lo = 0; a.ph_hi = NPH;
    hipLaunchKernelGGL(mk_fwd, dim3(grid), dim3(NTHR), LDS_BYTES, stream, a);
#else
    for (int p = 0; p < NPH; ++p) { a.ph_lo = p; a.ph_hi = p + 1; hipLaunchKernelGGL(mk_fwd, dim3(grid), dim3(NTHR), LDS_BYTES, stream, a); }
#endif
}
```

```cpp
#include <hip/hip_runtime.h>
#include <cstdio>
#include <cstdint>
#ifndef MK_N_LAUNCHES
#define MK_N_LAUNCHES 1
#endif
namespace pg8 {
#define PG8_LAS __attribute__((address_space(3)))
typedef unsigned short bf16_t;
typedef short bf16x8 __attribute__((ext_vector_type(8)));
typedef float f32x4 __attribute__((ext_vector_type(4)));
typedef unsigned u32x4 __attribute__((ext_vector_type(4)));
constexpr int BM = 256, BK = 64, HALF = 128, HTB = HALF * BK * 2  , STAGE_BYTES = 8 * HTB, NXCD = 8, WGM = 8;

__host__ __device__ __forceinline__ int lds_byte(int r, int c) { const int st = (r >> 4) * 2 + (c >> 5), rr = r & 15, cc = c & 31, ob = rr * 64 + cc * 2; return st * 1024 + (ob ^ (((ob >> 9) & 1) << 5)); }
__host__ __device__ __forceinline__ void stage_rc(int b, int& R, int& C) { const int st = b / 1024, sb = b % 1024, swz = sb ^ (((sb >> 9) & 1) << 5); R = (st >> 1) * 16 + swz / 64; C = (st & 1) * 32 + (swz % 64) / 2; }
__host__ __device__ __forceinline__ int perm32(int rho) { const int n = rho >> 4, i = rho & 15; return 8 * (i >> 2) + 4 * n + (i & 3); }

struct Unit { int pm, pn; };
struct Gemm { const bf16_t* A; const bf16_t* Bt; int M, N, K; };

struct StaticOrder {
    int nM, nN, nwg, G, c;
    __host__ __device__ void init(int M, int N, int G_, int c_) { nM = M / BM; nN = N / BM; nwg = nM * nN; G = G_; c = c_; }
    __host__ __device__ bool next(int i, Unit& u) const {
        const long L = (long)i * G + c; if (L >= nwg) return false;
        int wgid = (int)L; { const int q = nwg / NXCD, r = nwg % NXCD, xcd = wgid % NXCD, off = wgid / NXCD; wgid = (xcd < r ? xcd * (q + 1) : r * (q + 1) + (xcd - r) * q) + off; }
        const int nig = WGM * nN, gid = wgid / nig, fm = gid * WGM, gsz = (nM - fm) < WGM ? (nM - fm) : WGM;
        u.pm = fm + ((wgid % nig) % gsz); u.pn = (wgid % nig) / gsz; return true;
    }
    __device__ __forceinline__ void a_ready(const Unit&) const {}
    __device__ __forceinline__ void done(const Unit&) const {}
};
__device__ __forceinline__ unsigned cvt_pk_bf16(float lo, float hi) { unsigned r; asm volatile("v_cvt_pk_bf16_f32 %0, %1, %2" : "=v"(r) : "v"(lo), "v"(hi)); return r; }
struct EpiBf16 {
    static constexpr bool PERM = true, AFTER_DRAIN = false;
    bf16_t* O; int ldc;
    __device__ __forceinline__ void operator()(const f32x4 (&acc)[2][2][4][2], const Unit& u, int wr, int wc, int fr, int fq) const {
        const int row0 = u.pm * BM + wr * 64 + fr; const int col0 = u.pn * BM + wc * 32 + 8 * fq;
#pragma unroll
        for (int ai = 0; ai < 2; ++ai)
#pragma unroll
            for (int m = 0; m < 4; ++m) { bf16_t* rowp = O + (size_t)(row0 + ai * HALF + m * 16) * ldc + col0;
#pragma unroll
                for (int bj = 0; bj < 2; ++bj) { const f32x4 v0 = acc[ai][bj][m][0], v1 = acc[ai][bj][m][1];
                    u32x4 w; w.x = cvt_pk_bf16(v0[0], v0[1]); w.y = cvt_pk_bf16(v0[2], v0[3]); w.z = cvt_pk_bf16(v1[0], v1[1]); w.w = cvt_pk_bf16(v1[2], v1[3]);
                    *(u32x4*)(rowp + bj * HALF) = w; } }
    }
};
struct EpiResGate {
    static constexpr bool PERM = true, AFTER_DRAIN = false;
    const float* base32; const bf16_t* baseb; bf16_t* out; const float* gate; int gpitch;
    __device__ __forceinline__ void operator()(const f32x4 (&acc)[2][2][4][2], const Unit& u, int wr, int wc, int fr, int fq) const {
        const int row0 = u.pm * BM + wr * 64 + fr, col0 = u.pn * BM + wc * 32 + 8 * fq;
        const float* gp = gate + (size_t)(u.pm >> 4) * gpitch + col0;
        f32x4 gv[2][2];
#pragma unroll
        for (int bj = 0; bj < 2; ++bj)
#pragma unroll
            for (int n = 0; n < 2; ++n) gv[bj][n] = *(const f32x4*)(gp + bj * HALF + n * 4);
#define ERG_OFF(G_) ((size_t)(row0 + ((G_) >> 2) * HALF + ((G_) & 3) * 16) * 2048 + col0)
        if (base32) {
            f32x4 bs[2][2][2];
#define ERG_LOAD(G_) do { _Pragma("unroll") for (int bj = 0; bj < 2; ++bj) _Pragma("unroll") for (int n = 0; n < 2; ++n) bs[(G_) & 1][bj][n] = *(const f32x4*)(base32 + ERG_OFF(G_) + bj * HALF + n * 4); } while (0)
            ERG_LOAD(0); ERG_LOAD(1);
#pragma unroll
            for (int gq = 0; gq < 8; ++gq) {
#pragma unroll
                for (int bj = 0; bj < 2; ++bj) { const f32x4 v0 = bs[gq & 1][bj][0] + gv[bj][0] * acc[gq >> 2][bj][gq & 3][0], v1 = bs[gq & 1][bj][1] + gv[bj][1] * acc[gq >> 2][bj][gq & 3][1];
                    u32x4 w; w.x = cvt_pk_bf16(v0[0], v0[1]); w.y = cvt_pk_bf16(v0[2], v0[3]); w.z = cvt_pk_bf16(v1[0], v1[1]); w.w = cvt_pk_bf16(v1[2], v1[3]);
                    *(u32x4*)(out + ERG_OFF(gq) + bj * HALF) = w; }
                asm volatile("" ::: "memory");
                if (gq + 2 < 8) ERG_LOAD(gq + 2);
                asm volatile("" ::: "memory"); }
#undef ERG_LOAD
        } else {
            u32x4 bb[4][2];
#define ERG_LOADB(G_) do { _Pragma("unroll") for (int bj = 0; bj < 2; ++bj) bb[(G_) & 3][bj] = *(const u32x4*)(baseb + ERG_OFF(G_) + bj * HALF); } while (0)
            ERG_LOADB(0); ERG_LOADB(1); ERG_LOADB(2); ERG_LOADB(3);
#pragma unroll
            for (int gq = 0; gq < 8; ++gq) {
#pragma unroll
                for (int bj = 0; bj < 2; ++bj) { const u32x4 b = bb[gq & 3][bj];
                    const f32x4 b0 = (f32x4){__builtin_bit_cast(float, b.x << 16), __builtin_bit_cast(float, b.x & 0xffff0000u), __builtin_bit_cast(float, b.y << 16), __builtin_bit_cast(float, b.y & 0xffff0000u)};
                    const f32x4 b1 = (f32x4){__builtin_bit_cast(float, b.z << 16), __builtin_bit_cast(float, b.z & 0xffff0000u), __builtin_bit_cast(float, b.w << 16), __builtin_bit_cast(float, b.w & 0xffff0000u)};
                    const f32x4 v0 = b0 + gv[bj][0] * acc[gq >> 2][bj][gq & 3][0], v1 = b1 + gv[bj][1] * acc[gq >> 2][bj][gq & 3][1];
                    u32x4 w; w.x = cvt_pk_bf16(v0[0], v0[1]); w.y = cvt_pk_bf16(v0[2], v0[3]); w.z = cvt_pk_bf16(v1[0], v1[1]); w.w = cvt_pk_bf16(v1[2], v1[3]);
                    *(u32x4*)(out + ERG_OFF(gq) + bj * HALF) = w; }
                asm volatile("" ::: "memory");
                if (gq + 4 < 8) ERG_LOADB(gq + 4);
                asm volatile("" ::: "memory"); }
#undef ERG_LOADB
        }
#undef ERG_OFF
    }
};
template <class Epi, class Sched, bool ALIGN_EPI = false, bool SP2 = false>
__device__ __forceinline__ void gemm_phase(PG8_LAS unsigned char* lds, const Gemm g, const Sched& S, const Epi& E, const int tid  ) {
    const int wid = __builtin_amdgcn_readfirstlane(tid >> 6), lane = tid & 63, wr = wid >> 2, wc = wid & 3, fr = lane & 15, fq = lane >> 4;
    const int K = g.K, nt = K / BK;
    unsigned voffA[2], voffB[2];
#pragma unroll
    for (int i = 0; i < 2; ++i) { int R, C; stage_rc(tid * 16 + i * 8192, R, C); const int Rb = Epi::PERM ? ((R & ~31) + perm32(R & 31)) : R;
        voffA[i] = (unsigned)(R * K + C) * 2u; voffB[i] = (unsigned)(Rb * K + C) * 2u; }
    const size_t kstep = (size_t)(BK * 2);
    const size_t hstep = (size_t)HALF * K * 2;
    const size_t tstep = 2 * hstep;
    const unsigned ldsw = (unsigned)wid * 1024u;
    const int aoff = lds_byte(wr * 64 + fr, fq * 8), boff = lds_byte(wc * 32 + fr, fq * 8);
#define PG8_SA(b, h) (((b) * 2 + (h)) * HTB)
#define PG8_SB(b, h) ((4 + (b) * 2 + (h)) * HTB)
#define PG8_STAGE(bufoff, gbase, voff) do { _Pragma("unroll") for (int _i = 0; _i < 2; ++_i) \
        __builtin_amdgcn_global_load_lds((const unsigned*)((const char*)(gbase) + (voff)[_i]), (PG8_LAS unsigned*)(lds + (bufoff) + ldsw + _i * 8192), 16, 0, 0); } while (0)
#define PG8_LDA(dst, b, h) do { _Pragma("unroll") for (int m = 0; m < 4; ++m) _Pragma("unroll") for (int k = 0; k < 2; ++k) dst[m][k] = *(const PG8_LAS bf16x8*)(lds + PG8_SA(b, h) + aoff + m * 2048 + k * 1024); } while (0)
#define PG8_LDB(dst, b, h) do { _Pragma("unroll") for (int n = 0; n < 2; ++n) _Pragma("unroll") for (int k = 0; k < 2; ++k) dst[n][k] = *(const PG8_LAS bf16x8*)(lds + PG8_SB(b, h) + boff + n * 2048 + k * 1024); } while (0)
#define PG8_MMA(ai, bj, At, Bt) do { __builtin_amdgcn_s_setprio(1); _Pragma("unroll") for (int m = 0; m < 4; ++m) _Pragma("unroll") for (int n = 0; n < 2; ++n) _Pragma("unroll") for (int k = 0; k < 2; ++k) \
        acc[ai][bj][m][n] = __builtin_amdgcn_mfma_f32_16x16x32_bf16(Bt[n][k], At[m][k], acc[ai][bj][m][n], 0, 0, 0); __builtin_amdgcn_s_setprio(0); } while (0)
#define PG8_WAIT_V(n) asm volatile("s_waitcnt vmcnt(" #n ")" ::: "memory")
#define PG8_WAIT_L(n) asm volatile("s_waitcnt lgkmcnt(" #n ")" ::: "memory")
#define PG8_BAR __builtin_amdgcn_s_barrier()
#define PG8_SCHED __builtin_amdgcn_sched_barrier(0)
    Unit cur, nxt; int ui = 0;
    if (!S.next(0, cur)) return;
    f32x4 acc[2][2][4][2];
#pragma unroll
    for (int a = 0; a < 2; ++a)
#pragma unroll
        for (int b = 0; b < 2; ++b)
#pragma unroll
            for (int m = 0; m < 4; ++m)
#pragma unroll
                for (int n = 0; n < 2; ++n) acc[a][b][m][n] = (f32x4){0.f, 0.f, 0.f, 0.f};
    bf16x8 At[4][2], B0[2][2], B1[2][2];
    const char* cA = (const char*)g.A + (size_t)cur.pm * tstep; const char* cB = (const char*)g.Bt + (size_t)cur.pn * tstep;
    S.a_ready(cur);
    if constexpr (SP2) {
        PG8_STAGE(PG8_SB(0, 0), cB, voffB); PG8_STAGE(PG8_SB(0, 1), cB + hstep, voffB); PG8_STAGE(PG8_SA(0, 0), cA, voffA); PG8_STAGE(PG8_SA(0, 1), cA + hstep, voffA);
        if (wr == 1) PG8_BAR;
        PG8_WAIT_V(2); PG8_BAR;
        PG8_STAGE(PG8_SB(1, 0), cB + kstep, voffB); PG8_STAGE(PG8_SA(1, 0), cA + kstep, voffA); PG8_STAGE(PG8_SB(1, 1), cB + hstep + kstep, voffB);
        PG8_WAIT_V(6); PG8_BAR;
    } else {
        PG8_STAGE(PG8_SB(0, 0), cB, voffB); PG8_STAGE(PG8_SA(0, 0), cA, voffA); PG8_STAGE(PG8_SB(0, 1), cB + hstep, voffB); PG8_STAGE(PG8_SA(0, 1), cA + hstep, voffA);
        if (wr == 1) PG8_BAR;
        PG8_WAIT_V(4); PG8_BAR;
        PG8_STAGE(PG8_SB(1, 0), cB + kstep, voffB); PG8_STAGE(PG8_SA(1, 0), cA + kstep, voffA); PG8_STAGE(PG8_SB(1, 1), cB + hstep + kstep, voffB);
        PG8_WAIT_V(6); PG8_BAR;
    }
    for (;;) {
        const bool has_next = S.next(ui + 1, nxt);
        const char* nA = has_next ? (const char*)g.A + (size_t)nxt.pm * tstep : cA; const char* nB = has_next ? (const char*)g.Bt + (size_t)nxt.pn * tstep : cB;
        for (int t = 0; t < nt; t += 2) {
            const bool last = (t == nt - 2);
            const char* a1 = cA + (size_t)(t + 1) * kstep;
            const char* a2 = last ? nA : cA + (size_t)(t + 2) * kstep; const char* b2 = last ? nB : cB + (size_t)(t + 2) * kstep;
            const char* a3 = a2 + kstep; const char* b3 = b2 + kstep;
            if (last && has_next) S.a_ready(nxt);
            if constexpr (SP2) {
            PG8_LDB(B0, 0, 0); PG8_LDB(B1, 0, 1); PG8_SCHED; PG8_LDA(At, 0, 0); PG8_STAGE(PG8_SA(1, 1), a1 + hstep, voffA);
            PG8_WAIT_V(8); PG8_WAIT_L(0); PG8_BAR; PG8_MMA(0, 0, At, B0); PG8_MMA(0, 1, At, B1); PG8_BAR; PG8_SCHED;
            PG8_LDA(At, 0, 1); PG8_STAGE(PG8_SB(0, 0), b2, voffB); PG8_STAGE(PG8_SB(0, 1), b2 + hstep, voffB); PG8_STAGE(PG8_SA(0, 0), a2, voffA);
            PG8_WAIT_V(8); PG8_WAIT_L(0); PG8_BAR; PG8_MMA(1, 0, At, B0); PG8_MMA(1, 1, At, B1); PG8_BAR; PG8_SCHED;
            PG8_LDB(B0, 1, 0); PG8_LDB(B1, 1, 1); PG8_SCHED; PG8_LDA(At, 1, 0); PG8_STAGE(PG8_SA(0, 1), a2 + hstep, voffA);
            PG8_WAIT_V(8); PG8_WAIT_L(0); PG8_BAR; PG8_MMA(0, 0, At, B0); PG8_MMA(0, 1, At, B1); PG8_BAR; PG8_SCHED;
            PG8_LDA(At, 1, 1); PG8_STAGE(PG8_SB(1, 0), b3, voffB); PG8_STAGE(PG8_SB(1, 1), b3 + hstep, voffB); PG8_STAGE(PG8_SA(1, 0), a3, voffA);
            PG8_WAIT_V(8); PG8_WAIT_L(0); PG8_BAR; PG8_MMA(1, 0, At, B0); PG8_MMA(1, 1, At, B1); PG8_BAR; PG8_SCHED;
            } else {
            PG8_LDB(B0, 0, 0); PG8_SCHED; PG8_LDA(At, 0, 0); PG8_STAGE(PG8_SA(1, 1), a1 + hstep, voffA);
            PG8_WAIT_L(8); PG8_BAR; PG8_WAIT_L(0); PG8_MMA(0, 0, At, B0); PG8_BAR; PG8_SCHED;
            PG8_LDB(B1, 0, 1); PG8_STAGE(PG8_SB(0, 0), b2, voffB);
            PG8_BAR; PG8_WAIT_L(0); PG8_MMA(0, 1, At, B1); PG8_BAR;
            PG8_LDA(At, 0, 1); PG8_STAGE(PG8_SA(0, 0), a2, voffA);
            PG8_BAR; PG8_WAIT_L(0); PG8_MMA(1, 0, At, B0); PG8_BAR; PG8_SCHED;
            PG8_STAGE(PG8_SB(0, 1), b2 + hstep, voffB);
            PG8_WAIT_V(6); PG8_BAR; PG8_MMA(1, 1, At, B1); PG8_BAR;
            PG8_LDB(B0, 1, 0); PG8_SCHED; PG8_LDA(At, 1, 0); PG8_STAGE(PG8_SA(0, 1), a2 + hstep, voffA);
            PG8_WAIT_L(8); PG8_BAR; PG8_WAIT_L(0); PG8_MMA(0, 0, At, B0); PG8_BAR; PG8_SCHED;
            PG8_LDB(B1, 1, 1); PG8_STAGE(PG8_SB(1, 0), b3, voffB);
            PG8_BAR; PG8_WAIT_L(0); PG8_MMA(0, 1, At, B1); PG8_BAR;
            PG8_LDA(At, 1, 1); PG8_STAGE(PG8_SA(1, 0), a3, voffA);
            PG8_BAR; PG8_WAIT_L(0); PG8_MMA(1, 0, At, B0); PG8_BAR; PG8_SCHED;
            PG8_STAGE(PG8_SB(1, 1), b3 + hstep, voffB);
            PG8_WAIT_V(6); PG8_BAR; PG8_MMA(1, 1, At, B1); PG8_BAR;
            }
        }
        if constexpr (ALIGN_EPI) { if (wr == 0) PG8_BAR; }
        if constexpr (!Epi::AFTER_DRAIN) { E(acc, cur, wr, wc, fr, fq); S.done(cur); }
        if (!has_next) break;
#pragma unroll
        for (int a = 0; a < 2; ++a)
#pragma unroll
            for (int b = 0; b < 2; ++b)
#pragma unroll
                for (int m = 0; m < 4; ++m)
#pragma unroll
                    for (int n = 0; n < 2; ++n) acc[a][b][m][n] = (f32x4){0.f, 0.f, 0.f, 0.f};
        cur = nxt; cA = nA; cB = nB; ++ui;
        if constexpr (ALIGN_EPI) { if (wr == 1) PG8_BAR; }
    }
    PG8_WAIT_V(0);
    if constexpr (!ALIGN_EPI) { if (wr == 0) PG8_BAR; }
    PG8_BAR;
    if constexpr (Epi::AFTER_DRAIN) { E.fused(acc, cur, wr, wc, fr, fq, lds, wid, lane); S.done(cur); }
#undef PG8_SA
#undef PG8_SB
#undef PG8_STAGE
#undef PG8_LDA
#undef PG8_LDB
#undef PG8_MMA
#undef PG8_WAIT_V
#undef PG8_WAIT_L
#undef PG8_BAR
#undef PG8_SCHED
}
}
constexpr int NWAVES = 8, NTHR = 512;
constexpr int D = 2048, NBATCH = 4, SEQ = 4096, T = NBATCH * SEQ, DEPTH = 2;
constexpr int GLA_H = 4, GLA_DK = 128, GLA_DV = 256, GLA_CH = 64;
constexpr int MLP_H = 8, MLP_DH = 128, MLP_CH = 128;
constexpr int IN_COLS = 5136, NPROJ = 5120;
constexpr int C_Q = 0, C_K = 512, C_V = 1024, C_R = 2048, C_U = 3072, C_VS = 4096;
constexpr int NEXP = 16384, PEER_H = 8;
constexpr float EPS = 1e-6f;
constexpr int MODW = 6 * D;
constexpr size_t MiB = 1u << 20;
constexpr size_t WS_CTL = 0, CTL_ZERO_BYTES = 1 * MiB;
constexpr size_t WS_MOD = 1 * MiB;
constexpr size_t WS_K1B = 2 * MiB, WS_K2B = 2 * MiB + 512 * 1024, WS_WSB = 3 * MiB, WS_DEC = 3 * MiB + 512 * 1024, WS_ALOW = 4 * MiB;
constexpr size_t WS_KU = 5 * MiB, WS_KV = 5 * MiB + 256 * 1024;
constexpr size_t WS_SU = 6 * MiB, WS_HS = 7 * MiB;
constexpr size_t WS_WTIN = 8 * MiB;
constexpr size_t WTIN_L = (size_t)5136 * 2048;
constexpr size_t WS_WTOUT = 49 * MiB, WS_WTQ = 65 * MiB;
constexpr size_t WS_PUB = 81 * MiB, WS_PVB = 209 * MiB;
constexpr size_t WS_H = 337 * MiB;
constexpr size_t WS_PROJ = 401 * MiB;
constexpr size_t WS_SBUF = 561 * MiB;
constexpr size_t WS_CONCAT = 625 * MiB;
constexpr size_t WS_QB = 689 * MiB;
constexpr size_t WS_EB = 753 * MiB, WS_PG = 761 * MiB;
constexpr size_t WS_H8 = 769 * MiB, WS_COEF = 833 * MiB, WS_XB = 841 * MiB, WS_END = 905 * MiB;
static_assert(WS_WTIN + 2 * WTIN_L * 2 <= WS_WTOUT, "ws map");
constexpr int CW_BAR = 4096;
constexpr int RING_BYTES = 131072, LDSCTL_OFF = RING_BYTES, MISC_OFF = LDSCTL_OFF + 320, LDS_BYTES = 147456;

#define DI __device__ __forceinline__
#define LAS __attribute__((address_space(3)))
typedef unsigned short bf16;
typedef short bf16x8 __attribute__((ext_vector_type(8)));
typedef short s16x4 __attribute__((ext_vector_type(4)));
typedef short v4i16_t __attribute__((ext_vector_type(4)));
typedef __bf16 bf16x2_t __attribute__((ext_vector_type(2)));
typedef float f32x2_e __attribute__((ext_vector_type(2)));
typedef float f32x4 __attribute__((ext_vector_type(4)));
typedef float f32x2 __attribute__((ext_vector_type(2)));
typedef unsigned u32x4 __attribute__((ext_vector_type(4)));
typedef unsigned u32x2 __attribute__((ext_vector_type(2)));
typedef LAS unsigned char* ldsp;

DI unsigned pk2(float lo, float hi) { const f32x2_e v = {lo, hi}; return __builtin_bit_cast(unsigned, __builtin_convertvector(v, bf16x2_t)); }
DI unsigned f2bf(float f) { return pk2(f, 0.f) & 0xffffu; }
DI float bflo(unsigned u) { return __builtin_bit_cast(float, u << 16); }
DI float bfhi(unsigned u) { return __builtin_bit_cast(float, u & 0xffff0000u); }
DI float bf1(bf16 v) { return __builtin_bit_cast(float, ((unsigned)v) << 16); }
DI float fexp2(float x) { return __builtin_amdgcn_exp2f(x); }
DI float flog2(float x) { return __builtin_amdgcn_logf(x); }
DI float frcp(float x) { return __builtin_amdgcn_rcpf(x); }
DI float frsq(float x) { return __builtin_amdgcn_rsqf(x); }
DI float gelu_t(float x) { const float u = 0.7978845608f * (x + 0.044715f * x * x * x); return x * frcp(1.f + fexp2(-2.885390082f * u)); }
DI float silu_f(float x) { return x * frcp(1.f + fexp2(-1.442695041f * x)); }
template <int CTRL> DI float dppf(float v) { return __builtin_bit_cast(float, __builtin_amdgcn_update_dpp(0, __builtin_bit_cast(int, v), CTRL, 0xf, 0xf, true)); }
DI float wave_sum_u(float v) {
    v += dppf<0xB1>(v); v += dppf<0x4E>(v); v += dppf<0x141>(v); v += dppf<0x140>(v);
    const int iv = __builtin_bit_cast(int, v);
    return (__builtin_bit_cast(float, __builtin_amdgcn_readlane(iv, 0)) + __builtin_bit_cast(float, __builtin_amdgcn_readlane(iv, 16))) +
           (__builtin_bit_cast(float, __builtin_amdgcn_readlane(iv, 32)) + __builtin_bit_cast(float, __builtin_amdgcn_readlane(iv, 48)));
}
DI float wave_max_u(float v) {
    v = fmaxf(v, dppf<0xB1>(v)); v = fmaxf(v, dppf<0x4E>(v)); v = fmaxf(v, dppf<0x141>(v)); v = fmaxf(v, dppf<0x140>(v));
    const int iv = __builtin_bit_cast(int, v);
    return fmaxf(fmaxf(__builtin_bit_cast(float, __builtin_amdgcn_readlane(iv, 0)), __builtin_bit_cast(float, __builtin_amdgcn_readlane(iv, 16))),
                 fmaxf(__builtin_bit_cast(float, __builtin_amdgcn_readlane(iv, 32)), __builtin_bit_cast(float, __builtin_amdgcn_readlane(iv, 48))));
}
DI float wave_sum(float v) {
#pragma unroll
    for (int o = 1; o < 64; o <<= 1) v += __shfl_xor(v, o);
    return v;
}
DI float dot2bf(unsigned a, unsigned b, float c) { return __builtin_amdgcn_fdot2_f32_bf16(__builtin_bit_cast(bf16x2_t, a), __builtin_bit_cast(bf16x2_t, b), c, false); }
DI f32x4 mfma16(bf16x8 a, bf16x8 b, f32x4 c) { return __builtin_amdgcn_mfma_f32_16x16x32_bf16(a, b, c, 0, 0, 0); }
DI s16x4 tr4(const LAS bf16* p) { return __builtin_bit_cast(s16x4, __builtin_amdgcn_ds_read_tr16_b64_v4i16((LAS v4i16_t*)p)); }
DI bf16x8 tr8(const LAS bf16* p, int stride) { const s16x4 a = tr4(p), b = tr4(p + 4 * stride); return (bf16x8){a[0], a[1], a[2], a[3], b[0], b[1], b[2], b[3]}; }

#define XB_TMO      128
#define XB_XCNT(j)  (256  + 64 * (j))
#define XB_XSUB(j)  (1280 + 64 * (j))
#define XB_XGEN(j)  (2304 + 64 * (j))
#define XB_TOP      3328
#define XB_TOPGEN   3392
#define XCD_BAR_WORDS 3456
#define XB_SPIN_CAP (1u << 18)

__device__ __forceinline__ unsigned xb_ld(unsigned* p)              { return __hip_atomic_load(p, __ATOMIC_RELAXED, __HIP_MEMORY_SCOPE_AGENT); }
__device__ __forceinline__ unsigned xb_add(unsigned* p, unsigned v) { return __hip_atomic_fetch_add(p, v, __ATOMIC_RELAXED, __HIP_MEMORY_SCOPE_AGENT); }
__device__ __forceinline__ unsigned xb_xcc_id() { return (unsigned)__builtin_amdgcn_s_getreg((3 << 11) | 20) & 0xFu; }
#define XB_SPIN(cond, bar) do { unsigned _sp = 0; while (cond) { __builtin_amdgcn_s_sleep(1); \
    if ((++_sp & 255u) == 0u) { if (xb_ld(&(bar)[XB_TMO])) break; if (_sp > XB_SPIN_CAP) { atomicAdd(&(bar)[XB_TMO], 1u); break; } } } } while (0)

struct XcdBarrier {
    unsigned* bar; unsigned x;
    volatile LAS unsigned* st;
};

__device__ __forceinline__ XcdBarrier xcd_barrier_post(unsigned* bar, volatile LAS unsigned* st) {
    XcdBarrier b; b.bar = bar; b.x = xb_xcc_id(); b.st = st;
    if (threadIdx.x == 0) (void)xb_add(&bar[XB_XCNT(b.x)], 1u);
    return b;
}
__device__ __forceinline__ void xcd_barrier_complete(unsigned* bar, unsigned x, unsigned& nloc, unsigned& nx) {
    const unsigned G = gridDim.x * gridDim.y * gridDim.z;
    unsigned sum, cnt, mine, sp = 0u;
    for (;;) {
        sum = 0u; cnt = 0u; mine = 0u;
#pragma unroll
        for (unsigned j = 0; j < 16; ++j) { const unsigned c = xb_ld(&bar[XB_XCNT(j)]); sum += c; cnt += (c > 0u) ? 1u : 0u; mine = (j == x) ? c : mine; }
        if (sum == G) break;
        __builtin_amdgcn_s_sleep(1);
        if ((++sp & 255u) == 0u) { if (xb_ld(&bar[XB_TMO])) break; if (sp > XB_SPIN_CAP) { atomicAdd(&bar[XB_TMO], 1u); break; } }
    }
    nloc = mine > 0u ? mine : 1u; nx = cnt > 0u ? cnt : 1u;
}

__device__ __forceinline__ void xcd_barrier(const XcdBarrier& b) {
    asm volatile("s_waitcnt vmcnt(0)" ::: "memory");
    __syncthreads();
    if (threadIdx.x == 0) {
        unsigned* bar = b.bar;
        __builtin_amdgcn_s_waitcnt(0);
        unsigned nloc = b.st[0], nx = b.st[1];
        if (nloc == 0u) { xcd_barrier_complete(bar, b.x, nloc, nx); b.st[0] = nloc; b.st[1] = nx; }
        const unsigned old = xb_add(&bar[XB_XSUB(b.x)], 1u);
        const unsigned gen = old / nloc;
        if (old + 1u == (gen + 1u) * nloc) {
            __builtin_amdgcn_fence(__ATOMIC_RELEASE, "agent");
            asm volatile("s_waitcnt vmcnt(0)" ::: "memory");
            const unsigned og = xb_add(&bar[XB_TOP], 1u);
            const unsigned tg = og / nx;
            if (og + 1u == (tg + 1u) * nx) xb_add(&bar[XB_TOPGEN], 1u);
            else XB_SPIN(xb_ld(&bar[XB_TOPGEN]) == tg, bar);
            __builtin_amdgcn_fence(__ATOMIC_ACQUIRE, "agent");
            xb_add(&bar[XB_XGEN(b.x)], 1u);
            asm volatile("s_waitcnt vmcnt(0)" ::: "memory");
        } else {
            XB_SPIN(xb_ld(&bar[XB_XGEN(b.x)]) == gen, bar);
            __builtin_amdgcn_fence(__ATOMIC_ACQUIRE, "agent");
            asm volatile("s_waitcnt vmcnt(0)" ::: "memory");
        }
    }
    __syncthreads();
}
struct Ctx {
    ldsp lds; int tid, lane, wave, bid, G, gw, NGW;
    unsigned char* ws;
};
DI const float* KARG(int k) { asm volatile("" : "+s"(k)); return ((const float* const*)__builtin_amdgcn_kernarg_segment_ptr())[k]; }
#define LDS_WAIT() asm volatile("s_waitcnt lgkmcnt(0)" ::: "memory")
enum { I_X = 0, I_C, I_ADAW, I_ADAB, I_N1G, I_WIN, I_WA2, I_BA, I_GNG, I_VNG, I_MWS, I_MB, I_MOG, I_WOUT, I_N2G, I_WQ, I_K1, I_K2, I_PU, I_PV, I_FG };

DI void p0_ada(const Ctx& C) {
    LAS float* red = (LAS float*)C.lds;
    float* MOD = (float*)(C.ws + WS_MOD);
    for (int it = C.bid; it < 256; it += C.G) {
        const int l = it >> 7, cg = it & 127, c0 = cg * 96 + (C.lane < 48 ? C.lane : 47) * 2;
        const float* W = KARG(I_ADAW) + (size_t)l * D * MODW + (size_t)(C.wave * 256) * MODW + c0;
        float cv[4][4];
#pragma unroll
        for (int b = 0; b < 4; ++b)
#pragma unroll
            for (int i = 0; i < 4; ++i) cv[b][i] = silu_f(KARG(I_C)[b * D + C.wave * 256 + i * 64 + C.lane]);
        float acc[4][2];
#pragma unroll
        for (int b = 0; b < 4; ++b) { acc[b][0] = 0.f; acc[b][1] = 0.f; }
#pragma unroll
        for (int i = 0; i < 4; ++i) {
#pragma unroll 16
            for (int j = 0; j < 64; ++j) {
                const f32x2 w = *(const f32x2*)(W + (size_t)(i * 64 + j) * MODW);
#pragma unroll
                for (int b = 0; b < 4; ++b) { const float s = __builtin_bit_cast(float, __builtin_amdgcn_readlane(__builtin_bit_cast(int, cv[b][i]), j)); acc[b][0] += s * w.x; acc[b][1] += s * w.y; }
            }
        }
#pragma unroll
        for (int b = 0; b < 4; ++b) *(LAS f32x2*)(red + (C.wave * 4 + b) * 128 + C.lane * 2) = (f32x2){acc[b][0], acc[b][1]};
        __syncthreads();
        { const int b = C.tid >> 7, col = C.tid & 127;
          if (col < 96) { float s = KARG(I_ADAB)[l * MODW + cg * 96 + col];
#pragma unroll
              for (int w = 0; w < 8; ++w) s += red[(w * 4 + b) * 128 + col];
              MOD[(size_t)(l * 4 + b) * MODW + cg * 96 + col] = s; } }
        __syncthreads();
    }
}
DI void transpose_item(const float* W, int ldw, int src_col0, int ncols, bf16* WT, int dst_row0, int k0, LAS float* scr, int lane) {
    const int cl = lane & 31;
    float v[32];
#pragma unroll
    for (int i = 0; i < 32; ++i) { const int kk = 2 * i + (lane >> 5); v[i] = 0.f; if (cl < ncols) v[i] = W[(size_t)(k0 + kk) * ldw + src_col0 + cl]; }
#pragma unroll
    for (int i = 0; i < 32; ++i) { const int kk = 2 * i + (lane >> 5); scr[kk * 33 + cl] = v[i]; }
    LDS_WAIT();
    const int c = lane & 7;
#pragma unroll
    for (int j = 0; j < 4; ++j) { const int n = (lane >> 3) + 8 * j;
        if (n < ncols) { const LAS float* s = scr + (8 * c) * 33 + n;
            u32x4 o; o.x = pk2(s[0 * 33], s[1 * 33]); o.y = pk2(s[2 * 33], s[3 * 33]); o.z = pk2(s[4 * 33], s[5 * 33]); o.w = pk2(s[6 * 33], s[7 * 33]);
            *(u32x4*)(WT + (size_t)(dst_row0 + n) * 2048 + k0 + 8 * c) = o; } }
    LDS_WAIT();
}
DI void p0_prologue(const Ctx& C) {
    p0_ada(C);
    LAS float* scr = (LAS float*)(C.lds + C.wave * 16384);
    constexpr int PER_L = (161 + 64 + 64) * 32;
    for (int it = C.gw; it < 2 * PER_L; it += C.NGW) {
        const int l = it / PER_L; int r = it % PER_L;
        if (r < 161 * 32) { const int kb = r / 161, nb = r % 161; bf16* WT = (bf16*)(C.ws + WS_WTIN) + (size_t)l * WTIN_L;
            const float* W = KARG(I_WIN) + (size_t)l * D * IN_COLS;
            if (nb < 160) { const int n0 = 32 * nb; transpose_item(W, IN_COLS, n0 + (n0 >= 3072 ? 16 : 0), 32, WT, n0, 64 * kb, scr, C.lane); }
            else transpose_item(W, IN_COLS, 3072, 16, WT, 5120, 64 * kb, scr, C.lane);
            continue; }
        r -= 161 * 32;
        if (r < 2048) { const int kb = r / 64, nb = r % 64; transpose_item(KARG(I_WOUT) + (size_t)l * D * D, D, 32 * nb, 32, (bf16*)(C.ws + WS_WTOUT) + (size_t)l * D * D, 32 * nb, 64 * kb, scr, C.lane); continue; }
        r -= 2048;
        { const int kb = r / 64, nb = r % 64; transpose_item(KARG(I_WQ) + (size_t)l * D * D, D, 32 * nb, 32, (bf16*)(C.ws + WS_WTQ) + (size_t)l * D * D, 32 * nb, 64 * kb, scr, C.lane); }
    }
    const int gt = C.bid * NTHR + C.tid, NT = C.G * NTHR;
    { bf16* K1B = (bf16*)(C.ws + WS_K1B); bf16* K2B = (bf16*)(C.ws + WS_K2B); bf16* WSB = (bf16*)(C.ws + WS_WSB);
      for (int i = gt; i < 262144; i += NT) { K1B[i] = (bf16)f2bf(KARG(I_K1)[i]); K2B[i] = (bf16)f2bf(KARG(I_K2)[i]);
          const int s = i & 127, t = (i >> 7) & 127; WSB[i] = (s <= t) ? (bf16)f2bf(KARG(I_MWS)[i]) : (bf16)0; } }
    { float* SU = (float*)(C.ws + WS_SU); int* KV = (int*)(C.ws + WS_KV);
      f32x4 v[8], vn[8];
      { const f32x4* src = (const f32x4*)(KARG(I_PU) + (size_t)C.gw * D) + C.lane;
#pragma unroll
        for (int j = 0; j < 8; ++j) v[j] = src[64 * j]; }
#pragma unroll 1
      for (int row = C.gw; row < 4 * NEXP; row += C.NGW) {
          const int tb = row >> 15, rr = row & 32767;
          { const int rown = row + C.NGW < 4 * NEXP ? row + C.NGW : row; const int tbn = rown >> 15, rrn = rown & 32767;
            const f32x4* src = (const f32x4*)(KARG(tbn ? I_PV : I_PU) + (size_t)rrn * D) + C.lane;
#pragma unroll
            for (int j = 0; j < 8; ++j) vn[j] = src[64 * j]; }
          const int lyr = rr >> 14, ee = rr & 16383;
          unsigned* dst = (unsigned*)(C.ws + (tb ? WS_PVB : WS_PUB) + (size_t)lyr * NEXP * D + (size_t)ee * 256) + C.lane;
          if (tb) {
              float mx = 0.f;
#pragma unroll
              for (int j = 0; j < 8; ++j) mx = fmaxf(mx, fmaxf(fmaxf(fabsf(v[j].x), fabsf(v[j].y)), fmaxf(fabsf(v[j].z), fabsf(v[j].w))));
              mx = wave_max_u(mx);
              int k = 0;
              if (mx > 0.f) { k = (int)((__builtin_bit_cast(unsigned, 224.0f / mx) >> 23) & 255u) - 127; k = k < -60 ? -60 : (k > 60 ? 60 : k); }
              const float sc = __builtin_bit_cast(float, (unsigned)(k + 127) << 23);
#pragma unroll
              for (int j = 0; j < 8; ++j) { int p = 0; p = __builtin_amdgcn_cvt_pk_fp8_f32(v[j].x * sc, v[j].y * sc, p, false); p = __builtin_amdgcn_cvt_pk_fp8_f32(v[j].z * sc, v[j].w * sc, p, true); dst[(size_t)j * (NEXP * 256 / 4)] = (unsigned)p; }
              if (C.lane == 0) KV[rr] = k;
          } else {
              unsigned* dst4 = (unsigned*)(C.ws + WS_PUB + (size_t)lyr * NEXP * (D / 2) + (size_t)ee * 128) + (C.lane >> 1);
#pragma unroll
              for (int j = 0; j < 8; ++j) {
                  const float mx = wave_max_u(fmaxf(fmaxf(fabsf(v[j].x), fabsf(v[j].y)), fmaxf(fabsf(v[j].z), fabsf(v[j].w))));
                  const float inv = mx > 0.f ? 7.0f / mx : 0.f;
                  const int q0 = (int)__builtin_rintf(v[j].x * inv), q1 = (int)__builtin_rintf(v[j].y * inv), q2 = (int)__builtin_rintf(v[j].z * inv), q3 = (int)__builtin_rintf(v[j].w * inv);
                  const unsigned nib = (unsigned)(q0 & 15) | ((unsigned)(q1 & 15) << 8) | ((unsigned)(q2 & 15) << 16) | ((unsigned)(q3 & 15) << 24);
                  const unsigned other = (unsigned)__builtin_amdgcn_update_dpp(0, (int)nib, 0xB1, 0xf, 0xf, true);
                  if ((C.lane & 1) == 0) dst4[(size_t)j * (NEXP * 128 / 4)] = nib | (other << 4);
                  if (C.lane == 0) SU[(size_t)(lyr * 8 + j) * NEXP + ee] = mx * (1.0f / 7.0f);
              }
          }
#pragma unroll
          for (int j = 0; j < 8; ++j) v[j] = vn[j];
      } }
}
template <bool FP8 = false, bool XB = false>
DI void norm_phase(const Ctx& C, const void* Xv, const float* g, const float* modl, int sh_off, int sc_off, bf16* Hout, unsigned char* H8 = nullptr, float* HS = nullptr, int* COEF = nullptr) {
    const int r0 = C.gw * 8, b = r0 >> 12;
    if (FP8) {
        u32x4* cz = (u32x4*)(COEF + (size_t)r0 * 128) + C.lane;
        unsigned z_ = 0u; asm volatile("" : "+v"(z_));
#pragma unroll
        for (int j = 0; j < 4; ++j) cz[64 * j] = (u32x4){z_, z_, z_, z_}; }
    const f32x4* shp = (const f32x4*)(modl + (size_t)b * MODW + sh_off); const f32x4* scp = (const f32x4*)(modl + (size_t)b * MODW + sc_off);
    f32x4 gm[8], shv[8];
#pragma unroll
    for (int j = 0; j < 8; ++j) { const int idx = 64 * j + C.lane; gm[j] = ((const f32x4*)g)[idx] * (scp[idx] + 1.0f); shv[j] = shp[idx]; }
    u32x2 rb[8], rbn[8]; f32x4 rf[8], rfn[8];
    if (XB) { const u32x2* xr = (const u32x2*)((const bf16*)Xv + (size_t)r0 * D) + C.lane;
#pragma unroll
        for (int j = 0; j < 8; ++j) rb[j] = xr[64 * j]; }
    else { const f32x4* xr = (const f32x4*)((const float*)Xv + (size_t)r0 * D) + C.lane;
#pragma unroll
        for (int j = 0; j < 8; ++j) rf[j] = xr[64 * j]; }
#pragma unroll 1
    for (int i = 0; i < 8; ++i) {
        f32x4 v[8]; float s = 0.f;
        const int in_ = i + 1 < 8 ? i + 1 : i;
        if (XB) { const u32x2* xr = (const u32x2*)((const bf16*)Xv + (size_t)(r0 + in_) * D) + C.lane;
#pragma unroll
            for (int j = 0; j < 8; ++j) rbn[j] = xr[64 * j];
#pragma unroll
            for (int j = 0; j < 8; ++j) v[j] = (f32x4){bflo(rb[j].x), bfhi(rb[j].x), bflo(rb[j].y), bfhi(rb[j].y)}; }
        else { const f32x4* xr = (const f32x4*)((const float*)Xv + (size_t)(r0 + in_) * D) + C.lane;
#pragma unroll
            for (int j = 0; j < 8; ++j) rfn[j] = xr[64 * j];
#pragma unroll
            for (int j = 0; j < 8; ++j) v[j] = rf[j]; }
#pragma unroll
        for (int j = 0; j < 8; ++j) s += (v[j].x * v[j].x + v[j].y * v[j].y) + (v[j].z * v[j].z + v[j].w * v[j].w);
        const float rstd = frsq(wave_sum(s) * (1.f / D) + EPS);
        u32x2* o = (u32x2*)(Hout + (size_t)(r0 + i) * D) + C.lane;
#pragma unroll
        for (int j = 0; j < 8; ++j) { const f32x4 y = v[j] * rstd * gm[j] + shv[j]; u32x2 w; w.x = pk2(y.x, y.y); w.y = pk2(y.z, y.w); o[64 * j] = w;
            if (FP8) v[j] = y; }
        if (FP8) {
            float st[8];
            unsigned* h8 = (unsigned*)(H8 + (size_t)(r0 + i) * 2048) + (C.lane >> 1);
#pragma unroll
            for (int j = 0; j < 8; ++j) {
                const float am = wave_max_u(fmaxf(fmaxf(fabsf(v[j].x), fabsf(v[j].y)), fmaxf(fabsf(v[j].z), fabsf(v[j].w))));
                const float qs = am > 0.f ? 119.0f / am : 0.f; st[j] = am * (1.0f / 119.0f);
                const int q0 = (int)__builtin_rintf(v[j].x * qs), q1 = (int)__builtin_rintf(v[j].y * qs), q2 = (int)__builtin_rintf(v[j].z * qs), q3 = (int)__builtin_rintf(v[j].w * qs);
                const int a0 = (q0 + 8) >> 4, a1 = (q1 + 8) >> 4, a2 = (q2 + 8) >> 4, a3 = (q3 + 8) >> 4;
                const unsigned na = (unsigned)(a0 & 15) | ((unsigned)(a1 & 15) << 8) | ((unsigned)(a2 & 15) << 16) | ((unsigned)(a3 & 15) << 24);
                const unsigned nb = (unsigned)((q0 - 16 * a0) & 15) | ((unsigned)((q1 - 16 * a1) & 15) << 8) | ((unsigned)((q2 - 16 * a2) & 15) << 16) | ((unsigned)((q3 - 16 * a3) & 15) << 24);
                const unsigned oa = (unsigned)__builtin_amdgcn_update_dpp(0, (int)na, 0xB1, 0xf, 0xf, true), ob = (unsigned)__builtin_amdgcn_update_dpp(0, (int)nb, 0xB1, 0xf, 0xf, true);
                if ((C.lane & 1) == 0) { h8[32 * j] = na | (oa << 4); h8[256 + 32 * j] = nb | (ob << 4); } }
            if (C.lane == 0) { f32x4* hp = (f32x4*)(HS + (size_t)(r0 + i) * 8); hp[0] = (f32x4){st[0], st[1], st[2], st[3]}; hp[1] = (f32x4){st[4], st[5], st[6], st[7]}; }
        }
        if (XB) {
#pragma unroll
            for (int j = 0; j < 8; ++j) rb[j] = rbn[j]; }
        else {
#pragma unroll
            for (int j = 0; j < 8; ++j) rf[j] = rfn[j]; }
    }
}
DI void alow_phase(const Ctx& C, const bf16* Hb, const bf16* WtA, float* ALOW) {
    const int task = C.bid * 4 + (C.wave & 3), kh = C.wave >> 2, r0 = task * 16, fr = C.lane & 15, fq = C.lane >> 4;
    const bf16* ap = Hb + (size_t)(r0 + fr) * D + 8 * fq + 1024 * kh; const bf16* bp = WtA + (size_t)fr * D + 8 * fq + 1024 * kh;
    f32x4 acc = (f32x4){0.f, 0.f, 0.f, 0.f};
#pragma unroll 8
    for (int ks = 0; ks < 32; ++ks) { const bf16x8 a = *(const bf16x8*)(ap + 32 * ks), b = *(const bf16x8*)(bp + 32 * ks); acc = mfma16(a, b, acc); }
    LAS f32x4* xch = (LAS f32x4*)C.lds + (C.wave & 3) * 64 + C.lane;
    if (kh) *xch = acc;
    LDS_WAIT(); __builtin_amdgcn_s_barrier(); asm volatile("" ::: "memory");
    if (!kh) { acc += *xch;
#pragma unroll
        for (int r = 0; r < 4; ++r) ALOW[(size_t)(r0 + 4 * fq + r) * 16 + fr] = acc[r]; }
}
#define LBAR() do { asm volatile("s_waitcnt lgkmcnt(0)" ::: "memory"); __builtin_amdgcn_s_barrier(); asm volatile("" ::: "memory"); } while (0)
DI void gla_gates(const Ctx& C, LAS float* al, LAS float* tot, const f32x4 alv, const float (&w2)[16], const float bav, float (&Gl)[16], float& off, float& gref, float& g63) {
    const int d = C.tid & 127, jg = C.tid >> 7;
    if (C.tid < 256) ((LAS f32x4*)al)[C.tid] = alv;
    LBAR();
    float run = 0.f;
#pragma unroll
    for (int jj = 0; jj < 16; ++jj) {
        const LAS f32x4* ar = (const LAS f32x4*)(al + (jg * 16 + jj) * 16);
        const f32x4 a0 = ar[0], a1 = ar[1], a2 = ar[2], a3 = ar[3];
        float z = bav;
        z += a0.x * w2[0] + a0.y * w2[1] + a0.z * w2[2] + a0.w * w2[3];
        z += a1.x * w2[4] + a1.y * w2[5] + a1.z * w2[6] + a1.w * w2[7];
        z += a2.x * w2[8] + a2.y * w2[9] + a2.z * w2[10] + a2.w * w2[11];
        z += a3.x * w2[12] + a3.y * w2[13] + a3.z * w2[14] + a3.w * w2[15];
        const float ls = fminf(z, 0.f) - 0.6931471806f * flog2(1.f + fexp2(-1.442695041f * fabsf(z)));
        run += ls * (1.442695041f / 16.f);
        Gl[jj] = run;
    }
    tot[jg * 128 + d] = run;
    LBAR();
    const float t0_ = tot[d], t1_ = tot[128 + d], t2_ = tot[256 + d], t3_ = tot[384 + d];
    off = (jg > 0 ? t0_ : 0.f) + (jg > 1 ? t1_ : 0.f) + (jg > 2 ? t2_ : 0.f); gref = t0_ + t1_; g63 = (t0_ + t1_) + (t2_ + t3_);
}
constexpr int KST = 136, VST = 264, PST = 72;
struct GlaIn { f32x4 alv; u32x4 qt[2], kt[2]; u32x4 vt[4]; };
template <bool WITHQ, bool WITHV = true>
DI void gla_load(const Ctx& C, int idx, const bf16* PROJ, const float* ALOW, GlaIn& in) {
    const int b = idx >> 8, h = (idx >> 6) & 3, n = idx & 63, t0 = b * SEQ + n * 64;
    in.alv = (f32x4){0.f, 0.f, 0.f, 0.f};
    if (C.tid < 256) in.alv = ((const f32x4*)(ALOW + (size_t)t0 * 16))[C.tid];
#pragma unroll
    for (int i = 0; i < 2; ++i) { const int c = C.tid + 512 * i, j = c >> 4, ec = c & 15; const bf16* row = PROJ + (size_t)(t0 + j) * NPROJ + h * 128 + 8 * ec;
        in.kt[i] = *(const u32x4*)(row + C_K); if (WITHQ) in.qt[i] = *(const u32x4*)(row + C_Q); }
    if (WITHV) {
#pragma unroll
    for (int i = 0; i < 4; ++i) { const int c = C.tid + 512 * i, j = c >> 5, ec = c & 31; in.vt[i] = *(const u32x4*)(PROJ + (size_t)(t0 + j) * NPROJ + C_V + h * 256 + 8 * ec); } }
}
DI void store_qk_raw(const Ctx& C, const GlaIn& in, LAS bf16* QR, LAS bf16* KR) {
#pragma unroll
    for (int i = 0; i < 2; ++i) { const int c = C.tid + 512 * i, j = c >> 4, ec = c & 15; *(LAS u32x4*)(KR + j * KST + 8 * ec) = in.kt[i]; if (QR) *(LAS u32x4*)(QR + j * KST + 8 * ec) = in.qt[i]; }
}
DI void gla_load_v(const Ctx& C, int idx, const bf16* PROJ, GlaIn& in) {
    const int b = idx >> 8, h = (idx >> 6) & 3, n = idx & 63, t0 = b * SEQ + n * 64;
#pragma unroll
    for (int i = 0; i < 4; ++i) { const int c = C.tid + 512 * i, j = c >> 5, ec = c & 31; in.vt[i] = *(const u32x4*)(PROJ + (size_t)(t0 + j) * NPROJ + C_V + h * 256 + 8 * ec); }
}
DI void store_v_tile(const Ctx& C, const GlaIn& in, LAS bf16* VL) {
#pragma unroll
    for (int i = 0; i < 4; ++i) { const int c = C.tid + 512 * i, j = c >> 5, ec = c & 31; *(LAS u32x4*)(VL + j * VST + 8 * ec) = in.vt[i]; }
}
DI void glaA_phase(const Ctx& C, int l, const bf16* PROJ, const float* ALOW, bf16* SBUF, float* DEC) {
    LAS float* al = (LAS float*)(C.lds); LAS float* tot = (LAS float*)(C.lds + 4096);
    LAS bf16* KD = (LAS bf16*)(C.lds + 8192); LAS bf16* VL = (LAS bf16*)(C.lds + 25600); LAS bf16* SL = (LAS bf16*)(C.lds + 59392);
    const int d = C.tid & 127, jg = C.tid >> 7, h = (C.bid >> 6) & 3;
    LAS float* W2L = (LAS float*)(C.lds + 135168);
    if (jg == 0) {
#pragma unroll
        for (int r = 0; r < 16; ++r) W2L[r * 128 + d] = KARG(I_WA2)[(size_t)l * 16 * 512 + r * 512 + h * 128 + d]; }
    LBAR();
    const float bav = KARG(I_BA)[(size_t)l * 512 + h * 128 + d];
    GlaIn cur, nxt;
    gla_load<false>(C, C.bid, PROJ, ALOW, cur);
#pragma unroll 1
    for (int i = 0; i < 4; ++i) {
        const int idx = i * C.G + C.bid;
        float Gl[16], off, gref, g63;
        store_qk_raw(C, cur, nullptr, KD);
        {   float w2[16];
#pragma unroll
            for (int r = 0; r < 16; ++r) w2[r] = W2L[r * 128 + d];
            gla_gates(C, al, tot, cur.alv, w2, bav, Gl, off, gref, g63); }
#pragma unroll
        for (int jj = 0; jj < 16; ++jj) { const int j = jg * 16 + jj; KD[j * KST + d] = (bf16)f2bf(bf1(KD[j * KST + d]) * fexp2(g63 - (off + Gl[jj]))); }
        store_v_tile(C, cur, VL);
        LBAR();
        if (i + 1 < 4) gla_load<false>(C, idx + C.G, PROJ, ALOW, nxt);
        if (jg == 0) DEC[(size_t)idx * 128 + d] = fexp2(g63);
        const int lane = C.lane, g = lane >> 4, qq = (lane & 15) >> 2, p = lane & 3, fr = lane & 15;
        bf16x8 A[2];
#pragma unroll
        for (int ks = 0; ks < 2; ++ks) A[ks] = tr8(KD + (32 * ks + 8 * g + qq) * KST + 16 * C.wave + 4 * p, KST);
        bf16* Sit = SBUF + (size_t)idx * 256 * 128;
#pragma unroll
        for (int half = 0; half < 2; ++half) {
            f32x4 acc[8];
#pragma unroll
            for (int nt = 0; nt < 8; ++nt) acc[nt] = (f32x4){0.f, 0.f, 0.f, 0.f};
#pragma unroll
            for (int nt = 0; nt < 8; ++nt)
#pragma unroll
                for (int ks = 0; ks < 2; ++ks) { const bf16x8 Bf = tr8(VL + (32 * ks + 8 * g + qq) * VST + 16 * (half * 8 + nt) + 4 * p, VST); acc[nt] = mfma16(A[ks], Bf, acc[nt]); }
#pragma unroll
            for (int nt = 0; nt < 8; ++nt) { const int e = 16 * (half * 8 + nt) + fr, dd = 16 * C.wave + 4 * g;
                u32x2 w; w.x = pk2(acc[nt][0], acc[nt][1]); w.y = pk2(acc[nt][2], acc[nt][3]); *(LAS u32x2*)(SL + e * KST + dd) = w; }
        }
        LBAR();
#pragma unroll
        for (int k = 0; k < 8; ++k) { const int c = C.tid + 512 * k, e = c >> 4, ch = c & 15; *(u32x4*)(Sit + (size_t)e * 128 + 8 * ch) = *(const LAS u32x4*)(SL + e * KST + 8 * ch); }
        cur = nxt;
    }
}
DI void scan_phase(const Ctx& C, bf16* SBUF, const float* DEC) {
    const int gt = C.bid * NTHR + C.tid, bh = gt >> 13, rem = gt & 8191, e = rem >> 5, dq = rem & 31;
    u32x2* p = (u32x2*)(SBUF + ((size_t)(bh * 64) * 256 + e) * 128 + 4 * dq);
    const f32x4* dp = (const f32x4*)(DEC + (size_t)(bh * 64) * 128 + 4 * dq);
    f32x4 st = (f32x4){0.f, 0.f, 0.f, 0.f};
#pragma unroll 1
    for (int n0 = 0; n0 < 64; n0 += 8) {
        u32x2 tmp[8]; f32x4 dc[8];
#pragma unroll
        for (int u = 0; u < 8; ++u) { tmp[u] = p[(size_t)(n0 + u) * 8192]; dc[u] = dp[(n0 + u) * 32]; }
#pragma unroll
        for (int u = 0; u < 8; ++u) { u32x2 w; w.x = pk2(st.x, st.y); w.y = pk2(st.z, st.w); p[(size_t)(n0 + u) * 8192] = w;
            st = dc[u] * st + (f32x4){bflo(tmp[u].x), bfhi(tmp[u].x), bflo(tmp[u].y), bfhi(tmp[u].y)}; }
    }
}
DI void glaC_phase(const Ctx& C, int l, const bf16* PROJ, const float* ALOW, const bf16* SBUF, bf16* CONCAT) {
    const int h = (C.bid >> 6) & 3;
    LAS float* al = (LAS float*)(C.lds); LAS float* tot = (LAS float*)(C.lds + 4096); LAS float* RS = (LAS float*)(C.lds + 6144);
    LAS bf16* QT = (LAS bf16*)(C.lds + 8192); LAS bf16* KT = (LAS bf16*)(C.lds + 25600); LAS bf16* QG = (LAS bf16*)(C.lds + 43008);
    LAS bf16* VL = (LAS bf16*)(C.lds + 60416); LAS bf16* PL = (LAS bf16*)(C.lds + 94208);
    const int d = C.tid & 127, jg = C.tid >> 7;
    LAS float* W2L = (LAS float*)(C.lds + 135168);
    if (jg == 0) {
#pragma unroll
        for (int r = 0; r < 16; ++r) W2L[r * 128 + d] = KARG(I_WA2)[(size_t)l * 16 * 512 + r * 512 + h * 128 + d]; }
    LBAR();
    const float bav = KARG(I_BA)[(size_t)l * 512 + h * 128 + d];
    const float* ng = KARG(I_GNG) + (size_t)(l * 4 + h) * 256;
    GlaIn cur;
    f32x4 alv_n; u32x4 qtn[2], ktn[2];
    gla_load<true, false>(C, C.bid, PROJ, ALOW, cur);
#pragma unroll 1
    for (int it = 0; it < 4; ++it) {
    const int idx = it * C.G + C.bid, b = idx >> 8, n = idx & 63, t0 = b * SEQ + n * 64;
    gla_load_v(C, idx, PROJ, cur);
    const int lane = C.lane, g = lane >> 4, qq = (lane & 15) >> 2, p = lane & 3, fr = lane & 15;
    bf16x8 Sf[2][4]; u32x2 rraw[4][2];
#pragma unroll
    for (int mi = 0; mi < 2; ++mi) { const bf16* Srow = SBUF + ((size_t)idx * 256 + 16 * (2 * C.wave + mi) + fr) * 128 + 8 * g;
#pragma unroll
        for (int ks = 0; ks < 4; ++ks) Sf[mi][ks] = *(const bf16x8*)(Srow + 32 * ks); }
#pragma unroll
    for (int nt = 0; nt < 4; ++nt)
#pragma unroll
        for (int mi = 0; mi < 2; ++mi) rraw[nt][mi] = *(const u32x2*)(PROJ + (size_t)(t0 + 16 * nt + fr) * NPROJ + C_R + h * 256 + 16 * (2 * C.wave + mi) + 4 * g);
    store_qk_raw(C, cur, QT, KT);
    float Gl[16], off, gref, g63;
    {   float w2[16];
#pragma unroll
        for (int r = 0; r < 16; ++r) w2[r] = W2L[r * 128 + d];
        gla_gates(C, al, tot, cur.alv, w2, bav, Gl, off, gref, g63); }
#pragma unroll
    for (int jj = 0; jj < 16; ++jj) { const int j = jg * 16 + jj; const float Gv = off + Gl[jj];
        const float q = bf1(QT[j * KST + d]) * 0.08838834764831845f, k = bf1(KT[j * KST + d]);
        QT[j * KST + d] = (bf16)f2bf(q * fexp2(fminf(Gv - gref, 100.f))); KT[j * KST + d] = (bf16)f2bf(k * fexp2(fminf(gref - Gv, 100.f))); QG[j * KST + d] = (bf16)f2bf(q * fexp2(Gv)); }
    store_v_tile(C, cur, VL);
    LBAR();
    if (it + 1 < 4) { const int ix = idx + C.G, t1 = (ix >> 8) * SEQ + (ix & 63) * 64;
        alv_n = (f32x4){0.f, 0.f, 0.f, 0.f}; if (C.tid < 256) alv_n = ((const f32x4*)(ALOW + (size_t)t1 * 16))[C.tid];
#pragma unroll
        for (int i = 0; i < 2; ++i) { const int c = C.tid + 512 * i, j = c >> 4, ec = c & 15; const bf16* row = PROJ + (size_t)(t1 + j) * NPROJ + h * 128 + 8 * ec; ktn[i] = *(const u32x4*)(row + C_K); qtn[i] = *(const u32x4*)(row + C_Q); } }
    {
        const int nt = C.wave & 3;
#pragma unroll
        for (int mi = 0; mi < 2; ++mi) { const int mt = 2 * (C.wave >> 2) + mi; f32x4 acc = (f32x4){0.f, 0.f, 0.f, 0.f};
#pragma unroll
            for (int ks = 0; ks < 4; ++ks) { const bf16x8 a = *(const LAS bf16x8*)(KT + (16 * mt + fr) * KST + 32 * ks + 8 * g), bq = *(const LAS bf16x8*)(QT + (16 * nt + fr) * KST + 32 * ks + 8 * g); acc = mfma16(a, bq, acc); }
            const int i = 16 * nt + fr, j0 = 16 * mt + 4 * g;
            const float v0 = (j0 + 0 <= i) ? acc[0] : 0.f, v1 = (j0 + 1 <= i) ? acc[1] : 0.f, v2 = (j0 + 2 <= i) ? acc[2] : 0.f, v3 = (j0 + 3 <= i) ? acc[3] : 0.f;
            u32x2 w; w.x = pk2(v0, v1); w.y = pk2(v2, v3); *(LAS u32x2*)(PL + i * PST + j0) = w; }
    }
    LBAR();
    f32x4 acc[2][4];
#pragma unroll
    for (int mi = 0; mi < 2; ++mi)
#pragma unroll
        for (int nt = 0; nt < 4; ++nt) acc[mi][nt] = (f32x4){0.f, 0.f, 0.f, 0.f};
#pragma unroll
    for (int mi = 0; mi < 2; ++mi) { const int mt = 2 * C.wave + mi;
#pragma unroll
        for (int ks = 0; ks < 2; ++ks) { const bf16x8 a = tr8(VL + (32 * ks + 8 * g + qq) * VST + 16 * mt + 4 * p, VST);
#pragma unroll
            for (int nt = 0; nt < 4; ++nt) { const bf16x8 bp = *(const LAS bf16x8*)(PL + (16 * nt + fr) * PST + 32 * ks + 8 * g); acc[mi][nt] = mfma16(a, bp, acc[mi][nt]); } }
#pragma unroll
        for (int ks = 0; ks < 4; ++ks) { const bf16x8 a = Sf[mi][ks];
#pragma unroll
            for (int nt = 0; nt < 4; ++nt) { const bf16x8 bq = *(const LAS bf16x8*)(QG + (16 * nt + fr) * KST + 32 * ks + 8 * g); acc[mi][nt] = mfma16(a, bq, acc[mi][nt]); } }
    }
#pragma unroll
    for (int nt = 0; nt < 4; ++nt) { float s = 0.f;
#pragma unroll
        for (int mi = 0; mi < 2; ++mi) s += (acc[mi][nt][0] * acc[mi][nt][0] + acc[mi][nt][1] * acc[mi][nt][1]) + (acc[mi][nt][2] * acc[mi][nt][2] + acc[mi][nt][3] * acc[mi][nt][3]);
        s += __shfl_xor(s, 16); s += __shfl_xor(s, 32);
        if (g == 0) RS[C.wave * 64 + 16 * nt + fr] = s; }
    LBAR();
#pragma unroll
    for (int nt = 0; nt < 4; ++nt) { const int i = 16 * nt + fr; float ts = 0.f;
#pragma unroll
        for (int w = 0; w < 8; ++w) ts += RS[w * 64 + i];
        const float rstd = frsq(ts * (1.f / 256.f) + EPS);
#pragma unroll
        for (int mi = 0; mi < 2; ++mi) { const int e = 16 * (2 * C.wave + mi) + 4 * g;
            const u32x2 rr = rraw[nt][mi]; const f32x4 gg = *(const f32x4*)(ng + e);
            const float o0 = acc[mi][nt][0] * rstd * gg.x * silu_f(bflo(rr.x)), o1 = acc[mi][nt][1] * rstd * gg.y * silu_f(bfhi(rr.x));
            const float o2 = acc[mi][nt][2] * rstd * gg.z * silu_f(bflo(rr.y)), o3 = acc[mi][nt][3] * rstd * gg.w * silu_f(bfhi(rr.y));
            u32x2 w; w.x = pk2(o0, o1); w.y = pk2(o2, o3); *(LAS u32x2*)(VL + i * VST + e) = w; } }
    LBAR();
#pragma unroll
    for (int k = 0; k < 4; ++k) { const int c = C.tid + 512 * k, i = c >> 5, ec = c & 31; *(u32x4*)(CONCAT + (size_t)(t0 + i) * D + h * 256 + 8 * ec) = *(const LAS u32x4*)(VL + i * VST + 8 * ec); }
    LBAR();
    cur.alv = alv_n;
#pragma unroll
    for (int i = 0; i < 2; ++i) { cur.qt[i] = qtn[i]; cur.kt[i] = ktn[i]; }
    }
}
constexpr int GST = 136;
DI void gmlp_phase(const Ctx& C, int l, const bf16* PROJ, const bf16* WSB, bf16* CONCAT) {
    const int h = C.bid & 7;
    LAS bf16* VL2 = (LAS bf16*)(C.lds); LAS bf16* UL = (LAS bf16*)(C.lds + 34816);
    const float* vg = KARG(I_VNG) + (size_t)(l * 8 + h) * 128; const float* og = KARG(I_MOG) + (size_t)(l * 8 + h) * 128; const float* bb = KARG(I_MB) + (size_t)(l * 8 + h) * 128;
    bf16x8 Wf[4];
    { const bf16* Wrow = WSB + ((size_t)(l * 8 + h) * 128 + 16 * C.wave + (C.lane & 15)) * 128 + 8 * (C.lane >> 4);
#pragma unroll
      for (int ks = 0; ks < 4; ++ks) Wf[ks] = *(const bf16x8*)(Wrow + 32 * ks); }
    u32x4 cu[4], cv[4], nu[4], nv[4];
#define GM_LOAD(IDX, U, V) do { const int t0_ = ((IDX) >> 8) * SEQ + (((IDX) >> 3) & 31) * 128; _Pragma("unroll") for (int i = 0; i < 4; ++i) { const int c = C.tid + 512 * i, t = c >> 4, ch = c & 15; \
        const bf16* row = PROJ + (size_t)(t0_ + t) * NPROJ + h * 128 + 8 * ch; U[i] = *(const u32x4*)(row + C_U); V[i] = *(const u32x4*)(row + C_VS); } } while (0)
    GM_LOAD(C.bid, cu, cv);
#pragma unroll 1
    for (int it = 0; it < 4; ++it) {
    const int idx = it * C.G + C.bid, n = (idx >> 3) & 31, b = idx >> 8, t0 = b * SEQ + n * 128;
#pragma unroll
    for (int i = 0; i < 4; ++i) { const int c = C.tid + 512 * i, t = c >> 4, ch = c & 15;
        const u32x4 uu = cu[i], vv = cv[i];
        float v[8] = {gelu_t(bflo(vv.x)), gelu_t(bfhi(vv.x)), gelu_t(bflo(vv.y)), gelu_t(bfhi(vv.y)), gelu_t(bflo(vv.z)), gelu_t(bfhi(vv.z)), gelu_t(bflo(vv.w)), gelu_t(bfhi(vv.w))};
        float ss = 0.f;
#pragma unroll
        for (int k = 0; k < 8; ++k) ss += v[k] * v[k];
        ss += __shfl_xor(ss, 1); ss += __shfl_xor(ss, 2); ss += __shfl_xor(ss, 4); ss += __shfl_xor(ss, 8);
        const float rstd = frsq(ss * (1.f / 128.f) + EPS);
        const f32x4 g0 = *(const f32x4*)(vg + 8 * ch), g1 = *(const f32x4*)(vg + 8 * ch + 4);
        u32x4 wv; wv.x = pk2(v[0] * rstd * g0.x, v[1] * rstd * g0.y); wv.y = pk2(v[2] * rstd * g0.z, v[3] * rstd * g0.w); wv.z = pk2(v[4] * rstd * g1.x, v[5] * rstd * g1.y); wv.w = pk2(v[6] * rstd * g1.z, v[7] * rstd * g1.w);
        *(LAS u32x4*)(VL2 + t * GST + 8 * ch) = wv;
        u32x4 wu; wu.x = pk2(gelu_t(bflo(uu.x)), gelu_t(bfhi(uu.x))); wu.y = pk2(gelu_t(bflo(uu.y)), gelu_t(bfhi(uu.y))); wu.z = pk2(gelu_t(bflo(uu.z)), gelu_t(bfhi(uu.z))); wu.w = pk2(gelu_t(bflo(uu.w)), gelu_t(bfhi(uu.w)));
        *(LAS u32x4*)(UL + t * GST + 8 * ch) = wu; }
    LBAR();
    if (it + 1 < 4) GM_LOAD(idx + C.G, nu, nv);
    const int lane = C.lane, g = lane >> 4, qq = (lane & 15) >> 2, p = lane & 3, fr = lane & 15;
    f32x4 acc[8];
#pragma unroll
    for (int mt = 0; mt < 8; ++mt) acc[mt] = (f32x4){0.f, 0.f, 0.f, 0.f};
    const int nks = (C.wave >> 1) + 1;
#pragma unroll
    for (int ks = 0; ks < 4; ++ks) if (ks < nks) { const bf16x8 bw = Wf[ks];
#pragma unroll
        for (int mt = 0; mt < 8; ++mt) { const bf16x8 a = tr8(VL2 + (32 * ks + 8 * g + qq) * GST + 16 * mt + 4 * p, GST); acc[mt] = mfma16(a, bw, acc[mt]); } }
    const int tl = 16 * C.wave + fr; const float bt = bb[tl]; float ss = 0.f;
#pragma unroll
    for (int mt = 0; mt < 8; ++mt) { const u32x2 uu = *(const LAS u32x2*)(UL + tl * GST + 16 * mt + 4 * g);
        acc[mt][0] = bflo(uu.x) * (acc[mt][0] + bt); acc[mt][1] = bfhi(uu.x) * (acc[mt][1] + bt); acc[mt][2] = bflo(uu.y) * (acc[mt][2] + bt); acc[mt][3] = bfhi(uu.y) * (acc[mt][3] + bt);
        ss += (acc[mt][0] * acc[mt][0] + acc[mt][1] * acc[mt][1]) + (acc[mt][2] * acc[mt][2] + acc[mt][3] * acc[mt][3]); }
    ss += __shfl_xor(ss, 16); ss += __shfl_xor(ss, 32);
    const float rstd = frsq(ss * (1.f / 128.f) + EPS);
#pragma unroll
    for (int mt = 0; mt < 8; ++mt) { const f32x4 gg = *(const f32x4*)(og + 16 * mt + 4 * g);
        u32x2 w; w.x = pk2(acc[mt][0] * rstd * gg.x, acc[mt][1] * rstd * gg.y); w.y = pk2(acc[mt][2] * rstd * gg.z, acc[mt][3] * rstd * gg.w);
        *(LAS u32x2*)(UL + tl * GST + 16 * mt + 4 * g) = w; }
#pragma unroll
    for (int k = 0; k < 4; ++k) { const int c = lane + 64 * k, r = c >> 4, ch = c & 15; *(u32x4*)(CONCAT + (size_t)(t0 + 16 * C.wave + r) * D + 1024 + h * 128 + 8 * ch) = *(const LAS u32x4*)(UL + (16 * C.wave + r) * GST + 8 * ch); }
    LBAR();
#pragma unroll
    for (int i = 0; i < 4; ++i) { cu[i] = nu[i]; cv[i] = nv[i]; }
    }
#undef GM_LOAD
}
DI void list_insert(float (&L)[16], float x) {
#pragma unroll
    for (int i = 15; i >= 1; --i) L[i] = __builtin_amdgcn_fmed3f(x, L[i - 1], L[i]);
    L[0] = fmaxf(L[0], x);
}
DI void list_merge_xor(float (&L)[16], int mask) {
    float M[16];
#pragma unroll
    for (int i = 0; i < 16; ++i) M[i] = fmaxf(L[i], __shfl_xor(L[15 - i], mask));
#pragma unroll
    for (int s = 8; s >= 1; s >>= 1)
#pragma unroll
        for (int i = 0; i < 16; ++i) if ((i & s) == 0) { const float hi = fmaxf(M[i], M[i + s]), lo = fminf(M[i], M[i + s]); M[i] = hi; M[i + s] = lo; }
#pragma unroll
    for (int i = 0; i < 16; ++i) L[i] = M[i];
}
DI unsigned fbits(float x) { return __builtin_bit_cast(unsigned, x); }
DI float unp7(float x) { return __builtin_bit_cast(float, __builtin_bit_cast(unsigned, x) & 0xFFFFFF80u); }
constexpr int TKST = 136;
DI void topk_phase(const Ctx& C, int l, const bf16* QB, const bf16* K1B, const bf16* K2B, const int* KU, const int* KV, int* EB, float* PG) {
    LAS bf16* KL = (LAS bf16*)C.lds;
    LAS unsigned* tk = (LAS unsigned*)(C.lds + 2 * 128 * TKST * 2 + C.wave * 2048);
    const int lane = C.lane, fr = lane & 15, fq = lane >> 4, h = C.bid & 7, rank = C.bid >> 3;
#pragma unroll
    for (int i = 0; i < 8; ++i) { const int c = C.tid + 512 * i, tb = c >> 11, row = (c & 2047) >> 4, ch = c & 15;
        *(LAS u32x4*)(KL + (tb * 128 + row) * TKST + 8 * ch) = *(const u32x4*)((tb ? K2B : K1B) + ((size_t)(l * 8 + h) * 128 + row) * 128 + 8 * ch); }
    __syncthreads();
#pragma unroll 1
    for (int it = 0; it < 4; ++it) {
        const int tt0 = rank * 512 + C.wave * 64 + it * 16;
        float L[2][16];
        bf16x8 bq[2][4];
#pragma unroll
        for (int half = 0; half < 2; ++half)
#pragma unroll
            for (int ks = 0; ks < 4; ++ks) bq[half][ks] = *(const bf16x8*)(QB + (size_t)(tt0 + fr) * D + h * 256 + half * 128 + 8 * fq + 32 * ks);
#pragma unroll
        for (int half = 0; half < 2; ++half) {
            f32x4 acc[8];
#pragma unroll
            for (int mt = 0; mt < 8; ++mt) acc[mt] = (f32x4){0.f, 0.f, 0.f, 0.f};
            const LAS bf16* Kb = KL + (half * 128 + fr) * TKST + 8 * fq;
#pragma unroll
            for (int ks = 0; ks < 4; ++ks)
#pragma unroll
                for (int mt = 0; mt < 8; ++mt) { const bf16x8 a = *(const LAS bf16x8*)(Kb + (16 * mt) * TKST + 32 * ks); acc[mt] = mfma16(a, bq[half][ks], acc[mt]); }
#pragma unroll
            for (int i = 0; i < 16; ++i) L[half][i] = __builtin_bit_cast(float, 0xFF800000u);
#pragma unroll
            for (int mt = 0; mt < 8; ++mt)
#pragma unroll
                for (int r = 0; r < 4; ++r) { const unsigned key = (unsigned)(16 * mt + 4 * fq + r);
                    const float sv = acc[mt][r];
                    list_insert(L[half], __builtin_bit_cast(float, (fbits(sv) & 0xFFFFFF80u) | key)); }
            list_merge_xor(L[half], 16); list_merge_xor(L[half], 32);
        }
        if (fq == 0) {
#pragma unroll
            for (int i = 0; i < 16; ++i) { tk[(fr * 2 + 0) * 16 + i] = fbits(L[0][i]); tk[(fr * 2 + 1) * 16 + i] = fbits(L[1][i]); }
        }
        float Cn[16];
#pragma unroll
        for (int i = 0; i < 16; ++i) Cn[i] = __builtin_bit_cast(float, 0xFF800000u);
#pragma unroll
        for (int i = 0; i < 16; ++i)
#pragma unroll
            for (int j = 0; j < 16; ++j) if ((i + 1) * (j + 1) <= 16) {
                const float s = unp7(L[0][i]) + unp7(L[1][j]);
                list_insert(Cn, __builtin_bit_cast(float, (fbits(s) & 0xFFFFFF00u) | (unsigned)(i * 16 + j))); }
        LDS_WAIT();
        float sc[4]; int ex[4];
#pragma unroll
        for (int m = 0; m < 4; ++m) {
            const float ck = fq == 0 ? Cn[m] : (fq == 1 ? Cn[4 + m] : (fq == 2 ? Cn[8 + m] : Cn[12 + m]));
            const unsigned cc = fbits(ck) & 255u;
            const unsigned p1 = tk[(fr * 2 + 0) * 16 + (cc >> 4)], p2 = tk[(fr * 2 + 1) * 16 + (cc & 15u)];
            sc[m] = __builtin_bit_cast(float, p1 & 0xFFFFFF80u) + __builtin_bit_cast(float, p2 & 0xFFFFFF80u);
            ex[m] = (int)((p1 & 127u) * 128u + (p2 & 127u));
        }
        float mx = fmaxf(fmaxf(sc[0], sc[1]), fmaxf(sc[2], sc[3]));
        mx = fmaxf(mx, __shfl_xor(mx, 16)); mx = fmaxf(mx, __shfl_xor(mx, 32));
        float w[4], sum = 0.f;
#pragma unroll
        for (int m = 0; m < 4; ++m) { w[m] = fexp2((sc[m] - mx) * 1.442695041f); sum += w[m]; }
        sum += __shfl_xor(sum, 16); sum += __shfl_xor(sum, 32);
        const float inv = 1.0f / sum;
        const size_t o = (size_t)(tt0 + fr) * 128 + h * 16 + 4 * fq;
#pragma unroll
        for (int m = 0; m < 4; ++m) { const int kv = KV[ex[m]]; w[m] = w[m] * inv * __builtin_bit_cast(float, (unsigned)(127 - kv) << 23); }
        *(int4*)(EB + o) = make_int4((int)((f2bf(w[0]) << 16) | (unsigned)ex[0]), (int)((f2bf(w[1]) << 16) | (unsigned)ex[1]), (int)((f2bf(w[2]) << 16) | (unsigned)ex[2]), (int)((f2bf(w[3]) << 16) | (unsigned)ex[3]));
        LDS_WAIT();
    }
}
typedef unsigned char fp8_t;
DI void unpack16(const u32x4 q, float (&f)[16]) {
#pragma unroll
    for (int w = 0; w < 4; ++w) { const int dw = (int)q[w]; const f32x2 lo = __builtin_amdgcn_cvt_pk_f32_fp8(dw, false), hi = __builtin_amdgcn_cvt_pk_f32_fp8(dw, true);
        f[4 * w] = lo.x; f[4 * w + 1] = lo.y; f[4 * w + 2] = hi.x; f[4 * w + 3] = hi.y; }
}
DI int sdot8(int a, int b, int c) { return __builtin_amdgcn_sdot8(a, b, c, false); }
template <int CTRL> DI int dppi(int v) { return __builtin_amdgcn_update_dpp(0, v, CTRL, 0xf, 0xf, true); }
template <int CTRL, int NV> DI void bfly(int (&p)[16], const bool up) {
#pragma unroll
    for (int m = 0; m < NV / 2; ++m) { const int lo = p[m], hi = p[m + NV / 2]; const int keep = up ? hi : lo, send = up ? lo : hi; p[m] = keep + dppi<CTRL>(send); }
}
#define PU_ADD(P, LO_, HI_) (void)__hip_atomic_fetch_add((P), (long long)(((unsigned long long)(unsigned)(HI_) << 32) + (unsigned long long)(long long)(LO_)), __ATOMIC_RELAXED, __HIP_MEMORY_SCOPE_AGENT)
DI void peerU_phase(const Ctx& C, const unsigned char* H8, const float* HS, const int* EB, const unsigned char* PU4, const float* SU, int* COEF, const int emask = 0x3FFF) {
    const int x = C.bid & 7, rank = C.bid >> 3, lane = C.lane, rg = lane >> 3, c8 = lane & 7;
    const __amdgpu_buffer_rsrc_t trs = __builtin_amdgcn_make_buffer_rsrc((void*)(PU4 + (size_t)x * NEXP * 128), 0, NEXP * 128, 0x00020000);
    LAS float* su = (LAS float*)C.lds;
    {   const f32x4* src = (const f32x4*)(SU + (size_t)x * NEXP) + C.tid;
#pragma unroll
        for (int i = 0; i < 8; ++i) ((LAS f32x4*)su)[C.tid + 512 * i] = src[512 * i];
        __syncthreads(); }
    const int tbase = rank * 512 + C.wave * 64;
    long long* part = (long long*)COEF + (size_t)tbase * 64 + lane;
    const int* ebase = EB + (size_t)tbase * 128 + lane;
    const unsigned char* hbase = H8 + (size_t)tbase * 2048 + 128 * x + 16 * c8;
    const float* hsb = HS + (size_t)tbase * 8 + x;
    const int bp0 = 32 * rg, loff = 16 * c8;
    const bool b2 = (c8 & 4) != 0, b1 = (c8 & 2) != 0, b0 = (c8 & 1) != 0;
    int en0 = ebase[0] & emask, en1 = ebase[64] & emask;
    int er0 = ebase[128], er1 = ebase[192];
    u32x4 ha = *(const u32x4*)hbase, hb = *(const u32x4*)(hbase + 1024);
    float sc0 = su[en0], sc1 = su[en1], hs = hsb[0];
    u32x4 buf[16];
#pragma unroll
    for (int u = 0; u < 16; ++u) { const int e = __builtin_amdgcn_ds_bpermute(bp0 + 4 * (u >> 1), (u & 1) ? en1 : en0); buf[u] = __builtin_amdgcn_raw_buffer_load_b128(trs, e * 128 + loff, 0, 0); }
    __builtin_amdgcn_sched_barrier(0);
    en0 = er0 & emask; en1 = er1 & emask;
    int pend0 = 0, pend1 = 0; long long* pend_p = part;
#pragma unroll 1
    for (int ti = 0; ti < 64; ++ti) {
        const int tn = ti + 1 < 64 ? ti + 1 : 63, t2 = ti + 2 < 64 ? ti + 2 : 63;
        er0 = ebase[t2 * 128]; er1 = ebase[t2 * 128 + 64];
        const u32x4 han = *(const u32x4*)(hbase + (size_t)tn * 2048), hbn = *(const u32x4*)(hbase + (size_t)tn * 2048 + 1024);
        const float scn0 = su[en0], scn1 = su[en1], hsn = hsb[tn * 8];
        __builtin_amdgcn_sched_barrier(0);
        int p[16];
#pragma unroll
        for (int u0 = 0; u0 < 16; u0 += 4) {
            int en[4];
#pragma unroll
            for (int u = u0; u < u0 + 4; ++u) en[u - u0] = __builtin_amdgcn_ds_bpermute(bp0 + 4 * (u >> 1), (u & 1) ? en1 : en0);
#pragma unroll
            for (int u = u0; u < u0 + 4; ++u) {
                const u32x4 r = buf[u];
                int a = sdot8((int)r.x, (int)ha.x, 0); a = sdot8((int)r.y, (int)ha.y, a); a = sdot8((int)r.z, (int)ha.z, a); a = sdot8((int)r.w, (int)ha.w, a);
                int b = sdot8((int)r.x, (int)hb.x, 0); b = sdot8((int)r.y, (int)hb.y, b); b = sdot8((int)r.z, (int)hb.z, b); b = sdot8((int)r.w, (int)hb.w, b);
                p[u] = (a << 4) + b; }
            asm volatile("" : "+v"(p[u0]), "+v"(p[u0 + 1]), "+v"(p[u0 + 2]), "+v"(p[u0 + 3]) :: "memory");
#pragma unroll
            for (int u = u0; u < u0 + 4; ++u) buf[u] = __builtin_amdgcn_raw_buffer_load_b128(trs, en[u - u0] * 128 + loff, 0, 0);
            if (u0 == 4) PU_ADD(pend_p, pend0, pend1);
            __builtin_amdgcn_sched_barrier(0);
        }
        bfly<0x141, 16>(p, b2);
        bfly<0x4E, 8>(p, b1);
        bfly<0xB1, 4>(p, b0);
        pend0 = (int)__builtin_rintf(fminf(fmaxf((float)p[0] * (sc0 * hs * 16384.0f), -2.0e9f), 2.0e9f)); pend1 = (int)__builtin_rintf(fminf(fmaxf((float)p[1] * (sc1 * hs * 16384.0f), -2.0e9f), 2.0e9f)); pend_p = part + (size_t)ti * 64;
        asm volatile("" : "+v"(er0), "+v"(er1) :: "memory");
        en0 = er0 & emask; en1 = er1 & emask; ha = han; hb = hbn; sc0 = scn0; sc1 = scn1; hs = hsn;
    }
    PU_ADD(pend_p, pend0, pend1);
#undef PU_ADD
}
typedef long i64_t;
constexpr int PV_BLK = 272;
DI void peerV_phase(const Ctx& C, const int* EB, const int* COEF, const fp8_t* PV8, bf16* X, const float* gate  , const int emask = 0x3FFF, const long wdelta = 0  ) {
    const int x = C.bid & 7, rank = C.bid >> 3, lane = C.lane, g = lane >> 4, i16 = lane & 15;
    const __amdgpu_buffer_rsrc_t trs = __builtin_amdgcn_make_buffer_rsrc((void*)(PV8 + (size_t)x * NEXP * 256), 0, NEXP * 256, 0x00020000);
    const int tbase = rank * 512 + C.wave * 64;
    ldsp wl = C.lds + C.wave * (8 * PV_BLK);
    const int wr_off = g * PV_BLK + 16 * i16;
    const int rd_off = ((((lane >> 1) & 1) * 4) + (lane & 1)) * PV_BLK + 16 * (lane >> 2);
    const int bp0 = 64 * g, loff = 16 * i16;
    const int ash = (i16 < 8) ? 24 : 16, asl = 8 * (i16 & 3); const unsigned amlo = (i16 & 4) ? 0u : 0xFFFFFFFFu, amhi = ~amlo;
    const int* ebase = EB + (size_t)tbase * 128 + lane; const long long* pbase = (const long long*)COEF + (size_t)tbase * 64 + lane;
    const int col = 256 * x + 4 * lane;
    const f32x4 gt = *(const f32x4*)(gate + (size_t)(tbase >> 12) * MODW + col);
    long long pcc;
#define PV_LOAD_RAW(tt) do { pcc = pbase[(tt) * 64]; } while (0)
#define PV_PACK(PK0, PK1, INVA, GW0, GW1, ID0, ID1) do { const float rg0 = __builtin_bit_cast(float, (unsigned)(GW0) & 0xffff0000u), rg1 = __builtin_bit_cast(float, (unsigned)(GW1) & 0xffff0000u); const int pc0 = (int)(unsigned)(unsigned long long)pcc, pc1 = (int)((pcc - (long long)pc0) >> 32); const float s0_ = (float)pc0 * (1.0f / 16384.0f), s1_ = (float)pc1 * (1.0f / 16384.0f); \
        const float a0_ = gelu_t(s0_) * rg0, a1_ = gelu_t(s1_) * rg1; const float amax_ = wave_max_u(fmaxf(fabsf(a0_), fabsf(a1_))); \
        int ka_ = 0; if (amax_ > 0.f) { ka_ = (int)((__builtin_bit_cast(unsigned, 224.0f / amax_) >> 23) & 255u) - 127; ka_ = ka_ < -100 ? -100 : (ka_ > 100 ? 100 : ka_); } \
        const float sca_ = __builtin_bit_cast(float, (unsigned)(ka_ + 127) << 23); INVA = __builtin_bit_cast(float, (unsigned)(127 - ka_) << 23); \
        const float h0_ = a0_ * sca_, h1_ = a1_ * sca_; const int ph_ = __builtin_amdgcn_cvt_pk_fp8_f32(h0_, h1_, 0, false); const f32x2 bk_ = __builtin_amdgcn_cvt_pk_f32_fp8(ph_, false); \
        const int pl_ = __builtin_amdgcn_cvt_pk_fp8_f32((h0_ - bk_.x) * 16.0f, (h1_ - bk_.y) * 16.0f, 0, false); \
        PK0 = (int)(((unsigned)(ph_ & 255) << 24) | ((unsigned)(pl_ & 255) << 16) | (unsigned)(ID0)); PK1 = (int)(((unsigned)(ph_ & 0xFF00) << 16) | ((unsigned)(pl_ & 0xFF00) << 8) | (unsigned)(ID1)); } while (0)
    int eg0 = ebase[0], eg1 = ebase[64];
    int er0 = ebase[128], er1 = ebase[192];
    const int e0 = eg0 & emask, e1 = eg1 & emask;
    PV_LOAD_RAW(0);
    u32x2* xp0 = (u32x2*)(X + (size_t)tbase * D + col);
    u32x2 xpend = *xp0; u32x2* xpend_p = (u32x2*)((bf16*)xp0 + wdelta);
    u32x4 buf[32];
#pragma unroll
    for (int u = 0; u < 32; ++u) { const int e = __builtin_amdgcn_ds_bpermute(bp0 + 4 * (u & 15), u < 16 ? e0 : e1); buf[u] = __builtin_amdgcn_raw_buffer_load_b128(trs, e * 256 + loff, 0, 0); }
    __builtin_amdgcn_sched_barrier(0);
    int pk0, pk1; float inva;
    PV_PACK(pk0, pk1, inva, eg0, eg1, er0 & emask, er1 & emask);
    eg0 = er0; eg1 = er1;
#pragma unroll 1
    for (int ti = 0; ti < 64; ++ti) {
        const int tn = ti + 1 < 64 ? ti + 1 : 63, t2 = ti + 2 < 64 ? ti + 2 : 63;
        er0 = ebase[t2 * 128]; er1 = ebase[t2 * 128 + 64];
        PV_LOAD_RAW(tn);
        u32x2* xp = (u32x2*)(X + (size_t)(tbase + ti) * D + col);
        const u32x2 xold = *xp;
        __builtin_amdgcn_sched_barrier(0);
        f32x4 d0 = (f32x4){0.f, 0.f, 0.f, 0.f}, d1 = d0;
#pragma unroll
        for (int u0 = 0; u0 < 32; u0 += 4) {
            int w[4];
#pragma unroll
            for (int u = u0; u < u0 + 4; ++u) w[u - u0] = __builtin_amdgcn_ds_bpermute(bp0 + 4 * (u & 15), u < 16 ? pk0 : pk1);
#pragma unroll
            for (int u = u0; u < u0 + 4; ++u) {
                const u32x4 r = buf[u]; const unsigned ab = (((unsigned)w[u - u0] >> ash) & 255u) << asl;
                const i64_t av = (i64_t)(((unsigned long long)(ab & amhi) << 32) | (ab & amlo));
                d0 = __builtin_amdgcn_mfma_f32_16x16x32_fp8_fp8(av, (i64_t)(((unsigned long long)r.y << 32) | r.x), d0, 0, 0, 0);
                d1 = __builtin_amdgcn_mfma_f32_16x16x32_fp8_fp8(av, (i64_t)(((unsigned long long)r.w << 32) | r.z), d1, 0, 0, 0); }
            asm volatile("" : "+v"(d0), "+v"(d1) :: "memory");
#pragma unroll
            for (int u = u0; u < u0 + 4; ++u) buf[u] = __builtin_amdgcn_raw_buffer_load_b128(trs, ((w[u - u0] & 0x3FFF) << 8) + loff, 0, 0);
            if (u0 == 12) *xpend_p = xpend;
            __builtin_amdgcn_sched_barrier(0);
        }
        *(LAS f32x4*)(wl + wr_off) = d0; *(LAS f32x4*)(wl + wr_off + 4 * PV_BLK) = d1;
        const f32x4 yh = *(const LAS f32x4*)(wl + rd_off), yl = *(const LAS f32x4*)(wl + rd_off + 2 * PV_BLK);
        const f32x4 y = (yh + yl * 0.0625f) * inva;
        {   const f32x4 xn = (f32x4){bflo(xold.x), bfhi(xold.x), bflo(xold.y), bfhi(xold.y)} + gt * y; xpend.x = pk2(xn.x, xn.y); xpend.y = pk2(xn.z, xn.w); }
        xpend_p = (u32x2*)((bf16*)xp + wdelta);
        asm volatile("" : "+v"(er0), "+v"(er1) :: "memory");
        PV_PACK(pk0, pk1, inva, eg0, eg1, er0 & emask, er1 & emask);
        eg0 = er0; eg1 = er1;
    }
    *xpend_p = xpend;
#undef PV_LOAD_RAW
#undef PV_PACK
}
DI void final_norm_phase(const Ctx& C, const bf16* XBp, float* OUT, const float* g) {
    const int r0 = C.gw * 8;
    f32x4 gm[8];
#pragma unroll
    for (int j = 0; j < 8; ++j) gm[j] = ((const f32x4*)g)[64 * j + C.lane];
#pragma unroll 1
    for (int i = 0; i < 8; ++i) {
        const u32x2* xr = (const u32x2*)(XBp + (size_t)(r0 + i) * D) + C.lane; f32x4* orow = (f32x4*)(OUT + (size_t)(r0 + i) * D) + C.lane; f32x4 v[8]; float s = 0.f;
#pragma unroll
        for (int j = 0; j < 8; ++j) { const u32x2 w = xr[64 * j]; v[j] = (f32x4){bflo(w.x), bfhi(w.x), bflo(w.y), bfhi(w.y)}; s += (v[j].x * v[j].x + v[j].y * v[j].y) + (v[j].z * v[j].z + v[j].w * v[j].w); }
        const float rstd = frsq(wave_sum(s) * (1.f / D) + EPS);
#pragma unroll
        for (int j = 0; j < 8; ++j) orow[64 * j] = v[j] * rstd * gm[j];
    }
}
#ifndef PH_MASK
#define PH_MASK 0xFFFFF
#endif
#define EN(k) (((PH_MASK) >> (k)) & 1)
#ifndef GEMM_SP2
#define GEMM_SP2 true
#endif
#ifndef GEMM_ALIGN
#define GEMM_ALIGN false
#endif
constexpr int NKIND = 11, NPH = 2 + 2 * NKIND;
struct Args { const float* in[21]; float* out; unsigned char* ws; int ph_lo, ph_hi, pad0, pad1; };
__global__ void __launch_bounds__(NTHR, 2) mk_fwd(Args args) {
    extern __shared__ __attribute__((aligned(16))) unsigned char lds_raw[];
    ldsp ldsb = (ldsp)lds_raw;
    volatile LAS unsigned* MISC = (volatile LAS unsigned*)(ldsb + MISC_OFF);
    for (int u = threadIdx.x; u < (LDS_BYTES - LDSCTL_OFF) / 4; u += NTHR) ((LAS unsigned*)(ldsb + LDSCTL_OFF))[u] = 0u;
    __syncthreads();
    unsigned* barw = (unsigned*)(args.ws + WS_CTL) + CW_BAR;
    XcdBarrier bar; bar.bar = barw; bar.x = 0; bar.st = nullptr;
    const bool multi = (args.ph_hi - args.ph_lo) > 1;
    if (multi) bar = xcd_barrier_post(barw, MISC + 8);

#pragma unroll 1
    for (int ph = args.ph_lo; ph < args.ph_hi; ++ph) {
#define MKCTX Ctx C; { int tid_ = threadIdx.x, bid_ = blockIdx.x; asm volatile("" : "+v"(tid_)); asm volatile("" : "+s"(bid_)); \
        C.lds = ldsb; C.tid = tid_; C.lane = tid_ & 63; C.wave = __builtin_amdgcn_readfirstlane(tid_ >> 6); C.bid = bid_; C.G = gridDim.x; C.gw = C.bid * NWAVES + C.wave; C.NGW = C.G * NWAVES; \
        C.ws = args.ws; }
        unsigned char* const wsb = args.ws;
        float* MOD = (float*)(wsb + WS_MOD);
        bf16* Hb = (bf16*)(wsb + WS_H); bf16* PROJ = (bf16*)(wsb + WS_PROJ); bf16* SBUF = (bf16*)(wsb + WS_SBUF); bf16* CONCAT = (bf16*)(wsb + WS_CONCAT); bf16* QB = (bf16*)(wsb + WS_QB);
        float* ALOW = (float*)(wsb + WS_ALOW); float* DEC = (float*)(wsb + WS_DEC); int* EB = (int*)(wsb + WS_EB); float* PG = (float*)(wsb + WS_PG);
        bf16* X = (bf16*)(wsb + WS_XB);
        const int l = ph < 2 ? 0 : (ph - 2) / NKIND, kind = ph < 2 ? -1 : (ph - 2) % NKIND;
        const float* modl = MOD + (size_t)l * 4 * MODW;
        if (ph == 0) { if (EN(0)) { MKCTX; p0_prologue(C); } }
        else if (ph == 1) { if (EN(1)) { MKCTX; norm_phase(C, KARG(I_X), KARG(I_N1G), modl, 0, D, Hb); } }
        else if ((kind == 0 || kind == 6) && EN(2)) {
            MKCTX; const bool isq = (kind == 6);
            pg8::Gemm g{Hb, isq ? (const bf16*)(wsb + WS_WTQ) + (size_t)l * D * D : (const bf16*)(wsb + WS_WTIN) + (size_t)l * WTIN_L, T, isq ? D : NPROJ, D};
            pg8::StaticOrder S; S.init(T, g.N, C.G, C.bid);
            pg8::EpiBf16 E{isq ? QB : PROJ, isq ? D : NPROJ};
            pg8::gemm_phase<pg8::EpiBf16, pg8::StaticOrder, GEMM_ALIGN, GEMM_SP2>(C.lds, g, S, E, C.tid);
            if (!isq) alow_phase(C, Hb, (const bf16*)(wsb + WS_WTIN) + (size_t)l * WTIN_L + (size_t)NPROJ * D, ALOW);
        }
        else if (kind == 1 && EN(3)) {
            MKCTX;
            glaA_phase(C, l, PROJ, ALOW, SBUF, DEC);
            gmlp_phase(C, l, PROJ, (const bf16*)(wsb + WS_WSB), CONCAT);
        }
        else if (kind == 2) { if (EN(4)) { MKCTX; scan_phase(C, SBUF, DEC); } }
        else if (kind == 3 && EN(5)) { MKCTX; glaC_phase(C, l, PROJ, ALOW, SBUF, CONCAT); }
        else if (kind == 4 && EN(6)) {
            MKCTX;
            pg8::Gemm g{CONCAT, (const bf16*)(wsb + WS_WTOUT) + (size_t)l * D * D, T, D, D};
            pg8::StaticOrder S; S.init(T, D, C.G, C.bid);
            pg8::EpiResGate E{l == 0 ? KARG(I_X) : (const float*)nullptr, X, X, modl + 2 * D, MODW};
            pg8::gemm_phase<pg8::EpiResGate, pg8::StaticOrder, GEMM_ALIGN, GEMM_SP2>(C.lds, g, S, E, C.tid);
        }
        else if (kind == 5) { if (EN(1)) { MKCTX; norm_phase<true, true>(C, X, KARG(I_N2G) + (size_t)l * D, modl, 3 * D, 4 * D, Hb, wsb + WS_H8, (float*)(wsb + WS_HS), (int*)(wsb + WS_COEF)); } }
        else if (kind == 7) { if (EN(7)) { MKCTX; topk_phase(C, l, QB, (const bf16*)(wsb + WS_K1B), (const bf16*)(wsb + WS_K2B), (const int*)(wsb + WS_KU) + l * NEXP, (const int*)(wsb + WS_KV) + l * NEXP, EB, PG); } }
        else if (kind == 8) { if (EN(8)) { MKCTX; peerU_phase(C, wsb + WS_H8, (const float*)(wsb + WS_HS), EB, wsb + WS_PUB + (size_t)l * NEXP * (D / 2), (const float*)(wsb + WS_SU) + (size_t)l * 8 * NEXP, (int*)(wsb + WS_COEF)); } }
        else if (kind == 9) { if (EN(9)) { MKCTX; peerV_phase(C, EB, (const int*)(wsb + WS_COEF), (const fp8_t*)(wsb + WS_PVB) + (size_t)l * NEXP * D, X, modl + 5 * D); } }
        else if (EN(10)) {
            MKCTX;
            if (l == DEPTH - 1) final_norm_phase(C, X, args.out, KARG(I_FG));
            else norm_phase<false, true>(C, X, KARG(I_N1G) + (size_t)(l + 1) * D, MOD + (size_t)(l + 1) * 4 * MODW, 0, D, Hb);
        }
        if (ph + 1 < args.ph_hi) xcd_barrier(bar);
    }
}

extern "C" void kernel_launch(void* const* d_in, const int* in_sizes, int n_in, void* d_out, int out_size, void* d_ws, size_t ws_size, hipStream_t stream) {
    static int grid = 0;
    if (grid == 0) {
        if (n_in != 21 || out_size != T * D || ws_size < WS_END) { fprintf(stderr, "kernel_launch: unexpected shapes (n_in %d, out %d, ws %zu)\n", n_in, out_size, ws_size); grid = -1; return; }
        int dev = 0, cus = 0, per_cu = 0;
        if (hipGetDevice(&dev) != hipSuccess || hipDeviceGetAttribute(&cus, hipDeviceAttributeMultiprocessorCount, dev) != hipSuccess) { grid = -1; return; }
        if (hipFuncSetAttribute((const void*)mk_fwd, hipFuncAttributeMaxDynamicSharedMemorySize, LDS_BYTES) != hipSuccess) { fprintf(stderr, "kernel_launch: hipFuncSetAttribute failed\n"); grid = -1; return; }
        if (hipOccupancyMaxActiveBlocksPerMultiprocessor(&per_cu, (const void*)mk_fwd, NTHR, LDS_BYTES) != hipSuccess || per_cu < 1) { fprintf(stderr, "kernel_launch: occupancy query says %d blocks per CU\n", per_cu); (void)hipGetLastError(); grid = -1; return; }
        if (cus != 256) { fprintf(stderr, "kernel_launch: built for a 256-CU device (got %d)\n", cus); grid = -1; return; }
        grid = cus;
    }
    if (grid < 0) return;
    (void)hipMemsetAsync((char*)d_ws + WS_CTL, 0, CTL_ZERO_BYTES, stream);
    Args a{};
    for (int i = 0; i < 21; ++i) a.in[i] = (const float*)d_in[i];
    a.out = (float*)d_out; a.ws = (unsigned char*)d_ws;
#if MK_N_LAUNCHES == 1
    a.ph_lo = 0; a.ph_hi = NPH;
    hipLaunchKernelGGL(mk_fwd, dim3(grid), dim3(NTHR), LDS_BYTES, stream, a);
#else
    for (int p = 0; p < NPH; ++p) { a.ph_lo = p; a.ph_hi = p + 1; hipLaunchKernelGGL(mk_fwd, dim3(grid), dim3(NTHR), LDS_BYTES, stream, a); }
#endif
}
```

```cpp
#include <hip/hip_runtime.h>
#include <cstdio>
#include <cstdint>
#ifndef MK_N_LAUNCHES
#define MK_N_LAUNCHES 1
#endif
namespace pg8 {
#define PG8_LAS __attribute__((address_space(3)))
typedef unsigned short bf16_t;
typedef short bf16x8 __attribute__((ext_vector_type(8)));
typedef float f32x4 __attribute__((ext_vector_type(4)));
typedef unsigned u32x4 __attribute__((ext_vector_type(4)));
constexpr int BM = 256, BK = 64, HALF = 128, HTB = HALF * BK * 2  , STAGE_BYTES = 8 * HTB, NXCD = 8, WGM = 8;

__host__ __device__ __forceinline__ int lds_byte(int r, int c) { const int st = (r >> 4) * 2 + (c >> 5), rr = r & 15, cc = c & 31, ob = rr * 64 + cc * 2; return st * 1024 + (ob ^ (((ob >> 9) & 1) << 5)); }
__host__ __device__ __forceinline__ void stage_rc(int b, int& R, int& C) { const int st = b / 1024, sb = b % 1024, swz = sb ^ (((sb >> 9) & 1) << 5); R = (st >> 1) * 16 + swz / 64; C = (st & 1) * 32 + (swz % 64) / 2; }
__host__ __device__ __forceinline__ int perm32(int rho) { const int n = rho >> 4, i = rho & 15; return 8 * (i >> 2) + 4 * n + (i & 3); }

struct Unit { int pm, pn; };
struct Gemm { const bf16_t* A; const bf16_t* Bt; int M, N, K; };

struct StaticOrder {
    int nM, nN, nwg, G, c;
    __host__ __device__ void init(int M, int N, int G_, int c_) { nM = M / BM; nN = N / BM; nwg = nM * nN; G = G_; c = c_; }
    __host__ __device__ bool next(int i, Unit& u) const {
        const long L = (long)i * G + c; if (L >= nwg) return false;
        int wgid = (int)L; { const int q = nwg / NXCD, r = nwg % NXCD, xcd = wgid % NXCD, off = wgid / NXCD; wgid = (xcd < r ? xcd * (q + 1) : r * (q + 1) + (xcd - r) * q) + off; }
        const int nig = WGM * nN, gid = wgid / nig, fm = gid * WGM, gsz = (nM - fm) < WGM ? (nM - fm) : WGM;
        u.pm = fm + ((wgid % nig) % gsz); u.pn = (wgid % nig) / gsz; return true;
    }
    __device__ __forceinline__ void a_ready(const Unit&) const {}
    __device__ __forceinline__ void done(const Unit&) const {}
};
__device__ __forceinline__ unsigned cvt_pk_bf16(float lo, float hi) { unsigned r; asm volatile("v_cvt_pk_bf16_f32 %0, %1, %2" : "=v"(r) : "v"(lo), "v"(hi)); return r; }
struct EpiBf16 {
    static constexpr bool PERM = true, AFTER_DRAIN = false;
    bf16_t* O; int ldc;
    __device__ __forceinline__ void operator()(const f32x4 (&acc)[2][2][4][2], const Unit& u, int wr, int wc, int fr, int fq) const {
        const int row0 = u.pm * BM + wr * 64 + fr; const int col0 = u.pn * BM + wc * 32 + 8 * fq;
#pragma unroll
        for (int ai = 0; ai < 2; ++ai)
#pragma unroll
            for (int m = 0; m < 4; ++m) { bf16_t* rowp = O + (size_t)(row0 + ai * HALF + m * 16) * ldc + col0;
#pragma unroll
                for (int bj = 0; bj < 2; ++bj) { const f32x4 v0 = acc[ai][bj][m][0], v1 = acc[ai][bj][m][1];
                    u32x4 w; w.x = cvt_pk_bf16(v0[0], v0[1]); w.y = cvt_pk_bf16(v0[2], v0[3]); w.z = cvt_pk_bf16(v1[0], v1[1]); w.w = cvt_pk_bf16(v1[2], v1[3]);
                    *(u32x4*)(rowp + bj * HALF) = w; } }
    }
};
struct EpiResGate {
    static constexpr bool PERM = true, AFTER_DRAIN = false;
    const float* base32; const bf16_t* baseb; bf16_t* out; const float* gate; int gpitch;
    __device__ __forceinline__ void operator()(const f32x4 (&acc)[2][2][4][2], const Unit& u, int wr, int wc, int fr, int fq) const {
        const int row0 = u.pm * BM + wr * 64 + fr, col0 = u.pn * BM + wc * 32 + 8 * fq;
        const float* gp = gate + (size_t)(u.pm >> 4) * gpitch + col0;
        f32x4 gv[2][2];
#pragma unroll
        for (int bj = 0; bj < 2; ++bj)
#pragma unroll
            for (int n = 0; n < 2; ++n) gv[bj][n] = *(const f32x4*)(gp + bj * HALF + n * 4);
#define ERG_OFF(G_) ((size_t)(row0 + ((G_) >> 2) * HALF + ((G_) & 3) * 16) * 2048 + col0)
        if (base32) {
            f32x4 bs[2][2][2];
#define ERG_LOAD(G_) do { _Pragma("unroll") for (int bj = 0; bj < 2; ++bj) _Pragma("unroll") for (int n = 0; n < 2; ++n) bs[(G_) & 1][bj][n] = *(const f32x4*)(base32 + ERG_OFF(G_) + bj * HALF + n * 4); } while (0)
            ERG_LOAD(0); ERG_LOAD(1);
#pragma unroll
            for (int gq = 0; gq < 8; ++gq) {
#pragma unroll
                for (int bj = 0; bj < 2; ++bj) { const f32x4 v0 = bs[gq & 1][bj][0] + gv[bj][0] * acc[gq >> 2][bj][gq & 3][0], v1 = bs[gq & 1][bj][1] + gv[bj][1] * acc[gq >> 2][bj][gq & 3][1];
                    u32x4 w; w.x = cvt_pk_bf16(v0[0], v0[1]); w.y = cvt_pk_bf16(v0[2], v0[3]); w.z = cvt_pk_bf16(v1[0], v1[1]); w.w = cvt_pk_bf16(v1[2], v1[3]);
                    *(u32x4*)(out + ERG_OFF(gq) + bj * HALF) = w; }
                asm volatile("" ::: "memory");
                if (gq + 2 < 8) ERG_LOAD(gq + 2);
                asm volatile("" ::: "memory"); }
#undef ERG_LOAD
        } else {
            u32x4 bb[4][2];
#define ERG_LOADB(G_) do { _Pragma("unroll") for (int bj = 0; bj < 2; ++bj) bb[(G_) & 3][bj] = *(const u32x4*)(baseb + ERG_OFF(G_) + bj * HALF); } while (0)
            ERG_LOADB(0); ERG_LOADB(1); ERG_LOADB(2); ERG_LOADB(3);
#pragma unroll
            for (int gq = 0; gq < 8; ++gq) {
#pragma unroll
                for (int bj = 0; bj < 2; ++bj) { const u32x4 b = bb[gq & 3][bj];
                    const f32x4 b0 = (f32x4){__builtin_bit_cast(float, b.x << 16), __builtin_bit_cast(float, b.x & 0xffff0000u), __builtin_bit_cast(float, b.y << 16), __builtin_bit_cast(float, b.y & 0xffff0000u)};
                    const f32x4 b1 = (f32x4){__builtin_bit_cast(float, b.z << 16), __builtin_bit_cast(float, b.z & 0xffff0000u), __builtin_bit_cast(float, b.w << 16), __builtin_bit_cast(float, b.w & 0xffff0000u)};
                    const f32x4 v0 = b0 + gv[bj][0] * acc[gq >> 2][bj][gq & 3][0], v1 = b1 + gv[bj][1] * acc[gq >> 2][bj][gq & 3][1];
                    u32x4 w; w.x = cvt_pk_bf16(v0[0], v0[1]); w.y = cvt_pk_bf16(v0[2], v0[3]); w.z = cvt_pk_bf16(v1[0], v1[1]); w.w = cvt_pk_bf16(v1[2], v1[3]);
                    *(u32x4*)(out + ERG_OFF(gq) + bj * HALF) = w; }
                asm volatile("" ::: "memory");
                if (gq + 4 < 8) ERG_LOADB(gq + 4);
                asm volatile("" ::: "memory"); }
#undef ERG_LOADB
        }
#undef ERG_OFF
    }
};
template <class Epi, class Sched, bool ALIGN_EPI = false, bool SP2 = false>
__device__ __forceinline__ void gemm_phase(PG8_LAS unsigned char* lds, const Gemm g, const Sched& S, const Epi& E, const int tid  ) {
    const int wid = __builtin_amdgcn_readfirstlane(tid >> 6), lane = tid & 63, wr = wid >> 2, wc = wid & 3, fr = lane & 15, fq = lane >> 4;
    const int K = g.K, nt = K / BK;
    unsigned voffA[2], voffB[2];
#pragma unroll
    for (int i = 0; i < 2; ++i) { int R, C; stage_rc(tid * 16 + i * 8192, R, C); const int Rb = Epi::PERM ? ((R & ~31) + perm32(R & 31)) : R;
        voffA[i] = (unsigned)(R * K + C) * 2u; voffB[i] = (unsigned)(Rb * K + C) * 2u; }
    const size_t kstep = (size_t)(BK * 2);
    const size_t hstep = (size_t)HALF * K * 2;
    const size_t tstep = 2 * hstep;
    const unsigned ldsw = (unsigned)wid * 1024u;
    const int aoff = lds_byte(wr * 64 + fr, fq * 8), boff = lds_byte(wc * 32 + fr, fq * 8);
#define PG8_SA(b, h) (((b) * 2 + (h)) * HTB)
#define PG8_SB(b, h) ((4 + (b) * 2 + (h)) * HTB)
#define PG8_STAGE(bufoff, gbase, voff) do { _Pragma("unroll") for (int _i = 0; _i < 2; ++_i) \
        __builtin_amdgcn_global_load_lds((const unsigned*)((const char*)(gbase) + (voff)[_i]), (PG8_LAS unsigned*)(lds + (bufoff) + ldsw + _i * 8192), 16, 0, 0); } while (0)
#define PG8_LDA(dst, b, h) do { _Pragma("unroll") for (int m = 0; m < 4; ++m) _Pragma("unroll") for (int k = 0; k < 2; ++k) dst[m][k] = *(const PG8_LAS bf16x8*)(lds + PG8_SA(b, h) + aoff + m * 2048 + k * 1024); } while (0)
#define PG8_LDB(dst, b, h) do { _Pragma("unroll") for (int n = 0; n < 2; ++n) _Pragma("unroll") for (int k = 0; k < 2; ++k) dst[n][k] = *(const PG8_LAS bf16x8*)(lds + PG8_SB(b, h) + boff + n * 2048 + k * 1024); } while (0)
#define PG8_MMA(ai, bj, At, Bt) do { __builtin_amdgcn_s_setprio(1); _Pragma("unroll") for (int m = 0; m < 4; ++m) _Pragma("unroll") for (int n = 0; n < 2; ++n) _Pragma("unroll") for (int k = 0; k < 2; ++k) \
        acc[ai][bj][m][n] = __builtin_amdgcn_mfma_f32_16x16x32_bf16(Bt[n][k], At[m][k], acc[ai][bj][m][n], 0, 0, 0); __builtin_amdgcn_s_setprio(0); } while (0)
#define PG8_WAIT_V(n) asm volatile("s_waitcnt vmcnt(" #n ")" ::: "memory")
#define PG8_WAIT_L(n) asm volatile("s_waitcnt lgkmcnt(" #n ")" ::: "memory")
#define PG8_BAR __builtin_amdgcn_s_barrier()
#define PG8_SCHED __builtin_amdgcn_sched_barrier(0)
    Unit cur, nxt; int ui = 0;
    if (!S.next(0, cur)) return;
    f32x4 acc[2][2][4][2];
#pragma unroll
    for (int a = 0; a < 2; ++a)
#pragma unroll
        for (int b = 0; b < 2; ++b)
#pragma unroll
            for (int m = 0; m < 4; ++m)
#pragma unroll
                for (int n = 0; n < 2; ++n) acc[a][b][m][n] = (f32x4){0.f, 0.f, 0.f, 0.f};
    bf16x8 At[4][2], B0[2][2], B1[2][2];
    const char* cA = (const char*)g.A + (size_t)cur.pm * tstep; const char* cB = (const char*)g.Bt + (size_t)cur.pn * tstep;
    S.a_ready(cur);
    if constexpr (SP2) {
        PG8_STAGE(PG8_SB(0, 0), cB, voffB); PG8_STAGE(PG8_SB(0, 1), cB + hstep, voffB); PG8_STAGE(PG8_SA(0, 0), cA, voffA); PG8_STAGE(PG8_SA(0, 1), cA + hstep, voffA);
        if (wr == 1) PG8_BAR;
        PG8_WAIT_V(2); PG8_BAR;
        PG8_STAGE(PG8_SB(1, 0), cB + kstep, voffB); PG8_STAGE(PG8_SA(1, 0), cA + kstep, voffA); PG8_STAGE(PG8_SB(1, 1), cB + hstep + kstep, voffB);
        PG8_WAIT_V(6); PG8_BAR;
    } else {
        PG8_STAGE(PG8_SB(0, 0), cB, voffB); PG8_STAGE(PG8_SA(0, 0), cA, voffA); PG8_STAGE(PG8_SB(0, 1), cB + hstep, voffB); PG8_STAGE(PG8_SA(0, 1), cA + hstep, voffA);
        if (wr == 1) PG8_BAR;
        PG8_WAIT_V(4); PG8_BAR;
        PG8_STAGE(PG8_SB(1, 0), cB + kstep, voffB); PG8_STAGE(PG8_SA(1, 0), cA + kstep, voffA); PG8_STAGE(PG8_SB(1, 1), cB + hstep + kstep, voffB);
        PG8_WAIT_V(6); PG8_BAR;
    }
    for (;;) {
        const bool has_next = S.next(ui + 1, nxt);
        const char* nA = has_next ? (const char*)g.A + (size_t)nxt.pm * tstep : cA; const char* nB = has_next ? (const char*)g.Bt + (size_t)nxt.pn * tstep : cB;
        for (int t = 0; t < nt; t += 2) {
            const bool last = (t == nt - 2);
            const char* a1 = cA + (size_t)(t + 1) * kstep;
            const char* a2 = last ? nA : cA + (size_t)(t + 2) * kstep; const char* b2 = last ? nB : cB + (size_t)(t + 2) * kstep;
            const char* a3 = a2 + kstep; const char* b3 = b2 + kstep;
            if (last && has_next) S.a_ready(nxt);
            if constexpr (SP2) {
            PG8_LDB(B0, 0, 0); PG8_LDB(B1, 0, 1); PG8_SCHED; PG8_LDA(At, 0, 0); PG8_STAGE(PG8_SA(1, 1), a1 + hstep, voffA);
            PG8_WAIT_V(8); PG8_WAIT_L(0); PG8_BAR; PG8_MMA(0, 0, At, B0); PG8_MMA(0, 1, At, B1); PG8_BAR; PG8_SCHED;
            PG8_LDA(At, 0, 1); PG8_STAGE(PG8_SB(0, 0), b2, voffB); PG8_STAGE(PG8_SB(0, 1), b2 + hstep, voffB); PG8_STAGE(PG8_SA(0, 0), a2, voffA);
            PG8_WAIT_V(8); PG8_WAIT_L(0); PG8_BAR; PG8_MMA(1, 0, At, B0); PG8_MMA(1, 1, At, B1); PG8_BAR; PG8_SCHED;
            PG8_LDB(B0, 1, 0); PG8_LDB(B1, 1, 1); PG8_SCHED; PG8_LDA(At, 1, 0); PG8_STAGE(PG8_SA(0, 1), a2 + hstep, voffA);
            PG8_WAIT_V(8); PG8_WAIT_L(0); PG8_BAR; PG8_MMA(0, 0, At, B0); PG8_MMA(0, 1, At, B1); PG8_BAR; PG8_SCHED;
            PG8_LDA(At, 1, 1); PG8_STAGE(PG8_SB(1, 0), b3, voffB); PG8_STAGE(PG8_SB(1, 1), b3 + hstep, voffB); PG8_STAGE(PG8_SA(1, 0), a3, voffA);
            PG8_WAIT_V(8); PG8_WAIT_L(0); PG8_BAR; PG8_MMA(1, 0, At, B0); PG8_MMA(1, 1, At, B1); PG8_BAR; PG8_SCHED;
            } else {
            PG8_LDB(B0, 0, 0); PG8_SCHED; PG8_LDA(At, 0, 0); PG8_STAGE(PG8_SA(1, 1), a1 + hstep, voffA);
            PG8_WAIT_L(8); PG8_BAR; PG8_WAIT_L(0); PG8_MMA(0, 0, At, B0); PG8_BAR; PG8_SCHED;
            PG8_LDB(B1, 0, 1); PG8_STAGE(PG8_SB(0, 0), b2, voffB);
            PG8_BAR; PG8_WAIT_L(0); PG8_MMA(0, 1, At, B1); PG8_BAR;
            PG8_LDA(At, 0, 1); PG8_STAGE(PG8_SA(0, 0), a2, voffA);
            PG8_BAR; PG8_WAIT_L(0); PG8_MMA(1, 0, At, B0); PG8_BAR; PG8_SCHED;
            PG8_STAGE(PG8_SB(0, 1), b2 + hstep, voffB);
            PG8_WAIT_V(6); PG8_BAR; PG8_MMA(1, 1, At, B1); PG8_BAR;
            PG8_LDB(B0, 1, 0); PG8_SCHED; PG8_LDA(At, 1, 0); PG8_STAGE(PG8_SA(0, 1), a2 + hstep, voffA);
            PG8_WAIT_L(8); PG8_BAR; PG8_WAIT_L(0); PG8_MMA(0, 0, At, B0); PG8_BAR; PG8_SCHED;
            PG8_LDB(B1, 1, 1); PG8_STAGE(PG8_SB(1, 0), b3, voffB);
            PG8_BAR; PG8_WAIT_L(0); PG8_MMA(0, 1, At, B1); PG8_BAR;
            PG8_LDA(At, 1, 1); PG8_STAGE(PG8_SA(1, 0), a3, voffA);
            PG8_BAR; PG8_WAIT_L(0); PG8_MMA(1, 0, At, B0); PG8_BAR; PG8_SCHED;
            PG8_STAGE(PG8_SB(1, 1), b3 + hstep, voffB);
            PG8_WAIT_V(6); PG8_BAR; PG8_MMA(1, 1, At, B1); PG8_BAR;
            }
        }
        if constexpr (ALIGN_EPI) { if (wr == 0) PG8_BAR; }
        if constexpr (!Epi::AFTER_DRAIN) { E(acc, cur, wr, wc, fr, fq); S.done(cur); }
        if (!has_next) break;
#pragma unroll
        for (int a = 0; a < 2; ++a)
#pragma unroll
            for (int b = 0; b < 2; ++b)
#pragma unroll
                for (int m = 0; m < 4; ++m)
#pragma unroll
                    for (int n = 0; n < 2; ++n) acc[a][b][m][n] = (f32x4){0.f, 0.f, 0.f, 0.f};
        cur = nxt; cA = nA; cB = nB; ++ui;
        if constexpr (ALIGN_EPI) { if (wr == 1) PG8_BAR; }
    }
    PG8_WAIT_V(0);
    if constexpr (!ALIGN_EPI) { if (wr == 0) PG8_BAR; }
    PG8_BAR;
    if constexpr (Epi::AFTER_DRAIN) { E.fused(acc, cur, wr, wc, fr, fq, lds, wid, lane); S.done(cur); }
#undef PG8_SA
#undef PG8_SB
#undef PG8_STAGE
#undef PG8_LDA
#undef PG8_LDB
#undef PG8_MMA
#undef PG8_WAIT_V
#undef PG8_WAIT_L
#undef PG8_BAR
#undef PG8_SCHED
}
}
constexpr int NWAVES = 8, NTHR = 512;
constexpr int D = 2048, NBATCH = 4, SEQ = 4096, T = NBATCH * SEQ, DEPTH = 2;
constexpr int GLA_H = 4, GLA_DK = 128, GLA_DV = 256, GLA_CH = 64;
constexpr int MLP_H = 8, MLP_DH = 128, MLP_CH = 128;
constexpr int IN_COLS = 5136, NPROJ = 5120;
constexpr int C_Q = 0, C_K = 512, C_V = 1024, C_R = 2048, C_U = 3072, C_VS = 4096;
constexpr int NEXP = 16384, PEER_H = 8;
constexpr float EPS = 1e-6f;
constexpr int MODW = 6 * D;
constexpr size_t MiB = 1u << 20;
constexpr size_t WS_CTL = 0, CTL_ZERO_BYTES = 32768;
constexpr size_t WS_MOD = 1 * MiB;
constexpr size_t WS_K1B = 2 * MiB, WS_K2B = 2 * MiB + 512 * 1024, WS_WSB = 3 * MiB, WS_DEC = 3 * MiB + 512 * 1024, WS_ALOW = 4 * MiB;
constexpr size_t WS_KU = 5 * MiB, WS_KV = 5 * MiB + 256 * 1024;
constexpr size_t WS_SU = 6 * MiB, WS_HS = 7 * MiB;
constexpr size_t WS_WTIN = 8 * MiB;
constexpr size_t WTIN_L = (size_t)5136 * 2048;
constexpr size_t WS_WTOUT = 49 * MiB, WS_WTQ = 65 * MiB;
constexpr size_t WS_PUB = 81 * MiB, WS_PVB = 209 * MiB;
constexpr size_t WS_H = 337 * MiB;
constexpr size_t WS_PROJ = 401 * MiB;
constexpr size_t WS_SBUF = 561 * MiB;
constexpr size_t WS_CONCAT = 625 * MiB;
constexpr size_t WS_QB = 689 * MiB;
constexpr size_t WS_EB = 753 * MiB, WS_PG = 761 * MiB;
constexpr size_t WS_H8 = 769 * MiB, WS_COEF = 833 * MiB, WS_XB = 841 * MiB, WS_END = 905 * MiB;
static_assert(WS_WTIN + 2 * WTIN_L * 2 <= WS_WTOUT, "ws map");
constexpr int CW_BAR = 4096;
constexpr int RING_BYTES = 131072, LDSCTL_OFF = RING_BYTES, MISC_OFF = LDSCTL_OFF + 320, LDS_BYTES = 147456;

#define DI __device__ __forceinline__
#define LAS __attribute__((address_space(3)))
typedef unsigned short bf16;
typedef short bf16x8 __attribute__((ext_vector_type(8)));
typedef short s16x4 __attribute__((ext_vector_type(4)));
typedef short v4i16_t __attribute__((ext_vector_type(4)));
typedef __bf16 bf16x2_t __attribute__((ext_vector_type(2)));
typedef float f32x2_e __attribute__((ext_vector_type(2)));
typedef float f32x4 __attribute__((ext_vector_type(4)));
typedef float f32x2 __attribute__((ext_vector_type(2)));
typedef unsigned u32x4 __attribute__((ext_vector_type(4)));
typedef unsigned u32x2 __attribute__((ext_vector_type(2)));
typedef LAS unsigned char* ldsp;

DI unsigned pk2(float lo, float hi) { const f32x2_e v = {lo, hi}; return __builtin_bit_cast(unsigned, __builtin_convertvector(v, bf16x2_t)); }
DI unsigned f2bf(float f) { return pk2(f, 0.f) & 0xffffu; }
DI float bflo(unsigned u) { return __builtin_bit_cast(float, u << 16); }
DI float bfhi(unsigned u) { return __builtin_bit_cast(float, u & 0xffff0000u); }
DI float bf1(bf16 v) { return __builtin_bit_cast(float, ((unsigned)v) << 16); }
DI float fexp2(float x) { return __builtin_amdgcn_exp2f(x); }
DI float flog2(float x) { return __builtin_amdgcn_logf(x); }
DI float frcp(float x) { return __builtin_amdgcn_rcpf(x); }
DI float frsq(float x) { return __builtin_amdgcn_rsqf(x); }
DI float gelu_t(float x) { const float u = 0.7978845608f * (x + 0.044715f * x * x * x); return x * frcp(1.f + fexp2(-2.885390082f * u)); }
DI float silu_f(float x) { return x * frcp(1.f + fexp2(-1.442695041f * x)); }
template <int CTRL> DI float dppf(float v) { return __builtin_bit_cast(float, __builtin_amdgcn_update_dpp(0, __builtin_bit_cast(int, v), CTRL, 0xf, 0xf, true)); }
DI float wave_sum_u(float v) {
    v += dppf<0xB1>(v); v += dppf<0x4E>(v); v += dppf<0x141>(v); v += dppf<0x140>(v);
    const int iv = __builtin_bit_cast(int, v);
    return (__builtin_bit_cast(float, __builtin_amdgcn_readlane(iv, 0)) + __builtin_bit_cast(float, __builtin_amdgcn_readlane(iv, 16))) +
           (__builtin_bit_cast(float, __builtin_amdgcn_readlane(iv, 32)) + __builtin_bit_cast(float, __builtin_amdgcn_readlane(iv, 48)));
}
DI float wave_max_u(float v) {
    v = fmaxf(v, dppf<0xB1>(v)); v = fmaxf(v, dppf<0x4E>(v)); v = fmaxf(v, dppf<0x141>(v)); v = fmaxf(v, dppf<0x140>(v));
    const int iv = __builtin_bit_cast(int, v);
    return fmaxf(fmaxf(__builtin_bit_cast(float, __builtin_amdgcn_readlane(iv, 0)), __builtin_bit_cast(float, __builtin_amdgcn_readlane(iv, 16))),
                 fmaxf(__builtin_bit_cast(float, __builtin_amdgcn_readlane(iv, 32)), __builtin_bit_cast(float, __builtin_amdgcn_readlane(iv, 48))));
}
DI float wave_sum(float v) {
#pragma unroll
    for (int o = 1; o < 64; o <<= 1) v += __shfl_xor(v, o);
    return v;
}
DI float dot2bf(unsigned a, unsigned b, float c) { return __builtin_amdgcn_fdot2_f32_bf16(__builtin_bit_cast(bf16x2_t, a), __builtin_bit_cast(bf16x2_t, b), c, false); }
DI f32x4 mfma16(bf16x8 a, bf16x8 b, f32x4 c) { return __builtin_amdgcn_mfma_f32_16x16x32_bf16(a, b, c, 0, 0, 0); }
DI s16x4 tr4(const LAS bf16* p) { return __builtin_bit_cast(s16x4, __builtin_amdgcn_ds_read_tr16_b64_v4i16((LAS v4i16_t*)p)); }
DI bf16x8 tr8(const LAS bf16* p, int stride) { const s16x4 a = tr4(p), b = tr4(p + 4 * stride); return (bf16x8){a[0], a[1], a[2], a[3], b[0], b[1], b[2], b[3]}; }

#define XB_TMO      128
#define XB_XCNT(j)  (256  + 64 * (j))
#define XB_XSUB(j)  (1280 + 64 * (j))
#define XB_XGEN(j)  (2304 + 64 * (j))
#define XB_TOP      3328
#define XB_TOPGEN   3392
#define XCD_BAR_WORDS 3456
#define XB_SPIN_CAP (1u << 18)

__device__ __forceinline__ unsigned xb_ld(unsigned* p)              { return __hip_atomic_load(p, __ATOMIC_RELAXED, __HIP_MEMORY_SCOPE_AGENT); }
__device__ __forceinline__ unsigned xb_add(unsigned* p, unsigned v) { return __hip_atomic_fetch_add(p, v, __ATOMIC_RELAXED, __HIP_MEMORY_SCOPE_AGENT); }
__device__ __forceinline__ unsigned xb_xcc_id() { return (unsigned)__builtin_amdgcn_s_getreg((3 << 11) | 20) & 0xFu; }
#define XB_SPIN(cond, bar) do { unsigned _sp = 0; while (cond) { __builtin_amdgcn_s_sleep(1); \
    if ((++_sp & 255u) == 0u) { if (xb_ld(&(bar)[XB_TMO])) break; if (_sp > XB_SPIN_CAP) { atomicAdd(&(bar)[XB_TMO], 1u); break; } } } } while (0)

struct XcdBarrier {
    unsigned* bar; unsigned x;
    volatile LAS unsigned* st;
};

__device__ __forceinline__ XcdBarrier xcd_barrier_post(unsigned* bar, volatile LAS unsigned* st) {
    XcdBarrier b; b.bar = bar; b.x = xb_xcc_id(); b.st = st;
    if (threadIdx.x == 0) (void)xb_add(&bar[XB_XCNT(b.x)], 1u);
    return b;
}
__device__ __forceinline__ void xcd_barrier_complete(unsigned* bar, unsigned x, unsigned& nloc, unsigned& nx) {
    const unsigned G = gridDim.x * gridDim.y * gridDim.z;
    unsigned sum, cnt, mine, sp = 0u;
    for (;;) {
        sum = 0u; cnt = 0u; mine = 0u;
#pragma unroll
        for (unsigned j = 0; j < 16; ++j) { const unsigned c = xb_ld(&bar[XB_XCNT(j)]); sum += c; cnt += (c > 0u) ? 1u : 0u; mine = (j == x) ? c : mine; }
        if (sum == G) break;
        __builtin_amdgcn_s_sleep(1);
        if ((++sp & 255u) == 0u) { if (xb_ld(&bar[XB_TMO])) break; if (sp > XB_SPIN_CAP) { atomicAdd(&bar[XB_TMO], 1u); break; } }
    }
    nloc = mine > 0u ? mine : 1u; nx = cnt > 0u ? cnt : 1u;
}

__device__ __forceinline__ void xcd_barrier(const XcdBarrier& b) {
    asm volatile("s_waitcnt vmcnt(0)" ::: "memory");
    __syncthreads();
    if (threadIdx.x == 0) {
        unsigned* bar = b.bar;
        __builtin_amdgcn_s_waitcnt(0);
        unsigned nloc = b.st[0], nx = b.st[1];
        if (nloc == 0u) { xcd_barrier_complete(bar, b.x, nloc, nx); b.st[0] = nloc; b.st[1] = nx; }
        const unsigned old = xb_add(&bar[XB_XSUB(b.x)], 1u);
        const unsigned gen = old / nloc;
        if (old + 1u == (gen + 1u) * nloc) {
            __builtin_amdgcn_fence(__ATOMIC_RELEASE, "agent");
            asm volatile("s_waitcnt vmcnt(0)" ::: "memory");
            const unsigned og = xb_add(&bar[XB_TOP], 1u);
            const unsigned tg = og / nx;
            if (og + 1u == (tg + 1u) * nx) xb_add(&bar[XB_TOPGEN], 1u);
            else XB_SPIN(xb_ld(&bar[XB_TOPGEN]) == tg, bar);
            __builtin_amdgcn_fence(__ATOMIC_ACQUIRE, "agent");
            xb_add(&bar[XB_XGEN(b.x)], 1u);
            asm volatile("s_waitcnt vmcnt(0)" ::: "memory");
        } else {
            XB_SPIN(xb_ld(&bar[XB_XGEN(b.x)]) == gen, bar);
            __builtin_amdgcn_fence(__ATOMIC_ACQUIRE, "agent");
            asm volatile("s_waitcnt vmcnt(0)" ::: "memory");
        }
    }
    __syncthreads();
}
struct Ctx {
    ldsp lds; int tid, lane, wave, bid, G, gw, NGW;
    unsigned char* ws;
};
DI const float* KARG(int k) { asm volatile("" : "+s"(k)); return ((const float* const*)__builtin_amdgcn_kernarg_segment_ptr())[k]; }
#define LDS_WAIT() asm volatile("s_waitcnt lgkmcnt(0)" ::: "memory")
enum { I_X = 0, I_C, I_ADAW, I_ADAB, I_N1G, I_WIN, I_WA2, I_BA, I_GNG, I_VNG, I_MWS, I_MB, I_MOG, I_WOUT, I_N2G, I_WQ, I_K1, I_K2, I_PU, I_PV, I_FG };

DI void p0_ada(const Ctx& C) {
    LAS float* red = (LAS float*)C.lds;
    float* MOD = (float*)(C.ws + WS_MOD);
    for (int it = C.bid; it < 256; it += C.G) {
        const int l = it >> 7, cg = it & 127, c0 = cg * 96 + (C.lane < 48 ? C.lane : 47) * 2;
        const float* W = KARG(I_ADAW) + (size_t)l * D * MODW + (size_t)(C.wave * 256) * MODW + c0;
        float cv[4][4];
#pragma unroll
        for (int b = 0; b < 4; ++b)
#pragma unroll
            for (int i = 0; i < 4; ++i) cv[b][i] = silu_f(KARG(I_C)[b * D + C.wave * 256 + i * 64 + C.lane]);
        float acc[4][2];
#pragma unroll
        for (int b = 0; b < 4; ++b) { acc[b][0] = 0.f; acc[b][1] = 0.f; }
#pragma unroll
        for (int i = 0; i < 4; ++i) {
#pragma unroll 16
            for (int j = 0; j < 64; ++j) {
                const f32x2 w = *(const f32x2*)(W + (size_t)(i * 64 + j) * MODW);
#pragma unroll
                for (int b = 0; b < 4; ++b) { const float s = __builtin_bit_cast(float, __builtin_amdgcn_readlane(__builtin_bit_cast(int, cv[b][i]), j)); acc[b][0] += s * w.x; acc[b][1] += s * w.y; }
            }
        }
#pragma unroll
        for (int b = 0; b < 4; ++b) *(LAS f32x2*)(red + (C.wave * 4 + b) * 128 + C.lane * 2) = (f32x2){acc[b][0], acc[b][1]};
        __syncthreads();
        { const int b = C.tid >> 7, col = C.tid & 127;
          if (col < 96) { float s = KARG(I_ADAB)[l * MODW + cg * 96 + col];
#pragma unroll
              for (int w = 0; w < 8; ++w) s += red[(w * 4 + b) * 128 + col];
              MOD[(size_t)(l * 4 + b) * MODW + cg * 96 + col] = s; } }
        __syncthreads();
    }
}
DI void transpose_item(const float* W, int ldw, int src_col0, int ncols, bf16* WT, int dst_row0, int k0, LAS float* scr, int lane) {
    const int cl = lane & 31;
    float v[32];
#pragma unroll
    for (int i = 0; i < 32; ++i) { const int kk = 2 * i + (lane >> 5); v[i] = 0.f; if (cl < ncols) v[i] = W[(size_t)(k0 + kk) * ldw + src_col0 + cl]; }
#pragma unroll
    for (int i = 0; i < 32; ++i) { const int kk = 2 * i + (lane >> 5); scr[kk * 33 + cl] = v[i]; }
    LDS_WAIT();
    const int c = lane & 7;
#pragma unroll
    for (int j = 0; j < 4; ++j) { const int n = (lane >> 3) + 8 * j;
        if (n < ncols) { const LAS float* s = scr + (8 * c) * 33 + n;
            u32x4 o; o.x = pk2(s[0 * 33], s[1 * 33]); o.y = pk2(s[2 * 33], s[3 * 33]); o.z = pk2(s[4 * 33], s[5 * 33]); o.w = pk2(s[6 * 33], s[7 * 33]);
            *(u32x4*)(WT + (size_t)(dst_row0 + n) * 2048 + k0 + 8 * c) = o; } }
    LDS_WAIT();
}
DI void p0_prologue(const Ctx& C
    ) {
#define PRO_MARK(K_) do { } while (0)
    p0_ada(C);
    PRO_MARK(0);
    LAS float* scr = (LAS float*)(C.lds + C.wave * 16384);
    constexpr int PER_L = (161 + 64 + 64) * 32;
    for (int it = C.gw; it < 2 * PER_L; it += C.NGW) {
        const int l = it / PER_L; int r = it % PER_L;
        if (r < 161 * 32) { const int kb = r / 161, nb = r % 161; bf16* WT = (bf16*)(C.ws + WS_WTIN) + (size_t)l * WTIN_L;
            const float* W = KARG(I_WIN) + (size_t)l * D * IN_COLS;
            if (nb < 160) { const int n0 = 32 * nb; transpose_item(W, IN_COLS, n0 + (n0 >= 3072 ? 16 : 0), 32, WT, n0, 64 * kb, scr, C.lane); }
            else transpose_item(W, IN_COLS, 3072, 16, WT, 5120, 64 * kb, scr, C.lane);
            continue; }
        r -= 161 * 32;
        if (r < 2048) { const int kb = r / 64, nb = r % 64; transpose_item(KARG(I_WOUT) + (size_t)l * D * D, D, 32 * nb, 32, (bf16*)(C.ws + WS_WTOUT) + (size_t)l * D * D, 32 * nb, 64 * kb, scr, C.lane); continue; }
        r -= 2048;
        { const int kb = r / 64, nb = r % 64; transpose_item(KARG(I_WQ) + (size_t)l * D * D, D, 32 * nb, 32, (bf16*)(C.ws + WS_WTQ) + (size_t)l * D * D, 32 * nb, 64 * kb, scr, C.lane); }
    }
    PRO_MARK(1);
    const int gt = C.bid * NTHR + C.tid, NT = C.G * NTHR;
    { bf16* K1B = (bf16*)(C.ws + WS_K1B); bf16* K2B = (bf16*)(C.ws + WS_K2B); bf16* WSB = (bf16*)(C.ws + WS_WSB);
      for (int q = gt; q < 65536; q += NT) {
          const f32x4 a = ((const f32x4*)KARG(I_K1))[q], b = ((const f32x4*)KARG(I_K2))[q], w = ((const f32x4*)KARG(I_MWS))[q];
          ((u32x2*)K1B)[q] = (u32x2){pk2(a.x, a.y), pk2(a.z, a.w)}; ((u32x2*)K2B)[q] = (u32x2){pk2(b.x, b.y), pk2(b.z, b.w)};
          const int i = 4 * q, s = i & 127, t = (i >> 7) & 127;
          ((u32x2*)WSB)[q] = (u32x2){pk2(s <= t ? w.x : 0.f, s + 1 <= t ? w.y : 0.f), pk2(s + 2 <= t ? w.z : 0.f, s + 3 <= t ? w.w : 0.f)}; } }
    PRO_MARK(2);
    { float* SU = (float*)(C.ws + WS_SU); int* KV = (int*)(C.ws + WS_KV);
      f32x4 v[8], vn[8];
      { const f32x4* src = (const f32x4*)(KARG(I_PU) + (size_t)C.gw * D) + C.lane;
#pragma unroll
        for (int j = 0; j < 8; ++j) v[j] = src[64 * j]; }
#pragma unroll 1
      for (int row = C.gw; row < 4 * NEXP; row += C.NGW) {
          const int tb = row >> 15, rr = row & 32767;
          { const int rown = row + C.NGW < 4 * NEXP ? row + C.NGW : row; const int tbn = rown >> 15, rrn = rown & 32767;
            const f32x4* src = (const f32x4*)(KARG(tbn ? I_PV : I_PU) + (size_t)rrn * D) + C.lane;
#pragma unroll
            for (int j = 0; j < 8; ++j) vn[j] = src[64 * j]; }
          const int lyr = rr >> 14, ee = rr & 16383;
          unsigned* dst = (unsigned*)(C.ws + (tb ? WS_PVB : WS_PUB) + (size_t)lyr * NEXP * D + (size_t)ee * 256) + C.lane;
          if (tb) {
              float mx = 0.f;
#pragma unroll
              for (int j = 0; j < 8; ++j) mx = fmaxf(mx, fmaxf(fmaxf(fabsf(v[j].x), fabsf(v[j].y)), fmaxf(fabsf(v[j].z), fabsf(v[j].w))));
              mx = wave_max_u(mx);
              int k = 0;
              if (mx > 0.f) { k = (int)((__builtin_bit_cast(unsigned, 224.0f / mx) >> 23) & 255u) - 127; k = k < -60 ? -60 : (k > 60 ? 60 : k); }
              const float sc = __builtin_bit_cast(float, (unsigned)(k + 127) << 23);
#pragma unroll
              for (int j = 0; j < 8; ++j) { int p = 0; p = __builtin_amdgcn_cvt_pk_fp8_f32(v[j].x * sc, v[j].y * sc, p, false); p = __builtin_amdgcn_cvt_pk_fp8_f32(v[j].z * sc, v[j].w * sc, p, true); dst[(size_t)j * (NEXP * 256 / 4)] = (unsigned)p; }
              if (C.lane == 0) KV[rr] = k;
          } else {
              unsigned* dst4 = (unsigned*)(C.ws + WS_PUB + (size_t)lyr * NEXP * (D / 2) + (size_t)ee * 128) + (C.lane >> 1);
#pragma unroll
              for (int j = 0; j < 8; ++j) {
                  const float mx = wave_max_u(fmaxf(fmaxf(fabsf(v[j].x), fabsf(v[j].y)), fmaxf(fabsf(v[j].z), fabsf(v[j].w))));
                  const float inv = mx > 0.f ? 7.0f / mx : 0.f;
                  const int q0 = (int)__builtin_rintf(v[j].x * inv), q1 = (int)__builtin_rintf(v[j].y * inv), q2 = (int)__builtin_rintf(v[j].z * inv), q3 = (int)__builtin_rintf(v[j].w * inv);
                  const unsigned nib = (unsigned)(q0 & 15) | ((unsigned)(q1 & 15) << 8) | ((unsigned)(q2 & 15) << 16) | ((unsigned)(q3 & 15) << 24);
                  const unsigned other = (unsigned)__builtin_amdgcn_update_dpp(0, (int)nib, 0xB1, 0xf, 0xf, true);
                  if ((C.lane & 1) == 0) dst4[(size_t)j * (NEXP * 128 / 4)] = nib | (other << 4);
                  if (C.lane == 0) SU[(size_t)(lyr * 8 + j) * NEXP + ee] = mx * (1.0f / 7.0f);
              }
          }
#pragma unroll
          for (int j = 0; j < 8; ++j) v[j] = vn[j];
      } }
    PRO_MARK(3);
#undef PRO_MARK
}
template <bool FP8 = false, bool XB = false>
DI void norm_phase(const Ctx& C, const void* Xv, const float* g, const float* modl, int sh_off, int sc_off, bf16* Hout, unsigned char* H8 = nullptr, float* HS = nullptr, int* COEF = nullptr) {
    const int r0 = C.gw * 8, b = r0 >> 12;
    if (FP8) {
        u32x4* cz = (u32x4*)(COEF + (size_t)r0 * 128) + C.lane;
        unsigned z_ = 0u; asm volatile("" : "+v"(z_));
#pragma unroll
        for (int j = 0; j < 4; ++j) cz[64 * j] = (u32x4){z_, z_, z_, z_}; }
    const f32x4* shp = (const f32x4*)(modl + (size_t)b * MODW + sh_off); const f32x4* scp = (const f32x4*)(modl + (size_t)b * MODW + sc_off);
    f32x4 gm[8], shv[8];
#pragma unroll
    for (int j = 0; j < 8; ++j) { const int idx = 64 * j + C.lane; gm[j] = ((const f32x4*)g)[idx] * (scp[idx] + 1.0f); shv[j] = shp[idx]; }
    u32x2 rb[8], rbn[8]; f32x4 rf[8], rfn[8];
    if (XB) { const u32x2* xr = (const u32x2*)((const bf16*)Xv + (size_t)r0 * D) + C.lane;
#pragma unroll
        for (int j = 0; j < 8; ++j) rb[j] = xr[64 * j]; }
    else { const f32x4* xr = (const f32x4*)((const float*)Xv + (size_t)r0 * D) + C.lane;
#pragma unroll
        for (int j = 0; j < 8; ++j) rf[j] = xr[64 * j]; }
#pragma unroll 1
    for (int i = 0; i < 8; ++i) {
        f32x4 v[8]; float s = 0.f;
        const int in_ = i + 1 < 8 ? i + 1 : i;
        if (XB) { const u32x2* xr = (const u32x2*)((const bf16*)Xv + (size_t)(r0 + in_) * D) + C.lane;
#pragma unroll
            for (int j = 0; j < 8; ++j) rbn[j] = xr[64 * j];
#pragma unroll
            for (int j = 0; j < 8; ++j) v[j] = (f32x4){bflo(rb[j].x), bfhi(rb[j].x), bflo(rb[j].y), bfhi(rb[j].y)}; }
        else { const f32x4* xr = (const f32x4*)((const float*)Xv + (size_t)(r0 + in_) * D) + C.lane;
#pragma unroll
            for (int j = 0; j < 8; ++j) rfn[j] = xr[64 * j];
#pragma unroll
            for (int j = 0; j < 8; ++j) v[j] = rf[j]; }
#pragma unroll
        for (int j = 0; j < 8; ++j) s += (v[j].x * v[j].x + v[j].y * v[j].y) + (v[j].z * v[j].z + v[j].w * v[j].w);
        const float rstd = frsq(wave_sum(s) * (1.f / D) + EPS);
        u32x2* o = (u32x2*)(Hout + (size_t)(r0 + i) * D) + C.lane;
#pragma unroll
        for (int j = 0; j < 8; ++j) { const f32x4 y = v[j] * rstd * gm[j] + shv[j]; u32x2 w; w.x = pk2(y.x, y.y); w.y = pk2(y.z, y.w); o[64 * j] = w;
            if (FP8) v[j] = y; }
        if (FP8) {
            float st[8];
            unsigned* h8 = (unsigned*)(H8 + (size_t)(r0 + i) * 2048) + (C.lane >> 1);
#pragma unroll
            for (int j = 0; j < 8; ++j) {
                const float am = wave_max_u(fmaxf(fmaxf(fabsf(v[j].x), fabsf(v[j].y)), fmaxf(fabsf(v[j].z), fabsf(v[j].w))));
                const float qs = am > 0.f ? 119.0f / am : 0.f; st[j] = am * (1.0f / 119.0f);
                const int q0 = (int)__builtin_rintf(v[j].x * qs), q1 = (int)__builtin_rintf(v[j].y * qs), q2 = (int)__builtin_rintf(v[j].z * qs), q3 = (int)__builtin_rintf(v[j].w * qs);
                const int a0 = (q0 + 8) >> 4, a1 = (q1 + 8) >> 4, a2 = (q2 + 8) >> 4, a3 = (q3 + 8) >> 4;
                const unsigned na = (unsigned)(a0 & 15) | ((unsigned)(a1 & 15) << 8) | ((unsigned)(a2 & 15) << 16) | ((unsigned)(a3 & 15) << 24);
                const unsigned nb = (unsigned)((q0 - 16 * a0) & 15) | ((unsigned)((q1 - 16 * a1) & 15) << 8) | ((unsigned)((q2 - 16 * a2) & 15) << 16) | ((unsigned)((q3 - 16 * a3) & 15) << 24);
                const unsigned oa = (unsigned)__builtin_amdgcn_update_dpp(0, (int)na, 0xB1, 0xf, 0xf, true), ob = (unsigned)__builtin_amdgcn_update_dpp(0, (int)nb, 0xB1, 0xf, 0xf, true);
                if ((C.lane & 1) == 0) { h8[32 * j] = na | (oa << 4); h8[256 + 32 * j] = nb | (ob << 4); } }
            if (C.lane == 0) { f32x4* hp = (f32x4*)(HS + (size_t)(r0 + i) * 8); hp[0] = (f32x4){st[0], st[1], st[2], st[3]}; hp[1] = (f32x4){st[4], st[5], st[6], st[7]}; }
        }
        if (XB) {
#pragma unroll
            for (int j = 0; j < 8; ++j) rb[j] = rbn[j]; }
        else {
#pragma unroll
            for (int j = 0; j < 8; ++j) rf[j] = rfn[j]; }
    }
}
DI void alow_phase(const Ctx& C, const bf16* Hb, const bf16* WtA, float* ALOW) {
    const int task = C.bid * 4 + (C.wave & 3), kh = C.wave >> 2, r0 = task * 16, fr = C.lane & 15, fq = C.lane >> 4;
    constexpr int WST = 2056;
    LAS bf16* wl = (LAS bf16*)(C.lds + 4096);
#pragma unroll
    for (int i = 0; i < 8; ++i) { const int c = C.tid + 512 * i, row = c >> 8, ch = c & 255; *(LAS u32x4*)(wl + row * WST + 8 * ch) = *(const u32x4*)(WtA + (size_t)row * D + 8 * ch); }
    const bf16* ap = Hb + (size_t)(r0 + fr) * D + 8 * fq + 1024 * kh; const LAS bf16* bp = wl + fr * WST + 8 * fq + 1024 * kh;
    bf16x8 av[32];
#pragma unroll
    for (int ks = 0; ks < 32; ++ks) av[ks] = *(const bf16x8*)(ap + 32 * ks);
    LDS_WAIT(); __builtin_amdgcn_s_barrier(); asm volatile("" ::: "memory");
    f32x4 acc = (f32x4){0.f, 0.f, 0.f, 0.f};
#pragma unroll
    for (int ks = 0; ks < 32; ++ks) { const bf16x8 b = *(const LAS bf16x8*)(bp + 32 * ks); acc = mfma16(av[ks], b, acc); }
    LAS f32x4* xch = (LAS f32x4*)C.lds + (C.wave & 3) * 64 + C.lane;
    if (kh) *xch = acc;
    LDS_WAIT(); __builtin_amdgcn_s_barrier(); asm volatile("" ::: "memory");
    if (!kh) { acc += *xch;
#pragma unroll
        for (int r = 0; r < 4; ++r) ALOW[(size_t)(r0 + 4 * fq + r) * 16 + fr] = acc[r]; }
}
#define LBAR() do { asm volatile("s_waitcnt lgkmcnt(0)" ::: "memory"); __builtin_amdgcn_s_barrier(); asm volatile("" ::: "memory"); } while (0)
DI void gla_gates(const Ctx& C, LAS float* al, LAS float* tot, const f32x4 alv, const float (&w2)[16], const float bav, float (&Gl)[16], float& off, float& gref, float& g63) {
    const int d = C.tid & 127, jg = C.tid >> 7;
    if (C.tid < 256) ((LAS f32x4*)al)[C.tid] = alv;
    LBAR();
    float run = 0.f;
#pragma unroll
    for (int jj = 0; jj < 16; ++jj) {
        const LAS f32x4* ar = (const LAS f32x4*)(al + (jg * 16 + jj) * 16);
        const f32x4 a0 = ar[0], a1 = ar[1], a2 = ar[2], a3 = ar[3];
        float z = bav;
        z += a0.x * w2[0] + a0.y * w2[1] + a0.z * w2[2] + a0.w * w2[3];
        z += a1.x * w2[4] + a1.y * w2[5] + a1.z * w2[6] + a1.w * w2[7];
        z += a2.x * w2[8] + a2.y * w2[9] + a2.z * w2[10] + a2.w * w2[11];
        z += a3.x * w2[12] + a3.y * w2[13] + a3.z * w2[14] + a3.w * w2[15];
        const float ls = fminf(z, 0.f) - 0.6931471806f * flog2(1.f + fexp2(-1.442695041f * fabsf(z)));
        run += ls * (1.442695041f / 16.f);
        Gl[jj] = run;
    }
    tot[jg * 128 + d] = run;
    LBAR();
    const float t0_ = tot[d], t1_ = tot[128 + d], t2_ = tot[256 + d], t3_ = tot[384 + d];
    off = (jg > 0 ? t0_ : 0.f) + (jg > 1 ? t1_ : 0.f) + (jg > 2 ? t2_ : 0.f); gref = t0_ + t1_; g63 = (t0_ + t1_) + (t2_ + t3_);
}
constexpr int KST = 136, VST = 264, PST = 72;
struct GlaIn { f32x4 alv; u32x4 qt[2], kt[2]; u32x4 vt[4]; };
template <bool WITHQ, bool WITHV = true>
DI void gla_load(const Ctx& C, int idx, const bf16* PROJ, const float* ALOW, GlaIn& in) {
    const int b = idx >> 8, h = (idx >> 6) & 3, n = idx & 63, t0 = b * SEQ + n * 64;
    in.alv = (f32x4){0.f, 0.f, 0.f, 0.f};
    if (C.tid < 256) in.alv = ((const f32x4*)(ALOW + (size_t)t0 * 16))[C.tid];
#pragma unroll
    for (int i = 0; i < 2; ++i) { const int c = C.tid + 512 * i, j = c >> 4, ec = c & 15; const bf16* row = PROJ + (size_t)(t0 + j) * NPROJ + h * 128 + 8 * ec;
        in.kt[i] = *(const u32x4*)(row + C_K); if (WITHQ) in.qt[i] = *(const u32x4*)(row + C_Q); }
    if (WITHV) {
#pragma unroll
    for (int i = 0; i < 4; ++i) { const int c = C.tid + 512 * i, j = c >> 5, ec = c & 31; in.vt[i] = *(const u32x4*)(PROJ + (size_t)(t0 + j) * NPROJ + C_V + h * 256 + 8 * ec); } }
}
DI void store_qk_raw(const Ctx& C, const GlaIn& in, LAS bf16* QR, LAS bf16* KR) {
#pragma unroll
    for (int i = 0; i < 2; ++i) { const int c = C.tid + 512 * i, j = c >> 4, ec = c & 15; *(LAS u32x4*)(KR + j * KST + 8 * ec) = in.kt[i]; if (QR) *(LAS u32x4*)(QR + j * KST + 8 * ec) = in.qt[i]; }
}
DI void gla_load_v(const Ctx& C, int idx, const bf16* PROJ, GlaIn& in) {
    const int b = idx >> 8, h = (idx >> 6) & 3, n = idx & 63, t0 = b * SEQ + n * 64;
#pragma unroll
    for (int i = 0; i < 4; ++i) { const int c = C.tid + 512 * i, j = c >> 5, ec = c & 31; in.vt[i] = *(const u32x4*)(PROJ + (size_t)(t0 + j) * NPROJ + C_V + h * 256 + 8 * ec); }
}
DI void store_v_tile(const Ctx& C, const GlaIn& in, LAS bf16* VL) {
#pragma unroll
    for (int i = 0; i < 4; ++i) { const int c = C.tid + 512 * i, j = c >> 5, ec = c & 31; *(LAS u32x4*)(VL + j * VST + 8 * ec) = in.vt[i]; }
}
DI void glaA_phase(const Ctx& C, int l, const bf16* PROJ, const float* ALOW, bf16* SBUF, float* DEC) {
    LAS float* al = (LAS float*)(C.lds); LAS float* tot = (LAS float*)(C.lds + 4096);
    LAS bf16* KD = (LAS bf16*)(C.lds + 8192); LAS bf16* VL = (LAS bf16*)(C.lds + 25600); LAS bf16* SL = (LAS bf16*)(C.lds + 59392);
    const int d = C.tid & 127, jg = C.tid >> 7, h = (C.bid >> 6) & 3;
    LAS float* W2L = (LAS float*)(C.lds + 135168);
    if (jg == 0) {
#pragma unroll
        for (int r = 0; r < 16; ++r) W2L[r * 128 + d] = KARG(I_WA2)[(size_t)l * 16 * 512 + r * 512 + h * 128 + d]; }
    LBAR();
    const float bav = KARG(I_BA)[(size_t)l * 512 + h * 128 + d];
    GlaIn cur, nxt;
    gla_load<false>(C, C.bid, PROJ, ALOW, cur);
#pragma unroll 1
    for (int i = 0; i < 4; ++i) {
        const int idx = i * C.G + C.bid;
        float Gl[16], off, gref, g63;
        store_qk_raw(C, cur, nullptr, KD);
        {   float w2[16];
#pragma unroll
            for (int r = 0; r < 16; ++r) w2[r] = W2L[r * 128 + d];
            gla_gates(C, al, tot, cur.alv, w2, bav, Gl, off, gref, g63); }
#pragma unroll
        for (int jj = 0; jj < 16; ++jj) { const int j = jg * 16 + jj; KD[j * KST + d] = (bf16)f2bf(bf1(KD[j * KST + d]) * fexp2(g63 - (off + Gl[jj]))); }
        store_v_tile(C, cur, VL);
        LBAR();
        if (i + 1 < 4) gla_load<false>(C, idx + C.G, PROJ, ALOW, nxt);
        if (jg == 0) DEC[(size_t)idx * 128 + d] = fexp2(g63);
        const int lane = C.lane, g = lane >> 4, qq = (lane & 15) >> 2, p = lane & 3, fr = lane & 15;
        bf16x8 A[2];
#pragma unroll
        for (int ks = 0; ks < 2; ++ks) A[ks] = tr8(KD + (32 * ks + 8 * g + qq) * KST + 16 * C.wave + 4 * p, KST);
        bf16* Sit = SBUF + (size_t)idx * 256 * 128;
#pragma unroll
        for (int half = 0; half < 2; ++half) {
            f32x4 acc[8];
#pragma unroll
            for (int nt = 0; nt < 8; ++nt) acc[nt] = (f32x4){0.f, 0.f, 0.f, 0.f};
#pragma unroll
            for (int nt = 0; nt < 8; ++nt)
#pragma unroll
                for (int ks = 0; ks < 2; ++ks) { const bf16x8 Bf = tr8(VL + (32 * ks + 8 * g + qq) * VST + 16 * (half * 8 + nt) + 4 * p, VST); acc[nt] = mfma16(A[ks], Bf, acc[nt]); }
#pragma unroll
            for (int nt = 0; nt < 8; ++nt) { const int e = 16 * (half * 8 + nt) + fr, dd = 16 * C.wave + 4 * g;
                u32x2 w; w.x = pk2(acc[nt][0], acc[nt][1]); w.y = pk2(acc[nt][2], acc[nt][3]); *(LAS u32x2*)(SL + e * KST + dd) = w; }
        }
        LBAR();
#pragma unroll
        for (int k = 0; k < 8; ++k) { const int c = C.tid + 512 * k, e = c >> 4, ch = c & 15; *(u32x4*)(Sit + (size_t)e * 128 + 8 * ch) = *(const LAS u32x4*)(SL + e * KST + 8 * ch); }
        cur = nxt;
    }
}
DI void scan_phase(const Ctx& C, bf16* SBUF, const float* DEC) {
    const int gt = C.bid * NTHR + C.tid, bh = gt >> 13, rem = gt & 8191, e = rem >> 5, dq = rem & 31;
    u32x2* p = (u32x2*)(SBUF + ((size_t)(bh * 64) * 256 + e) * 128 + 4 * dq);
    LAS f32x4* dl = (LAS f32x4*)C.lds;
    {   const f32x4* dsrc = (const f32x4*)(DEC + (size_t)(bh * 64) * 128) + C.tid;
#pragma unroll
        for (int i = 0; i < 4; ++i) dl[C.tid + 512 * i] = dsrc[512 * i];
        __syncthreads(); }
    f32x4 st = (f32x4){0.f, 0.f, 0.f, 0.f};
#pragma unroll 1
    for (int n0 = 0; n0 < 64; n0 += 8) {
        u32x2 tmp[8];
#pragma unroll
        for (int u = 0; u < 8; ++u) tmp[u] = p[(size_t)(n0 + u) * 8192];
#pragma unroll
        for (int u = 0; u < 8; ++u) { u32x2 w; w.x = pk2(st.x, st.y); w.y = pk2(st.z, st.w); p[(size_t)(n0 + u) * 8192] = w;
            st = dl[(n0 + u) * 32 + dq] * st + (f32x4){bflo(tmp[u].x), bfhi(tmp[u].x), bflo(tmp[u].y), bfhi(tmp[u].y)}; }
    }
}
DI void glaC_phase(const Ctx& C, int l, const bf16* PROJ, const float* ALOW, const bf16* SBUF, bf16* CONCAT) {
    const int h = (C.bid >> 6) & 3;
    LAS float* al = (LAS float*)(C.lds); LAS float* tot = (LAS float*)(C.lds + 4096); LAS float* RS = (LAS float*)(C.lds + 6144);
    LAS bf16* QT = (LAS bf16*)(C.lds + 8192); LAS bf16* KT = (LAS bf16*)(C.lds + 25600); LAS bf16* QG = (LAS bf16*)(C.lds + 43008);
    LAS bf16* VL = (LAS bf16*)(C.lds + 60416); LAS bf16* PL = (LAS bf16*)(C.lds + 94208);
    const int d = C.tid & 127, jg = C.tid >> 7;
    LAS float* W2L = (LAS float*)(C.lds + 135168);
    if (jg == 0) {
#pragma unroll
        for (int r = 0; r < 16; ++r) W2L[r * 128 + d] = KARG(I_WA2)[(size_t)l * 16 * 512 + r * 512 + h * 128 + d]; }
    LBAR();
    const float bav = KARG(I_BA)[(size_t)l * 512 + h * 128 + d];
    const float* ng = KARG(I_GNG) + (size_t)(l * 4 + h) * 256;
    GlaIn cur;
    f32x4 alv_n; u32x4 qtn[2], ktn[2];
    gla_load<true, false>(C, C.bid, PROJ, ALOW, cur);
#pragma unroll 1
    for (int it = 0; it < 4; ++it) {
    const int idx = it * C.G + C.bid, b = idx >> 8, n = idx & 63, t0 = b * SEQ + n * 64;
    gla_load_v(C, idx, PROJ, cur);
    const int lane = C.lane, g = lane >> 4, qq = (lane & 15) >> 2, p = lane & 3, fr = lane & 15;
    bf16x8 Sf[2][4]; u32x2 rraw[4][2];
#pragma unroll
    for (int mi = 0; mi < 2; ++mi) { const bf16* Srow = SBUF + ((size_t)idx * 256 + 16 * (2 * C.wave + mi) + fr) * 128 + 8 * g;
#pragma unroll
        for (int ks = 0; ks < 4; ++ks) Sf[mi][ks] = *(const bf16x8*)(Srow + 32 * ks); }
#pragma unroll
    for (int nt = 0; nt < 4; ++nt)
#pragma unroll
        for (int mi = 0; mi < 2; ++mi) rraw[nt][mi] = *(const u32x2*)(PROJ + (size_t)(t0 + 16 * nt + fr) * NPROJ + C_R + h * 256 + 16 * (2 * C.wave + mi) + 4 * g);
    store_qk_raw(C, cur, QT, KT);
    float Gl[16], off, gref, g63;
    {   float w2[16];
#pragma unroll
        for (int r = 0; r < 16; ++r) w2[r] = W2L[r * 128 + d];
        gla_gates(C, al, tot, cur.alv, w2, bav, Gl, off, gref, g63); }
#pragma unroll
    for (int jj = 0; jj < 16; ++jj) { const int j = jg * 16 + jj; const float Gv = off + Gl[jj];
        const float q = bf1(QT[j * KST + d]) * 0.08838834764831845f, k = bf1(KT[j * KST + d]);
        QT[j * KST + d] = (bf16)f2bf(q * fexp2(fminf(Gv - gref, 100.f))); KT[j * KST + d] = (bf16)f2bf(k * fexp2(fminf(gref - Gv, 100.f))); QG[j * KST + d] = (bf16)f2bf(q * fexp2(Gv)); }
    store_v_tile(C, cur, VL);
    LBAR();
    if (it + 1 < 4) { const int ix = idx + C.G, t1 = (ix >> 8) * SEQ + (ix & 63) * 64;
        alv_n = (f32x4){0.f, 0.f, 0.f, 0.f}; if (C.tid < 256) alv_n = ((const f32x4*)(ALOW + (size_t)t1 * 16))[C.tid];
#pragma unroll
        for (int i = 0; i < 2; ++i) { const int c = C.tid + 512 * i, j = c >> 4, ec = c & 15; const bf16* row = PROJ + (size_t)(t1 + j) * NPROJ + h * 128 + 8 * ec; ktn[i] = *(const u32x4*)(row + C_K); qtn[i] = *(const u32x4*)(row + C_Q); } }
    {
        const int nt = C.wave & 3;
#pragma unroll
        for (int mi = 0; mi < 2; ++mi) { const int mt = 2 * (C.wave >> 2) + mi; f32x4 acc = (f32x4){0.f, 0.f, 0.f, 0.f};
#pragma unroll
            for (int ks = 0; ks < 4; ++ks) { const bf16x8 a = *(const LAS bf16x8*)(KT + (16 * mt + fr) * KST + 32 * ks + 8 * g), bq = *(const LAS bf16x8*)(QT + (16 * nt + fr) * KST + 32 * ks + 8 * g); acc = mfma16(a, bq, acc); }
            const int i = 16 * nt + fr, j0 = 16 * mt + 4 * g;
            const float v0 = (j0 + 0 <= i) ? acc[0] : 0.f, v1 = (j0 + 1 <= i) ? acc[1] : 0.f, v2 = (j0 + 2 <= i) ? acc[2] : 0.f, v3 = (j0 + 3 <= i) ? acc[3] : 0.f;
            u32x2 w; w.x = pk2(v0, v1); w.y = pk2(v2, v3); *(LAS u32x2*)(PL + i * PST + j0) = w; }
    }
    LBAR();
    f32x4 acc[2][4];
#pragma unroll
    for (int mi = 0; mi < 2; ++mi)
#pragma unroll
        for (int nt = 0; nt < 4; ++nt) acc[mi][nt] = (f32x4){0.f, 0.f, 0.f, 0.f};
#pragma unroll
    for (int mi = 0; mi < 2; ++mi) { const int mt = 2 * C.wave + mi;
#pragma unroll
        for (int ks = 0; ks < 2; ++ks) { const bf16x8 a = tr8(VL + (32 * ks + 8 * g + qq) * VST + 16 * mt + 4 * p, VST);
#pragma unroll
            for (int nt = 0; nt < 4; ++nt) { const bf16x8 bp = *(const LAS bf16x8*)(PL + (16 * nt + fr) * PST + 32 * ks + 8 * g); acc[mi][nt] = mfma16(a, bp, acc[mi][nt]); } }
#pragma unroll
        for (int ks = 0; ks < 4; ++ks) { const bf16x8 a = Sf[mi][ks];
#pragma unroll
            for (int nt = 0; nt < 4; ++nt) { const bf16x8 bq = *(const LAS bf16x8*)(QG + (16 * nt + fr) * KST + 32 * ks + 8 * g); acc[mi][nt] = mfma16(a, bq, acc[mi][nt]); } }
    }
#pragma unroll
    for (int nt = 0; nt < 4; ++nt) { float s = 0.f;
#pragma unroll
        for (int mi = 0; mi < 2; ++mi) s += (acc[mi][nt][0] * acc[mi][nt][0] + acc[mi][nt][1] * acc[mi][nt][1]) + (acc[mi][nt][2] * acc[mi][nt][2] + acc[mi][nt][3] * acc[mi][nt][3]);
        s += __shfl_xor(s, 16); s += __shfl_xor(s, 32);
        if (g == 0) RS[C.wave * 64 + 16 * nt + fr] = s; }
    LBAR();
#pragma unroll
    for (int nt = 0; nt < 4; ++nt) { const int i = 16 * nt + fr; float ts = 0.f;
#pragma unroll
        for (int w = 0; w < 8; ++w) ts += RS[w * 64 + i];
        const float rstd = frsq(ts * (1.f / 256.f) + EPS);
#pragma unroll
        for (int mi = 0; mi < 2; ++mi) { const int e = 16 * (2 * C.wave + mi) + 4 * g;
            const u32x2 rr = rraw[nt][mi]; const f32x4 gg = *(const f32x4*)(ng + e);
            const float o0 = acc[mi][nt][0] * rstd * gg.x * silu_f(bflo(rr.x)), o1 = acc[mi][nt][1] * rstd * gg.y * silu_f(bfhi(rr.x));
            const float o2 = acc[mi][nt][2] * rstd * gg.z * silu_f(bflo(rr.y)), o3 = acc[mi][nt][3] * rstd * gg.w * silu_f(bfhi(rr.y));
            u32x2 w; w.x = pk2(o0, o1); w.y = pk2(o2, o3); *(LAS u32x2*)(VL + i * VST + e) = w; } }
    LBAR();
#pragma unroll
    for (int k = 0; k < 4; ++k) { const int c = C.tid + 512 * k, i = c >> 5, ec = c & 31; *(u32x4*)(CONCAT + (size_t)(t0 + i) * D + h * 256 + 8 * ec) = *(const LAS u32x4*)(VL + i * VST + 8 * ec); }
    LBAR();
    cur.alv = alv_n;
#pragma unroll
    for (int i = 0; i < 2; ++i) { cur.qt[i] = qtn[i]; cur.kt[i] = ktn[i]; }
    }
}
constexpr int GST = 136;
DI void gmlp_phase(const Ctx& C, int l, const bf16* PROJ, const bf16* WSB, bf16* CONCAT) {
    const int h = C.bid & 7;
    LAS bf16* VL2 = (LAS bf16*)(C.lds); LAS bf16* UL = (LAS bf16*)(C.lds + 34816);
    const float* vg = KARG(I_VNG) + (size_t)(l * 8 + h) * 128; const float* og = KARG(I_MOG) + (size_t)(l * 8 + h) * 128; const float* bb = KARG(I_MB) + (size_t)(l * 8 + h) * 128;
    bf16x8 Wf[4];
    { const bf16* Wrow = WSB + ((size_t)(l * 8 + h) * 128 + 16 * C.wave + (C.lane & 15)) * 128 + 8 * (C.lane >> 4);
#pragma unroll
      for (int ks = 0; ks < 4; ++ks) Wf[ks] = *(const bf16x8*)(Wrow + 32 * ks); }
    u32x4 cu[4], cv[4], nu[4], nv[4];
#define GM_LOAD(IDX, U, V) do { const int t0_ = ((IDX) >> 8) * SEQ + (((IDX) >> 3) & 31) * 128; _Pragma("unroll") for (int i = 0; i < 4; ++i) { const int c = C.tid + 512 * i, t = c >> 4, ch = c & 15; \
        const bf16* row = PROJ + (size_t)(t0_ + t) * NPROJ + h * 128 + 8 * ch; U[i] = *(const u32x4*)(row + C_U); V[i] = *(const u32x4*)(row + C_VS); } } while (0)
    GM_LOAD(C.bid, cu, cv);
#pragma unroll 1
    for (int it = 0; it < 4; ++it) {
    const int idx = it * C.G + C.bid, n = (idx >> 3) & 31, b = idx >> 8, t0 = b * SEQ + n * 128;
#pragma unroll
    for (int i = 0; i < 4; ++i) { const int c = C.tid + 512 * i, t = c >> 4, ch = c & 15;
        const u32x4 uu = cu[i], vv = cv[i];
        float v[8] = {gelu_t(bflo(vv.x)), gelu_t(bfhi(vv.x)), gelu_t(bflo(vv.y)), gelu_t(bfhi(vv.y)), gelu_t(bflo(vv.z)), gelu_t(bfhi(vv.z)), gelu_t(bflo(vv.w)), gelu_t(bfhi(vv.w))};
        float ss = 0.f;
#pragma unroll
        for (int k = 0; k < 8; ++k) ss += v[k] * v[k];
        ss += __shfl_xor(ss, 1); ss += __shfl_xor(ss, 2); ss += __shfl_xor(ss, 4); ss += __shfl_xor(ss, 8);
        const float rstd = frsq(ss * (1.f / 128.f) + EPS);
        const f32x4 g0 = *(const f32x4*)(vg + 8 * ch), g1 = *(const f32x4*)(vg + 8 * ch + 4);
        u32x4 wv; wv.x = pk2(v[0] * rstd * g0.x, v[1] * rstd * g0.y); wv.y = pk2(v[2] * rstd * g0.z, v[3] * rstd * g0.w); wv.z = pk2(v[4] * rstd * g1.x, v[5] * rstd * g1.y); wv.w = pk2(v[6] * rstd * g1.z, v[7] * rstd * g1.w);
        *(LAS u32x4*)(VL2 + t * GST + 8 * ch) = wv;
        u32x4 wu; wu.x = pk2(gelu_t(bflo(uu.x)), gelu_t(bfhi(uu.x))); wu.y = pk2(gelu_t(bflo(uu.y)), gelu_t(bfhi(uu.y))); wu.z = pk2(gelu_t(bflo(uu.z)), gelu_t(bfhi(uu.z))); wu.w = pk2(gelu_t(bflo(uu.w)), gelu_t(bfhi(uu.w)));
        *(LAS u32x4*)(UL + t * GST + 8 * ch) = wu; }
    LBAR();
    if (it + 1 < 4) GM_LOAD(idx + C.G, nu, nv);
    const int lane = C.lane, g = lane >> 4, qq = (lane & 15) >> 2, p = lane & 3, fr = lane & 15;
    f32x4 acc[8];
#pragma unroll
    for (int mt = 0; mt < 8; ++mt) acc[mt] = (f32x4){0.f, 0.f, 0.f, 0.f};
    const int nks = (C.wave >> 1) + 1;
#pragma unroll
    for (int ks = 0; ks < 4; ++ks) if (ks < nks) { const bf16x8 bw = Wf[ks];
#pragma unroll
        for (int mt = 0; mt < 8; ++mt) { const bf16x8 a = tr8(VL2 + (32 * ks + 8 * g + qq) * GST + 16 * mt + 4 * p, GST); acc[mt] = mfma16(a, bw, acc[mt]); } }
    const int tl = 16 * C.wave + fr; const float bt = bb[tl]; float ss = 0.f;
#pragma unroll
    for (int mt = 0; mt < 8; ++mt) { const u32x2 uu = *(const LAS u32x2*)(UL + tl * GST + 16 * mt + 4 * g);
        acc[mt][0] = bflo(uu.x) * (acc[mt][0] + bt); acc[mt][1] = bfhi(uu.x) * (acc[mt][1] + bt); acc[mt][2] = bflo(uu.y) * (acc[mt][2] + bt); acc[mt][3] = bfhi(uu.y) * (acc[mt][3] + bt);
        ss += (acc[mt][0] * acc[mt][0] + acc[mt][1] * acc[mt][1]) + (acc[mt][2] * acc[mt][2] + acc[mt][3] * acc[mt][3]); }
    ss += __shfl_xor(ss, 16); ss += __shfl_xor(ss, 32);
    const float rstd = frsq(ss * (1.f / 128.f) + EPS);
#pragma unroll
    for (int mt = 0; mt < 8; ++mt) { const f32x4 gg = *(const f32x4*)(og + 16 * mt + 4 * g);
        u32x2 w; w.x = pk2(acc[mt][0] * rstd * gg.x, acc[mt][1] * rstd * gg.y); w.y = pk2(acc[mt][2] * rstd * gg.z, acc[mt][3] * rstd * gg.w);
        *(LAS u32x2*)(UL + tl * GST + 16 * mt + 4 * g) = w; }
#pragma unroll
    for (int k = 0; k < 4; ++k) { const int c = lane + 64 * k, r = c >> 4, ch = c & 15; *(u32x4*)(CONCAT + (size_t)(t0 + 16 * C.wave + r) * D + 1024 + h * 128 + 8 * ch) = *(const LAS u32x4*)(UL + (16 * C.wave + r) * GST + 8 * ch); }
    LBAR();
#pragma unroll
    for (int i = 0; i < 4; ++i) { cu[i] = nu[i]; cv[i] = nv[i]; }
    }
#undef GM_LOAD
}
DI void list_insert(float (&L)[16], float x) {
#pragma unroll
    for (int i = 15; i >= 1; --i) L[i] = __builtin_amdgcn_fmed3f(x, L[i - 1], L[i]);
    L[0] = fmaxf(L[0], x);
}
DI void list_merge_xor(float (&L)[16], int mask) {
    float M[16];
#pragma unroll
    for (int i = 0; i < 16; ++i) M[i] = fmaxf(L[i], __shfl_xor(L[15 - i], mask));
#pragma unroll
    for (int s = 8; s >= 1; s >>= 1)
#pragma unroll
        for (int i = 0; i < 16; ++i) if ((i & s) == 0) { const float hi = fmaxf(M[i], M[i + s]), lo = fminf(M[i], M[i + s]); M[i] = hi; M[i + s] = lo; }
#pragma unroll
    for (int i = 0; i < 16; ++i) L[i] = M[i];
}
DI unsigned fbits(float x) { return __builtin_bit_cast(unsigned, x); }
DI float unp7(float x) { return __builtin_bit_cast(float, __builtin_bit_cast(unsigned, x) & 0xFFFFFF80u); }
constexpr int TKST = 136;
DI void topk_phase(const Ctx& C, int l, const bf16* QB, const bf16* K1B, const bf16* K2B, const int* KU, const int* KV, int* EB, float* PG) {
    LAS bf16* KL = (LAS bf16*)C.lds;
    LAS unsigned* tk = (LAS unsigned*)(C.lds + 2 * 128 * TKST * 2 + C.wave * 2048);
    const int lane = C.lane, fr = lane & 15, fq = lane >> 4, h = C.bid & 7, rank = C.bid >> 3;
#pragma unroll
    for (int i = 0; i < 8; ++i) { const int c = C.tid + 512 * i, tb = c >> 11, row = (c & 2047) >> 4, ch = c & 15;
        *(LAS u32x4*)(KL + (tb * 128 + row) * TKST + 8 * ch) = *(const u32x4*)((tb ? K2B : K1B) + ((size_t)(l * 8 + h) * 128 + row) * 128 + 8 * ch); }
    LAS signed char* kvl = (LAS signed char*)(C.lds + 2 * 128 * TKST * 2 + 8 * 2048);
    {   const int4* src = (const int4*)KV + C.tid;
#pragma unroll
        for (int i = 0; i < 8; ++i) { const int4 v = src[512 * i]; ((LAS unsigned*)kvl)[C.tid + 512 * i] = (unsigned)(v.x & 255) | ((unsigned)(v.y & 255) << 8) | ((unsigned)(v.z & 255) << 16) | ((unsigned)v.w << 24); } }
    __syncthreads();
    bf16x8 bq[2][4], bqn[2][4];
#pragma unroll
    for (int half = 0; half < 2; ++half)
#pragma unroll
        for (int ks = 0; ks < 4; ++ks) bq[half][ks] = *(const bf16x8*)(QB + (size_t)(rank * 512 + C.wave * 64 + fr) * D + h * 256 + half * 128 + 8 * fq + 32 * ks);
#pragma unroll 1
    for (int it = 0; it < 4; ++it) {
        const int tt0 = rank * 512 + C.wave * 64 + it * 16;
        float L[2][16];
        {   const int ttn = rank * 512 + C.wave * 64 + (it + 1 < 4 ? it + 1 : it) * 16;
#pragma unroll
            for (int half = 0; half < 2; ++half)
#pragma unroll
                for (int ks = 0; ks < 4; ++ks) bqn[half][ks] = *(const bf16x8*)(QB + (size_t)(ttn + fr) * D + h * 256 + half * 128 + 8 * fq + 32 * ks); }
#pragma unroll
        for (int half = 0; half < 2; ++half) {
            f32x4 acc[8];
#pragma unroll
            for (int mt = 0; mt < 8; ++mt) acc[mt] = (f32x4){0.f, 0.f, 0.f, 0.f};
            const LAS bf16* Kb = KL + (half * 128 + fr) * TKST + 8 * fq;
#pragma unroll
            for (int ks = 0; ks < 4; ++ks)
#pragma unroll
                for (int mt = 0; mt < 8; ++mt) { const bf16x8 a = *(const LAS bf16x8*)(Kb + (16 * mt) * TKST + 32 * ks); acc[mt] = mfma16(a, bq[half][ks], acc[mt]); }
#pragma unroll
            for (int i = 0; i < 16; ++i) L[half][i] = __builtin_bit_cast(float, 0xFF800000u);
#pragma unroll
            for (int mt = 0; mt < 8; ++mt)
#pragma unroll
                for (int r = 0; r < 4; ++r) { const unsigned key = (unsigned)(16 * mt + 4 * fq + r);
                    const float sv = acc[mt][r];
                    list_insert(L[half], __builtin_bit_cast(float, (fbits(sv) & 0xFFFFFF80u) | key)); }
            list_merge_xor(L[half], 16); list_merge_xor(L[half], 32);
        }
        if (fq == 0) {
#pragma unroll
            for (int i = 0; i < 16; ++i) { tk[(fr * 2 + 0) * 16 + i] = fbits(L[0][i]); tk[(fr * 2 + 1) * 16 + i] = fbits(L[1][i]); }
        }
        float Cn[16];
#pragma unroll
        for (int i = 0; i < 16; ++i) Cn[i] = __builtin_bit_cast(float, 0xFF800000u);
#pragma unroll
        for (int i = 0; i < 16; ++i)
#pragma unroll
            for (int j = 0; j < 16; ++j) if ((i + 1) * (j + 1) <= 16) {
                const float s = unp7(L[0][i]) + unp7(L[1][j]);
                list_insert(Cn, __builtin_bit_cast(float, (fbits(s) & 0xFFFFFF00u) | (unsigned)(i * 16 + j))); }
        LDS_WAIT();
        float sc[4]; int ex[4];
#pragma unroll
        for (int m = 0; m < 4; ++m) {
            const float ck = fq == 0 ? Cn[m] : (fq == 1 ? Cn[4 + m] : (fq == 2 ? Cn[8 + m] : Cn[12 + m]));
            const unsigned cc = fbits(ck) & 255u;
            const unsigned p1 = tk[(fr * 2 + 0) * 16 + (cc >> 4)], p2 = tk[(fr * 2 + 1) * 16 + (cc & 15u)];
            sc[m] = __builtin_bit_cast(float, p1 & 0xFFFFFF80u) + __builtin_bit_cast(float, p2 & 0xFFFFFF80u);
            ex[m] = (int)((p1 & 127u) * 128u + (p2 & 127u));
        }
        float mx = fmaxf(fmaxf(sc[0], sc[1]), fmaxf(sc[2], sc[3]));
        mx = fmaxf(mx, __shfl_xor(mx, 16)); mx = fmaxf(mx, __shfl_xor(mx, 32));
        float w[4], sum = 0.f;
#pragma unroll
        for (int m = 0; m < 4; ++m) { w[m] = fexp2((sc[m] - mx) * 1.442695041f); sum += w[m]; }
        sum += __shfl_xor(sum, 16); sum += __shfl_xor(sum, 32);
        const float inv = 1.0f / sum;
        const size_t o = (size_t)(tt0 + fr) * 128 + h * 16 + 4 * fq;
#pragma unroll
        for (int m = 0; m < 4; ++m) { const int kv = (int)kvl[ex[m]]; w[m] = w[m] * inv * __builtin_bit_cast(float, (unsigned)(127 - kv) << 23); }
        *(int4*)(EB + o) = make_int4((int)((f2bf(w[0]) << 16) | (unsigned)ex[0]), (int)((f2bf(w[1]) << 16) | (unsigned)ex[1]), (int)((f2bf(w[2]) << 16) | (unsigned)ex[2]), (int)((f2bf(w[3]) << 16) | (unsigned)ex[3]));
        LDS_WAIT();
#pragma unroll
        for (int half = 0; half < 2; ++half)
#pragma unroll
            for (int ks = 0; ks < 4; ++ks) bq[half][ks] = bqn[half][ks];
    }
}
typedef unsigned char fp8_t;
DI void unpack16(const u32x4 q, float (&f)[16]) {
#pragma unroll
    for (int w = 0; w < 4; ++w) { const int dw = (int)q[w]; const f32x2 lo = __builtin_amdgcn_cvt_pk_f32_fp8(dw, false), hi = __builtin_amdgcn_cvt_pk_f32_fp8(dw, true);
        f[4 * w] = lo.x; f[4 * w + 1] = lo.y; f[4 * w + 2] = hi.x; f[4 * w + 3] = hi.y; }
}
DI int sdot8(int a, int b, int c) { return __builtin_amdgcn_sdot8(a, b, c, false); }
template <int CTRL> DI int dppi(int v) { return __builtin_amdgcn_update_dpp(0, v, CTRL, 0xf, 0xf, true); }
template <int CTRL, int NV> DI void bfly(int (&p)[16], const bool up) {
#pragma unroll
    for (int m = 0; m < NV / 2; ++m) { const int lo = p[m], hi = p[m + NV / 2]; const int keep = up ? hi : lo, send = up ? lo : hi; p[m] = keep + dppi<CTRL>(send); }
}
#define PU_ADD(P, LO_, HI_) (void)__hip_atomic_fetch_add((P), (long long)(((unsigned long long)(unsigned)(HI_) << 32) + (unsigned long long)(long long)(LO_)), __ATOMIC_RELAXED, __HIP_MEMORY_SCOPE_AGENT)
DI void peerU_phase(const Ctx& C, const unsigned char* H8, const float* HS, const int* EB, const unsigned char* PU4, const float* SU, int* COEF, const int emask = 0x3FFF) {
    const int x = C.bid & 7, rank = C.bid >> 3, lane = C.lane, rg = lane >> 3, c8 = lane & 7;
    const __amdgpu_buffer_rsrc_t trs = __builtin_amdgcn_make_buffer_rsrc((void*)(PU4 + (size_t)x * NEXP * 128), 0, NEXP * 128, 0x00020000);
    LAS float* su = (LAS float*)C.lds;
    {   const f32x4* src = (const f32x4*)(SU + (size_t)x * NEXP) + C.tid;
#pragma unroll
        for (int i = 0; i < 8; ++i) ((LAS f32x4*)su)[C.tid + 512 * i] = src[512 * i];
        __syncthreads(); }
    const int tbase = rank * 512 + C.wave * 64;
    long long* part = (long long*)COEF + (size_t)tbase * 64 + lane;
    const int* ebase = EB + (size_t)tbase * 128 + lane;
    const unsigned char* hbase = H8 + (size_t)tbase * 2048 + 128 * x + 16 * c8;
    const float* hsb = HS + (size_t)tbase * 8 + x;
    const int bp0 = 32 * rg, loff = 16 * c8;
    const bool b2 = (c8 & 4) != 0, b1 = (c8 & 2) != 0, b0 = (c8 & 1) != 0;
    int en0 = ebase[0] & emask, en1 = ebase[64] & emask;
    int er0 = ebase[128], er1 = ebase[192];
    u32x4 ha = *(const u32x4*)hbase, hb = *(const u32x4*)(hbase + 1024);
    float sc0 = su[en0], sc1 = su[en1], hs = hsb[0];
    u32x4 buf[16];
#pragma unroll
    for (int u = 0; u < 16; ++u) { const int e = __builtin_amdgcn_ds_bpermute(bp0 + 4 * (u >> 1), (u & 1) ? en1 : en0); buf[u] = __builtin_amdgcn_raw_buffer_load_b128(trs, e * 128 + loff, 0, 0); }
    __builtin_amdgcn_sched_barrier(0);
    en0 = er0 & emask; en1 = er1 & emask;
    int pend0 = 0, pend1 = 0; long long* pend_p = part;
#pragma unroll 1
    for (int ti = 0; ti < 64; ++ti) {
        const int tn = ti + 1 < 64 ? ti + 1 : 63, t2 = ti + 2 < 64 ? ti + 2 : 63;
        er0 = ebase[t2 * 128]; er1 = ebase[t2 * 128 + 64];
        const u32x4 han = *(const u32x4*)(hbase + (size_t)tn * 2048), hbn = *(const u32x4*)(hbase + (size_t)tn * 2048 + 1024);
        const float scn0 = su[en0], scn1 = su[en1], hsn = hsb[tn * 8];
        __builtin_amdgcn_sched_barrier(0);
        int p[16];
#pragma unroll
        for (int u0 = 0; u0 < 16; u0 += 4) {
            int en[4];
#pragma unroll
            for (int u = u0; u < u0 + 4; ++u) en[u - u0] = __builtin_amdgcn_ds_bpermute(bp0 + 4 * (u >> 1), (u & 1) ? en1 : en0);
#pragma unroll
            for (int u = u0; u < u0 + 4; ++u) {
                const u32x4 r = buf[u];
                int a = sdot8((int)r.x, (int)ha.x, 0); a = sdot8((int)r.y, (int)ha.y, a); a = sdot8((int)r.z, (int)ha.z, a); a = sdot8((int)r.w, (int)ha.w, a);
                int b = sdot8((int)r.x, (int)hb.x, 0); b = sdot8((int)r.y, (int)hb.y, b); b = sdot8((int)r.z, (int)hb.z, b); b = sdot8((int)r.w, (int)hb.w, b);
                p[u] = (a << 4) + b; }
            asm volatile("" : "+v"(p[u0]), "+v"(p[u0 + 1]), "+v"(p[u0 + 2]), "+v"(p[u0 + 3]) :: "memory");
#pragma unroll
            for (int u = u0; u < u0 + 4; ++u) buf[u] = __builtin_amdgcn_raw_buffer_load_b128(trs, en[u - u0] * 128 + loff, 0, 0);
            if (u0 == 4) PU_ADD(pend_p, pend0, pend1);
            __builtin_amdgcn_sched_barrier(0);
        }
        bfly<0x141, 16>(p, b2);
        bfly<0x4E, 8>(p, b1);
        bfly<0xB1, 4>(p, b0);
        pend0 = (int)__builtin_rintf(fminf(fmaxf((float)p[0] * (sc0 * hs * 16384.0f), -2.0e9f), 2.0e9f)); pend1 = (int)__builtin_rintf(fminf(fmaxf((float)p[1] * (sc1 * hs * 16384.0f), -2.0e9f), 2.0e9f)); pend_p = part + (size_t)ti * 64;
        asm volatile("" : "+v"(er0), "+v"(er1) :: "memory");
        en0 = er0 & emask; en1 = er1 & emask; ha = han; hb = hbn; sc0 = scn0; sc1 = scn1; hs = hsn;
    }
    PU_ADD(pend_p, pend0, pend1);
#undef PU_ADD
}
typedef long i64_t;
constexpr int PV_BLK = 272;
DI void peerV_phase(const Ctx& C, const int* EB, const int* COEF, const fp8_t* PV8, bf16* X, const float* gate  , const int emask = 0x3FFF, const long wdelta = 0  ) {
    const int x = C.bid & 7, rank = C.bid >> 3, lane = C.lane, g = lane >> 4, i16 = lane & 15;
    const __amdgpu_buffer_rsrc_t trs = __builtin_amdgcn_make_buffer_rsrc((void*)(PV8 + (size_t)x * NEXP * 256), 0, NEXP * 256, 0x00020000);
    const int tbase = rank * 512 + C.wave * 64;
    ldsp wl = C.lds + C.wave * (8 * PV_BLK);
    const int wr_off = g * PV_BLK + 16 * i16;
    const int rd_off = ((((lane >> 1) & 1) * 4) + (lane & 1)) * PV_BLK + 16 * (lane >> 2);
    const int bp0 = 64 * g, loff = 16 * i16;
    const int ash = (i16 < 8) ? 24 : 16, asl = 8 * (i16 & 3); const unsigned amlo = (i16 & 4) ? 0u : 0xFFFFFFFFu, amhi = ~amlo;
    const int* ebase = EB + (size_t)tbase * 128 + lane; const long long* pbase = (const long long*)COEF + (size_t)tbase * 64 + lane;
    const int col = 256 * x + 4 * lane;
    const f32x4 gt = *(const f32x4*)(gate + (size_t)(tbase >> 12) * MODW + col);
    long long pcc;
#define PV_LOAD_RAW(tt) do { pcc = pbase[(tt) * 64]; } while (0)
#define PV_PACK(PK0, PK1, INVA, GW0, GW1, ID0, ID1) do { const float rg0 = __builtin_bit_cast(float, (unsigned)(GW0) & 0xffff0000u), rg1 = __builtin_bit_cast(float, (unsigned)(GW1) & 0xffff0000u); const int pc0 = (int)(unsigned)(unsigned long long)pcc, pc1 = (int)((pcc - (long long)pc0) >> 32); const float s0_ = (float)pc0 * (1.0f / 16384.0f), s1_ = (float)pc1 * (1.0f / 16384.0f); \
        const float a0_ = gelu_t(s0_) * rg0, a1_ = gelu_t(s1_) * rg1; const float amax_ = wave_max_u(fmaxf(fabsf(a0_), fabsf(a1_))); \
        int ka_ = 0; if (amax_ > 0.f) { ka_ = (int)((__builtin_bit_cast(unsigned, 224.0f / amax_) >> 23) & 255u) - 127; ka_ = ka_ < -100 ? -100 : (ka_ > 100 ? 100 : ka_); } \
        const float sca_ = __builtin_bit_cast(float, (unsigned)(ka_ + 127) << 23); INVA = __builtin_bit_cast(float, (unsigned)(127 - ka_) << 23); \
        const float h0_ = a0_ * sca_, h1_ = a1_ * sca_; const int ph_ = __builtin_amdgcn_cvt_pk_fp8_f32(h0_, h1_, 0, false); const f32x2 bk_ = __builtin_amdgcn_cvt_pk_f32_fp8(ph_, false); \
        const int pl_ = __builtin_amdgcn_cvt_pk_fp8_f32((h0_ - bk_.x) * 16.0f, (h1_ - bk_.y) * 16.0f, 0, false); \
        PK0 = (int)(((unsigned)(ph_ & 255) << 24) | ((unsigned)(pl_ & 255) << 16) | (unsigned)(ID0)); PK1 = (int)(((unsigned)(ph_ & 0xFF00) << 16) | ((unsigned)(pl_ & 0xFF00) << 8) | (unsigned)(ID1)); } while (0)
    int eg0 = ebase[0], eg1 = ebase[64];
    int er0 = ebase[128], er1 = ebase[192];
    const int e0 = eg0 & emask, e1 = eg1 & emask;
    PV_LOAD_RAW(0);
    u32x2* xp0 = (u32x2*)(X + (size_t)tbase * D + col);
    u32x2 xpend = *xp0; u32x2* xpend_p = (u32x2*)((bf16*)xp0 + wdelta);
    u32x4 buf[32];
#pragma unroll
    for (int u = 0; u < 32; ++u) { const int e = __builtin_amdgcn_ds_bpermute(bp0 + 4 * (u & 15), u < 16 ? e0 : e1); buf[u] = __builtin_amdgcn_raw_buffer_load_b128(trs, e * 256 + loff, 0, 0); }
    __builtin_amdgcn_sched_barrier(0);
    int pk0, pk1; float inva;
    PV_PACK(pk0, pk1, inva, eg0, eg1, er0 & emask, er1 & emask);
    eg0 = er0; eg1 = er1;
#pragma unroll 1
    for (int ti = 0; ti < 64; ++ti) {
        const int tn = ti + 1 < 64 ? ti + 1 : 63, t2 = ti + 2 < 64 ? ti + 2 : 63;
        er0 = ebase[t2 * 128]; er1 = ebase[t2 * 128 + 64];
        PV_LOAD_RAW(tn);
        u32x2* xp = (u32x2*)(X + (size_t)(tbase + ti) * D + col);
        const u32x2 xold = *xp;
        __builtin_amdgcn_sched_barrier(0);
        f32x4 d0 = (f32x4){0.f, 0.f, 0.f, 0.f}, d1 = d0;
#pragma unroll
        for (int u0 = 0; u0 < 32; u0 += 4) {
            int w[4];
#pragma unroll
            for (int u = u0; u < u0 + 4; ++u) w[u - u0] = __builtin_amdgcn_ds_bpermute(bp0 + 4 * (u & 15), u < 16 ? pk0 : pk1);
#pragma unroll
            for (int u = u0; u < u0 + 4; ++u) {
                const u32x4 r = buf[u]; const unsigned ab = (((unsigned)w[u - u0] >> ash) & 255u) << asl;
                const i64_t av = (i64_t)(((unsigned long long)(ab & amhi) << 32) | (ab & amlo));
                d0 = __builtin_amdgcn_mfma_f32_16x16x32_fp8_fp8(av, (i64_t)(((unsigned long long)r.y << 32) | r.x), d0, 0, 0, 0);
                d1 = __builtin_amdgcn_mfma_f32_16x16x32_fp8_fp8(av, (i64_t)(((unsigned long long)r.w << 32) | r.z), d1, 0, 0, 0); }
            asm volatile("" : "+v"(d0), "+v"(d1) :: "memory");
#pragma unroll
            for (int u = u0; u < u0 + 4; ++u) buf[u] = __builtin_amdgcn_raw_buffer_load_b128(trs, ((w[u - u0] & 0x3FFF) << 8) + loff, 0, 0);
            if (u0 == 12) *xpend_p = xpend;
            __builtin_amdgcn_sched_barrier(0);
        }
        *(LAS f32x4*)(wl + wr_off) = d0; *(LAS f32x4*)(wl + wr_off + 4 * PV_BLK) = d1;
        const f32x4 yh = *(const LAS f32x4*)(wl + rd_off), yl = *(const LAS f32x4*)(wl + rd_off + 2 * PV_BLK);
        const f32x4 y = (yh + yl * 0.0625f) * inva;
        {   const f32x4 xn = (f32x4){bflo(xold.x), bfhi(xold.x), bflo(xold.y), bfhi(xold.y)} + gt * y; xpend.x = pk2(xn.x, xn.y); xpend.y = pk2(xn.z, xn.w); }
        xpend_p = (u32x2*)((bf16*)xp + wdelta);
        asm volatile("" : "+v"(er0), "+v"(er1) :: "memory");
        PV_PACK(pk0, pk1, inva, eg0, eg1, er0 & emask, er1 & emask);
        eg0 = er0; eg1 = er1;
    }
    *xpend_p = xpend;
#undef PV_LOAD_RAW
#undef PV_PACK
}
DI void final_norm_phase(const Ctx& C, const bf16* XBp, float* OUT, const float* g) {
    const int r0 = C.gw * 8;
    f32x4 gm[8];
#pragma unroll
    for (int j = 0; j < 8; ++j) gm[j] = ((const f32x4*)g)[64 * j + C.lane];
    u32x2 rb[8], rbn[8];
    { const u32x2* xr = (const u32x2*)(XBp + (size_t)r0 * D) + C.lane;
#pragma unroll
      for (int j = 0; j < 8; ++j) rb[j] = xr[64 * j]; }
#pragma unroll 1
    for (int i = 0; i < 8; ++i) {
        const int in_ = i + 1 < 8 ? i + 1 : i;
        { const u32x2* xr = (const u32x2*)(XBp + (size_t)(r0 + in_) * D) + C.lane;
#pragma unroll
          for (int j = 0; j < 8; ++j) rbn[j] = xr[64 * j]; }
        f32x4* orow = (f32x4*)(OUT + (size_t)(r0 + i) * D) + C.lane; f32x4 v[8]; float s = 0.f;
#pragma unroll
        for (int j = 0; j < 8; ++j) { const u32x2 w = rb[j]; v[j] = (f32x4){bflo(w.x), bfhi(w.x), bflo(w.y), bfhi(w.y)}; s += (v[j].x * v[j].x + v[j].y * v[j].y) + (v[j].z * v[j].z + v[j].w * v[j].w); }
        const float rstd = frsq(wave_sum(s) * (1.f / D) + EPS);
#pragma unroll
        for (int j = 0; j < 8; ++j) orow[64 * j] = v[j] * rstd * gm[j];
#pragma unroll
        for (int j = 0; j < 8; ++j) rb[j] = rbn[j];
    }
}
#ifndef PH_MASK
#define PH_MASK 0xFFFFF
#endif
#define EN(k) (((PH_MASK) >> (k)) & 1)
#ifndef GEMM_SP2
#define GEMM_SP2 true
#endif
#ifndef GEMM_ALIGN
#define GEMM_ALIGN false
#endif
constexpr int NKIND = 11, NPH = 2 + 2 * NKIND;
struct Args { const float* in[21]; float* out; unsigned char* ws; int ph_lo, ph_hi, pad0, pad1; };
__global__ void __launch_bounds__(NTHR, 2) mk_fwd(Args args) {
    extern __shared__ __attribute__((aligned(16))) unsigned char lds_raw[];
    ldsp ldsb = (ldsp)lds_raw;
    volatile LAS unsigned* MISC = (volatile LAS unsigned*)(ldsb + MISC_OFF);
    for (int u = threadIdx.x; u < (LDS_BYTES - LDSCTL_OFF) / 4; u += NTHR) ((LAS unsigned*)(ldsb + LDSCTL_OFF))[u] = 0u;
    __syncthreads();
    unsigned* barw = (unsigned*)(args.ws + WS_CTL) + CW_BAR;
    XcdBarrier bar; bar.bar = barw; bar.x = 0; bar.st = nullptr;
    const bool multi = (args.ph_hi - args.ph_lo) > 1;
    if (multi) bar = xcd_barrier_post(barw, MISC + 8);

#pragma unroll 1
    for (int ph = args.ph_lo; ph < args.ph_hi; ++ph) {
#define MKCTX Ctx C; { int tid_ = threadIdx.x, bid_ = blockIdx.x; asm volatile("" : "+v"(tid_)); asm volatile("" : "+s"(bid_)); \
        C.lds = ldsb; C.tid = tid_; C.lane = tid_ & 63; C.wave = __builtin_amdgcn_readfirstlane(tid_ >> 6); C.bid = bid_; C.G = gridDim.x; C.gw = C.bid * NWAVES + C.wave; C.NGW = C.G * NWAVES; \
        C.ws = args.ws; }
        unsigned char* const wsb = args.ws;
        float* MOD = (float*)(wsb + WS_MOD);
        bf16* Hb = (bf16*)(wsb + WS_H); bf16* PROJ = (bf16*)(wsb + WS_PROJ); bf16* SBUF = (bf16*)(wsb + WS_SBUF); bf16* CONCAT = (bf16*)(wsb + WS_CONCAT); bf16* QB = (bf16*)(wsb + WS_QB);
        float* ALOW = (float*)(wsb + WS_ALOW); float* DEC = (float*)(wsb + WS_DEC); int* EB = (int*)(wsb + WS_EB); float* PG = (float*)(wsb + WS_PG);
        bf16* X = (bf16*)(wsb + WS_XB);
        const int l = ph < 2 ? 0 : (ph - 2) / NKIND, kind = ph < 2 ? -1 : (ph - 2) % NKIND;
        const float* modl = MOD + (size_t)l * 4 * MODW;
        if (ph == 0) { if (EN(0)) { MKCTX; p0_prologue(C); } }
        else if (ph == 1) { if (EN(1)) { MKCTX; norm_phase(C, KARG(I_X), KARG(I_N1G), modl, 0, D, Hb); } }
        else if ((kind == 0 || kind == 6) && EN(2)) {
            MKCTX; const bool isq = (kind == 6);
            pg8::Gemm g{Hb, isq ? (const bf16*)(wsb + WS_WTQ) + (size_t)l * D * D : (const bf16*)(wsb + WS_WTIN) + (size_t)l * WTIN_L, T, isq ? D : NPROJ, D};
            pg8::StaticOrder S; S.init(T, g.N, C.G, C.bid);
            pg8::EpiBf16 E{isq ? QB : PROJ, isq ? D : NPROJ};
            pg8::gemm_phase<pg8::EpiBf16, pg8::StaticOrder, GEMM_ALIGN, GEMM_SP2>(C.lds, g, S, E, C.tid);
            if (!isq) alow_phase(C, Hb, (const bf16*)(wsb + WS_WTIN) + (size_t)l * WTIN_L + (size_t)NPROJ * D, ALOW);
        }
        else if (kind == 1 && EN(3)) {
            MKCTX;
            glaA_phase(C, l, PROJ, ALOW, SBUF, DEC);
            gmlp_phase(C, l, PROJ, (const bf16*)(wsb + WS_WSB), CONCAT);
        }
        else if (kind == 2) { if (EN(4)) { MKCTX; scan_phase(C, SBUF, DEC); } }
        else if (kind == 3 && EN(5)) { MKCTX; glaC_phase(C, l, PROJ, ALOW, SBUF, CONCAT); }
        else if (kind == 4 && EN(6)) {
            MKCTX;
            pg8::Gemm g{CONCAT, (const bf16*)(wsb + WS_WTOUT) + (size_t)l * D * D, T, D, D};
            pg8::StaticOrder S; S.init(T, D, C.G, C.bid);
            pg8::EpiResGate E{l == 0 ? KARG(I_X) : (const float*)nullptr, X, X, modl + 2 * D, MODW};
            pg8::gemm_phase<pg8::EpiResGate, pg8::StaticOrder, GEMM_ALIGN, GEMM_SP2>(C.lds, g, S, E, C.tid);
        }
        else if (kind == 5) { if (EN(1)) { MKCTX; norm_phase<true, true>(C, X, KARG(I_N2G) + (size_t)l * D, modl, 3 * D, 4 * D, Hb, wsb + WS_H8, (float*)(wsb + WS_HS), (int*)(wsb + WS_COEF)); } }
        else if (kind == 7) { if (EN(7)) { MKCTX; topk_phase(C, l, QB, (const bf16*)(wsb + WS_K1B), (const bf16*)(wsb + WS_K2B), (const int*)(wsb + WS_KU) + l * NEXP, (const int*)(wsb + WS_KV) + l * NEXP, EB, PG); } }
        else if (kind == 8) { if (EN(8)) { MKCTX; peerU_phase(C, wsb + WS_H8, (const float*)(wsb + WS_HS), EB, wsb + WS_PUB + (size_t)l * NEXP * (D / 2), (const float*)(wsb + WS_SU) + (size_t)l * 8 * NEXP, (int*)(wsb + WS_COEF)); } }
        else if (kind == 9) { if (EN(9)) { MKCTX; peerV_phase(C, EB, (const int*)(wsb + WS_COEF), (const fp8_t*)(wsb + WS_PVB) + (size_t)l * NEXP * D, X, modl + 5 * D); } }
        else if (EN(10)) {
            MKCTX;
            if (l == DEPTH - 1) final_norm_phase(C, X, args.out, KARG(I_FG));
            else norm_phase<false, true>(C, X, KARG(I_N1G) + (size_t)(l + 1) * D, MOD + (size_t)(l + 1) * 4 * MODW, 0, D, Hb);
        }
        if (ph + 1 < args.ph_hi) xcd_barrier(bar);
    }
}

extern "C" void kernel_launch(void* const* d_in, const int* in_sizes, int n_in, void* d_out, int out_size, void* d_ws, size_t ws_size, hipStream_t stream) {
    static int grid = 0;
    if (grid == 0) {
        if (n_in != 21 || out_size != T * D || ws_size < WS_END) { fprintf(stderr, "kernel_launch: unexpected shapes (n_in %d, out %d, ws %zu)\n", n_in, out_size, ws_size); grid = -1; return; }
        int dev = 0, cus = 0, per_cu = 0;
        if (hipGetDevice(&dev) != hipSuccess || hipDeviceGetAttribute(&cus, hipDeviceAttributeMultiprocessorCount, dev) != hipSuccess) { grid = -1; return; }
        if (hipFuncSetAttribute((const void*)mk_fwd, hipFuncAttributeMaxDynamicSharedMemorySize, LDS_BYTES) != hipSuccess) { fprintf(stderr, "kernel_launch: hipFuncSetAttribute failed\n"); grid = -1; return; }
        if (hipOccupancyMaxActiveBlocksPerMultiprocessor(&per_cu, (const void*)mk_fwd, NTHR, LDS_BYTES) != hipSuccess || per_cu < 1) { fprintf(stderr, "kernel_launch: occupancy query says %d blocks per CU\n", per_cu); (void)hipGetLastError(); grid = -1; return; }
        if (cus != 256) { fprintf(stderr, "kernel_launch: built for a 256-CU device (got %d)\n", cus); grid = -1; return; }
        grid = cus;
    }
    if (grid < 0) return;
    (void)hipMemsetAsync((char*)d_ws + WS_CTL, 0, CTL_ZERO_BYTES, stream);
    Args a{};
    for (int i = 0; i < 21; ++i) a.in[i] = (const float*)d_in[i];
    a.out = (float*)d_out; a.ws = (unsigned char*)d_ws;
#if MK_N_LAUNCHES == 1
    a.ph_lo = 0; a.ph_hi = NPH;
    hipLaunchKernelGGL(mk_fwd, dim3(grid), dim3(NTHR), LDS_BYTES, stream, a);
#else
    for (int p = 0; p < NPH; ++p) { a.ph_lo = p; a.ph_hi = p + 1; hipLaunchKernelGGL(mk_fwd, dim3(grid), dim3(NTHR), LDS_BYTES, stream, a); }
#endif
}
```
